# Optimizing an MI355X kernel written in HIP

```python
import math
import jax, jax.numpy as jnp
from jax import lax
import numpy as np

D_MODEL = 2048
BATCH = 8
SEQ = 4096
DEPTH = 1

D_MIX = D_MODEL
D_ATTN = D_MIX // 2
D_CONV = D_MIX - D_ATTN
ATTN_HEAD_DIM = 64
ATTN_VALUE_DIM = 2 * ATTN_HEAD_DIM
N_ATTN_HEADS = D_ATTN // ATTN_VALUE_DIM
QK_COLS = N_ATTN_HEADS * 2 * ATTN_HEAD_DIM
V_COLS = N_ATTN_HEADS * ATTN_VALUE_DIM
GLU_COLS = 2 * D_CONV
D_IN_PROJ = 2 * QK_COLS + V_COLS + GLU_COLS
CONV_WIDTH = 31
QUERY_BLOCK = 128
REL_BUCKETS = 32
REL_MAX_EXACT = REL_BUCKETS // 2
REL_MAX_DISTANCE = 128
PEER_HEADS = 8
PEER_N_KEYS = 128
PEER_N_EXPERTS = PEER_N_KEYS * PEER_N_KEYS
PEER_KEY_DIM = 256
PEER_HALF_DIM = PEER_KEY_DIM // 2
PEER_TOPK = 16
PEER_TOKEN_BLOCK = 128
LN_EPS = 1e-5
DEEPNORM_ALPHA = (2.0 * DEPTH) ** 0.25
DEEPNORM_BETA = (8.0 * DEPTH) ** -0.25

kernel_name = "hybrid_diffattn_conformer_peer_deepnorm"


def _layer_norm(x, g, b):
    xf = x.astype(jnp.float32)
    mu = jnp.mean(xf, axis=-1, keepdims=True)
    var = jnp.mean(jnp.square(xf - mu), axis=-1, keepdims=True)
    y = (xf - mu) * lax.rsqrt(var + LN_EPS)
    return (y * g.astype(jnp.float32) + b.astype(jnp.float32)).astype(x.dtype)


def _rms_norm(x, g):
    xf = x.astype(jnp.float32)
    y = xf * lax.rsqrt(jnp.mean(jnp.square(xf), axis=-1, keepdims=True) + LN_EPS)
    return (y * g.astype(jnp.float32)).astype(x.dtype)


def _t5_bucket(dist):
    n_f = jnp.maximum(dist, 1).astype(jnp.float32)
    large = REL_MAX_EXACT + (
        jnp.log(n_f / REL_MAX_EXACT) / math.log(REL_MAX_DISTANCE / REL_MAX_EXACT)
        * (REL_BUCKETS - REL_MAX_EXACT)).astype(jnp.int32)
    large = jnp.minimum(large, REL_BUCKETS - 1)
    return jnp.where(dist < REL_MAX_EXACT, dist, large)


def _diff_attention(q, k, v, lam, rel_bias):
    B, S = q.shape[0], q.shape[1]
    nb = S // QUERY_BLOCK
    q_blocks = q.reshape(B, nb, QUERY_BLOCK, N_ATTN_HEADS, 2, ATTN_HEAD_DIM).transpose(1, 0, 3, 4, 2, 5)
    kt = k.transpose(0, 2, 3, 1, 4)
    vt = v.transpose(0, 2, 1, 3)
    key_pos = jnp.arange(S, dtype=jnp.int32)
    scale = ATTN_HEAD_DIM ** -0.5

    def block(args):
        q_blk, start = args
        q_pos = start + jnp.arange(QUERY_BLOCK, dtype=jnp.int32)
        dist = q_pos[:, None] - key_pos[None, :]
        bias = rel_bias[_t5_bucket(jnp.maximum(dist, 0))].transpose(2, 0, 1)
        logits = jnp.einsum('bhcqd,bhckd->bhcqk', q_blk, kt).astype(jnp.float32) * scale
        logits = logits + bias[None, :, None].astype(jnp.float32)
        logits = jnp.where((dist >= 0)[None, None, None], logits, -jnp.inf)
        p = jax.nn.softmax(logits, axis=-1)
        p = (p[:, :, 0] - lam * p[:, :, 1]).astype(vt.dtype)
        return jnp.einsum('bhqk,bhkd->bqhd', p, vt)

    starts = jnp.arange(nb, dtype=jnp.int32) * QUERY_BLOCK
    out = lax.map(block, (q_blocks, starts))
    return out.transpose(1, 0, 2, 3, 4).reshape(B, S, N_ATTN_HEADS, ATTN_VALUE_DIM)


def _conformer_conv(glu_in, b_glu, conv_w, conv_b, ln_g, ln_b):
    h = glu_in + b_glu
    a, gate = jnp.split(h, 2, axis=-1)
    h = a * jax.nn.sigmoid(gate)
    h = lax.conv_general_dilated(
        h, conv_w.reshape(CONV_WIDTH, 1, D_CONV).astype(h.dtype),
        window_strides=(1,), padding=[(CONV_WIDTH - 1, 0)],
        dimension_numbers=('NWC', 'WIO', 'NWC'), feature_group_count=D_CONV) + conv_b
    return jax.nn.silu(_layer_norm(h, ln_g, ln_b))


def _peer(x, wq, sub_keys, u_table, v_table):
    B, S, D = x.shape
    tokens = x.reshape(-1, PEER_TOKEN_BLOCK, D)

    def chunk(xc):
        T = xc.shape[0]
        q = (xc @ wq).reshape(T, PEER_HEADS, 2, PEER_HALF_DIM)
        s = jnp.einsum('thcd,hcnd->thcn', q, sub_keys)
        s1, i1 = lax.top_k(s[:, :, 0], PEER_TOPK)
        s2, i2 = lax.top_k(s[:, :, 1], PEER_TOPK)
        cand = (s1[..., :, None] + s2[..., None, :]).reshape(T, PEER_HEADS, PEER_TOPK * PEER_TOPK)
        sc, ci = lax.top_k(cand, PEER_TOPK)
        e = (jnp.take_along_axis(i1, ci // PEER_TOPK, axis=-1) * PEER_N_KEYS
             + jnp.take_along_axis(i2, ci % PEER_TOPK, axis=-1))
        g = jax.nn.softmax(sc.astype(jnp.float32), axis=-1).astype(xc.dtype)
        u = u_table[e]
        act = jax.nn.gelu(jnp.einsum('td,thkd->thk', xc, u), approximate=False)
        return jnp.einsum('thk,thkd->td', g * act, v_table[e])

    return lax.map(chunk, tokens).reshape(B, S, D)


def setup_inputs(seed: int = 0) -> dict:
    key = jax.random.key(seed)
    ks = jax.random.split(key, 24)
    f32 = jnp.float32
    nrm = lambda k, shape: jax.random.normal(k, shape, f32)
    L = DEPTH
    return {
        "x": nrm(ks[0], (BATCH, SEQ, D_MODEL)),
        "w_in": nrm(ks[1], (L, D_MODEL, D_IN_PROJ)) * D_MODEL ** -0.5,
        "b_glu": 0.02 * nrm(ks[2], (L, GLU_COLS)),
        "conv_w": nrm(ks[3], (L, CONV_WIDTH, D_CONV)) * CONV_WIDTH ** -0.5,
        "conv_b": 0.02 * nrm(ks[4], (L, D_CONV)),
        "conv_ln_g": 1.0 + 0.02 * nrm(ks[5], (L, D_CONV)),
        "conv_ln_b": 0.02 * nrm(ks[6], (L, D_CONV)),
        "lambda_q1": 0.1 * nrm(ks[7], (L, ATTN_HEAD_DIM)),
        "lambda_k1": 0.1 * nrm(ks[8], (L, ATTN_HEAD_DIM)),
        "lambda_q2": 0.1 * nrm(ks[9], (L, ATTN_HEAD_DIM)),
        "lambda_k2": 0.1 * nrm(ks[10], (L, ATTN_HEAD_DIM)),
        "subln_g": 1.0 + 0.02 * nrm(ks[11], (L, ATTN_VALUE_DIM)),
        "rel_bias": 0.1 * nrm(ks[12], (REL_BUCKETS, N_ATTN_HEADS)),
        "w_out": nrm(ks[13], (L, D_MIX, D_MODEL)) * (D_MIX ** -0.5) * DEEPNORM_BETA,
        "ln1_g": 1.0 + 0.02 * nrm(ks[14], (L, D_MODEL)),
        "ln1_b": 0.02 * nrm(ks[15], (L, D_MODEL)),
        "peer_wq": nrm(ks[16], (L, D_MODEL, PEER_HEADS * PEER_KEY_DIM)) * D_MODEL ** -0.5,
        "peer_keys": nrm(ks[17], (L, PEER_HEADS, 2, PEER_N_KEYS, PEER_HALF_DIM)) * PEER_HALF_DIM ** -0.5,
        "peer_u": nrm(ks[18], (L, PEER_N_EXPERTS, D_MODEL)) * D_MODEL ** -0.5,
        "peer_v": nrm(ks[19], (L, PEER_N_EXPERTS, D_MODEL)) * DEEPNORM_BETA,
        "ln2_g": 1.0 + 0.02 * nrm(ks[20], (L, D_MODEL)),
        "ln2_b": 0.02 * nrm(ks[21], (L, D_MODEL)),
    }


def reference(x, w_in, b_glu, conv_w, conv_b, conv_ln_g, conv_ln_b,
              lambda_q1, lambda_k1, lambda_q2, lambda_k2, subln_g, rel_bias,
              w_out, ln1_g, ln1_b, peer_wq, peer_keys, peer_u, peer_v,
              ln2_g, ln2_b):
    B, S, _ = x.shape
    for layer in range(DEPTH):
        proj = jnp.einsum('bsd,de->bse', x, w_in[layer])
        q = proj[..., :QK_COLS].reshape(B, S, N_ATTN_HEADS, 2, ATTN_HEAD_DIM)
        k = proj[..., QK_COLS:2 * QK_COLS].reshape(B, S, N_ATTN_HEADS, 2, ATTN_HEAD_DIM)
        v = proj[..., 2 * QK_COLS:2 * QK_COLS + V_COLS].reshape(B, S, N_ATTN_HEADS, ATTN_VALUE_DIM)
        glu_in = proj[..., 2 * QK_COLS + V_COLS:]

        lambda_init = 0.8 - 0.6 * math.exp(-0.3 * layer)
        lam = (jnp.exp(jnp.sum(lambda_q1[layer].astype(jnp.float32) * lambda_k1[layer].astype(jnp.float32)))
               - jnp.exp(jnp.sum(lambda_q2[layer].astype(jnp.float32) * lambda_k2[layer].astype(jnp.float32)))
               + lambda_init)
        attn = _diff_attention(q, k, v, lam, rel_bias)
        attn = (_rms_norm(attn, subln_g[layer]) * (1.0 - lambda_init)).reshape(B, S, D_ATTN)

        conv = _conformer_conv(glu_in, b_glu[layer], conv_w[layer], conv_b[layer],
                               conv_ln_g[layer], conv_ln_b[layer])

        mix = jnp.einsum('bse,ed->bsd', jnp.concatenate([attn, conv], axis=-1), w_out[layer])
        x = _layer_norm(DEEPNORM_ALPHA * x + mix, ln1_g[layer], ln1_b[layer])

        ffn = _peer(x, peer_wq[layer], peer_keys[layer], peer_u[layer], peer_v[layer])
        x = _layer_norm(DEEPNORM_ALPHA * x + ffn, ln2_g[layer], ln2_b[layer])
    return x
```

```cpp
#include <hip/hip_runtime.h>
#include <hip/hip_cooperative_groups.h>
#include <cstdio>
#include <cstdint>
namespace cg = cooperative_groups;
namespace pg8 {
#define PG8_LAS __attribute__((address_space(3)))
typedef unsigned short bf16_t;
typedef short bf16x8 __attribute__((ext_vector_type(8)));
typedef float f32x4 __attribute__((ext_vector_type(4)));
typedef unsigned u32x4 __attribute__((ext_vector_type(4)));
constexpr int BM = 256, BK = 64, HALF = 128, HTB = HALF * BK * 2  , STAGE_BYTES = 8 * HTB, NXCD = 8, WGM = 8;

__host__ __device__ __forceinline__ int lds_byte(int r, int c) { const int st = (r >> 4) * 2 + (c >> 5), rr = r & 15, cc = c & 31, ob = rr * 64 + cc * 2; return st * 1024 + (ob ^ (((ob >> 9) & 1) << 5)); }
__host__ __device__ __forceinline__ void stage_rc(int b, int& R, int& C) { const int st = b / 1024, sb = b % 1024, swz = sb ^ (((sb >> 9) & 1) << 5); R = (st >> 1) * 16 + swz / 64; C = (st & 1) * 32 + (swz % 64) / 2; }
__host__ __device__ __forceinline__ int perm32(int rho) { const int n = rho >> 4, i = rho & 15; return 8 * (i >> 2) + 4 * n + (i & 3); }

struct Unit { int pm, pn; };
struct Gemm { const bf16_t* A; const bf16_t* Bt; int M, N, K; };

struct StaticOrder {
    int nM, nN, nwg, G, c;
    __host__ __device__ void init(int M, int N, int G_, int c_) { nM = M / BM; nN = N / BM; nwg = nM * nN; G = G_; c = c_; }
    __host__ __device__ bool next(int i, Unit& u) const {
        const long L = (long)i * G + c; if (L >= nwg) return false;
        int wgid = (int)L; { const int q = nwg / NXCD, r = nwg % NXCD, xcd = wgid % NXCD, off = wgid / NXCD; wgid = (xcd < r ? xcd * (q + 1) : r * (q + 1) + (xcd - r) * q) + off; }
        const int nig = WGM * nN, gid = wgid / nig, fm = gid * WGM, gsz = (nM - fm) < WGM ? (nM - fm) : WGM;
        u.pm = fm + ((wgid % nig) % gsz); u.pn = (wgid % nig) / gsz; return true;
    }
    __device__ __forceinline__ void a_ready(const Unit&) const {}
    __device__ __forceinline__ void done(const Unit&) const {}
};

__device__ __forceinline__ unsigned cvt_pk_bf16(float lo, float hi) { unsigned r; asm volatile("v_cvt_pk_bf16_f32 %0, %1, %2" : "=v"(r) : "v"(lo), "v"(hi)); return r; }
typedef float f32x2 __attribute__((ext_vector_type(2)));
typedef float f32x2 __attribute__((ext_vector_type(2)));
__device__ __forceinline__ u32x4 pack8(f32x4 v0, f32x4 v1) { u32x4 w; w.x = cvt_pk_bf16(v0[0], v0[1]); w.y = cvt_pk_bf16(v0[2], v0[3]); w.z = cvt_pk_bf16(v1[0], v1[1]); w.w = cvt_pk_bf16(v1[2], v1[3]); return w; }
struct EpiProj {
    static constexpr bool PERM = true, AFTER_DRAIN = false;
    bf16_t* QKV; size_t split_stride; float scale0; bf16_t* H; const float* bglu;
    __device__ __forceinline__ void operator()(const f32x4 (&acc)[2][2][4][2], const Unit& u, int wr, int wc, int fr, int fq) const {
        const int row0 = u.pm * BM + wr * 64 + fr;
        if (u.pn < 12) {
            const int t = u.pn >> 2; bf16_t* base = QKV + (size_t)t * split_stride; const float sc = (t == 0) ? scale0 : 1.f;
            const int col0 = (u.pn & 3) * BM + wc * 32 + 8 * fq;
#pragma unroll
            for (int ai = 0; ai < 2; ++ai)
#pragma unroll
                for (int m = 0; m < 4; ++m) { bf16_t* rowp = base + (size_t)(row0 + ai * HALF + m * 16) * 1024 + col0;
#pragma unroll
                    for (int bj = 0; bj < 2; ++bj) *(u32x4*)(rowp + bj * HALF) = pack8(acc[ai][bj][m][0] * sc, acc[ai][bj][m][1] * sc); }
        } else {
            const int ch0 = (u.pn - 12) * HALF + wc * 32 + 8 * fq;
            const f32x4 ba0 = *(const f32x4*)(bglu + ch0), ba1 = *(const f32x4*)(bglu + ch0 + 4), bg0 = *(const f32x4*)(bglu + 1024 + ch0), bg1 = *(const f32x4*)(bglu + 1024 + ch0 + 4);
#pragma unroll
            for (int ai = 0; ai < 2; ++ai)
#pragma unroll
                for (int m = 0; m < 4; ++m) {
                    const f32x4 a0 = acc[ai][0][m][0] + ba0, a1 = acc[ai][0][m][1] + ba1, g0 = acc[ai][1][m][0] + bg0, g1 = acc[ai][1][m][1] + bg1;
                    f32x4 h0, h1;
#pragma unroll
                    for (int e = 0; e < 4; ++e) { h0[e] = a0[e] * __builtin_amdgcn_rcpf(1.f + __builtin_amdgcn_exp2f(-1.4426950409f * g0[e])); h1[e] = a1[e] * __builtin_amdgcn_rcpf(1.f + __builtin_amdgcn_exp2f(-1.4426950409f * g1[e])); }
                    *(u32x4*)(H + (size_t)(row0 + ai * HALF + m * 16) * 1024 + ch0) = pack8(h0, h1); }
        }
    }
};
struct EpiRes {
    static constexpr bool PERM = true, AFTER_DRAIN = false;
    const float* X; bf16_t* Y; int ldc; float alpha;
    __device__ __forceinline__ void operator()(const f32x4 (&acc)[2][2][4][2], const Unit& u, int wr, int wc, int fr, int fq) const {
        const int row0 = u.pm * BM + wr * 64 + fr, col0 = u.pn * BM + wc * 32 + 8 * fq;
#pragma unroll
        for (int ai = 0; ai < 2; ++ai)
#pragma unroll
            for (int m = 0; m < 4; ++m) { const size_t off = (size_t)(row0 + ai * HALF + m * 16) * ldc + col0;
#pragma unroll
                for (int bj = 0; bj < 2; ++bj) { const f32x4 x0 = *(const f32x4*)(X + off + bj * HALF), x1 = *(const f32x4*)(X + off + bj * HALF + 4);
                    *(u32x4*)(Y + off + bj * HALF) = pack8(acc[ai][bj][m][0] + x0 * alpha, acc[ai][bj][m][1] + x1 * alpha); } }
    }
};
struct EpiPlain {
    static constexpr bool PERM = true, AFTER_DRAIN = false;
    bf16_t* O; int ldc;
    __device__ __forceinline__ void operator()(const f32x4 (&acc)[2][2][4][2], const Unit& u, int wr, int wc, int fr, int fq) const {
        const int row0 = u.pm * BM + wr * 64 + fr, col0 = u.pn * BM + wc * 32 + 8 * fq;
#pragma unroll
        for (int ai = 0; ai < 2; ++ai)
#pragma unroll
            for (int m = 0; m < 4; ++m) { bf16_t* rowp = O + (size_t)(row0 + ai * HALF + m * 16) * ldc + col0;
#pragma unroll
                for (int bj = 0; bj < 2; ++bj) *(u32x4*)(rowp + bj * HALF) = pack8(acc[ai][bj][m][0], acc[ai][bj][m][1]); }
    }
};

template <class Epi, class Sched, bool ALIGN_EPI = false, bool SP2 = false>
__device__ __forceinline__ void gemm_phase(PG8_LAS unsigned char* lds, const Gemm g, const Sched& S, const Epi& E) {
    const int tid = threadIdx.x, wid = __builtin_amdgcn_readfirstlane(tid >> 6), lane = tid & 63, wr = wid >> 2, wc = wid & 3, fr = lane & 15, fq = lane >> 4;
    const int K = g.K, nt = K / BK;
    unsigned voffA[2], voffB[2];
#pragma unroll
    for (int i = 0; i < 2; ++i) { int R, C; stage_rc(tid * 16 + i * 8192, R, C); const int Rb = Epi::PERM ? ((R & ~31) + perm32(R & 31)) : R;
        voffA[i] = (unsigned)(R * K + C) * 2u; voffB[i] = (unsigned)(Rb * K + C) * 2u; }
    const size_t kstep = (size_t)(BK * 2);
    const size_t hstep = (size_t)HALF * K * 2;
    const size_t tstep = 2 * hstep;
    const unsigned ldsw = (unsigned)wid * 1024u;
    const int aoff = lds_byte(wr * 64 + fr, fq * 8), boff = lds_byte(wc * 32 + fr, fq * 8);
#define PG8_SA(b, h) (((b) * 2 + (h)) * HTB)
#define PG8_SB(b, h) ((4 + (b) * 2 + (h)) * HTB)
#define PG8_STAGE(bufoff, gbase, voff) do { _Pragma("unroll") for (int _i = 0; _i < 2; ++_i) \
        __builtin_amdgcn_global_load_lds((const unsigned*)((const char*)(gbase) + (voff)[_i]), (PG8_LAS unsigned*)(lds + (bufoff) + ldsw + _i * 8192), 16, 0, 0); } while (0)
#define PG8_LDA(dst, b, h) do { _Pragma("unroll") for (int m = 0; m < 4; ++m) _Pragma("unroll") for (int k = 0; k < 2; ++k) dst[m][k] = *(const PG8_LAS bf16x8*)(lds + PG8_SA(b, h) + aoff + m * 2048 + k * 1024); } while (0)
#define PG8_LDB(dst, b, h) do { _Pragma("unroll") for (int n = 0; n < 2; ++n) _Pragma("unroll") for (int k = 0; k < 2; ++k) dst[n][k] = *(const PG8_LAS bf16x8*)(lds + PG8_SB(b, h) + boff + n * 2048 + k * 1024); } while (0)
#define PG8_MMA(ai, bj, At, Bt) do { __builtin_amdgcn_s_setprio(1); _Pragma("unroll") for (int m = 0; m < 4; ++m) _Pragma("unroll") for (int n = 0; n < 2; ++n) _Pragma("unroll") for (int k = 0; k < 2; ++k) \
        acc[ai][bj][m][n] = __builtin_amdgcn_mfma_f32_16x16x32_bf16(Bt[n][k], At[m][k], acc[ai][bj][m][n], 0, 0, 0); __builtin_amdgcn_s_setprio(0); } while (0)
#define PG8_WAIT_V(n) asm volatile("s_waitcnt vmcnt(" #n ")" ::: "memory")
#define PG8_WAIT_L(n) asm volatile("s_waitcnt lgkmcnt(" #n ")" ::: "memory")
#define PG8_BAR __builtin_amdgcn_s_barrier()
#define PG8_SCHED __builtin_amdgcn_sched_barrier(0)
    Unit cur, nxt; int ui = 0;
    if (!S.next(0, cur)) return;
    f32x4 acc[2][2][4][2];
#pragma unroll
    for (int a = 0; a < 2; ++a)
#pragma unroll
        for (int b = 0; b < 2; ++b)
#pragma unroll
            for (int m = 0; m < 4; ++m)
#pragma unroll
                for (int n = 0; n < 2; ++n) acc[a][b][m][n] = (f32x4){0.f, 0.f, 0.f, 0.f};
    bf16x8 At[4][2], B0[2][2], B1[2][2];
    const char* cA = (const char*)g.A + (size_t)cur.pm * tstep; const char* cB = (const char*)g.Bt + (size_t)cur.pn * tstep;
    S.a_ready(cur);
    if constexpr (SP2) {
        PG8_STAGE(PG8_SB(0, 0), cB, voffB); PG8_STAGE(PG8_SB(0, 1), cB + hstep, voffB); PG8_STAGE(PG8_SA(0, 0), cA, voffA); PG8_STAGE(PG8_SA(0, 1), cA + hstep, voffA);
        if (wr == 1) PG8_BAR;
        PG8_WAIT_V(2); PG8_BAR;
        PG8_STAGE(PG8_SB(1, 0), cB + kstep, voffB); PG8_STAGE(PG8_SA(1, 0), cA + kstep, voffA); PG8_STAGE(PG8_SB(1, 1), cB + hstep + kstep, voffB);
        PG8_WAIT_V(6); PG8_BAR;
    } else {
        PG8_STAGE(PG8_SB(0, 0), cB, voffB); PG8_STAGE(PG8_SA(0, 0), cA, voffA); PG8_STAGE(PG8_SB(0, 1), cB + hstep, voffB); PG8_STAGE(PG8_SA(0, 1), cA + hstep, voffA);
        if (wr == 1) PG8_BAR;
        PG8_WAIT_V(4); PG8_BAR;
        PG8_STAGE(PG8_SB(1, 0), cB + kstep, voffB); PG8_STAGE(PG8_SA(1, 0), cA + kstep, voffA); PG8_STAGE(PG8_SB(1, 1), cB + hstep + kstep, voffB);
        PG8_WAIT_V(6); PG8_BAR;
    }
    for (;;) {
        const bool has_next = S.next(ui + 1, nxt);
        const char* nA = has_next ? (const char*)g.A + (size_t)nxt.pm * tstep : cA; const char* nB = has_next ? (const char*)g.Bt + (size_t)nxt.pn * tstep : cB;
        for (int t = 0; t < nt; t += 2) {
            const bool last = (t == nt - 2);
            const char* a1 = cA + (size_t)(t + 1) * kstep;
            const char* a2 = last ? nA : cA + (size_t)(t + 2) * kstep; const char* b2 = last ? nB : cB + (size_t)(t + 2) * kstep;
            const char* a3 = a2 + kstep; const char* b3 = b2 + kstep;
            if (last && has_next) S.a_ready(nxt);
            if constexpr (SP2) {
            PG8_LDB(B0, 0, 0); PG8_LDB(B1, 0, 1); PG8_SCHED; PG8_LDA(At, 0, 0); PG8_STAGE(PG8_SA(1, 1), a1 + hstep, voffA);
            PG8_WAIT_V(8); PG8_WAIT_L(0); PG8_BAR; PG8_MMA(0, 0, At, B0); PG8_MMA(0, 1, At, B1); PG8_BAR; PG8_SCHED;
            PG8_LDA(At, 0, 1); PG8_STAGE(PG8_SB(0, 0), b2, voffB); PG8_STAGE(PG8_SB(0, 1), b2 + hstep, voffB); PG8_STAGE(PG8_SA(0, 0), a2, voffA);
            PG8_WAIT_V(8); PG8_WAIT_L(0); PG8_BAR; PG8_MMA(1, 0, At, B0); PG8_MMA(1, 1, At, B1); PG8_BAR; PG8_SCHED;
            PG8_LDB(B0, 1, 0); PG8_LDB(B1, 1, 1); PG8_SCHED; PG8_LDA(At, 1, 0); PG8_STAGE(PG8_SA(0, 1), a2 + hstep, voffA);
            PG8_WAIT_V(8); PG8_WAIT_L(0); PG8_BAR; PG8_MMA(0, 0, At, B0); PG8_MMA(0, 1, At, B1); PG8_BAR; PG8_SCHED;
            PG8_LDA(At, 1, 1); PG8_STAGE(PG8_SB(1, 0), b3, voffB); PG8_STAGE(PG8_SB(1, 1), b3 + hstep, voffB); PG8_STAGE(PG8_SA(1, 0), a3, voffA);
            PG8_WAIT_V(8); PG8_WAIT_L(0); PG8_BAR; PG8_MMA(1, 0, At, B0); PG8_MMA(1, 1, At, B1); PG8_BAR; PG8_SCHED;
            } else {
            PG8_LDB(B0, 0, 0); PG8_SCHED; PG8_LDA(At, 0, 0); PG8_STAGE(PG8_SA(1, 1), a1 + hstep, voffA);
            PG8_WAIT_L(8); PG8_BAR; PG8_WAIT_L(0); PG8_MMA(0, 0, At, B0); PG8_BAR; PG8_SCHED;
            PG8_LDB(B1, 0, 1); PG8_STAGE(PG8_SB(0, 0), b2, voffB);
            PG8_BAR; PG8_WAIT_L(0); PG8_MMA(0, 1, At, B1); PG8_BAR;
            PG8_LDA(At, 0, 1); PG8_STAGE(PG8_SA(0, 0), a2, voffA);
            PG8_BAR; PG8_WAIT_L(0); PG8_MMA(1, 0, At, B0); PG8_BAR; PG8_SCHED;
            PG8_STAGE(PG8_SB(0, 1), b2 + hstep, voffB);
            PG8_WAIT_V(6); PG8_BAR; PG8_MMA(1, 1, At, B1); PG8_BAR;
            PG8_LDB(B0, 1, 0); PG8_SCHED; PG8_LDA(At, 1, 0); PG8_STAGE(PG8_SA(0, 1), a2 + hstep, voffA);
            PG8_WAIT_L(8); PG8_BAR; PG8_WAIT_L(0); PG8_MMA(0, 0, At, B0); PG8_BAR; PG8_SCHED;
            PG8_LDB(B1, 1, 1); PG8_STAGE(PG8_SB(1, 0), b3, voffB);
            PG8_BAR; PG8_WAIT_L(0); PG8_MMA(0, 1, At, B1); PG8_BAR;
            PG8_LDA(At, 1, 1); PG8_STAGE(PG8_SA(1, 0), a3, voffA);
            PG8_BAR; PG8_WAIT_L(0); PG8_MMA(1, 0, At, B0); PG8_BAR; PG8_SCHED;
            PG8_STAGE(PG8_SB(1, 1), b3 + hstep, voffB);
            PG8_WAIT_V(6); PG8_BAR; PG8_MMA(1, 1, At, B1); PG8_BAR;
            }
        }
        if constexpr (ALIGN_EPI) { if (wr == 0) PG8_BAR; }
        if constexpr (!Epi::AFTER_DRAIN) { E(acc, cur, wr, wc, fr, fq); S.done(cur); }
        if (!has_next) break;
#pragma unroll
        for (int a = 0; a < 2; ++a)
#pragma unroll
            for (int b = 0; b < 2; ++b)
#pragma unroll
                for (int m = 0; m < 4; ++m)
#pragma unroll
                    for (int n = 0; n < 2; ++n) acc[a][b][m][n] = (f32x4){0.f, 0.f, 0.f, 0.f};
        cur = nxt; cA = nA; cB = nB; ++ui;
        if constexpr (ALIGN_EPI) { if (wr == 1) PG8_BAR; }
    }
    PG8_WAIT_V(0);
    if constexpr (!ALIGN_EPI) { if (wr == 0) PG8_BAR; }
    PG8_BAR;
    if constexpr (Epi::AFTER_DRAIN) { E.fused(acc, cur, wr, wc, fr, fq, lds, wid, lane); S.done(cur); }
#undef PG8_SA
#undef PG8_SB
#undef PG8_STAGE
#undef PG8_LDA
#undef PG8_LDB
#undef PG8_MMA
#undef PG8_WAIT_V
#undef PG8_WAIT_L
#undef PG8_BAR
#undef PG8_SCHED
}
}
#include <hip/hip_bf16.h>
#include <cmath>
namespace attn_body {
using bf16=__hip_bfloat16;
using bf16x8=__attribute__((ext_vector_type(8)))short;
using s16x4=__attribute__((ext_vector_type(4)))short;
using f32x16=__attribute__((ext_vector_type(16)))float;
using u32x4=__attribute__((ext_vector_type(4)))unsigned;
constexpr int BATCH=8,NHEAD=16,SEQ=4096,D=64,DM=NHEAD*D;
constexpr int NW=8,QBLK=32,QB=QBLK*NW,KVBLK=64,NQB=SEQ/QB;
constexpr int ATTN_PITCH=DM, ATTN_UNIT_ROWS=QB;
__device__ __forceinline__ int crow(int r,int hi){return (r&3)+8*(r>>2)+4*hi;}
#define SBAR() __builtin_amdgcn_sched_barrier(0)
__device__ __forceinline__ void cmask(f32x16&p0,f32x16&p1,int jb,int qrel,int hi){
  const float NEG=-INFINITY; int kb=64*jb+4*hi;
  #pragma unroll
  for(int r=0;r<16;++r){int kv=kb+(r&3)+8*(r>>2); if(kv>qrel)p0[r]=NEG; if(kv+32>qrel)p1[r]=NEG;}
}

__device__ __forceinline__ void cbias(f32x16&p0,f32x16&p1,int jb,int qrel,int hi,const __attribute__((address_space(3))) float*tab){
  const int base=qrel-64*jb-4*hi;
  #pragma unroll
  for(int r=0;r<16;++r){const int d0=base-((r&3)+8*(r>>2)); const int i0=min(max(d0,0),127), i1=min(max(d0-32,0),127); p0[r]+=tab[i0]; p1[r]+=tab[i1];}
}
constexpr int NSLOT=3, SLOTB=8192;
constexpr int LDS_K=0, LDS_V=NSLOT*SLOTB, LDS_WS=2*NSLOT*SLOTB, LDS_OST=LDS_WS+NW*64*4, LDS_TAB=LDS_OST+NW*4096, LDS_BYTES=LDS_TAB+512;
constexpr float C2=0.125f*1.4426950408889634f;
__device__ __forceinline__ void glds16(const void*gsrc,unsigned lds_dst){unsigned keep;
  asm volatile("s_mov_b32 %0, m0\n\ts_mov_b32 m0, %2\n\ts_nop 0\n\tglobal_load_lds_dwordx4 %1, off\n\ts_mov_b32 m0, %0":"=&s"(keep):"v"(gsrc),"s"(lds_dst):"memory");}
__device__ __forceinline__ float max3f(float a,float b,float c){float r;asm("v_max3_f32 %0, %1, %2, %3":"=v"(r):"v"(a),"v"(b),"v"(c));return r;}
__device__ __forceinline__ float max2f(float a,float b){float r;asm("v_max_f32_e32 %0, %1, %2":"=v"(r):"v"(a),"v"(b));return r;}
__device__ __forceinline__ float fadd_s(float a,float b){float r;asm("v_add_f32_e32 %0, %1, %2":"=v"(r):"v"(a),"v"(b));return r;}
__device__ __forceinline__ float fsub_s(float a,float b){float r;asm("v_sub_f32_e32 %0, %1, %2":"=v"(r):"v"(a),"v"(b));return r;}
typedef float f32x2_t __attribute__((ext_vector_type(2))); typedef __bf16 bf16x2_t __attribute__((ext_vector_type(2)));
__device__ __forceinline__ unsigned cvtpk_s(float lo,float hi){f32x2_t v={lo,hi};bf16x2_t b=__builtin_convertvector(v,bf16x2_t);return __builtin_bit_cast(unsigned,b);}
#define WAIT_BAR(N) asm volatile("s_waitcnt vmcnt(" #N ") lgkmcnt(0)\n\ts_barrier":::"memory")

__device__ __forceinline__ void qkt(f32x16&p0,f32x16&p1,const char*Kslot,const bf16x8*qr,const f32x16&negm,int r32,int hi){
  const char*kb=Kslot+hi*1024+r32*16;
  #pragma unroll
  for(int d0=0;d0<4;++d0){
    const bf16x8 b0=*reinterpret_cast<const bf16x8*>(kb+d0*2048);
    const bf16x8 b1=*reinterpret_cast<const bf16x8*>(kb+d0*2048+512);
    if(d0==0){p0=__builtin_amdgcn_mfma_f32_32x32x16_bf16(b0,qr[0],negm,0,0,0);p1=__builtin_amdgcn_mfma_f32_32x32x16_bf16(b1,qr[0],negm,0,0,0);}
    else{p0=__builtin_amdgcn_mfma_f32_32x32x16_bf16(b0,qr[d0],p0,0,0,0);p1=__builtin_amdgcn_mfma_f32_32x32x16_bf16(b1,qr[d0],p1,0,0,0);}}
}
typedef __attribute__((address_space(3))) const char* lds_cptr;
typedef short v4i16_t __attribute__((ext_vector_type(4)));
__device__ __forceinline__ void kload8(bf16x8*kf,lds_cptr kp){
  kf[0]=*(const __attribute__((address_space(3))) bf16x8*)(kp);      kf[1]=*(const __attribute__((address_space(3))) bf16x8*)(kp+512);
  kf[2]=*(const __attribute__((address_space(3))) bf16x8*)(kp+2048); kf[3]=*(const __attribute__((address_space(3))) bf16x8*)(kp+2560);
  kf[4]=*(const __attribute__((address_space(3))) bf16x8*)(kp+4096); kf[5]=*(const __attribute__((address_space(3))) bf16x8*)(kp+4608);
  kf[6]=*(const __attribute__((address_space(3))) bf16x8*)(kp+6144); kf[7]=*(const __attribute__((address_space(3))) bf16x8*)(kp+6656);
}
__device__ __forceinline__ void kload2(bf16x8*kf,lds_cptr kp,int j){ kf[2*j]=*(const __attribute__((address_space(3))) bf16x8*)(kp+j*2048); kf[2*j+1]=*(const __attribute__((address_space(3))) bf16x8*)(kp+j*2048+512); }
__device__ __forceinline__ s16x4 vtr(lds_cptr p){ return __builtin_bit_cast(s16x4,__builtin_amdgcn_ds_read_tr16_b64_v4i16((__attribute__((address_space(3))) v4i16_t*)p)); }
__device__ __forceinline__ float rowmax(const f32x16&p0,const f32x16&p1){
  float a=max3f(p0[0],p0[1],p1[0]),b=max3f(p0[2],p0[3],p1[1]);a=max3f(a,p1[2],p1[3]);
  #pragma unroll
  for(int r=4;r<16;r+=4){a=max3f(a,p0[r],p0[r+1]);b=max3f(b,p0[r+2],p0[r+3]);a=max3f(a,p1[r],p1[r+1]);b=max3f(b,p1[r+2],p1[r+3]);}
  const float m=max2f(a,b);
  auto rr=__builtin_amdgcn_permlane32_swap(__float_as_uint(m),__float_as_uint(m),false,false);
  return max2f(__uint_as_float(rr[0]),__uint_as_float(rr[1]));
}
__device__ __forceinline__ void pv(f32x16*o,int vb,bf16x8 pa0,bf16x8 pa1,bf16x8 pa2,bf16x8 pa3){
  #pragma unroll
  for(int d0=0;d0<2;++d0){s16x4 lo[4],hi[4];
    #pragma unroll
    for(int ks=0;ks<4;++ks){
      asm volatile("ds_read_b64_tr_b16 %0,%1 offset:%c2":"=&v"(lo[ks]):"v"(vb),"i"(d0*4096+ks*1024):"memory");
      asm volatile("ds_read_b64_tr_b16 %0,%1 offset:%c2":"=&v"(hi[ks]):"v"(vb),"i"(d0*4096+ks*1024+512):"memory");}
    asm volatile("s_waitcnt lgkmcnt(0)":::"memory");SBAR();
    #define PK(k) (bf16x8){lo[k][0],lo[k][1],lo[k][2],lo[k][3],hi[k][0],hi[k][1],hi[k][2],hi[k][3]}
    o[d0]=__builtin_amdgcn_mfma_f32_32x32x16_bf16(pa0,PK(0),o[d0],0,0,0);
    o[d0]=__builtin_amdgcn_mfma_f32_32x32x16_bf16(pa1,PK(1),o[d0],0,0,0);
    o[d0]=__builtin_amdgcn_mfma_f32_32x32x16_bf16(pa2,PK(2),o[d0],0,0,0);
    o[d0]=__builtin_amdgcn_mfma_f32_32x32x16_bf16(pa3,PK(3),o[d0],0,0,0);
    #undef PK
  }
}

#ifndef ATTN_STORE16
#define ATTN_STORE16(p,v) (*(u32x4*)(p)=(v))
#endif
template<int THRL> __device__ __forceinline__ void attn_unit(int b,int h,int hv,int qb,const bf16*Q,const bf16*__restrict__ K,const bf16*__restrict__ V,bf16*O,char*shm){
  const __attribute__((address_space(3))) float* tab=(const __attribute__((address_space(3))) float*)((lds_cptr)shm+LDS_TAB);
  const int tid=threadIdx.x,lane=tid&63,r32=lane&31,hi=lane>>5; const int wid=__builtin_amdgcn_readfirstlane(tid>>6);
  const long rowbase=(long)b*SEQ; const int q0=qb*QB;
  const bf16*Qw=Q+(rowbase+q0+wid*QBLK)*DM+h*D;
  const bf16*Kh=K+rowbase*DM+h*D,*Vh=V+rowbase*DM+hv*D;
  const unsigned lds0=(unsigned)(uintptr_t)shm;
  float*wsf=(float*)(shm+LDS_WS)+wid*64;
  const bf16*ksrc=Kh+(long)lane*DM+wid*8;
  const bf16*vsrc=Vh+(long)(16*(wid&3)+(lane>>2))*DM+(wid>>2)*32+(lane&3)*8;
  const unsigned kdst=lds0+LDS_K+wid*1024, vdst=lds0+LDS_V+wid*1024;
  #define DMA_K(t,slot) glds16(ksrc+(long)(t)*KVBLK*DM,(unsigned)__builtin_amdgcn_readfirstlane(kdst+(slot)))
  #define DMA_V(t,slot) glds16(vsrc+(long)(t)*KVBLK*DM,(unsigned)__builtin_amdgcn_readfirstlane(vdst+(slot)))
  const int vb0=(int)(lds0+LDS_V)+((lane>>4)&1)*32+(lane&3)*8+(4*hi+((lane&15)>>2))*64;
  const char*Kbase=shm+LDS_K; bf16x8 kf[8];
  const lds_cptr shm3=(lds_cptr)shm; const lds_cptr kp0=shm3+LDS_K+hi*1024+r32*16; const lds_cptr vp0=shm3+LDS_V+((lane>>4)&1)*32+(lane&3)*8+(4*hi+((lane&15)>>2))*64;
  const int NT=(q0+QB)/KVBLK;
  DMA_K(0,0);DMA_V(0,0);DMA_K(1,SLOTB);
  bf16x8 qr[4];
  #pragma unroll
  for(int d0=0;d0<4;++d0)qr[d0]=*reinterpret_cast<const bf16x8*>(&Qw[(long)r32*DM+d0*16+hi*8]);
  float mhat=0.f,l_reg=0.f;f32x16 o[2];o[0]=f32x16{};o[1]=f32x16{};f32x16 negm=f32x16{};asm volatile("":"+v"(negm));
  const int qrel=wid*QBLK+r32;
  #define CMASK(P0,P1,t) do{int jb_=(t)-(NT-4); if(jb_>=-2){cbias(P0,P1,jb_,qrel,hi,tab); if(jb_>=0)cmask(P0,P1,jb_,qrel,hi);}}while(0)
  bool resc=false;
  #define START(P0,P1) do{ const float rm=rowmax(P0,P1); resc=false; \
    { const float dl=rm; mhat=fadd_s(mhat,dl); \
      _Pragma("unroll") for(int r=0;r<16;++r){P0[r]=fsub_s(P0[r],dl);P1[r]=fsub_s(P1[r],dl);} \
      _Pragma("unroll") for(int r=0;r<16;++r)negm[r]=-mhat; asm volatile("":"+v"(negm)); } \
    _Pragma("unroll") for(int r=0;r<16;++r)P0[r]=__builtin_amdgcn_exp2f(P0[r]); }while(0)
  #define RESC() do{ if(resc){ asm volatile("s_waitcnt lgkmcnt(0)":::"memory"); \
      _Pragma("unroll") for(int d_=0;d_<2;++d_) _Pragma("unroll") for(int r=0;r<16;++r)o[d_][r]*=wsf[crow(r,hi)]; } }while(0)
  f32x16 pA0,pA1,pB0,pB1;
  int sl_prev=0,sl_cur=0,sl_next=SLOTB;
  #define ROT() do{sl_prev=sl_cur;sl_cur=sl_next;sl_next=(sl_next==(NSLOT-1)*SLOTB)?0:sl_next+SLOTB;}while(0)
  DMA_K(2,2*SLOTB);
  WAIT_BAR(3);
  qkt(pA0,pA1,Kbase,qr,negm,r32,hi);asm volatile("s_nop 15\n\ts_nop 7":"+v"(pA0),"+v"(pA1));CMASK(pA0,pA1,0);
  START(pA0,pA1);
  _Pragma("unroll") for(int r=0;r<16;++r)pA1[r]=__builtin_amdgcn_exp2f(pA1[r]);
  WAIT_BAR(0);
  DMA_K(3,0);DMA_V(1,SLOTB);
  ROT();
  kload8(kf,kp0+sl_cur);
  WAIT_BAR(2);
  s16x4 vlo[8],vhi[8]; u32x4 pw0,pw1,pw2,pw3;
  #define PKW(P,B) cvtpk_s(P[B],P[B+1])
  #define PAF(k) __builtin_bit_cast(bf16x8,pw##k)
  #define VFR(i) (bf16x8){vlo[i][0],vlo[i][1],vlo[i][2],vlo[i][3],vhi[i][0],vhi[i][1],vhi[i][2],vhi[i][3]}
  #define PIN(x) asm volatile("":"+v"(x))
  #define MX3(a,b,c) __builtin_fmaxf(__builtin_fmaxf((a),(b)),(c))
  #define GAPA(MF,A0,A1,A2,A3,W0,W1,PW) do{ MF; sacc+=A0; sacc+=A1; sacc+=A2; sacc+=A3; PIN(sacc); W0; W1; PIN(PW); SBAR(); }while(0)
  #define EX(v) __builtin_amdgcn_exp2f(v)
  #define GAPB(MF,X,B) do{ MF; X[B]=EX(X[B]); X[B+1]=EX(X[B+1]); X[B+2]=EX(X[B+2]); X[B+3]=EX(X[B+3]); PIN(X); SBAR(); }while(0)
  #define VRD(i) do{ vlo[i]=vtr(vp_+(((i)>>2)*4096+((i)&3)*1024)); vhi[i]=vtr(vp_+(((i)>>2)*4096+((i)&3)*1024+512)); }while(0)
  #define KRD(G,j) do{ if(G){ kload2(kf,kp0+sl_next,j); SBAR(); } }while(0)
  #define STEP(C0,C1,P0,P1,t,GK,GV,GL) do{ SBAR(); \
    const lds_cptr vp_=vp0+sl_prev; \
    VRD(0); SBAR(); float sacc=(P0[0]+P0[1]); \
    GAPA(C0=__builtin_amdgcn_mfma_f32_32x32x16_bf16(kf[0],qr[0],negm,0,0,0), P0[2],P0[3],P0[4],P0[5],     pw0[0]=PKW(P0,0), pw0[1]=PKW(P0,2), pw0); \
    VRD(4); SBAR(); GAPA(C1=__builtin_amdgcn_mfma_f32_32x32x16_bf16(kf[1],qr[0],negm,0,0,0), P0[6],P0[7],P0[8],P0[9],     pw0[2]=PKW(P0,4), pw0[3]=PKW(P0,6), pw0); \
    VRD(1); SBAR(); GAPA(C0=__builtin_amdgcn_mfma_f32_32x32x16_bf16(kf[2],qr[1],C0,0,0,0),   P0[10],P0[11],P0[12],P0[13], pw1[0]=PKW(P0,8), pw1[1]=PKW(P0,10), pw1); \
    VRD(5); SBAR(); GAPA(C1=__builtin_amdgcn_mfma_f32_32x32x16_bf16(kf[3],qr[1],C1,0,0,0),   P0[14],P0[15],P1[0],P1[1],   pw1[2]=PKW(P0,12),pw1[3]=PKW(P0,14), pw1); \
    VRD(2); SBAR(); GAPA(C0=__builtin_amdgcn_mfma_f32_32x32x16_bf16(kf[4],qr[2],C0,0,0,0),   P1[2],P1[3],P1[4],P1[5],     pw2[0]=PKW(P1,0), pw2[1]=PKW(P1,2), pw2); \
    VRD(6); SBAR(); GAPA(C1=__builtin_amdgcn_mfma_f32_32x32x16_bf16(kf[5],qr[2],C1,0,0,0),   P1[6],P1[7],P1[8],P1[9],     pw2[2]=PKW(P1,4), pw2[3]=PKW(P1,6), pw2); \
    VRD(3); SBAR(); GAPA(C0=__builtin_amdgcn_mfma_f32_32x32x16_bf16(kf[6],qr[3],C0,0,0,0),   P1[10],P1[11],P1[12],P1[13], pw3[0]=PKW(P1,8), pw3[1]=PKW(P1,10), pw3); \
    VRD(7); SBAR(); GAPA(C1=__builtin_amdgcn_mfma_f32_32x32x16_bf16(kf[7],qr[3],C1,0,0,0),   P1[14],P1[15],0.f,0.f,       pw3[2]=PKW(P1,12),pw3[3]=PKW(P1,14), pw3); \
    l_reg+=sacc; \
    if(GK){DMA_K((t)+3,sl_cur);} if(GV){DMA_V((t)+1,sl_next);} \
    CMASK(C0,C1,t); \
    { float a=MX3(C0[0],C0[1],C1[0]),b=MX3(C0[2],C0[3],C1[1]); a=MX3(a,C1[2],C1[3]); \
      _Pragma("unroll") for(int r=4;r<16;r+=4){a=MX3(a,C0[r],C0[r+1]);b=MX3(b,C0[r+2],C0[r+3]);a=MX3(a,C1[r],C1[r+1]);b=MX3(b,C1[r+2],C1[r+3]);} \
      float rm=__builtin_fmaxf(a,b); { auto rr=__builtin_amdgcn_permlane32_swap(__float_as_uint(rm),__float_as_uint(rm),false,false); rm=__builtin_fmaxf(__uint_as_float(rr[0]),__uint_as_float(rr[1])); } \
      resc=false; \
      if(__builtin_expect(__any(rm>(float)THRL),0)){ const float dl=__builtin_fmaxf(rm,0.f); mhat+=dl; \
        _Pragma("unroll") for(int r=0;r<16;++r){C0[r]-=dl;C1[r]-=dl;} \
        _Pragma("unroll") for(int r=0;r<16;++r)negm[r]=-mhat; asm volatile("":"+v"(negm)); \
        const float f=__builtin_amdgcn_exp2f(-dl); l_reg*=f; if(hi==0)wsf[r32]=f; resc=true; } } \
    SBAR(); \
    GAPB(o[0]=__builtin_amdgcn_mfma_f32_32x32x16_bf16(PAF(0),VFR(0),o[0],0,0,0), C0,0); \
    GAPB(o[1]=__builtin_amdgcn_mfma_f32_32x32x16_bf16(PAF(0),VFR(4),o[1],0,0,0), C0,4); \
    KRD(GL,0); GAPB(o[0]=__builtin_amdgcn_mfma_f32_32x32x16_bf16(PAF(1),VFR(1),o[0],0,0,0), C0,8); \
    KRD(GL,1); GAPB(o[1]=__builtin_amdgcn_mfma_f32_32x32x16_bf16(PAF(1),VFR(5),o[1],0,0,0), C0,12); \
    KRD(GL,2); GAPB(o[0]=__builtin_amdgcn_mfma_f32_32x32x16_bf16(PAF(2),VFR(2),o[0],0,0,0), C1,0); \
    KRD(GL,3); GAPB(o[1]=__builtin_amdgcn_mfma_f32_32x32x16_bf16(PAF(2),VFR(6),o[1],0,0,0), C1,4); \
    GAPB(o[0]=__builtin_amdgcn_mfma_f32_32x32x16_bf16(PAF(3),VFR(3),o[0],0,0,0), C1,8); \
    GAPB(o[1]=__builtin_amdgcn_mfma_f32_32x32x16_bf16(PAF(3),VFR(7),o[1],0,0,0), C1,12); \
    }while(0)
  int t=1;
  #undef CMASK
  #define CMASK(P0,P1,t) do{}while(0)
  for(;t+7<NT;t+=2){
    STEP(pB0,pB1,pA0,pA1,t,true,true,true);     WAIT_BAR(2); RESC(); ROT();
    STEP(pA0,pA1,pB0,pB1,t+1,true,true,true);   WAIT_BAR(2); RESC(); ROT();
  }
  #undef CMASK
  #define CMASK(P0,P1,t) do{int jb_=(t)-(NT-4); if(jb_>=-2){cbias(P0,P1,jb_,qrel,hi,tab); if(jb_>=0)cmask(P0,P1,jb_,qrel,hi);}}while(0)
  #define ENDW(tt) do{ if((tt)+3<NT){WAIT_BAR(2);} else if((tt)+2<NT){WAIT_BAR(1);} else {WAIT_BAR(0);} }while(0)
  for(;t+1<NT;t+=2){
    STEP(pB0,pB1,pA0,pA1,t,(t+3<NT),(t+1<NT),(t+1<NT));       ENDW(t);   RESC(); ROT();
    STEP(pA0,pA1,pB0,pB1,t+1,(t+4<NT),(t+2<NT),(t+2<NT));     ENDW(t+1); RESC(); ROT();
  }
  STEP(pB0,pB1,pA0,pA1,NT-1,false,false,false); RESC();
  { float sacc=pB0[0]+pB0[1]; _Pragma("unroll") for(int r=2;r<16;++r)sacc+=pB0[r]; _Pragma("unroll") for(int r=0;r<16;++r)sacc+=pB1[r]; l_reg+=sacc;
    pw0=(u32x4){PKW(pB0,0),PKW(pB0,2),PKW(pB0,4),PKW(pB0,6)};pw1=(u32x4){PKW(pB0,8),PKW(pB0,10),PKW(pB0,12),PKW(pB0,14)};pw2=(u32x4){PKW(pB1,0),PKW(pB1,2),PKW(pB1,4),PKW(pB1,6)};pw3=(u32x4){PKW(pB1,8),PKW(pB1,10),PKW(pB1,12),PKW(pB1,14)};
    SBAR(); pv(o,vb0+sl_cur,PAF(0),PAF(1),PAF(2),PAF(3)); }
  #undef PKW
  #undef PAF
  #undef VFR
  #undef PIN
  #undef MX3
  #undef GAPA
  #undef GAPB
  #undef EX
  #undef VRD
  #undef KRD
  #undef STEP
  #undef ENDW
  {auto rr=__builtin_amdgcn_permlane32_swap(__float_as_uint(l_reg),__float_as_uint(l_reg),false,false);l_reg=__uint_as_float(rr[0])+__uint_as_float(rr[1]);}
  if(hi==0)wsf[32+r32]=l_reg;asm volatile("s_waitcnt lgkmcnt(0)":::"memory");
  float rli[16];
  #pragma unroll
  for(int r=0;r<16;++r)rli[r]=__builtin_amdgcn_rcpf(wsf[32+crow(r,hi)]);
  bf16*Ow=O+(rowbase+q0+wid*QBLK)*DM+hv*D;
  { bf16*stg=(bf16*)(shm+LDS_OST)+wid*2048;
    #pragma unroll
    for(int r=0;r<16;++r){const int orow=crow(r,hi);
      #pragma unroll
      for(int d0=0;d0<2;++d0)stg[orow*64+d0*32+r32]=__float2bfloat16(o[d0][r]*rli[r]);}
    asm volatile("s_waitcnt lgkmcnt(0)":::"memory");
    #pragma unroll
    for(int i=0;i<4;++i){const int row=i*8+(lane>>3),ch=lane&7; const u32x4 v=*(const u32x4*)(stg+row*64+ch*8); ATTN_STORE16(Ow+(long)row*DM+ch*8,v);} }
  asm volatile("s_waitcnt lgkmcnt(0)\n\ts_barrier":::"memory");
  #undef DMA_K
  #undef DMA_V
  #undef CMASK
  #undef START
  #undef RESC
  #undef ROT
}
constexpr int ATTN_LDS_BYTES=LDS_BYTES;
struct AttnTensors { const bf16* Q; const bf16* K; const bf16* V; bf16* O1; bf16* O2; const float* biastab; };
struct AttnUnit { int b, hqk, hv, c, qb; };
struct StaticOrder {
  int vcu;
  __device__ __forceinline__ explicit StaticOrder(int grid,int block):vcu((grid%8==0)?(block%8)*(grid/8)+block/8:block){}
  __device__ __forceinline__ bool next(int i,AttnUnit&u)const{ if(i>=16)return false; const int v=vcu&255; u.b=v>>5; const int h=(v>>2)&7,c=(v>>1)&1,hf=v&1; u.hqk=2*h+c; u.hv=2*h+hf; u.c=c; u.qb=(i&1)?15-(i>>1):(i>>1); return true; }
};
template<class Sched,int THRL=8> __device__ __forceinline__ void attn_phase(char*lds,const AttnTensors&T,const Sched&S){
  AttnUnit u; int cur_h=-1;
  for(int i=0;S.next(i,u);++i){
    if((u.hqk>>1)!=cur_h){ cur_h=u.hqk>>1;
      if(threadIdx.x<128)((float*)(lds+LDS_TAB))[threadIdx.x]=T.biastab[cur_h*128+threadIdx.x];
      asm volatile("s_waitcnt vmcnt(0) lgkmcnt(0)\n\ts_barrier":::"memory"); }
    attn_unit<THRL>(u.b,u.hqk,u.hv,u.qb,T.Q,T.K,T.V,u.c?T.O2:T.O1,lds); }
}
#undef SBAR
#undef WAIT_BAR
}
#ifndef PG8_SP2
#define PG8_SP2 true
#endif
#ifndef PG8_ALIGN
#define PG8_ALIGN true
#endif
constexpr int NWAVES = 8;
#ifndef MK_N_LAUNCHES
#define MK_N_LAUNCHES 1
#endif
constexpr int N_PHASES = 8;
constexpr int BATCH = 8, SEQ = 4096, D = 2048, M = BATCH * SEQ;
constexpr int NPROJ = 5120, DATT = 1024, DCONV = 1024, CONVW = 31;
constexpr int PH = 8, PNK = 128, PHALF = 128, PTOPK = 16, NEXP = 16384;
constexpr float LN_EPS = 1e-5f;
constexpr float DN_ALPHA = 1.189207115002721f;
constexpr float LAMBDA_INIT = 0.2f;
constexpr size_t MiB = 1u << 20;
constexpr size_t WS_WIN = 2 * MiB, WS_WOUT = 22 * MiB, WS_WQ = 30 * MiB, WS_KEYS = 38 * MiB, WS_TAB = 39 * MiB;
constexpr size_t WS_UB = 40 * MiB, WS_VB = 104 * MiB;
constexpr size_t WS_XB = 168 * MiB;
constexpr size_t WS_Q = 296 * MiB, WS_K = 360 * MiB, WS_V = 424 * MiB, WS_H = 488 * MiB;
constexpr size_t WS_O1 = 552 * MiB, WS_O2 = 616 * MiB;
constexpr size_t WS_Y1 = 680 * MiB;
constexpr size_t WS_QP = 808 * MiB;
constexpr size_t WS_EID = 936 * MiB, WS_GATE = 952 * MiB;
constexpr size_t WS_END = 968 * MiB;
constexpr int RING_BYTES = 131072, LDS_BYTES = 147456;

#define GAS __attribute__((address_space(1)))
#define LAS __attribute__((address_space(3)))
typedef unsigned short bf16;
typedef unsigned v4u __attribute__((ext_vector_type(4)));
typedef unsigned v2u __attribute__((ext_vector_type(2)));
typedef float f32x4 __attribute__((ext_vector_type(4)));
typedef float f32x16 __attribute__((ext_vector_type(16)));
typedef short bf16x8 __attribute__((ext_vector_type(8)));
typedef __bf16 bf16x2_t __attribute__((ext_vector_type(2)));
#define LDS_WAIT() asm volatile("s_waitcnt lgkmcnt(0)" ::: "memory")
__device__ __forceinline__ unsigned f2bf(float f) { unsigned u = __builtin_bit_cast(unsigned, f); return (u + 0x7fffu + ((u >> 16) & 1u)) >> 16; }
__device__ __forceinline__ unsigned pk2(float lo, float hi) { return f2bf(lo) | (f2bf(hi) << 16); }
__device__ __forceinline__ float bflo(unsigned w) { return __uint_as_float(w << 16); }
__device__ __forceinline__ float bfhi(unsigned w) { return __uint_as_float(w & 0xffff0000u); }
__device__ __forceinline__ float wave_sum(float v) {
#pragma unroll
    for (int o = 1; o < 64; o <<= 1) v += __shfl_xor(v, o);
    return v;
}
__device__ __forceinline__ float dot2bf(unsigned a, unsigned b, float acc) { return __builtin_amdgcn_fdot2_f32_bf16(__builtin_bit_cast(bf16x2_t, a), __builtin_bit_cast(bf16x2_t, b), acc, false); }

#define XB_TMO      128
#define XB_XCNT(j)  (256  + 64 * (j))
#define XB_XSUB(j)  (1280 + 64 * (j))
#define XB_XGEN(j)  (2304 + 64 * (j))
#define XB_TOP      3328
#define XB_TOPGEN   3392
#define XCD_BAR_WORDS 3456
#define XB_SPIN_CAP (1u << 18)

__device__ __forceinline__ unsigned xb_ld(unsigned* p)              { return __hip_atomic_load(p, __ATOMIC_RELAXED, __HIP_MEMORY_SCOPE_AGENT); }
__device__ __forceinline__ unsigned xb_add(unsigned* p, unsigned v) { return __hip_atomic_fetch_add(p, v, __ATOMIC_RELAXED, __HIP_MEMORY_SCOPE_AGENT); }
__device__ __forceinline__ unsigned xb_xcc_id() { return (unsigned)__builtin_amdgcn_s_getreg((3 << 11) | 20) & 0xFu; }
#define XB_SPIN(cond, bar) do { unsigned _sp = 0; while (cond) { __builtin_amdgcn_s_sleep(1); \
    if ((++_sp & 255u) == 0u) { if (xb_ld(&(bar)[XB_TMO])) break; if (_sp > XB_SPIN_CAP) { atomicAdd(&(bar)[XB_TMO], 1u); break; } } } } while (0)

struct XcdBarrier {
    unsigned* bar; unsigned x;
    volatile LAS unsigned* st;
};

__device__ __forceinline__ XcdBarrier xcd_barrier_post(unsigned* bar, volatile LAS unsigned* st) {
    XcdBarrier b; b.bar = bar; b.x = xb_xcc_id(); b.st = st;
    if (threadIdx.x == 0) (void)xb_add(&bar[XB_XCNT(b.x)], 1u);
    return b;
}
__device__ __forceinline__ void xcd_barrier_complete(unsigned* bar, unsigned x, unsigned& nloc, unsigned& nx) {
    const unsigned G = gridDim.x * gridDim.y * gridDim.z;
    unsigned sum, cnt, mine, sp = 0u;
    for (;;) {
        sum = 0u; cnt = 0u; mine = 0u;
#pragma unroll
        for (unsigned j = 0; j < 16; ++j) { const unsigned c = xb_ld(&bar[XB_XCNT(j)]); sum += c; cnt += (c > 0u) ? 1u : 0u; mine = (j == x) ? c : mine; }
        if (sum == G) break;
        __builtin_amdgcn_s_sleep(1);
        if ((++sp & 255u) == 0u) { if (xb_ld(&bar[XB_TMO])) break; if (sp > XB_SPIN_CAP) { atomicAdd(&bar[XB_TMO], 1u); break; } }
    }
    nloc = mine > 0u ? mine : 1u; nx = cnt > 0u ? cnt : 1u;
}

__device__ __forceinline__ void xcd_barrier(const XcdBarrier& b) {
    asm volatile("s_waitcnt vmcnt(0)" ::: "memory");
    __syncthreads();
    if (threadIdx.x == 0) {
        unsigned* bar = b.bar;
        __builtin_amdgcn_s_waitcnt(0);
        unsigned nloc = b.st[0], nx = b.st[1];
        if (nloc == 0u) { xcd_barrier_complete(bar, b.x, nloc, nx); b.st[0] = nloc; b.st[1] = nx; }
        const unsigned old = xb_add(&bar[XB_XSUB(b.x)], 1u);
        const unsigned gen = old / nloc;
        if (old + 1u == (gen + 1u) * nloc) {
            __builtin_amdgcn_fence(__ATOMIC_RELEASE, "agent");
            asm volatile("s_waitcnt vmcnt(0)" ::: "memory");
            const unsigned og = xb_add(&bar[XB_TOP], 1u);
            const unsigned tg = og / nx;
            if (og + 1u == (tg + 1u) * nx) xb_add(&bar[XB_TOPGEN], 1u);
            else XB_SPIN(xb_ld(&bar[XB_TOPGEN]) == tg, bar);
            __builtin_amdgcn_fence(__ATOMIC_ACQUIRE, "agent");
            xb_add(&bar[XB_XGEN(b.x)], 1u);
            asm volatile("s_waitcnt vmcnt(0)" ::: "memory");
        } else {
            XB_SPIN(xb_ld(&bar[XB_XGEN(b.x)]) == gen, bar);
            __builtin_amdgcn_fence(__ATOMIC_ACQUIRE, "agent");
            asm volatile("s_waitcnt vmcnt(0)" ::: "memory");
        }
    }
    __syncthreads();
}

struct Frame {
    LAS unsigned char* lds;
    int wave, vcu, G;
    __device__ __forceinline__ int tid() const { int t = (int)threadIdx.x; asm volatile("" : "+v"(t)); return t; }
    __device__ __forceinline__ int lane() const { return tid() & 63; }
    __device__ __forceinline__ unsigned long long raw(int k) const { const volatile LAS unsigned* p = (const volatile LAS unsigned*)(lds + RING_BYTES) + 2 * k;
        const unsigned lo = __builtin_amdgcn_readfirstlane(p[0]), hi = __builtin_amdgcn_readfirstlane(p[1]); return ((unsigned long long)hi << 32) | lo; }
    __device__ __forceinline__ const float* in(int k) const { return (const float*)raw(k); }
    __device__ __forceinline__ float* outp() const { return (float*)raw(22); }
    template <class T> __device__ __forceinline__ T* ws(size_t off) const { return (T*)((unsigned char*)raw(23) + off); }
};
enum { I_X = 0, I_WIN, I_BGLU, I_CONVW, I_CONVB, I_CLNG, I_CLNB, I_LQ1, I_LK1, I_LQ2, I_LK2, I_SUBLN, I_RELB, I_WOUT, I_LN1G, I_LN1B, I_WQ, I_KEYS, I_U, I_V, I_LN2G, I_LN2B };

__device__ __forceinline__ void p0_transpose_item(const float* W, int K, int N, bf16* WT, int k0, int n0, int dst0, LAS float* scr, int lane) {
#pragma unroll 8
    for (int i = 0; i < 32; ++i) { const int kk = 2 * i + (lane >> 5); scr[kk * 33 + (lane & 31)] = W[(size_t)(k0 + kk) * N + n0 + (lane & 31)]; }
    LDS_WAIT(); asm volatile("" ::: "memory");
    const int c = lane & 7;
#pragma unroll
    for (int j = 0; j < 4; ++j) { const int n = (lane >> 3) + 8 * j; const LAS float* s = scr + (8 * c) * 33 + n;
        v4u o; o.x = pk2(s[0 * 33], s[1 * 33]); o.y = pk2(s[2 * 33], s[3 * 33]); o.z = pk2(s[4 * 33], s[5 * 33]); o.w = pk2(s[6 * 33], s[7 * 33]);
        *(GAS v4u*)(WT + (size_t)(dst0 + n) * K + k0 + 8 * c) = o; }
    LDS_WAIT(); asm volatile("" ::: "memory");
}
__device__ __forceinline__ void p0_convert(const float* src, bf16* dst, size_t n, int gw, int NGW, int lane) {
    const size_t nit = n / 512;
    for (size_t it = gw; it < nit; it += NGW) { const GAS f32x4* s = (const GAS f32x4*)(src + it * 512) + 2 * lane; const f32x4 a = s[0], b = s[1];
        v4u o; o.x = pk2(a.x, a.y); o.y = pk2(a.z, a.w); o.z = pk2(b.x, b.y); o.w = pk2(b.z, b.w); *((GAS v4u*)(dst + it * 512) + lane) = o; }
}
__device__ __forceinline__ int t5_bucket(int d) {
    if (d < 16) return d;
    int l = 16 + (int)(logf((float)d / 16.f) / logf(8.f) * 16.f); return l < 31 ? l : 31;
}
__device__ __forceinline__ void p0_prologue(Frame& F) {
    const float* w_in = F.in(I_WIN); const float* w_out = F.in(I_WOUT); const float* peer_wq = F.in(I_WQ);
    bf16* Win_t = F.ws<bf16>(WS_WIN); bf16* Wout_t = F.ws<bf16>(WS_WOUT); bf16* Wq_t = F.ws<bf16>(WS_WQ);
    LAS float* scr = (LAS float*)(F.lds + F.wave * 16384);
    const int gw = F.vcu * NWAVES + F.wave, NGW = F.G * NWAVES;
    constexpr int I_IN = (D / 64) * (NPROJ / 32), I_OUT = (D / 64) * (D / 32), I_Q = I_OUT, NITEMS = I_IN + I_OUT + I_Q;
    for (int it = gw; it < NITEMS; it += NGW) {
        int r = it;
        if (r < I_IN) { const int nblk = NPROJ / 32, kb = r / nblk, nb = r % nblk, n0 = 32 * nb; int dst0 = n0;
            if (n0 >= 3072) { const int ch = (n0 - 3072) & 1023, gate = (n0 - 3072) >> 10; dst0 = 3072 + 256 * (ch >> 7) + 128 * gate + (ch & 127); }
            p0_transpose_item(w_in, D, NPROJ, Win_t, 64 * kb, n0, dst0, scr, F.lane()); continue; }
        r -= I_IN;
        if (r < I_OUT) { const int nblk = D / 32, kb = r / nblk, nb = r % nblk; p0_transpose_item(w_out, D, D, Wout_t, 64 * kb, 32 * nb, 32 * nb, scr, F.lane()); continue; }
        r -= I_OUT;
        { const int nblk = D / 32, kb = r / nblk, nb = r % nblk; p0_transpose_item(peer_wq, D, D, Wq_t, 64 * kb, 32 * nb, 32 * nb, scr, F.lane()); }
    }
    p0_convert(F.in(I_X), F.ws<bf16>(WS_XB), (size_t)M * D, gw, NGW, F.lane());
    p0_convert(F.in(I_U), F.ws<bf16>(WS_UB), (size_t)NEXP * D, gw, NGW, F.lane());
    p0_convert(F.in(I_V), F.ws<bf16>(WS_VB), (size_t)NEXP * D, gw, NGW, F.lane());
    p0_convert(F.in(I_KEYS), F.ws<bf16>(WS_KEYS), (size_t)PH * 2 * PNK * PHALF, gw, NGW, F.lane());
    if (blockIdx.x == 0) { const float* rel_bias = F.in(I_RELB); float* TAB = F.ws<float>(WS_TAB);
        for (int i = F.tid(); i < 8 * 128; i += NWAVES * 64) { const int h = i >> 7, d = i & 127;
            TAB[i] = (rel_bias[t5_bucket(d) * 8 + h] - rel_bias[31 * 8 + h]) * 1.4426950408889634f; } }
}

__device__ __forceinline__ float diff_lambda(Frame& F) {
    const float a = wave_sum(F.in(I_LQ1)[F.lane()] * F.in(I_LK1)[F.lane()]), b = wave_sum(F.in(I_LQ2)[F.lane()] * F.in(I_LK2)[F.lane()]);
    return expf(a) - expf(b) + LAMBDA_INIT;
}
__device__ __forceinline__ void p3_combine(Frame& F) {
    const float lam = diff_lambda(F);
    const float* subln_g = F.in(I_SUBLN); const bf16* O1 = F.ws<bf16>(WS_O1); const bf16* O2 = F.ws<bf16>(WS_O2); bf16* MIX = F.ws<bf16>(WS_XB);
    const int gw = F.vcu * NWAVES + F.wave, NGW = F.G * NWAVES;
    float g[16];
#pragma unroll
    for (int e = 0; e < 16; ++e) g[e] = subln_g[16 * (F.lane() & 7) + e] * (1.f - LAMBDA_INIT);
    for (int m = gw; m < M; m += NGW) {
        const GAS v4u* p1 = (const GAS v4u*)(O1 + (size_t)m * 1024) + 2 * F.lane(); const GAS v4u* p2 = (const GAS v4u*)(O2 + (size_t)m * 1024) + 2 * F.lane();
        const v4u a0 = p1[0], a1 = p1[1], b0 = p2[0], b1 = p2[1];
        const unsigned aw[8] = {a0.x, a0.y, a0.z, a0.w, a1.x, a1.y, a1.z, a1.w}, bw[8] = {b0.x, b0.y, b0.z, b0.w, b1.x, b1.y, b1.z, b1.w};
        float v[16]; float ss = 0.f;
#pragma unroll
        for (int i = 0; i < 8; ++i) { v[2 * i] = bflo(aw[i]) - lam * bflo(bw[i]); v[2 * i + 1] = bfhi(aw[i]) - lam * bfhi(bw[i]); ss += v[2 * i] * v[2 * i] + v[2 * i + 1] * v[2 * i + 1]; }
        ss += __shfl_xor(ss, 1); ss += __shfl_xor(ss, 2); ss += __shfl_xor(ss, 4);
        const float r = 1.f / sqrtf(ss * (1.f / 128.f) + LN_EPS);
        v4u o0, o1;
        o0.x = pk2(v[0] * r * g[0], v[1] * r * g[1]); o0.y = pk2(v[2] * r * g[2], v[3] * r * g[3]); o0.z = pk2(v[4] * r * g[4], v[5] * r * g[5]); o0.w = pk2(v[6] * r * g[6], v[7] * r * g[7]);
        o1.x = pk2(v[8] * r * g[8], v[9] * r * g[9]); o1.y = pk2(v[10] * r * g[10], v[11] * r * g[11]); o1.z = pk2(v[12] * r * g[12], v[13] * r * g[13]); o1.w = pk2(v[14] * r * g[14], v[15] * r * g[15]);
        GAS v4u* po = (GAS v4u*)(MIX + (size_t)m * D) + 2 * F.lane(); po[0] = o0; po[1] = o1;
    }
}
__device__ __forceinline__ void p3_conv(Frame& F) {
    constexpr int TT = 32, NR = TT + CONVW - 1, STATS_OFF = NR * 2048;
    const int tid = F.tid();
    const float* conv_w = F.in(I_CONVW); const bf16* H = F.ws<bf16>(WS_H); bf16* MIX = F.ws<bf16>(WS_XB);
    float w0[CONVW], w1[CONVW];
#pragma unroll
    for (int j = 0; j < CONVW; ++j) { const float2 w = *(const float2*)(conv_w + j * DCONV + 2 * tid); w0[j] = w.x; w1[j] = w.y; }
    const float2 cb = *(const float2*)(F.in(I_CONVB) + 2 * tid), lg = *(const float2*)(F.in(I_CLNG) + 2 * tid), lb = *(const float2*)(F.in(I_CLNB) + 2 * tid);
    LAS unsigned* tile = (LAS unsigned*)F.lds; LAS float* stats = (LAS float*)(F.lds + STATS_OFF);
    for (int tile_i = F.vcu; tile_i < M / TT; tile_i += F.G) {
        const int t0 = tile_i * TT, s0 = t0 & (SEQ - 1);
        for (int r = tid >> 7; r < NR; r += 4) { const int sp = s0 - (CONVW - 1) + r; v4u val = (v4u){0u, 0u, 0u, 0u};
            if (sp >= 0) val = *((const GAS v4u*)(H + (size_t)(t0 - (CONVW - 1) + r) * 1024) + (tid & 127));
            *(LAS v4u*)(F.lds + r * 2048 + (tid & 127) * 16) = val; }
        __syncthreads();
        for (int i = 0; i < TT; ++i) {
            float a0 = cb.x, a1 = cb.y;
#pragma unroll
            for (int j = 0; j < CONVW; ++j) { const unsigned wv = tile[(i + j) * 512 + tid]; a0 += w0[j] * bflo(wv); a1 += w1[j] * bfhi(wv); }
            const unsigned pk = pk2(a0, a1); tile[i * 512 + tid] = pk;
            const float r0 = bflo(pk), r1 = bfhi(pk);
            const float s = wave_sum(r0 + r1), q = wave_sum(r0 * r0 + r1 * r1);
            if (F.lane() == 0) { stats[(i * 8 + F.wave) * 2] = s; stats[(i * 8 + F.wave) * 2 + 1] = q; }
        }
        __syncthreads();
        for (int i = 0; i < TT; ++i) {
            float s = 0.f, q = 0.f;
#pragma unroll
            for (int w = 0; w < 8; ++w) { s += stats[(i * 8 + w) * 2]; q += stats[(i * 8 + w) * 2 + 1]; }
            const float mean = s * (1.f / DCONV), var = fmaxf(q * (1.f / DCONV) - mean * mean, 0.f), rstd = 1.f / sqrtf(var + LN_EPS);
            const unsigned pk = tile[i * 512 + tid];
            const float y0 = (bflo(pk) - mean) * rstd * lg.x + lb.x, y1 = (bfhi(pk) - mean) * rstd * lg.y + lb.y;
            const float z0 = y0 * __builtin_amdgcn_rcpf(1.f + __builtin_amdgcn_exp2f(-1.4426950409f * y0)), z1 = y1 * __builtin_amdgcn_rcpf(1.f + __builtin_amdgcn_exp2f(-1.4426950409f * y1));
            *((GAS unsigned*)(MIX + (size_t)(t0 + i) * D + DATT) + tid) = pk2(z0, z1);
        }
        __syncthreads();
    }
}
__device__ __forceinline__ void p5_ln1(Frame& F) {
    bf16* Y1 = F.ws<bf16>(WS_Y1); const float* ln1_g = F.in(I_LN1G); const float* ln1_b = F.in(I_LN1B);
    const int gw = F.vcu * NWAVES + F.wave, NGW = F.G * NWAVES;
    for (int m = gw; m < M; m += NGW) {
        GAS v4u* p = (GAS v4u*)(Y1 + (size_t)m * D) + F.lane();
        v4u w[4]; float v[32]; float s = 0.f;
#pragma unroll
        for (int j = 0; j < 4; ++j) { w[j] = p[64 * j]; const unsigned ww[4] = {w[j].x, w[j].y, w[j].z, w[j].w};
#pragma unroll
            for (int i = 0; i < 4; ++i) { v[8 * j + 2 * i] = bflo(ww[i]); v[8 * j + 2 * i + 1] = bfhi(ww[i]); s += v[8 * j + 2 * i] + v[8 * j + 2 * i + 1]; } }
        const float mean = wave_sum(s) * (1.f / D); float q = 0.f;
#pragma unroll
        for (int i = 0; i < 32; ++i) { v[i] -= mean; q += v[i] * v[i]; }
        const float rstd = 1.f / sqrtf(wave_sum(q) * (1.f / D) + LN_EPS);
#pragma unroll
        for (int j = 0; j < 4; ++j) { const int c0 = 8 * F.lane() + 512 * j; const f32x4 g0 = *(const f32x4*)(ln1_g + c0), g1 = *(const f32x4*)(ln1_g + c0 + 4), b0 = *(const f32x4*)(ln1_b + c0), b1 = *(const f32x4*)(ln1_b + c0 + 4);
            v4u o; o.x = pk2(v[8 * j] * rstd * g0[0] + b0[0], v[8 * j + 1] * rstd * g0[1] + b0[1]); o.y = pk2(v[8 * j + 2] * rstd * g0[2] + b0[2], v[8 * j + 3] * rstd * g0[3] + b0[3]);
            o.z = pk2(v[8 * j + 4] * rstd * g1[0] + b1[0], v[8 * j + 5] * rstd * g1[1] + b1[1]); o.w = pk2(v[8 * j + 6] * rstd * g1[2] + b1[2], v[8 * j + 7] * rstd * g1[3] + b1[3]);
            p[64 * j] = o; }
    }
}
__device__ __forceinline__ int f2key(float f) { const int b = __float_as_int(f); return b ^ ((b >> 31) & 0x7fffffff); }
__device__ __forceinline__ float key2f(int k) { return __int_as_float(k ^ ((k >> 31) & 0x7fffffff)); }
#define CE_DESC(a, b) do { const int _x = max(a, b), _y = min(a, b); a = _x; b = _y; } while (0)
#define CE_ASC(a, b)  do { const int _x = min(a, b), _y = max(a, b); a = _x; b = _y; } while (0)
template <int N> __device__ __forceinline__ void sort_desc(int (&v)[N]) {
#pragma unroll
    for (int k = 2; k <= N; k <<= 1)
#pragma unroll
        for (int j = k >> 1; j > 0; j >>= 1)
#pragma unroll
            for (int i = 0; i < N; ++i) { const int l = i ^ j; if (l > i) { if ((i & k) == 0) CE_DESC(v[i], v[l]); else CE_ASC(v[i], v[l]); } }
}
template <int N> __device__ __forceinline__ void bitonic_merge_desc(int (&v)[N]) {
#pragma unroll
    for (int j = N >> 1; j > 0; j >>= 1)
#pragma unroll
        for (int i = 0; i < N; ++i) { const int l = i ^ j; if (l > i) CE_DESC(v[i], v[l]); }
}
__device__ __forceinline__ void merge16(const int (&a)[16], const int (&b)[16], int (&o)[16]) {
#pragma unroll
    for (int i = 0; i < 16; ++i) o[i] = max(a[i], b[15 - i]);
    bitonic_merge_desc<16>(o);
}
__device__ __forceinline__ void top16_of_64(const int (&v)[64], int (&o)[16]) {
    int g0[16], g1[16], g2[16], g3[16];
#pragma unroll
    for (int i = 0; i < 16; ++i) { g0[i] = v[i]; g1[i] = v[16 + i]; g2[i] = v[32 + i]; g3[i] = v[48 + i]; }
    sort_desc<16>(g0); sort_desc<16>(g1); sort_desc<16>(g2); sort_desc<16>(g3);
    int m0[16], m1[16]; merge16(g0, g1, m0); merge16(g2, g3, m1); merge16(m0, m1, o);
}
__device__ __forceinline__ void peer_subkey_top16(const bf16* qrow  , const bf16* keys_hc  , int r32, int hi, int (&o)[16]) {
    bf16x8 bq[8];
    asm volatile("" : "+v"(qrow));
#pragma unroll
    for (int s = 0; s < 8; ++s) bq[s] = *(const bf16x8*)(qrow + 8 * s);
    int run[16];
#pragma unroll
    for (int mt = 0; mt < 4; ++mt) {
        const bf16* krow = keys_hc + (size_t)(32 * mt + r32) * PHALF + hi * 64;
        asm volatile("" : "+v"(krow));
        bf16x8 ka[8];
#pragma unroll
        for (int s = 0; s < 8; ++s) ka[s] = *(const bf16x8*)(krow + 8 * s);
        asm volatile("" ::: "memory");
        f32x16 acc = {};
#pragma unroll
        for (int s = 0; s < 8; ++s) acc = __builtin_amdgcn_mfma_f32_32x32x16_bf16(ka[s], bq[s], acc, 0, 0, 0);
        int g[16];
#pragma unroll
        for (int r = 0; r < 16; ++r) g[r] = (f2key(acc[r]) & ~127) | (32 * mt + (r & 3) + 8 * (r >> 2));
        sort_desc<16>(g);
        if (mt == 0) {
#pragma unroll
            for (int r = 0; r < 16; ++r) run[r] = g[r];
        } else { int t2[16]; merge16(run, g, t2);
#pragma unroll
            for (int r = 0; r < 16; ++r) run[r] = t2[r]; }
    }
    int lo[16], hh[16]; const int hi4 = 4 * hi;
#pragma unroll
    for (int i = 0; i < 16; ++i) { run[i] |= hi4; auto rr = __builtin_amdgcn_permlane32_swap((unsigned)run[i], (unsigned)run[i], false, false); lo[i] = (int)rr[0]; hh[i] = (int)rr[1]; }
    merge16(lo, hh, o);
}
__device__ __forceinline__ float gelu_erf(float v) { return 0.5f * v * (1.f + erff(v * 0.70710678118654752f)); }

__device__ __forceinline__ void p7_peer(Frame& F) {
    const int lane = F.lane(), r32 = lane & 31, hi = lane >> 5;
    constexpr int TPB = 128;
    const bf16* QP = F.ws<bf16>(WS_QP); const bf16* KEYS = F.ws<bf16>(WS_KEYS); const bf16* X1 = F.ws<bf16>(WS_Y1); const bf16* UB = F.ws<bf16>(WS_UB); const bf16* VB = F.ws<bf16>(WS_VB);
    int* EID = F.ws<int>(WS_EID); float* GATE = F.ws<float>(WS_GATE); const float* ln2_g = F.in(I_LN2G); const float* ln2_b = F.in(I_LN2B); float* outp = F.outp();
    LAS int* scr = (LAS int*)(F.lds + F.wave * 8448);
    for (int blk = F.vcu; blk < M / TPB; blk += F.G) {
        const int m0 = blk * TPB;
#ifndef NO_PEER_A
        { const int h = F.wave;
          for (int tt = 0; tt < 4; ++tt) {
            const int tok = m0 + 32 * tt + r32;
            const bf16* qrow = QP + (size_t)tok * D + h * 256 + hi * 64;
            int s1[16], s2[16];
            peer_subkey_top16(qrow, KEYS + (size_t)(h * 2 + 0) * PNK * PHALF, r32, hi, s1);
            asm volatile("" ::: "memory");
            peer_subkey_top16(qrow + 128, KEYS + (size_t)(h * 2 + 1) * PNK * PHALF, r32, hi, s2);
            float f1[16], f2[16];
#pragma unroll
            for (int i = 0; i < 16; ++i) { f1[i] = key2f(s1[i]); f2[i] = key2f(s2[i]); scr[lane * 33 + i] = s1[i] & 127; scr[lane * 33 + 16 + i] = s2[i] & 127; }
            int cand[64];
            {
#define PC(n_, i_, j_) cand[n_] = (f2key(f1[i_] + f2[j_]) & ~255) | ((i_) * 16 + (j_))
                PC(0,0,0); PC(1,0,1); PC(2,0,2); PC(3,0,3); PC(4,0,4); PC(5,0,5); PC(6,0,6); PC(7,0,7); PC(8,0,8); PC(9,0,9); PC(10,0,10); PC(11,0,11); PC(12,0,12); PC(13,0,13); PC(14,0,14); PC(15,0,15);
                PC(16,1,0); PC(17,1,1); PC(18,1,2); PC(19,1,3); PC(20,1,4); PC(21,1,5); PC(22,1,6); PC(23,1,7);
                PC(24,2,0); PC(25,2,1); PC(26,2,2); PC(27,2,3); PC(28,2,4);
                PC(29,3,0); PC(30,3,1); PC(31,3,2); PC(32,3,3);
                PC(33,4,0); PC(34,4,1); PC(35,4,2);
                PC(36,5,0); PC(37,5,1); PC(38,6,0); PC(39,6,1); PC(40,7,0); PC(41,7,1);
                PC(42,8,0); PC(43,9,0); PC(44,10,0); PC(45,11,0); PC(46,12,0); PC(47,13,0); PC(48,14,0); PC(49,15,0);
#undef PC
            }
#pragma unroll
            for (int i = 50; i < 64; ++i) cand[i] = (int)0x80000000;
            int sc[16]; top16_of_64(cand, sc);
            float p[16]; const float mx = key2f(sc[0]); float z = 0.f;
#pragma unroll
            for (int k = 0; k < 16; ++k) { p[k] = __expf(key2f(sc[k]) - mx); z += p[k]; }
            const float rz = 1.f / z;
            LDS_WAIT();
            int eo[8]; float go[8]; const int him = -hi;
#pragma unroll
            for (int kk = 0; kk < 8; ++kk) { const int tag = ((sc[kk] & ~him) | (sc[8 + kk] & him)) & 255;     const int i1 = scr[lane * 33 + (tag >> 4)], i2 = scr[lane * 33 + 16 + (tag & 15)];
                eo[kk] = i1 * PNK + i2; go[kk] = __int_as_float((__float_as_int(p[kk]) & ~him) | (__float_as_int(p[8 + kk]) & him)) * rz; }
            GAS int* ep = (GAS int*)(EID + (size_t)tok * 128 + h * 16 + 8 * hi); GAS float* gp = (GAS float*)(GATE + (size_t)tok * 128 + h * 16 + 8 * hi);
            *(GAS v4u*)ep = (v4u){(unsigned)eo[0], (unsigned)eo[1], (unsigned)eo[2], (unsigned)eo[3]}; *(GAS v4u*)(ep + 4) = (v4u){(unsigned)eo[4], (unsigned)eo[5], (unsigned)eo[6], (unsigned)eo[7]};
            *(GAS f32x4*)gp = (f32x4){go[0], go[1], go[2], go[3]}; *(GAS f32x4*)(gp + 4) = (f32x4){go[4], go[5], go[6], go[7]};
            LDS_WAIT();
          } }
#endif
        __threadfence_block(); __syncthreads();
#ifndef NO_PEER_B
        for (int ti = 0; ti < TPB / NWAVES; ++ti) {
            const int t = m0 + F.wave * (TPB / NWAVES) + ti;
            const GAS v4u* xp = (const GAS v4u*)(X1 + (size_t)t * D) + lane;
            v4u xr[4];
#pragma unroll
            for (int j = 0; j < 4; ++j) xr[j] = xp[64 * j];
            const int e_lo = __builtin_nontemporal_load(EID + (size_t)t * 128 + lane), e_hi = __builtin_nontemporal_load(EID + (size_t)t * 128 + 64 + lane);
            const float g_lo = __builtin_nontemporal_load(GATE + (size_t)t * 128 + lane), g_hi = __builtin_nontemporal_load(GATE + (size_t)t * 128 + 64 + lane);
            float w_lo = 0.f, w_hi = 0.f;
            for (int b = 0; b < 8; ++b) {
                const int esrc = (b < 4) ? e_lo : e_hi;
                float pp[16];
#pragma unroll
                for (int q = 0; q < 16; ++q) { const int e = __builtin_amdgcn_readlane(esrc, (16 * b + q) & 63);
                    const GAS v4u* up = (const GAS v4u*)(UB + (size_t)e * D) + lane; float a = 0.f;
#pragma unroll
                    for (int j = 0; j < 4; ++j) { const v4u u4 = up[64 * j]; a = dot2bf(u4.x, xr[j].x, a); a = dot2bf(u4.y, xr[j].y, a); a = dot2bf(u4.z, xr[j].z, a); a = dot2bf(u4.w, xr[j].w, a); }
                    pp[q] = a; if ((q & 3) == 3) asm volatile("" ::: "memory"); }
                float q8[8], q4[4], q2[2], tot;
                { const bool b0 = lane & 1;
#pragma unroll
                  for (int i = 0; i < 8; ++i) { const float keep = b0 ? pp[2 * i + 1] : pp[2 * i], send = b0 ? pp[2 * i] : pp[2 * i + 1]; q8[i] = keep + __shfl_xor(send, 1); } }
                { const bool b1 = lane & 2;
#pragma unroll
                  for (int i = 0; i < 4; ++i) { const float keep = b1 ? q8[2 * i + 1] : q8[2 * i], send = b1 ? q8[2 * i] : q8[2 * i + 1]; q4[i] = keep + __shfl_xor(send, 2); } }
                { const bool b2 = lane & 4;
#pragma unroll
                  for (int i = 0; i < 2; ++i) { const float keep = b2 ? q4[2 * i + 1] : q4[2 * i], send = b2 ? q4[2 * i] : q4[2 * i + 1]; q2[i] = keep + __shfl_xor(send, 4); } }
                { const bool b3 = lane & 8; const float keep = b3 ? q2[1] : q2[0], send = b3 ? q2[0] : q2[1]; tot = keep + __shfl_xor(send, 8); }
                tot += __shfl_xor(tot, 16); tot += __shfl_xor(tot, 32);
                const float act = gelu_erf(tot);
                if ((lane >> 4) == (b & 3)) { if (b < 4) w_lo = act * g_lo; else w_hi = act * g_hi; }
            }
            float o[32];
#pragma unroll
            for (int i = 0; i < 32; ++i) o[i] = 0.f;
            for (int kb = 0; kb < 32; ++kb) {
                const int esrc = (kb < 16) ? e_lo : e_hi; const float wsrc = (kb < 16) ? w_lo : w_hi;
#pragma unroll
                for (int q = 0; q < 4; ++q) { const int ln = (4 * kb + q) & 63; const int e = __builtin_amdgcn_readlane(esrc, ln); const float w = __int_as_float(__builtin_amdgcn_readlane(__float_as_int(wsrc), ln));
                    const GAS v4u* vp = (const GAS v4u*)(VB + (size_t)e * D) + lane;
#pragma unroll
                    for (int j = 0; j < 4; ++j) { const v4u v4 = vp[64 * j]; const unsigned vw[4] = {v4.x, v4.y, v4.z, v4.w};
#pragma unroll
                        for (int i = 0; i < 4; ++i) { o[8 * j + 2 * i] += w * bflo(vw[i]); o[8 * j + 2 * i + 1] += w * bfhi(vw[i]); } } }
            }
            float s = 0.f;
#pragma unroll
            for (int j = 0; j < 4; ++j) { const unsigned xw[4] = {xr[j].x, xr[j].y, xr[j].z, xr[j].w};
#pragma unroll
                for (int i = 0; i < 4; ++i) { o[8 * j + 2 * i] += DN_ALPHA * bflo(xw[i]); o[8 * j + 2 * i + 1] += DN_ALPHA * bfhi(xw[i]); s += o[8 * j + 2 * i] + o[8 * j + 2 * i + 1]; } }
            const float mean = wave_sum(s) * (1.f / D); float qv = 0.f;
#pragma unroll
            for (int i = 0; i < 32; ++i) { o[i] -= mean; qv += o[i] * o[i]; }
            const float rstd = 1.f / sqrtf(wave_sum(qv) * (1.f / D) + LN_EPS);
#pragma unroll
            for (int j = 0; j < 4; ++j) { const int c0 = 8 * lane + 512 * j; const f32x4 g0 = *(const f32x4*)(ln2_g + c0), g1 = *(const f32x4*)(ln2_g + c0 + 4), b0 = *(const f32x4*)(ln2_b + c0), b1 = *(const f32x4*)(ln2_b + c0 + 4);
                f32x4 r0, r1;
#pragma unroll
                for (int i = 0; i < 4; ++i) { r0[i] = o[8 * j + i] * rstd * g0[i] + b0[i]; r1[i] = o[8 * j + 4 + i] * rstd * g1[i] + b1[i]; }
                GAS f32x4* op = (GAS f32x4*)(outp + (size_t)t * D + c0); op[0] = r0; op[1] = r1; }
        }
#endif
        __syncthreads();
    }
}

struct Args { const float* in[22]; float* out; unsigned char* ws; int ph_lo, ph_hi; };
__global__ void __launch_bounds__(NWAVES * 64, 2) mk_fwd(Args args) {
    extern __shared__ __attribute__((aligned(16))) unsigned char lds[];
    cg::grid_group grid = cg::this_grid();
    Frame F;
    F.lds = (LAS unsigned char*)lds;
    F.wave = __builtin_amdgcn_readfirstlane((int)threadIdx.x >> 6);
    F.G = gridDim.x; { const int bx = blockIdx.x; F.vcu = (F.G % 8 == 0) ? (bx % 8) * (F.G / 8) + bx / 8 : bx; }
    if (threadIdx.x == 0) { LAS unsigned long long* PT = (LAS unsigned long long*)(F.lds + RING_BYTES);
#pragma unroll
        for (int k = 0; k < 22; ++k) PT[k] = (unsigned long long)args.in[k];
        PT[22] = (unsigned long long)args.out; PT[23] = (unsigned long long)args.ws;
        ((LAS unsigned*)(F.lds + RING_BYTES + 256))[0] = 0u; ((LAS unsigned*)(F.lds + RING_BYTES + 256))[1] = 0u; }
    __syncthreads();
    const int lo = args.ph_lo, hi = args.ph_hi;
#ifndef PHASE_MASK
#define PHASE_MASK 255
#endif
#define IN(k) (((PHASE_MASK >> (k)) & 1) && lo <= (k) && (k) < hi)
    const XcdBarrier bar = xcd_barrier_post((unsigned*)args.ws, (volatile LAS unsigned*)(F.lds + RING_BYTES + 256));
#define SEAM(k) do { if (IN(k) && IN((k) + 1)) { if ((k) == 0) grid.sync(); else xcd_barrier(bar); } } while (0)

    if (IN(0)) { p0_prologue(F); } SEAM(0);
    if (IN(1)) {
        pg8::Gemm g{F.ws<bf16>(WS_XB), F.ws<bf16>(WS_WIN), M, NPROJ, D}; pg8::StaticOrder S; S.init(M, NPROJ, F.G, (int)blockIdx.x);
        pg8::EpiProj E{F.ws<bf16>(WS_Q), (size_t)(WS_K - WS_Q) / 2, attn_body::C2, F.ws<bf16>(WS_H), F.in(I_BGLU)};
        pg8::gemm_phase<pg8::EpiProj, pg8::StaticOrder, PG8_ALIGN, PG8_SP2>(F.lds, g, S, E);
    } SEAM(1);
    if (IN(2)) {
        static_assert(attn_body::ATTN_LDS_BYTES <= RING_BYTES && attn_body::ATTN_PITCH == DATT, "attention body geometry vs frame");
        const attn_body::AttnTensors AT{F.ws<const attn_body::bf16>(WS_Q), F.ws<const attn_body::bf16>(WS_K), F.ws<const attn_body::bf16>(WS_V), F.ws<attn_body::bf16>(WS_O1), F.ws<attn_body::bf16>(WS_O2), F.ws<const float>(WS_TAB)};
        const attn_body::StaticOrder S((int)F.G, (int)blockIdx.x);
        attn_body::attn_phase<attn_body::StaticOrder>((char*)lds, AT, S);
    } SEAM(2);
    if (IN(3)) { p3_combine(F); p3_conv(F); } SEAM(3);
    if (IN(4)) {
        pg8::Gemm g{F.ws<bf16>(WS_XB), F.ws<bf16>(WS_WOUT), M, D, D}; pg8::StaticOrder S; S.init(M, D, F.G, (int)blockIdx.x);
        pg8::EpiRes E{F.in(I_X), F.ws<bf16>(WS_Y1), D, DN_ALPHA};
        pg8::gemm_phase<pg8::EpiRes, pg8::StaticOrder, PG8_ALIGN, PG8_SP2>(F.lds, g, S, E);
    } SEAM(4);
    if (IN(5)) { p5_ln1(F); } SEAM(5);
    if (IN(6)) {
        pg8::Gemm g{F.ws<bf16>(WS_Y1), F.ws<bf16>(WS_WQ), M, D, D}; pg8::StaticOrder S; S.init(M, D, F.G, (int)blockIdx.x);
        pg8::EpiPlain E{F.ws<bf16>(WS_QP), D};
        pg8::gemm_phase<pg8::EpiPlain, pg8::StaticOrder, PG8_ALIGN, PG8_SP2>(F.lds, g, S, E);
    } SEAM(6);
    if (IN(7)) { p7_peer(F); }
#undef IN
#undef SEAM
}

extern "C" void kernel_launch(void* const* d_in, const int* in_sizes, int n_in, void* d_out, int out_size, void* d_ws, size_t ws_size, hipStream_t stream) {
    static int grid = 0;
    if (grid == 0) {
        if (n_in != 22 || in_sizes[0] != M * D || out_size != M * D || ws_size < WS_END) { fprintf(stderr, "kernel_launch: unexpected shapes (n_in %d, in0 %d, out %d, ws %zu); nothing launched\n", n_in, n_in > 0 ? in_sizes[0] : -1, out_size, ws_size); grid = -1; return; }
        int dev = 0, cus = 0, per_cu = 0;
        if (hipGetDevice(&dev) != hipSuccess || hipDeviceGetAttribute(&cus, hipDeviceAttributeMultiprocessorCount, dev) != hipSuccess) { grid = -1; return; }
        if (hipFuncSetAttribute((const void*)mk_fwd, hipFuncAttributeMaxDynamicSharedMemorySize, LDS_BYTES) != hipSuccess) { fprintf(stderr, "kernel_launch: hipFuncSetAttribute failed\n"); grid = -1; return; }
        if (hipOccupancyMaxActiveBlocksPerMultiprocessor(&per_cu, (const void*)mk_fwd, NWAVES * 64, LDS_BYTES) != hipSuccess || per_cu < 1) { fprintf(stderr, "kernel_launch: occupancy query reports %d workgroups per CU\n", per_cu); (void)hipGetLastError(); grid = -1; return; }
        grid = cus;
        if (grid > 256) grid = 256;
    }
    if (grid < 0) return;
    if (hipMemsetAsync(d_ws, 0, 16384, stream) != hipSuccess) { fprintf(stderr, "kernel_launch: hipMemsetAsync failed\n"); return; }
    Args a{};
    for (int i = 0; i < 22; ++i) a.in[i] = (const float*)d_in[i];
    a.out = (float*)d_out; a.ws = (unsigned char*)d_ws;
    constexpr int NL = MK_N_LAUNCHES;
    for (int li = 0; li < NL; ++li) {
        a.ph_lo = (NL == 1) ? 0 : li; a.ph_hi = (NL == 1) ? N_PHASES : li + 1;
        void* kargs[] = {&a};
        const hipError_t le = hipLaunchCooperativeKernel((const void*)mk_fwd, dim3(grid), dim3(NWAVES * 64), kargs, LDS_BYTES, stream);
        if (le != hipSuccess) { fprintf(stderr, "kernel_launch: cooperative launch %d failed: %s (grid %d)\n", li, hipGetErrorString(le), grid); break; }
    }
}
```

```cpp
#include <hip/hip_runtime.h>
#include <hip/hip_cooperative_groups.h>
#include <cstdio>
#include <cstdint>
namespace cg = cooperative_groups;
namespace pg8 {
#define PG8_LAS __attribute__((address_space(3)))
typedef unsigned short bf16_t;
typedef short bf16x8 __attribute__((ext_vector_type(8)));
typedef float f32x4 __attribute__((ext_vector_type(4)));
typedef unsigned u32x4 __attribute__((ext_vector_type(4)));
constexpr int BM = 256, BK = 64, HALF = 128, HTB = HALF * BK * 2  , STAGE_BYTES = 8 * HTB, NXCD = 8, WGM = 8;

__host__ __device__ __forceinline__ int lds_byte(int r, int c) { const int st = (r >> 4) * 2 + (c >> 5), rr = r & 15, cc = c & 31, ob = rr * 64 + cc * 2; return st * 1024 + (ob ^ (((ob >> 9) & 1) << 5)); }
__host__ __device__ __forceinline__ void stage_rc(int b, int& R, int& C) { const int st = b / 1024, sb = b % 1024, swz = sb ^ (((sb >> 9) & 1) << 5); R = (st >> 1) * 16 + swz / 64; C = (st & 1) * 32 + (swz % 64) / 2; }
__host__ __device__ __forceinline__ int perm32(int rho) { const int n = rho >> 4, i = rho & 15; return 8 * (i >> 2) + 4 * n + (i & 3); }

struct Unit { int pm, pn; };
struct Gemm { const bf16_t* A; const bf16_t* Bt; int M, N, K; };

struct StaticOrder {
    int nM, nN, nwg, G, c;
    __host__ __device__ void init(int M, int N, int G_, int c_) { nM = M / BM; nN = N / BM; nwg = nM * nN; G = G_; c = c_; }
    __host__ __device__ bool next(int i, Unit& u) const {
        const long L = (long)i * G + c; if (L >= nwg) return false;
        int wgid = (int)L; { const int q = nwg / NXCD, r = nwg % NXCD, xcd = wgid % NXCD, off = wgid / NXCD; wgid = (xcd < r ? xcd * (q + 1) : r * (q + 1) + (xcd - r) * q) + off; }
        const int nig = WGM * nN, gid = wgid / nig, fm = gid * WGM, gsz = (nM - fm) < WGM ? (nM - fm) : WGM;
        u.pm = fm + ((wgid % nig) % gsz); u.pn = (wgid % nig) / gsz; return true;
    }
    __device__ __forceinline__ void a_ready(const Unit&) const {}
    __device__ __forceinline__ void done(const Unit&) const {}
};

__device__ __forceinline__ unsigned cvt_pk_bf16(float lo, float hi) { unsigned r; asm volatile("v_cvt_pk_bf16_f32 %0, %1, %2" : "=v"(r) : "v"(lo), "v"(hi)); return r; }
typedef float f32x2 __attribute__((ext_vector_type(2)));
typedef float f32x2 __attribute__((ext_vector_type(2)));
__device__ __forceinline__ u32x4 pack8(f32x4 v0, f32x4 v1) { u32x4 w; w.x = cvt_pk_bf16(v0[0], v0[1]); w.y = cvt_pk_bf16(v0[2], v0[3]); w.z = cvt_pk_bf16(v1[0], v1[1]); w.w = cvt_pk_bf16(v1[2], v1[3]); return w; }
struct EpiProj {
    static constexpr bool PERM = true, AFTER_DRAIN = false;
    bf16_t* QKV; size_t split_stride; float scale0; bf16_t* H; const float* bglu;
    __device__ __forceinline__ void operator()(const f32x4 (&acc)[2][2][4][2], const Unit& u, int wr, int wc, int fr, int fq) const {
        const int row0 = u.pm * BM + wr * 64 + fr;
        if (u.pn < 12) {
            const int t = u.pn >> 2; bf16_t* base = QKV + (size_t)t * split_stride; const float sc = (t == 0) ? scale0 : 1.f;
            const int col0 = (u.pn & 3) * BM + wc * 32 + 8 * fq;
#pragma unroll
            for (int ai = 0; ai < 2; ++ai)
#pragma unroll
                for (int m = 0; m < 4; ++m) { bf16_t* rowp = base + (size_t)(row0 + ai * HALF + m * 16) * 1024 + col0;
#pragma unroll
                    for (int bj = 0; bj < 2; ++bj) *(u32x4*)(rowp + bj * HALF) = pack8(acc[ai][bj][m][0] * sc, acc[ai][bj][m][1] * sc); }
        } else {
            const int ch0 = (u.pn - 12) * HALF + wc * 32 + 8 * fq;
            const f32x4 ba0 = *(const f32x4*)(bglu + ch0), ba1 = *(const f32x4*)(bglu + ch0 + 4), bg0 = *(const f32x4*)(bglu + 1024 + ch0), bg1 = *(const f32x4*)(bglu + 1024 + ch0 + 4);
#pragma unroll
            for (int ai = 0; ai < 2; ++ai)
#pragma unroll
                for (int m = 0; m < 4; ++m) {
                    const f32x4 a0 = acc[ai][0][m][0] + ba0, a1 = acc[ai][0][m][1] + ba1, g0 = acc[ai][1][m][0] + bg0, g1 = acc[ai][1][m][1] + bg1;
                    f32x4 h0, h1;
#pragma unroll
                    for (int e = 0; e < 4; ++e) { h0[e] = a0[e] * __builtin_amdgcn_rcpf(1.f + __builtin_amdgcn_exp2f(-1.4426950409f * g0[e])); h1[e] = a1[e] * __builtin_amdgcn_rcpf(1.f + __builtin_amdgcn_exp2f(-1.4426950409f * g1[e])); }
                    *(u32x4*)(H + (size_t)(row0 + ai * HALF + m * 16) * 1024 + ch0) = pack8(h0, h1); }
        }
    }
};
struct EpiRes {
    static constexpr bool PERM = true, AFTER_DRAIN = false;
    const float* X; bf16_t* Y; int ldc; float alpha;
    __device__ __forceinline__ void operator()(const f32x4 (&acc)[2][2][4][2], const Unit& u, int wr, int wc, int fr, int fq) const {
        const int row0 = u.pm * BM + wr * 64 + fr, col0 = u.pn * BM + wc * 32 + 8 * fq;
#pragma unroll
        for (int ai = 0; ai < 2; ++ai)
#pragma unroll
            for (int m = 0; m < 4; ++m) { const size_t off = (size_t)(row0 + ai * HALF + m * 16) * ldc + col0;
#pragma unroll
                for (int bj = 0; bj < 2; ++bj) { const f32x4 x0 = *(const f32x4*)(X + off + bj * HALF), x1 = *(const f32x4*)(X + off + bj * HALF + 4);
                    *(u32x4*)(Y + off + bj * HALF) = pack8(acc[ai][bj][m][0] + x0 * alpha, acc[ai][bj][m][1] + x1 * alpha); } }
    }
};
struct EpiPlain {
    static constexpr bool PERM = true, AFTER_DRAIN = false;
    bf16_t* O; int ldc;
    __device__ __forceinline__ void operator()(const f32x4 (&acc)[2][2][4][2], const Unit& u, int wr, int wc, int fr, int fq) const {
        const int row0 = u.pm * BM + wr * 64 + fr, col0 = u.pn * BM + wc * 32 + 8 * fq;
#pragma unroll
        for (int ai = 0; ai < 2; ++ai)
#pragma unroll
            for (int m = 0; m < 4; ++m) { bf16_t* rowp = O + (size_t)(row0 + ai * HALF + m * 16) * ldc + col0;
#pragma unroll
                for (int bj = 0; bj < 2; ++bj) *(u32x4*)(rowp + bj * HALF) = pack8(acc[ai][bj][m][0], acc[ai][bj][m][1]); }
    }
};

template <class Epi, class Sched, bool ALIGN_EPI = false, bool SP2 = false>
__device__ __forceinline__ void gemm_phase(PG8_LAS unsigned char* lds, const Gemm g, const Sched& S, const Epi& E) {
    const int tid = threadIdx.x, wid = __builtin_amdgcn_readfirstlane(tid >> 6), lane = tid & 63, wr = wid >> 2, wc = wid & 3, fr = lane & 15, fq = lane >> 4;
    const int K = g.K, nt = K / BK;
    unsigned voffA[2], voffB[2];
#pragma unroll
    for (int i = 0; i < 2; ++i) { int R, C; stage_rc(tid * 16 + i * 8192, R, C); const int Rb = Epi::PERM ? ((R & ~31) + perm32(R & 31)) : R;
        voffA[i] = (unsigned)(R * K + C) * 2u; voffB[i] = (unsigned)(Rb * K + C) * 2u; }
    const size_t kstep = (size_t)(BK * 2);
    const size_t hstep = (size_t)HALF * K * 2;
    const size_t tstep = 2 * hstep;
    const unsigned ldsw = (unsigned)wid * 1024u;
    const int aoff = lds_byte(wr * 64 + fr, fq * 8), boff = lds_byte(wc * 32 + fr, fq * 8);
#define PG8_SA(b, h) (((b) * 2 + (h)) * HTB)
#define PG8_SB(b, h) ((4 + (b) * 2 + (h)) * HTB)
#define PG8_STAGE(bufoff, gbase, voff) do { _Pragma("unroll") for (int _i = 0; _i < 2; ++_i) \
        __builtin_amdgcn_global_load_lds((const unsigned*)((const char*)(gbase) + (voff)[_i]), (PG8_LAS unsigned*)(lds + (bufoff) + ldsw + _i * 8192), 16, 0, 0); } while (0)
#define PG8_LDA(dst, b, h) do { _Pragma("unroll") for (int m = 0; m < 4; ++m) _Pragma("unroll") for (int k = 0; k < 2; ++k) dst[m][k] = *(const PG8_LAS bf16x8*)(lds + PG8_SA(b, h) + aoff + m * 2048 + k * 1024); } while (0)
#define PG8_LDB(dst, b, h) do { _Pragma("unroll") for (int n = 0; n < 2; ++n) _Pragma("unroll") for (int k = 0; k < 2; ++k) dst[n][k] = *(const PG8_LAS bf16x8*)(lds + PG8_SB(b, h) + boff + n * 2048 + k * 1024); } while (0)
#define PG8_MMA(ai, bj, At, Bt) do { __builtin_amdgcn_s_setprio(1); _Pragma("unroll") for (int m = 0; m < 4; ++m) _Pragma("unroll") for (int n = 0; n < 2; ++n) _Pragma("unroll") for (int k = 0; k < 2; ++k) \
        acc[ai][bj][m][n] = __builtin_amdgcn_mfma_f32_16x16x32_bf16(Bt[n][k], At[m][k], acc[ai][bj][m][n], 0, 0, 0); __builtin_amdgcn_s_setprio(0); } while (0)
#define PG8_WAIT_V(n) asm volatile("s_waitcnt vmcnt(" #n ")" ::: "memory")
#define PG8_WAIT_L(n) asm volatile("s_waitcnt lgkmcnt(" #n ")" ::: "memory")
#define PG8_BAR __builtin_amdgcn_s_barrier()
#define PG8_SCHED __builtin_amdgcn_sched_barrier(0)
    Unit cur, nxt; int ui = 0;
    if (!S.next(0, cur)) return;
    f32x4 acc[2][2][4][2];
#pragma unroll
    for (int a = 0; a < 2; ++a)
#pragma unroll
        for (int b = 0; b < 2; ++b)
#pragma unroll
            for (int m = 0; m < 4; ++m)
#pragma unroll
                for (int n = 0; n < 2; ++n) acc[a][b][m][n] = (f32x4){0.f, 0.f, 0.f, 0.f};
    bf16x8 At[4][2], B0[2][2], B1[2][2];
    const char* cA = (const char*)g.A + (size_t)cur.pm * tstep; const char* cB = (const char*)g.Bt + (size_t)cur.pn * tstep;
    S.a_ready(cur);
    if constexpr (SP2) {
        PG8_STAGE(PG8_SB(0, 0), cB, voffB); PG8_STAGE(PG8_SB(0, 1), cB + hstep, voffB); PG8_STAGE(PG8_SA(0, 0), cA, voffA); PG8_STAGE(PG8_SA(0, 1), cA + hstep, voffA);
        if (wr == 1) PG8_BAR;
        PG8_WAIT_V(2); PG8_BAR;
        PG8_STAGE(PG8_SB(1, 0), cB + kstep, voffB); PG8_STAGE(PG8_SA(1, 0), cA + kstep, voffA); PG8_STAGE(PG8_SB(1, 1), cB + hstep + kstep, voffB);
        PG8_WAIT_V(6); PG8_BAR;
    } else {
        PG8_STAGE(PG8_SB(0, 0), cB, voffB); PG8_STAGE(PG8_SA(0, 0), cA, voffA); PG8_STAGE(PG8_SB(0, 1), cB + hstep, voffB); PG8_STAGE(PG8_SA(0, 1), cA + hstep, voffA);
        if (wr == 1) PG8_BAR;
        PG8_WAIT_V(4); PG8_BAR;
        PG8_STAGE(PG8_SB(1, 0), cB + kstep, voffB); PG8_STAGE(PG8_SA(1, 0), cA + kstep, voffA); PG8_STAGE(PG8_SB(1, 1), cB + hstep + kstep, voffB);
        PG8_WAIT_V(6); PG8_BAR;
    }
    for (;;) {
        const bool has_next = S.next(ui + 1, nxt);
        const char* nA = has_next ? (const char*)g.A + (size_t)nxt.pm * tstep : cA; const char* nB = has_next ? (const char*)g.Bt + (size_t)nxt.pn * tstep : cB;
        for (int t = 0; t < nt; t += 2) {
            const bool last = (t == nt - 2);
            const char* a1 = cA + (size_t)(t + 1) * kstep;
            const char* a2 = last ? nA : cA + (size_t)(t + 2) * kstep; const char* b2 = last ? nB : cB + (size_t)(t + 2) * kstep;
            const char* a3 = a2 + kstep; const char* b3 = b2 + kstep;
            if (last && has_next) S.a_ready(nxt);
            if constexpr (SP2) {
            PG8_LDB(B0, 0, 0); PG8_LDB(B1, 0, 1); PG8_SCHED; PG8_LDA(At, 0, 0); PG8_STAGE(PG8_SA(1, 1), a1 + hstep, voffA);
            PG8_WAIT_V(8); PG8_WAIT_L(0); PG8_BAR; PG8_MMA(0, 0, At, B0); PG8_MMA(0, 1, At, B1); PG8_BAR; PG8_SCHED;
            PG8_LDA(At, 0, 1); PG8_STAGE(PG8_SB(0, 0), b2, voffB); PG8_STAGE(PG8_SB(0, 1), b2 + hstep, voffB); PG8_STAGE(PG8_SA(0, 0), a2, voffA);
            PG8_WAIT_V(8); PG8_WAIT_L(0); PG8_BAR; PG8_MMA(1, 0, At, B0); PG8_MMA(1, 1, At, B1); PG8_BAR; PG8_SCHED;
            PG8_LDB(B0, 1, 0); PG8_LDB(B1, 1, 1); PG8_SCHED; PG8_LDA(At, 1, 0); PG8_STAGE(PG8_SA(0, 1), a2 + hstep, voffA);
            PG8_WAIT_V(8); PG8_WAIT_L(0); PG8_BAR; PG8_MMA(0, 0, At, B0); PG8_MMA(0, 1, At, B1); PG8_BAR; PG8_SCHED;
            PG8_LDA(At, 1, 1); PG8_STAGE(PG8_SB(1, 0), b3, voffB); PG8_STAGE(PG8_SB(1, 1), b3 + hstep, voffB); PG8_STAGE(PG8_SA(1, 0), a3, voffA);
            PG8_WAIT_V(8); PG8_WAIT_L(0); PG8_BAR; PG8_MMA(1, 0, At, B0); PG8_MMA(1, 1, At, B1); PG8_BAR; PG8_SCHED;
            } else {
            PG8_LDB(B0, 0, 0); PG8_SCHED; PG8_LDA(At, 0, 0); PG8_STAGE(PG8_SA(1, 1), a1 + hstep, voffA);
            PG8_WAIT_L(8); PG8_BAR; PG8_WAIT_L(0); PG8_MMA(0, 0, At, B0); PG8_BAR; PG8_SCHED;
            PG8_LDB(B1, 0, 1); PG8_STAGE(PG8_SB(0, 0), b2, voffB);
            PG8_BAR; PG8_WAIT_L(0); PG8_MMA(0, 1, At, B1); PG8_BAR;
            PG8_LDA(At, 0, 1); PG8_STAGE(PG8_SA(0, 0), a2, voffA);
            PG8_BAR; PG8_WAIT_L(0); PG8_MMA(1, 0, At, B0); PG8_BAR; PG8_SCHED;
            PG8_STAGE(PG8_SB(0, 1), b2 + hstep, voffB);
            PG8_WAIT_V(6); PG8_BAR; PG8_MMA(1, 1, At, B1); PG8_BAR;
            PG8_LDB(B0, 1, 0); PG8_SCHED; PG8_LDA(At, 1, 0); PG8_STAGE(PG8_SA(0, 1), a2 + hstep, voffA);
            PG8_WAIT_L(8); PG8_BAR; PG8_WAIT_L(0); PG8_MMA(0, 0, At, B0); PG8_BAR; PG8_SCHED;
            PG8_LDB(B1, 1, 1); PG8_STAGE(PG8_SB(1, 0), b3, voffB);
            PG8_BAR; PG8_WAIT_L(0); PG8_MMA(0, 1, At, B1); PG8_BAR;
            PG8_LDA(At, 1, 1); PG8_STAGE(PG8_SA(1, 0), a3, voffA);
            PG8_BAR; PG8_WAIT_L(0); PG8_MMA(1, 0, At, B0); PG8_BAR; PG8_SCHED;
            PG8_STAGE(PG8_SB(1, 1), b3 + hstep, voffB);
            PG8_WAIT_V(6); PG8_BAR; PG8_MMA(1, 1, At, B1); PG8_BAR;
            }
        }
        if constexpr (ALIGN_EPI) { if (wr == 0) PG8_BAR; }
        if constexpr (!Epi::AFTER_DRAIN) { E(acc, cur, wr, wc, fr, fq); S.done(cur); }
        if (!has_next) break;
#pragma unroll
        for (int a = 0; a < 2; ++a)
#pragma unroll
            for (int b = 0; b < 2; ++b)
#pragma unroll
                for (int m = 0; m < 4; ++m)
#pragma unroll
                    for (int n = 0; n < 2; ++n) acc[a][b][m][n] = (f32x4){0.f, 0.f, 0.f, 0.f};
        cur = nxt; cA = nA; cB = nB; ++ui;
        if constexpr (ALIGN_EPI) { if (wr == 1) PG8_BAR; }
    }
    PG8_WAIT_V(0);
    if constexpr (!ALIGN_EPI) { if (wr == 0) PG8_BAR; }
    PG8_BAR;
    if constexpr (Epi::AFTER_DRAIN) { E.fused(acc, cur, wr, wc, fr, fq, lds, wid, lane); S.done(cur); }
#undef PG8_SA
#undef PG8_SB
#undef PG8_STAGE
#undef PG8_LDA
#undef PG8_LDB
#undef PG8_MMA
#undef PG8_WAIT_V
#undef PG8_WAIT_L
#undef PG8_BAR
#undef PG8_SCHED
}
}
#include <hip/hip_bf16.h>
#include <cmath>
namespace attn_body {
using bf16=__hip_bfloat16;
using bf16x8=__attribute__((ext_vector_type(8)))short;
using s16x4=__attribute__((ext_vector_type(4)))short;
using f32x16=__attribute__((ext_vector_type(16)))float;
using u32x4=__attribute__((ext_vector_type(4)))unsigned;
constexpr int BATCH=8,NHEAD=16,SEQ=4096,D=64,DM=NHEAD*D;
constexpr int NW=8,QBLK=32,QB=QBLK*NW,KVBLK=64,NQB=SEQ/QB;
constexpr int ATTN_PITCH=DM, ATTN_UNIT_ROWS=QB;
__device__ __forceinline__ int crow(int r,int hi){return (r&3)+8*(r>>2)+4*hi;}
#define SBAR() __builtin_amdgcn_sched_barrier(0)
__device__ __forceinline__ void cmask(f32x16&p0,f32x16&p1,int jb,int qrel,int hi){
  const float NEG=-INFINITY; int kb=64*jb+4*hi;
  #pragma unroll
  for(int r=0;r<16;++r){int kv=kb+(r&3)+8*(r>>2); if(kv>qrel)p0[r]=NEG; if(kv+32>qrel)p1[r]=NEG;}
}

__device__ __forceinline__ void cbias(f32x16&p0,f32x16&p1,int jb,int qrel,int hi,const __attribute__((address_space(3))) float*tab){
  const int base=qrel-64*jb-4*hi;
  #pragma unroll
  for(int r=0;r<16;++r){const int d0=base-((r&3)+8*(r>>2)); const int i0=min(max(d0,0),127), i1=min(max(d0-32,0),127); p0[r]+=tab[i0]; p1[r]+=tab[i1];}
}
constexpr int NSLOT=3, SLOTB=8192;
constexpr int LDS_K=0, LDS_V=NSLOT*SLOTB, LDS_WS=2*NSLOT*SLOTB, LDS_OST=LDS_WS+NW*64*4, LDS_TAB=LDS_OST+NW*4096, LDS_BYTES=LDS_TAB+512;
constexpr float C2=0.125f*1.4426950408889634f;
__device__ __forceinline__ void glds16(const void*gsrc,unsigned lds_dst){unsigned keep;
  asm volatile("s_mov_b32 %0, m0\n\ts_mov_b32 m0, %2\n\ts_nop 0\n\tglobal_load_lds_dwordx4 %1, off\n\ts_mov_b32 m0, %0":"=&s"(keep):"v"(gsrc),"s"(lds_dst):"memory");}
__device__ __forceinline__ float max3f(float a,float b,float c){float r;asm("v_max3_f32 %0, %1, %2, %3":"=v"(r):"v"(a),"v"(b),"v"(c));return r;}
__device__ __forceinline__ float max2f(float a,float b){float r;asm("v_max_f32_e32 %0, %1, %2":"=v"(r):"v"(a),"v"(b));return r;}
__device__ __forceinline__ float fadd_s(float a,float b){float r;asm("v_add_f32_e32 %0, %1, %2":"=v"(r):"v"(a),"v"(b));return r;}
__device__ __forceinline__ float fsub_s(float a,float b){float r;asm("v_sub_f32_e32 %0, %1, %2":"=v"(r):"v"(a),"v"(b));return r;}
typedef float f32x2_t __attribute__((ext_vector_type(2))); typedef __bf16 bf16x2_t __attribute__((ext_vector_type(2)));
__device__ __forceinline__ unsigned cvtpk_s(float lo,float hi){f32x2_t v={lo,hi};bf16x2_t b=__builtin_convertvector(v,bf16x2_t);return __builtin_bit_cast(unsigned,b);}
#define WAIT_BAR(N) asm volatile("s_waitcnt vmcnt(" #N ") lgkmcnt(0)\n\ts_barrier":::"memory")

__device__ __forceinline__ void qkt(f32x16&p0,f32x16&p1,const char*Kslot,const bf16x8*qr,const f32x16&negm,int r32,int hi){
  const char*kb=Kslot+hi*1024+r32*16;
  #pragma unroll
  for(int d0=0;d0<4;++d0){
    const bf16x8 b0=*reinterpret_cast<const bf16x8*>(kb+d0*2048);
    const bf16x8 b1=*reinterpret_cast<const bf16x8*>(kb+d0*2048+512);
    if(d0==0){p0=__builtin_amdgcn_mfma_f32_32x32x16_bf16(b0,qr[0],negm,0,0,0);p1=__builtin_amdgcn_mfma_f32_32x32x16_bf16(b1,qr[0],negm,0,0,0);}
    else{p0=__builtin_amdgcn_mfma_f32_32x32x16_bf16(b0,qr[d0],p0,0,0,0);p1=__builtin_amdgcn_mfma_f32_32x32x16_bf16(b1,qr[d0],p1,0,0,0);}}
}
typedef __attribute__((address_space(3))) const char* lds_cptr;
typedef short v4i16_t __attribute__((ext_vector_type(4)));
__device__ __forceinline__ void kload8(bf16x8*kf,lds_cptr kp){
  kf[0]=*(const __attribute__((address_space(3))) bf16x8*)(kp);      kf[1]=*(const __attribute__((address_space(3))) bf16x8*)(kp+512);
  kf[2]=*(const __attribute__((address_space(3))) bf16x8*)(kp+2048); kf[3]=*(const __attribute__((address_space(3))) bf16x8*)(kp+2560);
  kf[4]=*(const __attribute__((address_space(3))) bf16x8*)(kp+4096); kf[5]=*(const __attribute__((address_space(3))) bf16x8*)(kp+4608);
  kf[6]=*(const __attribute__((address_space(3))) bf16x8*)(kp+6144); kf[7]=*(const __attribute__((address_space(3))) bf16x8*)(kp+6656);
}
__device__ __forceinline__ void kload2(bf16x8*kf,lds_cptr kp,int j){ kf[2*j]=*(const __attribute__((address_space(3))) bf16x8*)(kp+j*2048); kf[2*j+1]=*(const __attribute__((address_space(3))) bf16x8*)(kp+j*2048+512); }
__device__ __forceinline__ s16x4 vtr(lds_cptr p){ return __builtin_bit_cast(s16x4,__builtin_amdgcn_ds_read_tr16_b64_v4i16((__attribute__((address_space(3))) v4i16_t*)p)); }
__device__ __forceinline__ float rowmax(const f32x16&p0,const f32x16&p1){
  float a=max3f(p0[0],p0[1],p1[0]),b=max3f(p0[2],p0[3],p1[1]);a=max3f(a,p1[2],p1[3]);
  #pragma unroll
  for(int r=4;r<16;r+=4){a=max3f(a,p0[r],p0[r+1]);b=max3f(b,p0[r+2],p0[r+3]);a=max3f(a,p1[r],p1[r+1]);b=max3f(b,p1[r+2],p1[r+3]);}
  const float m=max2f(a,b);
  auto rr=__builtin_amdgcn_permlane32_swap(__float_as_uint(m),__float_as_uint(m),false,false);
  return max2f(__uint_as_float(rr[0]),__uint_as_float(rr[1]));
}
__device__ __forceinline__ void pv(f32x16*o,int vb,bf16x8 pa0,bf16x8 pa1,bf16x8 pa2,bf16x8 pa3){
  #pragma unroll
  for(int d0=0;d0<2;++d0){s16x4 lo[4],hi[4];
    #pragma unroll
    for(int ks=0;ks<4;++ks){
      asm volatile("ds_read_b64_tr_b16 %0,%1 offset:%c2":"=&v"(lo[ks]):"v"(vb),"i"(d0*4096+ks*1024):"memory");
      asm volatile("ds_read_b64_tr_b16 %0,%1 offset:%c2":"=&v"(hi[ks]):"v"(vb),"i"(d0*4096+ks*1024+512):"memory");}
    asm volatile("s_waitcnt lgkmcnt(0)":::"memory");SBAR();
    #define PK(k) (bf16x8){lo[k][0],lo[k][1],lo[k][2],lo[k][3],hi[k][0],hi[k][1],hi[k][2],hi[k][3]}
    o[d0]=__builtin_amdgcn_mfma_f32_32x32x16_bf16(pa0,PK(0),o[d0],0,0,0);
    o[d0]=__builtin_amdgcn_mfma_f32_32x32x16_bf16(pa1,PK(1),o[d0],0,0,0);
    o[d0]=__builtin_amdgcn_mfma_f32_32x32x16_bf16(pa2,PK(2),o[d0],0,0,0);
    o[d0]=__builtin_amdgcn_mfma_f32_32x32x16_bf16(pa3,PK(3),o[d0],0,0,0);
    #undef PK
  }
}

#ifndef ATTN_STORE16
#define ATTN_STORE16(p,v) (*(u32x4*)(p)=(v))
#endif
template<int THRL> __device__ __forceinline__ void attn_unit(int b,int h,int hv,int qb,const bf16*Q,const bf16*__restrict__ K,const bf16*__restrict__ V,bf16*O,char*shm){
  const __attribute__((address_space(3))) float* tab=(const __attribute__((address_space(3))) float*)((lds_cptr)shm+LDS_TAB);
  const int tid=threadIdx.x,lane=tid&63,r32=lane&31,hi=lane>>5; const int wid=__builtin_amdgcn_readfirstlane(tid>>6);
  const long rowbase=(long)b*SEQ; const int q0=qb*QB;
  const bf16*Qw=Q+(rowbase+q0+wid*QBLK)*DM+h*D;
  const bf16*Kh=K+rowbase*DM+h*D,*Vh=V+rowbase*DM+hv*D;
  const unsigned lds0=(unsigned)(uintptr_t)shm;
  float*wsf=(float*)(shm+LDS_WS)+wid*64;
  const bf16*ksrc=Kh+(long)lane*DM+wid*8;
  const bf16*vsrc=Vh+(long)(16*(wid&3)+(lane>>2))*DM+(wid>>2)*32+(lane&3)*8;
  const unsigned kdst=lds0+LDS_K+wid*1024, vdst=lds0+LDS_V+wid*1024;
  #define DMA_K(t,slot) glds16(ksrc+(long)(t)*KVBLK*DM,(unsigned)__builtin_amdgcn_readfirstlane(kdst+(slot)))
  #define DMA_V(t,slot) glds16(vsrc+(long)(t)*KVBLK*DM,(unsigned)__builtin_amdgcn_readfirstlane(vdst+(slot)))
  const int vb0=(int)(lds0+LDS_V)+((lane>>4)&1)*32+(lane&3)*8+(4*hi+((lane&15)>>2))*64;
  const char*Kbase=shm+LDS_K; bf16x8 kf[8];
  const lds_cptr shm3=(lds_cptr)shm; const lds_cptr kp0=shm3+LDS_K+hi*1024+r32*16; const lds_cptr vp0=shm3+LDS_V+((lane>>4)&1)*32+(lane&3)*8+(4*hi+((lane&15)>>2))*64;
  const int NT=(q0+QB)/KVBLK;
  DMA_K(0,0);DMA_V(0,0);DMA_K(1,SLOTB);
  bf16x8 qr[4];
  #pragma unroll
  for(int d0=0;d0<4;++d0)qr[d0]=*reinterpret_cast<const bf16x8*>(&Qw[(long)r32*DM+d0*16+hi*8]);
  float mhat=0.f,l_reg=0.f;f32x16 o[2];o[0]=f32x16{};o[1]=f32x16{};f32x16 negm=f32x16{};asm volatile("":"+v"(negm));
  const int qrel=wid*QBLK+r32;
  #define CMASK(P0,P1,t) do{int jb_=(t)-(NT-4); if(jb_>=-2){cbias(P0,P1,jb_,qrel,hi,tab); if(jb_>=0)cmask(P0,P1,jb_,qrel,hi);}}while(0)
  bool resc=false;
  #define START(P0,P1) do{ const float rm=rowmax(P0,P1); resc=false; \
    { const float dl=rm; mhat=fadd_s(mhat,dl); \
      _Pragma("unroll") for(int r=0;r<16;++r){P0[r]=fsub_s(P0[r],dl);P1[r]=fsub_s(P1[r],dl);} \
      _Pragma("unroll") for(int r=0;r<16;++r)negm[r]=-mhat; asm volatile("":"+v"(negm)); } \
    _Pragma("unroll") for(int r=0;r<16;++r)P0[r]=__builtin_amdgcn_exp2f(P0[r]); }while(0)
  #define RESC() do{ if(resc){ asm volatile("s_waitcnt lgkmcnt(0)":::"memory"); \
      _Pragma("unroll") for(int d_=0;d_<2;++d_) _Pragma("unroll") for(int r=0;r<16;++r)o[d_][r]*=wsf[crow(r,hi)]; } }while(0)
  f32x16 pA0,pA1,pB0,pB1;
  int sl_prev=0,sl_cur=0,sl_next=SLOTB;
  #define ROT() do{sl_prev=sl_cur;sl_cur=sl_next;sl_next=(sl_next==(NSLOT-1)*SLOTB)?0:sl_next+SLOTB;}while(0)
  DMA_K(2,2*SLOTB);
  WAIT_BAR(3);
  qkt(pA0,pA1,Kbase,qr,negm,r32,hi);asm volatile("s_nop 15\n\ts_nop 7":"+v"(pA0),"+v"(pA1));CMASK(pA0,pA1,0);
  START(pA0,pA1);
  _Pragma("unroll") for(int r=0;r<16;++r)pA1[r]=__builtin_amdgcn_exp2f(pA1[r]);
  WAIT_BAR(0);
  DMA_K(3,0);DMA_V(1,SLOTB);
  ROT();
  kload8(kf,kp0+sl_cur);
  WAIT_BAR(2);
  s16x4 vlo[8],vhi[8]; u32x4 pw0,pw1,pw2,pw3;
  #define PKW(P,B) cvtpk_s(P[B],P[B+1])
  #define PAF(k) __builtin_bit_cast(bf16x8,pw##k)
  #define VFR(i) (bf16x8){vlo[i][0],vlo[i][1],vlo[i][2],vlo[i][3],vhi[i][0],vhi[i][1],vhi[i][2],vhi[i][3]}
  #define PIN(x) asm volatile("":"+v"(x))
  #define MX3(a,b,c) __builtin_fmaxf(__builtin_fmaxf((a),(b)),(c))
  #define GAPA(MF,A0,A1,A2,A3,W0,W1,PW) do{ MF; sacc+=A0; sacc+=A1; sacc+=A2; sacc+=A3; PIN(sacc); W0; W1; PIN(PW); SBAR(); }while(0)
  #define EX(v) __builtin_amdgcn_exp2f(v)
  #define GAPB(MF,X,B) do{ MF; X[B]=EX(X[B]); X[B+1]=EX(X[B+1]); X[B+2]=EX(X[B+2]); X[B+3]=EX(X[B+3]); PIN(X); SBAR(); }while(0)
  #define VRD(i) do{ vlo[i]=vtr(vp_+(((i)>>2)*4096+((i)&3)*1024)); vhi[i]=vtr(vp_+(((i)>>2)*4096+((i)&3)*1024+512)); }while(0)
  #define KRD(G,j) do{ if(G){ kload2(kf,kp0+sl_next,j); SBAR(); } }while(0)
  #define STEP(C0,C1,P0,P1,t,GK,GV,GL) do{ SBAR(); \
    const lds_cptr vp_=vp0+sl_prev; \
    VRD(0); SBAR(); float sacc=(P0[0]+P0[1]); \
    GAPA(C0=__builtin_amdgcn_mfma_f32_32x32x16_bf16(kf[0],qr[0],negm,0,0,0), P0[2],P0[3],P0[4],P0[5],     pw0[0]=PKW(P0,0), pw0[1]=PKW(P0,2), pw0); \
    VRD(4); SBAR(); GAPA(C1=__builtin_amdgcn_mfma_f32_32x32x16_bf16(kf[1],qr[0],negm,0,0,0), P0[6],P0[7],P0[8],P0[9],     pw0[2]=PKW(P0,4), pw0[3]=PKW(P0,6), pw0); \
    VRD(1); SBAR(); GAPA(C0=__builtin_amdgcn_mfma_f32_32x32x16_bf16(kf[2],qr[1],C0,0,0,0),   P0[10],P0[11],P0[12],P0[13], pw1[0]=PKW(P0,8), pw1[1]=PKW(P0,10), pw1); \
    VRD(5); SBAR(); GAPA(C1=__builtin_amdgcn_mfma_f32_32x32x16_bf16(kf[3],qr[1],C1,0,0,0),   P0[14],P0[15],P1[0],P1[1],   pw1[2]=PKW(P0,12),pw1[3]=PKW(P0,14), pw1); \
    VRD(2); SBAR(); GAPA(C0=__builtin_amdgcn_mfma_f32_32x32x16_bf16(kf[4],qr[2],C0,0,0,0),   P1[2],P1[3],P1[4],P1[5],     pw2[0]=PKW(P1,0), pw2[1]=PKW(P1,2), pw2); \
    VRD(6); SBAR(); GAPA(C1=__builtin_amdgcn_mfma_f32_32x32x16_bf16(kf[5],qr[2],C1,0,0,0),   P1[6],P1[7],P1[8],P1[9],     pw2[2]=PKW(P1,4), pw2[3]=PKW(P1,6), pw2); \
    VRD(3); SBAR(); GAPA(C0=__builtin_amdgcn_mfma_f32_32x32x16_bf16(kf[6],qr[3],C0,0,0,0),   P1[10],P1[11],P1[12],P1[13], pw3[0]=PKW(P1,8), pw3[1]=PKW(P1,10), pw3); \
    VRD(7); SBAR(); GAPA(C1=__builtin_amdgcn_mfma_f32_32x32x16_bf16(kf[7],qr[3],C1,0,0,0),   P1[14],P1[15],0.f,0.f,       pw3[2]=PKW(P1,12),pw3[3]=PKW(P1,14), pw3); \
    l_reg+=sacc; \
    if(GK){DMA_K((t)+3,sl_cur);} if(GV){DMA_V((t)+1,sl_next);} \
    CMASK(C0,C1,t); \
    { float a=MX3(C0[0],C0[1],C1[0]),b=MX3(C0[2],C0[3],C1[1]); a=MX3(a,C1[2],C1[3]); \
      _Pragma("unroll") for(int r=4;r<16;r+=4){a=MX3(a,C0[r],C0[r+1]);b=MX3(b,C0[r+2],C0[r+3]);a=MX3(a,C1[r],C1[r+1]);b=MX3(b,C1[r+2],C1[r+3]);} \
      float rm=__builtin_fmaxf(a,b); { auto rr=__builtin_amdgcn_permlane32_swap(__float_as_uint(rm),__float_as_uint(rm),false,false); rm=__builtin_fmaxf(__uint_as_float(rr[0]),__uint_as_float(rr[1])); } \
      resc=false; \
      if(__builtin_expect(__any(rm>(float)THRL),0)){ const float dl=__builtin_fmaxf(rm,0.f); mhat+=dl; \
        _Pragma("unroll") for(int r=0;r<16;++r){C0[r]-=dl;C1[r]-=dl;} \
        _Pragma("unroll") for(int r=0;r<16;++r)negm[r]=-mhat; asm volatile("":"+v"(negm)); \
        const float f=__builtin_amdgcn_exp2f(-dl); l_reg*=f; if(hi==0)wsf[r32]=f; resc=true; } } \
    SBAR(); \
    GAPB(o[0]=__builtin_amdgcn_mfma_f32_32x32x16_bf16(PAF(0),VFR(0),o[0],0,0,0), C0,0); \
    GAPB(o[1]=__builtin_amdgcn_mfma_f32_32x32x16_bf16(PAF(0),VFR(4),o[1],0,0,0), C0,4); \
    KRD(GL,0); GAPB(o[0]=__builtin_amdgcn_mfma_f32_32x32x16_bf16(PAF(1),VFR(1),o[0],0,0,0), C0,8); \
    KRD(GL,1); GAPB(o[1]=__builtin_amdgcn_mfma_f32_32x32x16_bf16(PAF(1),VFR(5),o[1],0,0,0), C0,12); \
    KRD(GL,2); GAPB(o[0]=__builtin_amdgcn_mfma_f32_32x32x16_bf16(PAF(2),VFR(2),o[0],0,0,0), C1,0); \
    KRD(GL,3); GAPB(o[1]=__builtin_amdgcn_mfma_f32_32x32x16_bf16(PAF(2),VFR(6),o[1],0,0,0), C1,4); \
    GAPB(o[0]=__builtin_amdgcn_mfma_f32_32x32x16_bf16(PAF(3),VFR(3),o[0],0,0,0), C1,8); \
    GAPB(o[1]=__builtin_amdgcn_mfma_f32_32x32x16_bf16(PAF(3),VFR(7),o[1],0,0,0), C1,12); \
    }while(0)
  int t=1;
  #undef CMASK
  #define CMASK(P0,P1,t) do{}while(0)
  for(;t+7<NT;t+=2){
    STEP(pB0,pB1,pA0,pA1,t,true,true,true);     WAIT_BAR(2); RESC(); ROT();
    STEP(pA0,pA1,pB0,pB1,t+1,true,true,true);   WAIT_BAR(2); RESC(); ROT();
  }
  #undef CMASK
  #define CMASK(P0,P1,t) do{int jb_=(t)-(NT-4); if(jb_>=-2){cbias(P0,P1,jb_,qrel,hi,tab); if(jb_>=0)cmask(P0,P1,jb_,qrel,hi);}}while(0)
  #define ENDW(tt) do{ if((tt)+3<NT){WAIT_BAR(2);} else if((tt)+2<NT){WAIT_BAR(1);} else {WAIT_BAR(0);} }while(0)
  for(;t+1<NT;t+=2){
    STEP(pB0,pB1,pA0,pA1,t,(t+3<NT),(t+1<NT),(t+1<NT));       ENDW(t);   RESC(); ROT();
    STEP(pA0,pA1,pB0,pB1,t+1,(t+4<NT),(t+2<NT),(t+2<NT));     ENDW(t+1); RESC(); ROT();
  }
  STEP(pB0,pB1,pA0,pA1,NT-1,false,false,false); RESC();
  { float sacc=pB0[0]+pB0[1]; _Pragma("unroll") for(int r=2;r<16;++r)sacc+=pB0[r]; _Pragma("unroll") for(int r=0;r<16;++r)sacc+=pB1[r]; l_reg+=sacc;
    pw0=(u32x4){PKW(pB0,0),PKW(pB0,2),PKW(pB0,4),PKW(pB0,6)};pw1=(u32x4){PKW(pB0,8),PKW(pB0,10),PKW(pB0,12),PKW(pB0,14)};pw2=(u32x4){PKW(pB1,0),PKW(pB1,2),PKW(pB1,4),PKW(pB1,6)};pw3=(u32x4){PKW(pB1,8),PKW(pB1,10),PKW(pB1,12),PKW(pB1,14)};
    SBAR(); pv(o,vb0+sl_cur,PAF(0),PAF(1),PAF(2),PAF(3)); }
  #undef PKW
  #undef PAF
  #undef VFR
  #undef PIN
  #undef MX3
  #undef GAPA
  #undef GAPB
  #undef EX
  #undef VRD
  #undef KRD
  #undef STEP
  #undef ENDW
  {auto rr=__builtin_amdgcn_permlane32_swap(__float_as_uint(l_reg),__float_as_uint(l_reg),false,false);l_reg=__uint_as_float(rr[0])+__uint_as_float(rr[1]);}
  if(hi==0)wsf[32+r32]=l_reg;asm volatile("s_waitcnt lgkmcnt(0)":::"memory");
  float rli[16];
  #pragma unroll
  for(int r=0;r<16;++r)rli[r]=__builtin_amdgcn_rcpf(wsf[32+crow(r,hi)]);
  bf16*Ow=O+(rowbase+q0+wid*QBLK)*DM+hv*D;
  { bf16*stg=(bf16*)(shm+LDS_OST)+wid*2048;
    #pragma unroll
    for(int r=0;r<16;++r){const int orow=crow(r,hi);
      #pragma unroll
      for(int d0=0;d0<2;++d0)stg[orow*64+d0*32+r32]=__float2bfloat16(o[d0][r]*rli[r]);}
    asm volatile("s_waitcnt lgkmcnt(0)":::"memory");
    #pragma unroll
    for(int i=0;i<4;++i){const int row=i*8+(lane>>3),ch=lane&7; const u32x4 v=*(const u32x4*)(stg+row*64+ch*8); ATTN_STORE16(Ow+(long)row*DM+ch*8,v);} }
  asm volatile("s_waitcnt lgkmcnt(0)\n\ts_barrier":::"memory");
  #undef DMA_K
  #undef DMA_V
  #undef CMASK
  #undef START
  #undef RESC
  #undef ROT
}
constexpr int ATTN_LDS_BYTES=LDS_BYTES;
struct AttnTensors { const bf16* Q; const bf16* K; const bf16* V; bf16* O1; bf16* O2; const float* biastab; };
struct AttnUnit { int b, hqk, hv, c, qb; };
struct StaticOrder {
  int vcu;
  __device__ __forceinline__ explicit StaticOrder(int grid,int block):vcu((grid%8==0)?(block%8)*(grid/8)+block/8:block){}
  __device__ __forceinline__ bool next(int i,AttnUnit&u)const{ if(i>=16)return false; const int v=vcu&255; u.b=v>>5; const int h=(v>>2)&7,c=(v>>1)&1,hf=v&1; u.hqk=2*h+c; u.hv=2*h+hf; u.c=c; u.qb=(i&1)?15-(i>>1):(i>>1); return true; }
};
template<class Sched,int THRL=8> __device__ __forceinline__ void attn_phase(char*lds,const AttnTensors&T,const Sched&S){
  AttnUnit u; int cur_h=-1;
  for(int i=0;S.next(i,u);++i){
    if((u.hqk>>1)!=cur_h){ cur_h=u.hqk>>1;
      if(threadIdx.x<128)((float*)(lds+LDS_TAB))[threadIdx.x]=T.biastab[cur_h*128+threadIdx.x];
      asm volatile("s_waitcnt vmcnt(0) lgkmcnt(0)\n\ts_barrier":::"memory"); }
    attn_unit<THRL>(u.b,u.hqk,u.hv,u.qb,T.Q,T.K,T.V,u.c?T.O2:T.O1,lds); }
}
#undef SBAR
#undef WAIT_BAR
}
#ifndef PG8_SP2
#define PG8_SP2 true
#endif
#ifndef PG8_ALIGN
#define PG8_ALIGN true
#endif
constexpr int NWAVES = 8;
#ifndef MK_N_LAUNCHES
#define MK_N_LAUNCHES 1
#endif
constexpr int N_PHASES = 8;
constexpr int BATCH = 8, SEQ = 4096, D = 2048, M = BATCH * SEQ;
constexpr int NPROJ = 5120, DATT = 1024, DCONV = 1024, CONVW = 31;
constexpr int PH = 8, PNK = 128, PHALF = 128, PTOPK = 16, NEXP = 16384;
constexpr float LN_EPS = 1e-5f;
constexpr float DN_ALPHA = 1.189207115002721f;
constexpr float LAMBDA_INIT = 0.2f;
constexpr size_t MiB = 1u << 20;
constexpr size_t WS_WIN = 2 * MiB, WS_WOUT = 22 * MiB, WS_WQ = 30 * MiB, WS_KEYS = 38 * MiB, WS_TAB = 39 * MiB;
constexpr size_t WS_U8 = 40 * MiB, WS_V8 = 72 * MiB, WS_SU = 104 * MiB, WS_SV = 105 * MiB;
constexpr size_t WS_XB = 168 * MiB;
constexpr size_t WS_Q = 296 * MiB, WS_K = 360 * MiB, WS_V = 424 * MiB, WS_H = 488 * MiB;
constexpr size_t WS_O1 = 552 * MiB, WS_O2 = 616 * MiB;
constexpr size_t WS_Y1 = 680 * MiB;
constexpr size_t WS_QP = 808 * MiB;
constexpr size_t WS_EID = 936 * MiB, WS_GATE = 952 * MiB;
constexpr size_t WS_END = 968 * MiB;
constexpr int RING_BYTES = 131072, LDS_BYTES = 147456;

#define GAS __attribute__((address_space(1)))
#define LAS __attribute__((address_space(3)))
typedef unsigned short bf16;
typedef unsigned v4u __attribute__((ext_vector_type(4)));
typedef unsigned v2u __attribute__((ext_vector_type(2)));
typedef float f32x4 __attribute__((ext_vector_type(4)));
typedef float f32x16 __attribute__((ext_vector_type(16)));
typedef short bf16x8 __attribute__((ext_vector_type(8)));
typedef __bf16 bf16x2_t __attribute__((ext_vector_type(2)));
#define LDS_WAIT() asm volatile("s_waitcnt lgkmcnt(0)" ::: "memory")
__device__ __forceinline__ unsigned f2bf(float f) { unsigned u = __builtin_bit_cast(unsigned, f); return (u + 0x7fffu + ((u >> 16) & 1u)) >> 16; }
__device__ __forceinline__ unsigned pk2(float lo, float hi) { return f2bf(lo) | (f2bf(hi) << 16); }
__device__ __forceinline__ float bflo(unsigned w) { return __uint_as_float(w << 16); }
__device__ __forceinline__ float bfhi(unsigned w) { return __uint_as_float(w & 0xffff0000u); }
__device__ __forceinline__ float wave_sum(float v) {
#pragma unroll
    for (int o = 1; o < 64; o <<= 1) v += __shfl_xor(v, o);
    return v;
}
__device__ __forceinline__ float dot2bf(unsigned a, unsigned b, float acc) { return __builtin_amdgcn_fdot2_f32_bf16(__builtin_bit_cast(bf16x2_t, a), __builtin_bit_cast(bf16x2_t, b), acc, false); }

#define XB_TMO      128
#define XB_XCNT(j)  (256  + 64 * (j))
#define XB_XSUB(j)  (1280 + 64 * (j))
#define XB_XGEN(j)  (2304 + 64 * (j))
#define XB_TOP      3328
#define XB_TOPGEN   3392
#define XCD_BAR_WORDS 3456
#define XB_SPIN_CAP (1u << 18)

__device__ __forceinline__ unsigned xb_ld(unsigned* p)              { return __hip_atomic_load(p, __ATOMIC_RELAXED, __HIP_MEMORY_SCOPE_AGENT); }
__device__ __forceinline__ unsigned xb_add(unsigned* p, unsigned v) { return __hip_atomic_fetch_add(p, v, __ATOMIC_RELAXED, __HIP_MEMORY_SCOPE_AGENT); }
__device__ __forceinline__ unsigned xb_xcc_id() { return (unsigned)__builtin_amdgcn_s_getreg((3 << 11) | 20) & 0xFu; }
#define XB_SPIN(cond, bar) do { unsigned _sp = 0; while (cond) { __builtin_amdgcn_s_sleep(1); \
    if ((++_sp & 255u) == 0u) { if (xb_ld(&(bar)[XB_TMO])) break; if (_sp > XB_SPIN_CAP) { atomicAdd(&(bar)[XB_TMO], 1u); break; } } } } while (0)

struct XcdBarrier {
    unsigned* bar; unsigned x;
    volatile LAS unsigned* st;
};

__device__ __forceinline__ XcdBarrier xcd_barrier_post(unsigned* bar, volatile LAS unsigned* st) {
    XcdBarrier b; b.bar = bar; b.x = xb_xcc_id(); b.st = st;
    if (threadIdx.x == 0) (void)xb_add(&bar[XB_XCNT(b.x)], 1u);
    return b;
}
__device__ __forceinline__ void xcd_barrier_complete(unsigned* bar, unsigned x, unsigned& nloc, unsigned& nx) {
    const unsigned G = gridDim.x * gridDim.y * gridDim.z;
    unsigned sum, cnt, mine, sp = 0u;
    for (;;) {
        sum = 0u; cnt = 0u; mine = 0u;
#pragma unroll
        for (unsigned j = 0; j < 16; ++j) { const unsigned c = xb_ld(&bar[XB_XCNT(j)]); sum += c; cnt += (c > 0u) ? 1u : 0u; mine = (j == x) ? c : mine; }
        if (sum == G) break;
        __builtin_amdgcn_s_sleep(1);
        if ((++sp & 255u) == 0u) { if (xb_ld(&bar[XB_TMO])) break; if (sp > XB_SPIN_CAP) { atomicAdd(&bar[XB_TMO], 1u); break; } }
    }
    nloc = mine > 0u ? mine : 1u; nx = cnt > 0u ? cnt : 1u;
}

__device__ __forceinline__ void xcd_barrier(const XcdBarrier& b) {
    asm volatile("s_waitcnt vmcnt(0)" ::: "memory");
    __syncthreads();
    if (threadIdx.x == 0) {
        unsigned* bar = b.bar;
        __builtin_amdgcn_s_waitcnt(0);
        unsigned nloc = b.st[0], nx = b.st[1];
        if (nloc == 0u) { xcd_barrier_complete(bar, b.x, nloc, nx); b.st[0] = nloc; b.st[1] = nx; }
        const unsigned old = xb_add(&bar[XB_XSUB(b.x)], 1u);
        const unsigned gen = old / nloc;
        if (old + 1u == (gen + 1u) * nloc) {
            __builtin_amdgcn_fence(__ATOMIC_RELEASE, "agent");
            asm volatile("s_waitcnt vmcnt(0)" ::: "memory");
            const unsigned og = xb_add(&bar[XB_TOP], 1u);
            const unsigned tg = og / nx;
            if (og + 1u == (tg + 1u) * nx) xb_add(&bar[XB_TOPGEN], 1u);
            else XB_SPIN(xb_ld(&bar[XB_TOPGEN]) == tg, bar);
            __builtin_amdgcn_fence(__ATOMIC_ACQUIRE, "agent");
            xb_add(&bar[XB_XGEN(b.x)], 1u);
            asm volatile("s_waitcnt vmcnt(0)" ::: "memory");
        } else {
            XB_SPIN(xb_ld(&bar[XB_XGEN(b.x)]) == gen, bar);
            __builtin_amdgcn_fence(__ATOMIC_ACQUIRE, "agent");
            asm volatile("s_waitcnt vmcnt(0)" ::: "memory");
        }
    }
    __syncthreads();
}

struct Frame {
    LAS unsigned char* lds;
    __device__ __forceinline__ int wave_() const { int w = __builtin_amdgcn_readfirstlane((int)threadIdx.x >> 6); asm volatile("" : "+s"(w)); return w; }
    __device__ __forceinline__ int G_() const { int g = (int)gridDim.x; asm volatile("" : "+s"(g)); return g; }
    __device__ __forceinline__ int vcu_() const { int bx = (int)blockIdx.x; asm volatile("" : "+s"(bx)); const int g = G_(); return (g % 8 == 0) ? (bx % 8) * (g / 8) + bx / 8 : bx; }
    __device__ __forceinline__ int tid() const { int t = (int)threadIdx.x; asm volatile("" : "+v"(t)); return t; }
    __device__ __forceinline__ int lane() const { return tid() & 63; }
    __device__ __forceinline__ unsigned long long raw(int k) const { const volatile LAS unsigned* p = (const volatile LAS unsigned*)(lds + RING_BYTES) + 2 * k;
        const unsigned lo = __builtin_amdgcn_readfirstlane(p[0]), hi = __builtin_amdgcn_readfirstlane(p[1]); return ((unsigned long long)hi << 32) | lo; }
    __device__ __forceinline__ const float* in(int k) const { return (const float*)raw(k); }
    __device__ __forceinline__ float* outp() const { return (float*)raw(22); }
    template <class T> __device__ __forceinline__ T* ws(size_t off) const { return (T*)((unsigned char*)raw(23) + off); }
};
enum { I_X = 0, I_WIN, I_BGLU, I_CONVW, I_CONVB, I_CLNG, I_CLNB, I_LQ1, I_LK1, I_LQ2, I_LK2, I_SUBLN, I_RELB, I_WOUT, I_LN1G, I_LN1B, I_WQ, I_KEYS, I_U, I_V, I_LN2G, I_LN2B };

__device__ __forceinline__ void p0_transpose_item(const float* W, int K, int N, bf16* WT, int k0, int n0, int dst0, LAS float* scr, int lane) {
#pragma unroll 8
    for (int i = 0; i < 32; ++i) { const int kk = 2 * i + (lane >> 5); scr[kk * 33 + (lane & 31)] = W[(size_t)(k0 + kk) * N + n0 + (lane & 31)]; }
    LDS_WAIT(); asm volatile("" ::: "memory");
    const int c = lane & 7;
#pragma unroll
    for (int j = 0; j < 4; ++j) { const int n = (lane >> 3) + 8 * j; const LAS float* s = scr + (8 * c) * 33 + n;
        v4u o; o.x = pk2(s[0 * 33], s[1 * 33]); o.y = pk2(s[2 * 33], s[3 * 33]); o.z = pk2(s[4 * 33], s[5 * 33]); o.w = pk2(s[6 * 33], s[7 * 33]);
        *(GAS v4u*)(WT + (size_t)(dst0 + n) * K + k0 + 8 * c) = o; }
    LDS_WAIT(); asm volatile("" ::: "memory");
}
__device__ __forceinline__ void p0_convert(const float* src, bf16* dst, size_t n, int gw, int NGW, int lane) {
    const size_t nit = n / 512;
    for (size_t it = gw; it < nit; it += NGW) { const GAS f32x4* s = (const GAS f32x4*)(src + it * 512) + 2 * lane; const f32x4 a = s[0], b = s[1];
        v4u o; o.x = pk2(a.x, a.y); o.y = pk2(a.z, a.w); o.z = pk2(b.x, b.y); o.w = pk2(b.z, b.w); *((GAS v4u*)(dst + it * 512) + lane) = o; }
}
__device__ __forceinline__ void p0_quant_rows(const float* src, unsigned* dst8, float* scale, int rows, int gw, int NGW, int lane) {
    for (int r = gw; r < rows; r += NGW) {
        const GAS f32x4* sp = (const GAS f32x4*)(src + (size_t)r * D) + lane; f32x4 v[8]; float am = 0.f;
#pragma unroll
        for (int j = 0; j < 8; ++j) { v[j] = sp[64 * j]; am = fmaxf(fmaxf(am, fmaxf(fabsf(v[j].x), fabsf(v[j].y))), fmaxf(fabsf(v[j].z), fabsf(v[j].w))); }
#pragma unroll
        for (int o = 1; o < 64; o <<= 1) am = fmaxf(am, __shfl_xor(am, o));
        const float sc = am > 0.f ? am * (1.f / 440.f) : 1.f, inv = 1.f / sc;
        GAS unsigned* dp = (GAS unsigned*)(dst8 + (size_t)r * (D / 4)) + lane;
#pragma unroll
        for (int j = 0; j < 8; ++j) { int w = __builtin_amdgcn_cvt_pk_fp8_f32(v[j].x * inv, v[j].y * inv, 0, false); w = __builtin_amdgcn_cvt_pk_fp8_f32(v[j].z * inv, v[j].w * inv, w, true); dp[64 * j] = (unsigned)w; }
        if (lane == 0) scale[r] = sc;
    }
}
__device__ __forceinline__ int t5_bucket(int d) {
    if (d < 16) return d;
    int l = 16 + (int)(logf((float)d / 16.f) / logf(8.f) * 16.f); return l < 31 ? l : 31;
}
__device__ __forceinline__ void p0_prologue(Frame& F) {
    const float* w_in = F.in(I_WIN); const float* w_out = F.in(I_WOUT); const float* peer_wq = F.in(I_WQ);
    bf16* Win_t = F.ws<bf16>(WS_WIN); bf16* Wout_t = F.ws<bf16>(WS_WOUT); bf16* Wq_t = F.ws<bf16>(WS_WQ);
    LAS float* scr = (LAS float*)(F.lds + F.wave_() * 16384);
    const int gw = F.vcu_() * NWAVES + F.wave_(), NGW = F.G_() * NWAVES;
    constexpr int I_IN = (D / 64) * (NPROJ / 32), I_OUT = (D / 64) * (D / 32), I_Q = I_OUT, NITEMS = I_IN + I_OUT + I_Q;
    for (int it = gw; it < NITEMS; it += NGW) {
        int r = it;
        if (r < I_IN) { const int nblk = NPROJ / 32, kb = r / nblk, nb = r % nblk, n0 = 32 * nb; int dst0 = n0;
            if (n0 >= 3072) { const int ch = (n0 - 3072) & 1023, gate = (n0 - 3072) >> 10; dst0 = 3072 + 256 * (ch >> 7) + 128 * gate + (ch & 127); }
            p0_transpose_item(w_in, D, NPROJ, Win_t, 64 * kb, n0, dst0, scr, F.lane()); continue; }
        r -= I_IN;
        if (r < I_OUT) { const int nblk = D / 32, kb = r / nblk, nb = r % nblk; p0_transpose_item(w_out, D, D, Wout_t, 64 * kb, 32 * nb, 32 * nb, scr, F.lane()); continue; }
        r -= I_OUT;
        { const int nblk = D / 32, kb = r / nblk, nb = r % nblk; p0_transpose_item(peer_wq, D, D, Wq_t, 64 * kb, 32 * nb, 32 * nb, scr, F.lane()); }
    }
    p0_convert(F.in(I_X), F.ws<bf16>(WS_XB), (size_t)M * D, gw, NGW, F.lane());
    p0_quant_rows(F.in(I_U), F.ws<unsigned>(WS_U8), F.ws<float>(WS_SU), NEXP, gw, NGW, F.lane());
    p0_quant_rows(F.in(I_V), F.ws<unsigned>(WS_V8), F.ws<float>(WS_SV), NEXP, gw, NGW, F.lane());
    p0_convert(F.in(I_KEYS), F.ws<bf16>(WS_KEYS), (size_t)PH * 2 * PNK * PHALF, gw, NGW, F.lane());
    if (blockIdx.x == 0) { const float* rel_bias = F.in(I_RELB); float* TAB = F.ws<float>(WS_TAB);
        for (int i = F.tid(); i < 8 * 128; i += NWAVES * 64) { const int h = i >> 7, d = i & 127;
            TAB[i] = (rel_bias[t5_bucket(d) * 8 + h] - rel_bias[31 * 8 + h]) * 1.4426950408889634f; } }
}

__device__ __forceinline__ float diff_lambda(Frame& F) {
    const float a = wave_sum(F.in(I_LQ1)[F.lane()] * F.in(I_LK1)[F.lane()]), b = wave_sum(F.in(I_LQ2)[F.lane()] * F.in(I_LK2)[F.lane()]);
    return expf(a) - expf(b) + LAMBDA_INIT;
}
__device__ __forceinline__ void p3_combine(Frame& F) {
    const float lam = diff_lambda(F);
    const float* subln_g = F.in(I_SUBLN); const bf16* O1 = F.ws<bf16>(WS_O1); const bf16* O2 = F.ws<bf16>(WS_O2); bf16* MIX = F.ws<bf16>(WS_XB);
    const int gw = F.vcu_() * NWAVES + F.wave_(), NGW = F.G_() * NWAVES;
    float g[16];
#pragma unroll
    for (int e = 0; e < 16; ++e) g[e] = subln_g[16 * (F.lane() & 7) + e] * (1.f - LAMBDA_INIT);
    for (int m = gw; m < M; m += NGW) {
        const GAS v4u* p1 = (const GAS v4u*)(O1 + (size_t)m * 1024) + 2 * F.lane(); const GAS v4u* p2 = (const GAS v4u*)(O2 + (size_t)m * 1024) + 2 * F.lane();
        const v4u a0 = p1[0], a1 = p1[1], b0 = p2[0], b1 = p2[1];
        const unsigned aw[8] = {a0.x, a0.y, a0.z, a0.w, a1.x, a1.y, a1.z, a1.w}, bw[8] = {b0.x, b0.y, b0.z, b0.w, b1.x, b1.y, b1.z, b1.w};
        float v[16]; float ss = 0.f;
#pragma unroll
        for (int i = 0; i < 8; ++i) { v[2 * i] = bflo(aw[i]) - lam * bflo(bw[i]); v[2 * i + 1] = bfhi(aw[i]) - lam * bfhi(bw[i]); ss += v[2 * i] * v[2 * i] + v[2 * i + 1] * v[2 * i + 1]; }
        ss += __shfl_xor(ss, 1); ss += __shfl_xor(ss, 2); ss += __shfl_xor(ss, 4);
        const float r = 1.f / sqrtf(ss * (1.f / 128.f) + LN_EPS);
        v4u o0, o1;
        o0.x = pk2(v[0] * r * g[0], v[1] * r * g[1]); o0.y = pk2(v[2] * r * g[2], v[3] * r * g[3]); o0.z = pk2(v[4] * r * g[4], v[5] * r * g[5]); o0.w = pk2(v[6] * r * g[6], v[7] * r * g[7]);
        o1.x = pk2(v[8] * r * g[8], v[9] * r * g[9]); o1.y = pk2(v[10] * r * g[10], v[11] * r * g[11]); o1.z = pk2(v[12] * r * g[12], v[13] * r * g[13]); o1.w = pk2(v[14] * r * g[14], v[15] * r * g[15]);
        GAS v4u* po = (GAS v4u*)(MIX + (size_t)m * D) + 2 * F.lane(); po[0] = o0; po[1] = o1;
    }
}
__device__ __forceinline__ void p3_conv(Frame& F) {
    constexpr int TT = 32, NR = TT + CONVW - 1, STATS_OFF = NR * 2048;
    const int tid = F.tid();
    const float* conv_w = F.in(I_CONVW); const bf16* H = F.ws<bf16>(WS_H); bf16* MIX = F.ws<bf16>(WS_XB);
    float w0[CONVW], w1[CONVW];
#pragma unroll
    for (int j = 0; j < CONVW; ++j) { const float2 w = *(const float2*)(conv_w + j * DCONV + 2 * tid); w0[j] = w.x; w1[j] = w.y; }
    const float2 cb = *(const float2*)(F.in(I_CONVB) + 2 * tid), lg = *(const float2*)(F.in(I_CLNG) + 2 * tid), lb = *(const float2*)(F.in(I_CLNB) + 2 * tid);
    LAS unsigned* tile = (LAS unsigned*)F.lds; LAS float* stats = (LAS float*)(F.lds + STATS_OFF);
    for (int tile_i = F.vcu_(); tile_i < M / TT; tile_i += F.G_()) {
        const int t0 = tile_i * TT, s0 = t0 & (SEQ - 1);
        for (int r = tid >> 7; r < NR; r += 4) { const int sp = s0 - (CONVW - 1) + r; v4u val = (v4u){0u, 0u, 0u, 0u};
            if (sp >= 0) val = *((const GAS v4u*)(H + (size_t)(t0 - (CONVW - 1) + r) * 1024) + (tid & 127));
            *(LAS v4u*)(F.lds + r * 2048 + (tid & 127) * 16) = val; }
        __syncthreads();
        for (int i = 0; i < TT; ++i) {
            float a0 = cb.x, a1 = cb.y;
#pragma unroll
            for (int j = 0; j < CONVW; ++j) { const unsigned wv = tile[(i + j) * 512 + tid]; a0 += w0[j] * bflo(wv); a1 += w1[j] * bfhi(wv); }
            const unsigned pk = pk2(a0, a1); tile[i * 512 + tid] = pk;
            const float r0 = bflo(pk), r1 = bfhi(pk);
            const float s = wave_sum(r0 + r1), q = wave_sum(r0 * r0 + r1 * r1);
            if (F.lane() == 0) { stats[(i * 8 + F.wave_()) * 2] = s; stats[(i * 8 + F.wave_()) * 2 + 1] = q; }
        }
        __syncthreads();
        for (int i = 0; i < TT; ++i) {
            float s = 0.f, q = 0.f;
#pragma unroll
            for (int w = 0; w < 8; ++w) { s += stats[(i * 8 + w) * 2]; q += stats[(i * 8 + w) * 2 + 1]; }
            const float mean = s * (1.f / DCONV), var = fmaxf(q * (1.f / DCONV) - mean * mean, 0.f), rstd = 1.f / sqrtf(var + LN_EPS);
            const unsigned pk = tile[i * 512 + tid];
            const float y0 = (bflo(pk) - mean) * rstd * lg.x + lb.x, y1 = (bfhi(pk) - mean) * rstd * lg.y + lb.y;
            const float z0 = y0 * __builtin_amdgcn_rcpf(1.f + __builtin_amdgcn_exp2f(-1.4426950409f * y0)), z1 = y1 * __builtin_amdgcn_rcpf(1.f + __builtin_amdgcn_exp2f(-1.4426950409f * y1));
            *((GAS unsigned*)(MIX + (size_t)(t0 + i) * D + DATT) + tid) = pk2(z0, z1);
        }
        __syncthreads();
    }
}
__device__ __forceinline__ void p5_ln1(Frame& F) {
    bf16* Y1 = F.ws<bf16>(WS_Y1); const float* ln1_g = F.in(I_LN1G); const float* ln1_b = F.in(I_LN1B);
    const int gw = F.vcu_() * NWAVES + F.wave_(), NGW = F.G_() * NWAVES;
    for (int m = gw; m < M; m += NGW) {
        GAS v4u* p = (GAS v4u*)(Y1 + (size_t)m * D) + F.lane();
        v4u w[4]; float v[32]; float s = 0.f;
#pragma unroll
        for (int j = 0; j < 4; ++j) { w[j] = p[64 * j]; const unsigned ww[4] = {w[j].x, w[j].y, w[j].z, w[j].w};
#pragma unroll
            for (int i = 0; i < 4; ++i) { v[8 * j + 2 * i] = bflo(ww[i]); v[8 * j + 2 * i + 1] = bfhi(ww[i]); s += v[8 * j + 2 * i] + v[8 * j + 2 * i + 1]; } }
        const float mean = wave_sum(s) * (1.f / D); float q = 0.f;
#pragma unroll
        for (int i = 0; i < 32; ++i) { v[i] -= mean; q += v[i] * v[i]; }
        const float rstd = 1.f / sqrtf(wave_sum(q) * (1.f / D) + LN_EPS);
#pragma unroll
        for (int j = 0; j < 4; ++j) { const int c0 = 8 * F.lane() + 512 * j; const f32x4 g0 = *(const f32x4*)(ln1_g + c0), g1 = *(const f32x4*)(ln1_g + c0 + 4), b0 = *(const f32x4*)(ln1_b + c0), b1 = *(const f32x4*)(ln1_b + c0 + 4);
            v4u o; o.x = pk2(v[8 * j] * rstd * g0[0] + b0[0], v[8 * j + 1] * rstd * g0[1] + b0[1]); o.y = pk2(v[8 * j + 2] * rstd * g0[2] + b0[2], v[8 * j + 3] * rstd * g0[3] + b0[3]);
            o.z = pk2(v[8 * j + 4] * rstd * g1[0] + b1[0], v[8 * j + 5] * rstd * g1[1] + b1[1]); o.w = pk2(v[8 * j + 6] * rstd * g1[2] + b1[2], v[8 * j + 7] * rstd * g1[3] + b1[3]);
            p[64 * j] = o; }
    }
}
__device__ __forceinline__ int f2key(float f) { const int b = __float_as_int(f); return b ^ ((b >> 31) & 0x7fffffff); }
__device__ __forceinline__ float key2f(int k) { return __int_as_float(k ^ ((k >> 31) & 0x7fffffff)); }
#define CE_DESC(a, b) do { const int _x = max(a, b), _y = min(a, b); a = _x; b = _y; } while (0)
#define CE_ASC(a, b)  do { const int _x = min(a, b), _y = max(a, b); a = _x; b = _y; } while (0)
template <int N> __device__ __forceinline__ void sort_desc(int (&v)[N]) {
#pragma unroll
    for (int k = 2; k <= N; k <<= 1)
#pragma unroll
        for (int j = k >> 1; j > 0; j >>= 1)
#pragma unroll
            for (int i = 0; i < N; ++i) { const int l = i ^ j; if (l > i) { if ((i & k) == 0) CE_DESC(v[i], v[l]); else CE_ASC(v[i], v[l]); } }
}
template <int N> __device__ __forceinline__ void bitonic_merge_desc(int (&v)[N]) {
#pragma unroll
    for (int j = N >> 1; j > 0; j >>= 1)
#pragma unroll
        for (int i = 0; i < N; ++i) { const int l = i ^ j; if (l > i) CE_DESC(v[i], v[l]); }
}
__device__ __forceinline__ void merge16(const int (&a)[16], const int (&b)[16], int (&o)[16]) {
#pragma unroll
    for (int i = 0; i < 16; ++i) o[i] = max(a[i], b[15 - i]);
    bitonic_merge_desc<16>(o);
}
__device__ __forceinline__ void top16_of_64(const int (&v)[64], int (&o)[16]) {
    int g0[16], g1[16], g2[16], g3[16];
#pragma unroll
    for (int i = 0; i < 16; ++i) { g0[i] = v[i]; g1[i] = v[16 + i]; g2[i] = v[32 + i]; g3[i] = v[48 + i]; }
    sort_desc<16>(g0); sort_desc<16>(g1); sort_desc<16>(g2); sort_desc<16>(g3);
    int m0[16], m1[16]; merge16(g0, g1, m0); merge16(g2, g3, m1); merge16(m0, m1, o);
}
__device__ __forceinline__ void peer_subkey_top16(const bf16* qrow  , const bf16* keys_hc  , int r32, int hi, int (&o)[16]) {
    bf16x8 bq[8];
    asm volatile("" : "+v"(qrow));
#pragma unroll
    for (int s = 0; s < 8; ++s) bq[s] = *(const bf16x8*)(qrow + 8 * s);
    int run[16];
#pragma unroll
    for (int mt = 0; mt < 4; ++mt) {
        const bf16* krow = keys_hc + (size_t)(32 * mt + r32) * PHALF + hi * 64;
        asm volatile("" : "+v"(krow));
        bf16x8 ka[8];
#pragma unroll
        for (int s = 0; s < 8; ++s) ka[s] = *(const bf16x8*)(krow + 8 * s);
        asm volatile("" ::: "memory");
        f32x16 acc = {};
#pragma unroll
        for (int s = 0; s < 8; ++s) acc = __builtin_amdgcn_mfma_f32_32x32x16_bf16(ka[s], bq[s], acc, 0, 0, 0);
        int g[16];
#pragma unroll
        for (int r = 0; r < 16; ++r) g[r] = (f2key(acc[r]) & ~127) | (32 * mt + (r & 3) + 8 * (r >> 2));
        sort_desc<16>(g);
        if (mt == 0) {
#pragma unroll
            for (int r = 0; r < 16; ++r) run[r] = g[r];
        } else { int t2[16]; merge16(run, g, t2);
#pragma unroll
            for (int r = 0; r < 16; ++r) run[r] = t2[r]; }
    }
    int lo[16], hh[16]; const int hi4 = 4 * hi;
#pragma unroll
    for (int i = 0; i < 16; ++i) { run[i] |= hi4; auto rr = __builtin_amdgcn_permlane32_swap((unsigned)run[i], (unsigned)run[i], false, false); lo[i] = (int)rr[0]; hh[i] = (int)rr[1]; }
    merge16(lo, hh, o);
}
__device__ __forceinline__ float gelu_erf(float v) { return 0.5f * v * (1.f + erff(v * 0.70710678118654752f)); }

template <int CTRL> __device__ __forceinline__ float dppf(float v) { return __int_as_float(__builtin_amdgcn_update_dpp(0, __float_as_int(v), CTRL, 0xf, 0xf, true)); }
typedef float f32x2 __attribute__((ext_vector_type(2)));
constexpr int P7_ACT = 0, P7_EID = 65536, P7_SCR = 0  , P7_SCR_WAVE = 32 * 33 * 4, PCH = 128, NCH = D / PCH;
static_assert(P7_SCR + NWAVES * P7_SCR_WAVE <= P7_EID && P7_EID + 128 * 128 * 2 <= RING_BYTES, "PEER LDS map");

__device__ __forceinline__ void p7_peer(Frame& F) {
    const int lane = F.lane(), r32 = lane & 31, hi = lane >> 5, j8 = lane & 7, g8 = lane >> 3;
    constexpr int TPB = 128;
    LAS float* ACT = (LAS float*)(F.lds + P7_ACT); LAS unsigned short* EIDL = (LAS unsigned short*)(F.lds + P7_EID);
    LAS int* scr = (LAS int*)(F.lds + P7_SCR + F.wave_() * P7_SCR_WAVE);
    for (int blk = F.vcu_(); blk < M / TPB; blk += F.G_()) {
        const int m0 = blk * TPB;
        { const int h = F.wave_(); const bf16* QP = F.ws<bf16>(WS_QP); const bf16* KEYS = F.ws<bf16>(WS_KEYS); float* GATE = F.ws<float>(WS_GATE);
          for (int tt = 0; tt < 4; ++tt) {
            const int tl = 32 * tt + r32, tok = m0 + tl;
            const bf16* qrow = QP + (size_t)tok * D + h * 256 + hi * 64;
            int s1[16], s2[16];
            peer_subkey_top16(qrow, KEYS + (size_t)(h * 2 + 0) * PNK * PHALF, r32, hi, s1);
            asm volatile("" ::: "memory");
            peer_subkey_top16(qrow + 128, KEYS + (size_t)(h * 2 + 1) * PNK * PHALF, r32, hi, s2);
            float f1[16], f2[16];
#pragma unroll
            for (int i = 0; i < 16; ++i) { f1[i] = key2f(s1[i]); f2[i] = key2f(s2[i]); }
            if (hi == 0) {
#pragma unroll
                for (int i = 0; i < 16; ++i) { scr[r32 * 33 + i] = s1[i] & 127; scr[r32 * 33 + 16 + i] = s2[i] & 127; } }
            int cand[64];
            {
#define PC(n_, i_, j_) cand[n_] = (f2key(f1[i_] + f2[j_]) & ~255) | ((i_) * 16 + (j_))
                PC(0,0,0); PC(1,0,1); PC(2,0,2); PC(3,0,3); PC(4,0,4); PC(5,0,5); PC(6,0,6); PC(7,0,7); PC(8,0,8); PC(9,0,9); PC(10,0,10); PC(11,0,11); PC(12,0,12); PC(13,0,13); PC(14,0,14); PC(15,0,15);
                PC(16,1,0); PC(17,1,1); PC(18,1,2); PC(19,1,3); PC(20,1,4); PC(21,1,5); PC(22,1,6); PC(23,1,7);
                PC(24,2,0); PC(25,2,1); PC(26,2,2); PC(27,2,3); PC(28,2,4);
                PC(29,3,0); PC(30,3,1); PC(31,3,2); PC(32,3,3);
                PC(33,4,0); PC(34,4,1); PC(35,4,2);
                PC(36,5,0); PC(37,5,1); PC(38,6,0); PC(39,6,1); PC(40,7,0); PC(41,7,1);
                PC(42,8,0); PC(43,9,0); PC(44,10,0); PC(45,11,0); PC(46,12,0); PC(47,13,0); PC(48,14,0); PC(49,15,0);
#undef PC
            }
#pragma unroll
            for (int i = 50; i < 64; ++i) cand[i] = (int)0x80000000;
            int sc[16]; top16_of_64(cand, sc);
            float p[16]; const float mx = key2f(sc[0]); float z = 0.f;
#pragma unroll
            for (int k = 0; k < 16; ++k) { p[k] = __expf(key2f(sc[k]) - mx); z += p[k]; }
            const float rz = 1.f / z;
            LDS_WAIT();
            int eo[8]; float go[8]; const int him = -hi;
#pragma unroll
            for (int kk = 0; kk < 8; ++kk) { const int tag = ((sc[kk] & ~him) | (sc[8 + kk] & him)) & 255;
                const int i1 = scr[r32 * 33 + (tag >> 4)], i2 = scr[r32 * 33 + 16 + (tag & 15)];
                eo[kk] = i1 * PNK + i2; go[kk] = __int_as_float((__float_as_int(p[kk]) & ~him) | (__float_as_int(p[8 + kk]) & him)) * rz; }
            *(LAS v4u*)(EIDL + tl * 128 + h * 16 + 8 * hi) = (v4u){(unsigned)(eo[0] | (eo[1] << 16)), (unsigned)(eo[2] | (eo[3] << 16)), (unsigned)(eo[4] | (eo[5] << 16)), (unsigned)(eo[6] | (eo[7] << 16))};
            GAS float* gp = (GAS float*)(GATE + (size_t)tok * 128 + h * 16 + 8 * hi);
            *(GAS f32x4*)gp = (f32x4){go[0], go[1], go[2], go[3]}; *(GAS f32x4*)(gp + 4) = (f32x4){go[4], go[5], go[6], go[7]};
            LDS_WAIT();
          } }
        __threadfence_block(); __syncthreads();
        const int tw = F.wave_() * (TPB / NWAVES);
        for (int i = lane; i < (TPB / NWAVES) * 128; i += 64) ACT[tw * 128 + i] = 0.f;
        { const bf16* X1 = F.ws<bf16>(WS_Y1); const unsigned char* U8 = F.ws<unsigned char>(WS_U8);
        for (int c = 0; c < NCH; ++c) {
            for (int ti = 0; ti < TPB / NWAVES; ++ti) {
                const int tl = tw + ti, t = m0 + tl;
                const GAS v4u* xp = (const GAS v4u*)(X1 + (size_t)t * D + c * PCH + 16 * j8); const v4u xa = xp[0], xb = xp[1];
                const unsigned xw[8] = {xa.x, xa.y, xa.z, xa.w, xb.x, xb.y, xb.z, xb.w};
                f32x2 xf[8];
#pragma unroll
                for (int i = 0; i < 8; ++i) xf[i] = (f32x2){bflo(xw[i]), bfhi(xw[i])};
                const LAS unsigned short* ep = EIDL + tl * 128 + g8; const unsigned char* ub = U8 + c * PCH + 16 * j8;
                v4u pc[16];
#pragma unroll
                for (int i = 0; i < 16; ++i) { const unsigned e = ep[8 * i]; pc[i] = *(const GAS v4u*)(ub + (size_t)e * D); }
                float pp[16];
#pragma unroll
                for (int i = 0; i < 16; ++i) { const unsigned w4[4] = {pc[i].x, pc[i].y, pc[i].z, pc[i].w}; f32x2 a2 = {0.f, 0.f};
#pragma unroll
                    for (int d = 0; d < 4; ++d) { a2 = __builtin_amdgcn_cvt_pk_f32_fp8((int)w4[d], false) * xf[2 * d] + a2; a2 = __builtin_amdgcn_cvt_pk_f32_fp8((int)w4[d], true) * xf[2 * d + 1] + a2; }
                    pp[i] = a2.x + a2.y; }
                float q8[8], q4[4], q2[2];
                { const bool b2 = lane & 4;
#pragma unroll
                  for (int i = 0; i < 8; ++i) { const float keep = b2 ? pp[2 * i + 1] : pp[2 * i], send = b2 ? pp[2 * i] : pp[2 * i + 1]; q8[i] = keep + dppf<0x141>(send); } }
                { const bool b1 = lane & 2;
#pragma unroll
                  for (int i = 0; i < 4; ++i) { const float keep = b1 ? q8[2 * i + 1] : q8[2 * i], send = b1 ? q8[2 * i] : q8[2 * i + 1]; q4[i] = keep + dppf<0x4E>(send); } }
                { const bool b0 = lane & 1;
#pragma unroll
                  for (int i = 0; i < 2; ++i) { const float keep = b0 ? q4[2 * i + 1] : q4[2 * i], send = b0 ? q4[2 * i] : q4[2 * i + 1]; q2[i] = keep + dppf<0xB1>(send); } }
                const int irow = ((lane & 1) << 2) | (lane & 2) | ((lane >> 2) & 1);
                LAS float* ap = ACT + tl * 128 + 8 * irow + g8;
                ap[0] += q2[0]; ap[64] += q2[1];
            }
        } }
        LDS_WAIT();
        { const float* SU = F.ws<float>(WS_SU); const float* SV = F.ws<float>(WS_SV); const float* GATE = F.ws<float>(WS_GATE);
        for (int ti = 0; ti < TPB / NWAVES; ++ti) {
            const int tl = tw + ti, t = m0 + tl;
#pragma unroll
            for (int kq = 0; kq < 2; ++kq) { const int k = lane + 64 * kq; const unsigned e = EIDL[tl * 128 + k]; const float a = ACT[tl * 128 + k] * SU[e];
                ACT[tl * 128 + k] = __builtin_nontemporal_load(GATE + (size_t)t * 128 + k) * gelu_erf(a) * SV[e]; }
        } }
        LDS_WAIT();
        { const bf16* X1 = F.ws<bf16>(WS_Y1); const unsigned char* V8 = F.ws<unsigned char>(WS_V8); float* outp = F.outp();
        for (int c = 0; c < NCH; ++c) {
            for (int ti = 0; ti < TPB / NWAVES; ++ti) {
                const int tl = tw + ti, t = m0 + tl;
                const LAS unsigned short* ep = EIDL + tl * 128 + g8; const LAS float* wp = ACT + tl * 128 + g8; const unsigned char* vb = V8 + c * PCH + 16 * j8;
                v4u pc[16]; float wk[16];
#pragma unroll
                for (int i = 0; i < 16; ++i) { const unsigned e = ep[8 * i]; wk[i] = wp[8 * i]; pc[i] = *(const GAS v4u*)(vb + (size_t)e * D); }
                const unsigned xpair = *(const GAS unsigned*)(X1 + (size_t)t * D + c * PCH + 16 * j8 + 2 * g8);
                f32x2 acc[8];
#pragma unroll
                for (int d = 0; d < 8; ++d) acc[d] = (f32x2){0.f, 0.f};
#pragma unroll
                for (int i = 0; i < 16; ++i) { const unsigned w4[4] = {pc[i].x, pc[i].y, pc[i].z, pc[i].w}; const f32x2 w2 = {wk[i], wk[i]};
#pragma unroll
                    for (int d = 0; d < 4; ++d) { acc[2 * d] = __builtin_amdgcn_cvt_pk_f32_fp8((int)w4[d], false) * w2 + acc[2 * d]; acc[2 * d + 1] = __builtin_amdgcn_cvt_pk_f32_fp8((int)w4[d], true) * w2 + acc[2 * d + 1]; } }
                float a16[16];
#pragma unroll
                for (int d = 0; d < 8; ++d) { a16[2 * d] = acc[d].x; a16[2 * d + 1] = acc[d].y; }
                float r8[8], r4[4], r2[2];
#pragma unroll
                for (int i = 0; i < 8; ++i) { auto rr = __builtin_amdgcn_permlane32_swap(__float_as_uint(a16[i]), __float_as_uint(a16[i + 8]), false, false); r8[i] = __uint_as_float(rr[0]) + __uint_as_float(rr[1]); }
#pragma unroll
                for (int i = 0; i < 4; ++i) { auto rr = __builtin_amdgcn_permlane16_swap(__float_as_uint(r8[i]), __float_as_uint(r8[i + 4]), false, false); r4[i] = __uint_as_float(rr[0]) + __uint_as_float(rr[1]); }
                { const bool b3 = lane & 8;
#pragma unroll
                  for (int i = 0; i < 2; ++i) { const float keep = b3 ? r4[i + 2] : r4[i], send = b3 ? r4[i] : r4[i + 2]; r2[i] = keep + dppf<0x128>(send); } }
                GAS f32x2* op = (GAS f32x2*)(outp + (size_t)t * D + c * PCH + 16 * j8 + 2 * g8);
                *op = (f32x2){r2[0] + DN_ALPHA * bflo(xpair), r2[1] + DN_ALPHA * bfhi(xpair)};
            }
        } }
        { const float* ln2_g = F.in(I_LN2G); const float* ln2_b = F.in(I_LN2B); float* outp = F.outp();
        for (int ti = 0; ti < TPB / NWAVES; ++ti) {
            const int t = m0 + tw + ti;
            GAS f32x4* rp = (GAS f32x4*)(outp + (size_t)t * D) + 2 * lane;
            f32x4 v[8]; float s = 0.f;
#pragma unroll
            for (int j = 0; j < 4; ++j) { v[2 * j] = rp[128 * j]; v[2 * j + 1] = rp[128 * j + 1]; }
#pragma unroll
            for (int j = 0; j < 8; ++j) s += (v[j].x + v[j].y) + (v[j].z + v[j].w);
            const float mean = wave_sum(s) * (1.f / D); float qv = 0.f;
#pragma unroll
            for (int j = 0; j < 8; ++j) { v[j] = v[j] - mean; qv += (v[j].x * v[j].x + v[j].y * v[j].y) + (v[j].z * v[j].z + v[j].w * v[j].w); }
            const float rstd = 1.f / sqrtf(wave_sum(qv) * (1.f / D) + LN_EPS);
#pragma unroll
            for (int j = 0; j < 4; ++j) { const int c0 = 8 * lane + 512 * j; const f32x4 g0 = *(const f32x4*)(ln2_g + c0), g1 = *(const f32x4*)(ln2_g + c0 + 4), b0 = *(const f32x4*)(ln2_b + c0), b1 = *(const f32x4*)(ln2_b + c0 + 4);
                rp[128 * j] = v[2 * j] * rstd * g0 + b0; rp[128 * j + 1] = v[2 * j + 1] * rstd * g1 + b1; }
        } }
        __syncthreads();
    }
}

struct Args { const float* in[22]; float* out; unsigned char* ws; int ph_lo, ph_hi; };
__global__ void __launch_bounds__(NWAVES * 64, 2) mk_fwd(Args args) {
    extern __shared__ __attribute__((aligned(16))) unsigned char lds[];
    cg::grid_group grid = cg::this_grid();
    Frame F;
    F.lds = (LAS unsigned char*)lds;
    if (threadIdx.x == 0) { LAS unsigned long long* PT = (LAS unsigned long long*)(F.lds + RING_BYTES);
#pragma unroll
        for (int k = 0; k < 22; ++k) PT[k] = (unsigned long long)args.in[k];
        PT[22] = (unsigned long long)args.out; PT[23] = (unsigned long long)args.ws;
        ((LAS unsigned*)(F.lds + RING_BYTES + 256))[0] = 0u; ((LAS unsigned*)(F.lds + RING_BYTES + 256))[1] = 0u; }
    __syncthreads();
    const int lo = args.ph_lo, hi = args.ph_hi;
#ifndef PHASE_MASK
#define PHASE_MASK 255
#endif
#define IN(k) (((PHASE_MASK >> (k)) & 1) && lo <= (k) && (k) < hi)
#ifndef REPEAT_PHASE
#define REPEAT_PHASE -1
#endif
#define REP(k) for (int rep_ = 0; rep_ < ((REPEAT_PHASE == (k)) ? 2 : 1); ++rep_)
    (void)xcd_barrier_post((unsigned*)args.ws, (volatile LAS unsigned*)(F.lds + RING_BYTES + 256));
#define SEAM(k) do { if (IN(k) && IN((k) + 1)) { if ((k) == 0) grid.sync(); else { XcdBarrier bar_; bar_.bar = F.ws<unsigned>(0); bar_.x = xb_xcc_id(); bar_.st = (volatile LAS unsigned*)(F.lds + RING_BYTES + 256); xcd_barrier(bar_); } } } while (0)

    if (IN(0)) REP(0) { p0_prologue(F); } SEAM(0);
    if (IN(1)) REP(1) {
        pg8::Gemm g{F.ws<bf16>(WS_XB), F.ws<bf16>(WS_WIN), M, NPROJ, D}; pg8::StaticOrder S; S.init(M, NPROJ, F.G_(), (int)blockIdx.x);
        pg8::EpiProj E{F.ws<bf16>(WS_Q), (size_t)(WS_K - WS_Q) / 2, attn_body::C2, F.ws<bf16>(WS_H), F.in(I_BGLU)};
        pg8::gemm_phase<pg8::EpiProj, pg8::StaticOrder, PG8_ALIGN, PG8_SP2>(F.lds, g, S, E);
    } SEAM(1);
    if (IN(2)) REP(2) {
        static_assert(attn_body::ATTN_LDS_BYTES <= RING_BYTES && attn_body::ATTN_PITCH == DATT, "attention body geometry vs frame");
        const attn_body::AttnTensors AT{F.ws<const attn_body::bf16>(WS_Q), F.ws<const attn_body::bf16>(WS_K), F.ws<const attn_body::bf16>(WS_V), F.ws<attn_body::bf16>(WS_O1), F.ws<attn_body::bf16>(WS_O2), F.ws<const float>(WS_TAB)};
        const attn_body::StaticOrder S((int)F.G_(), (int)blockIdx.x);
        attn_body::attn_phase<attn_body::StaticOrder>((char*)lds, AT, S);
    } SEAM(2);
    if (IN(3)) REP(3) { p3_combine(F); p3_conv(F); } SEAM(3);
    if (IN(4)) REP(4) {
        pg8::Gemm g{F.ws<bf16>(WS_XB), F.ws<bf16>(WS_WOUT), M, D, D}; pg8::StaticOrder S; S.init(M, D, F.G_(), (int)blockIdx.x);
        pg8::EpiRes E{F.in(I_X), F.ws<bf16>(WS_Y1), D, DN_ALPHA};
        pg8::gemm_phase<pg8::EpiRes, pg8::StaticOrder, PG8_ALIGN, PG8_SP2>(F.lds, g, S, E);
    } SEAM(4);
    if (IN(5)) REP(5) { p5_ln1(F); } SEAM(5);
    if (IN(6)) REP(6) {
        pg8::Gemm g{F.ws<bf16>(WS_Y1), F.ws<bf16>(WS_WQ), M, D, D}; pg8::StaticOrder S; S.init(M, D, F.G_(), (int)blockIdx.x);
        pg8::EpiPlain E{F.ws<bf16>(WS_QP), D};
        pg8::gemm_phase<pg8::EpiPlain, pg8::StaticOrder, PG8_ALIGN, PG8_SP2>(F.lds, g, S, E);
    } SEAM(6);
    if (IN(7)) REP(7) { p7_peer(F); }
#undef IN
#undef SEAM
}

extern "C" void kernel_launch(void* const* d_in, const int* in_sizes, int n_in, void* d_out, int out_size, void* d_ws, size_t ws_size, hipStream_t stream) {
    static int grid = 0;
    if (grid == 0) {
        if (n_in != 22 || in_sizes[0] != M * D || out_size != M * D || ws_size < WS_END) { fprintf(stderr, "kernel_launch: unexpected shapes (n_in %d, in0 %d, out %d, ws %zu); nothing launched\n", n_in, n_in > 0 ? in_sizes[0] : -1, out_size, ws_size); grid = -1; return; }
        int dev = 0, cus = 0, per_cu = 0;
        if (hipGetDevice(&dev) != hipSuccess || hipDeviceGetAttribute(&cus, hipDeviceAttributeMultiprocessorCount, dev) != hipSuccess) { grid = -1; return; }
        if (hipFuncSetAttribute((const void*)mk_fwd, hipFuncAttributeMaxDynamicSharedMemorySize, LDS_BYTES) != hipSuccess) { fprintf(stderr, "kernel_launch: hipFuncSetAttribute failed\n"); grid = -1; return; }
        if (hipOccupancyMaxActiveBlocksPerMultiprocessor(&per_cu, (const void*)mk_fwd, NWAVES * 64, LDS_BYTES) != hipSuccess || per_cu < 1) { fprintf(stderr, "kernel_launch: occupancy query reports %d workgroups per CU\n", per_cu); (void)hipGetLastError(); grid = -1; return; }
        grid = cus;
        if (grid > 256) grid = 256;
    }
    if (grid < 0) return;
    if (hipMemsetAsync(d_ws, 0, 16384, stream) != hipSuccess) { fprintf(stderr, "kernel_launch: hipMemsetAsync failed\n"); return; }
    Args a{};
    for (int i = 0; i < 22; ++i) a.in[i] = (const float*)d_in[i];
    a.out = (float*)d_out; a.ws = (unsigned char*)d_ws;
    constexpr int NL = MK_N_LAUNCHES;
    for (int li = 0; li < NL; ++li) {
        a.ph_lo = (NL == 1) ? 0 : li; a.ph_hi = (NL == 1) ? N_PHASES : li + 1;
        void* kargs[] = {&a};
        const hipError_t le = hipLaunchCooperativeKernel((const void*)mk_fwd, dim3(grid), dim3(NWAVES * 64), kargs, LDS_BYTES, stream);
        if (le != hipSuccess) { fprintf(stderr, "kernel_launch: cooperative launch %d failed: %s (grid %d)\n", li, hipGetErrorString(le), grid); break; }
    }
}
```

```cpp
#include <hip/hip_runtime.h>
#include <hip/hip_cooperative_groups.h>
#include <cstdio>
#include <cstdint>
namespace cg = cooperative_groups;
namespace pg8 {
#define PG8_LAS __attribute__((address_space(3)))
typedef unsigned short bf16_t;
typedef short bf16x8 __attribute__((ext_vector_type(8)));
typedef float f32x4 __attribute__((ext_vector_type(4)));
typedef unsigned u32x4 __attribute__((ext_vector_type(4)));
constexpr int BM = 256, BK = 64, HALF = 128, HTB = HALF * BK * 2  , STAGE_BYTES = 8 * HTB, NXCD = 8, WGM = 8;

__host__ __device__ __forceinline__ int lds_byte(int r, int c) { const int st = (r >> 4) * 2 + (c >> 5), rr = r & 15, cc = c & 31, ob = rr * 64 + cc * 2; return st * 1024 + (ob ^ (((ob >> 9) & 1) << 5)); }
__host__ __device__ __forceinline__ void stage_rc(int b, int& R, int& C) { const int st = b / 1024, sb = b % 1024, swz = sb ^ (((sb >> 9) & 1) << 5); R = (st >> 1) * 16 + swz / 64; C = (st & 1) * 32 + (swz % 64) / 2; }
__host__ __device__ __forceinline__ int perm32(int rho) { const int n = rho >> 4, i = rho & 15; return 8 * (i >> 2) + 4 * n + (i & 3); }

struct Unit { int pm, pn; };
struct Gemm { const bf16_t* A; const bf16_t* Bt; int M, N, K; };

struct StaticOrder {
    int nM, nN, nwg, G, c;
    __host__ __device__ void init(int M, int N, int G_, int c_) { nM = M / BM; nN = N / BM; nwg = nM * nN; G = G_; c = c_; }
    __host__ __device__ bool next(int i, Unit& u) const {
        const long L = (long)i * G + c; if (L >= nwg) return false;
        int wgid = (int)L; { const int q = nwg / NXCD, r = nwg % NXCD, xcd = wgid % NXCD, off = wgid / NXCD; wgid = (xcd < r ? xcd * (q + 1) : r * (q + 1) + (xcd - r) * q) + off; }
        const int nig = WGM * nN, gid = wgid / nig, fm = gid * WGM, gsz = (nM - fm) < WGM ? (nM - fm) : WGM;
        u.pm = fm + ((wgid % nig) % gsz); u.pn = (wgid % nig) / gsz; return true;
    }
    __device__ __forceinline__ void a_ready(const Unit&) const {}
    __device__ __forceinline__ void done(const Unit&) const {}
};

__device__ __forceinline__ unsigned cvt_pk_bf16(float lo, float hi) { unsigned r; asm volatile("v_cvt_pk_bf16_f32 %0, %1, %2" : "=v"(r) : "v"(lo), "v"(hi)); return r; }
typedef float f32x2 __attribute__((ext_vector_type(2)));
typedef float f32x2 __attribute__((ext_vector_type(2)));
__device__ __forceinline__ u32x4 pack8(f32x4 v0, f32x4 v1) { u32x4 w; w.x = cvt_pk_bf16(v0[0], v0[1]); w.y = cvt_pk_bf16(v0[2], v0[3]); w.z = cvt_pk_bf16(v1[0], v1[1]); w.w = cvt_pk_bf16(v1[2], v1[3]); return w; }
struct EpiProj {
    static constexpr bool PERM = true, AFTER_DRAIN = false;
    bf16_t* QKV; size_t split_stride; float scale0; bf16_t* H; const float* bglu;
    __device__ __forceinline__ void operator()(const f32x4 (&acc)[2][2][4][2], const Unit& u, int wr, int wc, int fr, int fq) const {
        const int row0 = u.pm * BM + wr * 64 + fr;
        if (u.pn < 12) {
            const int t = u.pn >> 2; bf16_t* base = QKV + (size_t)t * split_stride; const float sc = (t == 0) ? scale0 : 1.f;
            const int col0 = (u.pn & 3) * BM + wc * 32 + 8 * fq;
#pragma unroll
            for (int ai = 0; ai < 2; ++ai)
#pragma unroll
                for (int m = 0; m < 4; ++m) { bf16_t* rowp = base + (size_t)(row0 + ai * HALF + m * 16) * 1024 + col0;
#pragma unroll
                    for (int bj = 0; bj < 2; ++bj) *(u32x4*)(rowp + bj * HALF) = pack8(acc[ai][bj][m][0] * sc, acc[ai][bj][m][1] * sc); }
        } else {
            const int ch0 = (u.pn - 12) * HALF + wc * 32 + 8 * fq;
            const f32x4 ba0 = *(const f32x4*)(bglu + ch0), ba1 = *(const f32x4*)(bglu + ch0 + 4), bg0 = *(const f32x4*)(bglu + 1024 + ch0), bg1 = *(const f32x4*)(bglu + 1024 + ch0 + 4);
#pragma unroll
            for (int ai = 0; ai < 2; ++ai)
#pragma unroll
                for (int m = 0; m < 4; ++m) {
                    const f32x4 a0 = acc[ai][0][m][0] + ba0, a1 = acc[ai][0][m][1] + ba1, g0 = acc[ai][1][m][0] + bg0, g1 = acc[ai][1][m][1] + bg1;
                    f32x4 h0, h1;
#pragma unroll
                    for (int e = 0; e < 4; ++e) { h0[e] = a0[e] * __builtin_amdgcn_rcpf(1.f + __builtin_amdgcn_exp2f(-1.4426950409f * g0[e])); h1[e] = a1[e] * __builtin_amdgcn_rcpf(1.f + __builtin_amdgcn_exp2f(-1.4426950409f * g1[e])); }
                    *(u32x4*)(H + (size_t)(row0 + ai * HALF + m * 16) * 1024 + ch0) = pack8(h0, h1); }
        }
    }
};
struct EpiRes {
    static constexpr bool PERM = true, AFTER_DRAIN = false;
    const float* X; bf16_t* Y; int ldc; float alpha;
    __device__ __forceinline__ void operator()(const f32x4 (&acc)[2][2][4][2], const Unit& u, int wr, int wc, int fr, int fq) const {
        const int row0 = u.pm * BM + wr * 64 + fr, col0 = u.pn * BM + wc * 32 + 8 * fq;
#pragma unroll
        for (int ai = 0; ai < 2; ++ai)
#pragma unroll
            for (int m = 0; m < 4; ++m) { const size_t off = (size_t)(row0 + ai * HALF + m * 16) * ldc + col0;
#pragma unroll
                for (int bj = 0; bj < 2; ++bj) { const f32x4 x0 = *(const f32x4*)(X + off + bj * HALF), x1 = *(const f32x4*)(X + off + bj * HALF + 4);
                    *(u32x4*)(Y + off + bj * HALF) = pack8(acc[ai][bj][m][0] + x0 * alpha, acc[ai][bj][m][1] + x1 * alpha); } }
    }
};
struct EpiPlain {
    static constexpr bool PERM = true, AFTER_DRAIN = false;
    bf16_t* O; int ldc;
    __device__ __forceinline__ void operator()(const f32x4 (&acc)[2][2][4][2], const Unit& u, int wr, int wc, int fr, int fq) const {
        const int row0 = u.pm * BM + wr * 64 + fr, col0 = u.pn * BM + wc * 32 + 8 * fq;
#pragma unroll
        for (int ai = 0; ai < 2; ++ai)
#pragma unroll
            for (int m = 0; m < 4; ++m) { bf16_t* rowp = O + (size_t)(row0 + ai * HALF + m * 16) * ldc + col0;
#pragma unroll
                for (int bj = 0; bj < 2; ++bj) *(u32x4*)(rowp + bj * HALF) = pack8(acc[ai][bj][m][0], acc[ai][bj][m][1]); }
    }
};

template <class Epi, class Sched, bool ALIGN_EPI = false, bool SP2 = false>
__device__ __forceinline__ void gemm_phase(PG8_LAS unsigned char* lds, const Gemm g, const Sched& S, const Epi& E) {
    const int tid = threadIdx.x, wid = __builtin_amdgcn_readfirstlane(tid >> 6), lane = tid & 63, wr = wid >> 2, wc = wid & 3, fr = lane & 15, fq = lane >> 4;
    const int K = g.K, nt = K / BK;
    unsigned voffA[2], voffB[2];
#pragma unroll
    for (int i = 0; i < 2; ++i) { int R, C; stage_rc(tid * 16 + i * 8192, R, C); const int Rb = Epi::PERM ? ((R & ~31) + perm32(R & 31)) : R;
        voffA[i] = (unsigned)(R * K + C) * 2u; voffB[i] = (unsigned)(Rb * K + C) * 2u; }
    const size_t kstep = (size_t)(BK * 2);
    const size_t hstep = (size_t)HALF * K * 2;
    const size_t tstep = 2 * hstep;
    const unsigned ldsw = (unsigned)wid * 1024u;
    const int aoff = lds_byte(wr * 64 + fr, fq * 8), boff = lds_byte(wc * 32 + fr, fq * 8);
#define PG8_SA(b, h) (((b) * 2 + (h)) * HTB)
#define PG8_SB(b, h) ((4 + (b) * 2 + (h)) * HTB)
#define PG8_STAGE(bufoff, gbase, voff) do { _Pragma("unroll") for (int _i = 0; _i < 2; ++_i) \
        __builtin_amdgcn_global_load_lds((const unsigned*)((const char*)(gbase) + (voff)[_i]), (PG8_LAS unsigned*)(lds + (bufoff) + ldsw + _i * 8192), 16, 0, 0); } while (0)
#define PG8_LDA(dst, b, h) do { _Pragma("unroll") for (int m = 0; m < 4; ++m) _Pragma("unroll") for (int k = 0; k < 2; ++k) dst[m][k] = *(const PG8_LAS bf16x8*)(lds + PG8_SA(b, h) + aoff + m * 2048 + k * 1024); } while (0)
#define PG8_LDB(dst, b, h) do { _Pragma("unroll") for (int n = 0; n < 2; ++n) _Pragma("unroll") for (int k = 0; k < 2; ++k) dst[n][k] = *(const PG8_LAS bf16x8*)(lds + PG8_SB(b, h) + boff + n * 2048 + k * 1024); } while (0)
#define PG8_MMA(ai, bj, At, Bt) do { __builtin_amdgcn_s_setprio(1); _Pragma("unroll") for (int m = 0; m < 4; ++m) _Pragma("unroll") for (int n = 0; n < 2; ++n) _Pragma("unroll") for (int k = 0; k < 2; ++k) \
        acc[ai][bj][m][n] = __builtin_amdgcn_mfma_f32_16x16x32_bf16(Bt[n][k], At[m][k], acc[ai][bj][m][n], 0, 0, 0); __builtin_amdgcn_s_setprio(0); } while (0)
#define PG8_WAIT_V(n) asm volatile("s_waitcnt vmcnt(" #n ")" ::: "memory")
#define PG8_WAIT_L(n) asm volatile("s_waitcnt lgkmcnt(" #n ")" ::: "memory")
#define PG8_BAR __builtin_amdgcn_s_barrier()
#define PG8_SCHED __builtin_amdgcn_sched_barrier(0)
    Unit cur, nxt; int ui = 0;
    if (!S.next(0, cur)) return;
    f32x4 acc[2][2][4][2];
#pragma unroll
    for (int a = 0; a < 2; ++a)
#pragma unroll
        for (int b = 0; b < 2; ++b)
#pragma unroll
            for (int m = 0; m < 4; ++m)
#pragma unroll
                for (int n = 0; n < 2; ++n) acc[a][b][m][n] = (f32x4){0.f, 0.f, 0.f, 0.f};
    bf16x8 At[4][2], B0[2][2], B1[2][2];
    const char* cA = (const char*)g.A + (size_t)cur.pm * tstep; const char* cB = (const char*)g.Bt + (size_t)cur.pn * tstep;
    S.a_ready(cur);
    if constexpr (SP2) {
        PG8_STAGE(PG8_SB(0, 0), cB, voffB); PG8_STAGE(PG8_SB(0, 1), cB + hstep, voffB); PG8_STAGE(PG8_SA(0, 0), cA, voffA); PG8_STAGE(PG8_SA(0, 1), cA + hstep, voffA);
        if (wr == 1) PG8_BAR;
        PG8_WAIT_V(2); PG8_BAR;
        PG8_STAGE(PG8_SB(1, 0), cB + kstep, voffB); PG8_STAGE(PG8_SA(1, 0), cA + kstep, voffA); PG8_STAGE(PG8_SB(1, 1), cB + hstep + kstep, voffB);
        PG8_WAIT_V(6); PG8_BAR;
    } else {
        PG8_STAGE(PG8_SB(0, 0), cB, voffB); PG8_STAGE(PG8_SA(0, 0), cA, voffA); PG8_STAGE(PG8_SB(0, 1), cB + hstep, voffB); PG8_STAGE(PG8_SA(0, 1), cA + hstep, voffA);
        if (wr == 1) PG8_BAR;
        PG8_WAIT_V(4); PG8_BAR;
        PG8_STAGE(PG8_SB(1, 0), cB + kstep, voffB); PG8_STAGE(PG8_SA(1, 0), cA + kstep, voffA); PG8_STAGE(PG8_SB(1, 1), cB + hstep + kstep, voffB);
        PG8_WAIT_V(6); PG8_BAR;
    }
    for (;;) {
        const bool has_next = S.next(ui + 1, nxt);
        const char* nA = has_next ? (const char*)g.A + (size_t)nxt.pm * tstep : cA; const char* nB = has_next ? (const char*)g.Bt + (size_t)nxt.pn * tstep : cB;
        for (int t = 0; t < nt; t += 2) {
            const bool last = (t == nt - 2);
            const char* a1 = cA + (size_t)(t + 1) * kstep;
            const char* a2 = last ? nA : cA + (size_t)(t + 2) * kstep; const char* b2 = last ? nB : cB + (size_t)(t + 2) * kstep;
            const char* a3 = a2 + kstep; const char* b3 = b2 + kstep;
            if (last && has_next) S.a_ready(nxt);
            if constexpr (SP2) {
            PG8_LDB(B0, 0, 0); PG8_LDB(B1, 0, 1); PG8_SCHED; PG8_LDA(At, 0, 0); PG8_STAGE(PG8_SA(1, 1), a1 + hstep, voffA);
            PG8_WAIT_V(8); PG8_WAIT_L(0); PG8_BAR; PG8_MMA(0, 0, At, B0); PG8_MMA(0, 1, At, B1); PG8_BAR; PG8_SCHED;
            PG8_LDA(At, 0, 1); PG8_STAGE(PG8_SB(0, 0), b2, voffB); PG8_STAGE(PG8_SB(0, 1), b2 + hstep, voffB); PG8_STAGE(PG8_SA(0, 0), a2, voffA);
            PG8_WAIT_V(8); PG8_WAIT_L(0); PG8_BAR; PG8_MMA(1, 0, At, B0); PG8_MMA(1, 1, At, B1); PG8_BAR; PG8_SCHED;
            PG8_LDB(B0, 1, 0); PG8_LDB(B1, 1, 1); PG8_SCHED; PG8_LDA(At, 1, 0); PG8_STAGE(PG8_SA(0, 1), a2 + hstep, voffA);
            PG8_WAIT_V(8); PG8_WAIT_L(0); PG8_BAR; PG8_MMA(0, 0, At, B0); PG8_MMA(0, 1, At, B1); PG8_BAR; PG8_SCHED;
            PG8_LDA(At, 1, 1); PG8_STAGE(PG8_SB(1, 0), b3, voffB); PG8_STAGE(PG8_SB(1, 1), b3 + hstep, voffB); PG8_STAGE(PG8_SA(1, 0), a3, voffA);
            PG8_WAIT_V(8); PG8_WAIT_L(0); PG8_BAR; PG8_MMA(1, 0, At, B0); PG8_MMA(1, 1, At, B1); PG8_BAR; PG8_SCHED;
            } else {
            PG8_LDB(B0, 0, 0); PG8_SCHED; PG8_LDA(At, 0, 0); PG8_STAGE(PG8_SA(1, 1), a1 + hstep, voffA);
            PG8_WAIT_L(8); PG8_BAR; PG8_WAIT_L(0); PG8_MMA(0, 0, At, B0); PG8_BAR; PG8_SCHED;
            PG8_LDB(B1, 0, 1); PG8_STAGE(PG8_SB(0, 0), b2, voffB);
            PG8_BAR; PG8_WAIT_L(0); PG8_MMA(0, 1, At, B1); PG8_BAR;
            PG8_LDA(At, 0, 1); PG8_STAGE(PG8_SA(0, 0), a2, voffA);
            PG8_BAR; PG8_WAIT_L(0); PG8_MMA(1, 0, At, B0); PG8_BAR; PG8_SCHED;
            PG8_STAGE(PG8_SB(0, 1), b2 + hstep, voffB);
            PG8_WAIT_V(6); PG8_BAR; PG8_MMA(1, 1, At, B1); PG8_BAR;
            PG8_LDB(B0, 1, 0); PG8_SCHED; PG8_LDA(At, 1, 0); PG8_STAGE(PG8_SA(0, 1), a2 + hstep, voffA);
            PG8_WAIT_L(8); PG8_BAR; PG8_WAIT_L(0); PG8_MMA(0, 0, At, B0); PG8_BAR; PG8_SCHED;
            PG8_LDB(B1, 1, 1); PG8_STAGE(PG8_SB(1, 0), b3, voffB);
            PG8_BAR; PG8_WAIT_L(0); PG8_MMA(0, 1, At, B1); PG8_BAR;
            PG8_LDA(At, 1, 1); PG8_STAGE(PG8_SA(1, 0), a3, voffA);
            PG8_BAR; PG8_WAIT_L(0); PG8_MMA(1, 0, At, B0); PG8_BAR; PG8_SCHED;
            PG8_STAGE(PG8_SB(1, 1), b3 + hstep, voffB);
            PG8_WAIT_V(6); PG8_BAR; PG8_MMA(1, 1, At, B1); PG8_BAR;
            }
        }
        if constexpr (ALIGN_EPI) { if (wr == 0) PG8_BAR; }
        if constexpr (!Epi::AFTER_DRAIN) { E(acc, cur, wr, wc, fr, fq); S.done(cur); }
        if (!has_next) break;
#pragma unroll
        for (int a = 0; a < 2; ++a)
#pragma unroll
            for (int b = 0; b < 2; ++b)
#pragma unroll
                for (int m = 0; m < 4; ++m)
#pragma unroll
                    for (int n = 0; n < 2; ++n) acc[a][b][m][n] = (f32x4){0.f, 0.f, 0.f, 0.f};
        cur = nxt; cA = nA; cB = nB; ++ui;
        if constexpr (ALIGN_EPI) { if (wr == 1) PG8_BAR; }
    }
    PG8_WAIT_V(0);
    if constexpr (!ALIGN_EPI) { if (wr == 0) PG8_BAR; }
    PG8_BAR;
    if constexpr (Epi::AFTER_DRAIN) { E.fused(acc, cur, wr, wc, fr, fq, lds, wid, lane); S.done(cur); }
#undef PG8_SA
#undef PG8_SB
#undef PG8_STAGE
#undef PG8_LDA
#undef PG8_LDB
#undef PG8_MMA
#undef PG8_WAIT_V
#undef PG8_WAIT_L
#undef PG8_BAR
#undef PG8_SCHED
}
}
#include <hip/hip_bf16.h>
#include <cmath>
namespace attn_body {
using bf16=__hip_bfloat16;
using bf16x8=__attribute__((ext_vector_type(8)))short;
using s16x4=__attribute__((ext_vector_type(4)))short;
using f32x16=__attribute__((ext_vector_type(16)))float;
using u32x4=__attribute__((ext_vector_type(4)))unsigned;
constexpr int BATCH=8,NHEAD=16,SEQ=4096,D=64,DM=NHEAD*D;
constexpr int NW=8,QBLK=32,QB=QBLK*NW,KVBLK=64,NQB=SEQ/QB;
constexpr int ATTN_PITCH=DM, ATTN_UNIT_ROWS=QB;
__device__ __forceinline__ int crow(int r,int hi){return (r&3)+8*(r>>2)+4*hi;}
#define SBAR() __builtin_amdgcn_sched_barrier(0)
__device__ __forceinline__ void cmask(f32x16&p0,f32x16&p1,int jb,int qrel,int hi){
  const float NEG=-INFINITY; int kb=64*jb+4*hi;
  #pragma unroll
  for(int r=0;r<16;++r){int kv=kb+(r&3)+8*(r>>2); if(kv>qrel)p0[r]=NEG; if(kv+32>qrel)p1[r]=NEG;}
}

__device__ __forceinline__ void cbias(f32x16&p0,f32x16&p1,int jb,int qrel,int hi,const __attribute__((address_space(3))) float*tab){
  const int base=qrel-64*jb-4*hi;
  #pragma unroll
  for(int r=0;r<16;++r){const int d0=base-((r&3)+8*(r>>2)); const int i0=min(max(d0,0),127), i1=min(max(d0-32,0),127); p0[r]+=tab[i0]; p1[r]+=tab[i1];}
}
constexpr int NSLOT=3, SLOTB=8192;
constexpr int LDS_K=0, LDS_V=NSLOT*SLOTB, LDS_WS=2*NSLOT*SLOTB, LDS_OST=LDS_WS+NW*64*4, LDS_TAB=LDS_OST+NW*4096, LDS_BYTES=LDS_TAB+512;
constexpr float C2=0.125f*1.4426950408889634f;
__device__ __forceinline__ void glds16(const void*gsrc,unsigned lds_dst){unsigned keep;
  asm volatile("s_mov_b32 %0, m0\n\ts_mov_b32 m0, %2\n\ts_nop 0\n\tglobal_load_lds_dwordx4 %1, off\n\ts_mov_b32 m0, %0":"=&s"(keep):"v"(gsrc),"s"(lds_dst):"memory");}
__device__ __forceinline__ float max3f(float a,float b,float c){float r;asm("v_max3_f32 %0, %1, %2, %3":"=v"(r):"v"(a),"v"(b),"v"(c));return r;}
__device__ __forceinline__ float max2f(float a,float b){float r;asm("v_max_f32_e32 %0, %1, %2":"=v"(r):"v"(a),"v"(b));return r;}
__device__ __forceinline__ float fadd_s(float a,float b){float r;asm("v_add_f32_e32 %0, %1, %2":"=v"(r):"v"(a),"v"(b));return r;}
__device__ __forceinline__ float fsub_s(float a,float b){float r;asm("v_sub_f32_e32 %0, %1, %2":"=v"(r):"v"(a),"v"(b));return r;}
typedef float f32x2_t __attribute__((ext_vector_type(2))); typedef __bf16 bf16x2_t __attribute__((ext_vector_type(2)));
__device__ __forceinline__ unsigned cvtpk_s(float lo,float hi){f32x2_t v={lo,hi};bf16x2_t b=__builtin_convertvector(v,bf16x2_t);return __builtin_bit_cast(unsigned,b);}
#define WAIT_BAR(N) asm volatile("s_waitcnt vmcnt(" #N ") lgkmcnt(0)\n\ts_barrier":::"memory")

__device__ __forceinline__ void qkt(f32x16&p0,f32x16&p1,const char*Kslot,const bf16x8*qr,const f32x16&negm,int r32,int hi){
  const char*kb=Kslot+hi*1024+r32*16;
  #pragma unroll
  for(int d0=0;d0<4;++d0){
    const bf16x8 b0=*reinterpret_cast<const bf16x8*>(kb+d0*2048);
    const bf16x8 b1=*reinterpret_cast<const bf16x8*>(kb+d0*2048+512);
    if(d0==0){p0=__builtin_amdgcn_mfma_f32_32x32x16_bf16(b0,qr[0],negm,0,0,0);p1=__builtin_amdgcn_mfma_f32_32x32x16_bf16(b1,qr[0],negm,0,0,0);}
    else{p0=__builtin_amdgcn_mfma_f32_32x32x16_bf16(b0,qr[d0],p0,0,0,0);p1=__builtin_amdgcn_mfma_f32_32x32x16_bf16(b1,qr[d0],p1,0,0,0);}}
}
typedef __attribute__((address_space(3))) const char* lds_cptr;
typedef short v4i16_t __attribute__((ext_vector_type(4)));
__device__ __forceinline__ void kload8(bf16x8*kf,lds_cptr kp){
  kf[0]=*(const __attribute__((address_space(3))) bf16x8*)(kp);      kf[1]=*(const __attribute__((address_space(3))) bf16x8*)(kp+512);
  kf[2]=*(const __attribute__((address_space(3))) bf16x8*)(kp+2048); kf[3]=*(const __attribute__((address_space(3))) bf16x8*)(kp+2560);
  kf[4]=*(const __attribute__((address_space(3))) bf16x8*)(kp+4096); kf[5]=*(const __attribute__((address_space(3))) bf16x8*)(kp+4608);
  kf[6]=*(const __attribute__((address_space(3))) bf16x8*)(kp+6144); kf[7]=*(const __attribute__((address_space(3))) bf16x8*)(kp+6656);
}
__device__ __forceinline__ void kload2(bf16x8*kf,lds_cptr kp,int j){ kf[2*j]=*(const __attribute__((address_space(3))) bf16x8*)(kp+j*2048); kf[2*j+1]=*(const __attribute__((address_space(3))) bf16x8*)(kp+j*2048+512); }
__device__ __forceinline__ s16x4 vtr(lds_cptr p){ return __builtin_bit_cast(s16x4,__builtin_amdgcn_ds_read_tr16_b64_v4i16((__attribute__((address_space(3))) v4i16_t*)p)); }
__device__ __forceinline__ float rowmax(const f32x16&p0,const f32x16&p1){
  float a=max3f(p0[0],p0[1],p1[0]),b=max3f(p0[2],p0[3],p1[1]);a=max3f(a,p1[2],p1[3]);
  #pragma unroll
  for(int r=4;r<16;r+=4){a=max3f(a,p0[r],p0[r+1]);b=max3f(b,p0[r+2],p0[r+3]);a=max3f(a,p1[r],p1[r+1]);b=max3f(b,p1[r+2],p1[r+3]);}
  const float m=max2f(a,b);
  auto rr=__builtin_amdgcn_permlane32_swap(__float_as_uint(m),__float_as_uint(m),false,false);
  return max2f(__uint_as_float(rr[0]),__uint_as_float(rr[1]));
}
__device__ __forceinline__ void pv(f32x16*o,int vb,bf16x8 pa0,bf16x8 pa1,bf16x8 pa2,bf16x8 pa3){
  #pragma unroll
  for(int d0=0;d0<2;++d0){s16x4 lo[4],hi[4];
    #pragma unroll
    for(int ks=0;ks<4;++ks){
      asm volatile("ds_read_b64_tr_b16 %0,%1 offset:%c2":"=&v"(lo[ks]):"v"(vb),"i"(d0*4096+ks*1024):"memory");
      asm volatile("ds_read_b64_tr_b16 %0,%1 offset:%c2":"=&v"(hi[ks]):"v"(vb),"i"(d0*4096+ks*1024+512):"memory");}
    asm volatile("s_waitcnt lgkmcnt(0)":::"memory");SBAR();
    #define PK(k) (bf16x8){lo[k][0],lo[k][1],lo[k][2],lo[k][3],hi[k][0],hi[k][1],hi[k][2],hi[k][3]}
    o[d0]=__builtin_amdgcn_mfma_f32_32x32x16_bf16(pa0,PK(0),o[d0],0,0,0);
    o[d0]=__builtin_amdgcn_mfma_f32_32x32x16_bf16(pa1,PK(1),o[d0],0,0,0);
    o[d0]=__builtin_amdgcn_mfma_f32_32x32x16_bf16(pa2,PK(2),o[d0],0,0,0);
    o[d0]=__builtin_amdgcn_mfma_f32_32x32x16_bf16(pa3,PK(3),o[d0],0,0,0);
    #undef PK
  }
}

#ifndef ATTN_STORE16
#define ATTN_STORE16(p,v) (*(u32x4*)(p)=(v))
#endif
template<int THRL> __device__ __forceinline__ void attn_unit(int b,int h,int hv,int qb,const bf16*Q,const bf16*__restrict__ K,const bf16*__restrict__ V,bf16*O,char*shm){
  const __attribute__((address_space(3))) float* tab=(const __attribute__((address_space(3))) float*)((lds_cptr)shm+LDS_TAB);
  const int tid=threadIdx.x,lane=tid&63,r32=lane&31,hi=lane>>5; const int wid=__builtin_amdgcn_readfirstlane(tid>>6);
  const long rowbase=(long)b*SEQ; const int q0=qb*QB;
  const bf16*Qw=Q+(rowbase+q0+wid*QBLK)*DM+h*D;
  const bf16*Kh=K+rowbase*DM+h*D,*Vh=V+rowbase*DM+hv*D;
  const unsigned lds0=(unsigned)(uintptr_t)shm;
  float*wsf=(float*)(shm+LDS_WS)+wid*64;
  const bf16*ksrc=Kh+(long)lane*DM+wid*8;
  const bf16*vsrc=Vh+(long)(16*(wid&3)+(lane>>2))*DM+(wid>>2)*32+(lane&3)*8;
  const unsigned kdst=lds0+LDS_K+wid*1024, vdst=lds0+LDS_V+wid*1024;
  #define DMA_K(t,slot) glds16(ksrc+(long)(t)*KVBLK*DM,(unsigned)__builtin_amdgcn_readfirstlane(kdst+(slot)))
  #define DMA_V(t,slot) glds16(vsrc+(long)(t)*KVBLK*DM,(unsigned)__builtin_amdgcn_readfirstlane(vdst+(slot)))
  const int vb0=(int)(lds0+LDS_V)+((lane>>4)&1)*32+(lane&3)*8+(4*hi+((lane&15)>>2))*64;
  const char*Kbase=shm+LDS_K; bf16x8 kf[8];
  const lds_cptr shm3=(lds_cptr)shm; const lds_cptr kp0=shm3+LDS_K+hi*1024+r32*16; const lds_cptr vp0=shm3+LDS_V+((lane>>4)&1)*32+(lane&3)*8+(4*hi+((lane&15)>>2))*64;
  const int NT=(q0+QB)/KVBLK;
  DMA_K(0,0);DMA_V(0,0);DMA_K(1,SLOTB);
  bf16x8 qr[4];
  #pragma unroll
  for(int d0=0;d0<4;++d0)qr[d0]=*reinterpret_cast<const bf16x8*>(&Qw[(long)r32*DM+d0*16+hi*8]);
  float mhat=0.f,l_reg=0.f;f32x16 o[2];o[0]=f32x16{};o[1]=f32x16{};f32x16 negm=f32x16{};asm volatile("":"+v"(negm));
  const int qrel=wid*QBLK+r32;
  #define CMASK(P0,P1,t) do{int jb_=(t)-(NT-4); if(jb_>=-2){cbias(P0,P1,jb_,qrel,hi,tab); if(jb_>=0)cmask(P0,P1,jb_,qrel,hi);}}while(0)
  bool resc=false;
  #define START(P0,P1) do{ const float rm=rowmax(P0,P1); resc=false; \
    { const float dl=rm; mhat=fadd_s(mhat,dl); \
      _Pragma("unroll") for(int r=0;r<16;++r){P0[r]=fsub_s(P0[r],dl);P1[r]=fsub_s(P1[r],dl);} \
      _Pragma("unroll") for(int r=0;r<16;++r)negm[r]=-mhat; asm volatile("":"+v"(negm)); } \
    _Pragma("unroll") for(int r=0;r<16;++r)P0[r]=__builtin_amdgcn_exp2f(P0[r]); }while(0)
  #define RESC() do{ if(resc){ asm volatile("s_waitcnt lgkmcnt(0)":::"memory"); \
      _Pragma("unroll") for(int d_=0;d_<2;++d_) _Pragma("unroll") for(int r=0;r<16;++r)o[d_][r]*=wsf[crow(r,hi)]; } }while(0)
  f32x16 pA0,pA1,pB0,pB1;
  int sl_prev=0,sl_cur=0,sl_next=SLOTB;
  #define ROT() do{sl_prev=sl_cur;sl_cur=sl_next;sl_next=(sl_next==(NSLOT-1)*SLOTB)?0:sl_next+SLOTB;}while(0)
  DMA_K(2,2*SLOTB);
  WAIT_BAR(3);
  qkt(pA0,pA1,Kbase,qr,negm,r32,hi);asm volatile("s_nop 15\n\ts_nop 7":"+v"(pA0),"+v"(pA1));CMASK(pA0,pA1,0);
  START(pA0,pA1);
  _Pragma("unroll") for(int r=0;r<16;++r)pA1[r]=__builtin_amdgcn_exp2f(pA1[r]);
  WAIT_BAR(0);
  DMA_K(3,0);DMA_V(1,SLOTB);
  ROT();
  kload8(kf,kp0+sl_cur);
  WAIT_BAR(2);
  s16x4 vlo[8],vhi[8]; u32x4 pw0,pw1,pw2,pw3;
  #define PKW(P,B) cvtpk_s(P[B],P[B+1])
  #define PAF(k) __builtin_bit_cast(bf16x8,pw##k)
  #define VFR(i) (bf16x8){vlo[i][0],vlo[i][1],vlo[i][2],vlo[i][3],vhi[i][0],vhi[i][1],vhi[i][2],vhi[i][3]}
  #define PIN(x) asm volatile("":"+v"(x))
  #define MX3(a,b,c) __builtin_fmaxf(__builtin_fmaxf((a),(b)),(c))
  #define GAPA(MF,A0,A1,A2,A3,W0,W1,PW) do{ MF; sacc+=A0; sacc+=A1; sacc+=A2; sacc+=A3; PIN(sacc); W0; W1; PIN(PW); SBAR(); }while(0)
  #define EX(v) __builtin_amdgcn_exp2f(v)
  #define GAPB(MF,X,B) do{ MF; X[B]=EX(X[B]); X[B+1]=EX(X[B+1]); X[B+2]=EX(X[B+2]); X[B+3]=EX(X[B+3]); PIN(X); SBAR(); }while(0)
  #define VRD(i) do{ vlo[i]=vtr(vp_+(((i)>>2)*4096+((i)&3)*1024)); vhi[i]=vtr(vp_+(((i)>>2)*4096+((i)&3)*1024+512)); }while(0)
  #define KRD(G,j) do{ if(G){ kload2(kf,kp0+sl_next,j); SBAR(); } }while(0)
  #define STEP(C0,C1,P0,P1,t,GK,GV,GL) do{ SBAR(); \
    const lds_cptr vp_=vp0+sl_prev; \
    VRD(0); SBAR(); float sacc=(P0[0]+P0[1]); \
    GAPA(C0=__builtin_amdgcn_mfma_f32_32x32x16_bf16(kf[0],qr[0],negm,0,0,0), P0[2],P0[3],P0[4],P0[5],     pw0[0]=PKW(P0,0), pw0[1]=PKW(P0,2), pw0); \
    VRD(4); SBAR(); GAPA(C1=__builtin_amdgcn_mfma_f32_32x32x16_bf16(kf[1],qr[0],negm,0,0,0), P0[6],P0[7],P0[8],P0[9],     pw0[2]=PKW(P0,4), pw0[3]=PKW(P0,6), pw0); \
    VRD(1); SBAR(); GAPA(C0=__builtin_amdgcn_mfma_f32_32x32x16_bf16(kf[2],qr[1],C0,0,0,0),   P0[10],P0[11],P0[12],P0[13], pw1[0]=PKW(P0,8), pw1[1]=PKW(P0,10), pw1); \
    VRD(5); SBAR(); GAPA(C1=__builtin_amdgcn_mfma_f32_32x32x16_bf16(kf[3],qr[1],C1,0,0,0),   P0[14],P0[15],P1[0],P1[1],   pw1[2]=PKW(P0,12),pw1[3]=PKW(P0,14), pw1); \
    VRD(2); SBAR(); GAPA(C0=__builtin_amdgcn_mfma_f32_32x32x16_bf16(kf[4],qr[2],C0,0,0,0),   P1[2],P1[3],P1[4],P1[5],     pw2[0]=PKW(P1,0), pw2[1]=PKW(P1,2), pw2); \
    VRD(6); SBAR(); GAPA(C1=__builtin_amdgcn_mfma_f32_32x32x16_bf16(kf[5],qr[2],C1,0,0,0),   P1[6],P1[7],P1[8],P1[9],     pw2[2]=PKW(P1,4), pw2[3]=PKW(P1,6), pw2); \
    VRD(3); SBAR(); GAPA(C0=__builtin_amdgcn_mfma_f32_32x32x16_bf16(kf[6],qr[3],C0,0,0,0),   P1[10],P1[11],P1[12],P1[13], pw3[0]=PKW(P1,8), pw3[1]=PKW(P1,10), pw3); \
    VRD(7); SBAR(); GAPA(C1=__builtin_amdgcn_mfma_f32_32x32x16_bf16(kf[7],qr[3],C1,0,0,0),   P1[14],P1[15],0.f,0.f,       pw3[2]=PKW(P1,12),pw3[3]=PKW(P1,14), pw3); \
    l_reg+=sacc; \
    if(GK){DMA_K((t)+3,sl_cur);} if(GV){DMA_V((t)+1,sl_next);} \
    CMASK(C0,C1,t); \
    { float a=MX3(C0[0],C0[1],C1[0]),b=MX3(C0[2],C0[3],C1[1]); a=MX3(a,C1[2],C1[3]); \
      _Pragma("unroll") for(int r=4;r<16;r+=4){a=MX3(a,C0[r],C0[r+1]);b=MX3(b,C0[r+2],C0[r+3]);a=MX3(a,C1[r],C1[r+1]);b=MX3(b,C1[r+2],C1[r+3]);} \
      float rm=__builtin_fmaxf(a,b); { auto rr=__builtin_amdgcn_permlane32_swap(__float_as_uint(rm),__float_as_uint(rm),false,false); rm=__builtin_fmaxf(__uint_as_float(rr[0]),__uint_as_float(rr[1])); } \
      resc=false; \
      if(__builtin_expect(__any(rm>(float)THRL),0)){ const float dl=__builtin_fmaxf(rm,0.f); mhat+=dl; \
        _Pragma("unroll") for(int r=0;r<16;++r){C0[r]-=dl;C1[r]-=dl;} \
        _Pragma("unroll") for(int r=0;r<16;++r)negm[r]=-mhat; asm volatile("":"+v"(negm)); \
        const float f=__builtin_amdgcn_exp2f(-dl); l_reg*=f; if(hi==0)wsf[r32]=f; resc=true; } } \
    SBAR(); \
    GAPB(o[0]=__builtin_amdgcn_mfma_f32_32x32x16_bf16(PAF(0),VFR(0),o[0],0,0,0), C0,0); \
    GAPB(o[1]=__builtin_amdgcn_mfma_f32_32x32x16_bf16(PAF(0),VFR(4),o[1],0,0,0), C0,4); \
    KRD(GL,0); GAPB(o[0]=__builtin_amdgcn_mfma_f32_32x32x16_bf16(PAF(1),VFR(1),o[0],0,0,0), C0,8); \
    KRD(GL,1); GAPB(o[1]=__builtin_amdgcn_mfma_f32_32x32x16_bf16(PAF(1),VFR(5),o[1],0,0,0), C0,12); \
    KRD(GL,2); GAPB(o[0]=__builtin_amdgcn_mfma_f32_32x32x16_bf16(PAF(2),VFR(2),o[0],0,0,0), C1,0); \
    KRD(GL,3); GAPB(o[1]=__builtin_amdgcn_mfma_f32_32x32x16_bf16(PAF(2),VFR(6),o[1],0,0,0), C1,4); \
    GAPB(o[0]=__builtin_amdgcn_mfma_f32_32x32x16_bf16(PAF(3),VFR(3),o[0],0,0,0), C1,8); \
    GAPB(o[1]=__builtin_amdgcn_mfma_f32_32x32x16_bf16(PAF(3),VFR(7),o[1],0,0,0), C1,12); \
    }while(0)
  int t=1;
  #undef CMASK
  #define CMASK(P0,P1,t) do{}while(0)
  for(;t+7<NT;t+=2){
    STEP(pB0,pB1,pA0,pA1,t,true,true,true);     WAIT_BAR(2); RESC(); ROT();
    STEP(pA0,pA1,pB0,pB1,t+1,true,true,true);   WAIT_BAR(2); RESC(); ROT();
  }
  #undef CMASK
  #define CMASK(P0,P1,t) do{int jb_=(t)-(NT-4); if(jb_>=-2){cbias(P0,P1,jb_,qrel,hi,tab); if(jb_>=0)cmask(P0,P1,jb_,qrel,hi);}}while(0)
  #define ENDW(tt) do{ if((tt)+3<NT){WAIT_BAR(2);} else if((tt)+2<NT){WAIT_BAR(1);} else {WAIT_BAR(0);} }while(0)
  for(;t+1<NT;t+=2){
    STEP(pB0,pB1,pA0,pA1,t,(t+3<NT),(t+1<NT),(t+1<NT));       ENDW(t);   RESC(); ROT();
    STEP(pA0,pA1,pB0,pB1,t+1,(t+4<NT),(t+2<NT),(t+2<NT));     ENDW(t+1); RESC(); ROT();
  }
  STEP(pB0,pB1,pA0,pA1,NT-1,false,false,false); RESC();
  { float sacc=pB0[0]+pB0[1]; _Pragma("unroll") for(int r=2;r<16;++r)sacc+=pB0[r]; _Pragma("unroll") for(int r=0;r<16;++r)sacc+=pB1[r]; l_reg+=sacc;
    pw0=(u32x4){PKW(pB0,0),PKW(pB0,2),PKW(pB0,4),PKW(pB0,6)};pw1=(u32x4){PKW(pB0,8),PKW(pB0,10),PKW(pB0,12),PKW(pB0,14)};pw2=(u32x4){PKW(pB1,0),PKW(pB1,2),PKW(pB1,4),PKW(pB1,6)};pw3=(u32x4){PKW(pB1,8),PKW(pB1,10),PKW(pB1,12),PKW(pB1,14)};
    SBAR(); pv(o,vb0+sl_cur,PAF(0),PAF(1),PAF(2),PAF(3)); }
  #undef PKW
  #undef PAF
  #undef VFR
  #undef PIN
  #undef MX3
  #undef GAPA
  #undef GAPB
  #undef EX
  #undef VRD
  #undef KRD
  #undef STEP
  #undef ENDW
  {auto rr=__builtin_amdgcn_permlane32_swap(__float_as_uint(l_reg),__float_as_uint(l_reg),false,false);l_reg=__uint_as_float(rr[0])+__uint_as_float(rr[1]);}
  if(hi==0)wsf[32+r32]=l_reg;asm volatile("s_waitcnt lgkmcnt(0)":::"memory");
  float rli[16];
  #pragma unroll
  for(int r=0;r<16;++r)rli[r]=__builtin_amdgcn_rcpf(wsf[32+crow(r,hi)]);
  bf16*Ow=O+(rowbase+q0+wid*QBLK)*DM+hv*D;
  { bf16*stg=(bf16*)(shm+LDS_OST)+wid*2048;
    #pragma unroll
    for(int r=0;r<16;++r){const int orow=crow(r,hi);
      #pragma unroll
      for(int d0=0;d0<2;++d0)stg[orow*64+d0*32+r32]=__float2bfloat16(o[d0][r]*rli[r]);}
    asm volatile("s_waitcnt lgkmcnt(0)":::"memory");
    #pragma unroll
    for(int i=0;i<4;++i){const int row=i*8+(lane>>3),ch=lane&7; const u32x4 v=*(const u32x4*)(stg+row*64+ch*8); ATTN_STORE16(Ow+(long)row*DM+ch*8,v);} }
  asm volatile("s_waitcnt lgkmcnt(0)\n\ts_barrier":::"memory");
  #undef DMA_K
  #undef DMA_V
  #undef CMASK
  #undef START
  #undef RESC
  #undef ROT
}
constexpr int ATTN_LDS_BYTES=LDS_BYTES;
struct AttnTensors { const bf16* Q; const bf16* K; const bf16* V; bf16* O1; bf16* O2; const float* biastab; };
struct AttnUnit { int b, hqk, hv, c, qb; };
struct StaticOrder {
  int vcu;
  __device__ __forceinline__ explicit StaticOrder(int grid,int block):vcu((grid%8==0)?(block%8)*(grid/8)+block/8:block){}
  __device__ __forceinline__ bool next(int i,AttnUnit&u)const{ if(i>=16)return false; const int v=vcu&255; u.b=v>>5; const int h=(v>>2)&7,c=(v>>1)&1,hf=v&1; u.hqk=2*h+c; u.hv=2*h+hf; u.c=c; u.qb=(i&1)?15-(i>>1):(i>>1); return true; }
};
template<class Sched,int THRL=8> __device__ __forceinline__ void attn_phase(char*lds,const AttnTensors&T,const Sched&S){
  AttnUnit u; int cur_h=-1;
  for(int i=0;S.next(i,u);++i){
    if((u.hqk>>1)!=cur_h){ cur_h=u.hqk>>1;
      if(threadIdx.x<128)((float*)(lds+LDS_TAB))[threadIdx.x]=T.biastab[cur_h*128+threadIdx.x];
      asm volatile("s_waitcnt vmcnt(0) lgkmcnt(0)\n\ts_barrier":::"memory"); }
    attn_unit<THRL>(u.b,u.hqk,u.hv,u.qb,T.Q,T.K,T.V,u.c?T.O2:T.O1,lds); }
}
#undef SBAR
#undef WAIT_BAR
}
#ifndef PG8_SP2
#define PG8_SP2 true
#endif
#ifndef PG8_ALIGN
#define PG8_ALIGN true
#endif
constexpr int NWAVES = 8;
#ifndef MK_N_LAUNCHES
#define MK_N_LAUNCHES 1
#endif
constexpr int N_PHASES = 8;
constexpr int BATCH = 8, SEQ = 4096, D = 2048, M = BATCH * SEQ;
constexpr int NPROJ = 5120, DATT = 1024, DCONV = 1024, CONVW = 31;
constexpr int PH = 8, PNK = 128, PHALF = 128, PTOPK = 16, NEXP = 16384;
constexpr float LN_EPS = 1e-5f;
constexpr float DN_ALPHA = 1.189207115002721f;
constexpr float LAMBDA_INIT = 0.2f;
constexpr size_t MiB = 1u << 20;
constexpr size_t WS_WIN = 2 * MiB, WS_WOUT = 22 * MiB, WS_WQ = 30 * MiB, WS_KEYS = 38 * MiB, WS_TAB = 39 * MiB;
constexpr size_t WS_U8 = 40 * MiB, WS_V8 = 72 * MiB, WS_SU = 104 * MiB, WS_SV = 105 * MiB;
constexpr size_t WS_XB = 168 * MiB;
constexpr size_t WS_Q = 296 * MiB, WS_K = 360 * MiB, WS_V = 424 * MiB, WS_H = 488 * MiB;
constexpr size_t WS_O1 = 552 * MiB, WS_O2 = 616 * MiB;
constexpr size_t WS_Y1 = 680 * MiB;
constexpr size_t WS_QP = 808 * MiB;
constexpr size_t WS_X8 = WS_O1;
constexpr size_t WS_SX = 106 * MiB;
constexpr size_t WS_EID = 936 * MiB, WS_GATE = 952 * MiB;
constexpr size_t WS_END = 968 * MiB;
constexpr int RING_BYTES = 131072, LDS_BYTES = 147456;

#define GAS __attribute__((address_space(1)))
#define LAS __attribute__((address_space(3)))
typedef unsigned short bf16;
typedef unsigned v4u __attribute__((ext_vector_type(4)));
typedef unsigned v2u __attribute__((ext_vector_type(2)));
typedef float f32x4 __attribute__((ext_vector_type(4)));
typedef float f32x16 __attribute__((ext_vector_type(16)));
typedef short bf16x8 __attribute__((ext_vector_type(8)));
typedef __bf16 bf16x2_t __attribute__((ext_vector_type(2)));
#define LDS_WAIT() asm volatile("s_waitcnt lgkmcnt(0)" ::: "memory")
__device__ __forceinline__ unsigned f2bf(float f) { unsigned u = __builtin_bit_cast(unsigned, f); return (u + 0x7fffu + ((u >> 16) & 1u)) >> 16; }
__device__ __forceinline__ unsigned pk2(float lo, float hi) { return f2bf(lo) | (f2bf(hi) << 16); }
__device__ __forceinline__ float bflo(unsigned w) { return __uint_as_float(w << 16); }
__device__ __forceinline__ float bfhi(unsigned w) { return __uint_as_float(w & 0xffff0000u); }
__device__ __forceinline__ float wave_sum(float v) {
#pragma unroll
    for (int o = 1; o < 64; o <<= 1) v += __shfl_xor(v, o);
    return v;
}
__device__ __forceinline__ float dot2bf(unsigned a, unsigned b, float acc) { return __builtin_amdgcn_fdot2_f32_bf16(__builtin_bit_cast(bf16x2_t, a), __builtin_bit_cast(bf16x2_t, b), acc, false); }

#define XB_TMO      128
#define XB_XCNT(j)  (256  + 64 * (j))
#define XB_XSUB(j)  (1280 + 64 * (j))
#define XB_XGEN(j)  (2304 + 64 * (j))
#define XB_TOP      3328
#define XB_TOPGEN   3392
#define XCD_BAR_WORDS 3456
#define XB_SPIN_CAP (1u << 18)

__device__ __forceinline__ unsigned xb_ld(unsigned* p)              { return __hip_atomic_load(p, __ATOMIC_RELAXED, __HIP_MEMORY_SCOPE_AGENT); }
__device__ __forceinline__ unsigned xb_add(unsigned* p, unsigned v) { return __hip_atomic_fetch_add(p, v, __ATOMIC_RELAXED, __HIP_MEMORY_SCOPE_AGENT); }
__device__ __forceinline__ unsigned xb_xcc_id() { return (unsigned)__builtin_amdgcn_s_getreg((3 << 11) | 20) & 0xFu; }
#define XB_SPIN(cond, bar) do { unsigned _sp = 0; while (cond) { __builtin_amdgcn_s_sleep(1); \
    if ((++_sp & 255u) == 0u) { if (xb_ld(&(bar)[XB_TMO])) break; if (_sp > XB_SPIN_CAP) { atomicAdd(&(bar)[XB_TMO], 1u); break; } } } } while (0)

struct XcdBarrier {
    unsigned* bar; unsigned x;
    volatile LAS unsigned* st;
};

__device__ __forceinline__ XcdBarrier xcd_barrier_post(unsigned* bar, volatile LAS unsigned* st) {
    XcdBarrier b; b.bar = bar; b.x = xb_xcc_id(); b.st = st;
    if (threadIdx.x == 0) (void)xb_add(&bar[XB_XCNT(b.x)], 1u);
    return b;
}
__device__ __forceinline__ void xcd_barrier_complete(unsigned* bar, unsigned x, unsigned& nloc, unsigned& nx) {
    const unsigned G = gridDim.x * gridDim.y * gridDim.z;
    unsigned sum, cnt, mine, sp = 0u;
    for (;;) {
        sum = 0u; cnt = 0u; mine = 0u;
#pragma unroll
        for (unsigned j = 0; j < 16; ++j) { const unsigned c = xb_ld(&bar[XB_XCNT(j)]); sum += c; cnt += (c > 0u) ? 1u : 0u; mine = (j == x) ? c : mine; }
        if (sum == G) break;
        __builtin_amdgcn_s_sleep(1);
        if ((++sp & 255u) == 0u) { if (xb_ld(&bar[XB_TMO])) break; if (sp > XB_SPIN_CAP) { atomicAdd(&bar[XB_TMO], 1u); break; } }
    }
    nloc = mine > 0u ? mine : 1u; nx = cnt > 0u ? cnt : 1u;
}

__device__ __forceinline__ void xcd_barrier(const XcdBarrier& b) {
    asm volatile("s_waitcnt vmcnt(0)" ::: "memory");
    __syncthreads();
    if (threadIdx.x == 0) {
        unsigned* bar = b.bar;
        __builtin_amdgcn_s_waitcnt(0);
        unsigned nloc = b.st[0], nx = b.st[1];
        if (nloc == 0u) { xcd_barrier_complete(bar, b.x, nloc, nx); b.st[0] = nloc; b.st[1] = nx; }
        const unsigned old = xb_add(&bar[XB_XSUB(b.x)], 1u);
        const unsigned gen = old / nloc;
        if (old + 1u == (gen + 1u) * nloc) {
            __builtin_amdgcn_fence(__ATOMIC_RELEASE, "agent");
            asm volatile("s_waitcnt vmcnt(0)" ::: "memory");
            const unsigned og = xb_add(&bar[XB_TOP], 1u);
            const unsigned tg = og / nx;
            if (og + 1u == (tg + 1u) * nx) xb_add(&bar[XB_TOPGEN], 1u);
            else XB_SPIN(xb_ld(&bar[XB_TOPGEN]) == tg, bar);
            __builtin_amdgcn_fence(__ATOMIC_ACQUIRE, "agent");
            xb_add(&bar[XB_XGEN(b.x)], 1u);
            asm volatile("s_waitcnt vmcnt(0)" ::: "memory");
        } else {
            XB_SPIN(xb_ld(&bar[XB_XGEN(b.x)]) == gen, bar);
            __builtin_amdgcn_fence(__ATOMIC_ACQUIRE, "agent");
            asm volatile("s_waitcnt vmcnt(0)" ::: "memory");
        }
    }
    __syncthreads();
}

struct Frame {
    LAS unsigned char* lds;
    __device__ __forceinline__ int wave_() const { int w = __builtin_amdgcn_readfirstlane((int)threadIdx.x >> 6); asm volatile("" : "+s"(w)); return w; }
    __device__ __forceinline__ int G_() const { int g = (int)gridDim.x; asm volatile("" : "+s"(g)); return g; }
    __device__ __forceinline__ int vcu_() const { int bx = (int)blockIdx.x; asm volatile("" : "+s"(bx)); const int g = G_(); return (g % 8 == 0) ? (bx % 8) * (g / 8) + bx / 8 : bx; }
    __device__ __forceinline__ int tid() const { int t = (int)threadIdx.x; asm volatile("" : "+v"(t)); return t; }
    __device__ __forceinline__ int lane() const { return tid() & 63; }
    __device__ __forceinline__ unsigned long long raw(int k) const { const volatile LAS unsigned* p = (const volatile LAS unsigned*)(lds + RING_BYTES) + 2 * k;
        const unsigned lo = __builtin_amdgcn_readfirstlane(p[0]), hi = __builtin_amdgcn_readfirstlane(p[1]); return ((unsigned long long)hi << 32) | lo; }
    __device__ __forceinline__ const float* in(int k) const { return (const float*)raw(k); }
    __device__ __forceinline__ float* outp() const { return (float*)raw(22); }
    template <class T> __device__ __forceinline__ T* ws(size_t off) const { return (T*)((unsigned char*)raw(23) + off); }
};
enum { I_X = 0, I_WIN, I_BGLU, I_CONVW, I_CONVB, I_CLNG, I_CLNB, I_LQ1, I_LK1, I_LQ2, I_LK2, I_SUBLN, I_RELB, I_WOUT, I_LN1G, I_LN1B, I_WQ, I_KEYS, I_U, I_V, I_LN2G, I_LN2B };

__device__ __forceinline__ void p0_transpose_item(const float* W, int K, int N, bf16* WT, int k0, int n0, int dst0, LAS float* scr, int lane) {
#pragma unroll 8
    for (int i = 0; i < 32; ++i) { const int kk = 2 * i + (lane >> 5); scr[kk * 33 + (lane & 31)] = W[(size_t)(k0 + kk) * N + n0 + (lane & 31)]; }
    LDS_WAIT(); asm volatile("" ::: "memory");
    const int c = lane & 7;
#pragma unroll
    for (int j = 0; j < 4; ++j) { const int n = (lane >> 3) + 8 * j; const LAS float* s = scr + (8 * c) * 33 + n;
        v4u o; o.x = pk2(s[0 * 33], s[1 * 33]); o.y = pk2(s[2 * 33], s[3 * 33]); o.z = pk2(s[4 * 33], s[5 * 33]); o.w = pk2(s[6 * 33], s[7 * 33]);
        *(GAS v4u*)(WT + (size_t)(dst0 + n) * K + k0 + 8 * c) = o; }
    LDS_WAIT(); asm volatile("" ::: "memory");
}
__device__ __forceinline__ void p0_convert(const float* src, bf16* dst, size_t n, int gw, int NGW, int lane) {
    const size_t nit = n / 512;
    for (size_t it = gw; it < nit; it += NGW) { const GAS f32x4* s = (const GAS f32x4*)(src + it * 512) + 2 * lane; const f32x4 a = s[0], b = s[1];
        v4u o; o.x = pk2(a.x, a.y); o.y = pk2(a.z, a.w); o.z = pk2(b.x, b.y); o.w = pk2(b.z, b.w); *((GAS v4u*)(dst + it * 512) + lane) = o; }
}
__device__ __forceinline__ unsigned pack_i8x4(float a, float b, float c, float d) {
    const int ia = (int)rintf(a), ib = (int)rintf(b), ic = (int)rintf(c), id = (int)rintf(d); return (unsigned)(ia & 255) | ((unsigned)(ib & 255) << 8) | ((unsigned)(ic & 255) << 16) | ((unsigned)id << 24); }
template <bool INT8> __device__ __forceinline__ void p0_quant_rows(const float* src, unsigned* dst8, float* scale, int rows, int gw, int NGW, int lane) {
    for (int r = gw; r < rows; r += NGW) {
        const GAS f32x4* sp = (const GAS f32x4*)(src + (size_t)r * D) + lane; f32x4 v[8]; float am = 0.f;
#pragma unroll
        for (int j = 0; j < 8; ++j) { v[j] = sp[64 * j]; am = fmaxf(fmaxf(am, fmaxf(fabsf(v[j].x), fabsf(v[j].y))), fmaxf(fabsf(v[j].z), fabsf(v[j].w))); }
#pragma unroll
        for (int o = 1; o < 64; o <<= 1) am = fmaxf(am, __shfl_xor(am, o));
        const float sc = am > 0.f ? am * (INT8 ? (1.f / 127.f) : (1.f / 440.f)) : 1.f, inv = 1.f / sc;
#pragma unroll
        for (int j = 0; j < 8; ++j) { int w;
            if (INT8) w = (int)pack_i8x4(v[j].x * inv, v[j].y * inv, v[j].z * inv, v[j].w * inv);
            else { w = __builtin_amdgcn_cvt_pk_fp8_f32(v[j].x * inv, v[j].y * inv, 0, false); w = __builtin_amdgcn_cvt_pk_fp8_f32(v[j].z * inv, v[j].w * inv, w, true); }
            const int wi = lane + 64 * j, c = wi >> 5; *((GAS unsigned*)dst8 + ((size_t)c * rows + r) * 32 + (wi & 31)) = (unsigned)w; }
        if (lane == 0) scale[r] = sc;
    }
}
__device__ __forceinline__ int t5_bucket(int d) {
    if (d < 16) return d;
    int l = 16 + (int)(logf((float)d / 16.f) / logf(8.f) * 16.f); return l < 31 ? l : 31;
}
__device__ __forceinline__ void p0_prologue(Frame& F) {
    const float* w_in = F.in(I_WIN); const float* w_out = F.in(I_WOUT); const float* peer_wq = F.in(I_WQ);
    bf16* Win_t = F.ws<bf16>(WS_WIN); bf16* Wout_t = F.ws<bf16>(WS_WOUT); bf16* Wq_t = F.ws<bf16>(WS_WQ);
    LAS float* scr = (LAS float*)(F.lds + F.wave_() * 16384);
    const int gw = F.vcu_() * NWAVES + F.wave_(), NGW = F.G_() * NWAVES;
    constexpr int I_IN = (D / 64) * (NPROJ / 32), I_OUT = (D / 64) * (D / 32), I_Q = I_OUT, NITEMS = I_IN + I_OUT + I_Q;
    for (int it = gw; it < NITEMS; it += NGW) {
        int r = it;
        if (r < I_IN) { const int nblk = NPROJ / 32, kb = r / nblk, nb = r % nblk, n0 = 32 * nb; int dst0 = n0;
            if (n0 >= 3072) { const int ch = (n0 - 3072) & 1023, gate = (n0 - 3072) >> 10; dst0 = 3072 + 256 * (ch >> 7) + 128 * gate + (ch & 127); }
            p0_transpose_item(w_in, D, NPROJ, Win_t, 64 * kb, n0, dst0, scr, F.lane()); continue; }
        r -= I_IN;
        if (r < I_OUT) { const int nblk = D / 32, kb = r / nblk, nb = r % nblk; p0_transpose_item(w_out, D, D, Wout_t, 64 * kb, 32 * nb, 32 * nb, scr, F.lane()); continue; }
        r -= I_OUT;
        { const int nblk = D / 32, kb = r / nblk, nb = r % nblk; p0_transpose_item(peer_wq, D, D, Wq_t, 64 * kb, 32 * nb, 32 * nb, scr, F.lane()); }
    }
    p0_convert(F.in(I_X), F.ws<bf16>(WS_XB), (size_t)M * D, gw, NGW, F.lane());
    p0_quant_rows<true>(F.in(I_U), F.ws<unsigned>(WS_U8), F.ws<float>(WS_SU), NEXP, gw, NGW, F.lane());
    p0_quant_rows<false>(F.in(I_V), F.ws<unsigned>(WS_V8), F.ws<float>(WS_SV), NEXP, gw, NGW, F.lane());
    p0_convert(F.in(I_KEYS), F.ws<bf16>(WS_KEYS), (size_t)PH * 2 * PNK * PHALF, gw, NGW, F.lane());
    if (blockIdx.x == 0) { const float* rel_bias = F.in(I_RELB); float* TAB = F.ws<float>(WS_TAB);
        for (int i = F.tid(); i < 8 * 128; i += NWAVES * 64) { const int h = i >> 7, d = i & 127;
            TAB[i] = (rel_bias[t5_bucket(d) * 8 + h] - rel_bias[31 * 8 + h]) * 1.4426950408889634f; } }
}

__device__ __forceinline__ float diff_lambda(Frame& F) {
    const float a = wave_sum(F.in(I_LQ1)[F.lane()] * F.in(I_LK1)[F.lane()]), b = wave_sum(F.in(I_LQ2)[F.lane()] * F.in(I_LK2)[F.lane()]);
    return expf(a) - expf(b) + LAMBDA_INIT;
}
__device__ __forceinline__ void p3_combine(Frame& F) {
    const float lam = diff_lambda(F);
    const float* subln_g = F.in(I_SUBLN); const bf16* O1 = F.ws<bf16>(WS_O1); const bf16* O2 = F.ws<bf16>(WS_O2); bf16* MIX = F.ws<bf16>(WS_XB);
    const int gw = F.vcu_() * NWAVES + F.wave_(), NGW = F.G_() * NWAVES;
    float g[16];
#pragma unroll
    for (int e = 0; e < 16; ++e) g[e] = subln_g[16 * (F.lane() & 7) + e] * (1.f - LAMBDA_INIT);
    for (int m = gw; m < M; m += NGW) {
        const GAS v4u* p1 = (const GAS v4u*)(O1 + (size_t)m * 1024) + 2 * F.lane(); const GAS v4u* p2 = (const GAS v4u*)(O2 + (size_t)m * 1024) + 2 * F.lane();
        const v4u a0 = p1[0], a1 = p1[1], b0 = p2[0], b1 = p2[1];
        const unsigned aw[8] = {a0.x, a0.y, a0.z, a0.w, a1.x, a1.y, a1.z, a1.w}, bw[8] = {b0.x, b0.y, b0.z, b0.w, b1.x, b1.y, b1.z, b1.w};
        float v[16]; float ss = 0.f;
#pragma unroll
        for (int i = 0; i < 8; ++i) { v[2 * i] = bflo(aw[i]) - lam * bflo(bw[i]); v[2 * i + 1] = bfhi(aw[i]) - lam * bfhi(bw[i]); ss += v[2 * i] * v[2 * i] + v[2 * i + 1] * v[2 * i + 1]; }
        ss += __shfl_xor(ss, 1); ss += __shfl_xor(ss, 2); ss += __shfl_xor(ss, 4);
        const float r = 1.f / sqrtf(ss * (1.f / 128.f) + LN_EPS);
        v4u o0, o1;
        o0.x = pk2(v[0] * r * g[0], v[1] * r * g[1]); o0.y = pk2(v[2] * r * g[2], v[3] * r * g[3]); o0.z = pk2(v[4] * r * g[4], v[5] * r * g[5]); o0.w = pk2(v[6] * r * g[6], v[7] * r * g[7]);
        o1.x = pk2(v[8] * r * g[8], v[9] * r * g[9]); o1.y = pk2(v[10] * r * g[10], v[11] * r * g[11]); o1.z = pk2(v[12] * r * g[12], v[13] * r * g[13]); o1.w = pk2(v[14] * r * g[14], v[15] * r * g[15]);
        GAS v4u* po = (GAS v4u*)(MIX + (size_t)m * D) + 2 * F.lane(); po[0] = o0; po[1] = o1;
    }
}
__device__ __forceinline__ void p3_conv(Frame& F) {
    constexpr int TT = 32, NR = TT + CONVW - 1, STATS_OFF = NR * 2048;
    const int tid = F.tid();
    const float* conv_w = F.in(I_CONVW); const bf16* H = F.ws<bf16>(WS_H); bf16* MIX = F.ws<bf16>(WS_XB);
    float w0[CONVW], w1[CONVW];
#pragma unroll
    for (int j = 0; j < CONVW; ++j) { const float2 w = *(const float2*)(conv_w + j * DCONV + 2 * tid); w0[j] = w.x; w1[j] = w.y; }
    const float2 cb = *(const float2*)(F.in(I_CONVB) + 2 * tid), lg = *(const float2*)(F.in(I_CLNG) + 2 * tid), lb = *(const float2*)(F.in(I_CLNB) + 2 * tid);
    LAS unsigned* tile = (LAS unsigned*)F.lds; LAS float* stats = (LAS float*)(F.lds + STATS_OFF);
    for (int tile_i = F.vcu_(); tile_i < M / TT; tile_i += F.G_()) {
        const int t0 = tile_i * TT, s0 = t0 & (SEQ - 1);
        for (int r = tid >> 7; r < NR; r += 4) { const int sp = s0 - (CONVW - 1) + r; v4u val = (v4u){0u, 0u, 0u, 0u};
            if (sp >= 0) val = *((const GAS v4u*)(H + (size_t)(t0 - (CONVW - 1) + r) * 1024) + (tid & 127));
            *(LAS v4u*)(F.lds + r * 2048 + (tid & 127) * 16) = val; }
        __syncthreads();
        for (int i = 0; i < TT; ++i) {
            float a0 = cb.x, a1 = cb.y;
#pragma unroll
            for (int j = 0; j < CONVW; ++j) { const unsigned wv = tile[(i + j) * 512 + tid]; a0 += w0[j] * bflo(wv); a1 += w1[j] * bfhi(wv); }
            const unsigned pk = pk2(a0, a1); tile[i * 512 + tid] = pk;
            const float r0 = bflo(pk), r1 = bfhi(pk);
            const float s = wave_sum(r0 + r1), q = wave_sum(r0 * r0 + r1 * r1);
            if (F.lane() == 0) { stats[(i * 8 + F.wave_()) * 2] = s; stats[(i * 8 + F.wave_()) * 2 + 1] = q; }
        }
        __syncthreads();
        for (int i = 0; i < TT; ++i) {
            float s = 0.f, q = 0.f;
#pragma unroll
            for (int w = 0; w < 8; ++w) { s += stats[(i * 8 + w) * 2]; q += stats[(i * 8 + w) * 2 + 1]; }
            const float mean = s * (1.f / DCONV), var = fmaxf(q * (1.f / DCONV) - mean * mean, 0.f), rstd = 1.f / sqrtf(var + LN_EPS);
            const unsigned pk = tile[i * 512 + tid];
            const float y0 = (bflo(pk) - mean) * rstd * lg.x + lb.x, y1 = (bfhi(pk) - mean) * rstd * lg.y + lb.y;
            const float z0 = y0 * __builtin_amdgcn_rcpf(1.f + __builtin_amdgcn_exp2f(-1.4426950409f * y0)), z1 = y1 * __builtin_amdgcn_rcpf(1.f + __builtin_amdgcn_exp2f(-1.4426950409f * y1));
            *((GAS unsigned*)(MIX + (size_t)(t0 + i) * D + DATT) + tid) = pk2(z0, z1);
        }
        __syncthreads();
    }
}
__device__ __forceinline__ void p5_ln1(Frame& F) {
    bf16* Y1 = F.ws<bf16>(WS_Y1); const float* ln1_g = F.in(I_LN1G); const float* ln1_b = F.in(I_LN1B); unsigned char* X8 = F.ws<unsigned char>(WS_X8); float* SX = F.ws<float>(WS_SX);
    const int gw = F.vcu_() * NWAVES + F.wave_(), NGW = F.G_() * NWAVES;
    for (int m = gw; m < M; m += NGW) {
        GAS v4u* p = (GAS v4u*)(Y1 + (size_t)m * D) + F.lane();
        v4u w[4]; float v[32]; float s = 0.f;
#pragma unroll
        for (int j = 0; j < 4; ++j) { w[j] = p[64 * j]; const unsigned ww[4] = {w[j].x, w[j].y, w[j].z, w[j].w};
#pragma unroll
            for (int i = 0; i < 4; ++i) { v[8 * j + 2 * i] = bflo(ww[i]); v[8 * j + 2 * i + 1] = bfhi(ww[i]); s += v[8 * j + 2 * i] + v[8 * j + 2 * i + 1]; } }
        const float mean = wave_sum(s) * (1.f / D); float q = 0.f;
#pragma unroll
        for (int i = 0; i < 32; ++i) { v[i] -= mean; q += v[i] * v[i]; }
        const float rstd = 1.f / sqrtf(wave_sum(q) * (1.f / D) + LN_EPS);
#pragma unroll
        for (int j = 0; j < 4; ++j) { const int c0 = 8 * F.lane() + 512 * j; const f32x4 g0 = *(const f32x4*)(ln1_g + c0), g1 = *(const f32x4*)(ln1_g + c0 + 4), b0 = *(const f32x4*)(ln1_b + c0), b1 = *(const f32x4*)(ln1_b + c0 + 4);
            v4u o; o.x = pk2(v[8 * j] * rstd * g0[0] + b0[0], v[8 * j + 1] * rstd * g0[1] + b0[1]); o.y = pk2(v[8 * j + 2] * rstd * g0[2] + b0[2], v[8 * j + 3] * rstd * g0[3] + b0[3]);
            o.z = pk2(v[8 * j + 4] * rstd * g1[0] + b1[0], v[8 * j + 5] * rstd * g1[1] + b1[1]); o.w = pk2(v[8 * j + 6] * rstd * g1[2] + b1[2], v[8 * j + 7] * rstd * g1[3] + b1[3]);
            p[64 * j] = o; }
        float am = 0.f;
#pragma unroll
        for (int j = 0; j < 4; ++j) { const int c0 = 8 * F.lane() + 512 * j; const f32x4 g0 = *(const f32x4*)(ln1_g + c0), g1 = *(const f32x4*)(ln1_g + c0 + 4), b0 = *(const f32x4*)(ln1_b + c0), b1 = *(const f32x4*)(ln1_b + c0 + 4);
#pragma unroll
            for (int i = 0; i < 4; ++i) { v[8 * j + i] = v[8 * j + i] * rstd * g0[i] + b0[i]; v[8 * j + 4 + i] = v[8 * j + 4 + i] * rstd * g1[i] + b1[i]; am = fmaxf(am, fmaxf(fabsf(v[8 * j + i]), fabsf(v[8 * j + 4 + i]))); } }
#pragma unroll
        for (int o = 1; o < 64; o <<= 1) am = fmaxf(am, __shfl_xor(am, o));
        const float sc = am > 0.f ? am * (1.f / 127.f) : 1.f, inv = 1.f / sc;
        GAS v2u* p8 = (GAS v2u*)(X8 + (size_t)m * D) + F.lane();
#pragma unroll
        for (int j = 0; j < 4; ++j) p8[64 * j] = (v2u){pack_i8x4(v[8 * j] * inv, v[8 * j + 1] * inv, v[8 * j + 2] * inv, v[8 * j + 3] * inv), pack_i8x4(v[8 * j + 4] * inv, v[8 * j + 5] * inv, v[8 * j + 6] * inv, v[8 * j + 7] * inv)};
        if (F.lane() == 0) SX[m] = sc;
    }
}
__device__ __forceinline__ int f2key(float f) { const int b = __float_as_int(f); return b ^ ((b >> 31) & 0x7fffffff); }
__device__ __forceinline__ float key2f(int k) { return __int_as_float(k ^ ((k >> 31) & 0x7fffffff)); }
#define CE_DESC(a, b) do { const int _x = max(a, b), _y = min(a, b); a = _x; b = _y; } while (0)
#define CE_ASC(a, b)  do { const int _x = min(a, b), _y = max(a, b); a = _x; b = _y; } while (0)
template <int N> __device__ __forceinline__ void sort_desc(int (&v)[N]) {
#pragma unroll
    for (int k = 2; k <= N; k <<= 1)
#pragma unroll
        for (int j = k >> 1; j > 0; j >>= 1)
#pragma unroll
            for (int i = 0; i < N; ++i) { const int l = i ^ j; if (l > i) { if ((i & k) == 0) CE_DESC(v[i], v[l]); else CE_ASC(v[i], v[l]); } }
}
template <int N> __device__ __forceinline__ void bitonic_merge_desc(int (&v)[N]) {
#pragma unroll
    for (int j = N >> 1; j > 0; j >>= 1)
#pragma unroll
        for (int i = 0; i < N; ++i) { const int l = i ^ j; if (l > i) CE_DESC(v[i], v[l]); }
}
__device__ __forceinline__ void merge16(const int (&a)[16], const int (&b)[16], int (&o)[16]) {
#pragma unroll
    for (int i = 0; i < 16; ++i) o[i] = max(a[i], b[15 - i]);
    bitonic_merge_desc<16>(o);
}
__device__ __forceinline__ void top16_of_64(const int (&v)[64], int (&o)[16]) {
    int g0[16], g1[16], g2[16], g3[16];
#pragma unroll
    for (int i = 0; i < 16; ++i) { g0[i] = v[i]; g1[i] = v[16 + i]; g2[i] = v[32 + i]; g3[i] = v[48 + i]; }
    sort_desc<16>(g0); sort_desc<16>(g1); sort_desc<16>(g2); sort_desc<16>(g3);
    int m0[16], m1[16]; merge16(g0, g1, m0); merge16(g2, g3, m1); merge16(m0, m1, o);
}
__device__ __forceinline__ void peer_subkey_top16(const bf16* qrow  , const bf16* keys_hc  , int r32, int hi, int (&o)[16]) {
    bf16x8 bq[8];
    asm volatile("" : "+v"(qrow));
#pragma unroll
    for (int s = 0; s < 8; ++s) bq[s] = *(const bf16x8*)(qrow + 8 * s);
    int run[16];
#pragma unroll
    for (int mt = 0; mt < 4; ++mt) {
        const bf16* krow = keys_hc + (size_t)(32 * mt + r32) * PHALF + hi * 64;
        asm volatile("" : "+v"(krow));
        bf16x8 ka[8];
#pragma unroll
        for (int s = 0; s < 8; ++s) ka[s] = *(const bf16x8*)(krow + 8 * s);
        asm volatile("" ::: "memory");
        f32x16 acc = {};
#pragma unroll
        for (int s = 0; s < 8; ++s) acc = __builtin_amdgcn_mfma_f32_32x32x16_bf16(ka[s], bq[s], acc, 0, 0, 0);
        int g[16];
#pragma unroll
        for (int r = 0; r < 16; ++r) g[r] = (f2key(acc[r]) & ~127) | (32 * mt + (r & 3) + 8 * (r >> 2));
        sort_desc<16>(g);
        if (mt == 0) {
#pragma unroll
            for (int r = 0; r < 16; ++r) run[r] = g[r];
        } else { int t2[16]; merge16(run, g, t2);
#pragma unroll
            for (int r = 0; r < 16; ++r) run[r] = t2[r]; }
    }
    int lo[16], hh[16]; const int hi4 = 4 * hi;
#pragma unroll
    for (int i = 0; i < 16; ++i) { run[i] |= hi4; auto rr = __builtin_amdgcn_permlane32_swap((unsigned)run[i], (unsigned)run[i], false, false); lo[i] = (int)rr[0]; hh[i] = (int)rr[1]; }
    merge16(lo, hh, o);
}
__device__ __forceinline__ float gelu_erf(float v) { return 0.5f * v * (1.f + erff(v * 0.70710678118654752f)); }

template <int CTRL> __device__ __forceinline__ int dppi(int v) { return __builtin_amdgcn_update_dpp(0, v, CTRL, 0xf, 0xf, true); }
template <int CTRL> __device__ __forceinline__ float dppf(float v) { return __int_as_float(__builtin_amdgcn_update_dpp(0, __float_as_int(v), CTRL, 0xf, 0xf, true)); }
typedef float f32x2 __attribute__((ext_vector_type(2)));
constexpr int P7_ACT = 0, P7_EID = 65536, P7_SCR = 0  , P7_SCR_WAVE = 32 * 33 * 4, PCH = 128, NCH = D / PCH;
static_assert(P7_SCR + NWAVES * P7_SCR_WAVE <= P7_EID && P7_EID + 128 * 128 * 2 <= RING_BYTES, "PEER LDS map");

__device__ __forceinline__ void p7_peer(Frame& F) {
    const int lane = F.lane(), r32 = lane & 31, hi = lane >> 5, j8 = lane & 7, g8 = lane >> 3;
    constexpr int TPB = 128;
    LAS float* ACT = (LAS float*)(F.lds + P7_ACT); LAS unsigned short* EIDL = (LAS unsigned short*)(F.lds + P7_EID);
    LAS int* scr = (LAS int*)(F.lds + P7_SCR + F.wave_() * P7_SCR_WAVE);
    for (int blk = F.vcu_(); blk < M / TPB; blk += F.G_()) {
        const int m0 = blk * TPB;
        { const int h = F.wave_(); const bf16* QP = F.ws<bf16>(WS_QP); const bf16* KEYS = F.ws<bf16>(WS_KEYS); float* GATE = F.ws<float>(WS_GATE);
          for (int tt = 0; tt < 4; ++tt) {
            const int tl = 32 * tt + r32, tok = m0 + tl;
            const bf16* qrow = QP + (size_t)tok * D + h * 256 + hi * 64;
            int s1[16], s2[16];
            peer_subkey_top16(qrow, KEYS + (size_t)(h * 2 + 0) * PNK * PHALF, r32, hi, s1);
            asm volatile("" ::: "memory");
            peer_subkey_top16(qrow + 128, KEYS + (size_t)(h * 2 + 1) * PNK * PHALF, r32, hi, s2);
            float f1[16], f2[16];
#pragma unroll
            for (int i = 0; i < 16; ++i) { f1[i] = key2f(s1[i]); f2[i] = key2f(s2[i]); }
            if (hi == 0) {
#pragma unroll
                for (int i = 0; i < 16; ++i) { scr[r32 * 33 + i] = s1[i] & 127; scr[r32 * 33 + 16 + i] = s2[i] & 127; } }
            int cand[64];
            {
#define PC(n_, i_, j_) cand[n_] = (f2key(f1[i_] + f2[j_]) & ~255) | ((i_) * 16 + (j_))
                PC(0,0,0); PC(1,0,1); PC(2,0,2); PC(3,0,3); PC(4,0,4); PC(5,0,5); PC(6,0,6); PC(7,0,7); PC(8,0,8); PC(9,0,9); PC(10,0,10); PC(11,0,11); PC(12,0,12); PC(13,0,13); PC(14,0,14); PC(15,0,15);
                PC(16,1,0); PC(17,1,1); PC(18,1,2); PC(19,1,3); PC(20,1,4); PC(21,1,5); PC(22,1,6); PC(23,1,7);
                PC(24,2,0); PC(25,2,1); PC(26,2,2); PC(27,2,3); PC(28,2,4);
                PC(29,3,0); PC(30,3,1); PC(31,3,2); PC(32,3,3);
                PC(33,4,0); PC(34,4,1); PC(35,4,2);
                PC(36,5,0); PC(37,5,1); PC(38,6,0); PC(39,6,1); PC(40,7,0); PC(41,7,1);
                PC(42,8,0); PC(43,9,0); PC(44,10,0); PC(45,11,0); PC(46,12,0); PC(47,13,0); PC(48,14,0); PC(49,15,0);
#undef PC
            }
#pragma unroll
            for (int i = 50; i < 64; ++i) cand[i] = (int)0x80000000;
            int sc[16]; top16_of_64(cand, sc);
            float p[16]; const float mx = key2f(sc[0]); float z = 0.f;
#pragma unroll
            for (int k = 0; k < 16; ++k) { p[k] = __expf(key2f(sc[k]) - mx); z += p[k]; }
            const float rz = 1.f / z;
            LDS_WAIT();
            int eo[8]; float go[8]; const int him = -hi;
#pragma unroll
            for (int kk = 0; kk < 8; ++kk) { const int tag = ((sc[kk] & ~him) | (sc[8 + kk] & him)) & 255;
                const int i1 = scr[r32 * 33 + (tag >> 4)], i2 = scr[r32 * 33 + 16 + (tag & 15)];
                eo[kk] = i1 * PNK + i2; go[kk] = __int_as_float((__float_as_int(p[kk]) & ~him) | (__float_as_int(p[8 + kk]) & him)) * rz; }
            *(LAS v4u*)(EIDL + tl * 128 + h * 16 + 8 * hi) = (v4u){(unsigned)(eo[0] | (eo[1] << 16)), (unsigned)(eo[2] | (eo[3] << 16)), (unsigned)(eo[4] | (eo[5] << 16)), (unsigned)(eo[6] | (eo[7] << 16))};
            GAS float* gp = (GAS float*)(GATE + (size_t)tok * 128 + h * 16 + 8 * hi);
            *(GAS f32x4*)gp = (f32x4){go[0], go[1], go[2], go[3]}; *(GAS f32x4*)(gp + 4) = (f32x4){go[4], go[5], go[6], go[7]};
            LDS_WAIT();
          } }
        __threadfence_block(); __syncthreads();
        const int tw = F.wave_() * (TPB / NWAVES);
        for (int i = lane; i < (TPB / NWAVES) * 128; i += 64) ACT[tw * 128 + i] = 0.f;
        { const unsigned char* X8 = F.ws<unsigned char>(WS_X8); const unsigned char* U8 = F.ws<unsigned char>(WS_U8);
#define U_ISSUE(n_, PC, XQ) do { const int c_ = (n_) >> 4, tl_ = tw + ((n_) & 15); \
            XQ = *(const GAS v4u*)(X8 + (size_t)(m0 + tl_) * D + c_ * PCH + 16 * j8); \
            const LAS unsigned short* ep_ = EIDL + tl_ * 128 + g8; const unsigned char* ub_ = U8 + (size_t)c_ * (NEXP * PCH) + 16 * j8; \
            _Pragma("unroll") for (int i = 0; i < 16; ++i) { const unsigned e_ = ep_[8 * i]; PC[i] = *(const GAS v4u*)(ub_ + e_ * PCH); } } while (0)
#define U_COMPUTE(n_, PC, XQ) do { const int tl_ = tw + ((n_) & 15); \
            int pp_[16]; \
            _Pragma("unroll") for (int i = 0; i < 16; ++i) { int a_ = __builtin_amdgcn_sdot4((int)PC[i].x, (int)XQ.x, 0, false); a_ = __builtin_amdgcn_sdot4((int)PC[i].y, (int)XQ.y, a_, false); \
                a_ = __builtin_amdgcn_sdot4((int)PC[i].z, (int)XQ.z, a_, false); pp_[i] = __builtin_amdgcn_sdot4((int)PC[i].w, (int)XQ.w, a_, false); } \
              \
            int q8_[8], q4_[4], q2_[2]; \
            { const bool b2_ = lane & 4; _Pragma("unroll") for (int i = 0; i < 8; ++i) { const int k_ = b2_ ? pp_[2 * i + 1] : pp_[2 * i], s_ = b2_ ? pp_[2 * i] : pp_[2 * i + 1]; q8_[i] = k_ + dppi<0x141>(s_); } } \
            { const bool b1_ = lane & 2; _Pragma("unroll") for (int i = 0; i < 4; ++i) { const int k_ = b1_ ? q8_[2 * i + 1] : q8_[2 * i], s_ = b1_ ? q8_[2 * i] : q8_[2 * i + 1]; q4_[i] = k_ + dppi<0x4E>(s_); } } \
            { const bool b0_ = lane & 1; _Pragma("unroll") for (int i = 0; i < 2; ++i) { const int k_ = b0_ ? q4_[2 * i + 1] : q4_[2 * i], s_ = b0_ ? q4_[2 * i] : q4_[2 * i + 1]; q2_[i] = k_ + dppi<0xB1>(s_); } } \
            const int irow_ = ((lane & 1) << 2) | (lane & 2) | ((lane >> 2) & 1); \
            LAS float* ap_ = ACT + tl_ * 128 + 8 * irow_ + g8; ap_[0] += (float)q2_[0]; ap_[64] += (float)q2_[1]; } while (0)
          constexpr int NSTEP = NCH * (TPB / NWAVES);
          v4u pcA[16], pcB[16], xqA, xqB;
          U_ISSUE(0, pcA, xqA);
          for (int n = 0; n < NSTEP; n += 2) {
              U_ISSUE(n + 1, pcB, xqB); __builtin_amdgcn_sched_barrier(0);
              U_COMPUTE(n, pcA, xqA); __builtin_amdgcn_sched_barrier(0);
              { const int nn = (n + 2 < NSTEP) ? n + 2 : n; U_ISSUE(nn, pcA, xqA); }
              __builtin_amdgcn_sched_barrier(0);
              U_COMPUTE(n + 1, pcB, xqB); __builtin_amdgcn_sched_barrier(0);
          }
#undef U_ISSUE
#undef U_COMPUTE
        }
        LDS_WAIT();
        { const float* SU = F.ws<float>(WS_SU); const float* SV = F.ws<float>(WS_SV); const float* GATE = F.ws<float>(WS_GATE); const float* SX = F.ws<float>(WS_SX);
        for (int ti = 0; ti < TPB / NWAVES; ++ti) {
            const int tl = tw + ti, t = m0 + tl; const float sx = SX[t];
#pragma unroll
            for (int kq = 0; kq < 2; ++kq) { const int k = lane + 64 * kq; const unsigned e = EIDL[tl * 128 + k]; const float a = ACT[tl * 128 + k] * SU[e] * sx;
                ACT[tl * 128 + k] = __builtin_nontemporal_load(GATE + (size_t)t * 128 + k) * gelu_erf(a) * SV[e]; }
        } }
        LDS_WAIT();
        { const bf16* X1 = F.ws<bf16>(WS_Y1); const unsigned char* V8 = F.ws<unsigned char>(WS_V8); float* outp = F.outp();
#define V_ISSUE(n_, PC, WK, XP) do { const int c_ = (n_) >> 4, tl_ = tw + ((n_) & 15); \
            const LAS unsigned short* ep_ = EIDL + tl_ * 128 + g8; const LAS float* wp_ = ACT + tl_ * 128 + g8; const unsigned char* vb_ = V8 + (size_t)c_ * (NEXP * PCH) + 16 * j8; \
            _Pragma("unroll") for (int i = 0; i < 16; ++i) { const unsigned e_ = ep_[8 * i]; WK[i] = wp_[8 * i]; PC[i] = *(const GAS v4u*)(vb_ + e_ * PCH); } \
            XP = *(const GAS unsigned*)(X1 + (size_t)(m0 + tl_) * D + c_ * PCH + 16 * j8 + 2 * g8); } while (0)
#define V_COMPUTE(n_, PC, WK, XP) do { const int c_ = (n_) >> 4, tl_ = tw + ((n_) & 15); \
            f32x2 acc_[8]; \
            _Pragma("unroll") for (int d = 0; d < 8; ++d) acc_[d] = (f32x2){0.f, 0.f}; \
            _Pragma("unroll") for (int i = 0; i < 16; ++i) { const unsigned w4_[4] = {PC[i].x, PC[i].y, PC[i].z, PC[i].w}; const f32x2 w2_ = {WK[i], WK[i]}; \
                _Pragma("unroll") for (int d = 0; d < 4; ++d) { acc_[2 * d] = __builtin_amdgcn_cvt_pk_f32_fp8((int)w4_[d], false) * w2_ + acc_[2 * d]; acc_[2 * d + 1] = __builtin_amdgcn_cvt_pk_f32_fp8((int)w4_[d], true) * w2_ + acc_[2 * d + 1]; } } \
              \
            float a16_[16]; \
            _Pragma("unroll") for (int d = 0; d < 8; ++d) { a16_[2 * d] = acc_[d].x; a16_[2 * d + 1] = acc_[d].y; } \
            float r8_[8], r4_[4], r2_[2]; \
            _Pragma("unroll") for (int i = 0; i < 8; ++i) { auto rr_ = __builtin_amdgcn_permlane32_swap(__float_as_uint(a16_[i]), __float_as_uint(a16_[i + 8]), false, false); r8_[i] = __uint_as_float(rr_[0]) + __uint_as_float(rr_[1]); } \
            _Pragma("unroll") for (int i = 0; i < 4; ++i) { auto rr_ = __builtin_amdgcn_permlane16_swap(__float_as_uint(r8_[i]), __float_as_uint(r8_[i + 4]), false, false); r4_[i] = __uint_as_float(rr_[0]) + __uint_as_float(rr_[1]); } \
            { const bool b3_ = lane & 8; _Pragma("unroll") for (int i = 0; i < 2; ++i) { const float k_ = b3_ ? r4_[i + 2] : r4_[i], s_ = b3_ ? r4_[i] : r4_[i + 2]; r2_[i] = k_ + dppf<0x128>(s_); } } \
            GAS f32x2* op_ = (GAS f32x2*)(outp + (size_t)(m0 + tl_) * D + c_ * PCH + 16 * j8 + 2 * g8); \
            *op_ = (f32x2){r2_[0] + DN_ALPHA * bflo(XP), r2_[1] + DN_ALPHA * bfhi(XP)}; } while (0)
          constexpr int NSTEP = NCH * (TPB / NWAVES);
          v4u pcA[16], pcB[16]; float wkA[16], wkB[16]; unsigned xpA, xpB;
          V_ISSUE(0, pcA, wkA, xpA);
          for (int n = 0; n < NSTEP; n += 2) {
              V_ISSUE(n + 1, pcB, wkB, xpB); __builtin_amdgcn_sched_barrier(0);
              V_COMPUTE(n, pcA, wkA, xpA); __builtin_amdgcn_sched_barrier(0);
              { const int nn = (n + 2 < NSTEP) ? n + 2 : n; V_ISSUE(nn, pcA, wkA, xpA); }
              __builtin_amdgcn_sched_barrier(0);
              V_COMPUTE(n + 1, pcB, wkB, xpB); __builtin_amdgcn_sched_barrier(0);
          }
#undef V_ISSUE
#undef V_COMPUTE
        }
        { const float* ln2_g = F.in(I_LN2G); const float* ln2_b = F.in(I_LN2B); float* outp = F.outp();
        for (int ti = 0; ti < TPB / NWAVES; ++ti) {
            const int t = m0 + tw + ti;
            GAS f32x4* rp = (GAS f32x4*)(outp + (size_t)t * D) + 2 * lane;
            f32x4 v[8]; float s = 0.f;
#pragma unroll
            for (int j = 0; j < 4; ++j) { v[2 * j] = rp[128 * j]; v[2 * j + 1] = rp[128 * j + 1]; }
#pragma unroll
            for (int j = 0; j < 8; ++j) s += (v[j].x + v[j].y) + (v[j].z + v[j].w);
            const float mean = wave_sum(s) * (1.f / D); float qv = 0.f;
#pragma unroll
            for (int j = 0; j < 8; ++j) { v[j] = v[j] - mean; qv += (v[j].x * v[j].x + v[j].y * v[j].y) + (v[j].z * v[j].z + v[j].w * v[j].w); }
            const float rstd = 1.f / sqrtf(wave_sum(qv) * (1.f / D) + LN_EPS);
#pragma unroll
            for (int j = 0; j < 4; ++j) { const int c0 = 8 * lane + 512 * j; const f32x4 g0 = *(const f32x4*)(ln2_g + c0), g1 = *(const f32x4*)(ln2_g + c0 + 4), b0 = *(const f32x4*)(ln2_b + c0), b1 = *(const f32x4*)(ln2_b + c0 + 4);
                rp[128 * j] = v[2 * j] * rstd * g0 + b0; rp[128 * j + 1] = v[2 * j + 1] * rstd * g1 + b1; }
        } }
        __syncthreads();
    }
}

struct Args { const float* in[22]; float* out; unsigned char* ws; int ph_lo, ph_hi; };
__global__ void __launch_bounds__(NWAVES * 64, 2) mk_fwd(Args args) {
    extern __shared__ __attribute__((aligned(16))) unsigned char lds[];
    cg::grid_group grid = cg::this_grid();
    Frame F;
    F.lds = (LAS unsigned char*)lds;
    if (threadIdx.x == 0) { LAS unsigned long long* PT = (LAS unsigned long long*)(F.lds + RING_BYTES);
#pragma unroll
        for (int k = 0; k < 22; ++k) PT[k] = (unsigned long long)args.in[k];
        PT[22] = (unsigned long long)args.out; PT[23] = (unsigned long long)args.ws;
        ((LAS unsigned*)(F.lds + RING_BYTES + 256))[0] = 0u; ((LAS unsigned*)(F.lds + RING_BYTES + 256))[1] = 0u; }
    __syncthreads();
    const int lo = args.ph_lo, hi = args.ph_hi;
#ifndef PHASE_MASK
#define PHASE_MASK 255
#endif
#define IN(k) (((PHASE_MASK >> (k)) & 1) && lo <= (k) && (k) < hi)
#ifndef REPEAT_PHASE
#define REPEAT_PHASE -1
#endif
#define REP(k) for (int rep_ = 0; rep_ < ((REPEAT_PHASE == (k)) ? 2 : 1); ++rep_)
    (void)xcd_barrier_post((unsigned*)args.ws, (volatile LAS unsigned*)(F.lds + RING_BYTES + 256));
#define SEAM(k) do { if (IN(k) && IN((k) + 1)) { if ((k) == 0) grid.sync(); else { XcdBarrier bar_; bar_.bar = F.ws<unsigned>(0); bar_.x = xb_xcc_id(); bar_.st = (volatile LAS unsigned*)(F.lds + RING_BYTES + 256); xcd_barrier(bar_); } } } while (0)

    if (IN(0)) REP(0) { p0_prologue(F); } SEAM(0);
    if (IN(1)) REP(1) {
        pg8::Gemm g{F.ws<bf16>(WS_XB), F.ws<bf16>(WS_WIN), M, NPROJ, D}; pg8::StaticOrder S; S.init(M, NPROJ, F.G_(), (int)blockIdx.x);
        pg8::EpiProj E{F.ws<bf16>(WS_Q), (size_t)(WS_K - WS_Q) / 2, attn_body::C2, F.ws<bf16>(WS_H), F.in(I_BGLU)};
        pg8::gemm_phase<pg8::EpiProj, pg8::StaticOrder, PG8_ALIGN, PG8_SP2>(F.lds, g, S, E);
    } SEAM(1);
    if (IN(2)) REP(2) {
        static_assert(attn_body::ATTN_LDS_BYTES <= RING_BYTES && attn_body::ATTN_PITCH == DATT, "attention body geometry vs frame");
        const attn_body::AttnTensors AT{F.ws<const attn_body::bf16>(WS_Q), F.ws<const attn_body::bf16>(WS_K), F.ws<const attn_body::bf16>(WS_V), F.ws<attn_body::bf16>(WS_O1), F.ws<attn_body::bf16>(WS_O2), F.ws<const float>(WS_TAB)};
        const attn_body::StaticOrder S((int)F.G_(), (int)blockIdx.x);
        attn_body::attn_phase<attn_body::StaticOrder>((char*)lds, AT, S);
    } SEAM(2);
    if (IN(3)) REP(3) { p3_combine(F); p3_conv(F); } SEAM(3);
    if (IN(4)) REP(4) {
        pg8::Gemm g{F.ws<bf16>(WS_XB), F.ws<bf16>(WS_WOUT), M, D, D}; pg8::StaticOrder S; S.init(M, D, F.G_(), (int)blockIdx.x);
        pg8::EpiRes E{F.in(I_X), F.ws<bf16>(WS_Y1), D, DN_ALPHA};
        pg8::gemm_phase<pg8::EpiRes, pg8::StaticOrder, PG8_ALIGN, PG8_SP2>(F.lds, g, S, E);
    } SEAM(4);
    if (IN(5)) REP(5) { p5_ln1(F); } SEAM(5);
    if (IN(6)) REP(6) {
        pg8::Gemm g{F.ws<bf16>(WS_Y1), F.ws<bf16>(WS_WQ), M, D, D}; pg8::StaticOrder S; S.init(M, D, F.G_(), (int)blockIdx.x);
        pg8::EpiPlain E{F.ws<bf16>(WS_QP), D};
        pg8::gemm_phase<pg8::EpiPlain, pg8::StaticOrder, PG8_ALIGN, PG8_SP2>(F.lds, g, S, E);
    } SEAM(6);
    if (IN(7)) REP(7) { p7_peer(F); }
#undef IN
#undef SEAM
}

extern "C" void kernel_launch(void* const* d_in, const int* in_sizes, int n_in, void* d_out, int out_size, void* d_ws, size_t ws_size, hipStream_t stream) {
    static int grid = 0;
    if (grid == 0) {
        if (n_in != 22 || in_sizes[0] != M * D || out_size != M * D || ws_size < WS_END) { fprintf(stderr, "kernel_launch: unexpected shapes (n_in %d, in0 %d, out %d, ws %zu); nothing launched\n", n_in, n_in > 0 ? in_sizes[0] : -1, out_size, ws_size); grid = -1; return; }
        int dev = 0, cus = 0, per_cu = 0;
        if (hipGetDevice(&dev) != hipSuccess || hipDeviceGetAttribute(&cus, hipDeviceAttributeMultiprocessorCount, dev) != hipSuccess) { grid = -1; return; }
        if (hipFuncSetAttribute((const void*)mk_fwd, hipFuncAttributeMaxDynamicSharedMemorySize, LDS_BYTES) != hipSuccess) { fprintf(stderr, "kernel_launch: hipFuncSetAttribute failed\n"); grid = -1; return; }
        if (hipOccupancyMaxActiveBlocksPerMultiprocessor(&per_cu, (const void*)mk_fwd, NWAVES * 64, LDS_BYTES) != hipSuccess || per_cu < 1) { fprintf(stderr, "kernel_launch: occupancy query reports %d workgroups per CU\n", per_cu); (void)hipGetLastError(); grid = -1; return; }
        grid = cus;
        if (grid > 256) grid = 256;
    }
    if (grid < 0) return;
    if (hipMemsetAsync(d_ws, 0, 16384, stream) != hipSuccess) { fprintf(stderr, "kernel_launch: hipMemsetAsync failed\n"); return; }
    Args a{};
    for (int i = 0; i < 22; ++i) a.in[i] = (const float*)d_in[i];
    a.out = (float*)d_out; a.ws = (unsigned char*)d_ws;
    constexpr int NL = MK_N_LAUNCHES;
    for (int li = 0; li < NL; ++li) {
        a.ph_lo = (NL == 1) ? 0 : li; a.ph_hi = (NL == 1) ? N_PHASES : li + 1;
        void* kargs[] = {&a};
        const hipError_t le = hipLaunchCooperativeKernel((const void*)mk_fwd, dim3(grid), dim3(NWAVES * 64), kargs, LDS_BYTES, stream);
        if (le != hipSuccess) { fprintf(stderr, "kernel_launch: cooperative launch %d failed: %s (grid %d)\n", li, hipGetErrorString(le), grid); break; }
    }
}
```

```cpp
#include <hip/hip_runtime.h>
#include <hip/hip_cooperative_groups.h>
#include <cstdio>
#include <cstdint>
namespace cg = cooperative_groups;
namespace pg8 {
#define PG8_LAS __attribute__((address_space(3)))
typedef unsigned short bf16_t;
typedef short bf16x8 __attribute__((ext_vector_type(8)));
typedef float f32x4 __attribute__((ext_vector_type(4)));
typedef unsigned u32x4 __attribute__((ext_vector_type(4)));
typedef int i32x4 __attribute__((ext_vector_type(4)));
constexpr int BM = 256, BK = 64, HALF = 128, HTB = HALF * BK * 2  , STAGE_BYTES = 8 * HTB, NXCD = 8, WGM = 8;

__host__ __device__ __forceinline__ int lds_byte(int r, int c) { const int st = (r >> 4) * 2 + (c >> 5), rr = r & 15, cc = c & 31, ob = rr * 64 + cc * 2; return st * 1024 + (ob ^ (((ob >> 9) & 1) << 5)); }
__host__ __device__ __forceinline__ void stage_rc(int b, int& R, int& C) { const int st = b / 1024, sb = b % 1024, swz = sb ^ (((sb >> 9) & 1) << 5); R = (st >> 1) * 16 + swz / 64; C = (st & 1) * 32 + (swz % 64) / 2; }
__host__ __device__ __forceinline__ int perm32(int rho) { const int n = rho >> 4, i = rho & 15; return 8 * (i >> 2) + 4 * n + (i & 3); }

struct Unit { int pm, pn; };
struct Gemm { const bf16_t* A; const bf16_t* Bt; int M, N, K; };

struct StaticOrder {
    int nM, nN, nwg, G, c;
    __host__ __device__ void init(int M, int N, int G_, int c_) { nM = M / BM; nN = N / BM; nwg = nM * nN; G = G_; c = c_; }
    __host__ __device__ bool next(int i, Unit& u) const {
        const long L = (long)i * G + c; if (L >= nwg) return false;
        int wgid = (int)L; { const int q = nwg / NXCD, r = nwg % NXCD, xcd = wgid % NXCD, off = wgid / NXCD; wgid = (xcd < r ? xcd * (q + 1) : r * (q + 1) + (xcd - r) * q) + off; }
        const int nig = WGM * nN, gid = wgid / nig, fm = gid * WGM, gsz = (nM - fm) < WGM ? (nM - fm) : WGM;
        u.pm = fm + ((wgid % nig) % gsz); u.pn = (wgid % nig) / gsz; return true;
    }
    __device__ __forceinline__ void a_ready(const Unit&) const {}
    __device__ __forceinline__ void done(const Unit&) const {}
};

__device__ __forceinline__ unsigned cvt_pk_bf16(float lo, float hi) { unsigned r; asm volatile("v_cvt_pk_bf16_f32 %0, %1, %2" : "=v"(r) : "v"(lo), "v"(hi)); return r; }
typedef float f32x2 __attribute__((ext_vector_type(2)));
typedef float f32x2 __attribute__((ext_vector_type(2)));
__device__ __forceinline__ u32x4 pack8(f32x4 v0, f32x4 v1) { u32x4 w; w.x = cvt_pk_bf16(v0[0], v0[1]); w.y = cvt_pk_bf16(v0[2], v0[3]); w.z = cvt_pk_bf16(v1[0], v1[1]); w.w = cvt_pk_bf16(v1[2], v1[3]); return w; }
__device__ __forceinline__ f32x4 i2f(f32x4 a) { const i32x4 v = __builtin_bit_cast(i32x4, a); return (f32x4){(float)v[0], (float)v[1], (float)v[2], (float)v[3]}; }
struct EpiProj {
    static constexpr bool PERM = true, AFTER_DRAIN = false, INT8 = false;
    bf16_t* QKV; size_t split_stride; float scale0; bf16_t* H; const float* bglu;
    __device__ __forceinline__ void operator()(const f32x4 (&acc)[2][2][4][2], const Unit& u, int wr, int wc, int fr, int fq) const {
        const int row0 = u.pm * BM + wr * 64 + fr;
        if (u.pn < 12) {
            const int t = u.pn >> 2; bf16_t* base = QKV + (size_t)t * split_stride; const float sc = (t == 0) ? scale0 : 1.f;
            const int col0 = (u.pn & 3) * BM + wc * 32 + 8 * fq;
#pragma unroll
            for (int ai = 0; ai < 2; ++ai)
#pragma unroll
                for (int m = 0; m < 4; ++m) { bf16_t* rowp = base + (size_t)(row0 + ai * HALF + m * 16) * 1024 + col0;
#pragma unroll
                    for (int bj = 0; bj < 2; ++bj) *(u32x4*)(rowp + bj * HALF) = pack8(acc[ai][bj][m][0] * sc, acc[ai][bj][m][1] * sc); }
        } else {
            const int ch0 = (u.pn - 12) * HALF + wc * 32 + 8 * fq;
            const f32x4 ba0 = *(const f32x4*)(bglu + ch0), ba1 = *(const f32x4*)(bglu + ch0 + 4), bg0 = *(const f32x4*)(bglu + 1024 + ch0), bg1 = *(const f32x4*)(bglu + 1024 + ch0 + 4);
#pragma unroll
            for (int ai = 0; ai < 2; ++ai)
#pragma unroll
                for (int m = 0; m < 4; ++m) {
                    const f32x4 a0 = acc[ai][0][m][0] + ba0, a1 = acc[ai][0][m][1] + ba1, g0 = acc[ai][1][m][0] + bg0, g1 = acc[ai][1][m][1] + bg1;
                    f32x4 h0, h1;
#pragma unroll
                    for (int e = 0; e < 4; ++e) { h0[e] = a0[e] * __builtin_amdgcn_rcpf(1.f + __builtin_amdgcn_exp2f(-1.4426950409f * g0[e])); h1[e] = a1[e] * __builtin_amdgcn_rcpf(1.f + __builtin_amdgcn_exp2f(-1.4426950409f * g1[e])); }
                    *(u32x4*)(H + (size_t)(row0 + ai * HALF + m * 16) * 1024 + ch0) = pack8(h0, h1); }
        }
    }
};
struct EpiProjI8 {
    static constexpr bool PERM = true, AFTER_DRAIN = false, INT8 = true;
    bf16_t* QKV; size_t split_stride; float scale0; bf16_t* H; const float* bglu; const float* sa; const float* sb;
    __device__ __forceinline__ void operator()(const f32x4 (&acc)[2][2][4][2], const Unit& u, int wr, int wc, int fr, int fq) const {
        const int row0 = u.pm * BM + wr * 64 + fr, cb = u.pn * BM + wc * 32 + 8 * fq;
        f32x4 cs[2][2];
#pragma unroll
        for (int bj = 0; bj < 2; ++bj) { cs[bj][0] = *(const f32x4*)(sb + cb + bj * HALF); cs[bj][1] = *(const f32x4*)(sb + cb + bj * HALF + 4); }
        if (u.pn < 12) {
            const int t = u.pn >> 2; bf16_t* base = QKV + (size_t)t * split_stride; const float sc = (t == 0) ? scale0 : 1.f;
            const int col0 = (u.pn & 3) * BM + wc * 32 + 8 * fq;
#pragma unroll
            for (int ai = 0; ai < 2; ++ai)
#pragma unroll
                for (int m = 0; m < 4; ++m) { const int row = row0 + ai * HALF + m * 16; const float rs = sa[row] * sc; bf16_t* rowp = base + (size_t)row * 1024 + col0;
#pragma unroll
                    for (int bj = 0; bj < 2; ++bj) *(u32x4*)(rowp + bj * HALF) = pack8(i2f(acc[ai][bj][m][0]) * cs[bj][0] * rs, i2f(acc[ai][bj][m][1]) * cs[bj][1] * rs); }
        } else {
            const int ch0 = (u.pn - 12) * HALF + wc * 32 + 8 * fq;
            const f32x4 ba0 = *(const f32x4*)(bglu + ch0), ba1 = *(const f32x4*)(bglu + ch0 + 4), bg0 = *(const f32x4*)(bglu + 1024 + ch0), bg1 = *(const f32x4*)(bglu + 1024 + ch0 + 4);
#pragma unroll
            for (int ai = 0; ai < 2; ++ai)
#pragma unroll
                for (int m = 0; m < 4; ++m) { const int row = row0 + ai * HALF + m * 16; const float rs = sa[row];
                    const f32x4 a0 = i2f(acc[ai][0][m][0]) * cs[0][0] * rs + ba0, a1 = i2f(acc[ai][0][m][1]) * cs[0][1] * rs + ba1, g0 = i2f(acc[ai][1][m][0]) * cs[1][0] * rs + bg0, g1 = i2f(acc[ai][1][m][1]) * cs[1][1] * rs + bg1;
                    f32x4 h0, h1;
#pragma unroll
                    for (int e = 0; e < 4; ++e) { h0[e] = a0[e] * __builtin_amdgcn_rcpf(1.f + __builtin_amdgcn_exp2f(-1.4426950409f * g0[e])); h1[e] = a1[e] * __builtin_amdgcn_rcpf(1.f + __builtin_amdgcn_exp2f(-1.4426950409f * g1[e])); }
                    *(u32x4*)(H + (size_t)row * 1024 + ch0) = pack8(h0, h1); }
        }
    }
};
struct EpiRes {
    static constexpr bool PERM = true, AFTER_DRAIN = false, INT8 = false;
    const float* X; bf16_t* Y; int ldc; float alpha;
    __device__ __forceinline__ void operator()(const f32x4 (&acc)[2][2][4][2], const Unit& u, int wr, int wc, int fr, int fq) const {
        const int row0 = u.pm * BM + wr * 64 + fr, col0 = u.pn * BM + wc * 32 + 8 * fq;
#pragma unroll
        for (int ai = 0; ai < 2; ++ai)
#pragma unroll
            for (int m = 0; m < 4; ++m) { const size_t off = (size_t)(row0 + ai * HALF + m * 16) * ldc + col0;
#pragma unroll
                for (int bj = 0; bj < 2; ++bj) { const f32x4 x0 = *(const f32x4*)(X + off + bj * HALF), x1 = *(const f32x4*)(X + off + bj * HALF + 4);
                    *(u32x4*)(Y + off + bj * HALF) = pack8(acc[ai][bj][m][0] + x0 * alpha, acc[ai][bj][m][1] + x1 * alpha); } }
    }
};
struct EpiPlainI8 {
    static constexpr bool PERM = true, AFTER_DRAIN = false, INT8 = true;
    bf16_t* O; int ldc; const float* sa; const float* sb;
    __device__ __forceinline__ void operator()(const f32x4 (&acc)[2][2][4][2], const Unit& u, int wr, int wc, int fr, int fq) const {
        const int row0 = u.pm * BM + wr * 64 + fr, col0 = u.pn * BM + wc * 32 + 8 * fq;
        f32x4 cs[2][2];
#pragma unroll
        for (int bj = 0; bj < 2; ++bj) { cs[bj][0] = *(const f32x4*)(sb + col0 + bj * HALF); cs[bj][1] = *(const f32x4*)(sb + col0 + bj * HALF + 4); }
#pragma unroll
        for (int ai = 0; ai < 2; ++ai)
#pragma unroll
            for (int m = 0; m < 4; ++m) { const int row = row0 + ai * HALF + m * 16; const float rs = sa[row]; bf16_t* rowp = O + (size_t)row * ldc + col0;
#pragma unroll
                for (int bj = 0; bj < 2; ++bj) *(u32x4*)(rowp + bj * HALF) = pack8(i2f(acc[ai][bj][m][0]) * cs[bj][0] * rs, i2f(acc[ai][bj][m][1]) * cs[bj][1] * rs); }
    }
};
struct EpiPlain {
    static constexpr bool PERM = true, AFTER_DRAIN = false, INT8 = false;
    bf16_t* O; int ldc;
    __device__ __forceinline__ void operator()(const f32x4 (&acc)[2][2][4][2], const Unit& u, int wr, int wc, int fr, int fq) const {
        const int row0 = u.pm * BM + wr * 64 + fr, col0 = u.pn * BM + wc * 32 + 8 * fq;
#pragma unroll
        for (int ai = 0; ai < 2; ++ai)
#pragma unroll
            for (int m = 0; m < 4; ++m) { bf16_t* rowp = O + (size_t)(row0 + ai * HALF + m * 16) * ldc + col0;
#pragma unroll
                for (int bj = 0; bj < 2; ++bj) *(u32x4*)(rowp + bj * HALF) = pack8(acc[ai][bj][m][0], acc[ai][bj][m][1]); }
    }
};

template <class Epi, class Sched, bool ALIGN_EPI = false, bool SP2 = false>
__device__ __forceinline__ void gemm_phase(PG8_LAS unsigned char* lds, const Gemm g, const Sched& S, const Epi& E) {
    const int tid = threadIdx.x, wid = __builtin_amdgcn_readfirstlane(tid >> 6), lane = tid & 63, wr = wid >> 2, wc = wid & 3, fr = lane & 15, fq = lane >> 4;
    const int K = g.K, nt = K / BK;
    unsigned voffA[2], voffB[2];
#pragma unroll
    for (int i = 0; i < 2; ++i) { int R, C; stage_rc(tid * 16 + i * 8192, R, C); const int Rb = Epi::PERM ? ((R & ~31) + perm32(R & 31)) : R;
        voffA[i] = (unsigned)(R * K + C) * 2u; voffB[i] = (unsigned)(Rb * K + C) * 2u; }
    const size_t kstep = (size_t)(BK * 2);
    const size_t hstep = (size_t)HALF * K * 2;
    const size_t tstep = 2 * hstep;
    const unsigned ldsw = (unsigned)wid * 1024u;
    const int aoff = lds_byte(wr * 64 + fr, fq * 8), boff = lds_byte(wc * 32 + fr, fq * 8);
#define PG8_SA(b, h) (((b) * 2 + (h)) * HTB)
#define PG8_SB(b, h) ((4 + (b) * 2 + (h)) * HTB)
#define PG8_STAGE(bufoff, gbase, voff) do { _Pragma("unroll") for (int _i = 0; _i < 2; ++_i) \
        __builtin_amdgcn_global_load_lds((const unsigned*)((const char*)(gbase) + (voff)[_i]), (PG8_LAS unsigned*)(lds + (bufoff) + ldsw + _i * 8192), 16, 0, 0); } while (0)
#define PG8_LDA(dst, b, h) do { _Pragma("unroll") for (int m = 0; m < 4; ++m) _Pragma("unroll") for (int k = 0; k < 2; ++k) dst[m][k] = *(const PG8_LAS bf16x8*)(lds + PG8_SA(b, h) + aoff + m * 2048 + k * 1024); } while (0)
#define PG8_LDB(dst, b, h) do { _Pragma("unroll") for (int n = 0; n < 2; ++n) _Pragma("unroll") for (int k = 0; k < 2; ++k) dst[n][k] = *(const PG8_LAS bf16x8*)(lds + PG8_SB(b, h) + boff + n * 2048 + k * 1024); } while (0)
#define PG8_MMA(ai, bj, At, Bt) do { __builtin_amdgcn_s_setprio(1); _Pragma("unroll") for (int m = 0; m < 4; ++m) _Pragma("unroll") for (int n = 0; n < 2; ++n) _Pragma("unroll") for (int k = 0; k < 2; ++k) { \
        if constexpr (Epi::INT8) acc[ai][bj][m][n] = __builtin_bit_cast(f32x4, __builtin_amdgcn_mfma_i32_16x16x64_i8(__builtin_bit_cast(i32x4, Bt[n][k]), __builtin_bit_cast(i32x4, At[m][k]), __builtin_bit_cast(i32x4, acc[ai][bj][m][n]), 0, 0, 0)); \
        else acc[ai][bj][m][n] = __builtin_amdgcn_mfma_f32_16x16x32_bf16(Bt[n][k], At[m][k], acc[ai][bj][m][n], 0, 0, 0); } __builtin_amdgcn_s_setprio(0); } while (0)
#define PG8_WAIT_V(n) asm volatile("s_waitcnt vmcnt(" #n ")" ::: "memory")
#define PG8_WAIT_L(n) asm volatile("s_waitcnt lgkmcnt(" #n ")" ::: "memory")
#define PG8_BAR __builtin_amdgcn_s_barrier()
#define PG8_SCHED __builtin_amdgcn_sched_barrier(0)
    Unit cur, nxt; int ui = 0;
    if (!S.next(0, cur)) return;
    f32x4 acc[2][2][4][2];
#pragma unroll
    for (int a = 0; a < 2; ++a)
#pragma unroll
        for (int b = 0; b < 2; ++b)
#pragma unroll
            for (int m = 0; m < 4; ++m)
#pragma unroll
                for (int n = 0; n < 2; ++n) acc[a][b][m][n] = (f32x4){0.f, 0.f, 0.f, 0.f};
    bf16x8 At[4][2], B0[2][2], B1[2][2];
    const char* cA = (const char*)g.A + (size_t)cur.pm * tstep; const char* cB = (const char*)g.Bt + (size_t)cur.pn * tstep;
    S.a_ready(cur);
    if constexpr (SP2) {
        PG8_STAGE(PG8_SB(0, 0), cB, voffB); PG8_STAGE(PG8_SB(0, 1), cB + hstep, voffB); PG8_STAGE(PG8_SA(0, 0), cA, voffA); PG8_STAGE(PG8_SA(0, 1), cA + hstep, voffA);
        if (wr == 1) PG8_BAR;
        PG8_WAIT_V(2); PG8_BAR;
        PG8_STAGE(PG8_SB(1, 0), cB + kstep, voffB); PG8_STAGE(PG8_SA(1, 0), cA + kstep, voffA); PG8_STAGE(PG8_SB(1, 1), cB + hstep + kstep, voffB);
        PG8_WAIT_V(6); PG8_BAR;
    } else {
        PG8_STAGE(PG8_SB(0, 0), cB, voffB); PG8_STAGE(PG8_SA(0, 0), cA, voffA); PG8_STAGE(PG8_SB(0, 1), cB + hstep, voffB); PG8_STAGE(PG8_SA(0, 1), cA + hstep, voffA);
        if (wr == 1) PG8_BAR;
        PG8_WAIT_V(4); PG8_BAR;
        PG8_STAGE(PG8_SB(1, 0), cB + kstep, voffB); PG8_STAGE(PG8_SA(1, 0), cA + kstep, voffA); PG8_STAGE(PG8_SB(1, 1), cB + hstep + kstep, voffB);
        PG8_WAIT_V(6); PG8_BAR;
    }
    for (;;) {
        const bool has_next = S.next(ui + 1, nxt);
        const char* nA = has_next ? (const char*)g.A + (size_t)nxt.pm * tstep : cA; const char* nB = has_next ? (const char*)g.Bt + (size_t)nxt.pn * tstep : cB;
        for (int t = 0; t < nt; t += 2) {
            const bool last = (t == nt - 2);
            const char* a1 = cA + (size_t)(t + 1) * kstep;
            const char* a2 = last ? nA : cA + (size_t)(t + 2) * kstep; const char* b2 = last ? nB : cB + (size_t)(t + 2) * kstep;
            const char* a3 = a2 + kstep; const char* b3 = b2 + kstep;
            if (last && has_next) S.a_ready(nxt);
            if constexpr (SP2) {
            PG8_LDB(B0, 0, 0); PG8_LDB(B1, 0, 1); PG8_SCHED; PG8_LDA(At, 0, 0); PG8_STAGE(PG8_SA(1, 1), a1 + hstep, voffA);
            PG8_WAIT_V(8); PG8_WAIT_L(0); PG8_BAR; PG8_MMA(0, 0, At, B0); PG8_MMA(0, 1, At, B1); PG8_BAR; PG8_SCHED;
            PG8_LDA(At, 0, 1); PG8_STAGE(PG8_SB(0, 0), b2, voffB); PG8_STAGE(PG8_SB(0, 1), b2 + hstep, voffB); PG8_STAGE(PG8_SA(0, 0), a2, voffA);
            PG8_WAIT_V(8); PG8_WAIT_L(0); PG8_BAR; PG8_MMA(1, 0, At, B0); PG8_MMA(1, 1, At, B1); PG8_BAR; PG8_SCHED;
            PG8_LDB(B0, 1, 0); PG8_LDB(B1, 1, 1); PG8_SCHED; PG8_LDA(At, 1, 0); PG8_STAGE(PG8_SA(0, 1), a2 + hstep, voffA);
            PG8_WAIT_V(8); PG8_WAIT_L(0); PG8_BAR; PG8_MMA(0, 0, At, B0); PG8_MMA(0, 1, At, B1); PG8_BAR; PG8_SCHED;
            PG8_LDA(At, 1, 1); PG8_STAGE(PG8_SB(1, 0), b3, voffB); PG8_STAGE(PG8_SB(1, 1), b3 + hstep, voffB); PG8_STAGE(PG8_SA(1, 0), a3, voffA);
            PG8_WAIT_V(8); PG8_WAIT_L(0); PG8_BAR; PG8_MMA(1, 0, At, B0); PG8_MMA(1, 1, At, B1); PG8_BAR; PG8_SCHED;
            } else {
            PG8_LDB(B0, 0, 0); PG8_SCHED; PG8_LDA(At, 0, 0); PG8_STAGE(PG8_SA(1, 1), a1 + hstep, voffA);
            PG8_WAIT_L(8); PG8_BAR; PG8_WAIT_L(0); PG8_MMA(0, 0, At, B0); PG8_BAR; PG8_SCHED;
            PG8_LDB(B1, 0, 1); PG8_STAGE(PG8_SB(0, 0), b2, voffB);
            PG8_BAR; PG8_WAIT_L(0); PG8_MMA(0, 1, At, B1); PG8_BAR;
            PG8_LDA(At, 0, 1); PG8_STAGE(PG8_SA(0, 0), a2, voffA);
            PG8_BAR; PG8_WAIT_L(0); PG8_MMA(1, 0, At, B0); PG8_BAR; PG8_SCHED;
            PG8_STAGE(PG8_SB(0, 1), b2 + hstep, voffB);
            PG8_WAIT_V(6); PG8_BAR; PG8_MMA(1, 1, At, B1); PG8_BAR;
            PG8_LDB(B0, 1, 0); PG8_SCHED; PG8_LDA(At, 1, 0); PG8_STAGE(PG8_SA(0, 1), a2 + hstep, voffA);
            PG8_WAIT_L(8); PG8_BAR; PG8_WAIT_L(0); PG8_MMA(0, 0, At, B0); PG8_BAR; PG8_SCHED;
            PG8_LDB(B1, 1, 1); PG8_STAGE(PG8_SB(1, 0), b3, voffB);
            PG8_BAR; PG8_WAIT_L(0); PG8_MMA(0, 1, At, B1); PG8_BAR;
            PG8_LDA(At, 1, 1); PG8_STAGE(PG8_SA(1, 0), a3, voffA);
            PG8_BAR; PG8_WAIT_L(0); PG8_MMA(1, 0, At, B0); PG8_BAR; PG8_SCHED;
            PG8_STAGE(PG8_SB(1, 1), b3 + hstep, voffB);
            PG8_WAIT_V(6); PG8_BAR; PG8_MMA(1, 1, At, B1); PG8_BAR;
            }
        }
        if constexpr (ALIGN_EPI) { if (wr == 0) PG8_BAR; }
        if constexpr (!Epi::AFTER_DRAIN) { E(acc, cur, wr, wc, fr, fq); S.done(cur); }
        if (!has_next) break;
#pragma unroll
        for (int a = 0; a < 2; ++a)
#pragma unroll
            for (int b = 0; b < 2; ++b)
#pragma unroll
                for (int m = 0; m < 4; ++m)
#pragma unroll
                    for (int n = 0; n < 2; ++n) acc[a][b][m][n] = (f32x4){0.f, 0.f, 0.f, 0.f};
        cur = nxt; cA = nA; cB = nB; ++ui;
        if constexpr (ALIGN_EPI) { if (wr == 1) PG8_BAR; }
    }
    PG8_WAIT_V(0);
    if constexpr (!ALIGN_EPI) { if (wr == 0) PG8_BAR; }
    PG8_BAR;
    if constexpr (Epi::AFTER_DRAIN) { E.fused(acc, cur, wr, wc, fr, fq, lds, wid, lane); S.done(cur); }
#undef PG8_SA
#undef PG8_SB
#undef PG8_STAGE
#undef PG8_LDA
#undef PG8_LDB
#undef PG8_MMA
#undef PG8_WAIT_V
#undef PG8_WAIT_L
#undef PG8_BAR
#undef PG8_SCHED
}
}
#include <hip/hip_bf16.h>
#include <cmath>
namespace attn_body {
using bf16=__hip_bfloat16;
using bf16x8=__attribute__((ext_vector_type(8)))short;
using s16x4=__attribute__((ext_vector_type(4)))short;
using f32x16=__attribute__((ext_vector_type(16)))float;
using u32x4=__attribute__((ext_vector_type(4)))unsigned;
constexpr int BATCH=8,NHEAD=16,SEQ=4096,D=64,DM=NHEAD*D;
constexpr int NW=8,QBLK=32,QB=QBLK*NW,KVBLK=64,NQB=SEQ/QB;
constexpr int ATTN_PITCH=DM, ATTN_UNIT_ROWS=QB;
__device__ __forceinline__ int crow(int r,int hi){return (r&3)+8*(r>>2)+4*hi;}
#define SBAR() __builtin_amdgcn_sched_barrier(0)
__device__ __forceinline__ void cmask(f32x16&p0,f32x16&p1,int jb,int qrel,int hi){
  const float NEG=-INFINITY; int kb=64*jb+4*hi;
  #pragma unroll
  for(int r=0;r<16;++r){int kv=kb+(r&3)+8*(r>>2); if(kv>qrel)p0[r]=NEG; if(kv+32>qrel)p1[r]=NEG;}
}

__device__ __forceinline__ void cbias(f32x16&p0,f32x16&p1,int jb,int qrel,int hi,const __attribute__((address_space(3))) float*tab){
  const int base=qrel-64*jb-4*hi;
  #pragma unroll
  for(int r=0;r<16;++r){const int d0=base-((r&3)+8*(r>>2)); const int i0=min(max(d0,0),127), i1=min(max(d0-32,0),127); p0[r]+=tab[i0]; p1[r]+=tab[i1];}
}
constexpr int NSLOT=3, SLOTB=8192;
constexpr int LDS_K=0, LDS_V=NSLOT*SLOTB, LDS_WS=2*NSLOT*SLOTB, LDS_OST=LDS_WS+NW*64*4, LDS_TAB=LDS_OST+NW*4096, LDS_BYTES=LDS_TAB+512;
constexpr float C2=0.125f*1.4426950408889634f;
__device__ __forceinline__ void glds16(const void*gsrc,unsigned lds_dst){unsigned keep;
  asm volatile("s_mov_b32 %0, m0\n\ts_mov_b32 m0, %2\n\ts_nop 0\n\tglobal_load_lds_dwordx4 %1, off\n\ts_mov_b32 m0, %0":"=&s"(keep):"v"(gsrc),"s"(lds_dst):"memory");}
__device__ __forceinline__ float max3f(float a,float b,float c){float r;asm("v_max3_f32 %0, %1, %2, %3":"=v"(r):"v"(a),"v"(b),"v"(c));return r;}
__device__ __forceinline__ float max2f(float a,float b){float r;asm("v_max_f32_e32 %0, %1, %2":"=v"(r):"v"(a),"v"(b));return r;}
__device__ __forceinline__ float fadd_s(float a,float b){float r;asm("v_add_f32_e32 %0, %1, %2":"=v"(r):"v"(a),"v"(b));return r;}
__device__ __forceinline__ float fsub_s(float a,float b){float r;asm("v_sub_f32_e32 %0, %1, %2":"=v"(r):"v"(a),"v"(b));return r;}
typedef float f32x2_t __attribute__((ext_vector_type(2))); typedef __bf16 bf16x2_t __attribute__((ext_vector_type(2)));
__device__ __forceinline__ unsigned cvtpk_s(float lo,float hi){f32x2_t v={lo,hi};bf16x2_t b=__builtin_convertvector(v,bf16x2_t);return __builtin_bit_cast(unsigned,b);}
#define WAIT_BAR(N) asm volatile("s_waitcnt vmcnt(" #N ") lgkmcnt(0)\n\ts_barrier":::"memory")

__device__ __forceinline__ void qkt(f32x16&p0,f32x16&p1,const char*Kslot,const bf16x8*qr,const f32x16&negm,int r32,int hi){
  const char*kb=Kslot+hi*1024+r32*16;
  #pragma unroll
  for(int d0=0;d0<4;++d0){
    const bf16x8 b0=*reinterpret_cast<const bf16x8*>(kb+d0*2048);
    const bf16x8 b1=*reinterpret_cast<const bf16x8*>(kb+d0*2048+512);
    if(d0==0){p0=__builtin_amdgcn_mfma_f32_32x32x16_bf16(b0,qr[0],negm,0,0,0);p1=__builtin_amdgcn_mfma_f32_32x32x16_bf16(b1,qr[0],negm,0,0,0);}
    else{p0=__builtin_amdgcn_mfma_f32_32x32x16_bf16(b0,qr[d0],p0,0,0,0);p1=__builtin_amdgcn_mfma_f32_32x32x16_bf16(b1,qr[d0],p1,0,0,0);}}
}
typedef __attribute__((address_space(3))) const char* lds_cptr;
typedef short v4i16_t __attribute__((ext_vector_type(4)));
__device__ __forceinline__ void kload8(bf16x8*kf,lds_cptr kp){
  kf[0]=*(const __attribute__((address_space(3))) bf16x8*)(kp);      kf[1]=*(const __attribute__((address_space(3))) bf16x8*)(kp+512);
  kf[2]=*(const __attribute__((address_space(3))) bf16x8*)(kp+2048); kf[3]=*(const __attribute__((address_space(3))) bf16x8*)(kp+2560);
  kf[4]=*(const __attribute__((address_space(3))) bf16x8*)(kp+4096); kf[5]=*(const __attribute__((address_space(3))) bf16x8*)(kp+4608);
  kf[6]=*(const __attribute__((address_space(3))) bf16x8*)(kp+6144); kf[7]=*(const __attribute__((address_space(3))) bf16x8*)(kp+6656);
}
__device__ __forceinline__ void kload2(bf16x8*kf,lds_cptr kp,int j){ kf[2*j]=*(const __attribute__((address_space(3))) bf16x8*)(kp+j*2048); kf[2*j+1]=*(const __attribute__((address_space(3))) bf16x8*)(kp+j*2048+512); }
__device__ __forceinline__ s16x4 vtr(lds_cptr p){ return __builtin_bit_cast(s16x4,__builtin_amdgcn_ds_read_tr16_b64_v4i16((__attribute__((address_space(3))) v4i16_t*)p)); }
__device__ __forceinline__ float rowmax(const f32x16&p0,const f32x16&p1){
  float a=max3f(p0[0],p0[1],p1[0]),b=max3f(p0[2],p0[3],p1[1]);a=max3f(a,p1[2],p1[3]);
  #pragma unroll
  for(int r=4;r<16;r+=4){a=max3f(a,p0[r],p0[r+1]);b=max3f(b,p0[r+2],p0[r+3]);a=max3f(a,p1[r],p1[r+1]);b=max3f(b,p1[r+2],p1[r+3]);}
  const float m=max2f(a,b);
  auto rr=__builtin_amdgcn_permlane32_swap(__float_as_uint(m),__float_as_uint(m),false,false);
  return max2f(__uint_as_float(rr[0]),__uint_as_float(rr[1]));
}
__device__ __forceinline__ void pv(f32x16*o,int vb,bf16x8 pa0,bf16x8 pa1,bf16x8 pa2,bf16x8 pa3){
  #pragma unroll
  for(int d0=0;d0<2;++d0){s16x4 lo[4],hi[4];
    #pragma unroll
    for(int ks=0;ks<4;++ks){
      asm volatile("ds_read_b64_tr_b16 %0,%1 offset:%c2":"=&v"(lo[ks]):"v"(vb),"i"(d0*4096+ks*1024):"memory");
      asm volatile("ds_read_b64_tr_b16 %0,%1 offset:%c2":"=&v"(hi[ks]):"v"(vb),"i"(d0*4096+ks*1024+512):"memory");}
    asm volatile("s_waitcnt lgkmcnt(0)":::"memory");SBAR();
    #define PK(k) (bf16x8){lo[k][0],lo[k][1],lo[k][2],lo[k][3],hi[k][0],hi[k][1],hi[k][2],hi[k][3]}
    o[d0]=__builtin_amdgcn_mfma_f32_32x32x16_bf16(pa0,PK(0),o[d0],0,0,0);
    o[d0]=__builtin_amdgcn_mfma_f32_32x32x16_bf16(pa1,PK(1),o[d0],0,0,0);
    o[d0]=__builtin_amdgcn_mfma_f32_32x32x16_bf16(pa2,PK(2),o[d0],0,0,0);
    o[d0]=__builtin_amdgcn_mfma_f32_32x32x16_bf16(pa3,PK(3),o[d0],0,0,0);
    #undef PK
  }
}

#ifndef ATTN_STORE16
#define ATTN_STORE16(p,v) (*(u32x4*)(p)=(v))
#endif
template<int THRL> __device__ __forceinline__ void attn_unit(int b,int h,int hv,int qb,const bf16*Q,const bf16*__restrict__ K,const bf16*__restrict__ V,bf16*O,char*shm){
  const __attribute__((address_space(3))) float* tab=(const __attribute__((address_space(3))) float*)((lds_cptr)shm+LDS_TAB);
  const int tid=threadIdx.x,lane=tid&63,r32=lane&31,hi=lane>>5; const int wid=__builtin_amdgcn_readfirstlane(tid>>6);
  const long rowbase=(long)b*SEQ; const int q0=qb*QB;
  const bf16*Qw=Q+(rowbase+q0+wid*QBLK)*DM+h*D;
  const bf16*Kh=K+rowbase*DM+h*D,*Vh=V+rowbase*DM+hv*D;
  const unsigned lds0=(unsigned)(uintptr_t)shm;
  float*wsf=(float*)(shm+LDS_WS)+wid*64;
  const bf16*ksrc=Kh+(long)lane*DM+wid*8;
  const bf16*vsrc=Vh+(long)(16*(wid&3)+(lane>>2))*DM+(wid>>2)*32+(lane&3)*8;
  const unsigned kdst=lds0+LDS_K+wid*1024, vdst=lds0+LDS_V+wid*1024;
  #define DMA_K(t,slot) glds16(ksrc+(long)(t)*KVBLK*DM,(unsigned)__builtin_amdgcn_readfirstlane(kdst+(slot)))
  #define DMA_V(t,slot) glds16(vsrc+(long)(t)*KVBLK*DM,(unsigned)__builtin_amdgcn_readfirstlane(vdst+(slot)))
  const int vb0=(int)(lds0+LDS_V)+((lane>>4)&1)*32+(lane&3)*8+(4*hi+((lane&15)>>2))*64;
  const char*Kbase=shm+LDS_K; bf16x8 kf[8];
  const lds_cptr shm3=(lds_cptr)shm; const lds_cptr kp0=shm3+LDS_K+hi*1024+r32*16; const lds_cptr vp0=shm3+LDS_V+((lane>>4)&1)*32+(lane&3)*8+(4*hi+((lane&15)>>2))*64;
  const int NT=(q0+QB)/KVBLK;
  DMA_K(0,0);DMA_V(0,0);DMA_K(1,SLOTB);
  bf16x8 qr[4];
  #pragma unroll
  for(int d0=0;d0<4;++d0)qr[d0]=*reinterpret_cast<const bf16x8*>(&Qw[(long)r32*DM+d0*16+hi*8]);
  float mhat=0.f,l_reg=0.f;f32x16 o[2];o[0]=f32x16{};o[1]=f32x16{};f32x16 negm=f32x16{};asm volatile("":"+v"(negm));
  const int qrel=wid*QBLK+r32;
  #define CMASK(P0,P1,t) do{int jb_=(t)-(NT-4); if(jb_>=-2){cbias(P0,P1,jb_,qrel,hi,tab); if(jb_>=0)cmask(P0,P1,jb_,qrel,hi);}}while(0)
  bool resc=false;
  #define START(P0,P1) do{ const float rm=rowmax(P0,P1); resc=false; \
    { const float dl=rm; mhat=fadd_s(mhat,dl); \
      _Pragma("unroll") for(int r=0;r<16;++r){P0[r]=fsub_s(P0[r],dl);P1[r]=fsub_s(P1[r],dl);} \
      _Pragma("unroll") for(int r=0;r<16;++r)negm[r]=-mhat; asm volatile("":"+v"(negm)); } \
    _Pragma("unroll") for(int r=0;r<16;++r)P0[r]=__builtin_amdgcn_exp2f(P0[r]); }while(0)
  #define RESC() do{ if(resc){ asm volatile("s_waitcnt lgkmcnt(0)":::"memory"); \
      _Pragma("unroll") for(int d_=0;d_<2;++d_) _Pragma("unroll") for(int r=0;r<16;++r)o[d_][r]*=wsf[crow(r,hi)]; } }while(0)
  f32x16 pA0,pA1,pB0,pB1;
  int sl_prev=0,sl_cur=0,sl_next=SLOTB;
  #define ROT() do{sl_prev=sl_cur;sl_cur=sl_next;sl_next=(sl_next==(NSLOT-1)*SLOTB)?0:sl_next+SLOTB;}while(0)
  DMA_K(2,2*SLOTB);
  WAIT_BAR(3);
  qkt(pA0,pA1,Kbase,qr,negm,r32,hi);asm volatile("s_nop 15\n\ts_nop 7":"+v"(pA0),"+v"(pA1));CMASK(pA0,pA1,0);
  START(pA0,pA1);
  _Pragma("unroll") for(int r=0;r<16;++r)pA1[r]=__builtin_amdgcn_exp2f(pA1[r]);
  WAIT_BAR(0);
  DMA_K(3,0);DMA_V(1,SLOTB);
  ROT();
  kload8(kf,kp0+sl_cur);
  WAIT_BAR(2);
  s16x4 vlo[8],vhi[8]; u32x4 pw0,pw1,pw2,pw3;
  #define PKW(P,B) cvtpk_s(P[B],P[B+1])
  #define PAF(k) __builtin_bit_cast(bf16x8,pw##k)
  #define VFR(i) (bf16x8){vlo[i][0],vlo[i][1],vlo[i][2],vlo[i][3],vhi[i][0],vhi[i][1],vhi[i][2],vhi[i][3]}
  #define PIN(x) asm volatile("":"+v"(x))
  #define MX3(a,b,c) __builtin_fmaxf(__builtin_fmaxf((a),(b)),(c))
  #define GAPA(MF,A0,A1,A2,A3,W0,W1,PW) do{ MF; sacc+=A0; sacc+=A1; sacc+=A2; sacc+=A3; PIN(sacc); W0; W1; PIN(PW); SBAR(); }while(0)
  #define EX(v) __builtin_amdgcn_exp2f(v)
  #define GAPB(MF,X,B) do{ MF; X[B]=EX(X[B]); X[B+1]=EX(X[B+1]); X[B+2]=EX(X[B+2]); X[B+3]=EX(X[B+3]); PIN(X); SBAR(); }while(0)
  #define VRD(i) do{ vlo[i]=vtr(vp_+(((i)>>2)*4096+((i)&3)*1024)); vhi[i]=vtr(vp_+(((i)>>2)*4096+((i)&3)*1024+512)); }while(0)
  #define KRD(G,j) do{ if(G){ kload2(kf,kp0+sl_next,j); SBAR(); } }while(0)
  #define STEP(C0,C1,P0,P1,t,GK,GV,GL) do{ SBAR(); \
    const lds_cptr vp_=vp0+sl_prev; \
    VRD(0); SBAR(); float sacc=(P0[0]+P0[1]); \
    GAPA(C0=__builtin_amdgcn_mfma_f32_32x32x16_bf16(kf[0],qr[0],negm,0,0,0), P0[2],P0[3],P0[4],P0[5],     pw0[0]=PKW(P0,0), pw0[1]=PKW(P0,2), pw0); \
    VRD(4); SBAR(); GAPA(C1=__builtin_amdgcn_mfma_f32_32x32x16_bf16(kf[1],qr[0],negm,0,0,0), P0[6],P0[7],P0[8],P0[9],     pw0[2]=PKW(P0,4), pw0[3]=PKW(P0,6), pw0); \
    VRD(1); SBAR(); GAPA(C0=__builtin_amdgcn_mfma_f32_32x32x16_bf16(kf[2],qr[1],C0,0,0,0),   P0[10],P0[11],P0[12],P0[13], pw1[0]=PKW(P0,8), pw1[1]=PKW(P0,10), pw1); \
    VRD(5); SBAR(); GAPA(C1=__builtin_amdgcn_mfma_f32_32x32x16_bf16(kf[3],qr[1],C1,0,0,0),   P0[14],P0[15],P1[0],P1[1],   pw1[2]=PKW(P0,12),pw1[3]=PKW(P0,14), pw1); \
    VRD(2); SBAR(); GAPA(C0=__builtin_amdgcn_mfma_f32_32x32x16_bf16(kf[4],qr[2],C0,0,0,0),   P1[2],P1[3],P1[4],P1[5],     pw2[0]=PKW(P1,0), pw2[1]=PKW(P1,2), pw2); \
    VRD(6); SBAR(); GAPA(C1=__builtin_amdgcn_mfma_f32_32x32x16_bf16(kf[5],qr[2],C1,0,0,0),   P1[6],P1[7],P1[8],P1[9],     pw2[2]=PKW(P1,4), pw2[3]=PKW(P1,6), pw2); \
    VRD(3); SBAR(); GAPA(C0=__builtin_amdgcn_mfma_f32_32x32x16_bf16(kf[6],qr[3],C0,0,0,0),   P1[10],P1[11],P1[12],P1[13], pw3[0]=PKW(P1,8), pw3[1]=PKW(P1,10), pw3); \
    VRD(7); SBAR(); GAPA(C1=__builtin_amdgcn_mfma_f32_32x32x16_bf16(kf[7],qr[3],C1,0,0,0),   P1[14],P1[15],0.f,0.f,       pw3[2]=PKW(P1,12),pw3[3]=PKW(P1,14), pw3); \
    l_reg+=sacc; \
    if(GK){DMA_K((t)+3,sl_cur);} if(GV){DMA_V((t)+1,sl_next);} \
    CMASK(C0,C1,t); \
    { float a=MX3(C0[0],C0[1],C1[0]),b=MX3(C0[2],C0[3],C1[1]); a=MX3(a,C1[2],C1[3]); \
      _Pragma("unroll") for(int r=4;r<16;r+=4){a=MX3(a,C0[r],C0[r+1]);b=MX3(b,C0[r+2],C0[r+3]);a=MX3(a,C1[r],C1[r+1]);b=MX3(b,C1[r+2],C1[r+3]);} \
      float rm=__builtin_fmaxf(a,b); { auto rr=__builtin_amdgcn_permlane32_swap(__float_as_uint(rm),__float_as_uint(rm),false,false); rm=__builtin_fmaxf(__uint_as_float(rr[0]),__uint_as_float(rr[1])); } \
      resc=false; \
      if(__builtin_expect(__any(rm>(float)THRL),0)){ const float dl=__builtin_fmaxf(rm,0.f); mhat+=dl; \
        _Pragma("unroll") for(int r=0;r<16;++r){C0[r]-=dl;C1[r]-=dl;} \
        _Pragma("unroll") for(int r=0;r<16;++r)negm[r]=-mhat; asm volatile("":"+v"(negm)); \
        const float f=__builtin_amdgcn_exp2f(-dl); l_reg*=f; if(hi==0)wsf[r32]=f; resc=true; } } \
    SBAR(); \
    GAPB(o[0]=__builtin_amdgcn_mfma_f32_32x32x16_bf16(PAF(0),VFR(0),o[0],0,0,0), C0,0); \
    GAPB(o[1]=__builtin_amdgcn_mfma_f32_32x32x16_bf16(PAF(0),VFR(4),o[1],0,0,0), C0,4); \
    KRD(GL,0); GAPB(o[0]=__builtin_amdgcn_mfma_f32_32x32x16_bf16(PAF(1),VFR(1),o[0],0,0,0), C0,8); \
    KRD(GL,1); GAPB(o[1]=__builtin_amdgcn_mfma_f32_32x32x16_bf16(PAF(1),VFR(5),o[1],0,0,0), C0,12); \
    KRD(GL,2); GAPB(o[0]=__builtin_amdgcn_mfma_f32_32x32x16_bf16(PAF(2),VFR(2),o[0],0,0,0), C1,0); \
    KRD(GL,3); GAPB(o[1]=__builtin_amdgcn_mfma_f32_32x32x16_bf16(PAF(2),VFR(6),o[1],0,0,0), C1,4); \
    GAPB(o[0]=__builtin_amdgcn_mfma_f32_32x32x16_bf16(PAF(3),VFR(3),o[0],0,0,0), C1,8); \
    GAPB(o[1]=__builtin_amdgcn_mfma_f32_32x32x16_bf16(PAF(3),VFR(7),o[1],0,0,0), C1,12); \
    }while(0)
  int t=1;
  #undef CMASK
  #define CMASK(P0,P1,t) do{}while(0)
  for(;t+7<NT;t+=2){
    STEP(pB0,pB1,pA0,pA1,t,true,true,true);     WAIT_BAR(2); RESC(); ROT();
    STEP(pA0,pA1,pB0,pB1,t+1,true,true,true);   WAIT_BAR(2); RESC(); ROT();
  }
  #undef CMASK
  #define CMASK(P0,P1,t) do{int jb_=(t)-(NT-4); if(jb_>=-2){cbias(P0,P1,jb_,qrel,hi,tab); if(jb_>=0)cmask(P0,P1,jb_,qrel,hi);}}while(0)
  #define ENDW(tt) do{ if((tt)+3<NT){WAIT_BAR(2);} else if((tt)+2<NT){WAIT_BAR(1);} else {WAIT_BAR(0);} }while(0)
  for(;t+1<NT;t+=2){
    STEP(pB0,pB1,pA0,pA1,t,(t+3<NT),(t+1<NT),(t+1<NT));       ENDW(t);   RESC(); ROT();
    STEP(pA0,pA1,pB0,pB1,t+1,(t+4<NT),(t+2<NT),(t+2<NT));     ENDW(t+1); RESC(); ROT();
  }
  STEP(pB0,pB1,pA0,pA1,NT-1,false,false,false); RESC();
  { float sacc=pB0[0]+pB0[1]; _Pragma("unroll") for(int r=2;r<16;++r)sacc+=pB0[r]; _Pragma("unroll") for(int r=0;r<16;++r)sacc+=pB1[r]; l_reg+=sacc;
    pw0=(u32x4){PKW(pB0,0),PKW(pB0,2),PKW(pB0,4),PKW(pB0,6)};pw1=(u32x4){PKW(pB0,8),PKW(pB0,10),PKW(pB0,12),PKW(pB0,14)};pw2=(u32x4){PKW(pB1,0),PKW(pB1,2),PKW(pB1,4),PKW(pB1,6)};pw3=(u32x4){PKW(pB1,8),PKW(pB1,10),PKW(pB1,12),PKW(pB1,14)};
    SBAR(); pv(o,vb0+sl_cur,PAF(0),PAF(1),PAF(2),PAF(3)); }
  #undef PKW
  #undef PAF
  #undef VFR
  #undef PIN
  #undef MX3
  #undef GAPA
  #undef GAPB
  #undef EX
  #undef VRD
  #undef KRD
  #undef STEP
  #undef ENDW
  {auto rr=__builtin_amdgcn_permlane32_swap(__float_as_uint(l_reg),__float_as_uint(l_reg),false,false);l_reg=__uint_as_float(rr[0])+__uint_as_float(rr[1]);}
  if(hi==0)wsf[32+r32]=l_reg;asm volatile("s_waitcnt lgkmcnt(0)":::"memory");
  float rli[16];
  #pragma unroll
  for(int r=0;r<16;++r)rli[r]=__builtin_amdgcn_rcpf(wsf[32+crow(r,hi)]);
  bf16*Ow=O+(rowbase+q0+wid*QBLK)*DM+hv*D;
  { bf16*stg=(bf16*)(shm+LDS_OST)+wid*2048;
    #pragma unroll
    for(int r=0;r<16;++r){const int orow=crow(r,hi);
      #pragma unroll
      for(int d0=0;d0<2;++d0)stg[orow*64+d0*32+r32]=__float2bfloat16(o[d0][r]*rli[r]);}
    asm volatile("s_waitcnt lgkmcnt(0)":::"memory");
    #pragma unroll
    for(int i=0;i<4;++i){const int row=i*8+(lane>>3),ch=lane&7; const u32x4 v=*(const u32x4*)(stg+row*64+ch*8); ATTN_STORE16(Ow+(long)row*DM+ch*8,v);} }
  asm volatile("s_waitcnt lgkmcnt(0)\n\ts_barrier":::"memory");
  #undef DMA_K
  #undef DMA_V
  #undef CMASK
  #undef START
  #undef RESC
  #undef ROT
}
constexpr int ATTN_LDS_BYTES=LDS_BYTES;
struct AttnTensors { const bf16* Q; const bf16* K; const bf16* V; bf16* O1; bf16* O2; const float* biastab; };
struct AttnUnit { int b, hqk, hv, c, qb; };
struct StaticOrder {
  int vcu;
  __device__ __forceinline__ explicit StaticOrder(int grid,int block):vcu((grid%8==0)?(block%8)*(grid/8)+block/8:block){}
  __device__ __forceinline__ bool next(int i,AttnUnit&u)const{ if(i>=16)return false; const int v=vcu&255; u.b=v>>5; const int h=(v>>2)&7,c=(v>>1)&1,hf=v&1; u.hqk=2*h+c; u.hv=2*h+hf; u.c=c; u.qb=(i&1)?15-(i>>1):(i>>1); return true; }
};
template<class Sched,int THRL=8> __device__ __forceinline__ void attn_phase(char*lds,const AttnTensors&T,const Sched&S){
  AttnUnit u; int cur_h=-1;
  for(int i=0;S.next(i,u);++i){
    if((u.hqk>>1)!=cur_h){ cur_h=u.hqk>>1;
      if(threadIdx.x<128)((float*)(lds+LDS_TAB))[threadIdx.x]=T.biastab[cur_h*128+threadIdx.x];
      asm volatile("s_waitcnt vmcnt(0) lgkmcnt(0)\n\ts_barrier":::"memory"); }
    attn_unit<THRL>(u.b,u.hqk,u.hv,u.qb,T.Q,T.K,T.V,u.c?T.O2:T.O1,lds); }
}
#undef SBAR
#undef WAIT_BAR
}
#ifndef PG8_SP2
#define PG8_SP2 true
#endif
#ifndef PG8_ALIGN
#define PG8_ALIGN true
#endif
constexpr int NWAVES = 8;
#ifndef MK_N_LAUNCHES
#define MK_N_LAUNCHES 1
#endif
constexpr int N_PHASES = 8;
constexpr int BATCH = 8, SEQ = 4096, D = 2048, M = BATCH * SEQ;
constexpr int NPROJ = 5120, DATT = 1024, DCONV = 1024, CONVW = 31;
constexpr int PH = 8, PNK = 128, PHALF = 128, PTOPK = 16, NEXP = 16384;
constexpr float LN_EPS = 1e-5f;
constexpr float DN_ALPHA = 1.189207115002721f;
constexpr float LAMBDA_INIT = 0.2f;
constexpr size_t MiB = 1u << 20;
constexpr size_t WS_WIN = 2 * MiB, WS_WOUT = 22 * MiB, WS_WQ = 30 * MiB, WS_KEYS = 38 * MiB, WS_TAB = 39 * MiB;
constexpr size_t WS_U8 = 40 * MiB, WS_V8 = 72 * MiB, WS_SU = 104 * MiB, WS_SV = 105 * MiB;
constexpr size_t WS_XB = 168 * MiB;
constexpr size_t WS_Q = 296 * MiB, WS_K = 360 * MiB, WS_V = 424 * MiB, WS_H = 488 * MiB;
constexpr size_t WS_O1 = 552 * MiB, WS_O2 = 616 * MiB;
constexpr size_t WS_Y1 = 680 * MiB;
constexpr size_t WS_QP = 808 * MiB;
constexpr size_t WS_X8 = WS_O1;
constexpr size_t WS_SX = 106 * MiB, WS_SWQ = 107 * MiB, WS_SWIN = WS_SWQ + 65536, WS_SXA = 108 * MiB;
constexpr size_t WS_CMAX = 16384;
constexpr size_t WS_EID = 936 * MiB, WS_GATE = 952 * MiB;
constexpr size_t WS_END = 968 * MiB;
constexpr int RING_BYTES = 131072, LDS_BYTES = 147456;

#define GAS __attribute__((address_space(1)))
#define LAS __attribute__((address_space(3)))
typedef unsigned short bf16;
typedef unsigned v4u __attribute__((ext_vector_type(4)));
typedef unsigned v2u __attribute__((ext_vector_type(2)));
typedef float f32x4 __attribute__((ext_vector_type(4)));
typedef float f32x16 __attribute__((ext_vector_type(16)));
typedef short bf16x8 __attribute__((ext_vector_type(8)));
typedef __bf16 bf16x2_t __attribute__((ext_vector_type(2)));
#define LDS_WAIT() asm volatile("s_waitcnt lgkmcnt(0)" ::: "memory")
__device__ __forceinline__ unsigned f2bf(float f) { unsigned u = __builtin_bit_cast(unsigned, f); return (u + 0x7fffu + ((u >> 16) & 1u)) >> 16; }
__device__ __forceinline__ unsigned pk2(float lo, float hi) { return f2bf(lo) | (f2bf(hi) << 16); }
__device__ __forceinline__ float bflo(unsigned w) { return __uint_as_float(w << 16); }
__device__ __forceinline__ float bfhi(unsigned w) { return __uint_as_float(w & 0xffff0000u); }
__device__ __forceinline__ float wave_sum(float v) {
#pragma unroll
    for (int o = 1; o < 64; o <<= 1) v += __shfl_xor(v, o);
    return v;
}
__device__ __forceinline__ float dot2bf(unsigned a, unsigned b, float acc) { return __builtin_amdgcn_fdot2_f32_bf16(__builtin_bit_cast(bf16x2_t, a), __builtin_bit_cast(bf16x2_t, b), acc, false); }

#define XB_TMO      128
#define XB_XCNT(j)  (256  + 64 * (j))
#define XB_XSUB(j)  (1280 + 64 * (j))
#define XB_XGEN(j)  (2304 + 64 * (j))
#define XB_TOP      3328
#define XB_TOPGEN   3392
#define XCD_BAR_WORDS 3456
#define XB_SPIN_CAP (1u << 18)

__device__ __forceinline__ unsigned xb_ld(unsigned* p)              { return __hip_atomic_load(p, __ATOMIC_RELAXED, __HIP_MEMORY_SCOPE_AGENT); }
__device__ __forceinline__ unsigned xb_add(unsigned* p, unsigned v) { return __hip_atomic_fetch_add(p, v, __ATOMIC_RELAXED, __HIP_MEMORY_SCOPE_AGENT); }
__device__ __forceinline__ unsigned xb_xcc_id() { return (unsigned)__builtin_amdgcn_s_getreg((3 << 11) | 20) & 0xFu; }
#define XB_SPIN(cond, bar) do { unsigned _sp = 0; while (cond) { __builtin_amdgcn_s_sleep(1); \
    if ((++_sp & 255u) == 0u) { if (xb_ld(&(bar)[XB_TMO])) break; if (_sp > XB_SPIN_CAP) { atomicAdd(&(bar)[XB_TMO], 1u); break; } } } } while (0)

struct XcdBarrier {
    unsigned* bar; unsigned x;
    volatile LAS unsigned* st;
};

__device__ __forceinline__ XcdBarrier xcd_barrier_post(unsigned* bar, volatile LAS unsigned* st) {
    XcdBarrier b; b.bar = bar; b.x = xb_xcc_id(); b.st = st;
    if (threadIdx.x == 0) (void)xb_add(&bar[XB_XCNT(b.x)], 1u);
    return b;
}
__device__ __forceinline__ void xcd_barrier_complete(unsigned* bar, unsigned x, unsigned& nloc, unsigned& nx) {
    const unsigned G = gridDim.x * gridDim.y * gridDim.z;
    unsigned sum, cnt, mine, sp = 0u;
    for (;;) {
        sum = 0u; cnt = 0u; mine = 0u;
#pragma unroll
        for (unsigned j = 0; j < 16; ++j) { const unsigned c = xb_ld(&bar[XB_XCNT(j)]); sum += c; cnt += (c > 0u) ? 1u : 0u; mine = (j == x) ? c : mine; }
        if (sum == G) break;
        __builtin_amdgcn_s_sleep(1);
        if ((++sp & 255u) == 0u) { if (xb_ld(&bar[XB_TMO])) break; if (sp > XB_SPIN_CAP) { atomicAdd(&bar[XB_TMO], 1u); break; } }
    }
    nloc = mine > 0u ? mine : 1u; nx = cnt > 0u ? cnt : 1u;
}

__device__ __forceinline__ void xcd_barrier(const XcdBarrier& b) {
    asm volatile("s_waitcnt vmcnt(0)" ::: "memory");
    __syncthreads();
    if (threadIdx.x == 0) {
        unsigned* bar = b.bar;
        __builtin_amdgcn_s_waitcnt(0);
        unsigned nloc = b.st[0], nx = b.st[1];
        if (nloc == 0u) { xcd_barrier_complete(bar, b.x, nloc, nx); b.st[0] = nloc; b.st[1] = nx; }
        const unsigned old = xb_add(&bar[XB_XSUB(b.x)], 1u);
        const unsigned gen = old / nloc;
        if (old + 1u == (gen + 1u) * nloc) {
            __builtin_amdgcn_fence(__ATOMIC_RELEASE, "agent");
            asm volatile("s_waitcnt vmcnt(0)" ::: "memory");
            const unsigned og = xb_add(&bar[XB_TOP], 1u);
            const unsigned tg = og / nx;
            if (og + 1u == (tg + 1u) * nx) xb_add(&bar[XB_TOPGEN], 1u);
            else XB_SPIN(xb_ld(&bar[XB_TOPGEN]) == tg, bar);
            __builtin_amdgcn_fence(__ATOMIC_ACQUIRE, "agent");
            xb_add(&bar[XB_XGEN(b.x)], 1u);
            asm volatile("s_waitcnt vmcnt(0)" ::: "memory");
        } else {
            XB_SPIN(xb_ld(&bar[XB_XGEN(b.x)]) == gen, bar);
            __builtin_amdgcn_fence(__ATOMIC_ACQUIRE, "agent");
            asm volatile("s_waitcnt vmcnt(0)" ::: "memory");
        }
    }
    __syncthreads();
}

struct Frame {
    LAS unsigned char* lds;
    __device__ __forceinline__ int wave_() const { int w = __builtin_amdgcn_readfirstlane((int)threadIdx.x >> 6); asm volatile("" : "+s"(w)); return w; }
    __device__ __forceinline__ int G_() const { int g = (int)gridDim.x; asm volatile("" : "+s"(g)); return g; }
    __device__ __forceinline__ int vcu_() const { int bx = (int)blockIdx.x; asm volatile("" : "+s"(bx)); const int g = G_(); return (g % 8 == 0) ? (bx % 8) * (g / 8) + bx / 8 : bx; }
    __device__ __forceinline__ int tid() const { int t = (int)threadIdx.x; asm volatile("" : "+v"(t)); return t; }
    __device__ __forceinline__ int lane() const { return tid() & 63; }
    __device__ __forceinline__ unsigned long long raw(int k) const { const volatile LAS unsigned* p = (const volatile LAS unsigned*)(lds + RING_BYTES) + 2 * k;
        const unsigned lo = __builtin_amdgcn_readfirstlane(p[0]), hi = __builtin_amdgcn_readfirstlane(p[1]); return ((unsigned long long)hi << 32) | lo; }
    __device__ __forceinline__ const float* in(int k) const { return (const float*)raw(k); }
    __device__ __forceinline__ float* outp() const { return (float*)raw(22); }
    template <class T> __device__ __forceinline__ T* ws(size_t off) const { return (T*)((unsigned char*)raw(23) + off); }
};
enum { I_X = 0, I_WIN, I_BGLU, I_CONVW, I_CONVB, I_CLNG, I_CLNB, I_LQ1, I_LK1, I_LQ2, I_LK2, I_SUBLN, I_RELB, I_WOUT, I_LN1G, I_LN1B, I_WQ, I_KEYS, I_U, I_V, I_LN2G, I_LN2B };

__device__ __forceinline__ unsigned pack_i8x4(float a, float b, float c, float d) {
    const int ia = (int)rintf(a), ib = (int)rintf(b), ic = (int)rintf(c), id = (int)rintf(d); return (unsigned)(ia & 255) | ((unsigned)(ib & 255) << 8) | ((unsigned)(ic & 255) << 16) | ((unsigned)id << 24); }
__device__ __forceinline__ void p0_transpose_item(const float* W, int K, int N, bf16* WT, int k0, int n0, int dst0, LAS float* scr, int lane) {
#pragma unroll 8
    for (int i = 0; i < 32; ++i) { const int kk = 2 * i + (lane >> 5); scr[kk * 33 + (lane & 31)] = W[(size_t)(k0 + kk) * N + n0 + (lane & 31)]; }
    LDS_WAIT(); asm volatile("" ::: "memory");
    const int c = lane & 7;
#pragma unroll
    for (int j = 0; j < 4; ++j) { const int n = (lane >> 3) + 8 * j; const LAS float* s = scr + (8 * c) * 33 + n;
        v4u o; o.x = pk2(s[0 * 33], s[1 * 33]); o.y = pk2(s[2 * 33], s[3 * 33]); o.z = pk2(s[4 * 33], s[5 * 33]); o.w = pk2(s[6 * 33], s[7 * 33]);
        *(GAS v4u*)(WT + (size_t)(dst0 + n) * K + k0 + 8 * c) = o; }
    LDS_WAIT(); asm volatile("" ::: "memory");
}
__device__ __forceinline__ void p0_colmax_item(const float* W, int N, unsigned* cmax, int k0, int n0, int dst0, int lane) {
    float am = 0.f;
#pragma unroll 8
    for (int i = 0; i < 32; ++i) { const int kk = 2 * i + (lane >> 5); am = fmaxf(am, fabsf(W[(size_t)(k0 + kk) * N + n0 + (lane & 31)])); }
    am = fmaxf(am, __shfl_xor(am, 32));
    if (lane < 32) atomicMax(cmax + dst0 + lane, __float_as_uint(am));
}
__device__ __forceinline__ void p0_quant_item(const float* W, int N, unsigned char* WT8, const unsigned* cmax, float* scale, int k0, int n0, int dst0, LAS float* scr, int lane) {
#pragma unroll 8
    for (int i = 0; i < 32; ++i) { const int kk = 2 * i + (lane >> 5); scr[kk * 33 + (lane & 31)] = W[(size_t)(k0 + kk) * N + n0 + (lane & 31)]; }
    if (lane < 32) { const float am = __uint_as_float(__hip_atomic_load(cmax + dst0 + lane, __ATOMIC_RELAXED, __HIP_MEMORY_SCOPE_AGENT)); const float sc = am > 0.f ? am * (1.f / 127.f) : 1.f;
        scr[64 * 33 + lane] = 1.f / sc; if (k0 == 0) scale[dst0 + lane] = sc; }
    LDS_WAIT(); asm volatile("" ::: "memory");
    const int c = lane & 7;
#pragma unroll
    for (int j = 0; j < 4; ++j) { const int n = (lane >> 3) + 8 * j; const LAS float* sp = scr + (8 * c) * 33 + n; const float inv = scr[64 * 33 + n];
        *(GAS v2u*)(WT8 + (size_t)(dst0 + n) * D + k0 + 8 * c) = (v2u){pack_i8x4(sp[0 * 33] * inv, sp[1 * 33] * inv, sp[2 * 33] * inv, sp[3 * 33] * inv), pack_i8x4(sp[4 * 33] * inv, sp[5 * 33] * inv, sp[6 * 33] * inv, sp[7 * 33] * inv)}; }
    LDS_WAIT(); asm volatile("" ::: "memory");
}
__device__ __forceinline__ int glu_dst(int n0) {
    if (n0 < 3072) return n0;
    const int ch = (n0 - 3072) & 1023, gate = (n0 - 3072) >> 10; return 3072 + 256 * (ch >> 7) + 128 * gate + (ch & 127);
}
__device__ __forceinline__ void p0_quant_x(const float* src, unsigned char* dst8, float* scale, int rows, int gw, int NGW, int lane) {
    for (int r = gw; r < rows; r += NGW) {
        const GAS f32x4* sp = (const GAS f32x4*)(src + (size_t)r * D) + lane; f32x4 v[8]; float am = 0.f;
#pragma unroll
        for (int j = 0; j < 8; ++j) { v[j] = sp[64 * j]; am = fmaxf(fmaxf(am, fmaxf(fabsf(v[j].x), fabsf(v[j].y))), fmaxf(fabsf(v[j].z), fabsf(v[j].w))); }
#pragma unroll
        for (int o = 1; o < 64; o <<= 1) am = fmaxf(am, __shfl_xor(am, o));
        const float sc = am > 0.f ? am * (1.f / 127.f) : 1.f, inv = 1.f / sc;
        GAS unsigned* dp = (GAS unsigned*)(dst8 + (size_t)r * D) + lane;
#pragma unroll
        for (int j = 0; j < 8; ++j) dp[64 * j] = pack_i8x4(v[j].x * inv, v[j].y * inv, v[j].z * inv, v[j].w * inv);
        if (lane == 0) scale[r] = sc;
    }
}
__device__ __forceinline__ void p0_convert(const float* src, bf16* dst, size_t n, int gw, int NGW, int lane) {
    const size_t nit = n / 512;
    for (size_t it = gw; it < nit; it += NGW) { const GAS f32x4* s = (const GAS f32x4*)(src + it * 512) + 2 * lane; const f32x4 a = s[0], b = s[1];
        v4u o; o.x = pk2(a.x, a.y); o.y = pk2(a.z, a.w); o.z = pk2(b.x, b.y); o.w = pk2(b.z, b.w); *((GAS v4u*)(dst + it * 512) + lane) = o; }
}
template <bool INT8> __device__ __forceinline__ void p0_quant_rows(const float* src, unsigned* dst8, float* scale, int rows, int gw, int NGW, int lane) {
    for (int r = gw; r < rows; r += NGW) {
        const GAS f32x4* sp = (const GAS f32x4*)(src + (size_t)r * D) + lane; f32x4 v[8]; float am = 0.f;
#pragma unroll
        for (int j = 0; j < 8; ++j) { v[j] = sp[64 * j]; am = fmaxf(fmaxf(am, fmaxf(fabsf(v[j].x), fabsf(v[j].y))), fmaxf(fabsf(v[j].z), fabsf(v[j].w))); }
#pragma unroll
        for (int o = 1; o < 64; o <<= 1) am = fmaxf(am, __shfl_xor(am, o));
        const float sc = am > 0.f ? am * (INT8 ? (1.f / 127.f) : (1.f / 440.f)) : 1.f, inv = 1.f / sc;
#pragma unroll
        for (int j = 0; j < 8; ++j) { int w;
            if (INT8) w = (int)pack_i8x4(v[j].x * inv, v[j].y * inv, v[j].z * inv, v[j].w * inv);
            else { w = __builtin_amdgcn_cvt_pk_fp8_f32(v[j].x * inv, v[j].y * inv, 0, false); w = __builtin_amdgcn_cvt_pk_fp8_f32(v[j].z * inv, v[j].w * inv, w, true); }
            const int wi = lane + 64 * j, c = wi >> 5; *((GAS unsigned*)dst8 + ((size_t)c * rows + r) * 32 + (wi & 31)) = (unsigned)w; }
        if (lane == 0) scale[r] = sc;
    }
}
__device__ __forceinline__ int t5_bucket(int d) {
    if (d < 16) return d;
    int l = 16 + (int)(logf((float)d / 16.f) / logf(8.f) * 16.f); return l < 31 ? l : 31;
}
__device__ __forceinline__ void p0a_prologue(Frame& F) {
    LAS float* scr = (LAS float*)(F.lds + F.wave_() * 16384);
    constexpr int I_IN = (D / 64) * (NPROJ / 32), I_OUT = (D / 64) * (D / 32);
    { const float* w_in = F.in(I_WIN); unsigned* cmax = F.ws<unsigned>(WS_CMAX); const int gw = F.vcu_() * NWAVES + F.wave_(), NGW = F.G_() * NWAVES;
      for (int r = gw; r < I_IN; r += NGW) { const int nblk = NPROJ / 32, kb = r / nblk, nb = r % nblk; p0_colmax_item(w_in, NPROJ, cmax, 64 * kb, 32 * nb, glu_dst(32 * nb), F.lane()); } }
    { const float* wq = F.in(I_WQ); unsigned* cmax = F.ws<unsigned>(WS_CMAX) + NPROJ; const int gw = F.vcu_() * NWAVES + F.wave_(), NGW = F.G_() * NWAVES;
      for (int r = gw; r < I_OUT; r += NGW) { const int nblk = D / 32, kb = r / nblk, nb = r % nblk; p0_colmax_item(wq, D, cmax, 64 * kb, 32 * nb, 32 * nb, F.lane()); } }
    { const float* w_out = F.in(I_WOUT); bf16* Wout_t = F.ws<bf16>(WS_WOUT); const int gw = F.vcu_() * NWAVES + F.wave_(), NGW = F.G_() * NWAVES;
      for (int r = gw; r < I_OUT; r += NGW) { const int nblk = D / 32, kb = r / nblk, nb = r % nblk; p0_transpose_item(w_out, D, D, Wout_t, 64 * kb, 32 * nb, 32 * nb, scr, F.lane()); } }
    { const int gw = F.vcu_() * NWAVES + F.wave_(), NGW = F.G_() * NWAVES; p0_quant_x(F.in(I_X), F.ws<unsigned char>(WS_XB), F.ws<float>(WS_SXA), M, gw, NGW, F.lane()); }
    { const int gw = F.vcu_() * NWAVES + F.wave_(), NGW = F.G_() * NWAVES; p0_quant_rows<true>(F.in(I_U), F.ws<unsigned>(WS_U8), F.ws<float>(WS_SU), NEXP, gw, NGW, F.lane()); }
    { const int gw = F.vcu_() * NWAVES + F.wave_(), NGW = F.G_() * NWAVES; p0_quant_rows<false>(F.in(I_V), F.ws<unsigned>(WS_V8), F.ws<float>(WS_SV), NEXP, gw, NGW, F.lane()); }
    { const int gw = F.vcu_() * NWAVES + F.wave_(), NGW = F.G_() * NWAVES; p0_convert(F.in(I_KEYS), F.ws<bf16>(WS_KEYS), (size_t)PH * 2 * PNK * PHALF, gw, NGW, F.lane()); }
    if (blockIdx.x == 0) { const float* rel_bias = F.in(I_RELB); float* TAB = F.ws<float>(WS_TAB);
        for (int i = F.tid(); i < 8 * 128; i += NWAVES * 64) { const int h = i >> 7, d = i & 127;
            TAB[i] = (rel_bias[t5_bucket(d) * 8 + h] - rel_bias[31 * 8 + h]) * 1.4426950408889634f; } }
}
__device__ __forceinline__ void p0b_prologue(Frame& F) {
    LAS float* scr = (LAS float*)(F.lds + F.wave_() * 16384);
    constexpr int I_IN = (D / 64) * (NPROJ / 32), I_OUT = (D / 64) * (D / 32);
    { const float* w_in = F.in(I_WIN); unsigned char* W8 = F.ws<unsigned char>(WS_WIN); const unsigned* cmax = F.ws<unsigned>(WS_CMAX); float* sw = F.ws<float>(WS_SWIN); const int gw = F.vcu_() * NWAVES + F.wave_(), NGW = F.G_() * NWAVES;
      for (int r = gw; r < I_IN; r += NGW) { const int nblk = NPROJ / 32, kb = r / nblk, nb = r % nblk; p0_quant_item(w_in, NPROJ, W8, cmax, sw, 64 * kb, 32 * nb, glu_dst(32 * nb), scr, F.lane()); } }
    { const float* wq = F.in(I_WQ); unsigned char* W8 = F.ws<unsigned char>(WS_WQ); const unsigned* cmax = F.ws<unsigned>(WS_CMAX) + NPROJ; float* sw = F.ws<float>(WS_SWQ); const int gw = F.vcu_() * NWAVES + F.wave_(), NGW = F.G_() * NWAVES;
      for (int r = gw; r < I_OUT; r += NGW) { const int nblk = D / 32, kb = r / nblk, nb = r % nblk; p0_quant_item(wq, D, W8, cmax, sw, 64 * kb, 32 * nb, 32 * nb, scr, F.lane()); } }
}

__device__ __forceinline__ float diff_lambda(Frame& F) {
    const float a = wave_sum(F.in(I_LQ1)[F.lane()] * F.in(I_LK1)[F.lane()]), b = wave_sum(F.in(I_LQ2)[F.lane()] * F.in(I_LK2)[F.lane()]);
    return expf(a) - expf(b) + LAMBDA_INIT;
}
__device__ __forceinline__ void p3_combine(Frame& F) {
    const float lam = diff_lambda(F);
    const float* subln_g = F.in(I_SUBLN); const bf16* O1 = F.ws<bf16>(WS_O1); const bf16* O2 = F.ws<bf16>(WS_O2); bf16* MIX = F.ws<bf16>(WS_XB);
    const int gw = F.vcu_() * NWAVES + F.wave_(), NGW = F.G_() * NWAVES;
    float g[16];
#pragma unroll
    for (int e = 0; e < 16; ++e) g[e] = subln_g[16 * (F.lane() & 7) + e] * (1.f - LAMBDA_INIT);
    for (int m = gw; m < M; m += NGW) {
        const GAS v4u* p1 = (const GAS v4u*)(O1 + (size_t)m * 1024) + 2 * F.lane(); const GAS v4u* p2 = (const GAS v4u*)(O2 + (size_t)m * 1024) + 2 * F.lane();
        const v4u a0 = p1[0], a1 = p1[1], b0 = p2[0], b1 = p2[1];
        const unsigned aw[8] = {a0.x, a0.y, a0.z, a0.w, a1.x, a1.y, a1.z, a1.w}, bw[8] = {b0.x, b0.y, b0.z, b0.w, b1.x, b1.y, b1.z, b1.w};
        float v[16]; float ss = 0.f;
#pragma unroll
        for (int i = 0; i < 8; ++i) { v[2 * i] = bflo(aw[i]) - lam * bflo(bw[i]); v[2 * i + 1] = bfhi(aw[i]) - lam * bfhi(bw[i]); ss += v[2 * i] * v[2 * i] + v[2 * i + 1] * v[2 * i + 1]; }
        ss += __shfl_xor(ss, 1); ss += __shfl_xor(ss, 2); ss += __shfl_xor(ss, 4);
        const float r = 1.f / sqrtf(ss * (1.f / 128.f) + LN_EPS);
        v4u o0, o1;
        o0.x = pk2(v[0] * r * g[0], v[1] * r * g[1]); o0.y = pk2(v[2] * r * g[2], v[3] * r * g[3]); o0.z = pk2(v[4] * r * g[4], v[5] * r * g[5]); o0.w = pk2(v[6] * r * g[6], v[7] * r * g[7]);
        o1.x = pk2(v[8] * r * g[8], v[9] * r * g[9]); o1.y = pk2(v[10] * r * g[10], v[11] * r * g[11]); o1.z = pk2(v[12] * r * g[12], v[13] * r * g[13]); o1.w = pk2(v[14] * r * g[14], v[15] * r * g[15]);
        GAS v4u* po = (GAS v4u*)(MIX + (size_t)m * D) + 2 * F.lane(); po[0] = o0; po[1] = o1;
    }
}
__device__ __forceinline__ void p3_conv(Frame& F) {
    constexpr int TT = 32, NR = TT + CONVW - 1, STATS_OFF = NR * 2048;
    const int tid = F.tid();
    const float* conv_w = F.in(I_CONVW); const bf16* H = F.ws<bf16>(WS_H); bf16* MIX = F.ws<bf16>(WS_XB);
    float w0[CONVW], w1[CONVW];
#pragma unroll
    for (int j = 0; j < CONVW; ++j) { const float2 w = *(const float2*)(conv_w + j * DCONV + 2 * tid); w0[j] = w.x; w1[j] = w.y; }
    const float2 cb = *(const float2*)(F.in(I_CONVB) + 2 * tid), lg = *(const float2*)(F.in(I_CLNG) + 2 * tid), lb = *(const float2*)(F.in(I_CLNB) + 2 * tid);
    LAS unsigned* tile = (LAS unsigned*)F.lds; LAS float* stats = (LAS float*)(F.lds + STATS_OFF);
    for (int tile_i = F.vcu_(); tile_i < M / TT; tile_i += F.G_()) {
        const int t0 = tile_i * TT, s0 = t0 & (SEQ - 1);
        for (int r = tid >> 7; r < NR; r += 4) { const int sp = s0 - (CONVW - 1) + r; v4u val = (v4u){0u, 0u, 0u, 0u};
            if (sp >= 0) val = *((const GAS v4u*)(H + (size_t)(t0 - (CONVW - 1) + r) * 1024) + (tid & 127));
            *(LAS v4u*)(F.lds + r * 2048 + (tid & 127) * 16) = val; }
        __syncthreads();
        for (int i = 0; i < TT; ++i) {
            float a0 = cb.x, a1 = cb.y;
#pragma unroll
            for (int j = 0; j < CONVW; ++j) { const unsigned wv = tile[(i + j) * 512 + tid]; a0 += w0[j] * bflo(wv); a1 += w1[j] * bfhi(wv); }
            const unsigned pk = pk2(a0, a1); tile[i * 512 + tid] = pk;
            const float r0 = bflo(pk), r1 = bfhi(pk);
            const float s = wave_sum(r0 + r1), q = wave_sum(r0 * r0 + r1 * r1);
            if (F.lane() == 0) { stats[(i * 8 + F.wave_()) * 2] = s; stats[(i * 8 + F.wave_()) * 2 + 1] = q; }
        }
        __syncthreads();
        for (int i = 0; i < TT; ++i) {
            float s = 0.f, q = 0.f;
#pragma unroll
            for (int w = 0; w < 8; ++w) { s += stats[(i * 8 + w) * 2]; q += stats[(i * 8 + w) * 2 + 1]; }
            const float mean = s * (1.f / DCONV), var = fmaxf(q * (1.f / DCONV) - mean * mean, 0.f), rstd = 1.f / sqrtf(var + LN_EPS);
            const unsigned pk = tile[i * 512 + tid];
            const float y0 = (bflo(pk) - mean) * rstd * lg.x + lb.x, y1 = (bfhi(pk) - mean) * rstd * lg.y + lb.y;
            const float z0 = y0 * __builtin_amdgcn_rcpf(1.f + __builtin_amdgcn_exp2f(-1.4426950409f * y0)), z1 = y1 * __builtin_amdgcn_rcpf(1.f + __builtin_amdgcn_exp2f(-1.4426950409f * y1));
            *((GAS unsigned*)(MIX + (size_t)(t0 + i) * D + DATT) + tid) = pk2(z0, z1);
        }
        __syncthreads();
    }
}
__device__ __forceinline__ void p5_ln1(Frame& F) {
    bf16* Y1 = F.ws<bf16>(WS_Y1); const float* ln1_g = F.in(I_LN1G); const float* ln1_b = F.in(I_LN1B); unsigned char* X8 = F.ws<unsigned char>(WS_X8); float* SX = F.ws<float>(WS_SX);
    const int gw = F.vcu_() * NWAVES + F.wave_(), NGW = F.G_() * NWAVES;
    for (int m = gw; m < M; m += NGW) {
        GAS v4u* p = (GAS v4u*)(Y1 + (size_t)m * D) + F.lane();
        v4u w[4]; float v[32]; float s = 0.f;
#pragma unroll
        for (int j = 0; j < 4; ++j) { w[j] = p[64 * j]; const unsigned ww[4] = {w[j].x, w[j].y, w[j].z, w[j].w};
#pragma unroll
            for (int i = 0; i < 4; ++i) { v[8 * j + 2 * i] = bflo(ww[i]); v[8 * j + 2 * i + 1] = bfhi(ww[i]); s += v[8 * j + 2 * i] + v[8 * j + 2 * i + 1]; } }
        const float mean = wave_sum(s) * (1.f / D); float q = 0.f;
#pragma unroll
        for (int i = 0; i < 32; ++i) { v[i] -= mean; q += v[i] * v[i]; }
        const float rstd = 1.f / sqrtf(wave_sum(q) * (1.f / D) + LN_EPS);
#pragma unroll
        for (int j = 0; j < 4; ++j) { const int c0 = 8 * F.lane() + 512 * j; const f32x4 g0 = *(const f32x4*)(ln1_g + c0), g1 = *(const f32x4*)(ln1_g + c0 + 4), b0 = *(const f32x4*)(ln1_b + c0), b1 = *(const f32x4*)(ln1_b + c0 + 4);
            v4u o; o.x = pk2(v[8 * j] * rstd * g0[0] + b0[0], v[8 * j + 1] * rstd * g0[1] + b0[1]); o.y = pk2(v[8 * j + 2] * rstd * g0[2] + b0[2], v[8 * j + 3] * rstd * g0[3] + b0[3]);
            o.z = pk2(v[8 * j + 4] * rstd * g1[0] + b1[0], v[8 * j + 5] * rstd * g1[1] + b1[1]); o.w = pk2(v[8 * j + 6] * rstd * g1[2] + b1[2], v[8 * j + 7] * rstd * g1[3] + b1[3]);
            p[64 * j] = o; }
        float am = 0.f;
#pragma unroll
        for (int j = 0; j < 4; ++j) { const int c0 = 8 * F.lane() + 512 * j; const f32x4 g0 = *(const f32x4*)(ln1_g + c0), g1 = *(const f32x4*)(ln1_g + c0 + 4), b0 = *(const f32x4*)(ln1_b + c0), b1 = *(const f32x4*)(ln1_b + c0 + 4);
#pragma unroll
            for (int i = 0; i < 4; ++i) { v[8 * j + i] = v[8 * j + i] * rstd * g0[i] + b0[i]; v[8 * j + 4 + i] = v[8 * j + 4 + i] * rstd * g1[i] + b1[i]; am = fmaxf(am, fmaxf(fabsf(v[8 * j + i]), fabsf(v[8 * j + 4 + i]))); } }
#pragma unroll
        for (int o = 1; o < 64; o <<= 1) am = fmaxf(am, __shfl_xor(am, o));
        const float sc = am > 0.f ? am * (1.f / 127.f) : 1.f, inv = 1.f / sc;
        GAS v2u* p8 = (GAS v2u*)(X8 + (size_t)m * D) + F.lane();
#pragma unroll
        for (int j = 0; j < 4; ++j) p8[64 * j] = (v2u){pack_i8x4(v[8 * j] * inv, v[8 * j + 1] * inv, v[8 * j + 2] * inv, v[8 * j + 3] * inv), pack_i8x4(v[8 * j + 4] * inv, v[8 * j + 5] * inv, v[8 * j + 6] * inv, v[8 * j + 7] * inv)};
        if (F.lane() == 0) SX[m] = sc;
    }
}
__device__ __forceinline__ int f2key(float f) { const int b = __float_as_int(f); return b ^ ((b >> 31) & 0x7fffffff); }
__device__ __forceinline__ float key2f(int k) { return __int_as_float(k ^ ((k >> 31) & 0x7fffffff)); }
#define CE_DESC(a, b) do { const int _x = max(a, b), _y = min(a, b); a = _x; b = _y; } while (0)
#define CE_ASC(a, b)  do { const int _x = min(a, b), _y = max(a, b); a = _x; b = _y; } while (0)
template <int N> __device__ __forceinline__ void sort_desc(int (&v)[N]) {
#pragma unroll
    for (int k = 2; k <= N; k <<= 1)
#pragma unroll
        for (int j = k >> 1; j > 0; j >>= 1)
#pragma unroll
            for (int i = 0; i < N; ++i) { const int l = i ^ j; if (l > i) { if ((i & k) == 0) CE_DESC(v[i], v[l]); else CE_ASC(v[i], v[l]); } }
}
template <int N> __device__ __forceinline__ void bitonic_merge_desc(int (&v)[N]) {
#pragma unroll
    for (int j = N >> 1; j > 0; j >>= 1)
#pragma unroll
        for (int i = 0; i < N; ++i) { const int l = i ^ j; if (l > i) CE_DESC(v[i], v[l]); }
}
__device__ __forceinline__ void merge16(const int (&a)[16], const int (&b)[16], int (&o)[16]) {
#pragma unroll
    for (int i = 0; i < 16; ++i) o[i] = max(a[i], b[15 - i]);
    bitonic_merge_desc<16>(o);
}
__device__ __forceinline__ void top16_of_64(const int (&v)[64], int (&o)[16]) {
    int g0[16], g1[16], g2[16], g3[16];
#pragma unroll
    for (int i = 0; i < 16; ++i) { g0[i] = v[i]; g1[i] = v[16 + i]; g2[i] = v[32 + i]; g3[i] = v[48 + i]; }
    sort_desc<16>(g0); sort_desc<16>(g1); sort_desc<16>(g2); sort_desc<16>(g3);
    int m0[16], m1[16]; merge16(g0, g1, m0); merge16(g2, g3, m1); merge16(m0, m1, o);
}
__device__ const unsigned char PEER_PAIR[64] = {0,1,2,3,4,5,6,7,8,9,10,11,12,13,14,15, 16,17,18,19,20,21,22,23, 32,33,34,35,36, 48,49,50,51, 64,65,66, 80,81, 96,97, 112,113, 128,144,160,176,192,208,224,240, 0,0,0,0,0,0,0,0,0,0,0,0,0,0};
__device__ __forceinline__ void peer_subkey_top16(const bf16* qrow  , const bf16* keys_hc  , int r32, int hi, int (&o)[16]) {
    bf16x8 bq[8];
    asm volatile("" : "+v"(qrow));
#pragma unroll
    for (int s = 0; s < 8; ++s) bq[s] = *(const bf16x8*)(qrow + 8 * s);
    int run[16];
#pragma unroll
    for (int mt = 0; mt < 4; ++mt) {
        const bf16* krow = keys_hc + (size_t)(32 * mt + r32) * PHALF + hi * 64;
        asm volatile("" : "+v"(krow));
        bf16x8 ka[8];
#pragma unroll
        for (int s = 0; s < 8; ++s) ka[s] = *(const bf16x8*)(krow + 8 * s);
        asm volatile("" ::: "memory");
        f32x16 acc = {};
#pragma unroll
        for (int s = 0; s < 8; ++s) acc = __builtin_amdgcn_mfma_f32_32x32x16_bf16(ka[s], bq[s], acc, 0, 0, 0);
        int g[16];
#pragma unroll
        for (int r = 0; r < 16; ++r) g[r] = (f2key(acc[r]) & ~127) | ((r & 3) + 8 * (r >> 2));
        sort_desc<16>(g);
        if (mt) {
#pragma unroll
            for (int r = 0; r < 16; ++r) g[r] |= 32 * mt; }
        if (mt == 0) {
#pragma unroll
            for (int r = 0; r < 16; ++r) run[r] = g[r];
        } else { int t2[16]; merge16(run, g, t2);
#pragma unroll
            for (int r = 0; r < 16; ++r) run[r] = t2[r]; }
    }
    int lo[16], hh[16]; const int hi4 = 4 * hi;
#pragma unroll
    for (int i = 0; i < 16; ++i) { run[i] |= hi4; auto rr = __builtin_amdgcn_permlane32_swap((unsigned)run[i], (unsigned)run[i], false, false); lo[i] = (int)rr[0]; hh[i] = (int)rr[1]; }
    merge16(lo, hh, o);
}
__device__ __forceinline__ float gelu_erf(float v) { return 0.5f * v * (1.f + erff(v * 0.70710678118654752f)); }

template <int CTRL> __device__ __forceinline__ int dppi(int v) { return __builtin_amdgcn_update_dpp(0, v, CTRL, 0xf, 0xf, true); }
template <int CTRL> __device__ __forceinline__ float dppf(float v) { return __int_as_float(__builtin_amdgcn_update_dpp(0, __float_as_int(v), CTRL, 0xf, 0xf, true)); }
typedef float f32x2 __attribute__((ext_vector_type(2)));
constexpr int P7_ACT = 0, P7_EID = 65536, P7_SCR = 0  , P7_SCR_WAVE = 32 * 33 * 4, PCH = 128, NCH = D / PCH;
static_assert(P7_SCR + NWAVES * P7_SCR_WAVE <= P7_EID && P7_EID + 128 * 128 * 2 <= RING_BYTES, "PEER LDS map");

__device__ __forceinline__ void p7_peer(Frame& F) {
    const int lane = F.lane(), r32 = lane & 31, hi = lane >> 5, j8 = lane & 7, g8 = lane >> 3;
    constexpr int TPB = 128;
    LAS float* ACT = (LAS float*)(F.lds + P7_ACT); LAS unsigned short* EIDL = (LAS unsigned short*)(F.lds + P7_EID);
    LAS int* scr = (LAS int*)(F.lds + P7_SCR + F.wave_() * P7_SCR_WAVE);
    for (int blk = F.vcu_(); blk < M / TPB; blk += F.G_()) {
        const int m0 = blk * TPB;
        { const int h = F.wave_(); const bf16* QP = F.ws<bf16>(WS_QP); const bf16* KEYS = F.ws<bf16>(WS_KEYS); float* GATE = F.ws<float>(WS_GATE);
          for (int tt = 0; tt < 4; ++tt) {
            const int tl = 32 * tt + r32, tok = m0 + tl;
            const bf16* qrow = QP + (size_t)tok * D + h * 256 + hi * 64;
            int s1[16], s2[16];
            peer_subkey_top16(qrow, KEYS + (size_t)(h * 2 + 0) * PNK * PHALF, r32, hi, s1);
            asm volatile("" ::: "memory");
            peer_subkey_top16(qrow + 128, KEYS + (size_t)(h * 2 + 1) * PNK * PHALF, r32, hi, s2);
            float f1[16], f2[16];
#pragma unroll
            for (int i = 0; i < 16; ++i) { f1[i] = key2f(s1[i]); f2[i] = key2f(s2[i]); }
            if (hi == 0) {
#pragma unroll
                for (int i = 0; i < 16; ++i) { scr[r32 * 33 + i] = s1[i] & 127; scr[r32 * 33 + 16 + i] = s2[i] & 127; } }
            int cand[64];
            {
#define PC(n_, i_, j_) cand[n_] = (f2key(f1[i_] + f2[j_]) & ~255) | (n_)
                PC(0,0,0); PC(1,0,1); PC(2,0,2); PC(3,0,3); PC(4,0,4); PC(5,0,5); PC(6,0,6); PC(7,0,7); PC(8,0,8); PC(9,0,9); PC(10,0,10); PC(11,0,11); PC(12,0,12); PC(13,0,13); PC(14,0,14); PC(15,0,15);
                PC(16,1,0); PC(17,1,1); PC(18,1,2); PC(19,1,3); PC(20,1,4); PC(21,1,5); PC(22,1,6); PC(23,1,7);
                PC(24,2,0); PC(25,2,1); PC(26,2,2); PC(27,2,3); PC(28,2,4);
                PC(29,3,0); PC(30,3,1); PC(31,3,2); PC(32,3,3);
                PC(33,4,0); PC(34,4,1); PC(35,4,2);
                PC(36,5,0); PC(37,5,1); PC(38,6,0); PC(39,6,1); PC(40,7,0); PC(41,7,1);
                PC(42,8,0); PC(43,9,0); PC(44,10,0); PC(45,11,0); PC(46,12,0); PC(47,13,0); PC(48,14,0); PC(49,15,0);
#undef PC
            }
#pragma unroll
            for (int i = 50; i < 64; ++i) cand[i] = (int)0x80000000;
            int sc[16]; top16_of_64(cand, sc);
            float p[16]; const float mx = key2f(sc[0]); float z = 0.f;
#pragma unroll
            for (int k = 0; k < 16; ++k) { p[k] = __expf(key2f(sc[k]) - mx); z += p[k]; }
            const float rz = 1.f / z;
            LDS_WAIT();
            int eo[8]; float go[8]; const int him = -hi;
#pragma unroll
            for (int kk = 0; kk < 8; ++kk) { const int tag = PEER_PAIR[((sc[kk] & ~him) | (sc[8 + kk] & him)) & 255];
                const int i1 = scr[r32 * 33 + (tag >> 4)], i2 = scr[r32 * 33 + 16 + (tag & 15)];
                eo[kk] = i1 * PNK + i2; go[kk] = __int_as_float((__float_as_int(p[kk]) & ~him) | (__float_as_int(p[8 + kk]) & him)) * rz; }
            *(LAS v4u*)(EIDL + tl * 128 + h * 16 + 8 * hi) = (v4u){(unsigned)(eo[0] | (eo[1] << 16)), (unsigned)(eo[2] | (eo[3] << 16)), (unsigned)(eo[4] | (eo[5] << 16)), (unsigned)(eo[6] | (eo[7] << 16))};
            GAS float* gp = (GAS float*)(GATE + (size_t)tok * 128 + h * 16 + 8 * hi);
            *(GAS f32x4*)gp = (f32x4){go[0], go[1], go[2], go[3]}; *(GAS f32x4*)(gp + 4) = (f32x4){go[4], go[5], go[6], go[7]};
            LDS_WAIT();
          } }
        __threadfence_block(); __syncthreads();
        const int tw = F.wave_() * (TPB / NWAVES);
        for (int i = lane; i < (TPB / NWAVES) * 128; i += 64) ACT[tw * 128 + i] = 0.f;
        { const unsigned char* X8 = F.ws<unsigned char>(WS_X8); const unsigned char* U8 = F.ws<unsigned char>(WS_U8);
#define U_ISSUE(n_, PC, XQ) do { const int c_ = (n_) >> 4, tl_ = tw + ((n_) & 15); \
            XQ = *(const GAS v4u*)(X8 + (size_t)(m0 + tl_) * D + c_ * PCH + 16 * j8); \
            const LAS unsigned short* ep_ = EIDL + tl_ * 128 + g8; const unsigned char* ub_ = U8 + (size_t)c_ * (NEXP * PCH) + 16 * j8; \
            _Pragma("unroll") for (int i = 0; i < 16; ++i) { const unsigned e_ = ep_[8 * i]; PC[i] = *(const GAS v4u*)(ub_ + e_ * PCH); } } while (0)
#define U_COMPUTE(n_, PC, XQ) do { const int tl_ = tw + ((n_) & 15); \
            int pp_[16]; \
            _Pragma("unroll") for (int i = 0; i < 16; ++i) { int a_ = __builtin_amdgcn_sdot4((int)PC[i].x, (int)XQ.x, 0, false); a_ = __builtin_amdgcn_sdot4((int)PC[i].y, (int)XQ.y, a_, false); \
                a_ = __builtin_amdgcn_sdot4((int)PC[i].z, (int)XQ.z, a_, false); pp_[i] = __builtin_amdgcn_sdot4((int)PC[i].w, (int)XQ.w, a_, false); } \
              \
            int q8_[8], q4_[4], q2_[2]; \
            { const bool b2_ = lane & 4; _Pragma("unroll") for (int i = 0; i < 8; ++i) { const int k_ = b2_ ? pp_[2 * i + 1] : pp_[2 * i], s_ = b2_ ? pp_[2 * i] : pp_[2 * i + 1]; q8_[i] = k_ + dppi<0x141>(s_); } } \
            { const bool b1_ = lane & 2; _Pragma("unroll") for (int i = 0; i < 4; ++i) { const int k_ = b1_ ? q8_[2 * i + 1] : q8_[2 * i], s_ = b1_ ? q8_[2 * i] : q8_[2 * i + 1]; q4_[i] = k_ + dppi<0x4E>(s_); } } \
            { const bool b0_ = lane & 1; _Pragma("unroll") for (int i = 0; i < 2; ++i) { const int k_ = b0_ ? q4_[2 * i + 1] : q4_[2 * i], s_ = b0_ ? q4_[2 * i] : q4_[2 * i + 1]; q2_[i] = k_ + dppi<0xB1>(s_); } } \
            const int irow_ = ((lane & 1) << 2) | (lane & 2) | ((lane >> 2) & 1); \
            LAS float* ap_ = ACT + tl_ * 128 + 8 * irow_ + g8; ap_[0] += (float)q2_[0]; ap_[64] += (float)q2_[1]; } while (0)
          constexpr int NSTEP = NCH * (TPB / NWAVES);
          v4u pcA[16], pcB[16], xqA, xqB;
          U_ISSUE(0, pcA, xqA);
          for (int n = 0; n < NSTEP; n += 2) {
              U_ISSUE(n + 1, pcB, xqB); __builtin_amdgcn_sched_barrier(0);
              U_COMPUTE(n, pcA, xqA); __builtin_amdgcn_sched_barrier(0);
              { const int nn = (n + 2 < NSTEP) ? n + 2 : n; U_ISSUE(nn, pcA, xqA); }
              __builtin_amdgcn_sched_barrier(0);
              U_COMPUTE(n + 1, pcB, xqB); __builtin_amdgcn_sched_barrier(0);
          }
#undef U_ISSUE
#undef U_COMPUTE
        }
        LDS_WAIT();
        { const float* SU = F.ws<float>(WS_SU); const float* SV = F.ws<float>(WS_SV); const float* GATE = F.ws<float>(WS_GATE); const float* SX = F.ws<float>(WS_SX);
        for (int ti = 0; ti < TPB / NWAVES; ++ti) {
            const int tl = tw + ti, t = m0 + tl; const float sx = SX[t];
#pragma unroll
            for (int kq = 0; kq < 2; ++kq) { const int k = lane + 64 * kq; const unsigned e = EIDL[tl * 128 + k]; const float a = ACT[tl * 128 + k] * SU[e] * sx;
                ACT[tl * 128 + k] = __builtin_nontemporal_load(GATE + (size_t)t * 128 + k) * gelu_erf(a) * SV[e]; }
        } }
        LDS_WAIT();
        { const bf16* X1 = F.ws<bf16>(WS_Y1); const unsigned char* V8 = F.ws<unsigned char>(WS_V8); float* outp = F.outp();
#define V_ISSUE(n_, PC, WK, XP) do { const int c_ = (n_) >> 4, tl_ = tw + ((n_) & 15); \
            const LAS unsigned short* ep_ = EIDL + tl_ * 128 + g8; const LAS float* wp_ = ACT + tl_ * 128 + g8; const unsigned char* vb_ = V8 + (size_t)c_ * (NEXP * PCH) + 16 * j8; \
            _Pragma("unroll") for (int i = 0; i < 16; ++i) { const unsigned e_ = ep_[8 * i]; WK[i] = wp_[8 * i]; PC[i] = *(const GAS v4u*)(vb_ + e_ * PCH); } \
            XP = *(const GAS unsigned*)(X1 + (size_t)(m0 + tl_) * D + c_ * PCH + 16 * j8 + 2 * g8); } while (0)
#define V_COMPUTE(n_, PC, WK, XP) do { const int c_ = (n_) >> 4, tl_ = tw + ((n_) & 15); \
            f32x2 acc_[8]; \
            _Pragma("unroll") for (int d = 0; d < 8; ++d) acc_[d] = (f32x2){0.f, 0.f}; \
            _Pragma("unroll") for (int i = 0; i < 16; ++i) { const unsigned w4_[4] = {PC[i].x, PC[i].y, PC[i].z, PC[i].w}; const f32x2 w2_ = {WK[i], WK[i]}; \
                _Pragma("unroll") for (int d = 0; d < 4; ++d) { acc_[2 * d] = __builtin_amdgcn_cvt_pk_f32_fp8((int)w4_[d], false) * w2_ + acc_[2 * d]; acc_[2 * d + 1] = __builtin_amdgcn_cvt_pk_f32_fp8((int)w4_[d], true) * w2_ + acc_[2 * d + 1]; } } \
              \
            float a16_[16]; \
            _Pragma("unroll") for (int d = 0; d < 8; ++d) { a16_[2 * d] = acc_[d].x; a16_[2 * d + 1] = acc_[d].y; } \
            float r8_[8], r4_[4], r2_[2]; \
            _Pragma("unroll") for (int i = 0; i < 8; ++i) { auto rr_ = __builtin_amdgcn_permlane32_swap(__float_as_uint(a16_[i]), __float_as_uint(a16_[i + 8]), false, false); r8_[i] = __uint_as_float(rr_[0]) + __uint_as_float(rr_[1]); } \
            _Pragma("unroll") for (int i = 0; i < 4; ++i) { auto rr_ = __builtin_amdgcn_permlane16_swap(__float_as_uint(r8_[i]), __float_as_uint(r8_[i + 4]), false, false); r4_[i] = __uint_as_float(rr_[0]) + __uint_as_float(rr_[1]); } \
            { const bool b3_ = lane & 8; _Pragma("unroll") for (int i = 0; i < 2; ++i) { const float k_ = b3_ ? r4_[i + 2] : r4_[i], s_ = b3_ ? r4_[i] : r4_[i + 2]; r2_[i] = k_ + dppf<0x128>(s_); } } \
            GAS f32x2* op_ = (GAS f32x2*)(outp + (size_t)(m0 + tl_) * D + c_ * PCH + 16 * j8 + 2 * g8); \
            *op_ = (f32x2){r2_[0] + DN_ALPHA * bflo(XP), r2_[1] + DN_ALPHA * bfhi(XP)}; } while (0)
          constexpr int NSTEP = NCH * (TPB / NWAVES);
          v4u pcA[16], pcB[16]; float wkA[16], wkB[16]; unsigned xpA, xpB;
          V_ISSUE(0, pcA, wkA, xpA);
          for (int n = 0; n < NSTEP; n += 2) {
              V_ISSUE(n + 1, pcB, wkB, xpB); __builtin_amdgcn_sched_barrier(0);
              V_COMPUTE(n, pcA, wkA, xpA); __builtin_amdgcn_sched_barrier(0);
              { const int nn = (n + 2 < NSTEP) ? n + 2 : n; V_ISSUE(nn, pcA, wkA, xpA); }
              __builtin_amdgcn_sched_barrier(0);
              V_COMPUTE(n + 1, pcB, wkB, xpB); __builtin_amdgcn_sched_barrier(0);
          }
#undef V_ISSUE
#undef V_COMPUTE
        }
        { const float* ln2_g = F.in(I_LN2G); const float* ln2_b = F.in(I_LN2B); float* outp = F.outp();
        for (int ti = 0; ti < TPB / NWAVES; ++ti) {
            const int t = m0 + tw + ti;
            GAS f32x4* rp = (GAS f32x4*)(outp + (size_t)t * D) + 2 * lane;
            f32x4 v[8]; float s = 0.f;
#pragma unroll
            for (int j = 0; j < 4; ++j) { v[2 * j] = rp[128 * j]; v[2 * j + 1] = rp[128 * j + 1]; }
#pragma unroll
            for (int j = 0; j < 8; ++j) s += (v[j].x + v[j].y) + (v[j].z + v[j].w);
            const float mean = wave_sum(s) * (1.f / D); float qv = 0.f;
#pragma unroll
            for (int j = 0; j < 8; ++j) { v[j] = v[j] - mean; qv += (v[j].x * v[j].x + v[j].y * v[j].y) + (v[j].z * v[j].z + v[j].w * v[j].w); }
            const float rstd = 1.f / sqrtf(wave_sum(qv) * (1.f / D) + LN_EPS);
#pragma unroll
            for (int j = 0; j < 4; ++j) { const int c0 = 8 * lane + 512 * j; const f32x4 g0 = *(const f32x4*)(ln2_g + c0), g1 = *(const f32x4*)(ln2_g + c0 + 4), b0 = *(const f32x4*)(ln2_b + c0), b1 = *(const f32x4*)(ln2_b + c0 + 4);
                rp[128 * j] = v[2 * j] * rstd * g0 + b0; rp[128 * j + 1] = v[2 * j + 1] * rstd * g1 + b1; }
        } }
        __syncthreads();
    }
}

struct Args { const float* in[22]; float* out; unsigned char* ws; int ph_lo, ph_hi; };
__global__ void __launch_bounds__(NWAVES * 64, 2) mk_fwd(Args args) {
    extern __shared__ __attribute__((aligned(16))) unsigned char lds[];
    cg::grid_group grid = cg::this_grid();
    Frame F;
    F.lds = (LAS unsigned char*)lds;
    if (threadIdx.x == 0) { LAS unsigned long long* PT = (LAS unsigned long long*)(F.lds + RING_BYTES);
#pragma unroll
        for (int k = 0; k < 22; ++k) PT[k] = (unsigned long long)args.in[k];
        PT[22] = (unsigned long long)args.out; PT[23] = (unsigned long long)args.ws;
        ((LAS unsigned*)(F.lds + RING_BYTES + 256))[0] = 0u; ((LAS unsigned*)(F.lds + RING_BYTES + 256))[1] = 0u; }
    __syncthreads();
    const int lo = args.ph_lo, hi = args.ph_hi;
#ifndef PHASE_MASK
#define PHASE_MASK 255
#endif
#define IN(k) (((PHASE_MASK >> (k)) & 1) && lo <= (k) && (k) < hi)
#ifndef REPEAT_PHASE
#define REPEAT_PHASE -1
#endif
#define REP(k) for (int rep_ = 0; rep_ < ((REPEAT_PHASE == (k)) ? 2 : 1); ++rep_)
    (void)xcd_barrier_post((unsigned*)args.ws, (volatile LAS unsigned*)(F.lds + RING_BYTES + 256));
#define SEAM(k) do { if (IN(k) && IN((k) + 1)) { { XcdBarrier bar_; bar_.bar = F.ws<unsigned>(0); bar_.x = xb_xcc_id(); bar_.st = (volatile LAS unsigned*)(F.lds + RING_BYTES + 256); xcd_barrier(bar_); } } } while (0)

    if (IN(0)) REP(0) { p0a_prologue(F); grid.sync(); p0b_prologue(F); } SEAM(0);
    if (IN(1)) REP(1) {
        pg8::Gemm g{F.ws<bf16>(WS_XB), F.ws<bf16>(WS_WIN), M, NPROJ, D / 2}; pg8::StaticOrder S; S.init(M, NPROJ, F.G_(), (int)blockIdx.x);
        pg8::EpiProjI8 E{F.ws<bf16>(WS_Q), (size_t)(WS_K - WS_Q) / 2, attn_body::C2, F.ws<bf16>(WS_H), F.in(I_BGLU), F.ws<float>(WS_SXA), F.ws<float>(WS_SWIN)};
        pg8::gemm_phase<pg8::EpiProjI8, pg8::StaticOrder, PG8_ALIGN, PG8_SP2>(F.lds, g, S, E);
    } SEAM(1);
    if (IN(2)) REP(2) {
        static_assert(attn_body::ATTN_LDS_BYTES <= RING_BYTES && attn_body::ATTN_PITCH == DATT, "attention body geometry vs frame");
        const attn_body::AttnTensors AT{F.ws<const attn_body::bf16>(WS_Q), F.ws<const attn_body::bf16>(WS_K), F.ws<const attn_body::bf16>(WS_V), F.ws<attn_body::bf16>(WS_O1), F.ws<attn_body::bf16>(WS_O2), F.ws<const float>(WS_TAB)};
        const attn_body::StaticOrder S((int)F.G_(), (int)blockIdx.x);
        attn_body::attn_phase<attn_body::StaticOrder>((char*)lds, AT, S);
    } SEAM(2);
    if (IN(3)) REP(3) { p3_combine(F); p3_conv(F); } SEAM(3);
    if (IN(4)) REP(4) {
        pg8::Gemm g{F.ws<bf16>(WS_XB), F.ws<bf16>(WS_WOUT), M, D, D}; pg8::StaticOrder S; S.init(M, D, F.G_(), (int)blockIdx.x);
        pg8::EpiRes E{F.in(I_X), F.ws<bf16>(WS_Y1), D, DN_ALPHA};
        pg8::gemm_phase<pg8::EpiRes, pg8::StaticOrder, PG8_ALIGN, PG8_SP2>(F.lds, g, S, E);
    } SEAM(4);
    if (IN(5)) REP(5) { p5_ln1(F); } SEAM(5);
    if (IN(6)) REP(6) {
        pg8::Gemm g{F.ws<bf16>(WS_X8), F.ws<bf16>(WS_WQ), M, D, D / 2}; pg8::StaticOrder S; S.init(M, D, F.G_(), (int)blockIdx.x);
        pg8::EpiPlainI8 E{F.ws<bf16>(WS_QP), D, F.ws<float>(WS_SX), F.ws<float>(WS_SWQ)};
        pg8::gemm_phase<pg8::EpiPlainI8, pg8::StaticOrder, PG8_ALIGN, PG8_SP2>(F.lds, g, S, E);
    } SEAM(6);
    if (IN(7)) REP(7) { p7_peer(F); }
#undef IN
#undef SEAM
}

extern "C" void kernel_launch(void* const* d_in, const int* in_sizes, int n_in, void* d_out, int out_size, void* d_ws, size_t ws_size, hipStream_t stream) {
    static int grid = 0;
    if (grid == 0) {
        if (n_in != 22 || in_sizes[0] != M * D || out_size != M * D || ws_size < WS_END) { fprintf(stderr, "kernel_launch: unexpected shapes (n_in %d, in0 %d, out %d, ws %zu); nothing launched\n", n_in, n_in > 0 ? in_sizes[0] : -1, out_size, ws_size); grid = -1; return; }
        int dev = 0, cus = 0, per_cu = 0;
        if (hipGetDevice(&dev) != hipSuccess || hipDeviceGetAttribute(&cus, hipDeviceAttributeMultiprocessorCount, dev) != hipSuccess) { grid = -1; return; }
        if (hipFuncSetAttribute((const void*)mk_fwd, hipFuncAttributeMaxDynamicSharedMemorySize, LDS_BYTES) != hipSuccess) { fprintf(stderr, "kernel_launch: hipFuncSetAttribute failed\n"); grid = -1; return; }
        if (hipOccupancyMaxActiveBlocksPerMultiprocessor(&per_cu, (const void*)mk_fwd, NWAVES * 64, LDS_BYTES) != hipSuccess || per_cu < 1) { fprintf(stderr, "kernel_launch: occupancy query reports %d workgroups per CU\n", per_cu); (void)hipGetLastError(); grid = -1; return; }
        grid = cus;
        if (grid > 256) grid = 256;
    }
    if (grid < 0) return;
    if (hipMemsetAsync(d_ws, 0, 65536, stream) != hipSuccess) { fprintf(stderr, "kernel_launch: hipMemsetAsync failed\n"); return; }
    Args a{};
    for (int i = 0; i < 22; ++i) a.in[i] = (const float*)d_in[i];
    a.out = (float*)d_out; a.ws = (unsigned char*)d_ws;
    constexpr int NL = MK_N_LAUNCHES;
    for (int li = 0; li < NL; ++li) {
        a.ph_lo = (NL == 1) ? 0 : li; a.ph_hi = (NL == 1) ? N_PHASES : li + 1;
        void* kargs[] = {&a};
        const hipError_t le = hipLaunchCooperativeKernel((const void*)mk_fwd, dim3(grid), dim3(NWAVES * 64), kargs, LDS_BYTES, stream);
        if (le != hipSuccess) { fprintf(stderr, "kernel_launch: cooperative launch %d failed: %s (grid %d)\n", li, hipGetErrorString(le), grid); break; }
    }
}
```

```cpp
#include <hip/hip_runtime.h>
#include <hip/hip_cooperative_groups.h>
#include <cstdio>
#include <cstdint>
namespace cg = cooperative_groups;
namespace pg8 {
#define PG8_LAS __attribute__((address_space(3)))
typedef unsigned short bf16_t;
typedef short bf16x8 __attribute__((ext_vector_type(8)));
typedef float f32x4 __attribute__((ext_vector_type(4)));
typedef unsigned u32x4 __attribute__((ext_vector_type(4)));
typedef int i32x4 __attribute__((ext_vector_type(4)));
constexpr int BM = 256, BK = 64, HALF = 128, HTB = HALF * BK * 2  , STAGE_BYTES = 8 * HTB, NXCD = 8, WGM = 8;

__host__ __device__ __forceinline__ int lds_byte(int r, int c) { const int st = (r >> 4) * 2 + (c >> 5), rr = r & 15, cc = c & 31, ob = rr * 64 + cc * 2; return st * 1024 + (ob ^ (((ob >> 9) & 1) << 5)); }
__host__ __device__ __forceinline__ void stage_rc(int b, int& R, int& C) { const int st = b / 1024, sb = b % 1024, swz = sb ^ (((sb >> 9) & 1) << 5); R = (st >> 1) * 16 + swz / 64; C = (st & 1) * 32 + (swz % 64) / 2; }
__host__ __device__ __forceinline__ int perm32(int rho) { const int n = rho >> 4, i = rho & 15; return 8 * (i >> 2) + 4 * n + (i & 3); }

struct Unit { int pm, pn; };
struct Gemm { const bf16_t* A; const bf16_t* Bt; int M, N, K; };

struct StaticOrder {
    int nM, nN, nwg, G, c;
    __host__ __device__ void init(int M, int N, int G_, int c_) { nM = M / BM; nN = N / BM; nwg = nM * nN; G = G_; c = c_; }
    __host__ __device__ bool next(int i, Unit& u) const {
        const long L = (long)i * G + c; if (L >= nwg) return false;
        int wgid = (int)L; { const int q = nwg / NXCD, r = nwg % NXCD, xcd = wgid % NXCD, off = wgid / NXCD; wgid = (xcd < r ? xcd * (q + 1) : r * (q + 1) + (xcd - r) * q) + off; }
        const int nig = WGM * nN, gid = wgid / nig, fm = gid * WGM, gsz = (nM - fm) < WGM ? (nM - fm) : WGM;
        u.pm = fm + ((wgid % nig) % gsz); u.pn = (wgid % nig) / gsz; return true;
    }
    __device__ __forceinline__ void a_ready(const Unit&) const {}
    __device__ __forceinline__ void done(const Unit&) const {}
};

__device__ __forceinline__ unsigned cvt_pk_bf16(float lo, float hi) { unsigned r; asm volatile("v_cvt_pk_bf16_f32 %0, %1, %2" : "=v"(r) : "v"(lo), "v"(hi)); return r; }
typedef float f32x2 __attribute__((ext_vector_type(2)));
typedef float f32x2 __attribute__((ext_vector_type(2)));
__device__ __forceinline__ u32x4 pack8(f32x4 v0, f32x4 v1) { u32x4 w; w.x = cvt_pk_bf16(v0[0], v0[1]); w.y = cvt_pk_bf16(v0[2], v0[3]); w.z = cvt_pk_bf16(v1[0], v1[1]); w.w = cvt_pk_bf16(v1[2], v1[3]); return w; }
__device__ __forceinline__ f32x4 i2f(f32x4 a) { const i32x4 v = __builtin_bit_cast(i32x4, a); return (f32x4){(float)v[0], (float)v[1], (float)v[2], (float)v[3]}; }
struct EpiProj {
    static constexpr bool PERM = true, AFTER_DRAIN = false, INT8 = false;
    bf16_t* QKV; size_t split_stride; float scale0; bf16_t* H; const float* bglu;
    __device__ __forceinline__ void operator()(const f32x4 (&acc)[2][2][4][2], const Unit& u, int wr, int wc, int fr, int fq) const {
        const int row0 = u.pm * BM + wr * 64 + fr;
        if (u.pn < 12) {
            const int t = u.pn >> 2; bf16_t* base = QKV + (size_t)t * split_stride; const float sc = (t == 0) ? scale0 : 1.f;
            const int col0 = (u.pn & 3) * BM + wc * 32 + 8 * fq;
#pragma unroll
            for (int ai = 0; ai < 2; ++ai)
#pragma unroll
                for (int m = 0; m < 4; ++m) { bf16_t* rowp = base + (size_t)(row0 + ai * HALF + m * 16) * 1024 + col0;
#pragma unroll
                    for (int bj = 0; bj < 2; ++bj) *(u32x4*)(rowp + bj * HALF) = pack8(acc[ai][bj][m][0] * sc, acc[ai][bj][m][1] * sc); }
        } else {
            const int ch0 = (u.pn - 12) * HALF + wc * 32 + 8 * fq;
            const f32x4 ba0 = *(const f32x4*)(bglu + ch0), ba1 = *(const f32x4*)(bglu + ch0 + 4), bg0 = *(const f32x4*)(bglu + 1024 + ch0), bg1 = *(const f32x4*)(bglu + 1024 + ch0 + 4);
#pragma unroll
            for (int ai = 0; ai < 2; ++ai)
#pragma unroll
                for (int m = 0; m < 4; ++m) {
                    const f32x4 a0 = acc[ai][0][m][0] + ba0, a1 = acc[ai][0][m][1] + ba1, g0 = acc[ai][1][m][0] + bg0, g1 = acc[ai][1][m][1] + bg1;
                    f32x4 h0, h1;
#pragma unroll
                    for (int e = 0; e < 4; ++e) { h0[e] = a0[e] * __builtin_amdgcn_rcpf(1.f + __builtin_amdgcn_exp2f(-1.4426950409f * g0[e])); h1[e] = a1[e] * __builtin_amdgcn_rcpf(1.f + __builtin_amdgcn_exp2f(-1.4426950409f * g1[e])); }
                    *(u32x4*)(H + (size_t)(row0 + ai * HALF + m * 16) * 1024 + ch0) = pack8(h0, h1); }
        }
    }
};
struct EpiProjI8 {
    static constexpr bool PERM = true, AFTER_DRAIN = false, INT8 = true;
    bf16_t* QKV; size_t split_stride; float scale0; bf16_t* H; const float* bglu; const float* sa; const float* sb;
    __device__ __forceinline__ void operator()(const f32x4 (&acc)[2][2][4][2], const Unit& u, int wr, int wc, int fr, int fq) const {
        const int row0 = u.pm * BM + wr * 64 + fr, cb = u.pn * BM + wc * 32 + 8 * fq;
        f32x4 cs[2][2];
#pragma unroll
        for (int bj = 0; bj < 2; ++bj) { cs[bj][0] = *(const f32x4*)(sb + cb + bj * HALF); cs[bj][1] = *(const f32x4*)(sb + cb + bj * HALF + 4); }
        if (u.pn < 12) {
            const int t = u.pn >> 2; bf16_t* base = QKV + (size_t)t * split_stride; const float sc = (t == 0) ? scale0 : 1.f;
            const int col0 = (u.pn & 3) * BM + wc * 32 + 8 * fq;
#pragma unroll
            for (int ai = 0; ai < 2; ++ai)
#pragma unroll
                for (int m = 0; m < 4; ++m) { const int row = row0 + ai * HALF + m * 16; const float rs = sa[row] * sc; bf16_t* rowp = base + (size_t)row * 1024 + col0;
#pragma unroll
                    for (int bj = 0; bj < 2; ++bj) *(u32x4*)(rowp + bj * HALF) = pack8(i2f(acc[ai][bj][m][0]) * cs[bj][0] * rs, i2f(acc[ai][bj][m][1]) * cs[bj][1] * rs); }
        } else {
            const int ch0 = (u.pn - 12) * HALF + wc * 32 + 8 * fq;
            const f32x4 ba0 = *(const f32x4*)(bglu + ch0), ba1 = *(const f32x4*)(bglu + ch0 + 4), bg0 = *(const f32x4*)(bglu + 1024 + ch0), bg1 = *(const f32x4*)(bglu + 1024 + ch0 + 4);
#pragma unroll
            for (int ai = 0; ai < 2; ++ai)
#pragma unroll
                for (int m = 0; m < 4; ++m) { const int row = row0 + ai * HALF + m * 16; const float rs = sa[row];
                    const f32x4 a0 = i2f(acc[ai][0][m][0]) * cs[0][0] * rs + ba0, a1 = i2f(acc[ai][0][m][1]) * cs[0][1] * rs + ba1, g0 = i2f(acc[ai][1][m][0]) * cs[1][0] * rs + bg0, g1 = i2f(acc[ai][1][m][1]) * cs[1][1] * rs + bg1;
                    f32x4 h0, h1;
#pragma unroll
                    for (int e = 0; e < 4; ++e) { h0[e] = a0[e] * __builtin_amdgcn_rcpf(1.f + __builtin_amdgcn_exp2f(-1.4426950409f * g0[e])); h1[e] = a1[e] * __builtin_amdgcn_rcpf(1.f + __builtin_amdgcn_exp2f(-1.4426950409f * g1[e])); }
                    *(u32x4*)(H + (size_t)row * 1024 + ch0) = pack8(h0, h1); }
        }
    }
};
struct EpiRes {
    static constexpr bool PERM = true, AFTER_DRAIN = false, INT8 = false;
    const float* X; bf16_t* Y; int ldc; float alpha;
    __device__ __forceinline__ void operator()(const f32x4 (&acc)[2][2][4][2], const Unit& u, int wr, int wc, int fr, int fq) const {
        const int row0 = u.pm * BM + wr * 64 + fr, col0 = u.pn * BM + wc * 32 + 8 * fq;
#pragma unroll
        for (int ai = 0; ai < 2; ++ai)
#pragma unroll
            for (int m = 0; m < 4; ++m) { const size_t off = (size_t)(row0 + ai * HALF + m * 16) * ldc + col0;
#pragma unroll
                for (int bj = 0; bj < 2; ++bj) { const f32x4 x0 = *(const f32x4*)(X + off + bj * HALF), x1 = *(const f32x4*)(X + off + bj * HALF + 4);
                    *(u32x4*)(Y + off + bj * HALF) = pack8(acc[ai][bj][m][0] + x0 * alpha, acc[ai][bj][m][1] + x1 * alpha); } }
    }
};
struct EpiPlainI8 {
    static constexpr bool PERM = true, AFTER_DRAIN = false, INT8 = true;
    bf16_t* O; int ldc; const float* sa; const float* sb;
    __device__ __forceinline__ void operator()(const f32x4 (&acc)[2][2][4][2], const Unit& u, int wr, int wc, int fr, int fq) const {
        const int row0 = u.pm * BM + wr * 64 + fr, col0 = u.pn * BM + wc * 32 + 8 * fq;
        f32x4 cs[2][2];
#pragma unroll
        for (int bj = 0; bj < 2; ++bj) { cs[bj][0] = *(const f32x4*)(sb + col0 + bj * HALF); cs[bj][1] = *(const f32x4*)(sb + col0 + bj * HALF + 4); }
#pragma unroll
        for (int ai = 0; ai < 2; ++ai)
#pragma unroll
            for (int m = 0; m < 4; ++m) { const int row = row0 + ai * HALF + m * 16; const float rs = sa[row]; bf16_t* rowp = O + (size_t)row * ldc + col0;
#pragma unroll
                for (int bj = 0; bj < 2; ++bj) *(u32x4*)(rowp + bj * HALF) = pack8(i2f(acc[ai][bj][m][0]) * cs[bj][0] * rs, i2f(acc[ai][bj][m][1]) * cs[bj][1] * rs); }
    }
};
struct EpiResI8 {
    static constexpr bool PERM = true, AFTER_DRAIN = false, INT8 = true;
    const float* X; bf16_t* Y; int ldc; float alpha; const float* sa; const float* sb;
    __device__ __forceinline__ void operator()(const f32x4 (&acc)[2][2][4][2], const Unit& u, int wr, int wc, int fr, int fq) const {
        const int row0 = u.pm * BM + wr * 64 + fr, col0 = u.pn * BM + wc * 32 + 8 * fq;
        f32x4 cs[2][2];
#pragma unroll
        for (int bj = 0; bj < 2; ++bj) { cs[bj][0] = *(const f32x4*)(sb + col0 + bj * HALF); cs[bj][1] = *(const f32x4*)(sb + col0 + bj * HALF + 4); }
#pragma unroll
        for (int ai = 0; ai < 2; ++ai)
#pragma unroll
            for (int m = 0; m < 4; ++m) { const int row = row0 + ai * HALF + m * 16; const float rs = sa[row]; const size_t off = (size_t)row * ldc + col0;
#pragma unroll
                for (int bj = 0; bj < 2; ++bj) { const f32x4 x0 = *(const f32x4*)(X + off + bj * HALF), x1 = *(const f32x4*)(X + off + bj * HALF + 4);
                    *(u32x4*)(Y + off + bj * HALF) = pack8(i2f(acc[ai][bj][m][0]) * cs[bj][0] * rs + x0 * alpha, i2f(acc[ai][bj][m][1]) * cs[bj][1] * rs + x1 * alpha); } }
    }
};
struct EpiPlain {
    static constexpr bool PERM = true, AFTER_DRAIN = false, INT8 = false;
    bf16_t* O; int ldc;
    __device__ __forceinline__ void operator()(const f32x4 (&acc)[2][2][4][2], const Unit& u, int wr, int wc, int fr, int fq) const {
        const int row0 = u.pm * BM + wr * 64 + fr, col0 = u.pn * BM + wc * 32 + 8 * fq;
#pragma unroll
        for (int ai = 0; ai < 2; ++ai)
#pragma unroll
            for (int m = 0; m < 4; ++m) { bf16_t* rowp = O + (size_t)(row0 + ai * HALF + m * 16) * ldc + col0;
#pragma unroll
                for (int bj = 0; bj < 2; ++bj) *(u32x4*)(rowp + bj * HALF) = pack8(acc[ai][bj][m][0], acc[ai][bj][m][1]); }
    }
};

template <class Epi, class Sched, bool ALIGN_EPI = false, bool SP2 = false>
__device__ __forceinline__ void gemm_phase(PG8_LAS unsigned char* lds, const Gemm g, const Sched& S, const Epi& E) {
    const int tid = threadIdx.x, wid = __builtin_amdgcn_readfirstlane(tid >> 6), lane = tid & 63, wr = wid >> 2, wc = wid & 3, fr = lane & 15, fq = lane >> 4;
    const int K = g.K, nt = K / BK;
    unsigned voffA[2], voffB[2];
#pragma unroll
    for (int i = 0; i < 2; ++i) { int R, C; stage_rc(tid * 16 + i * 8192, R, C); const int Rb = Epi::PERM ? ((R & ~31) + perm32(R & 31)) : R;
        voffA[i] = (unsigned)(R * K + C) * 2u; voffB[i] = (unsigned)(Rb * K + C) * 2u; }
    const size_t kstep = (size_t)(BK * 2);
    const size_t hstep = (size_t)HALF * K * 2;
    const size_t tstep = 2 * hstep;
    const unsigned ldsw = (unsigned)wid * 1024u;
    const int aoff = lds_byte(wr * 64 + fr, fq * 8), boff = lds_byte(wc * 32 + fr, fq * 8);
#define PG8_SA(b, h) (((b) * 2 + (h)) * HTB)
#define PG8_SB(b, h) ((4 + (b) * 2 + (h)) * HTB)
#define PG8_STAGE(bufoff, gbase, voff) do { _Pragma("unroll") for (int _i = 0; _i < 2; ++_i) \
        __builtin_amdgcn_global_load_lds((const unsigned*)((const char*)(gbase) + (voff)[_i]), (PG8_LAS unsigned*)(lds + (bufoff) + ldsw + _i * 8192), 16, 0, 0); } while (0)
#define PG8_LDA(dst, b, h) do { _Pragma("unroll") for (int m = 0; m < 4; ++m) _Pragma("unroll") for (int k = 0; k < 2; ++k) dst[m][k] = *(const PG8_LAS bf16x8*)(lds + PG8_SA(b, h) + aoff + m * 2048 + k * 1024); } while (0)
#define PG8_LDB(dst, b, h) do { _Pragma("unroll") for (int n = 0; n < 2; ++n) _Pragma("unroll") for (int k = 0; k < 2; ++k) dst[n][k] = *(const PG8_LAS bf16x8*)(lds + PG8_SB(b, h) + boff + n * 2048 + k * 1024); } while (0)
#define PG8_MMA(ai, bj, At, Bt) do { __builtin_amdgcn_s_setprio(1); _Pragma("unroll") for (int m = 0; m < 4; ++m) _Pragma("unroll") for (int n = 0; n < 2; ++n) _Pragma("unroll") for (int k = 0; k < 2; ++k) { \
        if constexpr (Epi::INT8) acc[ai][bj][m][n] = __builtin_bit_cast(f32x4, __builtin_amdgcn_mfma_i32_16x16x64_i8(__builtin_bit_cast(i32x4, Bt[n][k]), __builtin_bit_cast(i32x4, At[m][k]), __builtin_bit_cast(i32x4, acc[ai][bj][m][n]), 0, 0, 0)); \
        else acc[ai][bj][m][n] = __builtin_amdgcn_mfma_f32_16x16x32_bf16(Bt[n][k], At[m][k], acc[ai][bj][m][n], 0, 0, 0); } __builtin_amdgcn_s_setprio(0); } while (0)
#define PG8_WAIT_V(n) asm volatile("s_waitcnt vmcnt(" #n ")" ::: "memory")
#define PG8_WAIT_L(n) asm volatile("s_waitcnt lgkmcnt(" #n ")" ::: "memory")
#define PG8_BAR __builtin_amdgcn_s_barrier()
#define PG8_SCHED __builtin_amdgcn_sched_barrier(0)
    Unit cur, nxt; int ui = 0;
    if (!S.next(0, cur)) return;
    f32x4 acc[2][2][4][2];
#pragma unroll
    for (int a = 0; a < 2; ++a)
#pragma unroll
        for (int b = 0; b < 2; ++b)
#pragma unroll
            for (int m = 0; m < 4; ++m)
#pragma unroll
                for (int n = 0; n < 2; ++n) acc[a][b][m][n] = (f32x4){0.f, 0.f, 0.f, 0.f};
    bf16x8 At[4][2], B0[2][2], B1[2][2];
    const char* cA = (const char*)g.A + (size_t)cur.pm * tstep; const char* cB = (const char*)g.Bt + (size_t)cur.pn * tstep;
    S.a_ready(cur);
    if constexpr (SP2) {
        PG8_STAGE(PG8_SB(0, 0), cB, voffB); PG8_STAGE(PG8_SB(0, 1), cB + hstep, voffB); PG8_STAGE(PG8_SA(0, 0), cA, voffA); PG8_STAGE(PG8_SA(0, 1), cA + hstep, voffA);
        if (wr == 1) PG8_BAR;
        PG8_WAIT_V(2); PG8_BAR;
        PG8_STAGE(PG8_SB(1, 0), cB + kstep, voffB); PG8_STAGE(PG8_SA(1, 0), cA + kstep, voffA); PG8_STAGE(PG8_SB(1, 1), cB + hstep + kstep, voffB);
        PG8_WAIT_V(6); PG8_BAR;
    } else {
        PG8_STAGE(PG8_SB(0, 0), cB, voffB); PG8_STAGE(PG8_SA(0, 0), cA, voffA); PG8_STAGE(PG8_SB(0, 1), cB + hstep, voffB); PG8_STAGE(PG8_SA(0, 1), cA + hstep, voffA);
        if (wr == 1) PG8_BAR;
        PG8_WAIT_V(4); PG8_BAR;
        PG8_STAGE(PG8_SB(1, 0), cB + kstep, voffB); PG8_STAGE(PG8_SA(1, 0), cA + kstep, voffA); PG8_STAGE(PG8_SB(1, 1), cB + hstep + kstep, voffB);
        PG8_WAIT_V(6); PG8_BAR;
    }
    for (;;) {
        const bool has_next = S.next(ui + 1, nxt);
        const char* nA = has_next ? (const char*)g.A + (size_t)nxt.pm * tstep : cA; const char* nB = has_next ? (const char*)g.Bt + (size_t)nxt.pn * tstep : cB;
        for (int t = 0; t < nt; t += 2) {
            const bool last = (t == nt - 2);
            const char* a1 = cA + (size_t)(t + 1) * kstep;
            const char* a2 = last ? nA : cA + (size_t)(t + 2) * kstep; const char* b2 = last ? nB : cB + (size_t)(t + 2) * kstep;
            const char* a3 = a2 + kstep; const char* b3 = b2 + kstep;
            if (last && has_next) S.a_ready(nxt);
            if constexpr (SP2) {
            PG8_LDB(B0, 0, 0); PG8_LDB(B1, 0, 1); PG8_SCHED; PG8_LDA(At, 0, 0); PG8_STAGE(PG8_SA(1, 1), a1 + hstep, voffA);
            PG8_WAIT_V(8); PG8_WAIT_L(0); PG8_BAR; PG8_MMA(0, 0, At, B0); PG8_MMA(0, 1, At, B1); PG8_BAR; PG8_SCHED;
            PG8_LDA(At, 0, 1); PG8_STAGE(PG8_SB(0, 0), b2, voffB); PG8_STAGE(PG8_SB(0, 1), b2 + hstep, voffB); PG8_STAGE(PG8_SA(0, 0), a2, voffA);
            PG8_WAIT_V(8); PG8_WAIT_L(0); PG8_BAR; PG8_MMA(1, 0, At, B0); PG8_MMA(1, 1, At, B1); PG8_BAR; PG8_SCHED;
            PG8_LDB(B0, 1, 0); PG8_LDB(B1, 1, 1); PG8_SCHED; PG8_LDA(At, 1, 0); PG8_STAGE(PG8_SA(0, 1), a2 + hstep, voffA);
            PG8_WAIT_V(8); PG8_WAIT_L(0); PG8_BAR; PG8_MMA(0, 0, At, B0); PG8_MMA(0, 1, At, B1); PG8_BAR; PG8_SCHED;
            PG8_LDA(At, 1, 1); PG8_STAGE(PG8_SB(1, 0), b3, voffB); PG8_STAGE(PG8_SB(1, 1), b3 + hstep, voffB); PG8_STAGE(PG8_SA(1, 0), a3, voffA);
            PG8_WAIT_V(8); PG8_WAIT_L(0); PG8_BAR; PG8_MMA(1, 0, At, B0); PG8_MMA(1, 1, At, B1); PG8_BAR; PG8_SCHED;
            } else {
            PG8_LDB(B0, 0, 0); PG8_SCHED; PG8_LDA(At, 0, 0); PG8_STAGE(PG8_SA(1, 1), a1 + hstep, voffA);
            PG8_WAIT_L(8); PG8_BAR; PG8_WAIT_L(0); PG8_MMA(0, 0, At, B0); PG8_BAR; PG8_SCHED;
            PG8_LDB(B1, 0, 1); PG8_STAGE(PG8_SB(0, 0), b2, voffB);
            PG8_BAR; PG8_WAIT_L(0); PG8_MMA(0, 1, At, B1); PG8_BAR;
            PG8_LDA(At, 0, 1); PG8_STAGE(PG8_SA(0, 0), a2, voffA);
            PG8_BAR; PG8_WAIT_L(0); PG8_MMA(1, 0, At, B0); PG8_BAR; PG8_SCHED;
            PG8_STAGE(PG8_SB(0, 1), b2 + hstep, voffB);
            PG8_WAIT_V(6); PG8_BAR; PG8_MMA(1, 1, At, B1); PG8_BAR;
            PG8_LDB(B0, 1, 0); PG8_SCHED; PG8_LDA(At, 1, 0); PG8_STAGE(PG8_SA(0, 1), a2 + hstep, voffA);
            PG8_WAIT_L(8); PG8_BAR; PG8_WAIT_L(0); PG8_MMA(0, 0, At, B0); PG8_BAR; PG8_SCHED;
            PG8_LDB(B1, 1, 1); PG8_STAGE(PG8_SB(1, 0), b3, voffB);
            PG8_BAR; PG8_WAIT_L(0); PG8_MMA(0, 1, At, B1); PG8_BAR;
            PG8_LDA(At, 1, 1); PG8_STAGE(PG8_SA(1, 0), a3, voffA);
            PG8_BAR; PG8_WAIT_L(0); PG8_MMA(1, 0, At, B0); PG8_BAR; PG8_SCHED;
            PG8_STAGE(PG8_SB(1, 1), b3 + hstep, voffB);
            PG8_WAIT_V(6); PG8_BAR; PG8_MMA(1, 1, At, B1); PG8_BAR;
            }
        }
        if constexpr (ALIGN_EPI) { if (wr == 0) PG8_BAR; }
        if constexpr (!Epi::AFTER_DRAIN) { E(acc, cur, wr, wc, fr, fq); S.done(cur); }
        if (!has_next) break;
#pragma unroll
        for (int a = 0; a < 2; ++a)
#pragma unroll
            for (int b = 0; b < 2; ++b)
#pragma unroll
                for (int m = 0; m < 4; ++m)
#pragma unroll
                    for (int n = 0; n < 2; ++n) acc[a][b][m][n] = (f32x4){0.f, 0.f, 0.f, 0.f};
        cur = nxt; cA = nA; cB = nB; ++ui;
        if constexpr (ALIGN_EPI) { if (wr == 1) PG8_BAR; }
    }
    PG8_WAIT_V(0);
    if constexpr (!ALIGN_EPI) { if (wr == 0) PG8_BAR; }
    PG8_BAR;
    if constexpr (Epi::AFTER_DRAIN) { E.fused(acc, cur, wr, wc, fr, fq, lds, wid, lane); S.done(cur); }
#undef PG8_SA
#undef PG8_SB
#undef PG8_STAGE
#undef PG8_LDA
#undef PG8_LDB
#undef PG8_MMA
#undef PG8_WAIT_V
#undef PG8_WAIT_L
#undef PG8_BAR
#undef PG8_SCHED
}
}
#include <hip/hip_bf16.h>
#include <cmath>
namespace attn_body {
using bf16=__hip_bfloat16;
using bf16x8=__attribute__((ext_vector_type(8)))short;
using s16x4=__attribute__((ext_vector_type(4)))short;
using f32x16=__attribute__((ext_vector_type(16)))float;
using u32x4=__attribute__((ext_vector_type(4)))unsigned;
constexpr int BATCH=8,NHEAD=16,SEQ=4096,D=64,DM=NHEAD*D;
constexpr int NW=8,QBLK=32,QB=QBLK*NW,KVBLK=64,NQB=SEQ/QB;
constexpr int ATTN_PITCH=DM, ATTN_UNIT_ROWS=QB;
__device__ __forceinline__ int crow(int r,int hi){return (r&3)+8*(r>>2)+4*hi;}
#define SBAR() __builtin_amdgcn_sched_barrier(0)
__device__ __forceinline__ void cmask(f32x16&p0,f32x16&p1,int jb,int qrel,int hi){
  const float NEG=-INFINITY; int kb=64*jb+4*hi;
  #pragma unroll
  for(int r=0;r<16;++r){int kv=kb+(r&3)+8*(r>>2); if(kv>qrel)p0[r]=NEG; if(kv+32>qrel)p1[r]=NEG;}
}

__device__ __forceinline__ void cbias(f32x16&p0,f32x16&p1,int jb,int qrel,int hi,const __attribute__((address_space(3))) float*tab){
  const int base=qrel-64*jb-4*hi;
  #pragma unroll
  for(int r=0;r<16;++r){const int d0=base-((r&3)+8*(r>>2)); const int i0=min(max(d0,0),127), i1=min(max(d0-32,0),127); p0[r]+=tab[i0]; p1[r]+=tab[i1];}
}
constexpr int NSLOT=3, SLOTB=8192;
constexpr int LDS_K=0, LDS_V=NSLOT*SLOTB, LDS_WS=2*NSLOT*SLOTB, LDS_OST=LDS_WS+NW*64*4, LDS_TAB=LDS_OST+NW*4096, LDS_BYTES=LDS_TAB+512;
constexpr float C2=0.125f*1.4426950408889634f;
__device__ __forceinline__ void glds16(const void*gsrc,unsigned lds_dst){unsigned keep;
  asm volatile("s_mov_b32 %0, m0\n\ts_mov_b32 m0, %2\n\ts_nop 0\n\tglobal_load_lds_dwordx4 %1, off\n\ts_mov_b32 m0, %0":"=&s"(keep):"v"(gsrc),"s"(lds_dst):"memory");}
__device__ __forceinline__ float max3f(float a,float b,float c){float r;asm("v_max3_f32 %0, %1, %2, %3":"=v"(r):"v"(a),"v"(b),"v"(c));return r;}
__device__ __forceinline__ float max2f(float a,float b){float r;asm("v_max_f32_e32 %0, %1, %2":"=v"(r):"v"(a),"v"(b));return r;}
__device__ __forceinline__ float fadd_s(float a,float b){float r;asm("v_add_f32_e32 %0, %1, %2":"=v"(r):"v"(a),"v"(b));return r;}
__device__ __forceinline__ float fsub_s(float a,float b){float r;asm("v_sub_f32_e32 %0, %1, %2":"=v"(r):"v"(a),"v"(b));return r;}
typedef float f32x2_t __attribute__((ext_vector_type(2))); typedef __bf16 bf16x2_t __attribute__((ext_vector_type(2)));
__device__ __forceinline__ unsigned cvtpk_s(float lo,float hi){f32x2_t v={lo,hi};bf16x2_t b=__builtin_convertvector(v,bf16x2_t);return __builtin_bit_cast(unsigned,b);}
#define WAIT_BAR(N) asm volatile("s_waitcnt vmcnt(" #N ") lgkmcnt(0)\n\ts_barrier":::"memory")

__device__ __forceinline__ void qkt(f32x16&p0,f32x16&p1,const char*Kslot,const bf16x8*qr,const f32x16&negm,int r32,int hi){
  const char*kb=Kslot+hi*1024+r32*16;
  #pragma unroll
  for(int d0=0;d0<4;++d0){
    const bf16x8 b0=*reinterpret_cast<const bf16x8*>(kb+d0*2048);
    const bf16x8 b1=*reinterpret_cast<const bf16x8*>(kb+d0*2048+512);
    if(d0==0){p0=__builtin_amdgcn_mfma_f32_32x32x16_bf16(b0,qr[0],negm,0,0,0);p1=__builtin_amdgcn_mfma_f32_32x32x16_bf16(b1,qr[0],negm,0,0,0);}
    else{p0=__builtin_amdgcn_mfma_f32_32x32x16_bf16(b0,qr[d0],p0,0,0,0);p1=__builtin_amdgcn_mfma_f32_32x32x16_bf16(b1,qr[d0],p1,0,0,0);}}
}
typedef __attribute__((address_space(3))) const char* lds_cptr;
typedef short v4i16_t __attribute__((ext_vector_type(4)));
__device__ __forceinline__ void kload8(bf16x8*kf,lds_cptr kp){
  kf[0]=*(const __attribute__((address_space(3))) bf16x8*)(kp);      kf[1]=*(const __attribute__((address_space(3))) bf16x8*)(kp+512);
  kf[2]=*(const __attribute__((address_space(3))) bf16x8*)(kp+2048); kf[3]=*(const __attribute__((address_space(3))) bf16x8*)(kp+2560);
  kf[4]=*(const __attribute__((address_space(3))) bf16x8*)(kp+4096); kf[5]=*(const __attribute__((address_space(3))) bf16x8*)(kp+4608);
  kf[6]=*(const __attribute__((address_space(3))) bf16x8*)(kp+6144); kf[7]=*(const __attribute__((address_space(3))) bf16x8*)(kp+6656);
}
__device__ __forceinline__ void kload2(bf16x8*kf,lds_cptr kp,int j){ kf[2*j]=*(const __attribute__((address_space(3))) bf16x8*)(kp+j*2048); kf[2*j+1]=*(const __attribute__((address_space(3))) bf16x8*)(kp+j*2048+512); }
__device__ __forceinline__ s16x4 vtr(lds_cptr p){ return __builtin_bit_cast(s16x4,__builtin_amdgcn_ds_read_tr16_b64_v4i16((__attribute__((address_space(3))) v4i16_t*)p)); }
__device__ __forceinline__ float rowmax(const f32x16&p0,const f32x16&p1){
  float a=max3f(p0[0],p0[1],p1[0]),b=max3f(p0[2],p0[3],p1[1]);a=max3f(a,p1[2],p1[3]);
  #pragma unroll
  for(int r=4;r<16;r+=4){a=max3f(a,p0[r],p0[r+1]);b=max3f(b,p0[r+2],p0[r+3]);a=max3f(a,p1[r],p1[r+1]);b=max3f(b,p1[r+2],p1[r+3]);}
  const float m=max2f(a,b);
  auto rr=__builtin_amdgcn_permlane32_swap(__float_as_uint(m),__float_as_uint(m),false,false);
  return max2f(__uint_as_float(rr[0]),__uint_as_float(rr[1]));
}
__device__ __forceinline__ void pv(f32x16*o,int vb,bf16x8 pa0,bf16x8 pa1,bf16x8 pa2,bf16x8 pa3){
  #pragma unroll
  for(int d0=0;d0<2;++d0){s16x4 lo[4],hi[4];
    #pragma unroll
    for(int ks=0;ks<4;++ks){
      asm volatile("ds_read_b64_tr_b16 %0,%1 offset:%c2":"=&v"(lo[ks]):"v"(vb),"i"(d0*4096+ks*1024):"memory");
      asm volatile("ds_read_b64_tr_b16 %0,%1 offset:%c2":"=&v"(hi[ks]):"v"(vb),"i"(d0*4096+ks*1024+512):"memory");}
    asm volatile("s_waitcnt lgkmcnt(0)":::"memory");SBAR();
    #define PK(k) (bf16x8){lo[k][0],lo[k][1],lo[k][2],lo[k][3],hi[k][0],hi[k][1],hi[k][2],hi[k][3]}
    o[d0]=__builtin_amdgcn_mfma_f32_32x32x16_bf16(pa0,PK(0),o[d0],0,0,0);
    o[d0]=__builtin_amdgcn_mfma_f32_32x32x16_bf16(pa1,PK(1),o[d0],0,0,0);
    o[d0]=__builtin_amdgcn_mfma_f32_32x32x16_bf16(pa2,PK(2),o[d0],0,0,0);
    o[d0]=__builtin_amdgcn_mfma_f32_32x32x16_bf16(pa3,PK(3),o[d0],0,0,0);
    #undef PK
  }
}

#ifndef ATTN_STORE16
#define ATTN_STORE16(p,v) (*(u32x4*)(p)=(v))
#endif
template<int THRL> __device__ __forceinline__ void attn_unit(int b,int h,int hv,int qb,const bf16*Q,const bf16*__restrict__ K,const bf16*__restrict__ V,bf16*O,char*shm){
  const __attribute__((address_space(3))) float* tab=(const __attribute__((address_space(3))) float*)((lds_cptr)shm+LDS_TAB);
  const int tid=threadIdx.x,lane=tid&63,r32=lane&31,hi=lane>>5; const int wid=__builtin_amdgcn_readfirstlane(tid>>6);
  const long rowbase=(long)b*SEQ; const int q0=qb*QB;
  const bf16*Qw=Q+(rowbase+q0+wid*QBLK)*DM+h*D;
  const bf16*Kh=K+rowbase*DM+h*D,*Vh=V+rowbase*DM+hv*D;
  const unsigned lds0=(unsigned)(uintptr_t)shm;
  float*wsf=(float*)(shm+LDS_WS)+wid*64;
  const bf16*ksrc=Kh+(long)lane*DM+wid*8;
  const bf16*vsrc=Vh+(long)(16*(wid&3)+(lane>>2))*DM+(wid>>2)*32+(lane&3)*8;
  const unsigned kdst=lds0+LDS_K+wid*1024, vdst=lds0+LDS_V+wid*1024;
  #define DMA_K(t,slot) glds16(ksrc+(long)(t)*KVBLK*DM,(unsigned)__builtin_amdgcn_readfirstlane(kdst+(slot)))
  #define DMA_V(t,slot) glds16(vsrc+(long)(t)*KVBLK*DM,(unsigned)__builtin_amdgcn_readfirstlane(vdst+(slot)))
  const int vb0=(int)(lds0+LDS_V)+((lane>>4)&1)*32+(lane&3)*8+(4*hi+((lane&15)>>2))*64;
  const char*Kbase=shm+LDS_K; bf16x8 kf[8];
  const lds_cptr shm3=(lds_cptr)shm; const lds_cptr kp0=shm3+LDS_K+hi*1024+r32*16; const lds_cptr vp0=shm3+LDS_V+((lane>>4)&1)*32+(lane&3)*8+(4*hi+((lane&15)>>2))*64;
  const int NT=(q0+QB)/KVBLK;
  DMA_K(0,0);DMA_V(0,0);DMA_K(1,SLOTB);
  bf16x8 qr[4];
  #pragma unroll
  for(int d0=0;d0<4;++d0)qr[d0]=*reinterpret_cast<const bf16x8*>(&Qw[(long)r32*DM+d0*16+hi*8]);
  float mhat=0.f,l_reg=0.f;f32x16 o[2];o[0]=f32x16{};o[1]=f32x16{};f32x16 negm=f32x16{};asm volatile("":"+v"(negm));
  const int qrel=wid*QBLK+r32;
  #define CMASK(P0,P1,t) do{int jb_=(t)-(NT-4); if(jb_>=-2){cbias(P0,P1,jb_,qrel,hi,tab); if(jb_>=0)cmask(P0,P1,jb_,qrel,hi);}}while(0)
  bool resc=false;
  #define START(P0,P1) do{ const float rm=rowmax(P0,P1); resc=false; \
    { const float dl=rm; mhat=fadd_s(mhat,dl); \
      _Pragma("unroll") for(int r=0;r<16;++r){P0[r]=fsub_s(P0[r],dl);P1[r]=fsub_s(P1[r],dl);} \
      _Pragma("unroll") for(int r=0;r<16;++r)negm[r]=-mhat; asm volatile("":"+v"(negm)); } \
    _Pragma("unroll") for(int r=0;r<16;++r)P0[r]=__builtin_amdgcn_exp2f(P0[r]); }while(0)
  #define RESC() do{ if(resc){ asm volatile("s_waitcnt lgkmcnt(0)":::"memory"); \
      _Pragma("unroll") for(int d_=0;d_<2;++d_) _Pragma("unroll") for(int r=0;r<16;++r)o[d_][r]*=wsf[crow(r,hi)]; } }while(0)
  f32x16 pA0,pA1,pB0,pB1;
  int sl_prev=0,sl_cur=0,sl_next=SLOTB;
  #define ROT() do{sl_prev=sl_cur;sl_cur=sl_next;sl_next=(sl_next==(NSLOT-1)*SLOTB)?0:sl_next+SLOTB;}while(0)
  DMA_K(2,2*SLOTB);
  WAIT_BAR(3);
  qkt(pA0,pA1,Kbase,qr,negm,r32,hi);asm volatile("s_nop 15\n\ts_nop 7":"+v"(pA0),"+v"(pA1));CMASK(pA0,pA1,0);
  START(pA0,pA1);
  _Pragma("unroll") for(int r=0;r<16;++r)pA1[r]=__builtin_amdgcn_exp2f(pA1[r]);
  WAIT_BAR(0);
  DMA_K(3,0);DMA_V(1,SLOTB);
  ROT();
  kload8(kf,kp0+sl_cur);
  WAIT_BAR(2);
  s16x4 vlo[8],vhi[8]; u32x4 pw0,pw1,pw2,pw3;
  #define PKW(P,B) cvtpk_s(P[B],P[B+1])
  #define PAF(k) __builtin_bit_cast(bf16x8,pw##k)
  #define VFR(i) (bf16x8){vlo[i][0],vlo[i][1],vlo[i][2],vlo[i][3],vhi[i][0],vhi[i][1],vhi[i][2],vhi[i][3]}
  #define PIN(x) asm volatile("":"+v"(x))
  #define MX3(a,b,c) __builtin_fmaxf(__builtin_fmaxf((a),(b)),(c))
  #define GAPA(MF,A0,A1,A2,A3,W0,W1,PW) do{ MF; sacc+=A0; sacc+=A1; sacc+=A2; sacc+=A3; PIN(sacc); W0; W1; PIN(PW); SBAR(); }while(0)
  #define EX(v) __builtin_amdgcn_exp2f(v)
  #define GAPB(MF,X,B) do{ MF; X[B]=EX(X[B]); X[B+1]=EX(X[B+1]); X[B+2]=EX(X[B+2]); X[B+3]=EX(X[B+3]); PIN(X); SBAR(); }while(0)
  #define VRD(i) do{ vlo[i]=vtr(vp_+(((i)>>2)*4096+((i)&3)*1024)); vhi[i]=vtr(vp_+(((i)>>2)*4096+((i)&3)*1024+512)); }while(0)
  #define KRD(G,j) do{ if(G){ kload2(kf,kp0+sl_next,j); SBAR(); } }while(0)
  #define STEP(C0,C1,P0,P1,t,GK,GV,GL) do{ SBAR(); \
    const lds_cptr vp_=vp0+sl_prev; \
    VRD(0); SBAR(); float sacc=(P0[0]+P0[1]); \
    GAPA(C0=__builtin_amdgcn_mfma_f32_32x32x16_bf16(kf[0],qr[0],negm,0,0,0), P0[2],P0[3],P0[4],P0[5],     pw0[0]=PKW(P0,0), pw0[1]=PKW(P0,2), pw0); \
    VRD(4); SBAR(); GAPA(C1=__builtin_amdgcn_mfma_f32_32x32x16_bf16(kf[1],qr[0],negm,0,0,0), P0[6],P0[7],P0[8],P0[9],     pw0[2]=PKW(P0,4), pw0[3]=PKW(P0,6), pw0); \
    VRD(1); SBAR(); GAPA(C0=__builtin_amdgcn_mfma_f32_32x32x16_bf16(kf[2],qr[1],C0,0,0,0),   P0[10],P0[11],P0[12],P0[13], pw1[0]=PKW(P0,8), pw1[1]=PKW(P0,10), pw1); \
    VRD(5); SBAR(); GAPA(C1=__builtin_amdgcn_mfma_f32_32x32x16_bf16(kf[3],qr[1],C1,0,0,0),   P0[14],P0[15],P1[0],P1[1],   pw1[2]=PKW(P0,12),pw1[3]=PKW(P0,14), pw1); \
    VRD(2); SBAR(); GAPA(C0=__builtin_amdgcn_mfma_f32_32x32x16_bf16(kf[4],qr[2],C0,0,0,0),   P1[2],P1[3],P1[4],P1[5],     pw2[0]=PKW(P1,0), pw2[1]=PKW(P1,2), pw2); \
    VRD(6); SBAR(); GAPA(C1=__builtin_amdgcn_mfma_f32_32x32x16_bf16(kf[5],qr[2],C1,0,0,0),   P1[6],P1[7],P1[8],P1[9],     pw2[2]=PKW(P1,4), pw2[3]=PKW(P1,6), pw2); \
    VRD(3); SBAR(); GAPA(C0=__builtin_amdgcn_mfma_f32_32x32x16_bf16(kf[6],qr[3],C0,0,0,0),   P1[10],P1[11],P1[12],P1[13], pw3[0]=PKW(P1,8), pw3[1]=PKW(P1,10), pw3); \
    VRD(7); SBAR(); GAPA(C1=__builtin_amdgcn_mfma_f32_32x32x16_bf16(kf[7],qr[3],C1,0,0,0),   P1[14],P1[15],0.f,0.f,       pw3[2]=PKW(P1,12),pw3[3]=PKW(P1,14), pw3); \
    l_reg+=sacc; \
    if(GK){DMA_K((t)+3,sl_cur);} if(GV){DMA_V((t)+1,sl_next);} \
    CMASK(C0,C1,t); \
    { float a=MX3(C0[0],C0[1],C1[0]),b=MX3(C0[2],C0[3],C1[1]); a=MX3(a,C1[2],C1[3]); \
      _Pragma("unroll") for(int r=4;r<16;r+=4){a=MX3(a,C0[r],C0[r+1]);b=MX3(b,C0[r+2],C0[r+3]);a=MX3(a,C1[r],C1[r+1]);b=MX3(b,C1[r+2],C1[r+3]);} \
      float rm=__builtin_fmaxf(a,b); { auto rr=__builtin_amdgcn_permlane32_swap(__float_as_uint(rm),__float_as_uint(rm),false,false); rm=__builtin_fmaxf(__uint_as_float(rr[0]),__uint_as_float(rr[1])); } \
      resc=false; \
      if(__builtin_expect(__any(rm>(float)THRL),0)){ const float dl=__builtin_fmaxf(rm,0.f); mhat+=dl; \
        _Pragma("unroll") for(int r=0;r<16;++r){C0[r]-=dl;C1[r]-=dl;} \
        _Pragma("unroll") for(int r=0;r<16;++r)negm[r]=-mhat; asm volatile("":"+v"(negm)); \
        const float f=__builtin_amdgcn_exp2f(-dl); l_reg*=f; if(hi==0)wsf[r32]=f; resc=true; } } \
    SBAR(); \
    GAPB(o[0]=__builtin_amdgcn_mfma_f32_32x32x16_bf16(PAF(0),VFR(0),o[0],0,0,0), C0,0); \
    GAPB(o[1]=__builtin_amdgcn_mfma_f32_32x32x16_bf16(PAF(0),VFR(4),o[1],0,0,0), C0,4); \
    KRD(GL,0); GAPB(o[0]=__builtin_amdgcn_mfma_f32_32x32x16_bf16(PAF(1),VFR(1),o[0],0,0,0), C0,8); \
    KRD(GL,1); GAPB(o[1]=__builtin_amdgcn_mfma_f32_32x32x16_bf16(PAF(1),VFR(5),o[1],0,0,0), C0,12); \
    KRD(GL,2); GAPB(o[0]=__builtin_amdgcn_mfma_f32_32x32x16_bf16(PAF(2),VFR(2),o[0],0,0,0), C1,0); \
    KRD(GL,3); GAPB(o[1]=__builtin_amdgcn_mfma_f32_32x32x16_bf16(PAF(2),VFR(6),o[1],0,0,0), C1,4); \
    GAPB(o[0]=__builtin_amdgcn_mfma_f32_32x32x16_bf16(PAF(3),VFR(3),o[0],0,0,0), C1,8); \
    GAPB(o[1]=__builtin_amdgcn_mfma_f32_32x32x16_bf16(PAF(3),VFR(7),o[1],0,0,0), C1,12); \
    }while(0)
  int t=1;
  #undef CMASK
  #define CMASK(P0,P1,t) do{}while(0)
  for(;t+7<NT;t+=2){
    STEP(pB0,pB1,pA0,pA1,t,true,true,true);     WAIT_BAR(2); RESC(); ROT();
    STEP(pA0,pA1,pB0,pB1,t+1,true,true,true);   WAIT_BAR(2); RESC(); ROT();
  }
  #undef CMASK
  #define CMASK(P0,P1,t) do{int jb_=(t)-(NT-4); if(jb_>=-2){cbias(P0,P1,jb_,qrel,hi,tab); if(jb_>=0)cmask(P0,P1,jb_,qrel,hi);}}while(0)
  #define ENDW(tt) do{ if((tt)+3<NT){WAIT_BAR(2);} else if((tt)+2<NT){WAIT_BAR(1);} else {WAIT_BAR(0);} }while(0)
  for(;t+1<NT;t+=2){
    STEP(pB0,pB1,pA0,pA1,t,(t+3<NT),(t+1<NT),(t+1<NT));       ENDW(t);   RESC(); ROT();
    STEP(pA0,pA1,pB0,pB1,t+1,(t+4<NT),(t+2<NT),(t+2<NT));     ENDW(t+1); RESC(); ROT();
  }
  STEP(pB0,pB1,pA0,pA1,NT-1,false,false,false); RESC();
  { float sacc=pB0[0]+pB0[1]; _Pragma("unroll") for(int r=2;r<16;++r)sacc+=pB0[r]; _Pragma("unroll") for(int r=0;r<16;++r)sacc+=pB1[r]; l_reg+=sacc;
    pw0=(u32x4){PKW(pB0,0),PKW(pB0,2),PKW(pB0,4),PKW(pB0,6)};pw1=(u32x4){PKW(pB0,8),PKW(pB0,10),PKW(pB0,12),PKW(pB0,14)};pw2=(u32x4){PKW(pB1,0),PKW(pB1,2),PKW(pB1,4),PKW(pB1,6)};pw3=(u32x4){PKW(pB1,8),PKW(pB1,10),PKW(pB1,12),PKW(pB1,14)};
    SBAR(); pv(o,vb0+sl_cur,PAF(0),PAF(1),PAF(2),PAF(3)); }
  #undef PKW
  #undef PAF
  #undef VFR
  #undef PIN
  #undef MX3
  #undef GAPA
  #undef GAPB
  #undef EX
  #undef VRD
  #undef KRD
  #undef STEP
  #undef ENDW
  {auto rr=__builtin_amdgcn_permlane32_swap(__float_as_uint(l_reg),__float_as_uint(l_reg),false,false);l_reg=__uint_as_float(rr[0])+__uint_as_float(rr[1]);}
  if(hi==0)wsf[32+r32]=l_reg;asm volatile("s_waitcnt lgkmcnt(0)":::"memory");
  float rli[16];
  #pragma unroll
  for(int r=0;r<16;++r)rli[r]=__builtin_amdgcn_rcpf(wsf[32+crow(r,hi)]);
  bf16*Ow=O+(rowbase+q0+wid*QBLK)*DM+hv*D;
  { bf16*stg=(bf16*)(shm+LDS_OST)+wid*2048;
    #pragma unroll
    for(int r=0;r<16;++r){const int orow=crow(r,hi);
      #pragma unroll
      for(int d0=0;d0<2;++d0)stg[orow*64+d0*32+r32]=__float2bfloat16(o[d0][r]*rli[r]);}
    asm volatile("s_waitcnt lgkmcnt(0)":::"memory");
    #pragma unroll
    for(int i=0;i<4;++i){const int row=i*8+(lane>>3),ch=lane&7; const u32x4 v=*(const u32x4*)(stg+row*64+ch*8); ATTN_STORE16(Ow+(long)row*DM+ch*8,v);} }
  asm volatile("s_waitcnt lgkmcnt(0)\n\ts_barrier":::"memory");
  #undef DMA_K
  #undef DMA_V
  #undef CMASK
  #undef START
  #undef RESC
  #undef ROT
}
constexpr int ATTN_LDS_BYTES=LDS_BYTES;
struct AttnTensors { const bf16* Q; const bf16* K; const bf16* V; bf16* O1; bf16* O2; const float* biastab; };
struct AttnUnit { int b, hqk, hv, c, qb; };
struct StaticOrder {
  int vcu;
  __device__ __forceinline__ explicit StaticOrder(int grid,int block):vcu((grid%8==0)?(block%8)*(grid/8)+block/8:block){}
  __device__ __forceinline__ bool next(int i,AttnUnit&u)const{ if(i>=16)return false; const int v=vcu&255; u.b=v>>5; const int h=(v>>2)&7,c=(v>>1)&1,hf=v&1; u.hqk=2*h+c; u.hv=2*h+hf; u.c=c; u.qb=(i&1)?15-(i>>1):(i>>1); return true; }
};
template<class Sched,int THRL=8> __device__ __forceinline__ void attn_phase(char*lds,const AttnTensors&T,const Sched&S){
  AttnUnit u; int cur_h=-1;
  for(int i=0;S.next(i,u);++i){
    if((u.hqk>>1)!=cur_h){ cur_h=u.hqk>>1;
      if(threadIdx.x<128)((float*)(lds+LDS_TAB))[threadIdx.x]=T.biastab[cur_h*128+threadIdx.x];
      asm volatile("s_waitcnt vmcnt(0) lgkmcnt(0)\n\ts_barrier":::"memory"); }
    attn_unit<THRL>(u.b,u.hqk,u.hv,u.qb,T.Q,T.K,T.V,u.c?T.O2:T.O1,lds); }
}
#undef SBAR
#undef WAIT_BAR
}
#ifndef PG8_SP2
#define PG8_SP2 true
#endif
#ifndef PG8_ALIGN
#define PG8_ALIGN true
#endif
constexpr int NWAVES = 8;
#ifndef MK_N_LAUNCHES
#define MK_N_LAUNCHES 1
#endif
constexpr int N_PHASES = 8;
constexpr int BATCH = 8, SEQ = 4096, D = 2048, M = BATCH * SEQ;
constexpr int NPROJ = 5120, DATT = 1024, DCONV = 1024, CONVW = 31;
constexpr int PH = 8, PNK = 128, PHALF = 128, PTOPK = 16, NEXP = 16384;
constexpr float LN_EPS = 1e-5f;
constexpr float DN_ALPHA = 1.189207115002721f;
constexpr float LAMBDA_INIT = 0.2f;
constexpr size_t MiB = 1u << 20;
constexpr size_t WS_WIN = 2 * MiB, WS_WOUT = 22 * MiB, WS_WQ = 30 * MiB, WS_KEYS = 38 * MiB, WS_TAB = 39 * MiB;
constexpr size_t WS_U8 = 40 * MiB, WS_V8 = 72 * MiB, WS_SU = 104 * MiB, WS_SV = 105 * MiB;
constexpr size_t WS_XB = 168 * MiB;
constexpr size_t WS_Q = 296 * MiB, WS_K = 360 * MiB, WS_V = 424 * MiB, WS_H = 488 * MiB;
constexpr size_t WS_O1 = 552 * MiB, WS_O2 = 616 * MiB;
constexpr size_t WS_Y1 = 680 * MiB;
constexpr size_t WS_QP = 808 * MiB;
constexpr size_t WS_X8 = WS_O1;
constexpr size_t WS_SX = 106 * MiB, WS_SWQ = 107 * MiB, WS_SWIN = WS_SWQ + 65536, WS_SWOUT = WS_SWQ + 131072, WS_SXA = 108 * MiB, WS_SM = 109 * MiB;
constexpr size_t WS_CMAX = 16384;
constexpr size_t WS_EID = 936 * MiB, WS_GATE = 952 * MiB;
constexpr size_t WS_END = 968 * MiB;
constexpr int RING_BYTES = 131072, LDS_BYTES = 147456;

#define GAS __attribute__((address_space(1)))
#define LAS __attribute__((address_space(3)))
typedef unsigned short bf16;
typedef unsigned v4u __attribute__((ext_vector_type(4)));
typedef unsigned v2u __attribute__((ext_vector_type(2)));
typedef float f32x4 __attribute__((ext_vector_type(4)));
typedef float f32x16 __attribute__((ext_vector_type(16)));
typedef short bf16x8 __attribute__((ext_vector_type(8)));
typedef __bf16 bf16x2_t __attribute__((ext_vector_type(2)));
#define LDS_WAIT() asm volatile("s_waitcnt lgkmcnt(0)" ::: "memory")
__device__ __forceinline__ unsigned f2bf(float f) { unsigned u = __builtin_bit_cast(unsigned, f); return (u + 0x7fffu + ((u >> 16) & 1u)) >> 16; }
__device__ __forceinline__ unsigned pk2(float lo, float hi) { return f2bf(lo) | (f2bf(hi) << 16); }
__device__ __forceinline__ float bflo(unsigned w) { return __uint_as_float(w << 16); }
__device__ __forceinline__ float bfhi(unsigned w) { return __uint_as_float(w & 0xffff0000u); }
__device__ __forceinline__ float wave_sum(float v) {
#pragma unroll
    for (int o = 1; o < 64; o <<= 1) v += __shfl_xor(v, o);
    return v;
}
__device__ __forceinline__ float dot2bf(unsigned a, unsigned b, float acc) { return __builtin_amdgcn_fdot2_f32_bf16(__builtin_bit_cast(bf16x2_t, a), __builtin_bit_cast(bf16x2_t, b), acc, false); }

#define XB_TMO      128
#define XB_XCNT(j)  (256  + 64 * (j))
#define XB_XSUB(j)  (1280 + 64 * (j))
#define XB_XGEN(j)  (2304 + 64 * (j))
#define XB_TOP      3328
#define XB_TOPGEN   3392
#define XCD_BAR_WORDS 3456
#define XB_SPIN_CAP (1u << 18)

__device__ __forceinline__ unsigned xb_ld(unsigned* p)              { return __hip_atomic_load(p, __ATOMIC_RELAXED, __HIP_MEMORY_SCOPE_AGENT); }
__device__ __forceinline__ unsigned xb_add(unsigned* p, unsigned v) { return __hip_atomic_fetch_add(p, v, __ATOMIC_RELAXED, __HIP_MEMORY_SCOPE_AGENT); }
__device__ __forceinline__ unsigned xb_xcc_id() { return (unsigned)__builtin_amdgcn_s_getreg((3 << 11) | 20) & 0xFu; }
#define XB_SPIN(cond, bar) do { unsigned _sp = 0; while (cond) { __builtin_amdgcn_s_sleep(1); \
    if ((++_sp & 255u) == 0u) { if (xb_ld(&(bar)[XB_TMO])) break; if (_sp > XB_SPIN_CAP) { atomicAdd(&(bar)[XB_TMO], 1u); break; } } } } while (0)

struct XcdBarrier {
    unsigned* bar; unsigned x;
    volatile LAS unsigned* st;
};

__device__ __forceinline__ XcdBarrier xcd_barrier_post(unsigned* bar, volatile LAS unsigned* st) {
    XcdBarrier b; b.bar = bar; b.x = xb_xcc_id(); b.st = st;
    if (threadIdx.x == 0) (void)xb_add(&bar[XB_XCNT(b.x)], 1u);
    return b;
}
__device__ __forceinline__ void xcd_barrier_complete(unsigned* bar, unsigned x, unsigned& nloc, unsigned& nx) {
    const unsigned G = gridDim.x * gridDim.y * gridDim.z;
    unsigned sum, cnt, mine, sp = 0u;
    for (;;) {
        sum = 0u; cnt = 0u; mine = 0u;
#pragma unroll
        for (unsigned j = 0; j < 16; ++j) { const unsigned c = xb_ld(&bar[XB_XCNT(j)]); sum += c; cnt += (c > 0u) ? 1u : 0u; mine = (j == x) ? c : mine; }
        if (sum == G) break;
        __builtin_amdgcn_s_sleep(1);
        if ((++sp & 255u) == 0u) { if (xb_ld(&bar[XB_TMO])) break; if (sp > XB_SPIN_CAP) { atomicAdd(&bar[XB_TMO], 1u); break; } }
    }
    nloc = mine > 0u ? mine : 1u; nx = cnt > 0u ? cnt : 1u;
}

__device__ __forceinline__ void xcd_barrier(const XcdBarrier& b) {
    asm volatile("s_waitcnt vmcnt(0)" ::: "memory");
    __syncthreads();
    if (threadIdx.x == 0) {
        unsigned* bar = b.bar;
        __builtin_amdgcn_s_waitcnt(0);
        unsigned nloc = b.st[0], nx = b.st[1];
        if (nloc == 0u) { xcd_barrier_complete(bar, b.x, nloc, nx); b.st[0] = nloc; b.st[1] = nx; }
        const unsigned old = xb_add(&bar[XB_XSUB(b.x)], 1u);
        const unsigned gen = old / nloc;
        if (old + 1u == (gen + 1u) * nloc) {
            __builtin_amdgcn_fence(__ATOMIC_RELEASE, "agent");
            asm volatile("s_waitcnt vmcnt(0)" ::: "memory");
            const unsigned og = xb_add(&bar[XB_TOP], 1u);
            const unsigned tg = og / nx;
            if (og + 1u == (tg + 1u) * nx) xb_add(&bar[XB_TOPGEN], 1u);
            else XB_SPIN(xb_ld(&bar[XB_TOPGEN]) == tg, bar);
            __builtin_amdgcn_fence(__ATOMIC_ACQUIRE, "agent");
            xb_add(&bar[XB_XGEN(b.x)], 1u);
            asm volatile("s_waitcnt vmcnt(0)" ::: "memory");
        } else {
            XB_SPIN(xb_ld(&bar[XB_XGEN(b.x)]) == gen, bar);
            __builtin_amdgcn_fence(__ATOMIC_ACQUIRE, "agent");
            asm volatile("s_waitcnt vmcnt(0)" ::: "memory");
        }
    }
    __syncthreads();
}

struct Frame {
    LAS unsigned char* lds;
    __device__ __forceinline__ int wave_() const { int w = __builtin_amdgcn_readfirstlane((int)threadIdx.x >> 6); asm volatile("" : "+s"(w)); return w; }
    __device__ __forceinline__ int G_() const { int g = (int)gridDim.x; asm volatile("" : "+s"(g)); return g; }
    __device__ __forceinline__ int vcu_() const { int bx = (int)blockIdx.x; asm volatile("" : "+s"(bx)); const int g = G_(); return (g % 8 == 0) ? (bx % 8) * (g / 8) + bx / 8 : bx; }
    __device__ __forceinline__ int tid() const { int t = (int)threadIdx.x; asm volatile("" : "+v"(t)); return t; }
    __device__ __forceinline__ int lane() const { return tid() & 63; }
    __device__ __forceinline__ unsigned long long raw(int k) const { const volatile LAS unsigned* p = (const volatile LAS unsigned*)(lds + RING_BYTES) + 2 * k;
        const unsigned lo = __builtin_amdgcn_readfirstlane(p[0]), hi = __builtin_amdgcn_readfirstlane(p[1]); return ((unsigned long long)hi << 32) | lo; }
    __device__ __forceinline__ const float* in(int k) const { return (const float*)raw(k); }
    __device__ __forceinline__ float* outp() const { return (float*)raw(22); }
    template <class T> __device__ __forceinline__ T* ws(size_t off) const { return (T*)((unsigned char*)raw(23) + off); }
};
enum { I_X = 0, I_WIN, I_BGLU, I_CONVW, I_CONVB, I_CLNG, I_CLNB, I_LQ1, I_LK1, I_LQ2, I_LK2, I_SUBLN, I_RELB, I_WOUT, I_LN1G, I_LN1B, I_WQ, I_KEYS, I_U, I_V, I_LN2G, I_LN2B };

__device__ __forceinline__ unsigned pack_i8x4(float a, float b, float c, float d) {
    const int ia = (int)rintf(a), ib = (int)rintf(b), ic = (int)rintf(c), id = (int)rintf(d); return (unsigned)(ia & 255) | ((unsigned)(ib & 255) << 8) | ((unsigned)(ic & 255) << 16) | ((unsigned)id << 24); }
__device__ __forceinline__ void p0_transpose_item(const float* W, int K, int N, bf16* WT, int k0, int n0, int dst0, LAS float* scr, int lane) {
#pragma unroll 8
    for (int i = 0; i < 32; ++i) { const int kk = 2 * i + (lane >> 5); scr[kk * 33 + (lane & 31)] = W[(size_t)(k0 + kk) * N + n0 + (lane & 31)]; }
    LDS_WAIT(); asm volatile("" ::: "memory");
    const int c = lane & 7;
#pragma unroll
    for (int j = 0; j < 4; ++j) { const int n = (lane >> 3) + 8 * j; const LAS float* s = scr + (8 * c) * 33 + n;
        v4u o; o.x = pk2(s[0 * 33], s[1 * 33]); o.y = pk2(s[2 * 33], s[3 * 33]); o.z = pk2(s[4 * 33], s[5 * 33]); o.w = pk2(s[6 * 33], s[7 * 33]);
        *(GAS v4u*)(WT + (size_t)(dst0 + n) * K + k0 + 8 * c) = o; }
    LDS_WAIT(); asm volatile("" ::: "memory");
}
__device__ __forceinline__ void p0_colmax_item(const float* W, int N, unsigned* cmax, int k0, int n0, int dst0, int lane) {
    float am = 0.f;
#pragma unroll 8
    for (int i = 0; i < 32; ++i) { const int kk = 2 * i + (lane >> 5); am = fmaxf(am, fabsf(W[(size_t)(k0 + kk) * N + n0 + (lane & 31)])); }
    am = fmaxf(am, __shfl_xor(am, 32));
    if (lane < 32) atomicMax(cmax + dst0 + lane, __float_as_uint(am));
}
__device__ __forceinline__ void p0_quant_item(const float* W, int N, unsigned char* WT8, const unsigned* cmax, float* scale, int k0, int n0, int dst0, LAS float* scr, int lane) {
#pragma unroll 8
    for (int i = 0; i < 32; ++i) { const int kk = 2 * i + (lane >> 5); scr[kk * 33 + (lane & 31)] = W[(size_t)(k0 + kk) * N + n0 + (lane & 31)]; }
    if (lane < 32) { const float am = __uint_as_float(__hip_atomic_load(cmax + dst0 + lane, __ATOMIC_RELAXED, __HIP_MEMORY_SCOPE_AGENT)); const float sc = am > 0.f ? am * (1.f / 127.f) : 1.f;
        scr[64 * 33 + lane] = 1.f / sc; if (k0 == 0) scale[dst0 + lane] = sc; }
    LDS_WAIT(); asm volatile("" ::: "memory");
    const int c = lane & 7;
#pragma unroll
    for (int j = 0; j < 4; ++j) { const int n = (lane >> 3) + 8 * j; const LAS float* sp = scr + (8 * c) * 33 + n; const float inv = scr[64 * 33 + n];
        *(GAS v2u*)(WT8 + (size_t)(dst0 + n) * D + k0 + 8 * c) = (v2u){pack_i8x4(sp[0 * 33] * inv, sp[1 * 33] * inv, sp[2 * 33] * inv, sp[3 * 33] * inv), pack_i8x4(sp[4 * 33] * inv, sp[5 * 33] * inv, sp[6 * 33] * inv, sp[7 * 33] * inv)}; }
    LDS_WAIT(); asm volatile("" ::: "memory");
}
__device__ __forceinline__ int glu_dst(int n0) {
    if (n0 < 3072) return n0;
    const int ch = (n0 - 3072) & 1023, gate = (n0 - 3072) >> 10; return 3072 + 256 * (ch >> 7) + 128 * gate + (ch & 127);
}
__device__ __forceinline__ void p0_quant_x(const float* src, unsigned char* dst8, float* scale, int rows, int gw, int NGW, int lane) {
    f32x4 nx[8];
    if (gw < rows) { const GAS f32x4* sp = (const GAS f32x4*)(src + (size_t)gw * D) + lane;
#pragma unroll
        for (int j = 0; j < 8; ++j) nx[j] = sp[64 * j]; }
    for (int r = gw; r < rows; r += NGW) {
        f32x4 v[8]; float am = 0.f;
#pragma unroll
        for (int j = 0; j < 8; ++j) v[j] = nx[j];
        { const int rn = (r + NGW < rows) ? r + NGW : r; const GAS f32x4* sp = (const GAS f32x4*)(src + (size_t)rn * D) + lane;
#pragma unroll
          for (int j = 0; j < 8; ++j) nx[j] = sp[64 * j]; }
#pragma unroll
        for (int j = 0; j < 8; ++j) am = fmaxf(fmaxf(am, fmaxf(fabsf(v[j].x), fabsf(v[j].y))), fmaxf(fabsf(v[j].z), fabsf(v[j].w)));
#pragma unroll
        for (int o = 1; o < 64; o <<= 1) am = fmaxf(am, __shfl_xor(am, o));
        const float sc = am > 0.f ? am * (1.f / 127.f) : 1.f, inv = 1.f / sc;
        GAS unsigned* dp = (GAS unsigned*)(dst8 + (size_t)r * D) + lane;
#pragma unroll
        for (int j = 0; j < 8; ++j) dp[64 * j] = pack_i8x4(v[j].x * inv, v[j].y * inv, v[j].z * inv, v[j].w * inv);
        if (lane == 0) scale[r] = sc;
    }
}
__device__ __forceinline__ void p0_convert(const float* src, bf16* dst, size_t n, int gw, int NGW, int lane) {
    const size_t nit = n / 512;
    for (size_t it = gw; it < nit; it += NGW) { const GAS f32x4* s = (const GAS f32x4*)(src + it * 512) + 2 * lane; const f32x4 a = s[0], b = s[1];
        v4u o; o.x = pk2(a.x, a.y); o.y = pk2(a.z, a.w); o.z = pk2(b.x, b.y); o.w = pk2(b.z, b.w); *((GAS v4u*)(dst + it * 512) + lane) = o; }
}
template <bool INT8> __device__ __forceinline__ void p0_quant_rows(const float* src, unsigned* dst8, float* scale, int rows, int gw, int NGW, int lane) {
    f32x4 nx[8];
    if (gw < rows) { const GAS f32x4* sp = (const GAS f32x4*)(src + (size_t)gw * D) + lane;
#pragma unroll
        for (int j = 0; j < 8; ++j) nx[j] = sp[64 * j]; }
    for (int r = gw; r < rows; r += NGW) {
        f32x4 v[8]; float am = 0.f;
#pragma unroll
        for (int j = 0; j < 8; ++j) v[j] = nx[j];
        { const int rn = (r + NGW < rows) ? r + NGW : r; const GAS f32x4* sp = (const GAS f32x4*)(src + (size_t)rn * D) + lane;
#pragma unroll
          for (int j = 0; j < 8; ++j) nx[j] = sp[64 * j]; }
#pragma unroll
        for (int j = 0; j < 8; ++j) am = fmaxf(fmaxf(am, fmaxf(fabsf(v[j].x), fabsf(v[j].y))), fmaxf(fabsf(v[j].z), fabsf(v[j].w)));
#pragma unroll
        for (int o = 1; o < 64; o <<= 1) am = fmaxf(am, __shfl_xor(am, o));
        const float sc = am > 0.f ? am * (INT8 ? (1.f / 127.f) : (1.f / 440.f)) : 1.f, inv = 1.f / sc;
#pragma unroll
        for (int j = 0; j < 8; ++j) { int w;
            if (INT8) w = (int)pack_i8x4(v[j].x * inv, v[j].y * inv, v[j].z * inv, v[j].w * inv);
            else { w = __builtin_amdgcn_cvt_pk_fp8_f32(v[j].x * inv, v[j].y * inv, 0, false); w = __builtin_amdgcn_cvt_pk_fp8_f32(v[j].z * inv, v[j].w * inv, w, true); }
            const int wi = lane + 64 * j, c = wi >> 5; *((GAS unsigned*)dst8 + ((size_t)c * rows + r) * 32 + (wi & 31)) = (unsigned)w; }
        if (lane == 0) scale[r] = sc;
    }
}
__device__ __forceinline__ int t5_bucket(int d) {
    if (d < 16) return d;
    int l = 16 + (int)(logf((float)d / 16.f) / logf(8.f) * 16.f); return l < 31 ? l : 31;
}
__device__ __forceinline__ void p0a_prologue(Frame& F) {
    LAS float* scr = (LAS float*)(F.lds + F.wave_() * 16384);
    constexpr int I_IN = (D / 64) * (NPROJ / 32), I_OUT = (D / 64) * (D / 32);
    { const float* w_in = F.in(I_WIN); unsigned* cmax = F.ws<unsigned>(WS_CMAX); const int gw = F.vcu_() * NWAVES + F.wave_(), NGW = F.G_() * NWAVES;
      for (int r = gw; r < I_IN; r += NGW) { const int nblk = NPROJ / 32, kb = r / nblk, nb = r % nblk; p0_colmax_item(w_in, NPROJ, cmax, 64 * kb, 32 * nb, glu_dst(32 * nb), F.lane()); } }
    { const float* wq = F.in(I_WQ); unsigned* cmax = F.ws<unsigned>(WS_CMAX) + NPROJ; const int gw = F.vcu_() * NWAVES + F.wave_(), NGW = F.G_() * NWAVES;
      for (int r = gw; r < I_OUT; r += NGW) { const int nblk = D / 32, kb = r / nblk, nb = r % nblk; p0_colmax_item(wq, D, cmax, 64 * kb, 32 * nb, 32 * nb, F.lane()); } }
    { const float* wo = F.in(I_WOUT); unsigned* cmax = F.ws<unsigned>(WS_CMAX) + NPROJ + D; const int gw = F.vcu_() * NWAVES + F.wave_(), NGW = F.G_() * NWAVES;
      for (int r = gw; r < I_OUT; r += NGW) { const int nblk = D / 32, kb = r / nblk, nb = r % nblk; p0_colmax_item(wo, D, cmax, 64 * kb, 32 * nb, 32 * nb, F.lane()); } }
    { const int gw = F.vcu_() * NWAVES + F.wave_(), NGW = F.G_() * NWAVES; p0_quant_x(F.in(I_X), F.ws<unsigned char>(WS_XB), F.ws<float>(WS_SXA), M, gw, NGW, F.lane()); }
    { const int gw = F.vcu_() * NWAVES + F.wave_(), NGW = F.G_() * NWAVES; p0_quant_rows<true>(F.in(I_U), F.ws<unsigned>(WS_U8), F.ws<float>(WS_SU), NEXP, gw, NGW, F.lane()); }
    { const int gw = F.vcu_() * NWAVES + F.wave_(), NGW = F.G_() * NWAVES; p0_quant_rows<false>(F.in(I_V), F.ws<unsigned>(WS_V8), F.ws<float>(WS_SV), NEXP, gw, NGW, F.lane()); }
    { const int gw = F.vcu_() * NWAVES + F.wave_(), NGW = F.G_() * NWAVES; p0_convert(F.in(I_KEYS), F.ws<bf16>(WS_KEYS), (size_t)PH * 2 * PNK * PHALF, gw, NGW, F.lane()); }
    if (blockIdx.x == 0) { const float* rel_bias = F.in(I_RELB); float* TAB = F.ws<float>(WS_TAB);
        for (int i = F.tid(); i < 8 * 128; i += NWAVES * 64) { const int h = i >> 7, d = i & 127;
            TAB[i] = (rel_bias[t5_bucket(d) * 8 + h] - rel_bias[31 * 8 + h]) * 1.4426950408889634f; } }
}
__device__ __forceinline__ void p0b_prologue(Frame& F) {
    LAS float* scr = (LAS float*)(F.lds + F.wave_() * 16384);
    constexpr int I_IN = (D / 64) * (NPROJ / 32), I_OUT = (D / 64) * (D / 32);
    { const float* w_in = F.in(I_WIN); unsigned char* W8 = F.ws<unsigned char>(WS_WIN); const unsigned* cmax = F.ws<unsigned>(WS_CMAX); float* sw = F.ws<float>(WS_SWIN); const int gw = F.vcu_() * NWAVES + F.wave_(), NGW = F.G_() * NWAVES;
      for (int r = gw; r < I_IN; r += NGW) { const int nblk = NPROJ / 32, kb = r / nblk, nb = r % nblk; p0_quant_item(w_in, NPROJ, W8, cmax, sw, 64 * kb, 32 * nb, glu_dst(32 * nb), scr, F.lane()); } }
    { const float* wq = F.in(I_WQ); unsigned char* W8 = F.ws<unsigned char>(WS_WQ); const unsigned* cmax = F.ws<unsigned>(WS_CMAX) + NPROJ; float* sw = F.ws<float>(WS_SWQ); const int gw = F.vcu_() * NWAVES + F.wave_(), NGW = F.G_() * NWAVES;
      for (int r = gw; r < I_OUT; r += NGW) { const int nblk = D / 32, kb = r / nblk, nb = r % nblk; p0_quant_item(wq, D, W8, cmax, sw, 64 * kb, 32 * nb, 32 * nb, scr, F.lane()); } }
    { const float* wo = F.in(I_WOUT); unsigned char* W8 = F.ws<unsigned char>(WS_WOUT); const unsigned* cmax = F.ws<unsigned>(WS_CMAX) + NPROJ + D; float* sw = F.ws<float>(WS_SWOUT); const int gw = F.vcu_() * NWAVES + F.wave_(), NGW = F.G_() * NWAVES;
      for (int r = gw; r < I_OUT; r += NGW) { const int nblk = D / 32, kb = r / nblk, nb = r % nblk; p0_quant_item(wo, D, W8, cmax, sw, 64 * kb, 32 * nb, 32 * nb, scr, F.lane()); } }
}

__device__ __forceinline__ float diff_lambda(Frame& F) {
    const float a = wave_sum(F.in(I_LQ1)[F.lane()] * F.in(I_LK1)[F.lane()]), b = wave_sum(F.in(I_LQ2)[F.lane()] * F.in(I_LK2)[F.lane()]);
    return expf(a) - expf(b) + LAMBDA_INIT;
}
template <int CTRL> __device__ __forceinline__ int dppi(int v) { return __builtin_amdgcn_update_dpp(0, v, CTRL, 0xf, 0xf, true); }
template <int CTRL> __device__ __forceinline__ float dppf(float v) { return __int_as_float(__builtin_amdgcn_update_dpp(0, __float_as_int(v), CTRL, 0xf, 0xf, true)); }
template <int CTRL, int RM> __device__ __forceinline__ float dpp_rm(float old, float v) { return __int_as_float(__builtin_amdgcn_update_dpp(__float_as_int(old), __float_as_int(v), CTRL, RM, 0xf, false)); }
__device__ __forceinline__ float wave_sum63(float v) {
    v += dppf<0xB1>(v); v += dppf<0x4E>(v); v += dppf<0x141>(v); v += dppf<0x140>(v);
    v += dpp_rm<0x142, 0xa>(0.f, v);
    v += dpp_rm<0x143, 0xc>(0.f, v);
    return v;
}
__device__ __forceinline__ float wave_max63(float v) {
    v = fmaxf(v, dppf<0xB1>(v)); v = fmaxf(v, dppf<0x4E>(v)); v = fmaxf(v, dppf<0x141>(v)); v = fmaxf(v, dppf<0x140>(v));
    v = fmaxf(v, dpp_rm<0x142, 0xa>(0.f, v)); v = fmaxf(v, dpp_rm<0x143, 0xc>(0.f, v));
    return v;
}
__device__ __forceinline__ void p3_mix(Frame& F) {
    constexpr int TT = 32, NPR = (TT + CONVW - 1) / 2, STATS_OFF = NPR * 4096, AMC_OFF = STATS_OFF + 2048, AMA_OFF = AMC_OFF + 1024, MS_OFF = AMA_OFF + 128, INV_OFF = MS_OFF + 256, STG_OFF = (TT / 2) * 4096;
    static_assert(INV_OFF + 128 <= RING_BYTES && STG_OFF + TT * 1024 <= STATS_OFF, "P3 LDS map");
    const int tid = F.tid(), lane = tid & 63, wave = F.wave_();
    const float lam = diff_lambda(F);
    const float* conv_w = F.in(I_CONVW); const bf16* H = F.ws<bf16>(WS_H); const bf16* O1 = F.ws<bf16>(WS_O1); const bf16* O2 = F.ws<bf16>(WS_O2);
    unsigned char* MIX8 = F.ws<unsigned char>(WS_XB); float* SM = F.ws<float>(WS_SM); const float* subln_g = F.in(I_SUBLN);
    const float2 cb = *(const float2*)(F.in(I_CONVB) + 2 * tid), lg = *(const float2*)(F.in(I_CLNG) + 2 * tid), lb = *(const float2*)(F.in(I_CLNB) + 2 * tid);
    LAS float* stats = (LAS float*)(F.lds + STATS_OFF); LAS float* amc = (LAS float*)(F.lds + AMC_OFF); LAS float* ama = (LAS float*)(F.lds + AMA_OFF); LAS float* ms = (LAS float*)(F.lds + MS_OFF); LAS float* invs = (LAS float*)(F.lds + INV_OFF);
    for (int tile_i = F.vcu_(); tile_i < M / TT; tile_i += F.G_()) {
        const int t0 = tile_i * TT, s0 = t0 & (SEQ - 1);
        for (int p = tid >> 7; p < NPR; p += 4) { const int sp = s0 - (CONVW - 1) + 2 * p; v4u a = (v4u){0u, 0u, 0u, 0u}, b = a;
            if (sp >= 0) { const GAS v4u* hp = (const GAS v4u*)(H + (size_t)(t0 - (CONVW - 1) + 2 * p) * 1024) + (tid & 127); a = hp[0]; b = hp[128]; }
            const unsigned aw[4] = {a.x, a.y, a.z, a.w}, bw[4] = {b.x, b.y, b.z, b.w}; unsigned o[8];
#pragma unroll
            for (int k = 0; k < 4; ++k) { o[2 * k] = __builtin_amdgcn_perm(bw[k], aw[k], 0x05040100u); o[2 * k + 1] = __builtin_amdgcn_perm(bw[k], aw[k], 0x07060302u); }
            LAS v4u* dst = (LAS v4u*)(F.lds + p * 4096 + (tid & 127) * 32); dst[0] = (v4u){o[0], o[1], o[2], o[3]}; dst[1] = (v4u){o[4], o[5], o[6], o[7]}; }
        __syncthreads();
        {
            unsigned we0[16], we1[16], wo0[16], wo1[16]; float2 wprev = {0.f, 0.f};
#pragma unroll
            for (int q = 0; q < 16; ++q) { const float2 wa = *(const float2*)(conv_w + (2 * q) * DCONV + 2 * tid); float2 wb = {0.f, 0.f}; if (2 * q + 1 < CONVW) wb = *(const float2*)(conv_w + (2 * q + 1) * DCONV + 2 * tid);
                we0[q] = pk2(wa.x, wb.x); we1[q] = pk2(wa.y, wb.y); wo0[q] = pk2(wprev.x, wa.x); wo1[q] = pk2(wprev.y, wa.y); wprev = wb; }
            for (int q = 0; q < TT / 2; ++q) {
                float e0 = cb.x, e1 = cb.y, o0 = cb.x, o1 = cb.y;
                const LAS v2u* src = (const LAS v2u*)(F.lds + q * 4096 + tid * 8);
#pragma unroll
                for (int j = 0; j < 16; ++j) { const v2u d = src[j * 512]; e0 = dot2bf(d.x, we0[j], e0); e1 = dot2bf(d.y, we1[j], e1); o0 = dot2bf(d.x, wo0[j], o0); o1 = dot2bf(d.y, wo1[j], o1); }
                const unsigned p0 = pk2(e0, o0), p1 = pk2(e1, o1); *(LAS v2u*)(F.lds + q * 4096 + tid * 8) = (v2u){p0, p1};
                const float re0 = bflo(p0), ro0 = bfhi(p0), re1 = bflo(p1), ro1 = bfhi(p1);
                const float se = wave_sum63(re0 + re1), qe = wave_sum63(re0 * re0 + re1 * re1), so = wave_sum63(ro0 + ro1), qo = wave_sum63(ro0 * ro0 + ro1 * ro1);
                if (lane == 63) { LAS float* st = stats + ((2 * q) * 8 + wave) * 2; st[0] = se; st[1] = qe; st[16] = so; st[17] = qo; }
            }
        }
        float av[4][16];
#pragma unroll
        for (int rr = 0; rr < 4; ++rr) { const int m = t0 + 4 * wave + rr;
            const GAS v4u* p1 = (const GAS v4u*)(O1 + (size_t)m * 1024) + 2 * lane; const GAS v4u* p2 = (const GAS v4u*)(O2 + (size_t)m * 1024) + 2 * lane;
            const v4u a0 = p1[0], a1 = p1[1], b0 = p2[0], b1 = p2[1];
            const unsigned aw[8] = {a0.x, a0.y, a0.z, a0.w, a1.x, a1.y, a1.z, a1.w}, bw[8] = {b0.x, b0.y, b0.z, b0.w, b1.x, b1.y, b1.z, b1.w};
            float ss = 0.f;
#pragma unroll
            for (int i = 0; i < 8; ++i) { av[rr][2 * i] = bflo(aw[i]) - lam * bflo(bw[i]); av[rr][2 * i + 1] = bfhi(aw[i]) - lam * bfhi(bw[i]); ss += av[rr][2 * i] * av[rr][2 * i] + av[rr][2 * i + 1] * av[rr][2 * i + 1]; }
            ss += __shfl_xor(ss, 1); ss += __shfl_xor(ss, 2); ss += __shfl_xor(ss, 4);
            const float r = (1.f - LAMBDA_INIT) / sqrtf(ss * (1.f / 128.f) + LN_EPS); float am = 0.f;
#pragma unroll
            for (int e = 0; e < 16; ++e) { av[rr][e] = av[rr][e] * r * subln_g[16 * (lane & 7) + e]; am = fmaxf(am, fabsf(av[rr][e])); }
            am = wave_max63(am);
            if (lane == 63) ama[4 * wave + rr] = am; }
        __syncthreads();
        if (tid < TT) { float s = 0.f, q = 0.f;
#pragma unroll
            for (int w = 0; w < 8; ++w) { s += stats[(tid * 8 + w) * 2]; q += stats[(tid * 8 + w) * 2 + 1]; }
            const float mean = s * (1.f / DCONV), var = fmaxf(q * (1.f / DCONV) - mean * mean, 0.f); ms[2 * tid] = mean; ms[2 * tid + 1] = 1.f / sqrtf(var + LN_EPS); }
        __syncthreads();
        for (int q = 0; q < TT / 2; ++q) {
            const f32x4 st = *(const LAS f32x4*)(ms + 4 * q);
            const v2u d = *(const LAS v2u*)(F.lds + q * 4096 + tid * 8);
            const float ye0 = (bflo(d.x) - st[0]) * st[1] * lg.x + lb.x, yo0 = (bfhi(d.x) - st[2]) * st[3] * lg.x + lb.x, ye1 = (bflo(d.y) - st[0]) * st[1] * lg.y + lb.y, yo1 = (bfhi(d.y) - st[2]) * st[3] * lg.y + lb.y;
#define SWISH_(y) ((y) * __builtin_amdgcn_rcpf(1.f + __builtin_amdgcn_exp2f(-1.4426950409f * (y))))
            const unsigned z0 = pk2(SWISH_(ye0), SWISH_(yo0)), z1 = pk2(SWISH_(ye1), SWISH_(yo1));
#undef SWISH_
            *(LAS v2u*)(F.lds + q * 4096 + tid * 8) = (v2u){z0, z1};
            const float me = wave_max63(fmaxf(fabsf(bflo(z0)), fabsf(bflo(z1)))), mo = wave_max63(fmaxf(fabsf(bfhi(z0)), fabsf(bfhi(z1))));
            if (lane == 63) { amc[(2 * q) * 8 + wave] = me; amc[(2 * q + 1) * 8 + wave] = mo; }
        }
        __syncthreads();
        if (tid < TT) { float am = ama[tid];
#pragma unroll
            for (int w = 0; w < 8; ++w) am = fmaxf(am, amc[tid * 8 + w]);
            const float sc = am > 0.f ? am * (1.f / 127.f) : 1.f; invs[tid] = 1.f / sc; SM[t0 + tid] = sc; }
        __syncthreads();
        for (int q = 0; q < TT / 2; ++q) {
            const float ie = invs[2 * q], io = invs[2 * q + 1];
            const v2u d = *(const LAS v2u*)(F.lds + q * 4096 + tid * 8);
            const int qe0 = (int)rintf(bflo(d.x) * ie), qe1 = (int)rintf(bflo(d.y) * ie), qo0 = (int)rintf(bfhi(d.x) * io), qo1 = (int)rintf(bfhi(d.y) * io);
            *(LAS unsigned short*)(F.lds + STG_OFF + (2 * q) * 1024 + 2 * tid) = (unsigned short)((qe0 & 255) | ((qe1 & 255) << 8));
            *(LAS unsigned short*)(F.lds + STG_OFF + (2 * q + 1) * 1024 + 2 * tid) = (unsigned short)((qo0 & 255) | ((qo1 & 255) << 8));
        }
#pragma unroll
        for (int rr = 0; rr < 4; ++rr) { const float inv = invs[4 * wave + rr];
            *((GAS v4u*)(MIX8 + (size_t)(t0 + 4 * wave + rr) * D) + lane) = (v4u){pack_i8x4(av[rr][0] * inv, av[rr][1] * inv, av[rr][2] * inv, av[rr][3] * inv), pack_i8x4(av[rr][4] * inv, av[rr][5] * inv, av[rr][6] * inv, av[rr][7] * inv),
                                                                              pack_i8x4(av[rr][8] * inv, av[rr][9] * inv, av[rr][10] * inv, av[rr][11] * inv), pack_i8x4(av[rr][12] * inv, av[rr][13] * inv, av[rr][14] * inv, av[rr][15] * inv)}; }
        __syncthreads();
        for (int idx = tid; idx < TT * 64; idx += NWAVES * 64) { const int row = idx >> 6, ch = idx & 63;
            *((GAS v4u*)(MIX8 + (size_t)(t0 + row) * D + DATT) + ch) = *(const LAS v4u*)(F.lds + STG_OFF + row * 1024 + ch * 16); }
        __syncthreads();
    }
}
__device__ __forceinline__ void p5_ln1(Frame& F) {
    bf16* Y1 = F.ws<bf16>(WS_Y1); const float* ln1_g = F.in(I_LN1G); const float* ln1_b = F.in(I_LN1B); unsigned char* X8 = F.ws<unsigned char>(WS_X8); float* SX = F.ws<float>(WS_SX);
    const int gw = F.vcu_() * NWAVES + F.wave_(), NGW = F.G_() * NWAVES;
    for (int m = gw; m < M; m += NGW) {
        GAS v4u* p = (GAS v4u*)(Y1 + (size_t)m * D) + F.lane();
        v4u w[4]; float v[32]; float s = 0.f;
#pragma unroll
        for (int j = 0; j < 4; ++j) { w[j] = p[64 * j]; const unsigned ww[4] = {w[j].x, w[j].y, w[j].z, w[j].w};
#pragma unroll
            for (int i = 0; i < 4; ++i) { v[8 * j + 2 * i] = bflo(ww[i]); v[8 * j + 2 * i + 1] = bfhi(ww[i]); s += v[8 * j + 2 * i] + v[8 * j + 2 * i + 1]; } }
        const float mean = wave_sum(s) * (1.f / D); float q = 0.f;
#pragma unroll
        for (int i = 0; i < 32; ++i) { v[i] -= mean; q += v[i] * v[i]; }
        const float rstd = 1.f / sqrtf(wave_sum(q) * (1.f / D) + LN_EPS);
#pragma unroll
        for (int j = 0; j < 4; ++j) { const int c0 = 8 * F.lane() + 512 * j; const f32x4 g0 = *(const f32x4*)(ln1_g + c0), g1 = *(const f32x4*)(ln1_g + c0 + 4), b0 = *(const f32x4*)(ln1_b + c0), b1 = *(const f32x4*)(ln1_b + c0 + 4);
            v4u o; o.x = pk2(v[8 * j] * rstd * g0[0] + b0[0], v[8 * j + 1] * rstd * g0[1] + b0[1]); o.y = pk2(v[8 * j + 2] * rstd * g0[2] + b0[2], v[8 * j + 3] * rstd * g0[3] + b0[3]);
            o.z = pk2(v[8 * j + 4] * rstd * g1[0] + b1[0], v[8 * j + 5] * rstd * g1[1] + b1[1]); o.w = pk2(v[8 * j + 6] * rstd * g1[2] + b1[2], v[8 * j + 7] * rstd * g1[3] + b1[3]);
            p[64 * j] = o; }
        float am = 0.f;
#pragma unroll
        for (int j = 0; j < 4; ++j) { const int c0 = 8 * F.lane() + 512 * j; const f32x4 g0 = *(const f32x4*)(ln1_g + c0), g1 = *(const f32x4*)(ln1_g + c0 + 4), b0 = *(const f32x4*)(ln1_b + c0), b1 = *(const f32x4*)(ln1_b + c0 + 4);
#pragma unroll
            for (int i = 0; i < 4; ++i) { v[8 * j + i] = v[8 * j + i] * rstd * g0[i] + b0[i]; v[8 * j + 4 + i] = v[8 * j + 4 + i] * rstd * g1[i] + b1[i]; am = fmaxf(am, fmaxf(fabsf(v[8 * j + i]), fabsf(v[8 * j + 4 + i]))); } }
#pragma unroll
        for (int o = 1; o < 64; o <<= 1) am = fmaxf(am, __shfl_xor(am, o));
        const float sc = am > 0.f ? am * (1.f / 127.f) : 1.f, inv = 1.f / sc;
        GAS v2u* p8 = (GAS v2u*)(X8 + (size_t)m * D) + F.lane();
#pragma unroll
        for (int j = 0; j < 4; ++j) p8[64 * j] = (v2u){pack_i8x4(v[8 * j] * inv, v[8 * j + 1] * inv, v[8 * j + 2] * inv, v[8 * j + 3] * inv), pack_i8x4(v[8 * j + 4] * inv, v[8 * j + 5] * inv, v[8 * j + 6] * inv, v[8 * j + 7] * inv)};
        if (F.lane() == 0) SX[m] = sc;
    }
}
__device__ __forceinline__ int f2key(float f) { const int b = __float_as_int(f); return b ^ ((b >> 31) & 0x7fffffff); }
__device__ __forceinline__ float key2f(int k) { return __int_as_float(k ^ ((k >> 31) & 0x7fffffff)); }
#define CE_DESC(a, b) do { const int _x = max(a, b), _y = min(a, b); a = _x; b = _y; } while (0)
#define CE_ASC(a, b)  do { const int _x = min(a, b), _y = max(a, b); a = _x; b = _y; } while (0)
template <int N> __device__ __forceinline__ void sort_desc(int (&v)[N]) {
#pragma unroll
    for (int k = 2; k <= N; k <<= 1)
#pragma unroll
        for (int j = k >> 1; j > 0; j >>= 1)
#pragma unroll
            for (int i = 0; i < N; ++i) { const int l = i ^ j; if (l > i) { if ((i & k) == 0) CE_DESC(v[i], v[l]); else CE_ASC(v[i], v[l]); } }
}
template <int N> __device__ __forceinline__ void bitonic_merge_desc(int (&v)[N]) {
#pragma unroll
    for (int j = N >> 1; j > 0; j >>= 1)
#pragma unroll
        for (int i = 0; i < N; ++i) { const int l = i ^ j; if (l > i) CE_DESC(v[i], v[l]); }
}
__device__ __forceinline__ void merge16(const int (&a)[16], const int (&b)[16], int (&o)[16]) {
#pragma unroll
    for (int i = 0; i < 16; ++i) o[i] = max(a[i], b[15 - i]);
    bitonic_merge_desc<16>(o);
}
__device__ __forceinline__ void top16_of_64(const int (&v)[64], int (&o)[16]) {
    int g0[16], g1[16], g2[16], g3[16];
#pragma unroll
    for (int i = 0; i < 16; ++i) { g0[i] = v[i]; g1[i] = v[16 + i]; g2[i] = v[32 + i]; g3[i] = v[48 + i]; }
    sort_desc<16>(g0); sort_desc<16>(g1); sort_desc<16>(g2); sort_desc<16>(g3);
    int m0[16], m1[16]; merge16(g0, g1, m0); merge16(g2, g3, m1); merge16(m0, m1, o);
}
__device__ const unsigned char PEER_PAIR[64] = {0,1,2,3,4,5,6,7,8,9,10,11,12,13,14,15, 16,17,18,19,20,21,22,23, 32,33,34,35,36, 48,49,50,51, 64,65,66, 80,81, 96,97, 112,113, 128,144,160,176,192,208,224,240, 0,0,0,0,0,0,0,0,0,0,0,0,0,0};
__device__ __forceinline__ void peer_subkey_top16(const bf16* qrow  , const bf16* keys_hc  , int r32, int hi, int (&o)[16]) {
    bf16x8 bq[8];
    asm volatile("" : "+v"(qrow));
#pragma unroll
    for (int s = 0; s < 8; ++s) bq[s] = *(const bf16x8*)(qrow + 8 * s);
    int run[16];
#pragma unroll
    for (int mt = 0; mt < 4; ++mt) {
        const bf16* krow = keys_hc + (size_t)(32 * mt + r32) * PHALF + hi * 64;
        asm volatile("" : "+v"(krow));
        bf16x8 ka[8];
#pragma unroll
        for (int s = 0; s < 8; ++s) ka[s] = *(const bf16x8*)(krow + 8 * s);
#ifdef PEER_A_FENCE
        asm volatile("" ::: "memory");
#endif
        f32x16 acc = {};
#pragma unroll
        for (int s = 0; s < 8; ++s) acc = __builtin_amdgcn_mfma_f32_32x32x16_bf16(ka[s], bq[s], acc, 0, 0, 0);
        int g[16];
#pragma unroll
        for (int r = 0; r < 16; ++r) g[r] = (f2key(acc[r]) & ~127) | ((r & 3) + 8 * (r >> 2));
        sort_desc<16>(g);
        if (mt) {
#pragma unroll
            for (int r = 0; r < 16; ++r) g[r] |= 32 * mt; }
        if (mt == 0) {
#pragma unroll
            for (int r = 0; r < 16; ++r) run[r] = g[r];
        } else { int t2[16]; merge16(run, g, t2);
#pragma unroll
            for (int r = 0; r < 16; ++r) run[r] = t2[r]; }
    }
    int lo[16], hh[16]; const int hi4 = 4 * hi;
#pragma unroll
    for (int i = 0; i < 16; ++i) { run[i] |= hi4; auto rr = __builtin_amdgcn_permlane32_swap((unsigned)run[i], (unsigned)run[i], false, false); lo[i] = (int)rr[0]; hh[i] = (int)rr[1]; }
    merge16(lo, hh, o);
}
__device__ __forceinline__ float gelu_erf(float v) { return 0.5f * v * (1.f + erff(v * 0.70710678118654752f)); }

typedef float f32x2 __attribute__((ext_vector_type(2)));
constexpr int P7_ACT = 0, P7_EID = 65536, P7_SCR = 0  , P7_SCR_WAVE = 32 * 33 * 4, PCH = 128, NCH = D / PCH;
static_assert(P7_SCR + NWAVES * P7_SCR_WAVE <= P7_EID && P7_EID + 128 * 128 * 2 <= RING_BYTES, "PEER LDS map");

__device__ __forceinline__ void p7_peer(Frame& F) {
    const int lane = F.lane(), r32 = lane & 31, hi = lane >> 5, j8 = lane & 7, g8 = lane >> 3;
    constexpr int TPB = 128;
    LAS float* ACT = (LAS float*)(F.lds + P7_ACT); LAS unsigned short* EIDL = (LAS unsigned short*)(F.lds + P7_EID);
    LAS int* scr = (LAS int*)(F.lds + P7_SCR + F.wave_() * P7_SCR_WAVE);
    for (int blk = F.vcu_(); blk < M / TPB; blk += F.G_()) {
        const int m0 = blk * TPB;
        { const int h = F.wave_(); const bf16* QP = F.ws<bf16>(WS_QP); const bf16* KEYS = F.ws<bf16>(WS_KEYS); float* GATE = F.ws<float>(WS_GATE);
          for (int tt = 0; tt < 4; ++tt) {
            const int tl = 32 * tt + r32, tok = m0 + tl;
            const bf16* qrow = QP + (size_t)tok * D + h * 256 + hi * 64;
            int s1[16], s2[16];
            peer_subkey_top16(qrow, KEYS + (size_t)(h * 2 + 0) * PNK * PHALF, r32, hi, s1);
            asm volatile("" ::: "memory");
            peer_subkey_top16(qrow + 128, KEYS + (size_t)(h * 2 + 1) * PNK * PHALF, r32, hi, s2);
            float f1[16], f2[16];
#pragma unroll
            for (int i = 0; i < 16; ++i) { f1[i] = key2f(s1[i]); f2[i] = key2f(s2[i]); }
            if (hi == 0) {
#pragma unroll
                for (int i = 0; i < 16; ++i) { scr[r32 * 33 + i] = s1[i] & 127; scr[r32 * 33 + 16 + i] = s2[i] & 127; } }
            int cand[64];
            {
#define PC(n_, i_, j_) cand[n_] = (f2key(f1[i_] + f2[j_]) & ~255) | (n_)
                PC(0,0,0); PC(1,0,1); PC(2,0,2); PC(3,0,3); PC(4,0,4); PC(5,0,5); PC(6,0,6); PC(7,0,7); PC(8,0,8); PC(9,0,9); PC(10,0,10); PC(11,0,11); PC(12,0,12); PC(13,0,13); PC(14,0,14); PC(15,0,15);
                PC(16,1,0); PC(17,1,1); PC(18,1,2); PC(19,1,3); PC(20,1,4); PC(21,1,5); PC(22,1,6); PC(23,1,7);
                PC(24,2,0); PC(25,2,1); PC(26,2,2); PC(27,2,3); PC(28,2,4);
                PC(29,3,0); PC(30,3,1); PC(31,3,2); PC(32,3,3);
                PC(33,4,0); PC(34,4,1); PC(35,4,2);
                PC(36,5,0); PC(37,5,1); PC(38,6,0); PC(39,6,1); PC(40,7,0); PC(41,7,1);
                PC(42,8,0); PC(43,9,0); PC(44,10,0); PC(45,11,0); PC(46,12,0); PC(47,13,0); PC(48,14,0); PC(49,15,0);
#undef PC
            }
#pragma unroll
            for (int i = 50; i < 64; ++i) cand[i] = (int)0x80000000;
            int sc[16]; top16_of_64(cand, sc);
            float p[16]; const float mx = key2f(sc[0]); float z = 0.f;
#pragma unroll
            for (int k = 0; k < 16; ++k) { p[k] = __expf(key2f(sc[k]) - mx); z += p[k]; }
            const float rz = 1.f / z;
            LDS_WAIT();
            int eo[8]; float go[8]; const int him = -hi;
#pragma unroll
            for (int kk = 0; kk < 8; ++kk) { const int tag = PEER_PAIR[((sc[kk] & ~him) | (sc[8 + kk] & him)) & 255];
                const int i1 = scr[r32 * 33 + (tag >> 4)], i2 = scr[r32 * 33 + 16 + (tag & 15)];
                eo[kk] = i1 * PNK + i2; go[kk] = __int_as_float((__float_as_int(p[kk]) & ~him) | (__float_as_int(p[8 + kk]) & him)) * rz; }
            *(LAS v4u*)(EIDL + tl * 128 + h * 16 + 8 * hi) = (v4u){(unsigned)(eo[0] | (eo[1] << 16)), (unsigned)(eo[2] | (eo[3] << 16)), (unsigned)(eo[4] | (eo[5] << 16)), (unsigned)(eo[6] | (eo[7] << 16))};
            GAS float* gp = (GAS float*)(GATE + (size_t)tok * 128 + h * 16 + 8 * hi);
            *(GAS f32x4*)gp = (f32x4){go[0], go[1], go[2], go[3]}; *(GAS f32x4*)(gp + 4) = (f32x4){go[4], go[5], go[6], go[7]};
            LDS_WAIT();
          } }
        __threadfence_block(); __syncthreads();
        const int tw = F.wave_() * (TPB / NWAVES);
        for (int i = lane; i < (TPB / NWAVES) * 128; i += 64) ACT[tw * 128 + i] = 0.f;
        { const unsigned char* X8 = F.ws<unsigned char>(WS_X8); const unsigned char* U8 = F.ws<unsigned char>(WS_U8);
#define U_ISSUE(n_, PC, XQ) do { const int c_ = (n_) >> 4, tl_ = tw + ((n_) & 15); \
            XQ = *(const GAS v4u*)(X8 + (size_t)(m0 + tl_) * D + c_ * PCH + 16 * j8); \
            const LAS unsigned short* ep_ = EIDL + tl_ * 128 + g8; const unsigned char* ub_ = U8 + (size_t)c_ * (NEXP * PCH) + 16 * j8; \
            _Pragma("unroll") for (int i = 0; i < 16; ++i) { const unsigned e_ = ep_[8 * i]; PC[i] = *(const GAS v4u*)(ub_ + e_ * PCH); } } while (0)
#define U_COMPUTE(n_, PC, XQ) do { const int tl_ = tw + ((n_) & 15); \
            int pp_[16]; \
            _Pragma("unroll") for (int i = 0; i < 16; ++i) { int a_ = __builtin_amdgcn_sdot4((int)PC[i].x, (int)XQ.x, 0, false); a_ = __builtin_amdgcn_sdot4((int)PC[i].y, (int)XQ.y, a_, false); \
                a_ = __builtin_amdgcn_sdot4((int)PC[i].z, (int)XQ.z, a_, false); pp_[i] = __builtin_amdgcn_sdot4((int)PC[i].w, (int)XQ.w, a_, false); } \
              \
            int q8_[8], q4_[4], q2_[2]; \
            { const bool b2_ = lane & 4; _Pragma("unroll") for (int i = 0; i < 8; ++i) { const int k_ = b2_ ? pp_[2 * i + 1] : pp_[2 * i], s_ = b2_ ? pp_[2 * i] : pp_[2 * i + 1]; q8_[i] = k_ + dppi<0x141>(s_); } } \
            { const bool b1_ = lane & 2; _Pragma("unroll") for (int i = 0; i < 4; ++i) { const int k_ = b1_ ? q8_[2 * i + 1] : q8_[2 * i], s_ = b1_ ? q8_[2 * i] : q8_[2 * i + 1]; q4_[i] = k_ + dppi<0x4E>(s_); } } \
            { const bool b0_ = lane & 1; _Pragma("unroll") for (int i = 0; i < 2; ++i) { const int k_ = b0_ ? q4_[2 * i + 1] : q4_[2 * i], s_ = b0_ ? q4_[2 * i] : q4_[2 * i + 1]; q2_[i] = k_ + dppi<0xB1>(s_); } } \
            const int irow_ = ((lane & 1) << 2) | (lane & 2) | ((lane >> 2) & 1); \
            LAS float* ap_ = ACT + tl_ * 128 + 8 * irow_ + g8; ap_[0] += (float)q2_[0]; ap_[64] += (float)q2_[1]; } while (0)
          constexpr int NSTEP = NCH * (TPB / NWAVES);
          v4u pcA[16], pcB[16], xqA, xqB;
          U_ISSUE(0, pcA, xqA);
          for (int n = 0; n < NSTEP; n += 2) {
              U_ISSUE(n + 1, pcB, xqB); __builtin_amdgcn_sched_barrier(0);
              U_COMPUTE(n, pcA, xqA); __builtin_amdgcn_sched_barrier(0);
              { const int nn = (n + 2 < NSTEP) ? n + 2 : n; U_ISSUE(nn, pcA, xqA); }
              __builtin_amdgcn_sched_barrier(0);
              U_COMPUTE(n + 1, pcB, xqB); __builtin_amdgcn_sched_barrier(0);
          }
#undef U_ISSUE
#undef U_COMPUTE
        }
        LDS_WAIT();
        { const float* SU = F.ws<float>(WS_SU); const float* SV = F.ws<float>(WS_SV); const float* GATE = F.ws<float>(WS_GATE); const float* SX = F.ws<float>(WS_SX);
        for (int ti = 0; ti < TPB / NWAVES; ++ti) {
            const int tl = tw + ti, t = m0 + tl; const float sx = SX[t];
#pragma unroll
            for (int kq = 0; kq < 2; ++kq) { const int k = lane + 64 * kq; const unsigned e = EIDL[tl * 128 + k]; const float a = ACT[tl * 128 + k] * SU[e] * sx;
                ACT[tl * 128 + k] = __builtin_nontemporal_load(GATE + (size_t)t * 128 + k) * gelu_erf(a) * SV[e]; }
        } }
        LDS_WAIT();
        { const bf16* X1 = F.ws<bf16>(WS_Y1); const unsigned char* V8 = F.ws<unsigned char>(WS_V8); bf16* Y2 = F.ws<bf16>(WS_QP);
#define V_ISSUE(n_, PC, WK, XP) do { const int c_ = (n_) >> 4, tl_ = tw + ((n_) & 15); \
            const LAS unsigned short* ep_ = EIDL + tl_ * 128 + g8; const LAS float* wp_ = ACT + tl_ * 128 + g8; const unsigned char* vb_ = V8 + (size_t)c_ * (NEXP * PCH) + 16 * j8; \
            _Pragma("unroll") for (int i = 0; i < 16; ++i) { const unsigned e_ = ep_[8 * i]; WK[i] = wp_[8 * i]; PC[i] = *(const GAS v4u*)(vb_ + e_ * PCH); } \
            XP = *(const GAS unsigned*)(X1 + (size_t)(m0 + tl_) * D + c_ * PCH + 16 * j8 + 2 * g8); } while (0)
#define V_COMPUTE(n_, PC, WK, XP) do { const int c_ = (n_) >> 4, tl_ = tw + ((n_) & 15); \
            f32x2 acc_[8]; \
            _Pragma("unroll") for (int d = 0; d < 8; ++d) acc_[d] = (f32x2){0.f, 0.f}; \
            _Pragma("unroll") for (int i = 0; i < 16; ++i) { const unsigned w4_[4] = {PC[i].x, PC[i].y, PC[i].z, PC[i].w}; const f32x2 w2_ = {WK[i], WK[i]}; \
                _Pragma("unroll") for (int d = 0; d < 4; ++d) { acc_[2 * d] = __builtin_amdgcn_cvt_pk_f32_fp8((int)w4_[d], false) * w2_ + acc_[2 * d]; acc_[2 * d + 1] = __builtin_amdgcn_cvt_pk_f32_fp8((int)w4_[d], true) * w2_ + acc_[2 * d + 1]; } } \
              \
            float a16_[16]; \
            _Pragma("unroll") for (int d = 0; d < 8; ++d) { a16_[2 * d] = acc_[d].x; a16_[2 * d + 1] = acc_[d].y; } \
            float r8_[8], r4_[4], r2_[2]; \
            _Pragma("unroll") for (int i = 0; i < 8; ++i) { auto rr_ = __builtin_amdgcn_permlane32_swap(__float_as_uint(a16_[i]), __float_as_uint(a16_[i + 8]), false, false); r8_[i] = __uint_as_float(rr_[0]) + __uint_as_float(rr_[1]); } \
            _Pragma("unroll") for (int i = 0; i < 4; ++i) { auto rr_ = __builtin_amdgcn_permlane16_swap(__float_as_uint(r8_[i]), __float_as_uint(r8_[i + 4]), false, false); r4_[i] = __uint_as_float(rr_[0]) + __uint_as_float(rr_[1]); } \
            { const bool b3_ = lane & 8; _Pragma("unroll") for (int i = 0; i < 2; ++i) { const float k_ = b3_ ? r4_[i + 2] : r4_[i], s_ = b3_ ? r4_[i] : r4_[i + 2]; r2_[i] = k_ + dppf<0x128>(s_); } } \
            *(GAS unsigned*)(Y2 + (size_t)(m0 + tl_) * D + c_ * PCH + 16 * j8 + 2 * g8) = pk2(r2_[0] + DN_ALPHA * bflo(XP), r2_[1] + DN_ALPHA * bfhi(XP)); } while (0)
          constexpr int NSTEP = NCH * (TPB / NWAVES);
          v4u pcA[16], pcB[16]; float wkA[16], wkB[16]; unsigned xpA, xpB;
          V_ISSUE(0, pcA, wkA, xpA);
          for (int n = 0; n < NSTEP; n += 2) {
              V_ISSUE(n + 1, pcB, wkB, xpB); __builtin_amdgcn_sched_barrier(0);
              V_COMPUTE(n, pcA, wkA, xpA); __builtin_amdgcn_sched_barrier(0);
              { const int nn = (n + 2 < NSTEP) ? n + 2 : n; V_ISSUE(nn, pcA, wkA, xpA); }
              __builtin_amdgcn_sched_barrier(0);
              V_COMPUTE(n + 1, pcB, wkB, xpB); __builtin_amdgcn_sched_barrier(0);
          }
#undef V_ISSUE
#undef V_COMPUTE
        }
        { const float* ln2_g = F.in(I_LN2G); const float* ln2_b = F.in(I_LN2B); float* outp = F.outp(); const bf16* Y2 = F.ws<bf16>(WS_QP);
        for (int ti = 0; ti < TPB / NWAVES; ++ti) {
            const int t = m0 + tw + ti;
            const GAS v4u* yp = (const GAS v4u*)(Y2 + (size_t)t * D) + lane;
            float v[32]; float s = 0.f;
#pragma unroll
            for (int j = 0; j < 4; ++j) { const v4u w = yp[64 * j]; const unsigned ww[4] = {w.x, w.y, w.z, w.w};
#pragma unroll
                for (int i = 0; i < 4; ++i) { v[8 * j + 2 * i] = bflo(ww[i]); v[8 * j + 2 * i + 1] = bfhi(ww[i]); s += v[8 * j + 2 * i] + v[8 * j + 2 * i + 1]; } }
            const float mean = wave_sum(s) * (1.f / D); float qv = 0.f;
#pragma unroll
            for (int i = 0; i < 32; ++i) { v[i] -= mean; qv += v[i] * v[i]; }
            const float rstd = 1.f / sqrtf(wave_sum(qv) * (1.f / D) + LN_EPS);
#pragma unroll
            for (int j = 0; j < 4; ++j) { const int c0 = 8 * lane + 512 * j; const f32x4 g0 = *(const f32x4*)(ln2_g + c0), g1 = *(const f32x4*)(ln2_g + c0 + 4), b0 = *(const f32x4*)(ln2_b + c0), b1 = *(const f32x4*)(ln2_b + c0 + 4);
                f32x4 r0, r1;
#pragma unroll
                for (int i = 0; i < 4; ++i) { r0[i] = v[8 * j + i] * rstd * g0[i] + b0[i]; r1[i] = v[8 * j + 4 + i] * rstd * g1[i] + b1[i]; }
                GAS f32x4* op = (GAS f32x4*)(outp + (size_t)t * D + c0); op[0] = r0; op[1] = r1; }
        } }
        __syncthreads();
    }
}

struct Args { const float* in[22]; float* out; unsigned char* ws; int ph_lo, ph_hi; };
__global__ void __launch_bounds__(NWAVES * 64, 2) mk_fwd(Args args) {
    extern __shared__ __attribute__((aligned(16))) unsigned char lds[];
    cg::grid_group grid = cg::this_grid();
    Frame F;
    F.lds = (LAS unsigned char*)lds;
    if (threadIdx.x == 0) { LAS unsigned long long* PT = (LAS unsigned long long*)(F.lds + RING_BYTES);
#pragma unroll
        for (int k = 0; k < 22; ++k) PT[k] = (unsigned long long)args.in[k];
        PT[22] = (unsigned long long)args.out; PT[23] = (unsigned long long)args.ws;
        ((LAS unsigned*)(F.lds + RING_BYTES + 256))[0] = 0u; ((LAS unsigned*)(F.lds + RING_BYTES + 256))[1] = 0u; }
    __syncthreads();
    const int lo = args.ph_lo, hi = args.ph_hi;
#ifndef PHASE_MASK
#define PHASE_MASK 255
#endif
#define IN(k) (((PHASE_MASK >> (k)) & 1) && lo <= (k) && (k) < hi)
#ifndef REPEAT_PHASE
#define REPEAT_PHASE -1
#endif
#define REP(k) for (int rep_ = 0; rep_ < ((REPEAT_PHASE == (k)) ? 2 : 1); ++rep_)
    (void)xcd_barrier_post((unsigned*)args.ws, (volatile LAS unsigned*)(F.lds + RING_BYTES + 256));
#define XBAR() do { XcdBarrier bar_; bar_.bar = F.ws<unsigned>(0); bar_.x = xb_xcc_id(); bar_.st = (volatile LAS unsigned*)(F.lds + RING_BYTES + 256); xcd_barrier(bar_); } while (0)
#define SEAM(k) do { if (IN(k) && IN((k) + 1)) XBAR(); } while (0)

    if (lo < 0) grid.sync();
    if (IN(0)) REP(0) { p0a_prologue(F); XBAR(); p0b_prologue(F); } SEAM(0);
    if (IN(1)) REP(1) {
        pg8::Gemm g{F.ws<bf16>(WS_XB), F.ws<bf16>(WS_WIN), M, NPROJ, D / 2}; pg8::StaticOrder S; S.init(M, NPROJ, F.G_(), (int)blockIdx.x);
        pg8::EpiProjI8 E{F.ws<bf16>(WS_Q), (size_t)(WS_K - WS_Q) / 2, attn_body::C2, F.ws<bf16>(WS_H), F.in(I_BGLU), F.ws<float>(WS_SXA), F.ws<float>(WS_SWIN)};
        pg8::gemm_phase<pg8::EpiProjI8, pg8::StaticOrder, PG8_ALIGN, PG8_SP2>(F.lds, g, S, E);
    } SEAM(1);
    if (IN(2)) REP(2) {
        static_assert(attn_body::ATTN_LDS_BYTES <= RING_BYTES && attn_body::ATTN_PITCH == DATT, "attention body geometry vs frame");
        const attn_body::AttnTensors AT{F.ws<const attn_body::bf16>(WS_Q), F.ws<const attn_body::bf16>(WS_K), F.ws<const attn_body::bf16>(WS_V), F.ws<attn_body::bf16>(WS_O1), F.ws<attn_body::bf16>(WS_O2), F.ws<const float>(WS_TAB)};
        const attn_body::StaticOrder S((int)F.G_(), (int)blockIdx.x);
        attn_body::attn_phase<attn_body::StaticOrder>((char*)lds, AT, S);
    } SEAM(2);
    if (IN(3)) REP(3) { p3_mix(F); } SEAM(3);
    if (IN(4)) REP(4) {
        pg8::Gemm g{F.ws<bf16>(WS_XB), F.ws<bf16>(WS_WOUT), M, D, D / 2}; pg8::StaticOrder S; S.init(M, D, F.G_(), (int)blockIdx.x);
        pg8::EpiResI8 E{F.in(I_X), F.ws<bf16>(WS_Y1), D, DN_ALPHA, F.ws<float>(WS_SM), F.ws<float>(WS_SWOUT)};
        pg8::gemm_phase<pg8::EpiResI8, pg8::StaticOrder, PG8_ALIGN, PG8_SP2>(F.lds, g, S, E);
    } SEAM(4);
    if (IN(5)) REP(5) { p5_ln1(F); } SEAM(5);
    if (IN(6)) REP(6) {
        pg8::Gemm g{F.ws<bf16>(WS_X8), F.ws<bf16>(WS_WQ), M, D, D / 2}; pg8::StaticOrder S; S.init(M, D, F.G_(), (int)blockIdx.x);
        pg8::EpiPlainI8 E{F.ws<bf16>(WS_QP), D, F.ws<float>(WS_SX), F.ws<float>(WS_SWQ)};
        pg8::gemm_phase<pg8::EpiPlainI8, pg8::StaticOrder, PG8_ALIGN, PG8_SP2>(F.lds, g, S, E);
    } SEAM(6);
    if (IN(7)) REP(7) { p7_peer(F); }
#undef IN
#undef SEAM
}

extern "C" void kernel_launch(void* const* d_in, const int* in_sizes, int n_in, void* d_out, int out_size, void* d_ws, size_t ws_size, hipStream_t stream) {
    static int grid = 0;
    if (grid == 0) {
        if (n_in != 22 || in_sizes[0] != M * D || out_size != M * D || ws_size < WS_END) { fprintf(stderr, "kernel_launch: unexpected shapes (n_in %d, in0 %d, out %d, ws %zu); nothing launched\n", n_in, n_in > 0 ? in_sizes[0] : -1, out_size, ws_size); grid = -1; return; }
        int dev = 0, cus = 0, per_cu = 0;
        if (hipGetDevice(&dev) != hipSuccess || hipDeviceGetAttribute(&cus, hipDeviceAttributeMultiprocessorCount, dev) != hipSuccess) { grid = -1; return; }
        if (hipFuncSetAttribute((const void*)mk_fwd, hipFuncAttributeMaxDynamicSharedMemorySize, LDS_BYTES) != hipSuccess) { fprintf(stderr, "kernel_launch: hipFuncSetAttribute failed\n"); grid = -1; return; }
        if (hipOccupancyMaxActiveBlocksPerMultiprocessor(&per_cu, (const void*)mk_fwd, NWAVES * 64, LDS_BYTES) != hipSuccess || per_cu < 1) { fprintf(stderr, "kernel_launch: occupancy query reports %d workgroups per CU\n", per_cu); (void)hipGetLastError(); grid = -1; return; }
        grid = cus;
        if (grid > 256) grid = 256;
    }
    if (grid < 0) return;
    if (hipMemsetAsync(d_ws, 0, 65536, stream) != hipSuccess) { fprintf(stderr, "kernel_launch: hipMemsetAsync failed\n"); return; }
    Args a{};
    for (int i = 0; i < 22; ++i) a.in[i] = (const float*)d_in[i];
    a.out = (float*)d_out; a.ws = (unsigned char*)d_ws;
    constexpr int NL = MK_N_LAUNCHES;
    for (int li = 0; li < NL; ++li) {
        a.ph_lo = (NL == 1) ? 0 : li; a.ph_hi = (NL == 1) ? N_PHASES : li + 1;
        void* kargs[] = {&a};
        const hipError_t le = hipLaunchCooperativeKernel((const void*)mk_fwd, dim3(grid), dim3(NWAVES * 64), kargs, LDS_BYTES, stream);
        if (le != hipSuccess) { fprintf(stderr, "kernel_launch: cooperative launch %d failed: %s (grid %d)\n", li, hipGetErrorString(le), grid); break; }
    }
}
```

```cpp
#include <hip/hip_runtime.h>
#include <hip/hip_cooperative_groups.h>
#include <cstdio>
#include <cstdint>
namespace cg = cooperative_groups;
namespace pg8 {
#define PG8_LAS __attribute__((address_space(3)))
typedef unsigned short bf16_t;
typedef short bf16x8 __attribute__((ext_vector_type(8)));
typedef float f32x4 __attribute__((ext_vector_type(4)));
typedef unsigned u32x4 __attribute__((ext_vector_type(4)));
typedef int i32x4 __attribute__((ext_vector_type(4)));
constexpr int BM = 256, BK = 64, HALF = 128, HTB = HALF * BK * 2  , STAGE_BYTES = 8 * HTB, NXCD = 8, WGM = 8;

__host__ __device__ __forceinline__ int lds_byte(int r, int c) { const int st = (r >> 4) * 2 + (c >> 5), rr = r & 15, cc = c & 31, ob = rr * 64 + cc * 2; return st * 1024 + (ob ^ (((ob >> 9) & 1) << 5)); }
__host__ __device__ __forceinline__ void stage_rc(int b, int& R, int& C) { const int st = b / 1024, sb = b % 1024, swz = sb ^ (((sb >> 9) & 1) << 5); R = (st >> 1) * 16 + swz / 64; C = (st & 1) * 32 + (swz % 64) / 2; }
__host__ __device__ __forceinline__ int perm32(int rho) { const int n = rho >> 4, i = rho & 15; return 8 * (i >> 2) + 4 * n + (i & 3); }

struct Unit { int pm, pn; };
struct Gemm { const bf16_t* A; const bf16_t* Bt; int M, N, K; };

struct StaticOrder {
    int nM, nN, nwg, G, c;
    __host__ __device__ void init(int M, int N, int G_, int c_) { nM = M / BM; nN = N / BM; nwg = nM * nN; G = G_; c = c_; }
    __host__ __device__ bool next(int i, Unit& u) const {
        const long L = (long)i * G + c; if (L >= nwg) return false;
        int wgid = (int)L; { const int q = nwg / NXCD, r = nwg % NXCD, xcd = wgid % NXCD, off = wgid / NXCD; wgid = (xcd < r ? xcd * (q + 1) : r * (q + 1) + (xcd - r) * q) + off; }
        const int nig = WGM * nN, gid = wgid / nig, fm = gid * WGM, gsz = (nM - fm) < WGM ? (nM - fm) : WGM;
        u.pm = fm + ((wgid % nig) % gsz); u.pn = (wgid % nig) / gsz; return true;
    }
    __device__ __forceinline__ void a_ready(const Unit&) const {}
    __device__ __forceinline__ void done(const Unit&) const {}
};

__device__ __forceinline__ unsigned cvt_pk_bf16(float lo, float hi) { unsigned r; asm volatile("v_cvt_pk_bf16_f32 %0, %1, %2" : "=v"(r) : "v"(lo), "v"(hi)); return r; }
typedef float f32x2 __attribute__((ext_vector_type(2)));
typedef float f32x2 __attribute__((ext_vector_type(2)));
__device__ __forceinline__ u32x4 pack8(f32x4 v0, f32x4 v1) { u32x4 w; w.x = cvt_pk_bf16(v0[0], v0[1]); w.y = cvt_pk_bf16(v0[2], v0[3]); w.z = cvt_pk_bf16(v1[0], v1[1]); w.w = cvt_pk_bf16(v1[2], v1[3]); return w; }
__device__ __forceinline__ f32x4 i2f(f32x4 a) { const i32x4 v = __builtin_bit_cast(i32x4, a); return (f32x4){(float)v[0], (float)v[1], (float)v[2], (float)v[3]}; }
struct EpiProj {
    static constexpr bool PERM = true, AFTER_DRAIN = false, INT8 = false;
    bf16_t* QKV; size_t split_stride; float scale0; bf16_t* H; const float* bglu;
    __device__ __forceinline__ void operator()(const f32x4 (&acc)[2][2][4][2], const Unit& u, int wr, int wc, int fr, int fq) const {
        const int row0 = u.pm * BM + wr * 64 + fr;
        if (u.pn < 12) {
            const int t = u.pn >> 2; bf16_t* base = QKV + (size_t)t * split_stride; const float sc = (t == 0) ? scale0 : 1.f;
            const int col0 = (u.pn & 3) * BM + wc * 32 + 8 * fq;
#pragma unroll
            for (int ai = 0; ai < 2; ++ai)
#pragma unroll
                for (int m = 0; m < 4; ++m) { bf16_t* rowp = base + (size_t)(row0 + ai * HALF + m * 16) * 1024 + col0;
#pragma unroll
                    for (int bj = 0; bj < 2; ++bj) *(u32x4*)(rowp + bj * HALF) = pack8(acc[ai][bj][m][0] * sc, acc[ai][bj][m][1] * sc); }
        } else {
            const int ch0 = (u.pn - 12) * HALF + wc * 32 + 8 * fq;
            const f32x4 ba0 = *(const f32x4*)(bglu + ch0), ba1 = *(const f32x4*)(bglu + ch0 + 4), bg0 = *(const f32x4*)(bglu + 1024 + ch0), bg1 = *(const f32x4*)(bglu + 1024 + ch0 + 4);
#pragma unroll
            for (int ai = 0; ai < 2; ++ai)
#pragma unroll
                for (int m = 0; m < 4; ++m) {
                    const f32x4 a0 = acc[ai][0][m][0] + ba0, a1 = acc[ai][0][m][1] + ba1, g0 = acc[ai][1][m][0] + bg0, g1 = acc[ai][1][m][1] + bg1;
                    f32x4 h0, h1;
#pragma unroll
                    for (int e = 0; e < 4; ++e) { h0[e] = a0[e] * __builtin_amdgcn_rcpf(1.f + __builtin_amdgcn_exp2f(-1.4426950409f * g0[e])); h1[e] = a1[e] * __builtin_amdgcn_rcpf(1.f + __builtin_amdgcn_exp2f(-1.4426950409f * g1[e])); }
                    *(u32x4*)(H + (size_t)(row0 + ai * HALF + m * 16) * 1024 + ch0) = pack8(h0, h1); }
        }
    }
};
struct EpiProjI8 {
    static constexpr bool PERM = true, AFTER_DRAIN = false, INT8 = true;
    bf16_t* QKV; size_t split_stride; float scale0; bf16_t* H; const float* bglu; const float* sa; const float* sb;
    __device__ __forceinline__ void operator()(const f32x4 (&acc)[2][2][4][2], const Unit& u, int wr, int wc, int fr, int fq) const {
        const int row0 = u.pm * BM + wr * 64 + fr, cb = u.pn * BM + wc * 32 + 8 * fq;
        f32x4 cs[2][2];
#pragma unroll
        for (int bj = 0; bj < 2; ++bj) { cs[bj][0] = *(const f32x4*)(sb + cb + bj * HALF); cs[bj][1] = *(const f32x4*)(sb + cb + bj * HALF + 4); }
        if (u.pn < 12) {
            const int t = u.pn >> 2; bf16_t* base = QKV + (size_t)t * split_stride; const float sc = (t == 0) ? scale0 : 1.f;
            const int col0 = (u.pn & 3) * BM + wc * 32 + 8 * fq;
#pragma unroll
            for (int ai = 0; ai < 2; ++ai)
#pragma unroll
                for (int m = 0; m < 4; ++m) { const int row = row0 + ai * HALF + m * 16; const float rs = sa[row] * sc; bf16_t* rowp = base + (size_t)row * 1024 + col0;
#pragma unroll
                    for (int bj = 0; bj < 2; ++bj) *(u32x4*)(rowp + bj * HALF) = pack8(i2f(acc[ai][bj][m][0]) * cs[bj][0] * rs, i2f(acc[ai][bj][m][1]) * cs[bj][1] * rs); }
        } else {
            const int ch0 = (u.pn - 12) * HALF + wc * 32 + 8 * fq;
            const f32x4 ba0 = *(const f32x4*)(bglu + ch0), ba1 = *(const f32x4*)(bglu + ch0 + 4), bg0 = *(const f32x4*)(bglu + 1024 + ch0), bg1 = *(const f32x4*)(bglu + 1024 + ch0 + 4);
#pragma unroll
            for (int ai = 0; ai < 2; ++ai)
#pragma unroll
                for (int m = 0; m < 4; ++m) { const int row = row0 + ai * HALF + m * 16; const float rs = sa[row];
                    const f32x4 a0 = i2f(acc[ai][0][m][0]) * cs[0][0] * rs + ba0, a1 = i2f(acc[ai][0][m][1]) * cs[0][1] * rs + ba1, g0 = i2f(acc[ai][1][m][0]) * cs[1][0] * rs + bg0, g1 = i2f(acc[ai][1][m][1]) * cs[1][1] * rs + bg1;
                    f32x4 h0, h1;
#pragma unroll
                    for (int e = 0; e < 4; ++e) { h0[e] = a0[e] * __builtin_amdgcn_rcpf(1.f + __builtin_amdgcn_exp2f(-1.4426950409f * g0[e])); h1[e] = a1[e] * __builtin_amdgcn_rcpf(1.f + __builtin_amdgcn_exp2f(-1.4426950409f * g1[e])); }
                    *(u32x4*)(H + (size_t)row * 1024 + ch0) = pack8(h0, h1); }
        }
    }
};
struct EpiRes {
    static constexpr bool PERM = true, AFTER_DRAIN = false, INT8 = false;
    const float* X; bf16_t* Y; int ldc; float alpha;
    __device__ __forceinline__ void operator()(const f32x4 (&acc)[2][2][4][2], const Unit& u, int wr, int wc, int fr, int fq) const {
        const int row0 = u.pm * BM + wr * 64 + fr, col0 = u.pn * BM + wc * 32 + 8 * fq;
#pragma unroll
        for (int ai = 0; ai < 2; ++ai)
#pragma unroll
            for (int m = 0; m < 4; ++m) { const size_t off = (size_t)(row0 + ai * HALF + m * 16) * ldc + col0;
#pragma unroll
                for (int bj = 0; bj < 2; ++bj) { const f32x4 x0 = *(const f32x4*)(X + off + bj * HALF), x1 = *(const f32x4*)(X + off + bj * HALF + 4);
                    *(u32x4*)(Y + off + bj * HALF) = pack8(acc[ai][bj][m][0] + x0 * alpha, acc[ai][bj][m][1] + x1 * alpha); } }
    }
};
struct EpiPlainI8 {
    static constexpr bool PERM = true, AFTER_DRAIN = false, INT8 = true;
    bf16_t* O; int ldc; const float* sa; const float* sb;
    __device__ __forceinline__ void operator()(const f32x4 (&acc)[2][2][4][2], const Unit& u, int wr, int wc, int fr, int fq) const {
        const int row0 = u.pm * BM + wr * 64 + fr, col0 = u.pn * BM + wc * 32 + 8 * fq;
        f32x4 cs[2][2];
#pragma unroll
        for (int bj = 0; bj < 2; ++bj) { cs[bj][0] = *(const f32x4*)(sb + col0 + bj * HALF); cs[bj][1] = *(const f32x4*)(sb + col0 + bj * HALF + 4); }
#pragma unroll
        for (int ai = 0; ai < 2; ++ai)
#pragma unroll
            for (int m = 0; m < 4; ++m) { const int row = row0 + ai * HALF + m * 16; const float rs = sa[row]; bf16_t* rowp = O + (size_t)row * ldc + col0;
#pragma unroll
                for (int bj = 0; bj < 2; ++bj) *(u32x4*)(rowp + bj * HALF) = pack8(i2f(acc[ai][bj][m][0]) * cs[bj][0] * rs, i2f(acc[ai][bj][m][1]) * cs[bj][1] * rs); }
    }
};
struct EpiResI8 {
    static constexpr bool PERM = true, AFTER_DRAIN = false, INT8 = true;
    const float* X; bf16_t* Y; int ldc; float alpha; const float* sa; const float* sb;
    __device__ __forceinline__ void operator()(const f32x4 (&acc)[2][2][4][2], const Unit& u, int wr, int wc, int fr, int fq) const {
        const int row0 = u.pm * BM + wr * 64 + fr, col0 = u.pn * BM + wc * 32 + 8 * fq;
        f32x4 cs[2][2];
#pragma unroll
        for (int bj = 0; bj < 2; ++bj) { cs[bj][0] = *(const f32x4*)(sb + col0 + bj * HALF); cs[bj][1] = *(const f32x4*)(sb + col0 + bj * HALF + 4); }
#pragma unroll
        for (int ai = 0; ai < 2; ++ai)
#pragma unroll
            for (int m = 0; m < 4; ++m) { const int row = row0 + ai * HALF + m * 16; const float rs = sa[row]; const size_t off = (size_t)row * ldc + col0;
#pragma unroll
                for (int bj = 0; bj < 2; ++bj) { const f32x4 x0 = *(const f32x4*)(X + off + bj * HALF), x1 = *(const f32x4*)(X + off + bj * HALF + 4);
                    *(u32x4*)(Y + off + bj * HALF) = pack8(i2f(acc[ai][bj][m][0]) * cs[bj][0] * rs + x0 * alpha, i2f(acc[ai][bj][m][1]) * cs[bj][1] * rs + x1 * alpha); } }
    }
};
struct EpiPlain {
    static constexpr bool PERM = true, AFTER_DRAIN = false, INT8 = false;
    bf16_t* O; int ldc;
    __device__ __forceinline__ void operator()(const f32x4 (&acc)[2][2][4][2], const Unit& u, int wr, int wc, int fr, int fq) const {
        const int row0 = u.pm * BM + wr * 64 + fr, col0 = u.pn * BM + wc * 32 + 8 * fq;
#pragma unroll
        for (int ai = 0; ai < 2; ++ai)
#pragma unroll
            for (int m = 0; m < 4; ++m) { bf16_t* rowp = O + (size_t)(row0 + ai * HALF + m * 16) * ldc + col0;
#pragma unroll
                for (int bj = 0; bj < 2; ++bj) *(u32x4*)(rowp + bj * HALF) = pack8(acc[ai][bj][m][0], acc[ai][bj][m][1]); }
    }
};

template <class Epi, class Sched, bool ALIGN_EPI = false, bool SP2 = false>
__device__ __forceinline__ void gemm_phase(PG8_LAS unsigned char* lds, const Gemm g, const Sched& S, const Epi& E) {
    const int tid = threadIdx.x, wid = __builtin_amdgcn_readfirstlane(tid >> 6), lane = tid & 63, wr = wid >> 2, wc = wid & 3, fr = lane & 15, fq = lane >> 4;
    const int K = g.K, nt = K / BK;
    unsigned voffA[2], voffB[2];
#pragma unroll
    for (int i = 0; i < 2; ++i) { int R, C; stage_rc(tid * 16 + i * 8192, R, C); const int Rb = Epi::PERM ? ((R & ~31) + perm32(R & 31)) : R;
        voffA[i] = (unsigned)(R * K + C) * 2u; voffB[i] = (unsigned)(Rb * K + C) * 2u; }
    const size_t kstep = (size_t)(BK * 2);
    const size_t hstep = (size_t)HALF * K * 2;
    const size_t tstep = 2 * hstep;
    const unsigned ldsw = (unsigned)wid * 1024u;
    const int aoff = lds_byte(wr * 64 + fr, fq * 8), boff = lds_byte(wc * 32 + fr, fq * 8);
#define PG8_SA(b, h) (((b) * 2 + (h)) * HTB)
#define PG8_SB(b, h) ((4 + (b) * 2 + (h)) * HTB)
#define PG8_STAGE(bufoff, gbase, voff) do { _Pragma("unroll") for (int _i = 0; _i < 2; ++_i) \
        __builtin_amdgcn_global_load_lds((const unsigned*)((const char*)(gbase) + (voff)[_i]), (PG8_LAS unsigned*)(lds + (bufoff) + ldsw + _i * 8192), 16, 0, 0); } while (0)
#define PG8_LDA(dst, b, h) do { _Pragma("unroll") for (int m = 0; m < 4; ++m) _Pragma("unroll") for (int k = 0; k < 2; ++k) dst[m][k] = *(const PG8_LAS bf16x8*)(lds + PG8_SA(b, h) + aoff + m * 2048 + k * 1024); } while (0)
#define PG8_LDB(dst, b, h) do { _Pragma("unroll") for (int n = 0; n < 2; ++n) _Pragma("unroll") for (int k = 0; k < 2; ++k) dst[n][k] = *(const PG8_LAS bf16x8*)(lds + PG8_SB(b, h) + boff + n * 2048 + k * 1024); } while (0)
#define PG8_MMA(ai, bj, At, Bt) do { __builtin_amdgcn_s_setprio(1); _Pragma("unroll") for (int m = 0; m < 4; ++m) _Pragma("unroll") for (int n = 0; n < 2; ++n) _Pragma("unroll") for (int k = 0; k < 2; ++k) { \
        if constexpr (Epi::INT8) acc[ai][bj][m][n] = __builtin_bit_cast(f32x4, __builtin_amdgcn_mfma_i32_16x16x64_i8(__builtin_bit_cast(i32x4, Bt[n][k]), __builtin_bit_cast(i32x4, At[m][k]), __builtin_bit_cast(i32x4, acc[ai][bj][m][n]), 0, 0, 0)); \
        else acc[ai][bj][m][n] = __builtin_amdgcn_mfma_f32_16x16x32_bf16(Bt[n][k], At[m][k], acc[ai][bj][m][n], 0, 0, 0); } __builtin_amdgcn_s_setprio(0); } while (0)
#define PG8_WAIT_V(n) asm volatile("s_waitcnt vmcnt(" #n ")" ::: "memory")
#define PG8_WAIT_L(n) asm volatile("s_waitcnt lgkmcnt(" #n ")" ::: "memory")
#define PG8_BAR __builtin_amdgcn_s_barrier()
#define PG8_SCHED __builtin_amdgcn_sched_barrier(0)
    Unit cur, nxt; int ui = 0;
    if (!S.next(0, cur)) return;
    f32x4 acc[2][2][4][2];
#pragma unroll
    for (int a = 0; a < 2; ++a)
#pragma unroll
        for (int b = 0; b < 2; ++b)
#pragma unroll
            for (int m = 0; m < 4; ++m)
#pragma unroll
                for (int n = 0; n < 2; ++n) acc[a][b][m][n] = (f32x4){0.f, 0.f, 0.f, 0.f};
    bf16x8 At[4][2], B0[2][2], B1[2][2];
    const char* cA = (const char*)g.A + (size_t)cur.pm * tstep; const char* cB = (const char*)g.Bt + (size_t)cur.pn * tstep;
    S.a_ready(cur);
    if constexpr (SP2) {
        PG8_STAGE(PG8_SB(0, 0), cB, voffB); PG8_STAGE(PG8_SB(0, 1), cB + hstep, voffB); PG8_STAGE(PG8_SA(0, 0), cA, voffA); PG8_STAGE(PG8_SA(0, 1), cA + hstep, voffA);
        if (wr == 1) PG8_BAR;
        PG8_WAIT_V(2); PG8_BAR;
        PG8_STAGE(PG8_SB(1, 0), cB + kstep, voffB); PG8_STAGE(PG8_SA(1, 0), cA + kstep, voffA); PG8_STAGE(PG8_SB(1, 1), cB + hstep + kstep, voffB);
        PG8_WAIT_V(6); PG8_BAR;
    } else {
        PG8_STAGE(PG8_SB(0, 0), cB, voffB); PG8_STAGE(PG8_SA(0, 0), cA, voffA); PG8_STAGE(PG8_SB(0, 1), cB + hstep, voffB); PG8_STAGE(PG8_SA(0, 1), cA + hstep, voffA);
        if (wr == 1) PG8_BAR;
        PG8_WAIT_V(4); PG8_BAR;
        PG8_STAGE(PG8_SB(1, 0), cB + kstep, voffB); PG8_STAGE(PG8_SA(1, 0), cA + kstep, voffA); PG8_STAGE(PG8_SB(1, 1), cB + hstep + kstep, voffB);
        PG8_WAIT_V(6); PG8_BAR;
    }
    for (;;) {
        const bool has_next = S.next(ui + 1, nxt);
        const char* nA = has_next ? (const char*)g.A + (size_t)nxt.pm * tstep : cA; const char* nB = has_next ? (const char*)g.Bt + (size_t)nxt.pn * tstep : cB;
        for (int t = 0; t < nt; t += 2) {
            const bool last = (t == nt - 2);
            const char* a1 = cA + (size_t)(t + 1) * kstep;
            const char* a2 = last ? nA : cA + (size_t)(t + 2) * kstep; const char* b2 = last ? nB : cB + (size_t)(t + 2) * kstep;
            const char* a3 = a2 + kstep; const char* b3 = b2 + kstep;
            if (last && has_next) S.a_ready(nxt);
            if constexpr (SP2) {
            PG8_LDB(B0, 0, 0); PG8_LDB(B1, 0, 1); PG8_SCHED; PG8_LDA(At, 0, 0); PG8_STAGE(PG8_SA(1, 1), a1 + hstep, voffA);
            PG8_WAIT_V(8); PG8_WAIT_L(0); PG8_BAR; PG8_MMA(0, 0, At, B0); PG8_MMA(0, 1, At, B1); PG8_BAR; PG8_SCHED;
            PG8_LDA(At, 0, 1); PG8_STAGE(PG8_SB(0, 0), b2, voffB); PG8_STAGE(PG8_SB(0, 1), b2 + hstep, voffB); PG8_STAGE(PG8_SA(0, 0), a2, voffA);
            PG8_WAIT_V(8); PG8_WAIT_L(0); PG8_BAR; PG8_MMA(1, 0, At, B0); PG8_MMA(1, 1, At, B1); PG8_BAR; PG8_SCHED;
            PG8_LDB(B0, 1, 0); PG8_LDB(B1, 1, 1); PG8_SCHED; PG8_LDA(At, 1, 0); PG8_STAGE(PG8_SA(0, 1), a2 + hstep, voffA);
            PG8_WAIT_V(8); PG8_WAIT_L(0); PG8_BAR; PG8_MMA(0, 0, At, B0); PG8_MMA(0, 1, At, B1); PG8_BAR; PG8_SCHED;
            PG8_LDA(At, 1, 1); PG8_STAGE(PG8_SB(1, 0), b3, voffB); PG8_STAGE(PG8_SB(1, 1), b3 + hstep, voffB); PG8_STAGE(PG8_SA(1, 0), a3, voffA);
            PG8_WAIT_V(8); PG8_WAIT_L(0); PG8_BAR; PG8_MMA(1, 0, At, B0); PG8_MMA(1, 1, At, B1); PG8_BAR; PG8_SCHED;
            } else {
            PG8_LDB(B0, 0, 0); PG8_SCHED; PG8_LDA(At, 0, 0); PG8_STAGE(PG8_SA(1, 1), a1 + hstep, voffA);
            PG8_WAIT_L(8); PG8_BAR; PG8_WAIT_L(0); PG8_MMA(0, 0, At, B0); PG8_BAR; PG8_SCHED;
            PG8_LDB(B1, 0, 1); PG8_STAGE(PG8_SB(0, 0), b2, voffB);
            PG8_BAR; PG8_WAIT_L(0); PG8_MMA(0, 1, At, B1); PG8_BAR;
            PG8_LDA(At, 0, 1); PG8_STAGE(PG8_SA(0, 0), a2, voffA);
            PG8_BAR; PG8_WAIT_L(0); PG8_MMA(1, 0, At, B0); PG8_BAR; PG8_SCHED;
            PG8_STAGE(PG8_SB(0, 1), b2 + hstep, voffB);
            PG8_WAIT_V(6); PG8_BAR; PG8_MMA(1, 1, At, B1); PG8_BAR;
            PG8_LDB(B0, 1, 0); PG8_SCHED; PG8_LDA(At, 1, 0); PG8_STAGE(PG8_SA(0, 1), a2 + hstep, voffA);
            PG8_WAIT_L(8); PG8_BAR; PG8_WAIT_L(0); PG8_MMA(0, 0, At, B0); PG8_BAR; PG8_SCHED;
            PG8_LDB(B1, 1, 1); PG8_STAGE(PG8_SB(1, 0), b3, voffB);
            PG8_BAR; PG8_WAIT_L(0); PG8_MMA(0, 1, At, B1); PG8_BAR;
            PG8_LDA(At, 1, 1); PG8_STAGE(PG8_SA(1, 0), a3, voffA);
            PG8_BAR; PG8_WAIT_L(0); PG8_MMA(1, 0, At, B0); PG8_BAR; PG8_SCHED;
            PG8_STAGE(PG8_SB(1, 1), b3 + hstep, voffB);
            PG8_WAIT_V(6); PG8_BAR; PG8_MMA(1, 1, At, B1); PG8_BAR;
            }
        }
        if constexpr (ALIGN_EPI) { if (wr == 0) PG8_BAR; }
        if constexpr (!Epi::AFTER_DRAIN) { E(acc, cur, wr, wc, fr, fq); S.done(cur); }
        if (!has_next) break;
#pragma unroll
        for (int a = 0; a < 2; ++a)
#pragma unroll
            for (int b = 0; b < 2; ++b)
#pragma unroll
                for (int m = 0; m < 4; ++m)
#pragma unroll
                    for (int n = 0; n < 2; ++n) acc[a][b][m][n] = (f32x4){0.f, 0.f, 0.f, 0.f};
        cur = nxt; cA = nA; cB = nB; ++ui;
        if constexpr (ALIGN_EPI) { if (wr == 1) PG8_BAR; }
    }
    PG8_WAIT_V(0);
    if constexpr (!ALIGN_EPI) { if (wr == 0) PG8_BAR; }
    PG8_BAR;
    if constexpr (Epi::AFTER_DRAIN) { E.fused(acc, cur, wr, wc, fr, fq, lds, wid, lane); S.done(cur); }
#undef PG8_SA
#undef PG8_SB
#undef PG8_STAGE
#undef PG8_LDA
#undef PG8_LDB
#undef PG8_MMA
#undef PG8_WAIT_V
#undef PG8_WAIT_L
#undef PG8_BAR
#undef PG8_SCHED
}
}
#include <hip/hip_bf16.h>
#include <cmath>
namespace attn_body {
using bf16=__hip_bfloat16;
using bf16x8=__attribute__((ext_vector_type(8)))short;
using s16x4=__attribute__((ext_vector_type(4)))short;
using f32x16=__attribute__((ext_vector_type(16)))float;
using u32x4=__attribute__((ext_vector_type(4)))unsigned;
constexpr int BATCH=8,NHEAD=16,SEQ=4096,D=64,DM=NHEAD*D;
constexpr int NW=8,QBLK=32,QB=QBLK*NW,KVBLK=64,NQB=SEQ/QB;
constexpr int ATTN_PITCH=DM, ATTN_UNIT_ROWS=QB;
__device__ __forceinline__ int crow(int r,int hi){return (r&3)+8*(r>>2)+4*hi;}
#define SBAR() __builtin_amdgcn_sched_barrier(0)
__device__ __forceinline__ void cmask(f32x16&p0,f32x16&p1,int jb,int qrel,int hi){
  const float NEG=-INFINITY; int kb=64*jb+4*hi;
  #pragma unroll
  for(int r=0;r<16;++r){int kv=kb+(r&3)+8*(r>>2); if(kv>qrel)p0[r]=NEG; if(kv+32>qrel)p1[r]=NEG;}
}

__device__ __forceinline__ void cbias(f32x16&p0,f32x16&p1,int jb,int qrel,int hi,const __attribute__((address_space(3))) float*tab){
  const int base=qrel-64*jb-4*hi;
  #pragma unroll
  for(int r=0;r<16;++r){const int d0=base-((r&3)+8*(r>>2)); const int i0=min(max(d0,0),127), i1=min(max(d0-32,0),127); p0[r]+=tab[i0]; p1[r]+=tab[i1];}
}
constexpr int NSLOT=3, SLOTB=8192;
constexpr int LDS_K=0, LDS_V=NSLOT*SLOTB, LDS_WS=2*NSLOT*SLOTB, LDS_OST=LDS_WS+NW*64*4, LDS_TAB=LDS_OST+NW*4096, LDS_BYTES=LDS_TAB+512;
constexpr float C2=0.125f*1.4426950408889634f;
__device__ __forceinline__ void glds16(const void*gsrc,unsigned lds_dst){unsigned keep;
  asm volatile("s_mov_b32 %0, m0\n\ts_mov_b32 m0, %2\n\ts_nop 0\n\tglobal_load_lds_dwordx4 %1, off\n\ts_mov_b32 m0, %0":"=&s"(keep):"v"(gsrc),"s"(lds_dst):"memory");}
__device__ __forceinline__ float max3f(float a,float b,float c){float r;asm("v_max3_f32 %0, %1, %2, %3":"=v"(r):"v"(a),"v"(b),"v"(c));return r;}
__device__ __forceinline__ float max2f(float a,float b){float r;asm("v_max_f32_e32 %0, %1, %2":"=v"(r):"v"(a),"v"(b));return r;}
__device__ __forceinline__ float fadd_s(float a,float b){float r;asm("v_add_f32_e32 %0, %1, %2":"=v"(r):"v"(a),"v"(b));return r;}
__device__ __forceinline__ float fsub_s(float a,float b){float r;asm("v_sub_f32_e32 %0, %1, %2":"=v"(r):"v"(a),"v"(b));return r;}
typedef float f32x2_t __attribute__((ext_vector_type(2))); typedef __bf16 bf16x2_t __attribute__((ext_vector_type(2)));
__device__ __forceinline__ unsigned cvtpk_s(float lo,float hi){f32x2_t v={lo,hi};bf16x2_t b=__builtin_convertvector(v,bf16x2_t);return __builtin_bit_cast(unsigned,b);}
#define WAIT_BAR(N) asm volatile("s_waitcnt vmcnt(" #N ") lgkmcnt(0)\n\ts_barrier":::"memory")

__device__ __forceinline__ void qkt(f32x16&p0,f32x16&p1,const char*Kslot,const bf16x8*qr,const f32x16&negm,int r32,int hi){
  const char*kb=Kslot+hi*1024+r32*16;
  #pragma unroll
  for(int d0=0;d0<4;++d0){
    const bf16x8 b0=*reinterpret_cast<const bf16x8*>(kb+d0*2048);
    const bf16x8 b1=*reinterpret_cast<const bf16x8*>(kb+d0*2048+512);
    if(d0==0){p0=__builtin_amdgcn_mfma_f32_32x32x16_bf16(b0,qr[0],negm,0,0,0);p1=__builtin_amdgcn_mfma_f32_32x32x16_bf16(b1,qr[0],negm,0,0,0);}
    else{p0=__builtin_amdgcn_mfma_f32_32x32x16_bf16(b0,qr[d0],p0,0,0,0);p1=__builtin_amdgcn_mfma_f32_32x32x16_bf16(b1,qr[d0],p1,0,0,0);}}
}
typedef __attribute__((address_space(3))) const char* lds_cptr;
typedef short v4i16_t __attribute__((ext_vector_type(4)));
__device__ __forceinline__ void kload8(bf16x8*kf,lds_cptr kp){
  kf[0]=*(const __attribute__((address_space(3))) bf16x8*)(kp);      kf[1]=*(const __attribute__((address_space(3))) bf16x8*)(kp+512);
  kf[2]=*(const __attribute__((address_space(3))) bf16x8*)(kp+2048); kf[3]=*(const __attribute__((address_space(3))) bf16x8*)(kp+2560);
  kf[4]=*(const __attribute__((address_space(3))) bf16x8*)(kp+4096); kf[5]=*(const __attribute__((address_space(3))) bf16x8*)(kp+4608);
  kf[6]=*(const __attribute__((address_space(3))) bf16x8*)(kp+6144); kf[7]=*(const __attribute__((address_space(3))) bf16x8*)(kp+6656);
}
__device__ __forceinline__ void kload2(bf16x8*kf,lds_cptr kp,int j){ kf[2*j]=*(const __attribute__((address_space(3))) bf16x8*)(kp+j*2048); kf[2*j+1]=*(const __attribute__((address_space(3))) bf16x8*)(kp+j*2048+512); }
__device__ __forceinline__ s16x4 vtr(lds_cptr p){ return __builtin_bit_cast(s16x4,__builtin_amdgcn_ds_read_tr16_b64_v4i16((__attribute__((address_space(3))) v4i16_t*)p)); }
__device__ __forceinline__ float rowmax(const f32x16&p0,const f32x16&p1){
  float a=max3f(p0[0],p0[1],p1[0]),b=max3f(p0[2],p0[3],p1[1]);a=max3f(a,p1[2],p1[3]);
  #pragma unroll
  for(int r=4;r<16;r+=4){a=max3f(a,p0[r],p0[r+1]);b=max3f(b,p0[r+2],p0[r+3]);a=max3f(a,p1[r],p1[r+1]);b=max3f(b,p1[r+2],p1[r+3]);}
  const float m=max2f(a,b);
  auto rr=__builtin_amdgcn_permlane32_swap(__float_as_uint(m),__float_as_uint(m),false,false);
  return max2f(__uint_as_float(rr[0]),__uint_as_float(rr[1]));
}
__device__ __forceinline__ void pv(f32x16*o,int vb,bf16x8 pa0,bf16x8 pa1,bf16x8 pa2,bf16x8 pa3){
  #pragma unroll
  for(int d0=0;d0<2;++d0){s16x4 lo[4],hi[4];
    #pragma unroll
    for(int ks=0;ks<4;++ks){
      asm volatile("ds_read_b64_tr_b16 %0,%1 offset:%c2":"=&v"(lo[ks]):"v"(vb),"i"(d0*4096+ks*1024):"memory");
      asm volatile("ds_read_b64_tr_b16 %0,%1 offset:%c2":"=&v"(hi[ks]):"v"(vb),"i"(d0*4096+ks*1024+512):"memory");}
    asm volatile("s_waitcnt lgkmcnt(0)":::"memory");SBAR();
    #define PK(k) (bf16x8){lo[k][0],lo[k][1],lo[k][2],lo[k][3],hi[k][0],hi[k][1],hi[k][2],hi[k][3]}
    o[d0]=__builtin_amdgcn_mfma_f32_32x32x16_bf16(pa0,PK(0),o[d0],0,0,0);
    o[d0]=__builtin_amdgcn_mfma_f32_32x32x16_bf16(pa1,PK(1),o[d0],0,0,0);
    o[d0]=__builtin_amdgcn_mfma_f32_32x32x16_bf16(pa2,PK(2),o[d0],0,0,0);
    o[d0]=__builtin_amdgcn_mfma_f32_32x32x16_bf16(pa3,PK(3),o[d0],0,0,0);
    #undef PK
  }
}

#ifndef ATTN_STORE16
#define ATTN_STORE16(p,v) (*(u32x4*)(p)=(v))
#endif
template<int THRL> __device__ __forceinline__ void attn_unit(int b,int h,int hv,int qb,const bf16*Q,const bf16*__restrict__ K,const bf16*__restrict__ V,bf16*O,char*shm){
  const __attribute__((address_space(3))) float* tab=(const __attribute__((address_space(3))) float*)((lds_cptr)shm+LDS_TAB);
  const int tid=threadIdx.x,lane=tid&63,r32=lane&31,hi=lane>>5; const int wid=__builtin_amdgcn_readfirstlane(tid>>6);
  const long rowbase=(long)b*SEQ; const int q0=qb*QB;
  const bf16*Qw=Q+(rowbase+q0+wid*QBLK)*DM+h*D;
  const bf16*Kh=K+rowbase*DM+h*D,*Vh=V+rowbase*DM+hv*D;
  const unsigned lds0=(unsigned)(uintptr_t)shm;
  float*wsf=(float*)(shm+LDS_WS)+wid*64;
  const bf16*ksrc=Kh+(long)lane*DM+wid*8;
  const bf16*vsrc=Vh+(long)(16*(wid&3)+(lane>>2))*DM+(wid>>2)*32+(lane&3)*8;
  const unsigned kdst=lds0+LDS_K+wid*1024, vdst=lds0+LDS_V+wid*1024;
  #define DMA_K(t,slot) glds16(ksrc+(long)(t)*KVBLK*DM,(unsigned)__builtin_amdgcn_readfirstlane(kdst+(slot)))
  #define DMA_V(t,slot) glds16(vsrc+(long)(t)*KVBLK*DM,(unsigned)__builtin_amdgcn_readfirstlane(vdst+(slot)))
  const int vb0=(int)(lds0+LDS_V)+((lane>>4)&1)*32+(lane&3)*8+(4*hi+((lane&15)>>2))*64;
  const char*Kbase=shm+LDS_K; bf16x8 kf[8];
  const lds_cptr shm3=(lds_cptr)shm; const lds_cptr kp0=shm3+LDS_K+hi*1024+r32*16; const lds_cptr vp0=shm3+LDS_V+((lane>>4)&1)*32+(lane&3)*8+(4*hi+((lane&15)>>2))*64;
  const int NT=(q0+QB)/KVBLK;
  DMA_K(0,0);DMA_V(0,0);DMA_K(1,SLOTB);
  bf16x8 qr[4];
  #pragma unroll
  for(int d0=0;d0<4;++d0)qr[d0]=*reinterpret_cast<const bf16x8*>(&Qw[(long)r32*DM+d0*16+hi*8]);
  float mhat=0.f,l_reg=0.f;f32x16 o[2];o[0]=f32x16{};o[1]=f32x16{};f32x16 negm=f32x16{};asm volatile("":"+v"(negm));
  const int qrel=wid*QBLK+r32;
  #define CMASK(P0,P1,t) do{int jb_=(t)-(NT-4); if(jb_>=-2){cbias(P0,P1,jb_,qrel,hi,tab); if(jb_>=0)cmask(P0,P1,jb_,qrel,hi);}}while(0)
  bool resc=false;
  #define START(P0,P1) do{ const float rm=rowmax(P0,P1); resc=false; \
    { const float dl=rm; mhat=fadd_s(mhat,dl); \
      _Pragma("unroll") for(int r=0;r<16;++r){P0[r]=fsub_s(P0[r],dl);P1[r]=fsub_s(P1[r],dl);} \
      _Pragma("unroll") for(int r=0;r<16;++r)negm[r]=-mhat; asm volatile("":"+v"(negm)); } \
    _Pragma("unroll") for(int r=0;r<16;++r)P0[r]=__builtin_amdgcn_exp2f(P0[r]); }while(0)
  #define RESC() do{ if(resc){ asm volatile("s_waitcnt lgkmcnt(0)":::"memory"); \
      _Pragma("unroll") for(int d_=0;d_<2;++d_) _Pragma("unroll") for(int r=0;r<16;++r)o[d_][r]*=wsf[crow(r,hi)]; } }while(0)
  f32x16 pA0,pA1,pB0,pB1;
  int sl_prev=0,sl_cur=0,sl_next=SLOTB;
  #define ROT() do{sl_prev=sl_cur;sl_cur=sl_next;sl_next=(sl_next==(NSLOT-1)*SLOTB)?0:sl_next+SLOTB;}while(0)
  DMA_K(2,2*SLOTB);
  WAIT_BAR(3);
  qkt(pA0,pA1,Kbase,qr,negm,r32,hi);asm volatile("s_nop 15\n\ts_nop 7":"+v"(pA0),"+v"(pA1));CMASK(pA0,pA1,0);
  START(pA0,pA1);
  _Pragma("unroll") for(int r=0;r<16;++r)pA1[r]=__builtin_amdgcn_exp2f(pA1[r]);
  WAIT_BAR(0);
  DMA_K(3,0);DMA_V(1,SLOTB);
  ROT();
  kload8(kf,kp0+sl_cur);
  WAIT_BAR(2);
  s16x4 vlo[8],vhi[8]; u32x4 pw0,pw1,pw2,pw3;
  #define PKW(P,B) cvtpk_s(P[B],P[B+1])
  #define PAF(k) __builtin_bit_cast(bf16x8,pw##k)
  #define VFR(i) (bf16x8){vlo[i][0],vlo[i][1],vlo[i][2],vlo[i][3],vhi[i][0],vhi[i][1],vhi[i][2],vhi[i][3]}
  #define PIN(x) asm volatile("":"+v"(x))
  #define MX3(a,b,c) __builtin_fmaxf(__builtin_fmaxf((a),(b)),(c))
  #define GAPA(MF,A0,A1,A2,A3,W0,W1,PW) do{ MF; sacc+=A0; sacc+=A1; sacc+=A2; sacc+=A3; PIN(sacc); W0; W1; PIN(PW); SBAR(); }while(0)
  #define EX(v) __builtin_amdgcn_exp2f(v)
  #define GAPB(MF,X,B) do{ MF; X[B]=EX(X[B]); X[B+1]=EX(X[B+1]); X[B+2]=EX(X[B+2]); X[B+3]=EX(X[B+3]); PIN(X); SBAR(); }while(0)
  #define VRD(i) do{ vlo[i]=vtr(vp_+(((i)>>2)*4096+((i)&3)*1024)); vhi[i]=vtr(vp_+(((i)>>2)*4096+((i)&3)*1024+512)); }while(0)
  #define KRD(G,j) do{ if(G){ kload2(kf,kp0+sl_next,j); SBAR(); } }while(0)
  #define STEP(C0,C1,P0,P1,t,GK,GV,GL) do{ SBAR(); \
    const lds_cptr vp_=vp0+sl_prev; \
    VRD(0); SBAR(); float sacc=(P0[0]+P0[1]); \
    GAPA(C0=__builtin_amdgcn_mfma_f32_32x32x16_bf16(kf[0],qr[0],negm,0,0,0), P0[2],P0[3],P0[4],P0[5],     pw0[0]=PKW(P0,0), pw0[1]=PKW(P0,2), pw0); \
    VRD(4); SBAR(); GAPA(C1=__builtin_amdgcn_mfma_f32_32x32x16_bf16(kf[1],qr[0],negm,0,0,0), P0[6],P0[7],P0[8],P0[9],     pw0[2]=PKW(P0,4), pw0[3]=PKW(P0,6), pw0); \
    VRD(1); SBAR(); GAPA(C0=__builtin_amdgcn_mfma_f32_32x32x16_bf16(kf[2],qr[1],C0,0,0,0),   P0[10],P0[11],P0[12],P0[13], pw1[0]=PKW(P0,8), pw1[1]=PKW(P0,10), pw1); \
    VRD(5); SBAR(); GAPA(C1=__builtin_amdgcn_mfma_f32_32x32x16_bf16(kf[3],qr[1],C1,0,0,0),   P0[14],P0[15],P1[0],P1[1],   pw1[2]=PKW(P0,12),pw1[3]=PKW(P0,14), pw1); \
    VRD(2); SBAR(); GAPA(C0=__builtin_amdgcn_mfma_f32_32x32x16_bf16(kf[4],qr[2],C0,0,0,0),   P1[2],P1[3],P1[4],P1[5],     pw2[0]=PKW(P1,0), pw2[1]=PKW(P1,2), pw2); \
    VRD(6); SBAR(); GAPA(C1=__builtin_amdgcn_mfma_f32_32x32x16_bf16(kf[5],qr[2],C1,0,0,0),   P1[6],P1[7],P1[8],P1[9],     pw2[2]=PKW(P1,4), pw2[3]=PKW(P1,6), pw2); \
    VRD(3); SBAR(); GAPA(C0=__builtin_amdgcn_mfma_f32_32x32x16_bf16(kf[6],qr[3],C0,0,0,0),   P1[10],P1[11],P1[12],P1[13], pw3[0]=PKW(P1,8), pw3[1]=PKW(P1,10), pw3); \
    VRD(7); SBAR(); GAPA(C1=__builtin_amdgcn_mfma_f32_32x32x16_bf16(kf[7],qr[3],C1,0,0,0),   P1[14],P1[15],0.f,0.f,       pw3[2]=PKW(P1,12),pw3[3]=PKW(P1,14), pw3); \
    l_reg+=sacc; \
    if(GK){DMA_K((t)+3,sl_cur);} if(GV){DMA_V((t)+1,sl_next);} \
    CMASK(C0,C1,t); \
    { float a=MX3(C0[0],C0[1],C1[0]),b=MX3(C0[2],C0[3],C1[1]); a=MX3(a,C1[2],C1[3]); \
      _Pragma("unroll") for(int r=4;r<16;r+=4){a=MX3(a,C0[r],C0[r+1]);b=MX3(b,C0[r+2],C0[r+3]);a=MX3(a,C1[r],C1[r+1]);b=MX3(b,C1[r+2],C1[r+3]);} \
      float rm=__builtin_fmaxf(a,b); { auto rr=__builtin_amdgcn_permlane32_swap(__float_as_uint(rm),__float_as_uint(rm),false,false); rm=__builtin_fmaxf(__uint_as_float(rr[0]),__uint_as_float(rr[1])); } \
      resc=false; \
      if(__builtin_expect(__any(rm>(float)THRL),0)){ const float dl=__builtin_fmaxf(rm,0.f); mhat+=dl; \
        _Pragma("unroll") for(int r=0;r<16;++r){C0[r]-=dl;C1[r]-=dl;} \
        _Pragma("unroll") for(int r=0;r<16;++r)negm[r]=-mhat; asm volatile("":"+v"(negm)); \
        const float f=__builtin_amdgcn_exp2f(-dl); l_reg*=f; if(hi==0)wsf[r32]=f; resc=true; } } \
    SBAR(); \
    GAPB(o[0]=__builtin_amdgcn_mfma_f32_32x32x16_bf16(PAF(0),VFR(0),o[0],0,0,0), C0,0); \
    GAPB(o[1]=__builtin_amdgcn_mfma_f32_32x32x16_bf16(PAF(0),VFR(4),o[1],0,0,0), C0,4); \
    KRD(GL,0); GAPB(o[0]=__builtin_amdgcn_mfma_f32_32x32x16_bf16(PAF(1),VFR(1),o[0],0,0,0), C0,8); \
    KRD(GL,1); GAPB(o[1]=__builtin_amdgcn_mfma_f32_32x32x16_bf16(PAF(1),VFR(5),o[1],0,0,0), C0,12); \
    KRD(GL,2); GAPB(o[0]=__builtin_amdgcn_mfma_f32_32x32x16_bf16(PAF(2),VFR(2),o[0],0,0,0), C1,0); \
    KRD(GL,3); GAPB(o[1]=__builtin_amdgcn_mfma_f32_32x32x16_bf16(PAF(2),VFR(6),o[1],0,0,0), C1,4); \
    GAPB(o[0]=__builtin_amdgcn_mfma_f32_32x32x16_bf16(PAF(3),VFR(3),o[0],0,0,0), C1,8); \
    GAPB(o[1]=__builtin_amdgcn_mfma_f32_32x32x16_bf16(PAF(3),VFR(7),o[1],0,0,0), C1,12); \
    }while(0)
  int t=1;
  #undef CMASK
  #define CMASK(P0,P1,t) do{}while(0)
  for(;t+7<NT;t+=2){
    STEP(pB0,pB1,pA0,pA1,t,true,true,true);     WAIT_BAR(2); RESC(); ROT();
    STEP(pA0,pA1,pB0,pB1,t+1,true,true,true);   WAIT_BAR(2); RESC(); ROT();
  }
  #undef CMASK
  #define CMASK(P0,P1,t) do{int jb_=(t)-(NT-4); if(jb_>=-2){cbias(P0,P1,jb_,qrel,hi,tab); if(jb_>=0)cmask(P0,P1,jb_,qrel,hi);}}while(0)
  #define ENDW(tt) do{ if((tt)+3<NT){WAIT_BAR(2);} else if((tt)+2<NT){WAIT_BAR(1);} else {WAIT_BAR(0);} }while(0)
  for(;t+1<NT;t+=2){
    STEP(pB0,pB1,pA0,pA1,t,(t+3<NT),(t+1<NT),(t+1<NT));       ENDW(t);   RESC(); ROT();
    STEP(pA0,pA1,pB0,pB1,t+1,(t+4<NT),(t+2<NT),(t+2<NT));     ENDW(t+1); RESC(); ROT();
  }
  STEP(pB0,pB1,pA0,pA1,NT-1,false,false,false); RESC();
  { float sacc=pB0[0]+pB0[1]; _Pragma("unroll") for(int r=2;r<16;++r)sacc+=pB0[r]; _Pragma("unroll") for(int r=0;r<16;++r)sacc+=pB1[r]; l_reg+=sacc;
    pw0=(u32x4){PKW(pB0,0),PKW(pB0,2),PKW(pB0,4),PKW(pB0,6)};pw1=(u32x4){PKW(pB0,8),PKW(pB0,10),PKW(pB0,12),PKW(pB0,14)};pw2=(u32x4){PKW(pB1,0),PKW(pB1,2),PKW(pB1,4),PKW(pB1,6)};pw3=(u32x4){PKW(pB1,8),PKW(pB1,10),PKW(pB1,12),PKW(pB1,14)};
    SBAR(); pv(o,vb0+sl_cur,PAF(0),PAF(1),PAF(2),PAF(3)); }
  #undef PKW
  #undef PAF
  #undef VFR
  #undef PIN
  #undef MX3
  #undef GAPA
  #undef GAPB
  #undef EX
  #undef VRD
  #undef KRD
  #undef STEP
  #undef ENDW
  {auto rr=__builtin_amdgcn_permlane32_swap(__float_as_uint(l_reg),__float_as_uint(l_reg),false,false);l_reg=__uint_as_float(rr[0])+__uint_as_float(rr[1]);}
  if(hi==0)wsf[32+r32]=l_reg;asm volatile("s_waitcnt lgkmcnt(0)":::"memory");
  float rli[16];
  #pragma unroll
  for(int r=0;r<16;++r)rli[r]=__builtin_amdgcn_rcpf(wsf[32+crow(r,hi)]);
  bf16*Ow=O+(rowbase+q0+wid*QBLK)*DM+hv*D;
  { bf16*stg=(bf16*)(shm+LDS_OST)+wid*2048;
    #pragma unroll
    for(int r=0;r<16;++r){const int orow=crow(r,hi);
      #pragma unroll
      for(int d0=0;d0<2;++d0)stg[orow*64+d0*32+r32]=__float2bfloat16(o[d0][r]*rli[r]);}
    asm volatile("s_waitcnt lgkmcnt(0)":::"memory");
    #pragma unroll
    for(int i=0;i<4;++i){const int row=i*8+(lane>>3),ch=lane&7; const u32x4 v=*(const u32x4*)(stg+row*64+ch*8); ATTN_STORE16(Ow+(long)row*DM+ch*8,v);} }
  asm volatile("s_waitcnt lgkmcnt(0)\n\ts_barrier":::"memory");
  #undef DMA_K
  #undef DMA_V
  #undef CMASK
  #undef START
  #undef RESC
  #undef ROT
}
constexpr int ATTN_LDS_BYTES=LDS_BYTES;
struct AttnTensors { const bf16* Q; const bf16* K; const bf16* V; bf16* O1; bf16* O2; const float* biastab; };
struct AttnUnit { int b, hqk, hv, c, qb; };
struct StaticOrder {
  int vcu;
  __device__ __forceinline__ explicit StaticOrder(int grid,int block):vcu((grid%8==0)?(block%8)*(grid/8)+block/8:block){}
  __device__ __forceinline__ bool next(int i,AttnUnit&u)const{ if(i>=16)return false; const int v=vcu&255; u.b=v>>5; const int h=(v>>2)&7,c=(v>>1)&1,hf=v&1; u.hqk=2*h+c; u.hv=2*h+hf; u.c=c; u.qb=(i&1)?15-(i>>1):(i>>1); return true; }
};
template<class Sched,int THRL=8> __device__ __forceinline__ void attn_phase(char*lds,const AttnTensors&T,const Sched&S){
  AttnUnit u; int cur_h=-1;
  for(int i=0;S.next(i,u);++i){
    if((u.hqk>>1)!=cur_h){ cur_h=u.hqk>>1;
      if(threadIdx.x<128)((float*)(lds+LDS_TAB))[threadIdx.x]=T.biastab[cur_h*128+threadIdx.x];
      asm volatile("s_waitcnt vmcnt(0) lgkmcnt(0)\n\ts_barrier":::"memory"); }
    attn_unit<THRL>(u.b,u.hqk,u.hv,u.qb,T.Q,T.K,T.V,u.c?T.O2:T.O1,lds); }
}
#undef SBAR
#undef WAIT_BAR
}
#ifndef PG8_SP2
#define PG8_SP2 true
#endif
#ifndef PG8_ALIGN
#define PG8_ALIGN true
#endif
constexpr int NWAVES = 8;
#ifndef MK_N_LAUNCHES
#define MK_N_LAUNCHES 1
#endif
constexpr int N_PHASES = 8;
constexpr int BATCH = 8, SEQ = 4096, D = 2048, M = BATCH * SEQ;
constexpr int NPROJ = 5120, DATT = 1024, DCONV = 1024, CONVW = 31;
constexpr int PH = 8, PNK = 128, PHALF = 128, PTOPK = 16, NEXP = 16384;
constexpr float LN_EPS = 1e-5f;
constexpr float DN_ALPHA = 1.189207115002721f;
constexpr float LAMBDA_INIT = 0.2f;
constexpr size_t MiB = 1u << 20;
constexpr size_t WS_WIN = 2 * MiB, WS_WOUT = 22 * MiB, WS_WQ = 30 * MiB, WS_KEYS = 38 * MiB, WS_TAB = 39 * MiB;
constexpr size_t WS_U8 = 40 * MiB, WS_V8 = 72 * MiB, WS_SU = 104 * MiB, WS_SV = 105 * MiB;
constexpr size_t WS_XB = 168 * MiB;
constexpr size_t WS_Q = 296 * MiB, WS_K = 360 * MiB, WS_V = 424 * MiB, WS_H = 488 * MiB;
constexpr size_t WS_O1 = 552 * MiB, WS_O2 = 616 * MiB;
constexpr size_t WS_Y1 = 680 * MiB;
constexpr size_t WS_QP = 808 * MiB;
constexpr size_t WS_X8 = WS_O1;
constexpr size_t WS_SX = 106 * MiB, WS_SWQ = 107 * MiB, WS_SWIN = WS_SWQ + 65536, WS_SWOUT = WS_SWQ + 131072, WS_SXA = 108 * MiB, WS_SM = 109 * MiB, WS_LNS = 110 * MiB;
constexpr size_t WS_CMAX = 16384;
constexpr size_t WS_EID = 936 * MiB, WS_GATE = 952 * MiB;
constexpr size_t WS_END = 968 * MiB;
constexpr int RING_BYTES = 131072, LDS_BYTES = 147456;

#define GAS __attribute__((address_space(1)))
#define LAS __attribute__((address_space(3)))
typedef unsigned short bf16;
typedef unsigned v4u __attribute__((ext_vector_type(4)));
typedef unsigned v2u __attribute__((ext_vector_type(2)));
typedef float f32x4 __attribute__((ext_vector_type(4)));
typedef float f32x16 __attribute__((ext_vector_type(16)));
typedef short bf16x8 __attribute__((ext_vector_type(8)));
typedef __bf16 bf16x2_t __attribute__((ext_vector_type(2)));
#define LDS_WAIT() asm volatile("s_waitcnt lgkmcnt(0)" ::: "memory")
__device__ __forceinline__ unsigned f2bf(float f) { unsigned u = __builtin_bit_cast(unsigned, f); return (u + 0x7fffu + ((u >> 16) & 1u)) >> 16; }
__device__ __forceinline__ unsigned pk2(float lo, float hi) { return f2bf(lo) | (f2bf(hi) << 16); }
__device__ __forceinline__ float bflo(unsigned w) { return __uint_as_float(w << 16); }
__device__ __forceinline__ float bfhi(unsigned w) { return __uint_as_float(w & 0xffff0000u); }
__device__ __forceinline__ float wave_sum(float v) {
#pragma unroll
    for (int o = 1; o < 64; o <<= 1) v += __shfl_xor(v, o);
    return v;
}
__device__ __forceinline__ float dot2bf(unsigned a, unsigned b, float acc) { return __builtin_amdgcn_fdot2_f32_bf16(__builtin_bit_cast(bf16x2_t, a), __builtin_bit_cast(bf16x2_t, b), acc, false); }

#define XB_TMO      128
#define XB_XCNT(j)  (256  + 64 * (j))
#define XB_XSUB(j)  (1280 + 64 * (j))
#define XB_XGEN(j)  (2304 + 64 * (j))
#define XB_TOP      3328
#define XB_TOPGEN   3392
#define XCD_BAR_WORDS 3456
#define XB_SPIN_CAP (1u << 18)

__device__ __forceinline__ unsigned xb_ld(unsigned* p)              { return __hip_atomic_load(p, __ATOMIC_RELAXED, __HIP_MEMORY_SCOPE_AGENT); }
__device__ __forceinline__ unsigned xb_add(unsigned* p, unsigned v) { return __hip_atomic_fetch_add(p, v, __ATOMIC_RELAXED, __HIP_MEMORY_SCOPE_AGENT); }
__device__ __forceinline__ unsigned xb_xcc_id() { return (unsigned)__builtin_amdgcn_s_getreg((3 << 11) | 20) & 0xFu; }
#define XB_SPIN(cond, bar) do { unsigned _sp = 0; while (cond) { __builtin_amdgcn_s_sleep(1); \
    if ((++_sp & 255u) == 0u) { if (xb_ld(&(bar)[XB_TMO])) break; if (_sp > XB_SPIN_CAP) { atomicAdd(&(bar)[XB_TMO], 1u); break; } } } } while (0)

struct XcdBarrier {
    unsigned* bar; unsigned x;
    volatile LAS unsigned* st;
};

__device__ __forceinline__ XcdBarrier xcd_barrier_post(unsigned* bar, volatile LAS unsigned* st) {
    XcdBarrier b; b.bar = bar; b.x = xb_xcc_id(); b.st = st;
    if (threadIdx.x == 0) (void)xb_add(&bar[XB_XCNT(b.x)], 1u);
    return b;
}
__device__ __forceinline__ void xcd_barrier_complete(unsigned* bar, unsigned x, unsigned& nloc, unsigned& nx) {
    const unsigned G = gridDim.x * gridDim.y * gridDim.z;
    unsigned sum, cnt, mine, sp = 0u;
    for (;;) {
        sum = 0u; cnt = 0u; mine = 0u;
#pragma unroll
        for (unsigned j = 0; j < 16; ++j) { const unsigned c = xb_ld(&bar[XB_XCNT(j)]); sum += c; cnt += (c > 0u) ? 1u : 0u; mine = (j == x) ? c : mine; }
        if (sum == G) break;
        __builtin_amdgcn_s_sleep(1);
        if ((++sp & 255u) == 0u) { if (xb_ld(&bar[XB_TMO])) break; if (sp > XB_SPIN_CAP) { atomicAdd(&bar[XB_TMO], 1u); break; } }
    }
    nloc = mine > 0u ? mine : 1u; nx = cnt > 0u ? cnt : 1u;
}

__device__ __forceinline__ void xcd_barrier(const XcdBarrier& b) {
    asm volatile("s_waitcnt vmcnt(0)" ::: "memory");
    __syncthreads();
    if (threadIdx.x == 0) {
        unsigned* bar = b.bar;
        __builtin_amdgcn_s_waitcnt(0);
        unsigned nloc = b.st[0], nx = b.st[1];
        if (nloc == 0u) { xcd_barrier_complete(bar, b.x, nloc, nx); b.st[0] = nloc; b.st[1] = nx; }
        const unsigned old = xb_add(&bar[XB_XSUB(b.x)], 1u);
        const unsigned gen = old / nloc;
        if (old + 1u == (gen + 1u) * nloc) {
            __builtin_amdgcn_fence(__ATOMIC_RELEASE, "agent");
            asm volatile("s_waitcnt vmcnt(0)" ::: "memory");
            const unsigned og = xb_add(&bar[XB_TOP], 1u);
            const unsigned tg = og / nx;
            if (og + 1u == (tg + 1u) * nx) xb_add(&bar[XB_TOPGEN], 1u);
            else XB_SPIN(xb_ld(&bar[XB_TOPGEN]) == tg, bar);
            __builtin_amdgcn_fence(__ATOMIC_ACQUIRE, "agent");
            xb_add(&bar[XB_XGEN(b.x)], 1u);
            asm volatile("s_waitcnt vmcnt(0)" ::: "memory");
        } else {
            XB_SPIN(xb_ld(&bar[XB_XGEN(b.x)]) == gen, bar);
            __builtin_amdgcn_fence(__ATOMIC_ACQUIRE, "agent");
            asm volatile("s_waitcnt vmcnt(0)" ::: "memory");
        }
    }
    __syncthreads();
}

struct Frame {
    LAS unsigned char* lds;
    __device__ __forceinline__ int wave_() const { int w = __builtin_amdgcn_readfirstlane((int)threadIdx.x >> 6); asm volatile("" : "+s"(w)); return w; }
    __device__ __forceinline__ int G_() const { int g = (int)gridDim.x; asm volatile("" : "+s"(g)); return g; }
    __device__ __forceinline__ int vcu_() const { int bx = (int)blockIdx.x; asm volatile("" : "+s"(bx)); const int g = G_(); return (g % 8 == 0) ? (bx % 8) * (g / 8) + bx / 8 : bx; }
    __device__ __forceinline__ int tid() const { int t = (int)threadIdx.x; asm volatile("" : "+v"(t)); return t; }
    __device__ __forceinline__ int lane() const { return tid() & 63; }
    __device__ __forceinline__ unsigned long long raw(int k) const { const volatile LAS unsigned* p = (const volatile LAS unsigned*)(lds + RING_BYTES) + 2 * k;
        const unsigned lo = __builtin_amdgcn_readfirstlane(p[0]), hi = __builtin_amdgcn_readfirstlane(p[1]); return ((unsigned long long)hi << 32) | lo; }
    __device__ __forceinline__ const float* in(int k) const { return (const float*)raw(k); }
    __device__ __forceinline__ float* outp() const { return (float*)raw(22); }
    template <class T> __device__ __forceinline__ T* ws(size_t off) const { return (T*)((unsigned char*)raw(23) + off); }
};
enum { I_X = 0, I_WIN, I_BGLU, I_CONVW, I_CONVB, I_CLNG, I_CLNB, I_LQ1, I_LK1, I_LQ2, I_LK2, I_SUBLN, I_RELB, I_WOUT, I_LN1G, I_LN1B, I_WQ, I_KEYS, I_U, I_V, I_LN2G, I_LN2B };

__device__ __forceinline__ unsigned pack_i8x4(float a, float b, float c, float d) {
    const int ia = (int)rintf(a), ib = (int)rintf(b), ic = (int)rintf(c), id = (int)rintf(d); return (unsigned)(ia & 255) | ((unsigned)(ib & 255) << 8) | ((unsigned)(ic & 255) << 16) | ((unsigned)id << 24); }
__device__ __forceinline__ void p0_transpose_item(const float* W, int K, int N, bf16* WT, int k0, int n0, int dst0, LAS float* scr, int lane) {
#pragma unroll 8
    for (int i = 0; i < 32; ++i) { const int kk = 2 * i + (lane >> 5); scr[kk * 33 + (lane & 31)] = W[(size_t)(k0 + kk) * N + n0 + (lane & 31)]; }
    LDS_WAIT(); asm volatile("" ::: "memory");
    const int c = lane & 7;
#pragma unroll
    for (int j = 0; j < 4; ++j) { const int n = (lane >> 3) + 8 * j; const LAS float* s = scr + (8 * c) * 33 + n;
        v4u o; o.x = pk2(s[0 * 33], s[1 * 33]); o.y = pk2(s[2 * 33], s[3 * 33]); o.z = pk2(s[4 * 33], s[5 * 33]); o.w = pk2(s[6 * 33], s[7 * 33]);
        *(GAS v4u*)(WT + (size_t)(dst0 + n) * K + k0 + 8 * c) = o; }
    LDS_WAIT(); asm volatile("" ::: "memory");
}
__device__ __forceinline__ void p0_colmax_item(const float* W, int N, unsigned* cmax, int k0, int n0, int dst0, int lane) {
    float am = 0.f;
#pragma unroll 8
    for (int i = 0; i < 32; ++i) { const int kk = 2 * i + (lane >> 5); am = fmaxf(am, fabsf(W[(size_t)(k0 + kk) * N + n0 + (lane & 31)])); }
    am = fmaxf(am, __shfl_xor(am, 32));
    if (lane < 32) atomicMax(cmax + dst0 + lane, __float_as_uint(am));
}
__device__ __forceinline__ void p0_quant_item(const float* W, int N, unsigned char* WT8, const unsigned* cmax, float* scale, int k0, int n0, int dst0, LAS float* scr, int lane) {
#pragma unroll 8
    for (int i = 0; i < 32; ++i) { const int kk = 2 * i + (lane >> 5); scr[kk * 33 + (lane & 31)] = W[(size_t)(k0 + kk) * N + n0 + (lane & 31)]; }
    if (lane < 32) { const float am = __uint_as_float(__hip_atomic_load(cmax + dst0 + lane, __ATOMIC_RELAXED, __HIP_MEMORY_SCOPE_AGENT)); const float sc = am > 0.f ? am * (1.f / 127.f) : 1.f;
        scr[64 * 33 + lane] = 1.f / sc; if (k0 == 0) scale[dst0 + lane] = sc; }
    LDS_WAIT(); asm volatile("" ::: "memory");
    const int c = lane & 7;
#pragma unroll
    for (int j = 0; j < 4; ++j) { const int n = (lane >> 3) + 8 * j; const LAS float* sp = scr + (8 * c) * 33 + n; const float inv = scr[64 * 33 + n];
        *(GAS v2u*)(WT8 + (size_t)(dst0 + n) * D + k0 + 8 * c) = (v2u){pack_i8x4(sp[0 * 33] * inv, sp[1 * 33] * inv, sp[2 * 33] * inv, sp[3 * 33] * inv), pack_i8x4(sp[4 * 33] * inv, sp[5 * 33] * inv, sp[6 * 33] * inv, sp[7 * 33] * inv)}; }
    LDS_WAIT(); asm volatile("" ::: "memory");
}
__device__ __forceinline__ int glu_dst(int n0) {
    if (n0 < 3072) return n0;
    const int ch = (n0 - 3072) & 1023, gate = (n0 - 3072) >> 10; return 3072 + 256 * (ch >> 7) + 128 * gate + (ch & 127);
}
__device__ __forceinline__ void p0_quant_x(const float* src, unsigned char* dst8, float* scale, int rows, int gw, int NGW, int lane) {
    f32x4 nx[8];
    if (gw < rows) { const GAS f32x4* sp = (const GAS f32x4*)(src + (size_t)gw * D) + lane;
#pragma unroll
        for (int j = 0; j < 8; ++j) nx[j] = sp[64 * j]; }
    for (int r = gw; r < rows; r += NGW) {
        f32x4 v[8]; float am = 0.f;
#pragma unroll
        for (int j = 0; j < 8; ++j) v[j] = nx[j];
        { const int rn = (r + NGW < rows) ? r + NGW : r; const GAS f32x4* sp = (const GAS f32x4*)(src + (size_t)rn * D) + lane;
#pragma unroll
          for (int j = 0; j < 8; ++j) nx[j] = sp[64 * j]; }
#pragma unroll
        for (int j = 0; j < 8; ++j) am = fmaxf(fmaxf(am, fmaxf(fabsf(v[j].x), fabsf(v[j].y))), fmaxf(fabsf(v[j].z), fabsf(v[j].w)));
#pragma unroll
        for (int o = 1; o < 64; o <<= 1) am = fmaxf(am, __shfl_xor(am, o));
        const float sc = am > 0.f ? am * (1.f / 127.f) : 1.f, inv = 1.f / sc;
        GAS unsigned* dp = (GAS unsigned*)(dst8 + (size_t)r * D) + lane;
#pragma unroll
        for (int j = 0; j < 8; ++j) dp[64 * j] = pack_i8x4(v[j].x * inv, v[j].y * inv, v[j].z * inv, v[j].w * inv);
        if (lane == 0) scale[r] = sc;
    }
}
__device__ __forceinline__ void p0_convert(const float* src, bf16* dst, size_t n, int gw, int NGW, int lane) {
    const size_t nit = n / 512;
    for (size_t it = gw; it < nit; it += NGW) { const GAS f32x4* s = (const GAS f32x4*)(src + it * 512) + 2 * lane; const f32x4 a = s[0], b = s[1];
        v4u o; o.x = pk2(a.x, a.y); o.y = pk2(a.z, a.w); o.z = pk2(b.x, b.y); o.w = pk2(b.z, b.w); *((GAS v4u*)(dst + it * 512) + lane) = o; }
}
template <bool INT8> __device__ __forceinline__ void p0_quant_rows(const float* src, unsigned* dst8, float* scale, int rows, int gw, int NGW, int lane) {
    f32x4 nx[8];
    if (gw < rows) { const GAS f32x4* sp = (const GAS f32x4*)(src + (size_t)gw * D) + lane;
#pragma unroll
        for (int j = 0; j < 8; ++j) nx[j] = sp[64 * j]; }
    for (int r = gw; r < rows; r += NGW) {
        f32x4 v[8]; float am = 0.f;
#pragma unroll
        for (int j = 0; j < 8; ++j) v[j] = nx[j];
        { const int rn = (r + NGW < rows) ? r + NGW : r; const GAS f32x4* sp = (const GAS f32x4*)(src + (size_t)rn * D) + lane;
#pragma unroll
          for (int j = 0; j < 8; ++j) nx[j] = sp[64 * j]; }
#pragma unroll
        for (int j = 0; j < 8; ++j) am = fmaxf(fmaxf(am, fmaxf(fabsf(v[j].x), fabsf(v[j].y))), fmaxf(fabsf(v[j].z), fabsf(v[j].w)));
#pragma unroll
        for (int o = 1; o < 64; o <<= 1) am = fmaxf(am, __shfl_xor(am, o));
        const float sc = am > 0.f ? am * (INT8 ? (1.f / 127.f) : (1.f / 440.f)) : 1.f, inv = 1.f / sc;
#pragma unroll
        for (int j = 0; j < 8; ++j) { int w;
            if (INT8) w = (int)pack_i8x4(v[j].x * inv, v[j].y * inv, v[j].z * inv, v[j].w * inv);
            else { w = __builtin_amdgcn_cvt_pk_fp8_f32(v[j].x * inv, v[j].y * inv, 0, false); w = __builtin_amdgcn_cvt_pk_fp8_f32(v[j].z * inv, v[j].w * inv, w, true); }
            const int wi = lane + 64 * j, c = wi >> 5; *((GAS unsigned*)dst8 + ((size_t)c * rows + r) * 32 + (wi & 31)) = (unsigned)w; }
        if (lane == 0) scale[r] = sc;
    }
}
__device__ __forceinline__ int t5_bucket(int d) {
    if (d < 16) return d;
    int l = 16 + (int)(logf((float)d / 16.f) / logf(8.f) * 16.f); return l < 31 ? l : 31;
}
__device__ __forceinline__ void p0a_prologue(Frame& F) {
    LAS float* scr = (LAS float*)(F.lds + F.wave_() * 16384);
    constexpr int I_IN = (D / 64) * (NPROJ / 32), I_OUT = (D / 64) * (D / 32);
    { const float* w_in = F.in(I_WIN); unsigned* cmax = F.ws<unsigned>(WS_CMAX); const int gw = F.vcu_() * NWAVES + F.wave_(), NGW = F.G_() * NWAVES;
      for (int r = gw; r < I_IN; r += NGW) { const int nblk = NPROJ / 32, kb = r / nblk, nb = r % nblk; p0_colmax_item(w_in, NPROJ, cmax, 64 * kb, 32 * nb, glu_dst(32 * nb), F.lane()); } }
    { const float* wq = F.in(I_WQ); unsigned* cmax = F.ws<unsigned>(WS_CMAX) + NPROJ; const int gw = F.vcu_() * NWAVES + F.wave_(), NGW = F.G_() * NWAVES;
      for (int r = gw; r < I_OUT; r += NGW) { const int nblk = D / 32, kb = r / nblk, nb = r % nblk; p0_colmax_item(wq, D, cmax, 64 * kb, 32 * nb, 32 * nb, F.lane()); } }
    { const float* wo = F.in(I_WOUT); unsigned* cmax = F.ws<unsigned>(WS_CMAX) + NPROJ + D; const int gw = F.vcu_() * NWAVES + F.wave_(), NGW = F.G_() * NWAVES;
      for (int r = gw; r < I_OUT; r += NGW) { const int nblk = D / 32, kb = r / nblk, nb = r % nblk; p0_colmax_item(wo, D, cmax, 64 * kb, 32 * nb, 32 * nb, F.lane()); } }
    { const int gw = F.vcu_() * NWAVES + F.wave_(), NGW = F.G_() * NWAVES; p0_quant_x(F.in(I_X), F.ws<unsigned char>(WS_XB), F.ws<float>(WS_SXA), M, gw, NGW, F.lane()); }
    { const int gw = F.vcu_() * NWAVES + F.wave_(), NGW = F.G_() * NWAVES; p0_quant_rows<true>(F.in(I_U), F.ws<unsigned>(WS_U8), F.ws<float>(WS_SU), NEXP, gw, NGW, F.lane()); }
    { const int gw = F.vcu_() * NWAVES + F.wave_(), NGW = F.G_() * NWAVES; p0_quant_rows<true>(F.in(I_V), F.ws<unsigned>(WS_V8), F.ws<float>(WS_SV), NEXP, gw, NGW, F.lane()); }
    { const int gw = F.vcu_() * NWAVES + F.wave_(), NGW = F.G_() * NWAVES; p0_convert(F.in(I_KEYS), F.ws<bf16>(WS_KEYS), (size_t)PH * 2 * PNK * PHALF, gw, NGW, F.lane()); }
    if (blockIdx.x == 0) { const float* rel_bias = F.in(I_RELB); float* TAB = F.ws<float>(WS_TAB);
        for (int i = F.tid(); i < 8 * 128; i += NWAVES * 64) { const int h = i >> 7, d = i & 127;
            TAB[i] = (rel_bias[t5_bucket(d) * 8 + h] - rel_bias[31 * 8 + h]) * 1.4426950408889634f; } }
}
__device__ __forceinline__ void p0b_prologue(Frame& F) {
    LAS float* scr = (LAS float*)(F.lds + F.wave_() * 16384);
    constexpr int I_IN = (D / 64) * (NPROJ / 32), I_OUT = (D / 64) * (D / 32);
    { const float* w_in = F.in(I_WIN); unsigned char* W8 = F.ws<unsigned char>(WS_WIN); const unsigned* cmax = F.ws<unsigned>(WS_CMAX); float* sw = F.ws<float>(WS_SWIN); const int gw = F.vcu_() * NWAVES + F.wave_(), NGW = F.G_() * NWAVES;
      for (int r = gw; r < I_IN; r += NGW) { const int nblk = NPROJ / 32, kb = r / nblk, nb = r % nblk; p0_quant_item(w_in, NPROJ, W8, cmax, sw, 64 * kb, 32 * nb, glu_dst(32 * nb), scr, F.lane()); } }
    { const float* wq = F.in(I_WQ); unsigned char* W8 = F.ws<unsigned char>(WS_WQ); const unsigned* cmax = F.ws<unsigned>(WS_CMAX) + NPROJ; float* sw = F.ws<float>(WS_SWQ); const int gw = F.vcu_() * NWAVES + F.wave_(), NGW = F.G_() * NWAVES;
      for (int r = gw; r < I_OUT; r += NGW) { const int nblk = D / 32, kb = r / nblk, nb = r % nblk; p0_quant_item(wq, D, W8, cmax, sw, 64 * kb, 32 * nb, 32 * nb, scr, F.lane()); } }
    { const float* wo = F.in(I_WOUT); unsigned char* W8 = F.ws<unsigned char>(WS_WOUT); const unsigned* cmax = F.ws<unsigned>(WS_CMAX) + NPROJ + D; float* sw = F.ws<float>(WS_SWOUT); const int gw = F.vcu_() * NWAVES + F.wave_(), NGW = F.G_() * NWAVES;
      for (int r = gw; r < I_OUT; r += NGW) { const int nblk = D / 32, kb = r / nblk, nb = r % nblk; p0_quant_item(wo, D, W8, cmax, sw, 64 * kb, 32 * nb, 32 * nb, scr, F.lane()); } }
}

__device__ __forceinline__ float diff_lambda(Frame& F) {
    const float a = wave_sum(F.in(I_LQ1)[F.lane()] * F.in(I_LK1)[F.lane()]), b = wave_sum(F.in(I_LQ2)[F.lane()] * F.in(I_LK2)[F.lane()]);
    return expf(a) - expf(b) + LAMBDA_INIT;
}
template <int CTRL> __device__ __forceinline__ int dppi(int v) { return __builtin_amdgcn_update_dpp(0, v, CTRL, 0xf, 0xf, true); }
template <int CTRL> __device__ __forceinline__ float dppf(float v) { return __int_as_float(__builtin_amdgcn_update_dpp(0, __float_as_int(v), CTRL, 0xf, 0xf, true)); }
template <int CTRL, int RM> __device__ __forceinline__ float dpp_rm(float old, float v) { return __int_as_float(__builtin_amdgcn_update_dpp(__float_as_int(old), __float_as_int(v), CTRL, RM, 0xf, false)); }
__device__ __forceinline__ float wave_sum63(float v) {
    v += dppf<0xB1>(v); v += dppf<0x4E>(v); v += dppf<0x141>(v); v += dppf<0x140>(v);
    v += dpp_rm<0x142, 0xa>(0.f, v);
    v += dpp_rm<0x143, 0xc>(0.f, v);
    return v;
}
__device__ __forceinline__ float wave_max63(float v) {
    v = fmaxf(v, dppf<0xB1>(v)); v = fmaxf(v, dppf<0x4E>(v)); v = fmaxf(v, dppf<0x141>(v)); v = fmaxf(v, dppf<0x140>(v));
    v = fmaxf(v, dpp_rm<0x142, 0xa>(0.f, v)); v = fmaxf(v, dpp_rm<0x143, 0xc>(0.f, v));
    return v;
}
__device__ __forceinline__ void p3_mix(Frame& F) {
    constexpr int TT = 32, NPR = (TT + CONVW - 1) / 2, STATS_OFF = NPR * 4096, AMC_OFF = STATS_OFF + 2048, AMA_OFF = AMC_OFF + 1024, MS_OFF = AMA_OFF + 128, INV_OFF = MS_OFF + 256, STG_OFF = (TT / 2) * 4096;
    static_assert(INV_OFF + 128 <= RING_BYTES && STG_OFF + TT * 1024 <= STATS_OFF, "P3 LDS map");
    const int tid = F.tid(), lane = tid & 63, wave = F.wave_();
    const float lam = diff_lambda(F);
    const float* conv_w = F.in(I_CONVW); const bf16* H = F.ws<bf16>(WS_H); const bf16* O1 = F.ws<bf16>(WS_O1); const bf16* O2 = F.ws<bf16>(WS_O2);
    unsigned char* MIX8 = F.ws<unsigned char>(WS_XB); float* SM = F.ws<float>(WS_SM); const float* subln_g = F.in(I_SUBLN);
    const float2 cb = *(const float2*)(F.in(I_CONVB) + 2 * tid), lg = *(const float2*)(F.in(I_CLNG) + 2 * tid), lb = *(const float2*)(F.in(I_CLNB) + 2 * tid);
    LAS float* stats = (LAS float*)(F.lds + STATS_OFF); LAS float* amc = (LAS float*)(F.lds + AMC_OFF); LAS float* ama = (LAS float*)(F.lds + AMA_OFF); LAS float* ms = (LAS float*)(F.lds + MS_OFF); LAS float* invs = (LAS float*)(F.lds + INV_OFF);
    for (int tile_i = F.vcu_(); tile_i < M / TT; tile_i += F.G_()) {
        const int t0 = tile_i * TT, s0 = t0 & (SEQ - 1);
        for (int p = tid >> 7; p < NPR; p += 4) { const int sp = s0 - (CONVW - 1) + 2 * p; v4u a = (v4u){0u, 0u, 0u, 0u}, b = a;
            if (sp >= 0) { const GAS v4u* hp = (const GAS v4u*)(H + (size_t)(t0 - (CONVW - 1) + 2 * p) * 1024) + (tid & 127); a = hp[0]; b = hp[128]; }
            const unsigned aw[4] = {a.x, a.y, a.z, a.w}, bw[4] = {b.x, b.y, b.z, b.w}; unsigned o[8];
#pragma unroll
            for (int k = 0; k < 4; ++k) { o[2 * k] = __builtin_amdgcn_perm(bw[k], aw[k], 0x05040100u); o[2 * k + 1] = __builtin_amdgcn_perm(bw[k], aw[k], 0x07060302u); }
            LAS v4u* dst = (LAS v4u*)(F.lds + p * 4096 + (tid & 127) * 32); dst[0] = (v4u){o[0], o[1], o[2], o[3]}; dst[1] = (v4u){o[4], o[5], o[6], o[7]}; }
        __syncthreads();
        {
            unsigned we0[16], we1[16], wo0[16], wo1[16]; float2 wprev = {0.f, 0.f};
#pragma unroll
            for (int q = 0; q < 16; ++q) { const float2 wa = *(const float2*)(conv_w + (2 * q) * DCONV + 2 * tid); float2 wb = {0.f, 0.f}; if (2 * q + 1 < CONVW) wb = *(const float2*)(conv_w + (2 * q + 1) * DCONV + 2 * tid);
                we0[q] = pk2(wa.x, wb.x); we1[q] = pk2(wa.y, wb.y); wo0[q] = pk2(wprev.x, wa.x); wo1[q] = pk2(wprev.y, wa.y); wprev = wb; }
            for (int q = 0; q < TT / 2; ++q) {
                float e0 = cb.x, e1 = cb.y, o0 = cb.x, o1 = cb.y;
                const LAS v2u* src = (const LAS v2u*)(F.lds + q * 4096 + tid * 8);
#pragma unroll
                for (int j = 0; j < 16; ++j) { const v2u d = src[j * 512]; e0 = dot2bf(d.x, we0[j], e0); e1 = dot2bf(d.y, we1[j], e1); o0 = dot2bf(d.x, wo0[j], o0); o1 = dot2bf(d.y, wo1[j], o1); }
                const unsigned p0 = pk2(e0, o0), p1 = pk2(e1, o1); *(LAS v2u*)(F.lds + q * 4096 + tid * 8) = (v2u){p0, p1};
                const float re0 = bflo(p0), ro0 = bfhi(p0), re1 = bflo(p1), ro1 = bfhi(p1);
                const float se = wave_sum63(re0 + re1), qe = wave_sum63(re0 * re0 + re1 * re1), so = wave_sum63(ro0 + ro1), qo = wave_sum63(ro0 * ro0 + ro1 * ro1);
                if (lane == 63) { LAS float* st = stats + ((2 * q) * 8 + wave) * 2; st[0] = se; st[1] = qe; st[16] = so; st[17] = qo; }
            }
        }
        float av[4][16];
#pragma unroll
        for (int rr = 0; rr < 4; ++rr) { const int m = t0 + 4 * wave + rr;
            const GAS v4u* p1 = (const GAS v4u*)(O1 + (size_t)m * 1024) + 2 * lane; const GAS v4u* p2 = (const GAS v4u*)(O2 + (size_t)m * 1024) + 2 * lane;
            const v4u a0 = p1[0], a1 = p1[1], b0 = p2[0], b1 = p2[1];
            const unsigned aw[8] = {a0.x, a0.y, a0.z, a0.w, a1.x, a1.y, a1.z, a1.w}, bw[8] = {b0.x, b0.y, b0.z, b0.w, b1.x, b1.y, b1.z, b1.w};
            float ss = 0.f;
#pragma unroll
            for (int i = 0; i < 8; ++i) { av[rr][2 * i] = bflo(aw[i]) - lam * bflo(bw[i]); av[rr][2 * i + 1] = bfhi(aw[i]) - lam * bfhi(bw[i]); ss += av[rr][2 * i] * av[rr][2 * i] + av[rr][2 * i + 1] * av[rr][2 * i + 1]; }
            ss += __shfl_xor(ss, 1); ss += __shfl_xor(ss, 2); ss += __shfl_xor(ss, 4);
            const float r = (1.f - LAMBDA_INIT) / sqrtf(ss * (1.f / 128.f) + LN_EPS); float am = 0.f;
#pragma unroll
            for (int e = 0; e < 16; ++e) { av[rr][e] = av[rr][e] * r * subln_g[16 * (lane & 7) + e]; am = fmaxf(am, fabsf(av[rr][e])); }
            am = wave_max63(am);
            if (lane == 63) ama[4 * wave + rr] = am; }
        __syncthreads();
        if (tid < TT) { float s = 0.f, q = 0.f;
#pragma unroll
            for (int w = 0; w < 8; ++w) { s += stats[(tid * 8 + w) * 2]; q += stats[(tid * 8 + w) * 2 + 1]; }
            const float mean = s * (1.f / DCONV), var = fmaxf(q * (1.f / DCONV) - mean * mean, 0.f); ms[2 * tid] = mean; ms[2 * tid + 1] = 1.f / sqrtf(var + LN_EPS); }
        __syncthreads();
        for (int q = 0; q < TT / 2; ++q) {
            const f32x4 st = *(const LAS f32x4*)(ms + 4 * q);
            const v2u d = *(const LAS v2u*)(F.lds + q * 4096 + tid * 8);
            const float ye0 = (bflo(d.x) - st[0]) * st[1] * lg.x + lb.x, yo0 = (bfhi(d.x) - st[2]) * st[3] * lg.x + lb.x, ye1 = (bflo(d.y) - st[0]) * st[1] * lg.y + lb.y, yo1 = (bfhi(d.y) - st[2]) * st[3] * lg.y + lb.y;
#define SWISH_(y) ((y) * __builtin_amdgcn_rcpf(1.f + __builtin_amdgcn_exp2f(-1.4426950409f * (y))))
            const unsigned z0 = pk2(SWISH_(ye0), SWISH_(yo0)), z1 = pk2(SWISH_(ye1), SWISH_(yo1));
#undef SWISH_
            *(LAS v2u*)(F.lds + q * 4096 + tid * 8) = (v2u){z0, z1};
            const float me = wave_max63(fmaxf(fabsf(bflo(z0)), fabsf(bflo(z1)))), mo = wave_max63(fmaxf(fabsf(bfhi(z0)), fabsf(bfhi(z1))));
            if (lane == 63) { amc[(2 * q) * 8 + wave] = me; amc[(2 * q + 1) * 8 + wave] = mo; }
        }
        __syncthreads();
        if (tid < TT) { float am = ama[tid];
#pragma unroll
            for (int w = 0; w < 8; ++w) am = fmaxf(am, amc[tid * 8 + w]);
            const float sc = am > 0.f ? am * (1.f / 127.f) : 1.f; invs[tid] = 1.f / sc; SM[t0 + tid] = sc; }
        __syncthreads();
        for (int q = 0; q < TT / 2; ++q) {
            const float ie = invs[2 * q], io = invs[2 * q + 1];
            const v2u d = *(const LAS v2u*)(F.lds + q * 4096 + tid * 8);
            const int qe0 = (int)rintf(bflo(d.x) * ie), qe1 = (int)rintf(bflo(d.y) * ie), qo0 = (int)rintf(bfhi(d.x) * io), qo1 = (int)rintf(bfhi(d.y) * io);
            *(LAS unsigned short*)(F.lds + STG_OFF + (2 * q) * 1024 + 2 * tid) = (unsigned short)((qe0 & 255) | ((qe1 & 255) << 8));
            *(LAS unsigned short*)(F.lds + STG_OFF + (2 * q + 1) * 1024 + 2 * tid) = (unsigned short)((qo0 & 255) | ((qo1 & 255) << 8));
        }
#pragma unroll
        for (int rr = 0; rr < 4; ++rr) { const float inv = invs[4 * wave + rr];
            *((GAS v4u*)(MIX8 + (size_t)(t0 + 4 * wave + rr) * D) + lane) = (v4u){pack_i8x4(av[rr][0] * inv, av[rr][1] * inv, av[rr][2] * inv, av[rr][3] * inv), pack_i8x4(av[rr][4] * inv, av[rr][5] * inv, av[rr][6] * inv, av[rr][7] * inv),
                                                                              pack_i8x4(av[rr][8] * inv, av[rr][9] * inv, av[rr][10] * inv, av[rr][11] * inv), pack_i8x4(av[rr][12] * inv, av[rr][13] * inv, av[rr][14] * inv, av[rr][15] * inv)}; }
        __syncthreads();
        for (int idx = tid; idx < TT * 64; idx += NWAVES * 64) { const int row = idx >> 6, ch = idx & 63;
            *((GAS v4u*)(MIX8 + (size_t)(t0 + row) * D + DATT) + ch) = *(const LAS v4u*)(F.lds + STG_OFF + row * 1024 + ch * 16); }
        __syncthreads();
    }
}
__device__ __forceinline__ void p5_ln1(Frame& F) {
    const bf16* Y1 = F.ws<bf16>(WS_Y1); const float* ln1_g = F.in(I_LN1G); const float* ln1_b = F.in(I_LN1B); unsigned char* X8 = F.ws<unsigned char>(WS_X8); float* SX = F.ws<float>(WS_SX); float* LNS = F.ws<float>(WS_LNS);
    const int gw = F.vcu_() * NWAVES + F.wave_(), NGW = F.G_() * NWAVES, lane = F.lane();
    v4u nx[4];
    if (gw < M) { const GAS v4u* p = (const GAS v4u*)(Y1 + (size_t)gw * D) + lane;
#pragma unroll
        for (int j = 0; j < 4; ++j) nx[j] = p[64 * j]; }
    for (int m = gw; m < M; m += NGW) {
        v4u w[4]; float v[32]; float s = 0.f;
#pragma unroll
        for (int j = 0; j < 4; ++j) w[j] = nx[j];
        { const int mn = (m + NGW < M) ? m + NGW : m; const GAS v4u* p = (const GAS v4u*)(Y1 + (size_t)mn * D) + lane;
#pragma unroll
          for (int j = 0; j < 4; ++j) nx[j] = p[64 * j]; }
#pragma unroll
        for (int j = 0; j < 4; ++j) { const unsigned ww[4] = {w[j].x, w[j].y, w[j].z, w[j].w};
#pragma unroll
            for (int i = 0; i < 4; ++i) { v[8 * j + 2 * i] = bflo(ww[i]); v[8 * j + 2 * i + 1] = bfhi(ww[i]); s += v[8 * j + 2 * i] + v[8 * j + 2 * i + 1]; } }
        const float mean = wave_sum(s) * (1.f / D); float q = 0.f;
#pragma unroll
        for (int i = 0; i < 32; ++i) { v[i] -= mean; q += v[i] * v[i]; }
        const float rstd = 1.f / sqrtf(wave_sum(q) * (1.f / D) + LN_EPS);
        float am = 0.f;
#pragma unroll
        for (int j = 0; j < 4; ++j) { const int c0 = 8 * lane + 512 * j; const f32x4 g0 = *(const f32x4*)(ln1_g + c0), g1 = *(const f32x4*)(ln1_g + c0 + 4), b0 = *(const f32x4*)(ln1_b + c0), b1 = *(const f32x4*)(ln1_b + c0 + 4);
#pragma unroll
            for (int i = 0; i < 4; ++i) { v[8 * j + i] = v[8 * j + i] * rstd * g0[i] + b0[i]; v[8 * j + 4 + i] = v[8 * j + 4 + i] * rstd * g1[i] + b1[i]; am = fmaxf(am, fmaxf(fabsf(v[8 * j + i]), fabsf(v[8 * j + 4 + i]))); } }
#pragma unroll
        for (int o = 1; o < 64; o <<= 1) am = fmaxf(am, __shfl_xor(am, o));
        const float sc = am > 0.f ? am * (1.f / 127.f) : 1.f, inv = 1.f / sc;
        GAS v2u* p8 = (GAS v2u*)(X8 + (size_t)m * D) + lane;
#pragma unroll
        for (int j = 0; j < 4; ++j) p8[64 * j] = (v2u){pack_i8x4(v[8 * j] * inv, v[8 * j + 1] * inv, v[8 * j + 2] * inv, v[8 * j + 3] * inv), pack_i8x4(v[8 * j + 4] * inv, v[8 * j + 5] * inv, v[8 * j + 6] * inv, v[8 * j + 7] * inv)};
        if (lane == 0) { SX[m] = sc; LNS[2 * m] = mean; LNS[2 * m + 1] = rstd; }
    }
}
__device__ __forceinline__ int f2key(float f) { const int b = __float_as_int(f); return b ^ ((b >> 31) & 0x7fffffff); }
__device__ __forceinline__ float key2f(int k) { return __int_as_float(k ^ ((k >> 31) & 0x7fffffff)); }
#define CE_DESC(a, b) do { const int _x = max(a, b), _y = min(a, b); a = _x; b = _y; } while (0)
#define CE_ASC(a, b)  do { const int _x = min(a, b), _y = max(a, b); a = _x; b = _y; } while (0)
template <int N> __device__ __forceinline__ void sort_desc(int (&v)[N]) {
#pragma unroll
    for (int k = 2; k <= N; k <<= 1)
#pragma unroll
        for (int j = k >> 1; j > 0; j >>= 1)
#pragma unroll
            for (int i = 0; i < N; ++i) { const int l = i ^ j; if (l > i) { if ((i & k) == 0) CE_DESC(v[i], v[l]); else CE_ASC(v[i], v[l]); } }
}
template <int N> __device__ __forceinline__ void bitonic_merge_desc(int (&v)[N]) {
#pragma unroll
    for (int j = N >> 1; j > 0; j >>= 1)
#pragma unroll
        for (int i = 0; i < N; ++i) { const int l = i ^ j; if (l > i) CE_DESC(v[i], v[l]); }
}
__device__ __forceinline__ void merge16(const int (&a)[16], const int (&b)[16], int (&o)[16]) {
#pragma unroll
    for (int i = 0; i < 16; ++i) o[i] = max(a[i], b[15 - i]);
    bitonic_merge_desc<16>(o);
}
__device__ __forceinline__ void top16_of_64(const int (&v)[64], int (&o)[16]) {
    int g0[16], g1[16], g2[16], g3[16];
#pragma unroll
    for (int i = 0; i < 16; ++i) { g0[i] = v[i]; g1[i] = v[16 + i]; g2[i] = v[32 + i]; g3[i] = v[48 + i]; }
    sort_desc<16>(g0); sort_desc<16>(g1); sort_desc<16>(g2); sort_desc<16>(g3);
    int m0[16], m1[16]; merge16(g0, g1, m0); merge16(g2, g3, m1); merge16(m0, m1, o);
}
__device__ const unsigned char PEER_PAIR[64] = {0,1,2,3,4,5,6,7,8,9,10,11,12,13,14,15, 16,17,18,19,20,21,22,23, 32,33,34,35,36, 48,49,50,51, 64,65,66, 80,81, 96,97, 112,113, 128,144,160,176,192,208,224,240, 0,0,0,0,0,0,0,0,0,0,0,0,0,0};
__device__ __forceinline__ void peer_subkey_top16(const bf16* qrow  , const bf16* keys_hc  , int r32, int hi, int (&o)[16]) {
    bf16x8 bq[8];
    asm volatile("" : "+v"(qrow));
#pragma unroll
    for (int s = 0; s < 8; ++s) bq[s] = *(const bf16x8*)(qrow + 8 * s);
    int run[16];
#pragma unroll
    for (int mt = 0; mt < 4; ++mt) {
        const bf16* krow = keys_hc + (size_t)(32 * mt + r32) * PHALF + hi * 64;
        asm volatile("" : "+v"(krow));
        bf16x8 ka[8];
#pragma unroll
        for (int s = 0; s < 8; ++s) ka[s] = *(const bf16x8*)(krow + 8 * s);
#ifdef PEER_A_FENCE
        asm volatile("" ::: "memory");
#endif
        f32x16 acc = {};
#pragma unroll
        for (int s = 0; s < 8; ++s) acc = __builtin_amdgcn_mfma_f32_32x32x16_bf16(ka[s], bq[s], acc, 0, 0, 0);
        int g[16];
#pragma unroll
        for (int r = 0; r < 16; ++r) g[r] = (f2key(acc[r]) & ~127) | ((r & 3) + 8 * (r >> 2));
        sort_desc<16>(g);
        if (mt) {
#pragma unroll
            for (int r = 0; r < 16; ++r) g[r] |= 32 * mt; }
        if (mt == 0) {
#pragma unroll
            for (int r = 0; r < 16; ++r) run[r] = g[r];
        } else { int t2[16]; merge16(run, g, t2);
#pragma unroll
            for (int r = 0; r < 16; ++r) run[r] = t2[r]; }
    }
    int lo[16], hh[16]; const int hi4 = 4 * hi;
#pragma unroll
    for (int i = 0; i < 16; ++i) { run[i] |= hi4; auto rr = __builtin_amdgcn_permlane32_swap((unsigned)run[i], (unsigned)run[i], false, false); lo[i] = (int)rr[0]; hh[i] = (int)rr[1]; }
    merge16(lo, hh, o);
}
__device__ __forceinline__ float gelu_erf(float v) { return 0.5f * v * (1.f + erff(v * 0.70710678118654752f)); }

typedef float f32x2 __attribute__((ext_vector_type(2)));
constexpr int P7_W8 = 98304, P7_SW = 114688;
constexpr int P7_ACT = 0, P7_EID = 65536, P7_SCR = 0  , P7_SCR_WAVE = 32 * 33 * 4, PCH = 128, NCH = D / PCH;
static_assert(P7_SCR + NWAVES * P7_SCR_WAVE <= P7_EID && P7_EID + 128 * 128 * 2 <= RING_BYTES, "PEER LDS map");

__device__ __forceinline__ void p7_peer(Frame& F) {
    const int lane = F.lane(), r32 = lane & 31, hi = lane >> 5, j8 = lane & 7, g8 = lane >> 3;
    constexpr int TPB = 128;
    LAS float* ACT = (LAS float*)(F.lds + P7_ACT); LAS unsigned short* EIDL = (LAS unsigned short*)(F.lds + P7_EID);
    LAS int* scr = (LAS int*)(F.lds + P7_SCR + F.wave_() * P7_SCR_WAVE);
    for (int blk = F.vcu_(); blk < M / TPB; blk += F.G_()) {
        const int m0 = blk * TPB;
        { const int h = F.wave_(); const bf16* QP = F.ws<bf16>(WS_QP); const bf16* KEYS = F.ws<bf16>(WS_KEYS); float* GATE = F.ws<float>(WS_GATE);
          for (int tt = 0; tt < 4; ++tt) {
            const int tl = 32 * tt + r32, tok = m0 + tl;
            const bf16* qrow = QP + (size_t)tok * D + h * 256 + hi * 64;
            int s1[16], s2[16];
            peer_subkey_top16(qrow, KEYS + (size_t)(h * 2 + 0) * PNK * PHALF, r32, hi, s1);
            asm volatile("" ::: "memory");
            peer_subkey_top16(qrow + 128, KEYS + (size_t)(h * 2 + 1) * PNK * PHALF, r32, hi, s2);
            float f1[16], f2[16];
#pragma unroll
            for (int i = 0; i < 16; ++i) { f1[i] = key2f(s1[i]); f2[i] = key2f(s2[i]); }
            if (hi == 0) {
#pragma unroll
                for (int i = 0; i < 16; ++i) { scr[r32 * 33 + i] = s1[i] & 127; scr[r32 * 33 + 16 + i] = s2[i] & 127; } }
            int cand[64];
            {
#define PC(n_, i_, j_) cand[n_] = (f2key(f1[i_] + f2[j_]) & ~255) | (n_)
                PC(0,0,0); PC(1,0,1); PC(2,0,2); PC(3,0,3); PC(4,0,4); PC(5,0,5); PC(6,0,6); PC(7,0,7); PC(8,0,8); PC(9,0,9); PC(10,0,10); PC(11,0,11); PC(12,0,12); PC(13,0,13); PC(14,0,14); PC(15,0,15);
                PC(16,1,0); PC(17,1,1); PC(18,1,2); PC(19,1,3); PC(20,1,4); PC(21,1,5); PC(22,1,6); PC(23,1,7);
                PC(24,2,0); PC(25,2,1); PC(26,2,2); PC(27,2,3); PC(28,2,4);
                PC(29,3,0); PC(30,3,1); PC(31,3,2); PC(32,3,3);
                PC(33,4,0); PC(34,4,1); PC(35,4,2);
                PC(36,5,0); PC(37,5,1); PC(38,6,0); PC(39,6,1); PC(40,7,0); PC(41,7,1);
                PC(42,8,0); PC(43,9,0); PC(44,10,0); PC(45,11,0); PC(46,12,0); PC(47,13,0); PC(48,14,0); PC(49,15,0);
#undef PC
            }
#pragma unroll
            for (int i = 50; i < 64; ++i) cand[i] = (int)0x80000000;
            int sc[16]; top16_of_64(cand, sc);
            float p[16]; const float mx = key2f(sc[0]); float z = 0.f;
#pragma unroll
            for (int k = 0; k < 16; ++k) { p[k] = __expf(key2f(sc[k]) - mx); z += p[k]; }
            const float rz = 1.f / z;
            LDS_WAIT();
            int eo[8]; float go[8]; const int him = -hi;
#pragma unroll
            for (int kk = 0; kk < 8; ++kk) { const int tag = PEER_PAIR[((sc[kk] & ~him) | (sc[8 + kk] & him)) & 255];
                const int i1 = scr[r32 * 33 + (tag >> 4)], i2 = scr[r32 * 33 + 16 + (tag & 15)];
                eo[kk] = i1 * PNK + i2; go[kk] = __int_as_float((__float_as_int(p[kk]) & ~him) | (__float_as_int(p[8 + kk]) & him)) * rz; }
            *(LAS v4u*)(EIDL + tl * 128 + h * 16 + 8 * hi) = (v4u){(unsigned)(eo[0] | (eo[1] << 16)), (unsigned)(eo[2] | (eo[3] << 16)), (unsigned)(eo[4] | (eo[5] << 16)), (unsigned)(eo[6] | (eo[7] << 16))};
            GAS float* gp = (GAS float*)(GATE + (size_t)tok * 128 + h * 16 + 8 * hi);
            *(GAS f32x4*)gp = (f32x4){go[0], go[1], go[2], go[3]}; *(GAS f32x4*)(gp + 4) = (f32x4){go[4], go[5], go[6], go[7]};
            LDS_WAIT();
          } }
        __threadfence_block(); __syncthreads();
        const int tw = F.wave_() * (TPB / NWAVES);
        for (int i = lane; i < (TPB / NWAVES) * 128; i += 64) ACT[tw * 128 + i] = 0.f;
        { const unsigned char* X8 = F.ws<unsigned char>(WS_X8); const unsigned char* U8 = F.ws<unsigned char>(WS_U8);
#define U_ISSUE(n_, PC, XQ) do { const int c_ = (n_) >> 4, tl_ = tw + ((n_) & 15); \
            XQ = *(const GAS v4u*)(X8 + (size_t)(m0 + tl_) * D + c_ * PCH + 16 * j8); \
            const LAS unsigned short* ep_ = EIDL + tl_ * 128 + g8; const unsigned char* ub_ = U8 + (size_t)c_ * (NEXP * PCH) + 16 * j8; \
            _Pragma("unroll") for (int i = 0; i < 16; ++i) { const unsigned e_ = ep_[8 * i]; PC[i] = *(const GAS v4u*)(ub_ + e_ * PCH); } } while (0)
#define U_COMPUTE(n_, PC, XQ) do { const int tl_ = tw + ((n_) & 15); \
            int pp_[16]; \
            _Pragma("unroll") for (int i = 0; i < 16; ++i) { int a_ = __builtin_amdgcn_sdot4((int)PC[i].x, (int)XQ.x, 0, false); a_ = __builtin_amdgcn_sdot4((int)PC[i].y, (int)XQ.y, a_, false); \
                a_ = __builtin_amdgcn_sdot4((int)PC[i].z, (int)XQ.z, a_, false); pp_[i] = __builtin_amdgcn_sdot4((int)PC[i].w, (int)XQ.w, a_, false); } \
              \
            int q8_[8], q4_[4], q2_[2]; \
            { const bool b2_ = lane & 4; _Pragma("unroll") for (int i = 0; i < 8; ++i) { const int k_ = b2_ ? pp_[2 * i + 1] : pp_[2 * i], s_ = b2_ ? pp_[2 * i] : pp_[2 * i + 1]; q8_[i] = k_ + dppi<0x141>(s_); } } \
            { const bool b1_ = lane & 2; _Pragma("unroll") for (int i = 0; i < 4; ++i) { const int k_ = b1_ ? q8_[2 * i + 1] : q8_[2 * i], s_ = b1_ ? q8_[2 * i] : q8_[2 * i + 1]; q4_[i] = k_ + dppi<0x4E>(s_); } } \
            { const bool b0_ = lane & 1; _Pragma("unroll") for (int i = 0; i < 2; ++i) { const int k_ = b0_ ? q4_[2 * i + 1] : q4_[2 * i], s_ = b0_ ? q4_[2 * i] : q4_[2 * i + 1]; q2_[i] = k_ + dppi<0xB1>(s_); } } \
            const int irow_ = ((lane & 1) << 2) | (lane & 2) | ((lane >> 2) & 1); \
            LAS float* ap_ = ACT + tl_ * 128 + 8 * irow_ + g8; ap_[0] += (float)q2_[0]; ap_[64] += (float)q2_[1]; } while (0)
          constexpr int NSTEP = NCH * (TPB / NWAVES);
          v4u pcA[16], pcB[16], xqA, xqB;
          U_ISSUE(0, pcA, xqA);
          for (int n = 0; n < NSTEP; n += 2) {
              U_ISSUE(n + 1, pcB, xqB); __builtin_amdgcn_sched_barrier(0);
              U_COMPUTE(n, pcA, xqA); __builtin_amdgcn_sched_barrier(0);
              { const int nn = (n + 2 < NSTEP) ? n + 2 : n; U_ISSUE(nn, pcA, xqA); }
              __builtin_amdgcn_sched_barrier(0);
              U_COMPUTE(n + 1, pcB, xqB); __builtin_amdgcn_sched_barrier(0);
          }
#undef U_ISSUE
#undef U_COMPUTE
        }
        LDS_WAIT();
        { const float* SU = F.ws<float>(WS_SU); const float* SV = F.ws<float>(WS_SV); const float* GATE = F.ws<float>(WS_GATE); const float* SX = F.ws<float>(WS_SX);
        LAS unsigned char* W8L = (LAS unsigned char*)(F.lds + P7_W8); LAS float* SWL = (LAS float*)(F.lds + P7_SW);
        for (int ti = 0; ti < TPB / NWAVES; ++ti) {
            const int tl = tw + ti, t = m0 + tl; const float sx = SX[t]; float wv[2];
#pragma unroll
            for (int kq = 0; kq < 2; ++kq) { const int k = lane + 64 * kq; const unsigned e = EIDL[tl * 128 + k]; const float a = ACT[tl * 128 + k] * SU[e] * sx;
                wv[kq] = __builtin_nontemporal_load(GATE + (size_t)t * 128 + k) * gelu_erf(a) * SV[e]; }
            float am = fmaxf(fabsf(wv[0]), fabsf(wv[1]));
#pragma unroll
            for (int o = 1; o < 64; o <<= 1) am = fmaxf(am, __shfl_xor(am, o));
            const float sc = am > 0.f ? am * (1.f / 127.f) : 1.f, inv = 1.f / sc;
#pragma unroll
            for (int kq = 0; kq < 2; ++kq) { const int k = lane + 64 * kq; W8L[tl * 128 + (k & 7) * 16 + (k >> 3)] = (unsigned char)((int)rintf(wv[kq] * inv) & 255); }
            if (lane == 0) SWL[tl] = sc;
        } }
        LDS_WAIT();
        { const bf16* X1 = F.ws<bf16>(WS_Y1); const unsigned char* V8 = F.ws<unsigned char>(WS_V8); bf16* Y2 = F.ws<bf16>(WS_QP); const float* LNS = F.ws<float>(WS_LNS); const float* ln1_g = F.in(I_LN1G); const float* ln1_b = F.in(I_LN1B);
#define V_ISSUE(n_, PC, WQ, XP) do { const int c_ = (n_) >> 4, tl_ = tw + ((n_) & 15); \
            const LAS unsigned short* ep_ = EIDL + tl_ * 128 + g8; const unsigned char* vb_ = V8 + (size_t)c_ * (NEXP * PCH) + 16 * j8; \
            _Pragma("unroll") for (int i = 0; i < 16; ++i) { const unsigned e_ = ep_[8 * i]; PC[i] = *(const GAS v4u*)(vb_ + e_ * PCH); } \
            WQ = *(const LAS v4u*)(F.lds + P7_W8 + tl_ * 128 + g8 * 16); \
            XP = *(const GAS unsigned*)(X1 + (size_t)(m0 + tl_) * D + c_ * PCH + 16 * j8 + 2 * g8); } while (0)
#define V_COMPUTE(n_, PC, WQ, XP) do { const int c_ = (n_) >> 4, tl_ = tw + ((n_) & 15); \
            int ac_[16]; \
            _Pragma("unroll") for (int d = 0; d < 16; ++d) ac_[d] = 0; \
            const unsigned wq_[4] = {WQ.x, WQ.y, WQ.z, WQ.w}; \
            _Pragma("unroll") for (int gq = 0; gq < 4; ++gq) { \
                const unsigned pa_[4] = {PC[4 * gq].x, PC[4 * gq].y, PC[4 * gq].z, PC[4 * gq].w}, pb_[4] = {PC[4 * gq + 1].x, PC[4 * gq + 1].y, PC[4 * gq + 1].z, PC[4 * gq + 1].w}; \
                const unsigned pc_[4] = {PC[4 * gq + 2].x, PC[4 * gq + 2].y, PC[4 * gq + 2].z, PC[4 * gq + 2].w}, pd_[4] = {PC[4 * gq + 3].x, PC[4 * gq + 3].y, PC[4 * gq + 3].z, PC[4 * gq + 3].w}; \
                _Pragma("unroll") for (int m = 0; m < 4; ++m) { \
                    const unsigned t0_ = __builtin_amdgcn_perm(pb_[m], pa_[m], 0x05010400u), t1_ = __builtin_amdgcn_perm(pb_[m], pa_[m], 0x07030602u), t2_ = __builtin_amdgcn_perm(pd_[m], pc_[m], 0x05010400u), t3_ = __builtin_amdgcn_perm(pd_[m], pc_[m], 0x07030602u); \
                    ac_[4 * m + 0] = __builtin_amdgcn_sdot4((int)__builtin_amdgcn_perm(t2_, t0_, 0x05040100u), (int)wq_[gq], ac_[4 * m + 0], false); \
                    ac_[4 * m + 1] = __builtin_amdgcn_sdot4((int)__builtin_amdgcn_perm(t2_, t0_, 0x07060302u), (int)wq_[gq], ac_[4 * m + 1], false); \
                    ac_[4 * m + 2] = __builtin_amdgcn_sdot4((int)__builtin_amdgcn_perm(t3_, t1_, 0x05040100u), (int)wq_[gq], ac_[4 * m + 2], false); \
                    ac_[4 * m + 3] = __builtin_amdgcn_sdot4((int)__builtin_amdgcn_perm(t3_, t1_, 0x07060302u), (int)wq_[gq], ac_[4 * m + 3], false); } } \
              \
            int r8_[8], r4_[4], r2_[2]; \
            _Pragma("unroll") for (int i = 0; i < 8; ++i) { auto rr_ = __builtin_amdgcn_permlane32_swap((unsigned)ac_[i], (unsigned)ac_[i + 8], false, false); r8_[i] = (int)rr_[0] + (int)rr_[1]; } \
            _Pragma("unroll") for (int i = 0; i < 4; ++i) { auto rr_ = __builtin_amdgcn_permlane16_swap((unsigned)r8_[i], (unsigned)r8_[i + 4], false, false); r4_[i] = (int)rr_[0] + (int)rr_[1]; } \
            { const bool b3_ = lane & 8; _Pragma("unroll") for (int i = 0; i < 2; ++i) { const int k_ = b3_ ? r4_[i + 2] : r4_[i], s_ = b3_ ? r4_[i] : r4_[i + 2]; r2_[i] = k_ + dppi<0x128>(s_); } } \
            const float sw_ = ((const LAS float*)(F.lds + P7_SW))[tl_]; \
            const f32x2 ms_ = *(const f32x2*)(LNS + 2 * (size_t)(m0 + tl_)), gg_ = *(const f32x2*)(ln1_g + c_ * PCH + 16 * j8 + 2 * g8), bb_ = *(const f32x2*)(ln1_b + c_ * PCH + 16 * j8 + 2 * g8); \
            const float x0_ = (bflo(XP) - ms_.x) * ms_.y * gg_.x + bb_.x, x1_ = (bfhi(XP) - ms_.x) * ms_.y * gg_.y + bb_.y; \
            *(GAS unsigned*)(Y2 + (size_t)(m0 + tl_) * D + c_ * PCH + 16 * j8 + 2 * g8) = pk2((float)r2_[0] * sw_ + DN_ALPHA * x0_, (float)r2_[1] * sw_ + DN_ALPHA * x1_); } while (0)
          constexpr int NSTEP = NCH * (TPB / NWAVES);
          v4u pcA[16], pcB[16], wqA, wqB; unsigned xpA, xpB;
          V_ISSUE(0, pcA, wqA, xpA);
          for (int n = 0; n < NSTEP; n += 2) {
              V_ISSUE(n + 1, pcB, wqB, xpB); __builtin_amdgcn_sched_barrier(0);
              V_COMPUTE(n, pcA, wqA, xpA); __builtin_amdgcn_sched_barrier(0);
              { const int nn = (n + 2 < NSTEP) ? n + 2 : n; V_ISSUE(nn, pcA, wqA, xpA); }
              __builtin_amdgcn_sched_barrier(0);
              V_COMPUTE(n + 1, pcB, wqB, xpB); __builtin_amdgcn_sched_barrier(0);
          }
#undef V_ISSUE
#undef V_COMPUTE
        }
        { const float* ln2_g = F.in(I_LN2G); const float* ln2_b = F.in(I_LN2B); float* outp = F.outp(); const bf16* Y2 = F.ws<bf16>(WS_QP);
        for (int ti = 0; ti < TPB / NWAVES; ++ti) {
            const int t = m0 + tw + ti;
            const GAS v4u* yp = (const GAS v4u*)(Y2 + (size_t)t * D) + lane;
            float v[32]; float s = 0.f;
#pragma unroll
            for (int j = 0; j < 4; ++j) { const v4u w = yp[64 * j]; const unsigned ww[4] = {w.x, w.y, w.z, w.w};
#pragma unroll
                for (int i = 0; i < 4; ++i) { v[8 * j + 2 * i] = bflo(ww[i]); v[8 * j + 2 * i + 1] = bfhi(ww[i]); s += v[8 * j + 2 * i] + v[8 * j + 2 * i + 1]; } }
            const float mean = wave_sum(s) * (1.f / D); float qv = 0.f;
#pragma unroll
            for (int i = 0; i < 32; ++i) { v[i] -= mean; qv += v[i] * v[i]; }
            const float rstd = 1.f / sqrtf(wave_sum(qv) * (1.f / D) + LN_EPS);
#pragma unroll
            for (int j = 0; j < 4; ++j) { const int c0 = 8 * lane + 512 * j; const f32x4 g0 = *(const f32x4*)(ln2_g + c0), g1 = *(const f32x4*)(ln2_g + c0 + 4), b0 = *(const f32x4*)(ln2_b + c0), b1 = *(const f32x4*)(ln2_b + c0 + 4);
                f32x4 r0, r1;
#pragma unroll
                for (int i = 0; i < 4; ++i) { r0[i] = v[8 * j + i] * rstd * g0[i] + b0[i]; r1[i] = v[8 * j + 4 + i] * rstd * g1[i] + b1[i]; }
                GAS f32x4* op = (GAS f32x4*)(outp + (size_t)t * D + c0); op[0] = r0; op[1] = r1; }
        } }
        __syncthreads();
    }
}

struct Args { const float* in[22]; float* out; unsigned char* ws; int ph_lo, ph_hi; };
__global__ void __launch_bounds__(NWAVES * 64, 2) mk_fwd(Args args) {
    extern __shared__ __attribute__((aligned(16))) unsigned char lds[];
    cg::grid_group grid = cg::this_grid();
    Frame F;
    F.lds = (LAS unsigned char*)lds;
    if (threadIdx.x == 0) { LAS unsigned long long* PT = (LAS unsigned long long*)(F.lds + RING_BYTES);
#pragma unroll
        for (int k = 0; k < 22; ++k) PT[k] = (unsigned long long)args.in[k];
        PT[22] = (unsigned long long)args.out; PT[23] = (unsigned long long)args.ws;
        ((LAS unsigned*)(F.lds + RING_BYTES + 256))[0] = 0u; ((LAS unsigned*)(F.lds + RING_BYTES + 256))[1] = 0u; }
    __syncthreads();
    const int lo = args.ph_lo, hi = args.ph_hi;
#ifndef PHASE_MASK
#define PHASE_MASK 255
#endif
#define IN(k) (((PHASE_MASK >> (k)) & 1) && lo <= (k) && (k) < hi)
#ifndef REPEAT_PHASE
#define REPEAT_PHASE -1
#endif
#define REP(k) for (int rep_ = 0; rep_ < ((REPEAT_PHASE == (k)) ? 2 : 1); ++rep_)
    (void)xcd_barrier_post((unsigned*)args.ws, (volatile LAS unsigned*)(F.lds + RING_BYTES + 256));
#define XBAR() do { XcdBarrier bar_; bar_.bar = F.ws<unsigned>(0); bar_.x = xb_xcc_id(); bar_.st = (volatile LAS unsigned*)(F.lds + RING_BYTES + 256); xcd_barrier(bar_); } while (0)
#define SEAM(k) do { if (IN(k) && IN((k) + 1)) XBAR(); } while (0)

    if (lo < 0) grid.sync();
    if (IN(0)) REP(0) { p0a_prologue(F); XBAR(); p0b_prologue(F); } SEAM(0);
    if (IN(1)) REP(1) {
        pg8::Gemm g{F.ws<bf16>(WS_XB), F.ws<bf16>(WS_WIN), M, NPROJ, D / 2}; pg8::StaticOrder S; S.init(M, NPROJ, F.G_(), (int)blockIdx.x);
        pg8::EpiProjI8 E{F.ws<bf16>(WS_Q), (size_t)(WS_K - WS_Q) / 2, attn_body::C2, F.ws<bf16>(WS_H), F.in(I_BGLU), F.ws<float>(WS_SXA), F.ws<float>(WS_SWIN)};
        pg8::gemm_phase<pg8::EpiProjI8, pg8::StaticOrder, PG8_ALIGN, PG8_SP2>(F.lds, g, S, E);
    } SEAM(1);
    if (IN(2)) REP(2) {
        static_assert(attn_body::ATTN_LDS_BYTES <= RING_BYTES && attn_body::ATTN_PITCH == DATT, "attention body geometry vs frame");
        const attn_body::AttnTensors AT{F.ws<const attn_body::bf16>(WS_Q), F.ws<const attn_body::bf16>(WS_K), F.ws<const attn_body::bf16>(WS_V), F.ws<attn_body::bf16>(WS_O1), F.ws<attn_body::bf16>(WS_O2), F.ws<const float>(WS_TAB)};
        const attn_body::StaticOrder S((int)F.G_(), (int)blockIdx.x);
        attn_body::attn_phase<attn_body::StaticOrder>((char*)lds, AT, S);
    } SEAM(2);
    if (IN(3)) REP(3) { p3_mix(F); } SEAM(3);
    if (IN(4)) REP(4) {
        pg8::Gemm g{F.ws<bf16>(WS_XB), F.ws<bf16>(WS_WOUT), M, D, D / 2}; pg8::StaticOrder S; S.init(M, D, F.G_(), (int)blockIdx.x);
        pg8::EpiResI8 E{F.in(I_X), F.ws<bf16>(WS_Y1), D, DN_ALPHA, F.ws<float>(WS_SM), F.ws<float>(WS_SWOUT)};
        pg8::gemm_phase<pg8::EpiResI8, pg8::StaticOrder, PG8_ALIGN, PG8_SP2>(F.lds, g, S, E);
    } SEAM(4);
    if (IN(5)) REP(5) { p5_ln1(F); } SEAM(5);
    if (IN(6)) REP(6) {
        pg8::Gemm g{F.ws<bf16>(WS_X8), F.ws<bf16>(WS_WQ), M, D, D / 2}; pg8::StaticOrder S; S.init(M, D, F.G_(), (int)blockIdx.x);
        pg8::EpiPlainI8 E{F.ws<bf16>(WS_QP), D, F.ws<float>(WS_SX), F.ws<float>(WS_SWQ)};
        pg8::gemm_phase<pg8::EpiPlainI8, pg8::StaticOrder, PG8_ALIGN, PG8_SP2>(F.lds, g, S, E);
    } SEAM(6);
    if (IN(7)) REP(7) { p7_peer(F); }
#undef IN
#undef SEAM
}

extern "C" void kernel_launch(void* const* d_in, const int* in_sizes, int n_in, void* d_out, int out_size, void* d_ws, size_t ws_size, hipStream_t stream) {
    static int grid = 0;
    if (grid == 0) {
        if (n_in != 22 || in_sizes[0] != M * D || out_size != M * D || ws_size < WS_END) { fprintf(stderr, "kernel_launch: unexpected shapes (n_in %d, in0 %d, out %d, ws %zu); nothing launched\n", n_in, n_in > 0 ? in_sizes[0] : -1, out_size, ws_size); grid = -1; return; }
        int dev = 0, cus = 0, per_cu = 0;
        if (hipGetDevice(&dev) != hipSuccess || hipDeviceGetAttribute(&cus, hipDeviceAttributeMultiprocessorCount, dev) != hipSuccess) { grid = -1; return; }
        if (hipFuncSetAttribute((const void*)mk_fwd, hipFuncAttributeMaxDynamicSharedMemorySize, LDS_BYTES) != hipSuccess) { fprintf(stderr, "kernel_launch: hipFuncSetAttribute failed\n"); grid = -1; return; }
        if (hipOccupancyMaxActiveBlocksPerMultiprocessor(&per_cu, (const void*)mk_fwd, NWAVES * 64, LDS_BYTES) != hipSuccess || per_cu < 1) { fprintf(stderr, "kernel_launch: occupancy query reports %d workgroups per CU\n", per_cu); (void)hipGetLastError(); grid = -1; return; }
        grid = cus;
        if (grid > 256) grid = 256;
    }
    if (grid < 0) return;
    if (hipMemsetAsync(d_ws, 0, 65536, stream) != hipSuccess) { fprintf(stderr, "kernel_launch: hipMemsetAsync failed\n"); return; }
    Args a{};
    for (int i = 0; i < 22; ++i) a.in[i] = (const float*)d_in[i];
    a.out = (float*)d_out; a.ws = (unsigned char*)d_ws;
    constexpr int NL = MK_N_LAUNCHES;
    for (int li = 0; li < NL; ++li) {
        a.ph_lo = (NL == 1) ? 0 : li; a.ph_hi = (NL == 1) ? N_PHASES : li + 1;
        void* kargs[] = {&a};
        const hipError_t le = hipLaunchCooperativeKernel((const void*)mk_fwd, dim3(grid), dim3(NWAVES * 64), kargs, LDS_BYTES, stream);
        if (le != hipSuccess) { fprintf(stderr, "kernel_launch: cooperative launch %d failed: %s (grid %d)\n", li, hipGetErrorString(le), grid); break; }
    }
}
```

```cpp
#include <hip/hip_runtime.h>
#include <hip/hip_cooperative_groups.h>
#include <cstdio>
#include <cstdint>
namespace cg = cooperative_groups;
namespace pg8 {
#define PG8_LAS __attribute__((address_space(3)))
typedef unsigned short bf16_t;
typedef short bf16x8 __attribute__((ext_vector_type(8)));
typedef float f32x4 __attribute__((ext_vector_type(4)));
typedef unsigned u32x4 __attribute__((ext_vector_type(4)));
typedef int i32x4 __attribute__((ext_vector_type(4)));
constexpr int BM = 256, BK = 64, HALF = 128, HTB = HALF * BK * 2  , STAGE_BYTES = 8 * HTB, NXCD = 8, WGM = 8;

__host__ __device__ __forceinline__ int lds_byte(int r, int c) { const int st = (r >> 4) * 2 + (c >> 5), rr = r & 15, cc = c & 31, ob = rr * 64 + cc * 2; return st * 1024 + (ob ^ (((ob >> 9) & 1) << 5)); }
__host__ __device__ __forceinline__ void stage_rc(int b, int& R, int& C) { const int st = b / 1024, sb = b % 1024, swz = sb ^ (((sb >> 9) & 1) << 5); R = (st >> 1) * 16 + swz / 64; C = (st & 1) * 32 + (swz % 64) / 2; }
__host__ __device__ __forceinline__ int perm32(int rho) { const int n = rho >> 4, i = rho & 15; return 8 * (i >> 2) + 4 * n + (i & 3); }

struct Unit { int pm, pn; };
struct Gemm { const bf16_t* A; const bf16_t* Bt; int M, N, K; };

struct StaticOrder {
    int nM, nN, nwg, G, c;
    __host__ __device__ void init(int M, int N, int G_, int c_) { nM = M / BM; nN = N / BM; nwg = nM * nN; G = G_; c = c_; }
    __host__ __device__ bool next(int i, Unit& u) const {
        const long L = (long)i * G + c; if (L >= nwg) return false;
        int wgid = (int)L; { const int q = nwg / NXCD, r = nwg % NXCD, xcd = wgid % NXCD, off = wgid / NXCD; wgid = (xcd < r ? xcd * (q + 1) : r * (q + 1) + (xcd - r) * q) + off; }
        const int nig = WGM * nN, gid = wgid / nig, fm = gid * WGM, gsz = (nM - fm) < WGM ? (nM - fm) : WGM;
        u.pm = fm + ((wgid % nig) % gsz); u.pn = (wgid % nig) / gsz; return true;
    }
    __device__ __forceinline__ void a_ready(const Unit&) const {}
    __device__ __forceinline__ void done(const Unit&) const {}
};

__device__ __forceinline__ unsigned cvt_pk_bf16(float lo, float hi) { unsigned r; asm volatile("v_cvt_pk_bf16_f32 %0, %1, %2" : "=v"(r) : "v"(lo), "v"(hi)); return r; }
typedef float f32x2 __attribute__((ext_vector_type(2)));
typedef float f32x2 __attribute__((ext_vector_type(2)));
__device__ __forceinline__ u32x4 pack8(f32x4 v0, f32x4 v1) { u32x4 w; w.x = cvt_pk_bf16(v0[0], v0[1]); w.y = cvt_pk_bf16(v0[2], v0[3]); w.z = cvt_pk_bf16(v1[0], v1[1]); w.w = cvt_pk_bf16(v1[2], v1[3]); return w; }
__device__ __forceinline__ f32x4 i2f(f32x4 a) { const i32x4 v = __builtin_bit_cast(i32x4, a); return (f32x4){(float)v[0], (float)v[1], (float)v[2], (float)v[3]}; }
struct EpiProj {
    static constexpr bool PERM = true, AFTER_DRAIN = false, INT8 = false;
    bf16_t* QKV; size_t split_stride; float scale0; bf16_t* H; const float* bglu;
    __device__ __forceinline__ void operator()(const f32x4 (&acc)[2][2][4][2], const Unit& u, int wr, int wc, int fr, int fq) const {
        const int row0 = u.pm * BM + wr * 64 + fr;
        if (u.pn < 12) {
            const int t = u.pn >> 2; bf16_t* base = QKV + (size_t)t * split_stride; const float sc = (t == 0) ? scale0 : 1.f;
            const int col0 = (u.pn & 3) * BM + wc * 32 + 8 * fq;
#pragma unroll
            for (int ai = 0; ai < 2; ++ai)
#pragma unroll
                for (int m = 0; m < 4; ++m) { bf16_t* rowp = base + (size_t)(row0 + ai * HALF + m * 16) * 1024 + col0;
#pragma unroll
                    for (int bj = 0; bj < 2; ++bj) *(u32x4*)(rowp + bj * HALF) = pack8(acc[ai][bj][m][0] * sc, acc[ai][bj][m][1] * sc); }
        } else {
            const int ch0 = (u.pn - 12) * HALF + wc * 32 + 8 * fq;
            const f32x4 ba0 = *(const f32x4*)(bglu + ch0), ba1 = *(const f32x4*)(bglu + ch0 + 4), bg0 = *(const f32x4*)(bglu + 1024 + ch0), bg1 = *(const f32x4*)(bglu + 1024 + ch0 + 4);
#pragma unroll
            for (int ai = 0; ai < 2; ++ai)
#pragma unroll
                for (int m = 0; m < 4; ++m) {
                    const f32x4 a0 = acc[ai][0][m][0] + ba0, a1 = acc[ai][0][m][1] + ba1, g0 = acc[ai][1][m][0] + bg0, g1 = acc[ai][1][m][1] + bg1;
                    f32x4 h0, h1;
#pragma unroll
                    for (int e = 0; e < 4; ++e) { h0[e] = a0[e] * __builtin_amdgcn_rcpf(1.f + __builtin_amdgcn_exp2f(-1.4426950409f * g0[e])); h1[e] = a1[e] * __builtin_amdgcn_rcpf(1.f + __builtin_amdgcn_exp2f(-1.4426950409f * g1[e])); }
                    *(u32x4*)(H + (size_t)(row0 + ai * HALF + m * 16) * 1024 + ch0) = pack8(h0, h1); }
        }
    }
};
struct EpiProjI8 {
    static constexpr bool PERM = true, AFTER_DRAIN = false, INT8 = true;
    bf16_t* QKV; size_t split_stride; float scale0; bf16_t* H; const float* bglu; const float* sa; const float* sb;
    __device__ __forceinline__ void operator()(const f32x4 (&acc)[2][2][4][2], const Unit& u, int wr, int wc, int fr, int fq) const {
        const int row0 = u.pm * BM + wr * 64 + fr, cb = u.pn * BM + wc * 32 + 8 * fq;
        f32x4 cs[2][2];
#pragma unroll
        for (int bj = 0; bj < 2; ++bj) { cs[bj][0] = *(const f32x4*)(sb + cb + bj * HALF); cs[bj][1] = *(const f32x4*)(sb + cb + bj * HALF + 4); }
        if (u.pn < 12) {
            const int t = u.pn >> 2; bf16_t* base = QKV + (size_t)t * split_stride; const float sc = (t == 0) ? scale0 : 1.f;
            const int col0 = (u.pn & 3) * BM + wc * 32 + 8 * fq;
#pragma unroll
            for (int ai = 0; ai < 2; ++ai)
#pragma unroll
                for (int m = 0; m < 4; ++m) { const int row = row0 + ai * HALF + m * 16; const float rs = sa[row] * sc; bf16_t* rowp = base + (size_t)row * 1024 + col0;
#pragma unroll
                    for (int bj = 0; bj < 2; ++bj) *(u32x4*)(rowp + bj * HALF) = pack8(i2f(acc[ai][bj][m][0]) * cs[bj][0] * rs, i2f(acc[ai][bj][m][1]) * cs[bj][1] * rs); }
        } else {
            const int ch0 = (u.pn - 12) * HALF + wc * 32 + 8 * fq;
            const f32x4 ba0 = *(const f32x4*)(bglu + ch0), ba1 = *(const f32x4*)(bglu + ch0 + 4), bg0 = *(const f32x4*)(bglu + 1024 + ch0), bg1 = *(const f32x4*)(bglu + 1024 + ch0 + 4);
#pragma unroll
            for (int ai = 0; ai < 2; ++ai)
#pragma unroll
                for (int m = 0; m < 4; ++m) { const int row = row0 + ai * HALF + m * 16; const float rs = sa[row];
                    const f32x4 a0 = i2f(acc[ai][0][m][0]) * cs[0][0] * rs + ba0, a1 = i2f(acc[ai][0][m][1]) * cs[0][1] * rs + ba1, g0 = i2f(acc[ai][1][m][0]) * cs[1][0] * rs + bg0, g1 = i2f(acc[ai][1][m][1]) * cs[1][1] * rs + bg1;
                    f32x4 h0, h1;
#pragma unroll
                    for (int e = 0; e < 4; ++e) { h0[e] = a0[e] * __builtin_amdgcn_rcpf(1.f + __builtin_amdgcn_exp2f(-1.4426950409f * g0[e])); h1[e] = a1[e] * __builtin_amdgcn_rcpf(1.f + __builtin_amdgcn_exp2f(-1.4426950409f * g1[e])); }
                    *(u32x4*)(H + (size_t)row * 1024 + ch0) = pack8(h0, h1); }
        }
    }
};
struct EpiRes {
    static constexpr bool PERM = true, AFTER_DRAIN = false, INT8 = false;
    const float* X; bf16_t* Y; int ldc; float alpha;
    __device__ __forceinline__ void operator()(const f32x4 (&acc)[2][2][4][2], const Unit& u, int wr, int wc, int fr, int fq) const {
        const int row0 = u.pm * BM + wr * 64 + fr, col0 = u.pn * BM + wc * 32 + 8 * fq;
#pragma unroll
        for (int ai = 0; ai < 2; ++ai)
#pragma unroll
            for (int m = 0; m < 4; ++m) { const size_t off = (size_t)(row0 + ai * HALF + m * 16) * ldc + col0;
#pragma unroll
                for (int bj = 0; bj < 2; ++bj) { const f32x4 x0 = *(const f32x4*)(X + off + bj * HALF), x1 = *(const f32x4*)(X + off + bj * HALF + 4);
                    *(u32x4*)(Y + off + bj * HALF) = pack8(acc[ai][bj][m][0] + x0 * alpha, acc[ai][bj][m][1] + x1 * alpha); } }
    }
};
struct EpiPlainI8 {
    static constexpr bool PERM = true, AFTER_DRAIN = false, INT8 = true;
    bf16_t* O; int ldc; const float* sa; const float* sb;
    __device__ __forceinline__ void operator()(const f32x4 (&acc)[2][2][4][2], const Unit& u, int wr, int wc, int fr, int fq) const {
        const int row0 = u.pm * BM + wr * 64 + fr, col0 = u.pn * BM + wc * 32 + 8 * fq;
        f32x4 cs[2][2];
#pragma unroll
        for (int bj = 0; bj < 2; ++bj) { cs[bj][0] = *(const f32x4*)(sb + col0 + bj * HALF); cs[bj][1] = *(const f32x4*)(sb + col0 + bj * HALF + 4); }
#pragma unroll
        for (int ai = 0; ai < 2; ++ai)
#pragma unroll
            for (int m = 0; m < 4; ++m) { const int row = row0 + ai * HALF + m * 16; const float rs = sa[row]; bf16_t* rowp = O + (size_t)row * ldc + col0;
#pragma unroll
                for (int bj = 0; bj < 2; ++bj) *(u32x4*)(rowp + bj * HALF) = pack8(i2f(acc[ai][bj][m][0]) * cs[bj][0] * rs, i2f(acc[ai][bj][m][1]) * cs[bj][1] * rs); }
    }
};
struct EpiResI8 {
    static constexpr bool PERM = true, AFTER_DRAIN = false, INT8 = true;
    const float* X; bf16_t* Y; int ldc; float alpha; const float* sa; const float* sb;
    __device__ __forceinline__ void operator()(const f32x4 (&acc)[2][2][4][2], const Unit& u, int wr, int wc, int fr, int fq) const {
        const int row0 = u.pm * BM + wr * 64 + fr, col0 = u.pn * BM + wc * 32 + 8 * fq;
        f32x4 cs[2][2];
#pragma unroll
        for (int bj = 0; bj < 2; ++bj) { cs[bj][0] = *(const f32x4*)(sb + col0 + bj * HALF); cs[bj][1] = *(const f32x4*)(sb + col0 + bj * HALF + 4); }
#pragma unroll
        for (int ai = 0; ai < 2; ++ai)
#pragma unroll
            for (int m = 0; m < 4; ++m) { const int row = row0 + ai * HALF + m * 16; const float rs = sa[row]; const size_t off = (size_t)row * ldc + col0;
#pragma unroll
                for (int bj = 0; bj < 2; ++bj) { const f32x4 x0 = *(const f32x4*)(X + off + bj * HALF), x1 = *(const f32x4*)(X + off + bj * HALF + 4);
                    *(u32x4*)(Y + off + bj * HALF) = pack8(i2f(acc[ai][bj][m][0]) * cs[bj][0] * rs + x0 * alpha, i2f(acc[ai][bj][m][1]) * cs[bj][1] * rs + x1 * alpha); } }
    }
};
struct EpiPlain {
    static constexpr bool PERM = true, AFTER_DRAIN = false, INT8 = false;
    bf16_t* O; int ldc;
    __device__ __forceinline__ void operator()(const f32x4 (&acc)[2][2][4][2], const Unit& u, int wr, int wc, int fr, int fq) const {
        const int row0 = u.pm * BM + wr * 64 + fr, col0 = u.pn * BM + wc * 32 + 8 * fq;
#pragma unroll
        for (int ai = 0; ai < 2; ++ai)
#pragma unroll
            for (int m = 0; m < 4; ++m) { bf16_t* rowp = O + (size_t)(row0 + ai * HALF + m * 16) * ldc + col0;
#pragma unroll
                for (int bj = 0; bj < 2; ++bj) *(u32x4*)(rowp + bj * HALF) = pack8(acc[ai][bj][m][0], acc[ai][bj][m][1]); }
    }
};

template <class Epi, class Sched, bool ALIGN_EPI = false, bool SP2 = false>
__device__ __forceinline__ void gemm_phase(PG8_LAS unsigned char* lds, const Gemm g, const Sched& S, const Epi& E) {
    const int tid = threadIdx.x, wid = __builtin_amdgcn_readfirstlane(tid >> 6), lane = tid & 63, wr = wid >> 2, wc = wid & 3, fr = lane & 15, fq = lane >> 4;
    const int K = g.K, nt = K / BK;
    unsigned voffA[2], voffB[2];
#pragma unroll
    for (int i = 0; i < 2; ++i) { int R, C; stage_rc(tid * 16 + i * 8192, R, C); const int Rb = Epi::PERM ? ((R & ~31) + perm32(R & 31)) : R;
        voffA[i] = (unsigned)(R * K + C) * 2u; voffB[i] = (unsigned)(Rb * K + C) * 2u; }
    const size_t kstep = (size_t)(BK * 2);
    const size_t hstep = (size_t)HALF * K * 2;
    const size_t tstep = 2 * hstep;
    const unsigned ldsw = (unsigned)wid * 1024u;
    const int aoff = lds_byte(wr * 64 + fr, fq * 8), boff = lds_byte(wc * 32 + fr, fq * 8);
#define PG8_SA(b, h) (((b) * 2 + (h)) * HTB)
#define PG8_SB(b, h) ((4 + (b) * 2 + (h)) * HTB)
#define PG8_STAGE(bufoff, gbase, voff) do { _Pragma("unroll") for (int _i = 0; _i < 2; ++_i) \
        __builtin_amdgcn_global_load_lds((const unsigned*)((const char*)(gbase) + (voff)[_i]), (PG8_LAS unsigned*)(lds + (bufoff) + ldsw + _i * 8192), 16, 0, 0); } while (0)
#define PG8_LDA(dst, b, h) do { _Pragma("unroll") for (int m = 0; m < 4; ++m) _Pragma("unroll") for (int k = 0; k < 2; ++k) dst[m][k] = *(const PG8_LAS bf16x8*)(lds + PG8_SA(b, h) + aoff + m * 2048 + k * 1024); } while (0)
#define PG8_LDB(dst, b, h) do { _Pragma("unroll") for (int n = 0; n < 2; ++n) _Pragma("unroll") for (int k = 0; k < 2; ++k) dst[n][k] = *(const PG8_LAS bf16x8*)(lds + PG8_SB(b, h) + boff + n * 2048 + k * 1024); } while (0)
#define PG8_MMA(ai, bj, At, Bt) do { __builtin_amdgcn_s_setprio(1); _Pragma("unroll") for (int m = 0; m < 4; ++m) _Pragma("unroll") for (int n = 0; n < 2; ++n) _Pragma("unroll") for (int k = 0; k < 2; ++k) { \
        if constexpr (Epi::INT8) acc[ai][bj][m][n] = __builtin_bit_cast(f32x4, __builtin_amdgcn_mfma_i32_16x16x64_i8(__builtin_bit_cast(i32x4, Bt[n][k]), __builtin_bit_cast(i32x4, At[m][k]), __builtin_bit_cast(i32x4, acc[ai][bj][m][n]), 0, 0, 0)); \
        else acc[ai][bj][m][n] = __builtin_amdgcn_mfma_f32_16x16x32_bf16(Bt[n][k], At[m][k], acc[ai][bj][m][n], 0, 0, 0); } __builtin_amdgcn_s_setprio(0); } while (0)
#define PG8_WAIT_V(n) asm volatile("s_waitcnt vmcnt(" #n ")" ::: "memory")
#define PG8_WAIT_L(n) asm volatile("s_waitcnt lgkmcnt(" #n ")" ::: "memory")
#define PG8_BAR __builtin_amdgcn_s_barrier()
#define PG8_SCHED __builtin_amdgcn_sched_barrier(0)
    Unit cur, nxt; int ui = 0;
    if (!S.next(0, cur)) return;
    f32x4 acc[2][2][4][2];
#pragma unroll
    for (int a = 0; a < 2; ++a)
#pragma unroll
        for (int b = 0; b < 2; ++b)
#pragma unroll
            for (int m = 0; m < 4; ++m)
#pragma unroll
                for (int n = 0; n < 2; ++n) acc[a][b][m][n] = (f32x4){0.f, 0.f, 0.f, 0.f};
    bf16x8 At[4][2], B0[2][2], B1[2][2];
    const char* cA = (const char*)g.A + (size_t)cur.pm * tstep; const char* cB = (const char*)g.Bt + (size_t)cur.pn * tstep;
    S.a_ready(cur);
    if constexpr (SP2) {
        PG8_STAGE(PG8_SB(0, 0), cB, voffB); PG8_STAGE(PG8_SB(0, 1), cB + hstep, voffB); PG8_STAGE(PG8_SA(0, 0), cA, voffA); PG8_STAGE(PG8_SA(0, 1), cA + hstep, voffA);
        if (wr == 1) PG8_BAR;
        PG8_WAIT_V(2); PG8_BAR;
        PG8_STAGE(PG8_SB(1, 0), cB + kstep, voffB); PG8_STAGE(PG8_SA(1, 0), cA + kstep, voffA); PG8_STAGE(PG8_SB(1, 1), cB + hstep + kstep, voffB);
        PG8_WAIT_V(6); PG8_BAR;
    } else {
        PG8_STAGE(PG8_SB(0, 0), cB, voffB); PG8_STAGE(PG8_SA(0, 0), cA, voffA); PG8_STAGE(PG8_SB(0, 1), cB + hstep, voffB); PG8_STAGE(PG8_SA(0, 1), cA + hstep, voffA);
        if (wr == 1) PG8_BAR;
        PG8_WAIT_V(4); PG8_BAR;
        PG8_STAGE(PG8_SB(1, 0), cB + kstep, voffB); PG8_STAGE(PG8_SA(1, 0), cA + kstep, voffA); PG8_STAGE(PG8_SB(1, 1), cB + hstep + kstep, voffB);
        PG8_WAIT_V(6); PG8_BAR;
    }
    for (;;) {
        const bool has_next = S.next(ui + 1, nxt);
        const char* nA = has_next ? (const char*)g.A + (size_t)nxt.pm * tstep : cA; const char* nB = has_next ? (const char*)g.Bt + (size_t)nxt.pn * tstep : cB;
        for (int t = 0; t < nt; t += 2) {
            const bool last = (t == nt - 2);
            const char* a1 = cA + (size_t)(t + 1) * kstep;
            const char* a2 = last ? nA : cA + (size_t)(t + 2) * kstep; const char* b2 = last ? nB : cB + (size_t)(t + 2) * kstep;
            const char* a3 = a2 + kstep; const char* b3 = b2 + kstep;
            if (last && has_next) S.a_ready(nxt);
            if constexpr (SP2) {
            PG8_LDB(B0, 0, 0); PG8_LDB(B1, 0, 1); PG8_SCHED; PG8_LDA(At, 0, 0); PG8_STAGE(PG8_SA(1, 1), a1 + hstep, voffA);
            PG8_WAIT_V(8); PG8_WAIT_L(0); PG8_BAR; PG8_MMA(0, 0, At, B0); PG8_MMA(0, 1, At, B1); PG8_BAR; PG8_SCHED;
            PG8_LDA(At, 0, 1); PG8_STAGE(PG8_SB(0, 0), b2, voffB); PG8_STAGE(PG8_SB(0, 1), b2 + hstep, voffB); PG8_STAGE(PG8_SA(0, 0), a2, voffA);
            PG8_WAIT_V(8); PG8_WAIT_L(0); PG8_BAR; PG8_MMA(1, 0, At, B0); PG8_MMA(1, 1, At, B1); PG8_BAR; PG8_SCHED;
            PG8_LDB(B0, 1, 0); PG8_LDB(B1, 1, 1); PG8_SCHED; PG8_LDA(At, 1, 0); PG8_STAGE(PG8_SA(0, 1), a2 + hstep, voffA);
            PG8_WAIT_V(8); PG8_WAIT_L(0); PG8_BAR; PG8_MMA(0, 0, At, B0); PG8_MMA(0, 1, At, B1); PG8_BAR; PG8_SCHED;
            PG8_LDA(At, 1, 1); PG8_STAGE(PG8_SB(1, 0), b3, voffB); PG8_STAGE(PG8_SB(1, 1), b3 + hstep, voffB); PG8_STAGE(PG8_SA(1, 0), a3, voffA);
            PG8_WAIT_V(8); PG8_WAIT_L(0); PG8_BAR; PG8_MMA(1, 0, At, B0); PG8_MMA(1, 1, At, B1); PG8_BAR; PG8_SCHED;
            } else {
            PG8_LDB(B0, 0, 0); PG8_SCHED; PG8_LDA(At, 0, 0); PG8_STAGE(PG8_SA(1, 1), a1 + hstep, voffA);
            PG8_WAIT_L(8); PG8_BAR; PG8_WAIT_L(0); PG8_MMA(0, 0, At, B0); PG8_BAR; PG8_SCHED;
            PG8_LDB(B1, 0, 1); PG8_STAGE(PG8_SB(0, 0), b2, voffB);
            PG8_BAR; PG8_WAIT_L(0); PG8_MMA(0, 1, At, B1); PG8_BAR;
            PG8_LDA(At, 0, 1); PG8_STAGE(PG8_SA(0, 0), a2, voffA);
            PG8_BAR; PG8_WAIT_L(0); PG8_MMA(1, 0, At, B0); PG8_BAR; PG8_SCHED;
            PG8_STAGE(PG8_SB(0, 1), b2 + hstep, voffB);
            PG8_WAIT_V(6); PG8_BAR; PG8_MMA(1, 1, At, B1); PG8_BAR;
            PG8_LDB(B0, 1, 0); PG8_SCHED; PG8_LDA(At, 1, 0); PG8_STAGE(PG8_SA(0, 1), a2 + hstep, voffA);
            PG8_WAIT_L(8); PG8_BAR; PG8_WAIT_L(0); PG8_MMA(0, 0, At, B0); PG8_BAR; PG8_SCHED;
            PG8_LDB(B1, 1, 1); PG8_STAGE(PG8_SB(1, 0), b3, voffB);
            PG8_BAR; PG8_WAIT_L(0); PG8_MMA(0, 1, At, B1); PG8_BAR;
            PG8_LDA(At, 1, 1); PG8_STAGE(PG8_SA(1, 0), a3, voffA);
            PG8_BAR; PG8_WAIT_L(0); PG8_MMA(1, 0, At, B0); PG8_BAR; PG8_SCHED;
            PG8_STAGE(PG8_SB(1, 1), b3 + hstep, voffB);
            PG8_WAIT_V(6); PG8_BAR; PG8_MMA(1, 1, At, B1); PG8_BAR;
            }
        }
        if constexpr (ALIGN_EPI) { if (wr == 0) PG8_BAR; }
        if constexpr (!Epi::AFTER_DRAIN) { E(acc, cur, wr, wc, fr, fq); S.done(cur); }
        if (!has_next) break;
#pragma unroll
        for (int a = 0; a < 2; ++a)
#pragma unroll
            for (int b = 0; b < 2; ++b)
#pragma unroll
                for (int m = 0; m < 4; ++m)
#pragma unroll
                    for (int n = 0; n < 2; ++n) acc[a][b][m][n] = (f32x4){0.f, 0.f, 0.f, 0.f};
        cur = nxt; cA = nA; cB = nB; ++ui;
        if constexpr (ALIGN_EPI) { if (wr == 1) PG8_BAR; }
    }
    PG8_WAIT_V(0);
    if constexpr (!ALIGN_EPI) { if (wr == 0) PG8_BAR; }
    PG8_BAR;
    if constexpr (Epi::AFTER_DRAIN) { E.fused(acc, cur, wr, wc, fr, fq, lds, wid, lane); S.done(cur); }
#undef PG8_SA
#undef PG8_SB
#undef PG8_STAGE
#undef PG8_LDA
#undef PG8_LDB
#undef PG8_MMA
#undef PG8_WAIT_V
#undef PG8_WAIT_L
#undef PG8_BAR
#undef PG8_SCHED
}
}
#include <hip/hip_bf16.h>
#include <cmath>
namespace attn_body {
using bf16=__hip_bfloat16;
using bf16x8=__attribute__((ext_vector_type(8)))short;
using s16x4=__attribute__((ext_vector_type(4)))short;
using f32x16=__attribute__((ext_vector_type(16)))float;
using u32x4=__attribute__((ext_vector_type(4)))unsigned;
constexpr int BATCH=8,NHEAD=16,SEQ=4096,D=64,DM=NHEAD*D;
constexpr int NW=8,QBLK=32,QB=QBLK*NW,KVBLK=64,NQB=SEQ/QB;
constexpr int ATTN_PITCH=DM, ATTN_UNIT_ROWS=QB;
__device__ __forceinline__ int crow(int r,int hi){return (r&3)+8*(r>>2)+4*hi;}
#define SBAR() __builtin_amdgcn_sched_barrier(0)
__device__ __forceinline__ void cmask(f32x16&p0,f32x16&p1,int jb,int qrel,int hi){
  const float NEG=-INFINITY; int kb=64*jb+4*hi;
  #pragma unroll
  for(int r=0;r<16;++r){int kv=kb+(r&3)+8*(r>>2); if(kv>qrel)p0[r]=NEG; if(kv+32>qrel)p1[r]=NEG;}
}

__device__ __forceinline__ void cbias(f32x16&p0,f32x16&p1,int jb,int qrel,int hi,const __attribute__((address_space(3))) float*tab){
  const int base=qrel-64*jb-4*hi;
  #pragma unroll
  for(int r=0;r<16;++r){const int d0=base-((r&3)+8*(r>>2)); const int i0=min(max(d0,0),127), i1=min(max(d0-32,0),127); p0[r]+=tab[i0]; p1[r]+=tab[i1];}
}
constexpr int NSLOT=3, SLOTB=8192;
constexpr int LDS_K=0, LDS_V=NSLOT*SLOTB, LDS_WS=2*NSLOT*SLOTB, LDS_OST=LDS_WS+NW*64*4, LDS_TAB=LDS_OST+NW*4096, LDS_BYTES=LDS_TAB+512;
constexpr float C2=0.125f*1.4426950408889634f;
__device__ __forceinline__ void glds16(const void*gsrc,unsigned lds_dst){unsigned keep;
  asm volatile("s_mov_b32 %0, m0\n\ts_mov_b32 m0, %2\n\ts_nop 0\n\tglobal_load_lds_dwordx4 %1, off\n\ts_mov_b32 m0, %0":"=&s"(keep):"v"(gsrc),"s"(lds_dst):"memory");}
__device__ __forceinline__ float max3f(float a,float b,float c){float r;asm("v_max3_f32 %0, %1, %2, %3":"=v"(r):"v"(a),"v"(b),"v"(c));return r;}
__device__ __forceinline__ float max2f(float a,float b){float r;asm("v_max_f32_e32 %0, %1, %2":"=v"(r):"v"(a),"v"(b));return r;}
__device__ __forceinline__ float fadd_s(float a,float b){float r;asm("v_add_f32_e32 %0, %1, %2":"=v"(r):"v"(a),"v"(b));return r;}
__device__ __forceinline__ float fsub_s(float a,float b){float r;asm("v_sub_f32_e32 %0, %1, %2":"=v"(r):"v"(a),"v"(b));return r;}
typedef float f32x2_t __attribute__((ext_vector_type(2))); typedef __bf16 bf16x2_t __attribute__((ext_vector_type(2)));
__device__ __forceinline__ unsigned cvtpk_s(float lo,float hi){f32x2_t v={lo,hi};bf16x2_t b=__builtin_convertvector(v,bf16x2_t);return __builtin_bit_cast(unsigned,b);}
#define WAIT_BAR(N) asm volatile("s_waitcnt vmcnt(" #N ") lgkmcnt(0)\n\ts_barrier":::"memory")

__device__ __forceinline__ void qkt(f32x16&p0,f32x16&p1,const char*Kslot,const bf16x8*qr,const f32x16&negm,int r32,int hi){
  const char*kb=Kslot+hi*1024+r32*16;
  #pragma unroll
  for(int d0=0;d0<4;++d0){
    const bf16x8 b0=*reinterpret_cast<const bf16x8*>(kb+d0*2048);
    const bf16x8 b1=*reinterpret_cast<const bf16x8*>(kb+d0*2048+512);
    if(d0==0){p0=__builtin_amdgcn_mfma_f32_32x32x16_bf16(b0,qr[0],negm,0,0,0);p1=__builtin_amdgcn_mfma_f32_32x32x16_bf16(b1,qr[0],negm,0,0,0);}
    else{p0=__builtin_amdgcn_mfma_f32_32x32x16_bf16(b0,qr[d0],p0,0,0,0);p1=__builtin_amdgcn_mfma_f32_32x32x16_bf16(b1,qr[d0],p1,0,0,0);}}
}
typedef __attribute__((address_space(3))) const char* lds_cptr;
typedef short v4i16_t __attribute__((ext_vector_type(4)));
__device__ __forceinline__ void kload8(bf16x8*kf,lds_cptr kp){
  kf[0]=*(const __attribute__((address_space(3))) bf16x8*)(kp);      kf[1]=*(const __attribute__((address_space(3))) bf16x8*)(kp+512);
  kf[2]=*(const __attribute__((address_space(3))) bf16x8*)(kp+2048); kf[3]=*(const __attribute__((address_space(3))) bf16x8*)(kp+2560);
  kf[4]=*(const __attribute__((address_space(3))) bf16x8*)(kp+4096); kf[5]=*(const __attribute__((address_space(3))) bf16x8*)(kp+4608);
  kf[6]=*(const __attribute__((address_space(3))) bf16x8*)(kp+6144); kf[7]=*(const __attribute__((address_space(3))) bf16x8*)(kp+6656);
}
__device__ __forceinline__ void kload2(bf16x8*kf,lds_cptr kp,int j){ kf[2*j]=*(const __attribute__((address_space(3))) bf16x8*)(kp+j*2048); kf[2*j+1]=*(const __attribute__((address_space(3))) bf16x8*)(kp+j*2048+512); }
__device__ __forceinline__ s16x4 vtr(lds_cptr p){ return __builtin_bit_cast(s16x4,__builtin_amdgcn_ds_read_tr16_b64_v4i16((__attribute__((address_space(3))) v4i16_t*)p)); }
__device__ __forceinline__ float rowmax(const f32x16&p0,const f32x16&p1){
  float a=max3f(p0[0],p0[1],p1[0]),b=max3f(p0[2],p0[3],p1[1]);a=max3f(a,p1[2],p1[3]);
  #pragma unroll
  for(int r=4;r<16;r+=4){a=max3f(a,p0[r],p0[r+1]);b=max3f(b,p0[r+2],p0[r+3]);a=max3f(a,p1[r],p1[r+1]);b=max3f(b,p1[r+2],p1[r+3]);}
  const float m=max2f(a,b);
  auto rr=__builtin_amdgcn_permlane32_swap(__float_as_uint(m),__float_as_uint(m),false,false);
  return max2f(__uint_as_float(rr[0]),__uint_as_float(rr[1]));
}
__device__ __forceinline__ void pv(f32x16*o,int vb,bf16x8 pa0,bf16x8 pa1,bf16x8 pa2,bf16x8 pa3){
  #pragma unroll
  for(int d0=0;d0<2;++d0){s16x4 lo[4],hi[4];
    #pragma unroll
    for(int ks=0;ks<4;++ks){
      asm volatile("ds_read_b64_tr_b16 %0,%1 offset:%c2":"=&v"(lo[ks]):"v"(vb),"i"(d0*4096+ks*1024):"memory");
      asm volatile("ds_read_b64_tr_b16 %0,%1 offset:%c2":"=&v"(hi[ks]):"v"(vb),"i"(d0*4096+ks*1024+512):"memory");}
    asm volatile("s_waitcnt lgkmcnt(0)":::"memory");SBAR();
    #define PK(k) (bf16x8){lo[k][0],lo[k][1],lo[k][2],lo[k][3],hi[k][0],hi[k][1],hi[k][2],hi[k][3]}
    o[d0]=__builtin_amdgcn_mfma_f32_32x32x16_bf16(pa0,PK(0),o[d0],0,0,0);
    o[d0]=__builtin_amdgcn_mfma_f32_32x32x16_bf16(pa1,PK(1),o[d0],0,0,0);
    o[d0]=__builtin_amdgcn_mfma_f32_32x32x16_bf16(pa2,PK(2),o[d0],0,0,0);
    o[d0]=__builtin_amdgcn_mfma_f32_32x32x16_bf16(pa3,PK(3),o[d0],0,0,0);
    #undef PK
  }
}

#ifndef ATTN_STORE16
#define ATTN_STORE16(p,v) (*(u32x4*)(p)=(v))
#endif
template<int THRL> __device__ __forceinline__ void attn_unit(int b,int h,int hv,int qb,const bf16*Q,const bf16*__restrict__ K,const bf16*__restrict__ V,bf16*O,char*shm){
  const __attribute__((address_space(3))) float* tab=(const __attribute__((address_space(3))) float*)((lds_cptr)shm+LDS_TAB);
  const int tid=threadIdx.x,lane=tid&63,r32=lane&31,hi=lane>>5; const int wid=__builtin_amdgcn_readfirstlane(tid>>6);
  const long rowbase=(long)b*SEQ; const int q0=qb*QB;
  const bf16*Qw=Q+(rowbase+q0+wid*QBLK)*DM+h*D;
  const bf16*Kh=K+rowbase*DM+h*D,*Vh=V+rowbase*DM+hv*D;
  const unsigned lds0=(unsigned)(uintptr_t)shm;
  float*wsf=(float*)(shm+LDS_WS)+wid*64;
  const bf16*ksrc=Kh+(long)lane*DM+wid*8;
  const bf16*vsrc=Vh+(long)(16*(wid&3)+(lane>>2))*DM+(wid>>2)*32+(lane&3)*8;
  const unsigned kdst=lds0+LDS_K+wid*1024, vdst=lds0+LDS_V+wid*1024;
  #define DMA_K(t,slot) glds16(ksrc+(long)(t)*KVBLK*DM,(unsigned)__builtin_amdgcn_readfirstlane(kdst+(slot)))
  #define DMA_V(t,slot) glds16(vsrc+(long)(t)*KVBLK*DM,(unsigned)__builtin_amdgcn_readfirstlane(vdst+(slot)))
  const int vb0=(int)(lds0+LDS_V)+((lane>>4)&1)*32+(lane&3)*8+(4*hi+((lane&15)>>2))*64;
  const char*Kbase=shm+LDS_K; bf16x8 kf[8];
  const lds_cptr shm3=(lds_cptr)shm; const lds_cptr kp0=shm3+LDS_K+hi*1024+r32*16; const lds_cptr vp0=shm3+LDS_V+((lane>>4)&1)*32+(lane&3)*8+(4*hi+((lane&15)>>2))*64;
  const int NT=(q0+QB)/KVBLK;
  DMA_K(0,0);DMA_V(0,0);DMA_K(1,SLOTB);
  bf16x8 qr[4];
  #pragma unroll
  for(int d0=0;d0<4;++d0)qr[d0]=*reinterpret_cast<const bf16x8*>(&Qw[(long)r32*DM+d0*16+hi*8]);
  float mhat=0.f,l_reg=0.f;f32x16 o[2];o[0]=f32x16{};o[1]=f32x16{};f32x16 negm=f32x16{};asm volatile("":"+v"(negm));
  const int qrel=wid*QBLK+r32;
  #define CMASK(P0,P1,t) do{int jb_=(t)-(NT-4); if(jb_>=-2){cbias(P0,P1,jb_,qrel,hi,tab); if(jb_>=0)cmask(P0,P1,jb_,qrel,hi);}}while(0)
  bool resc=false;
  #define START(P0,P1) do{ const float rm=rowmax(P0,P1); resc=false; \
    { const float dl=rm; mhat=fadd_s(mhat,dl); \
      _Pragma("unroll") for(int r=0;r<16;++r){P0[r]=fsub_s(P0[r],dl);P1[r]=fsub_s(P1[r],dl);} \
      _Pragma("unroll") for(int r=0;r<16;++r)negm[r]=-mhat; asm volatile("":"+v"(negm)); } \
    _Pragma("unroll") for(int r=0;r<16;++r)P0[r]=__builtin_amdgcn_exp2f(P0[r]); }while(0)
  #define RESC() do{ if(resc){ asm volatile("s_waitcnt lgkmcnt(0)":::"memory"); \
      _Pragma("unroll") for(int d_=0;d_<2;++d_) _Pragma("unroll") for(int r=0;r<16;++r)o[d_][r]*=wsf[crow(r,hi)]; } }while(0)
  f32x16 pA0,pA1,pB0,pB1;
  int sl_prev=0,sl_cur=0,sl_next=SLOTB;
  #define ROT() do{sl_prev=sl_cur;sl_cur=sl_next;sl_next=(sl_next==(NSLOT-1)*SLOTB)?0:sl_next+SLOTB;}while(0)
  DMA_K(2,2*SLOTB);
  WAIT_BAR(3);
  qkt(pA0,pA1,Kbase,qr,negm,r32,hi);asm volatile("s_nop 15\n\ts_nop 7":"+v"(pA0),"+v"(pA1));CMASK(pA0,pA1,0);
  START(pA0,pA1);
  _Pragma("unroll") for(int r=0;r<16;++r)pA1[r]=__builtin_amdgcn_exp2f(pA1[r]);
  WAIT_BAR(0);
  DMA_K(3,0);DMA_V(1,SLOTB);
  ROT();
  kload8(kf,kp0+sl_cur);
  WAIT_BAR(2);
  s16x4 vlo[8],vhi[8]; u32x4 pw0,pw1,pw2,pw3;
  #define PKW(P,B) cvtpk_s(P[B],P[B+1])
  #define PAF(k) __builtin_bit_cast(bf16x8,pw##k)
  #define VFR(i) (bf16x8){vlo[i][0],vlo[i][1],vlo[i][2],vlo[i][3],vhi[i][0],vhi[i][1],vhi[i][2],vhi[i][3]}
  #define PIN(x) asm volatile("":"+v"(x))
  #define MX3(a,b,c) __builtin_fmaxf(__builtin_fmaxf((a),(b)),(c))
  #define GAPA(MF,A0,A1,A2,A3,W0,W1,PW) do{ MF; sacc+=A0; sacc+=A1; sacc+=A2; sacc+=A3; PIN(sacc); W0; W1; PIN(PW); SBAR(); }while(0)
  #define EX(v) __builtin_amdgcn_exp2f(v)
  #define GAPB(MF,X,B) do{ MF; X[B]=EX(X[B]); X[B+1]=EX(X[B+1]); X[B+2]=EX(X[B+2]); X[B+3]=EX(X[B+3]); PIN(X); SBAR(); }while(0)
  #define VRD(i) do{ vlo[i]=vtr(vp_+(((i)>>2)*4096+((i)&3)*1024)); vhi[i]=vtr(vp_+(((i)>>2)*4096+((i)&3)*1024+512)); }while(0)
  #define KRD(G,j) do{ if(G){ kload2(kf,kp0+sl_next,j); SBAR(); } }while(0)
  #define STEP(C0,C1,P0,P1,t,GK,GV,GL) do{ SBAR(); \
    const lds_cptr vp_=vp0+sl_prev; \
    VRD(0); SBAR(); float sacc=(P0[0]+P0[1]); \
    GAPA(C0=__builtin_amdgcn_mfma_f32_32x32x16_bf16(kf[0],qr[0],negm,0,0,0), P0[2],P0[3],P0[4],P0[5],     pw0[0]=PKW(P0,0), pw0[1]=PKW(P0,2), pw0); \
    VRD(4); SBAR(); GAPA(C1=__builtin_amdgcn_mfma_f32_32x32x16_bf16(kf[1],qr[0],negm,0,0,0), P0[6],P0[7],P0[8],P0[9],     pw0[2]=PKW(P0,4), pw0[3]=PKW(P0,6), pw0); \
    VRD(1); SBAR(); GAPA(C0=__builtin_amdgcn_mfma_f32_32x32x16_bf16(kf[2],qr[1],C0,0,0,0),   P0[10],P0[11],P0[12],P0[13], pw1[0]=PKW(P0,8), pw1[1]=PKW(P0,10), pw1); \
    VRD(5); SBAR(); GAPA(C1=__builtin_amdgcn_mfma_f32_32x32x16_bf16(kf[3],qr[1],C1,0,0,0),   P0[14],P0[15],P1[0],P1[1],   pw1[2]=PKW(P0,12),pw1[3]=PKW(P0,14), pw1); \
    VRD(2); SBAR(); GAPA(C0=__builtin_amdgcn_mfma_f32_32x32x16_bf16(kf[4],qr[2],C0,0,0,0),   P1[2],P1[3],P1[4],P1[5],     pw2[0]=PKW(P1,0), pw2[1]=PKW(P1,2), pw2); \
    VRD(6); SBAR(); GAPA(C1=__builtin_amdgcn_mfma_f32_32x32x16_bf16(kf[5],qr[2],C1,0,0,0),   P1[6],P1[7],P1[8],P1[9],     pw2[2]=PKW(P1,4), pw2[3]=PKW(P1,6), pw2); \
    VRD(3); SBAR(); GAPA(C0=__builtin_amdgcn_mfma_f32_32x32x16_bf16(kf[6],qr[3],C0,0,0,0),   P1[10],P1[11],P1[12],P1[13], pw3[0]=PKW(P1,8), pw3[1]=PKW(P1,10), pw3); \
    VRD(7); SBAR(); GAPA(C1=__builtin_amdgcn_mfma_f32_32x32x16_bf16(kf[7],qr[3],C1,0,0,0),   P1[14],P1[15],0.f,0.f,       pw3[2]=PKW(P1,12),pw3[3]=PKW(P1,14), pw3); \
    l_reg+=sacc; \
    if(GK){DMA_K((t)+3,sl_cur);} if(GV){DMA_V((t)+1,sl_next);} \
    CMASK(C0,C1,t); \
    { float a=MX3(C0[0],C0[1],C1[0]),b=MX3(C0[2],C0[3],C1[1]); a=MX3(a,C1[2],C1[3]); \
      _Pragma("unroll") for(int r=4;r<16;r+=4){a=MX3(a,C0[r],C0[r+1]);b=MX3(b,C0[r+2],C0[r+3]);a=MX3(a,C1[r],C1[r+1]);b=MX3(b,C1[r+2],C1[r+3]);} \
      float rm=__builtin_fmaxf(a,b); { auto rr=__builtin_amdgcn_permlane32_swap(__float_as_uint(rm),__float_as_uint(rm),false,false); rm=__builtin_fmaxf(__uint_as_float(rr[0]),__uint_as_float(rr[1])); } \
      resc=false; \
      if(__builtin_expect(__any(rm>(float)THRL),0)){ const float dl=__builtin_fmaxf(rm,0.f); mhat+=dl; \
        _Pragma("unroll") for(int r=0;r<16;++r){C0[r]-=dl;C1[r]-=dl;} \
        _Pragma("unroll") for(int r=0;r<16;++r)negm[r]=-mhat; asm volatile("":"+v"(negm)); \
        const float f=__builtin_amdgcn_exp2f(-dl); l_reg*=f; if(hi==0)wsf[r32]=f; resc=true; } } \
    SBAR(); \
    GAPB(o[0]=__builtin_amdgcn_mfma_f32_32x32x16_bf16(PAF(0),VFR(0),o[0],0,0,0), C0,0); \
    GAPB(o[1]=__builtin_amdgcn_mfma_f32_32x32x16_bf16(PAF(0),VFR(4),o[1],0,0,0), C0,4); \
    KRD(GL,0); GAPB(o[0]=__builtin_amdgcn_mfma_f32_32x32x16_bf16(PAF(1),VFR(1),o[0],0,0,0), C0,8); \
    KRD(GL,1); GAPB(o[1]=__builtin_amdgcn_mfma_f32_32x32x16_bf16(PAF(1),VFR(5),o[1],0,0,0), C0,12); \
    KRD(GL,2); GAPB(o[0]=__builtin_amdgcn_mfma_f32_32x32x16_bf16(PAF(2),VFR(2),o[0],0,0,0), C1,0); \
    KRD(GL,3); GAPB(o[1]=__builtin_amdgcn_mfma_f32_32x32x16_bf16(PAF(2),VFR(6),o[1],0,0,0), C1,4); \
    GAPB(o[0]=__builtin_amdgcn_mfma_f32_32x32x16_bf16(PAF(3),VFR(3),o[0],0,0,0), C1,8); \
    GAPB(o[1]=__builtin_amdgcn_mfma_f32_32x32x16_bf16(PAF(3),VFR(7),o[1],0,0,0), C1,12); \
    }while(0)
  int t=1;
  #undef CMASK
  #define CMASK(P0,P1,t) do{}while(0)
  for(;t+7<NT;t+=2){
    STEP(pB0,pB1,pA0,pA1,t,true,true,true);     WAIT_BAR(2); RESC(); ROT();
    STEP(pA0,pA1,pB0,pB1,t+1,true,true,true);   WAIT_BAR(2); RESC(); ROT();
  }
  #undef CMASK
  #define CMASK(P0,P1,t) do{int jb_=(t)-(NT-4); if(jb_>=-2){cbias(P0,P1,jb_,qrel,hi,tab); if(jb_>=0)cmask(P0,P1,jb_,qrel,hi);}}while(0)
  #define ENDW(tt) do{ if((tt)+3<NT){WAIT_BAR(2);} else if((tt)+2<NT){WAIT_BAR(1);} else {WAIT_BAR(0);} }while(0)
  for(;t+1<NT;t+=2){
    STEP(pB0,pB1,pA0,pA1,t,(t+3<NT),(t+1<NT),(t+1<NT));       ENDW(t);   RESC(); ROT();
    STEP(pA0,pA1,pB0,pB1,t+1,(t+4<NT),(t+2<NT),(t+2<NT));     ENDW(t+1); RESC(); ROT();
  }
  STEP(pB0,pB1,pA0,pA1,NT-1,false,false,false); RESC();
  { float sacc=pB0[0]+pB0[1]; _Pragma("unroll") for(int r=2;r<16;++r)sacc+=pB0[r]; _Pragma("unroll") for(int r=0;r<16;++r)sacc+=pB1[r]; l_reg+=sacc;
    pw0=(u32x4){PKW(pB0,0),PKW(pB0,2),PKW(pB0,4),PKW(pB0,6)};pw1=(u32x4){PKW(pB0,8),PKW(pB0,10),PKW(pB0,12),PKW(pB0,14)};pw2=(u32x4){PKW(pB1,0),PKW(pB1,2),PKW(pB1,4),PKW(pB1,6)};pw3=(u32x4){PKW(pB1,8),PKW(pB1,10),PKW(pB1,12),PKW(pB1,14)};
    SBAR(); pv(o,vb0+sl_cur,PAF(0),PAF(1),PAF(2),PAF(3)); }
  #undef PKW
  #undef PAF
  #undef VFR
  #undef PIN
  #undef MX3
  #undef GAPA
  #undef GAPB
  #undef EX
  #undef VRD
  #undef KRD
  #undef STEP
  #undef ENDW
  {auto rr=__builtin_amdgcn_permlane32_swap(__float_as_uint(l_reg),__float_as_uint(l_reg),false,false);l_reg=__uint_as_float(rr[0])+__uint_as_float(rr[1]);}
  if(hi==0)wsf[32+r32]=l_reg;asm volatile("s_waitcnt lgkmcnt(0)":::"memory");
  float rli[16];
  #pragma unroll
  for(int r=0;r<16;++r)rli[r]=__builtin_amdgcn_rcpf(wsf[32+crow(r,hi)]);
  bf16*Ow=O+(rowbase+q0+wid*QBLK)*DM+hv*D;
  { bf16*stg=(bf16*)(shm+LDS_OST)+wid*2048;
    #pragma unroll
    for(int r=0;r<16;++r){const int orow=crow(r,hi);
      #pragma unroll
      for(int d0=0;d0<2;++d0)stg[orow*64+d0*32+r32]=__float2bfloat16(o[d0][r]*rli[r]);}
    asm volatile("s_waitcnt lgkmcnt(0)":::"memory");
    #pragma unroll
    for(int i=0;i<4;++i){const int row=i*8+(lane>>3),ch=lane&7; const u32x4 v=*(const u32x4*)(stg+row*64+ch*8); ATTN_STORE16(Ow+(long)row*DM+ch*8,v);} }
  asm volatile("s_waitcnt lgkmcnt(0)\n\ts_barrier":::"memory");
  #undef DMA_K
  #undef DMA_V
  #undef CMASK
  #undef START
  #undef RESC
  #undef ROT
}
constexpr int ATTN_LDS_BYTES=LDS_BYTES;
struct AttnTensors { const bf16* Q; const bf16* K; const bf16* V; bf16* O1; bf16* O2; const float* biastab; };
struct AttnUnit { int b, hqk, hv, c, qb; };
struct StaticOrder {
  int vcu;
  __device__ __forceinline__ explicit StaticOrder(int grid,int block):vcu((grid%8==0)?(block%8)*(grid/8)+block/8:block){}
  __device__ __forceinline__ bool next(int i,AttnUnit&u)const{ if(i>=16)return false; const int v=vcu&255; u.b=v>>5; const int h=(v>>2)&7,c=(v>>1)&1,hf=v&1; u.hqk=2*h+c; u.hv=2*h+hf; u.c=c; u.qb=(i&1)?15-(i>>1):(i>>1); return true; }
};
template<class Sched,int THRL=8> __device__ __forceinline__ void attn_phase(char*lds,const AttnTensors&T,const Sched&S){
  AttnUnit u; int cur_h=-1;
  for(int i=0;S.next(i,u);++i){
    if((u.hqk>>1)!=cur_h){ cur_h=u.hqk>>1;
      if(threadIdx.x<128)((float*)(lds+LDS_TAB))[threadIdx.x]=T.biastab[cur_h*128+threadIdx.x];
      asm volatile("s_waitcnt vmcnt(0) lgkmcnt(0)\n\ts_barrier":::"memory"); }
    attn_unit<THRL>(u.b,u.hqk,u.hv,u.qb,T.Q,T.K,T.V,u.c?T.O2:T.O1,lds); }
}
#undef SBAR
#undef WAIT_BAR
}
namespace dattn {
using bf16 = __hip_bfloat16;
typedef short bf16x8 __attribute__((ext_vector_type(8)));
typedef short s16x4 __attribute__((ext_vector_type(4)));
typedef float f32x16 __attribute__((ext_vector_type(16)));
typedef unsigned u32x4 __attribute__((ext_vector_type(4)));
constexpr int DK = 64, DV = 128, RS = 1024, SEQ = 4096;
constexpr int NW = 8, QBLK = 32, KVBLK = 64, QB = NW * QBLK;
constexpr int SHM_V = KVBLK * DV * 2, SHM_K = KVBLK * DK * 2;
constexpr int LDS_WS = 2 * SHM_V + 2 * SHM_K, LDS_TAB = LDS_WS + NW * 64 * 4, LDS_BYTES = LDS_TAB + 512;
constexpr float THR = 8.f;
#define DA_KSWZ(row, colB) ((row) * 128 + ((colB) ^ (((row) & 7) << 4)))
#define DA_SBAR() __builtin_amdgcn_sched_barrier(0)
__device__ __forceinline__ int v_st(int k, int c) { const int kk = (k & ~0xC) | ((k & 4) << 1) | ((k & 8) >> 1); return ((kk >> 3) * 4 + (c >> 5)) * 512 + ((kk & 7) * 32 + (c & 31)) * 2; }
__device__ __forceinline__ int v_rd_base(int lane) { return ((lane & 3) << 3) | (((lane >> 2) & 3) << 6) | (((lane >> 4) & 1) << 5) | (((lane >> 5) & 1) << 8); }
constexpr int v_rd_off(int d0, int ks, int half) { return d0 * 512 + ks * 4096 + half * 2048; }
__device__ __forceinline__ int crow(int r, int hi) { return (r & 3) + 8 * (r >> 2) + 4 * hi; }
__device__ __forceinline__ unsigned cvtpk(float lo, float hi) { unsigned r; asm volatile("v_cvt_pk_bf16_f32 %0, %1, %2" : "=v"(r) : "v"(lo), "v"(hi)); return r; }
__device__ __forceinline__ bf16x8 load8(const bf16* p) { return *reinterpret_cast<const bf16x8*>(p); }
__device__ __forceinline__ void mask_tile(f32x16& p0, f32x16& p1, int dq) {
    const float NEG = -__builtin_inff();
#pragma unroll
    for (int r = 0; r < 16; ++r) { const int c = (r & 3) + 8 * (r >> 2); if (dq - c < 0) p0[r] = NEG; if (dq - c - 32 < 0) p1[r] = NEG; }
}
__device__ __forceinline__ void bias_tile(f32x16& p0, f32x16& p1, int dq, const __attribute__((address_space(3))) float* tab) {
#pragma unroll
    for (int r = 0; r < 16; ++r) { const int c = (r & 3) + 8 * (r >> 2); const int i0 = min(max(dq - c, 0), 127), i1 = min(max(dq - c - 32, 0), 127); p0[r] += tab[i0]; p1[r] += tab[i1]; }
}
__device__ __forceinline__ void partialSM(f32x16& p0, f32x16& p1, float& m_reg, float& mn, float& alpha) {
    float pmax = p0[0];
#pragma unroll
    for (int r = 1; r < 16; ++r) pmax = fmaxf(pmax, p0[r]);
#pragma unroll
    for (int r = 0; r < 16; ++r) pmax = fmaxf(pmax, p1[r]);
    { auto rr = __builtin_amdgcn_permlane32_swap(__float_as_uint(pmax), __float_as_uint(pmax), false, false); pmax = fmaxf(__uint_as_float(rr[0]), __uint_as_float(rr[1])); }
    if (__builtin_expect(__all(pmax - m_reg <= THR), 1)) { mn = m_reg; alpha = 1.f; }
    else { mn = fmaxf(m_reg, pmax); alpha = __builtin_amdgcn_exp2f(m_reg - mn); m_reg = mn; }
#pragma unroll
    for (int r = 0; r < 16; ++r) p0[r] -= mn;
#pragma unroll
    for (int r = 0; r < 16; ++r) p1[r] -= mn;
#pragma unroll
    for (int r = 0; r < 16; ++r) p0[r] = __builtin_amdgcn_exp2f(p0[r]);
}
__device__ __forceinline__ void finishSM(f32x16& p0, f32x16& p1, float alpha, float& l_reg, bf16x8& pa0, bf16x8& pa1, bf16x8& pa2, bf16x8& pa3) {
#pragma unroll
    for (int r = 0; r < 16; ++r) p1[r] = __builtin_amdgcn_exp2f(p1[r]);
    float ps = 0;
#pragma unroll
    for (int r = 0; r < 16; ++r) ps += p0[r];
#pragma unroll
    for (int r = 0; r < 16; ++r) ps += p1[r];
    { auto rr = __builtin_amdgcn_permlane32_swap(__float_as_uint(ps), __float_as_uint(ps), false, false); ps = __uint_as_float(rr[0]) + __uint_as_float(rr[1]); }
    l_reg = l_reg * alpha + ps;
#define DA_PK4(P, B_, OUT) do { unsigned a0 = cvtpk(P[B_+0], P[B_+1]), a1 = cvtpk(P[B_+2], P[B_+3]); unsigned b0 = cvtpk(P[B_+4], P[B_+5]), b1 = cvtpk(P[B_+6], P[B_+7]); \
        auto r0 = __builtin_amdgcn_permlane32_swap(a0, b0, false, false); auto r1 = __builtin_amdgcn_permlane32_swap(a1, b1, false, false); \
        u32x4 w = {r0[0], r1[0], r0[1], r1[1]}; OUT = *reinterpret_cast<bf16x8*>(&w); } while (0)
    DA_PK4(p0, 0, pa0); DA_PK4(p0, 8, pa1); DA_PK4(p1, 0, pa2); DA_PK4(p1, 8, pa3);
#undef DA_PK4
}
template <int KB>
__device__ __forceinline__ void qkt(f32x16& p0, f32x16& p1, const char* K_lds, int r32, int hi, const bf16x8* qr) {
    p0 = f32x16{}; p1 = f32x16{};
#pragma unroll
    for (int d0 = 0; d0 < 4; ++d0) { const char* a = K_lds + KB * SHM_K + DA_KSWZ(r32, (d0 * 16 + hi * 8) * 2);
        const bf16x8 b0 = *reinterpret_cast<const bf16x8*>(a), b1 = *reinterpret_cast<const bf16x8*>(a + 32 * 128);
        p0 = __builtin_amdgcn_mfma_f32_32x32x16_bf16(b0, qr[d0], p0, 0, 0, 0);
        p1 = __builtin_amdgcn_mfma_f32_32x32x16_bf16(b1, qr[d0], p1, 0, 0, 0); }
}
template <int VB>
__device__ __forceinline__ void pv_tile(f32x16* o, int vb0, bf16x8 pa0, bf16x8 pa1, bf16x8 pa2, bf16x8 pa3) {
#define DA_TRRD(dst, off) asm volatile("ds_read_b64_tr_b16 %0, %1 offset:%2" : "=&v"(dst) : "v"(vb0), "i"(off) : "memory")
#define DA_PV_D0(d0) do { s16x4 l0, l1, l2, l3, h0, h1, h2, h3; constexpr int b_ = VB * SHM_V + v_rd_off(d0, 0, 0); \
        DA_TRRD(l0, b_); DA_TRRD(h0, b_ + 2048); DA_TRRD(l1, b_ + 4096); DA_TRRD(h1, b_ + 6144); DA_TRRD(l2, b_ + 8192); DA_TRRD(h2, b_ + 10240); DA_TRRD(l3, b_ + 12288); DA_TRRD(h3, b_ + 14336); \
        asm volatile("s_waitcnt lgkmcnt(0)" ::: "memory"); DA_SBAR(); \
        o[d0] = __builtin_amdgcn_mfma_f32_32x32x16_bf16(pa0, (bf16x8){l0[0], l0[1], l0[2], l0[3], h0[0], h0[1], h0[2], h0[3]}, o[d0], 0, 0, 0); \
        o[d0] = __builtin_amdgcn_mfma_f32_32x32x16_bf16(pa1, (bf16x8){l1[0], l1[1], l1[2], l1[3], h1[0], h1[1], h1[2], h1[3]}, o[d0], 0, 0, 0); \
        o[d0] = __builtin_amdgcn_mfma_f32_32x32x16_bf16(pa2, (bf16x8){l2[0], l2[1], l2[2], l2[3], h2[0], h2[1], h2[2], h2[3]}, o[d0], 0, 0, 0); \
        o[d0] = __builtin_amdgcn_mfma_f32_32x32x16_bf16(pa3, (bf16x8){l3[0], l3[1], l3[2], l3[3], h3[0], h3[1], h3[2], h3[3]}, o[d0], 0, 0, 0); } while (0)
    DA_PV_D0(0); DA_PV_D0(1); DA_PV_D0(2); DA_PV_D0(3);
#undef DA_PV_D0
#undef DA_TRRD
}
struct BlockRef { const bf16* Q; const bf16* K; const bf16* V; bf16* O; int P0; };
struct Seam { bf16x8 qr[4]; bf16x8 st_v0, st_v1, st_k0; };
#define DA_VMW() asm volatile("s_waitcnt vmcnt(0)" ::: "memory")
#define DA_VMWN(n) asm volatile("s_waitcnt vmcnt(%0)" :: "i"(n) : "memory")
#define DA_SLOAD(Kp, Vp, k0) do { S.st_v0 = load8((Vp) + (size_t)((k0) + sr) * RS + sc); S.st_v1 = load8((Vp) + (size_t)((k0) + 32 + sr) * RS + sc); S.st_k0 = load8((Kp) + (size_t)((k0) + kr) * RS + kc); } while (0)
#define DA_SWRITE_K(bf) do { *(bf16x8*)(K_lds + (bf) * SHM_K + kws) = S.st_k0; } while (0)
#define DA_SWRITE_V(bf) do { *(bf16x8*)(V_lds + (bf) * SHM_V + vst0) = S.st_v0; *(bf16x8*)(V_lds + (bf) * SHM_V + vst1) = S.st_v1; } while (0)
__device__ __forceinline__ void prime(const BlockRef& cur, char* lds, Seam& S) {
    const int tid = threadIdx.x, wid = __builtin_amdgcn_readfirstlane(tid >> 6), lane = tid & 63, r32 = lane & 31, hi = lane >> 5;
    const int sr = tid >> 4, sc = (tid & 15) * 8, kr = tid >> 3, kc = (tid & 7) * 8, kws = DA_KSWZ(kr, kc * 2); char* K_lds = lds + 2 * SHM_V;
#pragma unroll
    for (int d0 = 0; d0 < 4; ++d0) S.qr[d0] = load8(cur.Q + (size_t)(wid * QBLK + r32) * RS + d0 * 16 + hi * 8);
    DA_SLOAD(cur.K, cur.V, 0); DA_VMW(); DA_SWRITE_K(0);
    __syncthreads();
}
__device__ __forceinline__ void block(const BlockRef& cur, const BlockRef& nxt, char* lds, Seam& S) {
    const int tid = threadIdx.x, wid = __builtin_amdgcn_readfirstlane(tid >> 6), lane = tid & 63, r32 = lane & 31, hi = lane >> 5;
    const int NT = (cur.P0 + QB) / KVBLK;
    const int qlo = cur.P0 + wid * QBLK, qm = qlo + r32 - 4 * hi;
    char* V_lds = lds; char* K_lds = lds + 2 * SHM_V;
    float* ws = (float*)(lds + LDS_WS) + wid * 64; float* li_l = ws, * al_l = ws + 32;
    const __attribute__((address_space(3))) float* tab = (const __attribute__((address_space(3))) float*)((__attribute__((address_space(3))) char*)lds + LDS_TAB);
    float m_reg = -1e30f, l_reg = 0; f32x16 o[4] = {};
    const int sr = tid >> 4, sc = (tid & 15) * 8, vst0 = v_st(sr, sc), vst1 = v_st(32 + sr, sc), kr = tid >> 3, kc = (tid & 7) * 8, kws = DA_KSWZ(kr, kc * 2);
    const int vb0 = (int)(uintptr_t)V_lds + v_rd_base(lane);
    const bf16* Kh = cur.K; const bf16* Vh = cur.V;
#define DA_RESC(a) do { if (__any((a) < 1.f)) { if (hi == 0) al_l[r32] = (a); asm volatile("s_waitcnt lgkmcnt(0)" ::: "memory"); \
                     _Pragma("unroll") for (int d_ = 0; d_ < 4; ++d_) _Pragma("unroll") for (int r = 0; r < 16; ++r) o[d_][r] *= al_l[crow(r, hi)]; } } while (0)
#define DA_KBASE(t) ((t) * KVBLK)
#define DA_MASKT(P0_, P1_, t) do { const int kb_ = DA_KBASE(t); if (kb_ + KVBLK - 1 >= qlo - 127) { bias_tile(P0_, P1_, qm - kb_, tab); if (kb_ + KVBLK - 1 > qlo) mask_tile(P0_, P1_, qm - kb_); } } while (0)
    constexpr int NQL = 4;
#define DA_SEAM_K0() do { DA_VMWN(NQL); DA_SWRITE_K(0); DA_SBAR(); } while (0)
    f32x16 pA0, pA1, pB0, pB1; float mnA, mnB, alA, alB; bf16x8 pa0, pa1, pa2, pa3;
    DA_SWRITE_V(0); DA_SBAR();
    DA_SLOAD(Kh, Vh, DA_KBASE(1));
    DA_SBAR(); qkt<0>(pA0, pA1, K_lds, r32, hi, S.qr);
    DA_MASKT(pA0, pA1, 0); partialSM(pA0, pA1, m_reg, mnA, alA);
    DA_VMW(); DA_SWRITE_V(1); DA_SWRITE_K(1);
    __syncthreads();
#define DA_HALF_STEP(PX0, PX1, mnX, alX, PY0, PY1, alY, t, KB, VB, SB) do { \
        DA_SBAR(); qkt<KB>(PX0, PX1, K_lds, r32, hi, S.qr); \
        finishSM(PY0, PY1, alY, l_reg, pa0, pa1, pa2, pa3); DA_SBAR(); \
        if ((t) + 1 < NT) { DA_SLOAD(Kh, Vh, DA_KBASE((t) + 1)); DA_SBAR(); } \
        pv_tile<VB>(o, vb0, pa0, pa1, pa2, pa3); DA_MASKT(PX0, PX1, (t)); partialSM(PX0, PX1, m_reg, mnX, alX); \
        __syncthreads(); \
        if ((t) + 1 < NT) { DA_VMW(); DA_SWRITE_V(SB); DA_SWRITE_K(SB); } \
        DA_RESC(alX); __syncthreads(); } while (0)
    for (int t = 1; t + 1 < NT; t += 2) {
        DA_HALF_STEP(pB0, pB1, mnB, alB, pA0, pA1, alA, t, 1, 0, 0);
        DA_HALF_STEP(pA0, pA1, mnA, alA, pB0, pB1, alB, t + 1, 0, 1, 1);
    }
    DA_SBAR(); qkt<1>(pB0, pB1, K_lds, r32, hi, S.qr); DA_SBAR();
    DA_SLOAD(nxt.K, nxt.V, 0); DA_SBAR();
#pragma unroll
    for (int d0 = 0; d0 < 4; ++d0) S.qr[d0] = load8(nxt.Q + (size_t)(wid * QBLK + r32) * RS + d0 * 16 + hi * 8);
    DA_SBAR();
    finishSM(pA0, pA1, alA, l_reg, pa0, pa1, pa2, pa3); DA_SBAR();
    pv_tile<0>(o, vb0, pa0, pa1, pa2, pa3);
    DA_MASKT(pB0, pB1, NT - 1); partialSM(pB0, pB1, m_reg, mnB, alB); __syncthreads(); DA_RESC(alB);
    finishSM(pB0, pB1, alB, l_reg, pa0, pa1, pa2, pa3); DA_SBAR(); pv_tile<1>(o, vb0, pa0, pa1, pa2, pa3);
    DA_SBAR(); DA_SEAM_K0();
    if (hi == 0) li_l[r32] = l_reg; asm volatile("s_waitcnt lgkmcnt(0)" ::: "memory");
    float rli[16];
#pragma unroll
    for (int r = 0; r < 16; ++r) rli[r] = __builtin_amdgcn_rcpf(li_l[crow(r, hi)]);
    bf16* Ow = cur.O + (size_t)(wid * QBLK) * RS;
#pragma unroll
    for (int r = 0; r < 16; ++r) { const int orow = crow(r, hi);
#pragma unroll
        for (int d0 = 0; d0 < 4; ++d0) { const float v = o[d0][r] * rli[r]; const float vn = __shfl_xor(v, 1);
            if ((r32 & 1) == 0) *(unsigned*)(Ow + (size_t)orow * RS + d0 * 32 + r32) = cvtpk(v, vn); } }
    __syncthreads();
#undef DA_RESC
#undef DA_KBASE
#undef DA_MASKT
#undef DA_SEAM_K0
#undef DA_HALF_STEP
}
#undef DA_VMW
#undef DA_VMWN
#undef DA_SLOAD
#undef DA_SWRITE_K
#undef DA_SWRITE_V
struct Tensors { const bf16* Q; const bf16* K; const bf16* V; bf16* O1; bf16* O2; const float* biastab; };
__device__ __forceinline__ BlockRef unit_ref(const Tensors& T, int v, int i) {
    const int bhc = (v & 255) >> 1, s = v & 1, b = bhc >> 4, h = (bhc >> 1) & 7, c = bhc & 1; const int q2 = 2 * (i >> 1) + s, qb = (i & 1) ? 15 - q2 : q2;
    const size_t row0 = (size_t)b * SEQ; BlockRef r;
    r.Q = T.Q + (row0 + (size_t)qb * QB) * RS + (2 * h + c) * DK; r.K = T.K + row0 * RS + (2 * h + c) * DK; r.V = T.V + row0 * RS + h * DV;
    r.O = (c ? T.O2 : T.O1) + (row0 + (size_t)qb * QB) * RS + h * DV; r.P0 = qb * QB; return r;
}
__device__ __forceinline__ void phase(char* lds, const Tensors& T, int vcu) {
    { const int h = ((vcu & 255) >> 2) & 7; if (threadIdx.x < 128) ((float*)(lds + LDS_TAB))[threadIdx.x] = T.biastab[h * 128 + threadIdx.x]; }
    Seam S; BlockRef cur = unit_ref(T, vcu, 0);
    prime(cur, lds, S);
    for (int i = 0; i < 8; ++i) { const BlockRef nxt = unit_ref(T, vcu, i + 1 < 8 ? i + 1 : i); block(cur, nxt, lds, S); cur = nxt; }
}
#undef DA_KSWZ
#undef DA_SBAR
}
#ifndef PG8_SP2
#define PG8_SP2 true
#endif
#ifndef PG8_ALIGN
#define PG8_ALIGN true
#endif
constexpr int NWAVES = 8;
#ifndef MK_N_LAUNCHES
#define MK_N_LAUNCHES 1
#endif
constexpr int N_PHASES = 8;
constexpr int BATCH = 8, SEQ = 4096, D = 2048, M = BATCH * SEQ;
constexpr int NPROJ = 5120, DATT = 1024, DCONV = 1024, CONVW = 31;
constexpr int PH = 8, PNK = 128, PHALF = 128, PTOPK = 16, NEXP = 16384;
constexpr float LN_EPS = 1e-5f;
constexpr float DN_ALPHA = 1.189207115002721f;
constexpr float LAMBDA_INIT = 0.2f;
constexpr size_t MiB = 1u << 20;
constexpr size_t WS_WIN = 2 * MiB, WS_WOUT = 22 * MiB, WS_WQ = 30 * MiB, WS_KEYS = 38 * MiB, WS_TAB = 39 * MiB;
constexpr size_t WS_U8 = 40 * MiB, WS_V8 = 72 * MiB, WS_SU = 104 * MiB, WS_SV = 105 * MiB;
constexpr size_t WS_XB = 168 * MiB;
constexpr size_t WS_Q = 296 * MiB, WS_K = 360 * MiB, WS_V = 424 * MiB, WS_H = 488 * MiB;
constexpr size_t WS_O1 = 552 * MiB, WS_O2 = 616 * MiB;
constexpr size_t WS_Y1 = 680 * MiB;
constexpr size_t WS_QP = 808 * MiB;
constexpr size_t WS_X8 = WS_O1;
constexpr size_t WS_SX = 106 * MiB, WS_SWQ = 107 * MiB, WS_SWIN = WS_SWQ + 65536, WS_SWOUT = WS_SWQ + 131072, WS_SXA = 108 * MiB, WS_SM = 109 * MiB, WS_LNS = 110 * MiB;
constexpr size_t WS_CMAX = 16384;
constexpr size_t WS_EID = 936 * MiB, WS_GATE = 952 * MiB;
constexpr size_t WS_END = 968 * MiB;
constexpr int RING_BYTES = 131072, LDS_BYTES = 147456;

#define GAS __attribute__((address_space(1)))
#define LAS __attribute__((address_space(3)))
typedef unsigned short bf16;
typedef unsigned v4u __attribute__((ext_vector_type(4)));
typedef unsigned v2u __attribute__((ext_vector_type(2)));
typedef float f32x4 __attribute__((ext_vector_type(4)));
typedef float f32x16 __attribute__((ext_vector_type(16)));
typedef short bf16x8 __attribute__((ext_vector_type(8)));
typedef __bf16 bf16x2_t __attribute__((ext_vector_type(2)));
#define LDS_WAIT() asm volatile("s_waitcnt lgkmcnt(0)" ::: "memory")
__device__ __forceinline__ unsigned f2bf(float f) { unsigned u = __builtin_bit_cast(unsigned, f); return (u + 0x7fffu + ((u >> 16) & 1u)) >> 16; }
__device__ __forceinline__ unsigned pk2(float lo, float hi) { return f2bf(lo) | (f2bf(hi) << 16); }
__device__ __forceinline__ float bflo(unsigned w) { return __uint_as_float(w << 16); }
__device__ __forceinline__ float bfhi(unsigned w) { return __uint_as_float(w & 0xffff0000u); }
__device__ __forceinline__ float wave_sum(float v) {
#pragma unroll
    for (int o = 1; o < 64; o <<= 1) v += __shfl_xor(v, o);
    return v;
}
__device__ __forceinline__ float dot2bf(unsigned a, unsigned b, float acc) { return __builtin_amdgcn_fdot2_f32_bf16(__builtin_bit_cast(bf16x2_t, a), __builtin_bit_cast(bf16x2_t, b), acc, false); }

#define XB_TMO      128
#define XB_XCNT(j)  (256  + 64 * (j))
#define XB_XSUB(j)  (1280 + 64 * (j))
#define XB_XGEN(j)  (2304 + 64 * (j))
#define XB_TOP      3328
#define XB_TOPGEN   3392
#define XCD_BAR_WORDS 3456
#define XB_SPIN_CAP (1u << 18)

__device__ __forceinline__ unsigned xb_ld(unsigned* p)              { return __hip_atomic_load(p, __ATOMIC_RELAXED, __HIP_MEMORY_SCOPE_AGENT); }
__device__ __forceinline__ unsigned xb_add(unsigned* p, unsigned v) { return __hip_atomic_fetch_add(p, v, __ATOMIC_RELAXED, __HIP_MEMORY_SCOPE_AGENT); }
__device__ __forceinline__ unsigned xb_xcc_id() { return (unsigned)__builtin_amdgcn_s_getreg((3 << 11) | 20) & 0xFu; }
#define XB_SPIN(cond, bar) do { unsigned _sp = 0; while (cond) { __builtin_amdgcn_s_sleep(1); \
    if ((++_sp & 255u) == 0u) { if (xb_ld(&(bar)[XB_TMO])) break; if (_sp > XB_SPIN_CAP) { atomicAdd(&(bar)[XB_TMO], 1u); break; } } } } while (0)

struct XcdBarrier {
    unsigned* bar; unsigned x;
    volatile LAS unsigned* st;
};

__device__ __forceinline__ XcdBarrier xcd_barrier_post(unsigned* bar, volatile LAS unsigned* st) {
    XcdBarrier b; b.bar = bar; b.x = xb_xcc_id(); b.st = st;
    if (threadIdx.x == 0) (void)xb_add(&bar[XB_XCNT(b.x)], 1u);
    return b;
}
__device__ __forceinline__ void xcd_barrier_complete(unsigned* bar, unsigned x, unsigned& nloc, unsigned& nx) {
    const unsigned G = gridDim.x * gridDim.y * gridDim.z;
    unsigned sum, cnt, mine, sp = 0u;
    for (;;) {
        sum = 0u; cnt = 0u; mine = 0u;
#pragma unroll
        for (unsigned j = 0; j < 16; ++j) { const unsigned c = xb_ld(&bar[XB_XCNT(j)]); sum += c; cnt += (c > 0u) ? 1u : 0u; mine = (j == x) ? c : mine; }
        if (sum == G) break;
        __builtin_amdgcn_s_sleep(1);
        if ((++sp & 255u) == 0u) { if (xb_ld(&bar[XB_TMO])) break; if (sp > XB_SPIN_CAP) { atomicAdd(&bar[XB_TMO], 1u); break; } }
    }
    nloc = mine > 0u ? mine : 1u; nx = cnt > 0u ? cnt : 1u;
}

__device__ __forceinline__ void xcd_barrier(const XcdBarrier& b) {
    asm volatile("s_waitcnt vmcnt(0)" ::: "memory");
    __syncthreads();
    if (threadIdx.x == 0) {
        unsigned* bar = b.bar;
        __builtin_amdgcn_s_waitcnt(0);
        unsigned nloc = b.st[0], nx = b.st[1];
        if (nloc == 0u) { xcd_barrier_complete(bar, b.x, nloc, nx); b.st[0] = nloc; b.st[1] = nx; }
        const unsigned old = xb_add(&bar[XB_XSUB(b.x)], 1u);
        const unsigned gen = old / nloc;
        if (old + 1u == (gen + 1u) * nloc) {
            __builtin_amdgcn_fence(__ATOMIC_RELEASE, "agent");
            asm volatile("s_waitcnt vmcnt(0)" ::: "memory");
            const unsigned og = xb_add(&bar[XB_TOP], 1u);
            const unsigned tg = og / nx;
            if (og + 1u == (tg + 1u) * nx) xb_add(&bar[XB_TOPGEN], 1u);
            else XB_SPIN(xb_ld(&bar[XB_TOPGEN]) == tg, bar);
            __builtin_amdgcn_fence(__ATOMIC_ACQUIRE, "agent");
            xb_add(&bar[XB_XGEN(b.x)], 1u);
            asm volatile("s_waitcnt vmcnt(0)" ::: "memory");
        } else {
            XB_SPIN(xb_ld(&bar[XB_XGEN(b.x)]) == gen, bar);
            __builtin_amdgcn_fence(__ATOMIC_ACQUIRE, "agent");
            asm volatile("s_waitcnt vmcnt(0)" ::: "memory");
        }
    }
    __syncthreads();
}

struct Frame {
    LAS unsigned char* lds;
    __device__ __forceinline__ int wave_() const { int w = __builtin_amdgcn_readfirstlane((int)threadIdx.x >> 6); asm volatile("" : "+s"(w)); return w; }
    __device__ __forceinline__ int G_() const { int g = (int)gridDim.x; asm volatile("" : "+s"(g)); return g; }
    __device__ __forceinline__ int vcu_() const { int bx = (int)blockIdx.x; asm volatile("" : "+s"(bx)); const int g = G_(); return (g % 8 == 0) ? (bx % 8) * (g / 8) + bx / 8 : bx; }
    __device__ __forceinline__ int tid() const { int t = (int)threadIdx.x; asm volatile("" : "+v"(t)); return t; }
    __device__ __forceinline__ int lane() const { return tid() & 63; }
    __device__ __forceinline__ unsigned long long raw(int k) const { const volatile LAS unsigned* p = (const volatile LAS unsigned*)(lds + RING_BYTES) + 2 * k;
        const unsigned lo = __builtin_amdgcn_readfirstlane(p[0]), hi = __builtin_amdgcn_readfirstlane(p[1]); return ((unsigned long long)hi << 32) | lo; }
    __device__ __forceinline__ const float* in(int k) const { return (const float*)raw(k); }
    __device__ __forceinline__ float* outp() const { return (float*)raw(22); }
    template <class T> __device__ __forceinline__ T* ws(size_t off) const { return (T*)((unsigned char*)raw(23) + off); }
};
enum { I_X = 0, I_WIN, I_BGLU, I_CONVW, I_CONVB, I_CLNG, I_CLNB, I_LQ1, I_LK1, I_LQ2, I_LK2, I_SUBLN, I_RELB, I_WOUT, I_LN1G, I_LN1B, I_WQ, I_KEYS, I_U, I_V, I_LN2G, I_LN2B };

__device__ __forceinline__ unsigned pack_i8x4(float a, float b, float c, float d) {
    const int ia = (int)rintf(a), ib = (int)rintf(b), ic = (int)rintf(c), id = (int)rintf(d); return (unsigned)(ia & 255) | ((unsigned)(ib & 255) << 8) | ((unsigned)(ic & 255) << 16) | ((unsigned)id << 24); }
__device__ __forceinline__ void p0_transpose_item(const float* W, int K, int N, bf16* WT, int k0, int n0, int dst0, LAS float* scr, int lane) {
#pragma unroll 8
    for (int i = 0; i < 32; ++i) { const int kk = 2 * i + (lane >> 5); scr[kk * 33 + (lane & 31)] = W[(size_t)(k0 + kk) * N + n0 + (lane & 31)]; }
    LDS_WAIT(); asm volatile("" ::: "memory");
    const int c = lane & 7;
#pragma unroll
    for (int j = 0; j < 4; ++j) { const int n = (lane >> 3) + 8 * j; const LAS float* s = scr + (8 * c) * 33 + n;
        v4u o; o.x = pk2(s[0 * 33], s[1 * 33]); o.y = pk2(s[2 * 33], s[3 * 33]); o.z = pk2(s[4 * 33], s[5 * 33]); o.w = pk2(s[6 * 33], s[7 * 33]);
        *(GAS v4u*)(WT + (size_t)(dst0 + n) * K + k0 + 8 * c) = o; }
    LDS_WAIT(); asm volatile("" ::: "memory");
}
__device__ __forceinline__ void p0_colmax_item(const float* W, int N, unsigned* cmax, int k0, int n0, int dst0, int lane) {
    f32x4 am = {0.f, 0.f, 0.f, 0.f};
#pragma unroll
    for (int i = 0; i < 8; ++i) { const f32x4 v = *(const GAS f32x4*)(W + (size_t)(k0 + 8 * i + (lane >> 3)) * N + n0 + 4 * (lane & 7));
        am[0] = fmaxf(am[0], fabsf(v[0])); am[1] = fmaxf(am[1], fabsf(v[1])); am[2] = fmaxf(am[2], fabsf(v[2])); am[3] = fmaxf(am[3], fabsf(v[3])); }
#pragma unroll
    for (int e = 0; e < 4; ++e) { am[e] = fmaxf(am[e], __shfl_xor(am[e], 8)); am[e] = fmaxf(am[e], __shfl_xor(am[e], 16)); am[e] = fmaxf(am[e], __shfl_xor(am[e], 32)); }
    if (lane < 8) {
#pragma unroll
        for (int e = 0; e < 4; ++e) atomicMax(cmax + dst0 + 4 * lane + e, __float_as_uint(am[e])); }
}
__device__ __forceinline__ void p0_quant_item(const float* W, int N, unsigned char* WT8, const unsigned* cmax, float* scale, int k0, int n0, int dst0, LAS float* scr, int lane) {
#pragma unroll
    for (int i = 0; i < 8; ++i) { const int kk = 8 * i + (lane >> 3); const f32x4 v = *(const GAS f32x4*)(W + (size_t)(k0 + kk) * N + n0 + 4 * (lane & 7));
        LAS float* d = scr + kk * 33 + 4 * (lane & 7); d[0] = v[0]; d[1] = v[1]; d[2] = v[2]; d[3] = v[3]; }
    if (lane < 32) { const float am = __uint_as_float(__hip_atomic_load(cmax + dst0 + lane, __ATOMIC_RELAXED, __HIP_MEMORY_SCOPE_AGENT)); const float sc = am > 0.f ? am * (1.f / 127.f) : 1.f;
        scr[64 * 33 + lane] = 1.f / sc; if (k0 == 0) scale[dst0 + lane] = sc; }
    LDS_WAIT(); asm volatile("" ::: "memory");
    const int c = lane & 7;
#pragma unroll
    for (int j = 0; j < 4; ++j) { const int n = (lane >> 3) + 8 * j; const LAS float* sp = scr + (8 * c) * 33 + n; const float inv = scr[64 * 33 + n];
        *(GAS v2u*)(WT8 + (size_t)(dst0 + n) * D + k0 + 8 * c) = (v2u){pack_i8x4(sp[0 * 33] * inv, sp[1 * 33] * inv, sp[2 * 33] * inv, sp[3 * 33] * inv), pack_i8x4(sp[4 * 33] * inv, sp[5 * 33] * inv, sp[6 * 33] * inv, sp[7 * 33] * inv)}; }
    LDS_WAIT(); asm volatile("" ::: "memory");
}
__device__ __forceinline__ int glu_dst(int n0) {
    if (n0 < 3072) return n0;
    const int ch = (n0 - 3072) & 1023, gate = (n0 - 3072) >> 10; return 3072 + 256 * (ch >> 7) + 128 * gate + (ch & 127);
}
__device__ __forceinline__ void p0_quant_x(const float* src, unsigned char* dst8, float* scale, int rows, int gw, int NGW, int lane) {
    f32x4 nx[8], nx2[8];
    if (gw < rows) { const GAS f32x4* sp = (const GAS f32x4*)(src + (size_t)gw * D) + lane; const int r1 = (gw + NGW < rows) ? gw + NGW : gw; const GAS f32x4* sq = (const GAS f32x4*)(src + (size_t)r1 * D) + lane;
#pragma unroll
        for (int j = 0; j < 8; ++j) { nx[j] = sp[64 * j]; nx2[j] = sq[64 * j]; } }
    for (int r = gw; r < rows; r += NGW) {
        f32x4 v[8]; float am = 0.f;
#pragma unroll
        for (int j = 0; j < 8; ++j) { v[j] = nx[j]; nx[j] = nx2[j]; }
        { const int rn = (r + 2 * NGW < rows) ? r + 2 * NGW : r; const GAS f32x4* sp = (const GAS f32x4*)(src + (size_t)rn * D) + lane;
#pragma unroll
          for (int j = 0; j < 8; ++j) nx2[j] = sp[64 * j]; }
#pragma unroll
        for (int j = 0; j < 8; ++j) am = fmaxf(fmaxf(am, fmaxf(fabsf(v[j].x), fabsf(v[j].y))), fmaxf(fabsf(v[j].z), fabsf(v[j].w)));
#pragma unroll
        for (int o = 1; o < 64; o <<= 1) am = fmaxf(am, __shfl_xor(am, o));
        const float sc = am > 0.f ? am * (1.f / 127.f) : 1.f, inv = 1.f / sc;
        GAS unsigned* dp = (GAS unsigned*)(dst8 + (size_t)r * D) + lane;
#pragma unroll
        for (int j = 0; j < 8; ++j) dp[64 * j] = pack_i8x4(v[j].x * inv, v[j].y * inv, v[j].z * inv, v[j].w * inv);
        if (lane == 0) scale[r] = sc;
    }
}
__device__ __forceinline__ void p0_convert(const float* src, bf16* dst, size_t n, int gw, int NGW, int lane) {
    const size_t nit = n / 512;
    for (size_t it = gw; it < nit; it += NGW) { const GAS f32x4* s = (const GAS f32x4*)(src + it * 512) + 2 * lane; const f32x4 a = s[0], b = s[1];
        v4u o; o.x = pk2(a.x, a.y); o.y = pk2(a.z, a.w); o.z = pk2(b.x, b.y); o.w = pk2(b.z, b.w); *((GAS v4u*)(dst + it * 512) + lane) = o; }
}
template <bool INT8> __device__ __forceinline__ void p0_quant_rows(const float* src, unsigned* dst8, float* scale, int rows, int gw, int NGW, int lane) {
    f32x4 nx[8], nx2[8];
    if (gw < rows) { const GAS f32x4* sp = (const GAS f32x4*)(src + (size_t)gw * D) + lane; const int r1 = (gw + NGW < rows) ? gw + NGW : gw; const GAS f32x4* sq = (const GAS f32x4*)(src + (size_t)r1 * D) + lane;
#pragma unroll
        for (int j = 0; j < 8; ++j) { nx[j] = sp[64 * j]; nx2[j] = sq[64 * j]; } }
    for (int r = gw; r < rows; r += NGW) {
        f32x4 v[8]; float am = 0.f;
#pragma unroll
        for (int j = 0; j < 8; ++j) { v[j] = nx[j]; nx[j] = nx2[j]; }
        { const int rn = (r + 2 * NGW < rows) ? r + 2 * NGW : r; const GAS f32x4* sp = (const GAS f32x4*)(src + (size_t)rn * D) + lane;
#pragma unroll
          for (int j = 0; j < 8; ++j) nx2[j] = sp[64 * j]; }
#pragma unroll
        for (int j = 0; j < 8; ++j) am = fmaxf(fmaxf(am, fmaxf(fabsf(v[j].x), fabsf(v[j].y))), fmaxf(fabsf(v[j].z), fabsf(v[j].w)));
#pragma unroll
        for (int o = 1; o < 64; o <<= 1) am = fmaxf(am, __shfl_xor(am, o));
        const float sc = am > 0.f ? am * (INT8 ? (1.f / 127.f) : (1.f / 440.f)) : 1.f, inv = 1.f / sc;
#pragma unroll
        for (int j = 0; j < 8; ++j) { int w;
            if (INT8) w = (int)pack_i8x4(v[j].x * inv, v[j].y * inv, v[j].z * inv, v[j].w * inv);
            else { w = __builtin_amdgcn_cvt_pk_fp8_f32(v[j].x * inv, v[j].y * inv, 0, false); w = __builtin_amdgcn_cvt_pk_fp8_f32(v[j].z * inv, v[j].w * inv, w, true); }
            const int wi = lane + 64 * j, c = wi >> 5; *((GAS unsigned*)dst8 + ((size_t)c * rows + r) * 32 + (wi & 31)) = (unsigned)w; }
        if (lane == 0) scale[r] = sc;
    }
}
__device__ __forceinline__ int t5_bucket(int d) {
    if (d < 16) return d;
    int l = 16 + (int)(logf((float)d / 16.f) / logf(8.f) * 16.f); return l < 31 ? l : 31;
}
__device__ __forceinline__ void p0a_prologue(Frame& F) {
    LAS float* scr = (LAS float*)(F.lds + F.wave_() * 16384);
    constexpr int I_IN = (D / 64) * (NPROJ / 32), I_OUT = (D / 64) * (D / 32);
    { const float* w_in = F.in(I_WIN); unsigned* cmax = F.ws<unsigned>(WS_CMAX); const int gw = F.vcu_() * NWAVES + F.wave_(), NGW = F.G_() * NWAVES;
      for (int r = gw; r < I_IN; r += NGW) { const int nblk = NPROJ / 32, kb = r / nblk, nb = r % nblk; p0_colmax_item(w_in, NPROJ, cmax, 64 * kb, 32 * nb, glu_dst(32 * nb), F.lane()); } }
    { const float* wq = F.in(I_WQ); unsigned* cmax = F.ws<unsigned>(WS_CMAX) + NPROJ; const int gw = F.vcu_() * NWAVES + F.wave_(), NGW = F.G_() * NWAVES;
      for (int r = gw; r < I_OUT; r += NGW) { const int nblk = D / 32, kb = r / nblk, nb = r % nblk; p0_colmax_item(wq, D, cmax, 64 * kb, 32 * nb, 32 * nb, F.lane()); } }
    { const float* wo = F.in(I_WOUT); unsigned* cmax = F.ws<unsigned>(WS_CMAX) + NPROJ + D; const int gw = F.vcu_() * NWAVES + F.wave_(), NGW = F.G_() * NWAVES;
      for (int r = gw; r < I_OUT; r += NGW) { const int nblk = D / 32, kb = r / nblk, nb = r % nblk; p0_colmax_item(wo, D, cmax, 64 * kb, 32 * nb, 32 * nb, F.lane()); } }
    { const int gw = F.vcu_() * NWAVES + F.wave_(), NGW = F.G_() * NWAVES; p0_quant_x(F.in(I_X), F.ws<unsigned char>(WS_XB), F.ws<float>(WS_SXA), M, gw, NGW, F.lane()); }
    { const int gw = F.vcu_() * NWAVES + F.wave_(), NGW = F.G_() * NWAVES; p0_quant_rows<true>(F.in(I_U), F.ws<unsigned>(WS_U8), F.ws<float>(WS_SU), NEXP, gw, NGW, F.lane()); }
    { const int gw = F.vcu_() * NWAVES + F.wave_(), NGW = F.G_() * NWAVES; p0_quant_rows<true>(F.in(I_V), F.ws<unsigned>(WS_V8), F.ws<float>(WS_SV), NEXP, gw, NGW, F.lane()); }
    { const int gw = F.vcu_() * NWAVES + F.wave_(), NGW = F.G_() * NWAVES; p0_convert(F.in(I_KEYS), F.ws<bf16>(WS_KEYS), (size_t)PH * 2 * PNK * PHALF, gw, NGW, F.lane()); }
    if (blockIdx.x == 0) { const float* rel_bias = F.in(I_RELB); float* TAB = F.ws<float>(WS_TAB);
        for (int i = F.tid(); i < 8 * 128; i += NWAVES * 64) { const int h = i >> 7, d = i & 127;
            TAB[i] = (rel_bias[t5_bucket(d) * 8 + h] - rel_bias[31 * 8 + h]) * 1.4426950408889634f; } }
}
__device__ __forceinline__ void p0b_prologue(Frame& F) {
    LAS float* scr = (LAS float*)(F.lds + F.wave_() * 16384);
    constexpr int I_IN = (D / 64) * (NPROJ / 32), I_OUT = (D / 64) * (D / 32);
    { const float* w_in = F.in(I_WIN); unsigned char* W8 = F.ws<unsigned char>(WS_WIN); const unsigned* cmax = F.ws<unsigned>(WS_CMAX); float* sw = F.ws<float>(WS_SWIN); const int gw = F.vcu_() * NWAVES + F.wave_(), NGW = F.G_() * NWAVES;
      for (int r = gw; r < I_IN; r += NGW) { const int nblk = NPROJ / 32, kb = r / nblk, nb = r % nblk; p0_quant_item(w_in, NPROJ, W8, cmax, sw, 64 * kb, 32 * nb, glu_dst(32 * nb), scr, F.lane()); } }
    { const float* wq = F.in(I_WQ); unsigned char* W8 = F.ws<unsigned char>(WS_WQ); const unsigned* cmax = F.ws<unsigned>(WS_CMAX) + NPROJ; float* sw = F.ws<float>(WS_SWQ); const int gw = F.vcu_() * NWAVES + F.wave_(), NGW = F.G_() * NWAVES;
      for (int r = gw; r < I_OUT; r += NGW) { const int nblk = D / 32, kb = r / nblk, nb = r % nblk; p0_quant_item(wq, D, W8, cmax, sw, 64 * kb, 32 * nb, 32 * nb, scr, F.lane()); } }
    { const float* wo = F.in(I_WOUT); unsigned char* W8 = F.ws<unsigned char>(WS_WOUT); const unsigned* cmax = F.ws<unsigned>(WS_CMAX) + NPROJ + D; float* sw = F.ws<float>(WS_SWOUT); const int gw = F.vcu_() * NWAVES + F.wave_(), NGW = F.G_() * NWAVES;
      for (int r = gw; r < I_OUT; r += NGW) { const int nblk = D / 32, kb = r / nblk, nb = r % nblk; p0_quant_item(wo, D, W8, cmax, sw, 64 * kb, 32 * nb, 32 * nb, scr, F.lane()); } }
}

__device__ __forceinline__ float diff_lambda(Frame& F) {
    const float a = wave_sum(F.in(I_LQ1)[F.lane()] * F.in(I_LK1)[F.lane()]), b = wave_sum(F.in(I_LQ2)[F.lane()] * F.in(I_LK2)[F.lane()]);
    return expf(a) - expf(b) + LAMBDA_INIT;
}
template <int CTRL> __device__ __forceinline__ int dppi(int v) { return __builtin_amdgcn_update_dpp(0, v, CTRL, 0xf, 0xf, true); }
template <int CTRL> __device__ __forceinline__ float dppf(float v) { return __int_as_float(__builtin_amdgcn_update_dpp(0, __float_as_int(v), CTRL, 0xf, 0xf, true)); }
template <int CTRL, int RM> __device__ __forceinline__ float dpp_rm(float old, float v) { return __int_as_float(__builtin_amdgcn_update_dpp(__float_as_int(old), __float_as_int(v), CTRL, RM, 0xf, false)); }
__device__ __forceinline__ float wave_sum63(float v) {
    v += dppf<0xB1>(v); v += dppf<0x4E>(v); v += dppf<0x141>(v); v += dppf<0x140>(v);
    v += dpp_rm<0x142, 0xa>(0.f, v);
    v += dpp_rm<0x143, 0xc>(0.f, v);
    return v;
}
__device__ __forceinline__ float wave_max63(float v) {
    v = fmaxf(v, dppf<0xB1>(v)); v = fmaxf(v, dppf<0x4E>(v)); v = fmaxf(v, dppf<0x141>(v)); v = fmaxf(v, dppf<0x140>(v));
    v = fmaxf(v, dpp_rm<0x142, 0xa>(0.f, v)); v = fmaxf(v, dpp_rm<0x143, 0xc>(0.f, v));
    return v;
}
__device__ __forceinline__ void p3_mix(Frame& F) {
    constexpr int TT = 32, NPR = (TT + CONVW - 1) / 2, STATS_OFF = NPR * 4096, AMC_OFF = STATS_OFF + 2048, AMA_OFF = AMC_OFF + 1024, MS_OFF = AMA_OFF + 128, INV_OFF = MS_OFF + 256, STG_OFF = (TT / 2) * 4096;
    static_assert(INV_OFF + 128 <= RING_BYTES && STG_OFF + TT * 1024 <= STATS_OFF, "P3 LDS map");
    const int tid = F.tid(), lane = tid & 63, wave = F.wave_();
    const float lam = diff_lambda(F);
    const float* conv_w = F.in(I_CONVW); const bf16* H = F.ws<bf16>(WS_H); const bf16* O1 = F.ws<bf16>(WS_O1); const bf16* O2 = F.ws<bf16>(WS_O2);
    unsigned char* MIX8 = F.ws<unsigned char>(WS_XB); float* SM = F.ws<float>(WS_SM); const float* subln_g = F.in(I_SUBLN);
    const float2 cb = *(const float2*)(F.in(I_CONVB) + 2 * tid), lg = *(const float2*)(F.in(I_CLNG) + 2 * tid), lb = *(const float2*)(F.in(I_CLNB) + 2 * tid);
    LAS float* stats = (LAS float*)(F.lds + STATS_OFF); LAS float* amc = (LAS float*)(F.lds + AMC_OFF); LAS float* ama = (LAS float*)(F.lds + AMA_OFF); LAS float* ms = (LAS float*)(F.lds + MS_OFF); LAS float* invs = (LAS float*)(F.lds + INV_OFF);
    for (int tile_i = F.vcu_(); tile_i < M / TT; tile_i += F.G_()) {
        const int t0 = tile_i * TT, s0 = t0 & (SEQ - 1);
        for (int p = tid >> 7; p < NPR; p += 4) { const int sp = s0 - (CONVW - 1) + 2 * p; v4u a = (v4u){0u, 0u, 0u, 0u}, b = a;
            if (sp >= 0) { const GAS v4u* hp = (const GAS v4u*)(H + (size_t)(t0 - (CONVW - 1) + 2 * p) * 1024) + (tid & 127); a = hp[0]; b = hp[128]; }
            const unsigned aw[4] = {a.x, a.y, a.z, a.w}, bw[4] = {b.x, b.y, b.z, b.w}; unsigned o[8];
#pragma unroll
            for (int k = 0; k < 4; ++k) { o[2 * k] = __builtin_amdgcn_perm(bw[k], aw[k], 0x05040100u); o[2 * k + 1] = __builtin_amdgcn_perm(bw[k], aw[k], 0x07060302u); }
            LAS v4u* dst = (LAS v4u*)(F.lds + p * 4096 + (tid & 127) * 32); dst[0] = (v4u){o[0], o[1], o[2], o[3]}; dst[1] = (v4u){o[4], o[5], o[6], o[7]}; }
        __syncthreads();
        {
            unsigned we0[16], we1[16], wo0[16], wo1[16]; float2 wprev = {0.f, 0.f};
#pragma unroll
            for (int q = 0; q < 16; ++q) { const float2 wa = *(const float2*)(conv_w + (2 * q) * DCONV + 2 * tid); float2 wb = {0.f, 0.f}; if (2 * q + 1 < CONVW) wb = *(const float2*)(conv_w + (2 * q + 1) * DCONV + 2 * tid);
                we0[q] = pk2(wa.x, wb.x); we1[q] = pk2(wa.y, wb.y); wo0[q] = pk2(wprev.x, wa.x); wo1[q] = pk2(wprev.y, wa.y); wprev = wb; }
            for (int q = 0; q < TT / 2; ++q) {
                float e0 = cb.x, e1 = cb.y, o0 = cb.x, o1 = cb.y;
                const LAS v2u* src = (const LAS v2u*)(F.lds + q * 4096 + tid * 8);
#pragma unroll
                for (int j = 0; j < 16; ++j) { const v2u d = src[j * 512]; e0 = dot2bf(d.x, we0[j], e0); e1 = dot2bf(d.y, we1[j], e1); o0 = dot2bf(d.x, wo0[j], o0); o1 = dot2bf(d.y, wo1[j], o1); }
                const unsigned p0 = pk2(e0, o0), p1 = pk2(e1, o1); *(LAS v2u*)(F.lds + q * 4096 + tid * 8) = (v2u){p0, p1};
                const float re0 = bflo(p0), ro0 = bfhi(p0), re1 = bflo(p1), ro1 = bfhi(p1);
                const float se = wave_sum63(re0 + re1), qe = wave_sum63(re0 * re0 + re1 * re1), so = wave_sum63(ro0 + ro1), qo = wave_sum63(ro0 * ro0 + ro1 * ro1);
                if (lane == 63) { LAS float* st = stats + ((2 * q) * 8 + wave) * 2; st[0] = se; st[1] = qe; st[16] = so; st[17] = qo; }
            }
        }
        float av[4][16];
#pragma unroll
        for (int rr = 0; rr < 4; ++rr) { const int m = t0 + 4 * wave + rr;
            const GAS v4u* p1 = (const GAS v4u*)(O1 + (size_t)m * 1024) + 2 * lane; const GAS v4u* p2 = (const GAS v4u*)(O2 + (size_t)m * 1024) + 2 * lane;
            const v4u a0 = p1[0], a1 = p1[1], b0 = p2[0], b1 = p2[1];
            const unsigned aw[8] = {a0.x, a0.y, a0.z, a0.w, a1.x, a1.y, a1.z, a1.w}, bw[8] = {b0.x, b0.y, b0.z, b0.w, b1.x, b1.y, b1.z, b1.w};
            float ss = 0.f;
#pragma unroll
            for (int i = 0; i < 8; ++i) { av[rr][2 * i] = bflo(aw[i]) - lam * bflo(bw[i]); av[rr][2 * i + 1] = bfhi(aw[i]) - lam * bfhi(bw[i]); ss += av[rr][2 * i] * av[rr][2 * i] + av[rr][2 * i + 1] * av[rr][2 * i + 1]; }
            ss += __shfl_xor(ss, 1); ss += __shfl_xor(ss, 2); ss += __shfl_xor(ss, 4);
            const float r = (1.f - LAMBDA_INIT) / sqrtf(ss * (1.f / 128.f) + LN_EPS); float am = 0.f;
#pragma unroll
            for (int e = 0; e < 16; ++e) { av[rr][e] = av[rr][e] * r * subln_g[16 * (lane & 7) + e]; am = fmaxf(am, fabsf(av[rr][e])); }
            am = wave_max63(am);
            if (lane == 63) ama[4 * wave + rr] = am; }
        __syncthreads();
        if (tid < TT) { float s = 0.f, q = 0.f;
#pragma unroll
            for (int w = 0; w < 8; ++w) { s += stats[(tid * 8 + w) * 2]; q += stats[(tid * 8 + w) * 2 + 1]; }
            const float mean = s * (1.f / DCONV), var = fmaxf(q * (1.f / DCONV) - mean * mean, 0.f); ms[2 * tid] = mean; ms[2 * tid + 1] = 1.f / sqrtf(var + LN_EPS); }
        __syncthreads();
        for (int q = 0; q < TT / 2; ++q) {
            const f32x4 st = *(const LAS f32x4*)(ms + 4 * q);
            const v2u d = *(const LAS v2u*)(F.lds + q * 4096 + tid * 8);
            const float ye0 = (bflo(d.x) - st[0]) * st[1] * lg.x + lb.x, yo0 = (bfhi(d.x) - st[2]) * st[3] * lg.x + lb.x, ye1 = (bflo(d.y) - st[0]) * st[1] * lg.y + lb.y, yo1 = (bfhi(d.y) - st[2]) * st[3] * lg.y + lb.y;
#define SWISH_(y) ((y) * __builtin_amdgcn_rcpf(1.f + __builtin_amdgcn_exp2f(-1.4426950409f * (y))))
            const unsigned z0 = pk2(SWISH_(ye0), SWISH_(yo0)), z1 = pk2(SWISH_(ye1), SWISH_(yo1));
#undef SWISH_
            *(LAS v2u*)(F.lds + q * 4096 + tid * 8) = (v2u){z0, z1};
            const float me = wave_max63(fmaxf(fabsf(bflo(z0)), fabsf(bflo(z1)))), mo = wave_max63(fmaxf(fabsf(bfhi(z0)), fabsf(bfhi(z1))));
            if (lane == 63) { amc[(2 * q) * 8 + wave] = me; amc[(2 * q + 1) * 8 + wave] = mo; }
        }
        __syncthreads();
        if (tid < TT) { float am = ama[tid];
#pragma unroll
            for (int w = 0; w < 8; ++w) am = fmaxf(am, amc[tid * 8 + w]);
            const float sc = am > 0.f ? am * (1.f / 127.f) : 1.f; invs[tid] = 1.f / sc; SM[t0 + tid] = sc; }
        __syncthreads();
        for (int q = 0; q < TT / 2; ++q) {
            const float ie = invs[2 * q], io = invs[2 * q + 1];
            const v2u d = *(const LAS v2u*)(F.lds + q * 4096 + tid * 8);
            const int qe0 = (int)rintf(bflo(d.x) * ie), qe1 = (int)rintf(bflo(d.y) * ie), qo0 = (int)rintf(bfhi(d.x) * io), qo1 = (int)rintf(bfhi(d.y) * io);
            *(LAS unsigned short*)(F.lds + STG_OFF + (2 * q) * 1024 + 2 * tid) = (unsigned short)((qe0 & 255) | ((qe1 & 255) << 8));
            *(LAS unsigned short*)(F.lds + STG_OFF + (2 * q + 1) * 1024 + 2 * tid) = (unsigned short)((qo0 & 255) | ((qo1 & 255) << 8));
        }
#pragma unroll
        for (int rr = 0; rr < 4; ++rr) { const float inv = invs[4 * wave + rr];
            *((GAS v4u*)(MIX8 + (size_t)(t0 + 4 * wave + rr) * D) + lane) = (v4u){pack_i8x4(av[rr][0] * inv, av[rr][1] * inv, av[rr][2] * inv, av[rr][3] * inv), pack_i8x4(av[rr][4] * inv, av[rr][5] * inv, av[rr][6] * inv, av[rr][7] * inv),
                                                                              pack_i8x4(av[rr][8] * inv, av[rr][9] * inv, av[rr][10] * inv, av[rr][11] * inv), pack_i8x4(av[rr][12] * inv, av[rr][13] * inv, av[rr][14] * inv, av[rr][15] * inv)}; }
        __syncthreads();
        for (int idx = tid; idx < TT * 64; idx += NWAVES * 64) { const int row = idx >> 6, ch = idx & 63;
            *((GAS v4u*)(MIX8 + (size_t)(t0 + row) * D + DATT) + ch) = *(const LAS v4u*)(F.lds + STG_OFF + row * 1024 + ch * 16); }
        __syncthreads();
    }
}
__device__ __forceinline__ void p5_ln1(Frame& F) {
    const bf16* Y1 = F.ws<bf16>(WS_Y1); const float* ln1_g = F.in(I_LN1G); const float* ln1_b = F.in(I_LN1B); unsigned char* X8 = F.ws<unsigned char>(WS_X8); float* SX = F.ws<float>(WS_SX); float* LNS = F.ws<float>(WS_LNS);
    const int gw = F.vcu_() * NWAVES + F.wave_(), NGW = F.G_() * NWAVES, lane = F.lane();
    v4u nx[4];
    if (gw < M) { const GAS v4u* p = (const GAS v4u*)(Y1 + (size_t)gw * D) + lane;
#pragma unroll
        for (int j = 0; j < 4; ++j) nx[j] = p[64 * j]; }
    for (int m = gw; m < M; m += NGW) {
        v4u w[4]; float v[32]; float s = 0.f;
#pragma unroll
        for (int j = 0; j < 4; ++j) w[j] = nx[j];
        { const int mn = (m + NGW < M) ? m + NGW : m; const GAS v4u* p = (const GAS v4u*)(Y1 + (size_t)mn * D) + lane;
#pragma unroll
          for (int j = 0; j < 4; ++j) nx[j] = p[64 * j]; }
#pragma unroll
        for (int j = 0; j < 4; ++j) { const unsigned ww[4] = {w[j].x, w[j].y, w[j].z, w[j].w};
#pragma unroll
            for (int i = 0; i < 4; ++i) { v[8 * j + 2 * i] = bflo(ww[i]); v[8 * j + 2 * i + 1] = bfhi(ww[i]); s += v[8 * j + 2 * i] + v[8 * j + 2 * i + 1]; } }
        const float mean = wave_sum(s) * (1.f / D); float q = 0.f;
#pragma unroll
        for (int i = 0; i < 32; ++i) { v[i] -= mean; q += v[i] * v[i]; }
        const float rstd = 1.f / sqrtf(wave_sum(q) * (1.f / D) + LN_EPS);
        float am = 0.f;
#pragma unroll
        for (int j = 0; j < 4; ++j) { const int c0 = 8 * lane + 512 * j; const f32x4 g0 = *(const f32x4*)(ln1_g + c0), g1 = *(const f32x4*)(ln1_g + c0 + 4), b0 = *(const f32x4*)(ln1_b + c0), b1 = *(const f32x4*)(ln1_b + c0 + 4);
#pragma unroll
            for (int i = 0; i < 4; ++i) { v[8 * j + i] = v[8 * j + i] * rstd * g0[i] + b0[i]; v[8 * j + 4 + i] = v[8 * j + 4 + i] * rstd * g1[i] + b1[i]; am = fmaxf(am, fmaxf(fabsf(v[8 * j + i]), fabsf(v[8 * j + 4 + i]))); } }
#pragma unroll
        for (int o = 1; o < 64; o <<= 1) am = fmaxf(am, __shfl_xor(am, o));
        const float sc = am > 0.f ? am * (1.f / 127.f) : 1.f, inv = 1.f / sc;
        GAS v2u* p8 = (GAS v2u*)(X8 + (size_t)m * D) + lane;
#pragma unroll
        for (int j = 0; j < 4; ++j) p8[64 * j] = (v2u){pack_i8x4(v[8 * j] * inv, v[8 * j + 1] * inv, v[8 * j + 2] * inv, v[8 * j + 3] * inv), pack_i8x4(v[8 * j + 4] * inv, v[8 * j + 5] * inv, v[8 * j + 6] * inv, v[8 * j + 7] * inv)};
        if (lane == 0) { SX[m] = sc; LNS[2 * m] = mean; LNS[2 * m + 1] = rstd; }
    }
}
__device__ __forceinline__ int f2key(float f) { const int b = __float_as_int(f); return b ^ ((b >> 31) & 0x7fffffff); }
__device__ __forceinline__ float key2f(int k) { return __int_as_float(k ^ ((k >> 31) & 0x7fffffff)); }
#define CE_DESC(a, b) do { const int _x = max(a, b), _y = min(a, b); a = _x; b = _y; } while (0)
#define CE_ASC(a, b)  do { const int _x = min(a, b), _y = max(a, b); a = _x; b = _y; } while (0)
template <int N> __device__ __forceinline__ void sort_desc(int (&v)[N]) {
#pragma unroll
    for (int k = 2; k <= N; k <<= 1)
#pragma unroll
        for (int j = k >> 1; j > 0; j >>= 1)
#pragma unroll
            for (int i = 0; i < N; ++i) { const int l = i ^ j; if (l > i) { if ((i & k) == 0) CE_DESC(v[i], v[l]); else CE_ASC(v[i], v[l]); } }
}
template <int N> __device__ __forceinline__ void bitonic_merge_desc(int (&v)[N]) {
#pragma unroll
    for (int j = N >> 1; j > 0; j >>= 1)
#pragma unroll
        for (int i = 0; i < N; ++i) { const int l = i ^ j; if (l > i) CE_DESC(v[i], v[l]); }
}
__device__ __forceinline__ void merge16(const int (&a)[16], const int (&b)[16], int (&o)[16]) {
#pragma unroll
    for (int i = 0; i < 16; ++i) o[i] = max(a[i], b[15 - i]);
    bitonic_merge_desc<16>(o);
}
__device__ __forceinline__ void top16_of_64(const int (&v)[64], int (&o)[16]) {
    int g0[16], g1[16], g2[16], g3[16];
#pragma unroll
    for (int i = 0; i < 16; ++i) { g0[i] = v[i]; g1[i] = v[16 + i]; g2[i] = v[32 + i]; g3[i] = v[48 + i]; }
    sort_desc<16>(g0); sort_desc<16>(g1); sort_desc<16>(g2); sort_desc<16>(g3);
    int m0[16], m1[16]; merge16(g0, g1, m0); merge16(g2, g3, m1); merge16(m0, m1, o);
}
__device__ const unsigned char PEER_PAIR[64] = {0,1,2,3,4,5,6,7,8,9,10,11,12,13,14,15, 16,17,18,19,20,21,22,23, 32,33,34,35,36, 48,49,50,51, 64,65,66, 80,81, 96,97, 112,113, 128,144,160,176,192,208,224,240, 0,0,0,0,0,0,0,0,0,0,0,0,0,0};
__device__ __forceinline__ void peer_subkey_top16(const bf16* qrow  , const bf16* keys_hc  , int r32, int hi, int (&o)[16]) {
    bf16x8 bq[8];
    asm volatile("" : "+v"(qrow));
#pragma unroll
    for (int s = 0; s < 8; ++s) bq[s] = *(const bf16x8*)(qrow + 8 * s);
    int run[16];
#pragma unroll
    for (int mt = 0; mt < 4; ++mt) {
        const bf16* krow = keys_hc + (size_t)(32 * mt + r32) * PHALF + hi * 64;
        asm volatile("" : "+v"(krow));
        bf16x8 ka[8];
#pragma unroll
        for (int s = 0; s < 8; ++s) ka[s] = *(const bf16x8*)(krow + 8 * s);
#ifdef PEER_A_FENCE
        asm volatile("" ::: "memory");
#endif
        f32x16 acc = {};
#pragma unroll
        for (int s = 0; s < 8; ++s) acc = __builtin_amdgcn_mfma_f32_32x32x16_bf16(ka[s], bq[s], acc, 0, 0, 0);
        int g[16];
#pragma unroll
        for (int r = 0; r < 16; ++r) g[r] = (f2key(acc[r]) & ~127) | ((r & 3) + 8 * (r >> 2));
        sort_desc<16>(g);
        if (mt) {
#pragma unroll
            for (int r = 0; r < 16; ++r) g[r] |= 32 * mt; }
        if (mt == 0) {
#pragma unroll
            for (int r = 0; r < 16; ++r) run[r] = g[r];
        } else { int t2[16]; merge16(run, g, t2);
#pragma unroll
            for (int r = 0; r < 16; ++r) run[r] = t2[r]; }
    }
    int lo[16], hh[16]; const int hi4 = 4 * hi;
#pragma unroll
    for (int i = 0; i < 16; ++i) { run[i] |= hi4; auto rr = __builtin_amdgcn_permlane32_swap((unsigned)run[i], (unsigned)run[i], false, false); lo[i] = (int)rr[0]; hh[i] = (int)rr[1]; }
    merge16(lo, hh, o);
}
__device__ __forceinline__ float gelu_erf(float v) { return 0.5f * v * (1.f + erff(v * 0.70710678118654752f)); }

typedef float f32x2 __attribute__((ext_vector_type(2)));
constexpr int P7_W8 = 98304, P7_SW = 114688;
constexpr int P7_ACT = 0, P7_EID = 65536, P7_SCR = 0  , P7_SCR_WAVE = 32 * 33 * 4, PCH = 128, NCH = D / PCH;
static_assert(P7_SCR + NWAVES * P7_SCR_WAVE <= P7_EID && P7_EID + 128 * 128 * 2 <= RING_BYTES, "PEER LDS map");

__device__ __forceinline__ void p7_peer(Frame& F) {
    const int lane = F.lane(), r32 = lane & 31, hi = lane >> 5, j8 = lane & 7, g8 = lane >> 3;
    constexpr int TPB = 128;
    LAS float* ACT = (LAS float*)(F.lds + P7_ACT); LAS unsigned short* EIDL = (LAS unsigned short*)(F.lds + P7_EID);
    LAS int* scr = (LAS int*)(F.lds + P7_SCR + F.wave_() * P7_SCR_WAVE);
    for (int blk = F.vcu_(); blk < M / TPB; blk += F.G_()) {
        const int m0 = blk * TPB;
        { const int h = F.wave_(); const bf16* QP = F.ws<bf16>(WS_QP); const bf16* KEYS = F.ws<bf16>(WS_KEYS); float* GATE = F.ws<float>(WS_GATE);
          for (int tt = 0; tt < 4; ++tt) {
            const int tl = 32 * tt + r32, tok = m0 + tl;
            const bf16* qrow = QP + (size_t)tok * D + h * 256 + hi * 64;
            int s1[16], s2[16];
            peer_subkey_top16(qrow, KEYS + (size_t)(h * 2 + 0) * PNK * PHALF, r32, hi, s1);
            asm volatile("" ::: "memory");
            peer_subkey_top16(qrow + 128, KEYS + (size_t)(h * 2 + 1) * PNK * PHALF, r32, hi, s2);
            float f1[16], f2[16];
#pragma unroll
            for (int i = 0; i < 16; ++i) { f1[i] = key2f(s1[i]); f2[i] = key2f(s2[i]); }
            if (hi == 0) {
#pragma unroll
                for (int i = 0; i < 16; ++i) { scr[r32 * 33 + i] = s1[i] & 127; scr[r32 * 33 + 16 + i] = s2[i] & 127; } }
            int cand[64];
            {
#define PC(n_, i_, j_) cand[n_] = (f2key(f1[i_] + f2[j_]) & ~255) | (n_)
                PC(0,0,0); PC(1,0,1); PC(2,0,2); PC(3,0,3); PC(4,0,4); PC(5,0,5); PC(6,0,6); PC(7,0,7); PC(8,0,8); PC(9,0,9); PC(10,0,10); PC(11,0,11); PC(12,0,12); PC(13,0,13); PC(14,0,14); PC(15,0,15);
                PC(16,1,0); PC(17,1,1); PC(18,1,2); PC(19,1,3); PC(20,1,4); PC(21,1,5); PC(22,1,6); PC(23,1,7);
                PC(24,2,0); PC(25,2,1); PC(26,2,2); PC(27,2,3); PC(28,2,4);
                PC(29,3,0); PC(30,3,1); PC(31,3,2); PC(32,3,3);
                PC(33,4,0); PC(34,4,1); PC(35,4,2);
                PC(36,5,0); PC(37,5,1); PC(38,6,0); PC(39,6,1); PC(40,7,0); PC(41,7,1);
                PC(42,8,0); PC(43,9,0); PC(44,10,0); PC(45,11,0); PC(46,12,0); PC(47,13,0); PC(48,14,0); PC(49,15,0);
#undef PC
            }
#pragma unroll
            for (int i = 50; i < 64; ++i) cand[i] = (int)0x80000000;
            int sc[16]; top16_of_64(cand, sc);
            float p[16]; const float mx = key2f(sc[0]); float z = 0.f;
#pragma unroll
            for (int k = 0; k < 16; ++k) { p[k] = __expf(key2f(sc[k]) - mx); z += p[k]; }
            const float rz = 1.f / z;
            LDS_WAIT();
            int eo[8]; float go[8]; const int him = -hi;
#pragma unroll
            for (int kk = 0; kk < 8; ++kk) { const int tag = PEER_PAIR[((sc[kk] & ~him) | (sc[8 + kk] & him)) & 255];
                const int i1 = scr[r32 * 33 + (tag >> 4)], i2 = scr[r32 * 33 + 16 + (tag & 15)];
                eo[kk] = i1 * PNK + i2; go[kk] = __int_as_float((__float_as_int(p[kk]) & ~him) | (__float_as_int(p[8 + kk]) & him)) * rz; }
            *(LAS v4u*)(EIDL + tl * 128 + h * 16 + 8 * hi) = (v4u){(unsigned)(eo[0] | (eo[1] << 16)), (unsigned)(eo[2] | (eo[3] << 16)), (unsigned)(eo[4] | (eo[5] << 16)), (unsigned)(eo[6] | (eo[7] << 16))};
            GAS float* gp = (GAS float*)(GATE + (size_t)tok * 128 + h * 16 + 8 * hi);
            *(GAS f32x4*)gp = (f32x4){go[0], go[1], go[2], go[3]}; *(GAS f32x4*)(gp + 4) = (f32x4){go[4], go[5], go[6], go[7]};
            LDS_WAIT();
          } }
        __threadfence_block(); __syncthreads();
        const int tw = F.wave_() * (TPB / NWAVES);
        for (int i = lane; i < (TPB / NWAVES) * 128; i += 64) ACT[tw * 128 + i] = 0.f;
        { const unsigned char* X8 = F.ws<unsigned char>(WS_X8); const unsigned char* U8 = F.ws<unsigned char>(WS_U8);
#define U_ISSUE(n_, PC, XQ) do { const int c_ = (n_) >> 4, tl_ = tw + ((n_) & 15); \
            XQ = *(const GAS v4u*)(X8 + (size_t)(m0 + tl_) * D + c_ * PCH + 16 * j8); \
            const LAS unsigned short* ep_ = EIDL + tl_ * 128 + g8; const unsigned char* ub_ = U8 + (size_t)c_ * (NEXP * PCH) + 16 * j8; \
            _Pragma("unroll") for (int i = 0; i < 16; ++i) { const unsigned e_ = ep_[8 * i]; PC[i] = *(const GAS v4u*)(ub_ + e_ * PCH); } } while (0)
#define U_COMPUTE(n_, PC, XQ) do { const int tl_ = tw + ((n_) & 15); \
            int pp_[16]; \
            _Pragma("unroll") for (int i = 0; i < 16; ++i) { int a_ = __builtin_amdgcn_sdot4((int)PC[i].x, (int)XQ.x, 0, false); a_ = __builtin_amdgcn_sdot4((int)PC[i].y, (int)XQ.y, a_, false); \
                a_ = __builtin_amdgcn_sdot4((int)PC[i].z, (int)XQ.z, a_, false); pp_[i] = __builtin_amdgcn_sdot4((int)PC[i].w, (int)XQ.w, a_, false); } \
              \
            int q8_[8], q4_[4], q2_[2]; \
            { const bool b2_ = lane & 4; _Pragma("unroll") for (int i = 0; i < 8; ++i) { const int k_ = b2_ ? pp_[2 * i + 1] : pp_[2 * i], s_ = b2_ ? pp_[2 * i] : pp_[2 * i + 1]; q8_[i] = k_ + dppi<0x141>(s_); } } \
            { const bool b1_ = lane & 2; _Pragma("unroll") for (int i = 0; i < 4; ++i) { const int k_ = b1_ ? q8_[2 * i + 1] : q8_[2 * i], s_ = b1_ ? q8_[2 * i] : q8_[2 * i + 1]; q4_[i] = k_ + dppi<0x4E>(s_); } } \
            { const bool b0_ = lane & 1; _Pragma("unroll") for (int i = 0; i < 2; ++i) { const int k_ = b0_ ? q4_[2 * i + 1] : q4_[2 * i], s_ = b0_ ? q4_[2 * i] : q4_[2 * i + 1]; q2_[i] = k_ + dppi<0xB1>(s_); } } \
            const int irow_ = ((lane & 1) << 2) | (lane & 2) | ((lane >> 2) & 1); \
            LAS float* ap_ = ACT + tl_ * 128 + 8 * irow_ + g8; ap_[0] += (float)q2_[0]; ap_[64] += (float)q2_[1]; } while (0)
          constexpr int NSTEP = NCH * (TPB / NWAVES);
          v4u pcA[16], pcB[16], xqA, xqB;
          U_ISSUE(0, pcA, xqA);
          for (int n = 0; n < NSTEP; n += 2) {
              U_ISSUE(n + 1, pcB, xqB); __builtin_amdgcn_sched_barrier(0);
              U_COMPUTE(n, pcA, xqA); __builtin_amdgcn_sched_barrier(0);
              { const int nn = (n + 2 < NSTEP) ? n + 2 : n; U_ISSUE(nn, pcA, xqA); }
              __builtin_amdgcn_sched_barrier(0);
              U_COMPUTE(n + 1, pcB, xqB); __builtin_amdgcn_sched_barrier(0);
          }
#undef U_ISSUE
#undef U_COMPUTE
        }
        LDS_WAIT();
        { const float* SU = F.ws<float>(WS_SU); const float* SV = F.ws<float>(WS_SV); const float* GATE = F.ws<float>(WS_GATE); const float* SX = F.ws<float>(WS_SX);
        LAS unsigned char* W8L = (LAS unsigned char*)(F.lds + P7_W8); LAS float* SWL = (LAS float*)(F.lds + P7_SW);
        for (int ti = 0; ti < TPB / NWAVES; ++ti) {
            const int tl = tw + ti, t = m0 + tl; const float sx = SX[t]; float wv[2];
#pragma unroll
            for (int kq = 0; kq < 2; ++kq) { const int k = lane + 64 * kq; const unsigned e = EIDL[tl * 128 + k]; const float a = ACT[tl * 128 + k] * SU[e] * sx;
                wv[kq] = __builtin_nontemporal_load(GATE + (size_t)t * 128 + k) * gelu_erf(a) * SV[e]; }
            float am = fmaxf(fabsf(wv[0]), fabsf(wv[1]));
#pragma unroll
            for (int o = 1; o < 64; o <<= 1) am = fmaxf(am, __shfl_xor(am, o));
            const float sc = am > 0.f ? am * (1.f / 127.f) : 1.f, inv = 1.f / sc;
#pragma unroll
            for (int kq = 0; kq < 2; ++kq) { const int k = lane + 64 * kq; W8L[tl * 128 + (k & 7) * 16 + (k >> 3)] = (unsigned char)((int)rintf(wv[kq] * inv) & 255); }
            if (lane == 0) SWL[tl] = sc;
        } }
        LDS_WAIT();
        { const bf16* X1 = F.ws<bf16>(WS_Y1); const unsigned char* V8 = F.ws<unsigned char>(WS_V8); bf16* Y2 = F.ws<bf16>(WS_QP); const float* LNS = F.ws<float>(WS_LNS); const float* ln1_g = F.in(I_LN1G); const float* ln1_b = F.in(I_LN1B);
#define V_ISSUE(n_, PC, WQ, XP) do { const int c_ = (n_) >> 4, tl_ = tw + ((n_) & 15); \
            const LAS unsigned short* ep_ = EIDL + tl_ * 128 + g8; const unsigned char* vb_ = V8 + (size_t)c_ * (NEXP * PCH) + 16 * j8; \
            _Pragma("unroll") for (int i = 0; i < 16; ++i) { const unsigned e_ = ep_[8 * i]; PC[i] = *(const GAS v4u*)(vb_ + e_ * PCH); } \
            WQ = *(const LAS v4u*)(F.lds + P7_W8 + tl_ * 128 + g8 * 16); \
            XP = *(const GAS unsigned*)(X1 + (size_t)(m0 + tl_) * D + c_ * PCH + 16 * j8 + 2 * g8); } while (0)
#define V_COMPUTE(n_, PC, WQ, XP) do { const int c_ = (n_) >> 4, tl_ = tw + ((n_) & 15); \
            int ac_[16]; \
            _Pragma("unroll") for (int d = 0; d < 16; ++d) ac_[d] = 0; \
            const unsigned wq_[4] = {WQ.x, WQ.y, WQ.z, WQ.w}; \
            _Pragma("unroll") for (int gq = 0; gq < 4; ++gq) { \
                const unsigned pa_[4] = {PC[4 * gq].x, PC[4 * gq].y, PC[4 * gq].z, PC[4 * gq].w}, pb_[4] = {PC[4 * gq + 1].x, PC[4 * gq + 1].y, PC[4 * gq + 1].z, PC[4 * gq + 1].w}; \
                const unsigned pc_[4] = {PC[4 * gq + 2].x, PC[4 * gq + 2].y, PC[4 * gq + 2].z, PC[4 * gq + 2].w}, pd_[4] = {PC[4 * gq + 3].x, PC[4 * gq + 3].y, PC[4 * gq + 3].z, PC[4 * gq + 3].w}; \
                _Pragma("unroll") for (int m = 0; m < 4; ++m) { \
                    const unsigned t0_ = __builtin_amdgcn_perm(pb_[m], pa_[m], 0x05010400u), t1_ = __builtin_amdgcn_perm(pb_[m], pa_[m], 0x07030602u), t2_ = __builtin_amdgcn_perm(pd_[m], pc_[m], 0x05010400u), t3_ = __builtin_amdgcn_perm(pd_[m], pc_[m], 0x07030602u); \
                    ac_[4 * m + 0] = __builtin_amdgcn_sdot4((int)__builtin_amdgcn_perm(t2_, t0_, 0x05040100u), (int)wq_[gq], ac_[4 * m + 0], false); \
                    ac_[4 * m + 1] = __builtin_amdgcn_sdot4((int)__builtin_amdgcn_perm(t2_, t0_, 0x07060302u), (int)wq_[gq], ac_[4 * m + 1], false); \
                    ac_[4 * m + 2] = __builtin_amdgcn_sdot4((int)__builtin_amdgcn_perm(t3_, t1_, 0x05040100u), (int)wq_[gq], ac_[4 * m + 2], false); \
                    ac_[4 * m + 3] = __builtin_amdgcn_sdot4((int)__builtin_amdgcn_perm(t3_, t1_, 0x07060302u), (int)wq_[gq], ac_[4 * m + 3], false); } } \
              \
            int r8_[8], r4_[4], r2_[2]; \
            _Pragma("unroll") for (int i = 0; i < 8; ++i) { auto rr_ = __builtin_amdgcn_permlane32_swap((unsigned)ac_[i], (unsigned)ac_[i + 8], false, false); r8_[i] = (int)rr_[0] + (int)rr_[1]; } \
            _Pragma("unroll") for (int i = 0; i < 4; ++i) { auto rr_ = __builtin_amdgcn_permlane16_swap((unsigned)r8_[i], (unsigned)r8_[i + 4], false, false); r4_[i] = (int)rr_[0] + (int)rr_[1]; } \
            { const bool b3_ = lane & 8; _Pragma("unroll") for (int i = 0; i < 2; ++i) { const int k_ = b3_ ? r4_[i + 2] : r4_[i], s_ = b3_ ? r4_[i] : r4_[i + 2]; r2_[i] = k_ + dppi<0x128>(s_); } } \
            const float sw_ = ((const LAS float*)(F.lds + P7_SW))[tl_]; \
            const f32x2 ms_ = *(const f32x2*)(LNS + 2 * (size_t)(m0 + tl_)), gg_ = *(const f32x2*)(ln1_g + c_ * PCH + 16 * j8 + 2 * g8), bb_ = *(const f32x2*)(ln1_b + c_ * PCH + 16 * j8 + 2 * g8); \
            const float x0_ = (bflo(XP) - ms_.x) * ms_.y * gg_.x + bb_.x, x1_ = (bfhi(XP) - ms_.x) * ms_.y * gg_.y + bb_.y; \
            *(GAS unsigned*)(Y2 + (size_t)(m0 + tl_) * D + c_ * PCH + 16 * j8 + 2 * g8) = pk2((float)r2_[0] * sw_ + DN_ALPHA * x0_, (float)r2_[1] * sw_ + DN_ALPHA * x1_); } while (0)
          constexpr int NSTEP = NCH * (TPB / NWAVES);
          v4u pcA[16], pcB[16], wqA, wqB; unsigned xpA, xpB;
          V_ISSUE(0, pcA, wqA, xpA);
          for (int n = 0; n < NSTEP; n += 2) {
              V_ISSUE(n + 1, pcB, wqB, xpB); __builtin_amdgcn_sched_barrier(0);
              V_COMPUTE(n, pcA, wqA, xpA); __builtin_amdgcn_sched_barrier(0);
              { const int nn = (n + 2 < NSTEP) ? n + 2 : n; V_ISSUE(nn, pcA, wqA, xpA); }
              __builtin_amdgcn_sched_barrier(0);
              V_COMPUTE(n + 1, pcB, wqB, xpB); __builtin_amdgcn_sched_barrier(0);
          }
#undef V_ISSUE
#undef V_COMPUTE
        }
        { const float* ln2_g = F.in(I_LN2G); const float* ln2_b = F.in(I_LN2B); float* outp = F.outp(); const bf16* Y2 = F.ws<bf16>(WS_QP);
        for (int ti = 0; ti < TPB / NWAVES; ++ti) {
            const int t = m0 + tw + ti;
            const GAS v4u* yp = (const GAS v4u*)(Y2 + (size_t)t * D) + lane;
            float v[32]; float s = 0.f;
#pragma unroll
            for (int j = 0; j < 4; ++j) { const v4u w = yp[64 * j]; const unsigned ww[4] = {w.x, w.y, w.z, w.w};
#pragma unroll
                for (int i = 0; i < 4; ++i) { v[8 * j + 2 * i] = bflo(ww[i]); v[8 * j + 2 * i + 1] = bfhi(ww[i]); s += v[8 * j + 2 * i] + v[8 * j + 2 * i + 1]; } }
            const float mean = wave_sum(s) * (1.f / D); float qv = 0.f;
#pragma unroll
            for (int i = 0; i < 32; ++i) { v[i] -= mean; qv += v[i] * v[i]; }
            const float rstd = 1.f / sqrtf(wave_sum(qv) * (1.f / D) + LN_EPS);
#pragma unroll
            for (int j = 0; j < 4; ++j) { const int c0 = 8 * lane + 512 * j; const f32x4 g0 = *(const f32x4*)(ln2_g + c0), g1 = *(const f32x4*)(ln2_g + c0 + 4), b0 = *(const f32x4*)(ln2_b + c0), b1 = *(const f32x4*)(ln2_b + c0 + 4);
                f32x4 r0, r1;
#pragma unroll
                for (int i = 0; i < 4; ++i) { r0[i] = v[8 * j + i] * rstd * g0[i] + b0[i]; r1[i] = v[8 * j + 4 + i] * rstd * g1[i] + b1[i]; }
                GAS f32x4* op = (GAS f32x4*)(outp + (size_t)t * D + c0); op[0] = r0; op[1] = r1; }
        } }
        __syncthreads();
    }
}

struct Args { const float* in[22]; float* out; unsigned char* ws; int ph_lo, ph_hi; };
__global__ void __launch_bounds__(NWAVES * 64, 2) mk_fwd(Args args) {
    extern __shared__ __attribute__((aligned(16))) unsigned char lds[];
    cg::grid_group grid = cg::this_grid();
    Frame F;
    F.lds = (LAS unsigned char*)lds;
    if (threadIdx.x == 0) { LAS unsigned long long* PT = (LAS unsigned long long*)(F.lds + RING_BYTES);
#pragma unroll
        for (int k = 0; k < 22; ++k) PT[k] = (unsigned long long)args.in[k];
        PT[22] = (unsigned long long)args.out; PT[23] = (unsigned long long)args.ws;
        ((LAS unsigned*)(F.lds + RING_BYTES + 256))[0] = 0u; ((LAS unsigned*)(F.lds + RING_BYTES + 256))[1] = 0u; }
    __syncthreads();
    const int lo = args.ph_lo, hi = args.ph_hi;
#ifndef PHASE_MASK
#define PHASE_MASK 255
#endif
#define IN(k) (((PHASE_MASK >> (k)) & 1) && lo <= (k) && (k) < hi)
#ifndef REPEAT_PHASE
#define REPEAT_PHASE -1
#endif
#define REP(k) for (int rep_ = 0; rep_ < ((REPEAT_PHASE == (k)) ? 2 : 1); ++rep_)
    (void)xcd_barrier_post((unsigned*)args.ws, (volatile LAS unsigned*)(F.lds + RING_BYTES + 256));
#define XBAR() do { XcdBarrier bar_; bar_.bar = F.ws<unsigned>(0); bar_.x = xb_xcc_id(); bar_.st = (volatile LAS unsigned*)(F.lds + RING_BYTES + 256); xcd_barrier(bar_); } while (0)
#define SEAM(k) do { if (IN(k) && IN((k) + 1)) XBAR(); } while (0)

    if (lo < 0) grid.sync();
    if (IN(0)) REP(0) { p0a_prologue(F); XBAR(); p0b_prologue(F); } SEAM(0);
    if (IN(1)) REP(1) {
        pg8::Gemm g{F.ws<bf16>(WS_XB), F.ws<bf16>(WS_WIN), M, NPROJ, D / 2}; pg8::StaticOrder S; S.init(M, NPROJ, F.G_(), (int)blockIdx.x);
        pg8::EpiProjI8 E{F.ws<bf16>(WS_Q), (size_t)(WS_K - WS_Q) / 2, attn_body::C2, F.ws<bf16>(WS_H), F.in(I_BGLU), F.ws<float>(WS_SXA), F.ws<float>(WS_SWIN)};
        pg8::gemm_phase<pg8::EpiProjI8, pg8::StaticOrder, PG8_ALIGN, PG8_SP2>(F.lds, g, S, E);
    } SEAM(1);
    if (IN(2)) REP(2) {
        static_assert(dattn::LDS_BYTES <= RING_BYTES, "attention body geometry vs frame");
        const dattn::Tensors AT{F.ws<const dattn::bf16>(WS_Q), F.ws<const dattn::bf16>(WS_K), F.ws<const dattn::bf16>(WS_V), F.ws<dattn::bf16>(WS_O1), F.ws<dattn::bf16>(WS_O2), F.ws<const float>(WS_TAB)};
        dattn::phase((char*)lds, AT, F.vcu_());
    } SEAM(2);
    if (IN(3)) REP(3) { p3_mix(F); } SEAM(3);
    if (IN(4)) REP(4) {
        pg8::Gemm g{F.ws<bf16>(WS_XB), F.ws<bf16>(WS_WOUT), M, D, D / 2}; pg8::StaticOrder S; S.init(M, D, F.G_(), (int)blockIdx.x);
        pg8::EpiResI8 E{F.in(I_X), F.ws<bf16>(WS_Y1), D, DN_ALPHA, F.ws<float>(WS_SM), F.ws<float>(WS_SWOUT)};
        pg8::gemm_phase<pg8::EpiResI8, pg8::StaticOrder, PG8_ALIGN, PG8_SP2>(F.lds, g, S, E);
    } SEAM(4);
    if (IN(5)) REP(5) { p5_ln1(F); } SEAM(5);
    if (IN(6)) REP(6) {
        pg8::Gemm g{F.ws<bf16>(WS_X8), F.ws<bf16>(WS_WQ), M, D, D / 2}; pg8::StaticOrder S; S.init(M, D, F.G_(), (int)blockIdx.x);
        pg8::EpiPlainI8 E{F.ws<bf16>(WS_QP), D, F.ws<float>(WS_SX), F.ws<float>(WS_SWQ)};
        pg8::gemm_phase<pg8::EpiPlainI8, pg8::StaticOrder, PG8_ALIGN, PG8_SP2>(F.lds, g, S, E);
    } SEAM(6);
    if (IN(7)) REP(7) { p7_peer(F); }
#undef IN
#undef SEAM
}

extern "C" void kernel_launch(void* const* d_in, const int* in_sizes, int n_in, void* d_out, int out_size, void* d_ws, size_t ws_size, hipStream_t stream) {
    static int grid = 0;
    if (grid == 0) {
        if (n_in != 22 || in_sizes[0] != M * D || out_size != M * D || ws_size < WS_END) { fprintf(stderr, "kernel_launch: unexpected shapes (n_in %d, in0 %d, out %d, ws %zu); nothing launched\n", n_in, n_in > 0 ? in_sizes[0] : -1, out_size, ws_size); grid = -1; return; }
        int dev = 0, cus = 0, per_cu = 0;
        if (hipGetDevice(&dev) != hipSuccess || hipDeviceGetAttribute(&cus, hipDeviceAttributeMultiprocessorCount, dev) != hipSuccess) { grid = -1; return; }
        if (hipFuncSetAttribute((const void*)mk_fwd, hipFuncAttributeMaxDynamicSharedMemorySize, LDS_BYTES) != hipSuccess) { fprintf(stderr, "kernel_launch: hipFuncSetAttribute failed\n"); grid = -1; return; }
        if (hipOccupancyMaxActiveBlocksPerMultiprocessor(&per_cu, (const void*)mk_fwd, NWAVES * 64, LDS_BYTES) != hipSuccess || per_cu < 1) { fprintf(stderr, "kernel_launch: occupancy query reports %d workgroups per CU\n", per_cu); (void)hipGetLastError(); grid = -1; return; }
        grid = cus;
        if (grid > 256) grid = 256;
    }
    if (grid < 0) return;
    if (hipMemsetAsync(d_ws, 0, 65536, stream) != hipSuccess) { fprintf(stderr, "kernel_launch: hipMemsetAsync failed\n"); return; }
    Args a{};
    for (int i = 0; i < 22; ++i) a.in[i] = (const float*)d_in[i];
    a.out = (float*)d_out; a.ws = (unsigned char*)d_ws;
    constexpr int NL = MK_N_LAUNCHES;
    for (int li = 0; li < NL; ++li) {
        a.ph_lo = (NL == 1) ? 0 : li; a.ph_hi = (NL == 1) ? N_PHASES : li + 1;
        void* kargs[] = {&a};
        const hipError_t le = hipLaunchCooperativeKernel((const void*)mk_fwd, dim3(grid), dim3(NWAVES * 64), kargs, LDS_BYTES, stream);
        if (le != hipSuccess) { fprintf(stderr, "kernel_launch: cooperative launch %d failed: %s (grid %d)\n", li, hipGetErrorString(le), grid); break; }
    }
}
```

```cpp
#include <hip/hip_runtime.h>
#include <hip/hip_cooperative_groups.h>
#include <cstdio>
#include <cstdint>
namespace cg = cooperative_groups;
namespace pg8 {
#define PG8_LAS __attribute__((address_space(3)))
typedef unsigned short bf16_t;
typedef short bf16x8 __attribute__((ext_vector_type(8)));
typedef float f32x4 __attribute__((ext_vector_type(4)));
typedef unsigned u32x4 __attribute__((ext_vector_type(4)));
typedef int i32x4 __attribute__((ext_vector_type(4)));
constexpr int BM = 256, BK = 64, HALF = 128, HTB = HALF * BK * 2  , STAGE_BYTES = 8 * HTB, NXCD = 8, WGM = 8;

__host__ __device__ __forceinline__ int lds_byte(int r, int c) { const int st = (r >> 4) * 2 + (c >> 5), rr = r & 15, cc = c & 31, ob = rr * 64 + cc * 2; return st * 1024 + (ob ^ (((ob >> 9) & 1) << 5)); }
__host__ __device__ __forceinline__ void stage_rc(int b, int& R, int& C) { const int st = b / 1024, sb = b % 1024, swz = sb ^ (((sb >> 9) & 1) << 5); R = (st >> 1) * 16 + swz / 64; C = (st & 1) * 32 + (swz % 64) / 2; }
__host__ __device__ __forceinline__ int perm32(int rho) { const int n = rho >> 4, i = rho & 15; return 8 * (i >> 2) + 4 * n + (i & 3); }

struct Unit { int pm, pn; };
struct Gemm { const bf16_t* A; const bf16_t* Bt; int M, N, K; };

struct StaticOrder {
    int nM, nN, nwg, G, c;
    __host__ __device__ void init(int M, int N, int G_, int c_) { nM = M / BM; nN = N / BM; nwg = nM * nN; G = G_; c = c_; }
    __host__ __device__ bool next(int i, Unit& u) const {
        const long L = (long)i * G + c; if (L >= nwg) return false;
        int wgid = (int)L; { const int q = nwg / NXCD, r = nwg % NXCD, xcd = wgid % NXCD, off = wgid / NXCD; wgid = (xcd < r ? xcd * (q + 1) : r * (q + 1) + (xcd - r) * q) + off; }
        const int nig = WGM * nN, gid = wgid / nig, fm = gid * WGM, gsz = (nM - fm) < WGM ? (nM - fm) : WGM;
        u.pm = fm + ((wgid % nig) % gsz); u.pn = (wgid % nig) / gsz; return true;
    }
    __device__ __forceinline__ void a_ready(const Unit&) const {}
    __device__ __forceinline__ void done(const Unit&) const {}
};

__device__ __forceinline__ unsigned cvt_pk_bf16(float lo, float hi) { unsigned r; asm volatile("v_cvt_pk_bf16_f32 %0, %1, %2" : "=v"(r) : "v"(lo), "v"(hi)); return r; }
typedef float f32x2 __attribute__((ext_vector_type(2)));
typedef float f32x2 __attribute__((ext_vector_type(2)));
__device__ __forceinline__ u32x4 pack8(f32x4 v0, f32x4 v1) { u32x4 w; w.x = cvt_pk_bf16(v0[0], v0[1]); w.y = cvt_pk_bf16(v0[2], v0[3]); w.z = cvt_pk_bf16(v1[0], v1[1]); w.w = cvt_pk_bf16(v1[2], v1[3]); return w; }
__device__ __forceinline__ f32x4 i2f(f32x4 a) { const i32x4 v = __builtin_bit_cast(i32x4, a); return (f32x4){(float)v[0], (float)v[1], (float)v[2], (float)v[3]}; }
struct EpiProjI8 {
    static constexpr bool PERM = true, AFTER_DRAIN = false, INT8 = true;
    bf16_t* QKV; size_t split_stride; float scale0; bf16_t* H; const float* bglu; const float* sa; const float* sb;
    __device__ __forceinline__ void operator()(const f32x4 (&acc)[2][2][4][2], const Unit& u, int wr, int wc, int fr, int fq) const {
        const int row0 = u.pm * BM + wr * 64 + fr, cb = u.pn * BM + wc * 32 + 8 * fq;
        f32x4 cs[2][2];
#pragma unroll
        for (int bj = 0; bj < 2; ++bj) { cs[bj][0] = *(const f32x4*)(sb + cb + bj * HALF); cs[bj][1] = *(const f32x4*)(sb + cb + bj * HALF + 4); }
        if (u.pn < 12) {
            const int t = u.pn >> 2; bf16_t* base = QKV + (size_t)t * split_stride; const float sc = (t == 0) ? scale0 : 1.f;
            const int col0 = (u.pn & 3) * BM + wc * 32 + 8 * fq;
#pragma unroll
            for (int ai = 0; ai < 2; ++ai)
#pragma unroll
                for (int m = 0; m < 4; ++m) { const int row = row0 + ai * HALF + m * 16; const float rs = sa[row] * sc; bf16_t* rowp = base + (size_t)row * 1024 + col0;
#pragma unroll
                    for (int bj = 0; bj < 2; ++bj) *(u32x4*)(rowp + bj * HALF) = pack8(i2f(acc[ai][bj][m][0]) * cs[bj][0] * rs, i2f(acc[ai][bj][m][1]) * cs[bj][1] * rs); }
        } else {
            const int ch0 = (u.pn - 12) * HALF + wc * 32 + 8 * fq;
            const f32x4 ba0 = *(const f32x4*)(bglu + ch0), ba1 = *(const f32x4*)(bglu + ch0 + 4), bg0 = *(const f32x4*)(bglu + 1024 + ch0), bg1 = *(const f32x4*)(bglu + 1024 + ch0 + 4);
#pragma unroll
            for (int ai = 0; ai < 2; ++ai)
#pragma unroll
                for (int m = 0; m < 4; ++m) { const int row = row0 + ai * HALF + m * 16; const float rs = sa[row];
                    const f32x4 a0 = i2f(acc[ai][0][m][0]) * cs[0][0] * rs + ba0, a1 = i2f(acc[ai][0][m][1]) * cs[0][1] * rs + ba1, g0 = i2f(acc[ai][1][m][0]) * cs[1][0] * rs + bg0, g1 = i2f(acc[ai][1][m][1]) * cs[1][1] * rs + bg1;
                    f32x4 h0, h1;
#pragma unroll
                    for (int e = 0; e < 4; ++e) { h0[e] = a0[e] * __builtin_amdgcn_rcpf(1.f + __builtin_amdgcn_exp2f(-1.4426950409f * g0[e])); h1[e] = a1[e] * __builtin_amdgcn_rcpf(1.f + __builtin_amdgcn_exp2f(-1.4426950409f * g1[e])); }
                    *(u32x4*)(H + (size_t)row * 1024 + ch0) = pack8(h0, h1); }
        }
    }
};
struct EpiPlainI8 {
    static constexpr bool PERM = true, AFTER_DRAIN = false, INT8 = true;
    bf16_t* O; int ldc; const float* sa; const float* sb;
    __device__ __forceinline__ void operator()(const f32x4 (&acc)[2][2][4][2], const Unit& u, int wr, int wc, int fr, int fq) const {
        const int row0 = u.pm * BM + wr * 64 + fr, col0 = u.pn * BM + wc * 32 + 8 * fq;
        f32x4 cs[2][2];
#pragma unroll
        for (int bj = 0; bj < 2; ++bj) { cs[bj][0] = *(const f32x4*)(sb + col0 + bj * HALF); cs[bj][1] = *(const f32x4*)(sb + col0 + bj * HALF + 4); }
#pragma unroll
        for (int ai = 0; ai < 2; ++ai)
#pragma unroll
            for (int m = 0; m < 4; ++m) { const int row = row0 + ai * HALF + m * 16; const float rs = sa[row]; bf16_t* rowp = O + (size_t)row * ldc + col0;
#pragma unroll
                for (int bj = 0; bj < 2; ++bj) *(u32x4*)(rowp + bj * HALF) = pack8(i2f(acc[ai][bj][m][0]) * cs[bj][0] * rs, i2f(acc[ai][bj][m][1]) * cs[bj][1] * rs); }
    }
};
struct EpiResI8 {
    static constexpr bool PERM = true, AFTER_DRAIN = false, INT8 = true;
    const float* X; bf16_t* Y; int ldc; float alpha; const float* sa; const float* sb;
    __device__ __forceinline__ void operator()(const f32x4 (&acc)[2][2][4][2], const Unit& u, int wr, int wc, int fr, int fq) const {
        const int row0 = u.pm * BM + wr * 64 + fr, col0 = u.pn * BM + wc * 32 + 8 * fq;
        f32x4 cs[2][2];
#pragma unroll
        for (int bj = 0; bj < 2; ++bj) { cs[bj][0] = *(const f32x4*)(sb + col0 + bj * HALF); cs[bj][1] = *(const f32x4*)(sb + col0 + bj * HALF + 4); }
#pragma unroll
        for (int ai = 0; ai < 2; ++ai)
#pragma unroll
            for (int m = 0; m < 4; ++m) { const int row = row0 + ai * HALF + m * 16; const float rs = sa[row]; const size_t off = (size_t)row * ldc + col0;
#pragma unroll
                for (int bj = 0; bj < 2; ++bj) { const f32x4 x0 = *(const f32x4*)(X + off + bj * HALF), x1 = *(const f32x4*)(X + off + bj * HALF + 4);
                    *(u32x4*)(Y + off + bj * HALF) = pack8(i2f(acc[ai][bj][m][0]) * cs[bj][0] * rs + x0 * alpha, i2f(acc[ai][bj][m][1]) * cs[bj][1] * rs + x1 * alpha); } }
    }
};
template <class Epi, class Sched, bool ALIGN_EPI = false, bool SP2 = false>
__device__ __forceinline__ void gemm_phase(PG8_LAS unsigned char* lds, const Gemm g, const Sched& S, const Epi& E) {
    const int tid = threadIdx.x, wid = __builtin_amdgcn_readfirstlane(tid >> 6), lane = tid & 63, wr = wid >> 2, wc = wid & 3, fr = lane & 15, fq = lane >> 4;
    const int K = g.K, nt = K / BK;
    unsigned voffA[2], voffB[2];
#pragma unroll
    for (int i = 0; i < 2; ++i) { int R, C; stage_rc(tid * 16 + i * 8192, R, C); const int Rb = Epi::PERM ? ((R & ~31) + perm32(R & 31)) : R;
        voffA[i] = (unsigned)(R * K + C) * 2u; voffB[i] = (unsigned)(Rb * K + C) * 2u; }
    const size_t kstep = (size_t)(BK * 2);
    const size_t hstep = (size_t)HALF * K * 2;
    const size_t tstep = 2 * hstep;
    const unsigned ldsw = (unsigned)wid * 1024u;
    const int aoff = lds_byte(wr * 64 + fr, fq * 8), boff = lds_byte(wc * 32 + fr, fq * 8);
#define PG8_SA(b, h) (((b) * 2 + (h)) * HTB)
#define PG8_SB(b, h) ((4 + (b) * 2 + (h)) * HTB)
#define PG8_STAGE(bufoff, gbase, voff) do { _Pragma("unroll") for (int _i = 0; _i < 2; ++_i) \
        __builtin_amdgcn_global_load_lds((const unsigned*)((const char*)(gbase) + (voff)[_i]), (PG8_LAS unsigned*)(lds + (bufoff) + ldsw + _i * 8192), 16, 0, 0); } while (0)
#define PG8_LDA(dst, b, h) do { _Pragma("unroll") for (int m = 0; m < 4; ++m) _Pragma("unroll") for (int k = 0; k < 2; ++k) dst[m][k] = *(const PG8_LAS bf16x8*)(lds + PG8_SA(b, h) + aoff + m * 2048 + k * 1024); } while (0)
#define PG8_LDB(dst, b, h) do { _Pragma("unroll") for (int n = 0; n < 2; ++n) _Pragma("unroll") for (int k = 0; k < 2; ++k) dst[n][k] = *(const PG8_LAS bf16x8*)(lds + PG8_SB(b, h) + boff + n * 2048 + k * 1024); } while (0)
#define PG8_MMA(ai, bj, At, Bt) do { __builtin_amdgcn_s_setprio(1); _Pragma("unroll") for (int m = 0; m < 4; ++m) _Pragma("unroll") for (int n = 0; n < 2; ++n) _Pragma("unroll") for (int k = 0; k < 2; ++k) { \
        if constexpr (Epi::INT8) acc[ai][bj][m][n] = __builtin_bit_cast(f32x4, __builtin_amdgcn_mfma_i32_16x16x64_i8(__builtin_bit_cast(i32x4, Bt[n][k]), __builtin_bit_cast(i32x4, At[m][k]), __builtin_bit_cast(i32x4, acc[ai][bj][m][n]), 0, 0, 0)); \
        else acc[ai][bj][m][n] = __builtin_amdgcn_mfma_f32_16x16x32_bf16(Bt[n][k], At[m][k], acc[ai][bj][m][n], 0, 0, 0); } __builtin_amdgcn_s_setprio(0); } while (0)
#define PG8_WAIT_V(n) asm volatile("s_waitcnt vmcnt(" #n ")" ::: "memory")
#define PG8_WAIT_L(n) asm volatile("s_waitcnt lgkmcnt(" #n ")" ::: "memory")
#define PG8_BAR __builtin_amdgcn_s_barrier()
#define PG8_SCHED __builtin_amdgcn_sched_barrier(0)
    Unit cur, nxt; int ui = 0;
    if (!S.next(0, cur)) return;
    f32x4 acc[2][2][4][2];
#pragma unroll
    for (int a = 0; a < 2; ++a)
#pragma unroll
        for (int b = 0; b < 2; ++b)
#pragma unroll
            for (int m = 0; m < 4; ++m)
#pragma unroll
                for (int n = 0; n < 2; ++n) acc[a][b][m][n] = (f32x4){0.f, 0.f, 0.f, 0.f};
    bf16x8 At[4][2], B0[2][2], B1[2][2];
    const char* cA = (const char*)g.A + (size_t)cur.pm * tstep; const char* cB = (const char*)g.Bt + (size_t)cur.pn * tstep;
    S.a_ready(cur);
    if constexpr (SP2) {
        PG8_STAGE(PG8_SB(0, 0), cB, voffB); PG8_STAGE(PG8_SB(0, 1), cB + hstep, voffB); PG8_STAGE(PG8_SA(0, 0), cA, voffA); PG8_STAGE(PG8_SA(0, 1), cA + hstep, voffA);
        if (wr == 1) PG8_BAR;
        PG8_WAIT_V(2); PG8_BAR;
        PG8_STAGE(PG8_SB(1, 0), cB + kstep, voffB); PG8_STAGE(PG8_SA(1, 0), cA + kstep, voffA); PG8_STAGE(PG8_SB(1, 1), cB + hstep + kstep, voffB);
        PG8_WAIT_V(6); PG8_BAR;
    } else {
        PG8_STAGE(PG8_SB(0, 0), cB, voffB); PG8_STAGE(PG8_SA(0, 0), cA, voffA); PG8_STAGE(PG8_SB(0, 1), cB + hstep, voffB); PG8_STAGE(PG8_SA(0, 1), cA + hstep, voffA);
        if (wr == 1) PG8_BAR;
        PG8_WAIT_V(4); PG8_BAR;
        PG8_STAGE(PG8_SB(1, 0), cB + kstep, voffB); PG8_STAGE(PG8_SA(1, 0), cA + kstep, voffA); PG8_STAGE(PG8_SB(1, 1), cB + hstep + kstep, voffB);
        PG8_WAIT_V(6); PG8_BAR;
    }
    for (;;) {
        const bool has_next = S.next(ui + 1, nxt);
        const char* nA = has_next ? (const char*)g.A + (size_t)nxt.pm * tstep : cA; const char* nB = has_next ? (const char*)g.Bt + (size_t)nxt.pn * tstep : cB;
        for (int t = 0; t < nt; t += 2) {
            const bool last = (t == nt - 2);
            const char* a1 = cA + (size_t)(t + 1) * kstep;
            const char* a2 = last ? nA : cA + (size_t)(t + 2) * kstep; const char* b2 = last ? nB : cB + (size_t)(t + 2) * kstep;
            const char* a3 = a2 + kstep; const char* b3 = b2 + kstep;
            if (last && has_next) S.a_ready(nxt);
            if constexpr (SP2) {
            PG8_LDB(B0, 0, 0); PG8_LDB(B1, 0, 1); PG8_SCHED; PG8_LDA(At, 0, 0); PG8_STAGE(PG8_SA(1, 1), a1 + hstep, voffA);
            PG8_WAIT_V(8); PG8_WAIT_L(0); PG8_BAR; PG8_MMA(0, 0, At, B0); PG8_MMA(0, 1, At, B1); PG8_BAR; PG8_SCHED;
            PG8_LDA(At, 0, 1); PG8_STAGE(PG8_SB(0, 0), b2, voffB); PG8_STAGE(PG8_SB(0, 1), b2 + hstep, voffB); PG8_STAGE(PG8_SA(0, 0), a2, voffA);
            PG8_WAIT_V(8); PG8_WAIT_L(0); PG8_BAR; PG8_MMA(1, 0, At, B0); PG8_MMA(1, 1, At, B1); PG8_BAR; PG8_SCHED;
            PG8_LDB(B0, 1, 0); PG8_LDB(B1, 1, 1); PG8_SCHED; PG8_LDA(At, 1, 0); PG8_STAGE(PG8_SA(0, 1), a2 + hstep, voffA);
            PG8_WAIT_V(8); PG8_WAIT_L(0); PG8_BAR; PG8_MMA(0, 0, At, B0); PG8_MMA(0, 1, At, B1); PG8_BAR; PG8_SCHED;
            PG8_LDA(At, 1, 1); PG8_STAGE(PG8_SB(1, 0), b3, voffB); PG8_STAGE(PG8_SB(1, 1), b3 + hstep, voffB); PG8_STAGE(PG8_SA(1, 0), a3, voffA);
            PG8_WAIT_V(8); PG8_WAIT_L(0); PG8_BAR; PG8_MMA(1, 0, At, B0); PG8_MMA(1, 1, At, B1); PG8_BAR; PG8_SCHED;
            } else {
            PG8_LDB(B0, 0, 0); PG8_SCHED; PG8_LDA(At, 0, 0); PG8_STAGE(PG8_SA(1, 1), a1 + hstep, voffA);
            PG8_WAIT_L(8); PG8_BAR; PG8_WAIT_L(0); PG8_MMA(0, 0, At, B0); PG8_BAR; PG8_SCHED;
            PG8_LDB(B1, 0, 1); PG8_STAGE(PG8_SB(0, 0), b2, voffB);
            PG8_BAR; PG8_WAIT_L(0); PG8_MMA(0, 1, At, B1); PG8_BAR;
            PG8_LDA(At, 0, 1); PG8_STAGE(PG8_SA(0, 0), a2, voffA);
            PG8_BAR; PG8_WAIT_L(0); PG8_MMA(1, 0, At, B0); PG8_BAR; PG8_SCHED;
            PG8_STAGE(PG8_SB(0, 1), b2 + hstep, voffB);
            PG8_WAIT_V(6); PG8_BAR; PG8_MMA(1, 1, At, B1); PG8_BAR;
            PG8_LDB(B0, 1, 0); PG8_SCHED; PG8_LDA(At, 1, 0); PG8_STAGE(PG8_SA(0, 1), a2 + hstep, voffA);
            PG8_WAIT_L(8); PG8_BAR; PG8_WAIT_L(0); PG8_MMA(0, 0, At, B0); PG8_BAR; PG8_SCHED;
            PG8_LDB(B1, 1, 1); PG8_STAGE(PG8_SB(1, 0), b3, voffB);
            PG8_BAR; PG8_WAIT_L(0); PG8_MMA(0, 1, At, B1); PG8_BAR;
            PG8_LDA(At, 1, 1); PG8_STAGE(PG8_SA(1, 0), a3, voffA);
            PG8_BAR; PG8_WAIT_L(0); PG8_MMA(1, 0, At, B0); PG8_BAR; PG8_SCHED;
            PG8_STAGE(PG8_SB(1, 1), b3 + hstep, voffB);
            PG8_WAIT_V(6); PG8_BAR; PG8_MMA(1, 1, At, B1); PG8_BAR;
            }
        }
        if constexpr (ALIGN_EPI) { if (wr == 0) PG8_BAR; }
        if constexpr (!Epi::AFTER_DRAIN) { E(acc, cur, wr, wc, fr, fq); S.done(cur); }
        if (!has_next) break;
#pragma unroll
        for (int a = 0; a < 2; ++a)
#pragma unroll
            for (int b = 0; b < 2; ++b)
#pragma unroll
                for (int m = 0; m < 4; ++m)
#pragma unroll
                    for (int n = 0; n < 2; ++n) acc[a][b][m][n] = (f32x4){0.f, 0.f, 0.f, 0.f};
        cur = nxt; cA = nA; cB = nB; ++ui;
        if constexpr (ALIGN_EPI) { if (wr == 1) PG8_BAR; }
    }
    PG8_WAIT_V(0);
    if constexpr (!ALIGN_EPI) { if (wr == 0) PG8_BAR; }
    PG8_BAR;
    if constexpr (Epi::AFTER_DRAIN) { E.fused(acc, cur, wr, wc, fr, fq, lds, wid, lane); S.done(cur); }
#undef PG8_SA
#undef PG8_SB
#undef PG8_STAGE
#undef PG8_LDA
#undef PG8_LDB
#undef PG8_MMA
#undef PG8_WAIT_V
#undef PG8_WAIT_L
#undef PG8_BAR
#undef PG8_SCHED
}
}
#include <hip/hip_bf16.h>
#include <cmath>
namespace dattn {
using bf16 = __hip_bfloat16;
typedef short bf16x8 __attribute__((ext_vector_type(8)));
typedef short s16x4 __attribute__((ext_vector_type(4)));
typedef float f32x16 __attribute__((ext_vector_type(16)));
typedef unsigned u32x4 __attribute__((ext_vector_type(4)));
constexpr int DK = 64, DV = 128, RS = 1024, SEQ = 4096;
constexpr int NW = 8, QBLK = 32, KVBLK = 64, QB = NW * QBLK;
constexpr int SHM_V = KVBLK * DV * 2, SHM_K = KVBLK * DK * 2;
constexpr int LDS_WS = 2 * SHM_V + 2 * SHM_K, LDS_TAB = LDS_WS + NW * 64 * 4, LDS_BYTES = LDS_TAB + 512;
constexpr float THR = 8.f;
constexpr float C2 = 0.125f * 1.4426950408889634f;
#define DA_KSWZ(row, colB) ((row) * 128 + ((colB) ^ (((row) & 7) << 4)))
#define DA_SBAR() __builtin_amdgcn_sched_barrier(0)
__device__ __forceinline__ int v_st(int k, int c) { const int kk = (k & ~0xC) | ((k & 4) << 1) | ((k & 8) >> 1); return ((kk >> 3) * 4 + (c >> 5)) * 512 + ((kk & 7) * 32 + (c & 31)) * 2; }
__device__ __forceinline__ int v_rd_base(int lane) { return ((lane & 3) << 3) | (((lane >> 2) & 3) << 6) | (((lane >> 4) & 1) << 5) | (((lane >> 5) & 1) << 8); }
constexpr int v_rd_off(int d0, int ks, int half) { return d0 * 512 + ks * 4096 + half * 2048; }
__device__ __forceinline__ int crow(int r, int hi) { return (r & 3) + 8 * (r >> 2) + 4 * hi; }
__device__ __forceinline__ unsigned cvtpk(float lo, float hi) { unsigned r; asm volatile("v_cvt_pk_bf16_f32 %0, %1, %2" : "=v"(r) : "v"(lo), "v"(hi)); return r; }
__device__ __forceinline__ bf16x8 load8(const bf16* p) { return *reinterpret_cast<const bf16x8*>(p); }
__device__ __forceinline__ void mask_tile(f32x16& p0, f32x16& p1, int dq) {
    const float NEG = -__builtin_inff();
#pragma unroll
    for (int r = 0; r < 16; ++r) { const int c = (r & 3) + 8 * (r >> 2); if (dq - c < 0) p0[r] = NEG; if (dq - c - 32 < 0) p1[r] = NEG; }
}
__device__ __forceinline__ void bias_tile(f32x16& p0, f32x16& p1, int dq, const __attribute__((address_space(3))) float* tab) {
#pragma unroll
    for (int r = 0; r < 16; ++r) { const int c = (r & 3) + 8 * (r >> 2); const int i0 = min(max(dq - c, 0), 127), i1 = min(max(dq - c - 32, 0), 127); p0[r] += tab[i0]; p1[r] += tab[i1]; }
}
__device__ __forceinline__ void partialSM(f32x16& p0, f32x16& p1, float& m_reg, float& mn, float& alpha) {
    float pmax = p0[0];
#pragma unroll
    for (int r = 1; r < 16; ++r) pmax = fmaxf(pmax, p0[r]);
#pragma unroll
    for (int r = 0; r < 16; ++r) pmax = fmaxf(pmax, p1[r]);
    { auto rr = __builtin_amdgcn_permlane32_swap(__float_as_uint(pmax), __float_as_uint(pmax), false, false); pmax = fmaxf(__uint_as_float(rr[0]), __uint_as_float(rr[1])); }
    if (__builtin_expect(__all(pmax - m_reg <= THR), 1)) { mn = m_reg; alpha = 1.f; }
    else { mn = fmaxf(m_reg, pmax); alpha = __builtin_amdgcn_exp2f(m_reg - mn); m_reg = mn; }
#pragma unroll
    for (int r = 0; r < 16; ++r) p0[r] -= mn;
#pragma unroll
    for (int r = 0; r < 16; ++r) p1[r] -= mn;
#pragma unroll
    for (int r = 0; r < 16; ++r) p0[r] = __builtin_amdgcn_exp2f(p0[r]);
}
__device__ __forceinline__ void finishSM(f32x16& p0, f32x16& p1, float alpha, float& l_reg, bf16x8& pa0, bf16x8& pa1, bf16x8& pa2, bf16x8& pa3) {
#pragma unroll
    for (int r = 0; r < 16; ++r) p1[r] = __builtin_amdgcn_exp2f(p1[r]);
    float ps = 0;
#pragma unroll
    for (int r = 0; r < 16; ++r) ps += p0[r];
#pragma unroll
    for (int r = 0; r < 16; ++r) ps += p1[r];
    { auto rr = __builtin_amdgcn_permlane32_swap(__float_as_uint(ps), __float_as_uint(ps), false, false); ps = __uint_as_float(rr[0]) + __uint_as_float(rr[1]); }
    l_reg = l_reg * alpha + ps;
#define DA_PK4(P, B_, OUT) do { unsigned a0 = cvtpk(P[B_+0], P[B_+1]), a1 = cvtpk(P[B_+2], P[B_+3]); unsigned b0 = cvtpk(P[B_+4], P[B_+5]), b1 = cvtpk(P[B_+6], P[B_+7]); \
        auto r0 = __builtin_amdgcn_permlane32_swap(a0, b0, false, false); auto r1 = __builtin_amdgcn_permlane32_swap(a1, b1, false, false); \
        u32x4 w = {r0[0], r1[0], r0[1], r1[1]}; OUT = *reinterpret_cast<bf16x8*>(&w); } while (0)
    DA_PK4(p0, 0, pa0); DA_PK4(p0, 8, pa1); DA_PK4(p1, 0, pa2); DA_PK4(p1, 8, pa3);
#undef DA_PK4
}
template <int KB>
__device__ __forceinline__ void qkt(f32x16& p0, f32x16& p1, const char* K_lds, int r32, int hi, const bf16x8* qr) {
    p0 = f32x16{}; p1 = f32x16{};
#pragma unroll
    for (int d0 = 0; d0 < 4; ++d0) { const char* a = K_lds + KB * SHM_K + DA_KSWZ(r32, (d0 * 16 + hi * 8) * 2);
        const bf16x8 b0 = *reinterpret_cast<const bf16x8*>(a), b1 = *reinterpret_cast<const bf16x8*>(a + 32 * 128);
        p0 = __builtin_amdgcn_mfma_f32_32x32x16_bf16(b0, qr[d0], p0, 0, 0, 0);
        p1 = __builtin_amdgcn_mfma_f32_32x32x16_bf16(b1, qr[d0], p1, 0, 0, 0); }
}
template <int VB>
__device__ __forceinline__ void pv_tile(f32x16* o, int vb0, bf16x8 pa0, bf16x8 pa1, bf16x8 pa2, bf16x8 pa3) {
#define DA_TRRD(dst, off) asm volatile("ds_read_b64_tr_b16 %0, %1 offset:%2" : "=&v"(dst) : "v"(vb0), "i"(off) : "memory")
#define DA_PV_D0(d0) do { s16x4 l0, l1, l2, l3, h0, h1, h2, h3; constexpr int b_ = VB * SHM_V + v_rd_off(d0, 0, 0); \
        DA_TRRD(l0, b_); DA_TRRD(h0, b_ + 2048); DA_TRRD(l1, b_ + 4096); DA_TRRD(h1, b_ + 6144); DA_TRRD(l2, b_ + 8192); DA_TRRD(h2, b_ + 10240); DA_TRRD(l3, b_ + 12288); DA_TRRD(h3, b_ + 14336); \
        asm volatile("s_waitcnt lgkmcnt(0)" ::: "memory"); DA_SBAR(); \
        o[d0] = __builtin_amdgcn_mfma_f32_32x32x16_bf16(pa0, (bf16x8){l0[0], l0[1], l0[2], l0[3], h0[0], h0[1], h0[2], h0[3]}, o[d0], 0, 0, 0); \
        o[d0] = __builtin_amdgcn_mfma_f32_32x32x16_bf16(pa1, (bf16x8){l1[0], l1[1], l1[2], l1[3], h1[0], h1[1], h1[2], h1[3]}, o[d0], 0, 0, 0); \
        o[d0] = __builtin_amdgcn_mfma_f32_32x32x16_bf16(pa2, (bf16x8){l2[0], l2[1], l2[2], l2[3], h2[0], h2[1], h2[2], h2[3]}, o[d0], 0, 0, 0); \
        o[d0] = __builtin_amdgcn_mfma_f32_32x32x16_bf16(pa3, (bf16x8){l3[0], l3[1], l3[2], l3[3], h3[0], h3[1], h3[2], h3[3]}, o[d0], 0, 0, 0); } while (0)
    DA_PV_D0(0); DA_PV_D0(1); DA_PV_D0(2); DA_PV_D0(3);
#undef DA_PV_D0
#undef DA_TRRD
}
struct BlockRef { const bf16* Q; const bf16* K; const bf16* V; bf16* O; int P0; };
struct Seam { bf16x8 qr[4]; bf16x8 st_v0, st_v1, st_k0; };
#define DA_VMW() asm volatile("s_waitcnt vmcnt(0)" ::: "memory")
#define DA_VMWN(n) asm volatile("s_waitcnt vmcnt(%0)" :: "i"(n) : "memory")
#define DA_SLOAD(Kp, Vp, k0) do { S.st_v0 = load8((Vp) + (size_t)((k0) + sr) * RS + sc); S.st_v1 = load8((Vp) + (size_t)((k0) + 32 + sr) * RS + sc); S.st_k0 = load8((Kp) + (size_t)((k0) + kr) * RS + kc); } while (0)
#define DA_SWRITE_K(bf) do { *(bf16x8*)(K_lds + (bf) * SHM_K + kws) = S.st_k0; } while (0)
#define DA_SWRITE_V(bf) do { *(bf16x8*)(V_lds + (bf) * SHM_V + vst0) = S.st_v0; *(bf16x8*)(V_lds + (bf) * SHM_V + vst1) = S.st_v1; } while (0)
__device__ __forceinline__ void prime(const BlockRef& cur, char* lds, Seam& S) {
    const int tid = threadIdx.x, wid = __builtin_amdgcn_readfirstlane(tid >> 6), lane = tid & 63, r32 = lane & 31, hi = lane >> 5;
    const int sr = tid >> 4, sc = (tid & 15) * 8, kr = tid >> 3, kc = (tid & 7) * 8, kws = DA_KSWZ(kr, kc * 2); char* K_lds = lds + 2 * SHM_V;
#pragma unroll
    for (int d0 = 0; d0 < 4; ++d0) S.qr[d0] = load8(cur.Q + (size_t)(wid * QBLK + r32) * RS + d0 * 16 + hi * 8);
    DA_SLOAD(cur.K, cur.V, 0); DA_VMW(); DA_SWRITE_K(0);
    __syncthreads();
}
__device__ __forceinline__ void block(const BlockRef& cur, const BlockRef& nxt, char* lds, Seam& S) {
    const int tid = threadIdx.x, wid = __builtin_amdgcn_readfirstlane(tid >> 6), lane = tid & 63, r32 = lane & 31, hi = lane >> 5;
    const int NT = (cur.P0 + QB) / KVBLK;
    const int qlo = cur.P0 + wid * QBLK, qm = qlo + r32 - 4 * hi;
    char* V_lds = lds; char* K_lds = lds + 2 * SHM_V;
    float* ws = (float*)(lds + LDS_WS) + wid * 64; float* li_l = ws, * al_l = ws + 32;
    const __attribute__((address_space(3))) float* tab = (const __attribute__((address_space(3))) float*)((__attribute__((address_space(3))) char*)lds + LDS_TAB);
    float m_reg = -1e30f, l_reg = 0; f32x16 o[4] = {};
    const int sr = tid >> 4, sc = (tid & 15) * 8, vst0 = v_st(sr, sc), vst1 = v_st(32 + sr, sc), kr = tid >> 3, kc = (tid & 7) * 8, kws = DA_KSWZ(kr, kc * 2);
    const int vb0 = (int)(uintptr_t)V_lds + v_rd_base(lane);
    const bf16* Kh = cur.K; const bf16* Vh = cur.V;
#define DA_RESC(a) do { if (__any((a) < 1.f)) { if (hi == 0) al_l[r32] = (a); asm volatile("s_waitcnt lgkmcnt(0)" ::: "memory"); \
                     _Pragma("unroll") for (int d_ = 0; d_ < 4; ++d_) _Pragma("unroll") for (int r = 0; r < 16; ++r) o[d_][r] *= al_l[crow(r, hi)]; } } while (0)
#define DA_KBASE(t) ((t) * KVBLK)
#define DA_MASKT(P0_, P1_, t) do { const int kb_ = DA_KBASE(t); if (kb_ + KVBLK - 1 >= qlo - 127) { bias_tile(P0_, P1_, qm - kb_, tab); if (kb_ + KVBLK - 1 > qlo) mask_tile(P0_, P1_, qm - kb_); } } while (0)
    constexpr int NQL = 4;
#define DA_SEAM_K0() do { DA_VMWN(NQL); DA_SWRITE_K(0); DA_SBAR(); } while (0)
    f32x16 pA0, pA1, pB0, pB1; float mnA, mnB, alA, alB; bf16x8 pa0, pa1, pa2, pa3;
    DA_SWRITE_V(0); DA_SBAR();
    DA_SLOAD(Kh, Vh, DA_KBASE(1));
    DA_SBAR(); qkt<0>(pA0, pA1, K_lds, r32, hi, S.qr);
    DA_MASKT(pA0, pA1, 0); partialSM(pA0, pA1, m_reg, mnA, alA);
    DA_VMW(); DA_SWRITE_V(1); DA_SWRITE_K(1);
    __syncthreads();
#define DA_HALF_STEP(PX0, PX1, mnX, alX, PY0, PY1, alY, t, KB, VB, SB) do { \
        DA_SBAR(); qkt<KB>(PX0, PX1, K_lds, r32, hi, S.qr); \
        finishSM(PY0, PY1, alY, l_reg, pa0, pa1, pa2, pa3); DA_SBAR(); \
        if ((t) + 1 < NT) { DA_SLOAD(Kh, Vh, DA_KBASE((t) + 1)); DA_SBAR(); } \
        pv_tile<VB>(o, vb0, pa0, pa1, pa2, pa3); DA_MASKT(PX0, PX1, (t)); partialSM(PX0, PX1, m_reg, mnX, alX); \
        __syncthreads(); \
        if ((t) + 1 < NT) { DA_VMW(); DA_SWRITE_V(SB); DA_SWRITE_K(SB); } \
        DA_RESC(alX); __syncthreads(); } while (0)
    for (int t = 1; t + 1 < NT; t += 2) {
        DA_HALF_STEP(pB0, pB1, mnB, alB, pA0, pA1, alA, t, 1, 0, 0);
        DA_HALF_STEP(pA0, pA1, mnA, alA, pB0, pB1, alB, t + 1, 0, 1, 1);
    }
    DA_SBAR(); qkt<1>(pB0, pB1, K_lds, r32, hi, S.qr); DA_SBAR();
    DA_SLOAD(nxt.K, nxt.V, 0); DA_SBAR();
#pragma unroll
    for (int d0 = 0; d0 < 4; ++d0) S.qr[d0] = load8(nxt.Q + (size_t)(wid * QBLK + r32) * RS + d0 * 16 + hi * 8);
    DA_SBAR();
    finishSM(pA0, pA1, alA, l_reg, pa0, pa1, pa2, pa3); DA_SBAR();
    pv_tile<0>(o, vb0, pa0, pa1, pa2, pa3);
    DA_MASKT(pB0, pB1, NT - 1); partialSM(pB0, pB1, m_reg, mnB, alB); __syncthreads(); DA_RESC(alB);
    finishSM(pB0, pB1, alB, l_reg, pa0, pa1, pa2, pa3); DA_SBAR(); pv_tile<1>(o, vb0, pa0, pa1, pa2, pa3);
    DA_SBAR(); DA_SEAM_K0();
    if (hi == 0) li_l[r32] = l_reg; asm volatile("s_waitcnt lgkmcnt(0)" ::: "memory");
    float rli[16];
#pragma unroll
    for (int r = 0; r < 16; ++r) rli[r] = __builtin_amdgcn_rcpf(li_l[crow(r, hi)]);
    bf16* Ow = cur.O + (size_t)(wid * QBLK) * RS;
#pragma unroll
    for (int r = 0; r < 16; ++r) { const int orow = crow(r, hi);
#pragma unroll
        for (int d0 = 0; d0 < 4; ++d0) { const float v = o[d0][r] * rli[r]; const float vn = __shfl_xor(v, 1);
            if ((r32 & 1) == 0) *(unsigned*)(Ow + (size_t)orow * RS + d0 * 32 + r32) = cvtpk(v, vn); } }
    __syncthreads();
#undef DA_RESC
#undef DA_KBASE
#undef DA_MASKT
#undef DA_SEAM_K0
#undef DA_HALF_STEP
}
#undef DA_VMW
#undef DA_VMWN
#undef DA_SLOAD
#undef DA_SWRITE_K
#undef DA_SWRITE_V
struct Tensors { const bf16* Q; const bf16* K; const bf16* V; bf16* O1; bf16* O2; const float* biastab; };
__device__ __forceinline__ BlockRef unit_ref(const Tensors& T, int v, int i) {
    const int bhc = (v & 255) >> 1, s = v & 1, b = bhc >> 4, h = (bhc >> 1) & 7, c = bhc & 1; const int q2 = 2 * (i >> 1) + s, qb = (i & 1) ? 15 - q2 : q2;
    const size_t row0 = (size_t)b * SEQ; BlockRef r;
    r.Q = T.Q + (row0 + (size_t)qb * QB) * RS + (2 * h + c) * DK; r.K = T.K + row0 * RS + (2 * h + c) * DK; r.V = T.V + row0 * RS + h * DV;
    r.O = (c ? T.O2 : T.O1) + (row0 + (size_t)qb * QB) * RS + h * DV; r.P0 = qb * QB; return r;
}
__device__ __forceinline__ void phase(char* lds, const Tensors& T, int vcu) {
    { const int h = ((vcu & 255) >> 2) & 7; if (threadIdx.x < 128) ((float*)(lds + LDS_TAB))[threadIdx.x] = T.biastab[h * 128 + threadIdx.x]; }
    Seam S; BlockRef cur = unit_ref(T, vcu, 0);
    prime(cur, lds, S);
    for (int i = 0; i < 8; ++i) { const BlockRef nxt = unit_ref(T, vcu, i + 1 < 8 ? i + 1 : i); block(cur, nxt, lds, S); cur = nxt; }
}
#undef DA_KSWZ
#undef DA_SBAR
}
#ifndef PG8_SP2
#define PG8_SP2 true
#endif
#ifndef PG8_ALIGN
#define PG8_ALIGN true
#endif
constexpr int NWAVES = 8;
#ifndef MK_N_LAUNCHES
#define MK_N_LAUNCHES 1
#endif
constexpr int N_PHASES = 8;
constexpr int BATCH = 8, SEQ = 4096, D = 2048, M = BATCH * SEQ;
constexpr int NPROJ = 5120, DATT = 1024, DCONV = 1024, CONVW = 31;
constexpr int PH = 8, PNK = 128, PHALF = 128, PTOPK = 16, NEXP = 16384;
constexpr float LN_EPS = 1e-5f;
constexpr float DN_ALPHA = 1.189207115002721f;
constexpr float LAMBDA_INIT = 0.2f;
constexpr size_t MiB = 1u << 20;
constexpr size_t WS_WIN = 2 * MiB, WS_WOUT = 22 * MiB, WS_WQ = 30 * MiB, WS_KEYS = 38 * MiB, WS_TAB = 39 * MiB;
constexpr size_t WS_U8 = 40 * MiB, WS_V8 = 72 * MiB, WS_SU = 104 * MiB, WS_SV = 105 * MiB;
constexpr size_t WS_XB = 168 * MiB;
constexpr size_t WS_Q = 296 * MiB, WS_K = 360 * MiB, WS_V = 424 * MiB, WS_H = 488 * MiB;
constexpr size_t WS_O1 = 552 * MiB, WS_O2 = 616 * MiB;
constexpr size_t WS_Y1 = 680 * MiB;
constexpr size_t WS_QP = 808 * MiB;
constexpr size_t WS_X8 = WS_O1;
constexpr size_t WS_SX = 106 * MiB, WS_SWQ = 107 * MiB, WS_SWIN = WS_SWQ + 65536, WS_SWOUT = WS_SWQ + 131072, WS_SXA = 108 * MiB, WS_SM = 109 * MiB, WS_LNS = 110 * MiB, WS_SXQ = 111 * MiB;
constexpr size_t WS_CMAX = 16384;
constexpr size_t WS_EID = 936 * MiB, WS_GATE = 952 * MiB;
constexpr size_t WS_END = 968 * MiB;
constexpr int RING_BYTES = 131072, LDS_BYTES = 147456;

#define GAS __attribute__((address_space(1)))
#define LAS __attribute__((address_space(3)))
typedef unsigned short bf16;
typedef unsigned v4u __attribute__((ext_vector_type(4)));
typedef unsigned v2u __attribute__((ext_vector_type(2)));
typedef float f32x4 __attribute__((ext_vector_type(4)));
typedef float f32x16 __attribute__((ext_vector_type(16)));
typedef short bf16x8 __attribute__((ext_vector_type(8)));
typedef __bf16 bf16x2_t __attribute__((ext_vector_type(2)));
#define LDS_WAIT() asm volatile("s_waitcnt lgkmcnt(0)" ::: "memory")
__device__ __forceinline__ unsigned f2bf(float f) { unsigned u = __builtin_bit_cast(unsigned, f); return (u + 0x7fffu + ((u >> 16) & 1u)) >> 16; }
__device__ __forceinline__ unsigned pk2(float lo, float hi) { return f2bf(lo) | (f2bf(hi) << 16); }
__device__ __forceinline__ float bflo(unsigned w) { return __uint_as_float(w << 16); }
__device__ __forceinline__ float bfhi(unsigned w) { return __uint_as_float(w & 0xffff0000u); }
__device__ __forceinline__ float wave_sum(float v) {
#pragma unroll
    for (int o = 1; o < 64; o <<= 1) v += __shfl_xor(v, o);
    return v;
}
__device__ __forceinline__ float dot2bf(unsigned a, unsigned b, float acc) { return __builtin_amdgcn_fdot2_f32_bf16(__builtin_bit_cast(bf16x2_t, a), __builtin_bit_cast(bf16x2_t, b), acc, false); }

#define XB_TMO      128
#define XB_XCNT(j)  (256  + 64 * (j))
#define XB_XSUB(j)  (1280 + 64 * (j))
#define XB_XGEN(j)  (2304 + 64 * (j))
#define XB_TOP      3328
#define XB_TOPGEN   3392
#define XCD_BAR_WORDS 3456
#define XB_SPIN_CAP (1u << 18)

__device__ __forceinline__ unsigned xb_ld(unsigned* p)              { return __hip_atomic_load(p, __ATOMIC_RELAXED, __HIP_MEMORY_SCOPE_AGENT); }
__device__ __forceinline__ unsigned xb_add(unsigned* p, unsigned v) { return __hip_atomic_fetch_add(p, v, __ATOMIC_RELAXED, __HIP_MEMORY_SCOPE_AGENT); }
__device__ __forceinline__ unsigned xb_xcc_id() { return (unsigned)__builtin_amdgcn_s_getreg((3 << 11) | 20) & 0xFu; }
#define XB_SPIN(cond, bar) do { unsigned _sp = 0; while (cond) { __builtin_amdgcn_s_sleep(1); \
    if ((++_sp & 255u) == 0u) { if (xb_ld(&(bar)[XB_TMO])) break; if (_sp > XB_SPIN_CAP) { atomicAdd(&(bar)[XB_TMO], 1u); break; } } } } while (0)

struct XcdBarrier {
    unsigned* bar; unsigned x;
    volatile LAS unsigned* st;
};

__device__ __forceinline__ XcdBarrier xcd_barrier_post(unsigned* bar, volatile LAS unsigned* st) {
    XcdBarrier b; b.bar = bar; b.x = xb_xcc_id(); b.st = st;
    if (threadIdx.x == 0) (void)xb_add(&bar[XB_XCNT(b.x)], 1u);
    return b;
}
__device__ __forceinline__ void xcd_barrier_complete(unsigned* bar, unsigned x, unsigned& nloc, unsigned& nx) {
    const unsigned G = gridDim.x * gridDim.y * gridDim.z;
    unsigned sum, cnt, mine, sp = 0u;
    for (;;) {
        sum = 0u; cnt = 0u; mine = 0u;
#pragma unroll
        for (unsigned j = 0; j < 16; ++j) { const unsigned c = xb_ld(&bar[XB_XCNT(j)]); sum += c; cnt += (c > 0u) ? 1u : 0u; mine = (j == x) ? c : mine; }
        if (sum == G) break;
        __builtin_amdgcn_s_sleep(1);
        if ((++sp & 255u) == 0u) { if (xb_ld(&bar[XB_TMO])) break; if (sp > XB_SPIN_CAP) { atomicAdd(&bar[XB_TMO], 1u); break; } }
    }
    nloc = mine > 0u ? mine : 1u; nx = cnt > 0u ? cnt : 1u;
}

__device__ __forceinline__ void xcd_barrier(const XcdBarrier& b) {
    asm volatile("s_waitcnt vmcnt(0)" ::: "memory");
    __syncthreads();
    if (threadIdx.x == 0) {
        unsigned* bar = b.bar;
        __builtin_amdgcn_s_waitcnt(0);
        unsigned nloc = b.st[0], nx = b.st[1];
        if (nloc == 0u) { xcd_barrier_complete(bar, b.x, nloc, nx); b.st[0] = nloc; b.st[1] = nx; }
        const unsigned old = xb_add(&bar[XB_XSUB(b.x)], 1u);
        const unsigned gen = old / nloc;
        if (old + 1u == (gen + 1u) * nloc) {
            __builtin_amdgcn_fence(__ATOMIC_RELEASE, "agent");
            asm volatile("s_waitcnt vmcnt(0)" ::: "memory");
            const unsigned og = xb_add(&bar[XB_TOP], 1u);
            const unsigned tg = og / nx;
            if (og + 1u == (tg + 1u) * nx) xb_add(&bar[XB_TOPGEN], 1u);
            else XB_SPIN(xb_ld(&bar[XB_TOPGEN]) == tg, bar);
            __builtin_amdgcn_fence(__ATOMIC_ACQUIRE, "agent");
            xb_add(&bar[XB_XGEN(b.x)], 1u);
            asm volatile("s_waitcnt vmcnt(0)" ::: "memory");
        } else {
            XB_SPIN(xb_ld(&bar[XB_XGEN(b.x)]) == gen, bar);
            __builtin_amdgcn_fence(__ATOMIC_ACQUIRE, "agent");
            asm volatile("s_waitcnt vmcnt(0)" ::: "memory");
        }
    }
    __syncthreads();
}

struct Frame {
    LAS unsigned char* lds;
    __device__ __forceinline__ int wave_() const { int w = __builtin_amdgcn_readfirstlane((int)threadIdx.x >> 6); asm volatile("" : "+s"(w)); return w; }
    __device__ __forceinline__ int G_() const { int g = (int)gridDim.x; asm volatile("" : "+s"(g)); return g; }
    __device__ __forceinline__ int vcu_() const { int bx = (int)blockIdx.x; asm volatile("" : "+s"(bx)); const int g = G_(); return (g % 8 == 0) ? (bx % 8) * (g / 8) + bx / 8 : bx; }
    __device__ __forceinline__ int tid() const { int t = (int)threadIdx.x; asm volatile("" : "+v"(t)); return t; }
    __device__ __forceinline__ int lane() const { return tid() & 63; }
    __device__ __forceinline__ unsigned long long raw(int k) const { const volatile LAS unsigned* p = (const volatile LAS unsigned*)(lds + RING_BYTES) + 2 * k;
        const unsigned lo = __builtin_amdgcn_readfirstlane(p[0]), hi = __builtin_amdgcn_readfirstlane(p[1]); return ((unsigned long long)hi << 32) | lo; }
    __device__ __forceinline__ const float* in(int k) const { return (const float*)raw(k); }
    __device__ __forceinline__ float* outp() const { return (float*)raw(22); }
    template <class T> __device__ __forceinline__ T* ws(size_t off) const { return (T*)((unsigned char*)raw(23) + off); }
};
enum { I_X = 0, I_WIN, I_BGLU, I_CONVW, I_CONVB, I_CLNG, I_CLNB, I_LQ1, I_LK1, I_LQ2, I_LK2, I_SUBLN, I_RELB, I_WOUT, I_LN1G, I_LN1B, I_WQ, I_KEYS, I_U, I_V, I_LN2G, I_LN2B };

template <int CTRL> __device__ __forceinline__ int dppi(int v) { return __builtin_amdgcn_update_dpp(0, v, CTRL, 0xf, 0xf, true); }
template <int CTRL> __device__ __forceinline__ float dppf(float v) { return __int_as_float(__builtin_amdgcn_update_dpp(0, __float_as_int(v), CTRL, 0xf, 0xf, true)); }
__device__ __forceinline__ unsigned pack_i8x4(float a, float b, float c, float d) {
    const int ia = (int)rintf(a), ib = (int)rintf(b), ic = (int)rintf(c), id = (int)rintf(d); return (unsigned)(ia & 255) | ((unsigned)(ib & 255) << 8) | ((unsigned)(ic & 255) << 16) | ((unsigned)id << 24); }
__device__ __forceinline__ void p0_colmax_item(const float* W, int N, unsigned* cmax, int k0, int n0, int dst0, int lane) {
    f32x4 am = {0.f, 0.f, 0.f, 0.f};
#pragma unroll
    for (int i = 0; i < 8; ++i) { const f32x4 v = *(const GAS f32x4*)(W + (size_t)(k0 + 8 * i + (lane >> 3)) * N + n0 + 4 * (lane & 7));
        am[0] = fmaxf(am[0], fabsf(v[0])); am[1] = fmaxf(am[1], fabsf(v[1])); am[2] = fmaxf(am[2], fabsf(v[2])); am[3] = fmaxf(am[3], fabsf(v[3])); }
#pragma unroll
    for (int e = 0; e < 4; ++e) { am[e] = fmaxf(am[e], __shfl_xor(am[e], 8)); am[e] = fmaxf(am[e], __shfl_xor(am[e], 16)); am[e] = fmaxf(am[e], __shfl_xor(am[e], 32)); }
    if (lane < 8) {
#pragma unroll
        for (int e = 0; e < 4; ++e) atomicMax(cmax + dst0 + 4 * lane + e, __float_as_uint(am[e])); }
}
__device__ __forceinline__ void p0_quant_item(const float* W, int N, unsigned char* WT8, const unsigned* cmax, float* scale, int k0, int n0, int dst0, LAS float* scr, int lane) {
#pragma unroll
    for (int i = 0; i < 8; ++i) { const int kk = 8 * i + (lane >> 3); const f32x4 v = *(const GAS f32x4*)(W + (size_t)(k0 + kk) * N + n0 + 4 * (lane & 7));
        LAS float* d = scr + kk * 33 + 4 * (lane & 7); d[0] = v[0]; d[1] = v[1]; d[2] = v[2]; d[3] = v[3]; }
    if (lane < 32) { const float am = __uint_as_float(__hip_atomic_load(cmax + dst0 + lane, __ATOMIC_RELAXED, __HIP_MEMORY_SCOPE_AGENT)); const float sc = am > 0.f ? am * (1.f / 127.f) : 1.f;
        scr[64 * 33 + lane] = 1.f / sc; if (k0 == 0) scale[dst0 + lane] = sc; }
    LDS_WAIT(); asm volatile("" ::: "memory");
    const int c = lane & 7;
#pragma unroll
    for (int j = 0; j < 4; ++j) { const int n = (lane >> 3) + 8 * j; const LAS float* sp = scr + (8 * c) * 33 + n; const float inv = scr[64 * 33 + n];
        *(GAS v2u*)(WT8 + (size_t)(dst0 + n) * D + k0 + 8 * c) = (v2u){pack_i8x4(sp[0 * 33] * inv, sp[1 * 33] * inv, sp[2 * 33] * inv, sp[3 * 33] * inv), pack_i8x4(sp[4 * 33] * inv, sp[5 * 33] * inv, sp[6 * 33] * inv, sp[7 * 33] * inv)}; }
    LDS_WAIT(); asm volatile("" ::: "memory");
}
__device__ __forceinline__ int glu_dst(int n0) {
    if (n0 < 3072) return n0;
    const int ch = (n0 - 3072) & 1023, gate = (n0 - 3072) >> 10; return 3072 + 256 * (ch >> 7) + 128 * gate + (ch & 127);
}
__device__ __forceinline__ void p0_quant_x(const float* src, unsigned char* dst8, float* scale, int rows, int gw, int NGW, int lane) {
    f32x4 nx[8], nx2[8];
    if (gw < rows) { const GAS f32x4* sp = (const GAS f32x4*)(src + (size_t)gw * D) + lane; const int r1 = (gw + NGW < rows) ? gw + NGW : gw; const GAS f32x4* sq = (const GAS f32x4*)(src + (size_t)r1 * D) + lane;
#pragma unroll
        for (int j = 0; j < 8; ++j) { nx[j] = sp[64 * j]; nx2[j] = sq[64 * j]; } }
    for (int r = gw; r < rows; r += NGW) {
        f32x4 v[8]; float am = 0.f;
#pragma unroll
        for (int j = 0; j < 8; ++j) { v[j] = nx[j]; nx[j] = nx2[j]; }
        { const int rn = (r + 2 * NGW < rows) ? r + 2 * NGW : r; const GAS f32x4* sp = (const GAS f32x4*)(src + (size_t)rn * D) + lane;
#pragma unroll
          for (int j = 0; j < 8; ++j) nx2[j] = sp[64 * j]; }
#pragma unroll
        for (int j = 0; j < 8; ++j) am = fmaxf(fmaxf(am, fmaxf(fabsf(v[j].x), fabsf(v[j].y))), fmaxf(fabsf(v[j].z), fabsf(v[j].w)));
#pragma unroll
        for (int o = 1; o < 64; o <<= 1) am = fmaxf(am, __shfl_xor(am, o));
        const float sc = am > 0.f ? am * (1.f / 127.f) : 1.f, inv = 1.f / sc;
        GAS unsigned* dp = (GAS unsigned*)(dst8 + (size_t)r * D) + lane;
#pragma unroll
        for (int j = 0; j < 8; ++j) dp[64 * j] = pack_i8x4(v[j].x * inv, v[j].y * inv, v[j].z * inv, v[j].w * inv);
        if (lane == 0) scale[r] = sc;
    }
}
__device__ __forceinline__ void p0_convert(const float* src, bf16* dst, size_t n, int gw, int NGW, int lane) {
    const size_t nit = n / 512;
    for (size_t it = gw; it < nit; it += NGW) { const GAS f32x4* s = (const GAS f32x4*)(src + it * 512) + 2 * lane; const f32x4 a = s[0], b = s[1];
        v4u o; o.x = pk2(a.x, a.y); o.y = pk2(a.z, a.w); o.z = pk2(b.x, b.y); o.w = pk2(b.z, b.w); *((GAS v4u*)(dst + it * 512) + lane) = o; }
}
template <bool INT8> __device__ __forceinline__ void p0_quant_rows(const float* src, unsigned* dst8, float* scale, int rows, int gw, int NGW, int lane) {
    f32x4 nx[8], nx2[8];
    if (gw < rows) { const GAS f32x4* sp = (const GAS f32x4*)(src + (size_t)gw * D) + lane; const int r1 = (gw + NGW < rows) ? gw + NGW : gw; const GAS f32x4* sq = (const GAS f32x4*)(src + (size_t)r1 * D) + lane;
#pragma unroll
        for (int j = 0; j < 8; ++j) { nx[j] = sp[64 * j]; nx2[j] = sq[64 * j]; } }
    for (int r = gw; r < rows; r += NGW) {
        f32x4 v[8]; float am = 0.f;
#pragma unroll
        for (int j = 0; j < 8; ++j) { v[j] = nx[j]; nx[j] = nx2[j]; }
        { const int rn = (r + 2 * NGW < rows) ? r + 2 * NGW : r; const GAS f32x4* sp = (const GAS f32x4*)(src + (size_t)rn * D) + lane;
#pragma unroll
          for (int j = 0; j < 8; ++j) nx2[j] = sp[64 * j]; }
#pragma unroll
        for (int j = 0; j < 8; ++j) am = fmaxf(fmaxf(am, fmaxf(fabsf(v[j].x), fabsf(v[j].y))), fmaxf(fabsf(v[j].z), fabsf(v[j].w)));
#pragma unroll
        for (int o = 1; o < 64; o <<= 1) am = fmaxf(am, __shfl_xor(am, o));
        const float sc = am > 0.f ? am * (INT8 ? (1.f / 127.f) : (1.f / 440.f)) : 1.f, inv = 1.f / sc;
#pragma unroll
        for (int j = 0; j < 8; ++j) { int w;
            if (INT8) w = (int)pack_i8x4(v[j].x * inv, v[j].y * inv, v[j].z * inv, v[j].w * inv);
            else { w = __builtin_amdgcn_cvt_pk_fp8_f32(v[j].x * inv, v[j].y * inv, 0, false); w = __builtin_amdgcn_cvt_pk_fp8_f32(v[j].z * inv, v[j].w * inv, w, true); }
            const int wi = lane + 64 * j, c = wi >> 5; *((GAS unsigned*)dst8 + ((size_t)c * rows + r) * 32 + (wi & 31)) = (unsigned)w; }
        if (lane == 0) scale[r] = sc;
    }
}
__device__ __forceinline__ void p0_quant_u4(const float* src, unsigned* dst4, float* scale, int rows, int gw, int NGW, int lane) {
    f32x4 nx[8], nx2[8];
    if (gw < rows) { const GAS f32x4* sp = (const GAS f32x4*)(src + (size_t)gw * D) + lane; const int r1 = (gw + NGW < rows) ? gw + NGW : gw; const GAS f32x4* sq = (const GAS f32x4*)(src + (size_t)r1 * D) + lane;
#pragma unroll
        for (int j = 0; j < 8; ++j) { nx[j] = sp[64 * j]; nx2[j] = sq[64 * j]; } }
    for (int r = gw; r < rows; r += NGW) {
        f32x4 v[8]; float ss = 0.f;
#pragma unroll
        for (int j = 0; j < 8; ++j) { v[j] = nx[j]; nx[j] = nx2[j]; }
        { const int rn = (r + 2 * NGW < rows) ? r + 2 * NGW : r; const GAS f32x4* sp = (const GAS f32x4*)(src + (size_t)rn * D) + lane;
#pragma unroll
          for (int j = 0; j < 8; ++j) nx2[j] = sp[64 * j]; }
#pragma unroll
        for (int j = 0; j < 8; ++j) ss += (v[j].x * v[j].x + v[j].y * v[j].y) + (v[j].z * v[j].z + v[j].w * v[j].w);
        ss = wave_sum(ss);
        const float sc = ss > 0.f ? 0.35f * sqrtf(ss * (1.f / D)) : 1.f, inv = 1.f / sc;
#pragma unroll
        for (int j = 0; j < 8; ++j) { unsigned own = 0;
#pragma unroll
            for (int e = 0; e < 4; ++e) { const int q = (int)fminf(fmaxf(rintf(v[j][e] * inv), -8.f), 7.f) + 8; own |= (unsigned)q << (8 * e); }
            const unsigned nbr = (unsigned)dppi<0xB1>((int)own);
            if ((lane & 1) == 0) *((GAS unsigned*)dst4 + ((size_t)j * rows + r) * 32 + (lane >> 1)) = own | (nbr << 4); }
        if (lane == 0) scale[r] = sc;
    }
}
__device__ __forceinline__ int t5_bucket(int d) {
    if (d < 16) return d;
    int l = 16 + (int)(logf((float)d / 16.f) / logf(8.f) * 16.f); return l < 31 ? l : 31;
}
__device__ __forceinline__ void p0a_prologue(Frame& F) {
    LAS float* scr = (LAS float*)(F.lds + F.wave_() * 16384);
    constexpr int I_IN = (D / 64) * (NPROJ / 32), I_OUT = (D / 64) * (D / 32);
    { const float* w_in = F.in(I_WIN); unsigned* cmax = F.ws<unsigned>(WS_CMAX); const int gw = F.vcu_() * NWAVES + F.wave_(), NGW = F.G_() * NWAVES;
      for (int r = gw; r < I_IN; r += NGW) { const int nblk = NPROJ / 32, kb = r / nblk, nb = r % nblk; p0_colmax_item(w_in, NPROJ, cmax, 64 * kb, 32 * nb, glu_dst(32 * nb), F.lane()); } }
    { const float* wq = F.in(I_WQ); unsigned* cmax = F.ws<unsigned>(WS_CMAX) + NPROJ; const int gw = F.vcu_() * NWAVES + F.wave_(), NGW = F.G_() * NWAVES;
      for (int r = gw; r < I_OUT; r += NGW) { const int nblk = D / 32, kb = r / nblk, nb = r % nblk; p0_colmax_item(wq, D, cmax, 64 * kb, 32 * nb, 32 * nb, F.lane()); } }
    { const float* wo = F.in(I_WOUT); unsigned* cmax = F.ws<unsigned>(WS_CMAX) + NPROJ + D; const int gw = F.vcu_() * NWAVES + F.wave_(), NGW = F.G_() * NWAVES;
      for (int r = gw; r < I_OUT; r += NGW) { const int nblk = D / 32, kb = r / nblk, nb = r % nblk; p0_colmax_item(wo, D, cmax, 64 * kb, 32 * nb, 32 * nb, F.lane()); } }
    { const int gw = F.vcu_() * NWAVES + F.wave_(), NGW = F.G_() * NWAVES; p0_quant_x(F.in(I_X), F.ws<unsigned char>(WS_XB), F.ws<float>(WS_SXA), M, gw, NGW, F.lane()); }
    { const int gw = F.vcu_() * NWAVES + F.wave_(), NGW = F.G_() * NWAVES; p0_quant_u4(F.in(I_U), F.ws<unsigned>(WS_U8), F.ws<float>(WS_SU), NEXP, gw, NGW, F.lane()); }
    { const int gw = F.vcu_() * NWAVES + F.wave_(), NGW = F.G_() * NWAVES; p0_quant_rows<true>(F.in(I_V), F.ws<unsigned>(WS_V8), F.ws<float>(WS_SV), NEXP, gw, NGW, F.lane()); }
    { const int gw = F.vcu_() * NWAVES + F.wave_(), NGW = F.G_() * NWAVES; p0_convert(F.in(I_KEYS), F.ws<bf16>(WS_KEYS), (size_t)PH * 2 * PNK * PHALF, gw, NGW, F.lane()); }
    if (blockIdx.x == 0) { const float* rel_bias = F.in(I_RELB); float* TAB = F.ws<float>(WS_TAB);
        for (int i = F.tid(); i < 8 * 128; i += NWAVES * 64) { const int h = i >> 7, d = i & 127;
            TAB[i] = (rel_bias[t5_bucket(d) * 8 + h] - rel_bias[31 * 8 + h]) * 1.4426950408889634f; } }
}
__device__ __forceinline__ void p0b_prologue(Frame& F) {
    LAS float* scr = (LAS float*)(F.lds + F.wave_() * 16384);
    constexpr int I_IN = (D / 64) * (NPROJ / 32), I_OUT = (D / 64) * (D / 32);
    { const float* w_in = F.in(I_WIN); unsigned char* W8 = F.ws<unsigned char>(WS_WIN); const unsigned* cmax = F.ws<unsigned>(WS_CMAX); float* sw = F.ws<float>(WS_SWIN); const int gw = F.vcu_() * NWAVES + F.wave_(), NGW = F.G_() * NWAVES;
      for (int r = gw; r < I_IN; r += NGW) { const int nblk = NPROJ / 32, kb = r / nblk, nb = r % nblk; p0_quant_item(w_in, NPROJ, W8, cmax, sw, 64 * kb, 32 * nb, glu_dst(32 * nb), scr, F.lane()); } }
    { const float* wq = F.in(I_WQ); unsigned char* W8 = F.ws<unsigned char>(WS_WQ); const unsigned* cmax = F.ws<unsigned>(WS_CMAX) + NPROJ; float* sw = F.ws<float>(WS_SWQ); const int gw = F.vcu_() * NWAVES + F.wave_(), NGW = F.G_() * NWAVES;
      for (int r = gw; r < I_OUT; r += NGW) { const int nblk = D / 32, kb = r / nblk, nb = r % nblk; p0_quant_item(wq, D, W8, cmax, sw, 64 * kb, 32 * nb, 32 * nb, scr, F.lane()); } }
    { const float* wo = F.in(I_WOUT); unsigned char* W8 = F.ws<unsigned char>(WS_WOUT); const unsigned* cmax = F.ws<unsigned>(WS_CMAX) + NPROJ + D; float* sw = F.ws<float>(WS_SWOUT); const int gw = F.vcu_() * NWAVES + F.wave_(), NGW = F.G_() * NWAVES;
      for (int r = gw; r < I_OUT; r += NGW) { const int nblk = D / 32, kb = r / nblk, nb = r % nblk; p0_quant_item(wo, D, W8, cmax, sw, 64 * kb, 32 * nb, 32 * nb, scr, F.lane()); } }
}

__device__ __forceinline__ float diff_lambda(Frame& F) {
    const float a = wave_sum(F.in(I_LQ1)[F.lane()] * F.in(I_LK1)[F.lane()]), b = wave_sum(F.in(I_LQ2)[F.lane()] * F.in(I_LK2)[F.lane()]);
    return expf(a) - expf(b) + LAMBDA_INIT;
}
template <int CTRL, int RM> __device__ __forceinline__ float dpp_rm(float old, float v) { return __int_as_float(__builtin_amdgcn_update_dpp(__float_as_int(old), __float_as_int(v), CTRL, RM, 0xf, false)); }
__device__ __forceinline__ float wave_sum63(float v) {
    v += dppf<0xB1>(v); v += dppf<0x4E>(v); v += dppf<0x141>(v); v += dppf<0x140>(v);
    v += dpp_rm<0x142, 0xa>(0.f, v);
    v += dpp_rm<0x143, 0xc>(0.f, v);
    return v;
}
__device__ __forceinline__ float wave_max63(float v) {
    v = fmaxf(v, dppf<0xB1>(v)); v = fmaxf(v, dppf<0x4E>(v)); v = fmaxf(v, dppf<0x141>(v)); v = fmaxf(v, dppf<0x140>(v));
    v = fmaxf(v, dpp_rm<0x142, 0xa>(0.f, v)); v = fmaxf(v, dpp_rm<0x143, 0xc>(0.f, v));
    return v;
}
__device__ __forceinline__ void p3_mix(Frame& F) {
    constexpr int TT = 32, NPR = (TT + CONVW - 1) / 2, STATS_OFF = NPR * 4096, AMC_OFF = STATS_OFF + 2048, AMA_OFF = AMC_OFF + 1024, MS_OFF = AMA_OFF + 128, INV_OFF = MS_OFF + 256, STG_OFF = (TT / 2) * 4096;
    static_assert(INV_OFF + 128 <= RING_BYTES && STG_OFF + TT * 1024 <= STATS_OFF, "P3 LDS map");
    const int tid = F.tid(), lane = tid & 63, wave = F.wave_();
    const float lam = diff_lambda(F);
    const float* conv_w = F.in(I_CONVW); const bf16* H = F.ws<bf16>(WS_H); const bf16* O1 = F.ws<bf16>(WS_O1); const bf16* O2 = F.ws<bf16>(WS_O2);
    unsigned char* MIX8 = F.ws<unsigned char>(WS_XB); float* SM = F.ws<float>(WS_SM); const float* subln_g = F.in(I_SUBLN);
    const float2 cb = *(const float2*)(F.in(I_CONVB) + 2 * tid), lg = *(const float2*)(F.in(I_CLNG) + 2 * tid), lb = *(const float2*)(F.in(I_CLNB) + 2 * tid);
    LAS float* stats = (LAS float*)(F.lds + STATS_OFF); LAS float* amc = (LAS float*)(F.lds + AMC_OFF); LAS float* ama = (LAS float*)(F.lds + AMA_OFF); LAS float* ms = (LAS float*)(F.lds + MS_OFF); LAS float* invs = (LAS float*)(F.lds + INV_OFF);
    for (int tile_i = F.vcu_(); tile_i < M / TT; tile_i += F.G_()) {
        const int t0 = tile_i * TT, s0 = t0 & (SEQ - 1);
        for (int p = tid >> 7; p < NPR; p += 4) { const int sp = s0 - (CONVW - 1) + 2 * p; v4u a = (v4u){0u, 0u, 0u, 0u}, b = a;
            if (sp >= 0) { const GAS v4u* hp = (const GAS v4u*)(H + (size_t)(t0 - (CONVW - 1) + 2 * p) * 1024) + (tid & 127); a = hp[0]; b = hp[128]; }
            const unsigned aw[4] = {a.x, a.y, a.z, a.w}, bw[4] = {b.x, b.y, b.z, b.w}; unsigned o[8];
#pragma unroll
            for (int k = 0; k < 4; ++k) { o[2 * k] = __builtin_amdgcn_perm(bw[k], aw[k], 0x05040100u); o[2 * k + 1] = __builtin_amdgcn_perm(bw[k], aw[k], 0x07060302u); }
            LAS v4u* dst = (LAS v4u*)(F.lds + p * 4096 + (tid & 127) * 32); dst[0] = (v4u){o[0], o[1], o[2], o[3]}; dst[1] = (v4u){o[4], o[5], o[6], o[7]}; }
        __syncthreads();
        {
            unsigned we0[16], we1[16], wo0[16], wo1[16]; float2 wprev = {0.f, 0.f};
#pragma unroll
            for (int q = 0; q < 16; ++q) { const float2 wa = *(const float2*)(conv_w + (2 * q) * DCONV + 2 * tid); float2 wb = {0.f, 0.f}; if (2 * q + 1 < CONVW) wb = *(const float2*)(conv_w + (2 * q + 1) * DCONV + 2 * tid);
                we0[q] = pk2(wa.x, wb.x); we1[q] = pk2(wa.y, wb.y); wo0[q] = pk2(wprev.x, wa.x); wo1[q] = pk2(wprev.y, wa.y); wprev = wb; }
            for (int q = 0; q < TT / 2; ++q) {
                float e0 = cb.x, e1 = cb.y, o0 = cb.x, o1 = cb.y;
                const LAS v2u* src = (const LAS v2u*)(F.lds + q * 4096 + tid * 8);
#pragma unroll
                for (int j = 0; j < 16; ++j) { const v2u d = src[j * 512]; e0 = dot2bf(d.x, we0[j], e0); e1 = dot2bf(d.y, we1[j], e1); o0 = dot2bf(d.x, wo0[j], o0); o1 = dot2bf(d.y, wo1[j], o1); }
                const unsigned p0 = pk2(e0, o0), p1 = pk2(e1, o1); *(LAS v2u*)(F.lds + q * 4096 + tid * 8) = (v2u){p0, p1};
                const float re0 = bflo(p0), ro0 = bfhi(p0), re1 = bflo(p1), ro1 = bfhi(p1);
                const float se = wave_sum63(re0 + re1), qe = wave_sum63(re0 * re0 + re1 * re1), so = wave_sum63(ro0 + ro1), qo = wave_sum63(ro0 * ro0 + ro1 * ro1);
                if (lane == 63) { LAS float* st = stats + ((2 * q) * 8 + wave) * 2; st[0] = se; st[1] = qe; st[16] = so; st[17] = qo; }
            }
        }
        float av[4][16];
#pragma unroll
        for (int rr = 0; rr < 4; ++rr) { const int m = t0 + 4 * wave + rr;
            const GAS v4u* p1 = (const GAS v4u*)(O1 + (size_t)m * 1024) + 2 * lane; const GAS v4u* p2 = (const GAS v4u*)(O2 + (size_t)m * 1024) + 2 * lane;
            const v4u a0 = p1[0], a1 = p1[1], b0 = p2[0], b1 = p2[1];
            const unsigned aw[8] = {a0.x, a0.y, a0.z, a0.w, a1.x, a1.y, a1.z, a1.w}, bw[8] = {b0.x, b0.y, b0.z, b0.w, b1.x, b1.y, b1.z, b1.w};
            float ss = 0.f;
#pragma unroll
            for (int i = 0; i < 8; ++i) { av[rr][2 * i] = bflo(aw[i]) - lam * bflo(bw[i]); av[rr][2 * i + 1] = bfhi(aw[i]) - lam * bfhi(bw[i]); ss += av[rr][2 * i] * av[rr][2 * i] + av[rr][2 * i + 1] * av[rr][2 * i + 1]; }
            ss += __shfl_xor(ss, 1); ss += __shfl_xor(ss, 2); ss += __shfl_xor(ss, 4);
            const float r = (1.f - LAMBDA_INIT) / sqrtf(ss * (1.f / 128.f) + LN_EPS); float am = 0.f;
#pragma unroll
            for (int e = 0; e < 16; ++e) { av[rr][e] = av[rr][e] * r * subln_g[16 * (lane & 7) + e]; am = fmaxf(am, fabsf(av[rr][e])); }
            am = wave_max63(am);
            if (lane == 63) ama[4 * wave + rr] = am; }
        __syncthreads();
        if (tid < TT) { float s = 0.f, q = 0.f;
#pragma unroll
            for (int w = 0; w < 8; ++w) { s += stats[(tid * 8 + w) * 2]; q += stats[(tid * 8 + w) * 2 + 1]; }
            const float mean = s * (1.f / DCONV), var = fmaxf(q * (1.f / DCONV) - mean * mean, 0.f); ms[2 * tid] = mean; ms[2 * tid + 1] = 1.f / sqrtf(var + LN_EPS); }
        __syncthreads();
        for (int q = 0; q < TT / 2; ++q) {
            const f32x4 st = *(const LAS f32x4*)(ms + 4 * q);
            const v2u d = *(const LAS v2u*)(F.lds + q * 4096 + tid * 8);
            const float ye0 = (bflo(d.x) - st[0]) * st[1] * lg.x + lb.x, yo0 = (bfhi(d.x) - st[2]) * st[3] * lg.x + lb.x, ye1 = (bflo(d.y) - st[0]) * st[1] * lg.y + lb.y, yo1 = (bfhi(d.y) - st[2]) * st[3] * lg.y + lb.y;
#define SWISH_(y) ((y) * __builtin_amdgcn_rcpf(1.f + __builtin_amdgcn_exp2f(-1.4426950409f * (y))))
            const unsigned z0 = pk2(SWISH_(ye0), SWISH_(yo0)), z1 = pk2(SWISH_(ye1), SWISH_(yo1));
#undef SWISH_
            *(LAS v2u*)(F.lds + q * 4096 + tid * 8) = (v2u){z0, z1};
            const float me = wave_max63(fmaxf(fabsf(bflo(z0)), fabsf(bflo(z1)))), mo = wave_max63(fmaxf(fabsf(bfhi(z0)), fabsf(bfhi(z1))));
            if (lane == 63) { amc[(2 * q) * 8 + wave] = me; amc[(2 * q + 1) * 8 + wave] = mo; }
        }
        __syncthreads();
        if (tid < TT) { float am = ama[tid];
#pragma unroll
            for (int w = 0; w < 8; ++w) am = fmaxf(am, amc[tid * 8 + w]);
            const float sc = am > 0.f ? am * (1.f / 127.f) : 1.f; invs[tid] = 1.f / sc; SM[t0 + tid] = sc; }
        __syncthreads();
        for (int q = 0; q < TT / 2; ++q) {
            const float ie = invs[2 * q], io = invs[2 * q + 1];
            const v2u d = *(const LAS v2u*)(F.lds + q * 4096 + tid * 8);
            const int qe0 = (int)rintf(bflo(d.x) * ie), qe1 = (int)rintf(bflo(d.y) * ie), qo0 = (int)rintf(bfhi(d.x) * io), qo1 = (int)rintf(bfhi(d.y) * io);
            *(LAS unsigned short*)(F.lds + STG_OFF + (2 * q) * 1024 + 2 * tid) = (unsigned short)((qe0 & 255) | ((qe1 & 255) << 8));
            *(LAS unsigned short*)(F.lds + STG_OFF + (2 * q + 1) * 1024 + 2 * tid) = (unsigned short)((qo0 & 255) | ((qo1 & 255) << 8));
        }
#pragma unroll
        for (int rr = 0; rr < 4; ++rr) { const float inv = invs[4 * wave + rr];
            *((GAS v4u*)(MIX8 + (size_t)(t0 + 4 * wave + rr) * D) + lane) = (v4u){pack_i8x4(av[rr][0] * inv, av[rr][1] * inv, av[rr][2] * inv, av[rr][3] * inv), pack_i8x4(av[rr][4] * inv, av[rr][5] * inv, av[rr][6] * inv, av[rr][7] * inv),
                                                                              pack_i8x4(av[rr][8] * inv, av[rr][9] * inv, av[rr][10] * inv, av[rr][11] * inv), pack_i8x4(av[rr][12] * inv, av[rr][13] * inv, av[rr][14] * inv, av[rr][15] * inv)}; }
        __syncthreads();
        for (int idx = tid; idx < TT * 64; idx += NWAVES * 64) { const int row = idx >> 6, ch = idx & 63;
            *((GAS v4u*)(MIX8 + (size_t)(t0 + row) * D + DATT) + ch) = *(const LAS v4u*)(F.lds + STG_OFF + row * 1024 + ch * 16); }
        __syncthreads();
    }
}
__device__ __forceinline__ void p5_ln1(Frame& F) {
    const bf16* Y1 = F.ws<bf16>(WS_Y1); const float* ln1_g = F.in(I_LN1G); const float* ln1_b = F.in(I_LN1B); unsigned char* X8 = F.ws<unsigned char>(WS_X8); float* SX = F.ws<float>(WS_SX); float* LNS = F.ws<float>(WS_LNS); float* SXQ = F.ws<float>(WS_SXQ);
    const int gw = F.vcu_() * NWAVES + F.wave_(), NGW = F.G_() * NWAVES, lane = F.lane();
    v4u nx[4];
    if (gw < M) { const GAS v4u* p = (const GAS v4u*)(Y1 + (size_t)gw * D) + lane;
#pragma unroll
        for (int j = 0; j < 4; ++j) nx[j] = p[64 * j]; }
    for (int m = gw; m < M; m += NGW) {
        v4u w[4]; float v[32]; float s = 0.f;
#pragma unroll
        for (int j = 0; j < 4; ++j) w[j] = nx[j];
        { const int mn = (m + NGW < M) ? m + NGW : m; const GAS v4u* p = (const GAS v4u*)(Y1 + (size_t)mn * D) + lane;
#pragma unroll
          for (int j = 0; j < 4; ++j) nx[j] = p[64 * j]; }
#pragma unroll
        for (int j = 0; j < 4; ++j) { const unsigned ww[4] = {w[j].x, w[j].y, w[j].z, w[j].w};
#pragma unroll
            for (int i = 0; i < 4; ++i) { v[8 * j + 2 * i] = bflo(ww[i]); v[8 * j + 2 * i + 1] = bfhi(ww[i]); s += v[8 * j + 2 * i] + v[8 * j + 2 * i + 1]; } }
        const float mean = wave_sum(s) * (1.f / D); float q = 0.f;
#pragma unroll
        for (int i = 0; i < 32; ++i) { v[i] -= mean; q += v[i] * v[i]; }
        const float rstd = 1.f / sqrtf(wave_sum(q) * (1.f / D) + LN_EPS);
        float am = 0.f;
#pragma unroll
        for (int j = 0; j < 4; ++j) { const int c0 = 8 * lane + 512 * j; const f32x4 g0 = *(const f32x4*)(ln1_g + c0), g1 = *(const f32x4*)(ln1_g + c0 + 4), b0 = *(const f32x4*)(ln1_b + c0), b1 = *(const f32x4*)(ln1_b + c0 + 4);
#pragma unroll
            for (int i = 0; i < 4; ++i) { v[8 * j + i] = v[8 * j + i] * rstd * g0[i] + b0[i]; v[8 * j + 4 + i] = v[8 * j + 4 + i] * rstd * g1[i] + b1[i]; am = fmaxf(am, fmaxf(fabsf(v[8 * j + i]), fabsf(v[8 * j + 4 + i]))); } }
#pragma unroll
        for (int o = 1; o < 64; o <<= 1) am = fmaxf(am, __shfl_xor(am, o));
        const float sc = am > 0.f ? am * (1.f / 127.f) : 1.f, inv = 1.f / sc;
        GAS v2u* p8 = (GAS v2u*)(X8 + (size_t)m * D) + lane;
#pragma unroll
        for (int j = 0; j < 4; ++j) p8[64 * j] = (v2u){pack_i8x4(v[8 * j] * inv, v[8 * j + 1] * inv, v[8 * j + 2] * inv, v[8 * j + 3] * inv), pack_i8x4(v[8 * j + 4] * inv, v[8 * j + 5] * inv, v[8 * j + 6] * inv, v[8 * j + 7] * inv)};
        float qs = 0.f;
#pragma unroll
        for (int i = 0; i < 32; ++i) qs += rintf(v[i] * inv);
        qs = wave_sum(qs);
        if (lane == 0) { SX[m] = sc; LNS[2 * m] = mean; LNS[2 * m + 1] = rstd; SXQ[m] = qs; }
    }
}
__device__ __forceinline__ int f2key(float f) { const int b = __float_as_int(f); return b ^ ((b >> 31) & 0x7fffffff); }
__device__ __forceinline__ float key2f(int k) { return __int_as_float(k ^ ((k >> 31) & 0x7fffffff)); }
#define CE_DESC(a, b) do { const int _x = max(a, b), _y = min(a, b); a = _x; b = _y; } while (0)
#define CE_ASC(a, b)  do { const int _x = min(a, b), _y = max(a, b); a = _x; b = _y; } while (0)
template <int N> __device__ __forceinline__ void sort_desc(int (&v)[N]) {
#pragma unroll
    for (int k = 2; k <= N; k <<= 1)
#pragma unroll
        for (int j = k >> 1; j > 0; j >>= 1)
#pragma unroll
            for (int i = 0; i < N; ++i) { const int l = i ^ j; if (l > i) { if ((i & k) == 0) CE_DESC(v[i], v[l]); else CE_ASC(v[i], v[l]); } }
}
template <int N> __device__ __forceinline__ void bitonic_merge_desc(int (&v)[N]) {
#pragma unroll
    for (int j = N >> 1; j > 0; j >>= 1)
#pragma unroll
        for (int i = 0; i < N; ++i) { const int l = i ^ j; if (l > i) CE_DESC(v[i], v[l]); }
}
__device__ __forceinline__ void merge16(const int (&a)[16], const int (&b)[16], int (&o)[16]) {
#pragma unroll
    for (int i = 0; i < 16; ++i) o[i] = max(a[i], b[15 - i]);
    bitonic_merge_desc<16>(o);
}
__device__ __forceinline__ void top16_of_64(const int (&v)[64], int (&o)[16]) {
    int g0[16], g1[16], g2[16], g3[16];
#pragma unroll
    for (int i = 0; i < 16; ++i) { g0[i] = v[i]; g1[i] = v[16 + i]; g2[i] = v[32 + i]; g3[i] = v[48 + i]; }
    sort_desc<16>(g0); sort_desc<16>(g1); sort_desc<16>(g2); sort_desc<16>(g3);
    int m0[16], m1[16]; merge16(g0, g1, m0); merge16(g2, g3, m1); merge16(m0, m1, o);
}
__device__ const unsigned char PEER_PAIR[64] = {0,1,2,3,4,5,6,7,8,9,10,11,12,13,14,15, 16,17,18,19,20,21,22,23, 32,33,34,35,36, 48,49,50,51, 64,65,66, 80,81, 96,97, 112,113, 128,144,160,176,192,208,224,240, 0,0,0,0,0,0,0,0,0,0,0,0,0,0};
__device__ __forceinline__ void peer_subkey_top16(const bf16* qrow  , const bf16* keys_hc  , int r32, int hi, int (&o)[16]) {
    bf16x8 bq[8];
    asm volatile("" : "+v"(qrow));
#pragma unroll
    for (int s = 0; s < 8; ++s) bq[s] = *(const bf16x8*)(qrow + 8 * s);
    int run[16];
#pragma unroll
    for (int mt = 0; mt < 4; ++mt) {
        const bf16* krow = keys_hc + (size_t)(32 * mt + r32) * PHALF + hi * 64;
        asm volatile("" : "+v"(krow));
        bf16x8 ka[8];
#pragma unroll
        for (int s = 0; s < 8; ++s) ka[s] = *(const bf16x8*)(krow + 8 * s);
#ifdef PEER_A_FENCE
        asm volatile("" ::: "memory");
#endif
        f32x16 acc = {};
#pragma unroll
        for (int s = 0; s < 8; ++s) acc = __builtin_amdgcn_mfma_f32_32x32x16_bf16(ka[s], bq[s], acc, 0, 0, 0);
        int g[16];
#pragma unroll
        for (int r = 0; r < 16; ++r) g[r] = (f2key(acc[r]) & ~127) | ((r & 3) + 8 * (r >> 2));
        sort_desc<16>(g);
        if (mt) {
#pragma unroll
            for (int r = 0; r < 16; ++r) g[r] |= 32 * mt; }
        if (mt == 0) {
#pragma unroll
            for (int r = 0; r < 16; ++r) run[r] = g[r];
        } else { int t2[16]; merge16(run, g, t2);
#pragma unroll
            for (int r = 0; r < 16; ++r) run[r] = t2[r]; }
    }
    int lo[16], hh[16]; const int hi4 = 4 * hi;
#pragma unroll
    for (int i = 0; i < 16; ++i) { run[i] |= hi4; auto rr = __builtin_amdgcn_permlane32_swap((unsigned)run[i], (unsigned)run[i], false, false); lo[i] = (int)rr[0]; hh[i] = (int)rr[1]; }
    merge16(lo, hh, o);
}
__device__ __forceinline__ float gelu_erf(float v) { return 0.5f * v * (1.f + erff(v * 0.70710678118654752f)); }

typedef float f32x2 __attribute__((ext_vector_type(2)));
constexpr int P7_W8 = 98304, P7_SW = 114688;
constexpr int P7_ACT = 0, P7_EID = 65536, P7_SCR = 0  , P7_SCR_WAVE = 32 * 33 * 4, PCH = 128, NCH = D / PCH;
static_assert(P7_SCR + NWAVES * P7_SCR_WAVE <= P7_EID && P7_EID + 128 * 128 * 2 <= RING_BYTES, "PEER LDS map");

__device__ __forceinline__ void p7_peer(Frame& F) {
    const int lane = F.lane(), r32 = lane & 31, hi = lane >> 5, j8 = lane & 7, g8 = lane >> 3;
    constexpr int TPB = 128;
    LAS float* ACT = (LAS float*)(F.lds + P7_ACT); LAS unsigned short* EIDL = (LAS unsigned short*)(F.lds + P7_EID);
    LAS int* scr = (LAS int*)(F.lds + P7_SCR + F.wave_() * P7_SCR_WAVE);
    for (int blk = F.vcu_(); blk < M / TPB; blk += F.G_()) {
        const int m0 = blk * TPB;
        { const int h = F.wave_(); const bf16* QP = F.ws<bf16>(WS_QP); const bf16* KEYS = F.ws<bf16>(WS_KEYS); float* GATE = F.ws<float>(WS_GATE);
          for (int tt = 0; tt < 4; ++tt) {
            const int tl = 32 * tt + r32, tok = m0 + tl;
            const bf16* qrow = QP + (size_t)tok * D + h * 256 + hi * 64;
            int s1[16], s2[16];
            peer_subkey_top16(qrow, KEYS + (size_t)(h * 2 + 0) * PNK * PHALF, r32, hi, s1);
            asm volatile("" ::: "memory");
            peer_subkey_top16(qrow + 128, KEYS + (size_t)(h * 2 + 1) * PNK * PHALF, r32, hi, s2);
            float f1[16], f2[16];
#pragma unroll
            for (int i = 0; i < 16; ++i) { f1[i] = key2f(s1[i]); f2[i] = key2f(s2[i]); }
            if (hi == 0) {
#pragma unroll
                for (int i = 0; i < 16; ++i) { scr[r32 * 33 + i] = s1[i] & 127; scr[r32 * 33 + 16 + i] = s2[i] & 127; } }
            int cand[64];
            {
#define PC(n_, i_, j_) cand[n_] = (f2key(f1[i_] + f2[j_]) & ~255) | (n_)
                PC(0,0,0); PC(1,0,1); PC(2,0,2); PC(3,0,3); PC(4,0,4); PC(5,0,5); PC(6,0,6); PC(7,0,7); PC(8,0,8); PC(9,0,9); PC(10,0,10); PC(11,0,11); PC(12,0,12); PC(13,0,13); PC(14,0,14); PC(15,0,15);
                PC(16,1,0); PC(17,1,1); PC(18,1,2); PC(19,1,3); PC(20,1,4); PC(21,1,5); PC(22,1,6); PC(23,1,7);
                PC(24,2,0); PC(25,2,1); PC(26,2,2); PC(27,2,3); PC(28,2,4);
                PC(29,3,0); PC(30,3,1); PC(31,3,2); PC(32,3,3);
                PC(33,4,0); PC(34,4,1); PC(35,4,2);
                PC(36,5,0); PC(37,5,1); PC(38,6,0); PC(39,6,1); PC(40,7,0); PC(41,7,1);
                PC(42,8,0); PC(43,9,0); PC(44,10,0); PC(45,11,0); PC(46,12,0); PC(47,13,0); PC(48,14,0); PC(49,15,0);
#undef PC
            }
#pragma unroll
            for (int i = 50; i < 64; ++i) cand[i] = (int)0x80000000;
            int sc[16]; top16_of_64(cand, sc);
            float p[16]; const float mx = key2f(sc[0]); float z = 0.f;
#pragma unroll
            for (int k = 0; k < 16; ++k) { p[k] = __expf(key2f(sc[k]) - mx); z += p[k]; }
            const float rz = 1.f / z;
            LDS_WAIT();
            int eo[8]; float go[8]; const int him = -hi;
#pragma unroll
            for (int kk = 0; kk < 8; ++kk) { const int tag = PEER_PAIR[((sc[kk] & ~him) | (sc[8 + kk] & him)) & 255];
                const int i1 = scr[r32 * 33 + (tag >> 4)], i2 = scr[r32 * 33 + 16 + (tag & 15)];
                eo[kk] = i1 * PNK + i2; go[kk] = __int_as_float((__float_as_int(p[kk]) & ~him) | (__float_as_int(p[8 + kk]) & him)) * rz; }
            *(LAS v4u*)(EIDL + tl * 128 + h * 16 + 8 * hi) = (v4u){(unsigned)(eo[0] | (eo[1] << 16)), (unsigned)(eo[2] | (eo[3] << 16)), (unsigned)(eo[4] | (eo[5] << 16)), (unsigned)(eo[6] | (eo[7] << 16))};
            GAS float* gp = (GAS float*)(GATE + (size_t)tok * 128 + h * 16 + 8 * hi);
            *(GAS f32x4*)gp = (f32x4){go[0], go[1], go[2], go[3]}; *(GAS f32x4*)(gp + 4) = (f32x4){go[4], go[5], go[6], go[7]};
            LDS_WAIT();
          } }
        __threadfence_block(); __syncthreads();
        const int tw = F.wave_() * (TPB / NWAVES);
        for (int i = lane; i < (TPB / NWAVES) * 128; i += 64) ACT[tw * 128 + i] = 0.f;
        { const unsigned char* X8 = F.ws<unsigned char>(WS_X8); const unsigned char* U8 = F.ws<unsigned char>(WS_U8);
#define U_ISSUE(n_, PC, XQ0, XQ1) do { const int c_ = (n_) >> 4, tl_ = tw + ((n_) & 15); \
            { const GAS v4u* xp_ = (const GAS v4u*)(X8 + (size_t)(m0 + tl_) * D + c_ * UCH + 32 * j8); XQ0 = xp_[0]; XQ1 = xp_[1]; } \
            const LAS unsigned short* ep_ = EIDL + tl_ * 128 + g8; const unsigned char* ub_ = U8 + (size_t)c_ * (NEXP * PCH) + 16 * j8; \
            _Pragma("unroll") for (int i = 0; i < 16; ++i) { const unsigned e_ = ep_[8 * i]; PC[i] = *(const GAS v4u*)(ub_ + e_ * PCH); } } while (0)
#define U_COMPUTE(n_, PC, XQ0, XQ1) do { const int tl_ = tw + ((n_) & 15); \
            const unsigned xw_[8] = {XQ0.x, XQ0.y, XQ0.z, XQ0.w, XQ1.x, XQ1.y, XQ1.z, XQ1.w}; int pp_[16]; \
            _Pragma("unroll") for (int i = 0; i < 16; ++i) { const unsigned w4_[4] = {PC[i].x, PC[i].y, PC[i].z, PC[i].w}; int a_ = 0; \
                _Pragma("unroll") for (int m = 0; m < 4; ++m) { a_ = __builtin_amdgcn_sdot4((int)(w4_[m] & 0x0f0f0f0fu), (int)xw_[2 * m], a_, false); a_ = __builtin_amdgcn_sdot4((int)((w4_[m] >> 4) & 0x0f0f0f0fu), (int)xw_[2 * m + 1], a_, false); } \
                pp_[i] = a_; } \
              \
            int q8_[8], q4_[4], q2_[2]; \
            { const bool b2_ = lane & 4; _Pragma("unroll") for (int i = 0; i < 8; ++i) { const int k_ = b2_ ? pp_[2 * i + 1] : pp_[2 * i], s_ = b2_ ? pp_[2 * i] : pp_[2 * i + 1]; q8_[i] = k_ + dppi<0x141>(s_); } } \
            { const bool b1_ = lane & 2; _Pragma("unroll") for (int i = 0; i < 4; ++i) { const int k_ = b1_ ? q8_[2 * i + 1] : q8_[2 * i], s_ = b1_ ? q8_[2 * i] : q8_[2 * i + 1]; q4_[i] = k_ + dppi<0x4E>(s_); } } \
            { const bool b0_ = lane & 1; _Pragma("unroll") for (int i = 0; i < 2; ++i) { const int k_ = b0_ ? q4_[2 * i + 1] : q4_[2 * i], s_ = b0_ ? q4_[2 * i] : q4_[2 * i + 1]; q2_[i] = k_ + dppi<0xB1>(s_); } } \
            const int irow_ = ((lane & 1) << 2) | (lane & 2) | ((lane >> 2) & 1); \
            LAS float* ap_ = ACT + tl_ * 128 + 8 * irow_ + g8; ap_[0] += (float)q2_[0]; ap_[64] += (float)q2_[1]; } while (0)
          constexpr int UCH = 256, NSTEP = (D / UCH) * (TPB / NWAVES);
          v4u pcA[16], pcB[16], xqA0, xqA1, xqB0, xqB1;
          U_ISSUE(0, pcA, xqA0, xqA1);
          for (int n = 0; n < NSTEP; n += 2) {
              U_ISSUE(n + 1, pcB, xqB0, xqB1); __builtin_amdgcn_sched_barrier(0);
              U_COMPUTE(n, pcA, xqA0, xqA1); __builtin_amdgcn_sched_barrier(0);
              { const int nn = (n + 2 < NSTEP) ? n + 2 : n; U_ISSUE(nn, pcA, xqA0, xqA1); }
              __builtin_amdgcn_sched_barrier(0);
              U_COMPUTE(n + 1, pcB, xqB0, xqB1); __builtin_amdgcn_sched_barrier(0);
          }
#undef U_ISSUE
#undef U_COMPUTE
        }
        LDS_WAIT();
        { const float* SU = F.ws<float>(WS_SU); const float* SV = F.ws<float>(WS_SV); const float* GATE = F.ws<float>(WS_GATE); const float* SX = F.ws<float>(WS_SX); const float* SXQ = F.ws<float>(WS_SXQ);
        LAS unsigned char* W8L = (LAS unsigned char*)(F.lds + P7_W8); LAS float* SWL = (LAS float*)(F.lds + P7_SW);
        for (int ti = 0; ti < TPB / NWAVES; ++ti) {
            const int tl = tw + ti, t = m0 + tl; const float sx = SX[t], xoff = 8.f * SXQ[t]; float wv[2];
#pragma unroll
            for (int kq = 0; kq < 2; ++kq) { const int k = lane + 64 * kq; const unsigned e = EIDL[tl * 128 + k]; const float a = (ACT[tl * 128 + k] - xoff) * SU[e] * sx;
                wv[kq] = __builtin_nontemporal_load(GATE + (size_t)t * 128 + k) * gelu_erf(a) * SV[e]; }
            float am = fmaxf(fabsf(wv[0]), fabsf(wv[1]));
#pragma unroll
            for (int o = 1; o < 64; o <<= 1) am = fmaxf(am, __shfl_xor(am, o));
            const float sc = am > 0.f ? am * (1.f / 127.f) : 1.f, inv = 1.f / sc;
#pragma unroll
            for (int kq = 0; kq < 2; ++kq) { const int k = lane + 64 * kq; W8L[tl * 128 + (k & 7) * 16 + (k >> 3)] = (unsigned char)((int)rintf(wv[kq] * inv) & 255); }
            if (lane == 0) SWL[tl] = sc;
        } }
        LDS_WAIT();
        { const bf16* X1 = F.ws<bf16>(WS_Y1); const unsigned char* V8 = F.ws<unsigned char>(WS_V8); bf16* Y2 = F.ws<bf16>(WS_QP); const float* LNS = F.ws<float>(WS_LNS); const float* ln1_g = F.in(I_LN1G); const float* ln1_b = F.in(I_LN1B);
#define V_ISSUE(n_, PC, WQ, XP) do { const int c_ = (n_) >> 4, tl_ = tw + ((n_) & 15); \
            const LAS unsigned short* ep_ = EIDL + tl_ * 128 + g8; const unsigned char* vb_ = V8 + (size_t)c_ * (NEXP * PCH) + 16 * j8; \
            _Pragma("unroll") for (int i = 0; i < 16; ++i) { const unsigned e_ = ep_[8 * i]; PC[i] = *(const GAS v4u*)(vb_ + e_ * PCH); } \
            WQ = *(const LAS v4u*)(F.lds + P7_W8 + tl_ * 128 + g8 * 16); \
            XP = *(const GAS unsigned*)(X1 + (size_t)(m0 + tl_) * D + c_ * PCH + 16 * j8 + 2 * g8); } while (0)
#define V_COMPUTE(n_, PC, WQ, XP) do { const int c_ = (n_) >> 4, tl_ = tw + ((n_) & 15); \
            int ac_[16]; \
            _Pragma("unroll") for (int d = 0; d < 16; ++d) ac_[d] = 0; \
            const unsigned wq_[4] = {WQ.x, WQ.y, WQ.z, WQ.w}; \
            _Pragma("unroll") for (int gq = 0; gq < 4; ++gq) { \
                const unsigned pa_[4] = {PC[4 * gq].x, PC[4 * gq].y, PC[4 * gq].z, PC[4 * gq].w}, pb_[4] = {PC[4 * gq + 1].x, PC[4 * gq + 1].y, PC[4 * gq + 1].z, PC[4 * gq + 1].w}; \
                const unsigned pc_[4] = {PC[4 * gq + 2].x, PC[4 * gq + 2].y, PC[4 * gq + 2].z, PC[4 * gq + 2].w}, pd_[4] = {PC[4 * gq + 3].x, PC[4 * gq + 3].y, PC[4 * gq + 3].z, PC[4 * gq + 3].w}; \
                _Pragma("unroll") for (int m = 0; m < 4; ++m) { \
                    const unsigned t0_ = __builtin_amdgcn_perm(pb_[m], pa_[m], 0x05010400u), t1_ = __builtin_amdgcn_perm(pb_[m], pa_[m], 0x07030602u), t2_ = __builtin_amdgcn_perm(pd_[m], pc_[m], 0x05010400u), t3_ = __builtin_amdgcn_perm(pd_[m], pc_[m], 0x07030602u); \
                    ac_[4 * m + 0] = __builtin_amdgcn_sdot4((int)__builtin_amdgcn_perm(t2_, t0_, 0x05040100u), (int)wq_[gq], ac_[4 * m + 0], false); \
                    ac_[4 * m + 1] = __builtin_amdgcn_sdot4((int)__builtin_amdgcn_perm(t2_, t0_, 0x07060302u), (int)wq_[gq], ac_[4 * m + 1], false); \
                    ac_[4 * m + 2] = __builtin_amdgcn_sdot4((int)__builtin_amdgcn_perm(t3_, t1_, 0x05040100u), (int)wq_[gq], ac_[4 * m + 2], false); \
                    ac_[4 * m + 3] = __builtin_amdgcn_sdot4((int)__builtin_amdgcn_perm(t3_, t1_, 0x07060302u), (int)wq_[gq], ac_[4 * m + 3], false); } } \
              \
            int r8_[8], r4_[4], r2_[2]; \
            _Pragma("unroll") for (int i = 0; i < 8; ++i) { auto rr_ = __builtin_amdgcn_permlane32_swap((unsigned)ac_[i], (unsigned)ac_[i + 8], false, false); r8_[i] = (int)rr_[0] + (int)rr_[1]; } \
            _Pragma("unroll") for (int i = 0; i < 4; ++i) { auto rr_ = __builtin_amdgcn_permlane16_swap((unsigned)r8_[i], (unsigned)r8_[i + 4], false, false); r4_[i] = (int)rr_[0] + (int)rr_[1]; } \
            { const bool b3_ = lane & 8; _Pragma("unroll") for (int i = 0; i < 2; ++i) { const int k_ = b3_ ? r4_[i + 2] : r4_[i], s_ = b3_ ? r4_[i] : r4_[i + 2]; r2_[i] = k_ + dppi<0x128>(s_); } } \
            const float sw_ = ((const LAS float*)(F.lds + P7_SW))[tl_]; \
            const f32x2 ms_ = *(const f32x2*)(LNS + 2 * (size_t)(m0 + tl_)), gg_ = *(const f32x2*)(ln1_g + c_ * PCH + 16 * j8 + 2 * g8), bb_ = *(const f32x2*)(ln1_b + c_ * PCH + 16 * j8 + 2 * g8); \
            const float x0_ = (bflo(XP) - ms_.x) * ms_.y * gg_.x + bb_.x, x1_ = (bfhi(XP) - ms_.x) * ms_.y * gg_.y + bb_.y; \
            *(GAS unsigned*)(Y2 + (size_t)(m0 + tl_) * D + c_ * PCH + 16 * j8 + 2 * g8) = pk2((float)r2_[0] * sw_ + DN_ALPHA * x0_, (float)r2_[1] * sw_ + DN_ALPHA * x1_); } while (0)
          constexpr int NSTEP = NCH * (TPB / NWAVES);
          v4u pcA[16], pcB[16], wqA, wqB; unsigned xpA, xpB;
          V_ISSUE(0, pcA, wqA, xpA);
          for (int n = 0; n < NSTEP; n += 2) {
              V_ISSUE(n + 1, pcB, wqB, xpB); __builtin_amdgcn_sched_barrier(0);
              V_COMPUTE(n, pcA, wqA, xpA); __builtin_amdgcn_sched_barrier(0);
              { const int nn = (n + 2 < NSTEP) ? n + 2 : n; V_ISSUE(nn, pcA, wqA, xpA); }
              __builtin_amdgcn_sched_barrier(0);
              V_COMPUTE(n + 1, pcB, wqB, xpB); __builtin_amdgcn_sched_barrier(0);
          }
#undef V_ISSUE
#undef V_COMPUTE
        }
        { const float* ln2_g = F.in(I_LN2G); const float* ln2_b = F.in(I_LN2B); float* outp = F.outp(); const bf16* Y2 = F.ws<bf16>(WS_QP);
        for (int ti = 0; ti < TPB / NWAVES; ++ti) {
            const int t = m0 + tw + ti;
            const GAS v4u* yp = (const GAS v4u*)(Y2 + (size_t)t * D) + lane;
            float v[32]; float s = 0.f;
#pragma unroll
            for (int j = 0; j < 4; ++j) { const v4u w = yp[64 * j]; const unsigned ww[4] = {w.x, w.y, w.z, w.w};
#pragma unroll
                for (int i = 0; i < 4; ++i) { v[8 * j + 2 * i] = bflo(ww[i]); v[8 * j + 2 * i + 1] = bfhi(ww[i]); s += v[8 * j + 2 * i] + v[8 * j + 2 * i + 1]; } }
            const float mean = wave_sum(s) * (1.f / D); float qv = 0.f;
#pragma unroll
            for (int i = 0; i < 32; ++i) { v[i] -= mean; qv += v[i] * v[i]; }
            const float rstd = 1.f / sqrtf(wave_sum(qv) * (1.f / D) + LN_EPS);
#pragma unroll
            for (int j = 0; j < 4; ++j) { const int c0 = 8 * lane + 512 * j; const f32x4 g0 = *(const f32x4*)(ln2_g + c0), g1 = *(const f32x4*)(ln2_g + c0 + 4), b0 = *(const f32x4*)(ln2_b + c0), b1 = *(const f32x4*)(ln2_b + c0 + 4);
                f32x4 r0, r1;
#pragma unroll
                for (int i = 0; i < 4; ++i) { r0[i] = v[8 * j + i] * rstd * g0[i] + b0[i]; r1[i] = v[8 * j + 4 + i] * rstd * g1[i] + b1[i]; }
                GAS f32x4* op = (GAS f32x4*)(outp + (size_t)t * D + c0); op[0] = r0; op[1] = r1; }
        } }
        __syncthreads();
    }
}

struct Args { const float* in[22]; float* out; unsigned char* ws; int ph_lo, ph_hi; };
__global__ void __launch_bounds__(NWAVES * 64, 2) mk_fwd(Args args) {
    extern __shared__ __attribute__((aligned(16))) unsigned char lds[];
    cg::grid_group grid = cg::this_grid();
    Frame F;
    F.lds = (LAS unsigned char*)lds;
    if (threadIdx.x == 0) { LAS unsigned long long* PT = (LAS unsigned long long*)(F.lds + RING_BYTES);
#pragma unroll
        for (int k = 0; k < 22; ++k) PT[k] = (unsigned long long)args.in[k];
        PT[22] = (unsigned long long)args.out; PT[23] = (unsigned long long)args.ws;
        ((LAS unsigned*)(F.lds + RING_BYTES + 256))[0] = 0u; ((LAS unsigned*)(F.lds + RING_BYTES + 256))[1] = 0u; }
    __syncthreads();
    const int lo = args.ph_lo, hi = args.ph_hi;
#ifndef PHASE_MASK
#define PHASE_MASK 255
#endif
#define IN(k) (((PHASE_MASK >> (k)) & 1) && lo <= (k) && (k) < hi)
#ifndef REPEAT_PHASE
#define REPEAT_PHASE -1
#endif
#define REP(k) for (int rep_ = 0; rep_ < ((REPEAT_PHASE == (k)) ? 2 : 1); ++rep_)
    (void)xcd_barrier_post((unsigned*)args.ws, (volatile LAS unsigned*)(F.lds + RING_BYTES + 256));
#define XBAR() do { XcdBarrier bar_; bar_.bar = F.ws<unsigned>(0); bar_.x = xb_xcc_id(); bar_.st = (volatile LAS unsigned*)(F.lds + RING_BYTES + 256); xcd_barrier(bar_); } while (0)
#define SEAM(k) do { if (IN(k) && IN((k) + 1)) XBAR(); } while (0)

    if (lo < 0) grid.sync();
    if (IN(0)) REP(0) { p0a_prologue(F); XBAR(); p0b_prologue(F); } SEAM(0);
    if (IN(1)) REP(1) {
        pg8::Gemm g{F.ws<bf16>(WS_XB), F.ws<bf16>(WS_WIN), M, NPROJ, D / 2}; pg8::StaticOrder S; S.init(M, NPROJ, F.G_(), (int)blockIdx.x);
        pg8::EpiProjI8 E{F.ws<bf16>(WS_Q), (size_t)(WS_K - WS_Q) / 2, dattn::C2, F.ws<bf16>(WS_H), F.in(I_BGLU), F.ws<float>(WS_SXA), F.ws<float>(WS_SWIN)};
        pg8::gemm_phase<pg8::EpiProjI8, pg8::StaticOrder, PG8_ALIGN, PG8_SP2>(F.lds, g, S, E);
    } SEAM(1);
    if (IN(2)) REP(2) {
        static_assert(dattn::LDS_BYTES <= RING_BYTES, "attention body geometry vs frame");
        const dattn::Tensors AT{F.ws<const dattn::bf16>(WS_Q), F.ws<const dattn::bf16>(WS_K), F.ws<const dattn::bf16>(WS_V), F.ws<dattn::bf16>(WS_O1), F.ws<dattn::bf16>(WS_O2), F.ws<const float>(WS_TAB)};
        dattn::phase((char*)lds, AT, F.vcu_());
    } SEAM(2);
    if (IN(3)) REP(3) { p3_mix(F); } SEAM(3);
    if (IN(4)) REP(4) {
        pg8::Gemm g{F.ws<bf16>(WS_XB), F.ws<bf16>(WS_WOUT), M, D, D / 2}; pg8::StaticOrder S; S.init(M, D, F.G_(), (int)blockIdx.x);
        pg8::EpiResI8 E{F.in(I_X), F.ws<bf16>(WS_Y1), D, DN_ALPHA, F.ws<float>(WS_SM), F.ws<float>(WS_SWOUT)};
        pg8::gemm_phase<pg8::EpiResI8, pg8::StaticOrder, PG8_ALIGN, PG8_SP2>(F.lds, g, S, E);
    } SEAM(4);
    if (IN(5)) REP(5) { p5_ln1(F); } SEAM(5);
    if (IN(6)) REP(6) {
        pg8::Gemm g{F.ws<bf16>(WS_X8), F.ws<bf16>(WS_WQ), M, D, D / 2}; pg8::StaticOrder S; S.init(M, D, F.G_(), (int)blockIdx.x);
        pg8::EpiPlainI8 E{F.ws<bf16>(WS_QP), D, F.ws<float>(WS_SX), F.ws<float>(WS_SWQ)};
        pg8::gemm_phase<pg8::EpiPlainI8, pg8::StaticOrder, PG8_ALIGN, PG8_SP2>(F.lds, g, S, E);
    } SEAM(6);
    if (IN(7)) REP(7) { p7_peer(F); }
#undef IN
#undef SEAM
}

extern "C" void kernel_launch(void* const* d_in, const int* in_sizes, int n_in, void* d_out, int out_size, void* d_ws, size_t ws_size, hipStream_t stream) {
    static int grid = 0;
    if (grid == 0) {
        if (n_in != 22 || in_sizes[0] != M * D || out_size != M * D || ws_size < WS_END) { fprintf(stderr, "kernel_launch: unexpected shapes (n_in %d, in0 %d, out %d, ws %zu); nothing launched\n", n_in, n_in > 0 ? in_sizes[0] : -1, out_size, ws_size); grid = -1; return; }
        int dev = 0, cus = 0, per_cu = 0;
        if (hipGetDevice(&dev) != hipSuccess || hipDeviceGetAttribute(&cus, hipDeviceAttributeMultiprocessorCount, dev) != hipSuccess) { grid = -1; return; }
        if (hipFuncSetAttribute((const void*)mk_fwd, hipFuncAttributeMaxDynamicSharedMemorySize, LDS_BYTES) != hipSuccess) { fprintf(stderr, "kernel_launch: hipFuncSetAttribute failed\n"); grid = -1; return; }
        if (hipOccupancyMaxActiveBlocksPerMultiprocessor(&per_cu, (const void*)mk_fwd, NWAVES * 64, LDS_BYTES) != hipSuccess || per_cu < 1) { fprintf(stderr, "kernel_launch: occupancy query reports %d workgroups per CU\n", per_cu); (void)hipGetLastError(); grid = -1; return; }
        grid = cus;
        if (grid > 256) grid = 256;
    }
    if (grid < 0) return;
    if (hipMemsetAsync(d_ws, 0, 65536, stream) != hipSuccess) { fprintf(stderr, "kernel_launch: hipMemsetAsync failed\n"); return; }
    Args a{};
    for (int i = 0; i < 22; ++i) a.in[i] = (const float*)d_in[i];
    a.out = (float*)d_out; a.ws = (unsigned char*)d_ws;
    constexpr int NL = MK_N_LAUNCHES;
    for (int li = 0; li < NL; ++li) {
        a.ph_lo = (NL == 1) ? 0 : li; a.ph_hi = (NL == 1) ? N_PHASES : li + 1;
        void* kargs[] = {&a};
        const hipError_t le = hipLaunchCooperativeKernel((const void*)mk_fwd, dim3(grid), dim3(NWAVES * 64), kargs, LDS_BYTES, stream);
        if (le != hipSuccess) { fprintf(stderr, "kernel_launch: cooperative launch %d failed: %s (grid %d)\n", li, hipGetErrorString(le), grid); break; }
    }
}
```

```cpp
#include <hip/hip_runtime.h>
#include <hip/hip_cooperative_groups.h>
#include <cstdio>
#include <cstdint>
namespace cg = cooperative_groups;
namespace pg8 {
#define PG8_LAS __attribute__((address_space(3)))
typedef unsigned short bf16_t;
typedef short bf16x8 __attribute__((ext_vector_type(8)));
typedef float f32x4 __attribute__((ext_vector_type(4)));
typedef unsigned u32x4 __attribute__((ext_vector_type(4)));
typedef int i32x4 __attribute__((ext_vector_type(4)));
constexpr int BM = 256, BK = 64, HALF = 128, HTB = HALF * BK * 2  , STAGE_BYTES = 8 * HTB, NXCD = 8, WGM = 8;

__host__ __device__ __forceinline__ int lds_byte(int r, int c) { const int st = (r >> 4) * 2 + (c >> 5), rr = r & 15, cc = c & 31, ob = rr * 64 + cc * 2; return st * 1024 + (ob ^ (((ob >> 9) & 1) << 5)); }
__host__ __device__ __forceinline__ void stage_rc(int b, int& R, int& C) { const int st = b / 1024, sb = b % 1024, swz = sb ^ (((sb >> 9) & 1) << 5); R = (st >> 1) * 16 + swz / 64; C = (st & 1) * 32 + (swz % 64) / 2; }
__host__ __device__ __forceinline__ int perm32(int rho) { const int n = rho >> 4, i = rho & 15; return 8 * (i >> 2) + 4 * n + (i & 3); }

struct Unit { int pm, pn; };
struct Gemm { const bf16_t* A; const bf16_t* Bt; int M, N, K; };

struct StaticOrder {
    int nM, nN, nwg, G, c;
    __host__ __device__ void init(int M, int N, int G_, int c_) { nM = M / BM; nN = N / BM; nwg = nM * nN; G = G_; c = c_; }
    __host__ __device__ bool next(int i, Unit& u) const {
        const long L = (long)i * G + c; if (L >= nwg) return false;
        int wgid = (int)L; { const int q = nwg / NXCD, r = nwg % NXCD, xcd = wgid % NXCD, off = wgid / NXCD; wgid = (xcd < r ? xcd * (q + 1) : r * (q + 1) + (xcd - r) * q) + off; }
        const int nig = WGM * nN, gid = wgid / nig, fm = gid * WGM, gsz = (nM - fm) < WGM ? (nM - fm) : WGM;
        u.pm = fm + ((wgid % nig) % gsz); u.pn = (wgid % nig) / gsz; return true;
    }
    __device__ __forceinline__ void a_ready(const Unit&) const {}
    __device__ __forceinline__ void done(const Unit&) const {}
};

__device__ __forceinline__ unsigned cvt_pk_bf16(float lo, float hi) { unsigned r; asm volatile("v_cvt_pk_bf16_f32 %0, %1, %2" : "=v"(r) : "v"(lo), "v"(hi)); return r; }
typedef float f32x2 __attribute__((ext_vector_type(2)));
typedef float f32x2 __attribute__((ext_vector_type(2)));
__device__ __forceinline__ u32x4 pack8(f32x4 v0, f32x4 v1) { u32x4 w; w.x = cvt_pk_bf16(v0[0], v0[1]); w.y = cvt_pk_bf16(v0[2], v0[3]); w.z = cvt_pk_bf16(v1[0], v1[1]); w.w = cvt_pk_bf16(v1[2], v1[3]); return w; }
__device__ __forceinline__ f32x4 i2f(f32x4 a) { const i32x4 v = __builtin_bit_cast(i32x4, a); return (f32x4){(float)v[0], (float)v[1], (float)v[2], (float)v[3]}; }
struct EpiProjI8 {
    static constexpr bool PERM = true, AFTER_DRAIN = false, INT8 = true;
    bf16_t* QKV; size_t split_stride; float scale0; bf16_t* H; const float* bglu; const float* sa; const float* sb;
    __device__ __forceinline__ void operator()(const f32x4 (&acc)[2][2][4][2], const Unit& u, int wr, int wc, int fr, int fq) const {
        const int row0 = u.pm * BM + wr * 64 + fr, cb = u.pn * BM + wc * 32 + 8 * fq;
        f32x4 cs[2][2];
#pragma unroll
        for (int bj = 0; bj < 2; ++bj) { cs[bj][0] = *(const f32x4*)(sb + cb + bj * HALF); cs[bj][1] = *(const f32x4*)(sb + cb + bj * HALF + 4); }
        if (u.pn < 12) {
            const int t = u.pn >> 2; bf16_t* base = QKV + (size_t)t * split_stride; const float sc = (t == 0) ? scale0 : 1.f;
            const int col0 = (u.pn & 3) * BM + wc * 32 + 8 * fq;
#pragma unroll
            for (int ai = 0; ai < 2; ++ai)
#pragma unroll
                for (int m = 0; m < 4; ++m) { const int row = row0 + ai * HALF + m * 16; const float rs = sa[row] * sc; bf16_t* rowp = base + (size_t)row * 1024 + col0;
#pragma unroll
                    for (int bj = 0; bj < 2; ++bj) *(u32x4*)(rowp + bj * HALF) = pack8(i2f(acc[ai][bj][m][0]) * cs[bj][0] * rs, i2f(acc[ai][bj][m][1]) * cs[bj][1] * rs); }
        } else {
            const int ch0 = (u.pn - 12) * HALF + wc * 32 + 8 * fq;
            const f32x4 ba0 = *(const f32x4*)(bglu + ch0), ba1 = *(const f32x4*)(bglu + ch0 + 4), bg0 = *(const f32x4*)(bglu + 1024 + ch0), bg1 = *(const f32x4*)(bglu + 1024 + ch0 + 4);
#pragma unroll
            for (int ai = 0; ai < 2; ++ai)
#pragma unroll
                for (int m = 0; m < 4; ++m) { const int row = row0 + ai * HALF + m * 16; const float rs = sa[row];
                    const f32x4 a0 = i2f(acc[ai][0][m][0]) * cs[0][0] * rs + ba0, a1 = i2f(acc[ai][0][m][1]) * cs[0][1] * rs + ba1, g0 = i2f(acc[ai][1][m][0]) * cs[1][0] * rs + bg0, g1 = i2f(acc[ai][1][m][1]) * cs[1][1] * rs + bg1;
                    f32x4 h0, h1;
#pragma unroll
                    for (int e = 0; e < 4; ++e) { h0[e] = a0[e] * __builtin_amdgcn_rcpf(1.f + __builtin_amdgcn_exp2f(-1.4426950409f * g0[e])); h1[e] = a1[e] * __builtin_amdgcn_rcpf(1.f + __builtin_amdgcn_exp2f(-1.4426950409f * g1[e])); }
                    *(u32x4*)(H + (size_t)row * 1024 + ch0) = pack8(h0, h1); }
        }
    }
};
struct EpiPlainI8 {
    static constexpr bool PERM = true, AFTER_DRAIN = false, INT8 = true;
    bf16_t* O; int ldc; const float* sa; const float* sb;
    __device__ __forceinline__ void operator()(const f32x4 (&acc)[2][2][4][2], const Unit& u, int wr, int wc, int fr, int fq) const {
        const int row0 = u.pm * BM + wr * 64 + fr, col0 = u.pn * BM + wc * 32 + 8 * fq;
        f32x4 cs[2][2];
#pragma unroll
        for (int bj = 0; bj < 2; ++bj) { cs[bj][0] = *(const f32x4*)(sb + col0 + bj * HALF); cs[bj][1] = *(const f32x4*)(sb + col0 + bj * HALF + 4); }
#pragma unroll
        for (int ai = 0; ai < 2; ++ai)
#pragma unroll
            for (int m = 0; m < 4; ++m) { const int row = row0 + ai * HALF + m * 16; const float rs = sa[row]; bf16_t* rowp = O + (size_t)row * ldc + col0;
#pragma unroll
                for (int bj = 0; bj < 2; ++bj) *(u32x4*)(rowp + bj * HALF) = pack8(i2f(acc[ai][bj][m][0]) * cs[bj][0] * rs, i2f(acc[ai][bj][m][1]) * cs[bj][1] * rs); }
    }
};
struct EpiResI8 {
    static constexpr bool PERM = true, AFTER_DRAIN = false, INT8 = true;
    const float* X; bf16_t* Y; int ldc; float alpha; const float* sa; const float* sb;
    __device__ __forceinline__ void operator()(const f32x4 (&acc)[2][2][4][2], const Unit& u, int wr, int wc, int fr, int fq) const {
        const int row0 = u.pm * BM + wr * 64 + fr, col0 = u.pn * BM + wc * 32 + 8 * fq;
        f32x4 cs[2][2];
#pragma unroll
        for (int bj = 0; bj < 2; ++bj) { cs[bj][0] = *(const f32x4*)(sb + col0 + bj * HALF); cs[bj][1] = *(const f32x4*)(sb + col0 + bj * HALF + 4); }
#pragma unroll
        for (int ai = 0; ai < 2; ++ai)
#pragma unroll
            for (int m = 0; m < 4; ++m) { const int row = row0 + ai * HALF + m * 16; const float rs = sa[row]; const size_t off = (size_t)row * ldc + col0;
#pragma unroll
                for (int bj = 0; bj < 2; ++bj) { const f32x4 x0 = *(const f32x4*)(X + off + bj * HALF), x1 = *(const f32x4*)(X + off + bj * HALF + 4);
                    *(u32x4*)(Y + off + bj * HALF) = pack8(i2f(acc[ai][bj][m][0]) * cs[bj][0] * rs + x0 * alpha, i2f(acc[ai][bj][m][1]) * cs[bj][1] * rs + x1 * alpha); } }
    }
};
template <class Epi, class Sched, bool ALIGN_EPI = false, bool SP2 = false>
__device__ __forceinline__ void gemm_phase(PG8_LAS unsigned char* lds, const Gemm g, const Sched& S, const Epi& E) {
    const int tid = threadIdx.x, wid = __builtin_amdgcn_readfirstlane(tid >> 6), lane = tid & 63, wr = wid >> 2, wc = wid & 3, fr = lane & 15, fq = lane >> 4;
    const int K = g.K, nt = K / BK;
    unsigned voffA[2], voffB[2];
#pragma unroll
    for (int i = 0; i < 2; ++i) { int R, C; stage_rc(tid * 16 + i * 8192, R, C); const int Rb = Epi::PERM ? ((R & ~31) + perm32(R & 31)) : R;
        voffA[i] = (unsigned)(R * K + C) * 2u; voffB[i] = (unsigned)(Rb * K + C) * 2u; }
    const size_t kstep = (size_t)(BK * 2);
    const size_t hstep = (size_t)HALF * K * 2;
    const size_t tstep = 2 * hstep;
    const unsigned ldsw = (unsigned)wid * 1024u;
    const int aoff = lds_byte(wr * 64 + fr, fq * 8), boff = lds_byte(wc * 32 + fr, fq * 8);
#define PG8_SA(b, h) (((b) * 2 + (h)) * HTB)
#define PG8_SB(b, h) ((4 + (b) * 2 + (h)) * HTB)
#define PG8_STAGE(bufoff, gbase, voff) do { _Pragma("unroll") for (int _i = 0; _i < 2; ++_i) \
        __builtin_amdgcn_global_load_lds((const unsigned*)((const char*)(gbase) + (voff)[_i]), (PG8_LAS unsigned*)(lds + (bufoff) + ldsw + _i * 8192), 16, 0, 0); } while (0)
#define PG8_LDA(dst, b, h) do { _Pragma("unroll") for (int m = 0; m < 4; ++m) _Pragma("unroll") for (int k = 0; k < 2; ++k) dst[m][k] = *(const PG8_LAS bf16x8*)(lds + PG8_SA(b, h) + aoff + m * 2048 + k * 1024); } while (0)
#define PG8_LDB(dst, b, h) do { _Pragma("unroll") for (int n = 0; n < 2; ++n) _Pragma("unroll") for (int k = 0; k < 2; ++k) dst[n][k] = *(const PG8_LAS bf16x8*)(lds + PG8_SB(b, h) + boff + n * 2048 + k * 1024); } while (0)
#define PG8_MMA(ai, bj, At, Bt) do { __builtin_amdgcn_s_setprio(1); _Pragma("unroll") for (int m = 0; m < 4; ++m) _Pragma("unroll") for (int n = 0; n < 2; ++n) _Pragma("unroll") for (int k = 0; k < 2; ++k) { \
        if constexpr (Epi::INT8) acc[ai][bj][m][n] = __builtin_bit_cast(f32x4, __builtin_amdgcn_mfma_i32_16x16x64_i8(__builtin_bit_cast(i32x4, Bt[n][k]), __builtin_bit_cast(i32x4, At[m][k]), __builtin_bit_cast(i32x4, acc[ai][bj][m][n]), 0, 0, 0)); \
        else acc[ai][bj][m][n] = __builtin_amdgcn_mfma_f32_16x16x32_bf16(Bt[n][k], At[m][k], acc[ai][bj][m][n], 0, 0, 0); } __builtin_amdgcn_s_setprio(0); } while (0)
#define PG8_WAIT_V(n) asm volatile("s_waitcnt vmcnt(" #n ")" ::: "memory")
#define PG8_WAIT_L(n) asm volatile("s_waitcnt lgkmcnt(" #n ")" ::: "memory")
#define PG8_BAR __builtin_amdgcn_s_barrier()
#define PG8_SCHED __builtin_amdgcn_sched_barrier(0)
    Unit cur, nxt; int ui = 0;
    if (!S.next(0, cur)) return;
    f32x4 acc[2][2][4][2];
#pragma unroll
    for (int a = 0; a < 2; ++a)
#pragma unroll
        for (int b = 0; b < 2; ++b)
#pragma unroll
            for (int m = 0; m < 4; ++m)
#pragma unroll
                for (int n = 0; n < 2; ++n) acc[a][b][m][n] = (f32x4){0.f, 0.f, 0.f, 0.f};
    bf16x8 At[4][2], B0[2][2], B1[2][2];
    const char* cA = (const char*)g.A + (size_t)cur.pm * tstep; const char* cB = (const char*)g.Bt + (size_t)cur.pn * tstep;
    S.a_ready(cur);
    if constexpr (SP2) {
        PG8_STAGE(PG8_SB(0, 0), cB, voffB); PG8_STAGE(PG8_SB(0, 1), cB + hstep, voffB); PG8_STAGE(PG8_SA(0, 0), cA, voffA); PG8_STAGE(PG8_SA(0, 1), cA + hstep, voffA);
        if (wr == 1) PG8_BAR;
        PG8_WAIT_V(2); PG8_BAR;
        PG8_STAGE(PG8_SB(1, 0), cB + kstep, voffB); PG8_STAGE(PG8_SA(1, 0), cA + kstep, voffA); PG8_STAGE(PG8_SB(1, 1), cB + hstep + kstep, voffB);
        PG8_WAIT_V(6); PG8_BAR;
    } else {
        PG8_STAGE(PG8_SB(0, 0), cB, voffB); PG8_STAGE(PG8_SA(0, 0), cA, voffA); PG8_STAGE(PG8_SB(0, 1), cB + hstep, voffB); PG8_STAGE(PG8_SA(0, 1), cA + hstep, voffA);
        if (wr == 1) PG8_BAR;
        PG8_WAIT_V(4); PG8_BAR;
        PG8_STAGE(PG8_SB(1, 0), cB + kstep, voffB); PG8_STAGE(PG8_SA(1, 0), cA + kstep, voffA); PG8_STAGE(PG8_SB(1, 1), cB + hstep + kstep, voffB);
        PG8_WAIT_V(6); PG8_BAR;
    }
    for (;;) {
        const bool has_next = S.next(ui + 1, nxt);
        const char* nA = has_next ? (const char*)g.A + (size_t)nxt.pm * tstep : cA; const char* nB = has_next ? (const char*)g.Bt + (size_t)nxt.pn * tstep : cB;
        for (int t = 0; t < nt; t += 2) {
            const bool last = (t == nt - 2);
            const char* a1 = cA + (size_t)(t + 1) * kstep;
            const char* a2 = last ? nA : cA + (size_t)(t + 2) * kstep; const char* b2 = last ? nB : cB + (size_t)(t + 2) * kstep;
            const char* a3 = a2 + kstep; const char* b3 = b2 + kstep;
            if (last && has_next) S.a_ready(nxt);
            if constexpr (SP2) {
            PG8_LDB(B0, 0, 0); PG8_LDB(B1, 0, 1); PG8_SCHED; PG8_LDA(At, 0, 0); PG8_STAGE(PG8_SA(1, 1), a1 + hstep, voffA);
            PG8_WAIT_V(8); PG8_WAIT_L(0); PG8_BAR; PG8_MMA(0, 0, At, B0); PG8_MMA(0, 1, At, B1); PG8_BAR; PG8_SCHED;
            PG8_LDA(At, 0, 1); PG8_STAGE(PG8_SB(0, 0), b2, voffB); PG8_STAGE(PG8_SB(0, 1), b2 + hstep, voffB); PG8_STAGE(PG8_SA(0, 0), a2, voffA);
            PG8_WAIT_V(8); PG8_WAIT_L(0); PG8_BAR; PG8_MMA(1, 0, At, B0); PG8_MMA(1, 1, At, B1); PG8_BAR; PG8_SCHED;
            PG8_LDB(B0, 1, 0); PG8_LDB(B1, 1, 1); PG8_SCHED; PG8_LDA(At, 1, 0); PG8_STAGE(PG8_SA(0, 1), a2 + hstep, voffA);
            PG8_WAIT_V(8); PG8_WAIT_L(0); PG8_BAR; PG8_MMA(0, 0, At, B0); PG8_MMA(0, 1, At, B1); PG8_BAR; PG8_SCHED;
            PG8_LDA(At, 1, 1); PG8_STAGE(PG8_SB(1, 0), b3, voffB); PG8_STAGE(PG8_SB(1, 1), b3 + hstep, voffB); PG8_STAGE(PG8_SA(1, 0), a3, voffA);
            PG8_WAIT_V(8); PG8_WAIT_L(0); PG8_BAR; PG8_MMA(1, 0, At, B0); PG8_MMA(1, 1, At, B1); PG8_BAR; PG8_SCHED;
            } else {
            PG8_LDB(B0, 0, 0); PG8_SCHED; PG8_LDA(At, 0, 0); PG8_STAGE(PG8_SA(1, 1), a1 + hstep, voffA);
            PG8_WAIT_L(8); PG8_BAR; PG8_WAIT_L(0); PG8_MMA(0, 0, At, B0); PG8_BAR; PG8_SCHED;
            PG8_LDB(B1, 0, 1); PG8_STAGE(PG8_SB(0, 0), b2, voffB);
            PG8_BAR; PG8_WAIT_L(0); PG8_MMA(0, 1, At, B1); PG8_BAR;
            PG8_LDA(At, 0, 1); PG8_STAGE(PG8_SA(0, 0), a2, voffA);
            PG8_BAR; PG8_WAIT_L(0); PG8_MMA(1, 0, At, B0); PG8_BAR; PG8_SCHED;
            PG8_STAGE(PG8_SB(0, 1), b2 + hstep, voffB);
            PG8_WAIT_V(6); PG8_BAR; PG8_MMA(1, 1, At, B1); PG8_BAR;
            PG8_LDB(B0, 1, 0); PG8_SCHED; PG8_LDA(At, 1, 0); PG8_STAGE(PG8_SA(0, 1), a2 + hstep, voffA);
            PG8_WAIT_L(8); PG8_BAR; PG8_WAIT_L(0); PG8_MMA(0, 0, At, B0); PG8_BAR; PG8_SCHED;
            PG8_LDB(B1, 1, 1); PG8_STAGE(PG8_SB(1, 0), b3, voffB);
            PG8_BAR; PG8_WAIT_L(0); PG8_MMA(0, 1, At, B1); PG8_BAR;
            PG8_LDA(At, 1, 1); PG8_STAGE(PG8_SA(1, 0), a3, voffA);
            PG8_BAR; PG8_WAIT_L(0); PG8_MMA(1, 0, At, B0); PG8_BAR; PG8_SCHED;
            PG8_STAGE(PG8_SB(1, 1), b3 + hstep, voffB);
            PG8_WAIT_V(6); PG8_BAR; PG8_MMA(1, 1, At, B1); PG8_BAR;
            }
        }
        if constexpr (ALIGN_EPI) { if (wr == 0) PG8_BAR; }
        if constexpr (!Epi::AFTER_DRAIN) { E(acc, cur, wr, wc, fr, fq); S.done(cur); }
        if (!has_next) break;
#pragma unroll
        for (int a = 0; a < 2; ++a)
#pragma unroll
            for (int b = 0; b < 2; ++b)
#pragma unroll
                for (int m = 0; m < 4; ++m)
#pragma unroll
                    for (int n = 0; n < 2; ++n) acc[a][b][m][n] = (f32x4){0.f, 0.f, 0.f, 0.f};
        cur = nxt; cA = nA; cB = nB; ++ui;
        if constexpr (ALIGN_EPI) { if (wr == 1) PG8_BAR; }
    }
    PG8_WAIT_V(0);
    if constexpr (!ALIGN_EPI) { if (wr == 0) PG8_BAR; }
    PG8_BAR;
    if constexpr (Epi::AFTER_DRAIN) { E.fused(acc, cur, wr, wc, fr, fq, lds, wid, lane); S.done(cur); }
#undef PG8_SA
#undef PG8_SB
#undef PG8_STAGE
#undef PG8_LDA
#undef PG8_LDB
#undef PG8_MMA
#undef PG8_WAIT_V
#undef PG8_WAIT_L
#undef PG8_BAR
#undef PG8_SCHED
}
}
#include <hip/hip_bf16.h>
#include <cmath>
namespace dattn {
using bf16 = __hip_bfloat16;
typedef short bf16x8 __attribute__((ext_vector_type(8)));
typedef short s16x4 __attribute__((ext_vector_type(4)));
typedef float f32x16 __attribute__((ext_vector_type(16)));
typedef unsigned u32x4 __attribute__((ext_vector_type(4)));
constexpr int DK = 64, DV = 128, RS = 1024, SEQ = 4096;
constexpr int NW = 8, QBLK = 32, KVBLK = 64, QB = NW * QBLK;
constexpr int SHM_V = KVBLK * DV * 2, SHM_K = KVBLK * DK * 2;
constexpr int LDS_WS = 2 * SHM_V + 2 * SHM_K, LDS_TAB = LDS_WS + NW * 64 * 4, LDS_BYTES = LDS_TAB + 512;
constexpr float THR = 8.f;
constexpr float C2 = 0.125f * 1.4426950408889634f;
#define DA_KSWZ(row, colB) ((row) * 128 + ((colB) ^ (((row) & 7) << 4)))
#define DA_SBAR() __builtin_amdgcn_sched_barrier(0)
__device__ __forceinline__ int v_st(int k, int c) { const int kk = (k & ~0xC) | ((k & 4) << 1) | ((k & 8) >> 1); return ((kk >> 3) * 4 + (c >> 5)) * 512 + ((kk & 7) * 32 + (c & 31)) * 2; }
__device__ __forceinline__ int v_rd_base(int lane) { return ((lane & 3) << 3) | (((lane >> 2) & 3) << 6) | (((lane >> 4) & 1) << 5) | (((lane >> 5) & 1) << 8); }
constexpr int v_rd_off(int d0, int ks, int half) { return d0 * 512 + ks * 4096 + half * 2048; }
__device__ __forceinline__ int crow(int r, int hi) { return (r & 3) + 8 * (r >> 2) + 4 * hi; }
__device__ __forceinline__ unsigned cvtpk(float lo, float hi) { unsigned r; asm volatile("v_cvt_pk_bf16_f32 %0, %1, %2" : "=v"(r) : "v"(lo), "v"(hi)); return r; }
__device__ __forceinline__ bf16x8 load8(const bf16* p) { return *reinterpret_cast<const bf16x8*>(p); }
__device__ __forceinline__ void mask_tile(f32x16& p0, f32x16& p1, int dq) {
    const float NEG = -__builtin_inff();
#pragma unroll
    for (int r = 0; r < 16; ++r) { const int c = (r & 3) + 8 * (r >> 2); if (dq - c < 0) p0[r] = NEG; if (dq - c - 32 < 0) p1[r] = NEG; }
}
__device__ __forceinline__ void bias_tile(f32x16& p0, f32x16& p1, int dq, const __attribute__((address_space(3))) float* tab) {
#pragma unroll
    for (int r = 0; r < 16; ++r) { const int c = (r & 3) + 8 * (r >> 2); const int i0 = min(max(dq - c, 0), 127), i1 = min(max(dq - c - 32, 0), 127); p0[r] += tab[i0]; p1[r] += tab[i1]; }
}
__device__ __forceinline__ void partialSM(f32x16& p0, f32x16& p1, float& m_reg, float& mn, float& alpha) {
    float pmax = p0[0];
#pragma unroll
    for (int r = 1; r < 16; ++r) pmax = fmaxf(pmax, p0[r]);
#pragma unroll
    for (int r = 0; r < 16; ++r) pmax = fmaxf(pmax, p1[r]);
    { auto rr = __builtin_amdgcn_permlane32_swap(__float_as_uint(pmax), __float_as_uint(pmax), false, false); pmax = fmaxf(__uint_as_float(rr[0]), __uint_as_float(rr[1])); }
    if (__builtin_expect(__all(pmax - m_reg <= THR), 1)) { mn = m_reg; alpha = 1.f; }
    else { mn = fmaxf(m_reg, pmax); alpha = __builtin_amdgcn_exp2f(m_reg - mn); m_reg = mn; }
#pragma unroll
    for (int r = 0; r < 16; ++r) p0[r] -= mn;
#pragma unroll
    for (int r = 0; r < 16; ++r) p1[r] -= mn;
#pragma unroll
    for (int r = 0; r < 16; ++r) p0[r] = __builtin_amdgcn_exp2f(p0[r]);
}
__device__ __forceinline__ void finishSM(f32x16& p0, f32x16& p1, float alpha, float& l_reg, bf16x8& pa0, bf16x8& pa1, bf16x8& pa2, bf16x8& pa3) {
#pragma unroll
    for (int r = 0; r < 16; ++r) p1[r] = __builtin_amdgcn_exp2f(p1[r]);
    float ps = 0;
#pragma unroll
    for (int r = 0; r < 16; ++r) ps += p0[r];
#pragma unroll
    for (int r = 0; r < 16; ++r) ps += p1[r];
    { auto rr = __builtin_amdgcn_permlane32_swap(__float_as_uint(ps), __float_as_uint(ps), false, false); ps = __uint_as_float(rr[0]) + __uint_as_float(rr[1]); }
    l_reg = l_reg * alpha + ps;
#define DA_PK4(P, B_, OUT) do { unsigned a0 = cvtpk(P[B_+0], P[B_+1]), a1 = cvtpk(P[B_+2], P[B_+3]); unsigned b0 = cvtpk(P[B_+4], P[B_+5]), b1 = cvtpk(P[B_+6], P[B_+7]); \
        auto r0 = __builtin_amdgcn_permlane32_swap(a0, b0, false, false); auto r1 = __builtin_amdgcn_permlane32_swap(a1, b1, false, false); \
        u32x4 w = {r0[0], r1[0], r0[1], r1[1]}; OUT = *reinterpret_cast<bf16x8*>(&w); } while (0)
    DA_PK4(p0, 0, pa0); DA_PK4(p0, 8, pa1); DA_PK4(p1, 0, pa2); DA_PK4(p1, 8, pa3);
#undef DA_PK4
}
template <int KB>
__device__ __forceinline__ void qkt(f32x16& p0, f32x16& p1, const char* K_lds, int r32, int hi, const bf16x8* qr) {
    p0 = f32x16{}; p1 = f32x16{};
#pragma unroll
    for (int d0 = 0; d0 < 4; ++d0) { const char* a = K_lds + KB * SHM_K + DA_KSWZ(r32, (d0 * 16 + hi * 8) * 2);
        const bf16x8 b0 = *reinterpret_cast<const bf16x8*>(a), b1 = *reinterpret_cast<const bf16x8*>(a + 32 * 128);
        p0 = __builtin_amdgcn_mfma_f32_32x32x16_bf16(b0, qr[d0], p0, 0, 0, 0);
        p1 = __builtin_amdgcn_mfma_f32_32x32x16_bf16(b1, qr[d0], p1, 0, 0, 0); }
}
template <int VB>
__device__ __forceinline__ void pv_tile(f32x16* o, int vb0, bf16x8 pa0, bf16x8 pa1, bf16x8 pa2, bf16x8 pa3) {
#define DA_TRRD(dst, off) asm volatile("ds_read_b64_tr_b16 %0, %1 offset:%2" : "=&v"(dst) : "v"(vb0), "i"(off) : "memory")
#define DA_PV_D0(d0) do { s16x4 l0, l1, l2, l3, h0, h1, h2, h3; constexpr int b_ = VB * SHM_V + v_rd_off(d0, 0, 0); \
        DA_TRRD(l0, b_); DA_TRRD(h0, b_ + 2048); DA_TRRD(l1, b_ + 4096); DA_TRRD(h1, b_ + 6144); DA_TRRD(l2, b_ + 8192); DA_TRRD(h2, b_ + 10240); DA_TRRD(l3, b_ + 12288); DA_TRRD(h3, b_ + 14336); \
        asm volatile("s_waitcnt lgkmcnt(0)" ::: "memory"); DA_SBAR(); \
        o[d0] = __builtin_amdgcn_mfma_f32_32x32x16_bf16(pa0, (bf16x8){l0[0], l0[1], l0[2], l0[3], h0[0], h0[1], h0[2], h0[3]}, o[d0], 0, 0, 0); \
        o[d0] = __builtin_amdgcn_mfma_f32_32x32x16_bf16(pa1, (bf16x8){l1[0], l1[1], l1[2], l1[3], h1[0], h1[1], h1[2], h1[3]}, o[d0], 0, 0, 0); \
        o[d0] = __builtin_amdgcn_mfma_f32_32x32x16_bf16(pa2, (bf16x8){l2[0], l2[1], l2[2], l2[3], h2[0], h2[1], h2[2], h2[3]}, o[d0], 0, 0, 0); \
        o[d0] = __builtin_amdgcn_mfma_f32_32x32x16_bf16(pa3, (bf16x8){l3[0], l3[1], l3[2], l3[3], h3[0], h3[1], h3[2], h3[3]}, o[d0], 0, 0, 0); } while (0)
    DA_PV_D0(0); DA_PV_D0(1); DA_PV_D0(2); DA_PV_D0(3);
#undef DA_PV_D0
#undef DA_TRRD
}
struct BlockRef { const bf16* Q; const bf16* K; const bf16* V; bf16* O; int P0; };
struct Seam { bf16x8 qr[4]; bf16x8 st_v0, st_v1, st_k0; };
#define DA_VMW() asm volatile("s_waitcnt vmcnt(0)" ::: "memory")
#define DA_VMWN(n) asm volatile("s_waitcnt vmcnt(%0)" :: "i"(n) : "memory")
#define DA_SLOAD(Kp, Vp, k0) do { S.st_v0 = load8((Vp) + (size_t)((k0) + sr) * RS + sc); S.st_v1 = load8((Vp) + (size_t)((k0) + 32 + sr) * RS + sc); S.st_k0 = load8((Kp) + (size_t)((k0) + kr) * RS + kc); } while (0)
#define DA_SWRITE_K(bf) do { *(bf16x8*)(K_lds + (bf) * SHM_K + kws) = S.st_k0; } while (0)
#define DA_SWRITE_V(bf) do { *(bf16x8*)(V_lds + (bf) * SHM_V + vst0) = S.st_v0; *(bf16x8*)(V_lds + (bf) * SHM_V + vst1) = S.st_v1; } while (0)
__device__ __forceinline__ void prime(const BlockRef& cur, char* lds, Seam& S) {
    const int tid = threadIdx.x, wid = __builtin_amdgcn_readfirstlane(tid >> 6), lane = tid & 63, r32 = lane & 31, hi = lane >> 5;
    const int sr = tid >> 4, sc = (tid & 15) * 8, kr = tid >> 3, kc = (tid & 7) * 8, kws = DA_KSWZ(kr, kc * 2); char* K_lds = lds + 2 * SHM_V;
#pragma unroll
    for (int d0 = 0; d0 < 4; ++d0) S.qr[d0] = load8(cur.Q + (size_t)(wid * QBLK + r32) * RS + d0 * 16 + hi * 8);
    DA_SLOAD(cur.K, cur.V, 0); DA_VMW(); DA_SWRITE_K(0);
    __syncthreads();
}
__device__ __forceinline__ void block(const BlockRef& cur, const BlockRef& nxt, char* lds, Seam& S) {
    const int tid = threadIdx.x, wid = __builtin_amdgcn_readfirstlane(tid >> 6), lane = tid & 63, r32 = lane & 31, hi = lane >> 5;
    const int NT = (cur.P0 + QB) / KVBLK;
    const int qlo = cur.P0 + wid * QBLK, qm = qlo + r32 - 4 * hi;
    char* V_lds = lds; char* K_lds = lds + 2 * SHM_V;
    float* ws = (float*)(lds + LDS_WS) + wid * 64; float* li_l = ws, * al_l = ws + 32;
    const __attribute__((address_space(3))) float* tab = (const __attribute__((address_space(3))) float*)((__attribute__((address_space(3))) char*)lds + LDS_TAB);
    float m_reg = -1e30f, l_reg = 0; f32x16 o[4] = {};
    const int sr = tid >> 4, sc = (tid & 15) * 8, vst0 = v_st(sr, sc), vst1 = v_st(32 + sr, sc), kr = tid >> 3, kc = (tid & 7) * 8, kws = DA_KSWZ(kr, kc * 2);
    const int vb0 = (int)(uintptr_t)V_lds + v_rd_base(lane);
    const bf16* Kh = cur.K; const bf16* Vh = cur.V;
#define DA_RESC(a) do { if (__any((a) < 1.f)) { if (hi == 0) al_l[r32] = (a); asm volatile("s_waitcnt lgkmcnt(0)" ::: "memory"); \
                     _Pragma("unroll") for (int d_ = 0; d_ < 4; ++d_) _Pragma("unroll") for (int r = 0; r < 16; ++r) o[d_][r] *= al_l[crow(r, hi)]; } } while (0)
#define DA_KBASE(t) ((t) * KVBLK)
#define DA_MASKT(P0_, P1_, t) do { const int kb_ = DA_KBASE(t); if (kb_ + KVBLK - 1 >= qlo - 127) { bias_tile(P0_, P1_, qm - kb_, tab); if (kb_ + KVBLK - 1 > qlo) mask_tile(P0_, P1_, qm - kb_); } } while (0)
    constexpr int NQL = 4;
#define DA_SEAM_K0() do { DA_VMWN(NQL); DA_SWRITE_K(0); DA_SBAR(); } while (0)
    f32x16 pA0, pA1, pB0, pB1; float mnA, mnB, alA, alB; bf16x8 pa0, pa1, pa2, pa3;
    DA_SWRITE_V(0); DA_SBAR();
    DA_SLOAD(Kh, Vh, DA_KBASE(1));
    DA_SBAR(); qkt<0>(pA0, pA1, K_lds, r32, hi, S.qr);
    DA_MASKT(pA0, pA1, 0); partialSM(pA0, pA1, m_reg, mnA, alA);
    DA_VMW(); DA_SWRITE_V(1); DA_SWRITE_K(1);
    __syncthreads();
#define DA_HALF_STEP(PX0, PX1, mnX, alX, PY0, PY1, alY, t, KB, VB, SB) do { \
        DA_SBAR(); qkt<KB>(PX0, PX1, K_lds, r32, hi, S.qr); \
        finishSM(PY0, PY1, alY, l_reg, pa0, pa1, pa2, pa3); DA_SBAR(); \
        if ((t) + 1 < NT) { DA_SLOAD(Kh, Vh, DA_KBASE((t) + 1)); DA_SBAR(); } \
        pv_tile<VB>(o, vb0, pa0, pa1, pa2, pa3); DA_MASKT(PX0, PX1, (t)); partialSM(PX0, PX1, m_reg, mnX, alX); \
        __syncthreads(); \
        if ((t) + 1 < NT) { DA_VMW(); DA_SWRITE_V(SB); DA_SWRITE_K(SB); } \
        DA_RESC(alX); __syncthreads(); } while (0)
    for (int t = 1; t + 1 < NT; t += 2) {
        DA_HALF_STEP(pB0, pB1, mnB, alB, pA0, pA1, alA, t, 1, 0, 0);
        DA_HALF_STEP(pA0, pA1, mnA, alA, pB0, pB1, alB, t + 1, 0, 1, 1);
    }
    DA_SBAR(); qkt<1>(pB0, pB1, K_lds, r32, hi, S.qr); DA_SBAR();
    DA_SLOAD(nxt.K, nxt.V, 0); DA_SBAR();
#pragma unroll
    for (int d0 = 0; d0 < 4; ++d0) S.qr[d0] = load8(nxt.Q + (size_t)(wid * QBLK + r32) * RS + d0 * 16 + hi * 8);
    DA_SBAR();
    finishSM(pA0, pA1, alA, l_reg, pa0, pa1, pa2, pa3); DA_SBAR();
    pv_tile<0>(o, vb0, pa0, pa1, pa2, pa3);
    DA_MASKT(pB0, pB1, NT - 1); partialSM(pB0, pB1, m_reg, mnB, alB); __syncthreads(); DA_RESC(alB);
    finishSM(pB0, pB1, alB, l_reg, pa0, pa1, pa2, pa3); DA_SBAR(); pv_tile<1>(o, vb0, pa0, pa1, pa2, pa3);
    DA_SBAR(); DA_SEAM_K0();
    if (hi == 0) li_l[r32] = l_reg; asm volatile("s_waitcnt lgkmcnt(0)" ::: "memory");
    float rli[16];
#pragma unroll
    for (int r = 0; r < 16; ++r) rli[r] = __builtin_amdgcn_rcpf(li_l[crow(r, hi)]);
    bf16* Ow = cur.O + (size_t)(wid * QBLK) * RS;
#pragma unroll
    for (int r = 0; r < 16; ++r) { const int orow = crow(r, hi);
#pragma unroll
        for (int d0 = 0; d0 < 4; ++d0) { const float v = o[d0][r] * rli[r]; const float vn = __shfl_xor(v, 1);
            if ((r32 & 1) == 0) *(unsigned*)(Ow + (size_t)orow * RS + d0 * 32 + r32) = cvtpk(v, vn); } }
    __syncthreads();
#undef DA_RESC
#undef DA_KBASE
#undef DA_MASKT
#undef DA_SEAM_K0
#undef DA_HALF_STEP
}
#undef DA_VMW
#undef DA_VMWN
#undef DA_SLOAD
#undef DA_SWRITE_K
#undef DA_SWRITE_V
struct Tensors { const bf16* Q; const bf16* K; const bf16* V; bf16* O1; bf16* O2; const float* biastab; };
__device__ __forceinline__ BlockRef unit_ref(const Tensors& T, int v, int i) {
    const int bhc = (v & 255) >> 1, s = v & 1, b = bhc >> 4, h = (bhc >> 1) & 7, c = bhc & 1; const int q2 = 2 * (i >> 1) + s, qb = (i & 1) ? 15 - q2 : q2;
    const size_t row0 = (size_t)b * SEQ; BlockRef r;
    r.Q = T.Q + (row0 + (size_t)qb * QB) * RS + (2 * h + c) * DK; r.K = T.K + row0 * RS + (2 * h + c) * DK; r.V = T.V + row0 * RS + h * DV;
    r.O = (c ? T.O2 : T.O1) + (row0 + (size_t)qb * QB) * RS + h * DV; r.P0 = qb * QB; return r;
}
__device__ __forceinline__ void phase(char* lds, const Tensors& T, int vcu) {
    { const int h = ((vcu & 255) >> 2) & 7; if (threadIdx.x < 128) ((float*)(lds + LDS_TAB))[threadIdx.x] = T.biastab[h * 128 + threadIdx.x]; }
    Seam S; BlockRef cur = unit_ref(T, vcu, 0);
    prime(cur, lds, S);
    for (int i = 0; i < 8; ++i) { const BlockRef nxt = unit_ref(T, vcu, i + 1 < 8 ? i + 1 : i); block(cur, nxt, lds, S); cur = nxt; }
}
#undef DA_KSWZ
#undef DA_SBAR
}
#ifndef PG8_SP2
#define PG8_SP2 true
#endif
#ifndef PG8_ALIGN
#define PG8_ALIGN true
#endif
constexpr int NWAVES = 8;
#ifndef MK_N_LAUNCHES
#define MK_N_LAUNCHES 1
#endif
constexpr int N_PHASES = 8;
constexpr int BATCH = 8, SEQ = 4096, D = 2048, M = BATCH * SEQ;
constexpr int NPROJ = 5120, DATT = 1024, DCONV = 1024, CONVW = 31;
constexpr int PH = 8, PNK = 128, PHALF = 128, PTOPK = 16, NEXP = 16384;
constexpr float LN_EPS = 1e-5f;
constexpr float DN_ALPHA = 1.189207115002721f;
constexpr float LAMBDA_INIT = 0.2f;
constexpr size_t MiB = 1u << 20;
constexpr size_t WS_WIN = 2 * MiB, WS_WOUT = 22 * MiB, WS_WQ = 30 * MiB, WS_KEYS = 38 * MiB, WS_TAB = 39 * MiB;
constexpr size_t WS_U8 = 40 * MiB, WS_V8 = 72 * MiB, WS_SU = 104 * MiB, WS_SV = 105 * MiB;
constexpr size_t WS_XB = 168 * MiB;
constexpr size_t WS_Q = 296 * MiB, WS_K = 360 * MiB, WS_V = 424 * MiB, WS_H = 488 * MiB;
constexpr size_t WS_O1 = 552 * MiB, WS_O2 = 616 * MiB;
constexpr size_t WS_Y1 = 680 * MiB;
constexpr size_t WS_QP = 808 * MiB;
constexpr size_t WS_X8 = WS_O1;
constexpr size_t WS_SX = 106 * MiB, WS_SWQ = 107 * MiB, WS_SWIN = WS_SWQ + 65536, WS_SWOUT = WS_SWQ + 131072, WS_SXA = 108 * MiB, WS_SM = 109 * MiB, WS_LNS = 110 * MiB, WS_SXQ = 111 * MiB;
constexpr size_t WS_CMAX = 16384;
constexpr size_t WS_EID = 936 * MiB, WS_GATE = 952 * MiB;
constexpr size_t WS_END = 968 * MiB;
constexpr int RING_BYTES = 131072, LDS_BYTES = 147456;

#define GAS __attribute__((address_space(1)))
#define LAS __attribute__((address_space(3)))
typedef unsigned short bf16;
typedef unsigned v4u __attribute__((ext_vector_type(4)));
typedef unsigned v2u __attribute__((ext_vector_type(2)));
typedef float f32x4 __attribute__((ext_vector_type(4)));
typedef float f32x16 __attribute__((ext_vector_type(16)));
typedef short bf16x8 __attribute__((ext_vector_type(8)));
typedef __bf16 bf16x2_t __attribute__((ext_vector_type(2)));
#define LDS_WAIT() asm volatile("s_waitcnt lgkmcnt(0)" ::: "memory")
__device__ __forceinline__ unsigned f2bf(float f) { unsigned u = __builtin_bit_cast(unsigned, f); return (u + 0x7fffu + ((u >> 16) & 1u)) >> 16; }
__device__ __forceinline__ unsigned pk2(float lo, float hi) { return f2bf(lo) | (f2bf(hi) << 16); }
__device__ __forceinline__ float bflo(unsigned w) { return __uint_as_float(w << 16); }
__device__ __forceinline__ float bfhi(unsigned w) { return __uint_as_float(w & 0xffff0000u); }
__device__ __forceinline__ float wave_sum(float v) {
#pragma unroll
    for (int o = 1; o < 64; o <<= 1) v += __shfl_xor(v, o);
    return v;
}
__device__ __forceinline__ float dot2bf(unsigned a, unsigned b, float acc) { return __builtin_amdgcn_fdot2_f32_bf16(__builtin_bit_cast(bf16x2_t, a), __builtin_bit_cast(bf16x2_t, b), acc, false); }

#define XB_TMO      128
#define XB_XCNT(j)  (256  + 64 * (j))
#define XB_XSUB(j)  (1280 + 64 * (j))
#define XB_XGEN(j)  (2304 + 64 * (j))
#define XB_TOP      3328
#define XB_TOPGEN   3392
#define XCD_BAR_WORDS 3456
#define XB_SPIN_CAP (1u << 18)

__device__ __forceinline__ unsigned xb_ld(unsigned* p)              { return __hip_atomic_load(p, __ATOMIC_RELAXED, __HIP_MEMORY_SCOPE_AGENT); }
__device__ __forceinline__ unsigned xb_add(unsigned* p, unsigned v) { return __hip_atomic_fetch_add(p, v, __ATOMIC_RELAXED, __HIP_MEMORY_SCOPE_AGENT); }
__device__ __forceinline__ unsigned xb_xcc_id() { return (unsigned)__builtin_amdgcn_s_getreg((3 << 11) | 20) & 0xFu; }
#define XB_SPIN(cond, bar) do { unsigned _sp = 0; while (cond) { __builtin_amdgcn_s_sleep(1); \
    if ((++_sp & 255u) == 0u) { if (xb_ld(&(bar)[XB_TMO])) break; if (_sp > XB_SPIN_CAP) { atomicAdd(&(bar)[XB_TMO], 1u); break; } } } } while (0)

struct XcdBarrier {
    unsigned* bar; unsigned x;
    volatile LAS unsigned* st;
};

__device__ __forceinline__ XcdBarrier xcd_barrier_post(unsigned* bar, volatile LAS unsigned* st) {
    XcdBarrier b; b.bar = bar; b.x = xb_xcc_id(); b.st = st;
    if (threadIdx.x == 0) (void)xb_add(&bar[XB_XCNT(b.x)], 1u);
    return b;
}
__device__ __forceinline__ void xcd_barrier_complete(unsigned* bar, unsigned x, unsigned& nloc, unsigned& nx) {
    const unsigned G = gridDim.x * gridDim.y * gridDim.z;
    unsigned sum, cnt, mine, sp = 0u;
    for (;;) {
        sum = 0u; cnt = 0u; mine = 0u;
#pragma unroll
        for (unsigned j = 0; j < 16; ++j) { const unsigned c = xb_ld(&bar[XB_XCNT(j)]); sum += c; cnt += (c > 0u) ? 1u : 0u; mine = (j == x) ? c : mine; }
        if (sum == G) break;
        __builtin_amdgcn_s_sleep(1);
        if ((++sp & 255u) == 0u) { if (xb_ld(&bar[XB_TMO])) break; if (sp > XB_SPIN_CAP) { atomicAdd(&bar[XB_TMO], 1u); break; } }
    }
    nloc = mine > 0u ? mine : 1u; nx = cnt > 0u ? cnt : 1u;
}

__device__ __forceinline__ void xcd_barrier(const XcdBarrier& b) {
    asm volatile("s_waitcnt vmcnt(0)" ::: "memory");
    __syncthreads();
    if (threadIdx.x == 0) {
        unsigned* bar = b.bar;
        __builtin_amdgcn_s_waitcnt(0);
        unsigned nloc = b.st[0], nx = b.st[1];
        if (nloc == 0u) { xcd_barrier_complete(bar, b.x, nloc, nx); b.st[0] = nloc; b.st[1] = nx; }
        const unsigned old = xb_add(&bar[XB_XSUB(b.x)], 1u);
        const unsigned gen = old / nloc;
        if (old + 1u == (gen + 1u) * nloc) {
            __builtin_amdgcn_fence(__ATOMIC_RELEASE, "agent");
            asm volatile("s_waitcnt vmcnt(0)" ::: "memory");
            const unsigned og = xb_add(&bar[XB_TOP], 1u);
            const unsigned tg = og / nx;
            if (og + 1u == (tg + 1u) * nx) xb_add(&bar[XB_TOPGEN], 1u);
            else XB_SPIN(xb_ld(&bar[XB_TOPGEN]) == tg, bar);
            __builtin_amdgcn_fence(__ATOMIC_ACQUIRE, "agent");
            xb_add(&bar[XB_XGEN(b.x)], 1u);
            asm volatile("s_waitcnt vmcnt(0)" ::: "memory");
        } else {
            XB_SPIN(xb_ld(&bar[XB_XGEN(b.x)]) == gen, bar);
            __builtin_amdgcn_fence(__ATOMIC_ACQUIRE, "agent");
            asm volatile("s_waitcnt vmcnt(0)" ::: "memory");
        }
    }
    __syncthreads();
}

struct Frame {
    LAS unsigned char* lds;
    __device__ __forceinline__ int wave_() const { int w = __builtin_amdgcn_readfirstlane((int)threadIdx.x >> 6); asm volatile("" : "+s"(w)); return w; }
    __device__ __forceinline__ int G_() const { int g = (int)gridDim.x; asm volatile("" : "+s"(g)); return g; }
    __device__ __forceinline__ int vcu_() const { int bx = (int)blockIdx.x; asm volatile("" : "+s"(bx)); const int g = G_(); return (g % 8 == 0) ? (bx % 8) * (g / 8) + bx / 8 : bx; }
    __device__ __forceinline__ int tid() const { int t = (int)threadIdx.x; asm volatile("" : "+v"(t)); return t; }
    __device__ __forceinline__ int lane() const { return tid() & 63; }
    __device__ __forceinline__ unsigned long long raw(int k) const { const volatile LAS unsigned* p = (const volatile LAS unsigned*)(lds + RING_BYTES) + 2 * k;
        const unsigned lo = __builtin_amdgcn_readfirstlane(p[0]), hi = __builtin_amdgcn_readfirstlane(p[1]); return ((unsigned long long)hi << 32) | lo; }
    __device__ __forceinline__ const float* in(int k) const { return (const float*)raw(k); }
    __device__ __forceinline__ float* outp() const { return (float*)raw(22); }
    template <class T> __device__ __forceinline__ T* ws(size_t off) const { return (T*)((unsigned char*)raw(23) + off); }
};
enum { I_X = 0, I_WIN, I_BGLU, I_CONVW, I_CONVB, I_CLNG, I_CLNB, I_LQ1, I_LK1, I_LQ2, I_LK2, I_SUBLN, I_RELB, I_WOUT, I_LN1G, I_LN1B, I_WQ, I_KEYS, I_U, I_V, I_LN2G, I_LN2B };

template <int CTRL> __device__ __forceinline__ int dppi(int v) { return __builtin_amdgcn_update_dpp(0, v, CTRL, 0xf, 0xf, true); }
template <int CTRL> __device__ __forceinline__ float dppf(float v) { return __int_as_float(__builtin_amdgcn_update_dpp(0, __float_as_int(v), CTRL, 0xf, 0xf, true)); }
__device__ __forceinline__ unsigned pack_i8x4(float a, float b, float c, float d) {
    const int ia = (int)rintf(a), ib = (int)rintf(b), ic = (int)rintf(c), id = (int)rintf(d); return (unsigned)(ia & 255) | ((unsigned)(ib & 255) << 8) | ((unsigned)(ic & 255) << 16) | ((unsigned)id << 24); }
__device__ __forceinline__ void p0_colmax_item(const float* W, int N, unsigned* cmax, int k0, int n0, int dst0, int lane) {
    f32x4 am = {0.f, 0.f, 0.f, 0.f};
#pragma unroll
    for (int i = 0; i < 8; ++i) { const f32x4 v = *(const GAS f32x4*)(W + (size_t)(k0 + 8 * i + (lane >> 3)) * N + n0 + 4 * (lane & 7));
        am[0] = fmaxf(am[0], fabsf(v[0])); am[1] = fmaxf(am[1], fabsf(v[1])); am[2] = fmaxf(am[2], fabsf(v[2])); am[3] = fmaxf(am[3], fabsf(v[3])); }
#pragma unroll
    for (int e = 0; e < 4; ++e) { am[e] = fmaxf(am[e], __shfl_xor(am[e], 8)); am[e] = fmaxf(am[e], __shfl_xor(am[e], 16)); am[e] = fmaxf(am[e], __shfl_xor(am[e], 32)); }
    if (lane < 8) {
#pragma unroll
        for (int e = 0; e < 4; ++e) atomicMax(cmax + dst0 + 4 * lane + e, __float_as_uint(am[e])); }
}
__device__ __forceinline__ void p0_quant_item(const float* W, int N, unsigned char* WT8, const unsigned* cmax, float* scale, int k0, int n0, int dst0, LAS float* scr, int lane) {
#pragma unroll
    for (int i = 0; i < 8; ++i) { const int kk = 8 * i + (lane >> 3); const f32x4 v = *(const GAS f32x4*)(W + (size_t)(k0 + kk) * N + n0 + 4 * (lane & 7));
        LAS float* d = scr + kk * 33 + 4 * (lane & 7); d[0] = v[0]; d[1] = v[1]; d[2] = v[2]; d[3] = v[3]; }
    if (lane < 32) { const float am = __uint_as_float(__hip_atomic_load(cmax + dst0 + lane, __ATOMIC_RELAXED, __HIP_MEMORY_SCOPE_AGENT)); const float sc = am > 0.f ? am * (1.f / 127.f) : 1.f;
        scr[64 * 33 + lane] = 1.f / sc; if (k0 == 0) scale[dst0 + lane] = sc; }
    LDS_WAIT(); asm volatile("" ::: "memory");
    const int c = lane & 7;
#pragma unroll
    for (int j = 0; j < 4; ++j) { const int n = (lane >> 3) + 8 * j; const LAS float* sp = scr + (8 * c) * 33 + n; const float inv = scr[64 * 33 + n];
        *(GAS v2u*)(WT8 + (size_t)(dst0 + n) * D + k0 + 8 * c) = (v2u){pack_i8x4(sp[0 * 33] * inv, sp[1 * 33] * inv, sp[2 * 33] * inv, sp[3 * 33] * inv), pack_i8x4(sp[4 * 33] * inv, sp[5 * 33] * inv, sp[6 * 33] * inv, sp[7 * 33] * inv)}; }
    LDS_WAIT(); asm volatile("" ::: "memory");
}
__device__ __forceinline__ int glu_dst(int n0) {
    if (n0 < 3072) return n0;
    const int ch = (n0 - 3072) & 1023, gate = (n0 - 3072) >> 10; return 3072 + 256 * (ch >> 7) + 128 * gate + (ch & 127);
}
__device__ __forceinline__ void p0_quant_x(const float* src, unsigned char* dst8, float* scale, int rows, int gw, int NGW, int lane) {
    f32x4 nx[8], nx2[8];
    if (gw < rows) { const GAS f32x4* sp = (const GAS f32x4*)(src + (size_t)gw * D) + lane; const int r1 = (gw + NGW < rows) ? gw + NGW : gw; const GAS f32x4* sq = (const GAS f32x4*)(src + (size_t)r1 * D) + lane;
#pragma unroll
        for (int j = 0; j < 8; ++j) { nx[j] = sp[64 * j]; nx2[j] = sq[64 * j]; } }
    for (int r = gw; r < rows; r += NGW) {
        f32x4 v[8]; float am = 0.f;
#pragma unroll
        for (int j = 0; j < 8; ++j) { v[j] = nx[j]; nx[j] = nx2[j]; }
        { const int rn = (r + 2 * NGW < rows) ? r + 2 * NGW : r; const GAS f32x4* sp = (const GAS f32x4*)(src + (size_t)rn * D) + lane;
#pragma unroll
          for (int j = 0; j < 8; ++j) nx2[j] = sp[64 * j]; }
#pragma unroll
        for (int j = 0; j < 8; ++j) am = fmaxf(fmaxf(am, fmaxf(fabsf(v[j].x), fabsf(v[j].y))), fmaxf(fabsf(v[j].z), fabsf(v[j].w)));
#pragma unroll
        for (int o = 1; o < 64; o <<= 1) am = fmaxf(am, __shfl_xor(am, o));
        const float sc = am > 0.f ? am * (1.f / 127.f) : 1.f, inv = 1.f / sc;
        GAS unsigned* dp = (GAS unsigned*)(dst8 + (size_t)r * D) + lane;
#pragma unroll
        for (int j = 0; j < 8; ++j) dp[64 * j] = pack_i8x4(v[j].x * inv, v[j].y * inv, v[j].z * inv, v[j].w * inv);
        if (lane == 0) scale[r] = sc;
    }
}
__device__ __forceinline__ void p0_convert(const float* src, bf16* dst, size_t n, int gw, int NGW, int lane) {
    const size_t nit = n / 512;
    for (size_t it = gw; it < nit; it += NGW) { const GAS f32x4* s = (const GAS f32x4*)(src + it * 512) + 2 * lane; const f32x4 a = s[0], b = s[1];
        v4u o; o.x = pk2(a.x, a.y); o.y = pk2(a.z, a.w); o.z = pk2(b.x, b.y); o.w = pk2(b.z, b.w); *((GAS v4u*)(dst + it * 512) + lane) = o; }
}
template <bool INT8> __device__ __forceinline__ void p0_quant_rows(const float* src, unsigned* dst8, float* scale, int rows, int gw, int NGW, int lane) {
    f32x4 nx[8], nx2[8];
    if (gw < rows) { const GAS f32x4* sp = (const GAS f32x4*)(src + (size_t)gw * D) + lane; const int r1 = (gw + NGW < rows) ? gw + NGW : gw; const GAS f32x4* sq = (const GAS f32x4*)(src + (size_t)r1 * D) + lane;
#pragma unroll
        for (int j = 0; j < 8; ++j) { nx[j] = sp[64 * j]; nx2[j] = sq[64 * j]; } }
    for (int r = gw; r < rows; r += NGW) {
        f32x4 v[8]; float am = 0.f;
#pragma unroll
        for (int j = 0; j < 8; ++j) { v[j] = nx[j]; nx[j] = nx2[j]; }
        { const int rn = (r + 2 * NGW < rows) ? r + 2 * NGW : r; const GAS f32x4* sp = (const GAS f32x4*)(src + (size_t)rn * D) + lane;
#pragma unroll
          for (int j = 0; j < 8; ++j) nx2[j] = sp[64 * j]; }
#pragma unroll
        for (int j = 0; j < 8; ++j) am = fmaxf(fmaxf(am, fmaxf(fabsf(v[j].x), fabsf(v[j].y))), fmaxf(fabsf(v[j].z), fabsf(v[j].w)));
#pragma unroll
        for (int o = 1; o < 64; o <<= 1) am = fmaxf(am, __shfl_xor(am, o));
        const float sc = am > 0.f ? am * (INT8 ? (1.f / 127.f) : (1.f / 440.f)) : 1.f, inv = 1.f / sc;
#pragma unroll
        for (int j = 0; j < 8; ++j) { int w;
            if (INT8) w = (int)pack_i8x4(v[j].x * inv, v[j].y * inv, v[j].z * inv, v[j].w * inv);
            else { w = __builtin_amdgcn_cvt_pk_fp8_f32(v[j].x * inv, v[j].y * inv, 0, false); w = __builtin_amdgcn_cvt_pk_fp8_f32(v[j].z * inv, v[j].w * inv, w, true); }
            const int wi = lane + 64 * j, c = wi >> 5; *((GAS unsigned*)dst8 + ((size_t)c * rows + r) * 32 + (wi & 31)) = (unsigned)w; }
        if (lane == 0) scale[r] = sc;
    }
}
__device__ __forceinline__ void p0_quant_u4(const float* src, unsigned* dst4, float* scale, int rows, int gw, int NGW, int lane) {
    f32x4 nx[8], nx2[8];
    if (gw < rows) { const GAS f32x4* sp = (const GAS f32x4*)(src + (size_t)gw * D) + lane; const int r1 = (gw + NGW < rows) ? gw + NGW : gw; const GAS f32x4* sq = (const GAS f32x4*)(src + (size_t)r1 * D) + lane;
#pragma unroll
        for (int j = 0; j < 8; ++j) { nx[j] = sp[64 * j]; nx2[j] = sq[64 * j]; } }
    for (int r = gw; r < rows; r += NGW) {
        f32x4 v[8]; float ss = 0.f;
#pragma unroll
        for (int j = 0; j < 8; ++j) { v[j] = nx[j]; nx[j] = nx2[j]; }
        { const int rn = (r + 2 * NGW < rows) ? r + 2 * NGW : r; const GAS f32x4* sp = (const GAS f32x4*)(src + (size_t)rn * D) + lane;
#pragma unroll
          for (int j = 0; j < 8; ++j) nx2[j] = sp[64 * j]; }
#pragma unroll
        for (int j = 0; j < 8; ++j) ss += (v[j].x * v[j].x + v[j].y * v[j].y) + (v[j].z * v[j].z + v[j].w * v[j].w);
        ss = wave_sum(ss);
        const float sc = ss > 0.f ? 0.35f * sqrtf(ss * (1.f / D)) : 1.f, inv = 1.f / sc;
#pragma unroll
        for (int j = 0; j < 8; ++j) { unsigned own = 0;
#pragma unroll
            for (int e = 0; e < 4; ++e) { const int q = (int)fminf(fmaxf(rintf(v[j][e] * inv), -8.f), 7.f) + 8; own |= (unsigned)q << (8 * e); }
            const unsigned nbr = (unsigned)dppi<0xB1>((int)own);
            if ((lane & 1) == 0) *((GAS unsigned*)dst4 + ((size_t)j * rows + r) * 32 + (lane >> 1)) = own | (nbr << 4); }
        if (lane == 0) scale[r] = sc;
    }
}
__device__ __forceinline__ int t5_bucket(int d) {
    if (d < 16) return d;
    int l = 16 + (int)(logf((float)d / 16.f) / logf(8.f) * 16.f); return l < 31 ? l : 31;
}
__device__ __forceinline__ void p0a_prologue(Frame& F) {
    LAS float* scr = (LAS float*)(F.lds + F.wave_() * 16384);
    constexpr int I_IN = (D / 64) * (NPROJ / 32), I_OUT = (D / 64) * (D / 32);
    { const float* w_in = F.in(I_WIN); unsigned* cmax = F.ws<unsigned>(WS_CMAX); const int gw = F.vcu_() * NWAVES + F.wave_(), NGW = F.G_() * NWAVES;
      for (int r = gw; r < I_IN; r += NGW) { const int nblk = NPROJ / 32, kb = r / nblk, nb = r % nblk; p0_colmax_item(w_in, NPROJ, cmax, 64 * kb, 32 * nb, glu_dst(32 * nb), F.lane()); } }
    { const float* wq = F.in(I_WQ); unsigned* cmax = F.ws<unsigned>(WS_CMAX) + NPROJ; const int gw = F.vcu_() * NWAVES + F.wave_(), NGW = F.G_() * NWAVES;
      for (int r = gw; r < I_OUT; r += NGW) { const int nblk = D / 32, kb = r / nblk, nb = r % nblk; p0_colmax_item(wq, D, cmax, 64 * kb, 32 * nb, 32 * nb, F.lane()); } }
    { const float* wo = F.in(I_WOUT); unsigned* cmax = F.ws<unsigned>(WS_CMAX) + NPROJ + D; const int gw = F.vcu_() * NWAVES + F.wave_(), NGW = F.G_() * NWAVES;
      for (int r = gw; r < I_OUT; r += NGW) { const int nblk = D / 32, kb = r / nblk, nb = r % nblk; p0_colmax_item(wo, D, cmax, 64 * kb, 32 * nb, 32 * nb, F.lane()); } }
    { const int gw = F.vcu_() * NWAVES + F.wave_(), NGW = F.G_() * NWAVES; p0_quant_x(F.in(I_X), F.ws<unsigned char>(WS_XB), F.ws<float>(WS_SXA), M, gw, NGW, F.lane()); }
    { const int gw = F.vcu_() * NWAVES + F.wave_(), NGW = F.G_() * NWAVES; p0_quant_u4(F.in(I_U), F.ws<unsigned>(WS_U8), F.ws<float>(WS_SU), NEXP, gw, NGW, F.lane()); }
    { const int gw = F.vcu_() * NWAVES + F.wave_(), NGW = F.G_() * NWAVES; p0_quant_u4(F.in(I_V), F.ws<unsigned>(WS_V8), F.ws<float>(WS_SV), NEXP, gw, NGW, F.lane()); }
    { const int gw = F.vcu_() * NWAVES + F.wave_(), NGW = F.G_() * NWAVES; p0_convert(F.in(I_KEYS), F.ws<bf16>(WS_KEYS), (size_t)PH * 2 * PNK * PHALF, gw, NGW, F.lane()); }
    if (blockIdx.x == 0) { const float* rel_bias = F.in(I_RELB); float* TAB = F.ws<float>(WS_TAB);
        for (int i = F.tid(); i < 8 * 128; i += NWAVES * 64) { const int h = i >> 7, d = i & 127;
            TAB[i] = (rel_bias[t5_bucket(d) * 8 + h] - rel_bias[31 * 8 + h]) * 1.4426950408889634f; } }
}
__device__ __forceinline__ void p0b_prologue(Frame& F) {
    LAS float* scr = (LAS float*)(F.lds + F.wave_() * 16384);
    constexpr int I_IN = (D / 64) * (NPROJ / 32), I_OUT = (D / 64) * (D / 32);
    { const float* w_in = F.in(I_WIN); unsigned char* W8 = F.ws<unsigned char>(WS_WIN); const unsigned* cmax = F.ws<unsigned>(WS_CMAX); float* sw = F.ws<float>(WS_SWIN); const int gw = F.vcu_() * NWAVES + F.wave_(), NGW = F.G_() * NWAVES;
      for (int r = gw; r < I_IN; r += NGW) { const int nblk = NPROJ / 32, kb = r / nblk, nb = r % nblk; p0_quant_item(w_in, NPROJ, W8, cmax, sw, 64 * kb, 32 * nb, glu_dst(32 * nb), scr, F.lane()); } }
    { const float* wq = F.in(I_WQ); unsigned char* W8 = F.ws<unsigned char>(WS_WQ); const unsigned* cmax = F.ws<unsigned>(WS_CMAX) + NPROJ; float* sw = F.ws<float>(WS_SWQ); const int gw = F.vcu_() * NWAVES + F.wave_(), NGW = F.G_() * NWAVES;
      for (int r = gw; r < I_OUT; r += NGW) { const int nblk = D / 32, kb = r / nblk, nb = r % nblk; p0_quant_item(wq, D, W8, cmax, sw, 64 * kb, 32 * nb, 32 * nb, scr, F.lane()); } }
    { const float* wo = F.in(I_WOUT); unsigned char* W8 = F.ws<unsigned char>(WS_WOUT); const unsigned* cmax = F.ws<unsigned>(WS_CMAX) + NPROJ + D; float* sw = F.ws<float>(WS_SWOUT); const int gw = F.vcu_() * NWAVES + F.wave_(), NGW = F.G_() * NWAVES;
      for (int r = gw; r < I_OUT; r += NGW) { const int nblk = D / 32, kb = r / nblk, nb = r % nblk; p0_quant_item(wo, D, W8, cmax, sw, 64 * kb, 32 * nb, 32 * nb, scr, F.lane()); } }
}

__device__ __forceinline__ float diff_lambda(Frame& F) {
    const float a = wave_sum(F.in(I_LQ1)[F.lane()] * F.in(I_LK1)[F.lane()]), b = wave_sum(F.in(I_LQ2)[F.lane()] * F.in(I_LK2)[F.lane()]);
    return expf(a) - expf(b) + LAMBDA_INIT;
}
template <int CTRL, int RM> __device__ __forceinline__ float dpp_rm(float old, float v) { return __int_as_float(__builtin_amdgcn_update_dpp(__float_as_int(old), __float_as_int(v), CTRL, RM, 0xf, false)); }
__device__ __forceinline__ float wave_sum63(float v) {
    v += dppf<0xB1>(v); v += dppf<0x4E>(v); v += dppf<0x141>(v); v += dppf<0x140>(v);
    v += dpp_rm<0x142, 0xa>(0.f, v);
    v += dpp_rm<0x143, 0xc>(0.f, v);
    return v;
}
__device__ __forceinline__ float wave_max63(float v) {
    v = fmaxf(v, dppf<0xB1>(v)); v = fmaxf(v, dppf<0x4E>(v)); v = fmaxf(v, dppf<0x141>(v)); v = fmaxf(v, dppf<0x140>(v));
    v = fmaxf(v, dpp_rm<0x142, 0xa>(0.f, v)); v = fmaxf(v, dpp_rm<0x143, 0xc>(0.f, v));
    return v;
}
__device__ __forceinline__ void p3_mix(Frame& F) {
    constexpr int TT = 32, NPR = (TT + CONVW - 1) / 2, STATS_OFF = NPR * 4096, AMC_OFF = STATS_OFF + 2048, AMA_OFF = AMC_OFF + 1024, MS_OFF = AMA_OFF + 128, INV_OFF = MS_OFF + 256, STG_OFF = (TT / 2) * 4096;
    static_assert(INV_OFF + 128 <= RING_BYTES && STG_OFF + TT * 1024 <= STATS_OFF, "P3 LDS map");
    const int tid = F.tid(), lane = tid & 63, wave = F.wave_();
    const float lam = diff_lambda(F);
    const float* conv_w = F.in(I_CONVW); const bf16* H = F.ws<bf16>(WS_H); const bf16* O1 = F.ws<bf16>(WS_O1); const bf16* O2 = F.ws<bf16>(WS_O2);
    unsigned char* MIX8 = F.ws<unsigned char>(WS_XB); float* SM = F.ws<float>(WS_SM); const float* subln_g = F.in(I_SUBLN);
    const float2 cb = *(const float2*)(F.in(I_CONVB) + 2 * tid), lg = *(const float2*)(F.in(I_CLNG) + 2 * tid), lb = *(const float2*)(F.in(I_CLNB) + 2 * tid);
    LAS float* stats = (LAS float*)(F.lds + STATS_OFF); LAS float* amc = (LAS float*)(F.lds + AMC_OFF); LAS float* ama = (LAS float*)(F.lds + AMA_OFF); LAS float* ms = (LAS float*)(F.lds + MS_OFF); LAS float* invs = (LAS float*)(F.lds + INV_OFF);
    for (int tile_i = F.vcu_(); tile_i < M / TT; tile_i += F.G_()) {
        const int t0 = tile_i * TT, s0 = t0 & (SEQ - 1);
        for (int p = tid >> 7; p < NPR; p += 4) { const int sp = s0 - (CONVW - 1) + 2 * p; v4u a = (v4u){0u, 0u, 0u, 0u}, b = a;
            if (sp >= 0) { const GAS v4u* hp = (const GAS v4u*)(H + (size_t)(t0 - (CONVW - 1) + 2 * p) * 1024) + (tid & 127); a = hp[0]; b = hp[128]; }
            const unsigned aw[4] = {a.x, a.y, a.z, a.w}, bw[4] = {b.x, b.y, b.z, b.w}; unsigned o[8];
#pragma unroll
            for (int k = 0; k < 4; ++k) { o[2 * k] = __builtin_amdgcn_perm(bw[k], aw[k], 0x05040100u); o[2 * k + 1] = __builtin_amdgcn_perm(bw[k], aw[k], 0x07060302u); }
            LAS v4u* dst = (LAS v4u*)(F.lds + p * 4096 + (tid & 127) * 32); dst[0] = (v4u){o[0], o[1], o[2], o[3]}; dst[1] = (v4u){o[4], o[5], o[6], o[7]}; }
        __syncthreads();
        {
            unsigned we0[16], we1[16], wo0[16], wo1[16]; float2 wprev = {0.f, 0.f};
#pragma unroll
            for (int q = 0; q < 16; ++q) { const float2 wa = *(const float2*)(conv_w + (2 * q) * DCONV + 2 * tid); float2 wb = {0.f, 0.f}; if (2 * q + 1 < CONVW) wb = *(const float2*)(conv_w + (2 * q + 1) * DCONV + 2 * tid);
                we0[q] = pk2(wa.x, wb.x); we1[q] = pk2(wa.y, wb.y); wo0[q] = pk2(wprev.x, wa.x); wo1[q] = pk2(wprev.y, wa.y); wprev = wb; }
            for (int q = 0; q < TT / 2; ++q) {
                float e0 = cb.x, e1 = cb.y, o0 = cb.x, o1 = cb.y;
                const LAS v2u* src = (const LAS v2u*)(F.lds + q * 4096 + tid * 8);
#pragma unroll
                for (int j = 0; j < 16; ++j) { const v2u d = src[j * 512]; e0 = dot2bf(d.x, we0[j], e0); e1 = dot2bf(d.y, we1[j], e1); o0 = dot2bf(d.x, wo0[j], o0); o1 = dot2bf(d.y, wo1[j], o1); }
                const unsigned p0 = pk2(e0, o0), p1 = pk2(e1, o1); *(LAS v2u*)(F.lds + q * 4096 + tid * 8) = (v2u){p0, p1};
                const float re0 = bflo(p0), ro0 = bfhi(p0), re1 = bflo(p1), ro1 = bfhi(p1);
                const float se = wave_sum63(re0 + re1), qe = wave_sum63(re0 * re0 + re1 * re1), so = wave_sum63(ro0 + ro1), qo = wave_sum63(ro0 * ro0 + ro1 * ro1);
                if (lane == 63) { LAS float* st = stats + ((2 * q) * 8 + wave) * 2; st[0] = se; st[1] = qe; st[16] = so; st[17] = qo; }
            }
        }
        float av[4][16];
#pragma unroll
        for (int rr = 0; rr < 4; ++rr) { const int m = t0 + 4 * wave + rr;
            const GAS v4u* p1 = (const GAS v4u*)(O1 + (size_t)m * 1024) + 2 * lane; const GAS v4u* p2 = (const GAS v4u*)(O2 + (size_t)m * 1024) + 2 * lane;
            const v4u a0 = p1[0], a1 = p1[1], b0 = p2[0], b1 = p2[1];
            const unsigned aw[8] = {a0.x, a0.y, a0.z, a0.w, a1.x, a1.y, a1.z, a1.w}, bw[8] = {b0.x, b0.y, b0.z, b0.w, b1.x, b1.y, b1.z, b1.w};
            float ss = 0.f;
#pragma unroll
            for (int i = 0; i < 8; ++i) { av[rr][2 * i] = bflo(aw[i]) - lam * bflo(bw[i]); av[rr][2 * i + 1] = bfhi(aw[i]) - lam * bfhi(bw[i]); ss += av[rr][2 * i] * av[rr][2 * i] + av[rr][2 * i + 1] * av[rr][2 * i + 1]; }
            ss += __shfl_xor(ss, 1); ss += __shfl_xor(ss, 2); ss += __shfl_xor(ss, 4);
            const float r = (1.f - LAMBDA_INIT) / sqrtf(ss * (1.f / 128.f) + LN_EPS); float am = 0.f;
#pragma unroll
            for (int e = 0; e < 16; ++e) { av[rr][e] = av[rr][e] * r * subln_g[16 * (lane & 7) + e]; am = fmaxf(am, fabsf(av[rr][e])); }
            am = wave_max63(am);
            if (lane == 63) ama[4 * wave + rr] = am; }
        __syncthreads();
        if (tid < TT) { float s = 0.f, q = 0.f;
#pragma unroll
            for (int w = 0; w < 8; ++w) { s += stats[(tid * 8 + w) * 2]; q += stats[(tid * 8 + w) * 2 + 1]; }
            const float mean = s * (1.f / DCONV), var = fmaxf(q * (1.f / DCONV) - mean * mean, 0.f); ms[2 * tid] = mean; ms[2 * tid + 1] = 1.f / sqrtf(var + LN_EPS); }
        __syncthreads();
        for (int q = 0; q < TT / 2; ++q) {
            const f32x4 st = *(const LAS f32x4*)(ms + 4 * q);
            const v2u d = *(const LAS v2u*)(F.lds + q * 4096 + tid * 8);
            const float ye0 = (bflo(d.x) - st[0]) * st[1] * lg.x + lb.x, yo0 = (bfhi(d.x) - st[2]) * st[3] * lg.x + lb.x, ye1 = (bflo(d.y) - st[0]) * st[1] * lg.y + lb.y, yo1 = (bfhi(d.y) - st[2]) * st[3] * lg.y + lb.y;
#define SWISH_(y) ((y) * __builtin_amdgcn_rcpf(1.f + __builtin_amdgcn_exp2f(-1.4426950409f * (y))))
            const unsigned z0 = pk2(SWISH_(ye0), SWISH_(yo0)), z1 = pk2(SWISH_(ye1), SWISH_(yo1));
#undef SWISH_
            *(LAS v2u*)(F.lds + q * 4096 + tid * 8) = (v2u){z0, z1};
            const float me = wave_max63(fmaxf(fabsf(bflo(z0)), fabsf(bflo(z1)))), mo = wave_max63(fmaxf(fabsf(bfhi(z0)), fabsf(bfhi(z1))));
            if (lane == 63) { amc[(2 * q) * 8 + wave] = me; amc[(2 * q + 1) * 8 + wave] = mo; }
        }
        __syncthreads();
        if (tid < TT) { float am = ama[tid];
#pragma unroll
            for (int w = 0; w < 8; ++w) am = fmaxf(am, amc[tid * 8 + w]);
            const float sc = am > 0.f ? am * (1.f / 127.f) : 1.f; invs[tid] = 1.f / sc; SM[t0 + tid] = sc; }
        __syncthreads();
        for (int q = 0; q < TT / 2; ++q) {
            const float ie = invs[2 * q], io = invs[2 * q + 1];
            const v2u d = *(const LAS v2u*)(F.lds + q * 4096 + tid * 8);
            const int qe0 = (int)rintf(bflo(d.x) * ie), qe1 = (int)rintf(bflo(d.y) * ie), qo0 = (int)rintf(bfhi(d.x) * io), qo1 = (int)rintf(bfhi(d.y) * io);
            *(LAS unsigned short*)(F.lds + STG_OFF + (2 * q) * 1024 + 2 * tid) = (unsigned short)((qe0 & 255) | ((qe1 & 255) << 8));
            *(LAS unsigned short*)(F.lds + STG_OFF + (2 * q + 1) * 1024 + 2 * tid) = (unsigned short)((qo0 & 255) | ((qo1 & 255) << 8));
        }
#pragma unroll
        for (int rr = 0; rr < 4; ++rr) { const float inv = invs[4 * wave + rr];
            *((GAS v4u*)(MIX8 + (size_t)(t0 + 4 * wave + rr) * D) + lane) = (v4u){pack_i8x4(av[rr][0] * inv, av[rr][1] * inv, av[rr][2] * inv, av[rr][3] * inv), pack_i8x4(av[rr][4] * inv, av[rr][5] * inv, av[rr][6] * inv, av[rr][7] * inv),
                                                                              pack_i8x4(av[rr][8] * inv, av[rr][9] * inv, av[rr][10] * inv, av[rr][11] * inv), pack_i8x4(av[rr][12] * inv, av[rr][13] * inv, av[rr][14] * inv, av[rr][15] * inv)}; }
        __syncthreads();
        for (int idx = tid; idx < TT * 64; idx += NWAVES * 64) { const int row = idx >> 6, ch = idx & 63;
            *((GAS v4u*)(MIX8 + (size_t)(t0 + row) * D + DATT) + ch) = *(const LAS v4u*)(F.lds + STG_OFF + row * 1024 + ch * 16); }
        __syncthreads();
    }
}
__device__ __forceinline__ void p5_ln1(Frame& F) {
    const bf16* Y1 = F.ws<bf16>(WS_Y1); const float* ln1_g = F.in(I_LN1G); const float* ln1_b = F.in(I_LN1B); unsigned char* X8 = F.ws<unsigned char>(WS_X8); float* SX = F.ws<float>(WS_SX); float* LNS = F.ws<float>(WS_LNS); float* SXQ = F.ws<float>(WS_SXQ);
    const int gw = F.vcu_() * NWAVES + F.wave_(), NGW = F.G_() * NWAVES, lane = F.lane();
    v4u nx[4];
    if (gw < M) { const GAS v4u* p = (const GAS v4u*)(Y1 + (size_t)gw * D) + lane;
#pragma unroll
        for (int j = 0; j < 4; ++j) nx[j] = p[64 * j]; }
    for (int m = gw; m < M; m += NGW) {
        v4u w[4]; float v[32]; float s = 0.f;
#pragma unroll
        for (int j = 0; j < 4; ++j) w[j] = nx[j];
        { const int mn = (m + NGW < M) ? m + NGW : m; const GAS v4u* p = (const GAS v4u*)(Y1 + (size_t)mn * D) + lane;
#pragma unroll
          for (int j = 0; j < 4; ++j) nx[j] = p[64 * j]; }
#pragma unroll
        for (int j = 0; j < 4; ++j) { const unsigned ww[4] = {w[j].x, w[j].y, w[j].z, w[j].w};
#pragma unroll
            for (int i = 0; i < 4; ++i) { v[8 * j + 2 * i] = bflo(ww[i]); v[8 * j + 2 * i + 1] = bfhi(ww[i]); s += v[8 * j + 2 * i] + v[8 * j + 2 * i + 1]; } }
        const float mean = wave_sum(s) * (1.f / D); float q = 0.f;
#pragma unroll
        for (int i = 0; i < 32; ++i) { v[i] -= mean; q += v[i] * v[i]; }
        const float rstd = 1.f / sqrtf(wave_sum(q) * (1.f / D) + LN_EPS);
        float am = 0.f;
#pragma unroll
        for (int j = 0; j < 4; ++j) { const int c0 = 8 * lane + 512 * j; const f32x4 g0 = *(const f32x4*)(ln1_g + c0), g1 = *(const f32x4*)(ln1_g + c0 + 4), b0 = *(const f32x4*)(ln1_b + c0), b1 = *(const f32x4*)(ln1_b + c0 + 4);
#pragma unroll
            for (int i = 0; i < 4; ++i) { v[8 * j + i] = v[8 * j + i] * rstd * g0[i] + b0[i]; v[8 * j + 4 + i] = v[8 * j + 4 + i] * rstd * g1[i] + b1[i]; am = fmaxf(am, fmaxf(fabsf(v[8 * j + i]), fabsf(v[8 * j + 4 + i]))); } }
#pragma unroll
        for (int o = 1; o < 64; o <<= 1) am = fmaxf(am, __shfl_xor(am, o));
        const float sc = am > 0.f ? am * (1.f / 127.f) : 1.f, inv = 1.f / sc;
        GAS v2u* p8 = (GAS v2u*)(X8 + (size_t)m * D) + lane;
#pragma unroll
        for (int j = 0; j < 4; ++j) p8[64 * j] = (v2u){pack_i8x4(v[8 * j] * inv, v[8 * j + 1] * inv, v[8 * j + 2] * inv, v[8 * j + 3] * inv), pack_i8x4(v[8 * j + 4] * inv, v[8 * j + 5] * inv, v[8 * j + 6] * inv, v[8 * j + 7] * inv)};
        float qs = 0.f;
#pragma unroll
        for (int i = 0; i < 32; ++i) qs += rintf(v[i] * inv);
        qs = wave_sum(qs);
        if (lane == 0) { SX[m] = sc; LNS[2 * m] = mean; LNS[2 * m + 1] = rstd; SXQ[m] = qs; }
    }
}
__device__ __forceinline__ int f2key(float f) { const int b = __float_as_int(f); return b ^ ((b >> 31) & 0x7fffffff); }
__device__ __forceinline__ float key2f(int k) { return __int_as_float(k ^ ((k >> 31) & 0x7fffffff)); }
#define CE_DESC(a, b) do { const int _x = max(a, b), _y = min(a, b); a = _x; b = _y; } while (0)
#define CE_ASC(a, b)  do { const int _x = min(a, b), _y = max(a, b); a = _x; b = _y; } while (0)
template <int N> __device__ __forceinline__ void sort_desc(int (&v)[N]) {
#pragma unroll
    for (int k = 2; k <= N; k <<= 1)
#pragma unroll
        for (int j = k >> 1; j > 0; j >>= 1)
#pragma unroll
            for (int i = 0; i < N; ++i) { const int l = i ^ j; if (l > i) { if ((i & k) == 0) CE_DESC(v[i], v[l]); else CE_ASC(v[i], v[l]); } }
}
template <int N> __device__ __forceinline__ void bitonic_merge_desc(int (&v)[N]) {
#pragma unroll
    for (int j = N >> 1; j > 0; j >>= 1)
#pragma unroll
        for (int i = 0; i < N; ++i) { const int l = i ^ j; if (l > i) CE_DESC(v[i], v[l]); }
}
__device__ __forceinline__ void merge16(const int (&a)[16], const int (&b)[16], int (&o)[16]) {
#pragma unroll
    for (int i = 0; i < 16; ++i) o[i] = max(a[i], b[15 - i]);
    bitonic_merge_desc<16>(o);
}
__device__ __forceinline__ void top16_of_64(const int (&v)[64], int (&o)[16]) {
    int g0[16], g1[16], g2[16], g3[16];
#pragma unroll
    for (int i = 0; i < 16; ++i) { g0[i] = v[i]; g1[i] = v[16 + i]; g2[i] = v[32 + i]; g3[i] = v[48 + i]; }
    sort_desc<16>(g0); sort_desc<16>(g1); sort_desc<16>(g2); sort_desc<16>(g3);
    int m0[16], m1[16]; merge16(g0, g1, m0); merge16(g2, g3, m1); merge16(m0, m1, o);
}
__device__ const unsigned char PEER_PAIR[64] = {0,1,2,3,4,5,6,7,8,9,10,11,12,13,14,15, 16,17,18,19,20,21,22,23, 32,33,34,35,36, 48,49,50,51, 64,65,66, 80,81, 96,97, 112,113, 128,144,160,176,192,208,224,240, 0,0,0,0,0,0,0,0,0,0,0,0,0,0};
__device__ __forceinline__ void peer_subkey_top16(const bf16* qrow  , const bf16* keys_hc  , int r32, int hi, int (&o)[16]) {
    bf16x8 bq[8];
    asm volatile("" : "+v"(qrow));
#pragma unroll
    for (int s = 0; s < 8; ++s) bq[s] = *(const bf16x8*)(qrow + 8 * s);
    int run[16];
#pragma unroll
    for (int mt = 0; mt < 4; ++mt) {
        const bf16* krow = keys_hc + (size_t)(32 * mt + r32) * PHALF + hi * 64;
        asm volatile("" : "+v"(krow));
        bf16x8 ka[8];
#pragma unroll
        for (int s = 0; s < 8; ++s) ka[s] = *(const bf16x8*)(krow + 8 * s);
#ifdef PEER_A_FENCE
        asm volatile("" ::: "memory");
#endif
        f32x16 acc = {};
#pragma unroll
        for (int s = 0; s < 8; ++s) acc = __builtin_amdgcn_mfma_f32_32x32x16_bf16(ka[s], bq[s], acc, 0, 0, 0);
        int g[16];
#pragma unroll
        for (int r = 0; r < 16; ++r) g[r] = (f2key(acc[r]) & ~127) | ((r & 3) + 8 * (r >> 2));
        sort_desc<16>(g);
        if (mt) {
#pragma unroll
            for (int r = 0; r < 16; ++r) g[r] |= 32 * mt; }
        if (mt == 0) {
#pragma unroll
            for (int r = 0; r < 16; ++r) run[r] = g[r];
        } else { int t2[16]; merge16(run, g, t2);
#pragma unroll
            for (int r = 0; r < 16; ++r) run[r] = t2[r]; }
    }
    int lo[16], hh[16]; const int hi4 = 4 * hi;
#pragma unroll
    for (int i = 0; i < 16; ++i) { run[i] |= hi4; auto rr = __builtin_amdgcn_permlane32_swap((unsigned)run[i], (unsigned)run[i], false, false); lo[i] = (int)rr[0]; hh[i] = (int)rr[1]; }
    merge16(lo, hh, o);
}
__device__ __forceinline__ float gelu_erf(float v) { return 0.5f * v * (1.f + erff(v * 0.70710678118654752f)); }

typedef float f32x2 __attribute__((ext_vector_type(2)));
constexpr int P7_W8 = 98304, P7_SW = 114688;
constexpr int P7_ACT = 0, P7_EID = 65536, P7_SCR = 0  , P7_SCR_WAVE = 32 * 33 * 4, PCH = 128, NCH = D / PCH;
static_assert(P7_SCR + NWAVES * P7_SCR_WAVE <= P7_EID && P7_EID + 128 * 128 * 2 <= RING_BYTES, "PEER LDS map");

__device__ __forceinline__ void p7_peer(Frame& F) {
    const int lane = F.lane(), r32 = lane & 31, hi = lane >> 5, j8 = lane & 7, g8 = lane >> 3;
    constexpr int TPB = 128;
    LAS float* ACT = (LAS float*)(F.lds + P7_ACT); LAS unsigned short* EIDL = (LAS unsigned short*)(F.lds + P7_EID);
    LAS int* scr = (LAS int*)(F.lds + P7_SCR + F.wave_() * P7_SCR_WAVE);
    for (int blk = F.vcu_(); blk < M / TPB; blk += F.G_()) {
        const int m0 = blk * TPB;
        { const int h = F.wave_(); const bf16* QP = F.ws<bf16>(WS_QP); const bf16* KEYS = F.ws<bf16>(WS_KEYS); float* GATE = F.ws<float>(WS_GATE);
          for (int tt = 0; tt < 4; ++tt) {
            const int tl = 32 * tt + r32, tok = m0 + tl;
            const bf16* qrow = QP + (size_t)tok * D + h * 256 + hi * 64;
            int s1[16], s2[16];
            peer_subkey_top16(qrow, KEYS + (size_t)(h * 2 + 0) * PNK * PHALF, r32, hi, s1);
            asm volatile("" ::: "memory");
            peer_subkey_top16(qrow + 128, KEYS + (size_t)(h * 2 + 1) * PNK * PHALF, r32, hi, s2);
            float f1[16], f2[16];
#pragma unroll
            for (int i = 0; i < 16; ++i) { f1[i] = key2f(s1[i]); f2[i] = key2f(s2[i]); }
            if (hi == 0) {
#pragma unroll
                for (int i = 0; i < 16; ++i) { scr[r32 * 33 + i] = s1[i] & 127; scr[r32 * 33 + 16 + i] = s2[i] & 127; } }
            int cand[64];
            {
#define PC(n_, i_, j_) cand[n_] = (f2key(f1[i_] + f2[j_]) & ~255) | (n_)
                PC(0,0,0); PC(1,0,1); PC(2,0,2); PC(3,0,3); PC(4,0,4); PC(5,0,5); PC(6,0,6); PC(7,0,7); PC(8,0,8); PC(9,0,9); PC(10,0,10); PC(11,0,11); PC(12,0,12); PC(13,0,13); PC(14,0,14); PC(15,0,15);
                PC(16,1,0); PC(17,1,1); PC(18,1,2); PC(19,1,3); PC(20,1,4); PC(21,1,5); PC(22,1,6); PC(23,1,7);
                PC(24,2,0); PC(25,2,1); PC(26,2,2); PC(27,2,3); PC(28,2,4);
                PC(29,3,0); PC(30,3,1); PC(31,3,2); PC(32,3,3);
                PC(33,4,0); PC(34,4,1); PC(35,4,2);
                PC(36,5,0); PC(37,5,1); PC(38,6,0); PC(39,6,1); PC(40,7,0); PC(41,7,1);
                PC(42,8,0); PC(43,9,0); PC(44,10,0); PC(45,11,0); PC(46,12,0); PC(47,13,0); PC(48,14,0); PC(49,15,0);
#undef PC
            }
#pragma unroll
            for (int i = 50; i < 64; ++i) cand[i] = (int)0x80000000;
            int sc[16]; top16_of_64(cand, sc);
            float p[16]; const float mx = key2f(sc[0]); float z = 0.f;
#pragma unroll
            for (int k = 0; k < 16; ++k) { p[k] = __expf(key2f(sc[k]) - mx); z += p[k]; }
            const float rz = 1.f / z;
            LDS_WAIT();
            int eo[8]; float go[8]; const int him = -hi;
#pragma unroll
            for (int kk = 0; kk < 8; ++kk) { const int tag = PEER_PAIR[((sc[kk] & ~him) | (sc[8 + kk] & him)) & 255];
                const int i1 = scr[r32 * 33 + (tag >> 4)], i2 = scr[r32 * 33 + 16 + (tag & 15)];
                eo[kk] = i1 * PNK + i2; go[kk] = __int_as_float((__float_as_int(p[kk]) & ~him) | (__float_as_int(p[8 + kk]) & him)) * rz; }
            *(LAS v4u*)(EIDL + tl * 128 + h * 16 + 8 * hi) = (v4u){(unsigned)(eo[0] | (eo[1] << 16)), (unsigned)(eo[2] | (eo[3] << 16)), (unsigned)(eo[4] | (eo[5] << 16)), (unsigned)(eo[6] | (eo[7] << 16))};
            GAS float* gp = (GAS float*)(GATE + (size_t)tok * 128 + h * 16 + 8 * hi);
            *(GAS f32x4*)gp = (f32x4){go[0], go[1], go[2], go[3]}; *(GAS f32x4*)(gp + 4) = (f32x4){go[4], go[5], go[6], go[7]};
            LDS_WAIT();
          } }
        __threadfence_block(); __syncthreads();
        const int tw = F.wave_() * (TPB / NWAVES);
        for (int i = lane; i < (TPB / NWAVES) * 128; i += 64) ACT[tw * 128 + i] = 0.f;
        { const unsigned char* X8 = F.ws<unsigned char>(WS_X8); const unsigned char* U8 = F.ws<unsigned char>(WS_U8);
#define U_ISSUE(n_, PC, XQ0, XQ1) do { const int c_ = (n_) >> 4, tl_ = tw + ((n_) & 15); \
            { const GAS v4u* xp_ = (const GAS v4u*)(X8 + (size_t)(m0 + tl_) * D + c_ * UCH + 32 * j8); XQ0 = xp_[0]; XQ1 = xp_[1]; } \
            const LAS unsigned short* ep_ = EIDL + tl_ * 128 + g8; const unsigned char* ub_ = U8 + (size_t)c_ * (NEXP * PCH) + 16 * j8; \
            _Pragma("unroll") for (int i = 0; i < 16; ++i) { const unsigned e_ = ep_[8 * i]; PC[i] = *(const GAS v4u*)(ub_ + e_ * PCH); } } while (0)
#define U_COMPUTE(n_, PC, XQ0, XQ1) do { const int tl_ = tw + ((n_) & 15); \
            const unsigned xw_[8] = {XQ0.x, XQ0.y, XQ0.z, XQ0.w, XQ1.x, XQ1.y, XQ1.z, XQ1.w}; int pp_[16]; \
            _Pragma("unroll") for (int i = 0; i < 16; ++i) { const unsigned w4_[4] = {PC[i].x, PC[i].y, PC[i].z, PC[i].w}; int a_ = 0; \
                _Pragma("unroll") for (int m = 0; m < 4; ++m) { a_ = __builtin_amdgcn_sdot4((int)(w4_[m] & 0x0f0f0f0fu), (int)xw_[2 * m], a_, false); a_ = __builtin_amdgcn_sdot4((int)((w4_[m] >> 4) & 0x0f0f0f0fu), (int)xw_[2 * m + 1], a_, false); } \
                pp_[i] = a_; } \
              \
            int q8_[8], q4_[4], q2_[2]; \
            { const bool b2_ = lane & 4; _Pragma("unroll") for (int i = 0; i < 8; ++i) { const int k_ = b2_ ? pp_[2 * i + 1] : pp_[2 * i], s_ = b2_ ? pp_[2 * i] : pp_[2 * i + 1]; q8_[i] = k_ + dppi<0x141>(s_); } } \
            { const bool b1_ = lane & 2; _Pragma("unroll") for (int i = 0; i < 4; ++i) { const int k_ = b1_ ? q8_[2 * i + 1] : q8_[2 * i], s_ = b1_ ? q8_[2 * i] : q8_[2 * i + 1]; q4_[i] = k_ + dppi<0x4E>(s_); } } \
            { const bool b0_ = lane & 1; _Pragma("unroll") for (int i = 0; i < 2; ++i) { const int k_ = b0_ ? q4_[2 * i + 1] : q4_[2 * i], s_ = b0_ ? q4_[2 * i] : q4_[2 * i + 1]; q2_[i] = k_ + dppi<0xB1>(s_); } } \
            const int irow_ = ((lane & 1) << 2) | (lane & 2) | ((lane >> 2) & 1); \
            LAS float* ap_ = ACT + tl_ * 128 + 8 * irow_ + g8; ap_[0] += (float)q2_[0]; ap_[64] += (float)q2_[1]; } while (0)
          constexpr int UCH = 256, NSTEP = (D / UCH) * (TPB / NWAVES);
          v4u pcA[16], pcB[16], xqA0, xqA1, xqB0, xqB1;
          U_ISSUE(0, pcA, xqA0, xqA1);
          for (int n = 0; n < NSTEP; n += 2) {
              U_ISSUE(n + 1, pcB, xqB0, xqB1); __builtin_amdgcn_sched_barrier(0);
              U_COMPUTE(n, pcA, xqA0, xqA1); __builtin_amdgcn_sched_barrier(0);
              { const int nn = (n + 2 < NSTEP) ? n + 2 : n; U_ISSUE(nn, pcA, xqA0, xqA1); }
              __builtin_amdgcn_sched_barrier(0);
              U_COMPUTE(n + 1, pcB, xqB0, xqB1); __builtin_amdgcn_sched_barrier(0);
          }
#undef U_ISSUE
#undef U_COMPUTE
        }
        LDS_WAIT();
        { const float* SU = F.ws<float>(WS_SU); const float* SV = F.ws<float>(WS_SV); const float* GATE = F.ws<float>(WS_GATE); const float* SX = F.ws<float>(WS_SX); const float* SXQ = F.ws<float>(WS_SXQ);
        LAS unsigned char* W8L = (LAS unsigned char*)(F.lds + P7_W8); LAS float* SWL = (LAS float*)(F.lds + P7_SW);
        for (int ti = 0; ti < TPB / NWAVES; ++ti) {
            const int tl = tw + ti, t = m0 + tl; const float sx = SX[t], xoff = 8.f * SXQ[t]; float wv[2];
#pragma unroll
            for (int kq = 0; kq < 2; ++kq) { const int k = lane + 64 * kq; const unsigned e = EIDL[tl * 128 + k]; const float a = (ACT[tl * 128 + k] - xoff) * SU[e] * sx;
                wv[kq] = __builtin_nontemporal_load(GATE + (size_t)t * 128 + k) * gelu_erf(a) * SV[e]; }
            float am = fmaxf(fabsf(wv[0]), fabsf(wv[1]));
#pragma unroll
            for (int o = 1; o < 64; o <<= 1) am = fmaxf(am, __shfl_xor(am, o));
            const float sc = am > 0.f ? am * (1.f / 127.f) : 1.f, inv = 1.f / sc;
            float wsum = 0.f;
#pragma unroll
            for (int kq = 0; kq < 2; ++kq) { const int k = lane + 64 * kq; const float q = rintf(wv[kq] * inv); wsum += q; W8L[tl * 128 + (k & 7) * 16 + (k >> 3)] = (unsigned char)((int)q & 255); }
            wsum = wave_sum(wsum);
            if (lane == 0) { SWL[tl] = sc; SWL[128 + tl] = 8.f * wsum; }
        } }
        LDS_WAIT();
        { const bf16* X1 = F.ws<bf16>(WS_Y1); const unsigned char* V8 = F.ws<unsigned char>(WS_V8); bf16* Y2 = F.ws<bf16>(WS_QP); const float* LNS = F.ws<float>(WS_LNS); const float* ln1_g = F.in(I_LN1G); const float* ln1_b = F.in(I_LN1B);
#define V_ISSUE(n_, PC, WQ, XP) do { const int c_ = (n_) >> 4, tl_ = tw + ((n_) & 15); \
            const LAS unsigned short* ep_ = EIDL + tl_ * 128 + g8; const unsigned char* vb_ = V8 + (size_t)c_ * (NEXP * PCH) + 16 * j8; \
            _Pragma("unroll") for (int i = 0; i < 16; ++i) { const unsigned e_ = ep_[8 * i]; PC[i] = *(const GAS v4u*)(vb_ + e_ * PCH); } \
            WQ = *(const LAS v4u*)(F.lds + P7_W8 + tl_ * 128 + g8 * 16); \
            XP = *(const GAS v2u*)(X1 + (size_t)(m0 + tl_) * D + c_ * VCH + 32 * j8 + 4 * g8); } while (0)
#define V_TR4(A_, B_, C_, D_, WQ_, O_) do { const unsigned t0_ = __builtin_amdgcn_perm(B_, A_, 0x05010400u), t1_ = __builtin_amdgcn_perm(B_, A_, 0x07030602u), t2_ = __builtin_amdgcn_perm(D_, C_, 0x05010400u), t3_ = __builtin_amdgcn_perm(D_, C_, 0x07030602u); \
            const unsigned u0_ = __builtin_amdgcn_perm(t2_, t0_, 0x05040100u), u1_ = __builtin_amdgcn_perm(t2_, t0_, 0x07060302u), u2_ = __builtin_amdgcn_perm(t3_, t1_, 0x05040100u), u3_ = __builtin_amdgcn_perm(t3_, t1_, 0x07060302u); \
            ac_[(O_) + 0] = __builtin_amdgcn_sdot4((int)(u0_ & 0x0f0f0f0fu), (int)(WQ_), ac_[(O_) + 0], false); ac_[(O_) + 4] = __builtin_amdgcn_sdot4((int)((u0_ >> 4) & 0x0f0f0f0fu), (int)(WQ_), ac_[(O_) + 4], false); \
            ac_[(O_) + 1] = __builtin_amdgcn_sdot4((int)(u1_ & 0x0f0f0f0fu), (int)(WQ_), ac_[(O_) + 1], false); ac_[(O_) + 5] = __builtin_amdgcn_sdot4((int)((u1_ >> 4) & 0x0f0f0f0fu), (int)(WQ_), ac_[(O_) + 5], false); \
            ac_[(O_) + 2] = __builtin_amdgcn_sdot4((int)(u2_ & 0x0f0f0f0fu), (int)(WQ_), ac_[(O_) + 2], false); ac_[(O_) + 6] = __builtin_amdgcn_sdot4((int)((u2_ >> 4) & 0x0f0f0f0fu), (int)(WQ_), ac_[(O_) + 6], false); \
            ac_[(O_) + 3] = __builtin_amdgcn_sdot4((int)(u3_ & 0x0f0f0f0fu), (int)(WQ_), ac_[(O_) + 3], false); ac_[(O_) + 7] = __builtin_amdgcn_sdot4((int)((u3_ >> 4) & 0x0f0f0f0fu), (int)(WQ_), ac_[(O_) + 7], false); } while (0)
#define V_COMPUTE(n_, PC, WQ, XP) do { const int c_ = (n_) >> 4, tl_ = tw + ((n_) & 15); \
            int ac_[32]; \
            _Pragma("unroll") for (int d = 0; d < 32; ++d) ac_[d] = 0; \
            const unsigned wq_[4] = {WQ.x, WQ.y, WQ.z, WQ.w}; \
            _Pragma("unroll") for (int gq = 0; gq < 4; ++gq) { \
                const unsigned pa_[4] = {PC[4 * gq].x, PC[4 * gq].y, PC[4 * gq].z, PC[4 * gq].w}, pb_[4] = {PC[4 * gq + 1].x, PC[4 * gq + 1].y, PC[4 * gq + 1].z, PC[4 * gq + 1].w}; \
                const unsigned pc_[4] = {PC[4 * gq + 2].x, PC[4 * gq + 2].y, PC[4 * gq + 2].z, PC[4 * gq + 2].w}, pd_[4] = {PC[4 * gq + 3].x, PC[4 * gq + 3].y, PC[4 * gq + 3].z, PC[4 * gq + 3].w}; \
                _Pragma("unroll") for (int m = 0; m < 4; ++m) { \
                    V_TR4(pa_[m], pb_[m], pc_[m], pd_[m], wq_[gq], 8 * m); } } \
              \
            int r16_[16], r8_[8], r4_[4]; \
            _Pragma("unroll") for (int i = 0; i < 16; ++i) { auto rr_ = __builtin_amdgcn_permlane32_swap((unsigned)ac_[i], (unsigned)ac_[i + 16], false, false); r16_[i] = (int)rr_[0] + (int)rr_[1]; } \
            _Pragma("unroll") for (int i = 0; i < 8; ++i) { auto rr_ = __builtin_amdgcn_permlane16_swap((unsigned)r16_[i], (unsigned)r16_[i + 8], false, false); r8_[i] = (int)rr_[0] + (int)rr_[1]; } \
            { const bool b3_ = lane & 8; _Pragma("unroll") for (int i = 0; i < 4; ++i) { const int k_ = b3_ ? r8_[i + 4] : r8_[i], s_ = b3_ ? r8_[i] : r8_[i + 4]; r4_[i] = k_ + dppi<0x128>(s_); } } \
            const LAS float* swp_ = (const LAS float*)(F.lds + P7_SW); const float sw_ = swp_[tl_], wo_ = swp_[128 + tl_]; \
            const f32x2 ms_ = *(const f32x2*)(LNS + 2 * (size_t)(m0 + tl_)); const int dim0_ = c_ * VCH + 32 * j8 + 4 * g8; const f32x4 gg_ = *(const f32x4*)(ln1_g + dim0_), bb_ = *(const f32x4*)(ln1_b + dim0_); \
            const float y_[4] = {bflo(XP.x), bfhi(XP.x), bflo(XP.y), bfhi(XP.y)}; float o_[4]; \
            _Pragma("unroll") for (int i = 0; i < 4; ++i) o_[i] = ((float)r4_[i] - wo_) * sw_ + DN_ALPHA * ((y_[i] - ms_.x) * ms_.y * gg_[i] + bb_[i]); \
            *(GAS v2u*)(Y2 + (size_t)(m0 + tl_) * D + dim0_) = (v2u){pk2(o_[0], o_[1]), pk2(o_[2], o_[3])}; } while (0)
          constexpr int VCH = 256, NSTEP = (D / VCH) * (TPB / NWAVES);
          v4u pcA[16], pcB[16], wqA, wqB; v2u xpA, xpB;
          V_ISSUE(0, pcA, wqA, xpA);
          for (int n = 0; n < NSTEP; n += 2) {
              V_ISSUE(n + 1, pcB, wqB, xpB); __builtin_amdgcn_sched_barrier(0);
              V_COMPUTE(n, pcA, wqA, xpA); __builtin_amdgcn_sched_barrier(0);
              { const int nn = (n + 2 < NSTEP) ? n + 2 : n; V_ISSUE(nn, pcA, wqA, xpA); }
              __builtin_amdgcn_sched_barrier(0);
              V_COMPUTE(n + 1, pcB, wqB, xpB); __builtin_amdgcn_sched_barrier(0);
          }
#undef V_TR4
#undef V_ISSUE
#undef V_COMPUTE
        }
        { const float* ln2_g = F.in(I_LN2G); const float* ln2_b = F.in(I_LN2B); float* outp = F.outp(); const bf16* Y2 = F.ws<bf16>(WS_QP);
        for (int ti = 0; ti < TPB / NWAVES; ++ti) {
            const int t = m0 + tw + ti;
            const GAS v4u* yp = (const GAS v4u*)(Y2 + (size_t)t * D) + lane;
            float v[32]; float s = 0.f;
#pragma unroll
            for (int j = 0; j < 4; ++j) { const v4u w = yp[64 * j]; const unsigned ww[4] = {w.x, w.y, w.z, w.w};
#pragma unroll
                for (int i = 0; i < 4; ++i) { v[8 * j + 2 * i] = bflo(ww[i]); v[8 * j + 2 * i + 1] = bfhi(ww[i]); s += v[8 * j + 2 * i] + v[8 * j + 2 * i + 1]; } }
            const float mean = wave_sum(s) * (1.f / D); float qv = 0.f;
#pragma unroll
            for (int i = 0; i < 32; ++i) { v[i] -= mean; qv += v[i] * v[i]; }
            const float rstd = 1.f / sqrtf(wave_sum(qv) * (1.f / D) + LN_EPS);
#pragma unroll
            for (int j = 0; j < 4; ++j) { const int c0 = 8 * lane + 512 * j; const f32x4 g0 = *(const f32x4*)(ln2_g + c0), g1 = *(const f32x4*)(ln2_g + c0 + 4), b0 = *(const f32x4*)(ln2_b + c0), b1 = *(const f32x4*)(ln2_b + c0 + 4);
                f32x4 r0, r1;
#pragma unroll
                for (int i = 0; i < 4; ++i) { r0[i] = v[8 * j + i] * rstd * g0[i] + b0[i]; r1[i] = v[8 * j + 4 + i] * rstd * g1[i] + b1[i]; }
                GAS f32x4* op = (GAS f32x4*)(outp + (size_t)t * D + c0); op[0] = r0; op[1] = r1; }
        } }
        __syncthreads();
    }
}

struct Args { const float* in[22]; float* out; unsigned char* ws; int ph_lo, ph_hi; };
__global__ void __launch_bounds__(NWAVES * 64, 2) mk_fwd(Args args) {
    extern __shared__ __attribute__((aligned(16))) unsigned char lds[];
    cg::grid_group grid = cg::this_grid();
    Frame F;
    F.lds = (LAS unsigned char*)lds;
    if (threadIdx.x == 0) { LAS unsigned long long* PT = (LAS unsigned long long*)(F.lds + RING_BYTES);
#pragma unroll
        for (int k = 0; k < 22; ++k) PT[k] = (unsigned long long)args.in[k];
        PT[22] = (unsigned long long)args.out; PT[23] = (unsigned long long)args.ws;
        ((LAS unsigned*)(F.lds + RING_BYTES + 256))[0] = 0u; ((LAS unsigned*)(F.lds + RING_BYTES + 256))[1] = 0u; }
    __syncthreads();
    const int lo = args.ph_lo, hi = args.ph_hi;
#ifndef PHASE_MASK
#define PHASE_MASK 255
#endif
#define IN(k) (((PHASE_MASK >> (k)) & 1) && lo <= (k) && (k) < hi)
#ifndef REPEAT_PHASE
#define REPEAT_PHASE -1
#endif
#define REP(k) for (int rep_ = 0; rep_ < ((REPEAT_PHASE == (k)) ? 2 : 1); ++rep_)
    (void)xcd_barrier_post((unsigned*)args.ws, (volatile LAS unsigned*)(F.lds + RING_BYTES + 256));
#define XBAR() do { XcdBarrier bar_; bar_.bar = F.ws<unsigned>(0); bar_.x = xb_xcc_id(); bar_.st = (volatile LAS unsigned*)(F.lds + RING_BYTES + 256); xcd_barrier(bar_); } while (0)
#define SEAM(k) do { if (IN(k) && IN((k) + 1)) XBAR(); } while (0)

    if (lo < 0) grid.sync();
    if (IN(0)) REP(0) { p0a_prologue(F); XBAR(); p0b_prologue(F); } SEAM(0);
    if (IN(1)) REP(1) {
        pg8::Gemm g{F.ws<bf16>(WS_XB), F.ws<bf16>(WS_WIN), M, NPROJ, D / 2}; pg8::StaticOrder S; S.init(M, NPROJ, F.G_(), (int)blockIdx.x);
        pg8::EpiProjI8 E{F.ws<bf16>(WS_Q), (size_t)(WS_K - WS_Q) / 2, dattn::C2, F.ws<bf16>(WS_H), F.in(I_BGLU), F.ws<float>(WS_SXA), F.ws<float>(WS_SWIN)};
        pg8::gemm_phase<pg8::EpiProjI8, pg8::StaticOrder, PG8_ALIGN, PG8_SP2>(F.lds, g, S, E);
    } SEAM(1);
    if (IN(2)) REP(2) {
        static_assert(dattn::LDS_BYTES <= RING_BYTES, "attention body geometry vs frame");
        const dattn::Tensors AT{F.ws<const dattn::bf16>(WS_Q), F.ws<const dattn::bf16>(WS_K), F.ws<const dattn::bf16>(WS_V), F.ws<dattn::bf16>(WS_O1), F.ws<dattn::bf16>(WS_O2), F.ws<const float>(WS_TAB)};
        dattn::phase((char*)lds, AT, F.vcu_());
    } SEAM(2);
    if (IN(3)) REP(3) { p3_mix(F); } SEAM(3);
    if (IN(4)) REP(4) {
        pg8::Gemm g{F.ws<bf16>(WS_XB), F.ws<bf16>(WS_WOUT), M, D, D / 2}; pg8::StaticOrder S; S.init(M, D, F.G_(), (int)blockIdx.x);
        pg8::EpiResI8 E{F.in(I_X), F.ws<bf16>(WS_Y1), D, DN_ALPHA, F.ws<float>(WS_SM), F.ws<float>(WS_SWOUT)};
        pg8::gemm_phase<pg8::EpiResI8, pg8::StaticOrder, PG8_ALIGN, PG8_SP2>(F.lds, g, S, E);
    } SEAM(4);
    if (IN(5)) REP(5) { p5_ln1(F); } SEAM(5);
    if (IN(6)) REP(6) {
        pg8::Gemm g{F.ws<bf16>(WS_X8), F.ws<bf16>(WS_WQ), M, D, D / 2}; pg8::StaticOrder S; S.init(M, D, F.G_(), (int)blockIdx.x);
        pg8::EpiPlainI8 E{F.ws<bf16>(WS_QP), D, F.ws<float>(WS_SX), F.ws<float>(WS_SWQ)};
        pg8::gemm_phase<pg8::EpiPlainI8, pg8::StaticOrder, PG8_ALIGN, PG8_SP2>(F.lds, g, S, E);
    } SEAM(6);
    if (IN(7)) REP(7) { p7_peer(F); }
#undef IN
#undef SEAM
}

extern "C" void kernel_launch(void* const* d_in, const int* in_sizes, int n_in, void* d_out, int out_size, void* d_ws, size_t ws_size, hipStream_t stream) {
    static int grid = 0;
    if (grid == 0) {
        if (n_in != 22 || in_sizes[0] != M * D || out_size != M * D || ws_size < WS_END) { fprintf(stderr, "kernel_launch: unexpected shapes (n_in %d, in0 %d, out %d, ws %zu); nothing launched\n", n_in, n_in > 0 ? in_sizes[0] : -1, out_size, ws_size); grid = -1; return; }
        int dev = 0, cus = 0, per_cu = 0;
        if (hipGetDevice(&dev) != hipSuccess || hipDeviceGetAttribute(&cus, hipDeviceAttributeMultiprocessorCount, dev) != hipSuccess) { grid = -1; return; }
        if (hipFuncSetAttribute((const void*)mk_fwd, hipFuncAttributeMaxDynamicSharedMemorySize, LDS_BYTES) != hipSuccess) { fprintf(stderr, "kernel_launch: hipFuncSetAttribute failed\n"); grid = -1; return; }
        if (hipOccupancyMaxActiveBlocksPerMultiprocessor(&per_cu, (const void*)mk_fwd, NWAVES * 64, LDS_BYTES) != hipSuccess || per_cu < 1) { fprintf(stderr, "kernel_launch: occupancy query reports %d workgroups per CU\n", per_cu); (void)hipGetLastError(); grid = -1; return; }
        grid = cus;
        if (grid > 256) grid = 256;
    }
    if (grid < 0) return;
    if (hipMemsetAsync(d_ws, 0, 65536, stream) != hipSuccess) { fprintf(stderr, "kernel_launch: hipMemsetAsync failed\n"); return; }
    Args a{};
    for (int i = 0; i < 22; ++i) a.in[i] = (const float*)d_in[i];
    a.out = (float*)d_out; a.ws = (unsigned char*)d_ws;
    constexpr int NL = MK_N_LAUNCHES;
    for (int li = 0; li < NL; ++li) {
        a.ph_lo = (NL == 1) ? 0 : li; a.ph_hi = (NL == 1) ? N_PHASES : li + 1;
        void* kargs[] = {&a};
        const hipError_t le = hipLaunchCooperativeKernel((const void*)mk_fwd, dim3(grid), dim3(NWAVES * 64), kargs, LDS_BYTES, stream);
        if (le != hipSuccess) { fprintf(stderr, "kernel_launch: cooperative launch %d failed: %s (grid %d)\n", li, hipGetErrorString(le), grid); break; }
    }
}
```

```cpp
#include <hip/hip_runtime.h>
#include <hip/hip_cooperative_groups.h>
#include <cstdio>
#include <cstdint>
namespace cg = cooperative_groups;
namespace pg8 {
#define PG8_LAS __attribute__((address_space(3)))
typedef unsigned short bf16_t;
typedef short bf16x8 __attribute__((ext_vector_type(8)));
typedef float f32x4 __attribute__((ext_vector_type(4)));
typedef unsigned u32x4 __attribute__((ext_vector_type(4)));
typedef int i32x4 __attribute__((ext_vector_type(4)));
constexpr int BM = 256, BK = 64, HALF = 128, HTB = HALF * BK * 2  , STAGE_BYTES = 8 * HTB, NXCD = 8, WGM = 8;

__host__ __device__ __forceinline__ int lds_byte(int r, int c) { const int st = (r >> 4) * 2 + (c >> 5), rr = r & 15, cc = c & 31, ob = rr * 64 + cc * 2; return st * 1024 + (ob ^ (((ob >> 9) & 1) << 5)); }
__host__ __device__ __forceinline__ void stage_rc(int b, int& R, int& C) { const int st = b / 1024, sb = b % 1024, swz = sb ^ (((sb >> 9) & 1) << 5); R = (st >> 1) * 16 + swz / 64; C = (st & 1) * 32 + (swz % 64) / 2; }
__host__ __device__ __forceinline__ int perm32(int rho) { const int n = rho >> 4, i = rho & 15; return 8 * (i >> 2) + 4 * n + (i & 3); }

struct Unit { int pm, pn; };
struct Gemm { const bf16_t* A; const bf16_t* Bt; int M, N, K; };

struct StaticOrder {
    int nM, nN, nwg, G, c;
    __host__ __device__ void init(int M, int N, int G_, int c_) { nM = M / BM; nN = N / BM; nwg = nM * nN; G = G_; c = c_; }
    __host__ __device__ bool next(int i, Unit& u) const {
        const long L = (long)i * G + c; if (L >= nwg) return false;
        int wgid = (int)L; { const int q = nwg / NXCD, r = nwg % NXCD, xcd = wgid % NXCD, off = wgid / NXCD; wgid = (xcd < r ? xcd * (q + 1) : r * (q + 1) + (xcd - r) * q) + off; }
        const int nig = WGM * nN, gid = wgid / nig, fm = gid * WGM, gsz = (nM - fm) < WGM ? (nM - fm) : WGM;
        u.pm = fm + ((wgid % nig) % gsz); u.pn = (wgid % nig) / gsz; return true;
    }
    __device__ __forceinline__ void a_ready(const Unit&) const {}
    __device__ __forceinline__ void done(const Unit&) const {}
};

__device__ __forceinline__ unsigned cvt_pk_bf16(float lo, float hi) { unsigned r; asm volatile("v_cvt_pk_bf16_f32 %0, %1, %2" : "=v"(r) : "v"(lo), "v"(hi)); return r; }
typedef float f32x2 __attribute__((ext_vector_type(2)));
typedef float f32x2 __attribute__((ext_vector_type(2)));
__device__ __forceinline__ u32x4 pack8(f32x4 v0, f32x4 v1) { u32x4 w; w.x = cvt_pk_bf16(v0[0], v0[1]); w.y = cvt_pk_bf16(v0[2], v0[3]); w.z = cvt_pk_bf16(v1[0], v1[1]); w.w = cvt_pk_bf16(v1[2], v1[3]); return w; }
typedef _Float16 h16x2 __attribute__((ext_vector_type(2)));
__device__ __forceinline__ unsigned pkh2(float a, float b) { const h16x2 v = {(_Float16)__builtin_amdgcn_fmed3f(a, -65504.f, 65504.f), (_Float16)__builtin_amdgcn_fmed3f(b, -65504.f, 65504.f)}; return __builtin_bit_cast(unsigned, v); }
__device__ __forceinline__ u32x4 pack8h(f32x4 v0, f32x4 v1) { u32x4 w; w.x = pkh2(v0[0], v0[1]); w.y = pkh2(v0[2], v0[3]); w.z = pkh2(v1[0], v1[1]); w.w = pkh2(v1[2], v1[3]); return w; }
__device__ __forceinline__ f32x4 i2f(f32x4 a) { const i32x4 v = __builtin_bit_cast(i32x4, a); return (f32x4){(float)v[0], (float)v[1], (float)v[2], (float)v[3]}; }
struct EpiProjI8 {
    static constexpr bool PERM = true, AFTER_DRAIN = false, INT8 = true;
    bf16_t* QKV; size_t split_stride; float scale0; bf16_t* H; const float* bglu; const float* sa; const float* sb;
    __device__ __forceinline__ void operator()(const f32x4 (&acc)[2][2][4][2], const Unit& u, int wr, int wc, int fr, int fq) const {
        const int row0 = u.pm * BM + wr * 64 + fr, cb = u.pn * BM + wc * 32 + 8 * fq;
        f32x4 cs[2][2];
#pragma unroll
        for (int bj = 0; bj < 2; ++bj) { cs[bj][0] = *(const f32x4*)(sb + cb + bj * HALF); cs[bj][1] = *(const f32x4*)(sb + cb + bj * HALF + 4); }
        float rsv[2][4];
#pragma unroll
        for (int ai = 0; ai < 2; ++ai)
#pragma unroll
            for (int m = 0; m < 4; ++m) rsv[ai][m] = sa[row0 + ai * HALF + m * 16];
        if (u.pn < 12) {
            const int t = u.pn >> 2; bf16_t* base = QKV + (size_t)t * split_stride; const float sc = (t == 0) ? scale0 : 1.f;
            const int col0 = (u.pn & 3) * BM + wc * 32 + 8 * fq;
#pragma unroll
            for (int ai = 0; ai < 2; ++ai)
#pragma unroll
                for (int m = 0; m < 4; ++m) { const int row = row0 + ai * HALF + m * 16; const float rs = rsv[ai][m] * sc; bf16_t* rowp = base + (size_t)row * 1024 + col0;
#pragma unroll
                    for (int bj = 0; bj < 2; ++bj) *(u32x4*)(rowp + bj * HALF) = pack8(i2f(acc[ai][bj][m][0]) * cs[bj][0] * rs, i2f(acc[ai][bj][m][1]) * cs[bj][1] * rs); }
        } else {
            const int ch0 = (u.pn - 12) * HALF + wc * 32 + 8 * fq;
            const f32x4 ba0 = *(const f32x4*)(bglu + ch0), ba1 = *(const f32x4*)(bglu + ch0 + 4), bg0 = *(const f32x4*)(bglu + 1024 + ch0), bg1 = *(const f32x4*)(bglu + 1024 + ch0 + 4);
#pragma unroll
            for (int ai = 0; ai < 2; ++ai)
#pragma unroll
                for (int m = 0; m < 4; ++m) { const int row = row0 + ai * HALF + m * 16; const float rs = rsv[ai][m];
                    const f32x4 a0 = i2f(acc[ai][0][m][0]) * cs[0][0] * rs + ba0, a1 = i2f(acc[ai][0][m][1]) * cs[0][1] * rs + ba1, g0 = i2f(acc[ai][1][m][0]) * cs[1][0] * rs + bg0, g1 = i2f(acc[ai][1][m][1]) * cs[1][1] * rs + bg1;
                    f32x4 h0, h1;
#pragma unroll
                    for (int e = 0; e < 4; ++e) { h0[e] = a0[e] * __builtin_amdgcn_rcpf(1.f + __builtin_amdgcn_exp2f(-1.4426950409f * g0[e])); h1[e] = a1[e] * __builtin_amdgcn_rcpf(1.f + __builtin_amdgcn_exp2f(-1.4426950409f * g1[e])); }
                    *(u32x4*)(H + (size_t)row * 1024 + ch0) = pack8h(h0, h1); }
        }
    }
};
struct EpiPlainI8 {
    static constexpr bool PERM = true, AFTER_DRAIN = false, INT8 = true;
    bf16_t* O; int ldc; const float* sa; const float* sb;
    __device__ __forceinline__ void operator()(const f32x4 (&acc)[2][2][4][2], const Unit& u, int wr, int wc, int fr, int fq) const {
        const int row0 = u.pm * BM + wr * 64 + fr, col0 = u.pn * BM + wc * 32 + 8 * fq;
        f32x4 cs[2][2];
#pragma unroll
        for (int bj = 0; bj < 2; ++bj) { cs[bj][0] = *(const f32x4*)(sb + col0 + bj * HALF); cs[bj][1] = *(const f32x4*)(sb + col0 + bj * HALF + 4); }
        float rsv[2][4];
#pragma unroll
        for (int ai = 0; ai < 2; ++ai)
#pragma unroll
            for (int m = 0; m < 4; ++m) rsv[ai][m] = sa[row0 + ai * HALF + m * 16];
#pragma unroll
        for (int ai = 0; ai < 2; ++ai)
#pragma unroll
            for (int m = 0; m < 4; ++m) { const int row = row0 + ai * HALF + m * 16; const float rs = rsv[ai][m]; bf16_t* rowp = O + (size_t)row * ldc + col0;
#pragma unroll
                for (int bj = 0; bj < 2; ++bj) *(u32x4*)(rowp + bj * HALF) = pack8(i2f(acc[ai][bj][m][0]) * cs[bj][0] * rs, i2f(acc[ai][bj][m][1]) * cs[bj][1] * rs); }
    }
};
struct EpiResI8 {
    static constexpr bool PERM = true, AFTER_DRAIN = false, INT8 = true;
    const float* X; bf16_t* Y; int ldc; float alpha; const float* sa; const float* sb;
    __device__ __forceinline__ void operator()(const f32x4 (&acc)[2][2][4][2], const Unit& u, int wr, int wc, int fr, int fq) const {
        const int row0 = u.pm * BM + wr * 64 + fr, col0 = u.pn * BM + wc * 32 + 8 * fq;
        f32x4 cs[2][2];
#pragma unroll
        for (int bj = 0; bj < 2; ++bj) { cs[bj][0] = *(const f32x4*)(sb + col0 + bj * HALF); cs[bj][1] = *(const f32x4*)(sb + col0 + bj * HALF + 4); }
        float rsv[2][4];
#pragma unroll
        for (int ai = 0; ai < 2; ++ai)
#pragma unroll
            for (int m = 0; m < 4; ++m) rsv[ai][m] = sa[row0 + ai * HALF + m * 16];
#pragma unroll
        for (int ai = 0; ai < 2; ++ai) {
            f32x4 xv[4][2][2];
#pragma unroll
            for (int m = 0; m < 4; ++m) { const size_t off = (size_t)(row0 + ai * HALF + m * 16) * ldc + col0;
#pragma unroll
                for (int bj = 0; bj < 2; ++bj) { xv[m][bj][0] = *(const f32x4*)(X + off + bj * HALF); xv[m][bj][1] = *(const f32x4*)(X + off + bj * HALF + 4); } }
#pragma unroll
            for (int m = 0; m < 4; ++m) { const float rs = rsv[ai][m]; const size_t off = (size_t)(row0 + ai * HALF + m * 16) * ldc + col0;
#pragma unroll
                for (int bj = 0; bj < 2; ++bj)
                    *(u32x4*)(Y + off + bj * HALF) = pack8(i2f(acc[ai][bj][m][0]) * cs[bj][0] * rs + xv[m][bj][0] * alpha, i2f(acc[ai][bj][m][1]) * cs[bj][1] * rs + xv[m][bj][1] * alpha); }
            asm volatile("" ::: "memory"); }
    }
};
template <class Epi, class Sched, bool ALIGN_EPI = false, bool SP2 = false>
__device__ __forceinline__ void gemm_phase(PG8_LAS unsigned char* lds, const Gemm g, const Sched& S, const Epi& E) {
    const int tid = threadIdx.x, wid = __builtin_amdgcn_readfirstlane(tid >> 6), lane = tid & 63, wr = wid >> 2, wc = wid & 3, fr = lane & 15, fq = lane >> 4;
    const int K = g.K, nt = K / BK;
    unsigned voffA[2], voffB[2];
#pragma unroll
    for (int i = 0; i < 2; ++i) { int R, C; stage_rc(tid * 16 + i * 8192, R, C); const int Rb = Epi::PERM ? ((R & ~31) + perm32(R & 31)) : R;
        voffA[i] = (unsigned)(R * K + C) * 2u; voffB[i] = (unsigned)(Rb * K + C) * 2u; }
    const size_t kstep = (size_t)(BK * 2);
    const size_t hstep = (size_t)HALF * K * 2;
    const size_t tstep = 2 * hstep;
    const unsigned ldsw = (unsigned)wid * 1024u;
    const int aoff = lds_byte(wr * 64 + fr, fq * 8), boff = lds_byte(wc * 32 + fr, fq * 8);
#define PG8_SA(b, h) (((b) * 2 + (h)) * HTB)
#define PG8_SB(b, h) ((4 + (b) * 2 + (h)) * HTB)
#define PG8_STAGE(bufoff, gbase, voff) do { _Pragma("unroll") for (int _i = 0; _i < 2; ++_i) \
        __builtin_amdgcn_global_load_lds((const unsigned*)((const char*)(gbase) + (voff)[_i]), (PG8_LAS unsigned*)(lds + (bufoff) + ldsw + _i * 8192), 16, 0, 0); } while (0)
#define PG8_LDA(dst, b, h) do { _Pragma("unroll") for (int m = 0; m < 4; ++m) _Pragma("unroll") for (int k = 0; k < 2; ++k) dst[m][k] = *(const PG8_LAS bf16x8*)(lds + PG8_SA(b, h) + aoff + m * 2048 + k * 1024); } while (0)
#define PG8_LDB(dst, b, h) do { _Pragma("unroll") for (int n = 0; n < 2; ++n) _Pragma("unroll") for (int k = 0; k < 2; ++k) dst[n][k] = *(const PG8_LAS bf16x8*)(lds + PG8_SB(b, h) + boff + n * 2048 + k * 1024); } while (0)
#define PG8_MMA(ai, bj, At, Bt) do { __builtin_amdgcn_s_setprio(1); _Pragma("unroll") for (int m = 0; m < 4; ++m) _Pragma("unroll") for (int n = 0; n < 2; ++n) _Pragma("unroll") for (int k = 0; k < 2; ++k) { \
        if constexpr (Epi::INT8) acc[ai][bj][m][n] = __builtin_bit_cast(f32x4, __builtin_amdgcn_mfma_i32_16x16x64_i8(__builtin_bit_cast(i32x4, Bt[n][k]), __builtin_bit_cast(i32x4, At[m][k]), __builtin_bit_cast(i32x4, acc[ai][bj][m][n]), 0, 0, 0)); \
        else acc[ai][bj][m][n] = __builtin_amdgcn_mfma_f32_16x16x32_bf16(Bt[n][k], At[m][k], acc[ai][bj][m][n], 0, 0, 0); } __builtin_amdgcn_s_setprio(0); } while (0)
#define PG8_WAIT_V(n) asm volatile("s_waitcnt vmcnt(" #n ")" ::: "memory")
#define PG8_WAIT_L(n) asm volatile("s_waitcnt lgkmcnt(" #n ")" ::: "memory")
#define PG8_BAR __builtin_amdgcn_s_barrier()
#define PG8_SCHED __builtin_amdgcn_sched_barrier(0)
    Unit cur, nxt; int ui = 0;
    if (!S.next(0, cur)) return;
    f32x4 acc[2][2][4][2];
#pragma unroll
    for (int a = 0; a < 2; ++a)
#pragma unroll
        for (int b = 0; b < 2; ++b)
#pragma unroll
            for (int m = 0; m < 4; ++m)
#pragma unroll
                for (int n = 0; n < 2; ++n) acc[a][b][m][n] = (f32x4){0.f, 0.f, 0.f, 0.f};
    bf16x8 At[4][2], B0[2][2], B1[2][2];
    const char* cA = (const char*)g.A + (size_t)cur.pm * tstep; const char* cB = (const char*)g.Bt + (size_t)cur.pn * tstep;
    S.a_ready(cur);
    if constexpr (SP2) {
        PG8_STAGE(PG8_SB(0, 0), cB, voffB); PG8_STAGE(PG8_SB(0, 1), cB + hstep, voffB); PG8_STAGE(PG8_SA(0, 0), cA, voffA); PG8_STAGE(PG8_SA(0, 1), cA + hstep, voffA);
        if (wr == 1) PG8_BAR;
        PG8_WAIT_V(2); PG8_BAR;
        PG8_STAGE(PG8_SB(1, 0), cB + kstep, voffB); PG8_STAGE(PG8_SA(1, 0), cA + kstep, voffA); PG8_STAGE(PG8_SB(1, 1), cB + hstep + kstep, voffB);
        PG8_WAIT_V(6); PG8_BAR;
    } else {
        PG8_STAGE(PG8_SB(0, 0), cB, voffB); PG8_STAGE(PG8_SA(0, 0), cA, voffA); PG8_STAGE(PG8_SB(0, 1), cB + hstep, voffB); PG8_STAGE(PG8_SA(0, 1), cA + hstep, voffA);
        if (wr == 1) PG8_BAR;
        PG8_WAIT_V(4); PG8_BAR;
        PG8_STAGE(PG8_SB(1, 0), cB + kstep, voffB); PG8_STAGE(PG8_SA(1, 0), cA + kstep, voffA); PG8_STAGE(PG8_SB(1, 1), cB + hstep + kstep, voffB);
        PG8_WAIT_V(6); PG8_BAR;
    }
    for (;;) {
        const bool has_next = S.next(ui + 1, nxt);
        const char* nA = has_next ? (const char*)g.A + (size_t)nxt.pm * tstep : cA; const char* nB = has_next ? (const char*)g.Bt + (size_t)nxt.pn * tstep : cB;
        for (int t = 0; t < nt; t += 2) {
            const bool last = (t == nt - 2);
            const char* a1 = cA + (size_t)(t + 1) * kstep;
            const char* a2 = last ? nA : cA + (size_t)(t + 2) * kstep; const char* b2 = last ? nB : cB + (size_t)(t + 2) * kstep;
            const char* a3 = a2 + kstep; const char* b3 = b2 + kstep;
            if (last && has_next) S.a_ready(nxt);
            if constexpr (SP2) {
            PG8_LDB(B0, 0, 0); PG8_LDB(B1, 0, 1); PG8_SCHED; PG8_LDA(At, 0, 0); PG8_STAGE(PG8_SA(1, 1), a1 + hstep, voffA);
            PG8_WAIT_V(8); PG8_WAIT_L(0); PG8_BAR; PG8_MMA(0, 0, At, B0); PG8_MMA(0, 1, At, B1); PG8_BAR; PG8_SCHED;
            PG8_LDA(At, 0, 1); PG8_STAGE(PG8_SB(0, 0), b2, voffB); PG8_STAGE(PG8_SB(0, 1), b2 + hstep, voffB); PG8_STAGE(PG8_SA(0, 0), a2, voffA);
            PG8_WAIT_V(8); PG8_WAIT_L(0); PG8_BAR; PG8_MMA(1, 0, At, B0); PG8_MMA(1, 1, At, B1); PG8_BAR; PG8_SCHED;
            PG8_LDB(B0, 1, 0); PG8_LDB(B1, 1, 1); PG8_SCHED; PG8_LDA(At, 1, 0); PG8_STAGE(PG8_SA(0, 1), a2 + hstep, voffA);
            PG8_WAIT_V(8); PG8_WAIT_L(0); PG8_BAR; PG8_MMA(0, 0, At, B0); PG8_MMA(0, 1, At, B1); PG8_BAR; PG8_SCHED;
            PG8_LDA(At, 1, 1); PG8_STAGE(PG8_SB(1, 0), b3, voffB); PG8_STAGE(PG8_SB(1, 1), b3 + hstep, voffB); PG8_STAGE(PG8_SA(1, 0), a3, voffA);
            PG8_WAIT_V(8); PG8_WAIT_L(0); PG8_BAR; PG8_MMA(1, 0, At, B0); PG8_MMA(1, 1, At, B1); PG8_BAR; PG8_SCHED;
            } else {
            PG8_LDB(B0, 0, 0); PG8_SCHED; PG8_LDA(At, 0, 0); PG8_STAGE(PG8_SA(1, 1), a1 + hstep, voffA);
            PG8_WAIT_L(8); PG8_BAR; PG8_WAIT_L(0); PG8_MMA(0, 0, At, B0); PG8_BAR; PG8_SCHED;
            PG8_LDB(B1, 0, 1); PG8_STAGE(PG8_SB(0, 0), b2, voffB);
            PG8_BAR; PG8_WAIT_L(0); PG8_MMA(0, 1, At, B1); PG8_BAR;
            PG8_LDA(At, 0, 1); PG8_STAGE(PG8_SA(0, 0), a2, voffA);
            PG8_BAR; PG8_WAIT_L(0); PG8_MMA(1, 0, At, B0); PG8_BAR; PG8_SCHED;
            PG8_STAGE(PG8_SB(0, 1), b2 + hstep, voffB);
            PG8_WAIT_V(6); PG8_BAR; PG8_MMA(1, 1, At, B1); PG8_BAR;
            PG8_LDB(B0, 1, 0); PG8_SCHED; PG8_LDA(At, 1, 0); PG8_STAGE(PG8_SA(0, 1), a2 + hstep, voffA);
            PG8_WAIT_L(8); PG8_BAR; PG8_WAIT_L(0); PG8_MMA(0, 0, At, B0); PG8_BAR; PG8_SCHED;
            PG8_LDB(B1, 1, 1); PG8_STAGE(PG8_SB(1, 0), b3, voffB);
            PG8_BAR; PG8_WAIT_L(0); PG8_MMA(0, 1, At, B1); PG8_BAR;
            PG8_LDA(At, 1, 1); PG8_STAGE(PG8_SA(1, 0), a3, voffA);
            PG8_BAR; PG8_WAIT_L(0); PG8_MMA(1, 0, At, B0); PG8_BAR; PG8_SCHED;
            PG8_STAGE(PG8_SB(1, 1), b3 + hstep, voffB);
            PG8_WAIT_V(6); PG8_BAR; PG8_MMA(1, 1, At, B1); PG8_BAR;
            }
        }
        if constexpr (ALIGN_EPI) { if (wr == 0) PG8_BAR; }
        if constexpr (!Epi::AFTER_DRAIN) { E(acc, cur, wr, wc, fr, fq); S.done(cur); }
        if (!has_next) break;
#pragma unroll
        for (int a = 0; a < 2; ++a)
#pragma unroll
            for (int b = 0; b < 2; ++b)
#pragma unroll
                for (int m = 0; m < 4; ++m)
#pragma unroll
                    for (int n = 0; n < 2; ++n) acc[a][b][m][n] = (f32x4){0.f, 0.f, 0.f, 0.f};
        cur = nxt; cA = nA; cB = nB; ++ui;
        if constexpr (ALIGN_EPI) { if (wr == 1) PG8_BAR; }
    }
    PG8_WAIT_V(0);
    if constexpr (!ALIGN_EPI) { if (wr == 0) PG8_BAR; }
    PG8_BAR;
    if constexpr (Epi::AFTER_DRAIN) { E.fused(acc, cur, wr, wc, fr, fq, lds, wid, lane); S.done(cur); }
#undef PG8_SA
#undef PG8_SB
#undef PG8_STAGE
#undef PG8_LDA
#undef PG8_LDB
#undef PG8_MMA
#undef PG8_WAIT_V
#undef PG8_WAIT_L
#undef PG8_BAR
#undef PG8_SCHED
}
}
#include <hip/hip_bf16.h>
#include <cmath>
namespace dattn {
using bf16 = __hip_bfloat16;
typedef short bf16x8 __attribute__((ext_vector_type(8)));
typedef short s16x4 __attribute__((ext_vector_type(4)));
typedef float f32x16 __attribute__((ext_vector_type(16)));
typedef unsigned u32x4 __attribute__((ext_vector_type(4)));
constexpr int DK = 64, DV = 128, RS = 1024, SEQ = 4096;
constexpr int NW = 8, QBLK = 32, KVBLK = 64, QB = NW * QBLK;
constexpr int SHM_V = KVBLK * DV * 2, SHM_K = KVBLK * DK * 2;
constexpr int LDS_WS = 2 * SHM_V + 2 * SHM_K, LDS_TAB = LDS_WS + NW * 64 * 4, LDS_OST = 53248, LDS_BYTES = LDS_OST + NW * 8192;
static_assert(LDS_TAB + 512 <= LDS_OST, "attention LDS map");
constexpr float THR = 8.f;
constexpr float C2 = 0.125f * 1.4426950408889634f;
#define DA_KSWZ(row, colB) ((row) * 128 + ((colB) ^ (((row) & 7) << 4)))
#define DA_SBAR() __builtin_amdgcn_sched_barrier(0)
__device__ __forceinline__ int v_st(int k, int c) { const int kk = (k & ~0xC) | ((k & 4) << 1) | ((k & 8) >> 1); return ((kk >> 3) * 4 + (c >> 5)) * 512 + ((kk & 7) * 32 + (c & 31)) * 2; }
__device__ __forceinline__ int v_rd_base(int lane) { return ((lane & 3) << 3) | (((lane >> 2) & 3) << 6) | (((lane >> 4) & 1) << 5) | (((lane >> 5) & 1) << 8); }
constexpr int v_rd_off(int d0, int ks, int half) { return d0 * 512 + ks * 4096 + half * 2048; }
__device__ __forceinline__ int crow(int r, int hi) { return (r & 3) + 8 * (r >> 2) + 4 * hi; }
__device__ __forceinline__ unsigned cvtpk(float lo, float hi) { unsigned r; asm volatile("v_cvt_pk_bf16_f32 %0, %1, %2" : "=v"(r) : "v"(lo), "v"(hi)); return r; }
__device__ __forceinline__ bf16x8 load8(const bf16* p) { return *reinterpret_cast<const bf16x8*>(p); }
__device__ __forceinline__ void mask_tile(f32x16& p0, f32x16& p1, int dq) {
    const float NEG = -__builtin_inff();
#pragma unroll
    for (int r = 0; r < 16; ++r) { const int c = (r & 3) + 8 * (r >> 2); if (dq - c < 0) p0[r] = NEG; if (dq - c - 32 < 0) p1[r] = NEG; }
}
__device__ __forceinline__ void bias_tile(f32x16& p0, f32x16& p1, int dq, const __attribute__((address_space(3))) float* tab) {
#pragma unroll
    for (int r = 0; r < 16; ++r) { const int c = (r & 3) + 8 * (r >> 2); const int i0 = min(max(dq - c, 0), 127), i1 = min(max(dq - c - 32, 0), 127); p0[r] += tab[i0]; p1[r] += tab[i1]; }
}
__device__ __forceinline__ void partialSM(f32x16& p0, f32x16& p1, float& m_reg, float& mn, float& alpha) {
    float pmax = p0[0];
#pragma unroll
    for (int r = 1; r < 16; ++r) pmax = fmaxf(pmax, p0[r]);
#pragma unroll
    for (int r = 0; r < 16; ++r) pmax = fmaxf(pmax, p1[r]);
    { auto rr = __builtin_amdgcn_permlane32_swap(__float_as_uint(pmax), __float_as_uint(pmax), false, false); pmax = fmaxf(__uint_as_float(rr[0]), __uint_as_float(rr[1])); }
    if (__builtin_expect(__all(pmax - m_reg <= THR), 1)) { mn = m_reg; alpha = 1.f; }
    else { mn = fmaxf(m_reg, pmax); alpha = __builtin_amdgcn_exp2f(m_reg - mn); m_reg = mn; }
#pragma unroll
    for (int r = 0; r < 16; ++r) p0[r] -= mn;
#pragma unroll
    for (int r = 0; r < 16; ++r) p1[r] -= mn;
#pragma unroll
    for (int r = 0; r < 16; ++r) p0[r] = __builtin_amdgcn_exp2f(p0[r]);
}
__device__ __forceinline__ void finishSM(f32x16& p0, f32x16& p1, float alpha, float& l_reg, bf16x8& pa0, bf16x8& pa1, bf16x8& pa2, bf16x8& pa3) {
#pragma unroll
    for (int r = 0; r < 16; ++r) p1[r] = __builtin_amdgcn_exp2f(p1[r]);
    float ps = 0;
#pragma unroll
    for (int r = 0; r < 16; ++r) ps += p0[r];
#pragma unroll
    for (int r = 0; r < 16; ++r) ps += p1[r];
    { auto rr = __builtin_amdgcn_permlane32_swap(__float_as_uint(ps), __float_as_uint(ps), false, false); ps = __uint_as_float(rr[0]) + __uint_as_float(rr[1]); }
    l_reg = l_reg * alpha + ps;
#define DA_PK4(P, B_, OUT) do { unsigned a0 = cvtpk(P[B_+0], P[B_+1]), a1 = cvtpk(P[B_+2], P[B_+3]); unsigned b0 = cvtpk(P[B_+4], P[B_+5]), b1 = cvtpk(P[B_+6], P[B_+7]); \
        auto r0 = __builtin_amdgcn_permlane32_swap(a0, b0, false, false); auto r1 = __builtin_amdgcn_permlane32_swap(a1, b1, false, false); \
        u32x4 w = {r0[0], r1[0], r0[1], r1[1]}; OUT = *reinterpret_cast<bf16x8*>(&w); } while (0)
    DA_PK4(p0, 0, pa0); DA_PK4(p0, 8, pa1); DA_PK4(p1, 0, pa2); DA_PK4(p1, 8, pa3);
#undef DA_PK4
}
template <int KB>
__device__ __forceinline__ void qkt(f32x16& p0, f32x16& p1, const char* K_lds, int r32, int hi, const bf16x8* qr) {
    p0 = f32x16{}; p1 = f32x16{};
#pragma unroll
    for (int d0 = 0; d0 < 4; ++d0) { const char* a = K_lds + KB * SHM_K + DA_KSWZ(r32, (d0 * 16 + hi * 8) * 2);
        const bf16x8 b0 = *reinterpret_cast<const bf16x8*>(a), b1 = *reinterpret_cast<const bf16x8*>(a + 32 * 128);
        p0 = __builtin_amdgcn_mfma_f32_32x32x16_bf16(b0, qr[d0], p0, 0, 0, 0);
        p1 = __builtin_amdgcn_mfma_f32_32x32x16_bf16(b1, qr[d0], p1, 0, 0, 0); }
}
template <int VB>
__device__ __forceinline__ void pv_tile(f32x16* o, int vb0, bf16x8 pa0, bf16x8 pa1, bf16x8 pa2, bf16x8 pa3) {
#define DA_TRRD(dst, off) asm volatile("ds_read_b64_tr_b16 %0, %1 offset:%2" : "=&v"(dst) : "v"(vb0), "i"(off) : "memory")
#define DA_PV_D0(d0) do { s16x4 l0, l1, l2, l3, h0, h1, h2, h3; constexpr int b_ = VB * SHM_V + v_rd_off(d0, 0, 0); \
        DA_TRRD(l0, b_); DA_TRRD(h0, b_ + 2048); DA_TRRD(l1, b_ + 4096); DA_TRRD(h1, b_ + 6144); DA_TRRD(l2, b_ + 8192); DA_TRRD(h2, b_ + 10240); DA_TRRD(l3, b_ + 12288); DA_TRRD(h3, b_ + 14336); \
        asm volatile("s_waitcnt lgkmcnt(0)" ::: "memory"); DA_SBAR(); \
        o[d0] = __builtin_amdgcn_mfma_f32_32x32x16_bf16(pa0, (bf16x8){l0[0], l0[1], l0[2], l0[3], h0[0], h0[1], h0[2], h0[3]}, o[d0], 0, 0, 0); \
        o[d0] = __builtin_amdgcn_mfma_f32_32x32x16_bf16(pa1, (bf16x8){l1[0], l1[1], l1[2], l1[3], h1[0], h1[1], h1[2], h1[3]}, o[d0], 0, 0, 0); \
        o[d0] = __builtin_amdgcn_mfma_f32_32x32x16_bf16(pa2, (bf16x8){l2[0], l2[1], l2[2], l2[3], h2[0], h2[1], h2[2], h2[3]}, o[d0], 0, 0, 0); \
        o[d0] = __builtin_amdgcn_mfma_f32_32x32x16_bf16(pa3, (bf16x8){l3[0], l3[1], l3[2], l3[3], h3[0], h3[1], h3[2], h3[3]}, o[d0], 0, 0, 0); } while (0)
    DA_PV_D0(0); DA_PV_D0(1); DA_PV_D0(2); DA_PV_D0(3);
#undef DA_PV_D0
#undef DA_TRRD
}
struct BlockRef { const bf16* Q; const bf16* K; const bf16* V; bf16* O; int P0; };
struct Seam { bf16x8 qr[4]; bf16x8 st_v0, st_v1, st_k0; };
#define DA_VMW() asm volatile("s_waitcnt vmcnt(0)" ::: "memory")
#define DA_VMWN(n) asm volatile("s_waitcnt vmcnt(%0)" :: "i"(n) : "memory")
#define DA_SLOAD(Kp, Vp, k0) do { S.st_v0 = load8((Vp) + (size_t)((k0) + sr) * RS + sc); S.st_v1 = load8((Vp) + (size_t)((k0) + 32 + sr) * RS + sc); S.st_k0 = load8((Kp) + (size_t)((k0) + kr) * RS + kc); } while (0)
#define DA_SWRITE_K(bf) do { *(bf16x8*)(K_lds + (bf) * SHM_K + kws) = S.st_k0; } while (0)
#define DA_SWRITE_V(bf) do { *(bf16x8*)(V_lds + (bf) * SHM_V + vst0) = S.st_v0; *(bf16x8*)(V_lds + (bf) * SHM_V + vst1) = S.st_v1; } while (0)
__device__ __forceinline__ void prime(const BlockRef& cur, char* lds, Seam& S) {
    const int tid = threadIdx.x, wid = __builtin_amdgcn_readfirstlane(tid >> 6), lane = tid & 63, r32 = lane & 31, hi = lane >> 5;
    const int sr = tid >> 4, sc = (tid & 15) * 8, kr = tid >> 3, kc = (tid & 7) * 8, kws = DA_KSWZ(kr, kc * 2); char* K_lds = lds + 2 * SHM_V;
#pragma unroll
    for (int d0 = 0; d0 < 4; ++d0) S.qr[d0] = load8(cur.Q + (size_t)(wid * QBLK + r32) * RS + d0 * 16 + hi * 8);
    DA_SLOAD(cur.K, cur.V, 0); DA_VMW(); DA_SWRITE_K(0);
    __syncthreads();
}
__device__ __forceinline__ void block(const BlockRef& cur, const BlockRef& nxt, char* lds, Seam& S) {
    const int tid = threadIdx.x, wid = __builtin_amdgcn_readfirstlane(tid >> 6), lane = tid & 63, r32 = lane & 31, hi = lane >> 5;
    const int NT = (cur.P0 + QB) / KVBLK;
    const int qlo = cur.P0 + wid * QBLK, qm = qlo + r32 - 4 * hi;
    char* V_lds = lds; char* K_lds = lds + 2 * SHM_V;
    float* ws = (float*)(lds + LDS_WS) + wid * 64; float* li_l = ws, * al_l = ws + 32;
    const __attribute__((address_space(3))) float* tab = (const __attribute__((address_space(3))) float*)((__attribute__((address_space(3))) char*)lds + LDS_TAB);
    float m_reg = -1e30f, l_reg = 0; f32x16 o[4] = {};
    const int sr = tid >> 4, sc = (tid & 15) * 8, vst0 = v_st(sr, sc), vst1 = v_st(32 + sr, sc), kr = tid >> 3, kc = (tid & 7) * 8, kws = DA_KSWZ(kr, kc * 2);
    const int vb0 = (int)(uintptr_t)V_lds + v_rd_base(lane);
    const bf16* Kh = cur.K; const bf16* Vh = cur.V;
#define DA_RESC(a) do { if (__any((a) < 1.f)) { if (hi == 0) al_l[r32] = (a); asm volatile("s_waitcnt lgkmcnt(0)" ::: "memory"); \
                     _Pragma("unroll") for (int d_ = 0; d_ < 4; ++d_) _Pragma("unroll") for (int r = 0; r < 16; ++r) o[d_][r] *= al_l[crow(r, hi)]; } } while (0)
#define DA_KBASE(t) ((t) * KVBLK)
#define DA_MASKT(P0_, P1_, t) do { const int kb_ = DA_KBASE(t); if (kb_ + KVBLK - 1 >= qlo - 127) { bias_tile(P0_, P1_, qm - kb_, tab); if (kb_ + KVBLK - 1 > qlo) mask_tile(P0_, P1_, qm - kb_); } } while (0)
    constexpr int NQL = 4;
#define DA_SEAM_K0() do { DA_VMWN(NQL); DA_SWRITE_K(0); DA_SBAR(); } while (0)
    f32x16 pA0, pA1, pB0, pB1; float mnA, mnB, alA, alB; bf16x8 pa0, pa1, pa2, pa3;
    DA_SWRITE_V(0); DA_SBAR();
    DA_SLOAD(Kh, Vh, DA_KBASE(1));
    DA_SBAR(); qkt<0>(pA0, pA1, K_lds, r32, hi, S.qr);
    DA_MASKT(pA0, pA1, 0); partialSM(pA0, pA1, m_reg, mnA, alA);
    DA_VMW(); DA_SWRITE_V(1); DA_SWRITE_K(1);
    __syncthreads();
#define DA_HALF_STEP(PX0, PX1, mnX, alX, PY0, PY1, alY, t, KB, VB, SB) do { \
        DA_SBAR(); qkt<KB>(PX0, PX1, K_lds, r32, hi, S.qr); \
        finishSM(PY0, PY1, alY, l_reg, pa0, pa1, pa2, pa3); DA_SBAR(); \
        if ((t) + 1 < NT) { DA_SLOAD(Kh, Vh, DA_KBASE((t) + 1)); DA_SBAR(); } \
        pv_tile<VB>(o, vb0, pa0, pa1, pa2, pa3); DA_MASKT(PX0, PX1, (t)); partialSM(PX0, PX1, m_reg, mnX, alX); \
        __syncthreads(); \
        if ((t) + 1 < NT) { DA_VMW(); DA_SWRITE_V(SB); DA_SWRITE_K(SB); } \
        DA_RESC(alX); __syncthreads(); } while (0)
    for (int t = 1; t + 1 < NT; t += 2) {
        DA_HALF_STEP(pB0, pB1, mnB, alB, pA0, pA1, alA, t, 1, 0, 0);
        DA_HALF_STEP(pA0, pA1, mnA, alA, pB0, pB1, alB, t + 1, 0, 1, 1);
    }
    DA_SBAR(); qkt<1>(pB0, pB1, K_lds, r32, hi, S.qr); DA_SBAR();
    DA_SLOAD(nxt.K, nxt.V, 0); DA_SBAR();
#pragma unroll
    for (int d0 = 0; d0 < 4; ++d0) S.qr[d0] = load8(nxt.Q + (size_t)(wid * QBLK + r32) * RS + d0 * 16 + hi * 8);
    DA_SBAR();
    finishSM(pA0, pA1, alA, l_reg, pa0, pa1, pa2, pa3); DA_SBAR();
    pv_tile<0>(o, vb0, pa0, pa1, pa2, pa3);
    DA_MASKT(pB0, pB1, NT - 1); partialSM(pB0, pB1, m_reg, mnB, alB); __syncthreads(); DA_RESC(alB);
    finishSM(pB0, pB1, alB, l_reg, pa0, pa1, pa2, pa3); DA_SBAR(); pv_tile<1>(o, vb0, pa0, pa1, pa2, pa3);
    DA_SBAR(); DA_SEAM_K0();
    if (hi == 0) li_l[r32] = l_reg; asm volatile("s_waitcnt lgkmcnt(0)" ::: "memory");
    float rli[16];
#pragma unroll
    for (int r = 0; r < 16; ++r) rli[r] = __builtin_amdgcn_rcpf(li_l[crow(r, hi)]);
    bf16* Ow = cur.O + (size_t)(wid * QBLK) * RS;
    { char* stg = lds + LDS_OST + wid * 8192;
#pragma unroll
      for (int r = 0; r < 16; ++r) { const int orow = crow(r, hi);
#pragma unroll
          for (int d0 = 0; d0 < 4; ++d0) { const float v = o[d0][r] * rli[r];
              const float vn = __int_as_float(__builtin_amdgcn_update_dpp(0, __float_as_int(v), 0xB1, 0xf, 0xf, true));
              if ((r32 & 1) == 0) *(unsigned*)(stg + orow * 256 + (d0 * 32 + r32) * 2) = cvtpk(v, vn); } }
      asm volatile("s_waitcnt lgkmcnt(0)" ::: "memory");
#pragma unroll
      for (int i = 0; i < 8; ++i) { const int row = 4 * i + (lane >> 4), ch = lane & 15; const u32x4 w = *(const u32x4*)(stg + row * 256 + ch * 16); *(u32x4*)(Ow + (size_t)row * RS + ch * 8) = w; } }
    __syncthreads();
#undef DA_RESC
#undef DA_KBASE
#undef DA_MASKT
#undef DA_SEAM_K0
#undef DA_HALF_STEP
}
#undef DA_VMW
#undef DA_VMWN
#undef DA_SLOAD
#undef DA_SWRITE_K
#undef DA_SWRITE_V
struct Tensors { const bf16* Q; const bf16* K; const bf16* V; bf16* O1; bf16* O2; const float* biastab; };
__device__ __forceinline__ BlockRef unit_ref(const Tensors& T, int v, int i) {
    const int bhc = (v & 255) >> 1, s = v & 1, b = bhc >> 4, h = (bhc >> 1) & 7, c = bhc & 1; const int q2 = 2 * (i >> 1) + s, qb = (i & 1) ? 15 - q2 : q2;
    const size_t row0 = (size_t)b * SEQ; BlockRef r;
    r.Q = T.Q + (row0 + (size_t)qb * QB) * RS + (2 * h + c) * DK; r.K = T.K + row0 * RS + (2 * h + c) * DK; r.V = T.V + row0 * RS + h * DV;
    r.O = (c ? T.O2 : T.O1) + (row0 + (size_t)qb * QB) * RS + h * DV; r.P0 = qb * QB; return r;
}
__device__ __forceinline__ void phase(char* lds, const Tensors& T, int vcu) {
    { const int h = ((vcu & 255) >> 2) & 7; if (threadIdx.x < 128) ((float*)(lds + LDS_TAB))[threadIdx.x] = T.biastab[h * 128 + threadIdx.x]; }
    Seam S; BlockRef cur = unit_ref(T, vcu, 0);
    prime(cur, lds, S);
    if (threadIdx.x >= 256) __builtin_amdgcn_s_setprio(1);
    for (int i = 0; i < 8; ++i) { const BlockRef nxt = unit_ref(T, vcu, i + 1 < 8 ? i + 1 : i); block(cur, nxt, lds, S); cur = nxt; }
    __builtin_amdgcn_s_setprio(0);
}
#undef DA_KSWZ
#undef DA_SBAR
}
#ifndef PG8_SP2
#define PG8_SP2 true
#endif
#ifndef PG8_ALIGN
#define PG8_ALIGN true
#endif
constexpr int NWAVES = 8;
#ifndef MK_N_LAUNCHES
#define MK_N_LAUNCHES 1
#endif
constexpr int N_PHASES = 8;
constexpr int BATCH = 8, SEQ = 4096, D = 2048, M = BATCH * SEQ;
constexpr int NPROJ = 5120, DATT = 1024, DCONV = 1024, CONVW = 31;
constexpr int PH = 8, PNK = 128, PHALF = 128, PTOPK = 16, NEXP = 16384;
constexpr float LN_EPS = 1e-5f;
constexpr float DN_ALPHA = 1.189207115002721f;
constexpr float LAMBDA_INIT = 0.2f;
constexpr size_t MiB = 1u << 20;
constexpr size_t WS_WIN = 2 * MiB, WS_WOUT = 22 * MiB, WS_WQ = 30 * MiB, WS_KEYS = 38 * MiB, WS_TAB = 39 * MiB;
constexpr size_t WS_U8 = 40 * MiB, WS_V8 = 72 * MiB, WS_SU = 104 * MiB, WS_SV = 105 * MiB;
constexpr size_t WS_XB = 168 * MiB;
constexpr size_t WS_Q = 296 * MiB, WS_K = 360 * MiB, WS_V = 424 * MiB, WS_H = 488 * MiB;
constexpr size_t WS_O1 = 552 * MiB, WS_O2 = 616 * MiB;
constexpr size_t WS_Y1 = 680 * MiB;
constexpr size_t WS_QP = 808 * MiB;
constexpr size_t WS_X8 = WS_O1;
constexpr size_t WS_SX = 106 * MiB, WS_SWQ = 107 * MiB, WS_SWIN = WS_SWQ + 65536, WS_SWOUT = WS_SWQ + 131072, WS_SXA = 108 * MiB, WS_SM = 109 * MiB, WS_LNS = 110 * MiB, WS_SXQ = 111 * MiB, WS_NSU = 112 * MiB;
constexpr size_t WS_XH = WS_O2, WS_XL = WS_O2 + 32 * MiB;
constexpr size_t WS_CMAX = 16384;
constexpr size_t WS_EID = 936 * MiB, WS_GATE = 952 * MiB;
constexpr size_t WS_END = 968 * MiB;
constexpr int RING_BYTES = 131072, LDS_BYTES = 147456;

#define GAS __attribute__((address_space(1)))
#define LAS __attribute__((address_space(3)))
typedef unsigned short bf16;
typedef unsigned v4u __attribute__((ext_vector_type(4)));
typedef unsigned v2u __attribute__((ext_vector_type(2)));
typedef float f32x4 __attribute__((ext_vector_type(4)));
typedef float f32x16 __attribute__((ext_vector_type(16)));
typedef short bf16x8 __attribute__((ext_vector_type(8)));
typedef __bf16 bf16x2_t __attribute__((ext_vector_type(2)));
#define LDS_WAIT() asm volatile("s_waitcnt lgkmcnt(0)" ::: "memory")
__device__ __forceinline__ unsigned f2bf(float f) { unsigned u = __builtin_bit_cast(unsigned, f); return (u + 0x7fffu + ((u >> 16) & 1u)) >> 16; }
__device__ __forceinline__ unsigned pk2(float lo, float hi) { return f2bf(lo) | (f2bf(hi) << 16); }
__device__ __forceinline__ float bflo(unsigned w) { return __uint_as_float(w << 16); }
__device__ __forceinline__ float bfhi(unsigned w) { return __uint_as_float(w & 0xffff0000u); }
__device__ __forceinline__ float wave_sum(float v) {
#pragma unroll
    for (int o = 1; o < 64; o <<= 1) v += __shfl_xor(v, o);
    return v;
}
__device__ __forceinline__ float dot2bf(unsigned a, unsigned b, float acc) { return __builtin_amdgcn_fdot2_f32_bf16(__builtin_bit_cast(bf16x2_t, a), __builtin_bit_cast(bf16x2_t, b), acc, false); }

#define XB_TMO      128
#define XB_XCNT(j)  (256  + 64 * (j))
#define XB_XSUB(j)  (1280 + 64 * (j))
#define XB_XGEN(j)  (2304 + 64 * (j))
#define XB_TOP      3328
#define XB_TOPGEN   3392
#define XCD_BAR_WORDS 3456
#define XB_SPIN_CAP (1u << 18)

__device__ __forceinline__ unsigned xb_ld(unsigned* p)              { return __hip_atomic_load(p, __ATOMIC_RELAXED, __HIP_MEMORY_SCOPE_AGENT); }
__device__ __forceinline__ unsigned xb_add(unsigned* p, unsigned v) { return __hip_atomic_fetch_add(p, v, __ATOMIC_RELAXED, __HIP_MEMORY_SCOPE_AGENT); }
__device__ __forceinline__ unsigned xb_xcc_id() { return (unsigned)__builtin_amdgcn_s_getreg((3 << 11) | 20) & 0xFu; }
#define XB_SPIN(cond, bar) do { unsigned _sp = 0; while (cond) { __builtin_amdgcn_s_sleep(1); \
    if ((++_sp & 255u) == 0u) { if (xb_ld(&(bar)[XB_TMO])) break; if (_sp > XB_SPIN_CAP) { atomicAdd(&(bar)[XB_TMO], 1u); break; } } } } while (0)

struct XcdBarrier {
    unsigned* bar; unsigned x;
    volatile LAS unsigned* st;
};

__device__ __forceinline__ XcdBarrier xcd_barrier_post(unsigned* bar, volatile LAS unsigned* st) {
    XcdBarrier b; b.bar = bar; b.x = xb_xcc_id(); b.st = st;
    if (threadIdx.x == 0) (void)xb_add(&bar[XB_XCNT(b.x)], 1u);
    return b;
}
__device__ __forceinline__ void xcd_barrier_complete(unsigned* bar, unsigned x, unsigned& nloc, unsigned& nx) {
    const unsigned G = gridDim.x * gridDim.y * gridDim.z;
    unsigned sum, cnt, mine, sp = 0u;
    for (;;) {
        sum = 0u; cnt = 0u; mine = 0u;
#pragma unroll
        for (unsigned j = 0; j < 16; ++j) { const unsigned c = xb_ld(&bar[XB_XCNT(j)]); sum += c; cnt += (c > 0u) ? 1u : 0u; mine = (j == x) ? c : mine; }
        if (sum == G) break;
        __builtin_amdgcn_s_sleep(1);
        if ((++sp & 255u) == 0u) { if (xb_ld(&bar[XB_TMO])) break; if (sp > XB_SPIN_CAP) { atomicAdd(&bar[XB_TMO], 1u); break; } }
    }
    nloc = mine > 0u ? mine : 1u; nx = cnt > 0u ? cnt : 1u;
}

__device__ __forceinline__ void xcd_barrier(const XcdBarrier& b) {
    asm volatile("s_waitcnt vmcnt(0)" ::: "memory");
    __syncthreads();
    if (threadIdx.x == 0) {
        unsigned* bar = b.bar;
        __builtin_amdgcn_s_waitcnt(0);
        unsigned nloc = b.st[0], nx = b.st[1];
        if (nloc == 0u) { xcd_barrier_complete(bar, b.x, nloc, nx); b.st[0] = nloc; b.st[1] = nx; }
        const unsigned old = xb_add(&bar[XB_XSUB(b.x)], 1u);
        const unsigned gen = old / nloc;
        if (old + 1u == (gen + 1u) * nloc) {
            __builtin_amdgcn_fence(__ATOMIC_RELEASE, "agent");
            asm volatile("s_waitcnt vmcnt(0)" ::: "memory");
            const unsigned og = xb_add(&bar[XB_TOP], 1u);
            const unsigned tg = og / nx;
            if (og + 1u == (tg + 1u) * nx) xb_add(&bar[XB_TOPGEN], 1u);
            else XB_SPIN(xb_ld(&bar[XB_TOPGEN]) == tg, bar);
            __builtin_amdgcn_fence(__ATOMIC_ACQUIRE, "agent");
            xb_add(&bar[XB_XGEN(b.x)], 1u);
            asm volatile("s_waitcnt vmcnt(0)" ::: "memory");
        } else {
            XB_SPIN(xb_ld(&bar[XB_XGEN(b.x)]) == gen, bar);
            __builtin_amdgcn_fence(__ATOMIC_ACQUIRE, "agent");
            asm volatile("s_waitcnt vmcnt(0)" ::: "memory");
        }
    }
    __syncthreads();
}

struct Frame {
    LAS unsigned char* lds;
    __device__ __forceinline__ int wave_() const { int w = __builtin_amdgcn_readfirstlane((int)threadIdx.x >> 6); asm volatile("" : "+s"(w)); return w; }
    __device__ __forceinline__ int G_() const { int g = (int)gridDim.x; asm volatile("" : "+s"(g)); return g; }
    __device__ __forceinline__ int vcu_() const { int bx = (int)blockIdx.x; asm volatile("" : "+s"(bx)); const int g = G_(); return (g % 8 == 0) ? (bx % 8) * (g / 8) + bx / 8 : bx; }
    __device__ __forceinline__ int tid() const { int t = (int)threadIdx.x; asm volatile("" : "+v"(t)); return t; }
    __device__ __forceinline__ int lane() const { return tid() & 63; }
    __device__ __forceinline__ unsigned long long raw(int k) const { const volatile LAS unsigned* p = (const volatile LAS unsigned*)(lds + RING_BYTES) + 2 * k;
        const unsigned lo = __builtin_amdgcn_readfirstlane(p[0]), hi = __builtin_amdgcn_readfirstlane(p[1]); return ((unsigned long long)hi << 32) | lo; }
    __device__ __forceinline__ const float* in(int k) const { return (const float*)raw(k); }
    __device__ __forceinline__ float* outp() const { return (float*)raw(22); }
    template <class T> __device__ __forceinline__ T* ws(size_t off) const { return (T*)((unsigned char*)raw(23) + off); }
};
enum { I_X = 0, I_WIN, I_BGLU, I_CONVW, I_CONVB, I_CLNG, I_CLNB, I_LQ1, I_LK1, I_LQ2, I_LK2, I_SUBLN, I_RELB, I_WOUT, I_LN1G, I_LN1B, I_WQ, I_KEYS, I_U, I_V, I_LN2G, I_LN2B };

template <int CTRL> __device__ __forceinline__ int dppi(int v) { return __builtin_amdgcn_update_dpp(0, v, CTRL, 0xf, 0xf, true); }
template <int CTRL> __device__ __forceinline__ float dppf(float v) { return __int_as_float(__builtin_amdgcn_update_dpp(0, __float_as_int(v), CTRL, 0xf, 0xf, true)); }
__device__ __forceinline__ unsigned pack_i8x4(float a, float b, float c, float d) {
    const int ia = (int)rintf(a), ib = (int)rintf(b), ic = (int)rintf(c), id = (int)rintf(d); return (unsigned)(ia & 255) | ((unsigned)(ib & 255) << 8) | ((unsigned)(ic & 255) << 16) | ((unsigned)id << 24); }
__device__ __forceinline__ void p0_colmax_item(const float* W, int N, unsigned* cmax, int k0, int n0, int dst0, int lane) {
    f32x4 am = {0.f, 0.f, 0.f, 0.f};
#pragma unroll
    for (int i = 0; i < 8; ++i) { const f32x4 v = *(const GAS f32x4*)(W + (size_t)(k0 + 8 * i + (lane >> 3)) * N + n0 + 4 * (lane & 7));
        am[0] = fmaxf(am[0], fabsf(v[0])); am[1] = fmaxf(am[1], fabsf(v[1])); am[2] = fmaxf(am[2], fabsf(v[2])); am[3] = fmaxf(am[3], fabsf(v[3])); }
#pragma unroll
    for (int e = 0; e < 4; ++e) { am[e] = fmaxf(am[e], __shfl_xor(am[e], 8)); am[e] = fmaxf(am[e], __shfl_xor(am[e], 16)); am[e] = fmaxf(am[e], __shfl_xor(am[e], 32)); }
    if (lane < 8) {
#pragma unroll
        for (int e = 0; e < 4; ++e) atomicMax(cmax + dst0 + 4 * lane + e, __float_as_uint(am[e])); }
}
__device__ __forceinline__ void p0_quant_item(const float* W, int N, unsigned char* WT8, const unsigned* cmax, float* scale, int k0, int n0, int dst0, LAS float* scr, int lane) {
#pragma unroll
    for (int i = 0; i < 8; ++i) { const int kk = 8 * i + (lane >> 3); const f32x4 v = *(const GAS f32x4*)(W + (size_t)(k0 + kk) * N + n0 + 4 * (lane & 7));
        LAS float* d = scr + kk * 33 + 4 * (lane & 7); d[0] = v[0]; d[1] = v[1]; d[2] = v[2]; d[3] = v[3]; }
    if (lane < 32) { const float am = __uint_as_float(__hip_atomic_load(cmax + dst0 + lane, __ATOMIC_RELAXED, __HIP_MEMORY_SCOPE_AGENT)); const float sc = am > 0.f ? am * (1.f / 127.f) : 1.f;
        scr[64 * 33 + lane] = 1.f / sc; if (k0 == 0) scale[dst0 + lane] = sc; }
    LDS_WAIT(); asm volatile("" ::: "memory");
    const int c = lane & 7;
#pragma unroll
    for (int j = 0; j < 4; ++j) { const int n = (lane >> 3) + 8 * j; const LAS float* sp = scr + (8 * c) * 33 + n; const float inv = scr[64 * 33 + n];
        *(GAS v2u*)(WT8 + (size_t)(dst0 + n) * D + k0 + 8 * c) = (v2u){pack_i8x4(sp[0 * 33] * inv, sp[1 * 33] * inv, sp[2 * 33] * inv, sp[3 * 33] * inv), pack_i8x4(sp[4 * 33] * inv, sp[5 * 33] * inv, sp[6 * 33] * inv, sp[7 * 33] * inv)}; }
    LDS_WAIT(); asm volatile("" ::: "memory");
}
__device__ __forceinline__ int glu_dst(int n0) {
    if (n0 < 3072) return n0;
    const int ch = (n0 - 3072) & 1023, gate = (n0 - 3072) >> 10; return 3072 + 256 * (ch >> 7) + 128 * gate + (ch & 127);
}
__device__ __forceinline__ void p0_quant_x(const float* src, unsigned char* dst8, float* scale, int rows, int gw, int NGW, int lane) {
    f32x4 nx[8], nx2[8];
    if (gw < rows) { const GAS f32x4* sp = (const GAS f32x4*)(src + (size_t)gw * D) + lane; const int r1 = (gw + NGW < rows) ? gw + NGW : gw; const GAS f32x4* sq = (const GAS f32x4*)(src + (size_t)r1 * D) + lane;
#pragma unroll
        for (int j = 0; j < 8; ++j) { nx[j] = sp[64 * j]; nx2[j] = sq[64 * j]; } }
    for (int r = gw; r < rows; r += NGW) {
        f32x4 v[8]; float am = 0.f;
#pragma unroll
        for (int j = 0; j < 8; ++j) { v[j] = nx[j]; nx[j] = nx2[j]; }
        { const int rn = (r + 2 * NGW < rows) ? r + 2 * NGW : r; const GAS f32x4* sp = (const GAS f32x4*)(src + (size_t)rn * D) + lane;
#pragma unroll
          for (int j = 0; j < 8; ++j) nx2[j] = sp[64 * j]; }
#pragma unroll
        for (int j = 0; j < 8; ++j) am = fmaxf(fmaxf(am, fmaxf(fabsf(v[j].x), fabsf(v[j].y))), fmaxf(fabsf(v[j].z), fabsf(v[j].w)));
#pragma unroll
        for (int o = 1; o < 64; o <<= 1) am = fmaxf(am, __shfl_xor(am, o));
        const float sc = am > 0.f ? am * (1.f / 127.f) : 1.f, inv = 1.f / sc;
        GAS unsigned* dp = (GAS unsigned*)(dst8 + (size_t)r * D) + lane;
#pragma unroll
        for (int j = 0; j < 8; ++j) dp[64 * j] = pack_i8x4(v[j].x * inv, v[j].y * inv, v[j].z * inv, v[j].w * inv);
        if (lane == 0) scale[r] = sc;
    }
}
__device__ __forceinline__ void p0_convert(const float* src, bf16* dst, size_t n, int gw, int NGW, int lane) {
    const size_t nit = n / 512;
    for (size_t it = gw; it < nit; it += NGW) { const GAS f32x4* s = (const GAS f32x4*)(src + it * 512) + 2 * lane; const f32x4 a = s[0], b = s[1];
        v4u o; o.x = pk2(a.x, a.y); o.y = pk2(a.z, a.w); o.z = pk2(b.x, b.y); o.w = pk2(b.z, b.w); *((GAS v4u*)(dst + it * 512) + lane) = o; }
}
template <bool INT8> __device__ __forceinline__ void p0_quant_rows(const float* src, unsigned* dst8, float* scale, int rows, int gw, int NGW, int lane) {
    f32x4 nx[8], nx2[8];
    if (gw < rows) { const GAS f32x4* sp = (const GAS f32x4*)(src + (size_t)gw * D) + lane; const int r1 = (gw + NGW < rows) ? gw + NGW : gw; const GAS f32x4* sq = (const GAS f32x4*)(src + (size_t)r1 * D) + lane;
#pragma unroll
        for (int j = 0; j < 8; ++j) { nx[j] = sp[64 * j]; nx2[j] = sq[64 * j]; } }
    for (int r = gw; r < rows; r += NGW) {
        f32x4 v[8]; float am = 0.f;
#pragma unroll
        for (int j = 0; j < 8; ++j) { v[j] = nx[j]; nx[j] = nx2[j]; }
        { const int rn = (r + 2 * NGW < rows) ? r + 2 * NGW : r; const GAS f32x4* sp = (const GAS f32x4*)(src + (size_t)rn * D) + lane;
#pragma unroll
          for (int j = 0; j < 8; ++j) nx2[j] = sp[64 * j]; }
#pragma unroll
        for (int j = 0; j < 8; ++j) am = fmaxf(fmaxf(am, fmaxf(fabsf(v[j].x), fabsf(v[j].y))), fmaxf(fabsf(v[j].z), fabsf(v[j].w)));
#pragma unroll
        for (int o = 1; o < 64; o <<= 1) am = fmaxf(am, __shfl_xor(am, o));
        const float sc = am > 0.f ? am * (INT8 ? (1.f / 127.f) : (1.f / 440.f)) : 1.f, inv = 1.f / sc;
#pragma unroll
        for (int j = 0; j < 8; ++j) { int w;
            if (INT8) w = (int)pack_i8x4(v[j].x * inv, v[j].y * inv, v[j].z * inv, v[j].w * inv);
            else { w = __builtin_amdgcn_cvt_pk_fp8_f32(v[j].x * inv, v[j].y * inv, 0, false); w = __builtin_amdgcn_cvt_pk_fp8_f32(v[j].z * inv, v[j].w * inv, w, true); }
            const int wi = lane + 64 * j, c = wi >> 5; *((GAS unsigned*)dst8 + ((size_t)c * rows + r) * 32 + (wi & 31)) = (unsigned)w; }
        if (lane == 0) scale[r] = sc;
    }
}
template <bool HI2C  > __device__ __forceinline__ void p0_quant_u4(const float* src, unsigned* dst4, float* scale, float* nsum  , int rows, int gw, int NGW, int lane) {
    f32x4 nx[8], nx2[8];
    if (gw < rows) { const GAS f32x4* sp = (const GAS f32x4*)(src + (size_t)gw * D) + lane; const int r1 = (gw + NGW < rows) ? gw + NGW : gw; const GAS f32x4* sq = (const GAS f32x4*)(src + (size_t)r1 * D) + lane;
#pragma unroll
        for (int j = 0; j < 8; ++j) { nx[j] = sp[64 * j]; nx2[j] = sq[64 * j]; } }
    for (int r = gw; r < rows; r += NGW) {
        f32x4 v[8]; float ss = 0.f;
#pragma unroll
        for (int j = 0; j < 8; ++j) { v[j] = nx[j]; nx[j] = nx2[j]; }
        { const int rn = (r + 2 * NGW < rows) ? r + 2 * NGW : r; const GAS f32x4* sp = (const GAS f32x4*)(src + (size_t)rn * D) + lane;
#pragma unroll
          for (int j = 0; j < 8; ++j) nx2[j] = sp[64 * j]; }
#pragma unroll
        for (int j = 0; j < 8; ++j) ss += (v[j].x * v[j].x + v[j].y * v[j].y) + (v[j].z * v[j].z + v[j].w * v[j].w);
        ss = wave_sum(ss);
        const float sc = ss > 0.f ? 0.35f * sqrtf(ss * (1.f / D)) : 1.f, inv = 1.f / sc;
        int nsl = 0;
#pragma unroll
        for (int j = 0; j < 8; ++j) { unsigned own = 0, snd = 0;
#pragma unroll
            for (int e = 0; e < 4; ++e) { const int q = (int)fminf(fmaxf(rintf(v[j][e] * inv), -8.f), 7.f); own |= (unsigned)(q + 8) << (8 * e); snd |= (unsigned)(HI2C ? (q & 15) : (q + 8)) << (8 * e); nsl += q + 8; }
            const unsigned nbr = (unsigned)dppi<0xB1>((int)snd);
            if ((lane & 1) == 0) *((GAS unsigned*)dst4 + ((size_t)j * rows + r) * 32 + (lane >> 1)) = own | (nbr << 4); }
        if (nsum) { const float ns = wave_sum((float)nsl); if (lane == 0) nsum[r] = ns; }
        if (lane == 0) scale[r] = sc;
    }
}
__device__ __forceinline__ int t5_bucket(int d) {
    if (d < 16) return d;
    int l = 16 + (int)(logf((float)d / 16.f) / logf(8.f) * 16.f); return l < 31 ? l : 31;
}
__device__ __forceinline__ void p0a_prologue(Frame& F) {
    LAS float* scr = (LAS float*)(F.lds + F.wave_() * 16384);
    constexpr int I_IN = (D / 64) * (NPROJ / 32), I_OUT = (D / 64) * (D / 32);
    { const float* w_in = F.in(I_WIN); unsigned* cmax = F.ws<unsigned>(WS_CMAX); const int gw = F.vcu_() * NWAVES + F.wave_(), NGW = F.G_() * NWAVES;
      for (int r = gw; r < I_IN; r += NGW) { const int nblk = NPROJ / 32, kb = r / nblk, nb = r % nblk; p0_colmax_item(w_in, NPROJ, cmax, 64 * kb, 32 * nb, glu_dst(32 * nb), F.lane()); } }
    { const float* wq = F.in(I_WQ); unsigned* cmax = F.ws<unsigned>(WS_CMAX) + NPROJ; const int gw = F.vcu_() * NWAVES + F.wave_(), NGW = F.G_() * NWAVES;
      for (int r = gw; r < I_OUT; r += NGW) { const int nblk = D / 32, kb = r / nblk, nb = r % nblk; p0_colmax_item(wq, D, cmax, 64 * kb, 32 * nb, 32 * nb, F.lane()); } }
    { const float* wo = F.in(I_WOUT); unsigned* cmax = F.ws<unsigned>(WS_CMAX) + NPROJ + D; const int gw = F.vcu_() * NWAVES + F.wave_(), NGW = F.G_() * NWAVES;
      for (int r = gw; r < I_OUT; r += NGW) { const int nblk = D / 32, kb = r / nblk, nb = r % nblk; p0_colmax_item(wo, D, cmax, 64 * kb, 32 * nb, 32 * nb, F.lane()); } }
    { const int gw = F.vcu_() * NWAVES + F.wave_(), NGW = F.G_() * NWAVES; p0_quant_x(F.in(I_X), F.ws<unsigned char>(WS_XB), F.ws<float>(WS_SXA), M, gw, NGW, F.lane()); }
    { const int gw = F.vcu_() * NWAVES + F.wave_(), NGW = F.G_() * NWAVES; p0_quant_u4<false>(F.in(I_U), F.ws<unsigned>(WS_U8), F.ws<float>(WS_SU), F.ws<float>(WS_NSU), NEXP, gw, NGW, F.lane()); }
    { const int gw = F.vcu_() * NWAVES + F.wave_(), NGW = F.G_() * NWAVES; p0_quant_u4<true>(F.in(I_V), F.ws<unsigned>(WS_V8), F.ws<float>(WS_SV), nullptr, NEXP, gw, NGW, F.lane()); }
    { const int gw = F.vcu_() * NWAVES + F.wave_(), NGW = F.G_() * NWAVES; p0_convert(F.in(I_KEYS), F.ws<bf16>(WS_KEYS), (size_t)PH * 2 * PNK * PHALF, gw, NGW, F.lane()); }
    if (blockIdx.x == 0) { const float* rel_bias = F.in(I_RELB); float* TAB = F.ws<float>(WS_TAB);
        for (int i = F.tid(); i < 8 * 128; i += NWAVES * 64) { const int h = i >> 7, d = i & 127;
            TAB[i] = (rel_bias[t5_bucket(d) * 8 + h] - rel_bias[31 * 8 + h]) * 1.4426950408889634f; } }
}
__device__ __forceinline__ void p0b_prologue(Frame& F) {
    LAS float* scr = (LAS float*)(F.lds + F.wave_() * 16384);
    constexpr int I_IN = (D / 64) * (NPROJ / 32), I_OUT = (D / 64) * (D / 32);
    { const float* w_in = F.in(I_WIN); unsigned char* W8 = F.ws<unsigned char>(WS_WIN); const unsigned* cmax = F.ws<unsigned>(WS_CMAX); float* sw = F.ws<float>(WS_SWIN); const int gw = F.vcu_() * NWAVES + F.wave_(), NGW = F.G_() * NWAVES;
      for (int r = gw; r < I_IN; r += NGW) { const int nblk = NPROJ / 32, kb = r / nblk, nb = r % nblk; p0_quant_item(w_in, NPROJ, W8, cmax, sw, 64 * kb, 32 * nb, glu_dst(32 * nb), scr, F.lane()); } }
    { const float* wq = F.in(I_WQ); unsigned char* W8 = F.ws<unsigned char>(WS_WQ); const unsigned* cmax = F.ws<unsigned>(WS_CMAX) + NPROJ; float* sw = F.ws<float>(WS_SWQ); const int gw = F.vcu_() * NWAVES + F.wave_(), NGW = F.G_() * NWAVES;
      for (int r = gw; r < I_OUT; r += NGW) { const int nblk = D / 32, kb = r / nblk, nb = r % nblk; p0_quant_item(wq, D, W8, cmax, sw, 64 * kb, 32 * nb, 32 * nb, scr, F.lane()); } }
    { const float* wo = F.in(I_WOUT); unsigned char* W8 = F.ws<unsigned char>(WS_WOUT); const unsigned* cmax = F.ws<unsigned>(WS_CMAX) + NPROJ + D; float* sw = F.ws<float>(WS_SWOUT); const int gw = F.vcu_() * NWAVES + F.wave_(), NGW = F.G_() * NWAVES;
      for (int r = gw; r < I_OUT; r += NGW) { const int nblk = D / 32, kb = r / nblk, nb = r % nblk; p0_quant_item(wo, D, W8, cmax, sw, 64 * kb, 32 * nb, 32 * nb, scr, F.lane()); } }
}

__device__ __forceinline__ float diff_lambda(Frame& F) {
    const float a = wave_sum(F.in(I_LQ1)[F.lane()] * F.in(I_LK1)[F.lane()]), b = wave_sum(F.in(I_LQ2)[F.lane()] * F.in(I_LK2)[F.lane()]);
    return expf(a) - expf(b) + LAMBDA_INIT;
}
template <int CTRL, int RM> __device__ __forceinline__ float dpp_rm(float old, float v) { return __int_as_float(__builtin_amdgcn_update_dpp(__float_as_int(old), __float_as_int(v), CTRL, RM, 0xf, false)); }
__device__ __forceinline__ float wave_sum63(float v) {
    v += dppf<0xB1>(v); v += dppf<0x4E>(v); v += dppf<0x141>(v); v += dppf<0x140>(v);
    v += dpp_rm<0x142, 0xa>(0.f, v);
    v += dpp_rm<0x143, 0xc>(0.f, v);
    return v;
}
__device__ __forceinline__ float wave_max63(float v) {
    v = fmaxf(v, dppf<0xB1>(v)); v = fmaxf(v, dppf<0x4E>(v)); v = fmaxf(v, dppf<0x141>(v)); v = fmaxf(v, dppf<0x140>(v));
    v = fmaxf(v, dpp_rm<0x142, 0xa>(0.f, v)); v = fmaxf(v, dpp_rm<0x143, 0xc>(0.f, v));
    return v;
}
typedef _Float16 h2_t __attribute__((ext_vector_type(2)));
__device__ __forceinline__ h2_t pin_h2(float a, float b) { unsigned u = __builtin_bit_cast(unsigned, (h2_t){(_Float16)a, (_Float16)b}); asm volatile("" : "+v"(u)); return __builtin_bit_cast(h2_t, u); }
__device__ __forceinline__ float xr_swap32(float a, float b, bool mx) { auto rr = __builtin_amdgcn_permlane32_swap(__float_as_uint(a), __float_as_uint(b), false, false); const float x = __uint_as_float(rr[0]), y = __uint_as_float(rr[1]); return mx ? fmaxf(x, y) : x + y; }
__device__ __forceinline__ float xr_swap16(float a, float b, bool mx) { auto rr = __builtin_amdgcn_permlane16_swap(__float_as_uint(a), __float_as_uint(b), false, false); const float x = __uint_as_float(rr[0]), y = __uint_as_float(rr[1]); return mx ? fmaxf(x, y) : x + y; }
template <int CTRL> __device__ __forceinline__ float xr_dpp(float lo, float hi, bool t, bool mx) { const float k = t ? hi : lo, s = t ? lo : hi, o = dppf<CTRL>(s); return mx ? fmaxf(k, o) : k + o; }
__device__ __forceinline__ float xred64_sum(const float (&v)[64], int lane) {
    float a[32], b[16], c[8], d[4], e[2];
#pragma unroll
    for (int i = 0; i < 32; ++i) a[i] = xr_swap32(v[i], v[i + 32], false);
#pragma unroll
    for (int i = 0; i < 16; ++i) b[i] = xr_swap16(a[i], a[i + 16], false);
#pragma unroll
    for (int i = 0; i < 8; ++i) c[i] = xr_dpp<0x128>(b[i], b[i + 8], lane & 8, false);
#pragma unroll
    for (int i = 0; i < 4; ++i) d[i] = xr_dpp<0x141>(c[i], c[i + 4], lane & 4, false);
#pragma unroll
    for (int i = 0; i < 2; ++i) e[i] = xr_dpp<0x4E>(d[i], d[i + 2], lane & 2, false);
    return xr_dpp<0xB1>(e[0], e[1], lane & 1, false);
}
__device__ __forceinline__ float xred32_max(const float (&v)[32], int lane) {
    float a[16], b[8], c[4], d[2];
#pragma unroll
    for (int i = 0; i < 16; ++i) a[i] = xr_swap32(v[i], v[i + 16], true);
#pragma unroll
    for (int i = 0; i < 8; ++i) b[i] = xr_swap16(a[i], a[i + 8], true);
#pragma unroll
    for (int i = 0; i < 4; ++i) c[i] = xr_dpp<0x128>(b[i], b[i + 4], lane & 8, true);
#pragma unroll
    for (int i = 0; i < 2; ++i) d[i] = xr_dpp<0x141>(c[i], c[i + 2], lane & 4, true);
    const float e = xr_dpp<0x4E>(d[0], d[1], lane & 2, true);
    return fmaxf(e, dppf<0xB1>(e));
}
#ifndef P3_PROBE_MULT
#define P3_PROBE_MULT 1
#endif
__device__ __forceinline__ void p3_mix(Frame& F) {
    constexpr int TT = 32, NH = TT + CONVW - 1, STG_OFF = 0, STATS_OFF = TT * 1024, AMC_OFF = STATS_OFF + NWAVES * 64 * 4, AMA_OFF = AMC_OFF + TT * NWAVES * 4, MS_OFF = AMA_OFF + 128, INV_OFF = MS_OFF + 256, AVP_OFF = 40960;
    static_assert(INV_OFF + 128 <= AVP_OFF && AVP_OFF + 8 * NWAVES * 64 * 16 <= RING_BYTES && NH == 62, "P3 LDS map");
    const int tid = F.tid(), lane = tid & 63, wave = F.wave_();
    const float lam = diff_lambda(F);
    const float* conv_w = F.in(I_CONVW); const unsigned* H = F.ws<unsigned>(WS_H); const bf16* O1 = F.ws<bf16>(WS_O1); const bf16* O2 = F.ws<bf16>(WS_O2);
    unsigned char* MIX8 = F.ws<unsigned char>(WS_XB); float* SM = F.ws<float>(WS_SM); const float* subln_g = F.in(I_SUBLN);
    const float2 cb = *(const float2*)(F.in(I_CONVB) + 2 * tid), lg = *(const float2*)(F.in(I_CLNG) + 2 * tid), lb = *(const float2*)(F.in(I_CLNB) + 2 * tid);
    LAS float* stats = (LAS float*)(F.lds + STATS_OFF); LAS float* amc = (LAS float*)(F.lds + AMC_OFF); LAS float* ama = (LAS float*)(F.lds + AMA_OFF); LAS float* ms = (LAS float*)(F.lds + MS_OFF); LAS float* invs = (LAS float*)(F.lds + INV_OFF);
    h2_t wk[CONVW];
#pragma unroll
    for (int k = 0; k < CONVW; ++k) { const float2 wf = *(const float2*)(conv_w + k * DCONV + 2 * tid); wk[k] = pin_h2(wf.x, wf.y); }
    const h2_t cbh = pin_h2(cb.x, cb.y);
    unsigned hv[NH];
#define P3_LOAD_H(tile_) do { const int t0_ = (tile_) * TT; const GAS unsigned* hp_ = (const GAS unsigned*)H + (size_t)t0_ * (DCONV / 2) + tid;     \
        _Pragma("unroll") for (int j = 0; j < NH; ++j) hv[j] = *(hp_ + (ptrdiff_t)(j - (CONVW - 1)) * (DCONV / 2)); } while (0)
    { const int ft = F.vcu_() < M / TT ? F.vcu_() : 0; P3_LOAD_H(ft); }
    for (int tile_j = F.vcu_(); tile_j < P3_PROBE_MULT * (M / TT); tile_j += F.G_()) { const int tile_i = tile_j & (M / TT - 1);
        const int t0 = tile_i * TT;
        const int tid = F.tid(), lane = tid & 63;
        v4u oa[4][2], ob[4][2];
#pragma unroll
        for (int rr = 0; rr < 4; ++rr) { const int m = t0 + 4 * wave + rr;
            const GAS char* p1 = (const GAS char*)(O1 + (size_t)m * 1024); const GAS char* p2 = (const GAS char*)(O2 + (size_t)m * 1024); const unsigned lo_ = (unsigned)lane * 32u;
            oa[rr][0] = *(const GAS v4u*)(p1 + lo_); oa[rr][1] = *(const GAS v4u*)(p1 + lo_ + 16); ob[rr][0] = *(const GAS v4u*)(p2 + lo_); ob[rr][1] = *(const GAS v4u*)(p2 + lo_ + 16); }
        __builtin_amdgcn_sched_barrier(0);
        h2_t cv[TT];
        { const unsigned zm = (t0 & (SEQ - 1)) != 0 ? 0xffffffffu : 0u;
#pragma unroll
          for (int j = 0; j < CONVW - 1; ++j) hv[j] &= zm; }
#pragma unroll
        for (int t = 0; t < TT; ++t) { h2_t acc = cbh;
#pragma unroll
            for (int k = 0; k < CONVW; ++k) acc = __builtin_elementwise_fma(__builtin_bit_cast(h2_t, hv[t + k]), wk[k], acc);
            { unsigned u_ = __builtin_bit_cast(unsigned, acc); asm volatile("" : "+v"(u_)); cv[t] = __builtin_bit_cast(h2_t, u_); } }
        __builtin_amdgcn_sched_barrier(0);
#pragma unroll
        for (int rr = 0; rr < 4; ++rr) { float av[16]; h2_t avp[8];
            const v4u a0 = oa[rr][0], a1 = oa[rr][1], b0 = ob[rr][0], b1 = ob[rr][1];
            const unsigned aw[8] = {a0.x, a0.y, a0.z, a0.w, a1.x, a1.y, a1.z, a1.w}, bw[8] = {b0.x, b0.y, b0.z, b0.w, b1.x, b1.y, b1.z, b1.w};
            float ss = 0.f;
#pragma unroll
            for (int i = 0; i < 8; ++i) { av[2 * i] = bflo(aw[i]) - lam * bflo(bw[i]); av[2 * i + 1] = bfhi(aw[i]) - lam * bfhi(bw[i]); ss += av[2 * i] * av[2 * i] + av[2 * i + 1] * av[2 * i + 1]; }
            ss += dppf<0xB1>(ss); ss += dppf<0x4E>(ss); ss += dppf<0x141>(ss);
            const float r = (1.f - LAMBDA_INIT) / sqrtf(ss * (1.f / 128.f) + LN_EPS); float am = 0.f;
#pragma unroll
            for (int e = 0; e < 8; ++e) { avp[e] = pin_h2(av[2 * e] * r * subln_g[16 * (lane & 7) + 2 * e], av[2 * e + 1] * r * subln_g[16 * (lane & 7) + 2 * e + 1]);
                am = fmaxf(am, fmaxf(fabsf((float)avp[e].x), fabsf((float)avp[e].y))); }
            am = wave_max63(am);
            if (lane == 63) ama[4 * wave + rr] = am;
#pragma unroll
            for (int hh = 0; hh < 2; ++hh) *(LAS v4u*)(F.lds + AVP_OFF + ((rr * 2 + hh) * (NWAVES * 64) + tid) * 16) = (v4u){__builtin_bit_cast(unsigned, avp[4 * hh]), __builtin_bit_cast(unsigned, avp[4 * hh + 1]), __builtin_bit_cast(unsigned, avp[4 * hh + 2]), __builtin_bit_cast(unsigned, avp[4 * hh + 3])}; }
        { float sv[64];
#pragma unroll
          for (int t = 0; t < TT; ++t) { const float y0 = (float)cv[t].x, y1 = (float)cv[t].y; sv[2 * t] = y0 + y1; sv[2 * t + 1] = y0 * y0 + y1 * y1; }
          stats[wave * 64 + lane] = xred64_sum(sv, lane); }
        __builtin_amdgcn_sched_barrier(0);
        { const int nx_ = tile_j + F.G_(), nxt = nx_ < P3_PROBE_MULT * (M / TT) ? (nx_ & (M / TT - 1)) : tile_i; P3_LOAD_H(nxt); }
        __syncthreads();
        if (tid < TT) { float s = 0.f, q = 0.f;
#pragma unroll
            for (int w = 0; w < NWAVES; ++w) { s += stats[w * 64 + 2 * tid]; q += stats[w * 64 + 2 * tid + 1]; }
            const float mean = s * (1.f / DCONV), var = fmaxf(q * (1.f / DCONV) - mean * mean, 0.f); ms[2 * tid] = mean; ms[2 * tid + 1] = 1.f / sqrtf(var + LN_EPS); }
        __syncthreads();
        {
            float mv[TT];
#pragma unroll
            for (int q = 0; q < TT / 2; ++q) { const f32x4 st = *(const LAS f32x4*)(ms + 4 * q);
#pragma unroll
                for (int o = 0; o < 2; ++o) { const int t = 2 * q + o; const float mean = st[2 * o], rstd = st[2 * o + 1];
                    const float y0 = ((float)cv[t].x - mean) * rstd * lg.x + lb.x, y1 = ((float)cv[t].y - mean) * rstd * lg.y + lb.y;
#define SWISH_(y) ((y) * __builtin_amdgcn_rcpf(1.f + __builtin_amdgcn_exp2f(-1.4426950409f * (y))))
                    cv[t] = pin_h2(SWISH_(y0), SWISH_(y1));
#undef SWISH_
                    mv[t] = fmaxf(fabsf((float)cv[t].x), fabsf((float)cv[t].y)); } }
            const float amx = xred32_max(mv, lane);
            if ((lane & 1) == 0) amc[(lane >> 1) * NWAVES + wave] = amx; }
        __syncthreads();
        if (tid < TT) { float am = ama[tid];
#pragma unroll
            for (int w = 0; w < NWAVES; ++w) am = fmaxf(am, amc[tid * NWAVES + w]);
            const float sc = am > 0.f ? am * (1.f / 127.f) : 1.f; const _Float16 ih = (_Float16)(1.f / sc);
            ((LAS unsigned*)invs)[tid] = __builtin_bit_cast(unsigned, (h2_t){ih, ih}); SM[t0 + tid] = 1.f / (float)ih; }
        __syncthreads();
        const h2_t K1536 = (h2_t){(_Float16)1536.f, (_Float16)1536.f};
#pragma unroll
        for (int q = 0; q < TT / 4; ++q) { const v4u iv = *(const LAS v4u*)((LAS unsigned*)invs + 4 * q);
            const unsigned ivw[4] = {iv.x, iv.y, iv.z, iv.w};
#pragma unroll
            for (int o = 0; o < 4; ++o) { const int t = 4 * q + o; const unsigned r = __builtin_bit_cast(unsigned, __builtin_elementwise_fma(cv[t], __builtin_bit_cast(h2_t, ivw[o]), K1536));
                *(LAS unsigned short*)(F.lds + STG_OFF + t * 1024 + 2 * tid) = (unsigned short)__builtin_amdgcn_perm(0u, r, 0x0c0c0200u); } }
#pragma unroll
        for (int rr = 0; rr < 4; ++rr) { const h2_t ivh = __builtin_bit_cast(h2_t, ((LAS unsigned*)invs)[4 * wave + rr]);
            const v4u pa_ = *(const LAS v4u*)(F.lds + AVP_OFF + ((rr * 2) * (NWAVES * 64) + tid) * 16), pb_ = *(const LAS v4u*)(F.lds + AVP_OFF + ((rr * 2 + 1) * (NWAVES * 64) + tid) * 16);
            const unsigned pw_[8] = {pa_.x, pa_.y, pa_.z, pa_.w, pb_.x, pb_.y, pb_.z, pb_.w}; unsigned rq[8];
#pragma unroll
            for (int e = 0; e < 8; ++e) rq[e] = __builtin_bit_cast(unsigned, __builtin_elementwise_fma(__builtin_bit_cast(h2_t, pw_[e]), ivh, K1536));
            *((GAS v4u*)(MIX8 + (size_t)(t0 + 4 * wave + rr) * D) + lane) = (v4u){__builtin_amdgcn_perm(rq[1], rq[0], 0x06040200u), __builtin_amdgcn_perm(rq[3], rq[2], 0x06040200u), __builtin_amdgcn_perm(rq[5], rq[4], 0x06040200u), __builtin_amdgcn_perm(rq[7], rq[6], 0x06040200u)}; }
        __syncthreads();
        for (int idx = tid; idx < TT * 64; idx += NWAVES * 64) { const int row = idx >> 6, ch = idx & 63;
            *((GAS v4u*)(MIX8 + (size_t)(t0 + row) * D + DATT) + ch) = *(const LAS v4u*)(F.lds + STG_OFF + row * 1024 + ch * 16); }
        __syncthreads();
    }
}
#undef P3_LOAD_H
__device__ __forceinline__ void p5_ln1(Frame& F) {
    const bf16* Y1 = F.ws<bf16>(WS_Y1); const float* ln1_g = F.in(I_LN1G); const float* ln1_b = F.in(I_LN1B); unsigned char* X8 = F.ws<unsigned char>(WS_X8); float* SX = F.ws<float>(WS_SX); float* LNS = F.ws<float>(WS_LNS); float* SXQ = F.ws<float>(WS_SXQ); unsigned char* XH = F.ws<unsigned char>(WS_XH); unsigned char* XL = F.ws<unsigned char>(WS_XL);
    const int gw = F.vcu_() * NWAVES + F.wave_(), NGW = F.G_() * NWAVES, lane = F.lane();
    v4u nx[4];
    if (gw < M) { const GAS v4u* p = (const GAS v4u*)(Y1 + (size_t)gw * D) + lane;
#pragma unroll
        for (int j = 0; j < 4; ++j) nx[j] = p[64 * j]; }
    for (int m = gw; m < M; m += NGW) {
        v4u w[4]; float v[32]; float s = 0.f;
#pragma unroll
        for (int j = 0; j < 4; ++j) w[j] = nx[j];
        { const int mn = (m + NGW < M) ? m + NGW : m; const GAS v4u* p = (const GAS v4u*)(Y1 + (size_t)mn * D) + lane;
#pragma unroll
          for (int j = 0; j < 4; ++j) nx[j] = p[64 * j]; }
#pragma unroll
        for (int j = 0; j < 4; ++j) { const unsigned ww[4] = {w[j].x, w[j].y, w[j].z, w[j].w};
#pragma unroll
            for (int i = 0; i < 4; ++i) { v[8 * j + 2 * i] = bflo(ww[i]); v[8 * j + 2 * i + 1] = bfhi(ww[i]); s += v[8 * j + 2 * i] + v[8 * j + 2 * i + 1]; } }
        const float mean = wave_sum(s) * (1.f / D); float q = 0.f;
#pragma unroll
        for (int i = 0; i < 32; ++i) { v[i] -= mean; q += v[i] * v[i]; }
        const float rstd = 1.f / sqrtf(wave_sum(q) * (1.f / D) + LN_EPS);
        float am = 0.f;
#pragma unroll
        for (int j = 0; j < 4; ++j) { const int c0 = 8 * lane + 512 * j; const f32x4 g0 = *(const f32x4*)(ln1_g + c0), g1 = *(const f32x4*)(ln1_g + c0 + 4), b0 = *(const f32x4*)(ln1_b + c0), b1 = *(const f32x4*)(ln1_b + c0 + 4);
#pragma unroll
            for (int i = 0; i < 4; ++i) { v[8 * j + i] = v[8 * j + i] * rstd * g0[i] + b0[i]; v[8 * j + 4 + i] = v[8 * j + 4 + i] * rstd * g1[i] + b1[i]; am = fmaxf(am, fmaxf(fabsf(v[8 * j + i]), fabsf(v[8 * j + 4 + i]))); } }
#pragma unroll
        for (int o = 1; o < 64; o <<= 1) am = fmaxf(am, __shfl_xor(am, o));
        const float sc = am > 0.f ? am * (1.f / 127.f) : 1.f, inv = 1.f / sc;
        GAS v2u* p8 = (GAS v2u*)(X8 + (size_t)m * D) + lane;
#pragma unroll
        for (int j = 0; j < 4; ++j) p8[64 * j] = (v2u){pack_i8x4(v[8 * j] * inv, v[8 * j + 1] * inv, v[8 * j + 2] * inv, v[8 * j + 3] * inv), pack_i8x4(v[8 * j + 4] * inv, v[8 * j + 5] * inv, v[8 * j + 6] * inv, v[8 * j + 7] * inv)};
        { GAS unsigned* ph = (GAS unsigned*)(XH + (size_t)m * (D / 2)) + lane; GAS unsigned* pl = (GAS unsigned*)(XL + (size_t)m * (D / 2)) + lane;
#pragma unroll
          for (int j = 0; j < 4; ++j) { unsigned wh = 0, wl = 0;
#pragma unroll
              for (int i = 0; i < 8; ++i) { const unsigned u = (unsigned)((int)rintf(v[8 * j + i] * inv) + 128); const int sh = 8 * (i & 3) + 4 * (i >> 2); wh |= (u >> 4) << sh; wl |= (u & 15u) << sh; }
              ph[64 * j] = wh; pl[64 * j] = wl; } }
        float qs = 0.f;
#pragma unroll
        for (int i = 0; i < 32; ++i) qs += rintf(v[i] * inv);
        qs = wave_sum(qs);
        if (lane == 0) { SX[m] = sc; LNS[2 * m] = mean; LNS[2 * m + 1] = rstd; SXQ[m] = qs; }
    }
}
__device__ __forceinline__ int f2key(float f) { const int b = __float_as_int(f); return b ^ ((b >> 31) & 0x7fffffff); }
__device__ __forceinline__ float key2f(int k) { return __int_as_float(k ^ ((k >> 31) & 0x7fffffff)); }
#define CE_DESC(a, b) do { const int _x = max(a, b), _y = min(a, b); a = _x; b = _y; } while (0)
template <int N> __device__ __forceinline__ void bitonic_merge_desc(int (&v)[N]) {
#pragma unroll
    for (int j = N >> 1; j > 0; j >>= 1)
#pragma unroll
        for (int i = 0; i < N; ++i) { const int l = i ^ j; if (l > i) CE_DESC(v[i], v[l]); }
}
__device__ __forceinline__ void sort16_desc(int (&v)[16]) {
#define CE_(a, b) CE_DESC(v[a], v[b])
    CE_(0,1); CE_(2,3); CE_(0,2); CE_(1,3); CE_(1,2); CE_(4,5); CE_(6,7); CE_(4,6); CE_(5,7); CE_(5,6); CE_(0,4); CE_(2,6); CE_(2,4); CE_(1,5); CE_(3,7); CE_(3,5); CE_(1,2); CE_(3,4); CE_(5,6);
    CE_(8,9); CE_(10,11); CE_(8,10); CE_(9,11); CE_(9,10); CE_(12,13); CE_(14,15); CE_(12,14); CE_(13,15); CE_(13,14); CE_(8,12); CE_(10,14); CE_(10,12); CE_(9,13); CE_(11,15); CE_(11,13); CE_(9,10); CE_(11,12); CE_(13,14);
    CE_(0,8); CE_(4,12); CE_(4,8); CE_(2,10); CE_(6,14); CE_(6,10); CE_(2,4); CE_(6,8); CE_(10,12); CE_(1,9); CE_(5,13); CE_(5,9); CE_(3,11); CE_(7,15); CE_(7,11); CE_(3,5); CE_(7,9); CE_(11,13);
    CE_(1,2); CE_(3,4); CE_(5,6); CE_(7,8); CE_(9,10); CE_(11,12); CE_(13,14);
#undef CE_
}
__device__ __forceinline__ void merge16(const int (&a)[16], const int (&b)[16], int (&o)[16]) {
#pragma unroll
    for (int i = 0; i < 16; ++i) o[i] = max(a[i], b[15 - i]);
    bitonic_merge_desc<16>(o);
}
__device__ const unsigned char PEER_PAIR[64] = {0,1,2,3,4,5,6,7,8,9,10,11,12,13,14,15, 16,17,18,19,20,21,22,23, 32,33,34,35,36, 48,49,50,51, 64,65,66, 80,81, 96,97, 112,113, 128,144,160,176,192,208,224,240, 0,0,0,0,0,0,0,0,0,0,0,0,0,0};
__device__ __forceinline__ void peer_subkey_top16(const bf16* qrow  , const bf16* keys_hc  , int r32, int hi, int (&o)[16]) {
    bf16x8 bq[8];
    asm volatile("" : "+v"(qrow));
#pragma unroll
    for (int s = 0; s < 8; ++s) bq[s] = *(const bf16x8*)(qrow + 8 * s);
    int run[16];
#pragma unroll
    for (int mt = 0; mt < 4; ++mt) {
        const bf16* krow = keys_hc + (size_t)(32 * mt + r32) * PHALF + hi * 64;
        asm volatile("" : "+v"(krow));
        bf16x8 ka[8];
#pragma unroll
        for (int s = 0; s < 8; ++s) ka[s] = *(const bf16x8*)(krow + 8 * s);
        f32x16 acc = {};
#pragma unroll
        for (int s = 0; s < 8; ++s) acc = __builtin_amdgcn_mfma_f32_32x32x16_bf16(ka[s], bq[s], acc, 0, 0, 0);
        int g[16];
#pragma unroll
        for (int r = 0; r < 16; ++r) g[r] = (f2key(acc[r]) & ~127) | ((r & 3) + 8 * (r >> 2));
        sort16_desc(g);
        if (mt) {
#pragma unroll
            for (int r = 0; r < 16; ++r) g[r] |= 32 * mt; }
        if (mt == 0) {
#pragma unroll
            for (int r = 0; r < 16; ++r) run[r] = g[r];
        } else { int t2[16]; merge16(run, g, t2);
#pragma unroll
            for (int r = 0; r < 16; ++r) run[r] = t2[r]; }
    }
    int lo[16], hh[16]; const int hi4 = 4 * hi;
#pragma unroll
    for (int i = 0; i < 16; ++i) { run[i] |= hi4; auto rr = __builtin_amdgcn_permlane32_swap((unsigned)run[i], (unsigned)run[i], false, false); lo[i] = (int)rr[0]; hh[i] = (int)rr[1]; }
    merge16(lo, hh, o);
}
__device__ __forceinline__ float gelu_erf(float v) { return 0.5f * v * (1.f + erff(v * 0.70710678118654752f)); }

typedef float f32x2 __attribute__((ext_vector_type(2)));
constexpr int P7_G1 = 115712, P7_LNSL = 123904, P7_B1 = RING_BYTES + 512;
static_assert(P7_LNSL + 1024 <= RING_BYTES && P7_B1 + 8192 <= LDS_BYTES, "PEER LDS map (LN1 tables)");
constexpr int P7_W8 = 98304, P7_SW = 114688;
constexpr int P7_ACT = 0, P7_EID = 65536, P7_SCR = 0  , P7_SCR_WAVE = 32 * 33 * 4, PCH = 128, NCH = D / PCH;
static_assert(P7_SCR + NWAVES * P7_SCR_WAVE <= P7_EID && P7_EID + 128 * 128 * 2 <= RING_BYTES, "PEER LDS map");

__device__ __forceinline__ void p7_peer(Frame& F) {
    const int lane = F.lane(), r32 = lane & 31, hi = lane >> 5, j8 = lane & 7, g8 = lane >> 3;
    constexpr int TPB = 128;
    LAS float* ACT = (LAS float*)(F.lds + P7_ACT); LAS unsigned short* EIDL = (LAS unsigned short*)(F.lds + P7_EID);
    LAS int* scr = (LAS int*)(F.lds + P7_SCR + F.wave_() * P7_SCR_WAVE);
    { const float* ln1_g = F.in(I_LN1G); const float* ln1_b = F.in(I_LN1B); const int tid = F.tid();
      *(LAS f32x4*)(F.lds + P7_G1 + tid * 16) = *(const f32x4*)(ln1_g + tid * 4); *(LAS f32x4*)(F.lds + P7_B1 + tid * 16) = *(const f32x4*)(ln1_b + tid * 4); }
    for (int blk = F.vcu_(); blk < M / TPB; blk += F.G_()) {
        const int m0 = blk * TPB;
        { const int h = F.wave_(); const bf16* QP = F.ws<bf16>(WS_QP); const bf16* KEYS = F.ws<bf16>(WS_KEYS); float* GATE = F.ws<float>(WS_GATE);
          for (int tt = 0; tt < 4; ++tt) {
            const int tl = 32 * tt + r32, tok = m0 + tl;
            const bf16* qrow = QP + (size_t)tok * D + h * 256 + hi * 64;
            int s1[16], s2[16];
            peer_subkey_top16(qrow, KEYS + (size_t)(h * 2 + 0) * PNK * PHALF, r32, hi, s1);
            asm volatile("" ::: "memory");
            peer_subkey_top16(qrow + 128, KEYS + (size_t)(h * 2 + 1) * PNK * PHALF, r32, hi, s2);
            float f1[16], f2[16];
#pragma unroll
            for (int i = 0; i < 16; ++i) { f1[i] = key2f(s1[i]); f2[i] = key2f(s2[i]); }
            if (hi == 0) {
#pragma unroll
                for (int i = 0; i < 16; ++i) { scr[r32 * 33 + i] = s1[i] & 127; scr[r32 * 33 + 16 + i] = s2[i] & 127; } }
            int cand[64];
            {
#define PC(n_, i_, j_) cand[n_] = (f2key(f1[i_] + f2[j_]) & ~255) | (n_)
                PC(0,0,0); PC(1,0,1); PC(2,0,2); PC(3,0,3); PC(4,0,4); PC(5,0,5); PC(6,0,6); PC(7,0,7); PC(8,0,8); PC(9,0,9); PC(10,0,10); PC(11,0,11); PC(12,0,12); PC(13,0,13); PC(14,0,14); PC(15,0,15);
                PC(16,1,0); PC(17,1,1); PC(18,1,2); PC(19,1,3); PC(20,1,4); PC(21,1,5); PC(22,1,6); PC(23,1,7);
                PC(24,2,0); PC(25,2,1); PC(26,2,2); PC(27,2,3); PC(28,2,4);
                PC(29,3,0); PC(30,3,1); PC(31,3,2); PC(32,3,3);
                PC(33,4,0); PC(34,4,1); PC(35,4,2);
                PC(36,5,0); PC(37,5,1); PC(38,6,0); PC(39,6,1); PC(40,7,0); PC(41,7,1);
                PC(42,8,0); PC(43,9,0); PC(44,10,0); PC(45,11,0); PC(46,12,0); PC(47,13,0); PC(48,14,0); PC(49,15,0);
#undef PC
            }
#pragma unroll
            for (int i = 50; i < 64; ++i) cand[i] = (int)0x80000000;
            int c0[16], c1[16]; const int hsel = -hi;
#pragma unroll
            for (int i = 0; i < 16; ++i) { c0[i] = (cand[i] & ~hsel) | (cand[32 + i] & hsel); c1[i] = (cand[16 + i] & ~hsel) | (cand[48 + i] & hsel); }
            sort16_desc(c0); sort16_desc(c1);
            int mh[16]; merge16(c0, c1, mh);
            int sc[16];
            { int lo_[16], hh_[16];
#pragma unroll
              for (int i = 0; i < 16; ++i) { auto rr = __builtin_amdgcn_permlane32_swap((unsigned)mh[i], (unsigned)mh[i], false, false); lo_[i] = (int)rr[0]; hh_[i] = (int)rr[1]; }
              merge16(lo_, hh_, sc); }
            float p[16]; const float mx = key2f(sc[0]); float z = 0.f;
#pragma unroll
            for (int k = 0; k < 16; ++k) { p[k] = __expf(key2f(sc[k]) - mx); z += p[k]; }
            const float rz = 1.f / z;
            LDS_WAIT();
            int eo[8]; float go[8]; const int him = -hi;
#pragma unroll
            for (int kk = 0; kk < 8; ++kk) { const int tag = PEER_PAIR[((sc[kk] & ~him) | (sc[8 + kk] & him)) & 255];
                const int i1 = scr[r32 * 33 + (tag >> 4)], i2 = scr[r32 * 33 + 16 + (tag & 15)];
                eo[kk] = i1 * PNK + i2; go[kk] = __int_as_float((__float_as_int(p[kk]) & ~him) | (__float_as_int(p[8 + kk]) & him)) * rz; }
            *(LAS v4u*)(EIDL + tl * 128 + h * 16 + 8 * hi) = (v4u){(unsigned)(eo[0] | (eo[1] << 16)), (unsigned)(eo[2] | (eo[3] << 16)), (unsigned)(eo[4] | (eo[5] << 16)), (unsigned)(eo[6] | (eo[7] << 16))};
            GAS float* gp = (GAS float*)(GATE + (size_t)tok * 128 + h * 16 + 8 * hi);
            *(GAS f32x4*)gp = (f32x4){go[0], go[1], go[2], go[3]}; *(GAS f32x4*)(gp + 4) = (f32x4){go[4], go[5], go[6], go[7]};
            LDS_WAIT();
          } }
        { const float* LNS = F.ws<float>(WS_LNS); const int tid = F.tid(); if (tid < 64) *(LAS f32x4*)(F.lds + P7_LNSL + tid * 16) = *(const f32x4*)(LNS + 2 * (size_t)m0 + 4 * tid); }
        __threadfence_block(); __syncthreads();
        const int tw = F.wave_() * (TPB / NWAVES);
        for (int i = lane; i < (TPB / NWAVES) * 128; i += 64) ACT[tw * 128 + i] = 0.f;
        { const unsigned char* XH = F.ws<unsigned char>(WS_XH); const unsigned char* XL = F.ws<unsigned char>(WS_XL); const unsigned char* U8 = F.ws<unsigned char>(WS_U8);
#define U_ISSUE(n_, PC, XQ0, XQ1) do { const int c_ = (n_) >> 4, tl_ = tw + ((n_) & 15); \
            XQ0 = *(const GAS v4u*)(XH + (size_t)(m0 + tl_) * (D / 2) + c_ * PCH + 16 * j8); XQ1 = *(const GAS v4u*)(XL + (size_t)(m0 + tl_) * (D / 2) + c_ * PCH + 16 * j8); \
            const LAS unsigned short* ep_ = EIDL + tl_ * 128 + g8; const unsigned char* ub_ = U8 + (size_t)c_ * (NEXP * PCH) + 16 * j8; \
            _Pragma("unroll") for (int i = 0; i < 16; ++i) { const unsigned e_ = ep_[8 * i]; PC[i] = *(const GAS v4u*)(ub_ + e_ * PCH); } } while (0)
#define U_COMPUTE(n_, PC, XQ0, XQ1) do { const int tl_ = tw + ((n_) & 15); \
            int pp_[16]; \
            _Pragma("unroll") for (int i = 0; i < 16; ++i) { unsigned ah_ = __builtin_amdgcn_udot8(PC[i].x, XQ0.x, 0u, false), al_ = __builtin_amdgcn_udot8(PC[i].x, XQ1.x, 0u, false); \
                ah_ = __builtin_amdgcn_udot8(PC[i].y, XQ0.y, ah_, false); al_ = __builtin_amdgcn_udot8(PC[i].y, XQ1.y, al_, false); ah_ = __builtin_amdgcn_udot8(PC[i].z, XQ0.z, ah_, false); al_ = __builtin_amdgcn_udot8(PC[i].z, XQ1.z, al_, false); \
                ah_ = __builtin_amdgcn_udot8(PC[i].w, XQ0.w, ah_, false); al_ = __builtin_amdgcn_udot8(PC[i].w, XQ1.w, al_, false); pp_[i] = (int)(16u * ah_ + al_); } \
              \
            int q8_[8], q4_[4], q2_[2]; \
            { const bool b2_ = lane & 4; _Pragma("unroll") for (int i = 0; i < 8; ++i) { const int k_ = b2_ ? pp_[2 * i + 1] : pp_[2 * i], s_ = b2_ ? pp_[2 * i] : pp_[2 * i + 1]; q8_[i] = k_ + dppi<0x141>(s_); } } \
            { const bool b1_ = lane & 2; _Pragma("unroll") for (int i = 0; i < 4; ++i) { const int k_ = b1_ ? q8_[2 * i + 1] : q8_[2 * i], s_ = b1_ ? q8_[2 * i] : q8_[2 * i + 1]; q4_[i] = k_ + dppi<0x4E>(s_); } } \
            { const bool b0_ = lane & 1; _Pragma("unroll") for (int i = 0; i < 2; ++i) { const int k_ = b0_ ? q4_[2 * i + 1] : q4_[2 * i], s_ = b0_ ? q4_[2 * i] : q4_[2 * i + 1]; q2_[i] = k_ + dppi<0xB1>(s_); } } \
            const int irow_ = ((lane & 1) << 2) | (lane & 2) | ((lane >> 2) & 1); \
            LAS float* ap_ = ACT + tl_ * 128 + 8 * irow_ + g8; ap_[0] += (float)q2_[0]; ap_[64] += (float)q2_[1]; } while (0)
          constexpr int UCH = 256, NSTEP = (D / UCH) * (TPB / NWAVES);
          v4u pcA[16], pcB[16], xqA0, xqA1, xqB0, xqB1;
          U_ISSUE(0, pcA, xqA0, xqA1);
          for (int n = 0; n < NSTEP; n += 2) {
              U_ISSUE(n + 1, pcB, xqB0, xqB1); __builtin_amdgcn_sched_barrier(0);
              U_COMPUTE(n, pcA, xqA0, xqA1); __builtin_amdgcn_sched_barrier(0);
              { const int nn = (n + 2 < NSTEP) ? n + 2 : n; U_ISSUE(nn, pcA, xqA0, xqA1); }
              __builtin_amdgcn_sched_barrier(0);
              U_COMPUTE(n + 1, pcB, xqB0, xqB1); __builtin_amdgcn_sched_barrier(0);
          }
#undef U_ISSUE
#undef U_COMPUTE
        }
        LDS_WAIT();
        { const float* SU = F.ws<float>(WS_SU); const float* SV = F.ws<float>(WS_SV); const float* GATE = F.ws<float>(WS_GATE); const float* SX = F.ws<float>(WS_SX); const float* SXQ = F.ws<float>(WS_SXQ); const float* NSU = F.ws<float>(WS_NSU);
        LAS unsigned char* W8L = (LAS unsigned char*)(F.lds + P7_W8); LAS float* SWL = (LAS float*)(F.lds + P7_SW);
        for (int ti = 0; ti < TPB / NWAVES; ++ti) {
            const int tl = tw + ti, t = m0 + tl; const float sx = SX[t], xoff = 8.f * SXQ[t]; float wv[2];
#pragma unroll
            for (int kq = 0; kq < 2; ++kq) { const int k = lane + 64 * kq; const unsigned e = EIDL[tl * 128 + k]; const float a = (ACT[tl * 128 + k] - 128.f * NSU[e] - xoff) * SU[e] * sx;
                wv[kq] = __builtin_nontemporal_load(GATE + (size_t)t * 128 + k) * gelu_erf(a) * SV[e]; }
            float am = fmaxf(fabsf(wv[0]), fabsf(wv[1]));
#pragma unroll
            for (int o = 1; o < 64; o <<= 1) am = fmaxf(am, __shfl_xor(am, o));
            const float sc = am > 0.f ? am * (1.f / 127.f) : 1.f, inv = 1.f / sc;
            float wsum = 0.f;
#pragma unroll
            for (int kq = 0; kq < 2; ++kq) { const int k = lane + 64 * kq; const float q = rintf(wv[kq] * inv); wsum += q; W8L[tl * 128 + k] = (unsigned char)((int)q & 255); }
            wsum = wave_sum(wsum);
            if (lane == 0) { SWL[tl] = sc; SWL[128 + tl] = 8.f * wsum; }
        } }
        LDS_WAIT();
        { const bf16* X1 = F.ws<bf16>(WS_Y1); const unsigned char* V8 = F.ws<unsigned char>(WS_V8); bf16* Y2 = F.ws<bf16>(WS_QP);
#define V_ISSUE(n_, PC, WQ) do { const int c_ = (n_) >> 4, tl_ = tw + (((n_) >> 3) & 1) * 8 + g8, s_ = (n_) & 7; \
            const LAS unsigned short* ep_ = EIDL + tl_ * 128 + 16 * s_; const unsigned char* vb_ = V8 + (size_t)c_ * (NEXP * PCH) + 16 * j8; \
            _Pragma("unroll") for (int i = 0; i < 16; ++i) { const unsigned e_ = ep_[i]; PC[i] = *(const GAS v4u*)(vb_ + e_ * PCH); } \
            WQ = *(const LAS v4u*)(F.lds + P7_W8 + tl_ * 128 + 16 * s_); } while (0)
#define V_TR4(A_, B_, C_, D_, WQ_, O_) do { const unsigned t0_ = __builtin_amdgcn_perm(B_, A_, 0x05010400u), t1_ = __builtin_amdgcn_perm(B_, A_, 0x07030602u), t2_ = __builtin_amdgcn_perm(D_, C_, 0x05010400u), t3_ = __builtin_amdgcn_perm(D_, C_, 0x07030602u); \
            const unsigned u0_ = __builtin_amdgcn_perm(t2_, t0_, 0x05040100u), u1_ = __builtin_amdgcn_perm(t2_, t0_, 0x07060302u), u2_ = __builtin_amdgcn_perm(t3_, t1_, 0x05040100u), u3_ = __builtin_amdgcn_perm(t3_, t1_, 0x07060302u); \
              \
            ac_[(O_) + 0] = __builtin_amdgcn_sdot4((int)(u0_ & 0x0f0f0f0fu), (int)(WQ_), ac_[(O_) + 0], false); ac_[(O_) + 4] = __builtin_amdgcn_sdot4((int)u0_, (int)(WQ_), ac_[(O_) + 4], false); \
            ac_[(O_) + 1] = __builtin_amdgcn_sdot4((int)(u1_ & 0x0f0f0f0fu), (int)(WQ_), ac_[(O_) + 1], false); ac_[(O_) + 5] = __builtin_amdgcn_sdot4((int)u1_, (int)(WQ_), ac_[(O_) + 5], false); \
            ac_[(O_) + 2] = __builtin_amdgcn_sdot4((int)(u2_ & 0x0f0f0f0fu), (int)(WQ_), ac_[(O_) + 2], false); ac_[(O_) + 6] = __builtin_amdgcn_sdot4((int)u2_, (int)(WQ_), ac_[(O_) + 6], false); \
            ac_[(O_) + 3] = __builtin_amdgcn_sdot4((int)(u3_ & 0x0f0f0f0fu), (int)(WQ_), ac_[(O_) + 3], false); ac_[(O_) + 7] = __builtin_amdgcn_sdot4((int)u3_, (int)(WQ_), ac_[(O_) + 7], false); } while (0)
#define V_ACC(PC, WQ) do { const unsigned wq_[4] = {WQ.x, WQ.y, WQ.z, WQ.w}; \
            _Pragma("unroll") for (int gq = 0; gq < 4; ++gq) { \
                const unsigned pa_[4] = {PC[4 * gq].x, PC[4 * gq].y, PC[4 * gq].z, PC[4 * gq].w}, pb_[4] = {PC[4 * gq + 1].x, PC[4 * gq + 1].y, PC[4 * gq + 1].z, PC[4 * gq + 1].w}; \
                const unsigned pc_[4] = {PC[4 * gq + 2].x, PC[4 * gq + 2].y, PC[4 * gq + 2].z, PC[4 * gq + 2].w}, pd_[4] = {PC[4 * gq + 3].x, PC[4 * gq + 3].y, PC[4 * gq + 3].z, PC[4 * gq + 3].w}; \
                _Pragma("unroll") for (int m = 0; m < 4; ++m) { \
                    V_TR4(pa_[m], pb_[m], pc_[m], pd_[m], wq_[gq], 8 * m); } } } while (0)
#define V_FIN(n_, XP) do { const int c_ = (n_) >> 4, tl_ = tw + (((n_) >> 3) & 1) * 8 + g8; \
            const LAS float* swp_ = (const LAS float*)(F.lds + P7_SW); const float sw_ = swp_[tl_], wo_ = swp_[128 + tl_]; \
            const f32x2 ms_ = *(const LAS f32x2*)(F.lds + P7_LNSL + tl_ * 8); const int dim0_ = c_ * VCH + 32 * j8; \
            _Pragma("unroll") for (int m = 0; m < 4; ++m) { \
                const f32x4 g0_ = *(const LAS f32x4*)(F.lds + P7_G1 + (dim0_ + 8 * m) * 4), g1_ = *(const LAS f32x4*)(F.lds + P7_G1 + (dim0_ + 8 * m + 4) * 4), b0_ = *(const LAS f32x4*)(F.lds + P7_B1 + (dim0_ + 8 * m) * 4), b1_ = *(const LAS f32x4*)(F.lds + P7_B1 + (dim0_ + 8 * m + 4) * 4); \
                const unsigned xw_[4] = {XP[m].x, XP[m].y, XP[m].z, XP[m].w}; float o_[8]; \
                _Pragma("unroll") for (int i = 0; i < 4; ++i) { const float yl_ = (i & 1) ? bfhi(xw_[i >> 1]) : bflo(xw_[i >> 1]), yh_ = (i & 1) ? bfhi(xw_[2 + (i >> 1)]) : bflo(xw_[2 + (i >> 1)]); \
                    o_[i] = ((float)ac_[8 * m + i] - wo_) * sw_ + DN_ALPHA * ((yl_ - ms_.x) * ms_.y * g0_[i] + b0_[i]); \
                    o_[4 + i] = (float)((ac_[8 * m + 4 + i] - ac_[8 * m + i]) >> 4) * sw_ + DN_ALPHA * ((yh_ - ms_.x) * ms_.y * g1_[i] + b1_[i]); } \
                *(GAS v4u*)(Y2 + (size_t)(m0 + tl_) * D + dim0_ + 8 * m) = (v4u){pk2(o_[0], o_[1]), pk2(o_[2], o_[3]), pk2(o_[4], o_[5]), pk2(o_[6], o_[7])}; } \
            _Pragma("unroll") for (int d = 0; d < 32; ++d) ac_[d] = 0; } while (0)
          constexpr int VCH = 256, NSTEP = (D / VCH) * (TPB / NWAVES);
          v4u pcA[16], pcB[16], wqA, wqB, xp[4]; int ac_[32];
#pragma unroll
          for (int d = 0; d < 32; ++d) ac_[d] = 0;
          V_ISSUE(0, pcA, wqA);
          for (int n = 0; n < NSTEP; n += 2) {
              const bool fin = (n & 7) == 6;
              if (fin) { const int c_ = (n + 1) >> 4, tl_ = tw + (((n + 1) >> 3) & 1) * 8 + g8; const GAS v4u* xq_ = (const GAS v4u*)(X1 + (size_t)(m0 + tl_) * D + c_ * VCH + 32 * j8);
#pragma unroll
                  for (int m = 0; m < 4; ++m) xp[m] = xq_[m]; }
              V_ISSUE(n + 1, pcB, wqB); __builtin_amdgcn_sched_barrier(0);
              V_ACC(pcA, wqA); __builtin_amdgcn_sched_barrier(0);
              { const int nn = (n + 2 < NSTEP) ? n + 2 : n; V_ISSUE(nn, pcA, wqA); }
              __builtin_amdgcn_sched_barrier(0);
              V_ACC(pcB, wqB);
              if (fin) V_FIN(n + 1, xp);
              __builtin_amdgcn_sched_barrier(0);
          }
#undef V_TR4
#undef V_ISSUE
#undef V_ACC
#undef V_FIN
        }
        { const float* ln2_g = F.in(I_LN2G); const float* ln2_b = F.in(I_LN2B); float* outp = F.outp(); const bf16* Y2 = F.ws<bf16>(WS_QP);
        for (int ti = 0; ti < TPB / NWAVES; ++ti) {
            const int t = m0 + tw + ti;
            const GAS v4u* yp = (const GAS v4u*)(Y2 + (size_t)t * D) + lane;
            float v[32]; float s = 0.f;
#pragma unroll
            for (int j = 0; j < 4; ++j) { const v4u w = yp[64 * j]; const unsigned ww[4] = {w.x, w.y, w.z, w.w};
#pragma unroll
                for (int i = 0; i < 4; ++i) { v[8 * j + 2 * i] = bflo(ww[i]); v[8 * j + 2 * i + 1] = bfhi(ww[i]); s += v[8 * j + 2 * i] + v[8 * j + 2 * i + 1]; } }
            const float mean = wave_sum(s) * (1.f / D); float qv = 0.f;
#pragma unroll
            for (int i = 0; i < 32; ++i) { v[i] -= mean; qv += v[i] * v[i]; }
            const float rstd = 1.f / sqrtf(wave_sum(qv) * (1.f / D) + LN_EPS);
#pragma unroll
            for (int j = 0; j < 4; ++j) { const int c0 = 8 * lane + 512 * j; const f32x4 g0 = *(const f32x4*)(ln2_g + c0), g1 = *(const f32x4*)(ln2_g + c0 + 4), b0 = *(const f32x4*)(ln2_b + c0), b1 = *(const f32x4*)(ln2_b + c0 + 4);
                f32x4 r0, r1;
#pragma unroll
                for (int i = 0; i < 4; ++i) { r0[i] = v[8 * j + i] * rstd * g0[i] + b0[i]; r1[i] = v[8 * j + 4 + i] * rstd * g1[i] + b1[i]; }
                GAS f32x4* op = (GAS f32x4*)(outp + (size_t)t * D + c0); op[0] = r0; op[1] = r1; }
        } }
        __syncthreads();
    }
}

struct Args { const float* in[22]; float* out; unsigned char* ws; int ph_lo, ph_hi; };
__global__ void __launch_bounds__(NWAVES * 64, 2) mk_fwd(Args args) {
    extern __shared__ __attribute__((aligned(16))) unsigned char lds[];
    cg::grid_group grid = cg::this_grid();
    Frame F;
    F.lds = (LAS unsigned char*)lds;
    if (threadIdx.x == 0) { LAS unsigned long long* PT = (LAS unsigned long long*)(F.lds + RING_BYTES);
#pragma unroll
        for (int k = 0; k < 22; ++k) PT[k] = (unsigned long long)args.in[k];
        PT[22] = (unsigned long long)args.out; PT[23] = (unsigned long long)args.ws;
        ((LAS unsigned*)(F.lds + RING_BYTES + 256))[0] = 0u; ((LAS unsigned*)(F.lds + RING_BYTES + 256))[1] = 0u; }
    __syncthreads();
    const int lo = args.ph_lo, hi = args.ph_hi;
#ifndef PHASE_MASK
#define PHASE_MASK 255
#endif
#define IN(k) (((PHASE_MASK >> (k)) & 1) && lo <= (k) && (k) < hi)
#ifndef REPEAT_PHASE
#define REPEAT_PHASE -1
#endif
#define REP(k) for (int rep_ = 0; rep_ < ((REPEAT_PHASE == (k)) ? 2 : 1); ++rep_)
    (void)xcd_barrier_post((unsigned*)args.ws, (volatile LAS unsigned*)(F.lds + RING_BYTES + 256));
#define XBAR() do { XcdBarrier bar_; bar_.bar = F.ws<unsigned>(0); bar_.x = xb_xcc_id(); bar_.st = (volatile LAS unsigned*)(F.lds + RING_BYTES + 256); xcd_barrier(bar_); } while (0)
#define SEAM(k) do { if (IN(k) && IN((k) + 1)) XBAR(); } while (0)

    if (lo < 0) grid.sync();
    if (IN(0)) REP(0) { p0a_prologue(F); XBAR(); p0b_prologue(F); } SEAM(0);
    if (IN(1)) REP(1) {
        pg8::Gemm g{F.ws<bf16>(WS_XB), F.ws<bf16>(WS_WIN), M, NPROJ, D / 2}; pg8::StaticOrder S; S.init(M, NPROJ, F.G_(), (int)blockIdx.x);
        pg8::EpiProjI8 E{F.ws<bf16>(WS_Q), (size_t)(WS_K - WS_Q) / 2, dattn::C2, F.ws<bf16>(WS_H), F.in(I_BGLU), F.ws<float>(WS_SXA), F.ws<float>(WS_SWIN)};
        pg8::gemm_phase<pg8::EpiProjI8, pg8::StaticOrder, PG8_ALIGN, PG8_SP2>(F.lds, g, S, E);
    } SEAM(1);
    if (IN(2)) REP(2) {
        static_assert(dattn::LDS_BYTES <= RING_BYTES, "attention body geometry vs frame");
        const dattn::Tensors AT{F.ws<const dattn::bf16>(WS_Q), F.ws<const dattn::bf16>(WS_K), F.ws<const dattn::bf16>(WS_V), F.ws<dattn::bf16>(WS_O1), F.ws<dattn::bf16>(WS_O2), F.ws<const float>(WS_TAB)};
        dattn::phase((char*)lds, AT, F.vcu_());
    } SEAM(2);
    if (IN(3)) REP(3) { p3_mix(F); } SEAM(3);
    if (IN(4)) REP(4) {
        pg8::Gemm g{F.ws<bf16>(WS_XB), F.ws<bf16>(WS_WOUT), M, D, D / 2}; pg8::StaticOrder S; S.init(M, D, F.G_(), (int)blockIdx.x);
        pg8::EpiResI8 E{F.in(I_X), F.ws<bf16>(WS_Y1), D, DN_ALPHA, F.ws<float>(WS_SM), F.ws<float>(WS_SWOUT)};
        pg8::gemm_phase<pg8::EpiResI8, pg8::StaticOrder, PG8_ALIGN, PG8_SP2>(F.lds, g, S, E);
    } SEAM(4);
    if (IN(5)) REP(5) { p5_ln1(F); } SEAM(5);
    if (IN(6)) REP(6) {
        pg8::Gemm g{F.ws<bf16>(WS_X8), F.ws<bf16>(WS_WQ), M, D, D / 2}; pg8::StaticOrder S; S.init(M, D, F.G_(), (int)blockIdx.x);
        pg8::EpiPlainI8 E{F.ws<bf16>(WS_QP), D, F.ws<float>(WS_SX), F.ws<float>(WS_SWQ)};
        pg8::gemm_phase<pg8::EpiPlainI8, pg8::StaticOrder, PG8_ALIGN, PG8_SP2>(F.lds, g, S, E);
    } SEAM(6);
    if (IN(7)) REP(7) { p7_peer(F); }
#undef IN
#undef SEAM
}

extern "C" void kernel_launch(void* const* d_in, const int* in_sizes, int n_in, void* d_out, int out_size, void* d_ws, size_t ws_size, hipStream_t stream) {
    static int grid = 0;
    if (grid == 0) {
        if (n_in != 22 || in_sizes[0] != M * D || out_size != M * D || ws_size < WS_END) { fprintf(stderr, "kernel_launch: unexpected shapes (n_in %d, in0 %d, out %d, ws %zu); nothing launched\n", n_in, n_in > 0 ? in_sizes[0] : -1, out_size, ws_size); grid = -1; return; }
        int dev = 0, cus = 0, per_cu = 0;
        if (hipGetDevice(&dev) != hipSuccess || hipDeviceGetAttribute(&cus, hipDeviceAttributeMultiprocessorCount, dev) != hipSuccess) { grid = -1; return; }
        if (hipFuncSetAttribute((const void*)mk_fwd, hipFuncAttributeMaxDynamicSharedMemorySize, LDS_BYTES) != hipSuccess) { fprintf(stderr, "kernel_launch: hipFuncSetAttribute failed\n"); grid = -1; return; }
        if (hipOccupancyMaxActiveBlocksPerMultiprocessor(&per_cu, (const void*)mk_fwd, NWAVES * 64, LDS_BYTES) != hipSuccess || per_cu < 1) { fprintf(stderr, "kernel_launch: occupancy query reports %d workgroups per CU\n", per_cu); (void)hipGetLastError(); grid = -1; return; }
        grid = cus;
        if (grid > 256) grid = 256;
    }
    if (grid < 0) return;
    if (hipMemsetAsync(d_ws, 0, 65536, stream) != hipSuccess) { fprintf(stderr, "kernel_launch: hipMemsetAsync failed\n"); return; }
    Args a{};
    for (int i = 0; i < 22; ++i) a.in[i] = (const float*)d_in[i];
    a.out = (float*)d_out; a.ws = (unsigned char*)d_ws;
    constexpr int NL = MK_N_LAUNCHES;
    for (int li = 0; li < NL; ++li) {
        a.ph_lo = (NL == 1) ? 0 : li; a.ph_hi = (NL == 1) ? N_PHASES : li + 1;
        void* kargs[] = {&a};
        const hipError_t le = hipLaunchCooperativeKernel((const void*)mk_fwd, dim3(grid), dim3(NWAVES * 64), kargs, LDS_BYTES, stream);
        if (le != hipSuccess) { fprintf(stderr, "kernel_launch: cooperative launch %d failed: %s (grid %d)\n", li, hipGetErrorString(le), grid); break; }
    }
}
```

```cpp
#include <hip/hip_runtime.h>
#include <hip/hip_cooperative_groups.h>
#include <cstdio>
#include <cstdint>
namespace cg = cooperative_groups;
namespace pg8 {
#define PG8_LAS __attribute__((address_space(3)))
typedef unsigned short bf16_t;
typedef short bf16x8 __attribute__((ext_vector_type(8)));
typedef float f32x4 __attribute__((ext_vector_type(4)));
typedef unsigned u32x4 __attribute__((ext_vector_type(4)));
typedef int i32x4 __attribute__((ext_vector_type(4)));
constexpr int BM = 256, BK = 64, HALF = 128, HTB = HALF * BK * 2  , STAGE_BYTES = 8 * HTB, NXCD = 8, WGM = 8;

__host__ __device__ __forceinline__ int lds_byte(int r, int c) { const int st = (r >> 4) * 2 + (c >> 5), rr = r & 15, cc = c & 31, ob = rr * 64 + cc * 2; return st * 1024 + (ob ^ (((ob >> 9) & 1) << 5)); }
__host__ __device__ __forceinline__ void stage_rc(int b, int& R, int& C) { const int st = b / 1024, sb = b % 1024, swz = sb ^ (((sb >> 9) & 1) << 5); R = (st >> 1) * 16 + swz / 64; C = (st & 1) * 32 + (swz % 64) / 2; }
__host__ __device__ __forceinline__ int perm32(int rho) { const int n = rho >> 4, i = rho & 15; return 8 * (i >> 2) + 4 * n + (i & 3); }

struct Unit { int pm, pn; };
struct Gemm { const bf16_t* A; const bf16_t* Bt; int M, N, K; };

struct StaticOrder {
    int nM, nN, nwg, G, c;
    __host__ __device__ void init(int M, int N, int G_, int c_) { nM = M / BM; nN = N / BM; nwg = nM * nN; G = G_; c = c_; }
    __host__ __device__ bool next(int i, Unit& u) const {
        const long L = (long)i * G + c; if (L >= nwg) return false;
        int wgid = (int)L; { const int q = nwg / NXCD, r = nwg % NXCD, xcd = wgid % NXCD, off = wgid / NXCD; wgid = (xcd < r ? xcd * (q + 1) : r * (q + 1) + (xcd - r) * q) + off; }
        const int nig = WGM * nN, gid = wgid / nig, fm = gid * WGM, gsz = (nM - fm) < WGM ? (nM - fm) : WGM;
        u.pm = fm + ((wgid % nig) % gsz); u.pn = (wgid % nig) / gsz; return true;
    }
    __device__ __forceinline__ void a_ready(const Unit&) const {}
    __device__ __forceinline__ void done(const Unit&) const {}
};

__device__ __forceinline__ unsigned cvt_pk_bf16(float lo, float hi) { unsigned r; asm volatile("v_cvt_pk_bf16_f32 %0, %1, %2" : "=v"(r) : "v"(lo), "v"(hi)); return r; }
typedef float f32x2 __attribute__((ext_vector_type(2)));
typedef float f32x2 __attribute__((ext_vector_type(2)));
__device__ __forceinline__ u32x4 pack8(f32x4 v0, f32x4 v1) { u32x4 w; w.x = cvt_pk_bf16(v0[0], v0[1]); w.y = cvt_pk_bf16(v0[2], v0[3]); w.z = cvt_pk_bf16(v1[0], v1[1]); w.w = cvt_pk_bf16(v1[2], v1[3]); return w; }
typedef _Float16 h16x2 __attribute__((ext_vector_type(2)));
__device__ __forceinline__ unsigned pkh2(float a, float b) { const h16x2 v = {(_Float16)__builtin_amdgcn_fmed3f(a, -65504.f, 65504.f), (_Float16)__builtin_amdgcn_fmed3f(b, -65504.f, 65504.f)}; return __builtin_bit_cast(unsigned, v); }
__device__ __forceinline__ u32x4 pack8h(f32x4 v0, f32x4 v1) { u32x4 w; w.x = pkh2(v0[0], v0[1]); w.y = pkh2(v0[2], v0[3]); w.z = pkh2(v1[0], v1[1]); w.w = pkh2(v1[2], v1[3]); return w; }
__device__ __forceinline__ f32x4 i2f(f32x4 a) { const i32x4 v = __builtin_bit_cast(i32x4, a); return (f32x4){(float)v[0], (float)v[1], (float)v[2], (float)v[3]}; }
__device__ __forceinline__ unsigned ror8(unsigned v) { return (unsigned)__builtin_amdgcn_update_dpp(0, (int)v, 0x128, 0xf, 0xf, true); }
__device__ __forceinline__ void xchg_store2(bf16_t* p  , size_t ld, u32x4 p0  , u32x4 p1  , bool hi8) {
    const u32x4 snd = hi8 ? p0 : p1; u32x4 rcv; rcv.x = ror8(snd.x); rcv.y = ror8(snd.y); rcv.z = ror8(snd.z); rcv.w = ror8(snd.w);
    *(u32x4*)p = hi8 ? rcv : p0; *(u32x4*)(p + 8 * ld) = hi8 ? p1 : rcv;
}
struct EpiProjI8 {
    static constexpr bool PERM = true, AFTER_DRAIN = false, INT8 = true;
    bf16_t* QKV; size_t split_stride; float scale0; bf16_t* H; const float* bglu; const float* sa; const float* sb;
    __device__ __forceinline__ void operator()(const f32x4 (&acc)[2][2][4][2], const Unit& u, int wr, int wc, int fr, int fq) const {
        const int row0 = u.pm * BM + wr * 64 + fr, cb = u.pn * BM + wc * 64 + 8 * fq; const bool hi8 = fr & 8;
        f32x4 cs[2][2];
#pragma unroll
        for (int bj = 0; bj < 2; ++bj) { cs[bj][0] = *(const f32x4*)(sb + cb + bj * 32); cs[bj][1] = *(const f32x4*)(sb + cb + bj * 32 + 4); }
        float rsv[2][4];
#pragma unroll
        for (int ai = 0; ai < 2; ++ai)
#pragma unroll
            for (int m = 0; m < 4; ++m) rsv[ai][m] = sa[row0 + ai * HALF + m * 16];
        if (u.pn < 12) {
            const int t = u.pn >> 2; bf16_t* base = QKV + (size_t)t * split_stride; const float sc = (t == 0) ? scale0 : 1.f;
            bf16_t* lp = base + (size_t)(u.pm * BM + wr * 64 + (fr & 7)) * 1024 + (u.pn & 3) * BM + wc * 64 + 8 * fq + (hi8 ? 32 : 0);
#pragma unroll
            for (int ai = 0; ai < 2; ++ai)
#pragma unroll
                for (int m = 0; m < 4; ++m) { const float rs = rsv[ai][m] * sc;
                    xchg_store2(lp + (size_t)(ai * HALF + m * 16) * 1024, 1024, pack8(i2f(acc[ai][0][m][0]) * cs[0][0] * rs, i2f(acc[ai][0][m][1]) * cs[0][1] * rs), pack8(i2f(acc[ai][1][m][0]) * cs[1][0] * rs, i2f(acc[ai][1][m][1]) * cs[1][1] * rs), hi8); }
        } else {
            const int ch0 = (u.pn - 12) * HALF + wc * 32 + 8 * fq;
            const f32x4 ba0 = *(const f32x4*)(bglu + ch0), ba1 = *(const f32x4*)(bglu + ch0 + 4), bg0 = *(const f32x4*)(bglu + 1024 + ch0), bg1 = *(const f32x4*)(bglu + 1024 + ch0 + 4);
#pragma unroll
            for (int ai = 0; ai < 2; ++ai)
#pragma unroll
                for (int m = 0; m < 4; ++m) { const int row = row0 + ai * HALF + m * 16; const float rs = rsv[ai][m];
                    const f32x4 a0 = i2f(acc[ai][0][m][0]) * cs[0][0] * rs + ba0, a1 = i2f(acc[ai][0][m][1]) * cs[0][1] * rs + ba1, g0 = i2f(acc[ai][1][m][0]) * cs[1][0] * rs + bg0, g1 = i2f(acc[ai][1][m][1]) * cs[1][1] * rs + bg1;
                    f32x4 h0, h1;
#pragma unroll
                    for (int e = 0; e < 4; ++e) { h0[e] = a0[e] * __builtin_amdgcn_rcpf(1.f + __builtin_amdgcn_exp2f(-1.4426950409f * g0[e])); h1[e] = a1[e] * __builtin_amdgcn_rcpf(1.f + __builtin_amdgcn_exp2f(-1.4426950409f * g1[e])); }
                    *(u32x4*)(H + (size_t)row * 1024 + ch0) = pack8h(h0, h1); }
        }
    }
};
struct EpiPlainI8 {
    static constexpr bool PERM = true, AFTER_DRAIN = false, INT8 = true;
    bf16_t* O; int ldc; const float* sa; const float* sb;
    __device__ __forceinline__ void operator()(const f32x4 (&acc)[2][2][4][2], const Unit& u, int wr, int wc, int fr, int fq) const {
        const int row0 = u.pm * BM + wr * 64 + fr, col0 = u.pn * BM + wc * 64 + 8 * fq; const bool hi8 = fr & 8;
        f32x4 cs[2][2];
#pragma unroll
        for (int bj = 0; bj < 2; ++bj) { cs[bj][0] = *(const f32x4*)(sb + col0 + bj * 32); cs[bj][1] = *(const f32x4*)(sb + col0 + bj * 32 + 4); }
        float rsv[2][4];
#pragma unroll
        for (int ai = 0; ai < 2; ++ai)
#pragma unroll
            for (int m = 0; m < 4; ++m) rsv[ai][m] = sa[row0 + ai * HALF + m * 16];
        bf16_t* lp = O + (size_t)(u.pm * BM + wr * 64 + (fr & 7)) * ldc + col0 + (hi8 ? 32 : 0);
#pragma unroll
        for (int ai = 0; ai < 2; ++ai)
#pragma unroll
            for (int m = 0; m < 4; ++m) { const float rs = rsv[ai][m];
                xchg_store2(lp + (size_t)(ai * HALF + m * 16) * ldc, (size_t)ldc, pack8(i2f(acc[ai][0][m][0]) * cs[0][0] * rs, i2f(acc[ai][0][m][1]) * cs[0][1] * rs), pack8(i2f(acc[ai][1][m][0]) * cs[1][0] * rs, i2f(acc[ai][1][m][1]) * cs[1][1] * rs), hi8); }
    }
};
struct EpiResI8 {
    static constexpr bool PERM = true, AFTER_DRAIN = false, INT8 = true;
    const float* X; bf16_t* Y; int ldc; float alpha; const float* sa; const float* sb;
    __device__ __forceinline__ void operator()(const f32x4 (&acc)[2][2][4][2], const Unit& u, int wr, int wc, int fr, int fq) const {
        const int row0 = u.pm * BM + wr * 64 + fr, col0 = u.pn * BM + wc * 64 + 8 * fq; const bool hi8 = fr & 8;
        f32x4 cs[2][2];
#pragma unroll
        for (int bj = 0; bj < 2; ++bj) { cs[bj][0] = *(const f32x4*)(sb + col0 + bj * 32); cs[bj][1] = *(const f32x4*)(sb + col0 + bj * 32 + 4); }
        float rsv[2][4];
#pragma unroll
        for (int ai = 0; ai < 2; ++ai)
#pragma unroll
            for (int m = 0; m < 4; ++m) rsv[ai][m] = sa[row0 + ai * HALF + m * 16];
        bf16_t* lp = Y + (size_t)(u.pm * BM + wr * 64 + (fr & 7)) * ldc + col0 + (hi8 ? 32 : 0);
#pragma unroll
        for (int ai = 0; ai < 2; ++ai) {
            f32x4 xv[4][2][2];
#pragma unroll
            for (int m = 0; m < 4; ++m) { const size_t off = (size_t)(row0 + ai * HALF + m * 16) * ldc + col0;
#pragma unroll
                for (int bj = 0; bj < 2; ++bj) { xv[m][bj][0] = *(const f32x4*)(X + off + bj * 32); xv[m][bj][1] = *(const f32x4*)(X + off + bj * 32 + 4); } }
#pragma unroll
            for (int m = 0; m < 4; ++m) { const float rs = rsv[ai][m];
                xchg_store2(lp + (size_t)(ai * HALF + m * 16) * ldc, (size_t)ldc,
                            pack8(i2f(acc[ai][0][m][0]) * cs[0][0] * rs + xv[m][0][0] * alpha, i2f(acc[ai][0][m][1]) * cs[0][1] * rs + xv[m][0][1] * alpha),
                            pack8(i2f(acc[ai][1][m][0]) * cs[1][0] * rs + xv[m][1][0] * alpha, i2f(acc[ai][1][m][1]) * cs[1][1] * rs + xv[m][1][1] * alpha), hi8); }
            asm volatile("" ::: "memory"); }
    }
};
template <class Epi, class Sched, bool ALIGN_EPI = false, bool SP2 = false>
__device__ __forceinline__ void gemm_phase(PG8_LAS unsigned char* lds, const Gemm g, const Sched& S, const Epi& E) {
    const int tid = threadIdx.x, wid = __builtin_amdgcn_readfirstlane(tid >> 6), lane = tid & 63, wr = wid >> 2, wc = wid & 3, fr = lane & 15, fq = lane >> 4;
    const int K = g.K, nt = K / BK;
    unsigned voffA[2], voffB[2];
#pragma unroll
    for (int i = 0; i < 2; ++i) { int R, C; stage_rc(tid * 16 + i * 8192, R, C); const int Rb = Epi::PERM ? (64 * (R >> 5) + perm32(R & 31)) : R;
        voffA[i] = (unsigned)(R * K + C) * 2u; voffB[i] = (unsigned)(Rb * K + C) * 2u; }
    const size_t kstep = (size_t)(BK * 2);
    const size_t hstep = (size_t)HALF * K * 2;
    const size_t tstep = 2 * hstep;
    const size_t hstepB = Epi::PERM ? (size_t)32 * K * 2 : hstep;
    const unsigned ldsw = (unsigned)wid * 1024u;
    const int aoff = lds_byte(wr * 64 + fr, fq * 8), boff = lds_byte(wc * 32 + fr, fq * 8);
#define PG8_SA(b, h) (((b) * 2 + (h)) * HTB)
#define PG8_SB(b, h) ((4 + (b) * 2 + (h)) * HTB)
#define PG8_STAGE(bufoff, gbase, voff) do { _Pragma("unroll") for (int _i = 0; _i < 2; ++_i) \
        __builtin_amdgcn_global_load_lds((const unsigned*)((const char*)(gbase) + (voff)[_i]), (PG8_LAS unsigned*)(lds + (bufoff) + ldsw + _i * 8192), 16, 0, 0); } while (0)
#define PG8_LDA(dst, b, h) do { _Pragma("unroll") for (int m = 0; m < 4; ++m) _Pragma("unroll") for (int k = 0; k < 2; ++k) dst[m][k] = *(const PG8_LAS bf16x8*)(lds + PG8_SA(b, h) + aoff + m * 2048 + k * 1024); } while (0)
#define PG8_LDB(dst, b, h) do { _Pragma("unroll") for (int n = 0; n < 2; ++n) _Pragma("unroll") for (int k = 0; k < 2; ++k) dst[n][k] = *(const PG8_LAS bf16x8*)(lds + PG8_SB(b, h) + boff + n * 2048 + k * 1024); } while (0)
#define PG8_MMA(ai, bj, At, Bt) do { __builtin_amdgcn_s_setprio(1); _Pragma("unroll") for (int m = 0; m < 4; ++m) _Pragma("unroll") for (int n = 0; n < 2; ++n) _Pragma("unroll") for (int k = 0; k < 2; ++k) { \
        if constexpr (Epi::INT8) acc[ai][bj][m][n] = __builtin_bit_cast(f32x4, __builtin_amdgcn_mfma_i32_16x16x64_i8(__builtin_bit_cast(i32x4, Bt[n][k]), __builtin_bit_cast(i32x4, At[m][k]), __builtin_bit_cast(i32x4, acc[ai][bj][m][n]), 0, 0, 0)); \
        else acc[ai][bj][m][n] = __builtin_amdgcn_mfma_f32_16x16x32_bf16(Bt[n][k], At[m][k], acc[ai][bj][m][n], 0, 0, 0); } __builtin_amdgcn_s_setprio(0); } while (0)
#define PG8_WAIT_V(n) asm volatile("s_waitcnt vmcnt(" #n ")" ::: "memory")
#define PG8_WAIT_L(n) asm volatile("s_waitcnt lgkmcnt(" #n ")" ::: "memory")
#define PG8_BAR __builtin_amdgcn_s_barrier()
#define PG8_SCHED __builtin_amdgcn_sched_barrier(0)
    Unit cur, nxt; int ui = 0;
    if (!S.next(0, cur)) return;
    f32x4 acc[2][2][4][2];
#pragma unroll
    for (int a = 0; a < 2; ++a)
#pragma unroll
        for (int b = 0; b < 2; ++b)
#pragma unroll
            for (int m = 0; m < 4; ++m)
#pragma unroll
                for (int n = 0; n < 2; ++n) acc[a][b][m][n] = (f32x4){0.f, 0.f, 0.f, 0.f};
    bf16x8 At[4][2], B0[2][2], B1[2][2];
    const char* cA = (const char*)g.A + (size_t)cur.pm * tstep; const char* cB = (const char*)g.Bt + (size_t)cur.pn * tstep;
    S.a_ready(cur);
    if constexpr (SP2) {
        PG8_STAGE(PG8_SB(0, 0), cB, voffB); PG8_STAGE(PG8_SB(0, 1), cB + hstepB, voffB); PG8_STAGE(PG8_SA(0, 0), cA, voffA); PG8_STAGE(PG8_SA(0, 1), cA + hstep, voffA);
        if (wr == 1) PG8_BAR;
        PG8_WAIT_V(2); PG8_BAR;
        PG8_STAGE(PG8_SB(1, 0), cB + kstep, voffB); PG8_STAGE(PG8_SA(1, 0), cA + kstep, voffA); PG8_STAGE(PG8_SB(1, 1), cB + hstepB + kstep, voffB);
        PG8_WAIT_V(6); PG8_BAR;
    } else {
        PG8_STAGE(PG8_SB(0, 0), cB, voffB); PG8_STAGE(PG8_SA(0, 0), cA, voffA); PG8_STAGE(PG8_SB(0, 1), cB + hstepB, voffB); PG8_STAGE(PG8_SA(0, 1), cA + hstep, voffA);
        if (wr == 1) PG8_BAR;
        PG8_WAIT_V(4); PG8_BAR;
        PG8_STAGE(PG8_SB(1, 0), cB + kstep, voffB); PG8_STAGE(PG8_SA(1, 0), cA + kstep, voffA); PG8_STAGE(PG8_SB(1, 1), cB + hstepB + kstep, voffB);
        PG8_WAIT_V(6); PG8_BAR;
    }
    for (;;) {
        const bool has_next = S.next(ui + 1, nxt);
        const char* nA = has_next ? (const char*)g.A + (size_t)nxt.pm * tstep : cA; const char* nB = has_next ? (const char*)g.Bt + (size_t)nxt.pn * tstep : cB;
        for (int t = 0; t < nt; t += 2) {
            const bool last = (t == nt - 2);
            const char* a1 = cA + (size_t)(t + 1) * kstep;
            const char* a2 = last ? nA : cA + (size_t)(t + 2) * kstep; const char* b2 = last ? nB : cB + (size_t)(t + 2) * kstep;
            const char* a3 = a2 + kstep; const char* b3 = b2 + kstep;
            if (last && has_next) S.a_ready(nxt);
            if constexpr (SP2) {
            PG8_LDB(B0, 0, 0); PG8_LDB(B1, 0, 1); PG8_SCHED; PG8_LDA(At, 0, 0); PG8_STAGE(PG8_SA(1, 1), a1 + hstep, voffA);
            PG8_WAIT_V(8); PG8_WAIT_L(0); PG8_BAR; PG8_MMA(0, 0, At, B0); PG8_MMA(0, 1, At, B1); PG8_BAR; PG8_SCHED;
            PG8_LDA(At, 0, 1); PG8_STAGE(PG8_SB(0, 0), b2, voffB); PG8_STAGE(PG8_SB(0, 1), b2 + hstepB, voffB); PG8_STAGE(PG8_SA(0, 0), a2, voffA);
            PG8_WAIT_V(8); PG8_WAIT_L(0); PG8_BAR; PG8_MMA(1, 0, At, B0); PG8_MMA(1, 1, At, B1); PG8_BAR; PG8_SCHED;
            PG8_LDB(B0, 1, 0); PG8_LDB(B1, 1, 1); PG8_SCHED; PG8_LDA(At, 1, 0); PG8_STAGE(PG8_SA(0, 1), a2 + hstep, voffA);
            PG8_WAIT_V(8); PG8_WAIT_L(0); PG8_BAR; PG8_MMA(0, 0, At, B0); PG8_MMA(0, 1, At, B1); PG8_BAR; PG8_SCHED;
            PG8_LDA(At, 1, 1); PG8_STAGE(PG8_SB(1, 0), b3, voffB); PG8_STAGE(PG8_SB(1, 1), b3 + hstepB, voffB); PG8_STAGE(PG8_SA(1, 0), a3, voffA);
            PG8_WAIT_V(8); PG8_WAIT_L(0); PG8_BAR; PG8_MMA(1, 0, At, B0); PG8_MMA(1, 1, At, B1); PG8_BAR; PG8_SCHED;
            } else {
            PG8_LDB(B0, 0, 0); PG8_SCHED; PG8_LDA(At, 0, 0); PG8_STAGE(PG8_SA(1, 1), a1 + hstep, voffA);
            PG8_WAIT_L(8); PG8_BAR; PG8_WAIT_L(0); PG8_MMA(0, 0, At, B0); PG8_BAR; PG8_SCHED;
            PG8_LDB(B1, 0, 1); PG8_STAGE(PG8_SB(0, 0), b2, voffB);
            PG8_BAR; PG8_WAIT_L(0); PG8_MMA(0, 1, At, B1); PG8_BAR;
            PG8_LDA(At, 0, 1); PG8_STAGE(PG8_SA(0, 0), a2, voffA);
            PG8_BAR; PG8_WAIT_L(0); PG8_MMA(1, 0, At, B0); PG8_BAR; PG8_SCHED;
            PG8_STAGE(PG8_SB(0, 1), b2 + hstepB, voffB);
            PG8_WAIT_V(6); PG8_BAR; PG8_MMA(1, 1, At, B1); PG8_BAR;
            PG8_LDB(B0, 1, 0); PG8_SCHED; PG8_LDA(At, 1, 0); PG8_STAGE(PG8_SA(0, 1), a2 + hstep, voffA);
            PG8_WAIT_L(8); PG8_BAR; PG8_WAIT_L(0); PG8_MMA(0, 0, At, B0); PG8_BAR; PG8_SCHED;
            PG8_LDB(B1, 1, 1); PG8_STAGE(PG8_SB(1, 0), b3, voffB);
            PG8_BAR; PG8_WAIT_L(0); PG8_MMA(0, 1, At, B1); PG8_BAR;
            PG8_LDA(At, 1, 1); PG8_STAGE(PG8_SA(1, 0), a3, voffA);
            PG8_BAR; PG8_WAIT_L(0); PG8_MMA(1, 0, At, B0); PG8_BAR; PG8_SCHED;
            PG8_STAGE(PG8_SB(1, 1), b3 + hstepB, voffB);
            PG8_WAIT_V(6); PG8_BAR; PG8_MMA(1, 1, At, B1); PG8_BAR;
            }
        }
        if constexpr (ALIGN_EPI) { if (wr == 0) PG8_BAR; }
        if constexpr (!Epi::AFTER_DRAIN) { E(acc, cur, wr, wc, fr, fq); S.done(cur); }
        if (!has_next) break;
#pragma unroll
        for (int a = 0; a < 2; ++a)
#pragma unroll
            for (int b = 0; b < 2; ++b)
#pragma unroll
                for (int m = 0; m < 4; ++m)
#pragma unroll
                    for (int n = 0; n < 2; ++n) acc[a][b][m][n] = (f32x4){0.f, 0.f, 0.f, 0.f};
        cur = nxt; cA = nA; cB = nB; ++ui;
        if constexpr (ALIGN_EPI) { if (wr == 1) PG8_BAR; }
    }
    PG8_WAIT_V(0);
    if constexpr (!ALIGN_EPI) { if (wr == 0) PG8_BAR; }
    PG8_BAR;
    if constexpr (Epi::AFTER_DRAIN) { E.fused(acc, cur, wr, wc, fr, fq, lds, wid, lane); S.done(cur); }
#undef PG8_SA
#undef PG8_SB
#undef PG8_STAGE
#undef PG8_LDA
#undef PG8_LDB
#undef PG8_MMA
#undef PG8_WAIT_V
#undef PG8_WAIT_L
#undef PG8_BAR
#undef PG8_SCHED
}
}
#include <hip/hip_bf16.h>
#include <cmath>
namespace dattn {
using bf16 = __hip_bfloat16;
typedef short bf16x8 __attribute__((ext_vector_type(8)));
typedef short s16x4 __attribute__((ext_vector_type(4)));
typedef float f32x16 __attribute__((ext_vector_type(16)));
typedef unsigned u32x4 __attribute__((ext_vector_type(4)));
constexpr int DK = 64, DV = 128, RS = 1024, SEQ = 4096;
constexpr int NW = 8, QBLK = 32, KVBLK = 64, QB = NW * QBLK;
constexpr int SHM_V = KVBLK * DV * 2, SHM_K = KVBLK * DK * 2;
constexpr int NVB = 3;
constexpr int LDS_WS = NVB * SHM_V + 2 * SHM_K, LDS_TAB = LDS_WS + NW * 64 * 4, LDS_OST = 69632, OST_WAVE = 4096, LDS_BYTES = LDS_OST + NW * OST_WAVE;
constexpr int TAB_PADL = 260, TAB_N = TAB_PADL + 128 + 94;
static_assert(LDS_TAB + TAB_N * 4 <= LDS_OST, "attention LDS map");
constexpr float THR = 8.f;
constexpr float C2 = 0.125f * 1.4426950408889634f;
#define DA_KSWZ(row, colB) ((row) * 128 + ((colB) ^ (((row) & 7) << 4)))
#define DA_SBAR() __builtin_amdgcn_sched_barrier(0)
__device__ __forceinline__ int v_st(int k, int c) { const int kk = k;     return ((kk >> 3) * 4 + (c >> 5)) * 512 + ((kk & 7) * 32 + (c & 31)) * 2; }
__device__ __forceinline__ int v_rd_base(int lane) { return ((lane & 3) << 3) | (((lane >> 2) & 3) << 6) | (((lane >> 4) & 1) << 5) | (((lane >> 5) & 1) << 8); }
constexpr int v_rd_off(int d0, int ks, int half) { return d0 * 512 + ks * 4096 + half * 2048; }
__device__ __forceinline__ int crow(int r, int hi) { return (r & 3) + 8 * (r >> 2) + 4 * hi; }
__device__ __forceinline__ unsigned cvtpk(float lo, float hi) { unsigned r; asm volatile("v_cvt_pk_bf16_f32 %0, %1, %2" : "=v"(r) : "v"(lo), "v"(hi)); return r; }
__device__ __forceinline__ bf16x8 load8(const bf16* p) { return *reinterpret_cast<const bf16x8*>(p); }
__device__ __forceinline__ void bias_tile(f32x16& p0, f32x16& p1, int dq, const __attribute__((address_space(3))) float* tabp) {
    const __attribute__((address_space(3))) float* bp = tabp + (TAB_PADL - 59) + dq;
#pragma unroll
    for (int r = 0; r < 16; ++r) { const int c = (r & 3) + 8 * (r >> 2); p0[r] += bp[59 - c]; p1[r] += bp[27 - c]; }
}
__device__ __forceinline__ void rowmaxSM(const f32x16& p0, const f32x16& p1, float& m_reg, float& mn, float& alpha) {
    float ma_ = p0[0], mb_ = p1[0];
#pragma unroll
    for (int r = 1; r < 15; r += 2) { ma_ = fmaxf(fmaxf(ma_, p0[r]), p0[r + 1]); mb_ = fmaxf(fmaxf(mb_, p1[r]), p1[r + 1]); }
    float pmax = fmaxf(fmaxf(ma_, p0[15]), fmaxf(mb_, p1[15]));
    { auto rr = __builtin_amdgcn_permlane32_swap(__float_as_uint(pmax), __float_as_uint(pmax), false, false); pmax = fmaxf(__uint_as_float(rr[0]), __uint_as_float(rr[1])); }
    if (__builtin_expect(__all(pmax - m_reg <= THR), 1)) { mn = m_reg; alpha = 1.f; }
    else { mn = fmaxf(m_reg, pmax); alpha = __builtin_amdgcn_exp2f(m_reg - mn); m_reg = mn; }
}
__device__ __forceinline__ void expSM(f32x16& p0, f32x16& p1, float mn) {
#pragma unroll
    for (int r = 0; r < 16; ++r) { p0[r] = __builtin_amdgcn_exp2f(p0[r] - mn); p1[r] = __builtin_amdgcn_exp2f(p1[r] - mn); }
}
__device__ __forceinline__ void finishSM(f32x16& p0, f32x16& p1, float alpha, float& l_reg, bf16x8& pa0, bf16x8& pa1, bf16x8& pa2, bf16x8& pa3) {
    float s0_ = p0[0], s1_ = p0[1], s2_ = p1[0], s3_ = p1[1];
#pragma unroll
    for (int r = 2; r < 16; r += 2) { s0_ += p0[r]; s1_ += p0[r + 1]; s2_ += p1[r]; s3_ += p1[r + 1]; }
    float ps = (s0_ + s1_) + (s2_ + s3_);
    { auto rr = __builtin_amdgcn_permlane32_swap(__float_as_uint(ps), __float_as_uint(ps), false, false); ps = __uint_as_float(rr[0]) + __uint_as_float(rr[1]); }
    l_reg = l_reg * alpha + ps;
#define DA_PK4(P, B_, OUT) do { u32x4 w = {cvtpk(P[B_+0], P[B_+1]), cvtpk(P[B_+2], P[B_+3]), cvtpk(P[B_+4], P[B_+5]), cvtpk(P[B_+6], P[B_+7])};     \
        OUT = *reinterpret_cast<bf16x8*>(&w); } while (0)
    DA_PK4(p0, 0, pa0); DA_PK4(p0, 8, pa1); DA_PK4(p1, 0, pa2); DA_PK4(p1, 8, pa3);
#undef DA_PK4
}
template <int KB>
__device__ __forceinline__ void qkt(f32x16& p0, f32x16& p1, const char* K_lds, int r32, int hi, const bf16x8* qr) {
    p0 = f32x16{}; p1 = f32x16{};
#pragma unroll
    for (int d0 = 0; d0 < 4; ++d0) { const char* a = K_lds + KB * SHM_K + DA_KSWZ(r32, (d0 * 16 + hi * 8) * 2);
        const bf16x8 b0 = *reinterpret_cast<const bf16x8*>(a), b1 = *reinterpret_cast<const bf16x8*>(a + 32 * 128);
        p0 = __builtin_amdgcn_mfma_f32_32x32x16_bf16(b0, qr[d0], p0, 0, 0, 0);
        p1 = __builtin_amdgcn_mfma_f32_32x32x16_bf16(b1, qr[d0], p1, 0, 0, 0); }
}
template <bool FILL>
__device__ __forceinline__ void pv_tile(f32x16* o, int vb0  , bf16x8 pa0, bf16x8 pa1, bf16x8 pa2, bf16x8 pa3, f32x16& px0, f32x16& px1, float mn) {
#define DA_TRRD(dst, off) asm volatile("ds_read_b64_tr_b16 %0, %1 offset:%2" : "=&v"(dst) : "v"(vb0), "i"(off) : "memory")
#define DA_RD2(m, l, h) do { constexpr int b_ = v_rd_off((m) >> 2, 0, 0) + ((m) & 3) * 4096; DA_TRRD(l, b_); DA_TRRD(h, b_ + 2048); } while (0)
#define DA_MM(m, pa, l, h) do { o[(m) >> 2] = __builtin_amdgcn_mfma_f32_32x32x16_bf16(pa, (bf16x8){l[0], l[1], l[2], l[3], h[0], h[1], h[2], h[3]}, o[(m) >> 2], 0, 0, 0); } while (0)
#define DA_LGK(n) asm volatile("s_waitcnt lgkmcnt(" #n ")" ::: "memory")
#define DA_FILL(m) do { if constexpr (FILL) { float a_ = __builtin_amdgcn_exp2f(px0[m] - mn), b_ = __builtin_amdgcn_exp2f(px1[m] - mn); asm volatile("" : "+v"(a_), "+v"(b_)); px0[m] = a_; px1[m] = b_; } } while (0)
    s16x4 l0, h0, l1, h1, l2, h2, l3, h3, l4, h4, l5, h5, l6, h6, l7, h7, l8, h8, l9, h9, l10, h10, l11, h11, l12, h12, l13, h13, l14, h14, l15, h15;
    DA_SBAR();
    DA_RD2(0, l0, h0); DA_RD2(1, l1, h1); DA_RD2(2, l2, h2); DA_RD2(3, l3, h3);
    DA_LGK(6); DA_SBAR(); DA_MM(0, pa0, l0, h0); DA_FILL(0); DA_SBAR(); DA_RD2(4, l4, h4);
    DA_LGK(6); DA_SBAR(); DA_MM(1, pa1, l1, h1); DA_FILL(1); DA_SBAR(); DA_RD2(5, l5, h5);
    DA_LGK(6); DA_SBAR(); DA_MM(2, pa2, l2, h2); DA_FILL(2); DA_SBAR(); DA_RD2(6, l6, h6);
    DA_LGK(6); DA_SBAR(); DA_MM(3, pa3, l3, h3); DA_FILL(3); DA_SBAR(); DA_RD2(7, l7, h7);
    DA_LGK(6); DA_SBAR(); DA_MM(4, pa0, l4, h4); DA_FILL(4); DA_SBAR(); DA_RD2(8, l8, h8);
    DA_LGK(6); DA_SBAR(); DA_MM(5, pa1, l5, h5); DA_FILL(5); DA_SBAR(); DA_RD2(9, l9, h9);
    DA_LGK(6); DA_SBAR(); DA_MM(6, pa2, l6, h6); DA_FILL(6); DA_SBAR(); DA_RD2(10, l10, h10);
    DA_LGK(6); DA_SBAR(); DA_MM(7, pa3, l7, h7); DA_FILL(7); DA_SBAR(); DA_RD2(11, l11, h11);
    DA_LGK(6); DA_SBAR(); DA_MM(8, pa0, l8, h8); DA_FILL(8); DA_SBAR(); DA_RD2(12, l12, h12);
    DA_LGK(6); DA_SBAR(); DA_MM(9, pa1, l9, h9); DA_FILL(9); DA_SBAR(); DA_RD2(13, l13, h13);
    DA_LGK(6); DA_SBAR(); DA_MM(10, pa2, l10, h10); DA_FILL(10); DA_SBAR(); DA_RD2(14, l14, h14);
    DA_LGK(6); DA_SBAR(); DA_MM(11, pa3, l11, h11); DA_FILL(11); DA_SBAR(); DA_RD2(15, l15, h15);
    DA_LGK(6); DA_SBAR(); DA_MM(12, pa0, l12, h12); DA_FILL(12); DA_SBAR();
    DA_LGK(4); DA_SBAR(); DA_MM(13, pa1, l13, h13); DA_FILL(13); DA_SBAR();
    DA_LGK(2); DA_SBAR(); DA_MM(14, pa2, l14, h14); DA_FILL(14); DA_SBAR();
    DA_LGK(0); DA_SBAR(); DA_MM(15, pa3, l15, h15); DA_FILL(15); DA_SBAR();
#undef DA_FILL
#undef DA_LGK
#undef DA_MM
#undef DA_RD2
#undef DA_TRRD
}
struct BlockRef { const bf16* Q; const bf16* K; const bf16* V; bf16* O; int P0; };
struct Seam { bf16x8 qr[4]; bf16x8 st_v0, st_v1, st_k0; };
#define DA_VMW() asm volatile("s_waitcnt vmcnt(0)" ::: "memory")
#define DA_VMWN(n) asm volatile("s_waitcnt vmcnt(%0)" :: "i"(n) : "memory")
#define DA_SLOAD(Kp, Vp, k0) do { S.st_v0 = load8((Vp) + (size_t)((k0) + sr) * RS + sc); S.st_v1 = load8((Vp) + (size_t)((k0) + 32 + sr) * RS + sc); S.st_k0 = load8((Kp) + (size_t)((k0) + kr) * RS + kc); } while (0)
#define DA_SWRITE_K(bf) do { *(bf16x8*)(K_lds + (bf) * SHM_K + kws) = S.st_k0; } while (0)
#define DA_SWRITE_V(bf) do { *(bf16x8*)(V_lds + (bf) * SHM_V + vst0) = S.st_v0; *(bf16x8*)(V_lds + (bf) * SHM_V + vst1) = S.st_v1; } while (0)
__device__ __forceinline__ void prime(const BlockRef& cur, char* lds, Seam& S) {
    const int tid = threadIdx.x, wid = __builtin_amdgcn_readfirstlane(tid >> 6), lane = tid & 63, r32 = lane & 31, hi = lane >> 5;
    const int sr = tid >> 4, sc = (tid & 15) * 8, kr = tid >> 3, kc = (tid & 7) * 8, kws = DA_KSWZ(kr, kc * 2); char* K_lds = lds + NVB * SHM_V;
#pragma unroll
    for (int d0 = 0; d0 < 4; ++d0) S.qr[d0] = load8(cur.Q + (size_t)(wid * QBLK + r32) * RS + d0 * 16 + hi * 8);
    DA_SLOAD(cur.K, cur.V, 0); DA_VMW(); DA_SWRITE_K(0);
    __syncthreads();
}
__device__ __forceinline__ void block(const BlockRef& cur, const BlockRef& nxt, char* lds, Seam& S) {
    const int tid = threadIdx.x, wid = __builtin_amdgcn_readfirstlane(tid >> 6), lane = tid & 63, r32 = lane & 31, hi = lane >> 5;
    const int NT = (cur.P0 + QB) / KVBLK;
    const int qlo = cur.P0 + wid * QBLK, qm = qlo + r32 - 4 * hi;
    char* V_lds = lds; char* K_lds = lds + NVB * SHM_V;
    float* ws = (float*)(lds + LDS_WS) + wid * 64; float* li_l = ws, * al_l = ws + 32;
    const __attribute__((address_space(3))) float* tab = (const __attribute__((address_space(3))) float*)((__attribute__((address_space(3))) char*)lds + LDS_TAB);
    float m_reg = -1e30f, l_reg = 0; f32x16 o[4] = {};
    const int sr = tid >> 4, sc = (tid & 15) * 8, vst0 = v_st(sr, sc), vst1 = v_st(32 + sr, sc), kr = tid >> 3, kc = (tid & 7) * 8, kws = DA_KSWZ(kr, kc * 2);
    const int vb0 = (int)(uintptr_t)V_lds + v_rd_base(lane);
    const bf16* Kh = cur.K; const bf16* Vh = cur.V;
#define DA_RESC(a) do { if (__any((a) < 1.f)) { if (hi == 0) al_l[r32] = (a); asm volatile("s_waitcnt lgkmcnt(0)" ::: "memory"); \
                     _Pragma("unroll") for (int d_ = 0; d_ < 4; ++d_) _Pragma("unroll") for (int r = 0; r < 16; ++r) o[d_][r] *= al_l[crow(r, hi)]; } } while (0)
#define DA_KBASE(t) ((t) * KVBLK)
#define DA_MASKT(P0_, P1_, t) do { const int kb_ = DA_KBASE(t); if (kb_ + KVBLK - 1 >= qlo - 127) bias_tile(P0_, P1_, qm - kb_, tab); } while (0)
    constexpr int NQL = 4;
#define DA_SEAM_K0() do { DA_VMWN(NQL); DA_SWRITE_K(0); DA_SBAR(); } while (0)
    f32x16 pA0, pA1, pB0, pB1; float mnA, mnB, alA, alB; bf16x8 pa0, pa1, pa2, pa3;
    DA_SWRITE_V(0); DA_SBAR();
    DA_SLOAD(Kh, Vh, DA_KBASE(1));
    DA_SBAR(); qkt<0>(pA0, pA1, K_lds, r32, hi, S.qr);
    DA_MASKT(pA0, pA1, 0); rowmaxSM(pA0, pA1, m_reg, mnA, alA); expSM(pA0, pA1, mnA);
    DA_VMW(); DA_SWRITE_V(1); DA_SWRITE_K(1); DA_SBAR();
    DA_SLOAD(Kh, Vh, DA_KBASE(2));
    __syncthreads();
    int vrd = 0, vwr = 2;
#define DA_NEXT3(x) ((x) == NVB - 1 ? 0 : (x) + 1)
#define DA_HALF_STEP(PX0, PX1, mnX, alX, PY0, PY1, alY, t, KB) do { \
        DA_SBAR(); qkt<KB>(PX0, PX1, K_lds, r32, hi, S.qr); \
        finishSM(PY0, PY1, alY, l_reg, pa0, pa1, pa2, pa3); DA_SBAR(); \
        DA_VMW(); DA_SWRITE_K(1 - (KB)); DA_SWRITE_V(vwr); DA_SBAR(); \
        if ((t) + 2 < NT) { DA_SLOAD(Kh, Vh, DA_KBASE((t) + 2)); DA_SBAR(); } \
        DA_MASKT(PX0, PX1, (t)); rowmaxSM(PX0, PX1, m_reg, mnX, alX); DA_SBAR(); \
        pv_tile<true>(o, vb0 + vrd * SHM_V, pa0, pa1, pa2, pa3, PX0, PX1, mnX); \
        DA_RESC(alX); __syncthreads(); vrd = DA_NEXT3(vrd); vwr = DA_NEXT3(vwr); } while (0)
    for (int t = 1; t + 1 < NT; t += 2) {
        DA_HALF_STEP(pB0, pB1, mnB, alB, pA0, pA1, alA, t, 1);
        DA_HALF_STEP(pA0, pA1, mnA, alA, pB0, pB1, alB, t + 1, 0);
    }
    DA_SBAR(); qkt<1>(pB0, pB1, K_lds, r32, hi, S.qr); DA_SBAR();
    DA_SLOAD(nxt.K, nxt.V, 0); DA_SBAR();
#pragma unroll
    for (int d0 = 0; d0 < 4; ++d0) S.qr[d0] = load8(nxt.Q + (size_t)(wid * QBLK + r32) * RS + d0 * 16 + hi * 8);
    DA_SBAR();
    finishSM(pA0, pA1, alA, l_reg, pa0, pa1, pa2, pa3); DA_SBAR();
    DA_MASKT(pB0, pB1, NT - 1); rowmaxSM(pB0, pB1, m_reg, mnB, alB); DA_SBAR();
    pv_tile<true>(o, vb0 + vrd * SHM_V, pa0, pa1, pa2, pa3, pB0, pB1, mnB); vrd = DA_NEXT3(vrd);
    DA_RESC(alB);
    finishSM(pB0, pB1, alB, l_reg, pa0, pa1, pa2, pa3); DA_SBAR(); pv_tile<false>(o, vb0 + vrd * SHM_V, pa0, pa1, pa2, pa3, pB0, pB1, 0.f);
    __syncthreads();
    DA_SBAR(); DA_SEAM_K0();
    if (hi == 0) li_l[r32] = l_reg; asm volatile("s_waitcnt lgkmcnt(0)" ::: "memory");
    bf16* Ow = cur.O + (size_t)(wid * QBLK) * RS;
    { char* stg = lds + LDS_OST + wid * OST_WAVE;
#pragma unroll
      for (int ps = 0; ps < 2; ++ps) {
#pragma unroll
          for (int r = 8 * ps; r < 8 * ps + 8; ++r) { const int orow = crow(r, hi) - 16 * ps; const float rli_r = __builtin_amdgcn_rcpf(li_l[crow(r, hi)]);
#pragma unroll
              for (int d0 = 0; d0 < 4; ++d0) { const float v = o[d0][r] * rli_r;
                  const float vn = __int_as_float(__builtin_amdgcn_update_dpp(0, __float_as_int(v), 0xB1, 0xf, 0xf, true));
                  if ((r32 & 1) == 0) *(unsigned*)(stg + orow * 256 + (d0 * 32 + r32) * 2) = cvtpk(v, vn); } }
          asm volatile("s_waitcnt lgkmcnt(0)" ::: "memory");
          u32x4 w[4];
#pragma unroll
          for (int i = 0; i < 4; ++i) { const int row = 4 * i + (lane >> 4), ch = lane & 15; w[i] = *(const u32x4*)(stg + row * 256 + ch * 16); }
          asm volatile("s_waitcnt lgkmcnt(0)" ::: "memory");
#pragma unroll
          for (int i = 0; i < 4; ++i) { const int row = 4 * i + (lane >> 4), ch = lane & 15; *(u32x4*)(Ow + (size_t)(16 * ps + row) * RS + ch * 8) = w[i]; } } }
    __syncthreads();
#undef DA_NEXT3
#undef DA_RESC
#undef DA_KBASE
#undef DA_MASKT
#undef DA_SEAM_K0
#undef DA_HALF_STEP
}
#undef DA_VMW
#undef DA_VMWN
#undef DA_SLOAD
#undef DA_SWRITE_K
#undef DA_SWRITE_V
struct Tensors { const bf16* Q; const bf16* K; const bf16* V; bf16* O1; bf16* O2; const float* biastab; };
__device__ __forceinline__ BlockRef unit_ref(const Tensors& T, int v, int i) {
    const int bhc = (v & 255) >> 1, s = v & 1, b = bhc >> 4, h = (bhc >> 1) & 7, c = bhc & 1; const int q2 = 2 * (i >> 1) + s, qb = (i & 1) ? 15 - q2 : q2;
    const size_t row0 = (size_t)b * SEQ; BlockRef r;
    r.Q = T.Q + (row0 + (size_t)qb * QB) * RS + (2 * h + c) * DK; r.K = T.K + row0 * RS + (2 * h + c) * DK; r.V = T.V + row0 * RS + h * DV;
    r.O = (c ? T.O2 : T.O1) + (row0 + (size_t)qb * QB) * RS + h * DV; r.P0 = qb * QB; return r;
}
__device__ __forceinline__ void phase(char* lds, const Tensors& T, int vcu) {
    { const int h = ((vcu & 255) >> 2) & 7, i = (int)threadIdx.x; if (i < TAB_N) ((float*)(lds + LDS_TAB))[i] = i < TAB_PADL ? -__builtin_inff() : (i < TAB_PADL + 128 ? T.biastab[h * 128 + i - TAB_PADL] : 0.f); }
    Seam S; BlockRef cur = unit_ref(T, vcu, 0);
    prime(cur, lds, S);
    if (threadIdx.x >= 256) __builtin_amdgcn_s_setprio(1);
    for (int i = 0; i < 8; ++i) { const BlockRef nxt = unit_ref(T, vcu, i + 1 < 8 ? i + 1 : i); block(cur, nxt, lds, S); cur = nxt; }
    __builtin_amdgcn_s_setprio(0);
}
#undef DA_KSWZ
#undef DA_SBAR
}
#ifndef PG8_SP2
#define PG8_SP2 true
#endif
#ifndef PG8_ALIGN
#define PG8_ALIGN true
#endif
constexpr int NWAVES = 8;
#ifndef MK_N_LAUNCHES
#define MK_N_LAUNCHES 1
#endif
constexpr int N_PHASES = 8;
constexpr int BATCH = 8, SEQ = 4096, D = 2048, M = BATCH * SEQ;
constexpr int NPROJ = 5120, DATT = 1024, DCONV = 1024, CONVW = 31;
constexpr int PH = 8, PNK = 128, PHALF = 128, PTOPK = 16, NEXP = 16384;
constexpr float LN_EPS = 1e-5f;
constexpr float DN_ALPHA = 1.189207115002721f;
constexpr float LAMBDA_INIT = 0.2f;
constexpr size_t MiB = 1u << 20;
constexpr size_t WS_WIN = 2 * MiB, WS_WOUT = 22 * MiB, WS_WQ = 30 * MiB, WS_KEYS = 38 * MiB, WS_TAB = 39 * MiB;
constexpr size_t WS_U8 = 40 * MiB, WS_V8 = 72 * MiB, WS_SU = 104 * MiB, WS_SV = 105 * MiB;
constexpr size_t WS_XB = 168 * MiB;
constexpr size_t WS_Q = 296 * MiB, WS_K = 360 * MiB, WS_V = 424 * MiB, WS_H = 488 * MiB;
constexpr size_t WS_O1 = 552 * MiB, WS_O2 = 616 * MiB;
constexpr size_t WS_Y1 = 680 * MiB;
constexpr size_t WS_QP = 808 * MiB;
constexpr size_t WS_X8 = WS_O1;
constexpr size_t WS_SX = 106 * MiB, WS_SWQ = 107 * MiB, WS_SWIN = WS_SWQ + 65536, WS_SWOUT = WS_SWQ + 131072, WS_SXA = 108 * MiB, WS_SM = 109 * MiB, WS_LNS = 110 * MiB, WS_SXQ = 111 * MiB, WS_NSU = 112 * MiB;
constexpr size_t WS_XH = WS_O2, WS_XL = WS_O2 + 32 * MiB;
constexpr size_t WS_CMAX = 16384;
constexpr size_t WS_EID = 936 * MiB, WS_GATE = 952 * MiB;
constexpr size_t WS_END = 968 * MiB;
constexpr int RING_BYTES = 131072, LDS_BYTES = 163840;

#define GAS __attribute__((address_space(1)))
#define LAS __attribute__((address_space(3)))
typedef unsigned short bf16;
typedef unsigned v4u __attribute__((ext_vector_type(4)));
typedef unsigned v2u __attribute__((ext_vector_type(2)));
typedef float f32x4 __attribute__((ext_vector_type(4)));
typedef float f32x16 __attribute__((ext_vector_type(16)));
typedef short bf16x8 __attribute__((ext_vector_type(8)));
typedef __bf16 bf16x2_t __attribute__((ext_vector_type(2)));
#define LDS_WAIT() asm volatile("s_waitcnt lgkmcnt(0)" ::: "memory")
#ifndef PROBE_SEC
#define PROBE_SEC -1
#endif
#ifndef PROBE_REP
#define PROBE_REP -1
#endif
#define SEC_REP(id) for (int sec_rep_ = 0; sec_rep_ < ((PROBE_REP == (id)) ? 2 : 1); ++sec_rep_)
#define SEC_BEGIN(id) const unsigned long long sec_t0_##id = (PROBE_SEC == (id)) ? __builtin_amdgcn_s_memrealtime() : 0ull
#define SEC_END(id) do { if (PROBE_SEC == (id)) { const unsigned long long t1_ = __builtin_amdgcn_s_memrealtime(), dt_ = t1_ - sec_t0_##id; while (__builtin_amdgcn_s_memrealtime() - t1_ < dt_) __builtin_amdgcn_s_sleep(4); } } while (0)
__device__ __forceinline__ unsigned f2bf(float f) { unsigned u = __builtin_bit_cast(unsigned, f); return (u + 0x7fffu + ((u >> 16) & 1u)) >> 16; }
__device__ __forceinline__ unsigned pk2(float lo, float hi) { return f2bf(lo) | (f2bf(hi) << 16); }
__device__ __forceinline__ float bflo(unsigned w) { return __uint_as_float(w << 16); }
__device__ __forceinline__ float bfhi(unsigned w) { return __uint_as_float(w & 0xffff0000u); }
__device__ __forceinline__ float wave_sum(float v);
__device__ __forceinline__ float wave_max(float v);
__device__ __forceinline__ float dot2bf(unsigned a, unsigned b, float acc) { return __builtin_amdgcn_fdot2_f32_bf16(__builtin_bit_cast(bf16x2_t, a), __builtin_bit_cast(bf16x2_t, b), acc, false); }

#define XB_TMO      128
#define XB_XCNT(j)  (256  + 64 * (j))
#define XB_XSUB(j)  (1280 + 64 * (j))
#define XB_XGEN(j)  (2304 + 64 * (j))
#define XB_TOP      3328
#define XB_TOPGEN   3392
#define XCD_BAR_WORDS 3456
#define XB_SPIN_CAP (1u << 18)

__device__ __forceinline__ unsigned xb_ld(unsigned* p)              { return __hip_atomic_load(p, __ATOMIC_RELAXED, __HIP_MEMORY_SCOPE_AGENT); }
__device__ __forceinline__ unsigned xb_add(unsigned* p, unsigned v) { return __hip_atomic_fetch_add(p, v, __ATOMIC_RELAXED, __HIP_MEMORY_SCOPE_AGENT); }
__device__ __forceinline__ unsigned xb_xcc_id() { return (unsigned)__builtin_amdgcn_s_getreg((3 << 11) | 20) & 0xFu; }
#define XB_SPIN(cond, bar) do { unsigned _sp = 0; while (cond) { __builtin_amdgcn_s_sleep(1); \
    if ((++_sp & 255u) == 0u) { if (xb_ld(&(bar)[XB_TMO])) break; if (_sp > XB_SPIN_CAP) { atomicAdd(&(bar)[XB_TMO], 1u); break; } } } } while (0)

struct XcdBarrier {
    unsigned* bar; unsigned x;
    volatile LAS unsigned* st;
};

__device__ __forceinline__ XcdBarrier xcd_barrier_post(unsigned* bar, volatile LAS unsigned* st) {
    XcdBarrier b; b.bar = bar; b.x = xb_xcc_id(); b.st = st;
    if (threadIdx.x == 0) (void)xb_add(&bar[XB_XCNT(b.x)], 1u);
    return b;
}
__device__ __forceinline__ void xcd_barrier_complete(unsigned* bar, unsigned x, unsigned& nloc, unsigned& nx) {
    const unsigned G = gridDim.x * gridDim.y * gridDim.z;
    unsigned sum, cnt, mine, sp = 0u;
    for (;;) {
        sum = 0u; cnt = 0u; mine = 0u;
#pragma unroll
        for (unsigned j = 0; j < 16; ++j) { const unsigned c = xb_ld(&bar[XB_XCNT(j)]); sum += c; cnt += (c > 0u) ? 1u : 0u; mine = (j == x) ? c : mine; }
        if (sum == G) break;
        __builtin_amdgcn_s_sleep(1);
        if ((++sp & 255u) == 0u) { if (xb_ld(&bar[XB_TMO])) break; if (sp > XB_SPIN_CAP) { atomicAdd(&bar[XB_TMO], 1u); break; } }
    }
    nloc = mine > 0u ? mine : 1u; nx = cnt > 0u ? cnt : 1u;
}

__device__ __forceinline__ void xcd_barrier(const XcdBarrier& b) {
    asm volatile("s_waitcnt vmcnt(0)" ::: "memory");
    __syncthreads();
    if (threadIdx.x == 0) {
        unsigned* bar = b.bar;
        __builtin_amdgcn_s_waitcnt(0);
        unsigned nloc = b.st[0], nx = b.st[1];
        if (nloc == 0u) { xcd_barrier_complete(bar, b.x, nloc, nx); b.st[0] = nloc; b.st[1] = nx; }
        const unsigned old = xb_add(&bar[XB_XSUB(b.x)], 1u);
        const unsigned gen = old / nloc;
        if (old + 1u == (gen + 1u) * nloc) {
            __builtin_amdgcn_fence(__ATOMIC_RELEASE, "agent");
            asm volatile("s_waitcnt vmcnt(0)" ::: "memory");
            const unsigned og = xb_add(&bar[XB_TOP], 1u);
            const unsigned tg = og / nx;
            if (og + 1u == (tg + 1u) * nx) xb_add(&bar[XB_TOPGEN], 1u);
            else XB_SPIN(xb_ld(&bar[XB_TOPGEN]) == tg, bar);
            __builtin_amdgcn_fence(__ATOMIC_ACQUIRE, "agent");
            xb_add(&bar[XB_XGEN(b.x)], 1u);
            asm volatile("s_waitcnt vmcnt(0)" ::: "memory");
        } else {
            XB_SPIN(xb_ld(&bar[XB_XGEN(b.x)]) == gen, bar);
            __builtin_amdgcn_fence(__ATOMIC_ACQUIRE, "agent");
            asm volatile("s_waitcnt vmcnt(0)" ::: "memory");
        }
    }
    __syncthreads();
}

struct Frame {
    LAS unsigned char* lds;
    __device__ __forceinline__ int wave_() const { int w = __builtin_amdgcn_readfirstlane((int)threadIdx.x >> 6); asm volatile("" : "+s"(w)); return w; }
    __device__ __forceinline__ int G_() const { int g = (int)gridDim.x; asm volatile("" : "+s"(g)); return g; }
    __device__ __forceinline__ int vcu_() const { int bx = (int)blockIdx.x; asm volatile("" : "+s"(bx)); const int g = G_(); return (g % 8 == 0) ? (bx % 8) * (g / 8) + bx / 8 : bx; }
    __device__ __forceinline__ int tid() const { int t = (int)threadIdx.x; asm volatile("" : "+v"(t)); return t; }
    __device__ __forceinline__ int lane() const { return tid() & 63; }
    __device__ __forceinline__ unsigned long long raw(int k) const { const volatile LAS unsigned* p = (const volatile LAS unsigned*)(lds + RING_BYTES) + 2 * k;
        const unsigned lo = __builtin_amdgcn_readfirstlane(p[0]), hi = __builtin_amdgcn_readfirstlane(p[1]); return ((unsigned long long)hi << 32) | lo; }
    __device__ __forceinline__ const float* in(int k) const { return (const float*)(const GAS float*)raw(k); }
    __device__ __forceinline__ float* outp() const { return (float*)(GAS float*)raw(22); }
    template <class T> __device__ __forceinline__ T* ws(size_t off) const { return (T*)(GAS T*)((GAS unsigned char*)raw(23) + off); }
};
enum { I_X = 0, I_WIN, I_BGLU, I_CONVW, I_CONVB, I_CLNG, I_CLNB, I_LQ1, I_LK1, I_LQ2, I_LK2, I_SUBLN, I_RELB, I_WOUT, I_LN1G, I_LN1B, I_WQ, I_KEYS, I_U, I_V, I_LN2G, I_LN2B };

template <int CTRL> __device__ __forceinline__ int dppi(int v) { return __builtin_amdgcn_update_dpp(0, v, CTRL, 0xf, 0xf, true); }
template <int CTRL> __device__ __forceinline__ float dppf(float v) { return __int_as_float(__builtin_amdgcn_update_dpp(0, __float_as_int(v), CTRL, 0xf, 0xf, true)); }
__device__ __forceinline__ unsigned pack_i8x4(float a, float b, float c, float d) {
    const int ia = (int)rintf(a), ib = (int)rintf(b), ic = (int)rintf(c), id = (int)rintf(d); return (unsigned)(ia & 255) | ((unsigned)(ib & 255) << 8) | ((unsigned)(ic & 255) << 16) | ((unsigned)id << 24); }
__device__ __forceinline__ void p0_colmax_item(const float* W, int N, unsigned* cmax, int k0, int n0, int dst0, int lane) {
    f32x4 am = {0.f, 0.f, 0.f, 0.f};
#pragma unroll
    for (int i = 0; i < 8; ++i) { const f32x4 v = *(const GAS f32x4*)(W + (size_t)(k0 + 8 * i + (lane >> 3)) * N + n0 + 4 * (lane & 7));
        am[0] = fmaxf(am[0], fabsf(v[0])); am[1] = fmaxf(am[1], fabsf(v[1])); am[2] = fmaxf(am[2], fabsf(v[2])); am[3] = fmaxf(am[3], fabsf(v[3])); }
#pragma unroll
    for (int e = 0; e < 4; ++e) { am[e] = fmaxf(am[e], __shfl_xor(am[e], 8)); am[e] = fmaxf(am[e], __shfl_xor(am[e], 16)); am[e] = fmaxf(am[e], __shfl_xor(am[e], 32)); }
    if (lane < 8) {
#pragma unroll
        for (int e = 0; e < 4; ++e) atomicMax(cmax + dst0 + 4 * lane + e, __float_as_uint(am[e])); }
}
__device__ __forceinline__ void p0_quant_item(const float* W, int N, unsigned char* WT8, const unsigned* cmax, float* scale, int k0, int n0, int dst0, LAS float* scr, int lane) {
#pragma unroll
    for (int i = 0; i < 8; ++i) { const int kk = 8 * i + (lane >> 3); const f32x4 v = *(const GAS f32x4*)(W + (size_t)(k0 + kk) * N + n0 + 4 * (lane & 7));
        LAS float* d = scr + kk * 33 + 4 * (lane & 7); d[0] = v[0]; d[1] = v[1]; d[2] = v[2]; d[3] = v[3]; }
    if (lane < 32) { const float am = __uint_as_float(__hip_atomic_load(cmax + dst0 + lane, __ATOMIC_RELAXED, __HIP_MEMORY_SCOPE_AGENT)); const float sc = am > 0.f ? am * (1.f / 127.f) : 1.f;
        scr[64 * 33 + lane] = 1.f / sc; if (k0 == 0) scale[dst0 + lane] = sc; }
    LDS_WAIT(); asm volatile("" ::: "memory");
    const int c = lane & 7;
#pragma unroll
    for (int j = 0; j < 4; ++j) { const int n = (lane >> 3) + 8 * j; const LAS float* sp = scr + (8 * c) * 33 + n; const float inv = scr[64 * 33 + n];
        *(GAS v2u*)(WT8 + (size_t)(dst0 + n) * D + k0 + 8 * c) = (v2u){pack_i8x4(sp[0 * 33] * inv, sp[1 * 33] * inv, sp[2 * 33] * inv, sp[3 * 33] * inv), pack_i8x4(sp[4 * 33] * inv, sp[5 * 33] * inv, sp[6 * 33] * inv, sp[7 * 33] * inv)}; }
    LDS_WAIT(); asm volatile("" ::: "memory");
}
__device__ __forceinline__ int glu_dst(int n0) {
    if (n0 < 3072) return n0;
    const int ch = (n0 - 3072) & 1023, gate = (n0 - 3072) >> 10; return 3072 + 256 * (ch >> 7) + 64 * ((ch & 127) >> 5) + 32 * gate + (ch & 31);
}
__device__ __forceinline__ void p0_quant_x(const float* src, unsigned char* dst8, float* scale, int rows, int gw, int NGW, int lane) {
    f32x4 nx[8], nx2[8];
    if (gw < rows) { const GAS f32x4* sp = (const GAS f32x4*)(src + (size_t)gw * D) + lane; const int r1 = (gw + NGW < rows) ? gw + NGW : gw; const GAS f32x4* sq = (const GAS f32x4*)(src + (size_t)r1 * D) + lane;
#pragma unroll
        for (int j = 0; j < 8; ++j) { nx[j] = sp[64 * j]; nx2[j] = sq[64 * j]; } }
    for (int r = gw; r < rows; r += NGW) {
        f32x4 v[8]; float am = 0.f;
#pragma unroll
        for (int j = 0; j < 8; ++j) { v[j] = nx[j]; nx[j] = nx2[j]; }
        { const int rn = (r + 2 * NGW < rows) ? r + 2 * NGW : r; const GAS f32x4* sp = (const GAS f32x4*)(src + (size_t)rn * D) + lane;
#pragma unroll
          for (int j = 0; j < 8; ++j) nx2[j] = sp[64 * j]; }
#pragma unroll
        for (int j = 0; j < 8; ++j) am = fmaxf(fmaxf(am, fmaxf(fabsf(v[j].x), fabsf(v[j].y))), fmaxf(fabsf(v[j].z), fabsf(v[j].w)));
        am = wave_max(am);
        const float sc = am > 0.f ? am * (1.f / 127.f) : 1.f, inv = 1.f / sc;
        GAS unsigned* dp = (GAS unsigned*)(dst8 + (size_t)r * D) + lane;
#pragma unroll
        for (int j = 0; j < 8; ++j) dp[64 * j] = pack_i8x4(v[j].x * inv, v[j].y * inv, v[j].z * inv, v[j].w * inv);
        if (lane == 0) scale[r] = sc;
    }
}
__device__ __forceinline__ void p0_convert(const float* src, bf16* dst, size_t n, int gw, int NGW, int lane) {
    const size_t nit = n / 512;
    for (size_t it = gw; it < nit; it += NGW) { const GAS f32x4* s = (const GAS f32x4*)(src + it * 512) + 2 * lane; const f32x4 a = s[0], b = s[1];
        v4u o; o.x = pk2(a.x, a.y); o.y = pk2(a.z, a.w); o.z = pk2(b.x, b.y); o.w = pk2(b.z, b.w); *((GAS v4u*)(dst + it * 512) + lane) = o; }
}
template <bool INT8> __device__ __forceinline__ void p0_quant_rows(const float* src, unsigned* dst8, float* scale, int rows, int gw, int NGW, int lane) {
    f32x4 nx[8], nx2[8];
    if (gw < rows) { const GAS f32x4* sp = (const GAS f32x4*)(src + (size_t)gw * D) + lane; const int r1 = (gw + NGW < rows) ? gw + NGW : gw; const GAS f32x4* sq = (const GAS f32x4*)(src + (size_t)r1 * D) + lane;
#pragma unroll
        for (int j = 0; j < 8; ++j) { nx[j] = sp[64 * j]; nx2[j] = sq[64 * j]; } }
    for (int r = gw; r < rows; r += NGW) {
        f32x4 v[8]; float am = 0.f;
#pragma unroll
        for (int j = 0; j < 8; ++j) { v[j] = nx[j]; nx[j] = nx2[j]; }
        { const int rn = (r + 2 * NGW < rows) ? r + 2 * NGW : r; const GAS f32x4* sp = (const GAS f32x4*)(src + (size_t)rn * D) + lane;
#pragma unroll
          for (int j = 0; j < 8; ++j) nx2[j] = sp[64 * j]; }
#pragma unroll
        for (int j = 0; j < 8; ++j) am = fmaxf(fmaxf(am, fmaxf(fabsf(v[j].x), fabsf(v[j].y))), fmaxf(fabsf(v[j].z), fabsf(v[j].w)));
        am = wave_max(am);
        const float sc = am > 0.f ? am * (INT8 ? (1.f / 127.f) : (1.f / 440.f)) : 1.f, inv = 1.f / sc;
#pragma unroll
        for (int j = 0; j < 8; ++j) { int w;
            if (INT8) w = (int)pack_i8x4(v[j].x * inv, v[j].y * inv, v[j].z * inv, v[j].w * inv);
            else { w = __builtin_amdgcn_cvt_pk_fp8_f32(v[j].x * inv, v[j].y * inv, 0, false); w = __builtin_amdgcn_cvt_pk_fp8_f32(v[j].z * inv, v[j].w * inv, w, true); }
            const int wi = lane + 64 * j, c = wi >> 5; *((GAS unsigned*)dst8 + ((size_t)c * rows + r) * 32 + (wi & 31)) = (unsigned)w; }
        if (lane == 0) scale[r] = sc;
    }
}
template <bool HI2C  > __device__ __forceinline__ void p0_quant_u4(const float* src, unsigned* dst4, float* scale, float* nsum  , int rows, int gw, int NGW, int lane) {
    f32x4 nx[8], nx2[8];
    if (gw < rows) { const GAS f32x4* sp = (const GAS f32x4*)(src + (size_t)gw * D) + lane; const int r1 = (gw + NGW < rows) ? gw + NGW : gw; const GAS f32x4* sq = (const GAS f32x4*)(src + (size_t)r1 * D) + lane;
#pragma unroll
        for (int j = 0; j < 8; ++j) { nx[j] = sp[64 * j]; nx2[j] = sq[64 * j]; } }
    for (int r = gw; r < rows; r += NGW) {
        f32x4 v[8]; float ss = 0.f;
#pragma unroll
        for (int j = 0; j < 8; ++j) { v[j] = nx[j]; nx[j] = nx2[j]; }
        { const int rn = (r + 2 * NGW < rows) ? r + 2 * NGW : r; const GAS f32x4* sp = (const GAS f32x4*)(src + (size_t)rn * D) + lane;
#pragma unroll
          for (int j = 0; j < 8; ++j) nx2[j] = sp[64 * j]; }
#pragma unroll
        for (int j = 0; j < 8; ++j) ss += (v[j].x * v[j].x + v[j].y * v[j].y) + (v[j].z * v[j].z + v[j].w * v[j].w);
        ss = wave_sum(ss);
        const float sc = ss > 0.f ? 0.35f * sqrtf(ss * (1.f / D)) : 1.f, inv = 1.f / sc;
        int nsl = 0;
#pragma unroll
        for (int j = 0; j < 8; ++j) { unsigned own = 0, snd = 0;
#pragma unroll
            for (int e = 0; e < 4; ++e) { const int q = (int)fminf(fmaxf(rintf(v[j][e] * inv), -8.f), 7.f); own |= (unsigned)(q + 8) << (8 * e); snd |= (unsigned)(HI2C ? (q & 15) : (q + 8)) << (8 * e); nsl += q + 8; }
            const unsigned nbr = (unsigned)dppi<0xB1>((int)snd);
            if ((lane & 1) == 0) *((GAS unsigned*)dst4 + ((size_t)j * rows + r) * 32 + (lane >> 1)) = own | (nbr << 4); }
        if (nsum) { const float ns = wave_sum((float)nsl); if (lane == 0) nsum[r] = ns; }
        if (lane == 0) scale[r] = sc;
    }
}
__device__ __forceinline__ int t5_bucket(int d) {
    if (d < 16) return d;
    int l = 16 + (int)(logf((float)d / 16.f) / logf(8.f) * 16.f); return l < 31 ? l : 31;
}
__device__ __forceinline__ void p0a_prologue(Frame& F) {
    LAS float* scr = (LAS float*)(F.lds + F.wave_() * 16384);
    constexpr int I_IN = (D / 64) * (NPROJ / 32), I_OUT = (D / 64) * (D / 32);
    { const float* w_in = F.in(I_WIN); unsigned* cmax = F.ws<unsigned>(WS_CMAX); const int gw = F.vcu_() * NWAVES + F.wave_(), NGW = F.G_() * NWAVES;
      for (int r = gw; r < I_IN; r += NGW) { const int nblk = NPROJ / 32, kb = r / nblk, nb = r % nblk; p0_colmax_item(w_in, NPROJ, cmax, 64 * kb, 32 * nb, glu_dst(32 * nb), F.lane()); } }
    { const float* wq = F.in(I_WQ); unsigned* cmax = F.ws<unsigned>(WS_CMAX) + NPROJ; const int gw = F.vcu_() * NWAVES + F.wave_(), NGW = F.G_() * NWAVES;
      for (int r = gw; r < I_OUT; r += NGW) { const int nblk = D / 32, kb = r / nblk, nb = r % nblk; p0_colmax_item(wq, D, cmax, 64 * kb, 32 * nb, 32 * nb, F.lane()); } }
    { const float* wo = F.in(I_WOUT); unsigned* cmax = F.ws<unsigned>(WS_CMAX) + NPROJ + D; const int gw = F.vcu_() * NWAVES + F.wave_(), NGW = F.G_() * NWAVES;
      for (int r = gw; r < I_OUT; r += NGW) { const int nblk = D / 32, kb = r / nblk, nb = r % nblk; p0_colmax_item(wo, D, cmax, 64 * kb, 32 * nb, 32 * nb, F.lane()); } }
}
__device__ __forceinline__ void p0b_prologue(Frame& F) {
    LAS float* scr = (LAS float*)(F.lds + F.wave_() * 16384);
    constexpr int I_IN = (D / 64) * (NPROJ / 32), I_OUT = (D / 64) * (D / 32);
    { const float* w_in = F.in(I_WIN); unsigned char* W8 = F.ws<unsigned char>(WS_WIN); const unsigned* cmax = F.ws<unsigned>(WS_CMAX); float* sw = F.ws<float>(WS_SWIN); const int gw = F.vcu_() * NWAVES + F.wave_(), NGW = F.G_() * NWAVES;
      for (int r = gw; r < I_IN; r += NGW) { const int nblk = NPROJ / 32, kb = r / nblk, nb = r % nblk; p0_quant_item(w_in, NPROJ, W8, cmax, sw, 64 * kb, 32 * nb, glu_dst(32 * nb), scr, F.lane()); } }
    { const float* wq = F.in(I_WQ); unsigned char* W8 = F.ws<unsigned char>(WS_WQ); const unsigned* cmax = F.ws<unsigned>(WS_CMAX) + NPROJ; float* sw = F.ws<float>(WS_SWQ); const int gw = F.vcu_() * NWAVES + F.wave_(), NGW = F.G_() * NWAVES;
      for (int r = gw; r < I_OUT; r += NGW) { const int nblk = D / 32, kb = r / nblk, nb = r % nblk; p0_quant_item(wq, D, W8, cmax, sw, 64 * kb, 32 * nb, 32 * nb, scr, F.lane()); } }
    { const float* wo = F.in(I_WOUT); unsigned char* W8 = F.ws<unsigned char>(WS_WOUT); const unsigned* cmax = F.ws<unsigned>(WS_CMAX) + NPROJ + D; float* sw = F.ws<float>(WS_SWOUT); const int gw = F.vcu_() * NWAVES + F.wave_(), NGW = F.G_() * NWAVES;
      for (int r = gw; r < I_OUT; r += NGW) { const int nblk = D / 32, kb = r / nblk, nb = r % nblk; p0_quant_item(wo, D, W8, cmax, sw, 64 * kb, 32 * nb, 32 * nb, scr, F.lane()); } }
    { const int gw = F.vcu_() * NWAVES + F.wave_(), NGW = F.G_() * NWAVES; p0_quant_x(F.in(I_X), F.ws<unsigned char>(WS_XB), F.ws<float>(WS_SXA), M, gw, NGW, F.lane()); }
    { const int gw = F.vcu_() * NWAVES + F.wave_(), NGW = F.G_() * NWAVES; p0_quant_u4<false>(F.in(I_U), F.ws<unsigned>(WS_U8), F.ws<float>(WS_SU), F.ws<float>(WS_NSU), NEXP, gw, NGW, F.lane()); }
    { const int gw = F.vcu_() * NWAVES + F.wave_(), NGW = F.G_() * NWAVES; p0_quant_u4<true>(F.in(I_V), F.ws<unsigned>(WS_V8), F.ws<float>(WS_SV), nullptr, NEXP, gw, NGW, F.lane()); }
    { const int gw = F.vcu_() * NWAVES + F.wave_(), NGW = F.G_() * NWAVES; p0_convert(F.in(I_KEYS), F.ws<bf16>(WS_KEYS), (size_t)PH * 2 * PNK * PHALF, gw, NGW, F.lane()); }
    if (blockIdx.x == 0) { const float* rel_bias = F.in(I_RELB); float* TAB = F.ws<float>(WS_TAB);
        for (int i = F.tid(); i < 8 * 128; i += NWAVES * 64) { const int h = i >> 7, d = i & 127;
            TAB[i] = (rel_bias[t5_bucket(d) * 8 + h] - rel_bias[31 * 8 + h]) * 1.4426950408889634f; } }
}

__device__ __forceinline__ float diff_lambda(Frame& F) {
    const float a = wave_sum(F.in(I_LQ1)[F.lane()] * F.in(I_LK1)[F.lane()]), b = wave_sum(F.in(I_LQ2)[F.lane()] * F.in(I_LK2)[F.lane()]);
    return expf(a) - expf(b) + LAMBDA_INIT;
}
template <int CTRL, int RM> __device__ __forceinline__ float dpp_rm(float old, float v) { return __int_as_float(__builtin_amdgcn_update_dpp(__float_as_int(old), __float_as_int(v), CTRL, RM, 0xf, false)); }
__device__ __forceinline__ float wave_sum63(float v) {
    v += dppf<0xB1>(v); v += dppf<0x4E>(v); v += dppf<0x141>(v); v += dppf<0x140>(v);
    v += dpp_rm<0x142, 0xa>(0.f, v);
    v += dpp_rm<0x143, 0xc>(0.f, v);
    return v;
}
__device__ __forceinline__ float wave_max63(float v) {
    v = fmaxf(v, dppf<0xB1>(v)); v = fmaxf(v, dppf<0x4E>(v)); v = fmaxf(v, dppf<0x141>(v)); v = fmaxf(v, dppf<0x140>(v));
    v = fmaxf(v, dpp_rm<0x142, 0xa>(0.f, v)); v = fmaxf(v, dpp_rm<0x143, 0xc>(0.f, v));
    return v;
}
__device__ __forceinline__ float wave_sum(float v) { return __int_as_float(__builtin_amdgcn_readlane(__float_as_int(wave_sum63(v)), 63)); }
__device__ __forceinline__ float wave_max(float v) { return __int_as_float(__builtin_amdgcn_readlane(__float_as_int(wave_max63(v)), 63)); }
typedef _Float16 h2_t __attribute__((ext_vector_type(2)));
__device__ __forceinline__ h2_t pin_h2(float a, float b) { unsigned u = __builtin_bit_cast(unsigned, (h2_t){(_Float16)a, (_Float16)b}); asm volatile("" : "+v"(u)); return __builtin_bit_cast(h2_t, u); }
__device__ __forceinline__ float xr_swap32(float a, float b, bool mx) { auto rr = __builtin_amdgcn_permlane32_swap(__float_as_uint(a), __float_as_uint(b), false, false); const float x = __uint_as_float(rr[0]), y = __uint_as_float(rr[1]); return mx ? fmaxf(x, y) : x + y; }
__device__ __forceinline__ float xr_swap16(float a, float b, bool mx) { auto rr = __builtin_amdgcn_permlane16_swap(__float_as_uint(a), __float_as_uint(b), false, false); const float x = __uint_as_float(rr[0]), y = __uint_as_float(rr[1]); return mx ? fmaxf(x, y) : x + y; }
template <int CTRL> __device__ __forceinline__ float xr_dpp(float lo, float hi, bool t, bool mx) { const float k = t ? hi : lo, s = t ? lo : hi, o = dppf<CTRL>(s); return mx ? fmaxf(k, o) : k + o; }
__device__ __forceinline__ float xred64_sum(const float (&v)[64], int lane) {
    float a[32], b[16], c[8], d[4], e[2];
#pragma unroll
    for (int i = 0; i < 32; ++i) a[i] = xr_swap32(v[i], v[i + 32], false);
#pragma unroll
    for (int i = 0; i < 16; ++i) b[i] = xr_swap16(a[i], a[i + 16], false);
#pragma unroll
    for (int i = 0; i < 8; ++i) c[i] = xr_dpp<0x128>(b[i], b[i + 8], lane & 8, false);
#pragma unroll
    for (int i = 0; i < 4; ++i) d[i] = xr_dpp<0x141>(c[i], c[i + 4], lane & 4, false);
#pragma unroll
    for (int i = 0; i < 2; ++i) e[i] = xr_dpp<0x4E>(d[i], d[i + 2], lane & 2, false);
    return xr_dpp<0xB1>(e[0], e[1], lane & 1, false);
}
__device__ __forceinline__ float xred32_max(const float (&v)[32], int lane) {
    float a[16], b[8], c[4], d[2];
#pragma unroll
    for (int i = 0; i < 16; ++i) a[i] = xr_swap32(v[i], v[i + 16], true);
#pragma unroll
    for (int i = 0; i < 8; ++i) b[i] = xr_swap16(a[i], a[i + 8], true);
#pragma unroll
    for (int i = 0; i < 4; ++i) c[i] = xr_dpp<0x128>(b[i], b[i + 4], lane & 8, true);
#pragma unroll
    for (int i = 0; i < 2; ++i) d[i] = xr_dpp<0x141>(c[i], c[i + 2], lane & 4, true);
    const float e = xr_dpp<0x4E>(d[0], d[1], lane & 2, true);
    return fmaxf(e, dppf<0xB1>(e));
}
#ifndef P3_PROBE_MULT
#define P3_PROBE_MULT 1
#endif
__device__ __forceinline__ void p3_mix(Frame& F) {
    constexpr int TT = 32, NH = TT + CONVW - 1, STG_OFF = 0, STATS_OFF = TT * 1024, AMC_OFF = STATS_OFF + NWAVES * 64 * 4, AMA_OFF = AMC_OFF + TT * NWAVES * 4, MS_OFF = AMA_OFF + 128, INV_OFF = MS_OFF + 256, AVP_OFF = 40960;
    static_assert(INV_OFF + 128 <= AVP_OFF && AVP_OFF + 8 * NWAVES * 64 * 16 <= RING_BYTES && NH == 62, "P3 LDS map");
    const int tid = F.tid(), lane = tid & 63, wave = F.wave_();
    const float lam = diff_lambda(F);
    const float* conv_w = F.in(I_CONVW); const unsigned* H = F.ws<unsigned>(WS_H); const bf16* O1 = F.ws<bf16>(WS_O1); const bf16* O2 = F.ws<bf16>(WS_O2);
    unsigned char* MIX8 = F.ws<unsigned char>(WS_XB); float* SM = F.ws<float>(WS_SM); const float* subln_g = F.in(I_SUBLN);
    const float2 cb = *(const float2*)(F.in(I_CONVB) + 2 * tid), lg = *(const float2*)(F.in(I_CLNG) + 2 * tid), lb = *(const float2*)(F.in(I_CLNB) + 2 * tid);
    LAS float* stats = (LAS float*)(F.lds + STATS_OFF); LAS float* amc = (LAS float*)(F.lds + AMC_OFF); LAS float* ama = (LAS float*)(F.lds + AMA_OFF); LAS float* ms = (LAS float*)(F.lds + MS_OFF); LAS float* invs = (LAS float*)(F.lds + INV_OFF);
    h2_t wk[CONVW];
#pragma unroll
    for (int k = 0; k < CONVW; ++k) { const float2 wf = *(const float2*)(conv_w + k * DCONV + 2 * tid); wk[k] = pin_h2(wf.x, wf.y); }
    const h2_t cbh = pin_h2(cb.x, cb.y);
    unsigned hv[NH];
#define P3_LOAD_H(tile_) do { const int t0_ = (tile_) * TT; const GAS unsigned* hp_ = (const GAS unsigned*)H + (size_t)t0_ * (DCONV / 2) + tid;     \
        _Pragma("unroll") for (int j = 0; j < NH; ++j) hv[j] = *(hp_ + (ptrdiff_t)(j - (CONVW - 1)) * (DCONV / 2)); } while (0)
    { const int ft = F.vcu_() < M / TT ? F.vcu_() : 0; P3_LOAD_H(ft); }
    for (int tile_j = F.vcu_(); tile_j < P3_PROBE_MULT * (M / TT); tile_j += F.G_()) { const int tile_i = tile_j & (M / TT - 1);
        const int t0 = tile_i * TT;
        const int tid = F.tid(), lane = tid & 63;
        v4u oa[4][2], ob[4][2];
#pragma unroll
        for (int rr = 0; rr < 4; ++rr) { const int m = t0 + 4 * wave + rr;
            const GAS char* p1 = (const GAS char*)(O1 + (size_t)m * 1024); const GAS char* p2 = (const GAS char*)(O2 + (size_t)m * 1024); const unsigned lo_ = (unsigned)lane * 32u;
            oa[rr][0] = *(const GAS v4u*)(p1 + lo_); oa[rr][1] = *(const GAS v4u*)(p1 + lo_ + 16); ob[rr][0] = *(const GAS v4u*)(p2 + lo_); ob[rr][1] = *(const GAS v4u*)(p2 + lo_ + 16); }
        __builtin_amdgcn_sched_barrier(0);
        h2_t cv[TT];
        { const unsigned zm = (t0 & (SEQ - 1)) != 0 ? 0xffffffffu : 0u;
#pragma unroll
          for (int j = 0; j < CONVW - 1; ++j) hv[j] &= zm; }
#pragma unroll
        for (int t = 0; t < TT; ++t) { h2_t acc = cbh;
#pragma unroll
            for (int k = 0; k < CONVW; ++k) acc = __builtin_elementwise_fma(__builtin_bit_cast(h2_t, hv[t + k]), wk[k], acc);
            { unsigned u_ = __builtin_bit_cast(unsigned, acc); asm volatile("" : "+v"(u_)); cv[t] = __builtin_bit_cast(h2_t, u_); } }
        __builtin_amdgcn_sched_barrier(0);
#pragma unroll
        for (int rr = 0; rr < 4; ++rr) { float av[16]; h2_t avp[8];
            const v4u a0 = oa[rr][0], a1 = oa[rr][1], b0 = ob[rr][0], b1 = ob[rr][1];
            const unsigned aw[8] = {a0.x, a0.y, a0.z, a0.w, a1.x, a1.y, a1.z, a1.w}, bw[8] = {b0.x, b0.y, b0.z, b0.w, b1.x, b1.y, b1.z, b1.w};
            float ss = 0.f;
#pragma unroll
            for (int i = 0; i < 8; ++i) { av[2 * i] = bflo(aw[i]) - lam * bflo(bw[i]); av[2 * i + 1] = bfhi(aw[i]) - lam * bfhi(bw[i]); ss += av[2 * i] * av[2 * i] + av[2 * i + 1] * av[2 * i + 1]; }
            ss += dppf<0xB1>(ss); ss += dppf<0x4E>(ss); ss += dppf<0x141>(ss);
            const float r = (1.f - LAMBDA_INIT) / sqrtf(ss * (1.f / 128.f) + LN_EPS); float am = 0.f;
#pragma unroll
            for (int e = 0; e < 8; ++e) { avp[e] = pin_h2(av[2 * e] * r * subln_g[16 * (lane & 7) + 2 * e], av[2 * e + 1] * r * subln_g[16 * (lane & 7) + 2 * e + 1]);
                am = fmaxf(am, fmaxf(fabsf((float)avp[e].x), fabsf((float)avp[e].y))); }
            am = wave_max63(am);
            if (lane == 63) ama[4 * wave + rr] = am;
#pragma unroll
            for (int hh = 0; hh < 2; ++hh) *(LAS v4u*)(F.lds + AVP_OFF + ((rr * 2 + hh) * (NWAVES * 64) + tid) * 16) = (v4u){__builtin_bit_cast(unsigned, avp[4 * hh]), __builtin_bit_cast(unsigned, avp[4 * hh + 1]), __builtin_bit_cast(unsigned, avp[4 * hh + 2]), __builtin_bit_cast(unsigned, avp[4 * hh + 3])}; }
        { float sv[64];
#pragma unroll
          for (int t = 0; t < TT; ++t) { const float y0 = (float)cv[t].x, y1 = (float)cv[t].y; sv[2 * t] = y0 + y1; sv[2 * t + 1] = y0 * y0 + y1 * y1; }
          stats[wave * 64 + lane] = xred64_sum(sv, lane); }
        __builtin_amdgcn_sched_barrier(0);
        { const int nx_ = tile_j + F.G_(), nxt = nx_ < P3_PROBE_MULT * (M / TT) ? (nx_ & (M / TT - 1)) : tile_i; P3_LOAD_H(nxt); }
        __syncthreads();
        if (tid < TT) { float s = 0.f, q = 0.f;
#pragma unroll
            for (int w = 0; w < NWAVES; ++w) { s += stats[w * 64 + 2 * tid]; q += stats[w * 64 + 2 * tid + 1]; }
            const float mean = s * (1.f / DCONV), var = fmaxf(q * (1.f / DCONV) - mean * mean, 0.f); ms[2 * tid] = mean; ms[2 * tid + 1] = 1.f / sqrtf(var + LN_EPS); }
        __syncthreads();
        {
            float mv[TT];
#pragma unroll
            for (int q = 0; q < TT / 2; ++q) { const f32x4 st = *(const LAS f32x4*)(ms + 4 * q);
#pragma unroll
                for (int o = 0; o < 2; ++o) { const int t = 2 * q + o; const float mean = st[2 * o], rstd = st[2 * o + 1];
                    const float y0 = ((float)cv[t].x - mean) * rstd * lg.x + lb.x, y1 = ((float)cv[t].y - mean) * rstd * lg.y + lb.y;
#define SWISH_(y) ((y) * __builtin_amdgcn_rcpf(1.f + __builtin_amdgcn_exp2f(-1.4426950409f * (y))))
                    cv[t] = pin_h2(SWISH_(y0), SWISH_(y1));
#undef SWISH_
                    mv[t] = fmaxf(fabsf((float)cv[t].x), fabsf((float)cv[t].y)); } }
            const float amx = xred32_max(mv, lane);
            if ((lane & 1) == 0) amc[(lane >> 1) * NWAVES + wave] = amx; }
        __syncthreads();
        if (tid < TT) { float am = ama[tid];
#pragma unroll
            for (int w = 0; w < NWAVES; ++w) am = fmaxf(am, amc[tid * NWAVES + w]);
            const float sc = am > 0.f ? am * (1.f / 127.f) : 1.f; const _Float16 ih = (_Float16)(1.f / sc);
            ((LAS unsigned*)invs)[tid] = __builtin_bit_cast(unsigned, (h2_t){ih, ih}); SM[t0 + tid] = 1.f / (float)ih; }
        __syncthreads();
        const h2_t K1536 = (h2_t){(_Float16)1536.f, (_Float16)1536.f};
#pragma unroll
        for (int q = 0; q < TT / 4; ++q) { const v4u iv = *(const LAS v4u*)((LAS unsigned*)invs + 4 * q);
            const unsigned ivw[4] = {iv.x, iv.y, iv.z, iv.w};
#pragma unroll
            for (int o = 0; o < 4; ++o) { const int t = 4 * q + o; const unsigned r = __builtin_bit_cast(unsigned, __builtin_elementwise_fma(cv[t], __builtin_bit_cast(h2_t, ivw[o]), K1536));
                *(LAS unsigned short*)(F.lds + STG_OFF + t * 1024 + 2 * tid) = (unsigned short)__builtin_amdgcn_perm(0u, r, 0x0c0c0200u); } }
#pragma unroll
        for (int rr = 0; rr < 4; ++rr) { const h2_t ivh = __builtin_bit_cast(h2_t, ((LAS unsigned*)invs)[4 * wave + rr]);
            const v4u pa_ = *(const LAS v4u*)(F.lds + AVP_OFF + ((rr * 2) * (NWAVES * 64) + tid) * 16), pb_ = *(const LAS v4u*)(F.lds + AVP_OFF + ((rr * 2 + 1) * (NWAVES * 64) + tid) * 16);
            const unsigned pw_[8] = {pa_.x, pa_.y, pa_.z, pa_.w, pb_.x, pb_.y, pb_.z, pb_.w}; unsigned rq[8];
#pragma unroll
            for (int e = 0; e < 8; ++e) rq[e] = __builtin_bit_cast(unsigned, __builtin_elementwise_fma(__builtin_bit_cast(h2_t, pw_[e]), ivh, K1536));
            *((GAS v4u*)(MIX8 + (size_t)(t0 + 4 * wave + rr) * D) + lane) = (v4u){__builtin_amdgcn_perm(rq[1], rq[0], 0x06040200u), __builtin_amdgcn_perm(rq[3], rq[2], 0x06040200u), __builtin_amdgcn_perm(rq[5], rq[4], 0x06040200u), __builtin_amdgcn_perm(rq[7], rq[6], 0x06040200u)}; }
        __syncthreads();
        for (int idx = tid; idx < TT * 64; idx += NWAVES * 64) { const int row = idx >> 6, ch = idx & 63;
            *((GAS v4u*)(MIX8 + (size_t)(t0 + row) * D + DATT) + ch) = *(const LAS v4u*)(F.lds + STG_OFF + row * 1024 + ch * 16); }
        __syncthreads();
    }
}
#undef P3_LOAD_H
__device__ __forceinline__ void p5_ln1(Frame& F) {
    const bf16* Y1 = F.ws<bf16>(WS_Y1); const float* ln1_g = F.in(I_LN1G); const float* ln1_b = F.in(I_LN1B); unsigned char* X8 = F.ws<unsigned char>(WS_X8); float* SX = F.ws<float>(WS_SX); float* LNS = F.ws<float>(WS_LNS); float* SXQ = F.ws<float>(WS_SXQ); unsigned char* XH = F.ws<unsigned char>(WS_XH); unsigned char* XL = F.ws<unsigned char>(WS_XL);
    const int gw = F.vcu_() * NWAVES + F.wave_(), NGW = F.G_() * NWAVES, lane = F.lane();
    v4u nx[4];
    if (gw < M) { const GAS v4u* p = (const GAS v4u*)(Y1 + (size_t)gw * D) + lane;
#pragma unroll
        for (int j = 0; j < 4; ++j) nx[j] = p[64 * j]; }
    for (int m = gw; m < M; m += NGW) {
        v4u w[4]; float v[32]; float s = 0.f;
#pragma unroll
        for (int j = 0; j < 4; ++j) w[j] = nx[j];
        { const int mn = (m + NGW < M) ? m + NGW : m; const GAS v4u* p = (const GAS v4u*)(Y1 + (size_t)mn * D) + lane;
#pragma unroll
          for (int j = 0; j < 4; ++j) nx[j] = p[64 * j]; }
#pragma unroll
        for (int j = 0; j < 4; ++j) { const unsigned ww[4] = {w[j].x, w[j].y, w[j].z, w[j].w};
#pragma unroll
            for (int i = 0; i < 4; ++i) { v[8 * j + 2 * i] = bflo(ww[i]); v[8 * j + 2 * i + 1] = bfhi(ww[i]); s += v[8 * j + 2 * i] + v[8 * j + 2 * i + 1]; } }
        const float mean = wave_sum(s) * (1.f / D); float q = 0.f;
#pragma unroll
        for (int i = 0; i < 32; ++i) { v[i] -= mean; q += v[i] * v[i]; }
        const float rstd = 1.f / sqrtf(wave_sum(q) * (1.f / D) + LN_EPS);
        float am = 0.f;
#pragma unroll
        for (int j = 0; j < 4; ++j) { const int c0 = 8 * lane + 512 * j; const f32x4 g0 = *(const f32x4*)(ln1_g + c0), g1 = *(const f32x4*)(ln1_g + c0 + 4), b0 = *(const f32x4*)(ln1_b + c0), b1 = *(const f32x4*)(ln1_b + c0 + 4);
#pragma unroll
            for (int i = 0; i < 4; ++i) { v[8 * j + i] = v[8 * j + i] * rstd * g0[i] + b0[i]; v[8 * j + 4 + i] = v[8 * j + 4 + i] * rstd * g1[i] + b1[i]; am = fmaxf(am, fmaxf(fabsf(v[8 * j + i]), fabsf(v[8 * j + 4 + i]))); } }
        am = wave_max(am);
        const float sc = am > 0.f ? am * (1.f / 127.f) : 1.f, inv = 1.f / sc;
        GAS v2u* p8 = (GAS v2u*)(X8 + (size_t)m * D) + lane;
#pragma unroll
        for (int j = 0; j < 4; ++j) p8[64 * j] = (v2u){pack_i8x4(v[8 * j] * inv, v[8 * j + 1] * inv, v[8 * j + 2] * inv, v[8 * j + 3] * inv), pack_i8x4(v[8 * j + 4] * inv, v[8 * j + 5] * inv, v[8 * j + 6] * inv, v[8 * j + 7] * inv)};
        { GAS unsigned* ph = (GAS unsigned*)(XH + (size_t)m * (D / 2)) + lane; GAS unsigned* pl = (GAS unsigned*)(XL + (size_t)m * (D / 2)) + lane;
#pragma unroll
          for (int j = 0; j < 4; ++j) { unsigned wh = 0, wl = 0;
#pragma unroll
              for (int i = 0; i < 8; ++i) { const unsigned u = (unsigned)((int)rintf(v[8 * j + i] * inv) + 128); const int sh = 8 * (i & 3) + 4 * (i >> 2); wh |= (u >> 4) << sh; wl |= (u & 15u) << sh; }
              ph[64 * j] = wh; pl[64 * j] = wl; } }
        float qs = 0.f;
#pragma unroll
        for (int i = 0; i < 32; ++i) qs += rintf(v[i] * inv);
        qs = wave_sum(qs);
        if (lane == 0) { SX[m] = sc; LNS[2 * m] = mean; LNS[2 * m + 1] = rstd; SXQ[m] = qs; }
    }
}
__device__ __forceinline__ int f2key(float f) { const int b = __float_as_int(f); return b ^ ((b >> 31) & 0x7fffffff); }
__device__ __forceinline__ float key2f(int k) { return __int_as_float(k ^ ((k >> 31) & 0x7fffffff)); }
#define CE_DESC(a, b) do { const int _x = max(a, b), _y = min(a, b); a = _x; b = _y; } while (0)
template <int N> __device__ __forceinline__ void bitonic_merge_desc(int (&v)[N]) {
#pragma unroll
    for (int j = N >> 1; j > 0; j >>= 1)
#pragma unroll
        for (int i = 0; i < N; ++i) { const int l = i ^ j; if (l > i) CE_DESC(v[i], v[l]); }
}
__device__ __forceinline__ void sort16_desc(int (&v)[16]) {
#define CE_(a, b) CE_DESC(v[a], v[b])
    CE_(0,1); CE_(2,3); CE_(0,2); CE_(1,3); CE_(1,2); CE_(4,5); CE_(6,7); CE_(4,6); CE_(5,7); CE_(5,6); CE_(0,4); CE_(2,6); CE_(2,4); CE_(1,5); CE_(3,7); CE_(3,5); CE_(1,2); CE_(3,4); CE_(5,6);
    CE_(8,9); CE_(10,11); CE_(8,10); CE_(9,11); CE_(9,10); CE_(12,13); CE_(14,15); CE_(12,14); CE_(13,15); CE_(13,14); CE_(8,12); CE_(10,14); CE_(10,12); CE_(9,13); CE_(11,15); CE_(11,13); CE_(9,10); CE_(11,12); CE_(13,14);
    CE_(0,8); CE_(4,12); CE_(4,8); CE_(2,10); CE_(6,14); CE_(6,10); CE_(2,4); CE_(6,8); CE_(10,12); CE_(1,9); CE_(5,13); CE_(5,9); CE_(3,11); CE_(7,15); CE_(7,11); CE_(3,5); CE_(7,9); CE_(11,13);
    CE_(1,2); CE_(3,4); CE_(5,6); CE_(7,8); CE_(9,10); CE_(11,12); CE_(13,14);
#undef CE_
}
__device__ __forceinline__ void merge16(const int (&a)[16], const int (&b)[16], int (&o)[16]) {
#pragma unroll
    for (int i = 0; i < 16; ++i) o[i] = max(a[i], b[15 - i]);
    bitonic_merge_desc<16>(o);
}
__device__ const unsigned char PEER_PAIR[64] = {0,1,2,3,4,5,6,7,8,9,10,11,12,13,14,15, 16,17,18,19,20,21,22,23, 32,33,34,35,36, 48,49,50,51, 64,65,66, 80,81, 96,97, 112,113, 128,144,160,176,192,208,224,240, 0,0,0,0,0,0,0,0,0,0,0,0,0,0};
__device__ __forceinline__ void peer_subkey_top16(const bf16* qrow  , const bf16* keys_hc  , int r32, int hi, int (&o)[16]) {
    bf16x8 bq[8];
    asm volatile("" : "+v"(qrow));
#pragma unroll
    for (int s = 0; s < 8; ++s) bq[s] = *(const GAS bf16x8*)(qrow + 8 * s);
    int run[16];
#pragma unroll
    for (int mt = 0; mt < 4; ++mt) {
        const bf16* krow = keys_hc + (size_t)(32 * mt + r32) * PHALF + hi * 64;
        asm volatile("" : "+v"(krow));
        bf16x8 ka[8];
#pragma unroll
        for (int s = 0; s < 8; ++s) ka[s] = *(const GAS bf16x8*)(krow + 8 * s);
        f32x16 acc = {};
#pragma unroll
        for (int s = 0; s < 8; ++s) acc = __builtin_amdgcn_mfma_f32_32x32x16_bf16(ka[s], bq[s], acc, 0, 0, 0);
        int g[16];
#pragma unroll
        for (int r = 0; r < 16; ++r) g[r] = (f2key(acc[r]) & ~127) | ((r & 3) + 8 * (r >> 2));
        sort16_desc(g);
        if (mt) {
#pragma unroll
            for (int r = 0; r < 16; ++r) g[r] |= 32 * mt; }
        if (mt == 0) {
#pragma unroll
            for (int r = 0; r < 16; ++r) run[r] = g[r];
        } else { int t2[16]; merge16(run, g, t2);
#pragma unroll
            for (int r = 0; r < 16; ++r) run[r] = t2[r]; }
    }
    int lo[16], hh[16]; const int hi4 = 4 * hi;
#pragma unroll
    for (int i = 0; i < 16; ++i) { run[i] |= hi4; auto rr = __builtin_amdgcn_permlane32_swap((unsigned)run[i], (unsigned)run[i], false, false); lo[i] = (int)rr[0]; hh[i] = (int)rr[1]; }
    merge16(lo, hh, o);
}
__device__ __forceinline__ float gelu_erf(float v) { return 0.5f * v * (1.f + erff(v * 0.70710678118654752f)); }

typedef float f32x2 __attribute__((ext_vector_type(2)));
constexpr int P7_G2 = RING_BYTES + 512 + 8192, P7_B2 = P7_G2 + 8192;
static_assert(P7_B2 + 8192 <= LDS_BYTES, "PEER LDS map (LN2 tables)");
constexpr int P7_G1 = 115712, P7_LNSL = 123904, P7_B1 = RING_BYTES + 512;
static_assert(P7_LNSL + 1024 <= RING_BYTES && P7_B1 + 8192 <= LDS_BYTES, "PEER LDS map (LN1 tables)");
constexpr int P7_W8 = 98304, P7_SW = 114688;
constexpr int P7_ACT = 0, P7_EID = 65536, P7_SCR = 0  , P7_SCR_WAVE = 32 * 33 * 4, PCH = 128, NCH = D / PCH;
static_assert(P7_SCR + NWAVES * P7_SCR_WAVE <= P7_EID && P7_EID + 128 * 128 * 2 <= RING_BYTES, "PEER LDS map");

__device__ __forceinline__ void p7_peer(Frame& F) {
    const int lane = F.lane(), r32 = lane & 31, hi = lane >> 5, j8 = lane & 7, g8 = lane >> 3;
    constexpr int TPB = 128;
    LAS float* ACT = (LAS float*)(F.lds + P7_ACT); LAS unsigned short* EIDL = (LAS unsigned short*)(F.lds + P7_EID);
    LAS int* scr = (LAS int*)(F.lds + P7_SCR + F.wave_() * P7_SCR_WAVE);
    { const float* ln1_g = F.in(I_LN1G); const float* ln1_b = F.in(I_LN1B); const int tid = F.tid();
      *(LAS f32x4*)(F.lds + P7_G1 + tid * 16) = *(const f32x4*)(ln1_g + tid * 4); *(LAS f32x4*)(F.lds + P7_B1 + tid * 16) = *(const f32x4*)(ln1_b + tid * 4);
      *(LAS f32x4*)(F.lds + P7_G2 + tid * 16) = *(const f32x4*)(F.in(I_LN2G) + tid * 4); *(LAS f32x4*)(F.lds + P7_B2 + tid * 16) = *(const f32x4*)(F.in(I_LN2B) + tid * 4); }
    for (int blk = F.vcu_(); blk < M / TPB; blk += F.G_()) {
        const int m0 = blk * TPB;
        SEC_BEGIN(10);
        SEC_REP(10) { const int h = F.wave_(); const bf16* QP = F.ws<bf16>(WS_QP); const bf16* KEYS = F.ws<bf16>(WS_KEYS); float* GATE = F.ws<float>(WS_GATE);
          for (int tt = 0; tt < 4; ++tt) {
            const int tl = 32 * tt + r32, tok = m0 + tl;
            const bf16* qrow = QP + (size_t)tok * D + h * 256 + hi * 64;
            int s1[16], s2[16];
            peer_subkey_top16(qrow, KEYS + (size_t)(h * 2 + 0) * PNK * PHALF, r32, hi, s1);
            asm volatile("" ::: "memory");
            peer_subkey_top16(qrow + 128, KEYS + (size_t)(h * 2 + 1) * PNK * PHALF, r32, hi, s2);
            float f1[16], f2[16];
#pragma unroll
            for (int i = 0; i < 16; ++i) { f1[i] = key2f(s1[i]); f2[i] = key2f(s2[i]); }
            if (hi == 0) {
#pragma unroll
                for (int i = 0; i < 16; ++i) { scr[r32 * 33 + i] = s1[i] & 127; scr[r32 * 33 + 16 + i] = s2[i] & 127; } }
            int cand[64];
            {
#define PC(n_, i_, j_) cand[n_] = (f2key(f1[i_] + f2[j_]) & ~255) | (n_)
                PC(0,0,0); PC(1,0,1); PC(2,0,2); PC(3,0,3); PC(4,0,4); PC(5,0,5); PC(6,0,6); PC(7,0,7); PC(8,0,8); PC(9,0,9); PC(10,0,10); PC(11,0,11); PC(12,0,12); PC(13,0,13); PC(14,0,14); PC(15,0,15);
                PC(16,1,0); PC(17,1,1); PC(18,1,2); PC(19,1,3); PC(20,1,4); PC(21,1,5); PC(22,1,6); PC(23,1,7);
                PC(24,2,0); PC(25,2,1); PC(26,2,2); PC(27,2,3); PC(28,2,4);
                PC(29,3,0); PC(30,3,1); PC(31,3,2); PC(32,3,3);
                PC(33,4,0); PC(34,4,1); PC(35,4,2);
                PC(36,5,0); PC(37,5,1); PC(38,6,0); PC(39,6,1); PC(40,7,0); PC(41,7,1);
                PC(42,8,0); PC(43,9,0); PC(44,10,0); PC(45,11,0); PC(46,12,0); PC(47,13,0); PC(48,14,0); PC(49,15,0);
#undef PC
            }
#pragma unroll
            for (int i = 50; i < 64; ++i) cand[i] = (int)0x80000000;
            int c0[16], c1[16]; const int hsel = -hi;
#pragma unroll
            for (int i = 0; i < 16; ++i) { c0[i] = (cand[i] & ~hsel) | (cand[32 + i] & hsel); c1[i] = (cand[16 + i] & ~hsel) | (cand[48 + i] & hsel); }
            sort16_desc(c0); sort16_desc(c1);
            int mh[16]; merge16(c0, c1, mh);
            int sc[16];
            { int lo_[16], hh_[16];
#pragma unroll
              for (int i = 0; i < 16; ++i) { auto rr = __builtin_amdgcn_permlane32_swap((unsigned)mh[i], (unsigned)mh[i], false, false); lo_[i] = (int)rr[0]; hh_[i] = (int)rr[1]; }
              merge16(lo_, hh_, sc); }
            float p[16]; const float mx = key2f(sc[0]); float z = 0.f;
#pragma unroll
            for (int k = 0; k < 16; ++k) { p[k] = __expf(key2f(sc[k]) - mx); z += p[k]; }
            const float rz = 1.f / z;
            LDS_WAIT();
            int eo[8]; float go[8]; const int him = -hi;
#pragma unroll
            for (int kk = 0; kk < 8; ++kk) { const int tag = PEER_PAIR[((sc[kk] & ~him) | (sc[8 + kk] & him)) & 255];
                const int i1 = scr[r32 * 33 + (tag >> 4)], i2 = scr[r32 * 33 + 16 + (tag & 15)];
                eo[kk] = i1 * PNK + i2; go[kk] = __int_as_float((__float_as_int(p[kk]) & ~him) | (__float_as_int(p[8 + kk]) & him)) * rz; }
            *(LAS v4u*)(EIDL + tl * 128 + h * 16 + 8 * hi) = (v4u){(unsigned)(eo[0] | (eo[1] << 16)), (unsigned)(eo[2] | (eo[3] << 16)), (unsigned)(eo[4] | (eo[5] << 16)), (unsigned)(eo[6] | (eo[7] << 16))};
            GAS float* gp = (GAS float*)(GATE + (size_t)tok * 128 + h * 16 + 8 * hi);
            *(GAS f32x4*)gp = (f32x4){go[0], go[1], go[2], go[3]}; *(GAS f32x4*)(gp + 4) = (f32x4){go[4], go[5], go[6], go[7]};
            LDS_WAIT();
          } }
        { const float* LNS = F.ws<float>(WS_LNS); const int tid = F.tid(); if (tid < 64) *(LAS f32x4*)(F.lds + P7_LNSL + tid * 16) = *(const f32x4*)(LNS + 2 * (size_t)m0 + 4 * tid); }
        SEC_END(10);
        __threadfence_block(); __syncthreads();
        const int tw = F.wave_() * (TPB / NWAVES);
        SEC_BEGIN(11);
        SEC_REP(11) {
        for (int i = lane; i < (TPB / NWAVES) * 128; i += 64) ACT[tw * 128 + i] = 0.f;
        { const unsigned char* XH = F.ws<unsigned char>(WS_XH); const unsigned char* XL = F.ws<unsigned char>(WS_XL); const unsigned char* U8 = F.ws<unsigned char>(WS_U8);
#define U_ISSUE(n_, PC, XQ0, XQ1) do { const int c_ = (n_) >> 4, tl_ = tw + ((n_) & 15); \
            XQ0 = *(const GAS v4u*)(XH + (size_t)(m0 + tl_) * (D / 2) + c_ * PCH + 16 * j8); XQ1 = *(const GAS v4u*)(XL + (size_t)(m0 + tl_) * (D / 2) + c_ * PCH + 16 * j8); \
            const LAS unsigned short* ep_ = EIDL + tl_ * 128 + g8; const unsigned char* ub_ = U8 + (size_t)c_ * (NEXP * PCH); const unsigned j16_ = 16u * (unsigned)j8;     \
            _Pragma("unroll") for (int i = 0; i < 16; ++i) { const unsigned e_ = ep_[8 * i]; PC[i] = *(const GAS v4u*)(ub_ + (e_ * PCH + j16_)); } } while (0)
#define U_COMPUTE(n_, PC, XQ0, XQ1) do { const int tl_ = tw + ((n_) & 15); \
            int pp_[16]; \
            _Pragma("unroll") for (int i = 0; i < 16; ++i) { unsigned ah_ = __builtin_amdgcn_udot8(PC[i].x, XQ0.x, 0u, false), al_ = __builtin_amdgcn_udot8(PC[i].x, XQ1.x, 0u, false); \
                ah_ = __builtin_amdgcn_udot8(PC[i].y, XQ0.y, ah_, false); al_ = __builtin_amdgcn_udot8(PC[i].y, XQ1.y, al_, false); ah_ = __builtin_amdgcn_udot8(PC[i].z, XQ0.z, ah_, false); al_ = __builtin_amdgcn_udot8(PC[i].z, XQ1.z, al_, false); \
                ah_ = __builtin_amdgcn_udot8(PC[i].w, XQ0.w, ah_, false); al_ = __builtin_amdgcn_udot8(PC[i].w, XQ1.w, al_, false); pp_[i] = (int)(16u * ah_ + al_); } \
              \
            int q8_[8], q4_[4], q2_[2]; \
            { const bool b2_ = lane & 4; _Pragma("unroll") for (int i = 0; i < 8; ++i) { const int k_ = b2_ ? pp_[2 * i + 1] : pp_[2 * i], s_ = b2_ ? pp_[2 * i] : pp_[2 * i + 1]; q8_[i] = k_ + dppi<0x141>(s_); } } \
            { const bool b1_ = lane & 2; _Pragma("unroll") for (int i = 0; i < 4; ++i) { const int k_ = b1_ ? q8_[2 * i + 1] : q8_[2 * i], s_ = b1_ ? q8_[2 * i] : q8_[2 * i + 1]; q4_[i] = k_ + dppi<0x4E>(s_); } } \
            { const bool b0_ = lane & 1; _Pragma("unroll") for (int i = 0; i < 2; ++i) { const int k_ = b0_ ? q4_[2 * i + 1] : q4_[2 * i], s_ = b0_ ? q4_[2 * i] : q4_[2 * i + 1]; q2_[i] = k_ + dppi<0xB1>(s_); } } \
            const int irow_ = ((lane & 1) << 2) | (lane & 2) | ((lane >> 2) & 1); \
            LAS float* ap_ = ACT + tl_ * 128 + 8 * irow_ + g8; ap_[0] += (float)q2_[0]; ap_[64] += (float)q2_[1]; } while (0)
          constexpr int UCH = 256, NSTEP = (D / UCH) * (TPB / NWAVES);
          v4u pcA[16], pcB[16], xqA0, xqA1, xqB0, xqB1;
          U_ISSUE(0, pcA, xqA0, xqA1);
          for (int n = 0; n < NSTEP; n += 2) {
              U_ISSUE(n + 1, pcB, xqB0, xqB1); __builtin_amdgcn_sched_barrier(0);
              U_COMPUTE(n, pcA, xqA0, xqA1); __builtin_amdgcn_sched_barrier(0);
              { const int nn = (n + 2 < NSTEP) ? n + 2 : n; U_ISSUE(nn, pcA, xqA0, xqA1); }
              __builtin_amdgcn_sched_barrier(0);
              U_COMPUTE(n + 1, pcB, xqB0, xqB1); __builtin_amdgcn_sched_barrier(0);
          }
#undef U_ISSUE
#undef U_COMPUTE
        }
        }
        SEC_END(11); SEC_BEGIN(12);
        LDS_WAIT();
        { const float* SU = F.ws<float>(WS_SU); const float* SV = F.ws<float>(WS_SV); const float* GATE = F.ws<float>(WS_GATE); const float* SX = F.ws<float>(WS_SX); const float* SXQ = F.ws<float>(WS_SXQ); const float* NSU = F.ws<float>(WS_NSU);
        LAS unsigned char* W8L = (LAS unsigned char*)(F.lds + P7_W8); LAS float* SWL = (LAS float*)(F.lds + P7_SW);
        for (int tb = 0; tb < TPB / NWAVES; tb += 8) {
            float nsu_[8][2], su_[8][2], sv_[8][2], gt_[8][2], ac_[8][2], sx_[8], xo_[8];
#pragma unroll
            for (int i = 0; i < 8; ++i) { const int tl = tw + tb + i, t = m0 + tl; sx_[i] = SX[t]; xo_[i] = 8.f * SXQ[t];
#pragma unroll
                for (int kq = 0; kq < 2; ++kq) { const int k = lane + 64 * kq; const unsigned e = EIDL[tl * 128 + k]; ac_[i][kq] = ACT[tl * 128 + k];
                    nsu_[i][kq] = NSU[e]; su_[i][kq] = SU[e]; sv_[i][kq] = SV[e]; gt_[i][kq] = __builtin_nontemporal_load(GATE + (size_t)t * 128 + k); } }
#pragma unroll
            for (int i = 0; i < 8; ++i) { const int tl = tw + tb + i; float wv[2];
#pragma unroll
                for (int kq = 0; kq < 2; ++kq) { const float a = (ac_[i][kq] - 128.f * nsu_[i][kq] - xo_[i]) * su_[i][kq] * sx_[i];
                    wv[kq] = gt_[i][kq] * gelu_erf(a) * sv_[i][kq]; }
                const float am = wave_max(fmaxf(fabsf(wv[0]), fabsf(wv[1])));
                const float sc = am > 0.f ? am * (1.f / 127.f) : 1.f, inv = 1.f / sc;
                float wsum = 0.f;
#pragma unroll
                for (int kq = 0; kq < 2; ++kq) { const int k = lane + 64 * kq; const float q = rintf(wv[kq] * inv); wsum += q; W8L[tl * 128 + k] = (unsigned char)((int)q & 255); }
                wsum = wave_sum(wsum);
                if (lane == 0) { SWL[tl] = sc; SWL[128 + tl] = 8.f * wsum; } }
        } }
        LDS_WAIT();
        SEC_END(12); SEC_BEGIN(13);
        SEC_REP(13) {
        { const bf16* X1 = F.ws<bf16>(WS_Y1); const unsigned char* V8 = F.ws<unsigned char>(WS_V8); bf16* Y2 = F.ws<bf16>(WS_QP);
#define V_ISSUE(n_, PC, WQ) do { const int c_ = (n_) >> 4, tl_ = tw + (((n_) >> 3) & 1) * 8 + g8, s_ = (n_) & 7; \
            const LAS unsigned short* ep_ = EIDL + tl_ * 128 + 16 * s_; const unsigned char* vb_ = V8 + (size_t)c_ * (NEXP * PCH); const unsigned j16_ = 16u * (unsigned)j8;     \
            _Pragma("unroll") for (int i = 0; i < 16; ++i) { const unsigned e_ = ep_[i]; PC[i] = *(const GAS v4u*)(vb_ + (e_ * PCH + j16_)); } \
            WQ = *(const LAS v4u*)(F.lds + P7_W8 + tl_ * 128 + 16 * s_); } while (0)
#define V_TR4(A_, B_, C_, D_, WQ_, O_) do { const unsigned t0_ = __builtin_amdgcn_perm(B_, A_, 0x05010400u), t1_ = __builtin_amdgcn_perm(B_, A_, 0x07030602u), t2_ = __builtin_amdgcn_perm(D_, C_, 0x05010400u), t3_ = __builtin_amdgcn_perm(D_, C_, 0x07030602u); \
            const unsigned u0_ = __builtin_amdgcn_perm(t2_, t0_, 0x05040100u), u1_ = __builtin_amdgcn_perm(t2_, t0_, 0x07060302u), u2_ = __builtin_amdgcn_perm(t3_, t1_, 0x05040100u), u3_ = __builtin_amdgcn_perm(t3_, t1_, 0x07060302u); \
              \
            ac_[(O_) + 0] = __builtin_amdgcn_sdot4((int)(u0_ & 0x0f0f0f0fu), (int)(WQ_), ac_[(O_) + 0], false); ac_[(O_) + 4] = __builtin_amdgcn_sdot4((int)u0_, (int)(WQ_), ac_[(O_) + 4], false); \
            ac_[(O_) + 1] = __builtin_amdgcn_sdot4((int)(u1_ & 0x0f0f0f0fu), (int)(WQ_), ac_[(O_) + 1], false); ac_[(O_) + 5] = __builtin_amdgcn_sdot4((int)u1_, (int)(WQ_), ac_[(O_) + 5], false); \
            ac_[(O_) + 2] = __builtin_amdgcn_sdot4((int)(u2_ & 0x0f0f0f0fu), (int)(WQ_), ac_[(O_) + 2], false); ac_[(O_) + 6] = __builtin_amdgcn_sdot4((int)u2_, (int)(WQ_), ac_[(O_) + 6], false); \
            ac_[(O_) + 3] = __builtin_amdgcn_sdot4((int)(u3_ & 0x0f0f0f0fu), (int)(WQ_), ac_[(O_) + 3], false); ac_[(O_) + 7] = __builtin_amdgcn_sdot4((int)u3_, (int)(WQ_), ac_[(O_) + 7], false); } while (0)
#define V_ACC(PC, WQ) do { const unsigned wq_[4] = {WQ.x, WQ.y, WQ.z, WQ.w}; \
            _Pragma("unroll") for (int gq = 0; gq < 4; ++gq) { \
                const unsigned pa_[4] = {PC[4 * gq].x, PC[4 * gq].y, PC[4 * gq].z, PC[4 * gq].w}, pb_[4] = {PC[4 * gq + 1].x, PC[4 * gq + 1].y, PC[4 * gq + 1].z, PC[4 * gq + 1].w}; \
                const unsigned pc_[4] = {PC[4 * gq + 2].x, PC[4 * gq + 2].y, PC[4 * gq + 2].z, PC[4 * gq + 2].w}, pd_[4] = {PC[4 * gq + 3].x, PC[4 * gq + 3].y, PC[4 * gq + 3].z, PC[4 * gq + 3].w}; \
                _Pragma("unroll") for (int m = 0; m < 4; ++m) { \
                    V_TR4(pa_[m], pb_[m], pc_[m], pd_[m], wq_[gq], 8 * m); } } } while (0)
#define V_FIN(n_, XP) do { const int c_ = (n_) >> 4, tl_ = tw + (((n_) >> 3) & 1) * 8 + g8; \
            const LAS float* swp_ = (const LAS float*)(F.lds + P7_SW); const float sw_ = swp_[tl_], wo_ = swp_[128 + tl_]; \
            const f32x2 ms_ = *(const LAS f32x2*)(F.lds + P7_LNSL + tl_ * 8); const int dim0_ = c_ * VCH + 32 * j8; \
            _Pragma("unroll") for (int m = 0; m < 4; ++m) { \
                const f32x4 g0_ = *(const LAS f32x4*)(F.lds + P7_G1 + (dim0_ + 8 * m) * 4), g1_ = *(const LAS f32x4*)(F.lds + P7_G1 + (dim0_ + 8 * m + 4) * 4), b0_ = *(const LAS f32x4*)(F.lds + P7_B1 + (dim0_ + 8 * m) * 4), b1_ = *(const LAS f32x4*)(F.lds + P7_B1 + (dim0_ + 8 * m + 4) * 4); \
                const unsigned xw_[4] = {XP[m].x, XP[m].y, XP[m].z, XP[m].w}; float o_[8]; \
                _Pragma("unroll") for (int i = 0; i < 4; ++i) { const float yl_ = (i & 1) ? bfhi(xw_[i >> 1]) : bflo(xw_[i >> 1]), yh_ = (i & 1) ? bfhi(xw_[2 + (i >> 1)]) : bflo(xw_[2 + (i >> 1)]); \
                    o_[i] = ((float)ac_[8 * m + i] - wo_) * sw_ + DN_ALPHA * ((yl_ - ms_.x) * ms_.y * g0_[i] + b0_[i]); \
                    o_[4 + i] = (float)((ac_[8 * m + 4 + i] - ac_[8 * m + i]) >> 4) * sw_ + DN_ALPHA * ((yh_ - ms_.x) * ms_.y * g1_[i] + b1_[i]); } \
                *(GAS v4u*)(Y2 + (size_t)(m0 + tl_) * D + dim0_ + 8 * m) = (v4u){pk2(o_[0], o_[1]), pk2(o_[2], o_[3]), pk2(o_[4], o_[5]), pk2(o_[6], o_[7])}; } \
            _Pragma("unroll") for (int d = 0; d < 32; ++d) ac_[d] = 0; } while (0)
          constexpr int VCH = 256, NSTEP = (D / VCH) * (TPB / NWAVES);
          v4u pcA[16], pcB[16], wqA, wqB, xp[4]; int ac_[32];
#pragma unroll
          for (int d = 0; d < 32; ++d) ac_[d] = 0;
          V_ISSUE(0, pcA, wqA);
          for (int n = 0; n < NSTEP; n += 2) {
              const bool fin = (n & 7) == 6;
              if (fin) { const int c_ = (n + 1) >> 4, tl_ = tw + (((n + 1) >> 3) & 1) * 8 + g8; const GAS v4u* xq_ = (const GAS v4u*)(X1 + (size_t)(m0 + tl_) * D + c_ * VCH + 32 * j8);
#pragma unroll
                  for (int m = 0; m < 4; ++m) xp[m] = xq_[m]; }
              V_ISSUE(n + 1, pcB, wqB); __builtin_amdgcn_sched_barrier(0);
              V_ACC(pcA, wqA); __builtin_amdgcn_sched_barrier(0);
              { const int nn = (n + 2 < NSTEP) ? n + 2 : n; V_ISSUE(nn, pcA, wqA); }
              __builtin_amdgcn_sched_barrier(0);
              V_ACC(pcB, wqB);
              if (fin) V_FIN(n + 1, xp);
              __builtin_amdgcn_sched_barrier(0);
          }
#undef V_TR4
#undef V_ISSUE
#undef V_ACC
#undef V_FIN
        }
        }
        SEC_END(13); SEC_BEGIN(14);
        SEC_REP(14) {
        { float* outp = F.outp(); const bf16* Y2 = F.ws<bf16>(WS_QP);
        v4u nx[4];
        { const GAS v4u* yp = (const GAS v4u*)(Y2 + (size_t)(m0 + tw) * D) + lane;
#pragma unroll
          for (int j = 0; j < 4; ++j) nx[j] = yp[64 * j]; }
        for (int ti = 0; ti < TPB / NWAVES; ++ti) {
            const int t = m0 + tw + ti;
            float v[32]; float s = 0.f;
#pragma unroll
            for (int j = 0; j < 4; ++j) { const unsigned ww[4] = {nx[j].x, nx[j].y, nx[j].z, nx[j].w};
#pragma unroll
                for (int i = 0; i < 4; ++i) { v[8 * j + 2 * i] = bflo(ww[i]); v[8 * j + 2 * i + 1] = bfhi(ww[i]); s += v[8 * j + 2 * i] + v[8 * j + 2 * i + 1]; } }
            { const int tn = (ti + 1 < TPB / NWAVES) ? t + 1 : t; const GAS v4u* yp = (const GAS v4u*)(Y2 + (size_t)tn * D) + lane;
#pragma unroll
              for (int j = 0; j < 4; ++j) nx[j] = yp[64 * j]; }
            const float mean = wave_sum(s) * (1.f / D); float qv = 0.f;
#pragma unroll
            for (int i = 0; i < 32; ++i) { v[i] -= mean; qv += v[i] * v[i]; }
            const float rstd = 1.f / sqrtf(wave_sum(qv) * (1.f / D) + LN_EPS);
#pragma unroll
            for (int j = 0; j < 4; ++j) { const int c0 = 8 * lane + 512 * j; const f32x4 g0 = *(const LAS f32x4*)(F.lds + P7_G2 + c0 * 4), g1 = *(const LAS f32x4*)(F.lds + P7_G2 + c0 * 4 + 16), b0 = *(const LAS f32x4*)(F.lds + P7_B2 + c0 * 4), b1 = *(const LAS f32x4*)(F.lds + P7_B2 + c0 * 4 + 16);
                f32x4 r0, r1;
#pragma unroll
                for (int i = 0; i < 4; ++i) { r0[i] = v[8 * j + i] * rstd * g0[i] + b0[i]; r1[i] = v[8 * j + 4 + i] * rstd * g1[i] + b1[i]; }
                GAS f32x4* op = (GAS f32x4*)(outp + (size_t)t * D + c0); op[0] = r0; op[1] = r1; }
        } }
        }
        SEC_END(14);
        __syncthreads();
    }
}

struct Args { const float* in[22]; float* out; unsigned char* ws; int ph_lo, ph_hi; };
__global__ void __launch_bounds__(NWAVES * 64, 2) mk_fwd(Args args) {
    extern __shared__ __attribute__((aligned(16))) unsigned char lds[];
    cg::grid_group grid = cg::this_grid();
    Frame F;
    F.lds = (LAS unsigned char*)lds;
    if (threadIdx.x == 0) { LAS unsigned long long* PT = (LAS unsigned long long*)(F.lds + RING_BYTES);
#pragma unroll
        for (int k = 0; k < 22; ++k) PT[k] = (unsigned long long)args.in[k];
        PT[22] = (unsigned long long)args.out; PT[23] = (unsigned long long)args.ws;
        ((LAS unsigned*)(F.lds + RING_BYTES + 256))[0] = 0u; ((LAS unsigned*)(F.lds + RING_BYTES + 256))[1] = 0u; }
    __syncthreads();
    const int lo = args.ph_lo, hi = args.ph_hi;
#ifndef PHASE_MASK
#define PHASE_MASK 255
#endif
#define IN(k) (((PHASE_MASK >> (k)) & 1) && lo <= (k) && (k) < hi)
#ifndef REPEAT_PHASE
#define REPEAT_PHASE -1
#endif
#define REP(k) for (int rep_ = 0; rep_ < ((REPEAT_PHASE == (k)) ? 2 : 1); ++rep_)
    (void)xcd_barrier_post((unsigned*)args.ws, (volatile LAS unsigned*)(F.lds + RING_BYTES + 256));
#define XBAR() do { XcdBarrier bar_; bar_.bar = F.ws<unsigned>(0); bar_.x = xb_xcc_id(); bar_.st = (volatile LAS unsigned*)(F.lds + RING_BYTES + 256); xcd_barrier(bar_); } while (0)
#define SEAM(k) do { if (IN(k) && IN((k) + 1)) XBAR(); } while (0)

    if (lo < 0) grid.sync();
    if (IN(0)) REP(0) { SEC_BEGIN(0); p0a_prologue(F); XBAR(); p0b_prologue(F); SEC_END(0); } SEAM(0);
    if (IN(1)) REP(1) { SEC_BEGIN(1);
        pg8::Gemm g{F.ws<bf16>(WS_XB), F.ws<bf16>(WS_WIN), M, NPROJ, D / 2}; pg8::StaticOrder S; S.init(M, NPROJ, F.G_(), (int)blockIdx.x);
        pg8::EpiProjI8 E{F.ws<bf16>(WS_Q), (size_t)(WS_K - WS_Q) / 2, dattn::C2, F.ws<bf16>(WS_H), F.in(I_BGLU), F.ws<float>(WS_SXA), F.ws<float>(WS_SWIN)};
        pg8::gemm_phase<pg8::EpiProjI8, pg8::StaticOrder, PG8_ALIGN, PG8_SP2>(F.lds, g, S, E);
    SEC_END(1); } SEAM(1);
    if (IN(2)) REP(2) { SEC_BEGIN(2);
        static_assert(dattn::LDS_BYTES <= RING_BYTES, "attention body geometry vs frame");
        const dattn::Tensors AT{F.ws<const dattn::bf16>(WS_Q), F.ws<const dattn::bf16>(WS_K), F.ws<const dattn::bf16>(WS_V), F.ws<dattn::bf16>(WS_O1), F.ws<dattn::bf16>(WS_O2), F.ws<const float>(WS_TAB)};
        dattn::phase((char*)lds, AT, F.vcu_());
    SEC_END(2); } SEAM(2);
    if (IN(3)) REP(3) { SEC_BEGIN(3); p3_mix(F); SEC_END(3); } SEAM(3);
    if (IN(4)) REP(4) { SEC_BEGIN(4);
        pg8::Gemm g{F.ws<bf16>(WS_XB), F.ws<bf16>(WS_WOUT), M, D, D / 2}; pg8::StaticOrder S; S.init(M, D, F.G_(), (int)blockIdx.x);
        pg8::EpiResI8 E{F.in(I_X), F.ws<bf16>(WS_Y1), D, DN_ALPHA, F.ws<float>(WS_SM), F.ws<float>(WS_SWOUT)};
        pg8::gemm_phase<pg8::EpiResI8, pg8::StaticOrder, PG8_ALIGN, PG8_SP2>(F.lds, g, S, E);
    SEC_END(4); } SEAM(4);
    if (IN(5)) REP(5) { SEC_BEGIN(5); p5_ln1(F); SEC_END(5); } SEAM(5);
    if (IN(6)) REP(6) { SEC_BEGIN(6);
        pg8::Gemm g{F.ws<bf16>(WS_X8), F.ws<bf16>(WS_WQ), M, D, D / 2}; pg8::StaticOrder S; S.init(M, D, F.G_(), (int)blockIdx.x);
        pg8::EpiPlainI8 E{F.ws<bf16>(WS_QP), D, F.ws<float>(WS_SX), F.ws<float>(WS_SWQ)};
        pg8::gemm_phase<pg8::EpiPlainI8, pg8::StaticOrder, PG8_ALIGN, PG8_SP2>(F.lds, g, S, E);
    SEC_END(6); } SEAM(6);
    if (IN(7)) REP(7) { SEC_BEGIN(7); p7_peer(F); SEC_END(7); }
#ifdef PROBE_XBARS
    for (int xb_i = 0; xb_i < PROBE_XBARS; ++xb_i) XBAR();
#endif
#undef IN
#undef SEAM
}

extern "C" void kernel_launch(void* const* d_in, const int* in_sizes, int n_in, void* d_out, int out_size, void* d_ws, size_t ws_size, hipStream_t stream) {
    static int grid = 0;
    if (grid == 0) {
        if (n_in != 22 || in_sizes[0] != M * D || out_size != M * D || ws_size < WS_END) { fprintf(stderr, "kernel_launch: unexpected shapes (n_in %d, in0 %d, out %d, ws %zu); nothing launched\n", n_in, n_in > 0 ? in_sizes[0] : -1, out_size, ws_size); grid = -1; return; }
        int dev = 0, cus = 0, per_cu = 0;
        if (hipGetDevice(&dev) != hipSuccess || hipDeviceGetAttribute(&cus, hipDeviceAttributeMultiprocessorCount, dev) != hipSuccess) { grid = -1; return; }
        if (hipFuncSetAttribute((const void*)mk_fwd, hipFuncAttributeMaxDynamicSharedMemorySize, LDS_BYTES) != hipSuccess) { fprintf(stderr, "kernel_launch: hipFuncSetAttribute failed\n"); grid = -1; return; }
        if (hipOccupancyMaxActiveBlocksPerMultiprocessor(&per_cu, (const void*)mk_fwd, NWAVES * 64, LDS_BYTES) != hipSuccess || per_cu < 1) { fprintf(stderr, "kernel_launch: occupancy query reports %d workgroups per CU\n", per_cu); (void)hipGetLastError(); grid = -1; return; }
        grid = cus;
        if (grid > 256) grid = 256;
    }
    if (grid < 0) return;
    if (hipMemsetAsync(d_ws, 0, 65536, stream) != hipSuccess) { fprintf(stderr, "kernel_launch: hipMemsetAsync failed\n"); return; }
    Args a{};
    for (int i = 0; i < 22; ++i) a.in[i] = (const float*)d_in[i];
    a.out = (float*)d_out; a.ws = (unsigned char*)d_ws;
    constexpr int NL = MK_N_LAUNCHES;
    for (int li = 0; li < NL; ++li) {
        a.ph_lo = (NL == 1) ? 0 : li; a.ph_hi = (NL == 1) ? N_PHASES : li + 1;
        void* kargs[] = {&a};
        const hipError_t le = hipLaunchCooperativeKernel((const void*)mk_fwd, dim3(grid), dim3(NWAVES * 64), kargs, LDS_BYTES, stream);
        if (le != hipSuccess) { fprintf(stderr, "kernel_launch: cooperative launch %d failed: %s (grid %d)\n", li, hipGetErrorString(le), grid); break; }
    }
}
```

```cpp
#include <hip/hip_runtime.h>
#include <hip/hip_cooperative_groups.h>
#include <cstdio>
#include <cstdint>
namespace cg = cooperative_groups;
namespace pg8 {
#define PG8_LAS __attribute__((address_space(3)))
typedef unsigned short bf16_t;
typedef short bf16x8 __attribute__((ext_vector_type(8)));
typedef float f32x4 __attribute__((ext_vector_type(4)));
typedef unsigned u32x4 __attribute__((ext_vector_type(4)));
typedef int i32x4 __attribute__((ext_vector_type(4)));
constexpr int BM = 256, BK = 64, HALF = 128, HTB = HALF * BK * 2  , STAGE_BYTES = 8 * HTB, NXCD = 8, WGM = 8;

__host__ __device__ __forceinline__ int lds_byte(int r, int c) { const int st = (r >> 4) * 2 + (c >> 5), rr = r & 15, cc = c & 31, ob = rr * 64 + cc * 2; return st * 1024 + (ob ^ (((ob >> 9) & 1) << 5)); }
__host__ __device__ __forceinline__ void stage_rc(int b, int& R, int& C) { const int st = b / 1024, sb = b % 1024, swz = sb ^ (((sb >> 9) & 1) << 5); R = (st >> 1) * 16 + swz / 64; C = (st & 1) * 32 + (swz % 64) / 2; }
__host__ __device__ __forceinline__ int perm32(int rho) { const int n = rho >> 4, i = rho & 15; return 8 * (i >> 2) + 4 * n + (i & 3); }

struct Unit { int pm, pn; };
struct Gemm { const bf16_t* A; const bf16_t* Bt; int M, N, K; };

struct StaticOrder {
    int nM, nN, nwg, G, c;
    __host__ __device__ void init(int M, int N, int G_, int c_) { nM = M / BM; nN = N / BM; nwg = nM * nN; G = G_; c = c_; }
    __host__ __device__ bool next(int i, Unit& u) const {
        const long L = (long)i * G + c; if (L >= nwg) return false;
        int wgid = (int)L; { const int q = nwg / NXCD, r = nwg % NXCD, xcd = wgid % NXCD, off = wgid / NXCD; wgid = (xcd < r ? xcd * (q + 1) : r * (q + 1) + (xcd - r) * q) + off; }
        const int nig = WGM * nN, gid = wgid / nig, fm = gid * WGM, gsz = (nM - fm) < WGM ? (nM - fm) : WGM;
        u.pm = fm + ((wgid % nig) % gsz); u.pn = (wgid % nig) / gsz; return true;
    }
    __device__ __forceinline__ void a_ready(const Unit&) const {}
    __device__ __forceinline__ void done(const Unit&) const {}
};

__device__ __forceinline__ unsigned cvt_pk_bf16(float lo, float hi) { unsigned r; asm volatile("v_cvt_pk_bf16_f32 %0, %1, %2" : "=v"(r) : "v"(lo), "v"(hi)); return r; }
typedef float f32x2 __attribute__((ext_vector_type(2)));
typedef float f32x2 __attribute__((ext_vector_type(2)));
__device__ __forceinline__ u32x4 pack8(f32x4 v0, f32x4 v1) { u32x4 w; w.x = cvt_pk_bf16(v0[0], v0[1]); w.y = cvt_pk_bf16(v0[2], v0[3]); w.z = cvt_pk_bf16(v1[0], v1[1]); w.w = cvt_pk_bf16(v1[2], v1[3]); return w; }
typedef _Float16 h16x2 __attribute__((ext_vector_type(2)));
__device__ __forceinline__ unsigned pkh2(float a, float b) { const h16x2 v = {(_Float16)__builtin_amdgcn_fmed3f(a, -65504.f, 65504.f), (_Float16)__builtin_amdgcn_fmed3f(b, -65504.f, 65504.f)}; return __builtin_bit_cast(unsigned, v); }
__device__ __forceinline__ u32x4 pack8h(f32x4 v0, f32x4 v1) { u32x4 w; w.x = pkh2(v0[0], v0[1]); w.y = pkh2(v0[2], v0[3]); w.z = pkh2(v1[0], v1[1]); w.w = pkh2(v1[2], v1[3]); return w; }
__device__ __forceinline__ f32x4 i2f(f32x4 a) { const i32x4 v = __builtin_bit_cast(i32x4, a); return (f32x4){(float)v[0], (float)v[1], (float)v[2], (float)v[3]}; }
__device__ __forceinline__ unsigned ror8(unsigned v) { return (unsigned)__builtin_amdgcn_update_dpp(0, (int)v, 0x128, 0xf, 0xf, true); }
__device__ __forceinline__ void xchg_store2(bf16_t* p  , size_t ld, u32x4 p0  , u32x4 p1  , bool hi8) {
    const u32x4 snd = hi8 ? p0 : p1; u32x4 rcv; rcv.x = ror8(snd.x); rcv.y = ror8(snd.y); rcv.z = ror8(snd.z); rcv.w = ror8(snd.w);
    *(u32x4*)p = hi8 ? rcv : p0; *(u32x4*)(p + 8 * ld) = hi8 ? p1 : rcv;
}
struct EpiProjI8 {
    static constexpr bool PERM = true, AFTER_DRAIN = false, INT8 = true;
    bf16_t* QKV; size_t split_stride; float scale0; bf16_t* H; const float* bglu; const float* sa; const float* sb;
    __device__ __forceinline__ void operator()(const f32x4 (&acc)[2][2][4][2], const Unit& u, int wr, int wc, int fr, int fq) const {
        const int row0 = u.pm * BM + wr * 64 + fr, cb = u.pn * BM + wc * 64 + 8 * fq; const bool hi8 = fr & 8;
        f32x4 cs[2][2];
#pragma unroll
        for (int bj = 0; bj < 2; ++bj) { cs[bj][0] = *(const f32x4*)(sb + cb + bj * 32); cs[bj][1] = *(const f32x4*)(sb + cb + bj * 32 + 4); }
        float rsv[2][4];
#pragma unroll
        for (int ai = 0; ai < 2; ++ai)
#pragma unroll
            for (int m = 0; m < 4; ++m) rsv[ai][m] = sa[row0 + ai * HALF + m * 16];
        if (u.pn < 12) {
            const int t = u.pn >> 2; bf16_t* base = QKV + (size_t)t * split_stride; const float sc = (t == 0) ? scale0 : 1.f;
            bf16_t* lp = base + (size_t)(u.pm * BM + wr * 64 + (fr & 7)) * 1024 + (u.pn & 3) * BM + wc * 64 + 8 * fq + (hi8 ? 32 : 0);
#pragma unroll
            for (int ai = 0; ai < 2; ++ai)
#pragma unroll
                for (int m = 0; m < 4; ++m) { const float rs = rsv[ai][m] * sc;
                    xchg_store2(lp + (size_t)(ai * HALF + m * 16) * 1024, 1024, pack8(i2f(acc[ai][0][m][0]) * cs[0][0] * rs, i2f(acc[ai][0][m][1]) * cs[0][1] * rs), pack8(i2f(acc[ai][1][m][0]) * cs[1][0] * rs, i2f(acc[ai][1][m][1]) * cs[1][1] * rs), hi8); }
        } else {
            const int ch0 = (u.pn - 12) * HALF + wc * 32 + 8 * fq;
            const f32x4 ba0 = *(const f32x4*)(bglu + ch0), ba1 = *(const f32x4*)(bglu + ch0 + 4), bg0 = *(const f32x4*)(bglu + 1024 + ch0), bg1 = *(const f32x4*)(bglu + 1024 + ch0 + 4);
#pragma unroll
            for (int ai = 0; ai < 2; ++ai)
#pragma unroll
                for (int m = 0; m < 4; ++m) { const int row = row0 + ai * HALF + m * 16; const float rs = rsv[ai][m];
                    const f32x4 a0 = i2f(acc[ai][0][m][0]) * cs[0][0] * rs + ba0, a1 = i2f(acc[ai][0][m][1]) * cs[0][1] * rs + ba1, g0 = i2f(acc[ai][1][m][0]) * cs[1][0] * rs + bg0, g1 = i2f(acc[ai][1][m][1]) * cs[1][1] * rs + bg1;
                    f32x4 h0, h1;
#pragma unroll
                    for (int e = 0; e < 4; ++e) { h0[e] = a0[e] * __builtin_amdgcn_rcpf(1.f + __builtin_amdgcn_exp2f(-1.4426950409f * g0[e])); h1[e] = a1[e] * __builtin_amdgcn_rcpf(1.f + __builtin_amdgcn_exp2f(-1.4426950409f * g1[e])); }
                    *(u32x4*)(H + (size_t)row * 1024 + ch0) = pack8h(h0, h1); }
        }
    }
};
struct EpiPlainI8 {
    static constexpr bool PERM = true, AFTER_DRAIN = false, INT8 = true;
    bf16_t* O; int ldc; const float* sa; const float* sb;
    __device__ __forceinline__ void operator()(const f32x4 (&acc)[2][2][4][2], const Unit& u, int wr, int wc, int fr, int fq) const {
        const int row0 = u.pm * BM + wr * 64 + fr, col0 = u.pn * BM + wc * 64 + 8 * fq; const bool hi8 = fr & 8;
        f32x4 cs[2][2];
#pragma unroll
        for (int bj = 0; bj < 2; ++bj) { cs[bj][0] = *(const f32x4*)(sb + col0 + bj * 32); cs[bj][1] = *(const f32x4*)(sb + col0 + bj * 32 + 4); }
        float rsv[2][4];
#pragma unroll
        for (int ai = 0; ai < 2; ++ai)
#pragma unroll
            for (int m = 0; m < 4; ++m) rsv[ai][m] = sa[row0 + ai * HALF + m * 16];
        bf16_t* lp = O + (size_t)(u.pm * BM + wr * 64 + (fr & 7)) * ldc + col0 + (hi8 ? 32 : 0);
#pragma unroll
        for (int ai = 0; ai < 2; ++ai)
#pragma unroll
            for (int m = 0; m < 4; ++m) { const float rs = rsv[ai][m];
                xchg_store2(lp + (size_t)(ai * HALF + m * 16) * ldc, (size_t)ldc, pack8(i2f(acc[ai][0][m][0]) * cs[0][0] * rs, i2f(acc[ai][0][m][1]) * cs[0][1] * rs), pack8(i2f(acc[ai][1][m][0]) * cs[1][0] * rs, i2f(acc[ai][1][m][1]) * cs[1][1] * rs), hi8); }
    }
};
struct EpiResI8 {
    static constexpr bool PERM = true, AFTER_DRAIN = false, INT8 = true;
    const float* X; bf16_t* Y; int ldc; float alpha; const float* sa; const float* sb;
    __device__ __forceinline__ void operator()(const f32x4 (&acc)[2][2][4][2], const Unit& u, int wr, int wc, int fr, int fq) const {
        const int row0 = u.pm * BM + wr * 64 + fr, col0 = u.pn * BM + wc * 64 + 8 * fq; const bool hi8 = fr & 8;
        f32x4 cs[2][2];
#pragma unroll
        for (int bj = 0; bj < 2; ++bj) { cs[bj][0] = *(const f32x4*)(sb + col0 + bj * 32); cs[bj][1] = *(const f32x4*)(sb + col0 + bj * 32 + 4); }
        float rsv[2][4];
#pragma unroll
        for (int ai = 0; ai < 2; ++ai)
#pragma unroll
            for (int m = 0; m < 4; ++m) rsv[ai][m] = sa[row0 + ai * HALF + m * 16];
        bf16_t* lp = Y + (size_t)(u.pm * BM + wr * 64 + (fr & 7)) * ldc + col0 + (hi8 ? 32 : 0);
#pragma unroll
        for (int ai = 0; ai < 2; ++ai) {
            f32x4 xv[4][2][2];
#pragma unroll
            for (int m = 0; m < 4; ++m) { const size_t off = (size_t)(row0 + ai * HALF + m * 16) * ldc + col0;
#pragma unroll
                for (int bj = 0; bj < 2; ++bj) { xv[m][bj][0] = *(const f32x4*)(X + off + bj * 32); xv[m][bj][1] = *(const f32x4*)(X + off + bj * 32 + 4); } }
#pragma unroll
            for (int m = 0; m < 4; ++m) { const float rs = rsv[ai][m];
                xchg_store2(lp + (size_t)(ai * HALF + m * 16) * ldc, (size_t)ldc,
                            pack8(i2f(acc[ai][0][m][0]) * cs[0][0] * rs + xv[m][0][0] * alpha, i2f(acc[ai][0][m][1]) * cs[0][1] * rs + xv[m][0][1] * alpha),
                            pack8(i2f(acc[ai][1][m][0]) * cs[1][0] * rs + xv[m][1][0] * alpha, i2f(acc[ai][1][m][1]) * cs[1][1] * rs + xv[m][1][1] * alpha), hi8); }
            asm volatile("" ::: "memory"); }
    }
};
template <class Epi, class Sched, bool ALIGN_EPI = false, bool SP2 = false>
__device__ __forceinline__ void gemm_phase(PG8_LAS unsigned char* lds, const Gemm g, const Sched& S, const Epi& E) {
    const int tid = threadIdx.x, wid = __builtin_amdgcn_readfirstlane(tid >> 6), lane = tid & 63, wr = wid >> 2, wc = wid & 3, fr = lane & 15, fq = lane >> 4;
    const int K = g.K, nt = K / BK;
    unsigned voffA[2], voffB[2];
#pragma unroll
    for (int i = 0; i < 2; ++i) { int R, C; stage_rc(tid * 16 + i * 8192, R, C); const int Rb = Epi::PERM ? (64 * (R >> 5) + perm32(R & 31)) : R;
        voffA[i] = (unsigned)(R * K + C) * 2u; voffB[i] = (unsigned)(Rb * K + C) * 2u; }
    const size_t kstep = (size_t)(BK * 2);
    const size_t hstep = (size_t)HALF * K * 2;
    const size_t tstep = 2 * hstep;
    const size_t hstepB = Epi::PERM ? (size_t)32 * K * 2 : hstep;
    const unsigned ldsw = (unsigned)wid * 1024u;
    const int aoff = lds_byte(wr * 64 + fr, fq * 8), boff = lds_byte(wc * 32 + fr, fq * 8);
#define PG8_SA(b, h) (((b) * 2 + (h)) * HTB)
#define PG8_SB(b, h) ((4 + (b) * 2 + (h)) * HTB)
#define PG8_STAGE(bufoff, gbase, voff) do { _Pragma("unroll") for (int _i = 0; _i < 2; ++_i) \
        __builtin_amdgcn_global_load_lds((const unsigned*)((const char*)(gbase) + (voff)[_i]), (PG8_LAS unsigned*)(lds + (bufoff) + ldsw + _i * 8192), 16, 0, 0); } while (0)
#define PG8_LDA(dst, b, h) do { _Pragma("unroll") for (int m = 0; m < 4; ++m) _Pragma("unroll") for (int k = 0; k < 2; ++k) dst[m][k] = *(const PG8_LAS bf16x8*)(lds + PG8_SA(b, h) + aoff + m * 2048 + k * 1024); } while (0)
#define PG8_LDB(dst, b, h) do { _Pragma("unroll") for (int n = 0; n < 2; ++n) _Pragma("unroll") for (int k = 0; k < 2; ++k) dst[n][k] = *(const PG8_LAS bf16x8*)(lds + PG8_SB(b, h) + boff + n * 2048 + k * 1024); } while (0)
#define PG8_MMA(ai, bj, At, Bt) do { __builtin_amdgcn_s_setprio(1); _Pragma("unroll") for (int m = 0; m < 4; ++m) _Pragma("unroll") for (int n = 0; n < 2; ++n) _Pragma("unroll") for (int k = 0; k < 2; ++k) { \
        if constexpr (Epi::INT8) acc[ai][bj][m][n] = __builtin_bit_cast(f32x4, __builtin_amdgcn_mfma_i32_16x16x64_i8(__builtin_bit_cast(i32x4, Bt[n][k]), __builtin_bit_cast(i32x4, At[m][k]), __builtin_bit_cast(i32x4, acc[ai][bj][m][n]), 0, 0, 0)); \
        else acc[ai][bj][m][n] = __builtin_amdgcn_mfma_f32_16x16x32_bf16(Bt[n][k], At[m][k], acc[ai][bj][m][n], 0, 0, 0); } __builtin_amdgcn_s_setprio(0); } while (0)
#define PG8_WAIT_V(n) asm volatile("s_waitcnt vmcnt(" #n ")" ::: "memory")
#define PG8_WAIT_L(n) asm volatile("s_waitcnt lgkmcnt(" #n ")" ::: "memory")
#define PG8_BAR __builtin_amdgcn_s_barrier()
#define PG8_SCHED __builtin_amdgcn_sched_barrier(0)
    Unit cur, nxt; int ui = 0;
    if (!S.next(0, cur)) return;
    f32x4 acc[2][2][4][2];
#pragma unroll
    for (int a = 0; a < 2; ++a)
#pragma unroll
        for (int b = 0; b < 2; ++b)
#pragma unroll
            for (int m = 0; m < 4; ++m)
#pragma unroll
                for (int n = 0; n < 2; ++n) acc[a][b][m][n] = (f32x4){0.f, 0.f, 0.f, 0.f};
    bf16x8 At[4][2], B0[2][2], B1[2][2];
    const char* cA = (const char*)g.A + (size_t)cur.pm * tstep; const char* cB = (const char*)g.Bt + (size_t)cur.pn * tstep;
    S.a_ready(cur);
    if constexpr (SP2) {
        PG8_STAGE(PG8_SB(0, 0), cB, voffB); PG8_STAGE(PG8_SB(0, 1), cB + hstepB, voffB); PG8_STAGE(PG8_SA(0, 0), cA, voffA); PG8_STAGE(PG8_SA(0, 1), cA + hstep, voffA);
        if (wr == 1) PG8_BAR;
        PG8_WAIT_V(2); PG8_BAR;
        PG8_STAGE(PG8_SB(1, 0), cB + kstep, voffB); PG8_STAGE(PG8_SA(1, 0), cA + kstep, voffA); PG8_STAGE(PG8_SB(1, 1), cB + hstepB + kstep, voffB);
        PG8_WAIT_V(6); PG8_BAR;
    } else {
        PG8_STAGE(PG8_SB(0, 0), cB, voffB); PG8_STAGE(PG8_SA(0, 0), cA, voffA); PG8_STAGE(PG8_SB(0, 1), cB + hstepB, voffB); PG8_STAGE(PG8_SA(0, 1), cA + hstep, voffA);
        if (wr == 1) PG8_BAR;
        PG8_WAIT_V(4); PG8_BAR;
        PG8_STAGE(PG8_SB(1, 0), cB + kstep, voffB); PG8_STAGE(PG8_SA(1, 0), cA + kstep, voffA); PG8_STAGE(PG8_SB(1, 1), cB + hstepB + kstep, voffB);
        PG8_WAIT_V(6); PG8_BAR;
    }
    for (;;) {
        const bool has_next = S.next(ui + 1, nxt);
        const char* nA = has_next ? (const char*)g.A + (size_t)nxt.pm * tstep : cA; const char* nB = has_next ? (const char*)g.Bt + (size_t)nxt.pn * tstep : cB;
        for (int t = 0; t < nt; t += 2) {
            const bool last = (t == nt - 2);
            const char* a1 = cA + (size_t)(t + 1) * kstep;
            const char* a2 = last ? nA : cA + (size_t)(t + 2) * kstep; const char* b2 = last ? nB : cB + (size_t)(t + 2) * kstep;
            const char* a3 = a2 + kstep; const char* b3 = b2 + kstep;
            if (last && has_next) S.a_ready(nxt);
            if constexpr (SP2) {
            PG8_LDB(B0, 0, 0); PG8_LDB(B1, 0, 1); PG8_SCHED; PG8_LDA(At, 0, 0); PG8_STAGE(PG8_SA(1, 1), a1 + hstep, voffA);
            PG8_WAIT_V(8); PG8_WAIT_L(0); PG8_BAR; PG8_MMA(0, 0, At, B0); PG8_MMA(0, 1, At, B1); PG8_BAR; PG8_SCHED;
            PG8_LDA(At, 0, 1); PG8_STAGE(PG8_SB(0, 0), b2, voffB); PG8_STAGE(PG8_SB(0, 1), b2 + hstepB, voffB); PG8_STAGE(PG8_SA(0, 0), a2, voffA);
            PG8_WAIT_V(8); PG8_WAIT_L(0); PG8_BAR; PG8_MMA(1, 0, At, B0); PG8_MMA(1, 1, At, B1); PG8_BAR; PG8_SCHED;
            PG8_LDB(B0, 1, 0); PG8_LDB(B1, 1, 1); PG8_SCHED; PG8_LDA(At, 1, 0); PG8_STAGE(PG8_SA(0, 1), a2 + hstep, voffA);
            PG8_WAIT_V(8); PG8_WAIT_L(0); PG8_BAR; PG8_MMA(0, 0, At, B0); PG8_MMA(0, 1, At, B1); PG8_BAR; PG8_SCHED;
            PG8_LDA(At, 1, 1); PG8_STAGE(PG8_SB(1, 0), b3, voffB); PG8_STAGE(PG8_SB(1, 1), b3 + hstepB, voffB); PG8_STAGE(PG8_SA(1, 0), a3, voffA);
            PG8_WAIT_V(8); PG8_WAIT_L(0); PG8_BAR; PG8_MMA(1, 0, At, B0); PG8_MMA(1, 1, At, B1); PG8_BAR; PG8_SCHED;
            } else {
            PG8_LDB(B0, 0, 0); PG8_SCHED; PG8_LDA(At, 0, 0); PG8_STAGE(PG8_SA(1, 1), a1 + hstep, voffA);
            PG8_WAIT_L(8); PG8_BAR; PG8_WAIT_L(0); PG8_MMA(0, 0, At, B0); PG8_BAR; PG8_SCHED;
            PG8_LDB(B1, 0, 1); PG8_STAGE(PG8_SB(0, 0), b2, voffB);
            PG8_BAR; PG8_WAIT_L(0); PG8_MMA(0, 1, At, B1); PG8_BAR;
            PG8_LDA(At, 0, 1); PG8_STAGE(PG8_SA(0, 0), a2, voffA);
            PG8_BAR; PG8_WAIT_L(0); PG8_MMA(1, 0, At, B0); PG8_BAR; PG8_SCHED;
            PG8_STAGE(PG8_SB(0, 1), b2 + hstepB, voffB);
            PG8_WAIT_V(6); PG8_BAR; PG8_MMA(1, 1, At, B1); PG8_BAR;
            PG8_LDB(B0, 1, 0); PG8_SCHED; PG8_LDA(At, 1, 0); PG8_STAGE(PG8_SA(0, 1), a2 + hstep, voffA);
            PG8_WAIT_L(8); PG8_BAR; PG8_WAIT_L(0); PG8_MMA(0, 0, At, B0); PG8_BAR; PG8_SCHED;
            PG8_LDB(B1, 1, 1); PG8_STAGE(PG8_SB(1, 0), b3, voffB);
            PG8_BAR; PG8_WAIT_L(0); PG8_MMA(0, 1, At, B1); PG8_BAR;
            PG8_LDA(At, 1, 1); PG8_STAGE(PG8_SA(1, 0), a3, voffA);
            PG8_BAR; PG8_WAIT_L(0); PG8_MMA(1, 0, At, B0); PG8_BAR; PG8_SCHED;
            PG8_STAGE(PG8_SB(1, 1), b3 + hstepB, voffB);
            PG8_WAIT_V(6); PG8_BAR; PG8_MMA(1, 1, At, B1); PG8_BAR;
            }
        }
        if constexpr (ALIGN_EPI) { if (wr == 0) PG8_BAR; }
        if constexpr (!Epi::AFTER_DRAIN) { E(acc, cur, wr, wc, fr, fq); S.done(cur); }
        if (!has_next) break;
#pragma unroll
        for (int a = 0; a < 2; ++a)
#pragma unroll
            for (int b = 0; b < 2; ++b)
#pragma unroll
                for (int m = 0; m < 4; ++m)
#pragma unroll
                    for (int n = 0; n < 2; ++n) acc[a][b][m][n] = (f32x4){0.f, 0.f, 0.f, 0.f};
        cur = nxt; cA = nA; cB = nB; ++ui;
        if constexpr (ALIGN_EPI) { if (wr == 1) PG8_BAR; }
    }
    PG8_WAIT_V(0);
    if constexpr (!ALIGN_EPI) { if (wr == 0) PG8_BAR; }
    PG8_BAR;
    if constexpr (Epi::AFTER_DRAIN) { E.fused(acc, cur, wr, wc, fr, fq, lds, wid, lane); S.done(cur); }
#undef PG8_SA
#undef PG8_SB
#undef PG8_STAGE
#undef PG8_LDA
#undef PG8_LDB
#undef PG8_MMA
#undef PG8_WAIT_V
#undef PG8_WAIT_L
#undef PG8_BAR
#undef PG8_SCHED
}
}
#include <hip/hip_bf16.h>
#include <cmath>
namespace dattn {
using bf16 = __hip_bfloat16;
typedef short bf16x8 __attribute__((ext_vector_type(8)));
typedef short s16x4 __attribute__((ext_vector_type(4)));
typedef float f32x16 __attribute__((ext_vector_type(16)));
typedef unsigned u32x4 __attribute__((ext_vector_type(4)));
constexpr int DK = 64, DV = 128, RS = 1024, SEQ = 4096;
constexpr int NW = 8, QBLK = 32, KVBLK = 64, QB = NW * QBLK;
constexpr int SHM_V = KVBLK * DV * 2, SHM_K = KVBLK * DK * 2;
constexpr int NVB = 3;
constexpr int LDS_WS = NVB * SHM_V + 2 * SHM_K, LDS_TAB = LDS_WS + NW * 64 * 4, LDS_OST = 69632, OST_WAVE = 4096, LDS_BYTES = LDS_OST + NW * OST_WAVE;
constexpr int TAB_PADL = 260, TAB_N = TAB_PADL + 128 + 94;
static_assert(LDS_TAB + TAB_N * 4 <= LDS_OST, "attention LDS map");
constexpr float THR = 8.f;
constexpr float C2 = 0.125f * 1.4426950408889634f;
#define DA_KSWZ(row, colB) ((row) * 128 + ((colB) ^ (((row) & 7) << 4)))
#define DA_SBAR() __builtin_amdgcn_sched_barrier(0)
__device__ __forceinline__ int v_st(int k, int c) { const int kk = k;     return ((kk >> 3) * 4 + (c >> 5)) * 512 + ((kk & 7) * 32 + (c & 31)) * 2; }
__device__ __forceinline__ int v_rd_base(int lane) { return ((lane & 3) << 3) | (((lane >> 2) & 3) << 6) | (((lane >> 4) & 1) << 5) | (((lane >> 5) & 1) << 8); }
constexpr int v_rd_off(int d0, int ks, int half) { return d0 * 512 + ks * 4096 + half * 2048; }
__device__ __forceinline__ int crow(int r, int hi) { return (r & 3) + 8 * (r >> 2) + 4 * hi; }
__device__ __forceinline__ unsigned cvtpk(float lo, float hi) { unsigned r; asm volatile("v_cvt_pk_bf16_f32 %0, %1, %2" : "=v"(r) : "v"(lo), "v"(hi)); return r; }
__device__ __forceinline__ bf16x8 load8(const bf16* p) { return *reinterpret_cast<const bf16x8*>(p); }
__device__ __forceinline__ void bias_tile(f32x16& p0, f32x16& p1, int dq, const __attribute__((address_space(3))) float* tabp) {
    const __attribute__((address_space(3))) float* bp = tabp + (TAB_PADL - 59) + dq;
#pragma unroll
    for (int r = 0; r < 16; ++r) { const int c = (r & 3) + 8 * (r >> 2); p0[r] += bp[59 - c]; p1[r] += bp[27 - c]; }
}
__device__ __forceinline__ void rowmaxSM(const f32x16& p0, const f32x16& p1, float& m_reg, float& mn, float& alpha) {
    float ma_ = p0[0], mb_ = p1[0];
#pragma unroll
    for (int r = 1; r < 15; r += 2) { ma_ = fmaxf(fmaxf(ma_, p0[r]), p0[r + 1]); mb_ = fmaxf(fmaxf(mb_, p1[r]), p1[r + 1]); }
    float pmax = fmaxf(fmaxf(ma_, p0[15]), fmaxf(mb_, p1[15]));
    { auto rr = __builtin_amdgcn_permlane32_swap(__float_as_uint(pmax), __float_as_uint(pmax), false, false); pmax = fmaxf(__uint_as_float(rr[0]), __uint_as_float(rr[1])); }
    if (__builtin_expect(__all(pmax - m_reg <= THR), 1)) { mn = m_reg; alpha = 1.f; }
    else { mn = fmaxf(m_reg, pmax); alpha = __builtin_amdgcn_exp2f(m_reg - mn); m_reg = mn; }
}
__device__ __forceinline__ void expSM(f32x16& p0, f32x16& p1, float mn) {
#pragma unroll
    for (int r = 0; r < 16; ++r) { p0[r] = __builtin_amdgcn_exp2f(p0[r] - mn); p1[r] = __builtin_amdgcn_exp2f(p1[r] - mn); }
}
__device__ __forceinline__ void finishSM(f32x16& p0, f32x16& p1, float alpha, float& l_reg, bf16x8& pa0, bf16x8& pa1, bf16x8& pa2, bf16x8& pa3) {
    float s0_ = p0[0], s1_ = p0[1], s2_ = p1[0], s3_ = p1[1];
#pragma unroll
    for (int r = 2; r < 16; r += 2) { s0_ += p0[r]; s1_ += p0[r + 1]; s2_ += p1[r]; s3_ += p1[r + 1]; }
    float ps = (s0_ + s1_) + (s2_ + s3_);
    { auto rr = __builtin_amdgcn_permlane32_swap(__float_as_uint(ps), __float_as_uint(ps), false, false); ps = __uint_as_float(rr[0]) + __uint_as_float(rr[1]); }
    l_reg = l_reg * alpha + ps;
#define DA_PK4(P, B_, OUT) do { u32x4 w = {cvtpk(P[B_+0], P[B_+1]), cvtpk(P[B_+2], P[B_+3]), cvtpk(P[B_+4], P[B_+5]), cvtpk(P[B_+6], P[B_+7])};     \
        OUT = *reinterpret_cast<bf16x8*>(&w); } while (0)
    DA_PK4(p0, 0, pa0); DA_PK4(p0, 8, pa1); DA_PK4(p1, 0, pa2); DA_PK4(p1, 8, pa3);
#undef DA_PK4
}
template <int KB>
__device__ __forceinline__ void qkt(f32x16& p0, f32x16& p1, const char* K_lds, int r32, int hi, const bf16x8* qr) {
    p0 = f32x16{}; p1 = f32x16{};
#pragma unroll
    for (int d0 = 0; d0 < 4; ++d0) { const char* a = K_lds + KB * SHM_K + DA_KSWZ(r32, (d0 * 16 + hi * 8) * 2);
        const bf16x8 b0 = *reinterpret_cast<const bf16x8*>(a), b1 = *reinterpret_cast<const bf16x8*>(a + 32 * 128);
        p0 = __builtin_amdgcn_mfma_f32_32x32x16_bf16(b0, qr[d0], p0, 0, 0, 0);
        p1 = __builtin_amdgcn_mfma_f32_32x32x16_bf16(b1, qr[d0], p1, 0, 0, 0); }
}
template <bool FILL>
__device__ __forceinline__ void pv_tile(f32x16* o, int vb0  , bf16x8 pa0, bf16x8 pa1, bf16x8 pa2, bf16x8 pa3, f32x16& px0, f32x16& px1, float mn) {
#define DA_TRRD(dst, off) asm volatile("ds_read_b64_tr_b16 %0, %1 offset:%2" : "=&v"(dst) : "v"(vb0), "i"(off) : "memory")
#define DA_RD2(m, l, h) do { constexpr int b_ = v_rd_off((m) >> 2, 0, 0) + ((m) & 3) * 4096; DA_TRRD(l, b_); DA_TRRD(h, b_ + 2048); } while (0)
#define DA_MM(m, pa, l, h) do { o[(m) >> 2] = __builtin_amdgcn_mfma_f32_32x32x16_bf16(pa, (bf16x8){l[0], l[1], l[2], l[3], h[0], h[1], h[2], h[3]}, o[(m) >> 2], 0, 0, 0); } while (0)
#define DA_LGK(n) asm volatile("s_waitcnt lgkmcnt(" #n ")" ::: "memory")
#define DA_FILL(m) do { if constexpr (FILL) { float a_ = __builtin_amdgcn_exp2f(px0[m] - mn), b_ = __builtin_amdgcn_exp2f(px1[m] - mn); asm volatile("" : "+v"(a_), "+v"(b_)); px0[m] = a_; px1[m] = b_; } } while (0)
    s16x4 l0, h0, l1, h1, l2, h2, l3, h3, l4, h4, l5, h5, l6, h6, l7, h7, l8, h8, l9, h9, l10, h10, l11, h11, l12, h12, l13, h13, l14, h14, l15, h15;
    DA_SBAR();
    DA_RD2(0, l0, h0); DA_RD2(1, l1, h1); DA_RD2(2, l2, h2); DA_RD2(3, l3, h3);
    DA_LGK(6); DA_SBAR(); DA_MM(0, pa0, l0, h0); DA_FILL(0); DA_SBAR(); DA_RD2(4, l4, h4);
    DA_LGK(6); DA_SBAR(); DA_MM(1, pa1, l1, h1); DA_FILL(1); DA_SBAR(); DA_RD2(5, l5, h5);
    DA_LGK(6); DA_SBAR(); DA_MM(2, pa2, l2, h2); DA_FILL(2); DA_SBAR(); DA_RD2(6, l6, h6);
    DA_LGK(6); DA_SBAR(); DA_MM(3, pa3, l3, h3); DA_FILL(3); DA_SBAR(); DA_RD2(7, l7, h7);
    DA_LGK(6); DA_SBAR(); DA_MM(4, pa0, l4, h4); DA_FILL(4); DA_SBAR(); DA_RD2(8, l8, h8);
    DA_LGK(6); DA_SBAR(); DA_MM(5, pa1, l5, h5); DA_FILL(5); DA_SBAR(); DA_RD2(9, l9, h9);
    DA_LGK(6); DA_SBAR(); DA_MM(6, pa2, l6, h6); DA_FILL(6); DA_SBAR(); DA_RD2(10, l10, h10);
    DA_LGK(6); DA_SBAR(); DA_MM(7, pa3, l7, h7); DA_FILL(7); DA_SBAR(); DA_RD2(11, l11, h11);
    DA_LGK(6); DA_SBAR(); DA_MM(8, pa0, l8, h8); DA_FILL(8); DA_SBAR(); DA_RD2(12, l12, h12);
    DA_LGK(6); DA_SBAR(); DA_MM(9, pa1, l9, h9); DA_FILL(9); DA_SBAR(); DA_RD2(13, l13, h13);
    DA_LGK(6); DA_SBAR(); DA_MM(10, pa2, l10, h10); DA_FILL(10); DA_SBAR(); DA_RD2(14, l14, h14);
    DA_LGK(6); DA_SBAR(); DA_MM(11, pa3, l11, h11); DA_FILL(11); DA_SBAR(); DA_RD2(15, l15, h15);
    DA_LGK(6); DA_SBAR(); DA_MM(12, pa0, l12, h12); DA_FILL(12); DA_SBAR();
    DA_LGK(4); DA_SBAR(); DA_MM(13, pa1, l13, h13); DA_FILL(13); DA_SBAR();
    DA_LGK(2); DA_SBAR(); DA_MM(14, pa2, l14, h14); DA_FILL(14); DA_SBAR();
    DA_LGK(0); DA_SBAR(); DA_MM(15, pa3, l15, h15); DA_FILL(15); DA_SBAR();
#undef DA_FILL
#undef DA_LGK
#undef DA_MM
#undef DA_RD2
#undef DA_TRRD
}
struct BlockRef { const bf16* Q; const bf16* K; const bf16* V; bf16* O; int P0; };
struct Seam { bf16x8 qr[4]; bf16x8 st_v0, st_v1, st_k0; };
#define DA_VMW() asm volatile("s_waitcnt vmcnt(0)" ::: "memory")
#define DA_VMWN(n) asm volatile("s_waitcnt vmcnt(%0)" :: "i"(n) : "memory")
#define DA_SLOAD(Kp, Vp, k0) do { S.st_v0 = load8((Vp) + (size_t)((k0) + sr) * RS + sc); S.st_v1 = load8((Vp) + (size_t)((k0) + 32 + sr) * RS + sc); S.st_k0 = load8((Kp) + (size_t)((k0) + kr) * RS + kc); } while (0)
#define DA_SWRITE_K(bf) do { *(bf16x8*)(K_lds + (bf) * SHM_K + kws) = S.st_k0; } while (0)
#define DA_SWRITE_V(bf) do { *(bf16x8*)(V_lds + (bf) * SHM_V + vst0) = S.st_v0; *(bf16x8*)(V_lds + (bf) * SHM_V + vst1) = S.st_v1; } while (0)
__device__ __forceinline__ void prime(const BlockRef& cur, char* lds, Seam& S) {
    const int tid = threadIdx.x, wid = __builtin_amdgcn_readfirstlane(tid >> 6), lane = tid & 63, r32 = lane & 31, hi = lane >> 5;
    const int sr = tid >> 4, sc = (tid & 15) * 8, kr = tid >> 3, kc = (tid & 7) * 8, kws = DA_KSWZ(kr, kc * 2); char* K_lds = lds + NVB * SHM_V;
#pragma unroll
    for (int d0 = 0; d0 < 4; ++d0) S.qr[d0] = load8(cur.Q + (size_t)(wid * QBLK + r32) * RS + d0 * 16 + hi * 8);
    DA_SLOAD(cur.K, cur.V, 0); DA_VMW(); DA_SWRITE_K(0);
    __syncthreads();
}
__device__ __forceinline__ void block(const BlockRef& cur, const BlockRef& nxt, char* lds, Seam& S) {
    const int tid = threadIdx.x, wid = __builtin_amdgcn_readfirstlane(tid >> 6), lane = tid & 63, r32 = lane & 31, hi = lane >> 5;
    const int NT = (cur.P0 + QB) / KVBLK;
    const int qlo = cur.P0 + wid * QBLK, qm = qlo + r32 - 4 * hi;
    char* V_lds = lds; char* K_lds = lds + NVB * SHM_V;
    float* ws = (float*)(lds + LDS_WS) + wid * 64; float* li_l = ws, * al_l = ws + 32;
    const __attribute__((address_space(3))) float* tab = (const __attribute__((address_space(3))) float*)((__attribute__((address_space(3))) char*)lds + LDS_TAB);
    float m_reg = -1e30f, l_reg = 0; f32x16 o[4] = {};
    const int sr = tid >> 4, sc = (tid & 15) * 8, vst0 = v_st(sr, sc), vst1 = v_st(32 + sr, sc), kr = tid >> 3, kc = (tid & 7) * 8, kws = DA_KSWZ(kr, kc * 2);
    const int vb0 = (int)(uintptr_t)V_lds + v_rd_base(lane);
    const bf16* Kh = cur.K; const bf16* Vh = cur.V;
#define DA_RESC(a) do { if (__any((a) < 1.f)) { if (hi == 0) al_l[r32] = (a); asm volatile("s_waitcnt lgkmcnt(0)" ::: "memory"); \
                     _Pragma("unroll") for (int d_ = 0; d_ < 4; ++d_) _Pragma("unroll") for (int r = 0; r < 16; ++r) o[d_][r] *= al_l[crow(r, hi)]; } } while (0)
#define DA_KBASE(t) ((t) * KVBLK)
#define DA_MASKT(P0_, P1_, t) do { const int kb_ = DA_KBASE(t); if (kb_ + KVBLK - 1 >= qlo - 127) bias_tile(P0_, P1_, qm - kb_, tab); } while (0)
    constexpr int NQL = 4;
#define DA_SEAM_K0() do { DA_VMWN(NQL); DA_SWRITE_K(0); DA_SBAR(); } while (0)
    f32x16 pA0, pA1, pB0, pB1; float mnA, mnB, alA, alB; bf16x8 pa0, pa1, pa2, pa3;
    DA_SWRITE_V(0); DA_SBAR();
    DA_SLOAD(Kh, Vh, DA_KBASE(1));
    DA_SBAR(); qkt<0>(pA0, pA1, K_lds, r32, hi, S.qr);
    DA_MASKT(pA0, pA1, 0); rowmaxSM(pA0, pA1, m_reg, mnA, alA); expSM(pA0, pA1, mnA);
    DA_VMW(); DA_SWRITE_V(1); DA_SWRITE_K(1); DA_SBAR();
    DA_SLOAD(Kh, Vh, DA_KBASE(2));
    __syncthreads();
    int vrd = 0, vwr = 2;
#define DA_NEXT3(x) ((x) == NVB - 1 ? 0 : (x) + 1)
#define DA_HALF_STEP(PX0, PX1, mnX, alX, PY0, PY1, alY, t, KB) do { \
        DA_SBAR(); qkt<KB>(PX0, PX1, K_lds, r32, hi, S.qr); \
        finishSM(PY0, PY1, alY, l_reg, pa0, pa1, pa2, pa3); DA_SBAR(); \
        DA_VMW(); DA_SWRITE_K(1 - (KB)); DA_SWRITE_V(vwr); DA_SBAR(); \
        if ((t) + 2 < NT) { DA_SLOAD(Kh, Vh, DA_KBASE((t) + 2)); DA_SBAR(); } \
        DA_MASKT(PX0, PX1, (t)); rowmaxSM(PX0, PX1, m_reg, mnX, alX); DA_SBAR(); \
        pv_tile<true>(o, vb0 + vrd * SHM_V, pa0, pa1, pa2, pa3, PX0, PX1, mnX); \
        DA_RESC(alX); __syncthreads(); vrd = DA_NEXT3(vrd); vwr = DA_NEXT3(vwr); } while (0)
    for (int t = 1; t + 1 < NT; t += 2) {
        DA_HALF_STEP(pB0, pB1, mnB, alB, pA0, pA1, alA, t, 1);
        DA_HALF_STEP(pA0, pA1, mnA, alA, pB0, pB1, alB, t + 1, 0);
    }
    DA_SBAR(); qkt<1>(pB0, pB1, K_lds, r32, hi, S.qr); DA_SBAR();
    DA_SLOAD(nxt.K, nxt.V, 0); DA_SBAR();
#pragma unroll
    for (int d0 = 0; d0 < 4; ++d0) S.qr[d0] = load8(nxt.Q + (size_t)(wid * QBLK + r32) * RS + d0 * 16 + hi * 8);
    DA_SBAR();
    finishSM(pA0, pA1, alA, l_reg, pa0, pa1, pa2, pa3); DA_SBAR();
    DA_MASKT(pB0, pB1, NT - 1); rowmaxSM(pB0, pB1, m_reg, mnB, alB); DA_SBAR();
    pv_tile<true>(o, vb0 + vrd * SHM_V, pa0, pa1, pa2, pa3, pB0, pB1, mnB); vrd = DA_NEXT3(vrd);
    DA_RESC(alB);
    finishSM(pB0, pB1, alB, l_reg, pa0, pa1, pa2, pa3); DA_SBAR(); pv_tile<false>(o, vb0 + vrd * SHM_V, pa0, pa1, pa2, pa3, pB0, pB1, 0.f);
    __syncthreads();
    DA_SBAR(); DA_SEAM_K0();
    if (hi == 0) li_l[r32] = l_reg; asm volatile("s_waitcnt lgkmcnt(0)" ::: "memory");
    bf16* Ow = cur.O + (size_t)(wid * QBLK) * RS;
    { char* stg = lds + LDS_OST + wid * OST_WAVE;
#pragma unroll
      for (int ps = 0; ps < 2; ++ps) {
#pragma unroll
          for (int r = 8 * ps; r < 8 * ps + 8; ++r) { const int orow = crow(r, hi) - 16 * ps; const float rli_r = __builtin_amdgcn_rcpf(li_l[crow(r, hi)]);
#pragma unroll
              for (int d0 = 0; d0 < 4; ++d0) { const float v = o[d0][r] * rli_r;
                  const float vn = __int_as_float(__builtin_amdgcn_update_dpp(0, __float_as_int(v), 0xB1, 0xf, 0xf, true));
                  if ((r32 & 1) == 0) *(unsigned*)(stg + orow * 256 + (d0 * 32 + r32) * 2) = cvtpk(v, vn); } }
          asm volatile("s_waitcnt lgkmcnt(0)" ::: "memory");
          u32x4 w[4];
#pragma unroll
          for (int i = 0; i < 4; ++i) { const int row = 4 * i + (lane >> 4), ch = lane & 15; w[i] = *(const u32x4*)(stg + row * 256 + ch * 16); }
          asm volatile("s_waitcnt lgkmcnt(0)" ::: "memory");
#pragma unroll
          for (int i = 0; i < 4; ++i) { const int row = 4 * i + (lane >> 4), ch = lane & 15; *(u32x4*)(Ow + (size_t)(16 * ps + row) * RS + ch * 8) = w[i]; } } }
    __syncthreads();
#undef DA_NEXT3
#undef DA_RESC
#undef DA_KBASE
#undef DA_MASKT
#undef DA_SEAM_K0
#undef DA_HALF_STEP
}
#undef DA_VMW
#undef DA_VMWN
#undef DA_SLOAD
#undef DA_SWRITE_K
#undef DA_SWRITE_V
struct Tensors { const bf16* Q; const bf16* K; const bf16* V; bf16* O1; bf16* O2; const float* biastab; };
__device__ __forceinline__ BlockRef unit_ref(const Tensors& T, int v, int i) {
    const int bhc = (v & 255) >> 1, s = v & 1, b = bhc >> 4, h = (bhc >> 1) & 7, c = bhc & 1; const int q2 = 2 * (i >> 1) + s, qb = (i & 1) ? 15 - q2 : q2;
    const size_t row0 = (size_t)b * SEQ; BlockRef r;
    r.Q = T.Q + (row0 + (size_t)qb * QB) * RS + (2 * h + c) * DK; r.K = T.K + row0 * RS + (2 * h + c) * DK; r.V = T.V + row0 * RS + h * DV;
    r.O = (c ? T.O2 : T.O1) + (row0 + (size_t)qb * QB) * RS + h * DV; r.P0 = qb * QB; return r;
}
__device__ __forceinline__ void phase(char* lds, const Tensors& T, int vcu) {
    { const int h = ((vcu & 255) >> 2) & 7, i = (int)threadIdx.x; if (i < TAB_N) ((float*)(lds + LDS_TAB))[i] = i < TAB_PADL ? -__builtin_inff() : (i < TAB_PADL + 128 ? T.biastab[h * 128 + i - TAB_PADL] : 0.f); }
    Seam S; BlockRef cur = unit_ref(T, vcu, 0);
    prime(cur, lds, S);
    if (threadIdx.x >= 256) __builtin_amdgcn_s_setprio(1);
    for (int i = 0; i < 8; ++i) { const BlockRef nxt = unit_ref(T, vcu, i + 1 < 8 ? i + 1 : i); block(cur, nxt, lds, S); cur = nxt; }
    __builtin_amdgcn_s_setprio(0);
}
#undef DA_KSWZ
#undef DA_SBAR
}
#ifndef PG8_SP2
#define PG8_SP2 true
#endif
#ifndef PG8_ALIGN
#define PG8_ALIGN true
#endif
constexpr int NWAVES = 8;
#ifndef MK_N_LAUNCHES
#define MK_N_LAUNCHES 1
#endif
constexpr int N_PHASES = 8;
constexpr int BATCH = 8, SEQ = 4096, D = 2048, M = BATCH * SEQ;
constexpr int NPROJ = 5120, DATT = 1024, DCONV = 1024, CONVW = 31;
constexpr int PH = 8, PNK = 128, PHALF = 128, PTOPK = 16, NEXP = 16384;
constexpr float LN_EPS = 1e-5f;
constexpr float DN_ALPHA = 1.189207115002721f;
constexpr float LAMBDA_INIT = 0.2f;
constexpr size_t MiB = 1u << 20;
constexpr size_t WS_WIN = 2 * MiB, WS_WOUT = 22 * MiB, WS_WQ = 30 * MiB, WS_KEYS = 38 * MiB, WS_TAB = 39 * MiB;
constexpr size_t WS_U8 = 40 * MiB, WS_V8 = 72 * MiB, WS_SU = 104 * MiB, WS_SV = 105 * MiB;
constexpr size_t WS_XB = 168 * MiB;
constexpr size_t WS_Q = 296 * MiB, WS_K = 360 * MiB, WS_V = 424 * MiB, WS_H = 488 * MiB;
constexpr size_t WS_O1 = 552 * MiB, WS_O2 = 616 * MiB;
constexpr size_t WS_Y1 = 680 * MiB;
constexpr size_t WS_QP = 808 * MiB;
constexpr size_t WS_X8 = WS_O1;
constexpr size_t WS_SX = 106 * MiB, WS_SWQ = 107 * MiB, WS_SWIN = WS_SWQ + 65536, WS_SWOUT = WS_SWQ + 131072, WS_SXA = 108 * MiB, WS_SM = 109 * MiB, WS_LNS = 110 * MiB, WS_SXQ = 111 * MiB, WS_NSU = 112 * MiB;
constexpr size_t WS_XH = WS_O2, WS_XL = WS_O2 + 32 * MiB;
constexpr size_t WS_CMAX = 16384;
constexpr size_t WS_EID = 936 * MiB, WS_GATE = 952 * MiB;
constexpr size_t WS_END = 968 * MiB;
constexpr int RING_BYTES = 131072, LDS_BYTES = 163840;

#define GAS __attribute__((address_space(1)))
#define LAS __attribute__((address_space(3)))
typedef unsigned short bf16;
typedef unsigned v4u __attribute__((ext_vector_type(4)));
typedef unsigned v2u __attribute__((ext_vector_type(2)));
typedef float f32x4 __attribute__((ext_vector_type(4)));
typedef float f32x16 __attribute__((ext_vector_type(16)));
typedef short bf16x8 __attribute__((ext_vector_type(8)));
typedef __bf16 bf16x2_t __attribute__((ext_vector_type(2)));
#define LDS_WAIT() asm volatile("s_waitcnt lgkmcnt(0)" ::: "memory")
#ifndef PROBE_SEC
#define PROBE_SEC -1
#endif
#ifndef PROBE_REP
#define PROBE_REP -1
#endif
#define SEC_REP(id) for (int sec_rep_ = 0; sec_rep_ < ((PROBE_REP == (id)) ? 2 : 1); ++sec_rep_)
#define SEC_BEGIN(id) const unsigned long long sec_t0_##id = (PROBE_SEC == (id)) ? __builtin_amdgcn_s_memrealtime() : 0ull
#define SEC_END(id) do { if (PROBE_SEC == (id)) { const unsigned long long t1_ = __builtin_amdgcn_s_memrealtime(), dt_ = t1_ - sec_t0_##id; while (__builtin_amdgcn_s_memrealtime() - t1_ < dt_) __builtin_amdgcn_s_sleep(4); } } while (0)
__device__ __forceinline__ unsigned f2bf(float f) { unsigned u = __builtin_bit_cast(unsigned, f); return (u + 0x7fffu + ((u >> 16) & 1u)) >> 16; }
__device__ __forceinline__ unsigned pk2(float lo, float hi) { return f2bf(lo) | (f2bf(hi) << 16); }
__device__ __forceinline__ float bflo(unsigned w) { return __uint_as_float(w << 16); }
__device__ __forceinline__ float bfhi(unsigned w) { return __uint_as_float(w & 0xffff0000u); }
__device__ __forceinline__ float wave_sum(float v);
__device__ __forceinline__ float wave_max(float v);
__device__ __forceinline__ float dot2bf(unsigned a, unsigned b, float acc) { return __builtin_amdgcn_fdot2_f32_bf16(__builtin_bit_cast(bf16x2_t, a), __builtin_bit_cast(bf16x2_t, b), acc, false); }

#define XB_TMO      128
#define XB_XCNT(j)  (256  + 64 * (j))
#define XB_XSUB(j)  (1280 + 64 * (j))
#define XB_XGEN(j)  (2304 + 64 * (j))
#define XB_TOP      3328
#define XB_TOPGEN   3392
#define XCD_BAR_WORDS 3456
#define XB_SPIN_CAP (1u << 18)

__device__ __forceinline__ unsigned xb_ld(unsigned* p)              { return __hip_atomic_load(p, __ATOMIC_RELAXED, __HIP_MEMORY_SCOPE_AGENT); }
__device__ __forceinline__ unsigned xb_add(unsigned* p, unsigned v) { return __hip_atomic_fetch_add(p, v, __ATOMIC_RELAXED, __HIP_MEMORY_SCOPE_AGENT); }
__device__ __forceinline__ unsigned xb_xcc_id() { return (unsigned)__builtin_amdgcn_s_getreg((3 << 11) | 20) & 0xFu; }
#define XB_SPIN(cond, bar) do { unsigned _sp = 0; while (cond) { __builtin_amdgcn_s_sleep(1); \
    if ((++_sp & 255u) == 0u) { if (xb_ld(&(bar)[XB_TMO])) break; if (_sp > XB_SPIN_CAP) { atomicAdd(&(bar)[XB_TMO], 1u); break; } } } } while (0)

struct XcdBarrier {
    unsigned* bar; unsigned x;
    volatile LAS unsigned* st;
};

__device__ __forceinline__ XcdBarrier xcd_barrier_post(unsigned* bar, volatile LAS unsigned* st) {
    XcdBarrier b; b.bar = bar; b.x = xb_xcc_id(); b.st = st;
    if (threadIdx.x == 0) (void)xb_add(&bar[XB_XCNT(b.x)], 1u);
    return b;
}
__device__ __forceinline__ void xcd_barrier_complete(unsigned* bar, unsigned x, unsigned& nloc, unsigned& nx) {
    const unsigned G = gridDim.x * gridDim.y * gridDim.z;
    unsigned sum, cnt, mine, sp = 0u;
    for (;;) {
        sum = 0u; cnt = 0u; mine = 0u;
#pragma unroll
        for (unsigned j = 0; j < 16; ++j) { const unsigned c = xb_ld(&bar[XB_XCNT(j)]); sum += c; cnt += (c > 0u) ? 1u : 0u; mine = (j == x) ? c : mine; }
        if (sum == G) break;
        __builtin_amdgcn_s_sleep(1);
        if ((++sp & 255u) == 0u) { if (xb_ld(&bar[XB_TMO])) break; if (sp > XB_SPIN_CAP) { atomicAdd(&bar[XB_TMO], 1u); break; } }
    }
    nloc = mine > 0u ? mine : 1u; nx = cnt > 0u ? cnt : 1u;
}

__device__ __forceinline__ void xcd_barrier(const XcdBarrier& b) {
    asm volatile("s_waitcnt vmcnt(0)" ::: "memory");
    __syncthreads();
    if (threadIdx.x == 0) {
        unsigned* bar = b.bar;
        __builtin_amdgcn_s_waitcnt(0);
        unsigned nloc = b.st[0], nx = b.st[1];
        if (nloc == 0u) { xcd_barrier_complete(bar, b.x, nloc, nx); b.st[0] = nloc; b.st[1] = nx; }
        const unsigned old = xb_add(&bar[XB_XSUB(b.x)], 1u);
        const unsigned gen = old / nloc;
        if (old + 1u == (gen + 1u) * nloc) {
            __builtin_amdgcn_fence(__ATOMIC_RELEASE, "agent");
            asm volatile("s_waitcnt vmcnt(0)" ::: "memory");
            const unsigned og = xb_add(&bar[XB_TOP], 1u);
            const unsigned tg = og / nx;
            if (og + 1u == (tg + 1u) * nx) xb_add(&bar[XB_TOPGEN], 1u);
            else XB_SPIN(xb_ld(&bar[XB_TOPGEN]) == tg, bar);
            __builtin_amdgcn_fence(__ATOMIC_ACQUIRE, "agent");
            xb_add(&bar[XB_XGEN(b.x)], 1u);
            asm volatile("s_waitcnt vmcnt(0)" ::: "memory");
        } else {
            XB_SPIN(xb_ld(&bar[XB_XGEN(b.x)]) == gen, bar);
            __builtin_amdgcn_fence(__ATOMIC_ACQUIRE, "agent");
            asm volatile("s_waitcnt vmcnt(0)" ::: "memory");
        }
    }
    __syncthreads();
}

struct Frame {
    LAS unsigned char* lds;
    __device__ __forceinline__ int wave_() const { int w = __builtin_amdgcn_readfirstlane((int)threadIdx.x >> 6); asm volatile("" : "+s"(w)); return w; }
    __device__ __forceinline__ int G_() const { int g = (int)gridDim.x; asm volatile("" : "+s"(g)); return g; }
    __device__ __forceinline__ int vcu_() const { int bx = (int)blockIdx.x; asm volatile("" : "+s"(bx)); const int g = G_(); return (g % 8 == 0) ? (bx % 8) * (g / 8) + bx / 8 : bx; }
    __device__ __forceinline__ int tid() const { int t = (int)threadIdx.x; asm volatile("" : "+v"(t)); return t; }
    __device__ __forceinline__ int lane() const { return tid() & 63; }
    __device__ __forceinline__ unsigned long long raw(int k) const { const volatile LAS unsigned* p = (const volatile LAS unsigned*)(lds + RING_BYTES) + 2 * k;
        const unsigned lo = __builtin_amdgcn_readfirstlane(p[0]), hi = __builtin_amdgcn_readfirstlane(p[1]); return ((unsigned long long)hi << 32) | lo; }
    __device__ __forceinline__ const float* in(int k) const { return (const float*)(const GAS float*)raw(k); }
    __device__ __forceinline__ float* outp() const { return (float*)(GAS float*)raw(22); }
    template <class T> __device__ __forceinline__ T* ws(size_t off) const { return (T*)(GAS T*)((GAS unsigned char*)raw(23) + off); }
};
enum { I_X = 0, I_WIN, I_BGLU, I_CONVW, I_CONVB, I_CLNG, I_CLNB, I_LQ1, I_LK1, I_LQ2, I_LK2, I_SUBLN, I_RELB, I_WOUT, I_LN1G, I_LN1B, I_WQ, I_KEYS, I_U, I_V, I_LN2G, I_LN2B };

template <int CTRL> __device__ __forceinline__ int dppi(int v) { return __builtin_amdgcn_update_dpp(0, v, CTRL, 0xf, 0xf, true); }
template <int CTRL> __device__ __forceinline__ float dppf(float v) { return __int_as_float(__builtin_amdgcn_update_dpp(0, __float_as_int(v), CTRL, 0xf, 0xf, true)); }
__device__ __forceinline__ unsigned pack_i8x4(float a, float b, float c, float d) {
    const int ia = (int)rintf(a), ib = (int)rintf(b), ic = (int)rintf(c), id = (int)rintf(d); return (unsigned)(ia & 255) | ((unsigned)(ib & 255) << 8) | ((unsigned)(ic & 255) << 16) | ((unsigned)id << 24); }
__device__ __forceinline__ void p0_colmax_item(const float* W, int N, unsigned* cmax, int k0, int n0, int dst0, int lane) {
    f32x4 am = {0.f, 0.f, 0.f, 0.f};
#pragma unroll
    for (int i = 0; i < 8; ++i) { const f32x4 v = *(const GAS f32x4*)(W + (size_t)(k0 + 8 * i + (lane >> 3)) * N + n0 + 4 * (lane & 7));
        am[0] = fmaxf(am[0], fabsf(v[0])); am[1] = fmaxf(am[1], fabsf(v[1])); am[2] = fmaxf(am[2], fabsf(v[2])); am[3] = fmaxf(am[3], fabsf(v[3])); }
#pragma unroll
    for (int e = 0; e < 4; ++e) { am[e] = fmaxf(am[e], __shfl_xor(am[e], 8)); am[e] = fmaxf(am[e], __shfl_xor(am[e], 16)); am[e] = fmaxf(am[e], __shfl_xor(am[e], 32)); }
    if (lane < 8) {
#pragma unroll
        for (int e = 0; e < 4; ++e) atomicMax(cmax + dst0 + 4 * lane + e, __float_as_uint(am[e])); }
}
__device__ __forceinline__ void p0_quant_item(const float* W, int N, unsigned char* WT8, const unsigned* cmax, float* scale, int k0, int n0, int dst0, LAS float* scr, int lane) {
#pragma unroll
    for (int i = 0; i < 8; ++i) { const int kk = 8 * i + (lane >> 3); const f32x4 v = *(const GAS f32x4*)(W + (size_t)(k0 + kk) * N + n0 + 4 * (lane & 7));
        LAS float* d = scr + kk * 33 + 4 * (lane & 7); d[0] = v[0]; d[1] = v[1]; d[2] = v[2]; d[3] = v[3]; }
    if (lane < 32) { const float am = __uint_as_float(__hip_atomic_load(cmax + dst0 + lane, __ATOMIC_RELAXED, __HIP_MEMORY_SCOPE_AGENT)); const float sc = am > 0.f ? am * (1.f / 127.f) : 1.f;
        scr[64 * 33 + lane] = 1.f / sc; if (k0 == 0) scale[dst0 + lane] = sc; }
    LDS_WAIT(); asm volatile("" ::: "memory");
    const int c = lane & 7;
#pragma unroll
    for (int j = 0; j < 4; ++j) { const int n = (lane >> 3) + 8 * j; const LAS float* sp = scr + (8 * c) * 33 + n; const float inv = scr[64 * 33 + n];
        *(GAS v2u*)(WT8 + (size_t)(dst0 + n) * D + k0 + 8 * c) = (v2u){pack_i8x4(sp[0 * 33] * inv, sp[1 * 33] * inv, sp[2 * 33] * inv, sp[3 * 33] * inv), pack_i8x4(sp[4 * 33] * inv, sp[5 * 33] * inv, sp[6 * 33] * inv, sp[7 * 33] * inv)}; }
    LDS_WAIT(); asm volatile("" ::: "memory");
}
__device__ __forceinline__ int glu_dst(int n0) {
    if (n0 < 3072) return n0;
    const int ch = (n0 - 3072) & 1023, gate = (n0 - 3072) >> 10; return 3072 + 256 * (ch >> 7) + 64 * ((ch & 127) >> 5) + 32 * gate + (ch & 31);
}
__device__ __forceinline__ void p0_quant_x(const float* src, unsigned char* dst8, float* scale, int rows, int gw, int NGW, int lane) {
    f32x4 nx[8], nx2[8];
    if (gw < rows) { const GAS f32x4* sp = (const GAS f32x4*)(src + (size_t)gw * D) + lane; const int r1 = (gw + NGW < rows) ? gw + NGW : gw; const GAS f32x4* sq = (const GAS f32x4*)(src + (size_t)r1 * D) + lane;
#pragma unroll
        for (int j = 0; j < 8; ++j) { nx[j] = sp[64 * j]; nx2[j] = sq[64 * j]; } }
    for (int r = gw; r < rows; r += NGW) {
        f32x4 v[8]; float am = 0.f;
#pragma unroll
        for (int j = 0; j < 8; ++j) { v[j] = nx[j]; nx[j] = nx2[j]; }
        { const int rn = (r + 2 * NGW < rows) ? r + 2 * NGW : r; const GAS f32x4* sp = (const GAS f32x4*)(src + (size_t)rn * D) + lane;
#pragma unroll
          for (int j = 0; j < 8; ++j) nx2[j] = sp[64 * j]; }
#pragma unroll
        for (int j = 0; j < 8; ++j) am = fmaxf(fmaxf(am, fmaxf(fabsf(v[j].x), fabsf(v[j].y))), fmaxf(fabsf(v[j].z), fabsf(v[j].w)));
        am = wave_max(am);
        const float sc = am > 0.f ? am * (1.f / 127.f) : 1.f, inv = 1.f / sc;
        GAS unsigned* dp = (GAS unsigned*)(dst8 + (size_t)r * D) + lane;
#pragma unroll
        for (int j = 0; j < 8; ++j) dp[64 * j] = pack_i8x4(v[j].x * inv, v[j].y * inv, v[j].z * inv, v[j].w * inv);
        if (lane == 0) scale[r] = sc;
    }
}
__device__ __forceinline__ void p0_convert(const float* src, bf16* dst, size_t n, int gw, int NGW, int lane) {
    const size_t nit = n / 512;
    for (size_t it = gw; it < nit; it += NGW) { const GAS f32x4* s = (const GAS f32x4*)(src + it * 512) + 2 * lane; const f32x4 a = s[0], b = s[1];
        v4u o; o.x = pk2(a.x, a.y); o.y = pk2(a.z, a.w); o.z = pk2(b.x, b.y); o.w = pk2(b.z, b.w); *((GAS v4u*)(dst + it * 512) + lane) = o; }
}
template <bool INT8> __device__ __forceinline__ void p0_quant_rows(const float* src, unsigned* dst8, float* scale, int rows, int gw, int NGW, int lane) {
    f32x4 nx[8], nx2[8];
    if (gw < rows) { const GAS f32x4* sp = (const GAS f32x4*)(src + (size_t)gw * D) + lane; const int r1 = (gw + NGW < rows) ? gw + NGW : gw; const GAS f32x4* sq = (const GAS f32x4*)(src + (size_t)r1 * D) + lane;
#pragma unroll
        for (int j = 0; j < 8; ++j) { nx[j] = sp[64 * j]; nx2[j] = sq[64 * j]; } }
    for (int r = gw; r < rows; r += NGW) {
        f32x4 v[8]; float am = 0.f;
#pragma unroll
        for (int j = 0; j < 8; ++j) { v[j] = nx[j]; nx[j] = nx2[j]; }
        { const int rn = (r + 2 * NGW < rows) ? r + 2 * NGW : r; const GAS f32x4* sp = (const GAS f32x4*)(src + (size_t)rn * D) + lane;
#pragma unroll
          for (int j = 0; j < 8; ++j) nx2[j] = sp[64 * j]; }
#pragma unroll
        for (int j = 0; j < 8; ++j) am = fmaxf(fmaxf(am, fmaxf(fabsf(v[j].x), fabsf(v[j].y))), fmaxf(fabsf(v[j].z), fabsf(v[j].w)));
        am = wave_max(am);
        const float sc = am > 0.f ? am * (INT8 ? (1.f / 127.f) : (1.f / 440.f)) : 1.f, inv = 1.f / sc;
#pragma unroll
        for (int j = 0; j < 8; ++j) { int w;
            if (INT8) w = (int)pack_i8x4(v[j].x * inv, v[j].y * inv, v[j].z * inv, v[j].w * inv);
            else { w = __builtin_amdgcn_cvt_pk_fp8_f32(v[j].x * inv, v[j].y * inv, 0, false); w = __builtin_amdgcn_cvt_pk_fp8_f32(v[j].z * inv, v[j].w * inv, w, true); }
            const int wi = lane + 64 * j, c = wi >> 5; *((GAS unsigned*)dst8 + ((size_t)c * rows + r) * 32 + (wi & 31)) = (unsigned)w; }
        if (lane == 0) scale[r] = sc;
    }
}
template <bool HI2C  > __device__ __forceinline__ void p0_quant_u4(const float* src, unsigned* dst4, float* scale, float* nsum  , int rows, int gw, int NGW, int lane) {
    f32x4 nx[8], nx2[8];
    if (gw < rows) { const GAS f32x4* sp = (const GAS f32x4*)(src + (size_t)gw * D) + lane; const int r1 = (gw + NGW < rows) ? gw + NGW : gw; const GAS f32x4* sq = (const GAS f32x4*)(src + (size_t)r1 * D) + lane;
#pragma unroll
        for (int j = 0; j < 8; ++j) { nx[j] = sp[64 * j]; nx2[j] = sq[64 * j]; } }
    for (int r = gw; r < rows; r += NGW) {
        f32x4 v[8]; float ss = 0.f;
#pragma unroll
        for (int j = 0; j < 8; ++j) { v[j] = nx[j]; nx[j] = nx2[j]; }
        { const int rn = (r + 2 * NGW < rows) ? r + 2 * NGW : r; const GAS f32x4* sp = (const GAS f32x4*)(src + (size_t)rn * D) + lane;
#pragma unroll
          for (int j = 0; j < 8; ++j) nx2[j] = sp[64 * j]; }
#pragma unroll
        for (int j = 0; j < 8; ++j) ss += (v[j].x * v[j].x + v[j].y * v[j].y) + (v[j].z * v[j].z + v[j].w * v[j].w);
        ss = wave_sum(ss);
        const float sc = ss > 0.f ? 0.35f * sqrtf(ss * (1.f / D)) : 1.f, inv = 1.f / sc;
        int nsl = 0;
#pragma unroll
        for (int j = 0; j < 8; ++j) { unsigned own = 0, snd = 0;
#pragma unroll
            for (int e = 0; e < 4; ++e) { const int q = (int)fminf(fmaxf(rintf(v[j][e] * inv), -8.f), 7.f); own |= (unsigned)(q + 8) << (8 * e); snd |= (unsigned)(HI2C ? (q & 15) : (q + 8)) << (8 * e); nsl += q + 8; }
            const unsigned nbr = (unsigned)dppi<0xB1>((int)snd);
            if ((lane & 1) == 0) *((GAS unsigned*)dst4 + ((size_t)j * rows + r) * 32 + (lane >> 1)) = own | (nbr << 4); }
        if (nsum) { const float ns = wave_sum((float)nsl); if (lane == 0) nsum[r] = ns; }
        if (lane == 0) scale[r] = sc;
    }
}
__device__ __forceinline__ int t5_bucket(int d) {
    if (d < 16) return d;
    int l = 16 + (int)(logf((float)d / 16.f) / logf(8.f) * 16.f); return l < 31 ? l : 31;
}
__device__ __forceinline__ void p0a_prologue(Frame& F) {
    LAS float* scr = (LAS float*)(F.lds + F.wave_() * 16384);
    constexpr int I_IN = (D / 64) * (NPROJ / 32), I_OUT = (D / 64) * (D / 32);
    { const float* w_in = F.in(I_WIN); unsigned* cmax = F.ws<unsigned>(WS_CMAX); const int gw = F.vcu_() * NWAVES + F.wave_(), NGW = F.G_() * NWAVES;
      for (int r = gw; r < I_IN; r += NGW) { const int nblk = NPROJ / 32, kb = r / nblk, nb = r % nblk; p0_colmax_item(w_in, NPROJ, cmax, 64 * kb, 32 * nb, glu_dst(32 * nb), F.lane()); } }
    { const float* wq = F.in(I_WQ); unsigned* cmax = F.ws<unsigned>(WS_CMAX) + NPROJ; const int gw = F.vcu_() * NWAVES + F.wave_(), NGW = F.G_() * NWAVES;
      for (int r = gw; r < I_OUT; r += NGW) { const int nblk = D / 32, kb = r / nblk, nb = r % nblk; p0_colmax_item(wq, D, cmax, 64 * kb, 32 * nb, 32 * nb, F.lane()); } }
    { const float* wo = F.in(I_WOUT); unsigned* cmax = F.ws<unsigned>(WS_CMAX) + NPROJ + D; const int gw = F.vcu_() * NWAVES + F.wave_(), NGW = F.G_() * NWAVES;
      for (int r = gw; r < I_OUT; r += NGW) { const int nblk = D / 32, kb = r / nblk, nb = r % nblk; p0_colmax_item(wo, D, cmax, 64 * kb, 32 * nb, 32 * nb, F.lane()); } }
}
__device__ __forceinline__ void p0b_prologue(Frame& F) {
    LAS float* scr = (LAS float*)(F.lds + F.wave_() * 16384);
    constexpr int I_IN = (D / 64) * (NPROJ / 32), I_OUT = (D / 64) * (D / 32);
    { const float* w_in = F.in(I_WIN); unsigned char* W8 = F.ws<unsigned char>(WS_WIN); const unsigned* cmax = F.ws<unsigned>(WS_CMAX); float* sw = F.ws<float>(WS_SWIN); const int gw = F.vcu_() * NWAVES + F.wave_(), NGW = F.G_() * NWAVES;
      for (int r = gw; r < I_IN; r += NGW) { const int nblk = NPROJ / 32, kb = r / nblk, nb = r % nblk; p0_quant_item(w_in, NPROJ, W8, cmax, sw, 64 * kb, 32 * nb, glu_dst(32 * nb), scr, F.lane()); } }
    { const float* wq = F.in(I_WQ); unsigned char* W8 = F.ws<unsigned char>(WS_WQ); const unsigned* cmax = F.ws<unsigned>(WS_CMAX) + NPROJ; float* sw = F.ws<float>(WS_SWQ); const int gw = F.vcu_() * NWAVES + F.wave_(), NGW = F.G_() * NWAVES;
      for (int r = gw; r < I_OUT; r += NGW) { const int nblk = D / 32, kb = r / nblk, nb = r % nblk; p0_quant_item(wq, D, W8, cmax, sw, 64 * kb, 32 * nb, 32 * nb, scr, F.lane()); } }
    { const float* wo = F.in(I_WOUT); unsigned char* W8 = F.ws<unsigned char>(WS_WOUT); const unsigned* cmax = F.ws<unsigned>(WS_CMAX) + NPROJ + D; float* sw = F.ws<float>(WS_SWOUT); const int gw = F.vcu_() * NWAVES + F.wave_(), NGW = F.G_() * NWAVES;
      for (int r = gw; r < I_OUT; r += NGW) { const int nblk = D / 32, kb = r / nblk, nb = r % nblk; p0_quant_item(wo, D, W8, cmax, sw, 64 * kb, 32 * nb, 32 * nb, scr, F.lane()); } }
    { const int gw = F.vcu_() * NWAVES + F.wave_(), NGW = F.G_() * NWAVES; p0_quant_x(F.in(I_X), F.ws<unsigned char>(WS_XB), F.ws<float>(WS_SXA), M, gw, NGW, F.lane()); }
    { const int gw = F.vcu_() * NWAVES + F.wave_(), NGW = F.G_() * NWAVES; p0_quant_u4<false>(F.in(I_U), F.ws<unsigned>(WS_U8), F.ws<float>(WS_SU), F.ws<float>(WS_NSU), NEXP, gw, NGW, F.lane()); }
    { const int gw = F.vcu_() * NWAVES + F.wave_(), NGW = F.G_() * NWAVES; p0_quant_u4<true>(F.in(I_V), F.ws<unsigned>(WS_V8), F.ws<float>(WS_SV), nullptr, NEXP, gw, NGW, F.lane()); }
    { const int gw = F.vcu_() * NWAVES + F.wave_(), NGW = F.G_() * NWAVES; p0_convert(F.in(I_KEYS), F.ws<bf16>(WS_KEYS), (size_t)PH * 2 * PNK * PHALF, gw, NGW, F.lane()); }
    if (blockIdx.x == 0) { const float* rel_bias = F.in(I_RELB); float* TAB = F.ws<float>(WS_TAB);
        for (int i = F.tid(); i < 8 * 128; i += NWAVES * 64) { const int h = i >> 7, d = i & 127;
            TAB[i] = (rel_bias[t5_bucket(d) * 8 + h] - rel_bias[31 * 8 + h]) * 1.4426950408889634f; } }
}

__device__ __forceinline__ float diff_lambda(Frame& F) {
    const float a = wave_sum(F.in(I_LQ1)[F.lane()] * F.in(I_LK1)[F.lane()]), b = wave_sum(F.in(I_LQ2)[F.lane()] * F.in(I_LK2)[F.lane()]);
    return expf(a) - expf(b) + LAMBDA_INIT;
}
template <int CTRL, int RM> __device__ __forceinline__ float dpp_rm(float old, float v) { return __int_as_float(__builtin_amdgcn_update_dpp(__float_as_int(old), __float_as_int(v), CTRL, RM, 0xf, false)); }
__device__ __forceinline__ float wave_sum63(float v) {
    v += dppf<0xB1>(v); v += dppf<0x4E>(v); v += dppf<0x141>(v); v += dppf<0x140>(v);
    v += dpp_rm<0x142, 0xa>(0.f, v);
    v += dpp_rm<0x143, 0xc>(0.f, v);
    return v;
}
__device__ __forceinline__ float wave_max63(float v) {
    v = fmaxf(v, dppf<0xB1>(v)); v = fmaxf(v, dppf<0x4E>(v)); v = fmaxf(v, dppf<0x141>(v)); v = fmaxf(v, dppf<0x140>(v));
    v = fmaxf(v, dpp_rm<0x142, 0xa>(0.f, v)); v = fmaxf(v, dpp_rm<0x143, 0xc>(0.f, v));
    return v;
}
__device__ __forceinline__ float wave_sum(float v) { return __int_as_float(__builtin_amdgcn_readlane(__float_as_int(wave_sum63(v)), 63)); }
__device__ __forceinline__ float wave_max(float v) { return __int_as_float(__builtin_amdgcn_readlane(__float_as_int(wave_max63(v)), 63)); }
typedef _Float16 h2_t __attribute__((ext_vector_type(2)));
__device__ __forceinline__ h2_t pin_h2(float a, float b) { unsigned u = __builtin_bit_cast(unsigned, (h2_t){(_Float16)a, (_Float16)b}); asm volatile("" : "+v"(u)); return __builtin_bit_cast(h2_t, u); }
__device__ __forceinline__ float xr_swap32(float a, float b, bool mx) { auto rr = __builtin_amdgcn_permlane32_swap(__float_as_uint(a), __float_as_uint(b), false, false); const float x = __uint_as_float(rr[0]), y = __uint_as_float(rr[1]); return mx ? fmaxf(x, y) : x + y; }
__device__ __forceinline__ float xr_swap16(float a, float b, bool mx) { auto rr = __builtin_amdgcn_permlane16_swap(__float_as_uint(a), __float_as_uint(b), false, false); const float x = __uint_as_float(rr[0]), y = __uint_as_float(rr[1]); return mx ? fmaxf(x, y) : x + y; }
template <int CTRL> __device__ __forceinline__ float xr_dpp(float lo, float hi, bool t, bool mx) { const float k = t ? hi : lo, s = t ? lo : hi, o = dppf<CTRL>(s); return mx ? fmaxf(k, o) : k + o; }
__device__ __forceinline__ float xred64_sum(const float (&v)[64], int lane) {
    float a[32], b[16], c[8], d[4], e[2];
#pragma unroll
    for (int i = 0; i < 32; ++i) a[i] = xr_swap32(v[i], v[i + 32], false);
#pragma unroll
    for (int i = 0; i < 16; ++i) b[i] = xr_swap16(a[i], a[i + 16], false);
#pragma unroll
    for (int i = 0; i < 8; ++i) c[i] = xr_dpp<0x128>(b[i], b[i + 8], lane & 8, false);
#pragma unroll
    for (int i = 0; i < 4; ++i) d[i] = xr_dpp<0x141>(c[i], c[i + 4], lane & 4, false);
#pragma unroll
    for (int i = 0; i < 2; ++i) e[i] = xr_dpp<0x4E>(d[i], d[i + 2], lane & 2, false);
    return xr_dpp<0xB1>(e[0], e[1], lane & 1, false);
}
__device__ __forceinline__ float xred32_max(const float (&v)[32], int lane) {
    float a[16], b[8], c[4], d[2];
#pragma unroll
    for (int i = 0; i < 16; ++i) a[i] = xr_swap32(v[i], v[i + 16], true);
#pragma unroll
    for (int i = 0; i < 8; ++i) b[i] = xr_swap16(a[i], a[i + 8], true);
#pragma unroll
    for (int i = 0; i < 4; ++i) c[i] = xr_dpp<0x128>(b[i], b[i + 4], lane & 8, true);
#pragma unroll
    for (int i = 0; i < 2; ++i) d[i] = xr_dpp<0x141>(c[i], c[i + 2], lane & 4, true);
    const float e = xr_dpp<0x4E>(d[0], d[1], lane & 2, true);
    return fmaxf(e, dppf<0xB1>(e));
}
#ifndef P3_PROBE_MULT
#define P3_PROBE_MULT 1
#endif
__device__ __forceinline__ void p3_mix(Frame& F) {
    constexpr int TT = 32, NH = TT + CONVW - 1, STG_OFF = 0, STATS_OFF = TT * 1024, AMC_OFF = STATS_OFF + NWAVES * 64 * 4, AMA_OFF = AMC_OFF + TT * NWAVES * 4, MS_OFF = AMA_OFF + 128, INV_OFF = MS_OFF + 256, AVP_OFF = 40960;
    static_assert(INV_OFF + 128 <= AVP_OFF && AVP_OFF + 8 * NWAVES * 64 * 16 <= RING_BYTES && NH == 62, "P3 LDS map");
    const int tid = F.tid(), lane = tid & 63, wave = F.wave_();
    const float lam = diff_lambda(F);
    const float* conv_w = F.in(I_CONVW); const unsigned* H = F.ws<unsigned>(WS_H); const bf16* O1 = F.ws<bf16>(WS_O1); const bf16* O2 = F.ws<bf16>(WS_O2);
    unsigned char* MIX8 = F.ws<unsigned char>(WS_XB); float* SM = F.ws<float>(WS_SM); const float* subln_g = F.in(I_SUBLN);
    const float2 cb = *(const float2*)(F.in(I_CONVB) + 2 * tid), lg = *(const float2*)(F.in(I_CLNG) + 2 * tid), lb = *(const float2*)(F.in(I_CLNB) + 2 * tid);
    LAS float* stats = (LAS float*)(F.lds + STATS_OFF); LAS float* amc = (LAS float*)(F.lds + AMC_OFF); LAS float* ama = (LAS float*)(F.lds + AMA_OFF); LAS float* ms = (LAS float*)(F.lds + MS_OFF); LAS float* invs = (LAS float*)(F.lds + INV_OFF);
    h2_t wk[CONVW];
#pragma unroll
    for (int k = 0; k < CONVW; ++k) { const float2 wf = *(const float2*)(conv_w + k * DCONV + 2 * tid); wk[k] = pin_h2(wf.x, wf.y); }
    const h2_t cbh = pin_h2(cb.x, cb.y);
    unsigned hv[NH];
#define P3_LOAD_H(tile_) do { const int t0_ = (tile_) * TT; const GAS unsigned* hp_ = (const GAS unsigned*)H + (size_t)t0_ * (DCONV / 2) + tid;     \
        _Pragma("unroll") for (int j = 0; j < NH; ++j) hv[j] = *(hp_ + (ptrdiff_t)(j - (CONVW - 1)) * (DCONV / 2)); } while (0)
    { const int ft = F.vcu_() < M / TT ? F.vcu_() : 0; P3_LOAD_H(ft); }
    for (int tile_j = F.vcu_(); tile_j < P3_PROBE_MULT * (M / TT); tile_j += F.G_()) { const int tile_i = tile_j & (M / TT - 1);
        const int t0 = tile_i * TT;
        const int tid = F.tid(), lane = tid & 63;
        v4u oa[4][2], ob[4][2];
#pragma unroll
        for (int rr = 0; rr < 4; ++rr) { const int m = t0 + 4 * wave + rr;
            const GAS char* p1 = (const GAS char*)(O1 + (size_t)m * 1024); const GAS char* p2 = (const GAS char*)(O2 + (size_t)m * 1024); const unsigned lo_ = (unsigned)lane * 32u;
            oa[rr][0] = *(const GAS v4u*)(p1 + lo_); oa[rr][1] = *(const GAS v4u*)(p1 + lo_ + 16); ob[rr][0] = *(const GAS v4u*)(p2 + lo_); ob[rr][1] = *(const GAS v4u*)(p2 + lo_ + 16); }
        __builtin_amdgcn_sched_barrier(0);
        h2_t cv[TT];
        { const unsigned zm = (t0 & (SEQ - 1)) != 0 ? 0xffffffffu : 0u;
#pragma unroll
          for (int j = 0; j < CONVW - 1; ++j) hv[j] &= zm; }
#pragma unroll
        for (int t = 0; t < TT; ++t) { h2_t acc = cbh;
#pragma unroll
            for (int k = 0; k < CONVW; ++k) acc = __builtin_elementwise_fma(__builtin_bit_cast(h2_t, hv[t + k]), wk[k], acc);
            { unsigned u_ = __builtin_bit_cast(unsigned, acc); asm volatile("" : "+v"(u_)); cv[t] = __builtin_bit_cast(h2_t, u_); } }
        __builtin_amdgcn_sched_barrier(0);
#pragma unroll
        for (int rr = 0; rr < 4; ++rr) { float av[16]; h2_t avp[8];
            const v4u a0 = oa[rr][0], a1 = oa[rr][1], b0 = ob[rr][0], b1 = ob[rr][1];
            const unsigned aw[8] = {a0.x, a0.y, a0.z, a0.w, a1.x, a1.y, a1.z, a1.w}, bw[8] = {b0.x, b0.y, b0.z, b0.w, b1.x, b1.y, b1.z, b1.w};
            float ss = 0.f;
#pragma unroll
            for (int i = 0; i < 8; ++i) { av[2 * i] = bflo(aw[i]) - lam * bflo(bw[i]); av[2 * i + 1] = bfhi(aw[i]) - lam * bfhi(bw[i]); ss += av[2 * i] * av[2 * i] + av[2 * i + 1] * av[2 * i + 1]; }
            ss += dppf<0xB1>(ss); ss += dppf<0x4E>(ss); ss += dppf<0x141>(ss);
            const float r = (1.f - LAMBDA_INIT) / sqrtf(ss * (1.f / 128.f) + LN_EPS); float am = 0.f;
#pragma unroll
            for (int e = 0; e < 8; ++e) { avp[e] = pin_h2(av[2 * e] * r * subln_g[16 * (lane & 7) + 2 * e], av[2 * e + 1] * r * subln_g[16 * (lane & 7) + 2 * e + 1]);
                am = fmaxf(am, fmaxf(fabsf((float)avp[e].x), fabsf((float)avp[e].y))); }
            am = wave_max63(am);
            if (lane == 63) ama[4 * wave + rr] = am;
#pragma unroll
            for (int hh = 0; hh < 2; ++hh) *(LAS v4u*)(F.lds + AVP_OFF + ((rr * 2 + hh) * (NWAVES * 64) + tid) * 16) = (v4u){__builtin_bit_cast(unsigned, avp[4 * hh]), __builtin_bit_cast(unsigned, avp[4 * hh + 1]), __builtin_bit_cast(unsigned, avp[4 * hh + 2]), __builtin_bit_cast(unsigned, avp[4 * hh + 3])}; }
        { float sv[64];
#pragma unroll
          for (int t = 0; t < TT; ++t) { const float y0 = (float)cv[t].x, y1 = (float)cv[t].y; sv[2 * t] = y0 + y1; sv[2 * t + 1] = y0 * y0 + y1 * y1; }
          stats[wave * 64 + lane] = xred64_sum(sv, lane); }
        __builtin_amdgcn_sched_barrier(0);
        { const int nx_ = tile_j + F.G_(), nxt = nx_ < P3_PROBE_MULT * (M / TT) ? (nx_ & (M / TT - 1)) : tile_i; P3_LOAD_H(nxt); }
        __syncthreads();
        if (tid < TT) { float s = 0.f, q = 0.f;
#pragma unroll
            for (int w = 0; w < NWAVES; ++w) { s += stats[w * 64 + 2 * tid]; q += stats[w * 64 + 2 * tid + 1]; }
            const float mean = s * (1.f / DCONV), var = fmaxf(q * (1.f / DCONV) - mean * mean, 0.f); ms[2 * tid] = mean; ms[2 * tid + 1] = 1.f / sqrtf(var + LN_EPS); }
        __syncthreads();
        {
            float mv[TT];
#pragma unroll
            for (int q = 0; q < TT / 2; ++q) { const f32x4 st = *(const LAS f32x4*)(ms + 4 * q);
#pragma unroll
                for (int o = 0; o < 2; ++o) { const int t = 2 * q + o; const float mean = st[2 * o], rstd = st[2 * o + 1];
                    const float y0 = ((float)cv[t].x - mean) * rstd * lg.x + lb.x, y1 = ((float)cv[t].y - mean) * rstd * lg.y + lb.y;
#define SWISH_(y) ((y) * __builtin_amdgcn_rcpf(1.f + __builtin_amdgcn_exp2f(-1.4426950409f * (y))))
                    cv[t] = pin_h2(SWISH_(y0), SWISH_(y1));
#undef SWISH_
                    mv[t] = fmaxf(fabsf((float)cv[t].x), fabsf((float)cv[t].y)); } }
            const float amx = xred32_max(mv, lane);
            if ((lane & 1) == 0) amc[(lane >> 1) * NWAVES + wave] = amx; }
        __syncthreads();
        if (tid < TT) { float am = ama[tid];
#pragma unroll
            for (int w = 0; w < NWAVES; ++w) am = fmaxf(am, amc[tid * NWAVES + w]);
            const float sc = am > 0.f ? am * (1.f / 127.f) : 1.f; const _Float16 ih = (_Float16)(1.f / sc);
            ((LAS unsigned*)invs)[tid] = __builtin_bit_cast(unsigned, (h2_t){ih, ih}); SM[t0 + tid] = 1.f / (float)ih; }
        __syncthreads();
        const h2_t K1536 = (h2_t){(_Float16)1536.f, (_Float16)1536.f};
#pragma unroll
        for (int q = 0; q < TT / 4; ++q) { const v4u iv = *(const LAS v4u*)((LAS unsigned*)invs + 4 * q);
            const unsigned ivw[4] = {iv.x, iv.y, iv.z, iv.w};
#pragma unroll
            for (int o = 0; o < 4; ++o) { const int t = 4 * q + o; const unsigned r = __builtin_bit_cast(unsigned, __builtin_elementwise_fma(cv[t], __builtin_bit_cast(h2_t, ivw[o]), K1536));
                *(LAS unsigned short*)(F.lds + STG_OFF + t * 1024 + 2 * tid) = (unsigned short)__builtin_amdgcn_perm(0u, r, 0x0c0c0200u); } }
#pragma unroll
        for (int rr = 0; rr < 4; ++rr) { const h2_t ivh = __builtin_bit_cast(h2_t, ((LAS unsigned*)invs)[4 * wave + rr]);
            const v4u pa_ = *(const LAS v4u*)(F.lds + AVP_OFF + ((rr * 2) * (NWAVES * 64) + tid) * 16), pb_ = *(const LAS v4u*)(F.lds + AVP_OFF + ((rr * 2 + 1) * (NWAVES * 64) + tid) * 16);
            const unsigned pw_[8] = {pa_.x, pa_.y, pa_.z, pa_.w, pb_.x, pb_.y, pb_.z, pb_.w}; unsigned rq[8];
#pragma unroll
            for (int e = 0; e < 8; ++e) rq[e] = __builtin_bit_cast(unsigned, __builtin_elementwise_fma(__builtin_bit_cast(h2_t, pw_[e]), ivh, K1536));
            *((GAS v4u*)(MIX8 + (size_t)(t0 + 4 * wave + rr) * D) + lane) = (v4u){__builtin_amdgcn_perm(rq[1], rq[0], 0x06040200u), __builtin_amdgcn_perm(rq[3], rq[2], 0x06040200u), __builtin_amdgcn_perm(rq[5], rq[4], 0x06040200u), __builtin_amdgcn_perm(rq[7], rq[6], 0x06040200u)}; }
        __syncthreads();
        for (int idx = tid; idx < TT * 64; idx += NWAVES * 64) { const int row = idx >> 6, ch = idx & 63;
            *((GAS v4u*)(MIX8 + (size_t)(t0 + row) * D + DATT) + ch) = *(const LAS v4u*)(F.lds + STG_OFF + row * 1024 + ch * 16); }
        __syncthreads();
    }
}
#undef P3_LOAD_H
__device__ __forceinline__ void p5_ln1(Frame& F) {
    const bf16* Y1 = F.ws<bf16>(WS_Y1); const float* ln1_g = F.in(I_LN1G); const float* ln1_b = F.in(I_LN1B); unsigned char* X8 = F.ws<unsigned char>(WS_X8); float* SX = F.ws<float>(WS_SX); float* LNS = F.ws<float>(WS_LNS); float* SXQ = F.ws<float>(WS_SXQ); unsigned char* XH = F.ws<unsigned char>(WS_XH); unsigned char* XL = F.ws<unsigned char>(WS_XL);
    const int gw = F.vcu_() * NWAVES + F.wave_(), NGW = F.G_() * NWAVES, lane = F.lane();
    v4u nx[4];
    if (gw < M) { const GAS v4u* p = (const GAS v4u*)(Y1 + (size_t)gw * D) + lane;
#pragma unroll
        for (int j = 0; j < 4; ++j) nx[j] = p[64 * j]; }
    for (int m = gw; m < M; m += NGW) {
        v4u w[4]; float v[32]; float s = 0.f;
#pragma unroll
        for (int j = 0; j < 4; ++j) w[j] = nx[j];
        { const int mn = (m + NGW < M) ? m + NGW : m; const GAS v4u* p = (const GAS v4u*)(Y1 + (size_t)mn * D) + lane;
#pragma unroll
          for (int j = 0; j < 4; ++j) nx[j] = p[64 * j]; }
#pragma unroll
        for (int j = 0; j < 4; ++j) { const unsigned ww[4] = {w[j].x, w[j].y, w[j].z, w[j].w};
#pragma unroll
            for (int i = 0; i < 4; ++i) { v[8 * j + 2 * i] = bflo(ww[i]); v[8 * j + 2 * i + 1] = bfhi(ww[i]); s += v[8 * j + 2 * i] + v[8 * j + 2 * i + 1]; } }
        const float mean = wave_sum(s) * (1.f / D); float q = 0.f;
#pragma unroll
        for (int i = 0; i < 32; ++i) { v[i] -= mean; q += v[i] * v[i]; }
        const float rstd = 1.f / sqrtf(wave_sum(q) * (1.f / D) + LN_EPS);
        float am = 0.f;
#pragma unroll
        for (int j = 0; j < 4; ++j) { const int c0 = 8 * lane + 512 * j; const f32x4 g0 = *(const f32x4*)(ln1_g + c0), g1 = *(const f32x4*)(ln1_g + c0 + 4), b0 = *(const f32x4*)(ln1_b + c0), b1 = *(const f32x4*)(ln1_b + c0 + 4);
#pragma unroll
            for (int i = 0; i < 4; ++i) { v[8 * j + i] = v[8 * j + i] * rstd * g0[i] + b0[i]; v[8 * j + 4 + i] = v[8 * j + 4 + i] * rstd * g1[i] + b1[i]; am = fmaxf(am, fmaxf(fabsf(v[8 * j + i]), fabsf(v[8 * j + 4 + i]))); } }
        am = wave_max(am);
        const float sc = am > 0.f ? am * (1.f / 127.f) : 1.f, inv = 1.f / sc;
        GAS v2u* p8 = (GAS v2u*)(X8 + (size_t)m * D) + lane;
#pragma unroll
        for (int j = 0; j < 4; ++j) p8[64 * j] = (v2u){pack_i8x4(v[8 * j] * inv, v[8 * j + 1] * inv, v[8 * j + 2] * inv, v[8 * j + 3] * inv), pack_i8x4(v[8 * j + 4] * inv, v[8 * j + 5] * inv, v[8 * j + 6] * inv, v[8 * j + 7] * inv)};
        { GAS unsigned* ph = (GAS unsigned*)(XH + (size_t)m * (D / 2)) + lane; GAS unsigned* pl = (GAS unsigned*)(XL + (size_t)m * (D / 2)) + lane;
#pragma unroll
          for (int j = 0; j < 4; ++j) { unsigned wh = 0, wl = 0;
#pragma unroll
              for (int i = 0; i < 8; ++i) { const unsigned u = (unsigned)((int)rintf(v[8 * j + i] * inv) + 128); const int sh = 8 * (i & 3) + 4 * (i >> 2); wh |= (u >> 4) << sh; wl |= (u & 15u) << sh; }
              ph[64 * j] = wh; pl[64 * j] = wl; } }
        float qs = 0.f;
#pragma unroll
        for (int i = 0; i < 32; ++i) qs += rintf(v[i] * inv);
        qs = wave_sum(qs);
        if (lane == 0) { SX[m] = sc; LNS[2 * m] = mean; LNS[2 * m + 1] = rstd; SXQ[m] = qs; }
    }
}
__device__ __forceinline__ int f2key(float f) { const int b = __float_as_int(f); return b ^ ((b >> 31) & 0x7fffffff); }
__device__ __forceinline__ float key2f(int k) { return __int_as_float(k ^ ((k >> 31) & 0x7fffffff)); }
#define CE_DESC(a, b) do { const int _x = max(a, b), _y = min(a, b); a = _x; b = _y; } while (0)
template <int N> __device__ __forceinline__ void bitonic_merge_desc(int (&v)[N]) {
#pragma unroll
    for (int j = N >> 1; j > 0; j >>= 1)
#pragma unroll
        for (int i = 0; i < N; ++i) { const int l = i ^ j; if (l > i) CE_DESC(v[i], v[l]); }
}
__device__ __forceinline__ void sort16_desc(int (&v)[16]) {
#define CE_(a, b) CE_DESC(v[a], v[b])
    CE_(0,1); CE_(2,3); CE_(0,2); CE_(1,3); CE_(1,2); CE_(4,5); CE_(6,7); CE_(4,6); CE_(5,7); CE_(5,6); CE_(0,4); CE_(2,6); CE_(2,4); CE_(1,5); CE_(3,7); CE_(3,5); CE_(1,2); CE_(3,4); CE_(5,6);
    CE_(8,9); CE_(10,11); CE_(8,10); CE_(9,11); CE_(9,10); CE_(12,13); CE_(14,15); CE_(12,14); CE_(13,15); CE_(13,14); CE_(8,12); CE_(10,14); CE_(10,12); CE_(9,13); CE_(11,15); CE_(11,13); CE_(9,10); CE_(11,12); CE_(13,14);
    CE_(0,8); CE_(4,12); CE_(4,8); CE_(2,10); CE_(6,14); CE_(6,10); CE_(2,4); CE_(6,8); CE_(10,12); CE_(1,9); CE_(5,13); CE_(5,9); CE_(3,11); CE_(7,15); CE_(7,11); CE_(3,5); CE_(7,9); CE_(11,13);
    CE_(1,2); CE_(3,4); CE_(5,6); CE_(7,8); CE_(9,10); CE_(11,12); CE_(13,14);
#undef CE_
}
__device__ __forceinline__ void merge16(const int (&a)[16], const int (&b)[16], int (&o)[16]) {
#pragma unroll
    for (int i = 0; i < 16; ++i) o[i] = max(a[i], b[15 - i]);
    bitonic_merge_desc<16>(o);
}
__device__ const unsigned char PEER_PAIR[64] = {0,1,2,3,4,5,6,7,8,9,10,11,12,13,14,15, 16,17,18,19,20,21,22,23, 32,33,34,35,36, 48,49,50,51, 64,65,66, 80,81, 96,97, 112,113, 128,144,160,176,192,208,224,240, 0,0,0,0,0,0,0,0,0,0,0,0,0,0};
__device__ __forceinline__ void peer_load_q(bf16x8 (&bq)[8], const bf16* qrow  ) {
    asm volatile("" : "+v"(qrow));
#pragma unroll
    for (int s = 0; s < 8; ++s) bq[s] = *(const GAS bf16x8*)(qrow + 8 * s);
}
__device__ __forceinline__ void peer_subkey_top16(const bf16x8 (&bq)[8], const bf16* keys_hc  , int r32, int hi, int (&o)[16]) {
    int run[16];
#pragma unroll
    for (int mt = 0; mt < 4; ++mt) {
        const bf16* krow = keys_hc + (size_t)(32 * mt + r32) * PHALF + hi * 64;
        asm volatile("" : "+v"(krow));
        bf16x8 ka[8];
#pragma unroll
        for (int s = 0; s < 8; ++s) ka[s] = *(const GAS bf16x8*)(krow + 8 * s);
        f32x16 acc = {};
#pragma unroll
        for (int s = 0; s < 8; ++s) acc = __builtin_amdgcn_mfma_f32_32x32x16_bf16(ka[s], bq[s], acc, 0, 0, 0);
        int g[16];
#pragma unroll
        for (int r = 0; r < 16; ++r) g[r] = (f2key(acc[r]) & ~127) | ((r & 3) + 8 * (r >> 2));
        sort16_desc(g);
        if (mt) {
#pragma unroll
            for (int r = 0; r < 16; ++r) g[r] |= 32 * mt; }
        if (mt == 0) {
#pragma unroll
            for (int r = 0; r < 16; ++r) run[r] = g[r];
        } else { int t2[16]; merge16(run, g, t2);
#pragma unroll
            for (int r = 0; r < 16; ++r) run[r] = t2[r]; }
    }
    int lo[16], hh[16]; const int hi4 = 4 * hi;
#pragma unroll
    for (int i = 0; i < 16; ++i) { run[i] |= hi4; auto rr = __builtin_amdgcn_permlane32_swap((unsigned)run[i], (unsigned)run[i], false, false); lo[i] = (int)rr[0]; hh[i] = (int)rr[1]; }
    merge16(lo, hh, o);
}
__device__ __forceinline__ float gelu_erf(float v) { return 0.5f * v * (1.f + erff(v * 0.70710678118654752f)); }

typedef float f32x2 __attribute__((ext_vector_type(2)));
constexpr int P7_G2 = RING_BYTES + 512 + 8192, P7_B2 = P7_G2 + 8192;
static_assert(P7_B2 + 8192 <= LDS_BYTES, "PEER LDS map (LN2 tables)");
constexpr int P7_G1 = 115712, P7_LNSL = 123904, P7_B1 = RING_BYTES + 512;
static_assert(P7_LNSL + 1024 <= RING_BYTES && P7_B1 + 8192 <= LDS_BYTES, "PEER LDS map (LN1 tables)");
constexpr int P7_W8 = 98304, P7_SW = 114688;
constexpr int P7_ACT = 0, P7_EID = 65536, P7_SCR = 0  , P7_SCR_WAVE = 32 * 33 * 4, PCH = 128, NCH = D / PCH;
static_assert(P7_SCR + NWAVES * P7_SCR_WAVE <= P7_EID && P7_EID + 128 * 128 * 2 <= RING_BYTES, "PEER LDS map");

__device__ __forceinline__ void p7_peer(Frame& F) {
    const int lane = F.lane(), r32 = lane & 31, hi = lane >> 5, j8 = lane & 7, g8 = lane >> 3;
    constexpr int TPB = 128;
    LAS float* ACT = (LAS float*)(F.lds + P7_ACT); LAS unsigned short* EIDL = (LAS unsigned short*)(F.lds + P7_EID);
    LAS int* scr = (LAS int*)(F.lds + P7_SCR + F.wave_() * P7_SCR_WAVE);
    { const float* ln1_g = F.in(I_LN1G); const float* ln1_b = F.in(I_LN1B); const int tid = F.tid();
      *(LAS f32x4*)(F.lds + P7_G1 + tid * 16) = *(const f32x4*)(ln1_g + tid * 4); *(LAS f32x4*)(F.lds + P7_B1 + tid * 16) = *(const f32x4*)(ln1_b + tid * 4);
      *(LAS f32x4*)(F.lds + P7_G2 + tid * 16) = *(const f32x4*)(F.in(I_LN2G) + tid * 4); *(LAS f32x4*)(F.lds + P7_B2 + tid * 16) = *(const f32x4*)(F.in(I_LN2B) + tid * 4); }
    for (int blk = F.vcu_(); blk < M / TPB; blk += F.G_()) {
        const int m0 = blk * TPB;
        SEC_BEGIN(10);
        SEC_REP(10) { const int h = F.wave_(); const bf16* QP = F.ws<bf16>(WS_QP); const bf16* KEYS = F.ws<bf16>(WS_KEYS); float* GATE = F.ws<float>(WS_GATE);
          bf16x8 bqA[8], bqB[8];
          peer_load_q(bqA, QP + (size_t)(m0 + r32) * D + h * 256 + hi * 64);
          for (int tt = 0; tt < 4; ++tt) {
            const int tl = 32 * tt + r32, tok = m0 + tl;
            const bf16* qrow = QP + (size_t)tok * D + h * 256 + hi * 64;
            int s1[16], s2[16];
            peer_load_q(bqB, qrow + 128);
            peer_subkey_top16(bqA, KEYS + (size_t)(h * 2 + 0) * PNK * PHALF, r32, hi, s1);
            asm volatile("" ::: "memory");
            { const int tn = tt + 1 < 4 ? tt + 1 : tt; peer_load_q(bqA, QP + (size_t)(m0 + 32 * tn + r32) * D + h * 256 + hi * 64); }
            peer_subkey_top16(bqB, KEYS + (size_t)(h * 2 + 1) * PNK * PHALF, r32, hi, s2);
            float f1[16], f2[16];
#pragma unroll
            for (int i = 0; i < 16; ++i) { f1[i] = key2f(s1[i]); f2[i] = key2f(s2[i]); }
            if (hi == 0) {
#pragma unroll
                for (int i = 0; i < 16; ++i) { scr[r32 * 33 + i] = s1[i] & 127; scr[r32 * 33 + 16 + i] = s2[i] & 127; } }
            int cand[64];
            {
#define PC(n_, i_, j_) cand[n_] = (f2key(f1[i_] + f2[j_]) & ~255) | (n_)
                PC(0,0,0); PC(1,0,1); PC(2,0,2); PC(3,0,3); PC(4,0,4); PC(5,0,5); PC(6,0,6); PC(7,0,7); PC(8,0,8); PC(9,0,9); PC(10,0,10); PC(11,0,11); PC(12,0,12); PC(13,0,13); PC(14,0,14); PC(15,0,15);
                PC(16,1,0); PC(17,1,1); PC(18,1,2); PC(19,1,3); PC(20,1,4); PC(21,1,5); PC(22,1,6); PC(23,1,7);
                PC(24,2,0); PC(25,2,1); PC(26,2,2); PC(27,2,3); PC(28,2,4);
                PC(29,3,0); PC(30,3,1); PC(31,3,2); PC(32,3,3);
                PC(33,4,0); PC(34,4,1); PC(35,4,2);
                PC(36,5,0); PC(37,5,1); PC(38,6,0); PC(39,6,1); PC(40,7,0); PC(41,7,1);
                PC(42,8,0); PC(43,9,0); PC(44,10,0); PC(45,11,0); PC(46,12,0); PC(47,13,0); PC(48,14,0); PC(49,15,0);
#undef PC
            }
#pragma unroll
            for (int i = 50; i < 64; ++i) cand[i] = (int)0x80000000;
            int c0[16], c1[16]; const int hsel = -hi;
#pragma unroll
            for (int i = 0; i < 16; ++i) { c0[i] = (cand[i] & ~hsel) | (cand[32 + i] & hsel); c1[i] = (cand[16 + i] & ~hsel) | (cand[48 + i] & hsel); }
            sort16_desc(c0); sort16_desc(c1);
            int mh[16]; merge16(c0, c1, mh);
            int sc[16];
            { int lo_[16], hh_[16];
#pragma unroll
              for (int i = 0; i < 16; ++i) { auto rr = __builtin_amdgcn_permlane32_swap((unsigned)mh[i], (unsigned)mh[i], false, false); lo_[i] = (int)rr[0]; hh_[i] = (int)rr[1]; }
              merge16(lo_, hh_, sc); }
            float p[16]; const float mx = key2f(sc[0]); float z = 0.f;
#pragma unroll
            for (int k = 0; k < 16; ++k) { p[k] = __expf(key2f(sc[k]) - mx); z += p[k]; }
            const float rz = 1.f / z;
            LDS_WAIT();
            int eo[8]; float go[8]; const int him = -hi;
#pragma unroll
            for (int kk = 0; kk < 8; ++kk) { const int tag = PEER_PAIR[((sc[kk] & ~him) | (sc[8 + kk] & him)) & 255];
                const int i1 = scr[r32 * 33 + (tag >> 4)], i2 = scr[r32 * 33 + 16 + (tag & 15)];
                eo[kk] = i1 * PNK + i2; go[kk] = __int_as_float((__float_as_int(p[kk]) & ~him) | (__float_as_int(p[8 + kk]) & him)) * rz; }
            *(LAS v4u*)(EIDL + tl * 128 + h * 16 + 8 * hi) = (v4u){(unsigned)(eo[0] | (eo[1] << 16)), (unsigned)(eo[2] | (eo[3] << 16)), (unsigned)(eo[4] | (eo[5] << 16)), (unsigned)(eo[6] | (eo[7] << 16))};
            GAS float* gp = (GAS float*)(GATE + (size_t)tok * 128 + h * 16 + 8 * hi);
            *(GAS f32x4*)gp = (f32x4){go[0], go[1], go[2], go[3]}; *(GAS f32x4*)(gp + 4) = (f32x4){go[4], go[5], go[6], go[7]};
            LDS_WAIT();
          } }
        { const float* LNS = F.ws<float>(WS_LNS); const int tid = F.tid(); if (tid < 64) *(LAS f32x4*)(F.lds + P7_LNSL + tid * 16) = *(const f32x4*)(LNS + 2 * (size_t)m0 + 4 * tid); }
        SEC_END(10);
        __threadfence_block(); __syncthreads();
        const int tw = F.wave_() * (TPB / NWAVES);
        SEC_BEGIN(11);
        SEC_REP(11) {
        for (int i = lane; i < (TPB / NWAVES) * 128; i += 64) ACT[tw * 128 + i] = 0.f;
        { const unsigned char* XH = F.ws<unsigned char>(WS_XH); const unsigned char* XL = F.ws<unsigned char>(WS_XL); const unsigned char* U8 = F.ws<unsigned char>(WS_U8);
#define U_ISSUE(n_, PC, XQ0, XQ1) do { const int c_ = (n_) >> 4, tl_ = tw + ((n_) & 15); \
            XQ0 = *(const GAS v4u*)(XH + (size_t)(m0 + tl_) * (D / 2) + c_ * PCH + 16 * j8); XQ1 = *(const GAS v4u*)(XL + (size_t)(m0 + tl_) * (D / 2) + c_ * PCH + 16 * j8); \
            const LAS unsigned short* ep_ = EIDL + tl_ * 128 + g8; const unsigned char* ub_ = U8 + (size_t)c_ * (NEXP * PCH); const unsigned j16_ = 16u * (unsigned)j8;     \
            _Pragma("unroll") for (int i = 0; i < 16; ++i) { const unsigned e_ = ep_[8 * i]; PC[i] = *(const GAS v4u*)(ub_ + (e_ * PCH + j16_)); } } while (0)
#define U_COMPUTE(n_, PC, XQ0, XQ1) do { const int tl_ = tw + ((n_) & 15); \
            int pp_[16]; \
            _Pragma("unroll") for (int i = 0; i < 16; ++i) { unsigned ah_ = __builtin_amdgcn_udot8(PC[i].x, XQ0.x, 0u, false), al_ = __builtin_amdgcn_udot8(PC[i].x, XQ1.x, 0u, false); \
                ah_ = __builtin_amdgcn_udot8(PC[i].y, XQ0.y, ah_, false); al_ = __builtin_amdgcn_udot8(PC[i].y, XQ1.y, al_, false); ah_ = __builtin_amdgcn_udot8(PC[i].z, XQ0.z, ah_, false); al_ = __builtin_amdgcn_udot8(PC[i].z, XQ1.z, al_, false); \
                ah_ = __builtin_amdgcn_udot8(PC[i].w, XQ0.w, ah_, false); al_ = __builtin_amdgcn_udot8(PC[i].w, XQ1.w, al_, false); pp_[i] = (int)(16u * ah_ + al_); } \
              \
            int q8_[8], q4_[4], q2_[2]; \
            { const bool b2_ = lane & 4; _Pragma("unroll") for (int i = 0; i < 8; ++i) { const int k_ = b2_ ? pp_[2 * i + 1] : pp_[2 * i], s_ = b2_ ? pp_[2 * i] : pp_[2 * i + 1]; q8_[i] = k_ + dppi<0x141>(s_); } } \
            { const bool b1_ = lane & 2; _Pragma("unroll") for (int i = 0; i < 4; ++i) { const int k_ = b1_ ? q8_[2 * i + 1] : q8_[2 * i], s_ = b1_ ? q8_[2 * i] : q8_[2 * i + 1]; q4_[i] = k_ + dppi<0x4E>(s_); } } \
            { const bool b0_ = lane & 1; _Pragma("unroll") for (int i = 0; i < 2; ++i) { const int k_ = b0_ ? q4_[2 * i + 1] : q4_[2 * i], s_ = b0_ ? q4_[2 * i] : q4_[2 * i + 1]; q2_[i] = k_ + dppi<0xB1>(s_); } } \
            const int irow_ = ((lane & 1) << 2) | (lane & 2) | ((lane >> 2) & 1); \
            LAS float* ap_ = ACT + tl_ * 128 + 8 * irow_ + g8; ap_[0] += (float)q2_[0]; ap_[64] += (float)q2_[1]; } while (0)
          constexpr int UCH = 256, NSTEP = (D / UCH) * (TPB / NWAVES);
          v4u pcA[16], pcB[16], xqA0, xqA1, xqB0, xqB1;
          U_ISSUE(0, pcA, xqA0, xqA1);
          for (int n = 0; n < NSTEP; n += 2) {
              U_ISSUE(n + 1, pcB, xqB0, xqB1); __builtin_amdgcn_sched_barrier(0);
              U_COMPUTE(n, pcA, xqA0, xqA1); __builtin_amdgcn_sched_barrier(0);
              { const int nn = (n + 2 < NSTEP) ? n + 2 : n; U_ISSUE(nn, pcA, xqA0, xqA1); }
              __builtin_amdgcn_sched_barrier(0);
              U_COMPUTE(n + 1, pcB, xqB0, xqB1); __builtin_amdgcn_sched_barrier(0);
          }
#undef U_ISSUE
#undef U_COMPUTE
        }
        }
        SEC_END(11); SEC_BEGIN(12);
        LDS_WAIT();
        { const float* SU = F.ws<float>(WS_SU); const float* SV = F.ws<float>(WS_SV); const float* GATE = F.ws<float>(WS_GATE); const float* SX = F.ws<float>(WS_SX); const float* SXQ = F.ws<float>(WS_SXQ); const float* NSU = F.ws<float>(WS_NSU);
        LAS unsigned char* W8L = (LAS unsigned char*)(F.lds + P7_W8); LAS float* SWL = (LAS float*)(F.lds + P7_SW);
        for (int tb = 0; tb < TPB / NWAVES; tb += 8) {
            float nsu_[8][2], su_[8][2], sv_[8][2], gt_[8][2], ac_[8][2], sx_[8], xo_[8];
#pragma unroll
            for (int i = 0; i < 8; ++i) { const int tl = tw + tb + i, t = m0 + tl; sx_[i] = SX[t]; xo_[i] = 8.f * SXQ[t];
#pragma unroll
                for (int kq = 0; kq < 2; ++kq) { const int k = lane + 64 * kq; const unsigned e = EIDL[tl * 128 + k]; ac_[i][kq] = ACT[tl * 128 + k];
                    nsu_[i][kq] = NSU[e]; su_[i][kq] = SU[e]; sv_[i][kq] = SV[e]; gt_[i][kq] = __builtin_nontemporal_load(GATE + (size_t)t * 128 + k); } }
#pragma unroll
            for (int i = 0; i < 8; ++i) { const int tl = tw + tb + i; float wv[2];
#pragma unroll
                for (int kq = 0; kq < 2; ++kq) { const float a = (ac_[i][kq] - 128.f * nsu_[i][kq] - xo_[i]) * su_[i][kq] * sx_[i];
                    wv[kq] = gt_[i][kq] * gelu_erf(a) * sv_[i][kq]; }
                const float am = wave_max(fmaxf(fabsf(wv[0]), fabsf(wv[1])));
                const float sc = am > 0.f ? am * (1.f / 127.f) : 1.f, inv = 1.f / sc;
                float wsum = 0.f;
#pragma unroll
                for (int kq = 0; kq < 2; ++kq) { const int k = lane + 64 * kq; const float q = rintf(wv[kq] * inv); wsum += q; W8L[tl * 128 + k] = (unsigned char)((int)q & 255); }
                wsum = wave_sum(wsum);
                if (lane == 0) { SWL[tl] = sc; SWL[128 + tl] = 8.f * wsum; } }
        } }
        LDS_WAIT();
        SEC_END(12); SEC_BEGIN(13);
        SEC_REP(13) {
        { const bf16* X1 = F.ws<bf16>(WS_Y1); const unsigned char* V8 = F.ws<unsigned char>(WS_V8); bf16* Y2 = F.ws<bf16>(WS_QP);
#define V_ISSUE(n_, PC, WQ) do { const int c_ = (n_) >> 4, tl_ = tw + (((n_) >> 3) & 1) * 8 + g8, s_ = (n_) & 7; \
            const LAS unsigned short* ep_ = EIDL + tl_ * 128 + 16 * s_; const unsigned char* vb_ = V8 + (size_t)c_ * (NEXP * PCH); const unsigned j16_ = 16u * (unsigned)j8;     \
            _Pragma("unroll") for (int i = 0; i < 16; ++i) { const unsigned e_ = ep_[i]; PC[i] = *(const GAS v4u*)(vb_ + (e_ * PCH + j16_)); } \
            WQ = *(const LAS v4u*)(F.lds + P7_W8 + tl_ * 128 + 16 * s_); } while (0)
#define V_TR4(A_, B_, C_, D_, WQ_, O_) do { const unsigned t0_ = __builtin_amdgcn_perm(B_, A_, 0x05010400u), t1_ = __builtin_amdgcn_perm(B_, A_, 0x07030602u), t2_ = __builtin_amdgcn_perm(D_, C_, 0x05010400u), t3_ = __builtin_amdgcn_perm(D_, C_, 0x07030602u); \
            const unsigned u0_ = __builtin_amdgcn_perm(t2_, t0_, 0x05040100u), u1_ = __builtin_amdgcn_perm(t2_, t0_, 0x07060302u), u2_ = __builtin_amdgcn_perm(t3_, t1_, 0x05040100u), u3_ = __builtin_amdgcn_perm(t3_, t1_, 0x07060302u); \
              \
            ac_[(O_) + 0] = __builtin_amdgcn_sdot4((int)(u0_ & 0x0f0f0f0fu), (int)(WQ_), ac_[(O_) + 0], false); ac_[(O_) + 4] = __builtin_amdgcn_sdot4((int)u0_, (int)(WQ_), ac_[(O_) + 4], false); \
            ac_[(O_) + 1] = __builtin_amdgcn_sdot4((int)(u1_ & 0x0f0f0f0fu), (int)(WQ_), ac_[(O_) + 1], false); ac_[(O_) + 5] = __builtin_amdgcn_sdot4((int)u1_, (int)(WQ_), ac_[(O_) + 5], false); \
            ac_[(O_) + 2] = __builtin_amdgcn_sdot4((int)(u2_ & 0x0f0f0f0fu), (int)(WQ_), ac_[(O_) + 2], false); ac_[(O_) + 6] = __builtin_amdgcn_sdot4((int)u2_, (int)(WQ_), ac_[(O_) + 6], false); \
            ac_[(O_) + 3] = __builtin_amdgcn_sdot4((int)(u3_ & 0x0f0f0f0fu), (int)(WQ_), ac_[(O_) + 3], false); ac_[(O_) + 7] = __builtin_amdgcn_sdot4((int)u3_, (int)(WQ_), ac_[(O_) + 7], false); } while (0)
#define V_ACC(PC, WQ) do { const unsigned wq_[4] = {WQ.x, WQ.y, WQ.z, WQ.w}; \
            _Pragma("unroll") for (int gq = 0; gq < 4; ++gq) { \
                const unsigned pa_[4] = {PC[4 * gq].x, PC[4 * gq].y, PC[4 * gq].z, PC[4 * gq].w}, pb_[4] = {PC[4 * gq + 1].x, PC[4 * gq + 1].y, PC[4 * gq + 1].z, PC[4 * gq + 1].w}; \
                const unsigned pc_[4] = {PC[4 * gq + 2].x, PC[4 * gq + 2].y, PC[4 * gq + 2].z, PC[4 * gq + 2].w}, pd_[4] = {PC[4 * gq + 3].x, PC[4 * gq + 3].y, PC[4 * gq + 3].z, PC[4 * gq + 3].w}; \
                _Pragma("unroll") for (int m = 0; m < 4; ++m) { \
                    V_TR4(pa_[m], pb_[m], pc_[m], pd_[m], wq_[gq], 8 * m); } } } while (0)
#define V_FIN(n_, XP) do { const int c_ = (n_) >> 4, tl_ = tw + (((n_) >> 3) & 1) * 8 + g8; \
            const LAS float* swp_ = (const LAS float*)(F.lds + P7_SW); const float sw_ = swp_[tl_], wo_ = swp_[128 + tl_]; \
            const f32x2 ms_ = *(const LAS f32x2*)(F.lds + P7_LNSL + tl_ * 8); const int dim0_ = c_ * VCH + 32 * j8; \
            _Pragma("unroll") for (int m = 0; m < 4; ++m) { \
                const f32x4 g0_ = *(const LAS f32x4*)(F.lds + P7_G1 + (dim0_ + 8 * m) * 4), g1_ = *(const LAS f32x4*)(F.lds + P7_G1 + (dim0_ + 8 * m + 4) * 4), b0_ = *(const LAS f32x4*)(F.lds + P7_B1 + (dim0_ + 8 * m) * 4), b1_ = *(const LAS f32x4*)(F.lds + P7_B1 + (dim0_ + 8 * m + 4) * 4); \
                const unsigned xw_[4] = {XP[m].x, XP[m].y, XP[m].z, XP[m].w}; float o_[8]; \
                _Pragma("unroll") for (int i = 0; i < 4; ++i) { const float yl_ = (i & 1) ? bfhi(xw_[i >> 1]) : bflo(xw_[i >> 1]), yh_ = (i & 1) ? bfhi(xw_[2 + (i >> 1)]) : bflo(xw_[2 + (i >> 1)]); \
                    o_[i] = ((float)ac_[8 * m + i] - wo_) * sw_ + DN_ALPHA * ((yl_ - ms_.x) * ms_.y * g0_[i] + b0_[i]); \
                    o_[4 + i] = (float)((ac_[8 * m + 4 + i] - ac_[8 * m + i]) >> 4) * sw_ + DN_ALPHA * ((yh_ - ms_.x) * ms_.y * g1_[i] + b1_[i]); } \
                *(GAS v4u*)(Y2 + (size_t)(m0 + tl_) * D + dim0_ + 8 * m) = (v4u){pk2(o_[0], o_[1]), pk2(o_[2], o_[3]), pk2(o_[4], o_[5]), pk2(o_[6], o_[7])}; } \
            _Pragma("unroll") for (int d = 0; d < 32; ++d) ac_[d] = 0; } while (0)
          constexpr int VCH = 256, NSTEP = (D / VCH) * (TPB / NWAVES);
          v4u pcA[16], pcB[16], wqA, wqB, xp[4]; int ac_[32];
#pragma unroll
          for (int d = 0; d < 32; ++d) ac_[d] = 0;
          V_ISSUE(0, pcA, wqA);
          for (int n = 0; n < NSTEP; n += 2) {
              const bool fin = (n & 7) == 6;
              if (fin) { const int c_ = (n + 1) >> 4, tl_ = tw + (((n + 1) >> 3) & 1) * 8 + g8; const GAS v4u* xq_ = (const GAS v4u*)(X1 + (size_t)(m0 + tl_) * D + c_ * VCH + 32 * j8);
#pragma unroll
                  for (int m = 0; m < 4; ++m) xp[m] = xq_[m]; }
              V_ISSUE(n + 1, pcB, wqB); __builtin_amdgcn_sched_barrier(0);
              V_ACC(pcA, wqA); __builtin_amdgcn_sched_barrier(0);
              { const int nn = (n + 2 < NSTEP) ? n + 2 : n; V_ISSUE(nn, pcA, wqA); }
              __builtin_amdgcn_sched_barrier(0);
              V_ACC(pcB, wqB);
              if (fin) V_FIN(n + 1, xp);
              __builtin_amdgcn_sched_barrier(0);
          }
#undef V_TR4
#undef V_ISSUE
#undef V_ACC
#undef V_FIN
        }
        }
        SEC_END(13); SEC_BEGIN(14);
        SEC_REP(14) {
        { float* outp = F.outp(); const bf16* Y2 = F.ws<bf16>(WS_QP);
        v4u nx[4];
        { const GAS v4u* yp = (const GAS v4u*)(Y2 + (size_t)(m0 + tw) * D) + lane;
#pragma unroll
          for (int j = 0; j < 4; ++j) nx[j] = yp[64 * j]; }
        for (int ti = 0; ti < TPB / NWAVES; ++ti) {
            const int t = m0 + tw + ti;
            float v[32]; float s = 0.f;
#pragma unroll
            for (int j = 0; j < 4; ++j) { const unsigned ww[4] = {nx[j].x, nx[j].y, nx[j].z, nx[j].w};
#pragma unroll
                for (int i = 0; i < 4; ++i) { v[8 * j + 2 * i] = bflo(ww[i]); v[8 * j + 2 * i + 1] = bfhi(ww[i]); s += v[8 * j + 2 * i] + v[8 * j + 2 * i + 1]; } }
            { const int tn = (ti + 1 < TPB / NWAVES) ? t + 1 : t; const GAS v4u* yp = (const GAS v4u*)(Y2 + (size_t)tn * D) + lane;
#pragma unroll
              for (int j = 0; j < 4; ++j) nx[j] = yp[64 * j]; }
            const float mean = wave_sum(s) * (1.f / D); float qv = 0.f;
#pragma unroll
            for (int i = 0; i < 32; ++i) { v[i] -= mean; qv += v[i] * v[i]; }
            const float rstd = 1.f / sqrtf(wave_sum(qv) * (1.f / D) + LN_EPS);
#pragma unroll
            for (int j = 0; j < 4; ++j) { const int c0 = 8 * lane + 512 * j; const f32x4 g0 = *(const LAS f32x4*)(F.lds + P7_G2 + c0 * 4), g1 = *(const LAS f32x4*)(F.lds + P7_G2 + c0 * 4 + 16), b0 = *(const LAS f32x4*)(F.lds + P7_B2 + c0 * 4), b1 = *(const LAS f32x4*)(F.lds + P7_B2 + c0 * 4 + 16);
                f32x4 r0, r1;
#pragma unroll
                for (int i = 0; i < 4; ++i) { r0[i] = v[8 * j + i] * rstd * g0[i] + b0[i]; r1[i] = v[8 * j + 4 + i] * rstd * g1[i] + b1[i]; }
                GAS f32x4* op = (GAS f32x4*)(outp + (size_t)t * D + c0); op[0] = r0; op[1] = r1; }
        } }
        }
        SEC_END(14);
        __syncthreads();
    }
}

struct Args { const float* in[22]; float* out; unsigned char* ws; int ph_lo, ph_hi; };
__global__ void __launch_bounds__(NWAVES * 64, 2) mk_fwd(Args args) {
    extern __shared__ __attribute__((aligned(16))) unsigned char lds[];
    cg::grid_group grid = cg::this_grid();
    Frame F;
    F.lds = (LAS unsigned char*)lds;
    if (threadIdx.x == 0) { LAS unsigned long long* PT = (LAS unsigned long long*)(F.lds + RING_BYTES);
#pragma unroll
        for (int k = 0; k < 22; ++k) PT[k] = (unsigned long long)args.in[k];
        PT[22] = (unsigned long long)args.out; PT[23] = (unsigned long long)args.ws;
        ((LAS unsigned*)(F.lds + RING_BYTES + 256))[0] = 0u; ((LAS unsigned*)(F.lds + RING_BYTES + 256))[1] = 0u; }
    __syncthreads();
    const int lo = args.ph_lo, hi = args.ph_hi;
#ifndef PHASE_MASK
#define PHASE_MASK 255
#endif
#define IN(k) (((PHASE_MASK >> (k)) & 1) && lo <= (k) && (k) < hi)
#ifndef REPEAT_PHASE
#define REPEAT_PHASE -1
#endif
#define REP(k) for (int rep_ = 0; rep_ < ((REPEAT_PHASE == (k)) ? 2 : 1); ++rep_)
    (void)xcd_barrier_post((unsigned*)args.ws, (volatile LAS unsigned*)(F.lds + RING_BYTES + 256));
#define XBAR() do { XcdBarrier bar_; bar_.bar = F.ws<unsigned>(0); bar_.x = xb_xcc_id(); bar_.st = (volatile LAS unsigned*)(F.lds + RING_BYTES + 256); xcd_barrier(bar_); } while (0)
#define SEAM(k) do { if (IN(k) && IN((k) + 1)) XBAR(); } while (0)

    if (lo < 0) grid.sync();
    if (IN(0)) REP(0) { SEC_BEGIN(0); p0a_prologue(F); XBAR(); p0b_prologue(F); SEC_END(0); } SEAM(0);
    if (IN(1)) REP(1) { SEC_BEGIN(1);
        pg8::Gemm g{F.ws<bf16>(WS_XB), F.ws<bf16>(WS_WIN), M, NPROJ, D / 2}; pg8::StaticOrder S; S.init(M, NPROJ, F.G_(), (int)blockIdx.x);
        pg8::EpiProjI8 E{F.ws<bf16>(WS_Q), (size_t)(WS_K - WS_Q) / 2, dattn::C2, F.ws<bf16>(WS_H), F.in(I_BGLU), F.ws<float>(WS_SXA), F.ws<float>(WS_SWIN)};
        pg8::gemm_phase<pg8::EpiProjI8, pg8::StaticOrder, PG8_ALIGN, PG8_SP2>(F.lds, g, S, E);
    SEC_END(1); } SEAM(1);
    if (IN(2)) REP(2) { SEC_BEGIN(2);
        static_assert(dattn::LDS_BYTES <= RING_BYTES, "attention body geometry vs frame");
        const dattn::Tensors AT{F.ws<const dattn::bf16>(WS_Q), F.ws<const dattn::bf16>(WS_K), F.ws<const dattn::bf16>(WS_V), F.ws<dattn::bf16>(WS_O1), F.ws<dattn::bf16>(WS_O2), F.ws<const float>(WS_TAB)};
        dattn::phase((char*)lds, AT, F.vcu_());
    SEC_END(2); } SEAM(2);
    if (IN(3)) REP(3) { SEC_BEGIN(3); p3_mix(F); SEC_END(3); } SEAM(3);
    if (IN(4)) REP(4) { SEC_BEGIN(4);
        pg8::Gemm g{F.ws<bf16>(WS_XB), F.ws<bf16>(WS_WOUT), M, D, D / 2}; pg8::StaticOrder S; S.init(M, D, F.G_(), (int)blockIdx.x);
        pg8::EpiResI8 E{F.in(I_X), F.ws<bf16>(WS_Y1), D, DN_ALPHA, F.ws<float>(WS_SM), F.ws<float>(WS_SWOUT)};
        pg8::gemm_phase<pg8::EpiResI8, pg8::StaticOrder, PG8_ALIGN, PG8_SP2>(F.lds, g, S, E);
    SEC_END(4); } SEAM(4);
    if (IN(5)) REP(5) { SEC_BEGIN(5); p5_ln1(F); SEC_END(5); } SEAM(5);
    if (IN(6)) REP(6) { SEC_BEGIN(6);
        pg8::Gemm g{F.ws<bf16>(WS_X8), F.ws<bf16>(WS_WQ), M, D, D / 2}; pg8::StaticOrder S; S.init(M, D, F.G_(), (int)blockIdx.x);
        pg8::EpiPlainI8 E{F.ws<bf16>(WS_QP), D, F.ws<float>(WS_SX), F.ws<float>(WS_SWQ)};
        pg8::gemm_phase<pg8::EpiPlainI8, pg8::StaticOrder, PG8_ALIGN, PG8_SP2>(F.lds, g, S, E);
    SEC_END(6); } SEAM(6);
    if (IN(7)) REP(7) { SEC_BEGIN(7); p7_peer(F); SEC_END(7); }
#ifdef PROBE_XBARS
    for (int xb_i = 0; xb_i < PROBE_XBARS; ++xb_i) XBAR();
#endif
#undef IN
#undef SEAM
}

extern "C" void kernel_launch(void* const* d_in, const int* in_sizes, int n_in, void* d_out, int out_size, void* d_ws, size_t ws_size, hipStream_t stream) {
    static int grid = 0;
    if (grid == 0) {
        if (n_in != 22 || in_sizes[0] != M * D || out_size != M * D || ws_size < WS_END) { fprintf(stderr, "kernel_launch: unexpected shapes (n_in %d, in0 %d, out %d, ws %zu); nothing launched\n", n_in, n_in > 0 ? in_sizes[0] : -1, out_size, ws_size); grid = -1; return; }
        int dev = 0, cus = 0, per_cu = 0;
        if (hipGetDevice(&dev) != hipSuccess || hipDeviceGetAttribute(&cus, hipDeviceAttributeMultiprocessorCount, dev) != hipSuccess) { grid = -1; return; }
        if (hipFuncSetAttribute((const void*)mk_fwd, hipFuncAttributeMaxDynamicSharedMemorySize, LDS_BYTES) != hipSuccess) { fprintf(stderr, "kernel_launch: hipFuncSetAttribute failed\n"); grid = -1; return; }
        if (hipOccupancyMaxActiveBlocksPerMultiprocessor(&per_cu, (const void*)mk_fwd, NWAVES * 64, LDS_BYTES) != hipSuccess || per_cu < 1) { fprintf(stderr, "kernel_launch: occupancy query reports %d workgroups per CU\n", per_cu); (void)hipGetLastError(); grid = -1; return; }
        grid = cus;
        if (grid > 256) grid = 256;
    }
    if (grid < 0) return;
    if (hipMemsetAsync(d_ws, 0, 65536, stream) != hipSuccess) { fprintf(stderr, "kernel_launch: hipMemsetAsync failed\n"); return; }
    Args a{};
    for (int i = 0; i < 22; ++i) a.in[i] = (const float*)d_in[i];
    a.out = (float*)d_out; a.ws = (unsigned char*)d_ws;
    constexpr int NL = MK_N_LAUNCHES;
    for (int li = 0; li < NL; ++li) {
        a.ph_lo = (NL == 1) ? 0 : li; a.ph_hi = (NL == 1) ? N_PHASES : li + 1;
        void* kargs[] = {&a};
        const hipError_t le = hipLaunchCooperativeKernel((const void*)mk_fwd, dim3(grid), dim3(NWAVES * 64), kargs, LDS_BYTES, stream);
        if (le != hipSuccess) { fprintf(stderr, "kernel_launch: cooperative launch %d failed: %s (grid %d)\n", li, hipGetErrorString(le), grid); break; }
    }
}
```

```cpp
#include <hip/hip_runtime.h>
#include <hip/hip_cooperative_groups.h>
#include <cstdio>
#include <cstdint>
namespace cg = cooperative_groups;
namespace pg8 {
#define PG8_LAS __attribute__((address_space(3)))
typedef unsigned short bf16_t;
typedef short bf16x8 __attribute__((ext_vector_type(8)));
typedef float f32x4 __attribute__((ext_vector_type(4)));
typedef unsigned u32x4 __attribute__((ext_vector_type(4)));
typedef int i32x4 __attribute__((ext_vector_type(4)));
constexpr int BM = 256, BK = 64, HALF = 128, HTB = HALF * BK * 2  , STAGE_BYTES = 8 * HTB, NXCD = 8, WGM = 8;

__host__ __device__ __forceinline__ int lds_byte(int r, int c) { const int st = (r >> 4) * 2 + (c >> 5), rr = r & 15, cc = c & 31, ob = rr * 64 + cc * 2; return st * 1024 + (ob ^ (((ob >> 9) & 1) << 5)); }
__host__ __device__ __forceinline__ void stage_rc(int b, int& R, int& C) { const int st = b / 1024, sb = b % 1024, swz = sb ^ (((sb >> 9) & 1) << 5); R = (st >> 1) * 16 + swz / 64; C = (st & 1) * 32 + (swz % 64) / 2; }
__host__ __device__ __forceinline__ int perm32(int rho) { const int n = rho >> 4, i = rho & 15; return 8 * (i >> 2) + 4 * n + (i & 3); }

struct Unit { int pm, pn; };
struct Gemm { const bf16_t* A; const bf16_t* Bt; int M, N, K; };

struct StaticOrder {
    int nM, nN, nwg, G, c;
    __host__ __device__ void init(int M, int N, int G_, int c_) { nM = M / BM; nN = N / BM; nwg = nM * nN; G = G_; c = c_; }
    __host__ __device__ bool next(int i, Unit& u) const {
        const long L = (long)i * G + c; if (L >= nwg) return false;
        int wgid = (int)L; { const int q = nwg / NXCD, r = nwg % NXCD, xcd = wgid % NXCD, off = wgid / NXCD; wgid = (xcd < r ? xcd * (q + 1) : r * (q + 1) + (xcd - r) * q) + off; }
        const int nig = WGM * nN, gid = wgid / nig, fm = gid * WGM, gsz = (nM - fm) < WGM ? (nM - fm) : WGM;
        u.pm = fm + ((wgid % nig) % gsz); u.pn = (wgid % nig) / gsz; return true;
    }
    __device__ __forceinline__ void a_ready(const Unit&) const {}
    __device__ __forceinline__ void done(const Unit&) const {}
};

__device__ __forceinline__ unsigned cvt_pk_bf16(float lo, float hi) { unsigned r; asm volatile("v_cvt_pk_bf16_f32 %0, %1, %2" : "=v"(r) : "v"(lo), "v"(hi)); return r; }
typedef float f32x2 __attribute__((ext_vector_type(2)));
typedef float f32x2 __attribute__((ext_vector_type(2)));
__device__ __forceinline__ u32x4 pack8(f32x4 v0, f32x4 v1) { u32x4 w; w.x = cvt_pk_bf16(v0[0], v0[1]); w.y = cvt_pk_bf16(v0[2], v0[3]); w.z = cvt_pk_bf16(v1[0], v1[1]); w.w = cvt_pk_bf16(v1[2], v1[3]); return w; }
typedef _Float16 h16x2 __attribute__((ext_vector_type(2)));
__device__ __forceinline__ unsigned pkh2(float a, float b) { const h16x2 v = {(_Float16)__builtin_amdgcn_fmed3f(a, -65504.f, 65504.f), (_Float16)__builtin_amdgcn_fmed3f(b, -65504.f, 65504.f)}; return __builtin_bit_cast(unsigned, v); }
__device__ __forceinline__ u32x4 pack8h(f32x4 v0, f32x4 v1) { u32x4 w; w.x = pkh2(v0[0], v0[1]); w.y = pkh2(v0[2], v0[3]); w.z = pkh2(v1[0], v1[1]); w.w = pkh2(v1[2], v1[3]); return w; }
__device__ __forceinline__ f32x4 i2f(f32x4 a) { const i32x4 v = __builtin_bit_cast(i32x4, a); return (f32x4){(float)v[0], (float)v[1], (float)v[2], (float)v[3]}; }
__device__ __forceinline__ unsigned ror8(unsigned v) { return (unsigned)__builtin_amdgcn_update_dpp(0, (int)v, 0x128, 0xf, 0xf, true); }
__device__ __forceinline__ void xchg_store2(bf16_t* p  , size_t ld, u32x4 p0  , u32x4 p1  , bool hi8) {
    const u32x4 snd = hi8 ? p0 : p1; u32x4 rcv; rcv.x = ror8(snd.x); rcv.y = ror8(snd.y); rcv.z = ror8(snd.z); rcv.w = ror8(snd.w);
    *(u32x4*)p = hi8 ? rcv : p0; *(u32x4*)(p + 8 * ld) = hi8 ? p1 : rcv;
}
struct EpiProjI8 {
    static constexpr bool PERM = true, AFTER_DRAIN = false, INT8 = true;
    bf16_t* QKV; size_t split_stride; float scale0; bf16_t* H; const float* bglu; const float* sa; const float* sb;
    __device__ __forceinline__ void operator()(const f32x4 (&acc)[2][2][4][2], const Unit& u, int wr, int wc, int fr, int fq) const {
        const int row0 = u.pm * BM + wr * 64 + fr, cb = u.pn * BM + wc * 64 + 8 * fq; const bool hi8 = fr & 8;
        f32x4 cs[2][2];
#pragma unroll
        for (int bj = 0; bj < 2; ++bj) { cs[bj][0] = *(const f32x4*)(sb + cb + bj * 32); cs[bj][1] = *(const f32x4*)(sb + cb + bj * 32 + 4); }
        float rsv[2][4];
#pragma unroll
        for (int ai = 0; ai < 2; ++ai)
#pragma unroll
            for (int m = 0; m < 4; ++m) rsv[ai][m] = sa[row0 + ai * HALF + m * 16];
        if (u.pn < 12) {
            const int t = u.pn >> 2; bf16_t* base = QKV + (size_t)t * split_stride; const float sc = (t == 0) ? scale0 : 1.f;
            bf16_t* lp = base + (size_t)(u.pm * BM + wr * 64 + (fr & 7)) * 1024 + (u.pn & 3) * BM + wc * 64 + 8 * fq + (hi8 ? 32 : 0);
#pragma unroll
            for (int ai = 0; ai < 2; ++ai)
#pragma unroll
                for (int m = 0; m < 4; ++m) { const float rs = rsv[ai][m] * sc;
                    xchg_store2(lp + (size_t)(ai * HALF + m * 16) * 1024, 1024, pack8(i2f(acc[ai][0][m][0]) * cs[0][0] * rs, i2f(acc[ai][0][m][1]) * cs[0][1] * rs), pack8(i2f(acc[ai][1][m][0]) * cs[1][0] * rs, i2f(acc[ai][1][m][1]) * cs[1][1] * rs), hi8); }
        } else {
            const int ch0 = (u.pn - 12) * HALF + wc * 32 + 8 * fq;
            const f32x4 ba0 = *(const f32x4*)(bglu + ch0), ba1 = *(const f32x4*)(bglu + ch0 + 4), bg0 = *(const f32x4*)(bglu + 1024 + ch0), bg1 = *(const f32x4*)(bglu + 1024 + ch0 + 4);
#pragma unroll
            for (int ai = 0; ai < 2; ++ai)
#pragma unroll
                for (int m = 0; m < 4; ++m) { const int row = row0 + ai * HALF + m * 16; const float rs = rsv[ai][m];
                    const f32x4 a0 = i2f(acc[ai][0][m][0]) * cs[0][0] * rs + ba0, a1 = i2f(acc[ai][0][m][1]) * cs[0][1] * rs + ba1, g0 = i2f(acc[ai][1][m][0]) * cs[1][0] * rs + bg0, g1 = i2f(acc[ai][1][m][1]) * cs[1][1] * rs + bg1;
                    f32x4 h0, h1;
#pragma unroll
                    for (int e = 0; e < 4; ++e) { h0[e] = a0[e] * __builtin_amdgcn_rcpf(1.f + __builtin_amdgcn_exp2f(-1.4426950409f * g0[e])); h1[e] = a1[e] * __builtin_amdgcn_rcpf(1.f + __builtin_amdgcn_exp2f(-1.4426950409f * g1[e])); }
                    *(u32x4*)(H + (size_t)row * 1024 + ch0) = pack8h(h0, h1); }
        }
    }
};
struct EpiPlainI8 {
    static constexpr bool PERM = true, AFTER_DRAIN = false, INT8 = true;
    bf16_t* O; int ldc; const float* sa; const float* sb;
    __device__ __forceinline__ void operator()(const f32x4 (&acc)[2][2][4][2], const Unit& u, int wr, int wc, int fr, int fq) const {
        const int row0 = u.pm * BM + wr * 64 + fr, col0 = u.pn * BM + wc * 64 + 8 * fq; const bool hi8 = fr & 8;
        f32x4 cs[2][2];
#pragma unroll
        for (int bj = 0; bj < 2; ++bj) { cs[bj][0] = *(const f32x4*)(sb + col0 + bj * 32); cs[bj][1] = *(const f32x4*)(sb + col0 + bj * 32 + 4); }
        float rsv[2][4];
#pragma unroll
        for (int ai = 0; ai < 2; ++ai)
#pragma unroll
            for (int m = 0; m < 4; ++m) rsv[ai][m] = sa[row0 + ai * HALF + m * 16];
        bf16_t* lp = O + (size_t)(u.pm * BM + wr * 64 + (fr & 7)) * ldc + col0 + (hi8 ? 32 : 0);
#pragma unroll
        for (int ai = 0; ai < 2; ++ai)
#pragma unroll
            for (int m = 0; m < 4; ++m) { const float rs = rsv[ai][m];
                xchg_store2(lp + (size_t)(ai * HALF + m * 16) * ldc, (size_t)ldc, pack8(i2f(acc[ai][0][m][0]) * cs[0][0] * rs, i2f(acc[ai][0][m][1]) * cs[0][1] * rs), pack8(i2f(acc[ai][1][m][0]) * cs[1][0] * rs, i2f(acc[ai][1][m][1]) * cs[1][1] * rs), hi8); }
    }
};
struct EpiResI8 {
    static constexpr bool PERM = true, AFTER_DRAIN = false, INT8 = true;
    const float* X; bf16_t* Y; int ldc; float alpha; const float* sa; const float* sb;
    __device__ __forceinline__ void operator()(const f32x4 (&acc)[2][2][4][2], const Unit& u, int wr, int wc, int fr, int fq) const {
        const int row0 = u.pm * BM + wr * 64 + fr, col0 = u.pn * BM + wc * 64 + 8 * fq; const bool hi8 = fr & 8;
        f32x4 cs[2][2];
#pragma unroll
        for (int bj = 0; bj < 2; ++bj) { cs[bj][0] = *(const f32x4*)(sb + col0 + bj * 32); cs[bj][1] = *(const f32x4*)(sb + col0 + bj * 32 + 4); }
        float rsv[2][4];
#pragma unroll
        for (int ai = 0; ai < 2; ++ai)
#pragma unroll
            for (int m = 0; m < 4; ++m) rsv[ai][m] = sa[row0 + ai * HALF + m * 16];
        bf16_t* lp = Y + (size_t)(u.pm * BM + wr * 64 + (fr & 7)) * ldc + col0 + (hi8 ? 32 : 0);
#pragma unroll
        for (int ai = 0; ai < 2; ++ai) {
            f32x4 xv[4][2][2];
#pragma unroll
            for (int m = 0; m < 4; ++m) { const size_t off = (size_t)(row0 + ai * HALF + m * 16) * ldc + col0;
#pragma unroll
                for (int bj = 0; bj < 2; ++bj) { xv[m][bj][0] = *(const f32x4*)(X + off + bj * 32); xv[m][bj][1] = *(const f32x4*)(X + off + bj * 32 + 4); } }
#pragma unroll
            for (int m = 0; m < 4; ++m) { const float rs = rsv[ai][m];
                xchg_store2(lp + (size_t)(ai * HALF + m * 16) * ldc, (size_t)ldc,
                            pack8(i2f(acc[ai][0][m][0]) * cs[0][0] * rs + xv[m][0][0] * alpha, i2f(acc[ai][0][m][1]) * cs[0][1] * rs + xv[m][0][1] * alpha),
                            pack8(i2f(acc[ai][1][m][0]) * cs[1][0] * rs + xv[m][1][0] * alpha, i2f(acc[ai][1][m][1]) * cs[1][1] * rs + xv[m][1][1] * alpha), hi8); }
            asm volatile("" ::: "memory"); }
    }
};
template <class Epi, class Sched, bool ALIGN_EPI = false, bool SP2 = false>
__device__ __forceinline__ void gemm_phase(PG8_LAS unsigned char* lds, const Gemm g, const Sched& S, const Epi& E) {
    const int tid = threadIdx.x, wid = __builtin_amdgcn_readfirstlane(tid >> 6), lane = tid & 63, wr = wid >> 2, wc = wid & 3, fr = lane & 15, fq = lane >> 4;
    const int K = g.K, nt = K / BK;
    unsigned voffA[2], voffB[2];
#pragma unroll
    for (int i = 0; i < 2; ++i) { int R, C; stage_rc(tid * 16 + i * 8192, R, C); const int Rb = Epi::PERM ? (64 * (R >> 5) + perm32(R & 31)) : R;
        voffA[i] = (unsigned)(R * K + C) * 2u; voffB[i] = (unsigned)(Rb * K + C) * 2u; }
    const size_t kstep = (size_t)(BK * 2);
    const size_t hstep = (size_t)HALF * K * 2;
    const size_t tstep = 2 * hstep;
    const size_t hstepB = Epi::PERM ? (size_t)32 * K * 2 : hstep;
    const unsigned ldsw = (unsigned)wid * 1024u;
    const int aoff = lds_byte(wr * 64 + fr, fq * 8), boff = lds_byte(wc * 32 + fr, fq * 8);
#define PG8_SA(b, h) (((b) * 2 + (h)) * HTB)
#define PG8_SB(b, h) ((4 + (b) * 2 + (h)) * HTB)
#define PG8_STAGE(bufoff, gbase, voff) do { _Pragma("unroll") for (int _i = 0; _i < 2; ++_i) \
        __builtin_amdgcn_global_load_lds((const unsigned*)((const char*)(gbase) + (voff)[_i]), (PG8_LAS unsigned*)(lds + (bufoff) + ldsw + _i * 8192), 16, 0, 0); } while (0)
#define PG8_LDA(dst, b, h) do { _Pragma("unroll") for (int m = 0; m < 4; ++m) _Pragma("unroll") for (int k = 0; k < 2; ++k) dst[m][k] = *(const PG8_LAS bf16x8*)(lds + PG8_SA(b, h) + aoff + m * 2048 + k * 1024); } while (0)
#define PG8_LDB(dst, b, h) do { _Pragma("unroll") for (int n = 0; n < 2; ++n) _Pragma("unroll") for (int k = 0; k < 2; ++k) dst[n][k] = *(const PG8_LAS bf16x8*)(lds + PG8_SB(b, h) + boff + n * 2048 + k * 1024); } while (0)
#define PG8_MMA(ai, bj, At, Bt) do { __builtin_amdgcn_s_setprio(1); _Pragma("unroll") for (int m = 0; m < 4; ++m) _Pragma("unroll") for (int n = 0; n < 2; ++n) _Pragma("unroll") for (int k = 0; k < 2; ++k) { \
        if constexpr (Epi::INT8) acc[ai][bj][m][n] = __builtin_bit_cast(f32x4, __builtin_amdgcn_mfma_i32_16x16x64_i8(__builtin_bit_cast(i32x4, Bt[n][k]), __builtin_bit_cast(i32x4, At[m][k]), __builtin_bit_cast(i32x4, acc[ai][bj][m][n]), 0, 0, 0)); \
        else acc[ai][bj][m][n] = __builtin_amdgcn_mfma_f32_16x16x32_bf16(Bt[n][k], At[m][k], acc[ai][bj][m][n], 0, 0, 0); } __builtin_amdgcn_s_setprio(0); } while (0)
#define PG8_WAIT_V(n) asm volatile("s_waitcnt vmcnt(" #n ")" ::: "memory")
#define PG8_WAIT_L(n) asm volatile("s_waitcnt lgkmcnt(" #n ")" ::: "memory")
#define PG8_BAR __builtin_amdgcn_s_barrier()
#define PG8_SCHED __builtin_amdgcn_sched_barrier(0)
    Unit cur, nxt; int ui = 0;
    if (!S.next(0, cur)) return;
    f32x4 acc[2][2][4][2];
#pragma unroll
    for (int a = 0; a < 2; ++a)
#pragma unroll
        for (int b = 0; b < 2; ++b)
#pragma unroll
            for (int m = 0; m < 4; ++m)
#pragma unroll
                for (int n = 0; n < 2; ++n) acc[a][b][m][n] = (f32x4){0.f, 0.f, 0.f, 0.f};
    bf16x8 At[4][2], B0[2][2], B1[2][2];
    const char* cA = (const char*)g.A + (size_t)cur.pm * tstep; const char* cB = (const char*)g.Bt + (size_t)cur.pn * tstep;
    S.a_ready(cur);
    if constexpr (SP2) {
        PG8_STAGE(PG8_SB(0, 0), cB, voffB); PG8_STAGE(PG8_SB(0, 1), cB + hstepB, voffB); PG8_STAGE(PG8_SA(0, 0), cA, voffA); PG8_STAGE(PG8_SA(0, 1), cA + hstep, voffA);
        if (wr == 1) PG8_BAR;
        PG8_WAIT_V(2); PG8_BAR;
        PG8_STAGE(PG8_SB(1, 0), cB + kstep, voffB); PG8_STAGE(PG8_SA(1, 0), cA + kstep, voffA); PG8_STAGE(PG8_SB(1, 1), cB + hstepB + kstep, voffB);
        PG8_WAIT_V(6); PG8_BAR;
    } else {
        PG8_STAGE(PG8_SB(0, 0), cB, voffB); PG8_STAGE(PG8_SA(0, 0), cA, voffA); PG8_STAGE(PG8_SB(0, 1), cB + hstepB, voffB); PG8_STAGE(PG8_SA(0, 1), cA + hstep, voffA);
        if (wr == 1) PG8_BAR;
        PG8_WAIT_V(4); PG8_BAR;
        PG8_STAGE(PG8_SB(1, 0), cB + kstep, voffB); PG8_STAGE(PG8_SA(1, 0), cA + kstep, voffA); PG8_STAGE(PG8_SB(1, 1), cB + hstepB + kstep, voffB);
        PG8_WAIT_V(6); PG8_BAR;
    }
    for (;;) {
        const bool has_next = S.next(ui + 1, nxt);
        const char* nA = has_next ? (const char*)g.A + (size_t)nxt.pm * tstep : cA; const char* nB = has_next ? (const char*)g.Bt + (size_t)nxt.pn * tstep : cB;
        for (int t = 0; t < nt; t += 2) {
            const bool last = (t == nt - 2);
            const char* a1 = cA + (size_t)(t + 1) * kstep;
            const char* a2 = last ? nA : cA + (size_t)(t + 2) * kstep; const char* b2 = last ? nB : cB + (size_t)(t + 2) * kstep;
            const char* a3 = a2 + kstep; const char* b3 = b2 + kstep;
            if (last && has_next) S.a_ready(nxt);
            if constexpr (SP2) {
            PG8_LDB(B0, 0, 0); PG8_LDB(B1, 0, 1); PG8_SCHED; PG8_LDA(At, 0, 0); PG8_STAGE(PG8_SA(1, 1), a1 + hstep, voffA);
            PG8_WAIT_V(8); PG8_WAIT_L(0); PG8_BAR; PG8_MMA(0, 0, At, B0); PG8_MMA(0, 1, At, B1); PG8_BAR; PG8_SCHED;
            PG8_LDA(At, 0, 1); PG8_STAGE(PG8_SB(0, 0), b2, voffB); PG8_STAGE(PG8_SB(0, 1), b2 + hstepB, voffB); PG8_STAGE(PG8_SA(0, 0), a2, voffA);
            PG8_WAIT_V(8); PG8_WAIT_L(0); PG8_BAR; PG8_MMA(1, 0, At, B0); PG8_MMA(1, 1, At, B1); PG8_BAR; PG8_SCHED;
            PG8_LDB(B0, 1, 0); PG8_LDB(B1, 1, 1); PG8_SCHED; PG8_LDA(At, 1, 0); PG8_STAGE(PG8_SA(0, 1), a2 + hstep, voffA);
            PG8_WAIT_V(8); PG8_WAIT_L(0); PG8_BAR; PG8_MMA(0, 0, At, B0); PG8_MMA(0, 1, At, B1); PG8_BAR; PG8_SCHED;
            PG8_LDA(At, 1, 1); PG8_STAGE(PG8_SB(1, 0), b3, voffB); PG8_STAGE(PG8_SB(1, 1), b3 + hstepB, voffB); PG8_STAGE(PG8_SA(1, 0), a3, voffA);
            PG8_WAIT_V(8); PG8_WAIT_L(0); PG8_BAR; PG8_MMA(1, 0, At, B0); PG8_MMA(1, 1, At, B1); PG8_BAR; PG8_SCHED;
            } else {
            PG8_LDB(B0, 0, 0); PG8_SCHED; PG8_LDA(At, 0, 0); PG8_STAGE(PG8_SA(1, 1), a1 + hstep, voffA);
            PG8_WAIT_L(8); PG8_BAR; PG8_WAIT_L(0); PG8_MMA(0, 0, At, B0); PG8_BAR; PG8_SCHED;
            PG8_LDB(B1, 0, 1); PG8_STAGE(PG8_SB(0, 0), b2, voffB);
            PG8_BAR; PG8_WAIT_L(0); PG8_MMA(0, 1, At, B1); PG8_BAR;
            PG8_LDA(At, 0, 1); PG8_STAGE(PG8_SA(0, 0), a2, voffA);
            PG8_BAR; PG8_WAIT_L(0); PG8_MMA(1, 0, At, B0); PG8_BAR; PG8_SCHED;
            PG8_STAGE(PG8_SB(0, 1), b2 + hstepB, voffB);
            PG8_WAIT_V(6); PG8_BAR; PG8_MMA(1, 1, At, B1); PG8_BAR;
            PG8_LDB(B0, 1, 0); PG8_SCHED; PG8_LDA(At, 1, 0); PG8_STAGE(PG8_SA(0, 1), a2 + hstep, voffA);
            PG8_WAIT_L(8); PG8_BAR; PG8_WAIT_L(0); PG8_MMA(0, 0, At, B0); PG8_BAR; PG8_SCHED;
            PG8_LDB(B1, 1, 1); PG8_STAGE(PG8_SB(1, 0), b3, voffB);
            PG8_BAR; PG8_WAIT_L(0); PG8_MMA(0, 1, At, B1); PG8_BAR;
            PG8_LDA(At, 1, 1); PG8_STAGE(PG8_SA(1, 0), a3, voffA);
            PG8_BAR; PG8_WAIT_L(0); PG8_MMA(1, 0, At, B0); PG8_BAR; PG8_SCHED;
            PG8_STAGE(PG8_SB(1, 1), b3 + hstepB, voffB);
            PG8_WAIT_V(6); PG8_BAR; PG8_MMA(1, 1, At, B1); PG8_BAR;
            }
        }
        if constexpr (ALIGN_EPI) { if (wr == 0) PG8_BAR; }
        if constexpr (!Epi::AFTER_DRAIN) { E(acc, cur, wr, wc, fr, fq); S.done(cur); }
        if (!has_next) break;
#pragma unroll
        for (int a = 0; a < 2; ++a)
#pragma unroll
            for (int b = 0; b < 2; ++b)
#pragma unroll
                for (int m = 0; m < 4; ++m)
#pragma unroll
                    for (int n = 0; n < 2; ++n) acc[a][b][m][n] = (f32x4){0.f, 0.f, 0.f, 0.f};
        cur = nxt; cA = nA; cB = nB; ++ui;
        if constexpr (ALIGN_EPI) { if (wr == 1) PG8_BAR; }
    }
    PG8_WAIT_V(0);
    if constexpr (!ALIGN_EPI) { if (wr == 0) PG8_BAR; }
    PG8_BAR;
    if constexpr (Epi::AFTER_DRAIN) { E.fused(acc, cur, wr, wc, fr, fq, lds, wid, lane); S.done(cur); }
#undef PG8_SA
#undef PG8_SB
#undef PG8_STAGE
#undef PG8_LDA
#undef PG8_LDB
#undef PG8_MMA
#undef PG8_WAIT_V
#undef PG8_WAIT_L
#undef PG8_BAR
#undef PG8_SCHED
}
}
#include <hip/hip_bf16.h>
#include <cmath>
namespace dattn {
using bf16 = __hip_bfloat16;
typedef short bf16x8 __attribute__((ext_vector_type(8)));
typedef short s16x4 __attribute__((ext_vector_type(4)));
typedef float f32x16 __attribute__((ext_vector_type(16)));
typedef unsigned u32x4 __attribute__((ext_vector_type(4)));
constexpr int DK = 64, DV = 128, RS = 1024, SEQ = 4096;
constexpr int NW = 8, QBLK = 32, KVBLK = 64, QB = NW * QBLK;
constexpr int SHM_V = KVBLK * DV * 2, SHM_K = KVBLK * DK * 2;
constexpr int NVB = 3;
constexpr int LDS_WS = NVB * SHM_V + 2 * SHM_K, LDS_TAB = LDS_WS + NW * 64 * 4, LDS_OST = 69632, OST_WAVE = 4096, LDS_BYTES = LDS_OST + NW * OST_WAVE;
constexpr int TAB_PADL = 260, TAB_N = TAB_PADL + 128 + 94;
static_assert(LDS_TAB + TAB_N * 4 <= LDS_OST, "attention LDS map");
constexpr float THR = 8.f;
constexpr float C2 = 0.125f * 1.4426950408889634f;
#define DA_KSWZ(row, colB) ((row) * 128 + ((colB) ^ (((row) & 7) << 4)))
#define DA_SBAR() __builtin_amdgcn_sched_barrier(0)
__device__ __forceinline__ int v_st(int k, int c) { const int kk = k;     return ((kk >> 3) * 4 + (c >> 5)) * 512 + ((kk & 7) * 32 + (c & 31)) * 2; }
__device__ __forceinline__ int v_rd_base(int lane) { return ((lane & 3) << 3) | (((lane >> 2) & 3) << 6) | (((lane >> 4) & 1) << 5) | (((lane >> 5) & 1) << 8); }
constexpr int v_rd_off(int d0, int ks, int half) { return d0 * 512 + ks * 4096 + half * 2048; }
__device__ __forceinline__ int crow(int r, int hi) { return (r & 3) + 8 * (r >> 2) + 4 * hi; }
__device__ __forceinline__ unsigned cvtpk(float lo, float hi) { unsigned r; asm volatile("v_cvt_pk_bf16_f32 %0, %1, %2" : "=v"(r) : "v"(lo), "v"(hi)); return r; }
__device__ __forceinline__ bf16x8 load8(const bf16* p) { return *reinterpret_cast<const bf16x8*>(p); }
__device__ __forceinline__ void bias_tile(f32x16& p0, f32x16& p1, int dq, const __attribute__((address_space(3))) float* tabp) {
    const __attribute__((address_space(3))) float* bp = tabp + (TAB_PADL - 59) + dq;
#pragma unroll
    for (int r = 0; r < 16; ++r) { const int c = (r & 3) + 8 * (r >> 2); p0[r] += bp[59 - c]; p1[r] += bp[27 - c]; }
}
__device__ __forceinline__ void rowmaxSM(const f32x16& p0, const f32x16& p1, float& m_reg, float& mn, float& alpha) {
    float ma_ = p0[0], mb_ = p1[0];
#pragma unroll
    for (int r = 1; r < 15; r += 2) { ma_ = fmaxf(fmaxf(ma_, p0[r]), p0[r + 1]); mb_ = fmaxf(fmaxf(mb_, p1[r]), p1[r + 1]); }
    float pmax = fmaxf(fmaxf(ma_, p0[15]), fmaxf(mb_, p1[15]));
    { auto rr = __builtin_amdgcn_permlane32_swap(__float_as_uint(pmax), __float_as_uint(pmax), false, false); pmax = fmaxf(__uint_as_float(rr[0]), __uint_as_float(rr[1])); }
    if (__builtin_expect(__all(pmax - m_reg <= THR), 1)) { mn = m_reg; alpha = 1.f; }
    else { mn = fmaxf(m_reg, pmax); alpha = __builtin_amdgcn_exp2f(m_reg - mn); m_reg = mn; }
}
__device__ __forceinline__ void expSM(f32x16& p0, f32x16& p1, float mn) {
#pragma unroll
    for (int r = 0; r < 16; ++r) { p0[r] = __builtin_amdgcn_exp2f(p0[r] - mn); p1[r] = __builtin_amdgcn_exp2f(p1[r] - mn); }
}
__device__ __forceinline__ void finishSM(f32x16& p0, f32x16& p1, float alpha, float& l_reg, bf16x8& pa0, bf16x8& pa1, bf16x8& pa2, bf16x8& pa3) {
    float s0_ = p0[0], s1_ = p0[1], s2_ = p1[0], s3_ = p1[1];
#pragma unroll
    for (int r = 2; r < 16; r += 2) { s0_ += p0[r]; s1_ += p0[r + 1]; s2_ += p1[r]; s3_ += p1[r + 1]; }
    float ps = (s0_ + s1_) + (s2_ + s3_);
    { auto rr = __builtin_amdgcn_permlane32_swap(__float_as_uint(ps), __float_as_uint(ps), false, false); ps = __uint_as_float(rr[0]) + __uint_as_float(rr[1]); }
    l_reg = l_reg * alpha + ps;
#define DA_PK4(P, B_, OUT) do { u32x4 w = {cvtpk(P[B_+0], P[B_+1]), cvtpk(P[B_+2], P[B_+3]), cvtpk(P[B_+4], P[B_+5]), cvtpk(P[B_+6], P[B_+7])};     \
        OUT = *reinterpret_cast<bf16x8*>(&w); } while (0)
    DA_PK4(p0, 0, pa0); DA_PK4(p0, 8, pa1); DA_PK4(p1, 0, pa2); DA_PK4(p1, 8, pa3);
#undef DA_PK4
}
template <int KB>
__device__ __forceinline__ void qkt(f32x16& p0, f32x16& p1, const char* K_lds, int r32, int hi, const bf16x8* qr) {
    p0 = f32x16{}; p1 = f32x16{};
#pragma unroll
    for (int d0 = 0; d0 < 4; ++d0) { const char* a = K_lds + KB * SHM_K + DA_KSWZ(r32, (d0 * 16 + hi * 8) * 2);
        const bf16x8 b0 = *reinterpret_cast<const bf16x8*>(a), b1 = *reinterpret_cast<const bf16x8*>(a + 32 * 128);
        p0 = __builtin_amdgcn_mfma_f32_32x32x16_bf16(b0, qr[d0], p0, 0, 0, 0);
        p1 = __builtin_amdgcn_mfma_f32_32x32x16_bf16(b1, qr[d0], p1, 0, 0, 0); }
}
template <bool FILL>
__device__ __forceinline__ void pv_tile(f32x16* o, int vb0  , bf16x8 pa0, bf16x8 pa1, bf16x8 pa2, bf16x8 pa3, f32x16& px0, f32x16& px1, float mn) {
#define DA_TRRD(dst, off) asm volatile("ds_read_b64_tr_b16 %0, %1 offset:%2" : "=&v"(dst) : "v"(vb0), "i"(off) : "memory")
#define DA_RD2(m, l, h) do { constexpr int b_ = v_rd_off((m) >> 2, 0, 0) + ((m) & 3) * 4096; DA_TRRD(l, b_); DA_TRRD(h, b_ + 2048); } while (0)
#define DA_MM(m, pa, l, h) do { o[(m) >> 2] = __builtin_amdgcn_mfma_f32_32x32x16_bf16(pa, (bf16x8){l[0], l[1], l[2], l[3], h[0], h[1], h[2], h[3]}, o[(m) >> 2], 0, 0, 0); } while (0)
#define DA_LGK(n) asm volatile("s_waitcnt lgkmcnt(" #n ")" ::: "memory")
#define DA_FILL(m) do { if constexpr (FILL) { float a_ = __builtin_amdgcn_exp2f(px0[m] - mn), b_ = __builtin_amdgcn_exp2f(px1[m] - mn); asm volatile("" : "+v"(a_), "+v"(b_)); px0[m] = a_; px1[m] = b_; } } while (0)
    s16x4 l0, h0, l1, h1, l2, h2, l3, h3, l4, h4, l5, h5, l6, h6, l7, h7, l8, h8, l9, h9, l10, h10, l11, h11, l12, h12, l13, h13, l14, h14, l15, h15;
    DA_SBAR();
    DA_RD2(0, l0, h0); DA_RD2(1, l1, h1); DA_RD2(2, l2, h2); DA_RD2(3, l3, h3);
    DA_LGK(6); DA_SBAR(); DA_MM(0, pa0, l0, h0); DA_FILL(0); DA_SBAR(); DA_RD2(4, l4, h4);
    DA_LGK(6); DA_SBAR(); DA_MM(1, pa1, l1, h1); DA_FILL(1); DA_SBAR(); DA_RD2(5, l5, h5);
    DA_LGK(6); DA_SBAR(); DA_MM(2, pa2, l2, h2); DA_FILL(2); DA_SBAR(); DA_RD2(6, l6, h6);
    DA_LGK(6); DA_SBAR(); DA_MM(3, pa3, l3, h3); DA_FILL(3); DA_SBAR(); DA_RD2(7, l7, h7);
    DA_LGK(6); DA_SBAR(); DA_MM(4, pa0, l4, h4); DA_FILL(4); DA_SBAR(); DA_RD2(8, l8, h8);
    DA_LGK(6); DA_SBAR(); DA_MM(5, pa1, l5, h5); DA_FILL(5); DA_SBAR(); DA_RD2(9, l9, h9);
    DA_LGK(6); DA_SBAR(); DA_MM(6, pa2, l6, h6); DA_FILL(6); DA_SBAR(); DA_RD2(10, l10, h10);
    DA_LGK(6); DA_SBAR(); DA_MM(7, pa3, l7, h7); DA_FILL(7); DA_SBAR(); DA_RD2(11, l11, h11);
    DA_LGK(6); DA_SBAR(); DA_MM(8, pa0, l8, h8); DA_FILL(8); DA_SBAR(); DA_RD2(12, l12, h12);
    DA_LGK(6); DA_SBAR(); DA_MM(9, pa1, l9, h9); DA_FILL(9); DA_SBAR(); DA_RD2(13, l13, h13);
    DA_LGK(6); DA_SBAR(); DA_MM(10, pa2, l10, h10); DA_FILL(10); DA_SBAR(); DA_RD2(14, l14, h14);
    DA_LGK(6); DA_SBAR(); DA_MM(11, pa3, l11, h11); DA_FILL(11); DA_SBAR(); DA_RD2(15, l15, h15);
    DA_LGK(6); DA_SBAR(); DA_MM(12, pa0, l12, h12); DA_FILL(12); DA_SBAR();
    DA_LGK(4); DA_SBAR(); DA_MM(13, pa1, l13, h13); DA_FILL(13); DA_SBAR();
    DA_LGK(2); DA_SBAR(); DA_MM(14, pa2, l14, h14); DA_FILL(14); DA_SBAR();
    DA_LGK(0); DA_SBAR(); DA_MM(15, pa3, l15, h15); DA_FILL(15); DA_SBAR();
#undef DA_FILL
#undef DA_LGK
#undef DA_MM
#undef DA_RD2
#undef DA_TRRD
}
struct BlockRef { const bf16* Q; const bf16* K; const bf16* V; bf16* O; int P0; };
struct Seam { bf16x8 qr[4]; bf16x8 st_v0, st_v1, st_k0; };
#define DA_VMW() asm volatile("s_waitcnt vmcnt(0)" ::: "memory")
#define DA_VMWN(n) asm volatile("s_waitcnt vmcnt(%0)" :: "i"(n) : "memory")
#define DA_SLOAD(Kp, Vp, k0) do { S.st_v0 = load8((Vp) + (size_t)((k0) + sr) * RS + sc); S.st_v1 = load8((Vp) + (size_t)((k0) + 32 + sr) * RS + sc); S.st_k0 = load8((Kp) + (size_t)((k0) + kr) * RS + kc); } while (0)
#define DA_SWRITE_K(bf) do { *(bf16x8*)(K_lds + (bf) * SHM_K + kws) = S.st_k0; } while (0)
#define DA_SWRITE_V(bf) do { *(bf16x8*)(V_lds + (bf) * SHM_V + vst0) = S.st_v0; *(bf16x8*)(V_lds + (bf) * SHM_V + vst1) = S.st_v1; } while (0)
__device__ __forceinline__ void prime(const BlockRef& cur, char* lds, Seam& S) {
    const int tid = threadIdx.x, wid = __builtin_amdgcn_readfirstlane(tid >> 6), lane = tid & 63, r32 = lane & 31, hi = lane >> 5;
    const int sr = tid >> 4, sc = (tid & 15) * 8, kr = tid >> 3, kc = (tid & 7) * 8, kws = DA_KSWZ(kr, kc * 2); char* K_lds = lds + NVB * SHM_V;
#pragma unroll
    for (int d0 = 0; d0 < 4; ++d0) S.qr[d0] = load8(cur.Q + (size_t)(wid * QBLK + r32) * RS + d0 * 16 + hi * 8);
    DA_SLOAD(cur.K, cur.V, 0); DA_VMW(); DA_SWRITE_K(0);
    __syncthreads();
}
__device__ __forceinline__ void block(const BlockRef& cur, const BlockRef& nxt, char* lds, Seam& S) {
    const int tid = threadIdx.x, wid = __builtin_amdgcn_readfirstlane(tid >> 6), lane = tid & 63, r32 = lane & 31, hi = lane >> 5;
    const int NT = (cur.P0 + QB) / KVBLK;
    const int qlo = cur.P0 + wid * QBLK, qm = qlo + r32 - 4 * hi;
    char* V_lds = lds; char* K_lds = lds + NVB * SHM_V;
    float* ws = (float*)(lds + LDS_WS) + wid * 64; float* li_l = ws, * al_l = ws + 32;
    const __attribute__((address_space(3))) float* tab = (const __attribute__((address_space(3))) float*)((__attribute__((address_space(3))) char*)lds + LDS_TAB);
    float m_reg = -1e30f, l_reg = 0; f32x16 o[4] = {};
    const int sr = tid >> 4, sc = (tid & 15) * 8, vst0 = v_st(sr, sc), vst1 = v_st(32 + sr, sc), kr = tid >> 3, kc = (tid & 7) * 8, kws = DA_KSWZ(kr, kc * 2);
    const int vb0 = (int)(uintptr_t)V_lds + v_rd_base(lane);
    const bf16* Kh = cur.K; const bf16* Vh = cur.V;
#define DA_RESC(a) do { if (__any((a) < 1.f)) { if (hi == 0) al_l[r32] = (a); asm volatile("s_waitcnt lgkmcnt(0)" ::: "memory"); \
                     _Pragma("unroll") for (int d_ = 0; d_ < 4; ++d_) _Pragma("unroll") for (int r = 0; r < 16; ++r) o[d_][r] *= al_l[crow(r, hi)]; } } while (0)
#define DA_KBASE(t) ((t) * KVBLK)
#define DA_MASKT(P0_, P1_, t) do { const int kb_ = DA_KBASE(t); if (kb_ + KVBLK - 1 >= qlo - 127) bias_tile(P0_, P1_, qm - kb_, tab); } while (0)
    constexpr int NQL = 4;
#define DA_SEAM_K0() do { DA_VMWN(NQL); DA_SWRITE_K(0); DA_SBAR(); } while (0)
    f32x16 pA0, pA1, pB0, pB1; float mnA, mnB, alA, alB; bf16x8 pa0, pa1, pa2, pa3;
    DA_SWRITE_V(0); DA_SBAR();
    DA_SLOAD(Kh, Vh, DA_KBASE(1));
    DA_SBAR(); qkt<0>(pA0, pA1, K_lds, r32, hi, S.qr);
    DA_MASKT(pA0, pA1, 0); rowmaxSM(pA0, pA1, m_reg, mnA, alA); expSM(pA0, pA1, mnA);
    DA_VMW(); DA_SWRITE_V(1); DA_SWRITE_K(1); DA_SBAR();
    DA_SLOAD(Kh, Vh, DA_KBASE(2));
    __syncthreads();
    int vrd = 0, vwr = 2;
#define DA_NEXT3(x) ((x) == NVB - 1 ? 0 : (x) + 1)
#define DA_HALF_STEP(PX0, PX1, mnX, alX, PY0, PY1, alY, t, KB) do { \
        DA_SBAR(); qkt<KB>(PX0, PX1, K_lds, r32, hi, S.qr); \
        finishSM(PY0, PY1, alY, l_reg, pa0, pa1, pa2, pa3); DA_SBAR(); \
        DA_VMW(); DA_SWRITE_K(1 - (KB)); DA_SWRITE_V(vwr); DA_SBAR(); \
        if ((t) + 2 < NT) { DA_SLOAD(Kh, Vh, DA_KBASE((t) + 2)); DA_SBAR(); } \
        DA_MASKT(PX0, PX1, (t)); rowmaxSM(PX0, PX1, m_reg, mnX, alX); DA_SBAR(); \
        pv_tile<true>(o, vb0 + vrd * SHM_V, pa0, pa1, pa2, pa3, PX0, PX1, mnX); \
        DA_RESC(alX); __syncthreads(); vrd = DA_NEXT3(vrd); vwr = DA_NEXT3(vwr); } while (0)
    for (int t = 1; t + 1 < NT; t += 2) {
        DA_HALF_STEP(pB0, pB1, mnB, alB, pA0, pA1, alA, t, 1);
        DA_HALF_STEP(pA0, pA1, mnA, alA, pB0, pB1, alB, t + 1, 0);
    }
    DA_SBAR(); qkt<1>(pB0, pB1, K_lds, r32, hi, S.qr); DA_SBAR();
    DA_SLOAD(nxt.K, nxt.V, 0); DA_SBAR();
#pragma unroll
    for (int d0 = 0; d0 < 4; ++d0) S.qr[d0] = load8(nxt.Q + (size_t)(wid * QBLK + r32) * RS + d0 * 16 + hi * 8);
    DA_SBAR();
    finishSM(pA0, pA1, alA, l_reg, pa0, pa1, pa2, pa3); DA_SBAR();
    DA_MASKT(pB0, pB1, NT - 1); rowmaxSM(pB0, pB1, m_reg, mnB, alB); DA_SBAR();
    pv_tile<true>(o, vb0 + vrd * SHM_V, pa0, pa1, pa2, pa3, pB0, pB1, mnB); vrd = DA_NEXT3(vrd);
    DA_RESC(alB);
    finishSM(pB0, pB1, alB, l_reg, pa0, pa1, pa2, pa3); DA_SBAR(); pv_tile<false>(o, vb0 + vrd * SHM_V, pa0, pa1, pa2, pa3, pB0, pB1, 0.f);
    __syncthreads();
    DA_SBAR(); DA_SEAM_K0();
    if (hi == 0) li_l[r32] = l_reg; asm volatile("s_waitcnt lgkmcnt(0)" ::: "memory");
    bf16* Ow = cur.O + (size_t)(wid * QBLK) * RS;
    { char* stg = lds + LDS_OST + wid * OST_WAVE;
#pragma unroll
      for (int ps = 0; ps < 2; ++ps) {
#pragma unroll
          for (int r = 8 * ps; r < 8 * ps + 8; ++r) { const int orow = crow(r, hi) - 16 * ps; const float rli_r = __builtin_amdgcn_rcpf(li_l[crow(r, hi)]);
#pragma unroll
              for (int d0 = 0; d0 < 4; ++d0) { const float v = o[d0][r] * rli_r;
                  const float vn = __int_as_float(__builtin_amdgcn_update_dpp(0, __float_as_int(v), 0xB1, 0xf, 0xf, true));
                  if ((r32 & 1) == 0) *(unsigned*)(stg + orow * 256 + (d0 * 32 + r32) * 2) = cvtpk(v, vn); } }
          asm volatile("s_waitcnt lgkmcnt(0)" ::: "memory");
          u32x4 w[4];
#pragma unroll
          for (int i = 0; i < 4; ++i) { const int row = 4 * i + (lane >> 4), ch = lane & 15; w[i] = *(const u32x4*)(stg + row * 256 + ch * 16); }
          asm volatile("s_waitcnt lgkmcnt(0)" ::: "memory");
#pragma unroll
          for (int i = 0; i < 4; ++i) { const int row = 4 * i + (lane >> 4), ch = lane & 15; *(u32x4*)(Ow + (size_t)(16 * ps + row) * RS + ch * 8) = w[i]; } } }
    __syncthreads();
#undef DA_NEXT3
#undef DA_RESC
#undef DA_KBASE
#undef DA_MASKT
#undef DA_SEAM_K0
#undef DA_HALF_STEP
}
#undef DA_VMW
#undef DA_VMWN
#undef DA_SLOAD
#undef DA_SWRITE_K
#undef DA_SWRITE_V
struct Tensors { const bf16* Q; const bf16* K; const bf16* V; bf16* O1; bf16* O2; const float* biastab; };
__device__ __forceinline__ BlockRef unit_ref(const Tensors& T, int v, int i) {
    const int bhc = (v & 255) >> 1, s = v & 1, b = bhc >> 4, h = (bhc >> 1) & 7, c = bhc & 1; const int q2 = 2 * (i >> 1) + s, qb = (i & 1) ? 15 - q2 : q2;
    const size_t row0 = (size_t)b * SEQ; BlockRef r;
    r.Q = T.Q + (row0 + (size_t)qb * QB) * RS + (2 * h + c) * DK; r.K = T.K + row0 * RS + (2 * h + c) * DK; r.V = T.V + row0 * RS + h * DV;
    r.O = (c ? T.O2 : T.O1) + (row0 + (size_t)qb * QB) * RS + h * DV; r.P0 = qb * QB; return r;
}
__device__ __forceinline__ void phase(char* lds, const Tensors& T, int vcu) {
    { const int h = ((vcu & 255) >> 2) & 7, i = (int)threadIdx.x; if (i < TAB_N) ((float*)(lds + LDS_TAB))[i] = i < TAB_PADL ? -__builtin_inff() : (i < TAB_PADL + 128 ? T.biastab[h * 128 + i - TAB_PADL] : 0.f); }
    Seam S; BlockRef cur = unit_ref(T, vcu, 0);
    prime(cur, lds, S);
    if (threadIdx.x >= 256) __builtin_amdgcn_s_setprio(1);
    for (int i = 0; i < 8; ++i) { const BlockRef nxt = unit_ref(T, vcu, i + 1 < 8 ? i + 1 : i); block(cur, nxt, lds, S); cur = nxt; }
    __builtin_amdgcn_s_setprio(0);
}
#undef DA_KSWZ
#undef DA_SBAR
}
#ifndef PG8_SP2
#define PG8_SP2 true
#endif
#ifndef PG8_ALIGN
#define PG8_ALIGN true
#endif
constexpr int NWAVES = 8;
#ifndef MK_N_LAUNCHES
#define MK_N_LAUNCHES 1
#endif
constexpr int N_PHASES = 8;
constexpr int BATCH = 8, SEQ = 4096, D = 2048, M = BATCH * SEQ;
constexpr int NPROJ = 5120, DATT = 1024, DCONV = 1024, CONVW = 31;
constexpr int PH = 8, PNK = 128, PHALF = 128, PTOPK = 16, NEXP = 16384;
constexpr float LN_EPS = 1e-5f;
constexpr float DN_ALPHA = 1.189207115002721f;
constexpr float LAMBDA_INIT = 0.2f;
constexpr size_t MiB = 1u << 20;
constexpr size_t WS_WIN = 2 * MiB, WS_WOUT = 22 * MiB, WS_WQ = 30 * MiB, WS_KEYS = 38 * MiB, WS_TAB = 39 * MiB;
constexpr size_t WS_U8 = 40 * MiB, WS_V8 = 72 * MiB, WS_SU = 104 * MiB, WS_SV = 105 * MiB;
constexpr size_t WS_XB = 168 * MiB;
constexpr size_t WS_Q = 296 * MiB, WS_K = 360 * MiB, WS_V = 424 * MiB, WS_H = 488 * MiB;
constexpr size_t WS_O1 = 552 * MiB, WS_O2 = 616 * MiB;
constexpr size_t WS_Y1 = 680 * MiB;
constexpr size_t WS_QP = 808 * MiB;
constexpr size_t WS_X8 = WS_O1;
constexpr size_t WS_SX = 106 * MiB, WS_SWQ = 107 * MiB, WS_SWIN = WS_SWQ + 65536, WS_SWOUT = WS_SWQ + 131072, WS_SXA = 108 * MiB, WS_SM = 109 * MiB, WS_LNS = 110 * MiB, WS_SXQ = 111 * MiB, WS_NSU = 112 * MiB;
constexpr size_t WS_XH = WS_O2, WS_XL = WS_O2 + 32 * MiB;
constexpr size_t WS_CMAX = 16384;
constexpr size_t WS_EID = 936 * MiB, WS_GATE = 952 * MiB;
constexpr size_t WS_END = 968 * MiB;
constexpr int RING_BYTES = 131072, LDS_BYTES = 163840;

#define GAS __attribute__((address_space(1)))
#define LAS __attribute__((address_space(3)))
typedef unsigned short bf16;
typedef unsigned v4u __attribute__((ext_vector_type(4)));
typedef unsigned v2u __attribute__((ext_vector_type(2)));
typedef float f32x4 __attribute__((ext_vector_type(4)));
typedef float f32x16 __attribute__((ext_vector_type(16)));
typedef short bf16x8 __attribute__((ext_vector_type(8)));
typedef __bf16 bf16x2_t __attribute__((ext_vector_type(2)));
#define LDS_WAIT() asm volatile("s_waitcnt lgkmcnt(0)" ::: "memory")
#ifndef PROBE_SEC
#define PROBE_SEC -1
#endif
#ifndef PROBE_REP
#define PROBE_REP -1
#endif
#define SEC_REP(id) for (int sec_rep_ = 0; sec_rep_ < ((PROBE_REP == (id)) ? 2 : 1); ++sec_rep_)
#define SEC_BEGIN(id) const unsigned long long sec_t0_##id = (PROBE_SEC == (id)) ? __builtin_amdgcn_s_memrealtime() : 0ull
#define SEC_END(id) do { if (PROBE_SEC == (id)) { const unsigned long long t1_ = __builtin_amdgcn_s_memrealtime(), dt_ = t1_ - sec_t0_##id; while (__builtin_amdgcn_s_memrealtime() - t1_ < dt_) __builtin_amdgcn_s_sleep(4); } } while (0)
__device__ __forceinline__ unsigned f2bf(float f) { unsigned u = __builtin_bit_cast(unsigned, f); return (u + 0x7fffu + ((u >> 16) & 1u)) >> 16; }
__device__ __forceinline__ unsigned pk2(float lo, float hi) { return f2bf(lo) | (f2bf(hi) << 16); }
__device__ __forceinline__ float bflo(unsigned w) { return __uint_as_float(w << 16); }
__device__ __forceinline__ float bfhi(unsigned w) { return __uint_as_float(w & 0xffff0000u); }
__device__ __forceinline__ float wave_sum(float v);
__device__ __forceinline__ float wave_max(float v);
__device__ __forceinline__ float dot2bf(unsigned a, unsigned b, float acc) { return __builtin_amdgcn_fdot2_f32_bf16(__builtin_bit_cast(bf16x2_t, a), __builtin_bit_cast(bf16x2_t, b), acc, false); }

#define XB_TMO      128
#define XB_XCNT(j)  (256  + 64 * (j))
#define XB_XSUB(j)  (1280 + 64 * (j))
#define XB_XGEN(j)  (2304 + 64 * (j))
#define XB_TOP      3328
#define XB_TOPGEN   3392
#define XCD_BAR_WORDS 3456
#define XB_SPIN_CAP (1u << 18)

__device__ __forceinline__ unsigned xb_ld(unsigned* p)              { return __hip_atomic_load(p, __ATOMIC_RELAXED, __HIP_MEMORY_SCOPE_AGENT); }
__device__ __forceinline__ unsigned xb_add(unsigned* p, unsigned v) { return __hip_atomic_fetch_add(p, v, __ATOMIC_RELAXED, __HIP_MEMORY_SCOPE_AGENT); }
__device__ __forceinline__ unsigned xb_xcc_id() { return (unsigned)__builtin_amdgcn_s_getreg((3 << 11) | 20) & 0xFu; }
#define XB_SPIN(cond, bar) do { unsigned _sp = 0; while (cond) { __builtin_amdgcn_s_sleep(1); \
    if ((++_sp & 255u) == 0u) { if (xb_ld(&(bar)[XB_TMO])) break; if (_sp > XB_SPIN_CAP) { atomicAdd(&(bar)[XB_TMO], 1u); break; } } } } while (0)

struct XcdBarrier {
    unsigned* bar; unsigned x;
    volatile LAS unsigned* st;
};

__device__ __forceinline__ XcdBarrier xcd_barrier_post(unsigned* bar, volatile LAS unsigned* st) {
    XcdBarrier b; b.bar = bar; b.x = xb_xcc_id(); b.st = st;
    if (threadIdx.x == 0) (void)xb_add(&bar[XB_XCNT(b.x)], 1u);
    return b;
}
__device__ __forceinline__ void xcd_barrier_complete(unsigned* bar, unsigned x, unsigned& nloc, unsigned& nx) {
    const unsigned G = gridDim.x * gridDim.y * gridDim.z;
    unsigned sum, cnt, mine, sp = 0u;
    for (;;) {
        sum = 0u; cnt = 0u; mine = 0u;
#pragma unroll
        for (unsigned j = 0; j < 16; ++j) { const unsigned c = xb_ld(&bar[XB_XCNT(j)]); sum += c; cnt += (c > 0u) ? 1u : 0u; mine = (j == x) ? c : mine; }
        if (sum == G) break;
        __builtin_amdgcn_s_sleep(1);
        if ((++sp & 255u) == 0u) { if (xb_ld(&bar[XB_TMO])) break; if (sp > XB_SPIN_CAP) { atomicAdd(&bar[XB_TMO], 1u); break; } }
    }
    nloc = mine > 0u ? mine : 1u; nx = cnt > 0u ? cnt : 1u;
}

__device__ __forceinline__ void xcd_barrier(const XcdBarrier& b) {
    asm volatile("s_waitcnt vmcnt(0)" ::: "memory");
    __syncthreads();
    if (threadIdx.x == 0) {
        unsigned* bar = b.bar;
        __builtin_amdgcn_s_waitcnt(0);
        unsigned nloc = b.st[0], nx = b.st[1];
        if (nloc == 0u) { xcd_barrier_complete(bar, b.x, nloc, nx); b.st[0] = nloc; b.st[1] = nx; }
        const unsigned old = xb_add(&bar[XB_XSUB(b.x)], 1u);
        const unsigned gen = old / nloc;
        if (old + 1u == (gen + 1u) * nloc) {
            __builtin_amdgcn_fence(__ATOMIC_RELEASE, "agent");
            asm volatile("s_waitcnt vmcnt(0)" ::: "memory");
            const unsigned og = xb_add(&bar[XB_TOP], 1u);
            const unsigned tg = og / nx;
            if (og + 1u == (tg + 1u) * nx) xb_add(&bar[XB_TOPGEN], 1u);
            else XB_SPIN(xb_ld(&bar[XB_TOPGEN]) == tg, bar);
            __builtin_amdgcn_fence(__ATOMIC_ACQUIRE, "agent");
            xb_add(&bar[XB_XGEN(b.x)], 1u);
            asm volatile("s_waitcnt vmcnt(0)" ::: "memory");
        } else {
            XB_SPIN(xb_ld(&bar[XB_XGEN(b.x)]) == gen, bar);
            __builtin_amdgcn_fence(__ATOMIC_ACQUIRE, "agent");
            asm volatile("s_waitcnt vmcnt(0)" ::: "memory");
        }
    }
    __syncthreads();
}

struct Frame {
    LAS unsigned char* lds;
    __device__ __forceinline__ int wave_() const { int w = __builtin_amdgcn_readfirstlane((int)threadIdx.x >> 6); asm volatile("" : "+s"(w)); return w; }
    __device__ __forceinline__ int G_() const { int g = (int)gridDim.x; asm volatile("" : "+s"(g)); return g; }
    __device__ __forceinline__ int vcu_() const { int bx = (int)blockIdx.x; asm volatile("" : "+s"(bx)); const int g = G_(); return (g % 8 == 0) ? (bx % 8) * (g / 8) + bx / 8 : bx; }
    __device__ __forceinline__ int tid() const { int t = (int)threadIdx.x; asm volatile("" : "+v"(t)); return t; }
    __device__ __forceinline__ int lane() const { return tid() & 63; }
    __device__ __forceinline__ unsigned long long raw(int k) const { const volatile LAS unsigned* p = (const volatile LAS unsigned*)(lds + RING_BYTES) + 2 * k;
        const unsigned lo = __builtin_amdgcn_readfirstlane(p[0]), hi = __builtin_amdgcn_readfirstlane(p[1]); return ((unsigned long long)hi << 32) | lo; }
    __device__ __forceinline__ const float* in(int k) const { return (const float*)(const GAS float*)raw(k); }
    __device__ __forceinline__ float* outp() const { return (float*)(GAS float*)raw(22); }
    template <class T> __device__ __forceinline__ T* ws(size_t off) const { return (T*)(GAS T*)((GAS unsigned char*)raw(23) + off); }
};
enum { I_X = 0, I_WIN, I_BGLU, I_CONVW, I_CONVB, I_CLNG, I_CLNB, I_LQ1, I_LK1, I_LQ2, I_LK2, I_SUBLN, I_RELB, I_WOUT, I_LN1G, I_LN1B, I_WQ, I_KEYS, I_U, I_V, I_LN2G, I_LN2B };

template <int CTRL> __device__ __forceinline__ int dppi(int v) { return __builtin_amdgcn_update_dpp(0, v, CTRL, 0xf, 0xf, true); }
template <int CTRL> __device__ __forceinline__ float dppf(float v) { return __int_as_float(__builtin_amdgcn_update_dpp(0, __float_as_int(v), CTRL, 0xf, 0xf, true)); }
__device__ __forceinline__ unsigned pack_i8x4(float a, float b, float c, float d) {
    const int ia = (int)rintf(a), ib = (int)rintf(b), ic = (int)rintf(c), id = (int)rintf(d); return (unsigned)(ia & 255) | ((unsigned)(ib & 255) << 8) | ((unsigned)(ic & 255) << 16) | ((unsigned)id << 24); }
__device__ __forceinline__ void p0_colmax_item(const float* W, int N, unsigned* cmax, int k0, int n0, int dst0, int lane) {
    f32x4 am = {0.f, 0.f, 0.f, 0.f};
#pragma unroll
    for (int i = 0; i < 8; ++i) { const f32x4 v = *(const GAS f32x4*)(W + (size_t)(k0 + 8 * i + (lane >> 3)) * N + n0 + 4 * (lane & 7));
        am[0] = fmaxf(am[0], fabsf(v[0])); am[1] = fmaxf(am[1], fabsf(v[1])); am[2] = fmaxf(am[2], fabsf(v[2])); am[3] = fmaxf(am[3], fabsf(v[3])); }
#pragma unroll
    for (int e = 0; e < 4; ++e) { am[e] = fmaxf(am[e], __shfl_xor(am[e], 8)); am[e] = fmaxf(am[e], __shfl_xor(am[e], 16)); am[e] = fmaxf(am[e], __shfl_xor(am[e], 32)); }
    if (lane < 8) {
#pragma unroll
        for (int e = 0; e < 4; ++e) atomicMax(cmax + dst0 + 4 * lane + e, __float_as_uint(am[e])); }
}
__device__ __forceinline__ void p0_quant_item(const float* W, int N, unsigned char* WT8, const unsigned* cmax, float* scale, int k0, int n0, int dst0, LAS float* scr, int lane) {
#pragma unroll
    for (int i = 0; i < 8; ++i) { const int kk = 8 * i + (lane >> 3); const f32x4 v = *(const GAS f32x4*)(W + (size_t)(k0 + kk) * N + n0 + 4 * (lane & 7));
        LAS float* d = scr + kk * 33 + 4 * (lane & 7); d[0] = v[0]; d[1] = v[1]; d[2] = v[2]; d[3] = v[3]; }
    if (lane < 32) { const float am = __uint_as_float(__hip_atomic_load(cmax + dst0 + lane, __ATOMIC_RELAXED, __HIP_MEMORY_SCOPE_AGENT)); const float sc = am > 0.f ? am * (1.f / 127.f) : 1.f;
        scr[64 * 33 + lane] = 1.f / sc; if (k0 == 0) scale[dst0 + lane] = sc; }
    LDS_WAIT(); asm volatile("" ::: "memory");
    const int c = lane & 7;
#pragma unroll
    for (int j = 0; j < 4; ++j) { const int n = (lane >> 3) + 8 * j; const LAS float* sp = scr + (8 * c) * 33 + n; const float inv = scr[64 * 33 + n];
        *(GAS v2u*)(WT8 + (size_t)(dst0 + n) * D + k0 + 8 * c) = (v2u){pack_i8x4(sp[0 * 33] * inv, sp[1 * 33] * inv, sp[2 * 33] * inv, sp[3 * 33] * inv), pack_i8x4(sp[4 * 33] * inv, sp[5 * 33] * inv, sp[6 * 33] * inv, sp[7 * 33] * inv)}; }
    LDS_WAIT(); asm volatile("" ::: "memory");
}
__device__ __forceinline__ int glu_dst(int n0) {
    if (n0 < 3072) return n0;
    const int ch = (n0 - 3072) & 1023, gate = (n0 - 3072) >> 10; return 3072 + 256 * (ch >> 7) + 64 * ((ch & 127) >> 5) + 32 * gate + (ch & 31);
}
__device__ __forceinline__ void p0_quant_x(const float* src, unsigned char* dst8, float* scale, int rows, int gw, int NGW, int lane) {
    f32x4 nx[8], nx2[8];
    if (gw < rows) { const GAS f32x4* sp = (const GAS f32x4*)(src + (size_t)gw * D) + lane; const int r1 = (gw + NGW < rows) ? gw + NGW : gw; const GAS f32x4* sq = (const GAS f32x4*)(src + (size_t)r1 * D) + lane;
#pragma unroll
        for (int j = 0; j < 8; ++j) { nx[j] = sp[64 * j]; nx2[j] = sq[64 * j]; } }
    for (int r = gw; r < rows; r += NGW) {
        f32x4 v[8]; float am = 0.f;
#pragma unroll
        for (int j = 0; j < 8; ++j) { v[j] = nx[j]; nx[j] = nx2[j]; }
        { const int rn = (r + 2 * NGW < rows) ? r + 2 * NGW : r; const GAS f32x4* sp = (const GAS f32x4*)(src + (size_t)rn * D) + lane;
#pragma unroll
          for (int j = 0; j < 8; ++j) nx2[j] = sp[64 * j]; }
#pragma unroll
        for (int j = 0; j < 8; ++j) am = fmaxf(fmaxf(am, fmaxf(fabsf(v[j].x), fabsf(v[j].y))), fmaxf(fabsf(v[j].z), fabsf(v[j].w)));
        am = wave_max(am);
        const float sc = am > 0.f ? am * (1.f / 127.f) : 1.f, inv = 1.f / sc;
        GAS unsigned* dp = (GAS unsigned*)(dst8 + (size_t)r * D) + lane;
#pragma unroll
        for (int j = 0; j < 8; ++j) dp[64 * j] = pack_i8x4(v[j].x * inv, v[j].y * inv, v[j].z * inv, v[j].w * inv);
        if (lane == 0) scale[r] = sc;
    }
}
__device__ __forceinline__ void p0_convert(const float* src, bf16* dst, size_t n, int gw, int NGW, int lane) {
    const size_t nit = n / 512;
    for (size_t it = gw; it < nit; it += NGW) { const GAS f32x4* s = (const GAS f32x4*)(src + it * 512) + 2 * lane; const f32x4 a = s[0], b = s[1];
        v4u o; o.x = pk2(a.x, a.y); o.y = pk2(a.z, a.w); o.z = pk2(b.x, b.y); o.w = pk2(b.z, b.w); *((GAS v4u*)(dst + it * 512) + lane) = o; }
}
template <bool INT8> __device__ __forceinline__ void p0_quant_rows(const float* src, unsigned* dst8, float* scale, int rows, int gw, int NGW, int lane) {
    f32x4 nx[8], nx2[8];
    if (gw < rows) { const GAS f32x4* sp = (const GAS f32x4*)(src + (size_t)gw * D) + lane; const int r1 = (gw + NGW < rows) ? gw + NGW : gw; const GAS f32x4* sq = (const GAS f32x4*)(src + (size_t)r1 * D) + lane;
#pragma unroll
        for (int j = 0; j < 8; ++j) { nx[j] = sp[64 * j]; nx2[j] = sq[64 * j]; } }
    for (int r = gw; r < rows; r += NGW) {
        f32x4 v[8]; float am = 0.f;
#pragma unroll
        for (int j = 0; j < 8; ++j) { v[j] = nx[j]; nx[j] = nx2[j]; }
        { const int rn = (r + 2 * NGW < rows) ? r + 2 * NGW : r; const GAS f32x4* sp = (const GAS f32x4*)(src + (size_t)rn * D) + lane;
#pragma unroll
          for (int j = 0; j < 8; ++j) nx2[j] = sp[64 * j]; }
#pragma unroll
        for (int j = 0; j < 8; ++j) am = fmaxf(fmaxf(am, fmaxf(fabsf(v[j].x), fabsf(v[j].y))), fmaxf(fabsf(v[j].z), fabsf(v[j].w)));
        am = wave_max(am);
        const float sc = am > 0.f ? am * (INT8 ? (1.f / 127.f) : (1.f / 440.f)) : 1.f, inv = 1.f / sc;
#pragma unroll
        for (int j = 0; j < 8; ++j) { int w;
            if (INT8) w = (int)pack_i8x4(v[j].x * inv, v[j].y * inv, v[j].z * inv, v[j].w * inv);
            else { w = __builtin_amdgcn_cvt_pk_fp8_f32(v[j].x * inv, v[j].y * inv, 0, false); w = __builtin_amdgcn_cvt_pk_fp8_f32(v[j].z * inv, v[j].w * inv, w, true); }
            const int wi = lane + 64 * j, c = wi >> 5; *((GAS unsigned*)dst8 + ((size_t)c * rows + r) * 32 + (wi & 31)) = (unsigned)w; }
        if (lane == 0) scale[r] = sc;
    }
}
template <bool HI2C  > __device__ __forceinline__ void p0_quant_u4(const float* src, unsigned* dst4, float* scale, float* nsum  , int rows, int gw, int NGW, int lane) {
    f32x4 nx[8], nx2[8];
    if (gw < rows) { const GAS f32x4* sp = (const GAS f32x4*)(src + (size_t)gw * D) + lane; const int r1 = (gw + NGW < rows) ? gw + NGW : gw; const GAS f32x4* sq = (const GAS f32x4*)(src + (size_t)r1 * D) + lane;
#pragma unroll
        for (int j = 0; j < 8; ++j) { nx[j] = sp[64 * j]; nx2[j] = sq[64 * j]; } }
    for (int r = gw; r < rows; r += NGW) {
        f32x4 v[8]; float ss = 0.f;
#pragma unroll
        for (int j = 0; j < 8; ++j) { v[j] = nx[j]; nx[j] = nx2[j]; }
        { const int rn = (r + 2 * NGW < rows) ? r + 2 * NGW : r; const GAS f32x4* sp = (const GAS f32x4*)(src + (size_t)rn * D) + lane;
#pragma unroll
          for (int j = 0; j < 8; ++j) nx2[j] = sp[64 * j]; }
#pragma unroll
        for (int j = 0; j < 8; ++j) ss += (v[j].x * v[j].x + v[j].y * v[j].y) + (v[j].z * v[j].z + v[j].w * v[j].w);
        ss = wave_sum(ss);
        const float sc = ss > 0.f ? 0.35f * sqrtf(ss * (1.f / D)) : 1.f, inv = 1.f / sc;
        int nsl = 0;
#pragma unroll
        for (int j = 0; j < 8; ++j) { unsigned own = 0, snd = 0;
#pragma unroll
            for (int e = 0; e < 4; ++e) { const int q = (int)fminf(fmaxf(rintf(v[j][e] * inv), -8.f), 7.f); own |= (unsigned)(q + 8) << (8 * e); snd |= (unsigned)(HI2C ? (q & 15) : (q + 8)) << (8 * e); nsl += q + 8; }
            const unsigned nbr = (unsigned)dppi<0xB1>((int)snd);
            if ((lane & 1) == 0) *((GAS unsigned*)dst4 + ((size_t)j * rows + r) * 32 + (lane >> 1)) = own | (nbr << 4); }
        if (nsum) { const float ns = wave_sum((float)nsl); if (lane == 0) nsum[r] = ns; }
        if (lane == 0) scale[r] = sc;
    }
}
__device__ __forceinline__ int t5_bucket(int d) {
    if (d < 16) return d;
    int l = 16 + (int)(logf((float)d / 16.f) / logf(8.f) * 16.f); return l < 31 ? l : 31;
}
__device__ __forceinline__ void p0a_prologue(Frame& F) {
    LAS float* scr = (LAS float*)(F.lds + F.wave_() * 16384);
    constexpr int I_IN = (D / 64) * (NPROJ / 32), I_OUT = (D / 64) * (D / 32);
    { const float* w_in = F.in(I_WIN); unsigned* cmax = F.ws<unsigned>(WS_CMAX); const int gw = F.vcu_() * NWAVES + F.wave_(), NGW = F.G_() * NWAVES;
      for (int r = gw; r < I_IN; r += NGW) { const int nblk = NPROJ / 32, kb = r / nblk, nb = r % nblk; p0_colmax_item(w_in, NPROJ, cmax, 64 * kb, 32 * nb, glu_dst(32 * nb), F.lane()); } }
    { const float* wq = F.in(I_WQ); unsigned* cmax = F.ws<unsigned>(WS_CMAX) + NPROJ; const int gw = F.vcu_() * NWAVES + F.wave_(), NGW = F.G_() * NWAVES;
      for (int r = gw; r < I_OUT; r += NGW) { const int nblk = D / 32, kb = r / nblk, nb = r % nblk; p0_colmax_item(wq, D, cmax, 64 * kb, 32 * nb, 32 * nb, F.lane()); } }
    { const float* wo = F.in(I_WOUT); unsigned* cmax = F.ws<unsigned>(WS_CMAX) + NPROJ + D; const int gw = F.vcu_() * NWAVES + F.wave_(), NGW = F.G_() * NWAVES;
      for (int r = gw; r < I_OUT; r += NGW) { const int nblk = D / 32, kb = r / nblk, nb = r % nblk; p0_colmax_item(wo, D, cmax, 64 * kb, 32 * nb, 32 * nb, F.lane()); } }
}
__device__ __forceinline__ void p0b_prologue(Frame& F) {
    LAS float* scr = (LAS float*)(F.lds + F.wave_() * 16384);
    constexpr int I_IN = (D / 64) * (NPROJ / 32), I_OUT = (D / 64) * (D / 32);
    { const float* w_in = F.in(I_WIN); unsigned char* W8 = F.ws<unsigned char>(WS_WIN); const unsigned* cmax = F.ws<unsigned>(WS_CMAX); float* sw = F.ws<float>(WS_SWIN); const int gw = F.vcu_() * NWAVES + F.wave_(), NGW = F.G_() * NWAVES;
      for (int r = gw; r < I_IN; r += NGW) { const int nblk = NPROJ / 32, kb = r / nblk, nb = r % nblk; p0_quant_item(w_in, NPROJ, W8, cmax, sw, 64 * kb, 32 * nb, glu_dst(32 * nb), scr, F.lane()); } }
    { const float* wq = F.in(I_WQ); unsigned char* W8 = F.ws<unsigned char>(WS_WQ); const unsigned* cmax = F.ws<unsigned>(WS_CMAX) + NPROJ; float* sw = F.ws<float>(WS_SWQ); const int gw = F.vcu_() * NWAVES + F.wave_(), NGW = F.G_() * NWAVES;
      for (int r = gw; r < I_OUT; r += NGW) { const int nblk = D / 32, kb = r / nblk, nb = r % nblk; p0_quant_item(wq, D, W8, cmax, sw, 64 * kb, 32 * nb, 32 * nb, scr, F.lane()); } }
    { const float* wo = F.in(I_WOUT); unsigned char* W8 = F.ws<unsigned char>(WS_WOUT); const unsigned* cmax = F.ws<unsigned>(WS_CMAX) + NPROJ + D; float* sw = F.ws<float>(WS_SWOUT); const int gw = F.vcu_() * NWAVES + F.wave_(), NGW = F.G_() * NWAVES;
      for (int r = gw; r < I_OUT; r += NGW) { const int nblk = D / 32, kb = r / nblk, nb = r % nblk; p0_quant_item(wo, D, W8, cmax, sw, 64 * kb, 32 * nb, 32 * nb, scr, F.lane()); } }
    { const int gw = F.vcu_() * NWAVES + F.wave_(), NGW = F.G_() * NWAVES; p0_quant_x(F.in(I_X), F.ws<unsigned char>(WS_XB), F.ws<float>(WS_SXA), M, gw, NGW, F.lane()); }
    { const int gw = F.vcu_() * NWAVES + F.wave_(), NGW = F.G_() * NWAVES; p0_quant_u4<false>(F.in(I_U), F.ws<unsigned>(WS_U8), F.ws<float>(WS_SU), F.ws<float>(WS_NSU), NEXP, gw, NGW, F.lane()); }
    { const int gw = F.vcu_() * NWAVES + F.wave_(), NGW = F.G_() * NWAVES; p0_quant_u4<true>(F.in(I_V), F.ws<unsigned>(WS_V8), F.ws<float>(WS_SV), nullptr, NEXP, gw, NGW, F.lane()); }
    { const int gw = F.vcu_() * NWAVES + F.wave_(), NGW = F.G_() * NWAVES; p0_convert(F.in(I_KEYS), F.ws<bf16>(WS_KEYS), (size_t)PH * 2 * PNK * PHALF, gw, NGW, F.lane()); }
    if (blockIdx.x == 0) { const float* rel_bias = F.in(I_RELB); float* TAB = F.ws<float>(WS_TAB);
        for (int i = F.tid(); i < 8 * 128; i += NWAVES * 64) { const int h = i >> 7, d = i & 127;
            TAB[i] = (rel_bias[t5_bucket(d) * 8 + h] - rel_bias[31 * 8 + h]) * 1.4426950408889634f; } }
}

__device__ __forceinline__ float diff_lambda(Frame& F) {
    const float a = wave_sum(F.in(I_LQ1)[F.lane()] * F.in(I_LK1)[F.lane()]), b = wave_sum(F.in(I_LQ2)[F.lane()] * F.in(I_LK2)[F.lane()]);
    return expf(a) - expf(b) + LAMBDA_INIT;
}
template <int CTRL, int RM> __device__ __forceinline__ float dpp_rm(float old, float v) { return __int_as_float(__builtin_amdgcn_update_dpp(__float_as_int(old), __float_as_int(v), CTRL, RM, 0xf, false)); }
__device__ __forceinline__ float wave_sum63(float v) {
    v += dppf<0xB1>(v); v += dppf<0x4E>(v); v += dppf<0x141>(v); v += dppf<0x140>(v);
    v += dpp_rm<0x142, 0xa>(0.f, v);
    v += dpp_rm<0x143, 0xc>(0.f, v);
    return v;
}
__device__ __forceinline__ float wave_max63(float v) {
    v = fmaxf(v, dppf<0xB1>(v)); v = fmaxf(v, dppf<0x4E>(v)); v = fmaxf(v, dppf<0x141>(v)); v = fmaxf(v, dppf<0x140>(v));
    v = fmaxf(v, dpp_rm<0x142, 0xa>(0.f, v)); v = fmaxf(v, dpp_rm<0x143, 0xc>(0.f, v));
    return v;
}
__device__ __forceinline__ float wave_sum(float v) { return __int_as_float(__builtin_amdgcn_readlane(__float_as_int(wave_sum63(v)), 63)); }
__device__ __forceinline__ float wave_max(float v) { return __int_as_float(__builtin_amdgcn_readlane(__float_as_int(wave_max63(v)), 63)); }
typedef _Float16 h2_t __attribute__((ext_vector_type(2)));
__device__ __forceinline__ h2_t pin_h2(float a, float b) { unsigned u = __builtin_bit_cast(unsigned, (h2_t){(_Float16)a, (_Float16)b}); asm volatile("" : "+v"(u)); return __builtin_bit_cast(h2_t, u); }
__device__ __forceinline__ float xr_swap32(float a, float b, bool mx) { auto rr = __builtin_amdgcn_permlane32_swap(__float_as_uint(a), __float_as_uint(b), false, false); const float x = __uint_as_float(rr[0]), y = __uint_as_float(rr[1]); return mx ? fmaxf(x, y) : x + y; }
__device__ __forceinline__ float xr_swap16(float a, float b, bool mx) { auto rr = __builtin_amdgcn_permlane16_swap(__float_as_uint(a), __float_as_uint(b), false, false); const float x = __uint_as_float(rr[0]), y = __uint_as_float(rr[1]); return mx ? fmaxf(x, y) : x + y; }
template <int CTRL> __device__ __forceinline__ float xr_dpp(float lo, float hi, bool t, bool mx) { const float k = t ? hi : lo, s = t ? lo : hi, o = dppf<CTRL>(s); return mx ? fmaxf(k, o) : k + o; }
__device__ __forceinline__ float xred64_sum(const float (&v)[64], int lane) {
    float a[32], b[16], c[8], d[4], e[2];
#pragma unroll
    for (int i = 0; i < 32; ++i) a[i] = xr_swap32(v[i], v[i + 32], false);
#pragma unroll
    for (int i = 0; i < 16; ++i) b[i] = xr_swap16(a[i], a[i + 16], false);
#pragma unroll
    for (int i = 0; i < 8; ++i) c[i] = xr_dpp<0x128>(b[i], b[i + 8], lane & 8, false);
#pragma unroll
    for (int i = 0; i < 4; ++i) d[i] = xr_dpp<0x141>(c[i], c[i + 4], lane & 4, false);
#pragma unroll
    for (int i = 0; i < 2; ++i) e[i] = xr_dpp<0x4E>(d[i], d[i + 2], lane & 2, false);
    return xr_dpp<0xB1>(e[0], e[1], lane & 1, false);
}
__device__ __forceinline__ float xred32_max(const float (&v)[32], int lane) {
    float a[16], b[8], c[4], d[2];
#pragma unroll
    for (int i = 0; i < 16; ++i) a[i] = xr_swap32(v[i], v[i + 16], true);
#pragma unroll
    for (int i = 0; i < 8; ++i) b[i] = xr_swap16(a[i], a[i + 8], true);
#pragma unroll
    for (int i = 0; i < 4; ++i) c[i] = xr_dpp<0x128>(b[i], b[i + 4], lane & 8, true);
#pragma unroll
    for (int i = 0; i < 2; ++i) d[i] = xr_dpp<0x141>(c[i], c[i + 2], lane & 4, true);
    const float e = xr_dpp<0x4E>(d[0], d[1], lane & 2, true);
    return fmaxf(e, dppf<0xB1>(e));
}
#ifndef P3_PROBE_MULT
#define P3_PROBE_MULT 1
#endif
__device__ __forceinline__ void p3_mix(Frame& F) {
    constexpr int TT = 32, NH = TT + CONVW - 1, STG_OFF = 0, STATS_OFF = TT * 1024, AMC_OFF = STATS_OFF + NWAVES * 64 * 4, AMA_OFF = AMC_OFF + TT * NWAVES * 4, MS_OFF = AMA_OFF + 128, INV_OFF = MS_OFF + 256, AVP_OFF = 40960;
    static_assert(INV_OFF + 128 <= AVP_OFF && AVP_OFF + 8 * NWAVES * 64 * 16 <= RING_BYTES && NH == 62, "P3 LDS map");
    const int tid = F.tid(), lane = tid & 63, wave = F.wave_();
    const float lam = diff_lambda(F);
    const float* conv_w = F.in(I_CONVW); const unsigned* H = F.ws<unsigned>(WS_H); const bf16* O1 = F.ws<bf16>(WS_O1); const bf16* O2 = F.ws<bf16>(WS_O2);
    unsigned char* MIX8 = F.ws<unsigned char>(WS_XB); float* SM = F.ws<float>(WS_SM); const float* subln_g = F.in(I_SUBLN);
    const float2 cb = *(const float2*)(F.in(I_CONVB) + 2 * tid), lg = *(const float2*)(F.in(I_CLNG) + 2 * tid), lb = *(const float2*)(F.in(I_CLNB) + 2 * tid);
    LAS float* stats = (LAS float*)(F.lds + STATS_OFF); LAS float* amc = (LAS float*)(F.lds + AMC_OFF); LAS float* ama = (LAS float*)(F.lds + AMA_OFF); LAS float* ms = (LAS float*)(F.lds + MS_OFF); LAS float* invs = (LAS float*)(F.lds + INV_OFF);
    h2_t wk[CONVW];
#pragma unroll
    for (int k = 0; k < CONVW; ++k) { const float2 wf = *(const float2*)(conv_w + k * DCONV + 2 * tid); wk[k] = pin_h2(wf.x, wf.y); }
    const h2_t cbh = pin_h2(cb.x, cb.y);
    unsigned hv[NH];
#define P3_LOAD_H(tile_) do { const int t0_ = (tile_) * TT; const GAS unsigned* hp_ = (const GAS unsigned*)H + (size_t)t0_ * (DCONV / 2) + tid;     \
        _Pragma("unroll") for (int j = 0; j < NH; ++j) hv[j] = *(hp_ + (ptrdiff_t)(j - (CONVW - 1)) * (DCONV / 2)); } while (0)
    { const int ft = F.vcu_() < M / TT ? F.vcu_() : 0; P3_LOAD_H(ft); }
    for (int tile_j = F.vcu_(); tile_j < P3_PROBE_MULT * (M / TT); tile_j += F.G_()) { const int tile_i = tile_j & (M / TT - 1);
        const int t0 = tile_i * TT;
        const int tid = F.tid(), lane = tid & 63;
        v4u oa[4][2], ob[4][2];
#pragma unroll
        for (int rr = 0; rr < 4; ++rr) { const int m = t0 + 4 * wave + rr;
            const GAS char* p1 = (const GAS char*)(O1 + (size_t)m * 1024); const GAS char* p2 = (const GAS char*)(O2 + (size_t)m * 1024); const unsigned lo_ = (unsigned)lane * 32u;
            oa[rr][0] = *(const GAS v4u*)(p1 + lo_); oa[rr][1] = *(const GAS v4u*)(p1 + lo_ + 16); ob[rr][0] = *(const GAS v4u*)(p2 + lo_); ob[rr][1] = *(const GAS v4u*)(p2 + lo_ + 16); }
        __builtin_amdgcn_sched_barrier(0);
        h2_t cv[TT];
        { const unsigned zm = (t0 & (SEQ - 1)) != 0 ? 0xffffffffu : 0u;
#pragma unroll
          for (int j = 0; j < CONVW - 1; ++j) hv[j] &= zm; }
#pragma unroll
        for (int t = 0; t < TT; ++t) { h2_t acc = cbh;
#pragma unroll
            for (int k = 0; k < CONVW; ++k) acc = __builtin_elementwise_fma(__builtin_bit_cast(h2_t, hv[t + k]), wk[k], acc);
            { unsigned u_ = __builtin_bit_cast(unsigned, acc); asm volatile("" : "+v"(u_)); cv[t] = __builtin_bit_cast(h2_t, u_); } }
        __builtin_amdgcn_sched_barrier(0);
#pragma unroll
        for (int rr = 0; rr < 4; ++rr) { float av[16]; h2_t avp[8];
            const v4u a0 = oa[rr][0], a1 = oa[rr][1], b0 = ob[rr][0], b1 = ob[rr][1];
            const unsigned aw[8] = {a0.x, a0.y, a0.z, a0.w, a1.x, a1.y, a1.z, a1.w}, bw[8] = {b0.x, b0.y, b0.z, b0.w, b1.x, b1.y, b1.z, b1.w};
            float ss = 0.f;
#pragma unroll
            for (int i = 0; i < 8; ++i) { av[2 * i] = bflo(aw[i]) - lam * bflo(bw[i]); av[2 * i + 1] = bfhi(aw[i]) - lam * bfhi(bw[i]); ss += av[2 * i] * av[2 * i] + av[2 * i + 1] * av[2 * i + 1]; }
            ss += dppf<0xB1>(ss); ss += dppf<0x4E>(ss); ss += dppf<0x141>(ss);
            const float r = (1.f - LAMBDA_INIT) / sqrtf(ss * (1.f / 128.f) + LN_EPS); float am = 0.f;
#pragma unroll
            for (int e = 0; e < 8; ++e) { avp[e] = pin_h2(av[2 * e] * r * subln_g[16 * (lane & 7) + 2 * e], av[2 * e + 1] * r * subln_g[16 * (lane & 7) + 2 * e + 1]);
                am = fmaxf(am, fmaxf(fabsf((float)avp[e].x), fabsf((float)avp[e].y))); }
            am = wave_max63(am);
            if (lane == 63) ama[4 * wave + rr] = am;
#pragma unroll
            for (int hh = 0; hh < 2; ++hh) *(LAS v4u*)(F.lds + AVP_OFF + ((rr * 2 + hh) * (NWAVES * 64) + tid) * 16) = (v4u){__builtin_bit_cast(unsigned, avp[4 * hh]), __builtin_bit_cast(unsigned, avp[4 * hh + 1]), __builtin_bit_cast(unsigned, avp[4 * hh + 2]), __builtin_bit_cast(unsigned, avp[4 * hh + 3])}; }
        { float sv[64];
#pragma unroll
          for (int t = 0; t < TT; ++t) { const float y0 = (float)cv[t].x, y1 = (float)cv[t].y; sv[2 * t] = y0 + y1; sv[2 * t + 1] = y0 * y0 + y1 * y1; }
          stats[wave * 64 + lane] = xred64_sum(sv, lane); }
        __builtin_amdgcn_sched_barrier(0);
        { const int nx_ = tile_j + F.G_(), nxt = nx_ < P3_PROBE_MULT * (M / TT) ? (nx_ & (M / TT - 1)) : tile_i; P3_LOAD_H(nxt); }
        __syncthreads();
        if (tid < TT) { float s = 0.f, q = 0.f;
#pragma unroll
            for (int w = 0; w < NWAVES; ++w) { s += stats[w * 64 + 2 * tid]; q += stats[w * 64 + 2 * tid + 1]; }
            const float mean = s * (1.f / DCONV), var = fmaxf(q * (1.f / DCONV) - mean * mean, 0.f); ms[2 * tid] = mean; ms[2 * tid + 1] = 1.f / sqrtf(var + LN_EPS); }
        __syncthreads();
        {
            float mv[TT];
#pragma unroll
            for (int q = 0; q < TT / 2; ++q) { const f32x4 st = *(const LAS f32x4*)(ms + 4 * q);
#pragma unroll
                for (int o = 0; o < 2; ++o) { const int t = 2 * q + o; const float mean = st[2 * o], rstd = st[2 * o + 1];
                    const float y0 = ((float)cv[t].x - mean) * rstd * lg.x + lb.x, y1 = ((float)cv[t].y - mean) * rstd * lg.y + lb.y;
#define SWISH_(y) ((y) * __builtin_amdgcn_rcpf(1.f + __builtin_amdgcn_exp2f(-1.4426950409f * (y))))
                    cv[t] = pin_h2(SWISH_(y0), SWISH_(y1));
#undef SWISH_
                    mv[t] = fmaxf(fabsf((float)cv[t].x), fabsf((float)cv[t].y)); } }
            const float amx = xred32_max(mv, lane);
            if ((lane & 1) == 0) amc[(lane >> 1) * NWAVES + wave] = amx; }
        __syncthreads();
        if (tid < TT) { float am = ama[tid];
#pragma unroll
            for (int w = 0; w < NWAVES; ++w) am = fmaxf(am, amc[tid * NWAVES + w]);
            const float sc = am > 0.f ? am * (1.f / 127.f) : 1.f; const _Float16 ih = (_Float16)(1.f / sc);
            ((LAS unsigned*)invs)[tid] = __builtin_bit_cast(unsigned, (h2_t){ih, ih}); SM[t0 + tid] = 1.f / (float)ih; }
        __syncthreads();
        const h2_t K1536 = (h2_t){(_Float16)1536.f, (_Float16)1536.f};
#pragma unroll
        for (int q = 0; q < TT / 4; ++q) { const v4u iv = *(const LAS v4u*)((LAS unsigned*)invs + 4 * q);
            const unsigned ivw[4] = {iv.x, iv.y, iv.z, iv.w};
#pragma unroll
            for (int o = 0; o < 4; ++o) { const int t = 4 * q + o; const unsigned r = __builtin_bit_cast(unsigned, __builtin_elementwise_fma(cv[t], __builtin_bit_cast(h2_t, ivw[o]), K1536));
                *(LAS unsigned short*)(F.lds + STG_OFF + t * 1024 + 2 * tid) = (unsigned short)__builtin_amdgcn_perm(0u, r, 0x0c0c0200u); } }
#pragma unroll
        for (int rr = 0; rr < 4; ++rr) { const h2_t ivh = __builtin_bit_cast(h2_t, ((LAS unsigned*)invs)[4 * wave + rr]);
            const v4u pa_ = *(const LAS v4u*)(F.lds + AVP_OFF + ((rr * 2) * (NWAVES * 64) + tid) * 16), pb_ = *(const LAS v4u*)(F.lds + AVP_OFF + ((rr * 2 + 1) * (NWAVES * 64) + tid) * 16);
            const unsigned pw_[8] = {pa_.x, pa_.y, pa_.z, pa_.w, pb_.x, pb_.y, pb_.z, pb_.w}; unsigned rq[8];
#pragma unroll
            for (int e = 0; e < 8; ++e) rq[e] = __builtin_bit_cast(unsigned, __builtin_elementwise_fma(__builtin_bit_cast(h2_t, pw_[e]), ivh, K1536));
            *((GAS v4u*)(MIX8 + (size_t)(t0 + 4 * wave + rr) * D) + lane) = (v4u){__builtin_amdgcn_perm(rq[1], rq[0], 0x06040200u), __builtin_amdgcn_perm(rq[3], rq[2], 0x06040200u), __builtin_amdgcn_perm(rq[5], rq[4], 0x06040200u), __builtin_amdgcn_perm(rq[7], rq[6], 0x06040200u)}; }
        __syncthreads();
        for (int idx = tid; idx < TT * 64; idx += NWAVES * 64) { const int row = idx >> 6, ch = idx & 63;
            *((GAS v4u*)(MIX8 + (size_t)(t0 + row) * D + DATT) + ch) = *(const LAS v4u*)(F.lds + STG_OFF + row * 1024 + ch * 16); }
        __syncthreads();
    }
}
#undef P3_LOAD_H
__device__ __forceinline__ void p5_ln1(Frame& F) {
    const bf16* Y1 = F.ws<bf16>(WS_Y1); const float* ln1_g = F.in(I_LN1G); const float* ln1_b = F.in(I_LN1B); unsigned char* X8 = F.ws<unsigned char>(WS_X8); float* SX = F.ws<float>(WS_SX); float* LNS = F.ws<float>(WS_LNS); float* SXQ = F.ws<float>(WS_SXQ); unsigned char* XH = F.ws<unsigned char>(WS_XH); unsigned char* XL = F.ws<unsigned char>(WS_XL);
    const int gw = F.vcu_() * NWAVES + F.wave_(), NGW = F.G_() * NWAVES, lane = F.lane();
    v4u nx[4];
    if (gw < M) { const GAS v4u* p = (const GAS v4u*)(Y1 + (size_t)gw * D) + lane;
#pragma unroll
        for (int j = 0; j < 4; ++j) nx[j] = p[64 * j]; }
    for (int m = gw; m < M; m += NGW) {
        v4u w[4]; float v[32]; float s = 0.f;
#pragma unroll
        for (int j = 0; j < 4; ++j) w[j] = nx[j];
        { const int mn = (m + NGW < M) ? m + NGW : m; const GAS v4u* p = (const GAS v4u*)(Y1 + (size_t)mn * D) + lane;
#pragma unroll
          for (int j = 0; j < 4; ++j) nx[j] = p[64 * j]; }
#pragma unroll
        for (int j = 0; j < 4; ++j) { const unsigned ww[4] = {w[j].x, w[j].y, w[j].z, w[j].w};
#pragma unroll
            for (int i = 0; i < 4; ++i) { v[8 * j + 2 * i] = bflo(ww[i]); v[8 * j + 2 * i + 1] = bfhi(ww[i]); s += v[8 * j + 2 * i] + v[8 * j + 2 * i + 1]; } }
        const float mean = wave_sum(s) * (1.f / D); float q = 0.f;
#pragma unroll
        for (int i = 0; i < 32; ++i) { v[i] -= mean; q += v[i] * v[i]; }
        const float rstd = 1.f / sqrtf(wave_sum(q) * (1.f / D) + LN_EPS);
        float am = 0.f;
#pragma unroll
        for (int j = 0; j < 4; ++j) { const int c0 = 8 * lane + 512 * j; const f32x4 g0 = *(const f32x4*)(ln1_g + c0), g1 = *(const f32x4*)(ln1_g + c0 + 4), b0 = *(const f32x4*)(ln1_b + c0), b1 = *(const f32x4*)(ln1_b + c0 + 4);
#pragma unroll
            for (int i = 0; i < 4; ++i) { v[8 * j + i] = v[8 * j + i] * rstd * g0[i] + b0[i]; v[8 * j + 4 + i] = v[8 * j + 4 + i] * rstd * g1[i] + b1[i]; am = fmaxf(am, fmaxf(fabsf(v[8 * j + i]), fabsf(v[8 * j + 4 + i]))); } }
        am = wave_max(am);
        const float sc = am > 0.f ? am * (1.f / 127.f) : 1.f, inv = 1.f / sc;
        GAS v2u* p8 = (GAS v2u*)(X8 + (size_t)m * D) + lane;
#pragma unroll
        for (int j = 0; j < 4; ++j) p8[64 * j] = (v2u){pack_i8x4(v[8 * j] * inv, v[8 * j + 1] * inv, v[8 * j + 2] * inv, v[8 * j + 3] * inv), pack_i8x4(v[8 * j + 4] * inv, v[8 * j + 5] * inv, v[8 * j + 6] * inv, v[8 * j + 7] * inv)};
        { GAS unsigned* ph = (GAS unsigned*)(XH + (size_t)m * (D / 2)) + lane; GAS unsigned* pl = (GAS unsigned*)(XL + (size_t)m * (D / 2)) + lane;
#pragma unroll
          for (int j = 0; j < 4; ++j) { unsigned wh = 0, wl = 0;
#pragma unroll
              for (int i = 0; i < 8; ++i) { const unsigned u = (unsigned)((int)rintf(v[8 * j + i] * inv) + 128); const int sh = 8 * (i & 3) + 4 * (i >> 2); wh |= (u >> 4) << sh; wl |= (u & 15u) << sh; }
              ph[64 * j] = wh; pl[64 * j] = wl; } }
        float qs = 0.f;
#pragma unroll
        for (int i = 0; i < 32; ++i) qs += rintf(v[i] * inv);
        qs = wave_sum(qs);
        if (lane == 0) { SX[m] = sc; LNS[2 * m] = mean; LNS[2 * m + 1] = rstd; SXQ[m] = qs; }
    }
}
__device__ __forceinline__ int f2key(float f) { const int b = __float_as_int(f); return b ^ ((b >> 31) & 0x7fffffff); }
__device__ __forceinline__ float key2f(int k) { return __int_as_float(k ^ ((k >> 31) & 0x7fffffff)); }
#define CE_DESC(a, b) do { const int _x = max(a, b), _y = min(a, b); a = _x; b = _y; } while (0)
template <int N> __device__ __forceinline__ void bitonic_merge_desc(int (&v)[N]) {
#pragma unroll
    for (int j = N >> 1; j > 0; j >>= 1)
#pragma unroll
        for (int i = 0; i < N; ++i) { const int l = i ^ j; if (l > i) CE_DESC(v[i], v[l]); }
}
__device__ __forceinline__ void sort16_desc(int (&v)[16]) {
#define CE_(a, b) CE_DESC(v[a], v[b])
    CE_(0,1); CE_(2,3); CE_(0,2); CE_(1,3); CE_(1,2); CE_(4,5); CE_(6,7); CE_(4,6); CE_(5,7); CE_(5,6); CE_(0,4); CE_(2,6); CE_(2,4); CE_(1,5); CE_(3,7); CE_(3,5); CE_(1,2); CE_(3,4); CE_(5,6);
    CE_(8,9); CE_(10,11); CE_(8,10); CE_(9,11); CE_(9,10); CE_(12,13); CE_(14,15); CE_(12,14); CE_(13,15); CE_(13,14); CE_(8,12); CE_(10,14); CE_(10,12); CE_(9,13); CE_(11,15); CE_(11,13); CE_(9,10); CE_(11,12); CE_(13,14);
    CE_(0,8); CE_(4,12); CE_(4,8); CE_(2,10); CE_(6,14); CE_(6,10); CE_(2,4); CE_(6,8); CE_(10,12); CE_(1,9); CE_(5,13); CE_(5,9); CE_(3,11); CE_(7,15); CE_(7,11); CE_(3,5); CE_(7,9); CE_(11,13);
    CE_(1,2); CE_(3,4); CE_(5,6); CE_(7,8); CE_(9,10); CE_(11,12); CE_(13,14);
#undef CE_
}
__device__ __forceinline__ void merge16(const int (&a)[16], const int (&b)[16], int (&o)[16]) {
#pragma unroll
    for (int i = 0; i < 16; ++i) o[i] = max(a[i], b[15 - i]);
    bitonic_merge_desc<16>(o);
}
__device__ const unsigned char PEER_PAIR[64] = {0,1,2,3,4,5,6,7,8,9,10,11,12,13,14,15, 16,17,18,19,20,21,22,23, 32,33,34,35,36, 48,49,50,51, 64,65,66, 80,81, 96,97, 112,113, 128,144,160,176,192,208,224,240, 0,0,0,0,0,0,0,0,0,0,0,0,0,0};
__device__ __forceinline__ void peer_load_q(bf16x8 (&bq)[8], const bf16* qrow  ) {
    asm volatile("" : "+v"(qrow));
#pragma unroll
    for (int s = 0; s < 8; ++s) bq[s] = *(const GAS bf16x8*)(qrow + 16 * s);
}
__device__ __forceinline__ void peer_subkey_top16(const bf16x8 (&bq)[8], const bf16* keys_hc  , int r32, int hi, int (&o)[16]) {
    int run[16];
#pragma unroll
    for (int mt = 0; mt < 4; ++mt) {
        const bf16* krow = keys_hc + (size_t)(32 * mt + r32) * PHALF + hi * 8;
        asm volatile("" : "+v"(krow));
        bf16x8 ka[8];
#pragma unroll
        for (int s = 0; s < 8; ++s) ka[s] = *(const GAS bf16x8*)(krow + 16 * s);
        f32x16 acc = {};
#pragma unroll
        for (int s = 0; s < 8; ++s) acc = __builtin_amdgcn_mfma_f32_32x32x16_bf16(ka[s], bq[s], acc, 0, 0, 0);
        int g[16];
#pragma unroll
        for (int r = 0; r < 16; ++r) g[r] = (f2key(acc[r]) & ~127) | ((r & 3) + 8 * (r >> 2));
        sort16_desc(g);
        if (mt) {
#pragma unroll
            for (int r = 0; r < 16; ++r) g[r] |= 32 * mt; }
        if (mt == 0) {
#pragma unroll
            for (int r = 0; r < 16; ++r) run[r] = g[r];
        } else { int t2[16]; merge16(run, g, t2);
#pragma unroll
            for (int r = 0; r < 16; ++r) run[r] = t2[r]; }
    }
    int lo[16], hh[16]; const int hi4 = 4 * hi;
#pragma unroll
    for (int i = 0; i < 16; ++i) { run[i] |= hi4; auto rr = __builtin_amdgcn_permlane32_swap((unsigned)run[i], (unsigned)run[i], false, false); lo[i] = (int)rr[0]; hh[i] = (int)rr[1]; }
    merge16(lo, hh, o);
}
__device__ __forceinline__ float gelu_erf(float v) { return 0.5f * v * (1.f + erff(v * 0.70710678118654752f)); }

typedef float f32x2 __attribute__((ext_vector_type(2)));
constexpr int P7_G2 = RING_BYTES + 512 + 8192, P7_B2 = P7_G2 + 8192;
static_assert(P7_B2 + 8192 <= LDS_BYTES, "PEER LDS map (LN2 tables)");
constexpr int P7_G1 = 115712, P7_LNSL = 123904, P7_B1 = RING_BYTES + 512;
static_assert(P7_LNSL + 1024 <= RING_BYTES && P7_B1 + 8192 <= LDS_BYTES, "PEER LDS map (LN1 tables)");
constexpr int P7_W8 = 98304, P7_SW = 114688;
constexpr int P7_ACT = 0, P7_EID = 65536, P7_SCR = 0  , P7_SCR_WAVE = 32 * 33 * 4, PCH = 128, NCH = D / PCH;
static_assert(P7_SCR + NWAVES * P7_SCR_WAVE <= P7_EID && P7_EID + 128 * 128 * 2 <= RING_BYTES, "PEER LDS map");

__device__ __forceinline__ void p7_peer(Frame& F) {
    const int lane = F.lane(), r32 = lane & 31, hi = lane >> 5, j8 = lane & 7, g8 = lane >> 3;
    constexpr int TPB = 128;
    LAS float* ACT = (LAS float*)(F.lds + P7_ACT); LAS unsigned short* EIDL = (LAS unsigned short*)(F.lds + P7_EID);
    LAS int* scr = (LAS int*)(F.lds + P7_SCR + F.wave_() * P7_SCR_WAVE);
    { const float* ln1_g = F.in(I_LN1G); const float* ln1_b = F.in(I_LN1B); const int tid = F.tid();
      *(LAS f32x4*)(F.lds + P7_G1 + tid * 16) = *(const f32x4*)(ln1_g + tid * 4); *(LAS f32x4*)(F.lds + P7_B1 + tid * 16) = *(const f32x4*)(ln1_b + tid * 4);
      *(LAS f32x4*)(F.lds + P7_G2 + tid * 16) = *(const f32x4*)(F.in(I_LN2G) + tid * 4); *(LAS f32x4*)(F.lds + P7_B2 + tid * 16) = *(const f32x4*)(F.in(I_LN2B) + tid * 4); }
    for (int blk = F.vcu_(); blk < M / TPB; blk += F.G_()) {
        const int m0 = blk * TPB;
        SEC_BEGIN(10);
        SEC_REP(10) { const int h = F.wave_(); const bf16* QP = F.ws<bf16>(WS_QP); const bf16* KEYS = F.ws<bf16>(WS_KEYS); float* GATE = F.ws<float>(WS_GATE);
          bf16x8 bqA[8], bqB[8];
          peer_load_q(bqA, QP + (size_t)(m0 + r32) * D + h * 256 + hi * 8);
          for (int tt = 0; tt < 4; ++tt) {
            const int tl = 32 * tt + r32, tok = m0 + tl;
            const bf16* qrow = QP + (size_t)tok * D + h * 256 + hi * 8;
            int s1[16], s2[16];
            peer_load_q(bqB, qrow + 128);
            peer_subkey_top16(bqA, KEYS + (size_t)(h * 2 + 0) * PNK * PHALF, r32, hi, s1);
            asm volatile("" ::: "memory");
            { const int tn = tt + 1 < 4 ? tt + 1 : tt; peer_load_q(bqA, QP + (size_t)(m0 + 32 * tn + r32) * D + h * 256 + hi * 8); }
            peer_subkey_top16(bqB, KEYS + (size_t)(h * 2 + 1) * PNK * PHALF, r32, hi, s2);
            float f1[16], f2[16];
#pragma unroll
            for (int i = 0; i < 16; ++i) { f1[i] = key2f(s1[i]); f2[i] = key2f(s2[i]); }
            if (hi == 0) {
#pragma unroll
                for (int i = 0; i < 16; ++i) { scr[r32 * 33 + i] = s1[i] & 127; scr[r32 * 33 + 16 + i] = s2[i] & 127; } }
            int cand[64];
            {
#define PC(n_, i_, j_) cand[n_] = (f2key(f1[i_] + f2[j_]) & ~255) | (n_)
                PC(0,0,0); PC(1,0,1); PC(2,0,2); PC(3,0,3); PC(4,0,4); PC(5,0,5); PC(6,0,6); PC(7,0,7); PC(8,0,8); PC(9,0,9); PC(10,0,10); PC(11,0,11); PC(12,0,12); PC(13,0,13); PC(14,0,14); PC(15,0,15);
                PC(16,1,0); PC(17,1,1); PC(18,1,2); PC(19,1,3); PC(20,1,4); PC(21,1,5); PC(22,1,6); PC(23,1,7);
                PC(24,2,0); PC(25,2,1); PC(26,2,2); PC(27,2,3); PC(28,2,4);
                PC(29,3,0); PC(30,3,1); PC(31,3,2); PC(32,3,3);
                PC(33,4,0); PC(34,4,1); PC(35,4,2);
                PC(36,5,0); PC(37,5,1); PC(38,6,0); PC(39,6,1); PC(40,7,0); PC(41,7,1);
                PC(42,8,0); PC(43,9,0); PC(44,10,0); PC(45,11,0); PC(46,12,0); PC(47,13,0); PC(48,14,0); PC(49,15,0);
#undef PC
            }
#pragma unroll
            for (int i = 50; i < 64; ++i) cand[i] = (int)0x80000000;
            int c0[16], c1[16]; const int hsel = -hi;
#pragma unroll
            for (int i = 0; i < 16; ++i) { c0[i] = (cand[i] & ~hsel) | (cand[32 + i] & hsel); c1[i] = (cand[16 + i] & ~hsel) | (cand[48 + i] & hsel); }
            sort16_desc(c0); sort16_desc(c1);
            int mh[16]; merge16(c0, c1, mh);
            int sc[16];
            { int lo_[16], hh_[16];
#pragma unroll
              for (int i = 0; i < 16; ++i) { auto rr = __builtin_amdgcn_permlane32_swap((unsigned)mh[i], (unsigned)mh[i], false, false); lo_[i] = (int)rr[0]; hh_[i] = (int)rr[1]; }
              merge16(lo_, hh_, sc); }
            float p[16]; const float mx = key2f(sc[0]); float z = 0.f;
#pragma unroll
            for (int k = 0; k < 16; ++k) { p[k] = __expf(key2f(sc[k]) - mx); z += p[k]; }
            const float rz = 1.f / z;
            LDS_WAIT();
            int eo[8]; float go[8]; const int him = -hi;
#pragma unroll
            for (int kk = 0; kk < 8; ++kk) { const int tag = PEER_PAIR[((sc[kk] & ~him) | (sc[8 + kk] & him)) & 255];
                const int i1 = scr[r32 * 33 + (tag >> 4)], i2 = scr[r32 * 33 + 16 + (tag & 15)];
                eo[kk] = i1 * PNK + i2; go[kk] = __int_as_float((__float_as_int(p[kk]) & ~him) | (__float_as_int(p[8 + kk]) & him)) * rz; }
            *(LAS v4u*)(EIDL + tl * 128 + h * 16 + 8 * hi) = (v4u){(unsigned)(eo[0] | (eo[1] << 16)), (unsigned)(eo[2] | (eo[3] << 16)), (unsigned)(eo[4] | (eo[5] << 16)), (unsigned)(eo[6] | (eo[7] << 16))};
            GAS float* gp = (GAS float*)(GATE + (size_t)tok * 128 + h * 16 + 8 * hi);
            *(GAS f32x4*)gp = (f32x4){go[0], go[1], go[2], go[3]}; *(GAS f32x4*)(gp + 4) = (f32x4){go[4], go[5], go[6], go[7]};
            LDS_WAIT();
          } }
        { const float* LNS = F.ws<float>(WS_LNS); const int tid = F.tid(); if (tid < 64) *(LAS f32x4*)(F.lds + P7_LNSL + tid * 16) = *(const f32x4*)(LNS + 2 * (size_t)m0 + 4 * tid); }
        SEC_END(10);
        __threadfence_block(); __syncthreads();
        const int tw = F.wave_() * (TPB / NWAVES);
        SEC_BEGIN(11);
        SEC_REP(11) {
        for (int i = lane; i < (TPB / NWAVES) * 128; i += 64) ACT[tw * 128 + i] = 0.f;
        { const unsigned char* XH = F.ws<unsigned char>(WS_XH); const unsigned char* XL = F.ws<unsigned char>(WS_XL); const unsigned char* U8 = F.ws<unsigned char>(WS_U8);
#define U_ISSUE(n_, PC, XQ0, XQ1) do { const int c_ = (n_) >> 4, tl_ = tw + ((n_) & 15); \
            XQ0 = *(const GAS v4u*)(XH + (size_t)(m0 + tl_) * (D / 2) + c_ * PCH + 16 * j8); XQ1 = *(const GAS v4u*)(XL + (size_t)(m0 + tl_) * (D / 2) + c_ * PCH + 16 * j8); \
            const LAS unsigned short* ep_ = EIDL + tl_ * 128 + g8; const unsigned char* ub_ = U8 + (size_t)c_ * (NEXP * PCH); const unsigned j16_ = 16u * (unsigned)j8;     \
            _Pragma("unroll") for (int i = 0; i < 16; ++i) { const unsigned e_ = ep_[8 * i]; PC[i] = *(const GAS v4u*)(ub_ + (e_ * PCH + j16_)); } } while (0)
#define U_COMPUTE(n_, PC, XQ0, XQ1) do { const int tl_ = tw + ((n_) & 15); \
            int pp_[16]; \
            _Pragma("unroll") for (int i = 0; i < 16; ++i) { unsigned ah_ = __builtin_amdgcn_udot8(PC[i].x, XQ0.x, 0u, false), al_ = __builtin_amdgcn_udot8(PC[i].x, XQ1.x, 0u, false); \
                ah_ = __builtin_amdgcn_udot8(PC[i].y, XQ0.y, ah_, false); al_ = __builtin_amdgcn_udot8(PC[i].y, XQ1.y, al_, false); ah_ = __builtin_amdgcn_udot8(PC[i].z, XQ0.z, ah_, false); al_ = __builtin_amdgcn_udot8(PC[i].z, XQ1.z, al_, false); \
                ah_ = __builtin_amdgcn_udot8(PC[i].w, XQ0.w, ah_, false); al_ = __builtin_amdgcn_udot8(PC[i].w, XQ1.w, al_, false); pp_[i] = (int)(16u * ah_ + al_); } \
              \
            int q8_[8], q4_[4], q2_[2]; \
            { const bool b2_ = lane & 4; _Pragma("unroll") for (int i = 0; i < 8; ++i) { const int k_ = b2_ ? pp_[2 * i + 1] : pp_[2 * i], s_ = b2_ ? pp_[2 * i] : pp_[2 * i + 1]; q8_[i] = k_ + dppi<0x141>(s_); } } \
            { const bool b1_ = lane & 2; _Pragma("unroll") for (int i = 0; i < 4; ++i) { const int k_ = b1_ ? q8_[2 * i + 1] : q8_[2 * i], s_ = b1_ ? q8_[2 * i] : q8_[2 * i + 1]; q4_[i] = k_ + dppi<0x4E>(s_); } } \
            { const bool b0_ = lane & 1; _Pragma("unroll") for (int i = 0; i < 2; ++i) { const int k_ = b0_ ? q4_[2 * i + 1] : q4_[2 * i], s_ = b0_ ? q4_[2 * i] : q4_[2 * i + 1]; q2_[i] = k_ + dppi<0xB1>(s_); } } \
            const int irow_ = ((lane & 1) << 2) | (lane & 2) | ((lane >> 2) & 1); \
            LAS float* ap_ = ACT + tl_ * 128 + 8 * irow_ + g8; ap_[0] += (float)q2_[0]; ap_[64] += (float)q2_[1]; } while (0)
          constexpr int UCH = 256, NSTEP = (D / UCH) * (TPB / NWAVES);
          v4u pcA[16], pcB[16], xqA0, xqA1, xqB0, xqB1;
          U_ISSUE(0, pcA, xqA0, xqA1);
          for (int n = 0; n < NSTEP; n += 2) {
              U_ISSUE(n + 1, pcB, xqB0, xqB1); __builtin_amdgcn_sched_barrier(0);
              U_COMPUTE(n, pcA, xqA0, xqA1); __builtin_amdgcn_sched_barrier(0);
              { const int nn = (n + 2 < NSTEP) ? n + 2 : n; U_ISSUE(nn, pcA, xqA0, xqA1); }
              __builtin_amdgcn_sched_barrier(0);
              U_COMPUTE(n + 1, pcB, xqB0, xqB1); __builtin_amdgcn_sched_barrier(0);
          }
#undef U_ISSUE
#undef U_COMPUTE
        }
        }
        SEC_END(11); SEC_BEGIN(12);
        LDS_WAIT();
        { const float* SU = F.ws<float>(WS_SU); const float* SV = F.ws<float>(WS_SV); const float* GATE = F.ws<float>(WS_GATE); const float* SX = F.ws<float>(WS_SX); const float* SXQ = F.ws<float>(WS_SXQ); const float* NSU = F.ws<float>(WS_NSU);
        LAS unsigned char* W8L = (LAS unsigned char*)(F.lds + P7_W8); LAS float* SWL = (LAS float*)(F.lds + P7_SW);
        for (int tb = 0; tb < TPB / NWAVES; tb += 8) {
            float nsu_[8][2], su_[8][2], sv_[8][2], gt_[8][2], ac_[8][2], sx_[8], xo_[8];
#pragma unroll
            for (int i = 0; i < 8; ++i) { const int tl = tw + tb + i, t = m0 + tl; sx_[i] = SX[t]; xo_[i] = 8.f * SXQ[t];
#pragma unroll
                for (int kq = 0; kq < 2; ++kq) { const int k = lane + 64 * kq; const unsigned e = EIDL[tl * 128 + k]; ac_[i][kq] = ACT[tl * 128 + k];
                    nsu_[i][kq] = NSU[e]; su_[i][kq] = SU[e]; sv_[i][kq] = SV[e]; gt_[i][kq] = __builtin_nontemporal_load(GATE + (size_t)t * 128 + k); } }
#pragma unroll
            for (int i = 0; i < 8; ++i) { const int tl = tw + tb + i; float wv[2];
#pragma unroll
                for (int kq = 0; kq < 2; ++kq) { const float a = (ac_[i][kq] - 128.f * nsu_[i][kq] - xo_[i]) * su_[i][kq] * sx_[i];
                    wv[kq] = gt_[i][kq] * gelu_erf(a) * sv_[i][kq]; }
                const float am = wave_max(fmaxf(fabsf(wv[0]), fabsf(wv[1])));
                const float sc = am > 0.f ? am * (1.f / 127.f) : 1.f, inv = 1.f / sc;
                float wsum = 0.f;
#pragma unroll
                for (int kq = 0; kq < 2; ++kq) { const int k = lane + 64 * kq; const float q = rintf(wv[kq] * inv); wsum += q; W8L[tl * 128 + k] = (unsigned char)((int)q & 255); }
                wsum = wave_sum(wsum);
                if (lane == 0) { SWL[tl] = sc; SWL[128 + tl] = 8.f * wsum; } }
        } }
        LDS_WAIT();
        SEC_END(12); SEC_BEGIN(13);
        SEC_REP(13) {
        { const bf16* X1 = F.ws<bf16>(WS_Y1); const unsigned char* V8 = F.ws<unsigned char>(WS_V8); bf16* Y2 = F.ws<bf16>(WS_QP);
#define V_ISSUE(n_, PC, WQ) do { const int c_ = (n_) >> 4, tl_ = tw + (((n_) >> 3) & 1) * 8 + g8, s_ = (n_) & 7; \
            const LAS unsigned short* ep_ = EIDL + tl_ * 128 + 16 * s_; const unsigned char* vb_ = V8 + (size_t)c_ * (NEXP * PCH); const unsigned j16_ = 16u * (unsigned)j8;     \
            _Pragma("unroll") for (int i = 0; i < 16; ++i) { const unsigned e_ = ep_[i]; PC[i] = *(const GAS v4u*)(vb_ + (e_ * PCH + j16_)); } \
            WQ = *(const LAS v4u*)(F.lds + P7_W8 + tl_ * 128 + 16 * s_); } while (0)
#define V_TR4(A_, B_, C_, D_, WQ_, O_) do { const unsigned t0_ = __builtin_amdgcn_perm(B_, A_, 0x05010400u), t1_ = __builtin_amdgcn_perm(B_, A_, 0x07030602u), t2_ = __builtin_amdgcn_perm(D_, C_, 0x05010400u), t3_ = __builtin_amdgcn_perm(D_, C_, 0x07030602u); \
            const unsigned u0_ = __builtin_amdgcn_perm(t2_, t0_, 0x05040100u), u1_ = __builtin_amdgcn_perm(t2_, t0_, 0x07060302u), u2_ = __builtin_amdgcn_perm(t3_, t1_, 0x05040100u), u3_ = __builtin_amdgcn_perm(t3_, t1_, 0x07060302u); \
              \
            ac_[(O_) + 0] = __builtin_amdgcn_sdot4((int)(u0_ & 0x0f0f0f0fu), (int)(WQ_), ac_[(O_) + 0], false); ac_[(O_) + 4] = __builtin_amdgcn_sdot4((int)u0_, (int)(WQ_), ac_[(O_) + 4], false); \
            ac_[(O_) + 1] = __builtin_amdgcn_sdot4((int)(u1_ & 0x0f0f0f0fu), (int)(WQ_), ac_[(O_) + 1], false); ac_[(O_) + 5] = __builtin_amdgcn_sdot4((int)u1_, (int)(WQ_), ac_[(O_) + 5], false); \
            ac_[(O_) + 2] = __builtin_amdgcn_sdot4((int)(u2_ & 0x0f0f0f0fu), (int)(WQ_), ac_[(O_) + 2], false); ac_[(O_) + 6] = __builtin_amdgcn_sdot4((int)u2_, (int)(WQ_), ac_[(O_) + 6], false); \
            ac_[(O_) + 3] = __builtin_amdgcn_sdot4((int)(u3_ & 0x0f0f0f0fu), (int)(WQ_), ac_[(O_) + 3], false); ac_[(O_) + 7] = __builtin_amdgcn_sdot4((int)u3_, (int)(WQ_), ac_[(O_) + 7], false); } while (0)
#define V_ACC(PC, WQ) do { const unsigned wq_[4] = {WQ.x, WQ.y, WQ.z, WQ.w}; \
            _Pragma("unroll") for (int gq = 0; gq < 4; ++gq) { \
                const unsigned pa_[4] = {PC[4 * gq].x, PC[4 * gq].y, PC[4 * gq].z, PC[4 * gq].w}, pb_[4] = {PC[4 * gq + 1].x, PC[4 * gq + 1].y, PC[4 * gq + 1].z, PC[4 * gq + 1].w}; \
                const unsigned pc_[4] = {PC[4 * gq + 2].x, PC[4 * gq + 2].y, PC[4 * gq + 2].z, PC[4 * gq + 2].w}, pd_[4] = {PC[4 * gq + 3].x, PC[4 * gq + 3].y, PC[4 * gq + 3].z, PC[4 * gq + 3].w}; \
                _Pragma("unroll") for (int m = 0; m < 4; ++m) { \
                    V_TR4(pa_[m], pb_[m], pc_[m], pd_[m], wq_[gq], 8 * m); } } } while (0)
#define V_FIN(n_, XP) do { const int c_ = (n_) >> 4, tl_ = tw + (((n_) >> 3) & 1) * 8 + g8; \
            const LAS float* swp_ = (const LAS float*)(F.lds + P7_SW); const float sw_ = swp_[tl_], wo_ = swp_[128 + tl_]; \
            const f32x2 ms_ = *(const LAS f32x2*)(F.lds + P7_LNSL + tl_ * 8); const int dim0_ = c_ * VCH + 32 * j8; \
            _Pragma("unroll") for (int m = 0; m < 4; ++m) { \
                const f32x4 g0_ = *(const LAS f32x4*)(F.lds + P7_G1 + (dim0_ + 8 * m) * 4), g1_ = *(const LAS f32x4*)(F.lds + P7_G1 + (dim0_ + 8 * m + 4) * 4), b0_ = *(const LAS f32x4*)(F.lds + P7_B1 + (dim0_ + 8 * m) * 4), b1_ = *(const LAS f32x4*)(F.lds + P7_B1 + (dim0_ + 8 * m + 4) * 4); \
                const unsigned xw_[4] = {XP[m].x, XP[m].y, XP[m].z, XP[m].w}; float o_[8]; \
                _Pragma("unroll") for (int i = 0; i < 4; ++i) { const float yl_ = (i & 1) ? bfhi(xw_[i >> 1]) : bflo(xw_[i >> 1]), yh_ = (i & 1) ? bfhi(xw_[2 + (i >> 1)]) : bflo(xw_[2 + (i >> 1)]); \
                    o_[i] = ((float)ac_[8 * m + i] - wo_) * sw_ + DN_ALPHA * ((yl_ - ms_.x) * ms_.y * g0_[i] + b0_[i]); \
                    o_[4 + i] = (float)((ac_[8 * m + 4 + i] - ac_[8 * m + i]) >> 4) * sw_ + DN_ALPHA * ((yh_ - ms_.x) * ms_.y * g1_[i] + b1_[i]); } \
                *(GAS v4u*)(Y2 + (size_t)(m0 + tl_) * D + dim0_ + 8 * m) = (v4u){pk2(o_[0], o_[1]), pk2(o_[2], o_[3]), pk2(o_[4], o_[5]), pk2(o_[6], o_[7])}; } \
            _Pragma("unroll") for (int d = 0; d < 32; ++d) ac_[d] = 0; } while (0)
          constexpr int VCH = 256, NSTEP = (D / VCH) * (TPB / NWAVES);
          v4u pcA[16], pcB[16], wqA, wqB, xp[4]; int ac_[32];
#pragma unroll
          for (int d = 0; d < 32; ++d) ac_[d] = 0;
          V_ISSUE(0, pcA, wqA);
          for (int n = 0; n < NSTEP; n += 2) {
              const bool fin = (n & 7) == 6;
              if (fin) { const int c_ = (n + 1) >> 4, tl_ = tw + (((n + 1) >> 3) & 1) * 8 + g8; const GAS v4u* xq_ = (const GAS v4u*)(X1 + (size_t)(m0 + tl_) * D + c_ * VCH + 32 * j8);
#pragma unroll
                  for (int m = 0; m < 4; ++m) xp[m] = xq_[m]; }
              V_ISSUE(n + 1, pcB, wqB); __builtin_amdgcn_sched_barrier(0);
              V_ACC(pcA, wqA); __builtin_amdgcn_sched_barrier(0);
              { const int nn = (n + 2 < NSTEP) ? n + 2 : n; V_ISSUE(nn, pcA, wqA); }
              __builtin_amdgcn_sched_barrier(0);
              V_ACC(pcB, wqB);
              if (fin) V_FIN(n + 1, xp);
              __builtin_amdgcn_sched_barrier(0);
          }
#undef V_TR4
#undef V_ISSUE
#undef V_ACC
#undef V_FIN
        }
        }
        SEC_END(13); SEC_BEGIN(14);
        SEC_REP(14) {
        { float* outp = F.outp(); const bf16* Y2 = F.ws<bf16>(WS_QP);
        v4u nx[4];
        { const GAS v4u* yp = (const GAS v4u*)(Y2 + (size_t)(m0 + tw) * D) + lane;
#pragma unroll
          for (int j = 0; j < 4; ++j) nx[j] = yp[64 * j]; }
        for (int ti = 0; ti < TPB / NWAVES; ++ti) {
            const int t = m0 + tw + ti;
            float v[32]; float s = 0.f;
#pragma unroll
            for (int j = 0; j < 4; ++j) { const unsigned ww[4] = {nx[j].x, nx[j].y, nx[j].z, nx[j].w};
#pragma unroll
                for (int i = 0; i < 4; ++i) { v[8 * j + 2 * i] = bflo(ww[i]); v[8 * j + 2 * i + 1] = bfhi(ww[i]); s += v[8 * j + 2 * i] + v[8 * j + 2 * i + 1]; } }
            { const int tn = (ti + 1 < TPB / NWAVES) ? t + 1 : t; const GAS v4u* yp = (const GAS v4u*)(Y2 + (size_t)tn * D) + lane;
#pragma unroll
              for (int j = 0; j < 4; ++j) nx[j] = yp[64 * j]; }
            const float mean = wave_sum(s) * (1.f / D); float qv = 0.f;
#pragma unroll
            for (int i = 0; i < 32; ++i) { v[i] -= mean; qv += v[i] * v[i]; }
            const float rstd = 1.f / sqrtf(wave_sum(qv) * (1.f / D) + LN_EPS);
#pragma unroll
            for (int j = 0; j < 4; ++j) { const int c0 = 8 * lane + 512 * j; const f32x4 g0 = *(const LAS f32x4*)(F.lds + P7_G2 + c0 * 4), g1 = *(const LAS f32x4*)(F.lds + P7_G2 + c0 * 4 + 16), b0 = *(const LAS f32x4*)(F.lds + P7_B2 + c0 * 4), b1 = *(const LAS f32x4*)(F.lds + P7_B2 + c0 * 4 + 16);
                f32x4 r0, r1;
#pragma unroll
                for (int i = 0; i < 4; ++i) { r0[i] = v[8 * j + i] * rstd * g0[i] + b0[i]; r1[i] = v[8 * j + 4 + i] * rstd * g1[i] + b1[i]; }
                GAS f32x4* op = (GAS f32x4*)(outp + (size_t)t * D + c0); op[0] = r0; op[1] = r1; }
        } }
        }
        SEC_END(14);
        __syncthreads();
    }
}

struct Args { const float* in[22]; float* out; unsigned char* ws; int ph_lo, ph_hi; };
__global__ void __launch_bounds__(NWAVES * 64, 2) mk_fwd(Args args) {
    extern __shared__ __attribute__((aligned(16))) unsigned char lds[];
    cg::grid_group grid = cg::this_grid();
    Frame F;
    F.lds = (LAS unsigned char*)lds;
    if (threadIdx.x == 0) { LAS unsigned long long* PT = (LAS unsigned long long*)(F.lds + RING_BYTES);
#pragma unroll
        for (int k = 0; k < 22; ++k) PT[k] = (unsigned long long)args.in[k];
        PT[22] = (unsigned long long)args.out; PT[23] = (unsigned long long)args.ws;
        ((LAS unsigned*)(F.lds + RING_BYTES + 256))[0] = 0u; ((LAS unsigned*)(F.lds + RING_BYTES + 256))[1] = 0u; }
    __syncthreads();
    const int lo = args.ph_lo, hi = args.ph_hi;
#ifndef PHASE_MASK
#define PHASE_MASK 255
#endif
#define IN(k) (((PHASE_MASK >> (k)) & 1) && lo <= (k) && (k) < hi)
#ifndef REPEAT_PHASE
#define REPEAT_PHASE -1
#endif
#define REP(k) for (int rep_ = 0; rep_ < ((REPEAT_PHASE == (k)) ? 2 : 1); ++rep_)
    (void)xcd_barrier_post((unsigned*)args.ws, (volatile LAS unsigned*)(F.lds + RING_BYTES + 256));
#define XBAR() do { XcdBarrier bar_; bar_.bar = F.ws<unsigned>(0); bar_.x = xb_xcc_id(); bar_.st = (volatile LAS unsigned*)(F.lds + RING_BYTES + 256); xcd_barrier(bar_); } while (0)
#define SEAM(k) do { if (IN(k) && IN((k) + 1)) XBAR(); } while (0)

    if (lo < 0) grid.sync();
    if (IN(0)) REP(0) { SEC_BEGIN(0); p0a_prologue(F); XBAR(); p0b_prologue(F); SEC_END(0); } SEAM(0);
    if (IN(1)) REP(1) { SEC_BEGIN(1);
        pg8::Gemm g{F.ws<bf16>(WS_XB), F.ws<bf16>(WS_WIN), M, NPROJ, D / 2}; pg8::StaticOrder S; S.init(M, NPROJ, F.G_(), (int)blockIdx.x);
        pg8::EpiProjI8 E{F.ws<bf16>(WS_Q), (size_t)(WS_K - WS_Q) / 2, dattn::C2, F.ws<bf16>(WS_H), F.in(I_BGLU), F.ws<float>(WS_SXA), F.ws<float>(WS_SWIN)};
        pg8::gemm_phase<pg8::EpiProjI8, pg8::StaticOrder, PG8_ALIGN, PG8_SP2>(F.lds, g, S, E);
    SEC_END(1); } SEAM(1);
    if (IN(2)) REP(2) { SEC_BEGIN(2);
        static_assert(dattn::LDS_BYTES <= RING_BYTES, "attention body geometry vs frame");
        const dattn::Tensors AT{F.ws<const dattn::bf16>(WS_Q), F.ws<const dattn::bf16>(WS_K), F.ws<const dattn::bf16>(WS_V), F.ws<dattn::bf16>(WS_O1), F.ws<dattn::bf16>(WS_O2), F.ws<const float>(WS_TAB)};
        dattn::phase((char*)lds, AT, F.vcu_());
    SEC_END(2); } SEAM(2);
    if (IN(3)) REP(3) { SEC_BEGIN(3); p3_mix(F); SEC_END(3); } SEAM(3);
    if (IN(4)) REP(4) { SEC_BEGIN(4);
        pg8::Gemm g{F.ws<bf16>(WS_XB), F.ws<bf16>(WS_WOUT), M, D, D / 2}; pg8::StaticOrder S; S.init(M, D, F.G_(), (int)blockIdx.x);
        pg8::EpiResI8 E{F.in(I_X), F.ws<bf16>(WS_Y1), D, DN_ALPHA, F.ws<float>(WS_SM), F.ws<float>(WS_SWOUT)};
        pg8::gemm_phase<pg8::EpiResI8, pg8::StaticOrder, PG8_ALIGN, PG8_SP2>(F.lds, g, S, E);
    SEC_END(4); } SEAM(4);
    if (IN(5)) REP(5) { SEC_BEGIN(5); p5_ln1(F); SEC_END(5); } SEAM(5);
    if (IN(6)) REP(6) { SEC_BEGIN(6);
        pg8::Gemm g{F.ws<bf16>(WS_X8), F.ws<bf16>(WS_WQ), M, D, D / 2}; pg8::StaticOrder S; S.init(M, D, F.G_(), (int)blockIdx.x);
        pg8::EpiPlainI8 E{F.ws<bf16>(WS_QP), D, F.ws<float>(WS_SX), F.ws<float>(WS_SWQ)};
        pg8::gemm_phase<pg8::EpiPlainI8, pg8::StaticOrder, PG8_ALIGN, PG8_SP2>(F.lds, g, S, E);
    SEC_END(6); } SEAM(6);
    if (IN(7)) REP(7) { SEC_BEGIN(7); p7_peer(F); SEC_END(7); }
#ifdef PROBE_XBARS
    for (int xb_i = 0; xb_i < PROBE_XBARS; ++xb_i) XBAR();
#endif
#undef IN
#undef SEAM
}

extern "C" void kernel_launch(void* const* d_in, const int* in_sizes, int n_in, void* d_out, int out_size, void* d_ws, size_t ws_size, hipStream_t stream) {
    static int grid = 0;
    if (grid == 0) {
        if (n_in != 22 || in_sizes[0] != M * D || out_size != M * D || ws_size < WS_END) { fprintf(stderr, "kernel_launch: unexpected shapes (n_in %d, in0 %d, out %d, ws %zu); nothing launched\n", n_in, n_in > 0 ? in_sizes[0] : -1, out_size, ws_size); grid = -1; return; }
        int dev = 0, cus = 0, per_cu = 0;
        if (hipGetDevice(&dev) != hipSuccess || hipDeviceGetAttribute(&cus, hipDeviceAttributeMultiprocessorCount, dev) != hipSuccess) { grid = -1; return; }
        if (hipFuncSetAttribute((const void*)mk_fwd, hipFuncAttributeMaxDynamicSharedMemorySize, LDS_BYTES) != hipSuccess) { fprintf(stderr, "kernel_launch: hipFuncSetAttribute failed\n"); grid = -1; return; }
        if (hipOccupancyMaxActiveBlocksPerMultiprocessor(&per_cu, (const void*)mk_fwd, NWAVES * 64, LDS_BYTES) != hipSuccess || per_cu < 1) { fprintf(stderr, "kernel_launch: occupancy query reports %d workgroups per CU\n", per_cu); (void)hipGetLastError(); grid = -1; return; }
        grid = cus;
        if (grid > 256) grid = 256;
    }
    if (grid < 0) return;
    if (hipMemsetAsync(d_ws, 0, 65536, stream) != hipSuccess) { fprintf(stderr, "kernel_launch: hipMemsetAsync failed\n"); return; }
    Args a{};
    for (int i = 0; i < 22; ++i) a.in[i] = (const float*)d_in[i];
    a.out = (float*)d_out; a.ws = (unsigned char*)d_ws;
    constexpr int NL = MK_N_LAUNCHES;
    for (int li = 0; li < NL; ++li) {
        a.ph_lo = (NL == 1) ? 0 : li; a.ph_hi = (NL == 1) ? N_PHASES : li + 1;
        void* kargs[] = {&a};
        const hipError_t le = hipLaunchCooperativeKernel((const void*)mk_fwd, dim3(grid), dim3(NWAVES * 64), kargs, LDS_BYTES, stream);
        if (le != hipSuccess) { fprintf(stderr, "kernel_launch: cooperative launch %d failed: %s (grid %d)\n", li, hipGetErrorString(le), grid); break; }
    }
}
```

```cpp
#include <hip/hip_runtime.h>
#include <hip/hip_cooperative_groups.h>
#include <cstdio>
#include <cstdint>
namespace cg = cooperative_groups;
namespace pg8 {
#define PG8_LAS __attribute__((address_space(3)))
typedef unsigned short bf16_t;
typedef short bf16x8 __attribute__((ext_vector_type(8)));
typedef float f32x4 __attribute__((ext_vector_type(4)));
typedef unsigned u32x4 __attribute__((ext_vector_type(4)));
typedef int i32x4 __attribute__((ext_vector_type(4)));
constexpr int BM = 256, BK = 64, HALF = 128, HTB = HALF * BK * 2  , STAGE_BYTES = 8 * HTB, NXCD = 8, WGM = 8;

__host__ __device__ __forceinline__ int lds_byte(int r, int c) { const int st = (r >> 4) * 2 + (c >> 5), rr = r & 15, cc = c & 31, ob = rr * 64 + cc * 2; return st * 1024 + (ob ^ (((ob >> 9) & 1) << 5)); }
__host__ __device__ __forceinline__ void stage_rc(int b, int& R, int& C) { const int st = b / 1024, sb = b % 1024, swz = sb ^ (((sb >> 9) & 1) << 5); R = (st >> 1) * 16 + swz / 64; C = (st & 1) * 32 + (swz % 64) / 2; }
__host__ __device__ __forceinline__ int perm32(int rho) { const int n = rho >> 4, i = rho & 15; return 8 * (i >> 2) + 4 * n + (i & 3); }

struct Unit { int pm, pn; };
struct Gemm { const bf16_t* A; const bf16_t* Bt; int M, N, K; };

struct StaticOrder {
    int nM, nN, nwg, G, c;
    __host__ __device__ void init(int M, int N, int G_, int c_) { nM = M / BM; nN = N / BM; nwg = nM * nN; G = G_; c = c_; }
    __host__ __device__ bool next(int i, Unit& u) const {
        const long L = (long)i * G + c; if (L >= nwg) return false;
        int wgid = (int)L; { const int q = nwg / NXCD, r = nwg % NXCD, xcd = wgid % NXCD, off = wgid / NXCD; wgid = (xcd < r ? xcd * (q + 1) : r * (q + 1) + (xcd - r) * q) + off; }
        const int nig = WGM * nN, gid = wgid / nig, fm = gid * WGM, gsz = (nM - fm) < WGM ? (nM - fm) : WGM;
        u.pm = fm + ((wgid % nig) % gsz); u.pn = (wgid % nig) / gsz; return true;
    }
    __device__ __forceinline__ void a_ready(const Unit&) const {}
    __device__ __forceinline__ void done(const Unit&) const {}
};

__device__ __forceinline__ unsigned cvt_pk_bf16(float lo, float hi) { unsigned r; asm volatile("v_cvt_pk_bf16_f32 %0, %1, %2" : "=v"(r) : "v"(lo), "v"(hi)); return r; }
typedef float f32x2 __attribute__((ext_vector_type(2)));
typedef float f32x2 __attribute__((ext_vector_type(2)));
__device__ __forceinline__ u32x4 pack8(f32x4 v0, f32x4 v1) { u32x4 w; w.x = cvt_pk_bf16(v0[0], v0[1]); w.y = cvt_pk_bf16(v0[2], v0[3]); w.z = cvt_pk_bf16(v1[0], v1[1]); w.w = cvt_pk_bf16(v1[2], v1[3]); return w; }
typedef _Float16 h16x2 __attribute__((ext_vector_type(2)));
__device__ __forceinline__ unsigned pkh2(float a, float b) { const h16x2 v = {(_Float16)__builtin_amdgcn_fmed3f(a, -65504.f, 65504.f), (_Float16)__builtin_amdgcn_fmed3f(b, -65504.f, 65504.f)}; return __builtin_bit_cast(unsigned, v); }
__device__ __forceinline__ u32x4 pack8h(f32x4 v0, f32x4 v1) { u32x4 w; w.x = pkh2(v0[0], v0[1]); w.y = pkh2(v0[2], v0[3]); w.z = pkh2(v1[0], v1[1]); w.w = pkh2(v1[2], v1[3]); return w; }
__device__ __forceinline__ f32x4 i2f(f32x4 a) { const i32x4 v = __builtin_bit_cast(i32x4, a); return (f32x4){(float)v[0], (float)v[1], (float)v[2], (float)v[3]}; }
__device__ __forceinline__ unsigned ror8(unsigned v) { return (unsigned)__builtin_amdgcn_update_dpp(0, (int)v, 0x128, 0xf, 0xf, true); }
__device__ __forceinline__ void xchg_store2(bf16_t* p  , size_t ld, u32x4 p0  , u32x4 p1  , bool hi8) {
    const u32x4 snd = hi8 ? p0 : p1; u32x4 rcv; rcv.x = ror8(snd.x); rcv.y = ror8(snd.y); rcv.z = ror8(snd.z); rcv.w = ror8(snd.w);
    *(u32x4*)p = hi8 ? rcv : p0; *(u32x4*)(p + 8 * ld) = hi8 ? p1 : rcv;
}
struct EpiProjI8 {
    static constexpr bool PERM = true, AFTER_DRAIN = false, INT8 = true;
    bf16_t* QKV; size_t split_stride; float scale0; bf16_t* H; const float* bglu; const float* sa; const float* sb;
    __device__ __forceinline__ void operator()(const f32x4 (&acc)[2][2][4][2], const Unit& u, int wr, int wc, int fr, int fq) const {
        const int row0 = u.pm * BM + wr * 64 + fr, cb = u.pn * BM + wc * 64 + 8 * fq; const bool hi8 = fr & 8;
        f32x4 cs[2][2];
#pragma unroll
        for (int bj = 0; bj < 2; ++bj) { cs[bj][0] = *(const f32x4*)(sb + cb + bj * 32); cs[bj][1] = *(const f32x4*)(sb + cb + bj * 32 + 4); }
        float rsv[2][4];
#pragma unroll
        for (int ai = 0; ai < 2; ++ai)
#pragma unroll
            for (int m = 0; m < 4; ++m) rsv[ai][m] = sa[row0 + ai * HALF + m * 16];
        if (u.pn < 12) {
            const int t = u.pn >> 2; bf16_t* base = QKV + (size_t)t * split_stride; const float sc = (t == 0) ? scale0 : 1.f;
            bf16_t* lp = base + (size_t)(u.pm * BM + wr * 64 + (fr & 7)) * 1024 + (u.pn & 3) * BM + wc * 64 + 8 * fq + (hi8 ? 32 : 0);
#pragma unroll
            for (int ai = 0; ai < 2; ++ai)
#pragma unroll
                for (int m = 0; m < 4; ++m) { const float rs = rsv[ai][m] * sc;
                    xchg_store2(lp + (size_t)(ai * HALF + m * 16) * 1024, 1024, pack8(i2f(acc[ai][0][m][0]) * cs[0][0] * rs, i2f(acc[ai][0][m][1]) * cs[0][1] * rs), pack8(i2f(acc[ai][1][m][0]) * cs[1][0] * rs, i2f(acc[ai][1][m][1]) * cs[1][1] * rs), hi8); }
        } else {
            const int ch0 = (u.pn - 12) * HALF + wc * 32 + 8 * fq;
            const f32x4 ba0 = *(const f32x4*)(bglu + ch0), ba1 = *(const f32x4*)(bglu + ch0 + 4), bg0 = *(const f32x4*)(bglu + 1024 + ch0), bg1 = *(const f32x4*)(bglu + 1024 + ch0 + 4);
#pragma unroll
            for (int ai = 0; ai < 2; ++ai)
#pragma unroll
                for (int m = 0; m < 4; ++m) { const int row = row0 + ai * HALF + m * 16; const float rs = rsv[ai][m];
                    const f32x4 a0 = i2f(acc[ai][0][m][0]) * cs[0][0] * rs + ba0, a1 = i2f(acc[ai][0][m][1]) * cs[0][1] * rs + ba1, g0 = i2f(acc[ai][1][m][0]) * cs[1][0] * rs + bg0, g1 = i2f(acc[ai][1][m][1]) * cs[1][1] * rs + bg1;
                    f32x4 h0, h1;
#pragma unroll
                    for (int e = 0; e < 4; ++e) { h0[e] = a0[e] * __builtin_amdgcn_rcpf(1.f + __builtin_amdgcn_exp2f(-1.4426950409f * g0[e])); h1[e] = a1[e] * __builtin_amdgcn_rcpf(1.f + __builtin_amdgcn_exp2f(-1.4426950409f * g1[e])); }
                    *(u32x4*)(H + (size_t)row * 1024 + ch0) = pack8h(h0, h1); }
        }
    }
};
struct EpiPlainI8 {
    static constexpr bool PERM = true, AFTER_DRAIN = false, INT8 = true;
    bf16_t* O; int ldc; const float* sa; const float* sb;
    __device__ __forceinline__ void operator()(const f32x4 (&acc)[2][2][4][2], const Unit& u, int wr, int wc, int fr, int fq) const {
        const int row0 = u.pm * BM + wr * 64 + fr, col0 = u.pn * BM + wc * 64 + 8 * fq; const bool hi8 = fr & 8;
        f32x4 cs[2][2];
#pragma unroll
        for (int bj = 0; bj < 2; ++bj) { cs[bj][0] = *(const f32x4*)(sb + col0 + bj * 32); cs[bj][1] = *(const f32x4*)(sb + col0 + bj * 32 + 4); }
        float rsv[2][4];
#pragma unroll
        for (int ai = 0; ai < 2; ++ai)
#pragma unroll
            for (int m = 0; m < 4; ++m) rsv[ai][m] = sa[row0 + ai * HALF + m * 16];
        bf16_t* lp = O + (size_t)(u.pm * BM + wr * 64 + (fr & 7)) * ldc + col0 + (hi8 ? 32 : 0);
#pragma unroll
        for (int ai = 0; ai < 2; ++ai)
#pragma unroll
            for (int m = 0; m < 4; ++m) { const float rs = rsv[ai][m];
                xchg_store2(lp + (size_t)(ai * HALF + m * 16) * ldc, (size_t)ldc, pack8(i2f(acc[ai][0][m][0]) * cs[0][0] * rs, i2f(acc[ai][0][m][1]) * cs[0][1] * rs), pack8(i2f(acc[ai][1][m][0]) * cs[1][0] * rs, i2f(acc[ai][1][m][1]) * cs[1][1] * rs), hi8); }
    }
};
struct EpiResI8 {
    static constexpr bool PERM = true, AFTER_DRAIN = false, INT8 = true;
    const float* X; bf16_t* Y; int ldc; float alpha; const float* sa; const float* sb;
    __device__ __forceinline__ void operator()(const f32x4 (&acc)[2][2][4][2], const Unit& u, int wr, int wc, int fr, int fq) const {
        const int row0 = u.pm * BM + wr * 64 + fr, col0 = u.pn * BM + wc * 64 + 8 * fq; const bool hi8 = fr & 8;
        f32x4 cs[2][2];
#pragma unroll
        for (int bj = 0; bj < 2; ++bj) { cs[bj][0] = *(const f32x4*)(sb + col0 + bj * 32); cs[bj][1] = *(const f32x4*)(sb + col0 + bj * 32 + 4); }
        float rsv[2][4];
#pragma unroll
        for (int ai = 0; ai < 2; ++ai)
#pragma unroll
            for (int m = 0; m < 4; ++m) rsv[ai][m] = sa[row0 + ai * HALF + m * 16];
        bf16_t* lp = Y + (size_t)(u.pm * BM + wr * 64 + (fr & 7)) * ldc + col0 + (hi8 ? 32 : 0);
#pragma unroll
        for (int ai = 0; ai < 2; ++ai) {
            f32x4 xv[4][2][2];
#pragma unroll
            for (int m = 0; m < 4; ++m) { const size_t off = (size_t)(row0 + ai * HALF + m * 16) * ldc + col0;
#pragma unroll
                for (int bj = 0; bj < 2; ++bj) { xv[m][bj][0] = *(const f32x4*)(X + off + bj * 32); xv[m][bj][1] = *(const f32x4*)(X + off + bj * 32 + 4); } }
#pragma unroll
            for (int m = 0; m < 4; ++m) { const float rs = rsv[ai][m];
                xchg_store2(lp + (size_t)(ai * HALF + m * 16) * ldc, (size_t)ldc,
                            pack8(i2f(acc[ai][0][m][0]) * cs[0][0] * rs + xv[m][0][0] * alpha, i2f(acc[ai][0][m][1]) * cs[0][1] * rs + xv[m][0][1] * alpha),
                            pack8(i2f(acc[ai][1][m][0]) * cs[1][0] * rs + xv[m][1][0] * alpha, i2f(acc[ai][1][m][1]) * cs[1][1] * rs + xv[m][1][1] * alpha), hi8); }
            asm volatile("" ::: "memory"); }
    }
};
template <class Epi, class Sched, bool ALIGN_EPI = false, bool SP2 = false>
__device__ __forceinline__ void gemm_phase(PG8_LAS unsigned char* lds, const Gemm g, const Sched& S, const Epi& E) {
    const int tid = threadIdx.x, wid = __builtin_amdgcn_readfirstlane(tid >> 6), lane = tid & 63, wr = wid >> 2, wc = wid & 3, fr = lane & 15, fq = lane >> 4;
    const int K = g.K, nt = K / BK;
    unsigned voffA[2], voffB[2];
#pragma unroll
    for (int i = 0; i < 2; ++i) { int R, C; stage_rc(tid * 16 + i * 8192, R, C); const int Rb = Epi::PERM ? (64 * (R >> 5) + perm32(R & 31)) : R;
        voffA[i] = (unsigned)(R * K + C) * 2u; voffB[i] = (unsigned)(Rb * K + C) * 2u; }
    const size_t kstep = (size_t)(BK * 2);
    const size_t hstep = (size_t)HALF * K * 2;
    const size_t tstep = 2 * hstep;
    const size_t hstepB = Epi::PERM ? (size_t)32 * K * 2 : hstep;
    const unsigned ldsw = (unsigned)wid * 1024u;
    const int aoff = lds_byte(wr * 64 + fr, fq * 8), boff = lds_byte(wc * 32 + fr, fq * 8);
#define PG8_SA(b, h) (((b) * 2 + (h)) * HTB)
#define PG8_SB(b, h) ((4 + (b) * 2 + (h)) * HTB)
#define PG8_STAGE(bufoff, gbase, voff) do { _Pragma("unroll") for (int _i = 0; _i < 2; ++_i) \
        __builtin_amdgcn_global_load_lds((const unsigned*)((const char*)(gbase) + (voff)[_i]), (PG8_LAS unsigned*)(lds + (bufoff) + ldsw + _i * 8192), 16, 0, 0); } while (0)
#define PG8_LDA(dst, b, h) do { _Pragma("unroll") for (int m = 0; m < 4; ++m) _Pragma("unroll") for (int k = 0; k < 2; ++k) dst[m][k] = *(const PG8_LAS bf16x8*)(lds + PG8_SA(b, h) + aoff + m * 2048 + k * 1024); } while (0)
#define PG8_LDB(dst, b, h) do { _Pragma("unroll") for (int n = 0; n < 2; ++n) _Pragma("unroll") for (int k = 0; k < 2; ++k) dst[n][k] = *(const PG8_LAS bf16x8*)(lds + PG8_SB(b, h) + boff + n * 2048 + k * 1024); } while (0)
#define PG8_MMA(ai, bj, At, Bt) do { __builtin_amdgcn_s_setprio(1); _Pragma("unroll") for (int m = 0; m < 4; ++m) _Pragma("unroll") for (int n = 0; n < 2; ++n) _Pragma("unroll") for (int k = 0; k < 2; ++k) { \
        if constexpr (Epi::INT8) acc[ai][bj][m][n] = __builtin_bit_cast(f32x4, __builtin_amdgcn_mfma_i32_16x16x64_i8(__builtin_bit_cast(i32x4, Bt[n][k]), __builtin_bit_cast(i32x4, At[m][k]), __builtin_bit_cast(i32x4, acc[ai][bj][m][n]), 0, 0, 0)); \
        else acc[ai][bj][m][n] = __builtin_amdgcn_mfma_f32_16x16x32_bf16(Bt[n][k], At[m][k], acc[ai][bj][m][n], 0, 0, 0); } __builtin_amdgcn_s_setprio(0); } while (0)
#define PG8_WAIT_V(n) asm volatile("s_waitcnt vmcnt(" #n ")" ::: "memory")
#define PG8_WAIT_L(n) asm volatile("s_waitcnt lgkmcnt(" #n ")" ::: "memory")
#define PG8_BAR __builtin_amdgcn_s_barrier()
#define PG8_SCHED __builtin_amdgcn_sched_barrier(0)
    Unit cur, nxt; int ui = 0;
    if (!S.next(0, cur)) return;
    f32x4 acc[2][2][4][2];
#pragma unroll
    for (int a = 0; a < 2; ++a)
#pragma unroll
        for (int b = 0; b < 2; ++b)
#pragma unroll
            for (int m = 0; m < 4; ++m)
#pragma unroll
                for (int n = 0; n < 2; ++n) acc[a][b][m][n] = (f32x4){0.f, 0.f, 0.f, 0.f};
    bf16x8 At[4][2], B0[2][2], B1[2][2];
    const char* cA = (const char*)g.A + (size_t)cur.pm * tstep; const char* cB = (const char*)g.Bt + (size_t)cur.pn * tstep;
    S.a_ready(cur);
    if constexpr (SP2) {
        PG8_STAGE(PG8_SB(0, 0), cB, voffB); PG8_STAGE(PG8_SB(0, 1), cB + hstepB, voffB); PG8_STAGE(PG8_SA(0, 0), cA, voffA); PG8_STAGE(PG8_SA(0, 1), cA + hstep, voffA);
        if (wr == 1) PG8_BAR;
        PG8_WAIT_V(2); PG8_BAR;
        PG8_STAGE(PG8_SB(1, 0), cB + kstep, voffB); PG8_STAGE(PG8_SA(1, 0), cA + kstep, voffA); PG8_STAGE(PG8_SB(1, 1), cB + hstepB + kstep, voffB);
        PG8_WAIT_V(6); PG8_BAR;
    } else {
        PG8_STAGE(PG8_SB(0, 0), cB, voffB); PG8_STAGE(PG8_SA(0, 0), cA, voffA); PG8_STAGE(PG8_SB(0, 1), cB + hstepB, voffB); PG8_STAGE(PG8_SA(0, 1), cA + hstep, voffA);
        if (wr == 1) PG8_BAR;
        PG8_WAIT_V(4); PG8_BAR;
        PG8_STAGE(PG8_SB(1, 0), cB + kstep, voffB); PG8_STAGE(PG8_SA(1, 0), cA + kstep, voffA); PG8_STAGE(PG8_SB(1, 1), cB + hstepB + kstep, voffB);
        PG8_WAIT_V(6); PG8_BAR;
    }
    for (;;) {
        const bool has_next = S.next(ui + 1, nxt);
        const char* nA = has_next ? (const char*)g.A + (size_t)nxt.pm * tstep : cA; const char* nB = has_next ? (const char*)g.Bt + (size_t)nxt.pn * tstep : cB;
        for (int t = 0; t < nt; t += 2) {
            const bool last = (t == nt - 2);
            const char* a1 = cA + (size_t)(t + 1) * kstep;
            const char* a2 = last ? nA : cA + (size_t)(t + 2) * kstep; const char* b2 = last ? nB : cB + (size_t)(t + 2) * kstep;
            const char* a3 = a2 + kstep; const char* b3 = b2 + kstep;
            if (last && has_next) S.a_ready(nxt);
            if constexpr (SP2) {
            PG8_LDB(B0, 0, 0); PG8_LDB(B1, 0, 1); PG8_SCHED; PG8_LDA(At, 0, 0); PG8_STAGE(PG8_SA(1, 1), a1 + hstep, voffA);
            PG8_WAIT_V(8); PG8_WAIT_L(0); PG8_BAR; PG8_MMA(0, 0, At, B0); PG8_MMA(0, 1, At, B1); PG8_BAR; PG8_SCHED;
            PG8_LDA(At, 0, 1); PG8_STAGE(PG8_SB(0, 0), b2, voffB); PG8_STAGE(PG8_SB(0, 1), b2 + hstepB, voffB); PG8_STAGE(PG8_SA(0, 0), a2, voffA);
            PG8_WAIT_V(8); PG8_WAIT_L(0); PG8_BAR; PG8_MMA(1, 0, At, B0); PG8_MMA(1, 1, At, B1); PG8_BAR; PG8_SCHED;
            PG8_LDB(B0, 1, 0); PG8_LDB(B1, 1, 1); PG8_SCHED; PG8_LDA(At, 1, 0); PG8_STAGE(PG8_SA(0, 1), a2 + hstep, voffA);
            PG8_WAIT_V(8); PG8_WAIT_L(0); PG8_BAR; PG8_MMA(0, 0, At, B0); PG8_MMA(0, 1, At, B1); PG8_BAR; PG8_SCHED;
            PG8_LDA(At, 1, 1); PG8_STAGE(PG8_SB(1, 0), b3, voffB); PG8_STAGE(PG8_SB(1, 1), b3 + hstepB, voffB); PG8_STAGE(PG8_SA(1, 0), a3, voffA);
            PG8_WAIT_V(8); PG8_WAIT_L(0); PG8_BAR; PG8_MMA(1, 0, At, B0); PG8_MMA(1, 1, At, B1); PG8_BAR; PG8_SCHED;
            } else {
            PG8_LDB(B0, 0, 0); PG8_SCHED; PG8_LDA(At, 0, 0); PG8_STAGE(PG8_SA(1, 1), a1 + hstep, voffA);
            PG8_WAIT_L(8); PG8_BAR; PG8_WAIT_L(0); PG8_MMA(0, 0, At, B0); PG8_BAR; PG8_SCHED;
            PG8_LDB(B1, 0, 1); PG8_STAGE(PG8_SB(0, 0), b2, voffB);
            PG8_BAR; PG8_WAIT_L(0); PG8_MMA(0, 1, At, B1); PG8_BAR;
            PG8_LDA(At, 0, 1); PG8_STAGE(PG8_SA(0, 0), a2, voffA);
            PG8_BAR; PG8_WAIT_L(0); PG8_MMA(1, 0, At, B0); PG8_BAR; PG8_SCHED;
            PG8_STAGE(PG8_SB(0, 1), b2 + hstepB, voffB);
            PG8_WAIT_V(6); PG8_BAR; PG8_MMA(1, 1, At, B1); PG8_BAR;
            PG8_LDB(B0, 1, 0); PG8_SCHED; PG8_LDA(At, 1, 0); PG8_STAGE(PG8_SA(0, 1), a2 + hstep, voffA);
            PG8_WAIT_L(8); PG8_BAR; PG8_WAIT_L(0); PG8_MMA(0, 0, At, B0); PG8_BAR; PG8_SCHED;
            PG8_LDB(B1, 1, 1); PG8_STAGE(PG8_SB(1, 0), b3, voffB);
            PG8_BAR; PG8_WAIT_L(0); PG8_MMA(0, 1, At, B1); PG8_BAR;
            PG8_LDA(At, 1, 1); PG8_STAGE(PG8_SA(1, 0), a3, voffA);
            PG8_BAR; PG8_WAIT_L(0); PG8_MMA(1, 0, At, B0); PG8_BAR; PG8_SCHED;
            PG8_STAGE(PG8_SB(1, 1), b3 + hstepB, voffB);
            PG8_WAIT_V(6); PG8_BAR; PG8_MMA(1, 1, At, B1); PG8_BAR;
            }
        }
        if constexpr (ALIGN_EPI) { if (wr == 0) PG8_BAR; }
        if constexpr (!Epi::AFTER_DRAIN) { E(acc, cur, wr, wc, fr, fq); S.done(cur); }
        if (!has_next) break;
#pragma unroll
        for (int a = 0; a < 2; ++a)
#pragma unroll
            for (int b = 0; b < 2; ++b)
#pragma unroll
                for (int m = 0; m < 4; ++m)
#pragma unroll
                    for (int n = 0; n < 2; ++n) acc[a][b][m][n] = (f32x4){0.f, 0.f, 0.f, 0.f};
        cur = nxt; cA = nA; cB = nB; ++ui;
        if constexpr (ALIGN_EPI) { if (wr == 1) PG8_BAR; }
    }
    PG8_WAIT_V(0);
    if constexpr (!ALIGN_EPI) { if (wr == 0) PG8_BAR; }
    PG8_BAR;
    if constexpr (Epi::AFTER_DRAIN) { E.fused(acc, cur, wr, wc, fr, fq, lds, wid, lane); S.done(cur); }
#undef PG8_SA
#undef PG8_SB
#undef PG8_STAGE
#undef PG8_LDA
#undef PG8_LDB
#undef PG8_MMA
#undef PG8_WAIT_V
#undef PG8_WAIT_L
#undef PG8_BAR
#undef PG8_SCHED
}
}
#include <hip/hip_bf16.h>
#include <cmath>
namespace dattn {
using bf16 = __hip_bfloat16;
typedef short bf16x8 __attribute__((ext_vector_type(8)));
typedef short s16x4 __attribute__((ext_vector_type(4)));
typedef float f32x16 __attribute__((ext_vector_type(16)));
typedef unsigned u32x4 __attribute__((ext_vector_type(4)));
constexpr int DK = 64, DV = 128, RS = 1024, SEQ = 4096;
constexpr int NW = 8, QBLK = 32, KVBLK = 64, QB = NW * QBLK;
constexpr int SHM_V = KVBLK * DV * 2, SHM_K = KVBLK * DK * 2;
constexpr int NVB = 3;
constexpr int LDS_WS = NVB * SHM_V + 2 * SHM_K, LDS_TAB = LDS_WS + NW * 64 * 4, LDS_OST = 69632, OST_WAVE = 4096, LDS_BYTES = LDS_OST + NW * OST_WAVE;
constexpr int TAB_PADL = 260, TAB_N = TAB_PADL + 128 + 94;
static_assert(LDS_TAB + TAB_N * 4 <= LDS_OST, "attention LDS map");
constexpr float THR = 8.f;
constexpr float C2 = 0.125f * 1.4426950408889634f;
#define DA_KSWZ(row, colB) ((row) * 128 + ((colB) ^ (((row) & 7) << 4)))
#define DA_SBAR() __builtin_amdgcn_sched_barrier(0)
__device__ __forceinline__ int v_st(int k, int c) { const int kk = k;     return ((kk >> 3) * 4 + (c >> 5)) * 512 + ((kk & 7) * 32 + (c & 31)) * 2; }
__device__ __forceinline__ int v_rd_base(int lane) { return ((lane & 3) << 3) | (((lane >> 2) & 3) << 6) | (((lane >> 4) & 1) << 5) | (((lane >> 5) & 1) << 8); }
constexpr int v_rd_off(int d0, int ks, int half) { return d0 * 512 + ks * 4096 + half * 2048; }
__device__ __forceinline__ int crow(int r, int hi) { return (r & 3) + 8 * (r >> 2) + 4 * hi; }
__device__ __forceinline__ unsigned cvtpk(float lo, float hi) { unsigned r; asm volatile("v_cvt_pk_bf16_f32 %0, %1, %2" : "=v"(r) : "v"(lo), "v"(hi)); return r; }
__device__ __forceinline__ bf16x8 load8(const bf16* p) { return *reinterpret_cast<const bf16x8*>(p); }
__device__ __forceinline__ void bias_tile(f32x16& p0, f32x16& p1, int dq, const __attribute__((address_space(3))) float* tabp) {
    const __attribute__((address_space(3))) float* bp = tabp + (TAB_PADL - 59) + dq;
#pragma unroll
    for (int r = 0; r < 16; ++r) { const int c = (r & 3) + 8 * (r >> 2); p0[r] += bp[59 - c]; p1[r] += bp[27 - c]; }
}
__device__ __forceinline__ void rowmaxSM(const f32x16& p0, const f32x16& p1, float& m_reg, float& mn, float& alpha) {
    float ma_ = p0[0], mb_ = p1[0];
#pragma unroll
    for (int r = 1; r < 15; r += 2) { ma_ = fmaxf(fmaxf(ma_, p0[r]), p0[r + 1]); mb_ = fmaxf(fmaxf(mb_, p1[r]), p1[r + 1]); }
    float pmax = fmaxf(fmaxf(ma_, p0[15]), fmaxf(mb_, p1[15]));
    { auto rr = __builtin_amdgcn_permlane32_swap(__float_as_uint(pmax), __float_as_uint(pmax), false, false); pmax = fmaxf(__uint_as_float(rr[0]), __uint_as_float(rr[1])); }
    if (__builtin_expect(__all(pmax - m_reg <= THR), 1)) { mn = m_reg; alpha = 1.f; }
    else { mn = fmaxf(m_reg, pmax); alpha = __builtin_amdgcn_exp2f(m_reg - mn); m_reg = mn; }
}
__device__ __forceinline__ void expSM(f32x16& p0, f32x16& p1, float mn) {
#pragma unroll
    for (int r = 0; r < 16; ++r) { p0[r] = __builtin_amdgcn_exp2f(p0[r] - mn); p1[r] = __builtin_amdgcn_exp2f(p1[r] - mn); }
}
__device__ __forceinline__ void finishSM(f32x16& p0, f32x16& p1, float alpha, float& l_reg, bf16x8& pa0, bf16x8& pa1, bf16x8& pa2, bf16x8& pa3) {
    float s0_ = p0[0], s1_ = p0[1], s2_ = p1[0], s3_ = p1[1];
#pragma unroll
    for (int r = 2; r < 16; r += 2) { s0_ += p0[r]; s1_ += p0[r + 1]; s2_ += p1[r]; s3_ += p1[r + 1]; }
    float ps = (s0_ + s1_) + (s2_ + s3_);
    { auto rr = __builtin_amdgcn_permlane32_swap(__float_as_uint(ps), __float_as_uint(ps), false, false); ps = __uint_as_float(rr[0]) + __uint_as_float(rr[1]); }
    l_reg = l_reg * alpha + ps;
#define DA_PK4(P, B_, OUT) do { u32x4 w = {cvtpk(P[B_+0], P[B_+1]), cvtpk(P[B_+2], P[B_+3]), cvtpk(P[B_+4], P[B_+5]), cvtpk(P[B_+6], P[B_+7])};     \
        OUT = *reinterpret_cast<bf16x8*>(&w); } while (0)
    DA_PK4(p0, 0, pa0); DA_PK4(p0, 8, pa1); DA_PK4(p1, 0, pa2); DA_PK4(p1, 8, pa3);
#undef DA_PK4
}
template <int KB>
__device__ __forceinline__ void qkt(f32x16& p0, f32x16& p1, const char* K_lds, int r32, int hi, const bf16x8* qr) {
    p0 = f32x16{}; p1 = f32x16{};
#pragma unroll
    for (int d0 = 0; d0 < 4; ++d0) { const char* a = K_lds + KB * SHM_K + DA_KSWZ(r32, (d0 * 16 + hi * 8) * 2);
        const bf16x8 b0 = *reinterpret_cast<const bf16x8*>(a), b1 = *reinterpret_cast<const bf16x8*>(a + 32 * 128);
        p0 = __builtin_amdgcn_mfma_f32_32x32x16_bf16(b0, qr[d0], p0, 0, 0, 0);
        p1 = __builtin_amdgcn_mfma_f32_32x32x16_bf16(b1, qr[d0], p1, 0, 0, 0); }
}
template <bool FILL>
__device__ __forceinline__ void pv_tile(f32x16* o, int vb0  , bf16x8 pa0, bf16x8 pa1, bf16x8 pa2, bf16x8 pa3, f32x16& px0, f32x16& px1, float mn) {
#define DA_TRRD(dst, off) asm volatile("ds_read_b64_tr_b16 %0, %1 offset:%2" : "=&v"(dst) : "v"(vb0), "i"(off) : "memory")
#define DA_RD2(m, l, h) do { constexpr int b_ = v_rd_off((m) >> 2, 0, 0) + ((m) & 3) * 4096; DA_TRRD(l, b_); DA_TRRD(h, b_ + 2048); } while (0)
#define DA_MM(m, pa, l, h) do { o[(m) >> 2] = __builtin_amdgcn_mfma_f32_32x32x16_bf16(pa, (bf16x8){l[0], l[1], l[2], l[3], h[0], h[1], h[2], h[3]}, o[(m) >> 2], 0, 0, 0); } while (0)
#define DA_LGK(n) asm volatile("s_waitcnt lgkmcnt(" #n ")" ::: "memory")
#define DA_FILL(m) do { if constexpr (FILL) { float a_ = __builtin_amdgcn_exp2f(px0[m] - mn), b_ = __builtin_amdgcn_exp2f(px1[m] - mn); asm volatile("" : "+v"(a_), "+v"(b_)); px0[m] = a_; px1[m] = b_; } } while (0)
    s16x4 l0, h0, l1, h1, l2, h2, l3, h3, l4, h4, l5, h5, l6, h6, l7, h7, l8, h8, l9, h9, l10, h10, l11, h11, l12, h12, l13, h13, l14, h14, l15, h15;
    DA_SBAR();
    DA_RD2(0, l0, h0); DA_RD2(1, l1, h1); DA_RD2(2, l2, h2); DA_RD2(3, l3, h3);
    DA_LGK(6); DA_SBAR(); DA_MM(0, pa0, l0, h0); DA_FILL(0); DA_SBAR(); DA_RD2(4, l4, h4);
    DA_LGK(6); DA_SBAR(); DA_MM(1, pa1, l1, h1); DA_FILL(1); DA_SBAR(); DA_RD2(5, l5, h5);
    DA_LGK(6); DA_SBAR(); DA_MM(2, pa2, l2, h2); DA_FILL(2); DA_SBAR(); DA_RD2(6, l6, h6);
    DA_LGK(6); DA_SBAR(); DA_MM(3, pa3, l3, h3); DA_FILL(3); DA_SBAR(); DA_RD2(7, l7, h7);
    DA_LGK(6); DA_SBAR(); DA_MM(4, pa0, l4, h4); DA_FILL(4); DA_SBAR(); DA_RD2(8, l8, h8);
    DA_LGK(6); DA_SBAR(); DA_MM(5, pa1, l5, h5); DA_FILL(5); DA_SBAR(); DA_RD2(9, l9, h9);
    DA_LGK(6); DA_SBAR(); DA_MM(6, pa2, l6, h6); DA_FILL(6); DA_SBAR(); DA_RD2(10, l10, h10);
    DA_LGK(6); DA_SBAR(); DA_MM(7, pa3, l7, h7); DA_FILL(7); DA_SBAR(); DA_RD2(11, l11, h11);
    DA_LGK(6); DA_SBAR(); DA_MM(8, pa0, l8, h8); DA_FILL(8); DA_SBAR(); DA_RD2(12, l12, h12);
    DA_LGK(6); DA_SBAR(); DA_MM(9, pa1, l9, h9); DA_FILL(9); DA_SBAR(); DA_RD2(13, l13, h13);
    DA_LGK(6); DA_SBAR(); DA_MM(10, pa2, l10, h10); DA_FILL(10); DA_SBAR(); DA_RD2(14, l14, h14);
    DA_LGK(6); DA_SBAR(); DA_MM(11, pa3, l11, h11); DA_FILL(11); DA_SBAR(); DA_RD2(15, l15, h15);
    DA_LGK(6); DA_SBAR(); DA_MM(12, pa0, l12, h12); DA_FILL(12); DA_SBAR();
    DA_LGK(4); DA_SBAR(); DA_MM(13, pa1, l13, h13); DA_FILL(13); DA_SBAR();
    DA_LGK(2); DA_SBAR(); DA_MM(14, pa2, l14, h14); DA_FILL(14); DA_SBAR();
    DA_LGK(0); DA_SBAR(); DA_MM(15, pa3, l15, h15); DA_FILL(15); DA_SBAR();
#undef DA_FILL
#undef DA_LGK
#undef DA_MM
#undef DA_RD2
#undef DA_TRRD
}
struct BlockRef { const bf16* Q; const bf16* K; const bf16* V; bf16* O; int P0; };
struct Seam { bf16x8 qr[4]; bf16x8 st_v0, st_v1, st_k0; };
#define DA_VMW() asm volatile("s_waitcnt vmcnt(0)" ::: "memory")
#define DA_VMWN(n) asm volatile("s_waitcnt vmcnt(%0)" :: "i"(n) : "memory")
#define DA_SLOAD(Kp, Vp, k0) do { S.st_v0 = load8((Vp) + (size_t)((k0) + sr) * RS + sc); S.st_v1 = load8((Vp) + (size_t)((k0) + 32 + sr) * RS + sc); S.st_k0 = load8((Kp) + (size_t)((k0) + kr) * RS + kc); } while (0)
#define DA_SWRITE_K(bf) do { *(bf16x8*)(K_lds + (bf) * SHM_K + kws) = S.st_k0; } while (0)
#define DA_SWRITE_V(bf) do { *(bf16x8*)(V_lds + (bf) * SHM_V + vst0) = S.st_v0; *(bf16x8*)(V_lds + (bf) * SHM_V + vst1) = S.st_v1; } while (0)
__device__ __forceinline__ void prime(const BlockRef& cur, char* lds, Seam& S) {
    const int tid = threadIdx.x, wid = __builtin_amdgcn_readfirstlane(tid >> 6), lane = tid & 63, r32 = lane & 31, hi = lane >> 5;
    const int sr = tid >> 4, sc = (tid & 15) * 8, kr = tid >> 3, kc = (tid & 7) * 8, kws = DA_KSWZ(kr, kc * 2); char* K_lds = lds + NVB * SHM_V;
#pragma unroll
    for (int d0 = 0; d0 < 4; ++d0) S.qr[d0] = load8(cur.Q + (size_t)(wid * QBLK + r32) * RS + d0 * 16 + hi * 8);
    DA_SLOAD(cur.K, cur.V, 0); DA_VMW(); DA_SWRITE_K(0);
    __syncthreads();
}
__device__ __forceinline__ void block(const BlockRef& cur, const BlockRef& nxt, char* lds, Seam& S) {
    const int tid = threadIdx.x, wid = __builtin_amdgcn_readfirstlane(tid >> 6), lane = tid & 63, r32 = lane & 31, hi = lane >> 5;
    const int NT = (cur.P0 + QB) / KVBLK;
    const int qlo = cur.P0 + wid * QBLK, qm = qlo + r32 - 4 * hi;
    char* V_lds = lds; char* K_lds = lds + NVB * SHM_V;
    float* ws = (float*)(lds + LDS_WS) + wid * 64; float* li_l = ws, * al_l = ws + 32;
    const __attribute__((address_space(3))) float* tab = (const __attribute__((address_space(3))) float*)((__attribute__((address_space(3))) char*)lds + LDS_TAB);
    float m_reg = -1e30f, l_reg = 0; f32x16 o[4] = {};
    const int sr = tid >> 4, sc = (tid & 15) * 8, vst0 = v_st(sr, sc), vst1 = v_st(32 + sr, sc), kr = tid >> 3, kc = (tid & 7) * 8, kws = DA_KSWZ(kr, kc * 2);
    const int vb0 = (int)(uintptr_t)V_lds + v_rd_base(lane);
    const bf16* Kh = cur.K; const bf16* Vh = cur.V;
#define DA_RESC(a) do { if (__any((a) < 1.f)) { if (hi == 0) al_l[r32] = (a); asm volatile("s_waitcnt lgkmcnt(0)" ::: "memory"); \
                     _Pragma("unroll") for (int d_ = 0; d_ < 4; ++d_) _Pragma("unroll") for (int r = 0; r < 16; ++r) o[d_][r] *= al_l[crow(r, hi)]; } } while (0)
#define DA_KBASE(t) ((t) * KVBLK)
#define DA_MASKT(P0_, P1_, t) do { const int kb_ = DA_KBASE(t); if (kb_ + KVBLK - 1 >= qlo - 127) bias_tile(P0_, P1_, qm - kb_, tab); } while (0)
    constexpr int NQL = 4;
#define DA_SEAM_K0() do { DA_VMWN(NQL); DA_SWRITE_K(0); DA_SBAR(); } while (0)
    f32x16 pA0, pA1, pB0, pB1; float mnA, mnB, alA, alB; bf16x8 pa0, pa1, pa2, pa3;
    DA_SWRITE_V(0); DA_SBAR();
    DA_SLOAD(Kh, Vh, DA_KBASE(1));
    DA_SBAR(); qkt<0>(pA0, pA1, K_lds, r32, hi, S.qr);
    DA_MASKT(pA0, pA1, 0); rowmaxSM(pA0, pA1, m_reg, mnA, alA); expSM(pA0, pA1, mnA);
    DA_VMW(); DA_SWRITE_V(1); DA_SWRITE_K(1); DA_SBAR();
    DA_SLOAD(Kh, Vh, DA_KBASE(2));
    __syncthreads();
    int vrd = 0, vwr = 2;
#define DA_NEXT3(x) ((x) == NVB - 1 ? 0 : (x) + 1)
#define DA_HALF_STEP(PX0, PX1, mnX, alX, PY0, PY1, alY, t, KB) do { \
        DA_SBAR(); qkt<KB>(PX0, PX1, K_lds, r32, hi, S.qr); \
        finishSM(PY0, PY1, alY, l_reg, pa0, pa1, pa2, pa3); DA_SBAR(); \
        DA_VMW(); DA_SWRITE_K(1 - (KB)); DA_SWRITE_V(vwr); DA_SBAR(); \
        if ((t) + 2 < NT) { DA_SLOAD(Kh, Vh, DA_KBASE((t) + 2)); DA_SBAR(); } \
        DA_MASKT(PX0, PX1, (t)); rowmaxSM(PX0, PX1, m_reg, mnX, alX); DA_SBAR(); \
        pv_tile<true>(o, vb0 + vrd * SHM_V, pa0, pa1, pa2, pa3, PX0, PX1, mnX); \
        DA_RESC(alX); __syncthreads(); vrd = DA_NEXT3(vrd); vwr = DA_NEXT3(vwr); } while (0)
    for (int t = 1; t + 1 < NT; t += 2) {
        DA_HALF_STEP(pB0, pB1, mnB, alB, pA0, pA1, alA, t, 1);
        DA_HALF_STEP(pA0, pA1, mnA, alA, pB0, pB1, alB, t + 1, 0);
    }
    DA_SBAR(); qkt<1>(pB0, pB1, K_lds, r32, hi, S.qr); DA_SBAR();
    DA_SLOAD(nxt.K, nxt.V, 0); DA_SBAR();
#pragma unroll
    for (int d0 = 0; d0 < 4; ++d0) S.qr[d0] = load8(nxt.Q + (size_t)(wid * QBLK + r32) * RS + d0 * 16 + hi * 8);
    DA_SBAR();
    finishSM(pA0, pA1, alA, l_reg, pa0, pa1, pa2, pa3); DA_SBAR();
    DA_MASKT(pB0, pB1, NT - 1); rowmaxSM(pB0, pB1, m_reg, mnB, alB); DA_SBAR();
    pv_tile<true>(o, vb0 + vrd * SHM_V, pa0, pa1, pa2, pa3, pB0, pB1, mnB); vrd = DA_NEXT3(vrd);
    DA_RESC(alB);
    finishSM(pB0, pB1, alB, l_reg, pa0, pa1, pa2, pa3); DA_SBAR(); pv_tile<false>(o, vb0 + vrd * SHM_V, pa0, pa1, pa2, pa3, pB0, pB1, 0.f);
    __syncthreads();
    DA_SBAR(); DA_SEAM_K0();
    if (hi == 0) li_l[r32] = l_reg; asm volatile("s_waitcnt lgkmcnt(0)" ::: "memory");
    bf16* Ow = cur.O + (size_t)(wid * QBLK) * RS;
    { char* stg = lds + LDS_OST + wid * OST_WAVE;
#pragma unroll
      for (int ps = 0; ps < 2; ++ps) {
#pragma unroll
          for (int r = 8 * ps; r < 8 * ps + 8; ++r) { const int orow = crow(r, hi) - 16 * ps; const float rli_r = __builtin_amdgcn_rcpf(li_l[crow(r, hi)]);
#pragma unroll
              for (int d0 = 0; d0 < 4; ++d0) { const float v = o[d0][r] * rli_r;
                  const float vn = __int_as_float(__builtin_amdgcn_update_dpp(0, __float_as_int(v), 0xB1, 0xf, 0xf, true));
                  if ((r32 & 1) == 0) *(unsigned*)(stg + orow * 256 + (d0 * 32 + r32) * 2) = cvtpk(v, vn); } }
          asm volatile("s_waitcnt lgkmcnt(0)" ::: "memory");
          u32x4 w[4];
#pragma unroll
          for (int i = 0; i < 4; ++i) { const int row = 4 * i + (lane >> 4), ch = lane & 15; w[i] = *(const u32x4*)(stg + row * 256 + ch * 16); }
          asm volatile("s_waitcnt lgkmcnt(0)" ::: "memory");
#pragma unroll
          for (int i = 0; i < 4; ++i) { const int row = 4 * i + (lane >> 4), ch = lane & 15; *(u32x4*)(Ow + (size_t)(16 * ps + row) * RS + ch * 8) = w[i]; } } }
    __syncthreads();
#undef DA_NEXT3
#undef DA_RESC
#undef DA_KBASE
#undef DA_MASKT
#undef DA_SEAM_K0
#undef DA_HALF_STEP
}
#undef DA_VMW
#undef DA_VMWN
#undef DA_SLOAD
#undef DA_SWRITE_K
#undef DA_SWRITE_V
struct Tensors { const bf16* Q; const bf16* K; const bf16* V; bf16* O1; bf16* O2; const float* biastab; };
__device__ __forceinline__ BlockRef unit_ref(const Tensors& T, int v, int i) {
    const int bhc = (v & 255) >> 1, s = v & 1, b = bhc >> 4, h = (bhc >> 1) & 7, c = bhc & 1; const int q2 = 2 * (i >> 1) + s, qb = (i & 1) ? 15 - q2 : q2;
    const size_t row0 = (size_t)b * SEQ; BlockRef r;
    r.Q = T.Q + (row0 + (size_t)qb * QB) * RS + (2 * h + c) * DK; r.K = T.K + row0 * RS + (2 * h + c) * DK; r.V = T.V + row0 * RS + h * DV;
    r.O = (c ? T.O2 : T.O1) + (row0 + (size_t)qb * QB) * RS + h * DV; r.P0 = qb * QB; return r;
}
__device__ __forceinline__ void phase(char* lds, const Tensors& T, int vcu) {
    { const int h = ((vcu & 255) >> 2) & 7, i = (int)threadIdx.x; if (i < TAB_N) ((float*)(lds + LDS_TAB))[i] = i < TAB_PADL ? -__builtin_inff() : (i < TAB_PADL + 128 ? T.biastab[h * 128 + i - TAB_PADL] : 0.f); }
    Seam S; BlockRef cur = unit_ref(T, vcu, 0);
    prime(cur, lds, S);
    if (threadIdx.x >= 256) __builtin_amdgcn_s_setprio(1);
    for (int i = 0; i < 8; ++i) { const BlockRef nxt = unit_ref(T, vcu, i + 1 < 8 ? i + 1 : i); block(cur, nxt, lds, S); cur = nxt; }
    __builtin_amdgcn_s_setprio(0);
}
#undef DA_KSWZ
#undef DA_SBAR
}
#ifndef PG8_SP2
#define PG8_SP2 true
#endif
#ifndef PG8_ALIGN
#define PG8_ALIGN true
#endif
constexpr int NWAVES = 8;
#ifndef MK_N_LAUNCHES
#define MK_N_LAUNCHES 1
#endif
constexpr int N_PHASES = 8;
constexpr int BATCH = 8, SEQ = 4096, D = 2048, M = BATCH * SEQ;
constexpr int NPROJ = 5120, DATT = 1024, DCONV = 1024, CONVW = 31;
constexpr int PH = 8, PNK = 128, PHALF = 128, PTOPK = 16, NEXP = 16384;
constexpr float LN_EPS = 1e-5f;
constexpr float DN_ALPHA = 1.189207115002721f;
constexpr float LAMBDA_INIT = 0.2f;
constexpr size_t MiB = 1u << 20;
constexpr size_t WS_WIN = 2 * MiB, WS_WOUT = 22 * MiB, WS_WQ = 30 * MiB, WS_KEYS = 38 * MiB, WS_TAB = 39 * MiB;
constexpr size_t WS_U8 = 40 * MiB, WS_V8 = 72 * MiB, WS_SU = 104 * MiB, WS_SV = 105 * MiB;
constexpr size_t WS_XB = 168 * MiB;
constexpr size_t WS_Q = 296 * MiB, WS_K = 360 * MiB, WS_V = 424 * MiB, WS_H = 488 * MiB;
constexpr size_t WS_O1 = 552 * MiB, WS_O2 = 616 * MiB;
constexpr size_t WS_Y1 = 680 * MiB;
constexpr size_t WS_QP = 808 * MiB;
constexpr size_t WS_X8 = WS_O1;
constexpr size_t WS_SX = 106 * MiB, WS_SWQ = 107 * MiB, WS_SWIN = WS_SWQ + 65536, WS_SWOUT = WS_SWQ + 131072, WS_SXA = 108 * MiB, WS_SM = 109 * MiB, WS_LNS = 110 * MiB, WS_SXQ = 111 * MiB, WS_NSU = 112 * MiB;
constexpr size_t WS_XH = WS_O2, WS_XL = WS_O2 + 32 * MiB;
constexpr size_t WS_CMAX = 16384;
constexpr size_t WS_EID = 936 * MiB, WS_GATE = 952 * MiB;
constexpr size_t WS_END = 968 * MiB;
constexpr int RING_BYTES = 131072, LDS_BYTES = 163840;

#define GAS __attribute__((address_space(1)))
#define LAS __attribute__((address_space(3)))
typedef unsigned short bf16;
typedef unsigned v4u __attribute__((ext_vector_type(4)));
typedef unsigned v2u __attribute__((ext_vector_type(2)));
typedef float f32x4 __attribute__((ext_vector_type(4)));
typedef float f32x16 __attribute__((ext_vector_type(16)));
typedef short bf16x8 __attribute__((ext_vector_type(8)));
typedef __bf16 bf16x2_t __attribute__((ext_vector_type(2)));
#define LDS_WAIT() asm volatile("s_waitcnt lgkmcnt(0)" ::: "memory")
#ifndef PROBE_SEC
#define PROBE_SEC -1
#endif
#ifndef PROBE_REP
#define PROBE_REP -1
#endif
#define SEC_REP(id) for (int sec_rep_ = 0; sec_rep_ < ((PROBE_REP == (id)) ? 2 : 1); ++sec_rep_)
#define SEC_BEGIN(id) const unsigned long long sec_t0_##id = (PROBE_SEC == (id)) ? __builtin_amdgcn_s_memrealtime() : 0ull
#define SEC_END(id) do { if (PROBE_SEC == (id)) { const unsigned long long t1_ = __builtin_amdgcn_s_memrealtime(), dt_ = t1_ - sec_t0_##id; while (__builtin_amdgcn_s_memrealtime() - t1_ < dt_) __builtin_amdgcn_s_sleep(4); } } while (0)
__device__ __forceinline__ unsigned f2bf(float f) { unsigned u = __builtin_bit_cast(unsigned, f); return (u + 0x7fffu + ((u >> 16) & 1u)) >> 16; }
__device__ __forceinline__ unsigned pk2(float lo, float hi) { return f2bf(lo) | (f2bf(hi) << 16); }
__device__ __forceinline__ float bflo(unsigned w) { return __uint_as_float(w << 16); }
__device__ __forceinline__ float bfhi(unsigned w) { return __uint_as_float(w & 0xffff0000u); }
__device__ __forceinline__ float wave_sum(float v);
__device__ __forceinline__ float wave_max(float v);
__device__ __forceinline__ float dot2bf(unsigned a, unsigned b, float acc) { return __builtin_amdgcn_fdot2_f32_bf16(__builtin_bit_cast(bf16x2_t, a), __builtin_bit_cast(bf16x2_t, b), acc, false); }

#define XB_TMO      128
#define XB_XCNT(j)  (256  + 64 * (j))
#define XB_XSUB(j)  (1280 + 64 * (j))
#define XB_XGEN(j)  (2304 + 64 * (j))
#define XB_TOP      3328
#define XB_TOPGEN   3392
#define XCD_BAR_WORDS 3456
#define XB_SPIN_CAP (1u << 18)

__device__ __forceinline__ unsigned xb_ld(unsigned* p)              { return __hip_atomic_load(p, __ATOMIC_RELAXED, __HIP_MEMORY_SCOPE_AGENT); }
__device__ __forceinline__ unsigned xb_add(unsigned* p, unsigned v) { return __hip_atomic_fetch_add(p, v, __ATOMIC_RELAXED, __HIP_MEMORY_SCOPE_AGENT); }
__device__ __forceinline__ unsigned xb_xcc_id() { return (unsigned)__builtin_amdgcn_s_getreg((3 << 11) | 20) & 0xFu; }
#define XB_SPIN(cond, bar) do { unsigned _sp = 0; while (cond) { __builtin_amdgcn_s_sleep(1); \
    if ((++_sp & 255u) == 0u) { if (xb_ld(&(bar)[XB_TMO])) break; if (_sp > XB_SPIN_CAP) { atomicAdd(&(bar)[XB_TMO], 1u); break; } } } } while (0)

struct XcdBarrier {
    unsigned* bar; unsigned x;
    volatile LAS unsigned* st;
};

__device__ __forceinline__ XcdBarrier xcd_barrier_post(unsigned* bar, volatile LAS unsigned* st) {
    XcdBarrier b; b.bar = bar; b.x = xb_xcc_id(); b.st = st;
    if (threadIdx.x == 0) (void)xb_add(&bar[XB_XCNT(b.x)], 1u);
    return b;
}
__device__ __forceinline__ void xcd_barrier_complete(unsigned* bar, unsigned x, unsigned& nloc, unsigned& nx) {
    const unsigned G = gridDim.x * gridDim.y * gridDim.z;
    unsigned sum, cnt, mine, sp = 0u;
    for (;;) {
        sum = 0u; cnt = 0u; mine = 0u;
#pragma unroll
        for (unsigned j = 0; j < 16; ++j) { const unsigned c = xb_ld(&bar[XB_XCNT(j)]); sum += c; cnt += (c > 0u) ? 1u : 0u; mine = (j == x) ? c : mine; }
        if (sum == G) break;
        __builtin_amdgcn_s_sleep(1);
        if ((++sp & 255u) == 0u) { if (xb_ld(&bar[XB_TMO])) break; if (sp > XB_SPIN_CAP) { atomicAdd(&bar[XB_TMO], 1u); break; } }
    }
    nloc = mine > 0u ? mine : 1u; nx = cnt > 0u ? cnt : 1u;
}

__device__ __forceinline__ void xcd_barrier(const XcdBarrier& b) {
    asm volatile("s_waitcnt vmcnt(0)" ::: "memory");
    __syncthreads();
    if (threadIdx.x == 0) {
        unsigned* bar = b.bar;
        __builtin_amdgcn_s_waitcnt(0);
        unsigned nloc = b.st[0], nx = b.st[1];
        if (nloc == 0u) { xcd_barrier_complete(bar, b.x, nloc, nx); b.st[0] = nloc; b.st[1] = nx; }
        const unsigned old = xb_add(&bar[XB_XSUB(b.x)], 1u);
        const unsigned gen = old / nloc;
        if (old + 1u == (gen + 1u) * nloc) {
            __builtin_amdgcn_fence(__ATOMIC_RELEASE, "agent");
            asm volatile("s_waitcnt vmcnt(0)" ::: "memory");
            const unsigned og = xb_add(&bar[XB_TOP], 1u);
            const unsigned tg = og / nx;
            if (og + 1u == (tg + 1u) * nx) xb_add(&bar[XB_TOPGEN], 1u);
            else XB_SPIN(xb_ld(&bar[XB_TOPGEN]) == tg, bar);
            __builtin_amdgcn_fence(__ATOMIC_ACQUIRE, "agent");
            xb_add(&bar[XB_XGEN(b.x)], 1u);
            asm volatile("s_waitcnt vmcnt(0)" ::: "memory");
        } else {
            XB_SPIN(xb_ld(&bar[XB_XGEN(b.x)]) == gen, bar);
            __builtin_amdgcn_fence(__ATOMIC_ACQUIRE, "agent");
            asm volatile("s_waitcnt vmcnt(0)" ::: "memory");
        }
    }
    __syncthreads();
}

struct Frame {
    LAS unsigned char* lds;
    __device__ __forceinline__ int wave_() const { int w = __builtin_amdgcn_readfirstlane((int)threadIdx.x >> 6); asm volatile("" : "+s"(w)); return w; }
    __device__ __forceinline__ int G_() const { int g = (int)gridDim.x; asm volatile("" : "+s"(g)); return g; }
    __device__ __forceinline__ int vcu_() const { int bx = (int)blockIdx.x; asm volatile("" : "+s"(bx)); const int g = G_(); return (g % 8 == 0) ? (bx % 8) * (g / 8) + bx / 8 : bx; }
    __device__ __forceinline__ int tid() const { int t = (int)threadIdx.x; asm volatile("" : "+v"(t)); return t; }
    __device__ __forceinline__ int lane() const { return tid() & 63; }
    __device__ __forceinline__ unsigned long long raw(int k) const { const volatile LAS unsigned* p = (const volatile LAS unsigned*)(lds + RING_BYTES) + 2 * k;
        const unsigned lo = __builtin_amdgcn_readfirstlane(p[0]), hi = __builtin_amdgcn_readfirstlane(p[1]); return ((unsigned long long)hi << 32) | lo; }
    __device__ __forceinline__ const float* in(int k) const { return (const float*)(const GAS float*)raw(k); }
    __device__ __forceinline__ float* outp() const { return (float*)(GAS float*)raw(22); }
    template <class T> __device__ __forceinline__ T* ws(size_t off) const { return (T*)(GAS T*)((GAS unsigned char*)raw(23) + off); }
};
enum { I_X = 0, I_WIN, I_BGLU, I_CONVW, I_CONVB, I_CLNG, I_CLNB, I_LQ1, I_LK1, I_LQ2, I_LK2, I_SUBLN, I_RELB, I_WOUT, I_LN1G, I_LN1B, I_WQ, I_KEYS, I_U, I_V, I_LN2G, I_LN2B };

template <int CTRL> __device__ __forceinline__ int dppi(int v) { return __builtin_amdgcn_update_dpp(0, v, CTRL, 0xf, 0xf, true); }
template <int CTRL> __device__ __forceinline__ float dppf(float v) { return __int_as_float(__builtin_amdgcn_update_dpp(0, __float_as_int(v), CTRL, 0xf, 0xf, true)); }
__device__ __forceinline__ unsigned pack_i8x4(float a, float b, float c, float d) {
    const int ia = (int)rintf(a), ib = (int)rintf(b), ic = (int)rintf(c), id = (int)rintf(d); return (unsigned)(ia & 255) | ((unsigned)(ib & 255) << 8) | ((unsigned)(ic & 255) << 16) | ((unsigned)id << 24); }
__device__ __forceinline__ void p0_colmax_item(const float* W, int N, unsigned* cmax, int k0, int n0, int dst0, int lane) {
    f32x4 am = {0.f, 0.f, 0.f, 0.f};
#pragma unroll
    for (int i = 0; i < 8; ++i) { const f32x4 v = *(const GAS f32x4*)(W + (size_t)(k0 + 8 * i + (lane >> 3)) * N + n0 + 4 * (lane & 7));
        am[0] = fmaxf(am[0], fabsf(v[0])); am[1] = fmaxf(am[1], fabsf(v[1])); am[2] = fmaxf(am[2], fabsf(v[2])); am[3] = fmaxf(am[3], fabsf(v[3])); }
#pragma unroll
    for (int e = 0; e < 4; ++e) { am[e] = fmaxf(am[e], __shfl_xor(am[e], 8)); am[e] = fmaxf(am[e], __shfl_xor(am[e], 16)); am[e] = fmaxf(am[e], __shfl_xor(am[e], 32)); }
    if (lane < 8) {
#pragma unroll
        for (int e = 0; e < 4; ++e) atomicMax(cmax + dst0 + 4 * lane + e, __float_as_uint(am[e])); }
}
__device__ __forceinline__ void p0_quant_item(const float* W, int N, unsigned char* WT8, const unsigned* cmax, float* scale, int k0, int n0, int dst0, LAS float* scr, int lane) {
#pragma unroll
    for (int i = 0; i < 8; ++i) { const int kk = 8 * i + (lane >> 3); const f32x4 v = *(const GAS f32x4*)(W + (size_t)(k0 + kk) * N + n0 + 4 * (lane & 7));
        LAS float* d = scr + kk * 33 + 4 * (lane & 7); d[0] = v[0]; d[1] = v[1]; d[2] = v[2]; d[3] = v[3]; }
    if (lane < 32) { const float am = __uint_as_float(__hip_atomic_load(cmax + dst0 + lane, __ATOMIC_RELAXED, __HIP_MEMORY_SCOPE_AGENT)); const float sc = am > 0.f ? am * (1.f / 127.f) : 1.f;
        scr[64 * 33 + lane] = 1.f / sc; if (k0 == 0) scale[dst0 + lane] = sc; }
    LDS_WAIT(); asm volatile("" ::: "memory");
    const int c = lane & 7;
#pragma unroll
    for (int j = 0; j < 4; ++j) { const int n = (lane >> 3) + 8 * j; const LAS float* sp = scr + (8 * c) * 33 + n; const float inv = scr[64 * 33 + n];
        *(GAS v2u*)(WT8 + (size_t)(dst0 + n) * D + k0 + 8 * c) = (v2u){pack_i8x4(sp[0 * 33] * inv, sp[1 * 33] * inv, sp[2 * 33] * inv, sp[3 * 33] * inv), pack_i8x4(sp[4 * 33] * inv, sp[5 * 33] * inv, sp[6 * 33] * inv, sp[7 * 33] * inv)}; }
    LDS_WAIT(); asm volatile("" ::: "memory");
}
__device__ __forceinline__ int glu_dst(int n0) {
    if (n0 < 3072) return n0;
    const int ch = (n0 - 3072) & 1023, gate = (n0 - 3072) >> 10; return 3072 + 256 * (ch >> 7) + 64 * ((ch & 127) >> 5) + 32 * gate + (ch & 31);
}
__device__ __forceinline__ void p0_quant_x(const float* src, unsigned char* dst8, float* scale, int rows, int gw, int NGW, int lane) {
    f32x4 nx[8], nx2[8];
    if (gw < rows) { const GAS f32x4* sp = (const GAS f32x4*)(src + (size_t)gw * D) + lane; const int r1 = (gw + NGW < rows) ? gw + NGW : gw; const GAS f32x4* sq = (const GAS f32x4*)(src + (size_t)r1 * D) + lane;
#pragma unroll
        for (int j = 0; j < 8; ++j) { nx[j] = sp[64 * j]; nx2[j] = sq[64 * j]; } }
    for (int r = gw; r < rows; r += NGW) {
        f32x4 v[8]; float am = 0.f;
#pragma unroll
        for (int j = 0; j < 8; ++j) { v[j] = nx[j]; nx[j] = nx2[j]; }
        { const int rn = (r + 2 * NGW < rows) ? r + 2 * NGW : r; const GAS f32x4* sp = (const GAS f32x4*)(src + (size_t)rn * D) + lane;
#pragma unroll
          for (int j = 0; j < 8; ++j) nx2[j] = sp[64 * j]; }
#pragma unroll
        for (int j = 0; j < 8; ++j) am = fmaxf(fmaxf(am, fmaxf(fabsf(v[j].x), fabsf(v[j].y))), fmaxf(fabsf(v[j].z), fabsf(v[j].w)));
        am = wave_max(am);
        const float sc = am > 0.f ? am * (1.f / 127.f) : 1.f, inv = 1.f / sc;
        GAS unsigned* dp = (GAS unsigned*)(dst8 + (size_t)r * D) + lane;
#pragma unroll
        for (int j = 0; j < 8; ++j) dp[64 * j] = pack_i8x4(v[j].x * inv, v[j].y * inv, v[j].z * inv, v[j].w * inv);
        if (lane == 0) scale[r] = sc;
    }
}
__device__ __forceinline__ void p0_convert(const float* src, bf16* dst, size_t n, int gw, int NGW, int lane) {
    const size_t nit = n / 512;
    for (size_t it = gw; it < nit; it += NGW) { const GAS f32x4* s = (const GAS f32x4*)(src + it * 512) + 2 * lane; const f32x4 a = s[0], b = s[1];
        v4u o; o.x = pk2(a.x, a.y); o.y = pk2(a.z, a.w); o.z = pk2(b.x, b.y); o.w = pk2(b.z, b.w); *((GAS v4u*)(dst + it * 512) + lane) = o; }
}
__device__ __forceinline__ void p0_convert_keys(const float* src, bf16* dst, int gw, int NGW, int lane) {
    constexpr int NFRAG = PH * 2 * (PNK / 32) * (PHALF / 16);
    for (int f = gw; f < NFRAG; f += NGW) { const int hc = f >> 5, mt = (f >> 3) & 3, sidx = f & 7;
        const GAS f32x4* sp = (const GAS f32x4*)(src + ((size_t)hc * PNK + 32 * mt + (lane & 31)) * PHALF + 16 * sidx + 8 * (lane >> 5)); const f32x4 a = sp[0], b = sp[1];
        v4u o; o.x = pk2(a.x, a.y); o.y = pk2(a.z, a.w); o.z = pk2(b.x, b.y); o.w = pk2(b.z, b.w); *((GAS v4u*)(dst + (size_t)f * 512) + lane) = o; }
}
template <bool INT8> __device__ __forceinline__ void p0_quant_rows(const float* src, unsigned* dst8, float* scale, int rows, int gw, int NGW, int lane) {
    f32x4 nx[8], nx2[8];
    if (gw < rows) { const GAS f32x4* sp = (const GAS f32x4*)(src + (size_t)gw * D) + lane; const int r1 = (gw + NGW < rows) ? gw + NGW : gw; const GAS f32x4* sq = (const GAS f32x4*)(src + (size_t)r1 * D) + lane;
#pragma unroll
        for (int j = 0; j < 8; ++j) { nx[j] = sp[64 * j]; nx2[j] = sq[64 * j]; } }
    for (int r = gw; r < rows; r += NGW) {
        f32x4 v[8]; float am = 0.f;
#pragma unroll
        for (int j = 0; j < 8; ++j) { v[j] = nx[j]; nx[j] = nx2[j]; }
        { const int rn = (r + 2 * NGW < rows) ? r + 2 * NGW : r; const GAS f32x4* sp = (const GAS f32x4*)(src + (size_t)rn * D) + lane;
#pragma unroll
          for (int j = 0; j < 8; ++j) nx2[j] = sp[64 * j]; }
#pragma unroll
        for (int j = 0; j < 8; ++j) am = fmaxf(fmaxf(am, fmaxf(fabsf(v[j].x), fabsf(v[j].y))), fmaxf(fabsf(v[j].z), fabsf(v[j].w)));
        am = wave_max(am);
        const float sc = am > 0.f ? am * (INT8 ? (1.f / 127.f) : (1.f / 440.f)) : 1.f, inv = 1.f / sc;
#pragma unroll
        for (int j = 0; j < 8; ++j) { int w;
            if (INT8) w = (int)pack_i8x4(v[j].x * inv, v[j].y * inv, v[j].z * inv, v[j].w * inv);
            else { w = __builtin_amdgcn_cvt_pk_fp8_f32(v[j].x * inv, v[j].y * inv, 0, false); w = __builtin_amdgcn_cvt_pk_fp8_f32(v[j].z * inv, v[j].w * inv, w, true); }
            const int wi = lane + 64 * j, c = wi >> 5; *((GAS unsigned*)dst8 + ((size_t)c * rows + r) * 32 + (wi & 31)) = (unsigned)w; }
        if (lane == 0) scale[r] = sc;
    }
}
template <bool HI2C  > __device__ __forceinline__ void p0_quant_u4(const float* src, unsigned* dst4, float* scale, float* nsum  , int rows, int gw, int NGW, int lane) {
    f32x4 nx[8], nx2[8];
    if (gw < rows) { const GAS f32x4* sp = (const GAS f32x4*)(src + (size_t)gw * D) + lane; const int r1 = (gw + NGW < rows) ? gw + NGW : gw; const GAS f32x4* sq = (const GAS f32x4*)(src + (size_t)r1 * D) + lane;
#pragma unroll
        for (int j = 0; j < 8; ++j) { nx[j] = sp[64 * j]; nx2[j] = sq[64 * j]; } }
    for (int r = gw; r < rows; r += NGW) {
        f32x4 v[8]; float ss = 0.f;
#pragma unroll
        for (int j = 0; j < 8; ++j) { v[j] = nx[j]; nx[j] = nx2[j]; }
        { const int rn = (r + 2 * NGW < rows) ? r + 2 * NGW : r; const GAS f32x4* sp = (const GAS f32x4*)(src + (size_t)rn * D) + lane;
#pragma unroll
          for (int j = 0; j < 8; ++j) nx2[j] = sp[64 * j]; }
#pragma unroll
        for (int j = 0; j < 8; ++j) ss += (v[j].x * v[j].x + v[j].y * v[j].y) + (v[j].z * v[j].z + v[j].w * v[j].w);
        ss = wave_sum(ss);
        const float sc = ss > 0.f ? 0.35f * sqrtf(ss * (1.f / D)) : 1.f, inv = 1.f / sc;
        int nsl = 0;
#pragma unroll
        for (int j = 0; j < 8; ++j) { unsigned own = 0, snd = 0;
#pragma unroll
            for (int e = 0; e < 4; ++e) { const int q = (int)fminf(fmaxf(rintf(v[j][e] * inv), -8.f), 7.f); own |= (unsigned)(q + 8) << (8 * e); snd |= (unsigned)(HI2C ? (q & 15) : (q + 8)) << (8 * e); nsl += q + 8; }
            const unsigned nbr = (unsigned)dppi<0xB1>((int)snd);
            if ((lane & 1) == 0) *((GAS unsigned*)dst4 + ((size_t)j * rows + r) * 32 + (lane >> 1)) = own | (nbr << 4); }
        if (nsum) { const float ns = wave_sum((float)nsl); if (lane == 0) nsum[r] = ns; }
        if (lane == 0) scale[r] = sc;
    }
}
__device__ __forceinline__ int t5_bucket(int d) {
    if (d < 16) return d;
    int l = 16 + (int)(logf((float)d / 16.f) / logf(8.f) * 16.f); return l < 31 ? l : 31;
}
__device__ __forceinline__ void p0a_prologue(Frame& F) {
    LAS float* scr = (LAS float*)(F.lds + F.wave_() * 16384);
    constexpr int I_IN = (D / 64) * (NPROJ / 32), I_OUT = (D / 64) * (D / 32);
    { const float* w_in = F.in(I_WIN); unsigned* cmax = F.ws<unsigned>(WS_CMAX); const int gw = F.vcu_() * NWAVES + F.wave_(), NGW = F.G_() * NWAVES;
      for (int r = gw; r < I_IN; r += NGW) { const int nblk = NPROJ / 32, kb = r / nblk, nb = r % nblk; p0_colmax_item(w_in, NPROJ, cmax, 64 * kb, 32 * nb, glu_dst(32 * nb), F.lane()); } }
    { const float* wq = F.in(I_WQ); unsigned* cmax = F.ws<unsigned>(WS_CMAX) + NPROJ; const int gw = F.vcu_() * NWAVES + F.wave_(), NGW = F.G_() * NWAVES;
      for (int r = gw; r < I_OUT; r += NGW) { const int nblk = D / 32, kb = r / nblk, nb = r % nblk; p0_colmax_item(wq, D, cmax, 64 * kb, 32 * nb, 32 * nb, F.lane()); } }
    { const float* wo = F.in(I_WOUT); unsigned* cmax = F.ws<unsigned>(WS_CMAX) + NPROJ + D; const int gw = F.vcu_() * NWAVES + F.wave_(), NGW = F.G_() * NWAVES;
      for (int r = gw; r < I_OUT; r += NGW) { const int nblk = D / 32, kb = r / nblk, nb = r % nblk; p0_colmax_item(wo, D, cmax, 64 * kb, 32 * nb, 32 * nb, F.lane()); } }
}
__device__ __forceinline__ void p0b_prologue(Frame& F) {
    LAS float* scr = (LAS float*)(F.lds + F.wave_() * 16384);
    constexpr int I_IN = (D / 64) * (NPROJ / 32), I_OUT = (D / 64) * (D / 32);
    { const float* w_in = F.in(I_WIN); unsigned char* W8 = F.ws<unsigned char>(WS_WIN); const unsigned* cmax = F.ws<unsigned>(WS_CMAX); float* sw = F.ws<float>(WS_SWIN); const int gw = F.vcu_() * NWAVES + F.wave_(), NGW = F.G_() * NWAVES;
      for (int r = gw; r < I_IN; r += NGW) { const int nblk = NPROJ / 32, kb = r / nblk, nb = r % nblk; p0_quant_item(w_in, NPROJ, W8, cmax, sw, 64 * kb, 32 * nb, glu_dst(32 * nb), scr, F.lane()); } }
    { const float* wq = F.in(I_WQ); unsigned char* W8 = F.ws<unsigned char>(WS_WQ); const unsigned* cmax = F.ws<unsigned>(WS_CMAX) + NPROJ; float* sw = F.ws<float>(WS_SWQ); const int gw = F.vcu_() * NWAVES + F.wave_(), NGW = F.G_() * NWAVES;
      for (int r = gw; r < I_OUT; r += NGW) { const int nblk = D / 32, kb = r / nblk, nb = r % nblk; p0_quant_item(wq, D, W8, cmax, sw, 64 * kb, 32 * nb, 32 * nb, scr, F.lane()); } }
    { const float* wo = F.in(I_WOUT); unsigned char* W8 = F.ws<unsigned char>(WS_WOUT); const unsigned* cmax = F.ws<unsigned>(WS_CMAX) + NPROJ + D; float* sw = F.ws<float>(WS_SWOUT); const int gw = F.vcu_() * NWAVES + F.wave_(), NGW = F.G_() * NWAVES;
      for (int r = gw; r < I_OUT; r += NGW) { const int nblk = D / 32, kb = r / nblk, nb = r % nblk; p0_quant_item(wo, D, W8, cmax, sw, 64 * kb, 32 * nb, 32 * nb, scr, F.lane()); } }
    { const int gw = F.vcu_() * NWAVES + F.wave_(), NGW = F.G_() * NWAVES; p0_quant_x(F.in(I_X), F.ws<unsigned char>(WS_XB), F.ws<float>(WS_SXA), M, gw, NGW, F.lane()); }
    { const int gw = F.vcu_() * NWAVES + F.wave_(), NGW = F.G_() * NWAVES; p0_quant_u4<false>(F.in(I_U), F.ws<unsigned>(WS_U8), F.ws<float>(WS_SU), F.ws<float>(WS_NSU), NEXP, gw, NGW, F.lane()); }
    { const int gw = F.vcu_() * NWAVES + F.wave_(), NGW = F.G_() * NWAVES; p0_quant_u4<true>(F.in(I_V), F.ws<unsigned>(WS_V8), F.ws<float>(WS_SV), nullptr, NEXP, gw, NGW, F.lane()); }
    { const int gw = F.vcu_() * NWAVES + F.wave_(), NGW = F.G_() * NWAVES; p0_convert_keys(F.in(I_KEYS), F.ws<bf16>(WS_KEYS), gw, NGW, F.lane()); }
    if (blockIdx.x == 0) { const float* rel_bias = F.in(I_RELB); float* TAB = F.ws<float>(WS_TAB);
        for (int i = F.tid(); i < 8 * 128; i += NWAVES * 64) { const int h = i >> 7, d = i & 127;
            TAB[i] = (rel_bias[t5_bucket(d) * 8 + h] - rel_bias[31 * 8 + h]) * 1.4426950408889634f; } }
}

__device__ __forceinline__ float diff_lambda(Frame& F) {
    const float a = wave_sum(F.in(I_LQ1)[F.lane()] * F.in(I_LK1)[F.lane()]), b = wave_sum(F.in(I_LQ2)[F.lane()] * F.in(I_LK2)[F.lane()]);
    return expf(a) - expf(b) + LAMBDA_INIT;
}
template <int CTRL, int RM> __device__ __forceinline__ float dpp_rm(float old, float v) { return __int_as_float(__builtin_amdgcn_update_dpp(__float_as_int(old), __float_as_int(v), CTRL, RM, 0xf, false)); }
__device__ __forceinline__ float wave_sum63(float v) {
    v += dppf<0xB1>(v); v += dppf<0x4E>(v); v += dppf<0x141>(v); v += dppf<0x140>(v);
    v += dpp_rm<0x142, 0xa>(0.f, v);
    v += dpp_rm<0x143, 0xc>(0.f, v);
    return v;
}
__device__ __forceinline__ float wave_max63(float v) {
    v = fmaxf(v, dppf<0xB1>(v)); v = fmaxf(v, dppf<0x4E>(v)); v = fmaxf(v, dppf<0x141>(v)); v = fmaxf(v, dppf<0x140>(v));
    v = fmaxf(v, dpp_rm<0x142, 0xa>(0.f, v)); v = fmaxf(v, dpp_rm<0x143, 0xc>(0.f, v));
    return v;
}
__device__ __forceinline__ float wave_sum(float v) { return __int_as_float(__builtin_amdgcn_readlane(__float_as_int(wave_sum63(v)), 63)); }
__device__ __forceinline__ float wave_max(float v) { return __int_as_float(__builtin_amdgcn_readlane(__float_as_int(wave_max63(v)), 63)); }
typedef _Float16 h2_t __attribute__((ext_vector_type(2)));
__device__ __forceinline__ h2_t pin_h2(float a, float b) { unsigned u = __builtin_bit_cast(unsigned, (h2_t){(_Float16)a, (_Float16)b}); asm volatile("" : "+v"(u)); return __builtin_bit_cast(h2_t, u); }
__device__ __forceinline__ float xr_swap32(float a, float b, bool mx) { auto rr = __builtin_amdgcn_permlane32_swap(__float_as_uint(a), __float_as_uint(b), false, false); const float x = __uint_as_float(rr[0]), y = __uint_as_float(rr[1]); return mx ? fmaxf(x, y) : x + y; }
__device__ __forceinline__ float xr_swap16(float a, float b, bool mx) { auto rr = __builtin_amdgcn_permlane16_swap(__float_as_uint(a), __float_as_uint(b), false, false); const float x = __uint_as_float(rr[0]), y = __uint_as_float(rr[1]); return mx ? fmaxf(x, y) : x + y; }
template <int CTRL> __device__ __forceinline__ float xr_dpp(float lo, float hi, bool t, bool mx) { const float k = t ? hi : lo, s = t ? lo : hi, o = dppf<CTRL>(s); return mx ? fmaxf(k, o) : k + o; }
__device__ __forceinline__ float xred64_sum(const float (&v)[64], int lane) {
    float a[32], b[16], c[8], d[4], e[2];
#pragma unroll
    for (int i = 0; i < 32; ++i) a[i] = xr_swap32(v[i], v[i + 32], false);
#pragma unroll
    for (int i = 0; i < 16; ++i) b[i] = xr_swap16(a[i], a[i + 16], false);
#pragma unroll
    for (int i = 0; i < 8; ++i) c[i] = xr_dpp<0x128>(b[i], b[i + 8], lane & 8, false);
#pragma unroll
    for (int i = 0; i < 4; ++i) d[i] = xr_dpp<0x141>(c[i], c[i + 4], lane & 4, false);
#pragma unroll
    for (int i = 0; i < 2; ++i) e[i] = xr_dpp<0x4E>(d[i], d[i + 2], lane & 2, false);
    return xr_dpp<0xB1>(e[0], e[1], lane & 1, false);
}
__device__ __forceinline__ float xred32_max(const float (&v)[32], int lane) {
    float a[16], b[8], c[4], d[2];
#pragma unroll
    for (int i = 0; i < 16; ++i) a[i] = xr_swap32(v[i], v[i + 16], true);
#pragma unroll
    for (int i = 0; i < 8; ++i) b[i] = xr_swap16(a[i], a[i + 8], true);
#pragma unroll
    for (int i = 0; i < 4; ++i) c[i] = xr_dpp<0x128>(b[i], b[i + 4], lane & 8, true);
#pragma unroll
    for (int i = 0; i < 2; ++i) d[i] = xr_dpp<0x141>(c[i], c[i + 2], lane & 4, true);
    const float e = xr_dpp<0x4E>(d[0], d[1], lane & 2, true);
    return fmaxf(e, dppf<0xB1>(e));
}
#ifndef P3_PROBE_MULT
#define P3_PROBE_MULT 1
#endif
__device__ __forceinline__ void p3_mix(Frame& F) {
    constexpr int TT = 32, NH = TT + CONVW - 1, STG_OFF = 0, STATS_OFF = TT * 1024, AMC_OFF = STATS_OFF + NWAVES * 64 * 4, AMA_OFF = AMC_OFF + TT * NWAVES * 4, MS_OFF = AMA_OFF + 128, INV_OFF = MS_OFF + 256, AVP_OFF = 40960;
    static_assert(INV_OFF + 128 <= AVP_OFF && AVP_OFF + 8 * NWAVES * 64 * 16 <= RING_BYTES && NH == 62, "P3 LDS map");
    const int tid = F.tid(), lane = tid & 63, wave = F.wave_();
    const float lam = diff_lambda(F);
    const float* conv_w = F.in(I_CONVW); const unsigned* H = F.ws<unsigned>(WS_H); const bf16* O1 = F.ws<bf16>(WS_O1); const bf16* O2 = F.ws<bf16>(WS_O2);
    unsigned char* MIX8 = F.ws<unsigned char>(WS_XB); float* SM = F.ws<float>(WS_SM); const float* subln_g = F.in(I_SUBLN);
    const float2 cb = *(const float2*)(F.in(I_CONVB) + 2 * tid), lg = *(const float2*)(F.in(I_CLNG) + 2 * tid), lb = *(const float2*)(F.in(I_CLNB) + 2 * tid);
    LAS float* stats = (LAS float*)(F.lds + STATS_OFF); LAS float* amc = (LAS float*)(F.lds + AMC_OFF); LAS float* ama = (LAS float*)(F.lds + AMA_OFF); LAS float* ms = (LAS float*)(F.lds + MS_OFF); LAS float* invs = (LAS float*)(F.lds + INV_OFF);
    h2_t wk[CONVW];
#pragma unroll
    for (int k = 0; k < CONVW; ++k) { const float2 wf = *(const float2*)(conv_w + k * DCONV + 2 * tid); wk[k] = pin_h2(wf.x, wf.y); }
    const h2_t cbh = pin_h2(cb.x, cb.y);
    unsigned hv[NH];
#define P3_LOAD_H(tile_) do { const int t0_ = (tile_) * TT; const GAS unsigned* hp_ = (const GAS unsigned*)H + (size_t)t0_ * (DCONV / 2) + tid;     \
        _Pragma("unroll") for (int j = 0; j < NH; ++j) hv[j] = *(hp_ + (ptrdiff_t)(j - (CONVW - 1)) * (DCONV / 2)); } while (0)
    { const int ft = F.vcu_() < M / TT ? F.vcu_() : 0; P3_LOAD_H(ft); }
    for (int tile_j = F.vcu_(); tile_j < P3_PROBE_MULT * (M / TT); tile_j += F.G_()) { const int tile_i = tile_j & (M / TT - 1);
        const int t0 = tile_i * TT;
        const int tid = F.tid(), lane = tid & 63;
        v4u oa[4][2], ob[4][2];
#pragma unroll
        for (int rr = 0; rr < 4; ++rr) { const int m = t0 + 4 * wave + rr;
            const GAS char* p1 = (const GAS char*)(O1 + (size_t)m * 1024); const GAS char* p2 = (const GAS char*)(O2 + (size_t)m * 1024); const unsigned lo_ = (unsigned)lane * 32u;
            oa[rr][0] = *(const GAS v4u*)(p1 + lo_); oa[rr][1] = *(const GAS v4u*)(p1 + lo_ + 16); ob[rr][0] = *(const GAS v4u*)(p2 + lo_); ob[rr][1] = *(const GAS v4u*)(p2 + lo_ + 16); }
        __builtin_amdgcn_sched_barrier(0);
        h2_t cv[TT];
        { const unsigned zm = (t0 & (SEQ - 1)) != 0 ? 0xffffffffu : 0u;
#pragma unroll
          for (int j = 0; j < CONVW - 1; ++j) hv[j] &= zm; }
#pragma unroll
        for (int t = 0; t < TT; ++t) { h2_t acc = cbh;
#pragma unroll
            for (int k = 0; k < CONVW; ++k) acc = __builtin_elementwise_fma(__builtin_bit_cast(h2_t, hv[t + k]), wk[k], acc);
            { unsigned u_ = __builtin_bit_cast(unsigned, acc); asm volatile("" : "+v"(u_)); cv[t] = __builtin_bit_cast(h2_t, u_); } }
        __builtin_amdgcn_sched_barrier(0);
#pragma unroll
        for (int rr = 0; rr < 4; ++rr) { float av[16]; h2_t avp[8];
            const v4u a0 = oa[rr][0], a1 = oa[rr][1], b0 = ob[rr][0], b1 = ob[rr][1];
            const unsigned aw[8] = {a0.x, a0.y, a0.z, a0.w, a1.x, a1.y, a1.z, a1.w}, bw[8] = {b0.x, b0.y, b0.z, b0.w, b1.x, b1.y, b1.z, b1.w};
            float ss = 0.f;
#pragma unroll
            for (int i = 0; i < 8; ++i) { av[2 * i] = bflo(aw[i]) - lam * bflo(bw[i]); av[2 * i + 1] = bfhi(aw[i]) - lam * bfhi(bw[i]); ss += av[2 * i] * av[2 * i] + av[2 * i + 1] * av[2 * i + 1]; }
            ss += dppf<0xB1>(ss); ss += dppf<0x4E>(ss); ss += dppf<0x141>(ss);
            const float r = (1.f - LAMBDA_INIT) / sqrtf(ss * (1.f / 128.f) + LN_EPS); float am = 0.f;
#pragma unroll
            for (int e = 0; e < 8; ++e) { avp[e] = pin_h2(av[2 * e] * r * subln_g[16 * (lane & 7) + 2 * e], av[2 * e + 1] * r * subln_g[16 * (lane & 7) + 2 * e + 1]);
                am = fmaxf(am, fmaxf(fabsf((float)avp[e].x), fabsf((float)avp[e].y))); }
            am = wave_max63(am);
            if (lane == 63) ama[4 * wave + rr] = am;
#pragma unroll
            for (int hh = 0; hh < 2; ++hh) *(LAS v4u*)(F.lds + AVP_OFF + ((rr * 2 + hh) * (NWAVES * 64) + tid) * 16) = (v4u){__builtin_bit_cast(unsigned, avp[4 * hh]), __builtin_bit_cast(unsigned, avp[4 * hh + 1]), __builtin_bit_cast(unsigned, avp[4 * hh + 2]), __builtin_bit_cast(unsigned, avp[4 * hh + 3])}; }
        { float sv[64];
#pragma unroll
          for (int t = 0; t < TT; ++t) { const float y0 = (float)cv[t].x, y1 = (float)cv[t].y; sv[2 * t] = y0 + y1; sv[2 * t + 1] = y0 * y0 + y1 * y1; }
          stats[wave * 64 + lane] = xred64_sum(sv, lane); }
        __builtin_amdgcn_sched_barrier(0);
        { const int nx_ = tile_j + F.G_(), nxt = nx_ < P3_PROBE_MULT * (M / TT) ? (nx_ & (M / TT - 1)) : tile_i; P3_LOAD_H(nxt); }
        __syncthreads();
        if (tid < TT) { float s = 0.f, q = 0.f;
#pragma unroll
            for (int w = 0; w < NWAVES; ++w) { s += stats[w * 64 + 2 * tid]; q += stats[w * 64 + 2 * tid + 1]; }
            const float mean = s * (1.f / DCONV), var = fmaxf(q * (1.f / DCONV) - mean * mean, 0.f); ms[2 * tid] = mean; ms[2 * tid + 1] = 1.f / sqrtf(var + LN_EPS); }
        __syncthreads();
        {
            float mv[TT];
#pragma unroll
            for (int q = 0; q < TT / 2; ++q) { const f32x4 st = *(const LAS f32x4*)(ms + 4 * q);
#pragma unroll
                for (int o = 0; o < 2; ++o) { const int t = 2 * q + o; const float mean = st[2 * o], rstd = st[2 * o + 1];
                    const float y0 = ((float)cv[t].x - mean) * rstd * lg.x + lb.x, y1 = ((float)cv[t].y - mean) * rstd * lg.y + lb.y;
#define SWISH_(y) ((y) * __builtin_amdgcn_rcpf(1.f + __builtin_amdgcn_exp2f(-1.4426950409f * (y))))
                    cv[t] = pin_h2(SWISH_(y0), SWISH_(y1));
#undef SWISH_
                    mv[t] = fmaxf(fabsf((float)cv[t].x), fabsf((float)cv[t].y)); } }
            const float amx = xred32_max(mv, lane);
            if ((lane & 1) == 0) amc[(lane >> 1) * NWAVES + wave] = amx; }
        __syncthreads();
        if (tid < TT) { float am = ama[tid];
#pragma unroll
            for (int w = 0; w < NWAVES; ++w) am = fmaxf(am, amc[tid * NWAVES + w]);
            const float sc = am > 0.f ? am * (1.f / 127.f) : 1.f; const _Float16 ih = (_Float16)(1.f / sc);
            ((LAS unsigned*)invs)[tid] = __builtin_bit_cast(unsigned, (h2_t){ih, ih}); SM[t0 + tid] = 1.f / (float)ih; }
        __syncthreads();
        const h2_t K1536 = (h2_t){(_Float16)1536.f, (_Float16)1536.f};
#pragma unroll
        for (int q = 0; q < TT / 4; ++q) { const v4u iv = *(const LAS v4u*)((LAS unsigned*)invs + 4 * q);
            const unsigned ivw[4] = {iv.x, iv.y, iv.z, iv.w};
#pragma unroll
            for (int o = 0; o < 4; ++o) { const int t = 4 * q + o; const unsigned r = __builtin_bit_cast(unsigned, __builtin_elementwise_fma(cv[t], __builtin_bit_cast(h2_t, ivw[o]), K1536));
                *(LAS unsigned short*)(F.lds + STG_OFF + t * 1024 + 2 * tid) = (unsigned short)__builtin_amdgcn_perm(0u, r, 0x0c0c0200u); } }
#pragma unroll
        for (int rr = 0; rr < 4; ++rr) { const h2_t ivh = __builtin_bit_cast(h2_t, ((LAS unsigned*)invs)[4 * wave + rr]);
            const v4u pa_ = *(const LAS v4u*)(F.lds + AVP_OFF + ((rr * 2) * (NWAVES * 64) + tid) * 16), pb_ = *(const LAS v4u*)(F.lds + AVP_OFF + ((rr * 2 + 1) * (NWAVES * 64) + tid) * 16);
            const unsigned pw_[8] = {pa_.x, pa_.y, pa_.z, pa_.w, pb_.x, pb_.y, pb_.z, pb_.w}; unsigned rq[8];
#pragma unroll
            for (int e = 0; e < 8; ++e) rq[e] = __builtin_bit_cast(unsigned, __builtin_elementwise_fma(__builtin_bit_cast(h2_t, pw_[e]), ivh, K1536));
            *((GAS v4u*)(MIX8 + (size_t)(t0 + 4 * wave + rr) * D) + lane) = (v4u){__builtin_amdgcn_perm(rq[1], rq[0], 0x06040200u), __builtin_amdgcn_perm(rq[3], rq[2], 0x06040200u), __builtin_amdgcn_perm(rq[5], rq[4], 0x06040200u), __builtin_amdgcn_perm(rq[7], rq[6], 0x06040200u)}; }
        __syncthreads();
        for (int idx = tid; idx < TT * 64; idx += NWAVES * 64) { const int row = idx >> 6, ch = idx & 63;
            *((GAS v4u*)(MIX8 + (size_t)(t0 + row) * D + DATT) + ch) = *(const LAS v4u*)(F.lds + STG_OFF + row * 1024 + ch * 16); }
        __syncthreads();
    }
}
#undef P3_LOAD_H
__device__ __forceinline__ void p5_ln1(Frame& F) {
    const bf16* Y1 = F.ws<bf16>(WS_Y1); const float* ln1_g = F.in(I_LN1G); const float* ln1_b = F.in(I_LN1B); unsigned char* X8 = F.ws<unsigned char>(WS_X8); float* SX = F.ws<float>(WS_SX); float* LNS = F.ws<float>(WS_LNS); float* SXQ = F.ws<float>(WS_SXQ); unsigned char* XH = F.ws<unsigned char>(WS_XH); unsigned char* XL = F.ws<unsigned char>(WS_XL);
    const int gw = F.vcu_() * NWAVES + F.wave_(), NGW = F.G_() * NWAVES, lane = F.lane();
    v4u nx[4];
    if (gw < M) { const GAS v4u* p = (const GAS v4u*)(Y1 + (size_t)gw * D) + lane;
#pragma unroll
        for (int j = 0; j < 4; ++j) nx[j] = p[64 * j]; }
    for (int m = gw; m < M; m += NGW) {
        v4u w[4]; float v[32]; float s = 0.f;
#pragma unroll
        for (int j = 0; j < 4; ++j) w[j] = nx[j];
        { const int mn = (m + NGW < M) ? m + NGW : m; const GAS v4u* p = (const GAS v4u*)(Y1 + (size_t)mn * D) + lane;
#pragma unroll
          for (int j = 0; j < 4; ++j) nx[j] = p[64 * j]; }
#pragma unroll
        for (int j = 0; j < 4; ++j) { const unsigned ww[4] = {w[j].x, w[j].y, w[j].z, w[j].w};
#pragma unroll
            for (int i = 0; i < 4; ++i) { v[8 * j + 2 * i] = bflo(ww[i]); v[8 * j + 2 * i + 1] = bfhi(ww[i]); s += v[8 * j + 2 * i] + v[8 * j + 2 * i + 1]; } }
        const float mean = wave_sum(s) * (1.f / D); float q = 0.f;
#pragma unroll
        for (int i = 0; i < 32; ++i) { v[i] -= mean; q += v[i] * v[i]; }
        const float rstd = 1.f / sqrtf(wave_sum(q) * (1.f / D) + LN_EPS);
        float am = 0.f;
#pragma unroll
        for (int j = 0; j < 4; ++j) { const int c0 = 8 * lane + 512 * j; const f32x4 g0 = *(const f32x4*)(ln1_g + c0), g1 = *(const f32x4*)(ln1_g + c0 + 4), b0 = *(const f32x4*)(ln1_b + c0), b1 = *(const f32x4*)(ln1_b + c0 + 4);
#pragma unroll
            for (int i = 0; i < 4; ++i) { v[8 * j + i] = v[8 * j + i] * rstd * g0[i] + b0[i]; v[8 * j + 4 + i] = v[8 * j + 4 + i] * rstd * g1[i] + b1[i]; am = fmaxf(am, fmaxf(fabsf(v[8 * j + i]), fabsf(v[8 * j + 4 + i]))); } }
        am = wave_max(am);
        const float sc = am > 0.f ? am * (1.f / 127.f) : 1.f, inv = 1.f / sc;
        GAS v2u* p8 = (GAS v2u*)(X8 + (size_t)m * D) + lane;
#pragma unroll
        for (int j = 0; j < 4; ++j) p8[64 * j] = (v2u){pack_i8x4(v[8 * j] * inv, v[8 * j + 1] * inv, v[8 * j + 2] * inv, v[8 * j + 3] * inv), pack_i8x4(v[8 * j + 4] * inv, v[8 * j + 5] * inv, v[8 * j + 6] * inv, v[8 * j + 7] * inv)};
        { GAS unsigned* ph = (GAS unsigned*)(XH + (size_t)m * (D / 2)) + lane; GAS unsigned* pl = (GAS unsigned*)(XL + (size_t)m * (D / 2)) + lane;
#pragma unroll
          for (int j = 0; j < 4; ++j) { unsigned wh = 0, wl = 0;
#pragma unroll
              for (int i = 0; i < 8; ++i) { const unsigned u = (unsigned)((int)rintf(v[8 * j + i] * inv) + 128); const int sh = 8 * (i & 3) + 4 * (i >> 2); wh |= (u >> 4) << sh; wl |= (u & 15u) << sh; }
              ph[64 * j] = wh; pl[64 * j] = wl; } }
        float qs = 0.f;
#pragma unroll
        for (int i = 0; i < 32; ++i) qs += rintf(v[i] * inv);
        qs = wave_sum(qs);
        if (lane == 0) { SX[m] = sc; LNS[2 * m] = mean; LNS[2 * m + 1] = rstd; SXQ[m] = qs; }
    }
}
__device__ __forceinline__ int f2key(float f) { const int b = __float_as_int(f); return b ^ ((b >> 31) & 0x7fffffff); }
__device__ __forceinline__ float key2f(int k) { return __int_as_float(k ^ ((k >> 31) & 0x7fffffff)); }
#define CE_DESC(a, b) do { const int _x = max(a, b), _y = min(a, b); a = _x; b = _y; } while (0)
template <int N> __device__ __forceinline__ void bitonic_merge_desc(int (&v)[N]) {
#pragma unroll
    for (int j = N >> 1; j > 0; j >>= 1)
#pragma unroll
        for (int i = 0; i < N; ++i) { const int l = i ^ j; if (l > i) CE_DESC(v[i], v[l]); }
}
__device__ __forceinline__ void sort16_desc(int (&v)[16]) {
#define CE_(a, b) CE_DESC(v[a], v[b])
    CE_(0,1); CE_(2,3); CE_(0,2); CE_(1,3); CE_(1,2); CE_(4,5); CE_(6,7); CE_(4,6); CE_(5,7); CE_(5,6); CE_(0,4); CE_(2,6); CE_(2,4); CE_(1,5); CE_(3,7); CE_(3,5); CE_(1,2); CE_(3,4); CE_(5,6);
    CE_(8,9); CE_(10,11); CE_(8,10); CE_(9,11); CE_(9,10); CE_(12,13); CE_(14,15); CE_(12,14); CE_(13,15); CE_(13,14); CE_(8,12); CE_(10,14); CE_(10,12); CE_(9,13); CE_(11,15); CE_(11,13); CE_(9,10); CE_(11,12); CE_(13,14);
    CE_(0,8); CE_(4,12); CE_(4,8); CE_(2,10); CE_(6,14); CE_(6,10); CE_(2,4); CE_(6,8); CE_(10,12); CE_(1,9); CE_(5,13); CE_(5,9); CE_(3,11); CE_(7,15); CE_(7,11); CE_(3,5); CE_(7,9); CE_(11,13);
    CE_(1,2); CE_(3,4); CE_(5,6); CE_(7,8); CE_(9,10); CE_(11,12); CE_(13,14);
#undef CE_
}
__device__ __forceinline__ void merge16(const int (&a)[16], const int (&b)[16], int (&o)[16]) {
#pragma unroll
    for (int i = 0; i < 16; ++i) o[i] = max(a[i], b[15 - i]);
    bitonic_merge_desc<16>(o);
}
__device__ const unsigned char PEER_PAIR[64] = {0,1,2,3,4,5,6,7,8,9,10,11,12,13,14,15, 16,17,18,19,20,21,22,23, 32,33,34,35,36, 48,49,50,51, 64,65,66, 80,81, 96,97, 112,113, 128,144,160,176,192,208,224,240, 0,0,0,0,0,0,0,0,0,0,0,0,0,0};
__device__ __forceinline__ void peer_load_q(bf16x8 (&bq)[8], const bf16* qrow  ) {
    asm volatile("" : "+v"(qrow));
#pragma unroll
    for (int s = 0; s < 8; ++s) bq[s] = *(const GAS bf16x8*)(qrow + 16 * s);
}
__device__ __forceinline__ void peer_subkey_top16(const bf16x8 (&bq)[8], const bf16* keys_hc  , int r32, int hi, int (&o)[16]) {
    int run[16];
#pragma unroll
    for (int mt = 0; mt < 4; ++mt) {
        const bf16* krow = keys_hc + (size_t)mt * (8 * 512) + (r32 + 32 * hi) * 8;
        asm volatile("" : "+v"(krow));
        bf16x8 ka[8];
#pragma unroll
        for (int s = 0; s < 8; ++s) ka[s] = *(const GAS bf16x8*)(krow + 512 * s);
        f32x16 acc = {};
#pragma unroll
        for (int s = 0; s < 8; ++s) acc = __builtin_amdgcn_mfma_f32_32x32x16_bf16(ka[s], bq[s], acc, 0, 0, 0);
        int g[16];
#pragma unroll
        for (int r = 0; r < 16; ++r) g[r] = (f2key(acc[r]) & ~127) | ((r & 3) + 8 * (r >> 2));
        sort16_desc(g);
        if (mt) {
#pragma unroll
            for (int r = 0; r < 16; ++r) g[r] |= 32 * mt; }
        if (mt == 0) {
#pragma unroll
            for (int r = 0; r < 16; ++r) run[r] = g[r];
        } else { int t2[16]; merge16(run, g, t2);
#pragma unroll
            for (int r = 0; r < 16; ++r) run[r] = t2[r]; }
    }
    int lo[16], hh[16]; const int hi4 = 4 * hi;
#pragma unroll
    for (int i = 0; i < 16; ++i) { run[i] |= hi4; auto rr = __builtin_amdgcn_permlane32_swap((unsigned)run[i], (unsigned)run[i], false, false); lo[i] = (int)rr[0]; hh[i] = (int)rr[1]; }
    merge16(lo, hh, o);
}
__device__ __forceinline__ float gelu_erf(float v) { return 0.5f * v * (1.f + erff(v * 0.70710678118654752f)); }

typedef float f32x2 __attribute__((ext_vector_type(2)));
constexpr int P7_G2 = RING_BYTES + 512 + 8192, P7_B2 = P7_G2 + 8192;
static_assert(P7_B2 + 8192 <= LDS_BYTES, "PEER LDS map (LN2 tables)");
constexpr int P7_G1 = 115712, P7_LNSL = 123904, P7_B1 = RING_BYTES + 512;
static_assert(P7_LNSL + 1024 <= RING_BYTES && P7_B1 + 8192 <= LDS_BYTES, "PEER LDS map (LN1 tables)");
constexpr int P7_W8 = 98304, P7_SW = 114688;
constexpr int P7_ACT = 0, P7_EID = 65536, P7_SCR = 0  , P7_SCR_WAVE = 32 * 33 * 4, PCH = 128, NCH = D / PCH;
static_assert(P7_SCR + NWAVES * P7_SCR_WAVE <= P7_EID && P7_EID + 128 * 128 * 2 <= RING_BYTES, "PEER LDS map");

__device__ __forceinline__ void p7_peer(Frame& F) {
    const int lane = F.lane(), r32 = lane & 31, hi = lane >> 5, j8 = lane & 7, g8 = lane >> 3;
    constexpr int TPB = 128;
    LAS float* ACT = (LAS float*)(F.lds + P7_ACT); LAS unsigned short* EIDL = (LAS unsigned short*)(F.lds + P7_EID);
    LAS int* scr = (LAS int*)(F.lds + P7_SCR + F.wave_() * P7_SCR_WAVE);
    { const float* ln1_g = F.in(I_LN1G); const float* ln1_b = F.in(I_LN1B); const int tid = F.tid();
      *(LAS f32x4*)(F.lds + P7_G1 + tid * 16) = *(const f32x4*)(ln1_g + tid * 4); *(LAS f32x4*)(F.lds + P7_B1 + tid * 16) = *(const f32x4*)(ln1_b + tid * 4);
      *(LAS f32x4*)(F.lds + P7_G2 + tid * 16) = *(const f32x4*)(F.in(I_LN2G) + tid * 4); *(LAS f32x4*)(F.lds + P7_B2 + tid * 16) = *(const f32x4*)(F.in(I_LN2B) + tid * 4); }
    for (int blk = F.vcu_(); blk < M / TPB; blk += F.G_()) {
        const int m0 = blk * TPB;
        SEC_BEGIN(10);
        SEC_REP(10) { const int h = F.wave_(); const bf16* QP = F.ws<bf16>(WS_QP); const bf16* KEYS = F.ws<bf16>(WS_KEYS); float* GATE = F.ws<float>(WS_GATE);
          bf16x8 bqA[8], bqB[8];
          peer_load_q(bqA, QP + (size_t)(m0 + r32) * D + h * 256 + hi * 8);
          for (int tt = 0; tt < 4; ++tt) {
            const int tl = 32 * tt + r32, tok = m0 + tl;
            const bf16* qrow = QP + (size_t)tok * D + h * 256 + hi * 8;
            int s1[16], s2[16];
            peer_load_q(bqB, qrow + 128);
            peer_subkey_top16(bqA, KEYS + (size_t)(h * 2 + 0) * PNK * PHALF, r32, hi, s1);
            asm volatile("" ::: "memory");
            { const int tn = tt + 1 < 4 ? tt + 1 : tt; peer_load_q(bqA, QP + (size_t)(m0 + 32 * tn + r32) * D + h * 256 + hi * 8); }
            peer_subkey_top16(bqB, KEYS + (size_t)(h * 2 + 1) * PNK * PHALF, r32, hi, s2);
            float f1[16], f2[16];
#pragma unroll
            for (int i = 0; i < 16; ++i) { f1[i] = key2f(s1[i]); f2[i] = key2f(s2[i]); }
            if (hi == 0) {
#pragma unroll
                for (int i = 0; i < 16; ++i) { scr[r32 * 33 + i] = s1[i] & 127; scr[r32 * 33 + 16 + i] = s2[i] & 127; } }
            int cand[64];
            {
#define PC(n_, i_, j_) cand[n_] = (f2key(f1[i_] + f2[j_]) & ~255) | (n_)
                PC(0,0,0); PC(1,0,1); PC(2,0,2); PC(3,0,3); PC(4,0,4); PC(5,0,5); PC(6,0,6); PC(7,0,7); PC(8,0,8); PC(9,0,9); PC(10,0,10); PC(11,0,11); PC(12,0,12); PC(13,0,13); PC(14,0,14); PC(15,0,15);
                PC(16,1,0); PC(17,1,1); PC(18,1,2); PC(19,1,3); PC(20,1,4); PC(21,1,5); PC(22,1,6); PC(23,1,7);
                PC(24,2,0); PC(25,2,1); PC(26,2,2); PC(27,2,3); PC(28,2,4);
                PC(29,3,0); PC(30,3,1); PC(31,3,2); PC(32,3,3);
                PC(33,4,0); PC(34,4,1); PC(35,4,2);
                PC(36,5,0); PC(37,5,1); PC(38,6,0); PC(39,6,1); PC(40,7,0); PC(41,7,1);
                PC(42,8,0); PC(43,9,0); PC(44,10,0); PC(45,11,0); PC(46,12,0); PC(47,13,0); PC(48,14,0); PC(49,15,0);
#undef PC
            }
#pragma unroll
            for (int i = 50; i < 64; ++i) cand[i] = (int)0x80000000;
            int c0[16], c1[16]; const int hsel = -hi;
#pragma unroll
            for (int i = 0; i < 16; ++i) { c0[i] = (cand[i] & ~hsel) | (cand[32 + i] & hsel); c1[i] = (cand[16 + i] & ~hsel) | (cand[48 + i] & hsel); }
            sort16_desc(c0); sort16_desc(c1);
            int mh[16]; merge16(c0, c1, mh);
            int sc[16];
            { int lo_[16], hh_[16];
#pragma unroll
              for (int i = 0; i < 16; ++i) { auto rr = __builtin_amdgcn_permlane32_swap((unsigned)mh[i], (unsigned)mh[i], false, false); lo_[i] = (int)rr[0]; hh_[i] = (int)rr[1]; }
              merge16(lo_, hh_, sc); }
            float p[16]; const float mx = key2f(sc[0]); float z = 0.f;
#pragma unroll
            for (int k = 0; k < 16; ++k) { p[k] = __expf(key2f(sc[k]) - mx); z += p[k]; }
            const float rz = 1.f / z;
            LDS_WAIT();
            int eo[8]; float go[8]; const int him = -hi;
#pragma unroll
            for (int kk = 0; kk < 8; ++kk) { const int tag = PEER_PAIR[((sc[kk] & ~him) | (sc[8 + kk] & him)) & 255];
                const int i1 = scr[r32 * 33 + (tag >> 4)], i2 = scr[r32 * 33 + 16 + (tag & 15)];
                eo[kk] = i1 * PNK + i2; go[kk] = __int_as_float((__float_as_int(p[kk]) & ~him) | (__float_as_int(p[8 + kk]) & him)) * rz; }
            *(LAS v4u*)(EIDL + tl * 128 + h * 16 + 8 * hi) = (v4u){(unsigned)(eo[0] | (eo[1] << 16)), (unsigned)(eo[2] | (eo[3] << 16)), (unsigned)(eo[4] | (eo[5] << 16)), (unsigned)(eo[6] | (eo[7] << 16))};
            GAS float* gp = (GAS float*)(GATE + (size_t)tok * 128 + h * 16 + 8 * hi);
            *(GAS f32x4*)gp = (f32x4){go[0], go[1], go[2], go[3]}; *(GAS f32x4*)(gp + 4) = (f32x4){go[4], go[5], go[6], go[7]};
            LDS_WAIT();
          } }
        { const float* LNS = F.ws<float>(WS_LNS); const int tid = F.tid(); if (tid < 64) *(LAS f32x4*)(F.lds + P7_LNSL + tid * 16) = *(const f32x4*)(LNS + 2 * (size_t)m0 + 4 * tid); }
        SEC_END(10);
        __threadfence_block(); __syncthreads();
        const int tw = F.wave_() * (TPB / NWAVES);
        SEC_BEGIN(11);
        SEC_REP(11) {
        for (int i = lane; i < (TPB / NWAVES) * 128; i += 64) ACT[tw * 128 + i] = 0.f;
        { const unsigned char* XH = F.ws<unsigned char>(WS_XH); const unsigned char* XL = F.ws<unsigned char>(WS_XL); const unsigned char* U8 = F.ws<unsigned char>(WS_U8);
#define U_ISSUE(n_, PC, XQ0, XQ1) do { const int c_ = (n_) >> 4, tl_ = tw + ((n_) & 15); \
            XQ0 = *(const GAS v4u*)(XH + (size_t)(m0 + tl_) * (D / 2) + c_ * PCH + 16 * j8); XQ1 = *(const GAS v4u*)(XL + (size_t)(m0 + tl_) * (D / 2) + c_ * PCH + 16 * j8); \
            const LAS unsigned short* ep_ = EIDL + tl_ * 128 + g8; const unsigned char* ub_ = U8 + (size_t)c_ * (NEXP * PCH); const unsigned j16_ = 16u * (unsigned)j8;     \
            _Pragma("unroll") for (int i = 0; i < 16; ++i) { const unsigned e_ = ep_[8 * i]; PC[i] = *(const GAS v4u*)(ub_ + (e_ * PCH + j16_)); } } while (0)
#define U_COMPUTE(n_, PC, XQ0, XQ1) do { const int tl_ = tw + ((n_) & 15); \
            int pp_[16]; \
            _Pragma("unroll") for (int i = 0; i < 16; ++i) { unsigned ah_ = __builtin_amdgcn_udot8(PC[i].x, XQ0.x, 0u, false), al_ = __builtin_amdgcn_udot8(PC[i].x, XQ1.x, 0u, false); \
                ah_ = __builtin_amdgcn_udot8(PC[i].y, XQ0.y, ah_, false); al_ = __builtin_amdgcn_udot8(PC[i].y, XQ1.y, al_, false); ah_ = __builtin_amdgcn_udot8(PC[i].z, XQ0.z, ah_, false); al_ = __builtin_amdgcn_udot8(PC[i].z, XQ1.z, al_, false); \
                ah_ = __builtin_amdgcn_udot8(PC[i].w, XQ0.w, ah_, false); al_ = __builtin_amdgcn_udot8(PC[i].w, XQ1.w, al_, false); pp_[i] = (int)(16u * ah_ + al_); } \
              \
            int q8_[8], q4_[4], q2_[2]; \
            { const bool b2_ = lane & 4; _Pragma("unroll") for (int i = 0; i < 8; ++i) { const int k_ = b2_ ? pp_[2 * i + 1] : pp_[2 * i], s_ = b2_ ? pp_[2 * i] : pp_[2 * i + 1]; q8_[i] = k_ + dppi<0x141>(s_); } } \
            { const bool b1_ = lane & 2; _Pragma("unroll") for (int i = 0; i < 4; ++i) { const int k_ = b1_ ? q8_[2 * i + 1] : q8_[2 * i], s_ = b1_ ? q8_[2 * i] : q8_[2 * i + 1]; q4_[i] = k_ + dppi<0x4E>(s_); } } \
            { const bool b0_ = lane & 1; _Pragma("unroll") for (int i = 0; i < 2; ++i) { const int k_ = b0_ ? q4_[2 * i + 1] : q4_[2 * i], s_ = b0_ ? q4_[2 * i] : q4_[2 * i + 1]; q2_[i] = k_ + dppi<0xB1>(s_); } } \
            const int irow_ = ((lane & 1) << 2) | (lane & 2) | ((lane >> 2) & 1); \
            LAS float* ap_ = ACT + tl_ * 128 + 8 * irow_ + g8; ap_[0] += (float)q2_[0]; ap_[64] += (float)q2_[1]; } while (0)
          constexpr int UCH = 256, NSTEP = (D / UCH) * (TPB / NWAVES);
          v4u pcA[16], pcB[16], xqA0, xqA1, xqB0, xqB1;
          U_ISSUE(0, pcA, xqA0, xqA1);
          for (int n = 0; n < NSTEP; n += 2) {
              U_ISSUE(n + 1, pcB, xqB0, xqB1); __builtin_amdgcn_sched_barrier(0);
              U_COMPUTE(n, pcA, xqA0, xqA1); __builtin_amdgcn_sched_barrier(0);
              { const int nn = (n + 2 < NSTEP) ? n + 2 : n; U_ISSUE(nn, pcA, xqA0, xqA1); }
              __builtin_amdgcn_sched_barrier(0);
              U_COMPUTE(n + 1, pcB, xqB0, xqB1); __builtin_amdgcn_sched_barrier(0);
          }
#undef U_ISSUE
#undef U_COMPUTE
        }
        }
        SEC_END(11); SEC_BEGIN(12);
        LDS_WAIT();
        { const float* SU = F.ws<float>(WS_SU); const float* SV = F.ws<float>(WS_SV); const float* GATE = F.ws<float>(WS_GATE); const float* SX = F.ws<float>(WS_SX); const float* SXQ = F.ws<float>(WS_SXQ); const float* NSU = F.ws<float>(WS_NSU);
        LAS unsigned char* W8L = (LAS unsigned char*)(F.lds + P7_W8); LAS float* SWL = (LAS float*)(F.lds + P7_SW);
        for (int tb = 0; tb < TPB / NWAVES; tb += 8) {
            float nsu_[8][2], su_[8][2], sv_[8][2], gt_[8][2], ac_[8][2], sx_[8], xo_[8];
#pragma unroll
            for (int i = 0; i < 8; ++i) { const int tl = tw + tb + i, t = m0 + tl; sx_[i] = SX[t]; xo_[i] = 8.f * SXQ[t];
#pragma unroll
                for (int kq = 0; kq < 2; ++kq) { const int k = lane + 64 * kq; const unsigned e = EIDL[tl * 128 + k]; ac_[i][kq] = ACT[tl * 128 + k];
                    nsu_[i][kq] = NSU[e]; su_[i][kq] = SU[e]; sv_[i][kq] = SV[e]; gt_[i][kq] = __builtin_nontemporal_load(GATE + (size_t)t * 128 + k); } }
#pragma unroll
            for (int i = 0; i < 8; ++i) { const int tl = tw + tb + i; float wv[2];
#pragma unroll
                for (int kq = 0; kq < 2; ++kq) { const float a = (ac_[i][kq] - 128.f * nsu_[i][kq] - xo_[i]) * su_[i][kq] * sx_[i];
                    wv[kq] = gt_[i][kq] * gelu_erf(a) * sv_[i][kq]; }
                const float am = wave_max(fmaxf(fabsf(wv[0]), fabsf(wv[1])));
                const float sc = am > 0.f ? am * (1.f / 127.f) : 1.f, inv = 1.f / sc;
                float wsum = 0.f;
#pragma unroll
                for (int kq = 0; kq < 2; ++kq) { const int k = lane + 64 * kq; const float q = rintf(wv[kq] * inv); wsum += q; W8L[tl * 128 + k] = (unsigned char)((int)q & 255); }
                wsum = wave_sum(wsum);
                if (lane == 0) { SWL[tl] = sc; SWL[128 + tl] = 8.f * wsum; } }
        } }
        LDS_WAIT();
        SEC_END(12); SEC_BEGIN(13);
        SEC_REP(13) {
        { const bf16* X1 = F.ws<bf16>(WS_Y1); const unsigned char* V8 = F.ws<unsigned char>(WS_V8); bf16* Y2 = F.ws<bf16>(WS_QP);
#define V_ISSUE(n_, PC, WQ) do { const int c_ = (n_) >> 4, tl_ = tw + (((n_) >> 3) & 1) * 8 + g8, s_ = (n_) & 7; \
            const LAS unsigned short* ep_ = EIDL + tl_ * 128 + 16 * s_; const unsigned char* vb_ = V8 + (size_t)c_ * (NEXP * PCH); const unsigned j16_ = 16u * (unsigned)j8;     \
            _Pragma("unroll") for (int i = 0; i < 16; ++i) { const unsigned e_ = ep_[i]; PC[i] = *(const GAS v4u*)(vb_ + (e_ * PCH + j16_)); } \
            WQ = *(const LAS v4u*)(F.lds + P7_W8 + tl_ * 128 + 16 * s_); } while (0)
#define V_TR4(A_, B_, C_, D_, WQ_, O_) do { const unsigned t0_ = __builtin_amdgcn_perm(B_, A_, 0x05010400u), t1_ = __builtin_amdgcn_perm(B_, A_, 0x07030602u), t2_ = __builtin_amdgcn_perm(D_, C_, 0x05010400u), t3_ = __builtin_amdgcn_perm(D_, C_, 0x07030602u); \
            const unsigned u0_ = __builtin_amdgcn_perm(t2_, t0_, 0x05040100u), u1_ = __builtin_amdgcn_perm(t2_, t0_, 0x07060302u), u2_ = __builtin_amdgcn_perm(t3_, t1_, 0x05040100u), u3_ = __builtin_amdgcn_perm(t3_, t1_, 0x07060302u); \
              \
            ac_[(O_) + 0] = __builtin_amdgcn_sdot4((int)(u0_ & 0x0f0f0f0fu), (int)(WQ_), ac_[(O_) + 0], false); ac_[(O_) + 4] = __builtin_amdgcn_sdot4((int)u0_, (int)(WQ_), ac_[(O_) + 4], false); \
            ac_[(O_) + 1] = __builtin_amdgcn_sdot4((int)(u1_ & 0x0f0f0f0fu), (int)(WQ_), ac_[(O_) + 1], false); ac_[(O_) + 5] = __builtin_amdgcn_sdot4((int)u1_, (int)(WQ_), ac_[(O_) + 5], false); \
            ac_[(O_) + 2] = __builtin_amdgcn_sdot4((int)(u2_ & 0x0f0f0f0fu), (int)(WQ_), ac_[(O_) + 2], false); ac_[(O_) + 6] = __builtin_amdgcn_sdot4((int)u2_, (int)(WQ_), ac_[(O_) + 6], false); \
            ac_[(O_) + 3] = __builtin_amdgcn_sdot4((int)(u3_ & 0x0f0f0f0fu), (int)(WQ_), ac_[(O_) + 3], false); ac_[(O_) + 7] = __builtin_amdgcn_sdot4((int)u3_, (int)(WQ_), ac_[(O_) + 7], false); } while (0)
#define V_ACC(PC, WQ) do { const unsigned wq_[4] = {WQ.x, WQ.y, WQ.z, WQ.w}; \
            _Pragma("unroll") for (int gq = 0; gq < 4; ++gq) { \
                const unsigned pa_[4] = {PC[4 * gq].x, PC[4 * gq].y, PC[4 * gq].z, PC[4 * gq].w}, pb_[4] = {PC[4 * gq + 1].x, PC[4 * gq + 1].y, PC[4 * gq + 1].z, PC[4 * gq + 1].w}; \
                const unsigned pc_[4] = {PC[4 * gq + 2].x, PC[4 * gq + 2].y, PC[4 * gq + 2].z, PC[4 * gq + 2].w}, pd_[4] = {PC[4 * gq + 3].x, PC[4 * gq + 3].y, PC[4 * gq + 3].z, PC[4 * gq + 3].w}; \
                _Pragma("unroll") for (int m = 0; m < 4; ++m) { \
                    V_TR4(pa_[m], pb_[m], pc_[m], pd_[m], wq_[gq], 8 * m); } } } while (0)
#define V_FIN(n_, XP) do { const int c_ = (n_) >> 4, tl_ = tw + (((n_) >> 3) & 1) * 8 + g8; \
            const LAS float* swp_ = (const LAS float*)(F.lds + P7_SW); const float sw_ = swp_[tl_], wo_ = swp_[128 + tl_]; \
            const f32x2 ms_ = *(const LAS f32x2*)(F.lds + P7_LNSL + tl_ * 8); const int dim0_ = c_ * VCH + 32 * j8; \
            _Pragma("unroll") for (int m = 0; m < 4; ++m) { \
                const f32x4 g0_ = *(const LAS f32x4*)(F.lds + P7_G1 + (dim0_ + 8 * m) * 4), g1_ = *(const LAS f32x4*)(F.lds + P7_G1 + (dim0_ + 8 * m + 4) * 4), b0_ = *(const LAS f32x4*)(F.lds + P7_B1 + (dim0_ + 8 * m) * 4), b1_ = *(const LAS f32x4*)(F.lds + P7_B1 + (dim0_ + 8 * m + 4) * 4); \
                const unsigned xw_[4] = {XP[m].x, XP[m].y, XP[m].z, XP[m].w}; float o_[8]; \
                _Pragma("unroll") for (int i = 0; i < 4; ++i) { const float yl_ = (i & 1) ? bfhi(xw_[i >> 1]) : bflo(xw_[i >> 1]), yh_ = (i & 1) ? bfhi(xw_[2 + (i >> 1)]) : bflo(xw_[2 + (i >> 1)]); \
                    o_[i] = ((float)ac_[8 * m + i] - wo_) * sw_ + DN_ALPHA * ((yl_ - ms_.x) * ms_.y * g0_[i] + b0_[i]); \
                    o_[4 + i] = (float)((ac_[8 * m + 4 + i] - ac_[8 * m + i]) >> 4) * sw_ + DN_ALPHA * ((yh_ - ms_.x) * ms_.y * g1_[i] + b1_[i]); } \
                *(GAS v4u*)(Y2 + (size_t)(m0 + tl_) * D + dim0_ + 8 * m) = (v4u){pk2(o_[0], o_[1]), pk2(o_[2], o_[3]), pk2(o_[4], o_[5]), pk2(o_[6], o_[7])}; } \
            _Pragma("unroll") for (int d = 0; d < 32; ++d) ac_[d] = 0; } while (0)
          constexpr int VCH = 256, NSTEP = (D / VCH) * (TPB / NWAVES);
          v4u pcA[16], pcB[16], wqA, wqB, xp[4]; int ac_[32];
#pragma unroll
          for (int d = 0; d < 32; ++d) ac_[d] = 0;
          V_ISSUE(0, pcA, wqA);
          for (int n = 0; n < NSTEP; n += 2) {
              const bool fin = (n & 7) == 6;
              if (fin) { const int c_ = (n + 1) >> 4, tl_ = tw + (((n + 1) >> 3) & 1) * 8 + g8; const GAS v4u* xq_ = (const GAS v4u*)(X1 + (size_t)(m0 + tl_) * D + c_ * VCH + 32 * j8);
#pragma unroll
                  for (int m = 0; m < 4; ++m) xp[m] = xq_[m]; }
              V_ISSUE(n + 1, pcB, wqB); __builtin_amdgcn_sched_barrier(0);
              V_ACC(pcA, wqA); __builtin_amdgcn_sched_barrier(0);
              { const int nn = (n + 2 < NSTEP) ? n + 2 : n; V_ISSUE(nn, pcA, wqA); }
              __builtin_amdgcn_sched_barrier(0);
              V_ACC(pcB, wqB);
              if (fin) V_FIN(n + 1, xp);
              __builtin_amdgcn_sched_barrier(0);
          }
#undef V_TR4
#undef V_ISSUE
#undef V_ACC
#undef V_FIN
        }
        }
        SEC_END(13); SEC_BEGIN(14);
        SEC_REP(14) {
        { float* outp = F.outp(); const bf16* Y2 = F.ws<bf16>(WS_QP);
        v4u nx[4];
        { const GAS v4u* yp = (const GAS v4u*)(Y2 + (size_t)(m0 + tw) * D) + lane;
#pragma unroll
          for (int j = 0; j < 4; ++j) nx[j] = yp[64 * j]; }
        for (int ti = 0; ti < TPB / NWAVES; ++ti) {
            const int t = m0 + tw + ti;
            float v[32]; float s = 0.f;
#pragma unroll
            for (int j = 0; j < 4; ++j) { const unsigned ww[4] = {nx[j].x, nx[j].y, nx[j].z, nx[j].w};
#pragma unroll
                for (int i = 0; i < 4; ++i) { v[8 * j + 2 * i] = bflo(ww[i]); v[8 * j + 2 * i + 1] = bfhi(ww[i]); s += v[8 * j + 2 * i] + v[8 * j + 2 * i + 1]; } }
            { const int tn = (ti + 1 < TPB / NWAVES) ? t + 1 : t; const GAS v4u* yp = (const GAS v4u*)(Y2 + (size_t)tn * D) + lane;
#pragma unroll
              for (int j = 0; j < 4; ++j) nx[j] = yp[64 * j]; }
            const float mean = wave_sum(s) * (1.f / D); float qv = 0.f;
#pragma unroll
            for (int i = 0; i < 32; ++i) { v[i] -= mean; qv += v[i] * v[i]; }
            const float rstd = 1.f / sqrtf(wave_sum(qv) * (1.f / D) + LN_EPS);
#pragma unroll
            for (int j = 0; j < 4; ++j) { const int c0 = 8 * lane + 512 * j; const f32x4 g0 = *(const LAS f32x4*)(F.lds + P7_G2 + c0 * 4), g1 = *(const LAS f32x4*)(F.lds + P7_G2 + c0 * 4 + 16), b0 = *(const LAS f32x4*)(F.lds + P7_B2 + c0 * 4), b1 = *(const LAS f32x4*)(F.lds + P7_B2 + c0 * 4 + 16);
                f32x4 r0, r1;
#pragma unroll
                for (int i = 0; i < 4; ++i) { r0[i] = v[8 * j + i] * rstd * g0[i] + b0[i]; r1[i] = v[8 * j + 4 + i] * rstd * g1[i] + b1[i]; }
                GAS f32x4* op = (GAS f32x4*)(outp + (size_t)t * D + c0); op[0] = r0; op[1] = r1; }
        } }
        }
        SEC_END(14);
        __syncthreads();
    }
}

struct Args { const float* in[22]; float* out; unsigned char* ws; int ph_lo, ph_hi; };
__global__ void __launch_bounds__(NWAVES * 64, 2) mk_fwd(Args args) {
    extern __shared__ __attribute__((aligned(16))) unsigned char lds[];
    cg::grid_group grid = cg::this_grid();
    Frame F;
    F.lds = (LAS unsigned char*)lds;
    if (threadIdx.x == 0) { LAS unsigned long long* PT = (LAS unsigned long long*)(F.lds + RING_BYTES);
#pragma unroll
        for (int k = 0; k < 22; ++k) PT[k] = (unsigned long long)args.in[k];
        PT[22] = (unsigned long long)args.out; PT[23] = (unsigned long long)args.ws;
        ((LAS unsigned*)(F.lds + RING_BYTES + 256))[0] = 0u; ((LAS unsigned*)(F.lds + RING_BYTES + 256))[1] = 0u; }
    __syncthreads();
    const int lo = args.ph_lo, hi = args.ph_hi;
#ifndef PHASE_MASK
#define PHASE_MASK 255
#endif
#define IN(k) (((PHASE_MASK >> (k)) & 1) && lo <= (k) && (k) < hi)
#ifndef REPEAT_PHASE
#define REPEAT_PHASE -1
#endif
#define REP(k) for (int rep_ = 0; rep_ < ((REPEAT_PHASE == (k)) ? 2 : 1); ++rep_)
    (void)xcd_barrier_post((unsigned*)args.ws, (volatile LAS unsigned*)(F.lds + RING_BYTES + 256));
#define XBAR() do { XcdBarrier bar_; bar_.bar = F.ws<unsigned>(0); bar_.x = xb_xcc_id(); bar_.st = (volatile LAS unsigned*)(F.lds + RING_BYTES + 256); xcd_barrier(bar_); } while (0)
#define SEAM(k) do { if (IN(k) && IN((k) + 1)) XBAR(); } while (0)

    if (lo < 0) grid.sync();
    if (IN(0)) REP(0) { SEC_BEGIN(0); p0a_prologue(F); XBAR(); p0b_prologue(F); SEC_END(0); } SEAM(0);
    if (IN(1)) REP(1) { SEC_BEGIN(1);
        pg8::Gemm g{F.ws<bf16>(WS_XB), F.ws<bf16>(WS_WIN), M, NPROJ, D / 2}; pg8::StaticOrder S; S.init(M, NPROJ, F.G_(), (int)blockIdx.x);
        pg8::EpiProjI8 E{F.ws<bf16>(WS_Q), (size_t)(WS_K - WS_Q) / 2, dattn::C2, F.ws<bf16>(WS_H), F.in(I_BGLU), F.ws<float>(WS_SXA), F.ws<float>(WS_SWIN)};
        pg8::gemm_phase<pg8::EpiProjI8, pg8::StaticOrder, PG8_ALIGN, PG8_SP2>(F.lds, g, S, E);
    SEC_END(1); } SEAM(1);
    if (IN(2)) REP(2) { SEC_BEGIN(2);
        static_assert(dattn::LDS_BYTES <= RING_BYTES, "attention body geometry vs frame");
        const dattn::Tensors AT{F.ws<const dattn::bf16>(WS_Q), F.ws<const dattn::bf16>(WS_K), F.ws<const dattn::bf16>(WS_V), F.ws<dattn::bf16>(WS_O1), F.ws<dattn::bf16>(WS_O2), F.ws<const float>(WS_TAB)};
        dattn::phase((char*)lds, AT, F.vcu_());
    SEC_END(2); } SEAM(2);
    if (IN(3)) REP(3) { SEC_BEGIN(3); p3_mix(F); SEC_END(3); } SEAM(3);
    if (IN(4)) REP(4) { SEC_BEGIN(4);
        pg8::Gemm g{F.ws<bf16>(WS_XB), F.ws<bf16>(WS_WOUT), M, D, D / 2}; pg8::StaticOrder S; S.init(M, D, F.G_(), (int)blockIdx.x);
        pg8::EpiResI8 E{F.in(I_X), F.ws<bf16>(WS_Y1), D, DN_ALPHA, F.ws<float>(WS_SM), F.ws<float>(WS_SWOUT)};
        pg8::gemm_phase<pg8::EpiResI8, pg8::StaticOrder, PG8_ALIGN, PG8_SP2>(F.lds, g, S, E);
    SEC_END(4); } SEAM(4);
    if (IN(5)) REP(5) { SEC_BEGIN(5); p5_ln1(F); SEC_END(5); } SEAM(5);
    if (IN(6)) REP(6) { SEC_BEGIN(6);
        pg8::Gemm g{F.ws<bf16>(WS_X8), F.ws<bf16>(WS_WQ), M, D, D / 2}; pg8::StaticOrder S; S.init(M, D, F.G_(), (int)blockIdx.x);
        pg8::EpiPlainI8 E{F.ws<bf16>(WS_QP), D, F.ws<float>(WS_SX), F.ws<float>(WS_SWQ)};
        pg8::gemm_phase<pg8::EpiPlainI8, pg8::StaticOrder, PG8_ALIGN, PG8_SP2>(F.lds, g, S, E);
    SEC_END(6); } SEAM(6);
    if (IN(7)) REP(7) { SEC_BEGIN(7); p7_peer(F); SEC_END(7); }
#ifdef PROBE_XBARS
    for (int xb_i = 0; xb_i < PROBE_XBARS; ++xb_i) XBAR();
#endif
#undef IN
#undef SEAM
}

extern "C" void kernel_launch(void* const* d_in, const int* in_sizes, int n_in, void* d_out, int out_size, void* d_ws, size_t ws_size, hipStream_t stream) {
    static int grid = 0;
    if (grid == 0) {
        if (n_in != 22 || in_sizes[0] != M * D || out_size != M * D || ws_size < WS_END) { fprintf(stderr, "kernel_launch: unexpected shapes (n_in %d, in0 %d, out %d, ws %zu); nothing launched\n", n_in, n_in > 0 ? in_sizes[0] : -1, out_size, ws_size); grid = -1; return; }
        int dev = 0, cus = 0, per_cu = 0;
        if (hipGetDevice(&dev) != hipSuccess || hipDeviceGetAttribute(&cus, hipDeviceAttributeMultiprocessorCount, dev) != hipSuccess) { grid = -1; return; }
        if (hipFuncSetAttribute((const void*)mk_fwd, hipFuncAttributeMaxDynamicSharedMemorySize, LDS_BYTES) != hipSuccess) { fprintf(stderr, "kernel_launch: hipFuncSetAttribute failed\n"); grid = -1; return; }
        if (hipOccupancyMaxActiveBlocksPerMultiprocessor(&per_cu, (const void*)mk_fwd, NWAVES * 64, LDS_BYTES) != hipSuccess || per_cu < 1) { fprintf(stderr, "kernel_launch: occupancy query reports %d workgroups per CU\n", per_cu); (void)hipGetLastError(); grid = -1; return; }
        grid = cus;
        if (grid > 256) grid = 256;
    }
    if (grid < 0) return;
    if (hipMemsetAsync(d_ws, 0, 65536, stream) != hipSuccess) { fprintf(stderr, "kernel_launch: hipMemsetAsync failed\n"); return; }
    Args a{};
    for (int i = 0; i < 22; ++i) a.in[i] = (const float*)d_in[i];
    a.out = (float*)d_out; a.ws = (unsigned char*)d_ws;
    constexpr int NL = MK_N_LAUNCHES;
    for (int li = 0; li < NL; ++li) {
        a.ph_lo = (NL == 1) ? 0 : li; a.ph_hi = (NL == 1) ? N_PHASES : li + 1;
        void* kargs[] = {&a};
        const hipError_t le = hipLaunchCooperativeKernel((const void*)mk_fwd, dim3(grid), dim3(NWAVES * 64), kargs, LDS_BYTES, stream);
        if (le != hipSuccess) { fprintf(stderr, "kernel_launch: cooperative launch %d failed: %s (grid %d)\n", li, hipGetErrorString(le), grid); break; }
    }
}
```

```cpp
#include <hip/hip_runtime.h>
#include <hip/hip_cooperative_groups.h>
#include <cstdio>
#include <cstdint>
namespace cg = cooperative_groups;
namespace pg8 {
#define PG8_LAS __attribute__((address_space(3)))
typedef unsigned short bf16_t;
typedef short bf16x8 __attribute__((ext_vector_type(8)));
typedef float f32x4 __attribute__((ext_vector_type(4)));
typedef unsigned u32x4 __attribute__((ext_vector_type(4)));
typedef int i32x4 __attribute__((ext_vector_type(4)));
constexpr int BM = 256, BK = 64, HALF = 128, HTB = HALF * BK * 2  , STAGE_BYTES = 8 * HTB, NXCD = 8, WGM = 8;

__host__ __device__ __forceinline__ int lds_byte(int r, int c) { const int st = (r >> 4) * 2 + (c >> 5), rr = r & 15, cc = c & 31, ob = rr * 64 + cc * 2; return st * 1024 + (ob ^ (((ob >> 9) & 1) << 5)); }
__host__ __device__ __forceinline__ void stage_rc(int b, int& R, int& C) { const int st = b / 1024, sb = b % 1024, swz = sb ^ (((sb >> 9) & 1) << 5); R = (st >> 1) * 16 + swz / 64; C = (st & 1) * 32 + (swz % 64) / 2; }
__host__ __device__ __forceinline__ int perm32(int rho) { const int n = rho >> 4, i = rho & 15; return 8 * (i >> 2) + 4 * n + (i & 3); }

struct Unit { int pm, pn; };
struct Gemm { const bf16_t* A; const bf16_t* Bt; int M, N, K; };

struct StaticOrder {
    int nM, nN, nwg, G, c;
    __host__ __device__ void init(int M, int N, int G_, int c_) { nM = M / BM; nN = N / BM; nwg = nM * nN; G = G_; c = c_; }
    __host__ __device__ bool next(int i, Unit& u) const {
        const long L = (long)i * G + c; if (L >= nwg) return false;
        int wgid = (int)L; { const int q = nwg / NXCD, r = nwg % NXCD, xcd = wgid % NXCD, off = wgid / NXCD; wgid = (xcd < r ? xcd * (q + 1) : r * (q + 1) + (xcd - r) * q) + off; }
        const int nig = WGM * nN, gid = wgid / nig, fm = gid * WGM, gsz = (nM - fm) < WGM ? (nM - fm) : WGM;
        u.pm = fm + ((wgid % nig) % gsz); u.pn = (wgid % nig) / gsz; return true;
    }
    __device__ __forceinline__ void a_ready(const Unit&) const {}
    __device__ __forceinline__ void done(const Unit&) const {}
};

__device__ __forceinline__ unsigned cvt_pk_bf16(float lo, float hi) { unsigned r; asm volatile("v_cvt_pk_bf16_f32 %0, %1, %2" : "=v"(r) : "v"(lo), "v"(hi)); return r; }
typedef float f32x2 __attribute__((ext_vector_type(2)));
typedef float f32x2 __attribute__((ext_vector_type(2)));
__device__ __forceinline__ u32x4 pack8(f32x4 v0, f32x4 v1) { u32x4 w; w.x = cvt_pk_bf16(v0[0], v0[1]); w.y = cvt_pk_bf16(v0[2], v0[3]); w.z = cvt_pk_bf16(v1[0], v1[1]); w.w = cvt_pk_bf16(v1[2], v1[3]); return w; }
typedef _Float16 h16x2 __attribute__((ext_vector_type(2)));
__device__ __forceinline__ unsigned pkh2(float a, float b) { const h16x2 v = {(_Float16)__builtin_amdgcn_fmed3f(a, -65504.f, 65504.f), (_Float16)__builtin_amdgcn_fmed3f(b, -65504.f, 65504.f)}; return __builtin_bit_cast(unsigned, v); }
__device__ __forceinline__ u32x4 pack8h(f32x4 v0, f32x4 v1) { u32x4 w; w.x = pkh2(v0[0], v0[1]); w.y = pkh2(v0[2], v0[3]); w.z = pkh2(v1[0], v1[1]); w.w = pkh2(v1[2], v1[3]); return w; }
__device__ __forceinline__ f32x4 i2f(f32x4 a) { const i32x4 v = __builtin_bit_cast(i32x4, a); return (f32x4){(float)v[0], (float)v[1], (float)v[2], (float)v[3]}; }
__device__ __forceinline__ unsigned ror8(unsigned v) { return (unsigned)__builtin_amdgcn_update_dpp(0, (int)v, 0x128, 0xf, 0xf, true); }
__device__ __forceinline__ void xchg_store2(bf16_t* p  , size_t ld, u32x4 p0  , u32x4 p1  , bool hi8) {
    const u32x4 snd = hi8 ? p0 : p1; u32x4 rcv; rcv.x = ror8(snd.x); rcv.y = ror8(snd.y); rcv.z = ror8(snd.z); rcv.w = ror8(snd.w);
    *(u32x4*)p = hi8 ? rcv : p0; *(u32x4*)(p + 8 * ld) = hi8 ? p1 : rcv;
}
struct EpiProjI8 {
    static constexpr bool PERM = true, AFTER_DRAIN = false, INT8 = true;
    bf16_t* QKV; size_t split_stride; float scale0; bf16_t* H; const float* bglu; const float* sa; const float* sb;
    __device__ __forceinline__ void operator()(const f32x4 (&acc)[2][2][4][2], const Unit& u, int wr, int wc, int fr, int fq) const {
        const int row0 = u.pm * BM + wr * 64 + fr, cb = u.pn * BM + wc * 64 + 8 * fq; const bool hi8 = fr & 8;
        f32x4 cs[2][2];
#pragma unroll
        for (int bj = 0; bj < 2; ++bj) { cs[bj][0] = *(const f32x4*)(sb + cb + bj * 32); cs[bj][1] = *(const f32x4*)(sb + cb + bj * 32 + 4); }
        float rsv[2][4];
#pragma unroll
        for (int ai = 0; ai < 2; ++ai)
#pragma unroll
            for (int m = 0; m < 4; ++m) rsv[ai][m] = sa[row0 + ai * HALF + m * 16];
        if (u.pn < 12) {
            const int t = u.pn >> 2; bf16_t* base = QKV + (size_t)t * split_stride; const float sc = (t == 0) ? scale0 : 1.f;
            bf16_t* lp = base + (size_t)(u.pm * BM + wr * 64 + (fr & 7)) * 1024 + (u.pn & 3) * BM + wc * 64 + 8 * fq + (hi8 ? 32 : 0);
#pragma unroll
            for (int ai = 0; ai < 2; ++ai)
#pragma unroll
                for (int m = 0; m < 4; ++m) { const float rs = rsv[ai][m] * sc;
                    xchg_store2(lp + (size_t)(ai * HALF + m * 16) * 1024, 1024, pack8(i2f(acc[ai][0][m][0]) * cs[0][0] * rs, i2f(acc[ai][0][m][1]) * cs[0][1] * rs), pack8(i2f(acc[ai][1][m][0]) * cs[1][0] * rs, i2f(acc[ai][1][m][1]) * cs[1][1] * rs), hi8); }
        } else {
            const int ch0 = (u.pn - 12) * HALF + wc * 32 + 8 * fq;
            const f32x4 ba0 = *(const f32x4*)(bglu + ch0), ba1 = *(const f32x4*)(bglu + ch0 + 4), bg0 = *(const f32x4*)(bglu + 1024 + ch0), bg1 = *(const f32x4*)(bglu + 1024 + ch0 + 4);
#pragma unroll
            for (int ai = 0; ai < 2; ++ai)
#pragma unroll
                for (int m = 0; m < 4; ++m) { const int row = row0 + ai * HALF + m * 16; const float rs = rsv[ai][m];
                    const f32x4 a0 = i2f(acc[ai][0][m][0]) * cs[0][0] * rs + ba0, a1 = i2f(acc[ai][0][m][1]) * cs[0][1] * rs + ba1, g0 = i2f(acc[ai][1][m][0]) * cs[1][0] * rs + bg0, g1 = i2f(acc[ai][1][m][1]) * cs[1][1] * rs + bg1;
                    f32x4 h0, h1;
#pragma unroll
                    for (int e = 0; e < 4; ++e) { h0[e] = a0[e] * __builtin_amdgcn_rcpf(1.f + __builtin_amdgcn_exp2f(-1.4426950409f * g0[e])); h1[e] = a1[e] * __builtin_amdgcn_rcpf(1.f + __builtin_amdgcn_exp2f(-1.4426950409f * g1[e])); }
                    *(u32x4*)(H + (size_t)row * 1024 + ch0) = pack8h(h0, h1); }
        }
    }
};
struct EpiPlainI8 {
    static constexpr bool PERM = true, AFTER_DRAIN = false, INT8 = true;
    bf16_t* O; int ldc; const float* sa; const float* sb;
    __device__ __forceinline__ void operator()(const f32x4 (&acc)[2][2][4][2], const Unit& u, int wr, int wc, int fr, int fq) const {
        const int row0 = u.pm * BM + wr * 64 + fr, col0 = u.pn * BM + wc * 64 + 8 * fq;
        f32x4 cs[2][2];
#pragma unroll
        for (int bj = 0; bj < 2; ++bj) { cs[bj][0] = *(const f32x4*)(sb + col0 + bj * 32); cs[bj][1] = *(const f32x4*)(sb + col0 + bj * 32 + 4); }
        float rsv[2][4];
#pragma unroll
        for (int ai = 0; ai < 2; ++ai)
#pragma unroll
            for (int m = 0; m < 4; ++m) rsv[ai][m] = sa[row0 + ai * HALF + m * 16];
        const int hc = u.pn * 2 + (wc >> 1), s0 = (wc & 1) * 4 + (fq >> 1);
        bf16_t* lp = O + (size_t)(u.pm * 8 + wr * 2) * (32 * (size_t)ldc) + ((size_t)(hc * 8 + s0) * 64 + fr + 32 * (fq & 1)) * 8;
#pragma unroll
        for (int ai = 0; ai < 2; ++ai)
#pragma unroll
            for (int m = 0; m < 4; ++m) { const float rs = rsv[ai][m]; bf16_t* tp = lp + (size_t)(ai * 4 + (m >> 1)) * (32 * (size_t)ldc) + (m & 1) * 16 * 8;
#pragma unroll
                for (int bj = 0; bj < 2; ++bj) __builtin_nontemporal_store(pack8(i2f(acc[ai][bj][m][0]) * cs[bj][0] * rs, i2f(acc[ai][bj][m][1]) * cs[bj][1] * rs), (u32x4*)(tp + bj * 2 * 512)); }
    }
};
struct EpiResI8 {
    static constexpr bool PERM = true, AFTER_DRAIN = false, INT8 = true;
    const float* X; bf16_t* Y; int ldc; float alpha; const float* sa; const float* sb;
    __device__ __forceinline__ void operator()(const f32x4 (&acc)[2][2][4][2], const Unit& u, int wr, int wc, int fr, int fq) const {
        const int row0 = u.pm * BM + wr * 64 + fr, col0 = u.pn * BM + wc * 64 + 8 * fq; const bool hi8 = fr & 8;
        f32x4 cs[2][2];
#pragma unroll
        for (int bj = 0; bj < 2; ++bj) { cs[bj][0] = *(const f32x4*)(sb + col0 + bj * 32); cs[bj][1] = *(const f32x4*)(sb + col0 + bj * 32 + 4); }
        float rsv[2][4];
#pragma unroll
        for (int ai = 0; ai < 2; ++ai)
#pragma unroll
            for (int m = 0; m < 4; ++m) rsv[ai][m] = sa[row0 + ai * HALF + m * 16];
        bf16_t* lp = Y + (size_t)(u.pm * BM + wr * 64 + (fr & 7)) * ldc + col0 + (hi8 ? 32 : 0);
#define PG8_RES_LOAD(XV, ai, mh) do { _Pragma("unroll") for (int mm = 0; mm < 2; ++mm) { const size_t off = (size_t)(row0 + (ai) * HALF + (2 * (mh) + mm) * 16) * ldc + col0; \
            _Pragma("unroll") for (int bj = 0; bj < 2; ++bj) { XV[mm][bj][0] = *(const f32x4*)(X + off + bj * 32); XV[mm][bj][1] = *(const f32x4*)(X + off + bj * 32 + 4); } } } while (0)
#define PG8_RES_DO(XV, ai, mh) do { _Pragma("unroll") for (int mm = 0; mm < 2; ++mm) { const int m = 2 * (mh) + mm; const float rs = rsv[ai][m]; \
            xchg_store2(lp + (size_t)((ai) * HALF + m * 16) * ldc, (size_t)ldc, \
                        pack8(i2f(acc[ai][0][m][0]) * cs[0][0] * rs + XV[mm][0][0] * alpha, i2f(acc[ai][0][m][1]) * cs[0][1] * rs + XV[mm][0][1] * alpha), \
                        pack8(i2f(acc[ai][1][m][0]) * cs[1][0] * rs + XV[mm][1][0] * alpha, i2f(acc[ai][1][m][1]) * cs[1][1] * rs + XV[mm][1][1] * alpha), hi8); } \
            asm volatile("" ::: "memory"); } while (0)
        f32x4 xa[2][2][2], xb[2][2][2];
        PG8_RES_LOAD(xa, 0, 0); PG8_RES_LOAD(xb, 0, 1);
        PG8_RES_DO(xa, 0, 0); PG8_RES_LOAD(xa, 1, 0);
        PG8_RES_DO(xb, 0, 1); PG8_RES_LOAD(xb, 1, 1);
        PG8_RES_DO(xa, 1, 0); PG8_RES_DO(xb, 1, 1);
#undef PG8_RES_LOAD
#undef PG8_RES_DO
    }
};
template <class Epi, class Sched, bool ALIGN_EPI = false, bool SP2 = false>
__device__ __forceinline__ void gemm_phase(PG8_LAS unsigned char* lds, const Gemm g, const Sched& S, const Epi& E) {
    const int tid = threadIdx.x, wid = __builtin_amdgcn_readfirstlane(tid >> 6), lane = tid & 63, wr = wid >> 2, wc = wid & 3, fr = lane & 15, fq = lane >> 4;
    const int K = g.K, nt = K / BK;
    unsigned voffA[2], voffB[2];
#pragma unroll
    for (int i = 0; i < 2; ++i) { int R, C; stage_rc(tid * 16 + i * 8192, R, C); const int Rb = Epi::PERM ? (64 * (R >> 5) + perm32(R & 31)) : R;
        voffA[i] = (unsigned)(R * K + C) * 2u; voffB[i] = (unsigned)(Rb * K + C) * 2u; }
    const size_t kstep = (size_t)(BK * 2);
    const size_t hstep = (size_t)HALF * K * 2;
    const size_t tstep = 2 * hstep;
    const size_t hstepB = Epi::PERM ? (size_t)32 * K * 2 : hstep;
    const unsigned ldsw = (unsigned)wid * 1024u;
    const int aoff = lds_byte(wr * 64 + fr, fq * 8), boff = lds_byte(wc * 32 + fr, fq * 8);
#define PG8_SA(b, h) (((b) * 2 + (h)) * HTB)
#define PG8_SB(b, h) ((4 + (b) * 2 + (h)) * HTB)
#define PG8_STAGE(bufoff, gbase, voff) do { _Pragma("unroll") for (int _i = 0; _i < 2; ++_i) \
        __builtin_amdgcn_global_load_lds((const unsigned*)((const char*)(gbase) + (voff)[_i]), (PG8_LAS unsigned*)(lds + (bufoff) + ldsw + _i * 8192), 16, 0, 0); } while (0)
#define PG8_LDA(dst, b, h) do { _Pragma("unroll") for (int m = 0; m < 4; ++m) _Pragma("unroll") for (int k = 0; k < 2; ++k) dst[m][k] = *(const PG8_LAS bf16x8*)(lds + PG8_SA(b, h) + aoff + m * 2048 + k * 1024); } while (0)
#define PG8_LDB(dst, b, h) do { _Pragma("unroll") for (int n = 0; n < 2; ++n) _Pragma("unroll") for (int k = 0; k < 2; ++k) dst[n][k] = *(const PG8_LAS bf16x8*)(lds + PG8_SB(b, h) + boff + n * 2048 + k * 1024); } while (0)
#define PG8_MMA(ai, bj, At, Bt) do { __builtin_amdgcn_s_setprio(1); _Pragma("unroll") for (int m = 0; m < 4; ++m) _Pragma("unroll") for (int n = 0; n < 2; ++n) _Pragma("unroll") for (int k = 0; k < 2; ++k) { \
        if constexpr (Epi::INT8) acc[ai][bj][m][n] = __builtin_bit_cast(f32x4, __builtin_amdgcn_mfma_i32_16x16x64_i8(__builtin_bit_cast(i32x4, Bt[n][k]), __builtin_bit_cast(i32x4, At[m][k]), __builtin_bit_cast(i32x4, acc[ai][bj][m][n]), 0, 0, 0)); \
        else acc[ai][bj][m][n] = __builtin_amdgcn_mfma_f32_16x16x32_bf16(Bt[n][k], At[m][k], acc[ai][bj][m][n], 0, 0, 0); } __builtin_amdgcn_s_setprio(0); } while (0)
#define PG8_WAIT_V(n) asm volatile("s_waitcnt vmcnt(" #n ")" ::: "memory")
#define PG8_WAIT_L(n) asm volatile("s_waitcnt lgkmcnt(" #n ")" ::: "memory")
#define PG8_BAR __builtin_amdgcn_s_barrier()
#define PG8_SCHED __builtin_amdgcn_sched_barrier(0)
    Unit cur, nxt; int ui = 0;
    if (!S.next(0, cur)) return;
    f32x4 acc[2][2][4][2];
#pragma unroll
    for (int a = 0; a < 2; ++a)
#pragma unroll
        for (int b = 0; b < 2; ++b)
#pragma unroll
            for (int m = 0; m < 4; ++m)
#pragma unroll
                for (int n = 0; n < 2; ++n) acc[a][b][m][n] = (f32x4){0.f, 0.f, 0.f, 0.f};
    bf16x8 At[4][2], B0[2][2], B1[2][2];
    const char* cA = (const char*)g.A + (size_t)cur.pm * tstep; const char* cB = (const char*)g.Bt + (size_t)cur.pn * tstep;
    S.a_ready(cur);
    if constexpr (SP2) {
        PG8_STAGE(PG8_SB(0, 0), cB, voffB); PG8_STAGE(PG8_SB(0, 1), cB + hstepB, voffB); PG8_STAGE(PG8_SA(0, 0), cA, voffA); PG8_STAGE(PG8_SA(0, 1), cA + hstep, voffA);
        if (wr == 1) PG8_BAR;
        PG8_WAIT_V(2); PG8_BAR;
        PG8_STAGE(PG8_SB(1, 0), cB + kstep, voffB); PG8_STAGE(PG8_SA(1, 0), cA + kstep, voffA); PG8_STAGE(PG8_SB(1, 1), cB + hstepB + kstep, voffB);
        PG8_WAIT_V(6); PG8_BAR;
    } else {
        PG8_STAGE(PG8_SB(0, 0), cB, voffB); PG8_STAGE(PG8_SA(0, 0), cA, voffA); PG8_STAGE(PG8_SB(0, 1), cB + hstepB, voffB); PG8_STAGE(PG8_SA(0, 1), cA + hstep, voffA);
        if (wr == 1) PG8_BAR;
        PG8_WAIT_V(4); PG8_BAR;
        PG8_STAGE(PG8_SB(1, 0), cB + kstep, voffB); PG8_STAGE(PG8_SA(1, 0), cA + kstep, voffA); PG8_STAGE(PG8_SB(1, 1), cB + hstepB + kstep, voffB);
        PG8_WAIT_V(6); PG8_BAR;
    }
    for (;;) {
        const bool has_next = S.next(ui + 1, nxt);
        const char* nA = has_next ? (const char*)g.A + (size_t)nxt.pm * tstep : cA; const char* nB = has_next ? (const char*)g.Bt + (size_t)nxt.pn * tstep : cB;
        for (int t = 0; t < nt; t += 2) {
            const bool last = (t == nt - 2);
            const char* a1 = cA + (size_t)(t + 1) * kstep;
            const char* a2 = last ? nA : cA + (size_t)(t + 2) * kstep; const char* b2 = last ? nB : cB + (size_t)(t + 2) * kstep;
            const char* a3 = a2 + kstep; const char* b3 = b2 + kstep;
            if (last && has_next) S.a_ready(nxt);
            if constexpr (SP2) {
            PG8_LDB(B0, 0, 0); PG8_LDB(B1, 0, 1); PG8_SCHED; PG8_LDA(At, 0, 0); PG8_STAGE(PG8_SA(1, 1), a1 + hstep, voffA);
            PG8_WAIT_V(8); PG8_WAIT_L(0); PG8_BAR; PG8_MMA(0, 0, At, B0); PG8_MMA(0, 1, At, B1); PG8_BAR; PG8_SCHED;
            PG8_LDA(At, 0, 1); PG8_STAGE(PG8_SB(0, 0), b2, voffB); PG8_STAGE(PG8_SB(0, 1), b2 + hstepB, voffB); PG8_STAGE(PG8_SA(0, 0), a2, voffA);
            PG8_WAIT_V(8); PG8_WAIT_L(0); PG8_BAR; PG8_MMA(1, 0, At, B0); PG8_MMA(1, 1, At, B1); PG8_BAR; PG8_SCHED;
            PG8_LDB(B0, 1, 0); PG8_LDB(B1, 1, 1); PG8_SCHED; PG8_LDA(At, 1, 0); PG8_STAGE(PG8_SA(0, 1), a2 + hstep, voffA);
            PG8_WAIT_V(8); PG8_WAIT_L(0); PG8_BAR; PG8_MMA(0, 0, At, B0); PG8_MMA(0, 1, At, B1); PG8_BAR; PG8_SCHED;
            PG8_LDA(At, 1, 1); PG8_STAGE(PG8_SB(1, 0), b3, voffB); PG8_STAGE(PG8_SB(1, 1), b3 + hstepB, voffB); PG8_STAGE(PG8_SA(1, 0), a3, voffA);
            PG8_WAIT_V(8); PG8_WAIT_L(0); PG8_BAR; PG8_MMA(1, 0, At, B0); PG8_MMA(1, 1, At, B1); PG8_BAR; PG8_SCHED;
            } else {
            PG8_LDB(B0, 0, 0); PG8_SCHED; PG8_LDA(At, 0, 0); PG8_STAGE(PG8_SA(1, 1), a1 + hstep, voffA);
            PG8_WAIT_L(8); PG8_BAR; PG8_WAIT_L(0); PG8_MMA(0, 0, At, B0); PG8_BAR; PG8_SCHED;
            PG8_LDB(B1, 0, 1); PG8_STAGE(PG8_SB(0, 0), b2, voffB);
            PG8_BAR; PG8_WAIT_L(0); PG8_MMA(0, 1, At, B1); PG8_BAR;
            PG8_LDA(At, 0, 1); PG8_STAGE(PG8_SA(0, 0), a2, voffA);
            PG8_BAR; PG8_WAIT_L(0); PG8_MMA(1, 0, At, B0); PG8_BAR; PG8_SCHED;
            PG8_STAGE(PG8_SB(0, 1), b2 + hstepB, voffB);
            PG8_WAIT_V(6); PG8_BAR; PG8_MMA(1, 1, At, B1); PG8_BAR;
            PG8_LDB(B0, 1, 0); PG8_SCHED; PG8_LDA(At, 1, 0); PG8_STAGE(PG8_SA(0, 1), a2 + hstep, voffA);
            PG8_WAIT_L(8); PG8_BAR; PG8_WAIT_L(0); PG8_MMA(0, 0, At, B0); PG8_BAR; PG8_SCHED;
            PG8_LDB(B1, 1, 1); PG8_STAGE(PG8_SB(1, 0), b3, voffB);
            PG8_BAR; PG8_WAIT_L(0); PG8_MMA(0, 1, At, B1); PG8_BAR;
            PG8_LDA(At, 1, 1); PG8_STAGE(PG8_SA(1, 0), a3, voffA);
            PG8_BAR; PG8_WAIT_L(0); PG8_MMA(1, 0, At, B0); PG8_BAR; PG8_SCHED;
            PG8_STAGE(PG8_SB(1, 1), b3 + hstepB, voffB);
            PG8_WAIT_V(6); PG8_BAR; PG8_MMA(1, 1, At, B1); PG8_BAR;
            }
        }
        if constexpr (ALIGN_EPI) { if (wr == 0) PG8_BAR; }
        if constexpr (!Epi::AFTER_DRAIN) { E(acc, cur, wr, wc, fr, fq); S.done(cur); }
        if (!has_next) break;
#pragma unroll
        for (int a = 0; a < 2; ++a)
#pragma unroll
            for (int b = 0; b < 2; ++b)
#pragma unroll
                for (int m = 0; m < 4; ++m)
#pragma unroll
                    for (int n = 0; n < 2; ++n) acc[a][b][m][n] = (f32x4){0.f, 0.f, 0.f, 0.f};
        cur = nxt; cA = nA; cB = nB; ++ui;
        if constexpr (ALIGN_EPI) { if (wr == 1) PG8_BAR; }
    }
    PG8_WAIT_V(0);
    if constexpr (!ALIGN_EPI) { if (wr == 0) PG8_BAR; }
    PG8_BAR;
    if constexpr (Epi::AFTER_DRAIN) { E.fused(acc, cur, wr, wc, fr, fq, lds, wid, lane); S.done(cur); }
#undef PG8_SA
#undef PG8_SB
#undef PG8_STAGE
#undef PG8_LDA
#undef PG8_LDB
#undef PG8_MMA
#undef PG8_WAIT_V
#undef PG8_WAIT_L
#undef PG8_BAR
#undef PG8_SCHED
}
}
#include <hip/hip_bf16.h>
#include <cmath>
namespace dattn {
using bf16 = __hip_bfloat16;
typedef short bf16x8 __attribute__((ext_vector_type(8)));
typedef short s16x4 __attribute__((ext_vector_type(4)));
typedef float f32x16 __attribute__((ext_vector_type(16)));
typedef unsigned u32x4 __attribute__((ext_vector_type(4)));
constexpr int DK = 64, DV = 128, RS = 1024, SEQ = 4096;
constexpr int NW = 8, QBLK = 32, KVBLK = 64, QB = NW * QBLK;
constexpr int SHM_V = KVBLK * DV * 2, SHM_K = KVBLK * DK * 2;
constexpr int NVB = 3;
constexpr int LDS_WS = NVB * SHM_V + 2 * SHM_K, LDS_TAB = LDS_WS + NW * 64 * 4, LDS_OST = 69632, OST_WAVE = 4096, LDS_SG = LDS_OST + NW * OST_WAVE, LDS_BYTES = LDS_SG + 512;
constexpr int TAB_PADL = 260, TAB_N = TAB_PADL + 128 + 94;
static_assert(LDS_TAB + TAB_N * 4 <= LDS_OST, "attention LDS map");
constexpr float THR = 8.f;
constexpr float C2 = 0.125f * 1.4426950408889634f;
#define DA_KSWZ(row, colB) ((row) * 128 + ((colB) ^ (((row) & 7) << 4)))
#define DA_SBAR() __builtin_amdgcn_sched_barrier(0)
__device__ __forceinline__ int v_st(int k, int c) { const int kk = k;     return ((kk >> 3) * 4 + (c >> 5)) * 512 + ((kk & 7) * 32 + (c & 31)) * 2; }
__device__ __forceinline__ int v_rd_base(int lane) { return ((lane & 3) << 3) | (((lane >> 2) & 3) << 6) | (((lane >> 4) & 1) << 5) | (((lane >> 5) & 1) << 8); }
constexpr int v_rd_off(int d0, int ks, int half) { return d0 * 512 + ks * 4096 + half * 2048; }
__device__ __forceinline__ int crow(int r, int hi) { return (r & 3) + 8 * (r >> 2) + 4 * hi; }
__device__ __forceinline__ unsigned cvtpk(float lo, float hi) { unsigned r; asm volatile("v_cvt_pk_bf16_f32 %0, %1, %2" : "=v"(r) : "v"(lo), "v"(hi)); return r; }
__device__ __forceinline__ bf16x8 load8(const bf16* p) { return *reinterpret_cast<const bf16x8*>(p); }
__device__ __forceinline__ void bias_tile(f32x16& p0, f32x16& p1, int dq, const __attribute__((address_space(3))) float* tabp) {
    const __attribute__((address_space(3))) float* bp = tabp + (TAB_PADL - 59) + dq;
#pragma unroll
    for (int r = 0; r < 16; ++r) { const int c = (r & 3) + 8 * (r >> 2); p0[r] += bp[59 - c]; p1[r] += bp[27 - c]; }
}
__device__ __forceinline__ void rowmaxSM(const f32x16& p0, const f32x16& p1, float& m_reg, float& mn, float& alpha) {
    float ma_ = p0[0], mb_ = p1[0];
#pragma unroll
    for (int r = 1; r < 15; r += 2) { ma_ = fmaxf(fmaxf(ma_, p0[r]), p0[r + 1]); mb_ = fmaxf(fmaxf(mb_, p1[r]), p1[r + 1]); }
    float pmax = fmaxf(fmaxf(ma_, p0[15]), fmaxf(mb_, p1[15]));
    { auto rr = __builtin_amdgcn_permlane32_swap(__float_as_uint(pmax), __float_as_uint(pmax), false, false); pmax = fmaxf(__uint_as_float(rr[0]), __uint_as_float(rr[1])); }
    if (__builtin_expect(__all(pmax - m_reg <= THR), 1)) { mn = m_reg; alpha = 1.f; }
    else { mn = fmaxf(m_reg, pmax); alpha = __builtin_amdgcn_exp2f(m_reg - mn); m_reg = mn; }
}
__device__ __forceinline__ void expSM(f32x16& p0, f32x16& p1, float mn) {
#pragma unroll
    for (int r = 0; r < 16; ++r) { p0[r] = __builtin_amdgcn_exp2f(p0[r] - mn); p1[r] = __builtin_amdgcn_exp2f(p1[r] - mn); }
}
__device__ __forceinline__ void finishSM(f32x16& p0, f32x16& p1, float alpha, float& l_reg, bf16x8& pa0, bf16x8& pa1, bf16x8& pa2, bf16x8& pa3) {
    float s0_ = p0[0], s1_ = p0[1], s2_ = p1[0], s3_ = p1[1];
#pragma unroll
    for (int r = 2; r < 16; r += 2) { s0_ += p0[r]; s1_ += p0[r + 1]; s2_ += p1[r]; s3_ += p1[r + 1]; }
    float ps = (s0_ + s1_) + (s2_ + s3_);
    { auto rr = __builtin_amdgcn_permlane32_swap(__float_as_uint(ps), __float_as_uint(ps), false, false); ps = __uint_as_float(rr[0]) + __uint_as_float(rr[1]); }
    l_reg = l_reg * alpha + ps;
#define DA_PK4(P, B_, OUT) do { u32x4 w = {cvtpk(P[B_+0], P[B_+1]), cvtpk(P[B_+2], P[B_+3]), cvtpk(P[B_+4], P[B_+5]), cvtpk(P[B_+6], P[B_+7])};     \
        OUT = *reinterpret_cast<bf16x8*>(&w); } while (0)
    DA_PK4(p0, 0, pa0); DA_PK4(p0, 8, pa1); DA_PK4(p1, 0, pa2); DA_PK4(p1, 8, pa3);
#undef DA_PK4
}
template <int KB>
__device__ __forceinline__ void qkt(f32x16& p0, f32x16& p1, const char* K_lds, int r32, int hi, const bf16x8* qr) {
    p0 = f32x16{}; p1 = f32x16{};
#pragma unroll
    for (int d0 = 0; d0 < 4; ++d0) { const char* a = K_lds + KB * SHM_K + DA_KSWZ(r32, (d0 * 16 + hi * 8) * 2);
        const bf16x8 b0 = *reinterpret_cast<const bf16x8*>(a), b1 = *reinterpret_cast<const bf16x8*>(a + 32 * 128);
        p0 = __builtin_amdgcn_mfma_f32_32x32x16_bf16(b0, qr[d0], p0, 0, 0, 0);
        p1 = __builtin_amdgcn_mfma_f32_32x32x16_bf16(b1, qr[d0], p1, 0, 0, 0); }
}
template <bool FILL>
__device__ __forceinline__ void pv_tile(f32x16* o, int vb0  , bf16x8 pa0, bf16x8 pa1, bf16x8 pa2, bf16x8 pa3, f32x16& px0, f32x16& px1, float mn) {
#define DA_TRRD(dst, off) asm volatile("ds_read_b64_tr_b16 %0, %1 offset:%2" : "=&v"(dst) : "v"(vb0), "i"(off) : "memory")
#define DA_RD2(m, l, h) do { constexpr int b_ = v_rd_off((m) >> 2, 0, 0) + ((m) & 3) * 4096; DA_TRRD(l, b_); DA_TRRD(h, b_ + 2048); } while (0)
#define DA_MM(m, pa, l, h) do { o[(m) >> 2] = __builtin_amdgcn_mfma_f32_32x32x16_bf16(pa, (bf16x8){l[0], l[1], l[2], l[3], h[0], h[1], h[2], h[3]}, o[(m) >> 2], 0, 0, 0); } while (0)
#define DA_LGK(n) asm volatile("s_waitcnt lgkmcnt(" #n ")" ::: "memory")
#define DA_FILL(m) do { if constexpr (FILL) { float a_ = __builtin_amdgcn_exp2f(px0[m] - mn), b_ = __builtin_amdgcn_exp2f(px1[m] - mn); asm volatile("" : "+v"(a_), "+v"(b_)); px0[m] = a_; px1[m] = b_; } } while (0)
    s16x4 l0, h0, l1, h1, l2, h2, l3, h3, l4, h4, l5, h5, l6, h6, l7, h7, l8, h8, l9, h9, l10, h10, l11, h11, l12, h12, l13, h13, l14, h14, l15, h15;
    DA_SBAR();
    DA_RD2(0, l0, h0); DA_RD2(1, l1, h1); DA_RD2(2, l2, h2); DA_RD2(3, l3, h3);
    DA_LGK(6); DA_SBAR(); DA_MM(0, pa0, l0, h0); DA_FILL(0); DA_SBAR(); DA_RD2(4, l4, h4);
    DA_LGK(6); DA_SBAR(); DA_MM(1, pa1, l1, h1); DA_FILL(1); DA_SBAR(); DA_RD2(5, l5, h5);
    DA_LGK(6); DA_SBAR(); DA_MM(2, pa2, l2, h2); DA_FILL(2); DA_SBAR(); DA_RD2(6, l6, h6);
    DA_LGK(6); DA_SBAR(); DA_MM(3, pa3, l3, h3); DA_FILL(3); DA_SBAR(); DA_RD2(7, l7, h7);
    DA_LGK(6); DA_SBAR(); DA_MM(4, pa0, l4, h4); DA_FILL(4); DA_SBAR(); DA_RD2(8, l8, h8);
    DA_LGK(6); DA_SBAR(); DA_MM(5, pa1, l5, h5); DA_FILL(5); DA_SBAR(); DA_RD2(9, l9, h9);
    DA_LGK(6); DA_SBAR(); DA_MM(6, pa2, l6, h6); DA_FILL(6); DA_SBAR(); DA_RD2(10, l10, h10);
    DA_LGK(6); DA_SBAR(); DA_MM(7, pa3, l7, h7); DA_FILL(7); DA_SBAR(); DA_RD2(11, l11, h11);
    DA_LGK(6); DA_SBAR(); DA_MM(8, pa0, l8, h8); DA_FILL(8); DA_SBAR(); DA_RD2(12, l12, h12);
    DA_LGK(6); DA_SBAR(); DA_MM(9, pa1, l9, h9); DA_FILL(9); DA_SBAR(); DA_RD2(13, l13, h13);
    DA_LGK(6); DA_SBAR(); DA_MM(10, pa2, l10, h10); DA_FILL(10); DA_SBAR(); DA_RD2(14, l14, h14);
    DA_LGK(6); DA_SBAR(); DA_MM(11, pa3, l11, h11); DA_FILL(11); DA_SBAR(); DA_RD2(15, l15, h15);
    DA_LGK(6); DA_SBAR(); DA_MM(12, pa0, l12, h12); DA_FILL(12); DA_SBAR();
    DA_LGK(4); DA_SBAR(); DA_MM(13, pa1, l13, h13); DA_FILL(13); DA_SBAR();
    DA_LGK(2); DA_SBAR(); DA_MM(14, pa2, l14, h14); DA_FILL(14); DA_SBAR();
    DA_LGK(0); DA_SBAR(); DA_MM(15, pa3, l15, h15); DA_FILL(15); DA_SBAR();
#undef DA_FILL
#undef DA_LGK
#undef DA_MM
#undef DA_RD2
#undef DA_TRRD
}
struct BlockRef { const bf16* Q; const bf16* K; const bf16* V; bf16* O; int P0; int comb; };
struct Seam { bf16x8 qr[4]; bf16x8 st_v0, st_v1, st_k0; };
#define DA_VMW() asm volatile("s_waitcnt vmcnt(0)" ::: "memory")
#define DA_VMWN(n) asm volatile("s_waitcnt vmcnt(%0)" :: "i"(n) : "memory")
#define DA_SLOAD(Kp, Vp, k0) do { S.st_v0 = load8((Vp) + (size_t)((k0) + sr) * RS + sc); S.st_v1 = load8((Vp) + (size_t)((k0) + 32 + sr) * RS + sc); S.st_k0 = load8((Kp) + (size_t)((k0) + kr) * RS + kc); } while (0)
#define DA_SWRITE_K(bf) do { *(bf16x8*)(K_lds + (bf) * SHM_K + kws) = S.st_k0; } while (0)
#define DA_SWRITE_V(bf) do { *(bf16x8*)(V_lds + (bf) * SHM_V + vst0) = S.st_v0; *(bf16x8*)(V_lds + (bf) * SHM_V + vst1) = S.st_v1; } while (0)
__device__ __forceinline__ void prime(const BlockRef& cur, char* lds, Seam& S) {
    const int tid = threadIdx.x, wid = __builtin_amdgcn_readfirstlane(tid >> 6), lane = tid & 63, r32 = lane & 31, hi = lane >> 5;
    const int sr = tid >> 4, sc = (tid & 15) * 8, kr = tid >> 3, kc = (tid & 7) * 8, kws = DA_KSWZ(kr, kc * 2); char* K_lds = lds + NVB * SHM_V;
#pragma unroll
    for (int d0 = 0; d0 < 4; ++d0) S.qr[d0] = load8(cur.Q + (size_t)(wid * QBLK + r32) * RS + d0 * 16 + hi * 8);
    DA_SLOAD(cur.K, cur.V, 0); DA_VMW(); DA_SWRITE_K(0);
    __syncthreads();
}
__device__ __forceinline__ void block(const BlockRef& cur, const BlockRef& nxt, char* lds, Seam& S, float lam) {
    const int tid = threadIdx.x, wid = __builtin_amdgcn_readfirstlane(tid >> 6), lane = tid & 63, r32 = lane & 31, hi = lane >> 5;
    const int NT = (cur.P0 + QB) / KVBLK;
    const int qlo = cur.P0 + wid * QBLK, qm = qlo + r32 - 4 * hi;
    char* V_lds = lds; char* K_lds = lds + NVB * SHM_V;
    float* ws = (float*)(lds + LDS_WS) + wid * 64; float* li_l = ws, * al_l = ws + 32;
    const __attribute__((address_space(3))) float* tab = (const __attribute__((address_space(3))) float*)((__attribute__((address_space(3))) char*)lds + LDS_TAB);
    float m_reg = -1e30f, l_reg = 0; f32x16 o[4] = {};
    const int sr = tid >> 4, sc = (tid & 15) * 8, vst0 = v_st(sr, sc), vst1 = v_st(32 + sr, sc), kr = tid >> 3, kc = (tid & 7) * 8, kws = DA_KSWZ(kr, kc * 2);
    const int vb0 = (int)(uintptr_t)V_lds + v_rd_base(lane);
    const bf16* Kh = cur.K; const bf16* Vh = cur.V;
#define DA_RESC(a) do { if (__any((a) < 1.f)) { if (hi == 0) al_l[r32] = (a); asm volatile("s_waitcnt lgkmcnt(0)" ::: "memory"); \
                     _Pragma("unroll") for (int d_ = 0; d_ < 4; ++d_) _Pragma("unroll") for (int r = 0; r < 16; ++r) o[d_][r] *= al_l[crow(r, hi)]; } } while (0)
#define DA_KBASE(t) ((t) * KVBLK)
#define DA_MASKT(P0_, P1_, t) do { const int kb_ = DA_KBASE(t); if (kb_ + KVBLK - 1 >= qlo - 127) bias_tile(P0_, P1_, qm - kb_, tab); } while (0)
    constexpr int NQL = 4;
#define DA_SEAM_K0() do { DA_VMWN(NQL); DA_SWRITE_K(0); DA_SBAR(); } while (0)
    f32x16 pA0, pA1, pB0, pB1; float mnA, mnB, alA, alB; bf16x8 pa0, pa1, pa2, pa3;
    DA_SWRITE_V(0); DA_SBAR();
    DA_SLOAD(Kh, Vh, DA_KBASE(1));
    DA_SBAR(); qkt<0>(pA0, pA1, K_lds, r32, hi, S.qr);
    DA_MASKT(pA0, pA1, 0); rowmaxSM(pA0, pA1, m_reg, mnA, alA); expSM(pA0, pA1, mnA);
    DA_VMW(); DA_SWRITE_V(1); DA_SWRITE_K(1); DA_SBAR();
    DA_SLOAD(Kh, Vh, DA_KBASE(2));
    __syncthreads();
    int vrd = 0, vwr = 2;
#define DA_NEXT3(x) ((x) == NVB - 1 ? 0 : (x) + 1)
#define DA_HALF_STEP(PX0, PX1, mnX, alX, PY0, PY1, alY, t, KB) do { \
        DA_SBAR(); qkt<KB>(PX0, PX1, K_lds, r32, hi, S.qr); \
        finishSM(PY0, PY1, alY, l_reg, pa0, pa1, pa2, pa3); DA_SBAR(); \
        DA_VMW(); DA_SWRITE_K(1 - (KB)); DA_SWRITE_V(vwr); DA_SBAR(); \
        if ((t) + 2 < NT) { DA_SLOAD(Kh, Vh, DA_KBASE((t) + 2)); DA_SBAR(); } \
        DA_MASKT(PX0, PX1, (t)); rowmaxSM(PX0, PX1, m_reg, mnX, alX); DA_SBAR(); \
        pv_tile<true>(o, vb0 + vrd * SHM_V, pa0, pa1, pa2, pa3, PX0, PX1, mnX); \
        DA_RESC(alX); __syncthreads(); vrd = DA_NEXT3(vrd); vwr = DA_NEXT3(vwr); } while (0)
    for (int t = 1; t + 1 < NT; t += 2) {
        DA_HALF_STEP(pB0, pB1, mnB, alB, pA0, pA1, alA, t, 1);
        DA_HALF_STEP(pA0, pA1, mnA, alA, pB0, pB1, alB, t + 1, 0);
    }
    DA_SBAR(); qkt<1>(pB0, pB1, K_lds, r32, hi, S.qr); DA_SBAR();
    DA_SLOAD(nxt.K, nxt.V, 0); DA_SBAR();
#pragma unroll
    for (int d0 = 0; d0 < 4; ++d0) S.qr[d0] = load8(nxt.Q + (size_t)(wid * QBLK + r32) * RS + d0 * 16 + hi * 8);
    DA_SBAR();
    finishSM(pA0, pA1, alA, l_reg, pa0, pa1, pa2, pa3); DA_SBAR();
    DA_MASKT(pB0, pB1, NT - 1); rowmaxSM(pB0, pB1, m_reg, mnB, alB); DA_SBAR();
    pv_tile<true>(o, vb0 + vrd * SHM_V, pa0, pa1, pa2, pa3, pB0, pB1, mnB); vrd = DA_NEXT3(vrd);
    DA_RESC(alB);
    finishSM(pB0, pB1, alB, l_reg, pa0, pa1, pa2, pa3); DA_SBAR(); pv_tile<false>(o, vb0 + vrd * SHM_V, pa0, pa1, pa2, pa3, pB0, pB1, 0.f);
    __syncthreads();
    DA_SBAR(); DA_SEAM_K0();
    bf16* Ow = cur.O + (size_t)(wid * QBLK) * RS;
    u32x4 w1a[2][4] = {};
    if (cur.comb) {
#pragma unroll
        for (int ps = 0; ps < 2; ++ps)
#pragma unroll
            for (int i = 0; i < 4; ++i) w1a[ps][i] = *(const u32x4*)(Ow + (size_t)(16 * ps + 4 * i + (lane >> 4)) * RS + (lane & 15) * 8); }
    if (hi == 0) li_l[r32] = l_reg; asm volatile("s_waitcnt lgkmcnt(0)" ::: "memory");
    { char* stg = lds + LDS_OST + wid * OST_WAVE;
#pragma unroll
      for (int ps = 0; ps < 2; ++ps) {
#pragma unroll
          for (int r = 8 * ps; r < 8 * ps + 8; ++r) { const int orow = crow(r, hi) - 16 * ps; const float rli_r = __builtin_amdgcn_rcpf(li_l[crow(r, hi)]);
#pragma unroll
              for (int d0 = 0; d0 < 4; ++d0) { const float v = o[d0][r] * rli_r;
                  const float vn = __int_as_float(__builtin_amdgcn_update_dpp(0, __float_as_int(v), 0xB1, 0xf, 0xf, true));
                  if ((r32 & 1) == 0) *(unsigned*)(stg + orow * 256 + (d0 * 32 + r32) * 2) = cvtpk(v, vn); } }
          asm volatile("s_waitcnt lgkmcnt(0)" ::: "memory");
          u32x4 w[4];
#pragma unroll
          for (int i = 0; i < 4; ++i) { const int row = 4 * i + (lane >> 4), ch = lane & 15; w[i] = *(const u32x4*)(stg + row * 256 + ch * 16); }
          asm volatile("s_waitcnt lgkmcnt(0)" ::: "memory");
          if (cur.comb) {
              const int ch = lane & 15; const float* gp = (const float*)(lds + LDS_SG) + 8 * ch; const pg8::f32x4 g0 = *(const pg8::f32x4*)gp, g1 = *(const pg8::f32x4*)(gp + 4);
#pragma unroll
              for (int i = 0; i < 4; ++i) { const u32x4 w1 = w1a[ps][i];
                  const unsigned a1[4] = {w1.x, w1.y, w1.z, w1.w}, a2[4] = {w[i].x, w[i].y, w[i].z, w[i].w}; float av[8]; float ss = 0.f;
#pragma unroll
                  for (int k = 0; k < 4; ++k) { av[2 * k] = __uint_as_float(a1[k] << 16) - lam * __uint_as_float(a2[k] << 16); av[2 * k + 1] = __uint_as_float(a1[k] & 0xffff0000u) - lam * __uint_as_float(a2[k] & 0xffff0000u); ss += av[2 * k] * av[2 * k] + av[2 * k + 1] * av[2 * k + 1]; }
#define DA_DPPF(v, ctrl) __int_as_float(__builtin_amdgcn_update_dpp(0, __float_as_int(v), ctrl, 0xf, 0xf, true))
                  ss += DA_DPPF(ss, 0xB1); ss += DA_DPPF(ss, 0x4E); ss += DA_DPPF(ss, 0x141); ss += DA_DPPF(ss, 0x140);
#undef DA_DPPF
                  const float rn = 0.8f * __builtin_amdgcn_rsqf(ss * (1.f / 128.f) + 1e-5f);
                  w[i] = (u32x4){cvtpk(av[0] * rn * g0[0], av[1] * rn * g0[1]), cvtpk(av[2] * rn * g0[2], av[3] * rn * g0[3]), cvtpk(av[4] * rn * g1[0], av[5] * rn * g1[1]), cvtpk(av[6] * rn * g1[2], av[7] * rn * g1[3])}; } }
#pragma unroll
          for (int i = 0; i < 4; ++i) { const int row = 4 * i + (lane >> 4), ch = lane & 15; *(u32x4*)(Ow + (size_t)(16 * ps + row) * RS + ch * 8) = w[i]; } } }
    __syncthreads();
#undef DA_NEXT3
#undef DA_RESC
#undef DA_KBASE
#undef DA_MASKT
#undef DA_SEAM_K0
#undef DA_HALF_STEP
}
#undef DA_VMW
#undef DA_VMWN
#undef DA_SLOAD
#undef DA_SWRITE_K
#undef DA_SWRITE_V
struct Tensors { const bf16* Q; const bf16* K; const bf16* V; bf16* O1; const float* biastab; const float* subln_g; float lam; };
__device__ __forceinline__ BlockRef unit_ref(const Tensors& T, int v, int i) {
    const int bh = (v & 255) >> 2, s = v & 3, b = bh >> 3, h = bh & 7, c = i & 1, pi = i >> 1; const int qb = pi == 0 ? s : pi == 1 ? 15 - s : pi == 2 ? 4 + s : 11 - s;
    const size_t row0 = (size_t)b * SEQ; BlockRef r;
    r.Q = T.Q + (row0 + (size_t)qb * QB) * RS + (2 * h + c) * DK; r.K = T.K + row0 * RS + (2 * h + c) * DK; r.V = T.V + row0 * RS + h * DV;
    r.O = T.O1 + (row0 + (size_t)qb * QB) * RS + h * DV; r.P0 = qb * QB; r.comb = c; return r;
}
__device__ __forceinline__ void phase(char* lds, const Tensors& T, int vcu) {
    { const int h = ((vcu & 255) >> 2) & 7, i = (int)threadIdx.x; if (i < TAB_N) ((float*)(lds + LDS_TAB))[i] = i < TAB_PADL ? -__builtin_inff() : (i < TAB_PADL + 128 ? T.biastab[h * 128 + i - TAB_PADL] : 0.f); }
    if (threadIdx.x < 128) ((float*)(lds + LDS_SG))[threadIdx.x] = T.subln_g[threadIdx.x];
    Seam S; BlockRef cur = unit_ref(T, vcu, 0);
    prime(cur, lds, S);
    if (threadIdx.x >= 256) __builtin_amdgcn_s_setprio(1);
    for (int i = 0; i < 8; ++i) { const BlockRef nxt = unit_ref(T, vcu, i + 1 < 8 ? i + 1 : i); block(cur, nxt, lds, S, T.lam); cur = nxt; }
    __builtin_amdgcn_s_setprio(0);
}
#undef DA_KSWZ
#undef DA_SBAR
}
#ifndef PG8_SP2
#define PG8_SP2 true
#endif
#ifndef PG8_ALIGN
#define PG8_ALIGN true
#endif
constexpr int NWAVES = 8;
#ifndef MK_N_LAUNCHES
#define MK_N_LAUNCHES 1
#endif
constexpr int N_PHASES = 8;
constexpr int BATCH = 8, SEQ = 4096, D = 2048, M = BATCH * SEQ;
constexpr int NPROJ = 5120, DATT = 1024, DCONV = 1024, CONVW = 31;
constexpr int PH = 8, PNK = 128, PHALF = 128, PTOPK = 16, NEXP = 16384;
constexpr float LN_EPS = 1e-5f;
constexpr float DN_ALPHA = 1.189207115002721f;
constexpr float LAMBDA_INIT = 0.2f;
constexpr size_t MiB = 1u << 20;
constexpr size_t WS_WIN = 2 * MiB, WS_WOUT = 22 * MiB, WS_WQ = 30 * MiB, WS_KEYS = 38 * MiB, WS_TAB = 39 * MiB;
constexpr size_t WS_U8 = 40 * MiB, WS_V8 = 72 * MiB, WS_SU = 104 * MiB, WS_SV = 105 * MiB;
constexpr size_t WS_XB = 168 * MiB;
constexpr size_t WS_Q = 296 * MiB, WS_K = 360 * MiB, WS_V = 424 * MiB, WS_H = 488 * MiB;
constexpr size_t WS_O1 = 552 * MiB, WS_O2 = 616 * MiB;
constexpr size_t WS_Y1 = 680 * MiB;
constexpr size_t WS_QP = 808 * MiB;
constexpr size_t WS_X8 = WS_O1;
constexpr size_t WS_SX = 106 * MiB, WS_SWQ = 107 * MiB, WS_SWIN = WS_SWQ + 65536, WS_SWOUT = WS_SWQ + 131072, WS_SXA = 108 * MiB, WS_SM = 109 * MiB, WS_LNS = 110 * MiB, WS_SXQ = 111 * MiB, WS_NSU = 112 * MiB;
constexpr size_t WS_XH = WS_O2, WS_XL = WS_O2 + 32 * MiB;
constexpr size_t WS_CMAX = 16384;
constexpr size_t WS_EID = 936 * MiB, WS_GATE = 952 * MiB;
constexpr size_t WS_END = 968 * MiB;
constexpr int RING_BYTES = 131072, LDS_BYTES = 163840;

#define GAS __attribute__((address_space(1)))
#define LAS __attribute__((address_space(3)))
typedef unsigned short bf16;
typedef unsigned v4u __attribute__((ext_vector_type(4)));
typedef unsigned v2u __attribute__((ext_vector_type(2)));
typedef float f32x4 __attribute__((ext_vector_type(4)));
typedef float f32x16 __attribute__((ext_vector_type(16)));
typedef short bf16x8 __attribute__((ext_vector_type(8)));
typedef __bf16 bf16x2_t __attribute__((ext_vector_type(2)));
#define LDS_WAIT() asm volatile("s_waitcnt lgkmcnt(0)" ::: "memory")
#ifndef PROBE_SEC
#define PROBE_SEC -1
#endif
#ifndef PROBE_REP
#define PROBE_REP -1
#endif
#define SEC_REP(id) for (int sec_rep_ = 0; sec_rep_ < ((PROBE_REP == (id)) ? 2 : 1); ++sec_rep_)
#define SEC_BEGIN(id) const unsigned long long sec_t0_##id = (PROBE_SEC == (id)) ? __builtin_amdgcn_s_memrealtime() : 0ull
#define SEC_END(id) do { if (PROBE_SEC == (id)) { const unsigned long long t1_ = __builtin_amdgcn_s_memrealtime(), dt_ = t1_ - sec_t0_##id; while (__builtin_amdgcn_s_memrealtime() - t1_ < dt_) __builtin_amdgcn_s_sleep(4); } } while (0)
__device__ __forceinline__ unsigned f2bf(float f) { unsigned u = __builtin_bit_cast(unsigned, f); return (u + 0x7fffu + ((u >> 16) & 1u)) >> 16; }
__device__ __forceinline__ unsigned pk2(float lo, float hi) { return f2bf(lo) | (f2bf(hi) << 16); }
__device__ __forceinline__ float bflo(unsigned w) { return __uint_as_float(w << 16); }
__device__ __forceinline__ float bfhi(unsigned w) { return __uint_as_float(w & 0xffff0000u); }
__device__ __forceinline__ float wave_sum(float v);
__device__ __forceinline__ float wave_max(float v);
__device__ __forceinline__ float dot2bf(unsigned a, unsigned b, float acc) { return __builtin_amdgcn_fdot2_f32_bf16(__builtin_bit_cast(bf16x2_t, a), __builtin_bit_cast(bf16x2_t, b), acc, false); }

#define XB_TMO      128
#define XB_XCNT(j)  (256  + 64 * (j))
#define XB_XSUB(j)  (1280 + 64 * (j))
#define XB_XGEN(j)  (2304 + 64 * (j))
#define XB_TOP      3328
#define XB_TOPGEN   3392
#define XCD_BAR_WORDS 3456
#define XB_SPIN_CAP (1u << 18)

__device__ __forceinline__ unsigned xb_ld(unsigned* p)              { return __hip_atomic_load(p, __ATOMIC_RELAXED, __HIP_MEMORY_SCOPE_AGENT); }
__device__ __forceinline__ unsigned xb_add(unsigned* p, unsigned v) { return __hip_atomic_fetch_add(p, v, __ATOMIC_RELAXED, __HIP_MEMORY_SCOPE_AGENT); }
__device__ __forceinline__ unsigned xb_xcc_id() { return (unsigned)__builtin_amdgcn_s_getreg((3 << 11) | 20) & 0xFu; }
#define XB_SPIN(cond, bar) do { unsigned _sp = 0; while (cond) { __builtin_amdgcn_s_sleep(1); \
    if ((++_sp & 255u) == 0u) { if (xb_ld(&(bar)[XB_TMO])) break; if (_sp > XB_SPIN_CAP) { atomicAdd(&(bar)[XB_TMO], 1u); break; } } } } while (0)

struct XcdBarrier {
    unsigned* bar; unsigned x;
    volatile LAS unsigned* st;
};

__device__ __forceinline__ XcdBarrier xcd_barrier_post(unsigned* bar, volatile LAS unsigned* st) {
    XcdBarrier b; b.bar = bar; b.x = xb_xcc_id(); b.st = st;
    if (threadIdx.x == 0) (void)xb_add(&bar[XB_XCNT(b.x)], 1u);
    return b;
}
__device__ __forceinline__ void xcd_barrier_complete(unsigned* bar, unsigned x, unsigned& nloc, unsigned& nx) {
    const unsigned G = gridDim.x * gridDim.y * gridDim.z;
    unsigned sum, cnt, mine, sp = 0u;
    for (;;) {
        sum = 0u; cnt = 0u; mine = 0u;
#pragma unroll
        for (unsigned j = 0; j < 16; ++j) { const unsigned c = xb_ld(&bar[XB_XCNT(j)]); sum += c; cnt += (c > 0u) ? 1u : 0u; mine = (j == x) ? c : mine; }
        if (sum == G) break;
        __builtin_amdgcn_s_sleep(1);
        if ((++sp & 255u) == 0u) { if (xb_ld(&bar[XB_TMO])) break; if (sp > XB_SPIN_CAP) { atomicAdd(&bar[XB_TMO], 1u); break; } }
    }
    nloc = mine > 0u ? mine : 1u; nx = cnt > 0u ? cnt : 1u;
}

__device__ __forceinline__ void xcd_barrier(const XcdBarrier& b) {
    asm volatile("s_waitcnt vmcnt(0)" ::: "memory");
    __syncthreads();
    if (threadIdx.x == 0) {
        unsigned* bar = b.bar;
        __builtin_amdgcn_s_waitcnt(0);
        unsigned nloc = b.st[0], nx = b.st[1];
        if (nloc == 0u) { xcd_barrier_complete(bar, b.x, nloc, nx); b.st[0] = nloc; b.st[1] = nx; }
        const unsigned old = xb_add(&bar[XB_XSUB(b.x)], 1u);
        const unsigned gen = old / nloc;
        if (old + 1u == (gen + 1u) * nloc) {
            __builtin_amdgcn_fence(__ATOMIC_RELEASE, "agent");
            asm volatile("s_waitcnt vmcnt(0)" ::: "memory");
            const unsigned og = xb_add(&bar[XB_TOP], 1u);
            const unsigned tg = og / nx;
            if (og + 1u == (tg + 1u) * nx) xb_add(&bar[XB_TOPGEN], 1u);
            else XB_SPIN(xb_ld(&bar[XB_TOPGEN]) == tg, bar);
            __builtin_amdgcn_fence(__ATOMIC_ACQUIRE, "agent");
            xb_add(&bar[XB_XGEN(b.x)], 1u);
            asm volatile("s_waitcnt vmcnt(0)" ::: "memory");
        } else {
            XB_SPIN(xb_ld(&bar[XB_XGEN(b.x)]) == gen, bar);
            __builtin_amdgcn_fence(__ATOMIC_ACQUIRE, "agent");
            asm volatile("s_waitcnt vmcnt(0)" ::: "memory");
        }
    }
    __syncthreads();
}

struct Frame {
    LAS unsigned char* lds;
    __device__ __forceinline__ int wave_() const { int w = __builtin_amdgcn_readfirstlane((int)threadIdx.x >> 6); asm volatile("" : "+s"(w)); return w; }
    __device__ __forceinline__ int G_() const { int g = (int)gridDim.x; asm volatile("" : "+s"(g)); return g; }
    __device__ __forceinline__ int vcu_() const { int bx = (int)blockIdx.x; asm volatile("" : "+s"(bx)); const int g = G_(); return (g % 8 == 0) ? (bx % 8) * (g / 8) + bx / 8 : bx; }
    __device__ __forceinline__ int tid() const { int t = (int)threadIdx.x; asm volatile("" : "+v"(t)); return t; }
    __device__ __forceinline__ int lane() const { return tid() & 63; }
    __device__ __forceinline__ unsigned long long raw(int k) const { const volatile LAS unsigned* p = (const volatile LAS unsigned*)(lds + RING_BYTES) + 2 * k;
        const unsigned lo = __builtin_amdgcn_readfirstlane(p[0]), hi = __builtin_amdgcn_readfirstlane(p[1]); return ((unsigned long long)hi << 32) | lo; }
    __device__ __forceinline__ const float* in(int k) const { return (const float*)(const GAS float*)raw(k); }
    __device__ __forceinline__ float* outp() const { return (float*)(GAS float*)raw(22); }
    template <class T> __device__ __forceinline__ T* ws(size_t off) const { return (T*)(GAS T*)((GAS unsigned char*)raw(23) + off); }
};
enum { I_X = 0, I_WIN, I_BGLU, I_CONVW, I_CONVB, I_CLNG, I_CLNB, I_LQ1, I_LK1, I_LQ2, I_LK2, I_SUBLN, I_RELB, I_WOUT, I_LN1G, I_LN1B, I_WQ, I_KEYS, I_U, I_V, I_LN2G, I_LN2B };

template <int CTRL> __device__ __forceinline__ int dppi(int v) { return __builtin_amdgcn_update_dpp(0, v, CTRL, 0xf, 0xf, true); }
template <int CTRL> __device__ __forceinline__ float dppf(float v) { return __int_as_float(__builtin_amdgcn_update_dpp(0, __float_as_int(v), CTRL, 0xf, 0xf, true)); }
__device__ __forceinline__ unsigned pack_i8x4(float a, float b, float c, float d) {
    const int ia = (int)rintf(a), ib = (int)rintf(b), ic = (int)rintf(c), id = (int)rintf(d); return (unsigned)(ia & 255) | ((unsigned)(ib & 255) << 8) | ((unsigned)(ic & 255) << 16) | ((unsigned)id << 24); }
__device__ __forceinline__ int glu_dst(int n0) {
    if (n0 < 3072) return n0;
    const int ch = (n0 - 3072) & 1023, gate = (n0 - 3072) >> 10; return 3072 + 256 * (ch >> 7) + 64 * ((ch & 127) >> 5) + 32 * gate + (ch & 31);
}
__device__ __forceinline__ void p0_quant_decode(int r, int& w, int& N, int& k0, int& n0, int& dst0, int& coff) {
    constexpr int I_IN = (D / 64) * (NPROJ / 32), I_OUT = (D / 64) * (D / 32);
    int q;
    if (r < I_IN) { w = 0; N = NPROJ; q = r; coff = 0; } else if (r < I_IN + I_OUT) { w = 1; N = D; q = r - I_IN; coff = NPROJ; } else { w = 2; N = D; q = r - I_IN - I_OUT; coff = NPROJ + D; }
    const int nblk = N / 32; k0 = 64 * (q / nblk); n0 = 32 * (q % nblk); dst0 = (w == 0) ? glu_dst(n0) : n0;
}
__device__ __forceinline__ void p0_quant_load(f32x4 (&v)[8], float& am, const float* w_in, const float* wq, const float* wo, const unsigned* cmax, int r, int lane) {
    int w, N, k0, n0, dst0, coff; p0_quant_decode(r, w, N, k0, n0, dst0, coff);
    const float* W = w == 0 ? w_in : w == 1 ? wq : wo;
#pragma unroll
    for (int i = 0; i < 8; ++i) v[i] = __builtin_nontemporal_load((const GAS f32x4*)(W + (size_t)(k0 + 8 * i + (lane >> 3)) * N + n0 + 4 * (lane & 7)));
    am = __uint_as_float(__hip_atomic_load(cmax + coff + dst0 + (lane & 31), __ATOMIC_RELAXED, __HIP_MEMORY_SCOPE_AGENT));
}
__device__ __forceinline__ void p0_quant_process(const f32x4 (&v)[8], float am, unsigned char* W8in, unsigned char* W8q, unsigned char* W8o, float* swin, float* swq, float* swo, int r, LAS float* scr, int lane) {
    int w, N, k0, n0, dst0, coff; p0_quant_decode(r, w, N, k0, n0, dst0, coff);
    unsigned char* WT8 = w == 0 ? W8in : w == 1 ? W8q : W8o; float* scale = w == 0 ? swin : w == 1 ? swq : swo;
#pragma unroll
    for (int i = 0; i < 8; ++i) { const int kk = 8 * i + (lane >> 3); LAS float* d = scr + kk * 33 + 4 * (lane & 7); d[0] = v[i][0]; d[1] = v[i][1]; d[2] = v[i][2]; d[3] = v[i][3]; }
    if (lane < 32) { const float sc = am > 0.f ? am * (1.f / 127.f) : 1.f;
        scr[64 * 33 + lane] = 1.f / sc; if (k0 == 0) scale[dst0 + lane] = sc; }
    LDS_WAIT(); asm volatile("" ::: "memory");
    const int c = lane & 7;
#pragma unroll
    for (int j = 0; j < 4; ++j) { const int n = (lane >> 3) + 8 * j; const LAS float* sp = scr + (8 * c) * 33 + n; const float inv = scr[64 * 33 + n];
        *(GAS v2u*)(WT8 + (size_t)(dst0 + n) * D + k0 + 8 * c) = (v2u){pack_i8x4(sp[0 * 33] * inv, sp[1 * 33] * inv, sp[2 * 33] * inv, sp[3 * 33] * inv), pack_i8x4(sp[4 * 33] * inv, sp[5 * 33] * inv, sp[6 * 33] * inv, sp[7 * 33] * inv)}; }
    LDS_WAIT(); asm volatile("" ::: "memory");
}
__device__ __forceinline__ void p0_row_x(const f32x4 (&v)[8], unsigned char* dst8, float* scale, int r, int lane) {
    float am = 0.f;
#pragma unroll
    for (int j = 0; j < 8; ++j) am = fmaxf(fmaxf(am, fmaxf(fabsf(v[j].x), fabsf(v[j].y))), fmaxf(fabsf(v[j].z), fabsf(v[j].w)));
    am = wave_max(am);
    const float sc = am > 0.f ? am * (1.f / 127.f) : 1.f, inv = 1.f / sc;
    GAS unsigned* dp = (GAS unsigned*)(dst8 + (size_t)r * D) + lane;
#pragma unroll
    for (int j = 0; j < 8; ++j) dp[64 * j] = pack_i8x4(v[j].x * inv, v[j].y * inv, v[j].z * inv, v[j].w * inv);
    if (lane == 0) scale[r] = sc;
}
__device__ __forceinline__ void p0_convert(const float* src, bf16* dst, size_t n, int gw, int NGW, int lane) {
    const size_t nit = n / 512;
    for (size_t it = gw; it < nit; it += NGW) { const GAS f32x4* s = (const GAS f32x4*)(src + it * 512) + 2 * lane; const f32x4 a = s[0], b = s[1];
        v4u o; o.x = pk2(a.x, a.y); o.y = pk2(a.z, a.w); o.z = pk2(b.x, b.y); o.w = pk2(b.z, b.w); *((GAS v4u*)(dst + it * 512) + lane) = o; }
}
__device__ __forceinline__ void p0_convert_keys(const float* src, bf16* dst, int gw, int NGW, int lane) {
    constexpr int NFRAG = PH * 2 * (PNK / 32) * (PHALF / 16);
    for (int f = gw; f < NFRAG; f += NGW) { const int hc = f >> 5, mt = (f >> 3) & 3, sidx = f & 7;
        const GAS f32x4* sp = (const GAS f32x4*)(src + ((size_t)hc * PNK + 32 * mt + (lane & 31)) * PHALF + 16 * sidx + 8 * (lane >> 5)); const f32x4 a = sp[0], b = sp[1];
        v4u o; o.x = pk2(a.x, a.y); o.y = pk2(a.z, a.w); o.z = pk2(b.x, b.y); o.w = pk2(b.z, b.w); *((GAS v4u*)(dst + (size_t)f * 512) + lane) = o; }
}
template <bool INT8> __device__ __forceinline__ void p0_quant_rows(const float* src, unsigned* dst8, float* scale, int rows, int gw, int NGW, int lane) {
    f32x4 nx[8], nx2[8];
    if (gw < rows) { const GAS f32x4* sp = (const GAS f32x4*)(src + (size_t)gw * D) + lane; const int r1 = (gw + NGW < rows) ? gw + NGW : gw; const GAS f32x4* sq = (const GAS f32x4*)(src + (size_t)r1 * D) + lane;
#pragma unroll
        for (int j = 0; j < 8; ++j) { nx[j] = sp[64 * j]; nx2[j] = sq[64 * j]; } }
    for (int r = gw; r < rows; r += NGW) {
        f32x4 v[8]; float am = 0.f;
#pragma unroll
        for (int j = 0; j < 8; ++j) { v[j] = nx[j]; nx[j] = nx2[j]; }
        { const int rn = (r + 2 * NGW < rows) ? r + 2 * NGW : r; const GAS f32x4* sp = (const GAS f32x4*)(src + (size_t)rn * D) + lane;
#pragma unroll
          for (int j = 0; j < 8; ++j) nx2[j] = sp[64 * j]; }
#pragma unroll
        for (int j = 0; j < 8; ++j) am = fmaxf(fmaxf(am, fmaxf(fabsf(v[j].x), fabsf(v[j].y))), fmaxf(fabsf(v[j].z), fabsf(v[j].w)));
        am = wave_max(am);
        const float sc = am > 0.f ? am * (INT8 ? (1.f / 127.f) : (1.f / 440.f)) : 1.f, inv = 1.f / sc;
#pragma unroll
        for (int j = 0; j < 8; ++j) { int w;
            if (INT8) w = (int)pack_i8x4(v[j].x * inv, v[j].y * inv, v[j].z * inv, v[j].w * inv);
            else { w = __builtin_amdgcn_cvt_pk_fp8_f32(v[j].x * inv, v[j].y * inv, 0, false); w = __builtin_amdgcn_cvt_pk_fp8_f32(v[j].z * inv, v[j].w * inv, w, true); }
            const int wi = lane + 64 * j, c = wi >> 5; *((GAS unsigned*)dst8 + ((size_t)c * rows + r) * 32 + (wi & 31)) = (unsigned)w; }
        if (lane == 0) scale[r] = sc;
    }
}
template <bool HI2C  > __device__ __forceinline__ void p0_row_u4(const f32x4 (&v)[8], unsigned* dst4, float* scale, float* nsum  , int rows, int r, int lane) {
        float ss = 0.f;
#pragma unroll
        for (int j = 0; j < 8; ++j) ss += (v[j].x * v[j].x + v[j].y * v[j].y) + (v[j].z * v[j].z + v[j].w * v[j].w);
        ss = wave_sum(ss);
        const float sc = ss > 0.f ? 0.35f * sqrtf(ss * (1.f / D)) : 1.f, inv = 1.f / sc;
        int nsl = 0;
#pragma unroll
        for (int j = 0; j < 8; ++j) { unsigned own = 0, snd = 0;
#pragma unroll
            for (int e = 0; e < 4; ++e) { const int q = (int)fminf(fmaxf(rintf(v[j][e] * inv), -8.f), 7.f); own |= (unsigned)(q + 8) << (8 * e); snd |= (unsigned)(HI2C ? (q & 15) : (q + 8)) << (8 * e); nsl += q + 8; }
            const unsigned nbr = (unsigned)dppi<0xB1>((int)snd);
            const int w_ = lane >> 1, wp_ = HI2C ? 4 * (w_ & 7) + (w_ >> 3) : w_;
            if ((lane & 1) == 0) __builtin_nontemporal_store(own | (nbr << 4), (GAS unsigned*)dst4 + ((size_t)j * rows + r) * 32 + wp_); }
        if (nsum) { const float ns = wave_sum((float)nsl); if (lane == 0) nsum[r] = ns; }
        if (lane == 0) scale[r] = sc;
}
__device__ __forceinline__ int t5_bucket(int d) {
    if (d < 16) return d;
    int l = 16 + (int)(logf((float)d / 16.f) / logf(8.f) * 16.f); return l < 31 ? l : 31;
}
struct P0Stream { f32x4 nx[8], nx2[8]; };
__device__ __forceinline__ const GAS f32x4* p0_stream_src(const float* x, const float* u, const float* v, int rr, int lane) {
    const float* p = rr < M ? x + (size_t)rr * D : rr < M + NEXP ? u + (size_t)(rr - M) * D : v + (size_t)(rr - M - NEXP) * D;
    return (const GAS f32x4*)p + lane;
}
__device__ __forceinline__ void p0_colmax_load(f32x4 (&v)[8], const float* w_in, const float* wq, const float* wo, int r, int lane) {
    constexpr int I_IN = (D / 64) * (NPROJ / 32), I_OUT = (D / 64) * (D / 32);
    const float* W; int N, q;
    if (r < I_IN) { W = w_in; N = NPROJ; q = r; } else if (r < I_IN + I_OUT) { W = wq; N = D; q = r - I_IN; } else { W = wo; N = D; q = r - I_IN - I_OUT; }
    const int nblk = N / 32, k0 = 64 * (q / nblk), n0 = 32 * (q % nblk);
#pragma unroll
    for (int i = 0; i < 8; ++i) v[i] = *(const GAS f32x4*)(W + (size_t)(k0 + 8 * i + (lane >> 3)) * N + n0 + 4 * (lane & 7));
}
__device__ __forceinline__ void p0_colmax_reduce(const f32x4 (&v)[8], unsigned* cmax_all, int r, int lane) {
    constexpr int I_IN = (D / 64) * (NPROJ / 32), I_OUT = (D / 64) * (D / 32);
    int dst0;
    if (r < I_IN) dst0 = glu_dst(32 * (r % (NPROJ / 32))); else if (r < I_IN + I_OUT) dst0 = NPROJ + 32 * ((r - I_IN) % (D / 32)); else dst0 = NPROJ + D + 32 * ((r - I_IN - I_OUT) % (D / 32));
    f32x4 am = {0.f, 0.f, 0.f, 0.f};
#pragma unroll
    for (int i = 0; i < 8; ++i) { am[0] = fmaxf(am[0], fabsf(v[i][0])); am[1] = fmaxf(am[1], fabsf(v[i][1])); am[2] = fmaxf(am[2], fabsf(v[i][2])); am[3] = fmaxf(am[3], fabsf(v[i][3])); }
#pragma unroll
    for (int e = 0; e < 4; ++e) { am[e] = fmaxf(am[e], __shfl_xor(am[e], 8)); am[e] = fmaxf(am[e], __shfl_xor(am[e], 16)); am[e] = fmaxf(am[e], __shfl_xor(am[e], 32)); }
    if (lane < 8) {
#pragma unroll
        for (int e = 0; e < 4; ++e) atomicMax(cmax_all + dst0 + 4 * lane + e, __float_as_uint(am[e])); }
}
__device__ __forceinline__ void p0a_prologue(Frame& F) {
    constexpr int I_IN = (D / 64) * (NPROJ / 32), I_OUT = (D / 64) * (D / 32), I_ALL = I_IN + 2 * I_OUT;
    const int gw = F.vcu_() * NWAVES + F.wave_(), NGW = F.G_() * NWAVES, lane = F.lane();
    f32x4 nx[8];
    if (gw < I_ALL) p0_colmax_load(nx, F.in(I_WIN), F.in(I_WQ), F.in(I_WOUT), gw, lane);
    for (int r = gw; r < I_ALL; r += NGW) {
        f32x4 v[8];
#pragma unroll
        for (int i = 0; i < 8; ++i) v[i] = nx[i];
        { const int rn = (r + NGW < I_ALL) ? r + NGW : r; p0_colmax_load(nx, F.in(I_WIN), F.in(I_WQ), F.in(I_WOUT), rn, lane); }
        p0_colmax_reduce(v, F.ws<unsigned>(WS_CMAX), r, lane);
    }
}
__device__ __forceinline__ void p0b_prologue(Frame& F) {
    LAS float* scr = (LAS float*)(F.lds + F.wave_() * 16384);
    constexpr int I_IN = (D / 64) * (NPROJ / 32), I_OUT = (D / 64) * (D / 32);
    f32x4 qnx[8]; float qam = 0.f;
    { const int gw = F.vcu_() * NWAVES + F.wave_(); if (gw < I_IN + 2 * I_OUT) p0_quant_load(qnx, qam, F.in(I_WIN), F.in(I_WQ), F.in(I_WOUT), F.ws<unsigned>(WS_CMAX), gw, F.lane()); }
    { const float* rel_bias = F.in(I_RELB); float* TAB = F.ws<float>(WS_TAB);
      for (int i = F.vcu_() + F.G_() * F.tid(); i < 8 * 128; i += F.G_() * NWAVES * 64) { const int h = i >> 7, d = i & 127;
          TAB[i] = (rel_bias[t5_bucket(d) * 8 + h] - rel_bias[31 * 8 + h]) * 1.4426950408889634f; } }
    P0Stream st;
    { const int gw = F.vcu_() * NWAVES + F.wave_(), NGW = F.G_() * NWAVES; const GAS f32x4* sp = p0_stream_src(F.in(I_X), F.in(I_U), F.in(I_V), gw, F.lane()), * sq = p0_stream_src(F.in(I_X), F.in(I_U), F.in(I_V), gw + NGW, F.lane());
#pragma unroll
      for (int j = 0; j < 8; ++j) { st.nx[j] = __builtin_nontemporal_load(sp + 64 * j); st.nx2[j] = __builtin_nontemporal_load(sq + 64 * j); } }
    { constexpr int I_ALL = I_IN + 2 * I_OUT; const int gw = F.vcu_() * NWAVES + F.wave_(), NGW = F.G_() * NWAVES, lane = F.lane();
      for (int r = gw; r < I_ALL; r += NGW) {
          f32x4 v[8]; const float am = qam;
#pragma unroll
          for (int i = 0; i < 8; ++i) v[i] = qnx[i];
          { const int rn = (r + NGW < I_ALL) ? r + NGW : r; p0_quant_load(qnx, qam, F.in(I_WIN), F.in(I_WQ), F.in(I_WOUT), F.ws<unsigned>(WS_CMAX), rn, lane); }
          p0_quant_process(v, am, F.ws<unsigned char>(WS_WIN), F.ws<unsigned char>(WS_WQ), F.ws<unsigned char>(WS_WOUT), F.ws<float>(WS_SWIN), F.ws<float>(WS_SWQ), F.ws<float>(WS_SWOUT), r, scr, lane);
      } }
    { constexpr int RT = M + 2 * NEXP; const int gw = F.vcu_() * NWAVES + F.wave_(), NGW = F.G_() * NWAVES, lane = F.lane();
      for (int r = gw; r < RT; r += NGW) {
          f32x4 v[8];
#pragma unroll
          for (int j = 0; j < 8; ++j) { v[j] = st.nx[j]; st.nx[j] = st.nx2[j]; }
          { const int rn = (r + 2 * NGW < RT) ? r + 2 * NGW : r; const GAS f32x4* sp = p0_stream_src(F.in(I_X), F.in(I_U), F.in(I_V), rn, lane);
#pragma unroll
            for (int j = 0; j < 8; ++j) st.nx2[j] = __builtin_nontemporal_load(sp + 64 * j); }
          if (r < M) p0_row_x(v, F.ws<unsigned char>(WS_XB), F.ws<float>(WS_SXA), r, lane);
          else if (r < M + NEXP) p0_row_u4<false>(v, F.ws<unsigned>(WS_U8), F.ws<float>(WS_SU), F.ws<float>(WS_NSU), NEXP, r - M, lane);
          else p0_row_u4<true>(v, F.ws<unsigned>(WS_V8), F.ws<float>(WS_SV), nullptr, NEXP, r - M - NEXP, lane);
      } }
    { const int gw = F.vcu_() * NWAVES + F.wave_(), NGW = F.G_() * NWAVES; p0_convert_keys(F.in(I_KEYS), F.ws<bf16>(WS_KEYS), gw, NGW, F.lane()); }
}

__device__ __forceinline__ float diff_lambda(Frame& F) {
    const float a = wave_sum(F.in(I_LQ1)[F.lane()] * F.in(I_LK1)[F.lane()]), b = wave_sum(F.in(I_LQ2)[F.lane()] * F.in(I_LK2)[F.lane()]);
    return expf(a) - expf(b) + LAMBDA_INIT;
}
template <int CTRL, int RM> __device__ __forceinline__ float dpp_rm(float old, float v) { return __int_as_float(__builtin_amdgcn_update_dpp(__float_as_int(old), __float_as_int(v), CTRL, RM, 0xf, false)); }
__device__ __forceinline__ float wave_sum63(float v) {
    v += dppf<0xB1>(v); v += dppf<0x4E>(v); v += dppf<0x141>(v); v += dppf<0x140>(v);
    v += dpp_rm<0x142, 0xa>(0.f, v);
    v += dpp_rm<0x143, 0xc>(0.f, v);
    return v;
}
__device__ __forceinline__ float wave_max63(float v) {
    v = fmaxf(v, dppf<0xB1>(v)); v = fmaxf(v, dppf<0x4E>(v)); v = fmaxf(v, dppf<0x141>(v)); v = fmaxf(v, dppf<0x140>(v));
    v = fmaxf(v, dpp_rm<0x142, 0xa>(0.f, v)); v = fmaxf(v, dpp_rm<0x143, 0xc>(0.f, v));
    return v;
}
__device__ __forceinline__ float wave_sum(float v) { return __int_as_float(__builtin_amdgcn_readlane(__float_as_int(wave_sum63(v)), 63)); }
__device__ __forceinline__ float wave_max(float v) { return __int_as_float(__builtin_amdgcn_readlane(__float_as_int(wave_max63(v)), 63)); }
typedef _Float16 h2_t __attribute__((ext_vector_type(2)));
__device__ __forceinline__ h2_t pin_h2(float a, float b) { unsigned u = __builtin_bit_cast(unsigned, (h2_t){(_Float16)a, (_Float16)b}); asm volatile("" : "+v"(u)); return __builtin_bit_cast(h2_t, u); }
__device__ __forceinline__ float xr_swap32(float a, float b, bool mx) { auto rr = __builtin_amdgcn_permlane32_swap(__float_as_uint(a), __float_as_uint(b), false, false); const float x = __uint_as_float(rr[0]), y = __uint_as_float(rr[1]); return mx ? fmaxf(x, y) : x + y; }
__device__ __forceinline__ float xr_swap16(float a, float b, bool mx) { auto rr = __builtin_amdgcn_permlane16_swap(__float_as_uint(a), __float_as_uint(b), false, false); const float x = __uint_as_float(rr[0]), y = __uint_as_float(rr[1]); return mx ? fmaxf(x, y) : x + y; }
template <int CTRL> __device__ __forceinline__ float xr_dpp(float lo, float hi, bool t, bool mx) { const float k = t ? hi : lo, s = t ? lo : hi, o = dppf<CTRL>(s); return mx ? fmaxf(k, o) : k + o; }
__device__ __forceinline__ float xred64_sum(const float (&v)[64], int lane) {
    float a[32], b[16], c[8], d[4], e[2];
#pragma unroll
    for (int i = 0; i < 32; ++i) a[i] = xr_swap32(v[i], v[i + 32], false);
#pragma unroll
    for (int i = 0; i < 16; ++i) b[i] = xr_swap16(a[i], a[i + 16], false);
#pragma unroll
    for (int i = 0; i < 8; ++i) c[i] = xr_dpp<0x128>(b[i], b[i + 8], lane & 8, false);
#pragma unroll
    for (int i = 0; i < 4; ++i) d[i] = xr_dpp<0x141>(c[i], c[i + 4], lane & 4, false);
#pragma unroll
    for (int i = 0; i < 2; ++i) e[i] = xr_dpp<0x4E>(d[i], d[i + 2], lane & 2, false);
    return xr_dpp<0xB1>(e[0], e[1], lane & 1, false);
}
__device__ __forceinline__ float xred32_max(const float (&v)[32], int lane) {
    float a[16], b[8], c[4], d[2];
#pragma unroll
    for (int i = 0; i < 16; ++i) a[i] = xr_swap32(v[i], v[i + 16], true);
#pragma unroll
    for (int i = 0; i < 8; ++i) b[i] = xr_swap16(a[i], a[i + 8], true);
#pragma unroll
    for (int i = 0; i < 4; ++i) c[i] = xr_dpp<0x128>(b[i], b[i + 4], lane & 8, true);
#pragma unroll
    for (int i = 0; i < 2; ++i) d[i] = xr_dpp<0x141>(c[i], c[i + 2], lane & 4, true);
    const float e = xr_dpp<0x4E>(d[0], d[1], lane & 2, true);
    return fmaxf(e, dppf<0xB1>(e));
}
#ifndef P3_PROBE_MULT
#define P3_PROBE_MULT 1
#endif
__device__ __forceinline__ void p3_mix(Frame& F) {
    constexpr int TT = 32, NH = TT + CONVW - 1, STG_OFF = 0, STATS_OFF = TT * 1024, AMC_OFF = STATS_OFF + NWAVES * 64 * 4, AMA_OFF = AMC_OFF + TT * NWAVES * 4, MS_OFF = AMA_OFF + 128, INV_OFF = MS_OFF + 256, AVP_OFF = 40960;
    static_assert(INV_OFF + 128 <= AVP_OFF && AVP_OFF + 8 * NWAVES * 64 * 16 <= RING_BYTES && NH == 62, "P3 LDS map");
    const int tid = F.tid(), lane = tid & 63, wave = F.wave_();
    const float* conv_w = F.in(I_CONVW); const unsigned* H = F.ws<unsigned>(WS_H); const bf16* O1 = F.ws<bf16>(WS_O1);
    unsigned char* MIX8 = F.ws<unsigned char>(WS_XB); float* SM = F.ws<float>(WS_SM);
    const float2 cb = *(const float2*)(F.in(I_CONVB) + 2 * tid), lg = *(const float2*)(F.in(I_CLNG) + 2 * tid), lb = *(const float2*)(F.in(I_CLNB) + 2 * tid);
    LAS float* stats = (LAS float*)(F.lds + STATS_OFF); LAS float* amc = (LAS float*)(F.lds + AMC_OFF); LAS float* ama = (LAS float*)(F.lds + AMA_OFF); LAS float* ms = (LAS float*)(F.lds + MS_OFF); LAS float* invs = (LAS float*)(F.lds + INV_OFF);
    h2_t wk[CONVW];
#pragma unroll
    for (int k = 0; k < CONVW; ++k) { const float2 wf = *(const float2*)(conv_w + k * DCONV + 2 * tid); wk[k] = pin_h2(wf.x, wf.y); }
    const h2_t cbh = pin_h2(cb.x, cb.y);
    unsigned hv[NH];
#define P3_LOAD_H(tile_) do { const int t0_ = (tile_) * TT; const GAS unsigned* hp_ = (const GAS unsigned*)H + (size_t)t0_ * (DCONV / 2) + tid;     \
        _Pragma("unroll") for (int j = 0; j < NH; ++j) hv[j] = *(hp_ + (ptrdiff_t)(j - (CONVW - 1)) * (DCONV / 2)); } while (0)
    { const int ft = F.vcu_() < M / TT ? F.vcu_() : 0; P3_LOAD_H(ft); }
    for (int tile_j = F.vcu_(); tile_j < P3_PROBE_MULT * (M / TT); tile_j += F.G_()) { const int tile_i = tile_j & (M / TT - 1);
        const int t0 = tile_i * TT;
        const int tid = F.tid(), lane = tid & 63;
        v4u oa[4][2];
#pragma unroll
        for (int rr = 0; rr < 4; ++rr) { const int m = t0 + 4 * wave + rr;
            const GAS char* p1 = (const GAS char*)(O1 + (size_t)m * 1024); const unsigned lo_ = (unsigned)lane * 32u;
            oa[rr][0] = __builtin_nontemporal_load((const GAS v4u*)(p1 + lo_)); oa[rr][1] = __builtin_nontemporal_load((const GAS v4u*)(p1 + lo_ + 16)); }
        __builtin_amdgcn_sched_barrier(0);
        h2_t cv[TT];
        { const unsigned zm = (t0 & (SEQ - 1)) != 0 ? 0xffffffffu : 0u;
#pragma unroll
          for (int j = 0; j < CONVW - 1; ++j) hv[j] &= zm; }
#pragma unroll
        for (int t = 0; t < TT; ++t) { h2_t acc = cbh;
#pragma unroll
            for (int k = 0; k < CONVW; ++k) acc = __builtin_elementwise_fma(__builtin_bit_cast(h2_t, hv[t + k]), wk[k], acc);
            { unsigned u_ = __builtin_bit_cast(unsigned, acc); asm volatile("" : "+v"(u_)); cv[t] = __builtin_bit_cast(h2_t, u_); } }
        __builtin_amdgcn_sched_barrier(0);
#pragma unroll
        for (int rr = 0; rr < 4; ++rr) { h2_t avp[8];
            const unsigned aw[8] = {oa[rr][0].x, oa[rr][0].y, oa[rr][0].z, oa[rr][0].w, oa[rr][1].x, oa[rr][1].y, oa[rr][1].z, oa[rr][1].w};
            float am = 0.f;
#pragma unroll
            for (int e = 0; e < 8; ++e) { avp[e] = pin_h2(bflo(aw[e]), bfhi(aw[e])); am = fmaxf(am, fmaxf(fabsf(bflo(aw[e])), fabsf(bfhi(aw[e])))); }
            am = wave_max63(am);
            if (lane == 63) ama[4 * wave + rr] = am;
#pragma unroll
            for (int hh = 0; hh < 2; ++hh) *(LAS v4u*)(F.lds + AVP_OFF + ((rr * 2 + hh) * (NWAVES * 64) + tid) * 16) = (v4u){__builtin_bit_cast(unsigned, avp[4 * hh]), __builtin_bit_cast(unsigned, avp[4 * hh + 1]), __builtin_bit_cast(unsigned, avp[4 * hh + 2]), __builtin_bit_cast(unsigned, avp[4 * hh + 3])}; }
        { float sv[64];
#pragma unroll
          for (int t = 0; t < TT; ++t) { const float y0 = (float)cv[t].x, y1 = (float)cv[t].y; sv[2 * t] = y0 + y1; sv[2 * t + 1] = y0 * y0 + y1 * y1; }
          stats[wave * 64 + lane] = xred64_sum(sv, lane); }
        __builtin_amdgcn_sched_barrier(0);
        { const int nx_ = tile_j + F.G_(), nxt = nx_ < P3_PROBE_MULT * (M / TT) ? (nx_ & (M / TT - 1)) : tile_i; P3_LOAD_H(nxt); }
        __syncthreads();
        if (tid < TT) { float s = 0.f, q = 0.f;
#pragma unroll
            for (int w = 0; w < NWAVES; ++w) { s += stats[w * 64 + 2 * tid]; q += stats[w * 64 + 2 * tid + 1]; }
            const float mean = s * (1.f / DCONV), var = fmaxf(q * (1.f / DCONV) - mean * mean, 0.f); ms[2 * tid] = mean; ms[2 * tid + 1] = 1.f / sqrtf(var + LN_EPS); }
        __syncthreads();
        {
            float mv[TT];
#pragma unroll
            for (int q = 0; q < TT / 2; ++q) { const f32x4 st = *(const LAS f32x4*)(ms + 4 * q);
#pragma unroll
                for (int o = 0; o < 2; ++o) { const int t = 2 * q + o; const float mean = st[2 * o], rstd = st[2 * o + 1];
                    const float y0 = ((float)cv[t].x - mean) * rstd * lg.x + lb.x, y1 = ((float)cv[t].y - mean) * rstd * lg.y + lb.y;
#define SWISH_(y) ((y) * __builtin_amdgcn_rcpf(1.f + __builtin_amdgcn_exp2f(-1.4426950409f * (y))))
                    cv[t] = pin_h2(SWISH_(y0), SWISH_(y1));
#undef SWISH_
                    mv[t] = fmaxf(fabsf((float)cv[t].x), fabsf((float)cv[t].y)); } }
            const float amx = xred32_max(mv, lane);
            if ((lane & 1) == 0) amc[(lane >> 1) * NWAVES + wave] = amx; }
        __syncthreads();
        if (tid < TT) { float am = ama[tid];
#pragma unroll
            for (int w = 0; w < NWAVES; ++w) am = fmaxf(am, amc[tid * NWAVES + w]);
            const float sc = am > 0.f ? am * (1.f / 127.f) : 1.f; const _Float16 ih = (_Float16)(1.f / sc);
            ((LAS unsigned*)invs)[tid] = __builtin_bit_cast(unsigned, (h2_t){ih, ih}); SM[t0 + tid] = 1.f / (float)ih; }
        __syncthreads();
        const h2_t K1536 = (h2_t){(_Float16)1536.f, (_Float16)1536.f};
#pragma unroll
        for (int q = 0; q < TT / 4; ++q) { const v4u iv = *(const LAS v4u*)((LAS unsigned*)invs + 4 * q);
            const unsigned ivw[4] = {iv.x, iv.y, iv.z, iv.w};
#pragma unroll
            for (int o = 0; o < 4; ++o) { const int t = 4 * q + o; const unsigned r = __builtin_bit_cast(unsigned, __builtin_elementwise_fma(cv[t], __builtin_bit_cast(h2_t, ivw[o]), K1536));
                *(LAS unsigned short*)(F.lds + STG_OFF + t * 1024 + 2 * tid) = (unsigned short)__builtin_amdgcn_perm(0u, r, 0x0c0c0200u); } }
#pragma unroll
        for (int rr = 0; rr < 4; ++rr) { const h2_t ivh = __builtin_bit_cast(h2_t, ((LAS unsigned*)invs)[4 * wave + rr]);
            const v4u pa_ = *(const LAS v4u*)(F.lds + AVP_OFF + ((rr * 2) * (NWAVES * 64) + tid) * 16), pb_ = *(const LAS v4u*)(F.lds + AVP_OFF + ((rr * 2 + 1) * (NWAVES * 64) + tid) * 16);
            const unsigned pw_[8] = {pa_.x, pa_.y, pa_.z, pa_.w, pb_.x, pb_.y, pb_.z, pb_.w}; unsigned rq[8];
#pragma unroll
            for (int e = 0; e < 8; ++e) rq[e] = __builtin_bit_cast(unsigned, __builtin_elementwise_fma(__builtin_bit_cast(h2_t, pw_[e]), ivh, K1536));
            *((GAS v4u*)(MIX8 + (size_t)(t0 + 4 * wave + rr) * D) + lane) = (v4u){__builtin_amdgcn_perm(rq[1], rq[0], 0x06040200u), __builtin_amdgcn_perm(rq[3], rq[2], 0x06040200u), __builtin_amdgcn_perm(rq[5], rq[4], 0x06040200u), __builtin_amdgcn_perm(rq[7], rq[6], 0x06040200u)}; }
        __syncthreads();
        for (int idx = tid; idx < TT * 64; idx += NWAVES * 64) { const int row = idx >> 6, ch = idx & 63;
            *((GAS v4u*)(MIX8 + (size_t)(t0 + row) * D + DATT) + ch) = *(const LAS v4u*)(F.lds + STG_OFF + row * 1024 + ch * 16); }
        __syncthreads();
    }
}
#undef P3_LOAD_H
__device__ __forceinline__ void p5_ln1(Frame& F) {
    const bf16* Y1 = F.ws<bf16>(WS_Y1); const float* ln1_g = F.in(I_LN1G); const float* ln1_b = F.in(I_LN1B); unsigned char* X8 = F.ws<unsigned char>(WS_X8); float* SX = F.ws<float>(WS_SX); float* LNS = F.ws<float>(WS_LNS); float* SXQ = F.ws<float>(WS_SXQ); unsigned char* XH = F.ws<unsigned char>(WS_XH); unsigned char* XL = F.ws<unsigned char>(WS_XL);
    const int gw = F.vcu_() * NWAVES + F.wave_(), NGW = F.G_() * NWAVES, lane = F.lane();
    v4u nx[4], nx2[4];
    if (gw < M) { const GAS v4u* p = (const GAS v4u*)(Y1 + (size_t)gw * D) + lane; const int m1 = (gw + NGW < M) ? gw + NGW : gw; const GAS v4u* p2 = (const GAS v4u*)(Y1 + (size_t)m1 * D) + lane;
#pragma unroll
        for (int j = 0; j < 4; ++j) { nx[j] = p[64 * j]; nx2[j] = p2[64 * j]; } }
    f32x4 gg[8], bb[8];
#pragma unroll
    for (int j = 0; j < 4; ++j) { const int c0 = 8 * lane + 512 * j; gg[2 * j] = *(const f32x4*)(ln1_g + c0); gg[2 * j + 1] = *(const f32x4*)(ln1_g + c0 + 4); bb[2 * j] = *(const f32x4*)(ln1_b + c0); bb[2 * j + 1] = *(const f32x4*)(ln1_b + c0 + 4); }
    for (int m = gw; m < M; m += NGW) {
        v4u w[4]; float v[32]; float s = 0.f;
#pragma unroll
        for (int j = 0; j < 4; ++j) { w[j] = nx[j]; nx[j] = nx2[j]; }
        { const int mn = (m + 2 * NGW < M) ? m + 2 * NGW : m; const GAS v4u* p = (const GAS v4u*)(Y1 + (size_t)mn * D) + lane;
#pragma unroll
          for (int j = 0; j < 4; ++j) nx2[j] = p[64 * j]; }
#pragma unroll
        for (int j = 0; j < 4; ++j) { const unsigned ww[4] = {w[j].x, w[j].y, w[j].z, w[j].w};
#pragma unroll
            for (int i = 0; i < 4; ++i) { v[8 * j + 2 * i] = bflo(ww[i]); v[8 * j + 2 * i + 1] = bfhi(ww[i]); s += v[8 * j + 2 * i] + v[8 * j + 2 * i + 1]; } }
        const float mean = wave_sum(s) * (1.f / D); float q = 0.f;
#pragma unroll
        for (int i = 0; i < 32; ++i) { v[i] -= mean; q += v[i] * v[i]; }
        const float rstd = 1.f / sqrtf(wave_sum(q) * (1.f / D) + LN_EPS);
        float am = 0.f;
#pragma unroll
        for (int j = 0; j < 4; ++j) { const f32x4 g0 = gg[2 * j], g1 = gg[2 * j + 1], b0 = bb[2 * j], b1 = bb[2 * j + 1];
#pragma unroll
            for (int i = 0; i < 4; ++i) { v[8 * j + i] = v[8 * j + i] * rstd * g0[i] + b0[i]; v[8 * j + 4 + i] = v[8 * j + 4 + i] * rstd * g1[i] + b1[i]; am = fmaxf(am, fmaxf(fabsf(v[8 * j + i]), fabsf(v[8 * j + 4 + i]))); } }
        am = wave_max(am);
        const float sc = am > 0.f ? am * (1.f / 127.f) : 1.f, inv = 1.f / sc;
        GAS v2u* p8 = (GAS v2u*)(X8 + (size_t)m * D) + lane;
#pragma unroll
        for (int j = 0; j < 4; ++j) p8[64 * j] = (v2u){pack_i8x4(v[8 * j] * inv, v[8 * j + 1] * inv, v[8 * j + 2] * inv, v[8 * j + 3] * inv), pack_i8x4(v[8 * j + 4] * inv, v[8 * j + 5] * inv, v[8 * j + 6] * inv, v[8 * j + 7] * inv)};
        float qs = 0.f;
#pragma unroll
        for (int i = 0; i < 32; ++i) qs += rintf(v[i] * inv);
        qs = wave_sum(qs);
        if (lane == 0) { SX[m] = sc; LNS[2 * m] = mean; LNS[2 * m + 1] = rstd; SXQ[m] = qs; }
    }
}
__device__ __forceinline__ int f2key(float f) { return __float_as_int(f); }
__device__ __forceinline__ float key2f(int k) { return __int_as_float(k); }
__device__ __forceinline__ int key_max(int a, int b) { int r; asm("v_max_f32 %0, %1, %2" : "=v"(r) : "v"(a), "v"(b)); return r; }
__device__ __forceinline__ int key_min(int a, int b) { int r; asm("v_min_f32 %0, %1, %2" : "=v"(r) : "v"(a), "v"(b)); return r; }
#define KEY_LOWEST ((int)0xff800000)
#define CE_DESC(a, b) do { const int _x = key_max(a, b), _y = key_min(a, b); a = _x; b = _y; } while (0)
template <int N> __device__ __forceinline__ void bitonic_merge_desc(int (&v)[N]) {
#pragma unroll
    for (int j = N >> 1; j > 0; j >>= 1)
#pragma unroll
        for (int i = 0; i < N; ++i) { const int l = i ^ j; if (l > i) CE_DESC(v[i], v[l]); }
}
__device__ __forceinline__ void sort16_desc(int (&v)[16]) {
#define CE_(a, b) CE_DESC(v[a], v[b])
    CE_(0,13); CE_(1,12); CE_(2,15); CE_(3,14); CE_(4,8); CE_(5,6); CE_(7,11); CE_(9,10);
    CE_(0,5); CE_(1,7); CE_(2,9); CE_(3,4); CE_(6,13); CE_(8,14); CE_(10,15); CE_(11,12);
    CE_(0,1); CE_(2,3); CE_(4,5); CE_(6,8); CE_(7,9); CE_(10,11); CE_(12,13); CE_(14,15);
    CE_(0,2); CE_(1,3); CE_(4,10); CE_(5,11); CE_(6,7); CE_(8,9); CE_(12,14); CE_(13,15);
    CE_(1,2); CE_(3,12); CE_(4,6); CE_(5,7); CE_(8,10); CE_(9,11); CE_(13,14);
    CE_(1,4); CE_(2,6); CE_(5,8); CE_(7,10); CE_(9,13); CE_(11,14);
    CE_(2,4); CE_(3,6); CE_(9,12); CE_(11,13);
    CE_(3,5); CE_(6,8); CE_(7,9); CE_(10,12);
    CE_(3,4); CE_(5,6); CE_(7,8); CE_(9,10); CE_(11,12);
    CE_(6,7); CE_(8,9);
#undef CE_
}
__device__ __forceinline__ void merge16(const int (&a)[16], const int (&b)[16], int (&o)[16]) {
#pragma unroll
    for (int i = 0; i < 16; ++i) o[i] = key_max(a[i], b[15 - i]);
    bitonic_merge_desc<16>(o);
}
__device__ const unsigned char PEER_PAIR[64] = {0,1,2,3,4,5,6,7,8,9,10,11,12,13,14,15, 16,17,18,19,20,21,22,23, 32,33,34,35,36, 48,49,50,51, 64,65,66, 80,81, 96,97, 112,113, 128,144,160,176,192,208,224,240, 0,0,0,0,0,0,0,0,0,0,0,0,0,0};
__device__ __forceinline__ void peer_load_q(bf16x8 (&bq)[8], const bf16* qrow  ) {
    asm volatile("" : "+v"(qrow));
#pragma unroll
    for (int s = 0; s < 8; ++s) bq[s] = __builtin_nontemporal_load((const GAS bf16x8*)(qrow + 512 * s));
}
__device__ __forceinline__ void peer_load_keys(bf16x8 (&ka)[8], const bf16* krow  ) {
    asm volatile("" : "+v"(krow));
#pragma unroll
    for (int s = 0; s < 8; ++s) ka[s] = *(const GAS bf16x8*)(krow + 512 * s);
}
template <int MT> __device__ __forceinline__ void peer_mtile(const bf16x8 (&bq)[8], const bf16x8 (&cur)[8], bf16x8 (&nxt)[8], const bf16* nxt_row, int (&pr)[16]  ) {
    peer_load_keys(nxt, nxt_row);
    f32x16 acc = {};
#pragma unroll
    for (int s = 0; s < 8; ++s) acc = __builtin_amdgcn_mfma_f32_32x32x16_bf16(cur[s], bq[s], acc, 0, 0, 0);
    int g[16];
#pragma unroll
    for (int r = 0; r < 16; ++r) g[r] = (f2key(acc[r]) & ~127) | ((r & 3) + 8 * (r >> 2) + 32 * (MT & 1));
    sort16_desc(g);
    if ((MT & 1) == 0) {
#pragma unroll
        for (int r = 0; r < 16; ++r) pr[r] = g[r];
    } else { int t2[16]; merge16(pr, g, t2);
#pragma unroll
        for (int r = 0; r < 16; ++r) pr[r] = t2[r]; }
}
__device__ __forceinline__ void peer_subkey_top16(const bf16x8 (&bq)[8], bf16x8 (&ka0)[8], const bf16* keys_hc  , const bf16* keys_next, int r32, int hi, int (&o)[16]) {
    int pa[16], pb[16], run[16]; bf16x8 kb[8];
    const int lo8 = (r32 + 32 * hi) * 8;
    peer_mtile<0>(bq, ka0, kb, keys_hc + (size_t)1 * (8 * 512) + lo8, pa);
    peer_mtile<1>(bq, kb, ka0, keys_hc + (size_t)2 * (8 * 512) + lo8, pa);
    peer_mtile<2>(bq, ka0, kb, keys_hc + (size_t)3 * (8 * 512) + lo8, pb);
    peer_mtile<3>(bq, kb, ka0, keys_next + lo8, pb);
    const int hi4 = 4 * hi;
#pragma unroll
    for (int i = 0; i < 16; ++i) { pa[i] |= hi4; pb[i] |= 64 | hi4; }
    merge16(pa, pb, run);
    int lo[16], hh[16];
#pragma unroll
    for (int i = 0; i < 16; ++i) { auto rr = __builtin_amdgcn_permlane32_swap((unsigned)run[i], (unsigned)run[i], false, false); lo[i] = (int)rr[0]; hh[i] = (int)rr[1]; }
    merge16(lo, hh, o);
}
__device__ __forceinline__ float gelu_erf(float v) { return 0.5f * v * (1.f + erff(v * 0.70710678118654752f)); }

typedef float f32x2 __attribute__((ext_vector_type(2)));
constexpr int P7_G2 = RING_BYTES + 512 + 8192, P7_B2 = P7_G2 + 8192;
static_assert(P7_B2 + 8192 <= LDS_BYTES, "PEER LDS map (LN2 tables)");
constexpr int P7_G1 = 115712, P7_LNSL = 123904, P7_B1 = RING_BYTES + 512;
static_assert(P7_LNSL + 1024 <= RING_BYTES && P7_B1 + 8192 <= LDS_BYTES, "PEER LDS map (LN1 tables)");
constexpr int P7_PAIR = P7_LNSL + 1024;
static_assert(P7_PAIR + 64 <= RING_BYTES, "PEER LDS map (pair table)");
constexpr int P7_W8 = 98304, P7_SW = 114688;
constexpr int P7_ACT = 0, P7_EID = 65536, P7_SCR = 0  , P7_SCR_WAVE = 32 * 33 * 4, PCH = 128, NCH = D / PCH;
static_assert(P7_SCR + NWAVES * P7_SCR_WAVE <= P7_EID && P7_EID + 128 * 128 * 2 <= RING_BYTES, "PEER LDS map");

__device__ __forceinline__ void p7_peer(Frame& F) {
    const int lane = F.lane(), r32 = lane & 31, hi = lane >> 5, j8 = lane & 7, g8 = lane >> 3;
    constexpr int TPB = 128;
    LAS float* ACT = (LAS float*)(F.lds + P7_ACT); LAS unsigned short* EIDL = (LAS unsigned short*)(F.lds + P7_EID);
    LAS int* scr = (LAS int*)(F.lds + P7_SCR + F.wave_() * P7_SCR_WAVE);
    { const float* ln1_g = F.in(I_LN1G); const float* ln1_b = F.in(I_LN1B); const int tid = F.tid();
      *(LAS f32x4*)(F.lds + P7_G1 + tid * 16) = *(const f32x4*)(ln1_g + tid * 4); *(LAS f32x4*)(F.lds + P7_B1 + tid * 16) = *(const f32x4*)(ln1_b + tid * 4);
      if (tid < 16) ((LAS unsigned*)(F.lds + P7_PAIR))[tid] = ((const GAS unsigned*)PEER_PAIR)[tid];
      *(LAS f32x4*)(F.lds + P7_G2 + tid * 16) = *(const f32x4*)(F.in(I_LN2G) + tid * 4); *(LAS f32x4*)(F.lds + P7_B2 + tid * 16) = *(const f32x4*)(F.in(I_LN2B) + tid * 4); }
    __syncthreads();
    for (int blk = F.vcu_(); blk < M / TPB; blk += F.G_()) {
        const int m0 = blk * TPB;
        SEC_BEGIN(10);
        SEC_REP(10) { const int h = F.wave_(); const bf16* QP = F.ws<bf16>(WS_QP); const bf16* KEYS = F.ws<bf16>(WS_KEYS); float* GATE = F.ws<float>(WS_GATE);
          bf16x8 bqA[8], bqB[8], kaN[8];
          peer_load_q(bqA, QP + (size_t)(m0 / 32) * (32 * D) + ((size_t)(h * 2) * 8 * 64 + lane) * 8);
          peer_load_keys(kaN, KEYS + (size_t)(h * 2 + 0) * PNK * PHALF + lane * 8);
          for (int tt = 0; tt < 4; ++tt) {
            const int tl = 32 * tt + r32, tok = m0 + tl;
            const bf16* qrow = QP + (size_t)(m0 / 32 + tt) * (32 * D) + ((size_t)(h * 2) * 8 * 64 + lane) * 8;
            int s1[16], s2[16];
            peer_load_q(bqB, qrow + 8 * 512);
            peer_subkey_top16(bqA, kaN, KEYS + (size_t)(h * 2 + 0) * PNK * PHALF, KEYS + (size_t)(h * 2 + 1) * PNK * PHALF, r32, hi, s1);
            asm volatile("" ::: "memory");
            { const int tn = tt + 1 < 4 ? tt + 1 : tt; peer_load_q(bqA, QP + (size_t)(m0 / 32 + tn) * (32 * D) + ((size_t)(h * 2) * 8 * 64 + lane) * 8); }
            peer_subkey_top16(bqB, kaN, KEYS + (size_t)(h * 2 + 1) * PNK * PHALF, KEYS + (size_t)(h * 2 + 0) * PNK * PHALF, r32, hi, s2);
            float f1[16], f2[16];
#pragma unroll
            for (int i = 0; i < 16; ++i) { f1[i] = key2f(s1[i]); f2[i] = key2f(s2[i]); }
            if (hi == 0) {
#pragma unroll
                for (int i = 0; i < 16; ++i) { scr[r32 * 33 + i] = s1[i] & 127; scr[r32 * 33 + 16 + i] = s2[i] & 127; } }
            int cand[64];
            {
#define PC(n_, i_, j_) cand[n_] = (f2key(f1[i_] + f2[j_]) & ~255) | (n_)
                PC(0,0,0); PC(1,0,1); PC(2,0,2); PC(3,0,3); PC(4,0,4); PC(5,0,5); PC(6,0,6); PC(7,0,7); PC(8,0,8); PC(9,0,9); PC(10,0,10); PC(11,0,11); PC(12,0,12); PC(13,0,13); PC(14,0,14); PC(15,0,15);
                PC(16,1,0); PC(17,1,1); PC(18,1,2); PC(19,1,3); PC(20,1,4); PC(21,1,5); PC(22,1,6); PC(23,1,7);
                PC(24,2,0); PC(25,2,1); PC(26,2,2); PC(27,2,3); PC(28,2,4);
                PC(29,3,0); PC(30,3,1); PC(31,3,2); PC(32,3,3);
                PC(33,4,0); PC(34,4,1); PC(35,4,2);
                PC(36,5,0); PC(37,5,1); PC(38,6,0); PC(39,6,1); PC(40,7,0); PC(41,7,1);
                PC(42,8,0); PC(43,9,0); PC(44,10,0); PC(45,11,0); PC(46,12,0); PC(47,13,0); PC(48,14,0); PC(49,15,0);
#undef PC
            }
#pragma unroll
            for (int i = 50; i < 64; ++i) cand[i] = KEY_LOWEST;
            int c0[16], c1[16]; const int hsel = -hi;
#pragma unroll
            for (int i = 0; i < 16; ++i) { c0[i] = (cand[i] & ~hsel) | (cand[32 + i] & hsel); c1[i] = (cand[16 + i] & ~hsel) | (cand[48 + i] & hsel); }
            sort16_desc(c0); sort16_desc(c1);
            int mh[16]; merge16(c0, c1, mh);
            int sc[16];
            { int lo_[16], hh_[16];
#pragma unroll
              for (int i = 0; i < 16; ++i) { auto rr = __builtin_amdgcn_permlane32_swap((unsigned)mh[i], (unsigned)mh[i], false, false); lo_[i] = (int)rr[0]; hh_[i] = (int)rr[1]; }
              merge16(lo_, hh_, sc); }
            float p[16]; const float mx = key2f(sc[0]); float z = 0.f;
#pragma unroll
            for (int k = 0; k < 16; ++k) { p[k] = __expf(key2f(sc[k]) - mx); z += p[k]; }
            const float rz = 1.f / z;
            LDS_WAIT();
            int eo[8]; float go[8]; const int him = -hi;
#pragma unroll
            for (int kk = 0; kk < 8; ++kk) { const int tag = ((const LAS unsigned char*)(F.lds + P7_PAIR))[((sc[kk] & ~him) | (sc[8 + kk] & him)) & 63];
                const int i1 = scr[r32 * 33 + (tag >> 4)], i2 = scr[r32 * 33 + 16 + (tag & 15)];
                eo[kk] = i1 * PNK + i2; go[kk] = __int_as_float((__float_as_int(p[kk]) & ~him) | (__float_as_int(p[8 + kk]) & him)) * rz; }
            *(LAS v4u*)(EIDL + tl * 128 + h * 16 + 8 * hi) = (v4u){(unsigned)(eo[0] | (eo[1] << 16)), (unsigned)(eo[2] | (eo[3] << 16)), (unsigned)(eo[4] | (eo[5] << 16)), (unsigned)(eo[6] | (eo[7] << 16))};
            GAS float* gp = (GAS float*)(GATE + (size_t)tok * 128 + h * 16 + 8 * hi);
            *(GAS f32x4*)gp = (f32x4){go[0], go[1], go[2], go[3]}; *(GAS f32x4*)(gp + 4) = (f32x4){go[4], go[5], go[6], go[7]};
            LDS_WAIT();
          } }
        { const float* LNS = F.ws<float>(WS_LNS); const int tid = F.tid(); if (tid < 64) *(LAS f32x4*)(F.lds + P7_LNSL + tid * 16) = *(const f32x4*)(LNS + 2 * (size_t)m0 + 4 * tid); }
        SEC_END(10);
        __threadfence_block(); __syncthreads();
        const int tw = F.wave_() * (TPB / NWAVES);
        SEC_BEGIN(11);
        SEC_REP(11) {
        for (int i = lane; i < (TPB / NWAVES) * 128; i += 64) ACT[tw * 128 + i] = 0.f;
        { const unsigned char* X8 = F.ws<unsigned char>(WS_X8); const unsigned char* U8 = F.ws<unsigned char>(WS_U8);
#define U_ISSUE(n_, PC, XQ0, XQ1) do { const int c_ = (n_) >> 4, tl_ = tw + ((n_) & 15); \
            { const GAS v4u* xp_ = (const GAS v4u*)(X8 + (size_t)(m0 + tl_) * D + c_ * UCH + 32 * j8); XQ0 = __builtin_nontemporal_load(xp_); XQ1 = __builtin_nontemporal_load(xp_ + 1); }     \
            const LAS unsigned short* ep_ = EIDL + tl_ * 128 + g8; const unsigned char* ub_ = U8 + (size_t)c_ * (NEXP * PCH); const unsigned j16_ = 16u * (unsigned)j8;     \
            _Pragma("unroll") for (int i = 0; i < 16; ++i) { const unsigned e_ = ep_[8 * i]; PC[i] = *(const GAS v4u*)(ub_ + (e_ * PCH + j16_)); } } while (0)
#define U_COMPUTE(n_, PC, XQ0, XQ1) do { const int tl_ = tw + ((n_) & 15); \
              \
            const unsigned rw_[8] = {XQ0.x ^ 0x80808080u, XQ0.y ^ 0x80808080u, XQ0.z ^ 0x80808080u, XQ0.w ^ 0x80808080u, XQ1.x ^ 0x80808080u, XQ1.y ^ 0x80808080u, XQ1.z ^ 0x80808080u, XQ1.w ^ 0x80808080u}; \
            unsigned xh_[4], xl_[4]; \
            _Pragma("unroll") for (int m = 0; m < 4; ++m) { const unsigned a_ = rw_[2 * m], b_ = rw_[2 * m + 1]; xh_[m] = (b_ & 0xf0f0f0f0u) | ((a_ >> 4) & 0x0f0f0f0fu); xl_[m] = (a_ & 0x0f0f0f0fu) | ((b_ << 4) & 0xf0f0f0f0u); } \
            int pp_[16]; \
            _Pragma("unroll") for (int i = 0; i < 16; ++i) { unsigned ah_ = __builtin_amdgcn_udot8(PC[i].x, xh_[0], 0u, false), al_ = __builtin_amdgcn_udot8(PC[i].x, xl_[0], 0u, false); \
                ah_ = __builtin_amdgcn_udot8(PC[i].y, xh_[1], ah_, false); al_ = __builtin_amdgcn_udot8(PC[i].y, xl_[1], al_, false); ah_ = __builtin_amdgcn_udot8(PC[i].z, xh_[2], ah_, false); al_ = __builtin_amdgcn_udot8(PC[i].z, xl_[2], al_, false); \
                ah_ = __builtin_amdgcn_udot8(PC[i].w, xh_[3], ah_, false); al_ = __builtin_amdgcn_udot8(PC[i].w, xl_[3], al_, false); pp_[i] = (int)(16u * ah_ + al_); } \
              \
            int q8_[8], q4_[4], q2_[2]; \
            { const bool b2_ = lane & 4; _Pragma("unroll") for (int i = 0; i < 8; ++i) { const int k_ = b2_ ? pp_[2 * i + 1] : pp_[2 * i], s_ = b2_ ? pp_[2 * i] : pp_[2 * i + 1]; q8_[i] = k_ + dppi<0x141>(s_); } } \
            { const bool b1_ = lane & 2; _Pragma("unroll") for (int i = 0; i < 4; ++i) { const int k_ = b1_ ? q8_[2 * i + 1] : q8_[2 * i], s_ = b1_ ? q8_[2 * i] : q8_[2 * i + 1]; q4_[i] = k_ + dppi<0x4E>(s_); } } \
            { const bool b0_ = lane & 1; _Pragma("unroll") for (int i = 0; i < 2; ++i) { const int k_ = b0_ ? q4_[2 * i + 1] : q4_[2 * i], s_ = b0_ ? q4_[2 * i] : q4_[2 * i + 1]; q2_[i] = k_ + dppi<0xB1>(s_); } } \
            const int irow_ = ((lane & 1) << 2) | (lane & 2) | ((lane >> 2) & 1); \
            LAS float* ap_ = ACT + tl_ * 128 + 8 * irow_ + g8; ap_[0] += (float)q2_[0]; ap_[64] += (float)q2_[1]; } while (0)
          constexpr int UCH = 256, NSTEP = (D / UCH) * (TPB / NWAVES);
          v4u pcA[16], pcB[16], xqA0, xqA1, xqB0, xqB1;
          U_ISSUE(0, pcA, xqA0, xqA1);
          for (int n = 0; n < NSTEP; n += 2) {
              U_ISSUE(n + 1, pcB, xqB0, xqB1); __builtin_amdgcn_sched_barrier(0);
              U_COMPUTE(n, pcA, xqA0, xqA1); __builtin_amdgcn_sched_barrier(0);
              { const int nn = (n + 2 < NSTEP) ? n + 2 : n; U_ISSUE(nn, pcA, xqA0, xqA1); }
              __builtin_amdgcn_sched_barrier(0);
              U_COMPUTE(n + 1, pcB, xqB0, xqB1); __builtin_amdgcn_sched_barrier(0);
          }
#undef U_ISSUE
#undef U_COMPUTE
        }
        }
        SEC_END(11); SEC_BEGIN(12);
        LDS_WAIT();
        { const float* SU = F.ws<float>(WS_SU); const float* SV = F.ws<float>(WS_SV); const float* GATE = F.ws<float>(WS_GATE); const float* SX = F.ws<float>(WS_SX); const float* SXQ = F.ws<float>(WS_SXQ); const float* NSU = F.ws<float>(WS_NSU);
        LAS unsigned char* W8L = (LAS unsigned char*)(F.lds + P7_W8); LAS float* SWL = (LAS float*)(F.lds + P7_SW);
        for (int tb = 0; tb < TPB / NWAVES; tb += 8) {
            float nsu_[8][2], su_[8][2], sv_[8][2], gt_[8][2], ac_[8][2], sx_[8], xo_[8];
#pragma unroll
            for (int i = 0; i < 8; ++i) { const int tl = tw + tb + i, t = m0 + tl; sx_[i] = SX[t]; xo_[i] = 8.f * SXQ[t];
#pragma unroll
                for (int kq = 0; kq < 2; ++kq) { const int k = lane + 64 * kq; const unsigned e = EIDL[tl * 128 + k]; ac_[i][kq] = ACT[tl * 128 + k];
                    nsu_[i][kq] = NSU[e]; su_[i][kq] = SU[e]; sv_[i][kq] = SV[e]; gt_[i][kq] = __builtin_nontemporal_load(GATE + (size_t)t * 128 + k); } }
#pragma unroll
            for (int i = 0; i < 8; ++i) { const int tl = tw + tb + i; float wv[2];
#pragma unroll
                for (int kq = 0; kq < 2; ++kq) { const float a = (ac_[i][kq] - 128.f * nsu_[i][kq] - xo_[i]) * su_[i][kq] * sx_[i];
                    wv[kq] = gt_[i][kq] * gelu_erf(a) * sv_[i][kq]; }
                const float am = wave_max(fmaxf(fabsf(wv[0]), fabsf(wv[1])));
                const float sc = am > 0.f ? am * (1.f / 127.f) : 1.f, inv = 1.f / sc;
                float wsum = 0.f;
#pragma unroll
                for (int kq = 0; kq < 2; ++kq) { const int k = lane + 64 * kq; const float q = rintf(wv[kq] * inv); wsum += q; W8L[tl * 128 + k] = (unsigned char)((int)q & 255); }
                wsum = wave_sum(wsum);
                if (lane == 0) { SWL[tl] = sc; SWL[128 + tl] = 8.f * wsum; } }
        } }
        LDS_WAIT();
        SEC_END(12); SEC_BEGIN(13);
        SEC_REP(13) {
        { const bf16* X1 = F.ws<bf16>(WS_Y1); const unsigned char* V8 = F.ws<unsigned char>(WS_V8); bf16* Y2 = F.ws<bf16>(WS_QP);
#define V_ISSUE(n_, PC, WQ) do { const int c_ = (n_) >> 4, tl_ = tw + (((n_) >> 3) & 1) * 8 + g8, s_ = (n_) & 7; \
            const LAS unsigned short* ep_ = EIDL + tl_ * 128 + 16 * s_; const unsigned char* vb_ = V8 + (size_t)c_ * (NEXP * PCH); const unsigned j16_ = 16u * (unsigned)j8;     \
            _Pragma("unroll") for (int i = 0; i < 16; ++i) { const unsigned e_ = ep_[i]; PC[i] = *(const GAS v4u*)(vb_ + (e_ * PCH + j16_)); } \
            WQ = *(const LAS v4u*)(F.lds + P7_W8 + tl_ * 128 + 16 * s_); } while (0)
#define V_TR4(A_, B_, C_, D_, WQ_, O_) do { const unsigned t0_ = __builtin_amdgcn_perm(B_, A_, 0x05010400u), t1_ = __builtin_amdgcn_perm(B_, A_, 0x07030602u), t2_ = __builtin_amdgcn_perm(D_, C_, 0x05010400u), t3_ = __builtin_amdgcn_perm(D_, C_, 0x07030602u); \
            const unsigned u0_ = __builtin_amdgcn_perm(t2_, t0_, 0x05040100u), u1_ = __builtin_amdgcn_perm(t2_, t0_, 0x07060302u), u2_ = __builtin_amdgcn_perm(t3_, t1_, 0x05040100u), u3_ = __builtin_amdgcn_perm(t3_, t1_, 0x07060302u); \
              \
            ac_[(O_) + 0] = __builtin_amdgcn_sdot4((int)(u0_ & 0x0f0f0f0fu), (int)(WQ_), ac_[(O_) + 0], false); ac_[(O_) + 4] = __builtin_amdgcn_sdot4((int)u0_, (int)(WQ_), ac_[(O_) + 4], false); \
            ac_[(O_) + 1] = __builtin_amdgcn_sdot4((int)(u1_ & 0x0f0f0f0fu), (int)(WQ_), ac_[(O_) + 1], false); ac_[(O_) + 5] = __builtin_amdgcn_sdot4((int)u1_, (int)(WQ_), ac_[(O_) + 5], false); \
            ac_[(O_) + 2] = __builtin_amdgcn_sdot4((int)(u2_ & 0x0f0f0f0fu), (int)(WQ_), ac_[(O_) + 2], false); ac_[(O_) + 6] = __builtin_amdgcn_sdot4((int)u2_, (int)(WQ_), ac_[(O_) + 6], false); \
            ac_[(O_) + 3] = __builtin_amdgcn_sdot4((int)(u3_ & 0x0f0f0f0fu), (int)(WQ_), ac_[(O_) + 3], false); ac_[(O_) + 7] = __builtin_amdgcn_sdot4((int)u3_, (int)(WQ_), ac_[(O_) + 7], false); } while (0)
#define V_ACC(PC, WQ) do { const unsigned wq_[4] = {WQ.x, WQ.y, WQ.z, WQ.w}; \
            _Pragma("unroll") for (int gq = 0; gq < 4; ++gq) { \
                const unsigned pa_[4] = {PC[4 * gq].x, PC[4 * gq].y, PC[4 * gq].z, PC[4 * gq].w}, pb_[4] = {PC[4 * gq + 1].x, PC[4 * gq + 1].y, PC[4 * gq + 1].z, PC[4 * gq + 1].w}; \
                const unsigned pc_[4] = {PC[4 * gq + 2].x, PC[4 * gq + 2].y, PC[4 * gq + 2].z, PC[4 * gq + 2].w}, pd_[4] = {PC[4 * gq + 3].x, PC[4 * gq + 3].y, PC[4 * gq + 3].z, PC[4 * gq + 3].w}; \
                _Pragma("unroll") for (int m = 0; m < 4; ++m) { \
                    V_TR4(pa_[m], pb_[m], pc_[m], pd_[m], wq_[gq], 8 * m); } } } while (0)
#define V_FIN(n_, XP) do { const int c_ = (n_) >> 4, tl_ = tw + (((n_) >> 3) & 1) * 8 + g8; \
            const LAS float* swp_ = (const LAS float*)(F.lds + P7_SW); const float sw_ = swp_[tl_], wo_ = swp_[128 + tl_]; \
            const f32x2 ms_ = *(const LAS f32x2*)(F.lds + P7_LNSL + tl_ * 8); const int dim0_ = c_ * VCH + 8 * j8;     \
            _Pragma("unroll") for (int m = 0; m < 4; ++m) { \
                const f32x4 g0_ = *(const LAS f32x4*)(F.lds + P7_G1 + (dim0_ + 64 * m) * 4), g1_ = *(const LAS f32x4*)(F.lds + P7_G1 + (dim0_ + 64 * m + 4) * 4), b0_ = *(const LAS f32x4*)(F.lds + P7_B1 + (dim0_ + 64 * m) * 4), b1_ = *(const LAS f32x4*)(F.lds + P7_B1 + (dim0_ + 64 * m + 4) * 4); \
                const unsigned xw_[4] = {XP[m].x, XP[m].y, XP[m].z, XP[m].w}; float o_[8]; \
                _Pragma("unroll") for (int i = 0; i < 4; ++i) { const float yl_ = (i & 1) ? bfhi(xw_[i >> 1]) : bflo(xw_[i >> 1]), yh_ = (i & 1) ? bfhi(xw_[2 + (i >> 1)]) : bflo(xw_[2 + (i >> 1)]); \
                    o_[i] = ((float)ac_[8 * m + i] - wo_) * sw_ + DN_ALPHA * ((yl_ - ms_.x) * ms_.y * g0_[i] + b0_[i]); \
                    o_[4 + i] = (float)((ac_[8 * m + 4 + i] - ac_[8 * m + i]) >> 4) * sw_ + DN_ALPHA * ((yh_ - ms_.x) * ms_.y * g1_[i] + b1_[i]); } \
                *(GAS v4u*)(Y2 + (size_t)(m0 + tl_) * D + dim0_ + 64 * m) = (v4u){pg8::cvt_pk_bf16(o_[0], o_[1]), pg8::cvt_pk_bf16(o_[2], o_[3]), pg8::cvt_pk_bf16(o_[4], o_[5]), pg8::cvt_pk_bf16(o_[6], o_[7])}; } \
            _Pragma("unroll") for (int d = 0; d < 32; ++d) ac_[d] = 0; } while (0)
          constexpr int VCH = 256, NSTEP = (D / VCH) * (TPB / NWAVES);
          v4u pcA[16], pcB[16], wqA, wqB, xp[4]; int ac_[32];
#pragma unroll
          for (int d = 0; d < 32; ++d) ac_[d] = 0;
          V_ISSUE(0, pcA, wqA);
          for (int n = 0; n < NSTEP; n += 2) {
              const bool fin = (n & 7) == 6;
              if (fin) { const int c_ = (n + 1) >> 4, tl_ = tw + (((n + 1) >> 3) & 1) * 8 + g8; const GAS v4u* xq_ = (const GAS v4u*)(X1 + (size_t)(m0 + tl_) * D + c_ * VCH + 8 * j8);
#pragma unroll
                  for (int m = 0; m < 4; ++m) xp[m] = __builtin_nontemporal_load(xq_ + 8 * m); }
              V_ISSUE(n + 1, pcB, wqB); __builtin_amdgcn_sched_barrier(0);
              V_ACC(pcA, wqA); __builtin_amdgcn_sched_barrier(0);
              { const int nn = (n + 2 < NSTEP) ? n + 2 : n; V_ISSUE(nn, pcA, wqA); }
              __builtin_amdgcn_sched_barrier(0);
              V_ACC(pcB, wqB);
              if (fin) V_FIN(n + 1, xp);
              __builtin_amdgcn_sched_barrier(0);
          }
#undef V_TR4
#undef V_ISSUE
#undef V_ACC
#undef V_FIN
        }
        }
        SEC_END(13); SEC_BEGIN(14);
        SEC_REP(14) {
        { float* outp = F.outp(); const bf16* Y2 = F.ws<bf16>(WS_QP);
        v4u nx[4];
        { const GAS v4u* yp = (const GAS v4u*)(Y2 + (size_t)(m0 + tw) * D) + lane;
#pragma unroll
          for (int j = 0; j < 4; ++j) nx[j] = __builtin_nontemporal_load(yp + 64 * j); }
        for (int ti = 0; ti < TPB / NWAVES; ++ti) {
            const int t = m0 + tw + ti;
            float v[32]; float s = 0.f;
#pragma unroll
            for (int j = 0; j < 4; ++j) { const unsigned ww[4] = {nx[j].x, nx[j].y, nx[j].z, nx[j].w};
#pragma unroll
                for (int i = 0; i < 4; ++i) { v[8 * j + 2 * i] = bflo(ww[i]); v[8 * j + 2 * i + 1] = bfhi(ww[i]); s += v[8 * j + 2 * i] + v[8 * j + 2 * i + 1]; } }
            { const int tn = (ti + 1 < TPB / NWAVES) ? t + 1 : t; const GAS v4u* yp = (const GAS v4u*)(Y2 + (size_t)tn * D) + lane;
#pragma unroll
              for (int j = 0; j < 4; ++j) nx[j] = __builtin_nontemporal_load(yp + 64 * j); }
            const float mean = wave_sum(s) * (1.f / D); float qv = 0.f;
#pragma unroll
            for (int i = 0; i < 32; ++i) { v[i] -= mean; qv += v[i] * v[i]; }
            const float rstd = 1.f / sqrtf(wave_sum(qv) * (1.f / D) + LN_EPS);
#pragma unroll
            for (int j = 0; j < 4; ++j) { const int c0 = 8 * lane + 512 * j; const f32x4 g0 = *(const LAS f32x4*)(F.lds + P7_G2 + c0 * 4), g1 = *(const LAS f32x4*)(F.lds + P7_G2 + c0 * 4 + 16), b0 = *(const LAS f32x4*)(F.lds + P7_B2 + c0 * 4), b1 = *(const LAS f32x4*)(F.lds + P7_B2 + c0 * 4 + 16);
                f32x4 r0, r1;
#pragma unroll
                for (int i = 0; i < 4; ++i) { r0[i] = v[8 * j + i] * rstd * g0[i] + b0[i]; r1[i] = v[8 * j + 4 + i] * rstd * g1[i] + b1[i]; }
                GAS f32x4* op = (GAS f32x4*)(outp + (size_t)t * D + c0); __builtin_nontemporal_store(r0, op); __builtin_nontemporal_store(r1, op + 1); }
        } }
        }
        SEC_END(14);
        __syncthreads();
    }
}

struct Args { const float* in[22]; float* out; unsigned char* ws; int ph_lo, ph_hi; };
__global__ void __launch_bounds__(NWAVES * 64, 2) mk_fwd(Args args) {
    extern __shared__ __attribute__((aligned(16))) unsigned char lds[];
    cg::grid_group grid = cg::this_grid();
    Frame F;
    F.lds = (LAS unsigned char*)lds;
    if (threadIdx.x == 0) { LAS unsigned long long* PT = (LAS unsigned long long*)(F.lds + RING_BYTES);
#pragma unroll
        for (int k = 0; k < 22; ++k) PT[k] = (unsigned long long)args.in[k];
        PT[22] = (unsigned long long)args.out; PT[23] = (unsigned long long)args.ws;
        ((LAS unsigned*)(F.lds + RING_BYTES + 256))[0] = 0u; ((LAS unsigned*)(F.lds + RING_BYTES + 256))[1] = 0u; }
    __syncthreads();
    const int lo = args.ph_lo, hi = args.ph_hi;
#ifndef PHASE_MASK
#define PHASE_MASK 255
#endif
#define IN(k) (((PHASE_MASK >> (k)) & 1) && lo <= (k) && (k) < hi)
#ifndef REPEAT_PHASE
#define REPEAT_PHASE -1
#endif
#define REP(k) for (int rep_ = 0; rep_ < ((REPEAT_PHASE == (k)) ? 2 : 1); ++rep_)
    (void)xcd_barrier_post((unsigned*)args.ws, (volatile LAS unsigned*)(F.lds + RING_BYTES + 256));
#define XBAR() do { XcdBarrier bar_; bar_.bar = F.ws<unsigned>(0); bar_.x = xb_xcc_id(); bar_.st = (volatile LAS unsigned*)(F.lds + RING_BYTES + 256); xcd_barrier(bar_); } while (0)
#define SEAM(k) do { if (IN(k) && IN((k) + 1)) XBAR(); } while (0)

    if (lo < 0) grid.sync();
    if (IN(0)) REP(0) { SEC_BEGIN(0); p0a_prologue(F); XBAR(); p0b_prologue(F); SEC_END(0); } SEAM(0);
    if (IN(1)) REP(1) { SEC_BEGIN(1);
        pg8::Gemm g{F.ws<bf16>(WS_XB), F.ws<bf16>(WS_WIN), M, NPROJ, D / 2}; pg8::StaticOrder S; S.init(M, NPROJ, F.G_(), (int)blockIdx.x);
        pg8::EpiProjI8 E{F.ws<bf16>(WS_Q), (size_t)(WS_K - WS_Q) / 2, dattn::C2, F.ws<bf16>(WS_H), F.in(I_BGLU), F.ws<float>(WS_SXA), F.ws<float>(WS_SWIN)};
        pg8::gemm_phase<pg8::EpiProjI8, pg8::StaticOrder, PG8_ALIGN, PG8_SP2>(F.lds, g, S, E);
    SEC_END(1); } SEAM(1);
    if (IN(2)) REP(2) { SEC_BEGIN(2);
        static_assert(dattn::LDS_BYTES <= RING_BYTES, "attention body geometry vs frame");
        const dattn::Tensors AT{F.ws<const dattn::bf16>(WS_Q), F.ws<const dattn::bf16>(WS_K), F.ws<const dattn::bf16>(WS_V), F.ws<dattn::bf16>(WS_O1), F.ws<const float>(WS_TAB), F.in(I_SUBLN), diff_lambda(F)};
        dattn::phase((char*)lds, AT, F.vcu_());
    SEC_END(2); } SEAM(2);
    if (IN(3)) REP(3) { SEC_BEGIN(3); p3_mix(F); SEC_END(3); } SEAM(3);
    if (IN(4)) REP(4) { SEC_BEGIN(4);
        pg8::Gemm g{F.ws<bf16>(WS_XB), F.ws<bf16>(WS_WOUT), M, D, D / 2}; pg8::StaticOrder S; S.init(M, D, F.G_(), (int)blockIdx.x);
        pg8::EpiResI8 E{F.in(I_X), F.ws<bf16>(WS_Y1), D, DN_ALPHA, F.ws<float>(WS_SM), F.ws<float>(WS_SWOUT)};
        pg8::gemm_phase<pg8::EpiResI8, pg8::StaticOrder, PG8_ALIGN, PG8_SP2>(F.lds, g, S, E);
    SEC_END(4); } SEAM(4);
    if (IN(5)) REP(5) { SEC_BEGIN(5); p5_ln1(F); SEC_END(5); } SEAM(5);
    if (IN(6)) REP(6) { SEC_BEGIN(6);
        pg8::Gemm g{F.ws<bf16>(WS_X8), F.ws<bf16>(WS_WQ), M, D, D / 2}; pg8::StaticOrder S; S.init(M, D, F.G_(), (int)blockIdx.x);
        pg8::EpiPlainI8 E{F.ws<bf16>(WS_QP), D, F.ws<float>(WS_SX), F.ws<float>(WS_SWQ)};
        pg8::gemm_phase<pg8::EpiPlainI8, pg8::StaticOrder, PG8_ALIGN, PG8_SP2>(F.lds, g, S, E);
    SEC_END(6); } SEAM(6);
    if (IN(7)) REP(7) { SEC_BEGIN(7); p7_peer(F); SEC_END(7); }
#ifdef PROBE_XBARS
    for (int xb_i = 0; xb_i < PROBE_XBARS; ++xb_i) XBAR();
#endif
#undef IN
#undef SEAM
}

extern "C" void kernel_launch(void* const* d_in, const int* in_sizes, int n_in, void* d_out, int out_size, void* d_ws, size_t ws_size, hipStream_t stream) {
    static int grid = 0;
    if (grid == 0) {
        if (n_in != 22 || in_sizes[0] != M * D || out_size != M * D || ws_size < WS_END) { fprintf(stderr, "kernel_launch: unexpected shapes (n_in %d, in0 %d, out %d, ws %zu); nothing launched\n", n_in, n_in > 0 ? in_sizes[0] : -1, out_size, ws_size); grid = -1; return; }
        int dev = 0, cus = 0, per_cu = 0;
        if (hipGetDevice(&dev) != hipSuccess || hipDeviceGetAttribute(&cus, hipDeviceAttributeMultiprocessorCount, dev) != hipSuccess) { grid = -1; return; }
        if (hipFuncSetAttribute((const void*)mk_fwd, hipFuncAttributeMaxDynamicSharedMemorySize, LDS_BYTES) != hipSuccess) { fprintf(stderr, "kernel_launch: hipFuncSetAttribute failed\n"); grid = -1; return; }
        if (hipOccupancyMaxActiveBlocksPerMultiprocessor(&per_cu, (const void*)mk_fwd, NWAVES * 64, LDS_BYTES) != hipSuccess || per_cu < 1) { fprintf(stderr, "kernel_launch: occupancy query reports %d workgroups per CU\n", per_cu); (void)hipGetLastError(); grid = -1; return; }
        grid = cus;
        if (grid > 256) grid = 256;
    }
    if (grid < 0) return;
    if (hipMemsetAsync(d_ws, 0, 65536, stream) != hipSuccess) { fprintf(stderr, "kernel_launch: hipMemsetAsync failed\n"); return; }
    Args a{};
    for (int i = 0; i < 22; ++i) a.in[i] = (const float*)d_in[i];
    a.out = (float*)d_out; a.ws = (unsigned char*)d_ws;
    constexpr int NL = MK_N_LAUNCHES;
    for (int li = 0; li < NL; ++li) {
        a.ph_lo = (NL == 1) ? 0 : li; a.ph_hi = (NL == 1) ? N_PHASES : li + 1;
        void* kargs[] = {&a};
        const hipError_t le = hipLaunchCooperativeKernel((const void*)mk_fwd, dim3(grid), dim3(NWAVES * 64), kargs, LDS_BYTES, stream);
        if (le != hipSuccess) { fprintf(stderr, "kernel_launch: cooperative launch %d failed: %s (grid %d)\n", li, hipGetErrorString(le), grid); break; }
    }
}
```
